# Optimizing an MI355X kernel written in HIP

```python
import numpy as np
import jax, jax.numpy as jnp
from jax import lax

D_MODEL = 1024
BATCH = 2
SEQ = 8192
DEPTH = 2
DEC_BATCH = 32
DEC_SEQ = 8
PAST_LEN = 16384
PAGE_SIZE = 128

DSA_HEAD_DIM = 64
DSA_HEADS = (D_MODEL // 4) // DSA_HEAD_DIM
DSA_PATTERNS = ((128, 1), (512, 4), (2048, 16))
DSA_MAX_WINDOW = 2048
ROPE_THETA = 10000.0
Q_BLOCK = 128
RET_HEAD_DIM = 64
RET_HEADS = (D_MODEL // 4) // RET_HEAD_DIM
GDN_HEAD_DIM = 128
GDN_HEADS = (D_MODEL // 2) // GDN_HEAD_DIM
CONV_WIDTH = 4
CHUNK = 64
DSA_W = DSA_HEADS * DSA_HEAD_DIM
RET_W = RET_HEADS * RET_HEAD_DIM
GDN_W = GDN_HEADS * GDN_HEAD_DIM
MIX_W = DSA_W + RET_W + GDN_W
CONV_DIM = 3 * GDN_W
IN_SIZES = (DSA_W, DSA_W, DSA_W, RET_W, RET_W, RET_W, RET_W, CONV_DIM, GDN_W, GDN_HEADS, GDN_HEADS)
IN_COLS = sum(IN_SIZES)
FFN_HIDDEN = ((-(-8 * D_MODEL // 3)) + 255) // 256 * 256
NORM_EPS = 1e-6

kernel_name = 'hybrid_dilated_retention_gdn_adaln_step'

F32 = jnp.float32


def rmsnorm(x, g):
    xf = x.astype(F32)
    y = xf * lax.rsqrt(jnp.mean(xf * xf, axis=-1, keepdims=True) + NORM_EPS)
    return (y * g.astype(F32)).astype(x.dtype)


def l2norm(x):
    xf = x.astype(F32)
    return xf * lax.rsqrt(jnp.sum(xf * xf, axis=-1, keepdims=True) + NORM_EPS)


def rope(x, pos, inv_freq):
    ang = pos.astype(F32)[:, None] * inv_freq[None, :]
    cos = jnp.cos(ang)[None, :, None, :]
    sin = jnp.sin(ang)[None, :, None, :]
    x1, x2 = jnp.split(x.astype(F32), 2, axis=-1)
    return jnp.concatenate([x1 * cos - x2 * sin, x1 * sin + x2 * cos], axis=-1).astype(x.dtype)


def dilated_attention(q, k_buf, v_buf, q_off):
    nbat, tq, nh, hd = q.shape
    qb = Q_BLOCK if tq % Q_BLOCK == 0 else tq
    nblk = tq // qb
    qs = q.reshape(nbat, nblk, qb, nh, hd).transpose(1, 0, 2, 3, 4)

    def block(args):
        qblk, b = args
        qf = qblk.astype(F32)
        rows = q_off + b * qb + jnp.arange(qb)
        lses, outs = [], []
        for window, dil in DSA_PATTERNS:
            idx = rows[:, None] - dil * jnp.arange(window // dil + 1)[None, :]
            valid = idx >= 0
            idx = jnp.maximum(idx, 0)
            kg = k_buf[:, idx].astype(F32)
            vg = v_buf[:, idx].astype(F32)
            s = jnp.einsum('bqhd,bqkhd->bhqk', qf, kg)
            s = jnp.where(valid[None, None], s, -jnp.inf)
            m = jnp.max(s, axis=-1, keepdims=True)
            p = jnp.exp(s - m)
            den = jnp.sum(p, axis=-1)
            o = jnp.einsum('bhqk,bqkhd->bqhd', p / den[..., None], vg)
            lses.append(jnp.transpose(m[..., 0] + jnp.log(den), (0, 2, 1)))
            outs.append(o)
        alpha = jax.nn.softmax(jnp.stack(lses, axis=0), axis=0)
        return jnp.sum(alpha[..., None] * jnp.stack(outs, axis=0), axis=0).astype(q.dtype)

    out = lax.map(block, (qs, jnp.arange(nblk)))
    return out.transpose(1, 0, 2, 3, 4).reshape(nbat, tq, nh, hd)


def retention(q, k, v, state, log_gamma):
    nbat, t, nh, dk = q.shape
    dv = v.shape[-1]
    cs = CHUNK if t % CHUNK == 0 else t
    n = t // cs
    chunks = lambda a: a.astype(F32).reshape(nbat, n, cs, nh, a.shape[-1]).transpose(1, 0, 3, 2, 4)
    qc, kc, vc = chunks(q), chunks(k), chunks(v)
    i = jnp.arange(cs, dtype=F32)
    diff = i[:, None] - i[None, :]
    causal = diff >= 0
    decay = jnp.where(causal[None], jnp.exp(log_gamma[:, None, None] * jnp.where(causal, diff, 0.0)[None]), 0.0)
    q_dec = jnp.exp(log_gamma[:, None] * (i[None, :] + 1.0))[None, :, :, None]
    k_dec = jnp.exp(log_gamma[:, None] * (cs - 1.0 - i)[None, :])[None, :, :, None]
    chunk_dec = jnp.exp(log_gamma * cs)[None, :, None, None]

    def step(s_prev, inp):
        qi, ki, vi = inp
        inner = jnp.einsum('bhqd,bhkd->bhqk', qi, ki) * decay[None]
        o = jnp.einsum('bhqk,bhkv->bhqv', inner, vi) + jnp.einsum('bhqd,bhdv->bhqv', qi, s_prev) * q_dec
        s_new = s_prev * chunk_dec + jnp.einsum('bhkd,bhkv->bhdv', ki * k_dec, vi)
        return s_new, o

    s_fin, o = lax.scan(step, state.astype(F32), (qc, kc, vc))
    o = o.transpose(1, 0, 3, 2, 4).reshape(nbat, t, nh, dv)
    return o.astype(q.dtype), s_fin.astype(state.dtype)


def gated_delta(q, k, v, g, beta, state):
    nbat, t, nh, dk = q.shape
    dv = v.shape[-1]
    cs = CHUNK if t % CHUNK == 0 else t
    n = t // cs
    chunks = lambda a: a.astype(F32).reshape(nbat, n, cs, nh, a.shape[-1]).transpose(1, 0, 3, 2, 4)
    qc = chunks(q) * (dk ** -0.5)
    kc, vc = chunks(k), chunks(v)
    bc = chunks(beta[..., None])[..., 0]
    gc = jnp.cumsum(chunks(g[..., None])[..., 0], axis=-1)
    ar = jnp.arange(cs)
    incl = ar[:, None] >= ar[None, :]
    strict = ar[:, None] > ar[None, :]
    eye = jnp.eye(cs, dtype=F32)

    def step(s_prev, inp):
        qi, ki, vi, bi, gi = inp
        gdiff = gi[..., :, None] - gi[..., None, :]
        dmask = jnp.where(incl, jnp.exp(jnp.where(incl, gdiff, 0.0)), 0.0)
        kb = ki * bi[..., None]
        lower = jnp.where(strict, jnp.einsum('bhid,bhjd->bhij', kb, ki) * dmask, 0.0)
        rhs = jnp.concatenate([vi * bi[..., None], kb * jnp.exp(gi)[..., None]], axis=-1)
        sol = lax.linalg.triangular_solve(eye + lower, rhs, left_side=True, lower=True, unit_diagonal=True)
        u, w = sol[..., :dv], sol[..., dv:]
        v_new = u - jnp.einsum('bhik,bhkv->bhiv', w, s_prev)
        attn = jnp.einsum('bhid,bhjd->bhij', qi, ki) * dmask
        o = jnp.einsum('bhid,bhdv->bhiv', qi * jnp.exp(gi)[..., None], s_prev) + jnp.einsum('bhij,bhjv->bhiv', attn, v_new)
        g_last = gi[..., -1]
        s_new = s_prev * jnp.exp(g_last)[..., None, None] + jnp.einsum(
            'bhjd,bhjv->bhdv', ki * jnp.exp(g_last[..., None] - gi)[..., None], v_new)
        return s_new, o

    s_fin, o = lax.scan(step, state.astype(F32), (qc, kc, vc, bc, gc))
    o = o.transpose(1, 0, 3, 2, 4).reshape(nbat, t, nh, dv)
    return o.astype(v.dtype), s_fin.astype(state.dtype)


def causal_conv(x, hist, w):
    t = x.shape[1]
    xp = jnp.concatenate([hist, x], axis=1)
    y = xp[:, 0:t] * w[0]
    for i in range(1, CONV_WIDTH):
        y = y + xp[:, i:i + t] * w[i]
    return jax.nn.silu(y), xp[:, xp.shape[1] - (CONV_WIDTH - 1):]


def mixer(h, pos, k_hist, v_hist, s_ret, s_gdn, conv_hist,
          w_in, ret_norm, conv_w, a_log, dt_bias, gdn_norm, w_out):
    nbat, t, _ = h.shape
    heads = lambda a, nh, d: a.reshape(nbat, t, nh, d)
    qa, ka, va, qr, kr, vr, gr, qkv_c, zc, beta_raw, a_raw = jnp.split(
        h @ w_in, np.cumsum(IN_SIZES)[:-1].tolist(), axis=-1)
    inv_a = 1.0 / (ROPE_THETA ** (jnp.arange(0, DSA_HEAD_DIM, 2, dtype=F32) / DSA_HEAD_DIM))
    qa = rope(heads(qa, DSA_HEADS, DSA_HEAD_DIM), pos, inv_a) * (DSA_HEAD_DIM ** -0.5)
    ka = rope(heads(ka, DSA_HEADS, DSA_HEAD_DIM), pos, inv_a)
    va = heads(va, DSA_HEADS, DSA_HEAD_DIM)
    oa = dilated_attention(qa, jnp.concatenate([k_hist, ka], axis=1),
                           jnp.concatenate([v_hist, va], axis=1), k_hist.shape[1])
    inv_r = 1.0 / (10000.0 ** jnp.linspace(0.0, 1.0, RET_HEAD_DIM // 2, dtype=F32))
    log_gamma = jnp.log(1.0 - 2.0 ** (-5.0 - jnp.arange(RET_HEADS, dtype=F32)))
    qr = rope(heads(qr, RET_HEADS, RET_HEAD_DIM), pos, inv_r)
    kr = rope(heads(kr, RET_HEADS, RET_HEAD_DIM), pos, inv_r) * (RET_HEAD_DIM ** -0.5)
    orr, s_ret_new = retention(qr, kr, heads(vr, RET_HEADS, RET_HEAD_DIM), s_ret, log_gamma)
    orr = rmsnorm(orr, ret_norm) * jax.nn.silu(heads(gr, RET_HEADS, RET_HEAD_DIM))
    qkv_c, conv_new = causal_conv(qkv_c, conv_hist, conv_w)
    qc, kc, vc = jnp.split(qkv_c, 3, axis=-1)
    qc = l2norm(heads(qc, GDN_HEADS, GDN_HEAD_DIM))
    kc = l2norm(heads(kc, GDN_HEADS, GDN_HEAD_DIM))
    vc = heads(vc, GDN_HEADS, GDN_HEAD_DIM)
    beta = jax.nn.sigmoid(beta_raw.astype(F32))
    g = -jnp.exp(a_log.astype(F32)) * jax.nn.softplus(a_raw.astype(F32) + dt_bias.astype(F32))
    oc, s_gdn_new = gated_delta(qc, kc, vc, g, beta, s_gdn)
    oc = rmsnorm(oc, gdn_norm) * jax.nn.silu(heads(zc, GDN_HEADS, GDN_HEAD_DIM))
    o = jnp.concatenate([oa.reshape(nbat, t, DSA_W), orr.reshape(nbat, t, RET_W),
                         oc.reshape(nbat, t, GDN_W)], axis=-1)
    return o @ w_out, ka, va, s_ret_new, s_gdn_new, conv_new


def trunk(x, c, pos, k_hist, v_hist, s_ret, s_gdn, conv_hist,
          ada_w, ada_b, norm_mix, norm_ffn, w_in, ret_norm, conv_w, a_log, dt_bias,
          gdn_norm, w_out, w_gate, w_up, w_down, final_norm):
    ks, vs, rs, gs, cs = [], [], [], [], []
    for l in range(DEPTH):
        mod = jax.nn.silu(c) @ ada_w[l] + ada_b[l]
        sh1, sc1, g1, sh2, sc2, g2 = [m[:, None, :] for m in jnp.split(mod, 6, axis=-1)]
        h = rmsnorm(x, norm_mix[l]) * (1 + sc1) + sh1
        o, ka, va, sr, sg, cv = mixer(h, pos, k_hist[l], v_hist[l], s_ret[l], s_gdn[l], conv_hist[l],
                                      w_in[l], ret_norm[l], conv_w[l], a_log[l], dt_bias[l],
                                      gdn_norm[l], w_out[l])
        x = x + g1 * o
        h = rmsnorm(x, norm_ffn[l]) * (1 + sc2) + sh2
        x = x + g2 * ((jax.nn.silu(h @ w_gate[l]) * (h @ w_up[l])) @ w_down[l])
        ks.append(ka); vs.append(va); rs.append(sr); gs.append(sg); cs.append(cv)
    return (rmsnorm(x, final_norm), jnp.stack(ks), jnp.stack(vs), jnp.stack(rs),
            jnp.stack(gs), jnp.stack(cs))


def setup_inputs(seed: int = 0) -> dict:
    key = jax.random.key(seed)
    ks = jax.random.split(key, 26)
    nrm = lambda k, shape, s: jax.random.normal(k, shape, F32) * s
    wb = min(DSA_MAX_WINDOW, PAST_LEN)
    dt = jnp.exp(jax.random.uniform(ks[20], (DEPTH, GDN_HEADS), F32, np.log(1e-3), np.log(1e-1)))
    return {
        'x_prompt': nrm(ks[0], (BATCH, SEQ, D_MODEL), 1.0),
        'x_sample': nrm(ks[1], (DEC_BATCH, DEC_SEQ, D_MODEL), 1.0),
        'cache_win_k': nrm(ks[2], (DEPTH, DEC_BATCH, wb, DSA_HEADS, DSA_HEAD_DIM), 1.0),
        'cache_win_v': nrm(ks[3], (DEPTH, DEC_BATCH, wb, DSA_HEADS, DSA_HEAD_DIM), 1.0),
        'state_ret': nrm(ks[4], (DEPTH, DEC_BATCH, RET_HEADS, RET_HEAD_DIM, RET_HEAD_DIM), 0.5),
        'state_gdn': nrm(ks[5], (DEPTH, DEC_BATCH, GDN_HEADS, GDN_HEAD_DIM, GDN_HEAD_DIM), 0.2),
        'state_conv': nrm(ks[6], (DEPTH, DEC_BATCH, CONV_WIDTH - 1, CONV_DIM), 1.0),
        'c_prompt': nrm(ks[7], (BATCH, D_MODEL), 1.0),
        'c_sample': nrm(ks[8], (DEC_BATCH, D_MODEL), 1.0),
        'ada_w': nrm(ks[9], (DEPTH, D_MODEL, 6 * D_MODEL), 0.5 * D_MODEL ** -0.5),
        'ada_b': nrm(ks[10], (DEPTH, 6 * D_MODEL), 0.02),
        'norm_mix': 1.0 + nrm(ks[11], (DEPTH, D_MODEL), 0.05),
        'norm_ffn': 1.0 + nrm(ks[12], (DEPTH, D_MODEL), 0.05),
        'w_in': nrm(ks[13], (DEPTH, D_MODEL, IN_COLS), D_MODEL ** -0.5),
        'ret_norm': 1.0 + nrm(ks[14], (DEPTH, RET_HEAD_DIM), 0.05),
        'conv_w': nrm(ks[15], (DEPTH, CONV_WIDTH, CONV_DIM), CONV_WIDTH ** -0.5),
        'a_log': jnp.log(jax.random.uniform(ks[16], (DEPTH, GDN_HEADS), F32, 1.0, 16.0)),
        'dt_bias': dt + jnp.log(-jnp.expm1(-dt)),
        'gdn_norm': 1.0 + nrm(ks[17], (DEPTH, GDN_HEAD_DIM), 0.05),
        'w_out': nrm(ks[18], (DEPTH, MIX_W, D_MODEL), MIX_W ** -0.5),
        'w_gate': nrm(ks[19], (DEPTH, D_MODEL, FFN_HIDDEN), D_MODEL ** -0.5),
        'w_up': nrm(ks[21], (DEPTH, D_MODEL, FFN_HIDDEN), D_MODEL ** -0.5),
        'w_down': nrm(ks[22], (DEPTH, FFN_HIDDEN, D_MODEL), FFN_HIDDEN ** -0.5),
        'final_norm': 1.0 + nrm(ks[23], (D_MODEL,), 0.05),
    }


def reference(x_prompt, x_sample, cache_win_k, cache_win_v, state_ret, state_gdn, state_conv,
              c_prompt, c_sample, ada_w, ada_b, norm_mix, norm_ffn, w_in, ret_norm, conv_w,
              a_log, dt_bias, gdn_norm, w_out, w_gate, w_up, w_down, final_norm):
    weights = (ada_w, ada_b, norm_mix, norm_ffn, w_in, ret_norm, conv_w, a_log, dt_bias,
               gdn_norm, w_out, w_gate, w_up, w_down, final_norm)
    nb, t_p, _ = x_prompt.shape
    dtp = x_prompt.dtype
    zk = jnp.zeros((DEPTH, nb, 0, DSA_HEADS, DSA_HEAD_DIM), dtp)
    zr = jnp.zeros((DEPTH, nb, RET_HEADS, RET_HEAD_DIM, RET_HEAD_DIM), dtp)
    zg = jnp.zeros((DEPTH, nb, GDN_HEADS, GDN_HEAD_DIM, GDN_HEAD_DIM), dtp)
    zc = jnp.zeros((DEPTH, nb, CONV_WIDTH - 1, CONV_DIM), dtp)
    pos_p = jnp.arange(t_p, dtype=jnp.int32)
    y_prompt, kp, vp, rp, gp, cp = trunk(x_prompt, c_prompt, pos_p, zk, zk, zr, zg, zc, *weights)
    pos_s = PAST_LEN + jnp.arange(x_sample.shape[1], dtype=jnp.int32)
    y_sample, ks, vs, rs, gs, cs = trunk(x_sample, c_sample, pos_s, cache_win_k, cache_win_v,
                                         state_ret, state_gdn, state_conv, *weights)
    return (y_prompt, y_sample, kp[:, :, -DSA_MAX_WINDOW:], vp[:, :, -DSA_MAX_WINDOW:], rp, gp, cp,
            ks, vs, rs, gs, cs)
```

```cpp
#ifndef __HIP_EMU__
#include <hip/hip_runtime.h>
#include <hip/hip_cooperative_groups.h>
#endif
#include <cstdio>
#include <cstdint>
#include <cmath>

#ifndef CFG_BATCH
#define CFG_BATCH 2
#endif
#ifndef CFG_SEQ
#define CFG_SEQ 8192
#endif
#ifndef CFG_DB
#define CFG_DB 32
#endif
constexpr int D = 1024, NL = 2, PB = CFG_BATCH, T = CFG_SEQ, DB = CFG_DB, DS = 8, PAST = 16384, WB = 2048;
constexpr int MP = PB * T, MS = DB * DS, M = MP + MS, MPAD = (M + 255) / 256 * 256, NC = PB + DB;
constexpr int INC = 3848, NPROJ = 3840, FF = 2816, NCH = T / 64, PWIN = T < 2048 ? T : 2048, NPOS = T + DS;
constexpr int NUNIT = PB * 4 * NCH;
constexpr float EPS = 1e-6f;
constexpr int C_QA = 0, C_KA = 256, C_VA = 512, C_QR = 768, C_KR = 1024, C_VR = 1280, C_GR = 1536, C_CONV = 1792, C_Z = 3328;
constexpr int SMEM_BYTES = 147456;
constexpr int NTHR = 512;

typedef unsigned short bf16_t;
typedef short bf16x8 __attribute__((ext_vector_type(8)));
typedef float f32x4 __attribute__((ext_vector_type(4)));
typedef unsigned u32x4 __attribute__((ext_vector_type(4)));
typedef unsigned u32x2 __attribute__((ext_vector_type(2)));

#ifdef __HIP_EMU__
#define LAUNCH(kern, grid, lds, stream, ...) emu_launch(grid, NTHR, [=]() { kern(__VA_ARGS__); })
#define DYN_SMEM(name) unsigned char* name = emu_dyn_smem()
#define WAVE_SYNC() emu_wave_bar()
#else
#define WAVE_SYNC() asm volatile("s_waitcnt lgkmcnt(0)" ::: "memory")
#define LAUNCH(kern, grid, lds, stream, ...) hipLaunchKernelGGL(kern, dim3(grid), dim3(NTHR), lds, stream, __VA_ARGS__)
#define DYN_SMEM(name) extern __shared__ __attribute__((aligned(16))) unsigned char name[]
#endif

#ifdef __HIP_EMU__
__device__ __forceinline__ int tidx() { return (int)threadIdx.x; }
#define LAUNDER_PTR(x)
#else
__device__ __forceinline__ int tidx() { int t = (int)threadIdx.x; asm volatile("" : "+v"(t)); return t; }
#define LAUNDER_PTR(x) asm volatile("" : "+s"(x))
#endif
__device__ __forceinline__ float bf2f(bf16_t v) { return __builtin_bit_cast(float, (unsigned)v << 16); }
__device__ __forceinline__ bf16_t f2bf(float f) { unsigned u = __builtin_bit_cast(unsigned, f); return (bf16_t)((u + 0x7fffu + ((u >> 16) & 1u)) >> 16); }
__device__ __forceinline__ unsigned pk2(float lo, float hi) { return (unsigned)f2bf(lo) | ((unsigned)f2bf(hi) << 16); }
__device__ __forceinline__ float silu_f(float x) { return x / (1.0f + expf(-x)); }
__device__ __forceinline__ float wave_sum(float v) {
#pragma unroll
    for (int o = 1; o < 64; o <<= 1) v += __shfl_xor(v, o);
    return v;
}
__device__ __forceinline__ float wave_max(float v) {
#pragma unroll
    for (int o = 1; o < 64; o <<= 1) v = fmaxf(v, __shfl_xor(v, o));
    return v;
}

struct P {
    const float *x_prompt, *x_sample, *cache_k, *cache_v, *state_ret, *state_gdn, *state_conv, *c_prompt, *c_sample, *ada_w, *ada_b, *norm_mix, *norm_ffn,
        *w_in, *ret_norm, *conv_w, *a_log, *dt_bias, *gdn_norm, *w_out, *w_gate, *w_up, *w_down, *final_norm;
    float* out; unsigned char* ws;
};

constexpr size_t O_YP = 0, O_YS = O_YP + (size_t)MP * D, O_PWK = O_YS + (size_t)MS * D, O_PWV = O_PWK + (size_t)NL * PB * PWIN * 256,
                 O_PRET = O_PWV + (size_t)NL * PB * PWIN * 256, O_PGDN = O_PRET + (size_t)NL * PB * 4 * 4096, O_PCONV = O_PGDN + (size_t)NL * PB * 4 * 16384,
                 O_SWK = O_PCONV + (size_t)NL * PB * 3 * 1536, O_SWV = O_SWK + (size_t)NL * DB * DS * 256, O_SRET = O_SWV + (size_t)NL * DB * DS * 256,
                 O_SGDN = O_SRET + (size_t)NL * DB * 4 * 4096, O_SCONV = O_SGDN + (size_t)NL * DB * 4 * 16384, O_END = O_SCONV + (size_t)NL * DB * 3 * 1536;

constexpr size_t al256(size_t x) { return (x + 255) / 256 * 256; }
constexpr size_t WS_CTL = 0, WS_CTL_BYTES = 1u << 20;
constexpr size_t WS_MOD = WS_CTL + WS_CTL_BYTES;
constexpr size_t WS_ROPE = al256(WS_MOD + (size_t)NL * NC * 6144 * 4);
constexpr size_t WS_WIN = al256(WS_ROPE + (size_t)4 * NPOS * 32 * 4);
constexpr size_t WS_WOUT = al256(WS_WIN + (size_t)NL * NPROJ * D * 2);
constexpr size_t WS_WGU = al256(WS_WOUT + (size_t)NL * D * D * 2);
constexpr size_t WS_WDN = al256(WS_WGU + (size_t)NL * 2 * FF * D * 2);
constexpr size_t WS_H = al256(WS_WDN + (size_t)NL * D * FF * 2);
constexpr size_t WS_PROJ = al256(WS_H + (size_t)MPAD * D * 2);
constexpr size_t WS_BETA = al256(WS_PROJ + (size_t)MPAD * NPROJ * 2);
constexpr size_t WS_G = al256(WS_BETA + (size_t)M * 4 * 4);
constexpr size_t WS_O = al256(WS_G + (size_t)M * 4 * 4);
constexpr size_t WS_RU = al256(WS_O + (size_t)MPAD * D * 2);
constexpr size_t WS_RS = al256(WS_RU + (size_t)NUNIT * 4096 * 4);
constexpr size_t WS_SCR = al256(WS_RS + (size_t)NUNIT * 4096 * 4);
constexpr size_t WS_GU = WS_SCR;
constexpr size_t WS_GW = al256(WS_GU + (size_t)NUNIT * 8192 * 4);
constexpr size_t WS_GQ = al256(WS_GW + (size_t)NUNIT * 8192 * 2);
constexpr size_t WS_GK = al256(WS_GQ + (size_t)NUNIT * 8192 * 2);
constexpr size_t WS_GA = al256(WS_GK + (size_t)NUNIT * 8192 * 2);
constexpr size_t WS_GD = al256(WS_GA + (size_t)NUNIT * 4096 * 2);
constexpr size_t WS_GV = al256(WS_GD + (size_t)NUNIT * 4);
constexpr size_t WS_GS = al256(WS_GV + (size_t)NUNIT * 8192 * 4);
constexpr size_t WS_GEND = al256(WS_GS + (size_t)NUNIT * 16384 * 4);
constexpr size_t WS_HID = WS_SCR;
constexpr size_t WS_HEND = al256(WS_HID + (size_t)MPAD * FF * 2);
constexpr size_t WS_END = WS_GEND > WS_HEND ? WS_GEND : WS_HEND;

#define WSP(T_, off) ((T_*)(p.ws + (off)))
__device__ __forceinline__ int row_cb(int r) { return r < MP ? r / T : PB + (r - MP) / DS; }
__device__ __forceinline__ int row_pi(int r) { return r < MP ? r % T : T + (r - MP) % DS; }
namespace pg8 {
#ifdef __HIP_EMU__
#define PG8_LAS
#else
#define PG8_LAS __attribute__((address_space(3)))
#endif
typedef unsigned short bf16_t;
typedef short bf16x8 __attribute__((ext_vector_type(8)));
typedef float f32x4 __attribute__((ext_vector_type(4)));
typedef unsigned u32x4 __attribute__((ext_vector_type(4)));
constexpr int BM = 256, BK = 64, HALF = 128, HTB = HALF * BK * 2  , STAGE_BYTES = 8 * HTB, NXCD = 8, WGM = 8;

__host__ __device__ __forceinline__ int lds_byte(int r, int c) { const int st = (r >> 4) * 2 + (c >> 5), rr = r & 15, cc = c & 31, ob = rr * 64 + cc * 2; return st * 1024 + (ob ^ (((ob >> 9) & 1) << 5)); }
__host__ __device__ __forceinline__ void stage_rc(int b, int& R, int& C) { const int st = b / 1024, sb = b % 1024, swz = sb ^ (((sb >> 9) & 1) << 5); R = (st >> 1) * 16 + swz / 64; C = (st & 1) * 32 + (swz % 64) / 2; }
__host__ __device__ __forceinline__ int perm32(int rho) { const int n = rho >> 4, i = rho & 15; return 8 * (i >> 2) + 4 * n + (i & 3); }

struct Unit { int pm, pn; };
struct Gemm { const bf16_t* A; const bf16_t* Bt; int M, N, K; };

struct StaticOrder {
    int nM, nN, nwg, G, c;
    __host__ __device__ void init(int M, int N, int G_, int c_) { nM = M / BM; nN = N / BM; nwg = nM * nN; G = G_; c = c_; }
    __host__ __device__ bool next(int i, Unit& u) const {
        const long L = (long)i * G + c; if (L >= nwg) return false;
        int wgid = (int)L; { const int q = nwg / NXCD, r = nwg % NXCD, xcd = wgid % NXCD, off = wgid / NXCD; wgid = (xcd < r ? xcd * (q + 1) : r * (q + 1) + (xcd - r) * q) + off; }
        const int nig = WGM * nN, gid = wgid / nig, fm = gid * WGM, gsz = (nM - fm) < WGM ? (nM - fm) : WGM;
        u.pm = fm + ((wgid % nig) % gsz); u.pn = (wgid % nig) / gsz; return true;
    }
    __device__ __forceinline__ void a_ready(const Unit&) const {}
    __device__ __forceinline__ void done(const Unit&) const {}
};


struct EpiStoreBf16 {
    static constexpr bool PERM = true, AFTER_DRAIN = false;
    bf16_t* O; int ldc;
    __device__ __forceinline__ void operator()(const f32x4 (&acc)[2][2][4][2], const Unit& u, int wr, int wc, int fr, int fq) const {
        const int row0 = u.pm * BM + wr * 64 + fr, col0 = u.pn * BM + wc * 32 + 8 * fq;
#pragma unroll
        for (int ai = 0; ai < 2; ++ai)
#pragma unroll
            for (int m = 0; m < 4; ++m) { bf16_t* rowp = O + (size_t)(row0 + ai * HALF + m * 16) * ldc + col0;
#pragma unroll
                for (int bj = 0; bj < 2; ++bj) { const f32x4 v0 = acc[ai][bj][m][0], v1 = acc[ai][bj][m][1];
                    u32x4 w; w.x = ::pk2(v0[0], v0[1]); w.y = ::pk2(v0[2], v0[3]); w.z = ::pk2(v1[0], v1[1]); w.w = ::pk2(v1[2], v1[3]);
                    *(u32x4*)(rowp + bj * HALF) = w; } }
    }
};
struct EpiResidual {
    static constexpr bool PERM = false, AFTER_DRAIN = false;
    float* X; const float* gate;
    __device__ __forceinline__ void operator()(const f32x4 (&acc)[2][2][4][2], const Unit& u, int wr, int wc, int fr, int fq) const {
        const int row0 = u.pm * BM + wr * 64 + fr, col0 = u.pn * BM + wc * 32 + 4 * fq;
#pragma unroll
        for (int ai = 0; ai < 2; ++ai)
#pragma unroll
            for (int m = 0; m < 4; ++m) { const int row = row0 + ai * HALF + m * 16;
                if (MPAD != M && row >= M) continue;
                const float* g = gate + (size_t)::row_cb(row) * 6144 + col0; float* xp = X + (size_t)row * D + col0;
#pragma unroll
                for (int bj = 0; bj < 2; ++bj)
#pragma unroll
                    for (int n = 0; n < 2; ++n) { const f32x4 gv = *(const f32x4*)(g + bj * HALF + n * 16); f32x4* xq = (f32x4*)(xp + bj * HALF + n * 16); *xq = *xq + gv * acc[ai][bj][m][n]; } }
    }
};
struct EpiSwiglu {
    static constexpr bool PERM = true, AFTER_DRAIN = false;
    bf16_t* Hd;
    __device__ __forceinline__ void operator()(const f32x4 (&acc)[2][2][4][2], const Unit& u, int wr, int wc, int fr, int fq) const {
        const int row0 = u.pm * BM + wr * 64 + fr, col0 = u.pn * HALF + wc * 32 + 8 * fq;
#pragma unroll
        for (int ai = 0; ai < 2; ++ai)
#pragma unroll
            for (int m = 0; m < 4; ++m) { bf16_t* rowp = Hd + (size_t)(row0 + ai * HALF + m * 16) * FF + col0;
                float v[8];
#pragma unroll
                for (int n = 0; n < 2; ++n)
#pragma unroll
                    for (int j = 0; j < 4; ++j) { const float gt = acc[ai][0][m][n][j], up = acc[ai][1][m][n][j]; v[4 * n + j] = ::silu_f(gt) * up; }
                u32x4 w; w.x = ::pk2(v[0], v[1]); w.y = ::pk2(v[2], v[3]); w.z = ::pk2(v[4], v[5]); w.w = ::pk2(v[6], v[7]);
                *(u32x4*)rowp = w; }
    }
};

#ifdef __HIP_EMU__
template <class Epi, class Sched, bool ALIGN_EPI = false, bool SP2 = false>
__device__ __forceinline__ void gemm_phase(unsigned char* lds, const Gemm g, const Sched& S, const Epi& E) {
    const int tid = threadIdx.x, wid = tid >> 6, lane = tid & 63, wr = wid >> 2, wc = wid & 3, fr = lane & 15, fq = lane >> 4;
    Unit cur;
    for (int ui = 0; S.next(ui, cur); ++ui) {
        f32x4 acc[2][2][4][2];
        for (int ai = 0; ai < 2; ++ai) for (int bj = 0; bj < 2; ++bj) for (int m = 0; m < 4; ++m) for (int n = 0; n < 2; ++n) for (int j = 0; j < 4; ++j) {
            const int row = 256 * cur.pm + 128 * ai + 64 * wr + 16 * m + fr;
            const int col = Epi::PERM ? 256 * cur.pn + 128 * bj + 32 * wc + 8 * fq + 4 * n + j : 256 * cur.pn + 128 * bj + 32 * wc + 16 * n + 4 * fq + j;
            const bf16_t* a = g.A + (size_t)row * g.K; const bf16_t* b = g.Bt + (size_t)col * g.K; float s = 0.f;
            for (int k = 0; k < g.K; ++k) s += ::bf2f(a[k]) * ::bf2f(b[k]);
            acc[ai][bj][m][n][j] = s; }
        E(acc, cur, wr, wc, fr, fq);
    }
}
#else
template <class Epi, class Sched, bool ALIGN_EPI = false, bool SP2 = false>
__device__ __forceinline__ void gemm_phase(PG8_LAS unsigned char* lds, const Gemm g, const Sched& S, const Epi& E) {
    const int tid = ::tidx(), wid = __builtin_amdgcn_readfirstlane(tid >> 6), lane = tid & 63, wr = wid >> 2, wc = wid & 3, fr = lane & 15, fq = lane >> 4;
    const int K = g.K, nt = K / BK;
    unsigned voffA[2], voffB[2];
#pragma unroll
    for (int i = 0; i < 2; ++i) { int R, C; stage_rc(tid * 16 + i * 8192, R, C); const int Rb = Epi::PERM ? ((R & ~31) + perm32(R & 31)) : R;
        voffA[i] = (unsigned)(R * K + C) * 2u; voffB[i] = (unsigned)(Rb * K + C) * 2u; }
    const size_t kstep = (size_t)(BK * 2);
    const size_t hstep = (size_t)HALF * K * 2;
    const size_t tstep = 2 * hstep;
    const unsigned ldsw = (unsigned)wid * 1024u;
    const int aoff = lds_byte(wr * 64 + fr, fq * 8), boff = lds_byte(wc * 32 + fr, fq * 8);
#define PG8_SA(b, h) (((b) * 2 + (h)) * HTB)
#define PG8_SB(b, h) ((4 + (b) * 2 + (h)) * HTB)
#define PG8_STAGE(bufoff, gbase, voff) do { _Pragma("unroll") for (int _i = 0; _i < 2; ++_i) \
        __builtin_amdgcn_global_load_lds((const unsigned*)((const char*)(gbase) + (voff)[_i]), (PG8_LAS unsigned*)(lds + (bufoff) + ldsw + _i * 8192), 16, 0, 0); } while (0)
#define PG8_LDA(dst, b, h) do { _Pragma("unroll") for (int m = 0; m < 4; ++m) _Pragma("unroll") for (int k = 0; k < 2; ++k) dst[m][k] = *(const PG8_LAS bf16x8*)(lds + PG8_SA(b, h) + aoff + m * 2048 + k * 1024); } while (0)
#define PG8_LDB(dst, b, h) do { _Pragma("unroll") for (int n = 0; n < 2; ++n) _Pragma("unroll") for (int k = 0; k < 2; ++k) dst[n][k] = *(const PG8_LAS bf16x8*)(lds + PG8_SB(b, h) + boff + n * 2048 + k * 1024); } while (0)
#define PG8_MMA(ai, bj, At, Bt) do { __builtin_amdgcn_s_setprio(1); _Pragma("unroll") for (int m = 0; m < 4; ++m) _Pragma("unroll") for (int n = 0; n < 2; ++n) _Pragma("unroll") for (int k = 0; k < 2; ++k) \
        acc[ai][bj][m][n] = __builtin_amdgcn_mfma_f32_16x16x32_bf16(Bt[n][k], At[m][k], acc[ai][bj][m][n], 0, 0, 0); __builtin_amdgcn_s_setprio(0); } while (0)
#define PG8_WAIT_V(n) asm volatile("s_waitcnt vmcnt(" #n ")" ::: "memory")
#define PG8_WAIT_L(n) asm volatile("s_waitcnt lgkmcnt(" #n ")" ::: "memory")
#define PG8_BAR __builtin_amdgcn_s_barrier()
#define PG8_SCHED __builtin_amdgcn_sched_barrier(0)
    Unit cur, nxt; int ui = 0;
    if (!S.next(0, cur)) return;
    f32x4 acc[2][2][4][2];
#pragma unroll
    for (int a = 0; a < 2; ++a)
#pragma unroll
        for (int b = 0; b < 2; ++b)
#pragma unroll
            for (int m = 0; m < 4; ++m)
#pragma unroll
                for (int n = 0; n < 2; ++n) acc[a][b][m][n] = (f32x4){0.f, 0.f, 0.f, 0.f};
    bf16x8 At[4][2], B0[2][2], B1[2][2];
    const char* cA = (const char*)g.A + (size_t)cur.pm * tstep; const char* cB = (const char*)g.Bt + (size_t)cur.pn * tstep;
    S.a_ready(cur);
    if constexpr (SP2) {
        PG8_STAGE(PG8_SB(0, 0), cB, voffB); PG8_STAGE(PG8_SB(0, 1), cB + hstep, voffB); PG8_STAGE(PG8_SA(0, 0), cA, voffA); PG8_STAGE(PG8_SA(0, 1), cA + hstep, voffA);
        if (wr == 1) PG8_BAR;
        PG8_WAIT_V(2); PG8_BAR;
        PG8_STAGE(PG8_SB(1, 0), cB + kstep, voffB); PG8_STAGE(PG8_SA(1, 0), cA + kstep, voffA); PG8_STAGE(PG8_SB(1, 1), cB + hstep + kstep, voffB);
        PG8_WAIT_V(6); PG8_BAR;
    } else {
        PG8_STAGE(PG8_SB(0, 0), cB, voffB); PG8_STAGE(PG8_SA(0, 0), cA, voffA); PG8_STAGE(PG8_SB(0, 1), cB + hstep, voffB); PG8_STAGE(PG8_SA(0, 1), cA + hstep, voffA);
        if (wr == 1) PG8_BAR;
        PG8_WAIT_V(4); PG8_BAR;
        PG8_STAGE(PG8_SB(1, 0), cB + kstep, voffB); PG8_STAGE(PG8_SA(1, 0), cA + kstep, voffA); PG8_STAGE(PG8_SB(1, 1), cB + hstep + kstep, voffB);
        PG8_WAIT_V(6); PG8_BAR;
    }
    for (;;) {
        const bool has_next = S.next(ui + 1, nxt);
        const char* nA = has_next ? (const char*)g.A + (size_t)nxt.pm * tstep : cA; const char* nB = has_next ? (const char*)g.Bt + (size_t)nxt.pn * tstep : cB;
        for (int t = 0; t < nt; t += 2) {
            const bool last = (t == nt - 2);
            const char* a1 = cA + (size_t)(t + 1) * kstep;
            const char* a2 = last ? nA : cA + (size_t)(t + 2) * kstep; const char* b2 = last ? nB : cB + (size_t)(t + 2) * kstep;
            const char* a3 = a2 + kstep; const char* b3 = b2 + kstep;
            if (last && has_next) S.a_ready(nxt);
            if constexpr (SP2) {
            PG8_LDB(B0, 0, 0); PG8_LDB(B1, 0, 1); PG8_SCHED; PG8_LDA(At, 0, 0); PG8_STAGE(PG8_SA(1, 1), a1 + hstep, voffA);
            PG8_WAIT_V(8); PG8_WAIT_L(0); PG8_BAR; PG8_MMA(0, 0, At, B0); PG8_MMA(0, 1, At, B1); PG8_BAR; PG8_SCHED;
            PG8_LDA(At, 0, 1); PG8_STAGE(PG8_SB(0, 0), b2, voffB); PG8_STAGE(PG8_SB(0, 1), b2 + hstep, voffB); PG8_STAGE(PG8_SA(0, 0), a2, voffA);
            PG8_WAIT_V(8); PG8_WAIT_L(0); PG8_BAR; PG8_MMA(1, 0, At, B0); PG8_MMA(1, 1, At, B1); PG8_BAR; PG8_SCHED;
            PG8_LDB(B0, 1, 0); PG8_LDB(B1, 1, 1); PG8_SCHED; PG8_LDA(At, 1, 0); PG8_STAGE(PG8_SA(0, 1), a2 + hstep, voffA);
            PG8_WAIT_V(8); PG8_WAIT_L(0); PG8_BAR; PG8_MMA(0, 0, At, B0); PG8_MMA(0, 1, At, B1); PG8_BAR; PG8_SCHED;
            PG8_LDA(At, 1, 1); PG8_STAGE(PG8_SB(1, 0), b3, voffB); PG8_STAGE(PG8_SB(1, 1), b3 + hstep, voffB); PG8_STAGE(PG8_SA(1, 0), a3, voffA);
            PG8_WAIT_V(8); PG8_WAIT_L(0); PG8_BAR; PG8_MMA(1, 0, At, B0); PG8_MMA(1, 1, At, B1); PG8_BAR; PG8_SCHED;
            } else {
            PG8_LDB(B0, 0, 0); PG8_SCHED; PG8_LDA(At, 0, 0); PG8_STAGE(PG8_SA(1, 1), a1 + hstep, voffA);
            PG8_WAIT_L(8); PG8_BAR; PG8_WAIT_L(0); PG8_MMA(0, 0, At, B0); PG8_BAR; PG8_SCHED;
            PG8_LDB(B1, 0, 1); PG8_STAGE(PG8_SB(0, 0), b2, voffB);
            PG8_BAR; PG8_WAIT_L(0); PG8_MMA(0, 1, At, B1); PG8_BAR;
            PG8_LDA(At, 0, 1); PG8_STAGE(PG8_SA(0, 0), a2, voffA);
            PG8_BAR; PG8_WAIT_L(0); PG8_MMA(1, 0, At, B0); PG8_BAR; PG8_SCHED;
            PG8_STAGE(PG8_SB(0, 1), b2 + hstep, voffB);
            PG8_WAIT_V(6); PG8_BAR; PG8_MMA(1, 1, At, B1); PG8_BAR;
            PG8_LDB(B0, 1, 0); PG8_SCHED; PG8_LDA(At, 1, 0); PG8_STAGE(PG8_SA(0, 1), a2 + hstep, voffA);
            PG8_WAIT_L(8); PG8_BAR; PG8_WAIT_L(0); PG8_MMA(0, 0, At, B0); PG8_BAR; PG8_SCHED;
            PG8_LDB(B1, 1, 1); PG8_STAGE(PG8_SB(1, 0), b3, voffB);
            PG8_BAR; PG8_WAIT_L(0); PG8_MMA(0, 1, At, B1); PG8_BAR;
            PG8_LDA(At, 1, 1); PG8_STAGE(PG8_SA(1, 0), a3, voffA);
            PG8_BAR; PG8_WAIT_L(0); PG8_MMA(1, 0, At, B0); PG8_BAR; PG8_SCHED;
            PG8_STAGE(PG8_SB(1, 1), b3 + hstep, voffB);
            PG8_WAIT_V(6); PG8_BAR; PG8_MMA(1, 1, At, B1); PG8_BAR;
            }
        }
        if constexpr (ALIGN_EPI) { if (wr == 0) PG8_BAR; }
        if constexpr (!Epi::AFTER_DRAIN) { E(acc, cur, wr, wc, fr, fq); S.done(cur); }
        if (!has_next) break;
#pragma unroll
        for (int a = 0; a < 2; ++a)
#pragma unroll
            for (int b = 0; b < 2; ++b)
#pragma unroll
                for (int m = 0; m < 4; ++m)
#pragma unroll
                    for (int n = 0; n < 2; ++n) acc[a][b][m][n] = (f32x4){0.f, 0.f, 0.f, 0.f};
        cur = nxt; cA = nA; cB = nB; ++ui;
        if constexpr (ALIGN_EPI) { if (wr == 1) PG8_BAR; }
    }
    PG8_WAIT_V(0);
    if constexpr (!ALIGN_EPI) { if (wr == 0) PG8_BAR; }
    PG8_BAR;
    if constexpr (Epi::AFTER_DRAIN) { E.fused(acc, cur, wr, wc, fr, fq, lds, wid, lane); S.done(cur); }
#undef PG8_SA
#undef PG8_SB
#undef PG8_STAGE
#undef PG8_LDA
#undef PG8_LDB
#undef PG8_MMA
#undef PG8_WAIT_V
#undef PG8_WAIT_L
#undef PG8_BAR
#undef PG8_SCHED
}
#endif
}


__device__ __forceinline__ void transpose_item(const float* W, int ldw, bf16_t* WT, int K, int k0, int n0, int drow0, float* scr, int lane) {
#pragma unroll 8
    for (int i = 0; i < 32; ++i) { const int kk = 2 * i + (lane >> 5); scr[kk * 33 + (lane & 31)] = W[(size_t)(k0 + kk) * ldw + n0 + (lane & 31)]; }
    WAVE_SYNC();
    const int c = lane & 7;
#pragma unroll
    for (int j = 0; j < 4; ++j) { const int n = (lane >> 3) + 8 * j; const float* s = scr + (8 * c) * 33 + n;
        u32x4 o; o.x = pk2(s[0 * 33], s[1 * 33]); o.y = pk2(s[2 * 33], s[3 * 33]); o.z = pk2(s[4 * 33], s[5 * 33]); o.w = pk2(s[6 * 33], s[7 * 33]);
        *(u32x4*)(WT + (size_t)(drow0 + n) * K + k0 + 8 * c) = o; }
    WAVE_SYNC();
}
__device__ __forceinline__ void ph_convert(const P& p, unsigned char* smem) {
    const int lane = tidx() & 63, wave = tidx() >> 6;
    float* scr = (float*)smem + wave * (64 * 33 + 32);
    constexpr int I_IN = 16 * 120, I_OUT = 16 * 32, I_G = 16 * 88, I_DN = 44 * 32, I_L = I_IN + I_OUT + 2 * I_G + I_DN;
    const int gw = blockIdx.x * 8 + wave, ngw = gridDim.x * 8;
    for (int it = gw; it < NL * I_L; it += ngw) {
        const int l = it / I_L; int r = it % I_L;
        if (r < I_IN) { const int kb = r / 120, nb = r % 120; transpose_item(p.w_in + (size_t)l * D * INC, INC, WSP(bf16_t, WS_WIN) + (size_t)l * NPROJ * D, D, kb * 64, nb * 32, nb * 32, scr, lane); continue; }
        r -= I_IN;
        if (r < I_OUT) { const int kb = r / 32, nb = r % 32; transpose_item(p.w_out + (size_t)l * D * D, D, WSP(bf16_t, WS_WOUT) + (size_t)l * D * D, D, kb * 64, nb * 32, nb * 32, scr, lane); continue; }
        r -= I_OUT;
        if (r < 2 * I_G) { const int up = r / I_G; r %= I_G; const int kb = r / 88, nb = r % 88, n0 = nb * 32;
            transpose_item((up ? p.w_up : p.w_gate) + (size_t)l * D * FF, FF, WSP(bf16_t, WS_WGU) + (size_t)l * 2 * FF * D, D, kb * 64, n0, (n0 / 128) * 256 + up * 128 + (n0 % 128), scr, lane); continue; }
        r -= 2 * I_G;
        { const int kb = r / 32, nb = r % 32; transpose_item(p.w_down + (size_t)l * FF * D, D, WSP(bf16_t, WS_WDN) + (size_t)l * D * FF, FF, kb * 64, nb * 32, nb * 32, scr, lane); }
    }
}

__device__ __forceinline__ void ph_adaln(const P& p, unsigned char* smem) {
    float* sc = (float*)smem;
    float* red = sc + NC * 256;
    const int tid = tidx(), col = tid & 31, kg = tid >> 5;
    float* MOD = WSP(float, WS_MOD);
    for (int it = blockIdx.x; it < NL * 192; it += gridDim.x) {
        const int l = it / 192, cb0 = (it % 192) * 32;
        float acc[NC];
#pragma unroll
        for (int r = 0; r < NC; ++r) acc[r] = 0.f;
        for (int kc = 0; kc < 4; ++kc) {
            __syncthreads();
            for (int e = tid; e < NC * 256; e += NTHR) { const int r = e >> 8, k = e & 255; const float c = r < PB ? p.c_prompt[r * D + kc * 256 + k] : p.c_sample[(r - PB) * D + kc * 256 + k]; sc[e] = silu_f(c); }
            __syncthreads();
            for (int kk = 0; kk < 16; ++kk) { const int k = kg * 16 + kk; const float w = p.ada_w[((size_t)l * D + kc * 256 + k) * 6144 + cb0 + col];
#pragma unroll
                for (int r = 0; r < NC; ++r) acc[r] += sc[r * 256 + k] * w; }
        }
#pragma unroll
        for (int r = 0; r < NC; ++r) red[(kg * NC + r) * 32 + col] = acc[r];
        __syncthreads();
        for (int e = tid; e < NC * 32; e += NTHR) { const int r = e >> 5, c = e & 31; float s = p.ada_b[l * 6144 + cb0 + c];
            for (int g = 0; g < 16; ++g) s += red[(g * NC + r) * 32 + c];
            MOD[((size_t)l * NC + r) * 6144 + cb0 + c] = s; }
        __syncthreads();
    }
}

__device__ __forceinline__ void ph_ropetab_copyx(const P& p) {
    const size_t gt = (size_t)blockIdx.x * NTHR + tidx(), ng = (size_t)gridDim.x * NTHR;
    float* tab = WSP(float, WS_ROPE);
    for (size_t e = gt; e < (size_t)NPOS * 32; e += ng) {
        const int pi = (int)(e >> 5), i = (int)(e & 31); const double pos = pi < T ? (double)pi : (double)(PAST + pi - T);
        const double ia = exp(-log(10000.0) * (double)i / 32.0), ir = exp(-log(10000.0) * (double)i / 31.0);
        tab[e] = (float)cos(pos * ia); tab[(size_t)NPOS * 32 + e] = (float)sin(pos * ia);
        tab[(size_t)2 * NPOS * 32 + e] = (float)cos(pos * ir); tab[(size_t)3 * NPOS * 32 + e] = (float)sin(pos * ir);
    }
    const f32x4* xp = (const f32x4*)p.x_prompt; const f32x4* xs = (const f32x4*)p.x_sample; f32x4* o = (f32x4*)p.out;
    for (size_t e = gt; e < (size_t)MP * D / 4; e += ng) o[e] = xp[e];
    for (size_t e = gt; e < (size_t)MS * D / 4; e += ng) o[(size_t)MP * D / 4 + e] = xs[e];
}

template <int WHICH> __device__ __forceinline__ void ph_norm_mod(const P& p, int l) {
    const int lane = tidx() & 63, wave = tidx() >> 6, gw = blockIdx.x * 8 + wave, ngw = gridDim.x * 8;
    const float* nw = (WHICH == 0 ? p.norm_mix : p.norm_ffn) + l * D;
    bf16_t* H = WSP(bf16_t, WS_H);
    for (int r = gw; r < M; r += ngw) {
        const float* xr = p.out + (size_t)r * D; const float* mod = WSP(float, WS_MOD) + ((size_t)l * NC + row_cb(r)) * 6144 + (WHICH == 0 ? 0 : 3072);
        f32x4 v[4]; float ss = 0.f;
#pragma unroll
        for (int j = 0; j < 4; ++j) { v[j] = *(const f32x4*)(xr + 4 * lane + 256 * j); ss += (v[j][0] * v[j][0] + v[j][1] * v[j][1]) + (v[j][2] * v[j][2] + v[j][3] * v[j][3]); }
        const float rstd = 1.0f / sqrtf(wave_sum(ss) * (1.0f / D) + EPS);
        float a8[8];
#pragma unroll
        for (int c = 0; c < 8; ++c) a8[c] = 0.f;
#pragma unroll
        for (int j = 0; j < 4; ++j) { const int k = 4 * lane + 256 * j;
            const f32x4 g = *(const f32x4*)(nw + k), sh = *(const f32x4*)(mod + k), sc = *(const f32x4*)(mod + 1024 + k);
            f32x4 h;
#pragma unroll
            for (int e = 0; e < 4; ++e) h[e] = v[j][e] * rstd * g[e] * (1.0f + sc[e]) + sh[e];
            u32x2 w; w.x = pk2(h[0], h[1]); w.y = pk2(h[2], h[3]); *(u32x2*)(H + (size_t)r * D + k) = w;
            if (WHICH == 0) {
#pragma unroll
                for (int e = 0; e < 4; ++e) { const float* wr = p.w_in + ((size_t)l * D + k + e) * INC + NPROJ; const f32x4 w0 = *(const f32x4*)wr, w1 = *(const f32x4*)(wr + 4);
#pragma unroll
                    for (int c = 0; c < 4; ++c) { a8[c] += h[e] * w0[c]; a8[4 + c] += h[e] * w1[c]; } }
            }
        }
        if (WHICH == 0) {
#pragma unroll
            for (int c = 0; c < 8; ++c) a8[c] = wave_sum(a8[c]);
            if (lane < 4) { float braw = lane == 0 ? a8[0] : lane == 1 ? a8[1] : lane == 2 ? a8[2] : a8[3]; WSP(float, WS_BETA)[(size_t)r * 4 + lane] = 1.0f / (1.0f + expf(-braw)); }
            else if (lane < 8) { const int hh = lane - 4; float araw = hh == 0 ? a8[4] : hh == 1 ? a8[5] : hh == 2 ? a8[6] : a8[7];
                const float xx = araw + p.dt_bias[l * 4 + hh]; const float sp = xx > 20.f ? xx : log1pf(expf(xx));
                WSP(float, WS_G)[(size_t)r * 4 + hh] = -expf(p.a_log[l * 4 + hh]) * sp; }
        }
    }
}

__device__ __forceinline__ void ph_rope_out(const P& p, int l) {
    const size_t gt = (size_t)blockIdx.x * NTHR + tidx(), ng = (size_t)gridDim.x * NTHR;
    bf16_t* PR = WSP(bf16_t, WS_PROJ); const float* tab = WSP(float, WS_ROPE);
    for (size_t e = gt; e < (size_t)M * 512; e += ng) {
        const int r = (int)(e >> 9), rem = (int)(e & 511), sec = rem >> 7, hh = (rem & 127) >> 5, d = rem & 31;
        const int off = sec == 0 ? C_QA : sec == 1 ? C_KA : sec == 2 ? C_QR : C_KR; const float scale = (sec == 0 || sec == 3) ? 0.125f : 1.0f;
        const float* ct = tab + (size_t)(sec >= 2 ? 2 : 0) * NPOS * 32 + (size_t)row_pi(r) * 32 + d; const float c = ct[0], s = ct[(size_t)NPOS * 32];
        bf16_t* x = PR + (size_t)r * NPROJ + off + hh * 64 + d; const float x1 = bf2f(x[0]), x2 = bf2f(x[32]);
        const float o1 = (x1 * c - x2 * s) * scale, o2 = (x1 * s + x2 * c) * scale;
        x[0] = f2bf(o1); x[32] = f2bf(o2);
        if (sec == 1) {
            if (r < MP) { const int b = r / T, t = r % T; if (t >= T - PWIN) { float* o = p.out + O_PWK + (((size_t)l * PB + b) * PWIN + (t - (T - PWIN))) * 256 + hh * 64 + d; o[0] = o1; o[32] = o2; } }
            else { const int b = (r - MP) / DS, i = (r - MP) % DS; float* o = p.out + O_SWK + (((size_t)l * DB + b) * DS + i) * 256 + hh * 64 + d; o[0] = o1; o[32] = o2; }
        }
    }
    for (size_t e = gt; e < (size_t)M * 256; e += ng) {
        const int r = (int)(e >> 8), c = (int)(e & 255); const float v = bf2f(PR[(size_t)r * NPROJ + C_VA + c]);
        if (r < MP) { const int b = r / T, t = r % T; if (t >= T - PWIN) p.out[O_PWV + (((size_t)l * PB + b) * PWIN + (t - (T - PWIN))) * 256 + c] = v; }
        else { const int b = (r - MP) / DS, i = (r - MP) % DS; p.out[O_SWV + (((size_t)l * DB + b) * DS + i) * 256 + c] = v; }
    }
    for (size_t e = gt; e < (size_t)(PB + DB) * 3 * 1536; e += ng) {
        const int c = (int)(e % 1536), j = (int)((e / 1536) % 3), bb = (int)(e / (3 * 1536));
        if (bb < PB) p.out[O_PCONV + (((size_t)l * PB + bb) * 3 + j) * 1536 + c] = bf2f(PR[(size_t)(bb * T + T - 3 + j) * NPROJ + C_CONV + c]);
        else { const int b = bb - PB; p.out[O_SCONV + (((size_t)l * DB + b) * 3 + j) * 1536 + c] = bf2f(PR[(size_t)(MP + b * DS + DS - 3 + j) * NPROJ + C_CONV + c]); }
    }
}

__device__ __forceinline__ void attn_wave(const P& p, int l, int r, int h, int lane) {
    const bf16_t* PR = WSP(bf16_t, WS_PROJ);
    const bool samp = r >= MP; const int b = samp ? (r - MP) / DS : r / T; const int tq = samp ? WB + (r - MP) % DS : r % T;
    float q[64];
    { const bf16_t* qp = PR + (size_t)r * NPROJ + C_QA + h * 64;
#pragma unroll
      for (int j = 0; j < 8; ++j) { const bf16x8 v = *(const bf16x8*)(qp + 8 * j);
#pragma unroll
          for (int e = 0; e < 8; ++e) q[8 * j + e] = bf2f((bf16_t)v[e]); } }
    float sc[7]; float mx = -INFINITY;
#pragma unroll
    for (int i = 0; i < 7; ++i) {
        const int e = lane + 64 * i; float s = -INFINITY;
        if (e < 387) { const int pat = e / 129, j = e % 129, dil = pat == 0 ? 1 : pat == 1 ? 4 : 16; const int rr = tq - dil * j;
            if (rr >= 0) {
                float a = 0.f;
                if (samp && rr < WB) { const float* kp = p.cache_k + ((((size_t)l * DB + b) * WB + rr) * 4 + h) * 64;
#pragma unroll
                    for (int j4 = 0; j4 < 16; ++j4) { const f32x4 kv = *(const f32x4*)(kp + 4 * j4); a += q[4 * j4] * kv[0] + q[4 * j4 + 1] * kv[1] + q[4 * j4 + 2] * kv[2] + q[4 * j4 + 3] * kv[3]; } }
                else { const int kr = samp ? MP + b * DS + (rr - WB) : b * T + rr; const bf16_t* kp = PR + (size_t)kr * NPROJ + C_KA + h * 64;
#pragma unroll
                    for (int j8 = 0; j8 < 8; ++j8) { const bf16x8 kv = *(const bf16x8*)(kp + 8 * j8);
#pragma unroll
                        for (int e2 = 0; e2 < 8; ++e2) a += q[8 * j8 + e2] * bf2f((bf16_t)kv[e2]); } }
                s = a; } }
        sc[i] = s; mx = fmaxf(mx, s);
    }
    mx = wave_max(mx);
    float lsum = 0.f;
#pragma unroll
    for (int i = 0; i < 7; ++i) { sc[i] = sc[i] == -INFINITY ? 0.f : expf(sc[i] - mx); lsum += sc[i]; }
    lsum = wave_sum(lsum);
    float o = 0.f;
#pragma unroll
    for (int i = 0; i < 7; ++i) {
        for (int ln = 0; ln < 64; ++ln) {
            const int e = ln + 64 * i; if (e >= 387) break;
            const float pe = __shfl(sc[i], ln);
            const int pat = e / 129, j = e % 129, dil = pat == 0 ? 1 : pat == 1 ? 4 : 16; const int rr = tq - dil * j;
            if (rr < 0) continue;
            float v;
            if (samp && rr < WB) v = p.cache_v[((((size_t)l * DB + b) * WB + rr) * 4 + h) * 64 + lane];
            else { const int kr = samp ? MP + b * DS + (rr - WB) : b * T + rr; v = bf2f(PR[(size_t)kr * NPROJ + C_VA + h * 64 + lane]); }
            o += pe * v;
        }
    }
    WSP(bf16_t, WS_O)[(size_t)r * D + h * 64 + lane] = f2bf(o / lsum);
}
__device__ __forceinline__ void ph_attn(const P& p, int l) {
    const int lane = tidx() & 63, wave = tidx() >> 6, gw = blockIdx.x * 8 + wave, ngw = gridDim.x * 8;
    for (int it = gw; it < M * 4; it += ngw) attn_wave(p, l, it >> 2, it & 3, lane);
}

__device__ __forceinline__ float ret_lg(int h) { return logf(1.0f - exp2f(-5.0f - (float)h)); }
__device__ __forceinline__ void ph_ret_local(const P& p, int l, unsigned char* smem) {
    float* ks = (float*)smem; float* vs = ks + 64 * 64; const int tid = tidx(); const bf16_t* PR = WSP(bf16_t, WS_PROJ);
    for (int u = blockIdx.x; u < NUNIT; u += gridDim.x) {
        const int n = u % NCH, h = (u / NCH) % 4, b = u / (NCH * 4); const float lg = ret_lg(h);
        __syncthreads();
        for (int e = tid; e < 4096; e += NTHR) { const int j = e >> 6, d = e & 63; const size_t row = (size_t)(b * T + n * 64 + j) * NPROJ;
            ks[e] = bf2f(PR[row + C_KR + h * 64 + d]) * expf(lg * (float)(63 - j)); vs[e] = bf2f(PR[row + C_VR + h * 64 + d]); }
        __syncthreads();
        const int d = tid >> 3, e0 = (tid & 7) * 8; float acc[8];
#pragma unroll
        for (int i = 0; i < 8; ++i) acc[i] = 0.f;
        for (int j = 0; j < 64; ++j) { const float kd = ks[j * 64 + d];
#pragma unroll
            for (int i = 0; i < 8; ++i) acc[i] += kd * vs[j * 64 + e0 + i]; }
        float* U = WSP(float, WS_RU) + (size_t)u * 4096 + d * 64 + e0;
#pragma unroll
        for (int i = 0; i < 8; ++i) U[i] = acc[i];
    }
}
__device__ __forceinline__ void ph_ret_scan(const P& p, int l) {
    const int gt = blockIdx.x * NTHR + tidx(), ng = gridDim.x * NTHR;
    for (int e = gt; e < PB * 4 * 4096; e += ng) {
        const int bh = e >> 12, de = e & 4095, h = bh & 3; const float cd = expf(ret_lg(h) * 64.0f);
        const float* U = WSP(float, WS_RU) + (size_t)bh * NCH * 4096 + de; float* SPv = WSP(float, WS_RS) + (size_t)bh * NCH * 4096 + de;
        float s = 0.f;
        for (int n = 0; n < NCH; ++n) { SPv[(size_t)n * 4096] = s; s = s * cd + U[(size_t)n * 4096]; }
        p.out[O_PRET + ((size_t)l * PB * 4 + bh) * 4096 + de] = s;
    }
}
__device__ __forceinline__ void ph_ret_out(const P& p, int l, unsigned char* smem) {
    float* qs = (float*)smem; float* ks = qs + 64 * 65; float* vs = ks + 64 * 65; float* ss = vs + 64 * 65; float* as = ss + 64 * 65;
    const int tid = tidx(); const bf16_t* PR = WSP(bf16_t, WS_PROJ);
    for (int u = blockIdx.x; u < NUNIT; u += gridDim.x) {
        const int n = u % NCH, h = (u / NCH) % 4, b = u / (NCH * 4); const float lg = ret_lg(h);
        __syncthreads();
        for (int e = tid; e < 4096; e += NTHR) { const int j = e >> 6, d = e & 63; const size_t row = (size_t)(b * T + n * 64 + j) * NPROJ;
            qs[j * 65 + d] = bf2f(PR[row + C_QR + h * 64 + d]); ks[j * 65 + d] = bf2f(PR[row + C_KR + h * 64 + d]); vs[j * 65 + d] = bf2f(PR[row + C_VR + h * 64 + d]);
            ss[j * 65 + d] = WSP(float, WS_RS)[(size_t)u * 4096 + e]; }
        __syncthreads();
        const int i = tid >> 3, c0 = (tid & 7) * 8;
#pragma unroll
        for (int jj = 0; jj < 8; ++jj) { const int j = c0 + jj; float a = 0.f;
            if (j <= i) { for (int d = 0; d < 64; ++d) a += qs[i * 65 + d] * ks[j * 65 + d]; a *= expf(lg * (float)(i - j)); }
            as[i * 65 + j] = a; }
        __syncthreads();
        float o[8]; float o2[8];
#pragma unroll
        for (int e = 0; e < 8; ++e) { o[e] = 0.f; o2[e] = 0.f; }
        for (int j = 0; j < 64; ++j) { const float a = as[i * 65 + j], qd = qs[i * 65 + j];
#pragma unroll
            for (int e = 0; e < 8; ++e) { o[e] += a * vs[j * 65 + c0 + e]; o2[e] += qd * ss[j * 65 + c0 + e]; } }
        const float qdec = expf(lg * (float)(i + 1)); float sq = 0.f;
#pragma unroll
        for (int e = 0; e < 8; ++e) { o[e] += o2[e] * qdec; sq += o[e] * o[e]; }
        sq += __shfl_xor(sq, 1); sq += __shfl_xor(sq, 2); sq += __shfl_xor(sq, 4);
        const float rstd = 1.0f / sqrtf(sq * (1.0f / 64.0f) + EPS);
        const size_t row = (size_t)(b * T + n * 64 + i);
#pragma unroll
        for (int e = 0; e < 8; ++e) { const float g = bf2f(PR[row * NPROJ + C_GR + h * 64 + c0 + e]);
            WSP(bf16_t, WS_O)[row * D + 256 + h * 64 + c0 + e] = f2bf(o[e] * rstd * p.ret_norm[l * 64 + c0 + e] * silu_f(g)); }
    }
}
__device__ __forceinline__ void ph_ret_sample(const P& p, int l, unsigned char* smem) {
    float* S0 = (float*)smem; float* qs = S0 + 4096; float* ks = qs + 8 * 64; float* vs = ks + 8 * 64;
    const int tid = tidx(); const bf16_t* PR = WSP(bf16_t, WS_PROJ);
    for (int u = blockIdx.x; u < DB * 4; u += gridDim.x) {
        const int h = u & 3, b = u >> 2; const float lg = ret_lg(h);
        __syncthreads();
        for (int e = tid; e < 4096; e += NTHR) S0[e] = p.state_ret[(((size_t)l * DB + b) * 4 + h) * 4096 + e];
        { const int j = tid >> 6, d = tid & 63; const size_t row = (size_t)(MP + b * DS + j) * NPROJ;
          qs[tid] = bf2f(PR[row + C_QR + h * 64 + d]); ks[tid] = bf2f(PR[row + C_KR + h * 64 + d]); vs[tid] = bf2f(PR[row + C_VR + h * 64 + d]); }
        __syncthreads();
        { const int i = tid >> 6, e = tid & 63; float o = 0.f;
          for (int j = 0; j <= i; ++j) { float a = 0.f; for (int d = 0; d < 64; ++d) a += qs[i * 64 + d] * ks[j * 64 + d]; o += a * expf(lg * (float)(i - j)) * vs[j * 64 + e]; }
          float o2 = 0.f; for (int d = 0; d < 64; ++d) o2 += qs[i * 64 + d] * S0[d * 64 + e];
          o += o2 * expf(lg * (float)(i + 1));
          const float rstd = 1.0f / sqrtf(wave_sum(o * o) * (1.0f / 64.0f) + EPS);
          const size_t row = (size_t)(MP + b * DS + i); const float g = bf2f(PR[row * NPROJ + C_GR + h * 64 + e]);
          WSP(bf16_t, WS_O)[row * D + 256 + h * 64 + e] = f2bf(o * rstd * p.ret_norm[l * 64 + e] * silu_f(g)); }
        for (int x = tid; x < 4096; x += NTHR) { const int d = x >> 6, e = x & 63; float s = S0[x] * expf(lg * (float)DS);
            for (int j = 0; j < DS; ++j) s += ks[j * 64 + d] * expf(lg * (float)(DS - 1 - j)) * vs[j * 64 + e];
            p.out[O_SRET + (((size_t)l * DB + b) * 4 + h) * 4096 + x] = s; }
    }
}

template <int CS, int LDL> __device__ __forceinline__ void fwd_subst(float (&X)[CS], const float* Ls) {
#pragma unroll
    for (int i = 1; i < CS; ++i) {
        float a = X[i];
#pragma unroll
        for (int j4 = 0; j4 < (i + 3) / 4; ++j4) { const f32x4 lv = *(const f32x4*)(Ls + i * LDL + 4 * j4);
#pragma unroll
            for (int e = 0; e < 4; ++e) if (4 * j4 + e < i) a -= lv[e] * X[4 * j4 + e]; }
        X[i] = a;
    }
}
constexpr int QP = 132;
__device__ __forceinline__ void ph_gdn_prep(const P& p, int l, unsigned char* smem) {
    float* Ls = (float*)smem; float* As = Ls + 64 * 68; float* gs = As + 64 * 68; float* gcs = gs + 64; float* bts = gcs + 64;
    float* qs = bts + 64; float* ks = qs + 64 * QP; float* vs = ks + 64 * QP;
    const int tid = tidx(); const bf16_t* PR = WSP(bf16_t, WS_PROJ);
    for (int u = blockIdx.x; u < NUNIT; u += gridDim.x) {
        const int n = u % NCH, h = (u / NCH) % 4, b = u / (NCH * 4);
        __syncthreads();
        if (tid < 384) { const int sec = tid >> 7, c = tid & 127, col = sec * 512 + h * 128 + c; float* dst = sec == 0 ? qs : sec == 1 ? ks : vs;
            const float w0 = p.conv_w[(l * 4 + 0) * 1536 + col], w1 = p.conv_w[(l * 4 + 1) * 1536 + col], w2 = p.conv_w[(l * 4 + 2) * 1536 + col], w3 = p.conv_w[(l * 4 + 3) * 1536 + col];
            const int t0 = n * 64; const bf16_t* src = PR + (size_t)(b * T) * NPROJ + C_CONV + col;
            float x0 = t0 >= 3 ? bf2f(src[(size_t)(t0 - 3) * NPROJ]) : 0.f, x1 = t0 >= 2 ? bf2f(src[(size_t)(t0 - 2) * NPROJ]) : 0.f, x2 = t0 >= 1 ? bf2f(src[(size_t)(t0 - 1) * NPROJ]) : 0.f;
            const bf16_t* sp = src + (size_t)t0 * NPROJ; float* dp = dst + c;
#pragma unroll 4
            for (int i = 0; i < 64; ++i) { const float x3 = bf2f(*sp); const float y = w0 * x0 + w1 * x1 + w2 * x2 + w3 * x3; *dp = silu_f(y); x0 = x1; x1 = x2; x2 = x3; sp += NPROJ; dp += QP; } }
        else if (tid < 448) { const int i = tid - 384; const size_t row = (size_t)(b * T + n * 64 + i); gs[i] = WSP(float, WS_G)[row * 4 + h]; bts[i] = WSP(float, WS_BETA)[row * 4 + h]; }
        __syncthreads();
        { const int rid = tid >> 2, part = tid & 3; float* rowp = (rid < 64 ? qs + rid * QP : ks + (rid - 64) * QP) + part * 32; float s = 0.f;
          for (int d = 0; d < 32; ++d) s += rowp[d] * rowp[d];
          s += __shfl_xor(s, 1); s += __shfl_xor(s, 2); const float sc = 1.0f / sqrtf(s + EPS);
          for (int d = 0; d < 32; ++d) rowp[d] *= sc; }
        if (tid == 0) { float a = 0.f; for (int i = 0; i < 64; ++i) { a += gs[i]; gcs[i] = a; } }
        __syncthreads();
        { const int i = tid >> 3, j0 = (tid & 7) * 8;
#pragma unroll
          for (int jj = 0; jj < 8; ++jj) { const int j = j0 + jj; float lv = 0.f, av = 0.f;
              if (j <= i) { float dk = 0.f, dq = 0.f; for (int d = 0; d < 128; ++d) { const float kj = ks[j * QP + d]; dk += ks[i * QP + d] * kj; dq += qs[i * QP + d] * kj; }
                  const float e = expf(gcs[i] - gcs[j]); av = dq * e * 0.08838834764831845f; lv = j < i ? bts[i] * dk * e : 0.f; }
              Ls[i * 68 + j] = lv; As[i * 68 + j] = av; } }
        __syncthreads();
        if (tid < 256) { const int c = tid; float X[64];
            if (c < 128) {
#pragma unroll
                for (int i = 0; i < 64; ++i) X[i] = vs[i * QP + c] * bts[i]; }
            else {
#pragma unroll
                for (int i = 0; i < 64; ++i) X[i] = ks[i * QP + c - 128] * bts[i] * expf(gcs[i]); }
            fwd_subst<64, 68>(X, Ls);
            if (c < 128) { float* U = WSP(float, WS_GU) + (size_t)u * 8192 + c;
#pragma unroll
                for (int i = 0; i < 64; ++i) U[i * 128] = X[i]; }
            else { bf16_t* W = WSP(bf16_t, WS_GW) + (size_t)u * 8192 + c - 128;
#pragma unroll
                for (int i = 0; i < 64; ++i) W[i * 128] = f2bf(X[i]); }
        } else { const int t2 = tid - 256; const float gl = gcs[63];
#pragma unroll 2
            for (int e = t2; e < 8192; e += 256) { const int i = e >> 7, d = e & 127;
                WSP(bf16_t, WS_GQ)[(size_t)u * 8192 + e] = f2bf(qs[i * QP + d] * 0.08838834764831845f * expf(gcs[i]));
                WSP(bf16_t, WS_GK)[(size_t)u * 8192 + e] = f2bf(ks[i * QP + d] * expf(gl - gcs[i])); }
#pragma unroll 2
            for (int e = t2; e < 4096; e += 256) WSP(bf16_t, WS_GA)[(size_t)u * 4096 + e] = f2bf(As[(e >> 6) * 68 + (e & 63)]);
            if (t2 == 0) WSP(float, WS_GD)[u] = expf(gl); }
    }
}
__device__ __forceinline__ void ph_gdn_chain(const P& p, int l, unsigned char* smem) {
    float* Ss = (float*)smem; float* Ws = Ss + 128 * 32; float* Ks = Ws + 64 * 128; float* vn = Ks + 64 * 128;
    const int tid = tidx();
    for (int it = blockIdx.x; it < PB * 4 * 4; it += gridDim.x) {
        const int sl = it & 3, bh = it >> 2;
        __syncthreads();
        for (int e = tid; e < 4096; e += NTHR) Ss[e] = 0.f;
        for (int n = 0; n < NCH; ++n) {
            const int u = bh * NCH + n;
            __syncthreads();
            { const bf16_t* W = WSP(bf16_t, WS_GW) + (size_t)u * 8192; const bf16_t* K = WSP(bf16_t, WS_GK) + (size_t)u * 8192;
              for (int e = tid; e < 1024; e += NTHR) { const bf16x8 wv = *(const bf16x8*)(W + 8 * e), kv = *(const bf16x8*)(K + 8 * e);
#pragma unroll
                  for (int x = 0; x < 8; ++x) { Ws[8 * e + x] = bf2f((bf16_t)wv[x]); Ks[8 * e + x] = bf2f((bf16_t)kv[x]); } }
              float* SPo = WSP(float, WS_GS) + (size_t)u * 16384 + sl * 32;
              for (int e = tid; e < 4096; e += NTHR) SPo[(e >> 5) * 128 + (e & 31)] = Ss[e]; }
            __syncthreads();
            { const int i = tid >> 3, c0 = (tid & 7) * 4; f32x4 a = *(const f32x4*)(WSP(float, WS_GU) + (size_t)u * 8192 + i * 128 + sl * 32 + c0);
              for (int d = 0; d < 128; ++d) { const float w = Ws[i * 128 + d]; a -= w * *(const f32x4*)(Ss + d * 32 + c0); }
              *(f32x4*)(vn + i * 32 + c0) = a; *(f32x4*)(WSP(float, WS_GV) + (size_t)u * 8192 + i * 128 + sl * 32 + c0) = a; }
            __syncthreads();
            { const int d = tid >> 2, c0 = (tid & 3) * 8; const float dec = WSP(float, WS_GD)[u];
              f32x4 a0 = *(const f32x4*)(Ss + d * 32 + c0) * dec, a1 = *(const f32x4*)(Ss + d * 32 + c0 + 4) * dec;
              for (int i = 0; i < 64; ++i) { const float kd = Ks[i * 128 + d]; a0 += kd * *(const f32x4*)(vn + i * 32 + c0); a1 += kd * *(const f32x4*)(vn + i * 32 + c0 + 4); }
              *(f32x4*)(Ss + d * 32 + c0) = a0; *(f32x4*)(Ss + d * 32 + c0 + 4) = a1; }
        }
        __syncthreads();
        { float* o = p.out + O_PGDN + ((size_t)l * PB * 4 + bh) * 16384 + sl * 32;
          for (int e = tid; e < 4096; e += NTHR) o[(e >> 5) * 128 + (e & 31)] = Ss[e]; }
    }
}
__device__ __forceinline__ void ph_gdn_out(const P& p, int l, unsigned char* smem) {
    float* SPs = (float*)smem; float* VNs = SPs + 128 * 128; bf16_t* QGs = (bf16_t*)(VNs + 64 * 128); bf16_t* ATs = QGs + 64 * 128;
    const int tid = tidx(); const bf16_t* PR = WSP(bf16_t, WS_PROJ);
    for (int u = blockIdx.x; u < NUNIT; u += gridDim.x) {
        const int n = u % NCH, h = (u / NCH) % 4, b = u / (NCH * 4);
        __syncthreads();
        { const f32x4* s = (const f32x4*)(WSP(float, WS_GS) + (size_t)u * 16384); for (int e = tid; e < 4096; e += NTHR) ((f32x4*)SPs)[e] = s[e];
          const f32x4* v = (const f32x4*)(WSP(float, WS_GV) + (size_t)u * 8192); for (int e = tid; e < 2048; e += NTHR) ((f32x4*)VNs)[e] = v[e];
          const u32x4* q = (const u32x4*)(WSP(bf16_t, WS_GQ) + (size_t)u * 8192); for (int e = tid; e < 1024; e += NTHR) ((u32x4*)QGs)[e] = q[e];
          const u32x4* a = (const u32x4*)(WSP(bf16_t, WS_GA) + (size_t)u * 4096); for (int e = tid; e < 512; e += NTHR) ((u32x4*)ATs)[e] = a[e]; }
        __syncthreads();
        const int i = tid >> 3, cg = tid & 7; f32x4 o[4];
#pragma unroll
        for (int k = 0; k < 4; ++k) o[k] = (f32x4){0.f, 0.f, 0.f, 0.f};
        for (int d = 0; d < 128; ++d) { const float qg = bf2f(QGs[i * 128 + d]);
#pragma unroll
            for (int k = 0; k < 4; ++k) o[k] += qg * *(const f32x4*)(SPs + d * 128 + 32 * k + 4 * cg); }
        for (int j = 0; j < 64; ++j) { const float a = bf2f(ATs[i * 64 + j]);
#pragma unroll
            for (int k = 0; k < 4; ++k) o[k] += a * *(const f32x4*)(VNs + j * 128 + 32 * k + 4 * cg); }
        float sq = 0.f;
#pragma unroll
        for (int k = 0; k < 4; ++k) sq += (o[k][0] * o[k][0] + o[k][1] * o[k][1]) + (o[k][2] * o[k][2] + o[k][3] * o[k][3]);
        sq += __shfl_xor(sq, 1); sq += __shfl_xor(sq, 2); sq += __shfl_xor(sq, 4);
        const float rstd = 1.0f / sqrtf(sq * (1.0f / 128.0f) + EPS);
        const size_t row = (size_t)(b * T + n * 64 + i);
#pragma unroll
        for (int k = 0; k < 4; ++k)
#pragma unroll
            for (int e = 0; e < 4; ++e) { const int c = 32 * k + 4 * cg + e; const float z = bf2f(PR[row * NPROJ + C_Z + h * 128 + c]);
                WSP(bf16_t, WS_O)[row * D + 512 + h * 128 + c] = f2bf(o[k][e] * rstd * p.gdn_norm[l * 128 + c] * silu_f(z)); }
    }
}
__device__ __forceinline__ void ph_gdn_sample(const P& p, int l, unsigned char* smem) {
    float* qs = (float*)smem; float* ks = qs + 8 * QP; float* vs = ks + 8 * QP; float* us = vs + 8 * QP; float* wsm = us + 8 * 128; float* vn = wsm + 8 * 128;
    float* Ls = vn + 8 * 128; float* As = Ls + 8 * 8; float* gs = As + 8 * 8; float* gcs = gs + 8; float* bts = gcs + 8; float* S0 = bts + 8;
    const int tid = tidx(); const bf16_t* PR = WSP(bf16_t, WS_PROJ);
    for (int u = blockIdx.x; u < DB * 4; u += gridDim.x) {
        const int h = u & 3, b = u >> 2;
        __syncthreads();
#pragma unroll 4
        for (int e = tid; e < 16384; e += NTHR) S0[e] = p.state_gdn[(((size_t)l * DB + b) * 4 + h) * 16384 + e];
        if (tid < 384) { const int sec = tid >> 7, c = tid & 127, col = sec * 512 + h * 128 + c; float* dst = sec == 0 ? qs : sec == 1 ? ks : vs;
            const float w0 = p.conv_w[(l * 4 + 0) * 1536 + col], w1 = p.conv_w[(l * 4 + 1) * 1536 + col], w2 = p.conv_w[(l * 4 + 2) * 1536 + col], w3 = p.conv_w[(l * 4 + 3) * 1536 + col];
            const float* hist = p.state_conv + (((size_t)l * DB + b) * 3) * 1536 + col; const bf16_t* src = PR + (size_t)(MP + b * DS) * NPROJ + C_CONV + col;
            float x0 = hist[0], x1 = hist[1536], x2 = hist[2 * 1536];
            for (int i = 0; i < DS; ++i) { const float x3 = bf2f(src[(size_t)i * NPROJ]); const float y = w0 * x0 + w1 * x1 + w2 * x2 + w3 * x3; dst[i * QP + c] = silu_f(y); x0 = x1; x1 = x2; x2 = x3; } }
        else if (tid < 384 + DS) { const int i = tid - 384; const size_t row = (size_t)(MP + b * DS + i); gs[i] = WSP(float, WS_G)[row * 4 + h]; bts[i] = WSP(float, WS_BETA)[row * 4 + h]; }
        __syncthreads();
        if (tid < 64) { const int rid = tid >> 2, part = tid & 3; float* rowp = (rid < 8 ? qs + rid * QP : ks + (rid - 8) * QP) + part * 32; float s = 0.f;
            for (int d = 0; d < 32; ++d) s += rowp[d] * rowp[d];
            s += __shfl_xor(s, 1); s += __shfl_xor(s, 2); const float sc = 1.0f / sqrtf(s + EPS);
            for (int d = 0; d < 32; ++d) rowp[d] *= sc; }
        if (tid == 64) { float a = 0.f; for (int i = 0; i < DS; ++i) { a += gs[i]; gcs[i] = a; } }
        __syncthreads();
        if (tid < 64) { const int i = tid >> 3, j = tid & 7; float lv = 0.f, av = 0.f;
            if (j <= i) { float dk = 0.f, dq = 0.f; for (int d = 0; d < 128; ++d) { const float kj = ks[j * QP + d]; dk += ks[i * QP + d] * kj; dq += qs[i * QP + d] * kj; }
                const float e = expf(gcs[i] - gcs[j]); av = dq * e * 0.08838834764831845f; lv = j < i ? bts[i] * dk * e : 0.f; }
            Ls[i * 8 + j] = lv; As[i * 8 + j] = av; }
        __syncthreads();
        if (tid < 256) { const int c = tid; float X[8];
            if (c < 128) {
#pragma unroll
                for (int i = 0; i < 8; ++i) X[i] = vs[i * QP + c] * bts[i]; }
            else {
#pragma unroll
                for (int i = 0; i < 8; ++i) X[i] = ks[i * QP + c - 128] * bts[i] * expf(gcs[i]); }
            fwd_subst<8, 8>(X, Ls);
            float* dst = c < 128 ? us + c : wsm + c - 128;
#pragma unroll
            for (int i = 0; i < 8; ++i) dst[i * 128] = X[i]; }
        __syncthreads();
        const int i = tid >> 6, c2 = (tid & 63) * 2;
        { float a0 = us[i * 128 + c2], a1 = us[i * 128 + c2 + 1];
          for (int d = 0; d < 128; ++d) { const float w = wsm[i * 128 + d]; a0 -= w * S0[d * 128 + c2]; a1 -= w * S0[d * 128 + c2 + 1]; }
          vn[i * 128 + c2] = a0; vn[i * 128 + c2 + 1] = a1; }
        __syncthreads();
        { float o0 = 0.f, o1 = 0.f; const float qsc = 0.08838834764831845f * expf(gcs[i]);
          for (int d = 0; d < 128; ++d) { const float qg = qs[i * QP + d] * qsc; o0 += qg * S0[d * 128 + c2]; o1 += qg * S0[d * 128 + c2 + 1]; }
          for (int j = 0; j < DS; ++j) { const float a = As[i * 8 + j]; o0 += a * vn[j * 128 + c2]; o1 += a * vn[j * 128 + c2 + 1]; }
          const float rstd = 1.0f / sqrtf(wave_sum(o0 * o0 + o1 * o1) * (1.0f / 128.0f) + EPS);
          const size_t row = (size_t)(MP + b * DS + i);
          const float z0 = bf2f(PR[row * NPROJ + C_Z + h * 128 + c2]), z1 = bf2f(PR[row * NPROJ + C_Z + h * 128 + c2 + 1]);
          bf16_t* O = WSP(bf16_t, WS_O) + row * D + 512 + h * 128 + c2;
          O[0] = f2bf(o0 * rstd * p.gdn_norm[l * 128 + c2] * silu_f(z0)); O[1] = f2bf(o1 * rstd * p.gdn_norm[l * 128 + c2 + 1] * silu_f(z1)); }
        { const float gl = gcs[DS - 1], dec = expf(gl); float* o = p.out + O_SGDN + (((size_t)l * DB + b) * 4 + h) * 16384;
#pragma unroll 2
          for (int e = tid; e < 16384; e += NTHR) { const int d = e >> 7, c = e & 127; float s = S0[e] * dec;
              for (int j = 0; j < DS; ++j) s += ks[j * QP + d] * expf(gl - gcs[j]) * vn[j * 128 + c];
              o[e] = s; } }
    }
}

__device__ __forceinline__ void ph_final_norm(const P& p) {
    const int lane = tidx() & 63, wave = tidx() >> 6, gw = blockIdx.x * 8 + wave, ngw = gridDim.x * 8;
    for (int r = gw; r < M; r += ngw) {
        float* xr = p.out + (size_t)r * D; f32x4 v[4]; float ss = 0.f;
#pragma unroll
        for (int j = 0; j < 4; ++j) { v[j] = *(const f32x4*)(xr + 4 * lane + 256 * j); ss += (v[j][0] * v[j][0] + v[j][1] * v[j][1]) + (v[j][2] * v[j][2] + v[j][3] * v[j][3]); }
        const float rstd = 1.0f / sqrtf(wave_sum(ss) * (1.0f / D) + EPS);
#pragma unroll
        for (int j = 0; j < 4; ++j) { const f32x4 g = *(const f32x4*)(p.final_norm + 4 * lane + 256 * j); *(f32x4*)(xr + 4 * lane + 256 * j) = v[j] * rstd * g; }
    }
}

enum Phase { PH_PRO = 0, PH_NORM1, PH_GEMM_IN, PH_ROPE, PH_MIX1, PH_MIX2, PH_MIX3, PH_GEMM_OUT, PH_NORM2, PH_GEMM_GU, PH_GEMM_DN, PH_FINAL };
#ifdef __HIP_EMU__
#define LDSP(x) (x)
#else
#define LDSP(x) ((PG8_LAS unsigned char*)(x))
#endif
template <int PH> __device__ __forceinline__ void run_phase(const P& p, int l, unsigned char* smem) {
    if constexpr (PH == PH_PRO) { ph_convert(p, smem); __syncthreads(); ph_adaln(p, smem); ph_ropetab_copyx(p); }
    else if constexpr (PH == PH_NORM1) ph_norm_mod<0>(p, l);
    else if constexpr (PH == PH_GEMM_IN) {
        pg8::Gemm g{WSP(bf16_t, WS_H), WSP(bf16_t, WS_WIN) + (size_t)l * NPROJ * D, MPAD, NPROJ, D}; pg8::StaticOrder S; S.init(MPAD, NPROJ, (int)gridDim.x, (int)blockIdx.x);
        pg8::EpiStoreBf16 E{WSP(bf16_t, WS_PROJ), NPROJ};
        pg8::gemm_phase<pg8::EpiStoreBf16, pg8::StaticOrder, true, true>(LDSP(smem), g, S, E);
    }
    else if constexpr (PH == PH_ROPE) ph_rope_out(p, l);
    else if constexpr (PH == PH_MIX1) { ph_attn(p, l); ph_ret_local(p, l, smem); ph_gdn_prep(p, l, smem); ph_ret_sample(p, l, smem); ph_gdn_sample(p, l, smem); }
    else if constexpr (PH == PH_MIX2) { ph_gdn_chain(p, l, smem); ph_ret_scan(p, l); }
    else if constexpr (PH == PH_MIX3) { ph_ret_out(p, l, smem); ph_gdn_out(p, l, smem); }
    else if constexpr (PH == PH_GEMM_OUT) {
        pg8::Gemm g{WSP(bf16_t, WS_O), WSP(bf16_t, WS_WOUT) + (size_t)l * D * D, MPAD, D, D}; pg8::StaticOrder S; S.init(MPAD, D, (int)gridDim.x, (int)blockIdx.x);
        pg8::EpiResidual E{p.out, WSP(float, WS_MOD) + (size_t)l * NC * 6144 + 2048};
        pg8::gemm_phase<pg8::EpiResidual, pg8::StaticOrder, true, true>(LDSP(smem), g, S, E);
    }
    else if constexpr (PH == PH_NORM2) ph_norm_mod<1>(p, l);
    else if constexpr (PH == PH_GEMM_GU) {
        pg8::Gemm g{WSP(bf16_t, WS_H), WSP(bf16_t, WS_WGU) + (size_t)l * 2 * FF * D, MPAD, 2 * FF, D}; pg8::StaticOrder S; S.init(MPAD, 2 * FF, (int)gridDim.x, (int)blockIdx.x);
        pg8::EpiSwiglu E{WSP(bf16_t, WS_HID)};
        pg8::gemm_phase<pg8::EpiSwiglu, pg8::StaticOrder, true, true>(LDSP(smem), g, S, E);
    }
    else if constexpr (PH == PH_GEMM_DN) {
        pg8::Gemm g{WSP(bf16_t, WS_HID), WSP(bf16_t, WS_WDN) + (size_t)l * D * FF, MPAD, D, FF}; pg8::StaticOrder S; S.init(MPAD, D, (int)gridDim.x, (int)blockIdx.x);
        pg8::EpiResidual E{p.out, WSP(float, WS_MOD) + (size_t)l * NC * 6144 + 5120};
        pg8::gemm_phase<pg8::EpiResidual, pg8::StaticOrder, true, true>(LDSP(smem), g, S, E);
    }
    else if constexpr (PH == PH_FINAL) ph_final_norm(p);
}
template <int PH> __global__ void __launch_bounds__(NTHR, 2) k_phase(P p, int l) { DYN_SMEM(smem); run_phase<PH>(p, l, smem); }


#ifndef __HIP_EMU__
#define GRID_SYNC() grid.sync()
__global__ void __launch_bounds__(NTHR, 2) k_mega(P p_arg) {
    DYN_SMEM(smem);
#if defined(__HIP_DEVICE_COMPILE__)
#define PHASE(PH_, l_) do { const __attribute__((address_space(4))) P* kp_ = (const __attribute__((address_space(4))) P*)__builtin_amdgcn_kernarg_segment_ptr(); LAUNDER_PTR(kp_); P pl_; __builtin_memcpy(&pl_, kp_, sizeof(P)); run_phase<PH_>(pl_, l_, smem); } while (0)
#else
#define PHASE(PH_, l_) run_phase<PH_>(p_arg, l_, smem)
#endif
    cooperative_groups::grid_group grid = cooperative_groups::this_grid();
    PHASE(PH_PRO, 0); GRID_SYNC();
#define LAYER(l) do { PHASE(PH_NORM1, l); GRID_SYNC(); PHASE(PH_GEMM_IN, l); GRID_SYNC(); PHASE(PH_ROPE, l); GRID_SYNC(); PHASE(PH_MIX1, l); GRID_SYNC(); PHASE(PH_MIX2, l); GRID_SYNC(); \
        PHASE(PH_MIX3, l); GRID_SYNC(); PHASE(PH_GEMM_OUT, l); GRID_SYNC(); PHASE(PH_NORM2, l); GRID_SYNC(); PHASE(PH_GEMM_GU, l); GRID_SYNC(); PHASE(PH_GEMM_DN, l); GRID_SYNC(); } while (0)
    static_assert(NL == 2, "two layers written out (a loop over the layers makes hipcc hoist every phase's constants to the loop preheader and spill)");
    LAYER(0); LAYER(1);
    PHASE(PH_FINAL, 0);
}
#endif

template <int PH> static void launch_phase(const P& p, int l, int grid, hipStream_t stream) {
#ifndef __HIP_EMU__
    static bool attr_done = false;
    if (!attr_done) { (void)hipFuncSetAttribute((const void*)k_phase<PH>, hipFuncAttributeMaxDynamicSharedMemorySize, SMEM_BYTES); attr_done = true; }
#endif
    LAUNCH(k_phase<PH>, grid, SMEM_BYTES, stream, p, l);
}

extern "C" void kernel_launch(void* const* d_in, const int* in_sizes, int n_in, void* d_out, int out_size, void* d_ws, size_t ws_size, hipStream_t stream) {
    if (n_in != 24 || (size_t)out_size != O_END || ws_size < WS_END) {
        fprintf(stderr, "kernel_launch: shape mismatch: n_in %d out_size %d (want %zu) ws %zu (want %zu)\n", n_in, out_size, (size_t)O_END, ws_size, (size_t)WS_END); return; }
    P p{};
    const float** pp = (const float**)&p;
    for (int i = 0; i < 24; ++i) pp[i] = (const float*)d_in[i];
    p.out = (float*)d_out; p.ws = (unsigned char*)d_ws;
#ifndef __HIP_EMU__
    static int grid = 0;
    if (grid == 0) {
        int dev = 0, cus = 0, per_cu = 0;
        if (hipGetDevice(&dev) != hipSuccess || hipDeviceGetAttribute(&cus, hipDeviceAttributeMultiprocessorCount, dev) != hipSuccess || cus <= 0) { fprintf(stderr, "kernel_launch: device query failed\n"); grid = -1; return; }
        if (hipFuncSetAttribute((const void*)k_mega, hipFuncAttributeMaxDynamicSharedMemorySize, SMEM_BYTES) != hipSuccess) { fprintf(stderr, "kernel_launch: hipFuncSetAttribute failed\n"); grid = -1; return; }
        if (hipOccupancyMaxActiveBlocksPerMultiprocessor(&per_cu, (const void*)k_mega, NTHR, SMEM_BYTES) != hipSuccess || per_cu < 1) { fprintf(stderr, "kernel_launch: occupancy query says %d blocks per CU\n", per_cu); grid = -1; return; }
        grid = cus;
    }
    if (grid < 0) return;
    { void* args[] = {(void*)&p};
      hipError_t e = hipLaunchCooperativeKernel((const void*)k_mega, dim3(grid), dim3(NTHR), args, SMEM_BYTES, stream);
      if (e != hipSuccess) fprintf(stderr, "kernel_launch: cooperative launch failed: %s (grid %d)\n", hipGetErrorString(e), grid);
      return; }
#else
    int grid = 16;
#endif
    launch_phase<PH_PRO>(p, 0, grid, stream);
    for (int l = 0; l < NL; ++l) {
        launch_phase<PH_NORM1>(p, l, grid, stream);
        launch_phase<PH_GEMM_IN>(p, l, grid, stream);
        launch_phase<PH_ROPE>(p, l, grid, stream);
        launch_phase<PH_MIX1>(p, l, grid, stream);
        launch_phase<PH_MIX2>(p, l, grid, stream);
        launch_phase<PH_MIX3>(p, l, grid, stream);
        launch_phase<PH_GEMM_OUT>(p, l, grid, stream);
        launch_phase<PH_NORM2>(p, l, grid, stream);
        launch_phase<PH_GEMM_GU>(p, l, grid, stream);
        launch_phase<PH_GEMM_DN>(p, l, grid, stream);
    }
    launch_phase<PH_FINAL>(p, 0, grid, stream);
}
```

```cpp
#ifndef __HIP_EMU__
#include <hip/hip_runtime.h>
#include <hip/hip_cooperative_groups.h>
#endif
#include <cstdio>
#include <cstdint>
#include <cmath>

#ifndef CFG_BATCH
#define CFG_BATCH 2
#endif
#ifndef CFG_SEQ
#define CFG_SEQ 8192
#endif
#ifndef CFG_DB
#define CFG_DB 32
#endif
constexpr int D = 1024, NL = 2, PB = CFG_BATCH, T = CFG_SEQ, DB = CFG_DB, DS = 8, PAST = 16384, WB = 2048;
constexpr int MP = PB * T, MS = DB * DS, M = MP + MS, MPAD = (M + 255) / 256 * 256, NC = PB + DB;
constexpr int INC = 3848, NPROJ = 3840, FF = 2816, NCH = T / 64, PWIN = T < 2048 ? T : 2048, NPOS = T + DS;
constexpr int NUNIT = PB * 4 * NCH;
constexpr float EPS = 1e-6f;
constexpr float LOG2E = 1.4426950408889634f;
static_assert(T % 512 == 0, "the attention job decomposition wants T % 512 == 0");
constexpr int C_QA = 0, C_KA = 256, C_VA = 512, C_QR = 768, C_KR = 1024, C_VR = 1280, C_GR = 1536, C_CONV = 1792, C_Z = 3328;
constexpr int SMEM_BYTES = 147456;
constexpr int NTHR = 512;

typedef unsigned short bf16_t;
typedef short bf16x8 __attribute__((ext_vector_type(8)));
typedef float f32x4 __attribute__((ext_vector_type(4)));
typedef unsigned u32x4 __attribute__((ext_vector_type(4)));
typedef unsigned u32x2 __attribute__((ext_vector_type(2)));
typedef float f32x16 __attribute__((ext_vector_type(16)));

#ifdef __HIP_EMU__
#define LAUNCH(kern, grid, lds, stream, ...) emu_launch(grid, NTHR, [=]() { kern(__VA_ARGS__); })
#define DYN_SMEM(name) unsigned char* name = emu_dyn_smem()
#define WAVE_SYNC() emu_wave_bar()
#define MFMA32(a, b, c) emu_mfma32(a, b, c)
#define MFMA16(a, b, c) emu_mfma16(a, b, c)
#else
#define WAVE_SYNC() asm volatile("s_waitcnt lgkmcnt(0)" ::: "memory")
#define MFMA32(a, b, c) __builtin_amdgcn_mfma_f32_32x32x16_bf16(a, b, c, 0, 0, 0)
#define MFMA16(a, b, c) __builtin_amdgcn_mfma_f32_16x16x32_bf16(a, b, c, 0, 0, 0)
#define LAUNCH(kern, grid, lds, stream, ...) hipLaunchKernelGGL(kern, dim3(grid), dim3(NTHR), lds, stream, __VA_ARGS__)
#define DYN_SMEM(name) extern __shared__ __attribute__((aligned(16))) unsigned char name[]
#endif

#ifdef __HIP_EMU__
__device__ __forceinline__ int tidx() { return (int)threadIdx.x; }
#define LAUNDER_PTR(x)
#else
__device__ __forceinline__ int tidx() { int t = (int)threadIdx.x; asm volatile("" : "+v"(t)); return t; }
#define LAUNDER_PTR(x) asm volatile("" : "+s"(x))
#endif
__device__ __forceinline__ float bf2f(bf16_t v) { return __builtin_bit_cast(float, (unsigned)v << 16); }
__device__ __forceinline__ bf16_t f2bf(float f) { unsigned u = __builtin_bit_cast(unsigned, f); return (bf16_t)((u + 0x7fffu + ((u >> 16) & 1u)) >> 16); }
__device__ __forceinline__ unsigned pk2(float lo, float hi) { return (unsigned)f2bf(lo) | ((unsigned)f2bf(hi) << 16); }
__device__ __forceinline__ float silu_f(float x) { return x / (1.0f + expf(-x)); }
__device__ __forceinline__ float wave_sum(float v) {
#pragma unroll
    for (int o = 1; o < 64; o <<= 1) v += __shfl_xor(v, o);
    return v;
}
__device__ __forceinline__ float wave_max(float v) {
#pragma unroll
    for (int o = 1; o < 64; o <<= 1) v = fmaxf(v, __shfl_xor(v, o));
    return v;
}

struct P {
    const float *x_prompt, *x_sample, *cache_k, *cache_v, *state_ret, *state_gdn, *state_conv, *c_prompt, *c_sample, *ada_w, *ada_b, *norm_mix, *norm_ffn,
        *w_in, *ret_norm, *conv_w, *a_log, *dt_bias, *gdn_norm, *w_out, *w_gate, *w_up, *w_down, *final_norm;
    float* out; unsigned char* ws;
};

constexpr size_t O_YP = 0, O_YS = O_YP + (size_t)MP * D, O_PWK = O_YS + (size_t)MS * D, O_PWV = O_PWK + (size_t)NL * PB * PWIN * 256,
                 O_PRET = O_PWV + (size_t)NL * PB * PWIN * 256, O_PGDN = O_PRET + (size_t)NL * PB * 4 * 4096, O_PCONV = O_PGDN + (size_t)NL * PB * 4 * 16384,
                 O_SWK = O_PCONV + (size_t)NL * PB * 3 * 1536, O_SWV = O_SWK + (size_t)NL * DB * DS * 256, O_SRET = O_SWV + (size_t)NL * DB * DS * 256,
                 O_SGDN = O_SRET + (size_t)NL * DB * 4 * 4096, O_SCONV = O_SGDN + (size_t)NL * DB * 4 * 16384, O_END = O_SCONV + (size_t)NL * DB * 3 * 1536;

constexpr size_t al256(size_t x) { return (x + 255) / 256 * 256; }
constexpr size_t WS_CTL = 0, WS_CTL_BYTES = 1u << 20;
constexpr size_t WS_MOD = WS_CTL + WS_CTL_BYTES;
constexpr size_t WS_ROPE = al256(WS_MOD + (size_t)NL * NC * 6144 * 4);
constexpr size_t WS_WIN = al256(WS_ROPE + (size_t)4 * NPOS * 32 * 4);
constexpr size_t WS_WOUT = al256(WS_WIN + (size_t)NL * NPROJ * D * 2);
constexpr size_t WS_WGU = al256(WS_WOUT + (size_t)NL * D * D * 2);
constexpr size_t WS_WDN = al256(WS_WGU + (size_t)NL * 2 * FF * D * 2);
constexpr size_t WS_H = al256(WS_WDN + (size_t)NL * D * FF * 2);
constexpr size_t WS_PROJ = al256(WS_H + (size_t)MPAD * D * 2);
constexpr size_t WS_BETA = al256(WS_PROJ + (size_t)MPAD * NPROJ * 2);
constexpr size_t WS_G = al256(WS_BETA + (size_t)M * 4 * 4);
constexpr size_t WS_O = al256(WS_G + (size_t)M * 4 * 4);
constexpr size_t WS_RU = al256(WS_O + (size_t)MPAD * D * 2);
constexpr size_t WS_RS = al256(WS_RU + (size_t)NUNIT * 4096 * 4);
constexpr size_t WS_SCR = al256(WS_RS + (size_t)NUNIT * 4096 * 4);
constexpr size_t WS_GU = WS_SCR;
constexpr size_t WS_GW = al256(WS_GU + (size_t)NUNIT * 8192 * 4);
constexpr size_t WS_GQ = al256(WS_GW + (size_t)NUNIT * 8192 * 2);
constexpr size_t WS_GK = al256(WS_GQ + (size_t)NUNIT * 8192 * 2);
constexpr size_t WS_GA = al256(WS_GK + (size_t)NUNIT * 8192 * 2);
constexpr size_t WS_GD = al256(WS_GA + (size_t)NUNIT * 4096 * 2);
constexpr size_t WS_GV = al256(WS_GD + (size_t)NUNIT * 4);
constexpr size_t WS_GS = al256(WS_GV + (size_t)NUNIT * 8192 * 4);
constexpr size_t WS_GEND = al256(WS_GS + (size_t)NUNIT * 16384 * 4);
constexpr size_t WS_KH = WS_GEND;
constexpr size_t WS_VT1 = al256(WS_KH + (size_t)MP * 256 * 2);
constexpr size_t WS_VT4 = al256(WS_VT1 + (size_t)MP * 256 * 2);
constexpr size_t WS_VT16 = al256(WS_VT4 + (size_t)MP * 256 * 2);
constexpr size_t WS_AML = al256(WS_VT16 + (size_t)MP * 256 * 2);
constexpr size_t WS_AEND = al256(WS_AML + (size_t)MP * 4 * 3 * 2 * 4);
constexpr size_t WS_APO = WS_H;
static_assert((size_t)MP * 4 * 3 * 64 * 2 <= (size_t)MPAD * D * 2, "attention partials overlay H");
constexpr size_t WS_HID = WS_SCR;
constexpr size_t WS_HEND = al256(WS_HID + (size_t)MPAD * FF * 2);
constexpr size_t WS_END = WS_AEND > WS_HEND ? WS_AEND : WS_HEND;

#define WSP(T_, off) ((T_*)(p.ws + (off)))
__device__ __forceinline__ int row_cb(int r) { return r < MP ? r / T : PB + (r - MP) / DS; }
__device__ __forceinline__ int row_pi(int r) { return r < MP ? r % T : T + (r - MP) % DS; }
namespace pg8 {
#ifdef __HIP_EMU__
#define PG8_LAS
#else
#define PG8_LAS __attribute__((address_space(3)))
#endif
typedef unsigned short bf16_t;
typedef short bf16x8 __attribute__((ext_vector_type(8)));
typedef float f32x4 __attribute__((ext_vector_type(4)));
typedef unsigned u32x4 __attribute__((ext_vector_type(4)));
constexpr int BM = 256, BK = 64, HALF = 128, HTB = HALF * BK * 2  , STAGE_BYTES = 8 * HTB, NXCD = 8, WGM = 8;

__host__ __device__ __forceinline__ int lds_byte(int r, int c) { const int st = (r >> 4) * 2 + (c >> 5), rr = r & 15, cc = c & 31, ob = rr * 64 + cc * 2; return st * 1024 + (ob ^ (((ob >> 9) & 1) << 5)); }
__host__ __device__ __forceinline__ void stage_rc(int b, int& R, int& C) { const int st = b / 1024, sb = b % 1024, swz = sb ^ (((sb >> 9) & 1) << 5); R = (st >> 1) * 16 + swz / 64; C = (st & 1) * 32 + (swz % 64) / 2; }
__host__ __device__ __forceinline__ int perm32(int rho) { const int n = rho >> 4, i = rho & 15; return 8 * (i >> 2) + 4 * n + (i & 3); }

struct Unit { int pm, pn; };
struct Gemm { const bf16_t* A; const bf16_t* Bt; int M, N, K; };

struct StaticOrder {
    int nM, nN, nwg, G, c;
    __host__ __device__ void init(int M, int N, int G_, int c_) { nM = M / BM; nN = N / BM; nwg = nM * nN; G = G_; c = c_; }
    __host__ __device__ bool next(int i, Unit& u) const {
        const long L = (long)i * G + c; if (L >= nwg) return false;
        int wgid = (int)L; { const int q = nwg / NXCD, r = nwg % NXCD, xcd = wgid % NXCD, off = wgid / NXCD; wgid = (xcd < r ? xcd * (q + 1) : r * (q + 1) + (xcd - r) * q) + off; }
        const int nig = WGM * nN, gid = wgid / nig, fm = gid * WGM, gsz = (nM - fm) < WGM ? (nM - fm) : WGM;
        u.pm = fm + ((wgid % nig) % gsz); u.pn = (wgid % nig) / gsz; return true;
    }
    __device__ __forceinline__ void a_ready(const Unit&) const {}
    __device__ __forceinline__ void done(const Unit&) const {}
};


struct EpiStoreBf16 {
    static constexpr bool PERM = true, AFTER_DRAIN = false;
    bf16_t* O; int ldc;
    __device__ __forceinline__ void operator()(const f32x4 (&acc)[2][2][4][2], const Unit& u, int wr, int wc, int fr, int fq) const {
        const int row0 = u.pm * BM + wr * 64 + fr, col0 = u.pn * BM + wc * 32 + 8 * fq;
#pragma unroll
        for (int ai = 0; ai < 2; ++ai)
#pragma unroll
            for (int m = 0; m < 4; ++m) { bf16_t* rowp = O + (size_t)(row0 + ai * HALF + m * 16) * ldc + col0;
#pragma unroll
                for (int bj = 0; bj < 2; ++bj) { const f32x4 v0 = acc[ai][bj][m][0], v1 = acc[ai][bj][m][1];
                    u32x4 w; w.x = ::pk2(v0[0], v0[1]); w.y = ::pk2(v0[2], v0[3]); w.z = ::pk2(v1[0], v1[1]); w.w = ::pk2(v1[2], v1[3]);
                    *(u32x4*)(rowp + bj * HALF) = w; } }
    }
};
struct EpiResidual {
    static constexpr bool PERM = false, AFTER_DRAIN = false;
    float* X; const float* gate;
    __device__ __forceinline__ void operator()(const f32x4 (&acc)[2][2][4][2], const Unit& u, int wr, int wc, int fr, int fq) const {
        const int row0 = u.pm * BM + wr * 64 + fr, col0 = u.pn * BM + wc * 32 + 4 * fq;
#pragma unroll
        for (int ai = 0; ai < 2; ++ai)
#pragma unroll
            for (int m = 0; m < 4; ++m) { const int row = row0 + ai * HALF + m * 16;
                if (MPAD != M && row >= M) continue;
                const float* g = gate + (size_t)::row_cb(row) * 6144 + col0; float* xp = X + (size_t)row * D + col0;
#pragma unroll
                for (int bj = 0; bj < 2; ++bj)
#pragma unroll
                    for (int n = 0; n < 2; ++n) { const f32x4 gv = *(const f32x4*)(g + bj * HALF + n * 16); f32x4* xq = (f32x4*)(xp + bj * HALF + n * 16); *xq = *xq + gv * acc[ai][bj][m][n]; } }
    }
};
struct EpiSwiglu {
    static constexpr bool PERM = true, AFTER_DRAIN = false;
    bf16_t* Hd;
    __device__ __forceinline__ void operator()(const f32x4 (&acc)[2][2][4][2], const Unit& u, int wr, int wc, int fr, int fq) const {
        const int row0 = u.pm * BM + wr * 64 + fr, col0 = u.pn * HALF + wc * 32 + 8 * fq;
#pragma unroll
        for (int ai = 0; ai < 2; ++ai)
#pragma unroll
            for (int m = 0; m < 4; ++m) { bf16_t* rowp = Hd + (size_t)(row0 + ai * HALF + m * 16) * FF + col0;
                float v[8];
#pragma unroll
                for (int n = 0; n < 2; ++n)
#pragma unroll
                    for (int j = 0; j < 4; ++j) { const float gt = acc[ai][0][m][n][j], up = acc[ai][1][m][n][j]; v[4 * n + j] = ::silu_f(gt) * up; }
                u32x4 w; w.x = ::pk2(v[0], v[1]); w.y = ::pk2(v[2], v[3]); w.z = ::pk2(v[4], v[5]); w.w = ::pk2(v[6], v[7]);
                *(u32x4*)rowp = w; }
    }
};

#ifdef __HIP_EMU__
template <class Epi, class Sched, bool ALIGN_EPI = false, bool SP2 = false>
__device__ __forceinline__ void gemm_phase(unsigned char* lds, const Gemm g, const Sched& S, const Epi& E) {
    const int tid = threadIdx.x, wid = tid >> 6, lane = tid & 63, wr = wid >> 2, wc = wid & 3, fr = lane & 15, fq = lane >> 4;
    Unit cur;
    for (int ui = 0; S.next(ui, cur); ++ui) {
        f32x4 acc[2][2][4][2];
        for (int ai = 0; ai < 2; ++ai) for (int bj = 0; bj < 2; ++bj) for (int m = 0; m < 4; ++m) for (int n = 0; n < 2; ++n) for (int j = 0; j < 4; ++j) {
            const int row = 256 * cur.pm + 128 * ai + 64 * wr + 16 * m + fr;
            const int col = Epi::PERM ? 256 * cur.pn + 128 * bj + 32 * wc + 8 * fq + 4 * n + j : 256 * cur.pn + 128 * bj + 32 * wc + 16 * n + 4 * fq + j;
            const bf16_t* a = g.A + (size_t)row * g.K; const bf16_t* b = g.Bt + (size_t)col * g.K; float s = 0.f;
            for (int k = 0; k < g.K; ++k) s += ::bf2f(a[k]) * ::bf2f(b[k]);
            acc[ai][bj][m][n][j] = s; }
        E(acc, cur, wr, wc, fr, fq);
    }
}
#else
template <class Epi, class Sched, bool ALIGN_EPI = false, bool SP2 = false>
__device__ __forceinline__ void gemm_phase(PG8_LAS unsigned char* lds, const Gemm g, const Sched& S, const Epi& E) {
    const int tid = ::tidx(), wid = __builtin_amdgcn_readfirstlane(tid >> 6), lane = tid & 63, wr = wid >> 2, wc = wid & 3, fr = lane & 15, fq = lane >> 4;
    const int K = g.K, nt = K / BK;
    unsigned voffA[2], voffB[2];
#pragma unroll
    for (int i = 0; i < 2; ++i) { int R, C; stage_rc(tid * 16 + i * 8192, R, C); const int Rb = Epi::PERM ? ((R & ~31) + perm32(R & 31)) : R;
        voffA[i] = (unsigned)(R * K + C) * 2u; voffB[i] = (unsigned)(Rb * K + C) * 2u; }
    const size_t kstep = (size_t)(BK * 2);
    const size_t hstep = (size_t)HALF * K * 2;
    const size_t tstep = 2 * hstep;
    const unsigned ldsw = (unsigned)wid * 1024u;
    const int aoff = lds_byte(wr * 64 + fr, fq * 8), boff = lds_byte(wc * 32 + fr, fq * 8);
#define PG8_SA(b, h) (((b) * 2 + (h)) * HTB)
#define PG8_SB(b, h) ((4 + (b) * 2 + (h)) * HTB)
#define PG8_STAGE(bufoff, gbase, voff) do { _Pragma("unroll") for (int _i = 0; _i < 2; ++_i) \
        __builtin_amdgcn_global_load_lds((const unsigned*)((const char*)(gbase) + (voff)[_i]), (PG8_LAS unsigned*)(lds + (bufoff) + ldsw + _i * 8192), 16, 0, 0); } while (0)
#define PG8_LDA(dst, b, h) do { _Pragma("unroll") for (int m = 0; m < 4; ++m) _Pragma("unroll") for (int k = 0; k < 2; ++k) dst[m][k] = *(const PG8_LAS bf16x8*)(lds + PG8_SA(b, h) + aoff + m * 2048 + k * 1024); } while (0)
#define PG8_LDB(dst, b, h) do { _Pragma("unroll") for (int n = 0; n < 2; ++n) _Pragma("unroll") for (int k = 0; k < 2; ++k) dst[n][k] = *(const PG8_LAS bf16x8*)(lds + PG8_SB(b, h) + boff + n * 2048 + k * 1024); } while (0)
#define PG8_MMA(ai, bj, At, Bt) do { __builtin_amdgcn_s_setprio(1); _Pragma("unroll") for (int m = 0; m < 4; ++m) _Pragma("unroll") for (int n = 0; n < 2; ++n) _Pragma("unroll") for (int k = 0; k < 2; ++k) \
        acc[ai][bj][m][n] = __builtin_amdgcn_mfma_f32_16x16x32_bf16(Bt[n][k], At[m][k], acc[ai][bj][m][n], 0, 0, 0); __builtin_amdgcn_s_setprio(0); } while (0)
#define PG8_WAIT_V(n) asm volatile("s_waitcnt vmcnt(" #n ")" ::: "memory")
#define PG8_WAIT_L(n) asm volatile("s_waitcnt lgkmcnt(" #n ")" ::: "memory")
#define PG8_BAR __builtin_amdgcn_s_barrier()
#define PG8_SCHED __builtin_amdgcn_sched_barrier(0)
    Unit cur, nxt; int ui = 0;
    if (!S.next(0, cur)) return;
    f32x4 acc[2][2][4][2];
#pragma unroll
    for (int a = 0; a < 2; ++a)
#pragma unroll
        for (int b = 0; b < 2; ++b)
#pragma unroll
            for (int m = 0; m < 4; ++m)
#pragma unroll
                for (int n = 0; n < 2; ++n) acc[a][b][m][n] = (f32x4){0.f, 0.f, 0.f, 0.f};
    bf16x8 At[4][2], B0[2][2], B1[2][2];
    const char* cA = (const char*)g.A + (size_t)cur.pm * tstep; const char* cB = (const char*)g.Bt + (size_t)cur.pn * tstep;
    S.a_ready(cur);
    if constexpr (SP2) {
        PG8_STAGE(PG8_SB(0, 0), cB, voffB); PG8_STAGE(PG8_SB(0, 1), cB + hstep, voffB); PG8_STAGE(PG8_SA(0, 0), cA, voffA); PG8_STAGE(PG8_SA(0, 1), cA + hstep, voffA);
        if (wr == 1) PG8_BAR;
        PG8_WAIT_V(2); PG8_BAR;
        PG8_STAGE(PG8_SB(1, 0), cB + kstep, voffB); PG8_STAGE(PG8_SA(1, 0), cA + kstep, voffA); PG8_STAGE(PG8_SB(1, 1), cB + hstep + kstep, voffB);
        PG8_WAIT_V(6); PG8_BAR;
    } else {
        PG8_STAGE(PG8_SB(0, 0), cB, voffB); PG8_STAGE(PG8_SA(0, 0), cA, voffA); PG8_STAGE(PG8_SB(0, 1), cB + hstep, voffB); PG8_STAGE(PG8_SA(0, 1), cA + hstep, voffA);
        if (wr == 1) PG8_BAR;
        PG8_WAIT_V(4); PG8_BAR;
        PG8_STAGE(PG8_SB(1, 0), cB + kstep, voffB); PG8_STAGE(PG8_SA(1, 0), cA + kstep, voffA); PG8_STAGE(PG8_SB(1, 1), cB + hstep + kstep, voffB);
        PG8_WAIT_V(6); PG8_BAR;
    }
    for (;;) {
        const bool has_next = S.next(ui + 1, nxt);
        const char* nA = has_next ? (const char*)g.A + (size_t)nxt.pm * tstep : cA; const char* nB = has_next ? (const char*)g.Bt + (size_t)nxt.pn * tstep : cB;
        for (int t = 0; t < nt; t += 2) {
            const bool last = (t == nt - 2);
            const char* a1 = cA + (size_t)(t + 1) * kstep;
            const char* a2 = last ? nA : cA + (size_t)(t + 2) * kstep; const char* b2 = last ? nB : cB + (size_t)(t + 2) * kstep;
            const char* a3 = a2 + kstep; const char* b3 = b2 + kstep;
            if (last && has_next) S.a_ready(nxt);
            if constexpr (SP2) {
            PG8_LDB(B0, 0, 0); PG8_LDB(B1, 0, 1); PG8_SCHED; PG8_LDA(At, 0, 0); PG8_STAGE(PG8_SA(1, 1), a1 + hstep, voffA);
            PG8_WAIT_V(8); PG8_WAIT_L(0); PG8_BAR; PG8_MMA(0, 0, At, B0); PG8_MMA(0, 1, At, B1); PG8_BAR; PG8_SCHED;
            PG8_LDA(At, 0, 1); PG8_STAGE(PG8_SB(0, 0), b2, voffB); PG8_STAGE(PG8_SB(0, 1), b2 + hstep, voffB); PG8_STAGE(PG8_SA(0, 0), a2, voffA);
            PG8_WAIT_V(8); PG8_WAIT_L(0); PG8_BAR; PG8_MMA(1, 0, At, B0); PG8_MMA(1, 1, At, B1); PG8_BAR; PG8_SCHED;
            PG8_LDB(B0, 1, 0); PG8_LDB(B1, 1, 1); PG8_SCHED; PG8_LDA(At, 1, 0); PG8_STAGE(PG8_SA(0, 1), a2 + hstep, voffA);
            PG8_WAIT_V(8); PG8_WAIT_L(0); PG8_BAR; PG8_MMA(0, 0, At, B0); PG8_MMA(0, 1, At, B1); PG8_BAR; PG8_SCHED;
            PG8_LDA(At, 1, 1); PG8_STAGE(PG8_SB(1, 0), b3, voffB); PG8_STAGE(PG8_SB(1, 1), b3 + hstep, voffB); PG8_STAGE(PG8_SA(1, 0), a3, voffA);
            PG8_WAIT_V(8); PG8_WAIT_L(0); PG8_BAR; PG8_MMA(1, 0, At, B0); PG8_MMA(1, 1, At, B1); PG8_BAR; PG8_SCHED;
            } else {
            PG8_LDB(B0, 0, 0); PG8_SCHED; PG8_LDA(At, 0, 0); PG8_STAGE(PG8_SA(1, 1), a1 + hstep, voffA);
            PG8_WAIT_L(8); PG8_BAR; PG8_WAIT_L(0); PG8_MMA(0, 0, At, B0); PG8_BAR; PG8_SCHED;
            PG8_LDB(B1, 0, 1); PG8_STAGE(PG8_SB(0, 0), b2, voffB);
            PG8_BAR; PG8_WAIT_L(0); PG8_MMA(0, 1, At, B1); PG8_BAR;
            PG8_LDA(At, 0, 1); PG8_STAGE(PG8_SA(0, 0), a2, voffA);
            PG8_BAR; PG8_WAIT_L(0); PG8_MMA(1, 0, At, B0); PG8_BAR; PG8_SCHED;
            PG8_STAGE(PG8_SB(0, 1), b2 + hstep, voffB);
            PG8_WAIT_V(6); PG8_BAR; PG8_MMA(1, 1, At, B1); PG8_BAR;
            PG8_LDB(B0, 1, 0); PG8_SCHED; PG8_LDA(At, 1, 0); PG8_STAGE(PG8_SA(0, 1), a2 + hstep, voffA);
            PG8_WAIT_L(8); PG8_BAR; PG8_WAIT_L(0); PG8_MMA(0, 0, At, B0); PG8_BAR; PG8_SCHED;
            PG8_LDB(B1, 1, 1); PG8_STAGE(PG8_SB(1, 0), b3, voffB);
            PG8_BAR; PG8_WAIT_L(0); PG8_MMA(0, 1, At, B1); PG8_BAR;
            PG8_LDA(At, 1, 1); PG8_STAGE(PG8_SA(1, 0), a3, voffA);
            PG8_BAR; PG8_WAIT_L(0); PG8_MMA(1, 0, At, B0); PG8_BAR; PG8_SCHED;
            PG8_STAGE(PG8_SB(1, 1), b3 + hstep, voffB);
            PG8_WAIT_V(6); PG8_BAR; PG8_MMA(1, 1, At, B1); PG8_BAR;
            }
        }
        if constexpr (ALIGN_EPI) { if (wr == 0) PG8_BAR; }
        if constexpr (!Epi::AFTER_DRAIN) { E(acc, cur, wr, wc, fr, fq); S.done(cur); }
        if (!has_next) break;
#pragma unroll
        for (int a = 0; a < 2; ++a)
#pragma unroll
            for (int b = 0; b < 2; ++b)
#pragma unroll
                for (int m = 0; m < 4; ++m)
#pragma unroll
                    for (int n = 0; n < 2; ++n) acc[a][b][m][n] = (f32x4){0.f, 0.f, 0.f, 0.f};
        cur = nxt; cA = nA; cB = nB; ++ui;
        if constexpr (ALIGN_EPI) { if (wr == 1) PG8_BAR; }
    }
    PG8_WAIT_V(0);
    if constexpr (!ALIGN_EPI) { if (wr == 0) PG8_BAR; }
    PG8_BAR;
    if constexpr (Epi::AFTER_DRAIN) { E.fused(acc, cur, wr, wc, fr, fq, lds, wid, lane); S.done(cur); }
#undef PG8_SA
#undef PG8_SB
#undef PG8_STAGE
#undef PG8_LDA
#undef PG8_LDB
#undef PG8_MMA
#undef PG8_WAIT_V
#undef PG8_WAIT_L
#undef PG8_BAR
#undef PG8_SCHED
}
#endif
}


__device__ __forceinline__ void transpose_item(const float* W, int ldw, bf16_t* WT, int K, int k0, int n0, int drow0, float* scr, int lane) {
#pragma unroll 8
    for (int i = 0; i < 32; ++i) { const int kk = 2 * i + (lane >> 5); scr[kk * 33 + (lane & 31)] = W[(size_t)(k0 + kk) * ldw + n0 + (lane & 31)]; }
    WAVE_SYNC();
    const int c = lane & 7;
#pragma unroll
    for (int j = 0; j < 4; ++j) { const int n = (lane >> 3) + 8 * j; const float* s = scr + (8 * c) * 33 + n;
        u32x4 o; o.x = pk2(s[0 * 33], s[1 * 33]); o.y = pk2(s[2 * 33], s[3 * 33]); o.z = pk2(s[4 * 33], s[5 * 33]); o.w = pk2(s[6 * 33], s[7 * 33]);
        *(u32x4*)(WT + (size_t)(drow0 + n) * K + k0 + 8 * c) = o; }
    WAVE_SYNC();
}
__device__ __forceinline__ void ph_convert(const P& p, unsigned char* smem) {
    const int lane = tidx() & 63, wave = tidx() >> 6;
    float* scr = (float*)smem + wave * (64 * 33 + 32);
    constexpr int I_IN = 16 * 120, I_OUT = 16 * 32, I_G = 16 * 88, I_DN = 44 * 32, I_L = I_IN + I_OUT + 2 * I_G + I_DN;
    const int gw = blockIdx.x * 8 + wave, ngw = gridDim.x * 8;
    for (int it = gw; it < NL * I_L; it += ngw) {
        const int l = it / I_L; int r = it % I_L;
        if (r < I_IN) { const int kb = r / 120, nb = r % 120; transpose_item(p.w_in + (size_t)l * D * INC, INC, WSP(bf16_t, WS_WIN) + (size_t)l * NPROJ * D, D, kb * 64, nb * 32, nb * 32, scr, lane); continue; }
        r -= I_IN;
        if (r < I_OUT) { const int kb = r / 32, nb = r % 32; transpose_item(p.w_out + (size_t)l * D * D, D, WSP(bf16_t, WS_WOUT) + (size_t)l * D * D, D, kb * 64, nb * 32, nb * 32, scr, lane); continue; }
        r -= I_OUT;
        if (r < 2 * I_G) { const int up = r / I_G; r %= I_G; const int kb = r / 88, nb = r % 88, n0 = nb * 32;
            transpose_item((up ? p.w_up : p.w_gate) + (size_t)l * D * FF, FF, WSP(bf16_t, WS_WGU) + (size_t)l * 2 * FF * D, D, kb * 64, n0, (n0 / 128) * 256 + up * 128 + (n0 % 128), scr, lane); continue; }
        r -= 2 * I_G;
        { const int kb = r / 32, nb = r % 32; transpose_item(p.w_down + (size_t)l * FF * D, D, WSP(bf16_t, WS_WDN) + (size_t)l * D * FF, FF, kb * 64, nb * 32, nb * 32, scr, lane); }
    }
}

__device__ __forceinline__ void ph_adaln(const P& p, unsigned char* smem) {
    float* sc = (float*)smem;
    float* red = sc + NC * 256;
    const int tid = tidx(), col = tid & 31, kg = tid >> 5;
    float* MOD = WSP(float, WS_MOD);
    for (int it = blockIdx.x; it < NL * 192; it += gridDim.x) {
        const int l = it / 192, cb0 = (it % 192) * 32;
        float acc[NC];
#pragma unroll
        for (int r = 0; r < NC; ++r) acc[r] = 0.f;
        for (int kc = 0; kc < 4; ++kc) {
            __syncthreads();
            for (int e = tid; e < NC * 256; e += NTHR) { const int r = e >> 8, k = e & 255; const float c = r < PB ? p.c_prompt[r * D + kc * 256 + k] : p.c_sample[(r - PB) * D + kc * 256 + k]; sc[e] = silu_f(c); }
            __syncthreads();
            for (int kk = 0; kk < 16; ++kk) { const int k = kg * 16 + kk; const float w = p.ada_w[((size_t)l * D + kc * 256 + k) * 6144 + cb0 + col];
#pragma unroll
                for (int r = 0; r < NC; ++r) acc[r] += sc[r * 256 + k] * w; }
        }
#pragma unroll
        for (int r = 0; r < NC; ++r) red[(kg * NC + r) * 32 + col] = acc[r];
        __syncthreads();
        for (int e = tid; e < NC * 32; e += NTHR) { const int r = e >> 5, c = e & 31; float s = p.ada_b[l * 6144 + cb0 + c];
            for (int g = 0; g < 16; ++g) s += red[(g * NC + r) * 32 + c];
            MOD[((size_t)l * NC + r) * 6144 + cb0 + c] = s; }
        __syncthreads();
    }
}

__device__ __forceinline__ void ph_ropetab_copyx(const P& p) {
    const size_t gt = (size_t)blockIdx.x * NTHR + tidx(), ng = (size_t)gridDim.x * NTHR;
    float* tab = WSP(float, WS_ROPE);
    for (size_t e = gt; e < (size_t)NPOS * 32; e += ng) {
        const int pi = (int)(e >> 5), i = (int)(e & 31); const double pos = pi < T ? (double)pi : (double)(PAST + pi - T);
        const double ia = exp(-log(10000.0) * (double)i / 32.0), ir = exp(-log(10000.0) * (double)i / 31.0);
        tab[e] = (float)cos(pos * ia); tab[(size_t)NPOS * 32 + e] = (float)sin(pos * ia);
        tab[(size_t)2 * NPOS * 32 + e] = (float)cos(pos * ir); tab[(size_t)3 * NPOS * 32 + e] = (float)sin(pos * ir);
    }
    const f32x4* xp = (const f32x4*)p.x_prompt; const f32x4* xs = (const f32x4*)p.x_sample; f32x4* o = (f32x4*)p.out;
    for (size_t e = gt; e < (size_t)MP * D / 4; e += ng) o[e] = xp[e];
    for (size_t e = gt; e < (size_t)MS * D / 4; e += ng) o[(size_t)MP * D / 4 + e] = xs[e];
}

template <int WHICH> __device__ __forceinline__ void ph_norm_mod(const P& p, int l) {
    const int lane = tidx() & 63, wave = tidx() >> 6, gw = blockIdx.x * 8 + wave, ngw = gridDim.x * 8;
    const float* nw = (WHICH == 0 ? p.norm_mix : p.norm_ffn) + l * D;
    bf16_t* H = WSP(bf16_t, WS_H);
    for (int r = gw; r < M; r += ngw) {
        const float* xr = p.out + (size_t)r * D; const float* mod = WSP(float, WS_MOD) + ((size_t)l * NC + row_cb(r)) * 6144 + (WHICH == 0 ? 0 : 3072);
        f32x4 v[4]; float ss = 0.f;
#pragma unroll
        for (int j = 0; j < 4; ++j) { v[j] = *(const f32x4*)(xr + 4 * lane + 256 * j); ss += (v[j][0] * v[j][0] + v[j][1] * v[j][1]) + (v[j][2] * v[j][2] + v[j][3] * v[j][3]); }
        const float rstd = 1.0f / sqrtf(wave_sum(ss) * (1.0f / D) + EPS);
        float a8[8];
#pragma unroll
        for (int c = 0; c < 8; ++c) a8[c] = 0.f;
#pragma unroll
        for (int j = 0; j < 4; ++j) { const int k = 4 * lane + 256 * j;
            const f32x4 g = *(const f32x4*)(nw + k), sh = *(const f32x4*)(mod + k), sc = *(const f32x4*)(mod + 1024 + k);
            f32x4 h;
#pragma unroll
            for (int e = 0; e < 4; ++e) h[e] = v[j][e] * rstd * g[e] * (1.0f + sc[e]) + sh[e];
            u32x2 w; w.x = pk2(h[0], h[1]); w.y = pk2(h[2], h[3]); *(u32x2*)(H + (size_t)r * D + k) = w;
            if (WHICH == 0) {
#pragma unroll
                for (int e = 0; e < 4; ++e) { const float* wr = p.w_in + ((size_t)l * D + k + e) * INC + NPROJ; const f32x4 w0 = *(const f32x4*)wr, w1 = *(const f32x4*)(wr + 4);
#pragma unroll
                    for (int c = 0; c < 4; ++c) { a8[c] += h[e] * w0[c]; a8[4 + c] += h[e] * w1[c]; } }
            }
        }
        if (WHICH == 0) {
#pragma unroll
            for (int c = 0; c < 8; ++c) a8[c] = wave_sum(a8[c]);
            if (lane < 4) { float braw = lane == 0 ? a8[0] : lane == 1 ? a8[1] : lane == 2 ? a8[2] : a8[3]; WSP(float, WS_BETA)[(size_t)r * 4 + lane] = 1.0f / (1.0f + expf(-braw)); }
            else if (lane < 8) { const int hh = lane - 4; float araw = hh == 0 ? a8[4] : hh == 1 ? a8[5] : hh == 2 ? a8[6] : a8[7];
                const float xx = araw + p.dt_bias[l * 4 + hh]; const float sp = xx > 20.f ? xx : log1pf(expf(xx));
                WSP(float, WS_G)[(size_t)r * 4 + hh] = -expf(p.a_log[l * 4 + hh]) * sp; }
        }
    }
}

__device__ __forceinline__ void ph_rope_out(const P& p, int l) {
    const size_t gt = (size_t)blockIdx.x * NTHR + tidx(), ng = (size_t)gridDim.x * NTHR;
    bf16_t* PR = WSP(bf16_t, WS_PROJ); const float* tab = WSP(float, WS_ROPE);
    for (size_t e = gt; e < (size_t)M * 512; e += ng) {
        const int r = (int)(e >> 9), rem = (int)(e & 511), sec = rem >> 7, hh = (rem & 127) >> 5, d = rem & 31;
        const int off = sec == 0 ? C_QA : sec == 1 ? C_KA : sec == 2 ? C_QR : C_KR; const float scale = sec == 0 ? 0.125f * LOG2E : sec == 3 ? 0.125f : 1.0f;
        const float* ct = tab + (size_t)(sec >= 2 ? 2 : 0) * NPOS * 32 + (size_t)row_pi(r) * 32 + d; const float c = ct[0], s = ct[(size_t)NPOS * 32];
        bf16_t* x = PR + (size_t)r * NPROJ + off + hh * 64 + d; const float x1 = bf2f(x[0]), x2 = bf2f(x[32]);
        const float o1 = (x1 * c - x2 * s) * scale, o2 = (x1 * s + x2 * c) * scale;
        x[0] = f2bf(o1); x[32] = f2bf(o2);
        if (sec == 1) {
            if (r < MP) { const int b = r / T, t = r % T; bf16_t* kh = WSP(bf16_t, WS_KH) + ((size_t)(b * 4 + hh) * T + t) * 64 + d; kh[0] = f2bf(o1); kh[32] = f2bf(o2);
                if (t >= T - PWIN) { float* o = p.out + O_PWK + (((size_t)l * PB + b) * PWIN + (t - (T - PWIN))) * 256 + hh * 64 + d; o[0] = o1; o[32] = o2; } }
            else { const int b = (r - MP) / DS, i = (r - MP) % DS; float* o = p.out + O_SWK + (((size_t)l * DB + b) * DS + i) * 256 + hh * 64 + d; o[0] = o1; o[32] = o2; }
        }
    }
    for (size_t e = gt; e < (size_t)M * 256; e += ng) {
        const int r = (int)(e >> 8), c = (int)(e & 255); const float v = bf2f(PR[(size_t)r * NPROJ + C_VA + c]);
        if (r < MP) { const int b = r / T, t = r % T; if (t >= T - PWIN) p.out[O_PWV + (((size_t)l * PB + b) * PWIN + (t - (T - PWIN))) * 256 + c] = v; }
        else { const int b = (r - MP) / DS, i = (r - MP) % DS; p.out[O_SWV + (((size_t)l * DB + b) * DS + i) * 256 + c] = v; }
    }
    for (size_t e = gt; e < (size_t)(PB + DB) * 3 * 1536; e += ng) {
        const int c = (int)(e % 1536), j = (int)((e / 1536) % 3), bb = (int)(e / (3 * 1536));
        if (bb < PB) p.out[O_PCONV + (((size_t)l * PB + bb) * 3 + j) * 1536 + c] = bf2f(PR[(size_t)(bb * T + T - 3 + j) * NPROJ + C_CONV + c]);
        else { const int b = bb - PB; p.out[O_SCONV + (((size_t)l * DB + b) * 3 + j) * 1536 + c] = bf2f(PR[(size_t)(MP + b * DS + DS - 3 + j) * NPROJ + C_CONV + c]); }
    }
}

__device__ __forceinline__ void attn_wave_sample(const P& p, int l, int r, int h, int lane, float* sw  ) {
    const bf16_t* PR = WSP(bf16_t, WS_PROJ);
    const int b = (r - MP) / DS; const int tq = WB + (r - MP) % DS;
    float q[64];
    { const bf16_t* qp = PR + (size_t)r * NPROJ + C_QA + h * 64;
#pragma unroll
      for (int j = 0; j < 8; ++j) { const bf16x8 v = *(const bf16x8*)(qp + 8 * j);
#pragma unroll
          for (int e = 0; e < 8; ++e) q[8 * j + e] = bf2f((bf16_t)v[e]); } }
    float mx = -INFINITY;
#pragma unroll 1
    for (int i = 0; i < 7; ++i) {
        const int e = lane + 64 * i;
        if (e < 387) { const int pat = e / 129, j = e % 129, dil = pat == 0 ? 1 : pat == 1 ? 4 : 16; const int rr = tq - dil * j;
            float a = 0.f;
            if (rr < WB) { const float* kp = p.cache_k + ((((size_t)l * DB + b) * WB + rr) * 4 + h) * 64;
#pragma unroll
                for (int j4 = 0; j4 < 16; ++j4) { const f32x4 kv = *(const f32x4*)(kp + 4 * j4); a += q[4 * j4] * kv[0] + q[4 * j4 + 1] * kv[1] + q[4 * j4 + 2] * kv[2] + q[4 * j4 + 3] * kv[3]; } }
            else { const bf16_t* kp = PR + (size_t)(MP + b * DS + (rr - WB)) * NPROJ + C_KA + h * 64;
#pragma unroll
                for (int j8 = 0; j8 < 8; ++j8) { const bf16x8 kv = *(const bf16x8*)(kp + 8 * j8);
#pragma unroll
                    for (int e2 = 0; e2 < 8; ++e2) a += q[8 * j8 + e2] * bf2f((bf16_t)kv[e2]); } }
            sw[e] = a; mx = fmaxf(mx, a); }
    }
    mx = wave_max(mx);
    float lsum = 0.f;
#pragma unroll 1
    for (int i = 0; i < 7; ++i) { const int e = lane + 64 * i; if (e < 387) { const float pe = exp2f(sw[e] - mx); sw[e] = pe; lsum += pe; } }
    lsum = wave_sum(lsum);
    WAVE_SYNC();
    float o = 0.f;
#pragma unroll 4
    for (int e = 0; e < 387; ++e) {
        const float pe = sw[e];
        const int pat = e / 129, j = e % 129, dil = pat == 0 ? 1 : pat == 1 ? 4 : 16; const int rr = tq - dil * j;
        float v;
        if (rr < WB) v = p.cache_v[((((size_t)l * DB + b) * WB + rr) * 4 + h) * 64 + lane];
        else v = bf2f(PR[(size_t)(MP + b * DS + (rr - WB)) * NPROJ + C_VA + h * 64 + lane]);
        o += pe * v;
    }
    WAVE_SYNC();
    WSP(bf16_t, WS_O)[(size_t)r * D + h * 64 + lane] = f2bf(o / lsum);
}
__device__ __forceinline__ void ph_attn_sample(const P& p, int l, unsigned char* smem) {
    const int lane = tidx() & 63, wave = tidx() >> 6, gw = blockIdx.x * 8 + wave, ngw = gridDim.x * 8;
    float* sw = (float*)smem + wave * 392;
    for (int it = gw; it < MS * 4; it += ngw) attn_wave_sample(p, l, MP + (it >> 2), it & 3, lane, sw);
}
__device__ __forceinline__ bf16x8 pack8(const f32x16& v, int s8) {
    u32x4 w; w.x = pk2(v[s8], v[s8 + 1]); w.y = pk2(v[s8 + 2], v[s8 + 3]); w.z = pk2(v[s8 + 4], v[s8 + 5]); w.w = pk2(v[s8 + 6], v[s8 + 7]); return __builtin_bit_cast(bf16x8, w);
}
__device__ __forceinline__ void attn_job(const P& p, int jb, int lane) {
    const int c = lane & 31, hi = lane >> 5;
    constexpr int NB = T / 512;
    const int unit = jb / 48, jj = jb % 48, pat = jj >> 4, sub = jj & 15;
    const int blk = unit % NB, h = (unit / NB) & 3, b = unit / (NB * 4), bh = b * 4 + h;
    int dil, r, qi0; const bf16_t* VT;
    if (pat == 0) { dil = 1; r = 0; qi0 = blk * 512 + sub * 32; VT = WSP(bf16_t, WS_VT1) + (size_t)bh * 64 * T; }
    else if (pat == 1) { dil = 4; r = sub >> 2; qi0 = blk * 128 + (sub & 3) * 32; VT = WSP(bf16_t, WS_VT4) + (size_t)(bh * 4 + r) * 64 * (T / 4); }
    else { dil = 16; r = sub; qi0 = blk * 32; VT = WSP(bf16_t, WS_VT16) + (size_t)(bh * 16 + r) * 64 * (T / 16); }
    const int SL = T / dil;
    const int tq = dil * (qi0 + c) + r;
    const bf16_t* qp = WSP(bf16_t, WS_PROJ) + (size_t)(b * T + tq) * NPROJ + C_QA + h * 64 + 8 * hi;
    bf16x8 qf[4];
#pragma unroll
    for (int ks = 0; ks < 4; ++ks) qf[ks] = *(const bf16x8*)(qp + 16 * ks);
    const bf16_t* KHb = WSP(bf16_t, WS_KH) + (size_t)bh * T * 64;
    f32x16 S[5];
#pragma unroll
    for (int i = 0; i < 5; ++i) {
        const int kt0 = qi0 - 128 + 32 * i;
        f32x16 acc;
#pragma unroll
        for (int e = 0; e < 16; ++e) acc[e] = 0.f;
        if (kt0 >= 0) { const bf16_t* kp = KHb + (size_t)(dil * (kt0 + c) + r) * 64 + 8 * hi;
#pragma unroll
            for (int ks = 0; ks < 4; ++ks) acc = MFMA32(*(const bf16x8*)(kp + 16 * ks), qf[ks], acc);
            if (i == 0) {
#pragma unroll
                for (int e = 0; e < 16; ++e) { const int krow = (e & 3) + 8 * (e >> 2) + 4 * hi; if (krow < c) acc[e] = -INFINITY; } }
            if (i == 4) {
#pragma unroll
                for (int e = 0; e < 16; ++e) { const int krow = (e & 3) + 8 * (e >> 2) + 4 * hi; if (krow > c) acc[e] = -INFINITY; } }
        } else {
#pragma unroll
            for (int e = 0; e < 16; ++e) acc[e] = -INFINITY; }
        S[i] = acc;
    }
    float mx = -INFINITY;
#pragma unroll
    for (int i = 0; i < 5; ++i)
#pragma unroll
        for (int e = 0; e < 16; ++e) mx = fmaxf(mx, S[i][e]);
    mx = fmaxf(mx, __shfl_xor(mx, 32));
    float lsum = 0.f;
#pragma unroll
    for (int i = 0; i < 5; ++i)
#pragma unroll
        for (int e = 0; e < 16; ++e) { const float pe = exp2f(S[i][e] - mx); S[i][e] = pe; lsum += pe; }
    lsum += __shfl_xor(lsum, 32);
    f32x16 O[2];
#pragma unroll
    for (int dt = 0; dt < 2; ++dt)
#pragma unroll
        for (int e = 0; e < 16; ++e) O[dt][e] = 0.f;
#pragma unroll
    for (int i = 0; i < 5; ++i) {
        const int kt0 = qi0 - 128 + 32 * i;
        if (kt0 >= 0) {
#pragma unroll
            for (int s2 = 0; s2 < 2; ++s2) { const bf16x8 pf = pack8(S[i], 8 * s2);
#pragma unroll
                for (int dt = 0; dt < 2; ++dt) { const bf16_t* vp = VT + (size_t)(dt * 32 + c) * SL + kt0 + 16 * s2 + 4 * hi;
                    const u32x2 lo = *(const u32x2*)vp, hh = *(const u32x2*)(vp + 8); u32x4 w; w.x = lo.x; w.y = lo.y; w.z = hh.x; w.w = hh.y;
                    O[dt] = MFMA32(__builtin_bit_cast(bf16x8, w), pf, O[dt]); } }
        }
    }
    const size_t idx = ((size_t)(b * T + tq) * 4 + h) * 3 + pat;
    bf16_t* po = WSP(bf16_t, WS_APO) + idx * 64;
#pragma unroll
    for (int dt = 0; dt < 2; ++dt)
#pragma unroll
        for (int g = 0; g < 4; ++g) { u32x2 w; w.x = pk2(O[dt][4 * g], O[dt][4 * g + 1]); w.y = pk2(O[dt][4 * g + 2], O[dt][4 * g + 3]); *(u32x2*)(po + 32 * dt + 8 * g + 4 * hi) = w; }
    if (hi == 0) { float* ml = WSP(float, WS_AML) + idx * 2; ml[0] = mx; ml[1] = lsum; }
}
__device__ __forceinline__ void ph_attn_jobs(const P& p) {
    const int lane = tidx() & 63, wave = tidx() >> 6, gw = blockIdx.x * 8 + wave, ngw = gridDim.x * 8;
    for (int jb = gw; jb < PB * 4 * (T / 512) * 48; jb += ngw) attn_job(p, jb, lane);
}
__device__ __forceinline__ void ph_attn_combine(const P& p) {
    const size_t gt = (size_t)blockIdx.x * NTHR + tidx(), ng = (size_t)gridDim.x * NTHR;
    for (size_t e = gt; e < (size_t)MP * 4 * 16; e += ng) {
        const size_t rh = e >> 4; const int dq = (int)(e & 15) * 4;
        const float* ml = WSP(float, WS_AML) + rh * 6; const float m0 = ml[0], m1 = ml[2], m2 = ml[4];
        const float mm = fmaxf(m0, fmaxf(m1, m2)); const float w0 = exp2f(m0 - mm), w1 = exp2f(m1 - mm), w2 = exp2f(m2 - mm);
        const float inv = 1.0f / (w0 * ml[1] + w1 * ml[3] + w2 * ml[5]);
        const bf16_t* po = WSP(bf16_t, WS_APO) + rh * 192 + dq;
        const u32x2 a = *(const u32x2*)po, bq = *(const u32x2*)(po + 64), cq = *(const u32x2*)(po + 128);
        float o[4];
        o[0] = w0 * bf2f((bf16_t)(a.x & 0xffff)) + w1 * bf2f((bf16_t)(bq.x & 0xffff)) + w2 * bf2f((bf16_t)(cq.x & 0xffff));
        o[1] = w0 * bf2f((bf16_t)(a.x >> 16)) + w1 * bf2f((bf16_t)(bq.x >> 16)) + w2 * bf2f((bf16_t)(cq.x >> 16));
        o[2] = w0 * bf2f((bf16_t)(a.y & 0xffff)) + w1 * bf2f((bf16_t)(bq.y & 0xffff)) + w2 * bf2f((bf16_t)(cq.y & 0xffff));
        o[3] = w0 * bf2f((bf16_t)(a.y >> 16)) + w1 * bf2f((bf16_t)(bq.y >> 16)) + w2 * bf2f((bf16_t)(cq.y >> 16));
        const size_t row = rh >> 2; const int h = (int)(rh & 3);
        u32x2 w; w.x = pk2(o[0] * inv, o[1] * inv); w.y = pk2(o[2] * inv, o[3] * inv);
        *(u32x2*)(WSP(bf16_t, WS_O) + row * D + h * 64 + dq) = w;
    }
}
__device__ __forceinline__ void ph_vtrans(const P& p, unsigned char* smem) {
    bf16_t* vt = (bf16_t*)smem;
    const int tid = tidx(); const bf16_t* PR = WSP(bf16_t, WS_PROJ);
    for (int u = blockIdx.x; u < PB * 4 * (T / 256); u += gridDim.x) {
        const int tile = u % (T / 256), bh = u / (T / 256), h = bh & 3, b = bh >> 2;
        __syncthreads();
#pragma unroll
        for (int k = 0; k < 4; ++k) { const int ch = tid + NTHR * k, t = ch >> 3, d8 = (ch & 7) * 8;
            *(u32x4*)(vt + t * 72 + d8) = *(const u32x4*)(PR + (size_t)(b * T + tile * 256 + t) * NPROJ + C_VA + h * 64 + d8); }
        __syncthreads();
#pragma unroll
        for (int k = 0; k < 4; ++k) { const int ch = tid + NTHR * k;
            { const int d = ch >> 5, t0 = (ch & 31) * 8; u32x4 w;
              w.x = (unsigned)vt[(t0 + 0) * 72 + d] | ((unsigned)vt[(t0 + 1) * 72 + d] << 16); w.y = (unsigned)vt[(t0 + 2) * 72 + d] | ((unsigned)vt[(t0 + 3) * 72 + d] << 16);
              w.z = (unsigned)vt[(t0 + 4) * 72 + d] | ((unsigned)vt[(t0 + 5) * 72 + d] << 16); w.w = (unsigned)vt[(t0 + 6) * 72 + d] | ((unsigned)vt[(t0 + 7) * 72 + d] << 16);
              *(u32x4*)(WSP(bf16_t, WS_VT1) + ((size_t)bh * 64 + d) * T + tile * 256 + t0) = w; }
            { const int r = ch >> 9, d = (ch >> 3) & 63, s0 = (ch & 7) * 8; u32x4 w;
#define VT4E(e_) ((unsigned)vt[(4 * (s0 + (e_)) + r) * 72 + d])
              w.x = VT4E(0) | (VT4E(1) << 16); w.y = VT4E(2) | (VT4E(3) << 16); w.z = VT4E(4) | (VT4E(5) << 16); w.w = VT4E(6) | (VT4E(7) << 16);
#undef VT4E
              *(u32x4*)(WSP(bf16_t, WS_VT4) + ((size_t)(bh * 4 + r) * 64 + d) * (T / 4) + tile * 64 + s0) = w; }
            { const int r = ch >> 7, d = (ch >> 1) & 63, s0 = (ch & 1) * 8; u32x4 w;
#define VT16E(e_) ((unsigned)vt[(16 * (s0 + (e_)) + r) * 72 + d])
              w.x = VT16E(0) | (VT16E(1) << 16); w.y = VT16E(2) | (VT16E(3) << 16); w.z = VT16E(4) | (VT16E(5) << 16); w.w = VT16E(6) | (VT16E(7) << 16);
#undef VT16E
              *(u32x4*)(WSP(bf16_t, WS_VT16) + ((size_t)(bh * 16 + r) * 64 + d) * (T / 16) + tile * 16 + s0) = w; }
        }
    }
}

__device__ __forceinline__ float ret_lg(int h) { return logf(1.0f - exp2f(-5.0f - (float)h)); }
__device__ __forceinline__ void ph_ret_local(const P& p, int l, unsigned char* smem) {
    float* ks = (float*)smem; float* vs = ks + 64 * 64; const int tid = tidx(); const bf16_t* PR = WSP(bf16_t, WS_PROJ);
    for (int u = blockIdx.x; u < NUNIT; u += gridDim.x) {
        const int n = u % NCH, h = (u / NCH) % 4, b = u / (NCH * 4); const float lg = ret_lg(h);
        __syncthreads();
        for (int e = tid; e < 4096; e += NTHR) { const int j = e >> 6, d = e & 63; const size_t row = (size_t)(b * T + n * 64 + j) * NPROJ;
            ks[e] = bf2f(PR[row + C_KR + h * 64 + d]) * expf(lg * (float)(63 - j)); vs[e] = bf2f(PR[row + C_VR + h * 64 + d]); }
        __syncthreads();
        const int d = tid >> 3, e0 = (tid & 7) * 8; float acc[8];
#pragma unroll
        for (int i = 0; i < 8; ++i) acc[i] = 0.f;
        for (int j = 0; j < 64; ++j) { const float kd = ks[j * 64 + d];
#pragma unroll
            for (int i = 0; i < 8; ++i) acc[i] += kd * vs[j * 64 + e0 + i]; }
        float* U = WSP(float, WS_RU) + (size_t)u * 4096 + d * 64 + e0;
#pragma unroll
        for (int i = 0; i < 8; ++i) U[i] = acc[i];
    }
}
__device__ __forceinline__ void ph_ret_scan(const P& p, int l) {
    const int gt = blockIdx.x * NTHR + tidx(), ng = gridDim.x * NTHR;
    for (int e = gt; e < PB * 4 * 4096; e += ng) {
        const int bh = e >> 12, de = e & 4095, h = bh & 3; const float cd = expf(ret_lg(h) * 64.0f);
        const float* U = WSP(float, WS_RU) + (size_t)bh * NCH * 4096 + de; float* SPv = WSP(float, WS_RS) + (size_t)bh * NCH * 4096 + de;
        float s = 0.f;
        for (int n = 0; n < NCH; ++n) { SPv[(size_t)n * 4096] = s; s = s * cd + U[(size_t)n * 4096]; }
        p.out[O_PRET + ((size_t)l * PB * 4 + bh) * 4096 + de] = s;
    }
}
__device__ __forceinline__ void ph_ret_out(const P& p, int l, unsigned char* smem) {
    float* qs = (float*)smem; float* ks = qs + 64 * 65; float* vs = ks + 64 * 65; float* ss = vs + 64 * 65; float* as = ss + 64 * 65;
    const int tid = tidx(); const bf16_t* PR = WSP(bf16_t, WS_PROJ);
    for (int u = blockIdx.x; u < NUNIT; u += gridDim.x) {
        const int n = u % NCH, h = (u / NCH) % 4, b = u / (NCH * 4); const float lg = ret_lg(h);
        __syncthreads();
        for (int e = tid; e < 4096; e += NTHR) { const int j = e >> 6, d = e & 63; const size_t row = (size_t)(b * T + n * 64 + j) * NPROJ;
            qs[j * 65 + d] = bf2f(PR[row + C_QR + h * 64 + d]); ks[j * 65 + d] = bf2f(PR[row + C_KR + h * 64 + d]); vs[j * 65 + d] = bf2f(PR[row + C_VR + h * 64 + d]);
            ss[j * 65 + d] = WSP(float, WS_RS)[(size_t)u * 4096 + e]; }
        __syncthreads();
        const int i = tid >> 3, c0 = (tid & 7) * 8;
#pragma unroll
        for (int jj = 0; jj < 8; ++jj) { const int j = c0 + jj; float a = 0.f;
            if (j <= i) { for (int d = 0; d < 64; ++d) a += qs[i * 65 + d] * ks[j * 65 + d]; a *= expf(lg * (float)(i - j)); }
            as[i * 65 + j] = a; }
        __syncthreads();
        float o[8]; float o2[8];
#pragma unroll
        for (int e = 0; e < 8; ++e) { o[e] = 0.f; o2[e] = 0.f; }
        for (int j = 0; j < 64; ++j) { const float a = as[i * 65 + j], qd = qs[i * 65 + j];
#pragma unroll
            for (int e = 0; e < 8; ++e) { o[e] += a * vs[j * 65 + c0 + e]; o2[e] += qd * ss[j * 65 + c0 + e]; } }
        const float qdec = expf(lg * (float)(i + 1)); float sq = 0.f;
#pragma unroll
        for (int e = 0; e < 8; ++e) { o[e] += o2[e] * qdec; sq += o[e] * o[e]; }
        sq += __shfl_xor(sq, 1); sq += __shfl_xor(sq, 2); sq += __shfl_xor(sq, 4);
        const float rstd = 1.0f / sqrtf(sq * (1.0f / 64.0f) + EPS);
        const size_t row = (size_t)(b * T + n * 64 + i);
#pragma unroll
        for (int e = 0; e < 8; ++e) { const float g = bf2f(PR[row * NPROJ + C_GR + h * 64 + c0 + e]);
            WSP(bf16_t, WS_O)[row * D + 256 + h * 64 + c0 + e] = f2bf(o[e] * rstd * p.ret_norm[l * 64 + c0 + e] * silu_f(g)); }
    }
}
__device__ __forceinline__ void ph_ret_sample(const P& p, int l, unsigned char* smem) {
    float* S0 = (float*)smem; float* qs = S0 + 4096; float* ks = qs + 8 * 64; float* vs = ks + 8 * 64;
    const int tid = tidx(); const bf16_t* PR = WSP(bf16_t, WS_PROJ);
    for (int u = blockIdx.x; u < DB * 4; u += gridDim.x) {
        const int h = u & 3, b = u >> 2; const float lg = ret_lg(h);
        __syncthreads();
        for (int e = tid; e < 4096; e += NTHR) S0[e] = p.state_ret[(((size_t)l * DB + b) * 4 + h) * 4096 + e];
        { const int j = tid >> 6, d = tid & 63; const size_t row = (size_t)(MP + b * DS + j) * NPROJ;
          qs[tid] = bf2f(PR[row + C_QR + h * 64 + d]); ks[tid] = bf2f(PR[row + C_KR + h * 64 + d]); vs[tid] = bf2f(PR[row + C_VR + h * 64 + d]); }
        __syncthreads();
        { const int i = tid >> 6, e = tid & 63; float o = 0.f;
          for (int j = 0; j <= i; ++j) { float a = 0.f; for (int d = 0; d < 64; ++d) a += qs[i * 64 + d] * ks[j * 64 + d]; o += a * expf(lg * (float)(i - j)) * vs[j * 64 + e]; }
          float o2 = 0.f; for (int d = 0; d < 64; ++d) o2 += qs[i * 64 + d] * S0[d * 64 + e];
          o += o2 * expf(lg * (float)(i + 1));
          const float rstd = 1.0f / sqrtf(wave_sum(o * o) * (1.0f / 64.0f) + EPS);
          const size_t row = (size_t)(MP + b * DS + i); const float g = bf2f(PR[row * NPROJ + C_GR + h * 64 + e]);
          WSP(bf16_t, WS_O)[row * D + 256 + h * 64 + e] = f2bf(o * rstd * p.ret_norm[l * 64 + e] * silu_f(g)); }
        for (int x = tid; x < 4096; x += NTHR) { const int d = x >> 6, e = x & 63; float s = S0[x] * expf(lg * (float)DS);
            for (int j = 0; j < DS; ++j) s += ks[j * 64 + d] * expf(lg * (float)(DS - 1 - j)) * vs[j * 64 + e];
            p.out[O_SRET + (((size_t)l * DB + b) * 4 + h) * 4096 + x] = s; }
    }
}

template <int CS, int LDL> __device__ __forceinline__ void fwd_subst(float (&X)[CS], const float* Ls) {
#pragma unroll
    for (int i = 1; i < CS; ++i) {
        float a = X[i];
#pragma unroll
        for (int j4 = 0; j4 < (i + 3) / 4; ++j4) { const f32x4 lv = *(const f32x4*)(Ls + i * LDL + 4 * j4);
#pragma unroll
            for (int e = 0; e < 4; ++e) if (4 * j4 + e < i) a -= lv[e] * X[4 * j4 + e]; }
        X[i] = a;
    }
}
constexpr int QP = 132;
__device__ __forceinline__ void ph_gdn_prep(const P& p, int l, unsigned char* smem) {
    float* Ls = (float*)smem; float* As = Ls + 64 * 68; float* gs = As + 64 * 68; float* gcs = gs + 64; float* bts = gcs + 64;
    float* qs = bts + 64; float* ks = qs + 64 * QP; float* vs = ks + 64 * QP;
    const int tid = tidx(); const bf16_t* PR = WSP(bf16_t, WS_PROJ);
    for (int u = blockIdx.x; u < NUNIT; u += gridDim.x) {
        const int n = u % NCH, h = (u / NCH) % 4, b = u / (NCH * 4);
        __syncthreads();
        if (tid < 384) { const int sec = tid >> 7, c = tid & 127, col = sec * 512 + h * 128 + c; float* dst = sec == 0 ? qs : sec == 1 ? ks : vs;
            const float w0 = p.conv_w[(l * 4 + 0) * 1536 + col], w1 = p.conv_w[(l * 4 + 1) * 1536 + col], w2 = p.conv_w[(l * 4 + 2) * 1536 + col], w3 = p.conv_w[(l * 4 + 3) * 1536 + col];
            const int t0 = n * 64; const bf16_t* src = PR + (size_t)(b * T) * NPROJ + C_CONV + col;
            float x0 = t0 >= 3 ? bf2f(src[(size_t)(t0 - 3) * NPROJ]) : 0.f, x1 = t0 >= 2 ? bf2f(src[(size_t)(t0 - 2) * NPROJ]) : 0.f, x2 = t0 >= 1 ? bf2f(src[(size_t)(t0 - 1) * NPROJ]) : 0.f;
            const bf16_t* sp = src + (size_t)t0 * NPROJ; float* dp = dst + c;
#pragma unroll 4
            for (int i = 0; i < 64; ++i) { const float x3 = bf2f(*sp); const float y = w0 * x0 + w1 * x1 + w2 * x2 + w3 * x3; *dp = silu_f(y); x0 = x1; x1 = x2; x2 = x3; sp += NPROJ; dp += QP; } }
        else if (tid < 448) { const int i = tid - 384; const size_t row = (size_t)(b * T + n * 64 + i); gs[i] = WSP(float, WS_G)[row * 4 + h]; bts[i] = WSP(float, WS_BETA)[row * 4 + h]; }
        __syncthreads();
        { const int rid = tid >> 2, part = tid & 3; float* rowp = (rid < 64 ? qs + rid * QP : ks + (rid - 64) * QP) + part * 32; float s = 0.f;
          for (int d = 0; d < 32; ++d) s += rowp[d] * rowp[d];
          s += __shfl_xor(s, 1); s += __shfl_xor(s, 2); const float sc = 1.0f / sqrtf(s + EPS);
          for (int d = 0; d < 32; ++d) rowp[d] *= sc; }
        if (tid == 0) { float a = 0.f; for (int i = 0; i < 64; ++i) { a += gs[i]; gcs[i] = a; } }
        __syncthreads();
        { const int i = tid >> 3, j0 = (tid & 7) * 8;
#pragma unroll
          for (int jj = 0; jj < 8; ++jj) { const int j = j0 + jj; float lv = 0.f, av = 0.f;
              if (j <= i) { float dk = 0.f, dq = 0.f; for (int d = 0; d < 128; ++d) { const float kj = ks[j * QP + d]; dk += ks[i * QP + d] * kj; dq += qs[i * QP + d] * kj; }
                  const float e = expf(gcs[i] - gcs[j]); av = dq * e * 0.08838834764831845f; lv = j < i ? bts[i] * dk * e : 0.f; }
              Ls[i * 68 + j] = lv; As[i * 68 + j] = av; } }
        __syncthreads();
        if (tid < 256) { const int c = tid; float X[64];
            if (c < 128) {
#pragma unroll
                for (int i = 0; i < 64; ++i) X[i] = vs[i * QP + c] * bts[i]; }
            else {
#pragma unroll
                for (int i = 0; i < 64; ++i) X[i] = ks[i * QP + c - 128] * bts[i] * expf(gcs[i]); }
            fwd_subst<64, 68>(X, Ls);
            if (c < 128) { float* U = WSP(float, WS_GU) + (size_t)u * 8192 + c;
#pragma unroll
                for (int i = 0; i < 64; ++i) U[i * 128] = X[i]; }
            else { bf16_t* W = WSP(bf16_t, WS_GW) + (size_t)u * 8192 + c - 128;
#pragma unroll
                for (int i = 0; i < 64; ++i) W[i * 128] = f2bf(X[i]); }
        } else { const int t2 = tid - 256; const float gl = gcs[63];
#pragma unroll 2
            for (int e = t2; e < 8192; e += 256) { const int i = e >> 7, d = e & 127;
                WSP(bf16_t, WS_GQ)[(size_t)u * 8192 + e] = f2bf(qs[i * QP + d] * 0.08838834764831845f * expf(gcs[i]));
                WSP(bf16_t, WS_GK)[(size_t)u * 8192 + e] = f2bf(ks[i * QP + d] * expf(gl - gcs[i])); }
#pragma unroll 2
            for (int e = t2; e < 4096; e += 256) WSP(bf16_t, WS_GA)[(size_t)u * 4096 + e] = f2bf(As[(e >> 6) * 68 + (e & 63)]);
            if (t2 == 0) WSP(float, WS_GD)[u] = expf(gl); }
    }
}
__device__ __forceinline__ void ph_gdn_chain(const P& p, int l, unsigned char* smem) {
    float* Ss = (float*)smem; float* Ws = Ss + 128 * 32; float* Ks = Ws + 64 * 128; float* vn = Ks + 64 * 128;
    const int tid = tidx();
    for (int it = blockIdx.x; it < PB * 4 * 4; it += gridDim.x) {
        const int sl = it & 3, bh = it >> 2;
        __syncthreads();
        for (int e = tid; e < 4096; e += NTHR) Ss[e] = 0.f;
        for (int n = 0; n < NCH; ++n) {
            const int u = bh * NCH + n;
            __syncthreads();
            { const bf16_t* W = WSP(bf16_t, WS_GW) + (size_t)u * 8192; const bf16_t* K = WSP(bf16_t, WS_GK) + (size_t)u * 8192;
              for (int e = tid; e < 1024; e += NTHR) { const bf16x8 wv = *(const bf16x8*)(W + 8 * e), kv = *(const bf16x8*)(K + 8 * e);
#pragma unroll
                  for (int x = 0; x < 8; ++x) { Ws[8 * e + x] = bf2f((bf16_t)wv[x]); Ks[8 * e + x] = bf2f((bf16_t)kv[x]); } }
              float* SPo = WSP(float, WS_GS) + (size_t)u * 16384 + sl * 32;
              for (int e = tid; e < 4096; e += NTHR) SPo[(e >> 5) * 128 + (e & 31)] = Ss[e]; }
            __syncthreads();
            { const int i = tid >> 3, c0 = (tid & 7) * 4; f32x4 a = *(const f32x4*)(WSP(float, WS_GU) + (size_t)u * 8192 + i * 128 + sl * 32 + c0);
              for (int d = 0; d < 128; ++d) { const float w = Ws[i * 128 + d]; a -= w * *(const f32x4*)(Ss + d * 32 + c0); }
              *(f32x4*)(vn + i * 32 + c0) = a; *(f32x4*)(WSP(float, WS_GV) + (size_t)u * 8192 + i * 128 + sl * 32 + c0) = a; }
            __syncthreads();
            { const int d = tid >> 2, c0 = (tid & 3) * 8; const float dec = WSP(float, WS_GD)[u];
              f32x4 a0 = *(const f32x4*)(Ss + d * 32 + c0) * dec, a1 = *(const f32x4*)(Ss + d * 32 + c0 + 4) * dec;
              for (int i = 0; i < 64; ++i) { const float kd = Ks[i * 128 + d]; a0 += kd * *(const f32x4*)(vn + i * 32 + c0); a1 += kd * *(const f32x4*)(vn + i * 32 + c0 + 4); }
              *(f32x4*)(Ss + d * 32 + c0) = a0; *(f32x4*)(Ss + d * 32 + c0 + 4) = a1; }
        }
        __syncthreads();
        { float* o = p.out + O_PGDN + ((size_t)l * PB * 4 + bh) * 16384 + sl * 32;
          for (int e = tid; e < 4096; e += NTHR) o[(e >> 5) * 128 + (e & 31)] = Ss[e]; }
    }
}
__device__ __forceinline__ void ph_gdn_out(const P& p, int l, unsigned char* smem) {
    float* SPs = (float*)smem; float* VNs = SPs + 128 * 128; bf16_t* QGs = (bf16_t*)(VNs + 64 * 128); bf16_t* ATs = QGs + 64 * 128;
    const int tid = tidx(); const bf16_t* PR = WSP(bf16_t, WS_PROJ);
    for (int u = blockIdx.x; u < NUNIT; u += gridDim.x) {
        const int n = u % NCH, h = (u / NCH) % 4, b = u / (NCH * 4);
        __syncthreads();
        { const f32x4* s = (const f32x4*)(WSP(float, WS_GS) + (size_t)u * 16384); for (int e = tid; e < 4096; e += NTHR) ((f32x4*)SPs)[e] = s[e];
          const f32x4* v = (const f32x4*)(WSP(float, WS_GV) + (size_t)u * 8192); for (int e = tid; e < 2048; e += NTHR) ((f32x4*)VNs)[e] = v[e];
          const u32x4* q = (const u32x4*)(WSP(bf16_t, WS_GQ) + (size_t)u * 8192); for (int e = tid; e < 1024; e += NTHR) ((u32x4*)QGs)[e] = q[e];
          const u32x4* a = (const u32x4*)(WSP(bf16_t, WS_GA) + (size_t)u * 4096); for (int e = tid; e < 512; e += NTHR) ((u32x4*)ATs)[e] = a[e]; }
        __syncthreads();
        const int i = tid >> 3, cg = tid & 7; f32x4 o[4];
#pragma unroll
        for (int k = 0; k < 4; ++k) o[k] = (f32x4){0.f, 0.f, 0.f, 0.f};
        for (int d = 0; d < 128; ++d) { const float qg = bf2f(QGs[i * 128 + d]);
#pragma unroll
            for (int k = 0; k < 4; ++k) o[k] += qg * *(const f32x4*)(SPs + d * 128 + 32 * k + 4 * cg); }
        for (int j = 0; j < 64; ++j) { const float a = bf2f(ATs[i * 64 + j]);
#pragma unroll
            for (int k = 0; k < 4; ++k) o[k] += a * *(const f32x4*)(VNs + j * 128 + 32 * k + 4 * cg); }
        float sq = 0.f;
#pragma unroll
        for (int k = 0; k < 4; ++k) sq += (o[k][0] * o[k][0] + o[k][1] * o[k][1]) + (o[k][2] * o[k][2] + o[k][3] * o[k][3]);
        sq += __shfl_xor(sq, 1); sq += __shfl_xor(sq, 2); sq += __shfl_xor(sq, 4);
        const float rstd = 1.0f / sqrtf(sq * (1.0f / 128.0f) + EPS);
        const size_t row = (size_t)(b * T + n * 64 + i);
#pragma unroll
        for (int k = 0; k < 4; ++k)
#pragma unroll
            for (int e = 0; e < 4; ++e) { const int c = 32 * k + 4 * cg + e; const float z = bf2f(PR[row * NPROJ + C_Z + h * 128 + c]);
                WSP(bf16_t, WS_O)[row * D + 512 + h * 128 + c] = f2bf(o[k][e] * rstd * p.gdn_norm[l * 128 + c] * silu_f(z)); }
    }
}
__device__ __forceinline__ void ph_gdn_sample(const P& p, int l, unsigned char* smem) {
    float* qs = (float*)smem; float* ks = qs + 8 * QP; float* vs = ks + 8 * QP; float* us = vs + 8 * QP; float* wsm = us + 8 * 128; float* vn = wsm + 8 * 128;
    float* Ls = vn + 8 * 128; float* As = Ls + 8 * 8; float* gs = As + 8 * 8; float* gcs = gs + 8; float* bts = gcs + 8; float* S0 = bts + 8;
    const int tid = tidx(); const bf16_t* PR = WSP(bf16_t, WS_PROJ);
    for (int u = blockIdx.x; u < DB * 4; u += gridDim.x) {
        const int h = u & 3, b = u >> 2;
        __syncthreads();
#pragma unroll 4
        for (int e = tid; e < 16384; e += NTHR) S0[e] = p.state_gdn[(((size_t)l * DB + b) * 4 + h) * 16384 + e];
        if (tid < 384) { const int sec = tid >> 7, c = tid & 127, col = sec * 512 + h * 128 + c; float* dst = sec == 0 ? qs : sec == 1 ? ks : vs;
            const float w0 = p.conv_w[(l * 4 + 0) * 1536 + col], w1 = p.conv_w[(l * 4 + 1) * 1536 + col], w2 = p.conv_w[(l * 4 + 2) * 1536 + col], w3 = p.conv_w[(l * 4 + 3) * 1536 + col];
            const float* hist = p.state_conv + (((size_t)l * DB + b) * 3) * 1536 + col; const bf16_t* src = PR + (size_t)(MP + b * DS) * NPROJ + C_CONV + col;
            float x0 = hist[0], x1 = hist[1536], x2 = hist[2 * 1536];
            for (int i = 0; i < DS; ++i) { const float x3 = bf2f(src[(size_t)i * NPROJ]); const float y = w0 * x0 + w1 * x1 + w2 * x2 + w3 * x3; dst[i * QP + c] = silu_f(y); x0 = x1; x1 = x2; x2 = x3; } }
        else if (tid < 384 + DS) { const int i = tid - 384; const size_t row = (size_t)(MP + b * DS + i); gs[i] = WSP(float, WS_G)[row * 4 + h]; bts[i] = WSP(float, WS_BETA)[row * 4 + h]; }
        __syncthreads();
        if (tid < 64) { const int rid = tid >> 2, part = tid & 3; float* rowp = (rid < 8 ? qs + rid * QP : ks + (rid - 8) * QP) + part * 32; float s = 0.f;
            for (int d = 0; d < 32; ++d) s += rowp[d] * rowp[d];
            s += __shfl_xor(s, 1); s += __shfl_xor(s, 2); const float sc = 1.0f / sqrtf(s + EPS);
            for (int d = 0; d < 32; ++d) rowp[d] *= sc; }
        if (tid == 64) { float a = 0.f; for (int i = 0; i < DS; ++i) { a += gs[i]; gcs[i] = a; } }
        __syncthreads();
        if (tid < 64) { const int i = tid >> 3, j = tid & 7; float lv = 0.f, av = 0.f;
            if (j <= i) { float dk = 0.f, dq = 0.f; for (int d = 0; d < 128; ++d) { const float kj = ks[j * QP + d]; dk += ks[i * QP + d] * kj; dq += qs[i * QP + d] * kj; }
                const float e = expf(gcs[i] - gcs[j]); av = dq * e * 0.08838834764831845f; lv = j < i ? bts[i] * dk * e : 0.f; }
            Ls[i * 8 + j] = lv; As[i * 8 + j] = av; }
        __syncthreads();
        if (tid < 256) { const int c = tid; float X[8];
            if (c < 128) {
#pragma unroll
                for (int i = 0; i < 8; ++i) X[i] = vs[i * QP + c] * bts[i]; }
            else {
#pragma unroll
                for (int i = 0; i < 8; ++i) X[i] = ks[i * QP + c - 128] * bts[i] * expf(gcs[i]); }
            fwd_subst<8, 8>(X, Ls);
            float* dst = c < 128 ? us + c : wsm + c - 128;
#pragma unroll
            for (int i = 0; i < 8; ++i) dst[i * 128] = X[i]; }
        __syncthreads();
        const int i = tid >> 6, c2 = (tid & 63) * 2;
        { float a0 = us[i * 128 + c2], a1 = us[i * 128 + c2 + 1];
          for (int d = 0; d < 128; ++d) { const float w = wsm[i * 128 + d]; a0 -= w * S0[d * 128 + c2]; a1 -= w * S0[d * 128 + c2 + 1]; }
          vn[i * 128 + c2] = a0; vn[i * 128 + c2 + 1] = a1; }
        __syncthreads();
        { float o0 = 0.f, o1 = 0.f; const float qsc = 0.08838834764831845f * expf(gcs[i]);
          for (int d = 0; d < 128; ++d) { const float qg = qs[i * QP + d] * qsc; o0 += qg * S0[d * 128 + c2]; o1 += qg * S0[d * 128 + c2 + 1]; }
          for (int j = 0; j < DS; ++j) { const float a = As[i * 8 + j]; o0 += a * vn[j * 128 + c2]; o1 += a * vn[j * 128 + c2 + 1]; }
          const float rstd = 1.0f / sqrtf(wave_sum(o0 * o0 + o1 * o1) * (1.0f / 128.0f) + EPS);
          const size_t row = (size_t)(MP + b * DS + i);
          const float z0 = bf2f(PR[row * NPROJ + C_Z + h * 128 + c2]), z1 = bf2f(PR[row * NPROJ + C_Z + h * 128 + c2 + 1]);
          bf16_t* O = WSP(bf16_t, WS_O) + row * D + 512 + h * 128 + c2;
          O[0] = f2bf(o0 * rstd * p.gdn_norm[l * 128 + c2] * silu_f(z0)); O[1] = f2bf(o1 * rstd * p.gdn_norm[l * 128 + c2 + 1] * silu_f(z1)); }
        { const float gl = gcs[DS - 1], dec = expf(gl); float* o = p.out + O_SGDN + (((size_t)l * DB + b) * 4 + h) * 16384;
#pragma unroll 2
          for (int e = tid; e < 16384; e += NTHR) { const int d = e >> 7, c = e & 127; float s = S0[e] * dec;
              for (int j = 0; j < DS; ++j) s += ks[j * QP + d] * expf(gl - gcs[j]) * vn[j * 128 + c];
              o[e] = s; } }
    }
}

__device__ __forceinline__ void ph_final_norm(const P& p) {
    const int lane = tidx() & 63, wave = tidx() >> 6, gw = blockIdx.x * 8 + wave, ngw = gridDim.x * 8;
    for (int r = gw; r < M; r += ngw) {
        float* xr = p.out + (size_t)r * D; f32x4 v[4]; float ss = 0.f;
#pragma unroll
        for (int j = 0; j < 4; ++j) { v[j] = *(const f32x4*)(xr + 4 * lane + 256 * j); ss += (v[j][0] * v[j][0] + v[j][1] * v[j][1]) + (v[j][2] * v[j][2] + v[j][3] * v[j][3]); }
        const float rstd = 1.0f / sqrtf(wave_sum(ss) * (1.0f / D) + EPS);
#pragma unroll
        for (int j = 0; j < 4; ++j) { const f32x4 g = *(const f32x4*)(p.final_norm + 4 * lane + 256 * j); *(f32x4*)(xr + 4 * lane + 256 * j) = v[j] * rstd * g; }
    }
}

enum Phase { PH_PRO = 0, PH_NORM1, PH_GEMM_IN, PH_ROPE, PH_MIX1, PH_MIX2, PH_MIX3, PH_GEMM_OUT, PH_NORM2, PH_GEMM_GU, PH_GEMM_DN, PH_FINAL };
#ifdef __HIP_EMU__
#define LDSP(x) (x)
#else
#define LDSP(x) ((PG8_LAS unsigned char*)(x))
#endif
template <int PH> __device__ __forceinline__ void run_phase(const P& p, int l, unsigned char* smem) {
    if constexpr (PH == PH_PRO) { ph_convert(p, smem); __syncthreads(); ph_adaln(p, smem); ph_ropetab_copyx(p); }
    else if constexpr (PH == PH_NORM1) ph_norm_mod<0>(p, l);
    else if constexpr (PH == PH_GEMM_IN) {
        pg8::Gemm g{WSP(bf16_t, WS_H), WSP(bf16_t, WS_WIN) + (size_t)l * NPROJ * D, MPAD, NPROJ, D}; pg8::StaticOrder S; S.init(MPAD, NPROJ, (int)gridDim.x, (int)blockIdx.x);
        pg8::EpiStoreBf16 E{WSP(bf16_t, WS_PROJ), NPROJ};
        pg8::gemm_phase<pg8::EpiStoreBf16, pg8::StaticOrder, true, true>(LDSP(smem), g, S, E);
    }
    else if constexpr (PH == PH_ROPE) { ph_rope_out(p, l); ph_vtrans(p, smem); }
    else if constexpr (PH == PH_MIX1) { ph_attn_jobs(p); __syncthreads(); ph_attn_sample(p, l, smem); ph_ret_local(p, l, smem); ph_gdn_prep(p, l, smem); ph_ret_sample(p, l, smem); ph_gdn_sample(p, l, smem); }
    else if constexpr (PH == PH_MIX2) { ph_gdn_chain(p, l, smem); ph_ret_scan(p, l); ph_attn_combine(p); }
    else if constexpr (PH == PH_MIX3) { ph_ret_out(p, l, smem); ph_gdn_out(p, l, smem); }
    else if constexpr (PH == PH_GEMM_OUT) {
        pg8::Gemm g{WSP(bf16_t, WS_O), WSP(bf16_t, WS_WOUT) + (size_t)l * D * D, MPAD, D, D}; pg8::StaticOrder S; S.init(MPAD, D, (int)gridDim.x, (int)blockIdx.x);
        pg8::EpiResidual E{p.out, WSP(float, WS_MOD) + (size_t)l * NC * 6144 + 2048};
        pg8::gemm_phase<pg8::EpiResidual, pg8::StaticOrder, true, true>(LDSP(smem), g, S, E);
    }
    else if constexpr (PH == PH_NORM2) ph_norm_mod<1>(p, l);
    else if constexpr (PH == PH_GEMM_GU) {
        pg8::Gemm g{WSP(bf16_t, WS_H), WSP(bf16_t, WS_WGU) + (size_t)l * 2 * FF * D, MPAD, 2 * FF, D}; pg8::StaticOrder S; S.init(MPAD, 2 * FF, (int)gridDim.x, (int)blockIdx.x);
        pg8::EpiSwiglu E{WSP(bf16_t, WS_HID)};
        pg8::gemm_phase<pg8::EpiSwiglu, pg8::StaticOrder, true, true>(LDSP(smem), g, S, E);
    }
    else if constexpr (PH == PH_GEMM_DN) {
        pg8::Gemm g{WSP(bf16_t, WS_HID), WSP(bf16_t, WS_WDN) + (size_t)l * D * FF, MPAD, D, FF}; pg8::StaticOrder S; S.init(MPAD, D, (int)gridDim.x, (int)blockIdx.x);
        pg8::EpiResidual E{p.out, WSP(float, WS_MOD) + (size_t)l * NC * 6144 + 5120};
        pg8::gemm_phase<pg8::EpiResidual, pg8::StaticOrder, true, true>(LDSP(smem), g, S, E);
    }
    else if constexpr (PH == PH_FINAL) ph_final_norm(p);
}
template <int PH> __global__ void __launch_bounds__(NTHR, 2) k_phase(P p, int l) { DYN_SMEM(smem); run_phase<PH>(p, l, smem); }


#ifndef __HIP_EMU__
#define GRID_SYNC() grid.sync()
__global__ void __launch_bounds__(NTHR, 2) k_mega(P p_arg) {
    DYN_SMEM(smem);
#if defined(__HIP_DEVICE_COMPILE__)
#define PHASE(PH_, l_) do { const __attribute__((address_space(4))) P* kp_ = (const __attribute__((address_space(4))) P*)__builtin_amdgcn_kernarg_segment_ptr(); LAUNDER_PTR(kp_); P pl_; __builtin_memcpy(&pl_, kp_, sizeof(P)); run_phase<PH_>(pl_, l_, smem); } while (0)
#else
#define PHASE(PH_, l_) run_phase<PH_>(p_arg, l_, smem)
#endif
    cooperative_groups::grid_group grid = cooperative_groups::this_grid();
    PHASE(PH_PRO, 0); GRID_SYNC();
#define LAYER(l) do { PHASE(PH_NORM1, l); GRID_SYNC(); PHASE(PH_GEMM_IN, l); GRID_SYNC(); PHASE(PH_ROPE, l); GRID_SYNC(); PHASE(PH_MIX1, l); GRID_SYNC(); PHASE(PH_MIX2, l); GRID_SYNC(); \
        PHASE(PH_MIX3, l); GRID_SYNC(); PHASE(PH_GEMM_OUT, l); GRID_SYNC(); PHASE(PH_NORM2, l); GRID_SYNC(); PHASE(PH_GEMM_GU, l); GRID_SYNC(); PHASE(PH_GEMM_DN, l); GRID_SYNC(); } while (0)
    static_assert(NL == 2, "two layers written out (a loop over the layers makes hipcc hoist every phase's constants to the loop preheader and spill)");
    LAYER(0); LAYER(1);
    PHASE(PH_FINAL, 0);
}
#endif

template <int PH> static void launch_phase(const P& p, int l, int grid, hipStream_t stream) {
#ifndef __HIP_EMU__
    static bool attr_done = false;
    if (!attr_done) { (void)hipFuncSetAttribute((const void*)k_phase<PH>, hipFuncAttributeMaxDynamicSharedMemorySize, SMEM_BYTES); attr_done = true; }
#endif
    LAUNCH(k_phase<PH>, grid, SMEM_BYTES, stream, p, l);
}

extern "C" void kernel_launch(void* const* d_in, const int* in_sizes, int n_in, void* d_out, int out_size, void* d_ws, size_t ws_size, hipStream_t stream) {
    if (n_in != 24 || (size_t)out_size != O_END || ws_size < WS_END) {
        fprintf(stderr, "kernel_launch: shape mismatch: n_in %d out_size %d (want %zu) ws %zu (want %zu)\n", n_in, out_size, (size_t)O_END, ws_size, (size_t)WS_END); return; }
    P p{};
    const float** pp = (const float**)&p;
    for (int i = 0; i < 24; ++i) pp[i] = (const float*)d_in[i];
    p.out = (float*)d_out; p.ws = (unsigned char*)d_ws;
#ifndef __HIP_EMU__
    static int grid = 0;
    if (grid == 0) {
        int dev = 0, cus = 0, per_cu = 0;
        if (hipGetDevice(&dev) != hipSuccess || hipDeviceGetAttribute(&cus, hipDeviceAttributeMultiprocessorCount, dev) != hipSuccess || cus <= 0) { fprintf(stderr, "kernel_launch: device query failed\n"); grid = -1; return; }
        if (hipFuncSetAttribute((const void*)k_mega, hipFuncAttributeMaxDynamicSharedMemorySize, SMEM_BYTES) != hipSuccess) { fprintf(stderr, "kernel_launch: hipFuncSetAttribute failed\n"); grid = -1; return; }
        if (hipOccupancyMaxActiveBlocksPerMultiprocessor(&per_cu, (const void*)k_mega, NTHR, SMEM_BYTES) != hipSuccess || per_cu < 1) { fprintf(stderr, "kernel_launch: occupancy query says %d blocks per CU\n", per_cu); grid = -1; return; }
        grid = cus;
    }
    if (grid < 0) return;
    { void* args[] = {(void*)&p};
      hipError_t e = hipLaunchCooperativeKernel((const void*)k_mega, dim3(grid), dim3(NTHR), args, SMEM_BYTES, stream);
      if (e != hipSuccess) fprintf(stderr, "kernel_launch: cooperative launch failed: %s (grid %d)\n", hipGetErrorString(e), grid);
      return; }
#else
    int grid = 16;
#endif
    launch_phase<PH_PRO>(p, 0, grid, stream);
    for (int l = 0; l < NL; ++l) {
        launch_phase<PH_NORM1>(p, l, grid, stream);
        launch_phase<PH_GEMM_IN>(p, l, grid, stream);
        launch_phase<PH_ROPE>(p, l, grid, stream);
        launch_phase<PH_MIX1>(p, l, grid, stream);
        launch_phase<PH_MIX2>(p, l, grid, stream);
        launch_phase<PH_MIX3>(p, l, grid, stream);
        launch_phase<PH_GEMM_OUT>(p, l, grid, stream);
        launch_phase<PH_NORM2>(p, l, grid, stream);
        launch_phase<PH_GEMM_GU>(p, l, grid, stream);
        launch_phase<PH_GEMM_DN>(p, l, grid, stream);
    }
    launch_phase<PH_FINAL>(p, 0, grid, stream);
}
```

```cpp
#ifndef __HIP_EMU__
#include <hip/hip_runtime.h>
#include <hip/hip_cooperative_groups.h>
#endif
#include <cstdio>
#include <cstdint>
#include <cmath>

#ifndef CFG_BATCH
#define CFG_BATCH 2
#endif
#ifndef CFG_SEQ
#define CFG_SEQ 8192
#endif
#ifndef CFG_DB
#define CFG_DB 32
#endif
constexpr int D = 1024, NL = 2, PB = CFG_BATCH, T = CFG_SEQ, DB = CFG_DB, DS = 8, PAST = 16384, WB = 2048;
constexpr int MP = PB * T, MS = DB * DS, M = MP + MS, MPAD = (M + 255) / 256 * 256, NC = PB + DB;
constexpr int INC = 3848, NPROJ = 3840, FF = 2816, NCH = T / 64, PWIN = T < 2048 ? T : 2048, NPOS = T + DS;
constexpr int NUNIT = PB * 4 * NCH;
constexpr float EPS = 1e-6f;
constexpr float LOG2E = 1.4426950408889634f;
static_assert(T % 512 == 0, "the attention job decomposition wants T % 512 == 0");
constexpr int C_QA = 0, C_KA = 256, C_VA = 512, C_QR = 768, C_KR = 1024, C_VR = 1280, C_GR = 1536, C_CONV = 1792, C_Z = 3328;
constexpr int SMEM_BYTES = 147456;
constexpr int NTHR = 512;
constexpr int BAR_LDS_OFF = SMEM_BYTES - 64;

typedef unsigned short bf16_t;
typedef short bf16x8 __attribute__((ext_vector_type(8)));
typedef float f32x4 __attribute__((ext_vector_type(4)));
typedef unsigned u32x4 __attribute__((ext_vector_type(4)));
typedef unsigned u32x2 __attribute__((ext_vector_type(2)));
typedef float f32x16 __attribute__((ext_vector_type(16)));

#ifdef __HIP_EMU__
#define LAUNCH(kern, grid, lds, stream, ...) emu_launch(grid, NTHR, [=]() { kern(__VA_ARGS__); })
#define DYN_SMEM(name) unsigned char* name = emu_dyn_smem()
#define WAVE_SYNC() emu_wave_bar()
#define MFMA32(a, b, c) emu_mfma32(a, b, c)
#define MFMA16(a, b, c) emu_mfma16(a, b, c)
#else
#define WAVE_SYNC() asm volatile("s_waitcnt lgkmcnt(0)" ::: "memory")
#define MFMA32(a, b, c) __builtin_amdgcn_mfma_f32_32x32x16_bf16(a, b, c, 0, 0, 0)
#define MFMA16(a, b, c) __builtin_amdgcn_mfma_f32_16x16x32_bf16(a, b, c, 0, 0, 0)
#define LAUNCH(kern, grid, lds, stream, ...) hipLaunchKernelGGL(kern, dim3(grid), dim3(NTHR), lds, stream, __VA_ARGS__)
#define DYN_SMEM(name) extern __shared__ __attribute__((aligned(16))) unsigned char name[]
#endif

#ifdef __HIP_EMU__
__device__ __forceinline__ int tidx() { return (int)threadIdx.x; }
#define LAUNDER_PTR(x)
#else
__device__ __forceinline__ int tidx() { int t = (int)threadIdx.x; asm volatile("" : "+v"(t)); return t; }
#define LAUNDER_PTR(x) asm volatile("" : "+s"(x))
#endif
__device__ __forceinline__ float bf2f(bf16_t v) { return __builtin_bit_cast(float, (unsigned)v << 16); }
__device__ __forceinline__ bf16_t f2bf(float f) { unsigned u = __builtin_bit_cast(unsigned, f); return (bf16_t)((u + 0x7fffu + ((u >> 16) & 1u)) >> 16); }
__device__ __forceinline__ unsigned pk2(float lo, float hi) { return (unsigned)f2bf(lo) | ((unsigned)f2bf(hi) << 16); }
__device__ __forceinline__ float silu_f(float x) { return x / (1.0f + expf(-x)); }
__device__ __forceinline__ float wave_sum(float v) {
#pragma unroll
    for (int o = 1; o < 64; o <<= 1) v += __shfl_xor(v, o);
    return v;
}
__device__ __forceinline__ float wave_max(float v) {
#pragma unroll
    for (int o = 1; o < 64; o <<= 1) v = fmaxf(v, __shfl_xor(v, o));
    return v;
}

struct P {
    const float *x_prompt, *x_sample, *cache_k, *cache_v, *state_ret, *state_gdn, *state_conv, *c_prompt, *c_sample, *ada_w, *ada_b, *norm_mix, *norm_ffn,
        *w_in, *ret_norm, *conv_w, *a_log, *dt_bias, *gdn_norm, *w_out, *w_gate, *w_up, *w_down, *final_norm;
    float* out; unsigned char* ws;
};

constexpr size_t O_YP = 0, O_YS = O_YP + (size_t)MP * D, O_PWK = O_YS + (size_t)MS * D, O_PWV = O_PWK + (size_t)NL * PB * PWIN * 256,
                 O_PRET = O_PWV + (size_t)NL * PB * PWIN * 256, O_PGDN = O_PRET + (size_t)NL * PB * 4 * 4096, O_PCONV = O_PGDN + (size_t)NL * PB * 4 * 16384,
                 O_SWK = O_PCONV + (size_t)NL * PB * 3 * 1536, O_SWV = O_SWK + (size_t)NL * DB * DS * 256, O_SRET = O_SWV + (size_t)NL * DB * DS * 256,
                 O_SGDN = O_SRET + (size_t)NL * DB * 4 * 4096, O_SCONV = O_SGDN + (size_t)NL * DB * 4 * 16384, O_END = O_SCONV + (size_t)NL * DB * 3 * 1536;

constexpr size_t al256(size_t x) { return (x + 255) / 256 * 256; }
constexpr size_t WS_CTL = 0, WS_CTL_BYTES = 1u << 20;
constexpr size_t WS_MOD = WS_CTL + WS_CTL_BYTES;
constexpr size_t WS_ROPE = al256(WS_MOD + (size_t)NL * NC * 6144 * 4);
constexpr size_t WS_WIN = al256(WS_ROPE + (size_t)4 * NPOS * 32 * 4);
constexpr size_t WS_WOUT = al256(WS_WIN + (size_t)NL * NPROJ * D * 2);
constexpr size_t WS_WGU = al256(WS_WOUT + (size_t)NL * D * D * 2);
constexpr size_t WS_WDN = al256(WS_WGU + (size_t)NL * 2 * FF * D * 2);
constexpr size_t WS_H = al256(WS_WDN + (size_t)NL * D * FF * 2);
constexpr size_t WS_PROJ = al256(WS_H + (size_t)MPAD * D * 2);
constexpr size_t WS_BETA = al256(WS_PROJ + (size_t)MPAD * NPROJ * 2);
constexpr size_t WS_G = al256(WS_BETA + (size_t)M * 4 * 4);
constexpr size_t WS_O = al256(WS_G + (size_t)M * 4 * 4);
constexpr size_t WS_RU = al256(WS_O + (size_t)MPAD * D * 2);
constexpr size_t WS_RS = al256(WS_RU + (size_t)NUNIT * 4096 * 4);
constexpr size_t WS_SCR = al256(WS_RS + (size_t)NUNIT * 4096 * 4);
constexpr size_t WS_GU = WS_SCR;
constexpr size_t WS_GW = al256(WS_GU + (size_t)NUNIT * 8192 * 4);
constexpr size_t WS_GQ = al256(WS_GW + (size_t)NUNIT * 8192 * 2);
constexpr size_t WS_GK = al256(WS_GQ + (size_t)NUNIT * 8192 * 2);
constexpr size_t WS_GA = al256(WS_GK + (size_t)NUNIT * 8192 * 2);
constexpr size_t WS_GD = al256(WS_GA + (size_t)NUNIT * 4096 * 2);
constexpr size_t WS_GV = al256(WS_GD + (size_t)NUNIT * 4);
constexpr size_t WS_GS = al256(WS_GV + (size_t)NUNIT * 8192 * 4);
constexpr size_t WS_GEND = al256(WS_GS + (size_t)NUNIT * 16384 * 4);
constexpr size_t WS_KH = WS_GEND;
constexpr size_t WS_VT1 = al256(WS_KH + (size_t)MP * 256 * 2);
constexpr size_t WS_VT4 = al256(WS_VT1 + (size_t)MP * 256 * 2);
constexpr size_t WS_VT16 = al256(WS_VT4 + (size_t)MP * 256 * 2);
constexpr size_t WS_AML = al256(WS_VT16 + (size_t)MP * 256 * 2);
constexpr size_t WS_AEND = al256(WS_AML + (size_t)MP * 4 * 3 * 2 * 4);
constexpr size_t WS_APO = WS_H;
static_assert((size_t)MP * 4 * 3 * 64 * 2 <= (size_t)MPAD * D * 2, "attention partials overlay H");
constexpr size_t WS_HID = WS_SCR;
constexpr size_t WS_HEND = al256(WS_HID + (size_t)MPAD * FF * 2);
constexpr size_t WS_END = WS_AEND > WS_HEND ? WS_AEND : WS_HEND;

#define WSP(T_, off) ((T_*)(p.ws + (off)))
__device__ __forceinline__ int row_cb(int r) { return r < MP ? r / T : PB + (r - MP) / DS; }
__device__ __forceinline__ int row_pi(int r) { return r < MP ? r % T : T + (r - MP) % DS; }
namespace pg8 {
#ifdef __HIP_EMU__
#define PG8_LAS
#else
#define PG8_LAS __attribute__((address_space(3)))
#endif
typedef unsigned short bf16_t;
typedef short bf16x8 __attribute__((ext_vector_type(8)));
typedef float f32x4 __attribute__((ext_vector_type(4)));
typedef unsigned u32x4 __attribute__((ext_vector_type(4)));
constexpr int BM = 256, BK = 64, HALF = 128, HTB = HALF * BK * 2  , STAGE_BYTES = 8 * HTB, NXCD = 8, WGM = 8;

__host__ __device__ __forceinline__ int lds_byte(int r, int c) { const int st = (r >> 4) * 2 + (c >> 5), rr = r & 15, cc = c & 31, ob = rr * 64 + cc * 2; return st * 1024 + (ob ^ (((ob >> 9) & 1) << 5)); }
__host__ __device__ __forceinline__ void stage_rc(int b, int& R, int& C) { const int st = b / 1024, sb = b % 1024, swz = sb ^ (((sb >> 9) & 1) << 5); R = (st >> 1) * 16 + swz / 64; C = (st & 1) * 32 + (swz % 64) / 2; }
__host__ __device__ __forceinline__ int perm32(int rho) { const int n = rho >> 4, i = rho & 15; return 8 * (i >> 2) + 4 * n + (i & 3); }

struct Unit { int pm, pn; };
struct Gemm { const bf16_t* A; const bf16_t* Bt; int M, N, K; };

struct StaticOrder {
    int nM, nN, nwg, G, c;
    __host__ __device__ void init(int M, int N, int G_, int c_) { nM = M / BM; nN = N / BM; nwg = nM * nN; G = G_; c = c_; }
    __host__ __device__ bool next(int i, Unit& u) const {
        const long L = (long)i * G + c; if (L >= nwg) return false;
        int wgid = (int)L; { const int q = nwg / NXCD, r = nwg % NXCD, xcd = wgid % NXCD, off = wgid / NXCD; wgid = (xcd < r ? xcd * (q + 1) : r * (q + 1) + (xcd - r) * q) + off; }
        const int nig = WGM * nN, gid = wgid / nig, fm = gid * WGM, gsz = (nM - fm) < WGM ? (nM - fm) : WGM;
        u.pm = fm + ((wgid % nig) % gsz); u.pn = (wgid % nig) / gsz; return true;
    }
    __device__ __forceinline__ void a_ready(const Unit&) const {}
    __device__ __forceinline__ void done(const Unit&) const {}
};


struct EpiStoreBf16 {
    static constexpr bool PERM = true, AFTER_DRAIN = false;
    bf16_t* O; int ldc;
    __device__ __forceinline__ void operator()(const f32x4 (&acc)[2][2][4][2], const Unit& u, int wr, int wc, int fr, int fq) const {
        const int row0 = u.pm * BM + wr * 64 + fr, col0 = u.pn * BM + wc * 32 + 8 * fq;
#pragma unroll
        for (int ai = 0; ai < 2; ++ai)
#pragma unroll
            for (int m = 0; m < 4; ++m) { bf16_t* rowp = O + (size_t)(row0 + ai * HALF + m * 16) * ldc + col0;
#pragma unroll
                for (int bj = 0; bj < 2; ++bj) { const f32x4 v0 = acc[ai][bj][m][0], v1 = acc[ai][bj][m][1];
                    u32x4 w; w.x = ::pk2(v0[0], v0[1]); w.y = ::pk2(v0[2], v0[3]); w.z = ::pk2(v1[0], v1[1]); w.w = ::pk2(v1[2], v1[3]);
                    *(u32x4*)(rowp + bj * HALF) = w; } }
    }
};
struct EpiResidual {
    static constexpr bool PERM = false, AFTER_DRAIN = false;
    float* X; const float* gate;
    __device__ __forceinline__ void operator()(const f32x4 (&acc)[2][2][4][2], const Unit& u, int wr, int wc, int fr, int fq) const {
        const int row0 = u.pm * BM + wr * 64 + fr, col0 = u.pn * BM + wc * 32 + 4 * fq;
#pragma unroll
        for (int ai = 0; ai < 2; ++ai)
#pragma unroll
            for (int m = 0; m < 4; ++m) { const int row = row0 + ai * HALF + m * 16;
                if (MPAD != M && row >= M) continue;
                const float* g = gate + (size_t)::row_cb(row) * 6144 + col0; float* xp = X + (size_t)row * D + col0;
#pragma unroll
                for (int bj = 0; bj < 2; ++bj)
#pragma unroll
                    for (int n = 0; n < 2; ++n) { const f32x4 gv = *(const f32x4*)(g + bj * HALF + n * 16); f32x4* xq = (f32x4*)(xp + bj * HALF + n * 16); *xq = *xq + gv * acc[ai][bj][m][n]; } }
    }
};
struct EpiSwiglu {
    static constexpr bool PERM = true, AFTER_DRAIN = false;
    bf16_t* Hd;
    __device__ __forceinline__ void operator()(const f32x4 (&acc)[2][2][4][2], const Unit& u, int wr, int wc, int fr, int fq) const {
        const int row0 = u.pm * BM + wr * 64 + fr, col0 = u.pn * HALF + wc * 32 + 8 * fq;
#pragma unroll
        for (int ai = 0; ai < 2; ++ai)
#pragma unroll
            for (int m = 0; m < 4; ++m) { bf16_t* rowp = Hd + (size_t)(row0 + ai * HALF + m * 16) * FF + col0;
                float v[8];
#pragma unroll
                for (int n = 0; n < 2; ++n)
#pragma unroll
                    for (int j = 0; j < 4; ++j) { const float gt = acc[ai][0][m][n][j], up = acc[ai][1][m][n][j]; v[4 * n + j] = ::silu_f(gt) * up; }
                u32x4 w; w.x = ::pk2(v[0], v[1]); w.y = ::pk2(v[2], v[3]); w.z = ::pk2(v[4], v[5]); w.w = ::pk2(v[6], v[7]);
                *(u32x4*)rowp = w; }
    }
};

#ifdef __HIP_EMU__
template <class Epi, class Sched, bool ALIGN_EPI = false, bool SP2 = false>
__device__ __forceinline__ void gemm_phase(unsigned char* lds, const Gemm g, const Sched& S, const Epi& E) {
    const int tid = threadIdx.x, wid = tid >> 6, lane = tid & 63, wr = wid >> 2, wc = wid & 3, fr = lane & 15, fq = lane >> 4;
    Unit cur;
    for (int ui = 0; S.next(ui, cur); ++ui) {
        f32x4 acc[2][2][4][2];
        for (int ai = 0; ai < 2; ++ai) for (int bj = 0; bj < 2; ++bj) for (int m = 0; m < 4; ++m) for (int n = 0; n < 2; ++n) for (int j = 0; j < 4; ++j) {
            const int row = 256 * cur.pm + 128 * ai + 64 * wr + 16 * m + fr;
            const int col = Epi::PERM ? 256 * cur.pn + 128 * bj + 32 * wc + 8 * fq + 4 * n + j : 256 * cur.pn + 128 * bj + 32 * wc + 16 * n + 4 * fq + j;
            const bf16_t* a = g.A + (size_t)row * g.K; const bf16_t* b = g.Bt + (size_t)col * g.K; float s = 0.f;
            for (int k = 0; k < g.K; ++k) s += ::bf2f(a[k]) * ::bf2f(b[k]);
            acc[ai][bj][m][n][j] = s; }
        E(acc, cur, wr, wc, fr, fq);
    }
}
#else
template <class Epi, class Sched, bool ALIGN_EPI = false, bool SP2 = false>
__device__ __forceinline__ void gemm_phase(PG8_LAS unsigned char* lds, const Gemm g, const Sched& S, const Epi& E) {
    const int tid = ::tidx(), wid = __builtin_amdgcn_readfirstlane(tid >> 6), lane = tid & 63, wr = wid >> 2, wc = wid & 3, fr = lane & 15, fq = lane >> 4;
    const int K = g.K, nt = K / BK;
    unsigned voffA[2], voffB[2];
#pragma unroll
    for (int i = 0; i < 2; ++i) { int R, C; stage_rc(tid * 16 + i * 8192, R, C); const int Rb = Epi::PERM ? ((R & ~31) + perm32(R & 31)) : R;
        voffA[i] = (unsigned)(R * K + C) * 2u; voffB[i] = (unsigned)(Rb * K + C) * 2u; }
    const size_t kstep = (size_t)(BK * 2);
    const size_t hstep = (size_t)HALF * K * 2;
    const size_t tstep = 2 * hstep;
    const unsigned ldsw = (unsigned)wid * 1024u;
    const int aoff = lds_byte(wr * 64 + fr, fq * 8), boff = lds_byte(wc * 32 + fr, fq * 8);
#define PG8_SA(b, h) (((b) * 2 + (h)) * HTB)
#define PG8_SB(b, h) ((4 + (b) * 2 + (h)) * HTB)
#define PG8_STAGE(bufoff, gbase, voff) do { _Pragma("unroll") for (int _i = 0; _i < 2; ++_i) \
        __builtin_amdgcn_global_load_lds((const unsigned*)((const char*)(gbase) + (voff)[_i]), (PG8_LAS unsigned*)(lds + (bufoff) + ldsw + _i * 8192), 16, 0, 0); } while (0)
#define PG8_LDA(dst, b, h) do { _Pragma("unroll") for (int m = 0; m < 4; ++m) _Pragma("unroll") for (int k = 0; k < 2; ++k) dst[m][k] = *(const PG8_LAS bf16x8*)(lds + PG8_SA(b, h) + aoff + m * 2048 + k * 1024); } while (0)
#define PG8_LDB(dst, b, h) do { _Pragma("unroll") for (int n = 0; n < 2; ++n) _Pragma("unroll") for (int k = 0; k < 2; ++k) dst[n][k] = *(const PG8_LAS bf16x8*)(lds + PG8_SB(b, h) + boff + n * 2048 + k * 1024); } while (0)
#define PG8_MMA(ai, bj, At, Bt) do { __builtin_amdgcn_s_setprio(1); _Pragma("unroll") for (int m = 0; m < 4; ++m) _Pragma("unroll") for (int n = 0; n < 2; ++n) _Pragma("unroll") for (int k = 0; k < 2; ++k) \
        acc[ai][bj][m][n] = __builtin_amdgcn_mfma_f32_16x16x32_bf16(Bt[n][k], At[m][k], acc[ai][bj][m][n], 0, 0, 0); __builtin_amdgcn_s_setprio(0); } while (0)
#define PG8_WAIT_V(n) asm volatile("s_waitcnt vmcnt(" #n ")" ::: "memory")
#define PG8_WAIT_L(n) asm volatile("s_waitcnt lgkmcnt(" #n ")" ::: "memory")
#define PG8_BAR __builtin_amdgcn_s_barrier()
#define PG8_SCHED __builtin_amdgcn_sched_barrier(0)
    Unit cur, nxt; int ui = 0;
    if (!S.next(0, cur)) return;
    f32x4 acc[2][2][4][2];
#pragma unroll
    for (int a = 0; a < 2; ++a)
#pragma unroll
        for (int b = 0; b < 2; ++b)
#pragma unroll
            for (int m = 0; m < 4; ++m)
#pragma unroll
                for (int n = 0; n < 2; ++n) acc[a][b][m][n] = (f32x4){0.f, 0.f, 0.f, 0.f};
    bf16x8 At[4][2], B0[2][2], B1[2][2];
    const char* cA = (const char*)g.A + (size_t)cur.pm * tstep; const char* cB = (const char*)g.Bt + (size_t)cur.pn * tstep;
    S.a_ready(cur);
    if constexpr (SP2) {
        PG8_STAGE(PG8_SB(0, 0), cB, voffB); PG8_STAGE(PG8_SB(0, 1), cB + hstep, voffB); PG8_STAGE(PG8_SA(0, 0), cA, voffA); PG8_STAGE(PG8_SA(0, 1), cA + hstep, voffA);
        if (wr == 1) PG8_BAR;
        PG8_WAIT_V(2); PG8_BAR;
        PG8_STAGE(PG8_SB(1, 0), cB + kstep, voffB); PG8_STAGE(PG8_SA(1, 0), cA + kstep, voffA); PG8_STAGE(PG8_SB(1, 1), cB + hstep + kstep, voffB);
        PG8_WAIT_V(6); PG8_BAR;
    } else {
        PG8_STAGE(PG8_SB(0, 0), cB, voffB); PG8_STAGE(PG8_SA(0, 0), cA, voffA); PG8_STAGE(PG8_SB(0, 1), cB + hstep, voffB); PG8_STAGE(PG8_SA(0, 1), cA + hstep, voffA);
        if (wr == 1) PG8_BAR;
        PG8_WAIT_V(4); PG8_BAR;
        PG8_STAGE(PG8_SB(1, 0), cB + kstep, voffB); PG8_STAGE(PG8_SA(1, 0), cA + kstep, voffA); PG8_STAGE(PG8_SB(1, 1), cB + hstep + kstep, voffB);
        PG8_WAIT_V(6); PG8_BAR;
    }
    for (;;) {
        const bool has_next = S.next(ui + 1, nxt);
        const char* nA = has_next ? (const char*)g.A + (size_t)nxt.pm * tstep : cA; const char* nB = has_next ? (const char*)g.Bt + (size_t)nxt.pn * tstep : cB;
        for (int t = 0; t < nt; t += 2) {
            const bool last = (t == nt - 2);
            const char* a1 = cA + (size_t)(t + 1) * kstep;
            const char* a2 = last ? nA : cA + (size_t)(t + 2) * kstep; const char* b2 = last ? nB : cB + (size_t)(t + 2) * kstep;
            const char* a3 = a2 + kstep; const char* b3 = b2 + kstep;
            if (last && has_next) S.a_ready(nxt);
            if constexpr (SP2) {
            PG8_LDB(B0, 0, 0); PG8_LDB(B1, 0, 1); PG8_SCHED; PG8_LDA(At, 0, 0); PG8_STAGE(PG8_SA(1, 1), a1 + hstep, voffA);
            PG8_WAIT_V(8); PG8_WAIT_L(0); PG8_BAR; PG8_MMA(0, 0, At, B0); PG8_MMA(0, 1, At, B1); PG8_BAR; PG8_SCHED;
            PG8_LDA(At, 0, 1); PG8_STAGE(PG8_SB(0, 0), b2, voffB); PG8_STAGE(PG8_SB(0, 1), b2 + hstep, voffB); PG8_STAGE(PG8_SA(0, 0), a2, voffA);
            PG8_WAIT_V(8); PG8_WAIT_L(0); PG8_BAR; PG8_MMA(1, 0, At, B0); PG8_MMA(1, 1, At, B1); PG8_BAR; PG8_SCHED;
            PG8_LDB(B0, 1, 0); PG8_LDB(B1, 1, 1); PG8_SCHED; PG8_LDA(At, 1, 0); PG8_STAGE(PG8_SA(0, 1), a2 + hstep, voffA);
            PG8_WAIT_V(8); PG8_WAIT_L(0); PG8_BAR; PG8_MMA(0, 0, At, B0); PG8_MMA(0, 1, At, B1); PG8_BAR; PG8_SCHED;
            PG8_LDA(At, 1, 1); PG8_STAGE(PG8_SB(1, 0), b3, voffB); PG8_STAGE(PG8_SB(1, 1), b3 + hstep, voffB); PG8_STAGE(PG8_SA(1, 0), a3, voffA);
            PG8_WAIT_V(8); PG8_WAIT_L(0); PG8_BAR; PG8_MMA(1, 0, At, B0); PG8_MMA(1, 1, At, B1); PG8_BAR; PG8_SCHED;
            } else {
            PG8_LDB(B0, 0, 0); PG8_SCHED; PG8_LDA(At, 0, 0); PG8_STAGE(PG8_SA(1, 1), a1 + hstep, voffA);
            PG8_WAIT_L(8); PG8_BAR; PG8_WAIT_L(0); PG8_MMA(0, 0, At, B0); PG8_BAR; PG8_SCHED;
            PG8_LDB(B1, 0, 1); PG8_STAGE(PG8_SB(0, 0), b2, voffB);
            PG8_BAR; PG8_WAIT_L(0); PG8_MMA(0, 1, At, B1); PG8_BAR;
            PG8_LDA(At, 0, 1); PG8_STAGE(PG8_SA(0, 0), a2, voffA);
            PG8_BAR; PG8_WAIT_L(0); PG8_MMA(1, 0, At, B0); PG8_BAR; PG8_SCHED;
            PG8_STAGE(PG8_SB(0, 1), b2 + hstep, voffB);
            PG8_WAIT_V(6); PG8_BAR; PG8_MMA(1, 1, At, B1); PG8_BAR;
            PG8_LDB(B0, 1, 0); PG8_SCHED; PG8_LDA(At, 1, 0); PG8_STAGE(PG8_SA(0, 1), a2 + hstep, voffA);
            PG8_WAIT_L(8); PG8_BAR; PG8_WAIT_L(0); PG8_MMA(0, 0, At, B0); PG8_BAR; PG8_SCHED;
            PG8_LDB(B1, 1, 1); PG8_STAGE(PG8_SB(1, 0), b3, voffB);
            PG8_BAR; PG8_WAIT_L(0); PG8_MMA(0, 1, At, B1); PG8_BAR;
            PG8_LDA(At, 1, 1); PG8_STAGE(PG8_SA(1, 0), a3, voffA);
            PG8_BAR; PG8_WAIT_L(0); PG8_MMA(1, 0, At, B0); PG8_BAR; PG8_SCHED;
            PG8_STAGE(PG8_SB(1, 1), b3 + hstep, voffB);
            PG8_WAIT_V(6); PG8_BAR; PG8_MMA(1, 1, At, B1); PG8_BAR;
            }
        }
        if constexpr (ALIGN_EPI) { if (wr == 0) PG8_BAR; }
        if constexpr (!Epi::AFTER_DRAIN) { E(acc, cur, wr, wc, fr, fq); S.done(cur); }
        if (!has_next) break;
#pragma unroll
        for (int a = 0; a < 2; ++a)
#pragma unroll
            for (int b = 0; b < 2; ++b)
#pragma unroll
                for (int m = 0; m < 4; ++m)
#pragma unroll
                    for (int n = 0; n < 2; ++n) acc[a][b][m][n] = (f32x4){0.f, 0.f, 0.f, 0.f};
        cur = nxt; cA = nA; cB = nB; ++ui;
        if constexpr (ALIGN_EPI) { if (wr == 1) PG8_BAR; }
    }
    PG8_WAIT_V(0);
    if constexpr (!ALIGN_EPI) { if (wr == 0) PG8_BAR; }
    PG8_BAR;
    if constexpr (Epi::AFTER_DRAIN) { E.fused(acc, cur, wr, wc, fr, fq, lds, wid, lane); S.done(cur); }
#undef PG8_SA
#undef PG8_SB
#undef PG8_STAGE
#undef PG8_LDA
#undef PG8_LDB
#undef PG8_MMA
#undef PG8_WAIT_V
#undef PG8_WAIT_L
#undef PG8_BAR
#undef PG8_SCHED
}
#endif
}


__device__ __forceinline__ void transpose_item(const float* W, int ldw, bf16_t* WT, int K, int k0, int n0, int drow0, float* scr, int lane) {
#pragma unroll 8
    for (int i = 0; i < 32; ++i) { const int kk = 2 * i + (lane >> 5); scr[kk * 33 + (lane & 31)] = W[(size_t)(k0 + kk) * ldw + n0 + (lane & 31)]; }
    WAVE_SYNC();
    const int c = lane & 7;
#pragma unroll
    for (int j = 0; j < 4; ++j) { const int n = (lane >> 3) + 8 * j; const float* s = scr + (8 * c) * 33 + n;
        u32x4 o; o.x = pk2(s[0 * 33], s[1 * 33]); o.y = pk2(s[2 * 33], s[3 * 33]); o.z = pk2(s[4 * 33], s[5 * 33]); o.w = pk2(s[6 * 33], s[7 * 33]);
        *(u32x4*)(WT + (size_t)(drow0 + n) * K + k0 + 8 * c) = o; }
    WAVE_SYNC();
}
__device__ __forceinline__ void ph_convert(const P& p, unsigned char* smem) {
    const int lane = tidx() & 63, wave = tidx() >> 6;
    float* scr = (float*)smem + wave * (64 * 33 + 32);
    constexpr int I_IN = 16 * 120, I_OUT = 16 * 32, I_G = 16 * 88, I_DN = 44 * 32, I_L = I_IN + I_OUT + 2 * I_G + I_DN;
    const int gw = blockIdx.x * 8 + wave, ngw = gridDim.x * 8;
    for (int it = gw; it < NL * I_L; it += ngw) {
        const int l = it / I_L; int r = it % I_L;
        if (r < I_IN) { const int kb = r / 120, nb = r % 120; transpose_item(p.w_in + (size_t)l * D * INC, INC, WSP(bf16_t, WS_WIN) + (size_t)l * NPROJ * D, D, kb * 64, nb * 32, nb * 32, scr, lane); continue; }
        r -= I_IN;
        if (r < I_OUT) { const int kb = r / 32, nb = r % 32; transpose_item(p.w_out + (size_t)l * D * D, D, WSP(bf16_t, WS_WOUT) + (size_t)l * D * D, D, kb * 64, nb * 32, nb * 32, scr, lane); continue; }
        r -= I_OUT;
        if (r < 2 * I_G) { const int up = r / I_G; r %= I_G; const int kb = r / 88, nb = r % 88, n0 = nb * 32;
            transpose_item((up ? p.w_up : p.w_gate) + (size_t)l * D * FF, FF, WSP(bf16_t, WS_WGU) + (size_t)l * 2 * FF * D, D, kb * 64, n0, (n0 / 128) * 256 + up * 128 + (n0 % 128), scr, lane); continue; }
        r -= 2 * I_G;
        { const int kb = r / 32, nb = r % 32; transpose_item(p.w_down + (size_t)l * FF * D, D, WSP(bf16_t, WS_WDN) + (size_t)l * D * FF, FF, kb * 64, nb * 32, nb * 32, scr, lane); }
    }
}

__device__ __forceinline__ void ph_adaln(const P& p, unsigned char* smem) {
    float* sc = (float*)smem;
    float* red = sc + NC * 256;
    const int tid = tidx(), col = tid & 31, kg = tid >> 5;
    float* MOD = WSP(float, WS_MOD);
    for (int it = blockIdx.x; it < NL * 192; it += gridDim.x) {
        const int l = it / 192, cb0 = (it % 192) * 32;
        float acc[NC];
#pragma unroll
        for (int r = 0; r < NC; ++r) acc[r] = 0.f;
        for (int kc = 0; kc < 4; ++kc) {
            __syncthreads();
            for (int e = tid; e < NC * 256; e += NTHR) { const int r = e >> 8, k = e & 255; const float c = r < PB ? p.c_prompt[r * D + kc * 256 + k] : p.c_sample[(r - PB) * D + kc * 256 + k]; sc[e] = silu_f(c); }
            __syncthreads();
            for (int kk = 0; kk < 16; ++kk) { const int k = kg * 16 + kk; const float w = p.ada_w[((size_t)l * D + kc * 256 + k) * 6144 + cb0 + col];
#pragma unroll
                for (int r = 0; r < NC; ++r) acc[r] += sc[r * 256 + k] * w; }
        }
#pragma unroll
        for (int r = 0; r < NC; ++r) red[(kg * NC + r) * 32 + col] = acc[r];
        __syncthreads();
        for (int e = tid; e < NC * 32; e += NTHR) { const int r = e >> 5, c = e & 31; float s = p.ada_b[l * 6144 + cb0 + c];
            for (int g = 0; g < 16; ++g) s += red[(g * NC + r) * 32 + c];
            MOD[((size_t)l * NC + r) * 6144 + cb0 + c] = s; }
        __syncthreads();
    }
}

__device__ __forceinline__ void ph_ropetab_copyx(const P& p) {
    const size_t gt = (size_t)blockIdx.x * NTHR + tidx(), ng = (size_t)gridDim.x * NTHR;
    float* tab = WSP(float, WS_ROPE);
    for (size_t e = gt; e < (size_t)NPOS * 32; e += ng) {
        const int pi = (int)(e >> 5), i = (int)(e & 31); const double pos = pi < T ? (double)pi : (double)(PAST + pi - T);
        const double ia = exp(-log(10000.0) * (double)i / 32.0), ir = exp(-log(10000.0) * (double)i / 31.0);
        tab[e] = (float)cos(pos * ia); tab[(size_t)NPOS * 32 + e] = (float)sin(pos * ia);
        tab[(size_t)2 * NPOS * 32 + e] = (float)cos(pos * ir); tab[(size_t)3 * NPOS * 32 + e] = (float)sin(pos * ir);
    }
    const f32x4* xp = (const f32x4*)p.x_prompt; const f32x4* xs = (const f32x4*)p.x_sample; f32x4* o = (f32x4*)p.out;
    for (size_t e = gt; e < (size_t)MP * D / 4; e += ng) o[e] = xp[e];
    for (size_t e = gt; e < (size_t)MS * D / 4; e += ng) o[(size_t)MP * D / 4 + e] = xs[e];
}

template <int WHICH> __device__ __forceinline__ void ph_norm_mod(const P& p, int l) {
    const int lane = tidx() & 63, wave = tidx() >> 6, gw = blockIdx.x * 8 + wave, ngw = gridDim.x * 8;
    const float* nw = (WHICH == 0 ? p.norm_mix : p.norm_ffn) + l * D;
    bf16_t* H = WSP(bf16_t, WS_H);
    for (int r = gw; r < M; r += ngw) {
        const float* xr = p.out + (size_t)r * D; const float* mod = WSP(float, WS_MOD) + ((size_t)l * NC + row_cb(r)) * 6144 + (WHICH == 0 ? 0 : 3072);
        f32x4 v[4]; float ss = 0.f;
#pragma unroll
        for (int j = 0; j < 4; ++j) { v[j] = *(const f32x4*)(xr + 4 * lane + 256 * j); ss += (v[j][0] * v[j][0] + v[j][1] * v[j][1]) + (v[j][2] * v[j][2] + v[j][3] * v[j][3]); }
        const float rstd = 1.0f / sqrtf(wave_sum(ss) * (1.0f / D) + EPS);
        float a8[8];
#pragma unroll
        for (int c = 0; c < 8; ++c) a8[c] = 0.f;
#pragma unroll
        for (int j = 0; j < 4; ++j) { const int k = 4 * lane + 256 * j;
            const f32x4 g = *(const f32x4*)(nw + k), sh = *(const f32x4*)(mod + k), sc = *(const f32x4*)(mod + 1024 + k);
            f32x4 h;
#pragma unroll
            for (int e = 0; e < 4; ++e) h[e] = v[j][e] * rstd * g[e] * (1.0f + sc[e]) + sh[e];
            u32x2 w; w.x = pk2(h[0], h[1]); w.y = pk2(h[2], h[3]); *(u32x2*)(H + (size_t)r * D + k) = w;
            if (WHICH == 0) {
#pragma unroll
                for (int e = 0; e < 4; ++e) { const float* wr = p.w_in + ((size_t)l * D + k + e) * INC + NPROJ; const f32x4 w0 = *(const f32x4*)wr, w1 = *(const f32x4*)(wr + 4);
#pragma unroll
                    for (int c = 0; c < 4; ++c) { a8[c] += h[e] * w0[c]; a8[4 + c] += h[e] * w1[c]; } }
            }
        }
        if (WHICH == 0) {
#pragma unroll
            for (int c = 0; c < 8; ++c) a8[c] = wave_sum(a8[c]);
            if (lane < 4) { float braw = lane == 0 ? a8[0] : lane == 1 ? a8[1] : lane == 2 ? a8[2] : a8[3]; WSP(float, WS_BETA)[(size_t)r * 4 + lane] = 1.0f / (1.0f + expf(-braw)); }
            else if (lane < 8) { const int hh = lane - 4; float araw = hh == 0 ? a8[4] : hh == 1 ? a8[5] : hh == 2 ? a8[6] : a8[7];
                const float xx = araw + p.dt_bias[l * 4 + hh]; const float sp = xx > 20.f ? xx : log1pf(expf(xx));
                WSP(float, WS_G)[(size_t)r * 4 + hh] = -expf(p.a_log[l * 4 + hh]) * sp; }
        }
    }
}

__device__ __forceinline__ void ph_rope_out(const P& p, int l) {
    const size_t gt = (size_t)blockIdx.x * NTHR + tidx(), ng = (size_t)gridDim.x * NTHR;
    bf16_t* PR = WSP(bf16_t, WS_PROJ); const float* tab = WSP(float, WS_ROPE);
    for (size_t e = gt; e < (size_t)M * 512; e += ng) {
        const int r = (int)(e >> 9), rem = (int)(e & 511), sec = rem >> 7, hh = (rem & 127) >> 5, d = rem & 31;
        const int off = sec == 0 ? C_QA : sec == 1 ? C_KA : sec == 2 ? C_QR : C_KR; const float scale = sec == 0 ? 0.125f * LOG2E : sec == 3 ? 0.125f : 1.0f;
        const float* ct = tab + (size_t)(sec >= 2 ? 2 : 0) * NPOS * 32 + (size_t)row_pi(r) * 32 + d; const float c = ct[0], s = ct[(size_t)NPOS * 32];
        bf16_t* x = PR + (size_t)r * NPROJ + off + hh * 64 + d; const float x1 = bf2f(x[0]), x2 = bf2f(x[32]);
        const float o1 = (x1 * c - x2 * s) * scale, o2 = (x1 * s + x2 * c) * scale;
        x[0] = f2bf(o1); x[32] = f2bf(o2);
        if (sec == 1) {
            if (r < MP) { const int b = r / T, t = r % T; bf16_t* kh = WSP(bf16_t, WS_KH) + ((size_t)(b * 4 + hh) * T + t) * 64 + d; kh[0] = f2bf(o1); kh[32] = f2bf(o2);
                if (t >= T - PWIN) { float* o = p.out + O_PWK + (((size_t)l * PB + b) * PWIN + (t - (T - PWIN))) * 256 + hh * 64 + d; o[0] = o1; o[32] = o2; } }
            else { const int b = (r - MP) / DS, i = (r - MP) % DS; float* o = p.out + O_SWK + (((size_t)l * DB + b) * DS + i) * 256 + hh * 64 + d; o[0] = o1; o[32] = o2; }
        }
    }
    for (size_t e = gt; e < (size_t)M * 256; e += ng) {
        const int r = (int)(e >> 8), c = (int)(e & 255); const float v = bf2f(PR[(size_t)r * NPROJ + C_VA + c]);
        if (r < MP) { const int b = r / T, t = r % T; if (t >= T - PWIN) p.out[O_PWV + (((size_t)l * PB + b) * PWIN + (t - (T - PWIN))) * 256 + c] = v; }
        else { const int b = (r - MP) / DS, i = (r - MP) % DS; p.out[O_SWV + (((size_t)l * DB + b) * DS + i) * 256 + c] = v; }
    }
    for (size_t e = gt; e < (size_t)(PB + DB) * 3 * 1536; e += ng) {
        const int c = (int)(e % 1536), j = (int)((e / 1536) % 3), bb = (int)(e / (3 * 1536));
        if (bb < PB) p.out[O_PCONV + (((size_t)l * PB + bb) * 3 + j) * 1536 + c] = bf2f(PR[(size_t)(bb * T + T - 3 + j) * NPROJ + C_CONV + c]);
        else { const int b = bb - PB; p.out[O_SCONV + (((size_t)l * DB + b) * 3 + j) * 1536 + c] = bf2f(PR[(size_t)(MP + b * DS + DS - 3 + j) * NPROJ + C_CONV + c]); }
    }
}

__device__ __forceinline__ void attn_wave_sample(const P& p, int l, int r, int h, int lane, float* sw  ) {
    const bf16_t* PR = WSP(bf16_t, WS_PROJ);
    const int b = (r - MP) / DS; const int tq = WB + (r - MP) % DS;
    float q[64];
    { const bf16_t* qp = PR + (size_t)r * NPROJ + C_QA + h * 64;
#pragma unroll
      for (int j = 0; j < 8; ++j) { const bf16x8 v = *(const bf16x8*)(qp + 8 * j);
#pragma unroll
          for (int e = 0; e < 8; ++e) q[8 * j + e] = bf2f((bf16_t)v[e]); } }
    float mx = -INFINITY;
#pragma unroll 1
    for (int i = 0; i < 7; ++i) {
        const int e = lane + 64 * i;
        if (e < 387) { const int pat = e / 129, j = e % 129, dil = pat == 0 ? 1 : pat == 1 ? 4 : 16; const int rr = tq - dil * j;
            float a = 0.f;
            if (rr < WB) { const float* kp = p.cache_k + ((((size_t)l * DB + b) * WB + rr) * 4 + h) * 64;
#pragma unroll
                for (int j4 = 0; j4 < 16; ++j4) { const f32x4 kv = *(const f32x4*)(kp + 4 * j4); a += q[4 * j4] * kv[0] + q[4 * j4 + 1] * kv[1] + q[4 * j4 + 2] * kv[2] + q[4 * j4 + 3] * kv[3]; } }
            else { const bf16_t* kp = PR + (size_t)(MP + b * DS + (rr - WB)) * NPROJ + C_KA + h * 64;
#pragma unroll
                for (int j8 = 0; j8 < 8; ++j8) { const bf16x8 kv = *(const bf16x8*)(kp + 8 * j8);
#pragma unroll
                    for (int e2 = 0; e2 < 8; ++e2) a += q[8 * j8 + e2] * bf2f((bf16_t)kv[e2]); } }
            sw[e] = a; mx = fmaxf(mx, a); }
    }
    mx = wave_max(mx);
    float lsum = 0.f;
#pragma unroll 1
    for (int i = 0; i < 7; ++i) { const int e = lane + 64 * i; if (e < 387) { const float pe = exp2f(sw[e] - mx); sw[e] = pe; lsum += pe; } }
    lsum = wave_sum(lsum);
    WAVE_SYNC();
    float o = 0.f;
#pragma unroll 4
    for (int e = 0; e < 387; ++e) {
        const float pe = sw[e];
        const int pat = e / 129, j = e % 129, dil = pat == 0 ? 1 : pat == 1 ? 4 : 16; const int rr = tq - dil * j;
        float v;
        if (rr < WB) v = p.cache_v[((((size_t)l * DB + b) * WB + rr) * 4 + h) * 64 + lane];
        else v = bf2f(PR[(size_t)(MP + b * DS + (rr - WB)) * NPROJ + C_VA + h * 64 + lane]);
        o += pe * v;
    }
    WAVE_SYNC();
    WSP(bf16_t, WS_O)[(size_t)r * D + h * 64 + lane] = f2bf(o / lsum);
}
__device__ __forceinline__ void ph_attn_sample(const P& p, int l, unsigned char* smem) {
    const int lane = tidx() & 63, wave = tidx() >> 6, gw = blockIdx.x * 8 + wave, ngw = gridDim.x * 8;
    float* sw = (float*)smem + wave * 392;
    for (int it = gw; it < MS * 4; it += ngw) attn_wave_sample(p, l, MP + (it >> 2), it & 3, lane, sw);
}
__device__ __forceinline__ bf16x8 pack8(const f32x16& v, int s8) {
    u32x4 w; w.x = pk2(v[s8], v[s8 + 1]); w.y = pk2(v[s8 + 2], v[s8 + 3]); w.z = pk2(v[s8 + 4], v[s8 + 5]); w.w = pk2(v[s8 + 6], v[s8 + 7]); return __builtin_bit_cast(bf16x8, w);
}
__device__ __forceinline__ void attn_job(const P& p, int jb, int lane) {
    const int c = lane & 31, hi = lane >> 5;
    constexpr int NB = T / 512;
    const int unit = jb / 48, jj = jb % 48, pat = jj >> 4, sub = jj & 15;
    const int blk = unit % NB, h = (unit / NB) & 3, b = unit / (NB * 4), bh = b * 4 + h;
    int dil, r, qi0; const bf16_t* VT;
    if (pat == 0) { dil = 1; r = 0; qi0 = blk * 512 + sub * 32; VT = WSP(bf16_t, WS_VT1) + (size_t)bh * 64 * T; }
    else if (pat == 1) { dil = 4; r = sub >> 2; qi0 = blk * 128 + (sub & 3) * 32; VT = WSP(bf16_t, WS_VT4) + (size_t)(bh * 4 + r) * 64 * (T / 4); }
    else { dil = 16; r = sub; qi0 = blk * 32; VT = WSP(bf16_t, WS_VT16) + (size_t)(bh * 16 + r) * 64 * (T / 16); }
    const int SL = T / dil;
    const int tq = dil * (qi0 + c) + r;
    const bf16_t* qp = WSP(bf16_t, WS_PROJ) + (size_t)(b * T + tq) * NPROJ + C_QA + h * 64 + 8 * hi;
    bf16x8 qf[4];
#pragma unroll
    for (int ks = 0; ks < 4; ++ks) qf[ks] = *(const bf16x8*)(qp + 16 * ks);
    const bf16_t* KHb = WSP(bf16_t, WS_KH) + (size_t)bh * T * 64;
    f32x16 S[5];
#pragma unroll
    for (int i = 0; i < 5; ++i) {
        const int kt0 = qi0 - 128 + 32 * i;
        f32x16 acc;
#pragma unroll
        for (int e = 0; e < 16; ++e) acc[e] = 0.f;
        if (kt0 >= 0) { const bf16_t* kp = KHb + (size_t)(dil * (kt0 + c) + r) * 64 + 8 * hi;
#pragma unroll
            for (int ks = 0; ks < 4; ++ks) acc = MFMA32(*(const bf16x8*)(kp + 16 * ks), qf[ks], acc);
            if (i == 0) {
#pragma unroll
                for (int e = 0; e < 16; ++e) { const int krow = (e & 3) + 8 * (e >> 2) + 4 * hi; if (krow < c) acc[e] = -INFINITY; } }
            if (i == 4) {
#pragma unroll
                for (int e = 0; e < 16; ++e) { const int krow = (e & 3) + 8 * (e >> 2) + 4 * hi; if (krow > c) acc[e] = -INFINITY; } }
        } else {
#pragma unroll
            for (int e = 0; e < 16; ++e) acc[e] = -INFINITY; }
        S[i] = acc;
    }
    float mx = -INFINITY;
#pragma unroll
    for (int i = 0; i < 5; ++i)
#pragma unroll
        for (int e = 0; e < 16; ++e) mx = fmaxf(mx, S[i][e]);
    mx = fmaxf(mx, __shfl_xor(mx, 32));
    float lsum = 0.f;
#pragma unroll
    for (int i = 0; i < 5; ++i)
#pragma unroll
        for (int e = 0; e < 16; ++e) { const float pe = exp2f(S[i][e] - mx); S[i][e] = pe; lsum += pe; }
    lsum += __shfl_xor(lsum, 32);
    f32x16 O[2];
#pragma unroll
    for (int dt = 0; dt < 2; ++dt)
#pragma unroll
        for (int e = 0; e < 16; ++e) O[dt][e] = 0.f;
#pragma unroll
    for (int i = 0; i < 5; ++i) {
        const int kt0 = qi0 - 128 + 32 * i;
        if (kt0 >= 0) {
#pragma unroll
            for (int s2 = 0; s2 < 2; ++s2) { const bf16x8 pf = pack8(S[i], 8 * s2);
#pragma unroll
                for (int dt = 0; dt < 2; ++dt) { const bf16_t* vp = VT + (size_t)(dt * 32 + c) * SL + kt0 + 16 * s2 + 4 * hi;
                    const u32x2 lo = *(const u32x2*)vp, hh = *(const u32x2*)(vp + 8); u32x4 w; w.x = lo.x; w.y = lo.y; w.z = hh.x; w.w = hh.y;
                    O[dt] = MFMA32(__builtin_bit_cast(bf16x8, w), pf, O[dt]); } }
        }
    }
    const size_t idx = ((size_t)(b * T + tq) * 4 + h) * 3 + pat;
    bf16_t* po = WSP(bf16_t, WS_APO) + idx * 64;
#pragma unroll
    for (int dt = 0; dt < 2; ++dt)
#pragma unroll
        for (int g = 0; g < 4; ++g) { u32x2 w; w.x = pk2(O[dt][4 * g], O[dt][4 * g + 1]); w.y = pk2(O[dt][4 * g + 2], O[dt][4 * g + 3]); *(u32x2*)(po + 32 * dt + 8 * g + 4 * hi) = w; }
    if (hi == 0) { float* ml = WSP(float, WS_AML) + idx * 2; ml[0] = mx; ml[1] = lsum; }
}
__device__ __forceinline__ void ph_attn_jobs(const P& p) {
    const int lane = tidx() & 63, wave = tidx() >> 6, gw = blockIdx.x * 8 + wave, ngw = gridDim.x * 8;
    for (int jb = gw; jb < PB * 4 * (T / 512) * 48; jb += ngw) attn_job(p, jb, lane);
}
__device__ __forceinline__ void ph_attn_combine(const P& p) {
    const size_t gt = (size_t)blockIdx.x * NTHR + tidx(), ng = (size_t)gridDim.x * NTHR;
    for (size_t e = gt; e < (size_t)MP * 4 * 16; e += ng) {
        const size_t rh = e >> 4; const int dq = (int)(e & 15) * 4;
        const float* ml = WSP(float, WS_AML) + rh * 6; const float m0 = ml[0], m1 = ml[2], m2 = ml[4];
        const float mm = fmaxf(m0, fmaxf(m1, m2)); const float w0 = exp2f(m0 - mm), w1 = exp2f(m1 - mm), w2 = exp2f(m2 - mm);
        const float inv = 1.0f / (w0 * ml[1] + w1 * ml[3] + w2 * ml[5]);
        const bf16_t* po = WSP(bf16_t, WS_APO) + rh * 192 + dq;
        const u32x2 a = *(const u32x2*)po, bq = *(const u32x2*)(po + 64), cq = *(const u32x2*)(po + 128);
        float o[4];
        o[0] = w0 * bf2f((bf16_t)(a.x & 0xffff)) + w1 * bf2f((bf16_t)(bq.x & 0xffff)) + w2 * bf2f((bf16_t)(cq.x & 0xffff));
        o[1] = w0 * bf2f((bf16_t)(a.x >> 16)) + w1 * bf2f((bf16_t)(bq.x >> 16)) + w2 * bf2f((bf16_t)(cq.x >> 16));
        o[2] = w0 * bf2f((bf16_t)(a.y & 0xffff)) + w1 * bf2f((bf16_t)(bq.y & 0xffff)) + w2 * bf2f((bf16_t)(cq.y & 0xffff));
        o[3] = w0 * bf2f((bf16_t)(a.y >> 16)) + w1 * bf2f((bf16_t)(bq.y >> 16)) + w2 * bf2f((bf16_t)(cq.y >> 16));
        const size_t row = rh >> 2; const int h = (int)(rh & 3);
        u32x2 w; w.x = pk2(o[0] * inv, o[1] * inv); w.y = pk2(o[2] * inv, o[3] * inv);
        *(u32x2*)(WSP(bf16_t, WS_O) + row * D + h * 64 + dq) = w;
    }
}
__device__ __forceinline__ void ph_vtrans(const P& p, unsigned char* smem) {
    bf16_t* vt = (bf16_t*)smem;
    const int tid = tidx(); const bf16_t* PR = WSP(bf16_t, WS_PROJ);
    for (int u = blockIdx.x; u < PB * 4 * (T / 256); u += gridDim.x) {
        const int tile = u % (T / 256), bh = u / (T / 256), h = bh & 3, b = bh >> 2;
        __syncthreads();
#pragma unroll
        for (int k = 0; k < 4; ++k) { const int ch = tid + NTHR * k, t = ch >> 3, d8 = (ch & 7) * 8;
            *(u32x4*)(vt + t * 72 + d8) = *(const u32x4*)(PR + (size_t)(b * T + tile * 256 + t) * NPROJ + C_VA + h * 64 + d8); }
        __syncthreads();
#pragma unroll
        for (int k = 0; k < 4; ++k) { const int ch = tid + NTHR * k;
            { const int d = ch >> 5, t0 = (ch & 31) * 8; u32x4 w;
              w.x = (unsigned)vt[(t0 + 0) * 72 + d] | ((unsigned)vt[(t0 + 1) * 72 + d] << 16); w.y = (unsigned)vt[(t0 + 2) * 72 + d] | ((unsigned)vt[(t0 + 3) * 72 + d] << 16);
              w.z = (unsigned)vt[(t0 + 4) * 72 + d] | ((unsigned)vt[(t0 + 5) * 72 + d] << 16); w.w = (unsigned)vt[(t0 + 6) * 72 + d] | ((unsigned)vt[(t0 + 7) * 72 + d] << 16);
              *(u32x4*)(WSP(bf16_t, WS_VT1) + ((size_t)bh * 64 + d) * T + tile * 256 + t0) = w; }
            { const int r = ch >> 9, d = (ch >> 3) & 63, s0 = (ch & 7) * 8; u32x4 w;
#define VT4E(e_) ((unsigned)vt[(4 * (s0 + (e_)) + r) * 72 + d])
              w.x = VT4E(0) | (VT4E(1) << 16); w.y = VT4E(2) | (VT4E(3) << 16); w.z = VT4E(4) | (VT4E(5) << 16); w.w = VT4E(6) | (VT4E(7) << 16);
#undef VT4E
              *(u32x4*)(WSP(bf16_t, WS_VT4) + ((size_t)(bh * 4 + r) * 64 + d) * (T / 4) + tile * 64 + s0) = w; }
            { const int r = ch >> 7, d = (ch >> 1) & 63, s0 = (ch & 1) * 8; u32x4 w;
#define VT16E(e_) ((unsigned)vt[(16 * (s0 + (e_)) + r) * 72 + d])
              w.x = VT16E(0) | (VT16E(1) << 16); w.y = VT16E(2) | (VT16E(3) << 16); w.z = VT16E(4) | (VT16E(5) << 16); w.w = VT16E(6) | (VT16E(7) << 16);
#undef VT16E
              *(u32x4*)(WSP(bf16_t, WS_VT16) + ((size_t)(bh * 16 + r) * 64 + d) * (T / 16) + tile * 16 + s0) = w; }
        }
    }
}

__device__ __forceinline__ float ret_lg(int h) { return logf(1.0f - exp2f(-5.0f - (float)h)); }
__device__ __forceinline__ void ph_ret_local(const P& p, int l, unsigned char* smem) {
    float* ks = (float*)smem; float* vs = ks + 64 * 64; const int tid = tidx(); const bf16_t* PR = WSP(bf16_t, WS_PROJ);
    for (int u = blockIdx.x; u < NUNIT; u += gridDim.x) {
        const int n = u % NCH, h = (u / NCH) % 4, b = u / (NCH * 4); const float lg = ret_lg(h);
        __syncthreads();
        for (int e = tid; e < 4096; e += NTHR) { const int j = e >> 6, d = e & 63; const size_t row = (size_t)(b * T + n * 64 + j) * NPROJ;
            ks[e] = bf2f(PR[row + C_KR + h * 64 + d]) * expf(lg * (float)(63 - j)); vs[e] = bf2f(PR[row + C_VR + h * 64 + d]); }
        __syncthreads();
        const int d = tid >> 3, e0 = (tid & 7) * 8; float acc[8];
#pragma unroll
        for (int i = 0; i < 8; ++i) acc[i] = 0.f;
        for (int j = 0; j < 64; ++j) { const float kd = ks[j * 64 + d];
#pragma unroll
            for (int i = 0; i < 8; ++i) acc[i] += kd * vs[j * 64 + e0 + i]; }
        float* U = WSP(float, WS_RU) + (size_t)u * 4096 + d * 64 + e0;
#pragma unroll
        for (int i = 0; i < 8; ++i) U[i] = acc[i];
    }
}
__device__ __forceinline__ void ph_ret_scan(const P& p, int l) {
    const int gt = blockIdx.x * NTHR + tidx(), ng = gridDim.x * NTHR;
    for (int e = gt; e < PB * 4 * 4096; e += ng) {
        const int bh = e >> 12, de = e & 4095, h = bh & 3; const float cd = expf(ret_lg(h) * 64.0f);
        const float* U = WSP(float, WS_RU) + (size_t)bh * NCH * 4096 + de; float* SPv = WSP(float, WS_RS) + (size_t)bh * NCH * 4096 + de;
        float s = 0.f;
        for (int n = 0; n < NCH; ++n) { SPv[(size_t)n * 4096] = s; s = s * cd + U[(size_t)n * 4096]; }
        p.out[O_PRET + ((size_t)l * PB * 4 + bh) * 4096 + de] = s;
    }
}
__device__ __forceinline__ void ph_ret_out(const P& p, int l, unsigned char* smem) {
    float* qs = (float*)smem; float* ks = qs + 64 * 65; float* vs = ks + 64 * 65; float* ss = vs + 64 * 65; float* as = ss + 64 * 65;
    const int tid = tidx(); const bf16_t* PR = WSP(bf16_t, WS_PROJ);
    for (int u = blockIdx.x; u < NUNIT; u += gridDim.x) {
        const int n = u % NCH, h = (u / NCH) % 4, b = u / (NCH * 4); const float lg = ret_lg(h);
        __syncthreads();
        for (int e = tid; e < 4096; e += NTHR) { const int j = e >> 6, d = e & 63; const size_t row = (size_t)(b * T + n * 64 + j) * NPROJ;
            qs[j * 65 + d] = bf2f(PR[row + C_QR + h * 64 + d]); ks[j * 65 + d] = bf2f(PR[row + C_KR + h * 64 + d]); vs[j * 65 + d] = bf2f(PR[row + C_VR + h * 64 + d]);
            ss[j * 65 + d] = WSP(float, WS_RS)[(size_t)u * 4096 + e]; }
        __syncthreads();
        const int i = tid >> 3, c0 = (tid & 7) * 8;
#pragma unroll
        for (int jj = 0; jj < 8; ++jj) { const int j = c0 + jj; float a = 0.f;
            if (j <= i) { for (int d = 0; d < 64; ++d) a += qs[i * 65 + d] * ks[j * 65 + d]; a *= expf(lg * (float)(i - j)); }
            as[i * 65 + j] = a; }
        __syncthreads();
        float o[8]; float o2[8];
#pragma unroll
        for (int e = 0; e < 8; ++e) { o[e] = 0.f; o2[e] = 0.f; }
        for (int j = 0; j < 64; ++j) { const float a = as[i * 65 + j], qd = qs[i * 65 + j];
#pragma unroll
            for (int e = 0; e < 8; ++e) { o[e] += a * vs[j * 65 + c0 + e]; o2[e] += qd * ss[j * 65 + c0 + e]; } }
        const float qdec = expf(lg * (float)(i + 1)); float sq = 0.f;
#pragma unroll
        for (int e = 0; e < 8; ++e) { o[e] += o2[e] * qdec; sq += o[e] * o[e]; }
        sq += __shfl_xor(sq, 1); sq += __shfl_xor(sq, 2); sq += __shfl_xor(sq, 4);
        const float rstd = 1.0f / sqrtf(sq * (1.0f / 64.0f) + EPS);
        const size_t row = (size_t)(b * T + n * 64 + i);
#pragma unroll
        for (int e = 0; e < 8; ++e) { const float g = bf2f(PR[row * NPROJ + C_GR + h * 64 + c0 + e]);
            WSP(bf16_t, WS_O)[row * D + 256 + h * 64 + c0 + e] = f2bf(o[e] * rstd * p.ret_norm[l * 64 + c0 + e] * silu_f(g)); }
    }
}
__device__ __forceinline__ void ph_ret_sample(const P& p, int l, unsigned char* smem) {
    float* S0 = (float*)smem; float* qs = S0 + 4096; float* ks = qs + 8 * 64; float* vs = ks + 8 * 64;
    const int tid = tidx(); const bf16_t* PR = WSP(bf16_t, WS_PROJ);
    for (int u = blockIdx.x; u < DB * 4; u += gridDim.x) {
        const int h = u & 3, b = u >> 2; const float lg = ret_lg(h);
        __syncthreads();
        for (int e = tid; e < 4096; e += NTHR) S0[e] = p.state_ret[(((size_t)l * DB + b) * 4 + h) * 4096 + e];
        { const int j = tid >> 6, d = tid & 63; const size_t row = (size_t)(MP + b * DS + j) * NPROJ;
          qs[tid] = bf2f(PR[row + C_QR + h * 64 + d]); ks[tid] = bf2f(PR[row + C_KR + h * 64 + d]); vs[tid] = bf2f(PR[row + C_VR + h * 64 + d]); }
        __syncthreads();
        { const int i = tid >> 6, e = tid & 63; float o = 0.f;
          for (int j = 0; j <= i; ++j) { float a = 0.f; for (int d = 0; d < 64; ++d) a += qs[i * 64 + d] * ks[j * 64 + d]; o += a * expf(lg * (float)(i - j)) * vs[j * 64 + e]; }
          float o2 = 0.f; for (int d = 0; d < 64; ++d) o2 += qs[i * 64 + d] * S0[d * 64 + e];
          o += o2 * expf(lg * (float)(i + 1));
          const float rstd = 1.0f / sqrtf(wave_sum(o * o) * (1.0f / 64.0f) + EPS);
          const size_t row = (size_t)(MP + b * DS + i); const float g = bf2f(PR[row * NPROJ + C_GR + h * 64 + e]);
          WSP(bf16_t, WS_O)[row * D + 256 + h * 64 + e] = f2bf(o * rstd * p.ret_norm[l * 64 + e] * silu_f(g)); }
        for (int x = tid; x < 4096; x += NTHR) { const int d = x >> 6, e = x & 63; float s = S0[x] * expf(lg * (float)DS);
            for (int j = 0; j < DS; ++j) s += ks[j * 64 + d] * expf(lg * (float)(DS - 1 - j)) * vs[j * 64 + e];
            p.out[O_SRET + (((size_t)l * DB + b) * 4 + h) * 4096 + x] = s; }
    }
}

template <int CS, int LDL> __device__ __forceinline__ void fwd_subst(float (&X)[CS], const float* Ls) {
#pragma unroll
    for (int i = 1; i < CS; ++i) {
        float a = X[i];
#pragma unroll
        for (int j4 = 0; j4 < (i + 3) / 4; ++j4) { const f32x4 lv = *(const f32x4*)(Ls + i * LDL + 4 * j4);
#pragma unroll
            for (int e = 0; e < 4; ++e) if (4 * j4 + e < i) a -= lv[e] * X[4 * j4 + e]; }
        X[i] = a;
    }
}
constexpr int QP = 132;
__device__ __forceinline__ void ph_gdn_prep(const P& p, int l, unsigned char* smem) {
    float* Ls = (float*)smem; float* As = Ls + 64 * 68; float* gs = As + 64 * 68; float* gcs = gs + 64; float* bts = gcs + 64;
    float* qs = bts + 64; float* ks = qs + 64 * QP; float* vs = ks + 64 * QP;
    const int tid = tidx(); const bf16_t* PR = WSP(bf16_t, WS_PROJ);
    for (int u = blockIdx.x; u < NUNIT; u += gridDim.x) {
        const int n = u % NCH, h = (u / NCH) % 4, b = u / (NCH * 4);
        __syncthreads();
        if (tid < 384) { const int sec = tid >> 7, c = tid & 127, col = sec * 512 + h * 128 + c; float* dst = sec == 0 ? qs : sec == 1 ? ks : vs;
            const float w0 = p.conv_w[(l * 4 + 0) * 1536 + col], w1 = p.conv_w[(l * 4 + 1) * 1536 + col], w2 = p.conv_w[(l * 4 + 2) * 1536 + col], w3 = p.conv_w[(l * 4 + 3) * 1536 + col];
            const int t0 = n * 64; const bf16_t* src = PR + (size_t)(b * T) * NPROJ + C_CONV + col;
            float x0 = t0 >= 3 ? bf2f(src[(size_t)(t0 - 3) * NPROJ]) : 0.f, x1 = t0 >= 2 ? bf2f(src[(size_t)(t0 - 2) * NPROJ]) : 0.f, x2 = t0 >= 1 ? bf2f(src[(size_t)(t0 - 1) * NPROJ]) : 0.f;
            const bf16_t* sp = src + (size_t)t0 * NPROJ; float* dp = dst + c;
#pragma unroll 4
            for (int i = 0; i < 64; ++i) { const float x3 = bf2f(*sp); const float y = w0 * x0 + w1 * x1 + w2 * x2 + w3 * x3; *dp = silu_f(y); x0 = x1; x1 = x2; x2 = x3; sp += NPROJ; dp += QP; } }
        else if (tid < 448) { const int i = tid - 384; const size_t row = (size_t)(b * T + n * 64 + i); gs[i] = WSP(float, WS_G)[row * 4 + h]; bts[i] = WSP(float, WS_BETA)[row * 4 + h]; }
        __syncthreads();
        { const int rid = tid >> 2, part = tid & 3; float* rowp = (rid < 64 ? qs + rid * QP : ks + (rid - 64) * QP) + part * 32; float s = 0.f;
          for (int d = 0; d < 32; ++d) s += rowp[d] * rowp[d];
          s += __shfl_xor(s, 1); s += __shfl_xor(s, 2); const float sc = 1.0f / sqrtf(s + EPS);
          for (int d = 0; d < 32; ++d) rowp[d] *= sc; }
        if (tid == 0) { float a = 0.f; for (int i = 0; i < 64; ++i) { a += gs[i]; gcs[i] = a; } }
        __syncthreads();
        { const int i = tid >> 3, j0 = (tid & 7) * 8;
#pragma unroll
          for (int jj = 0; jj < 8; ++jj) { const int j = j0 + jj; float lv = 0.f, av = 0.f;
              if (j <= i) { float dk = 0.f, dq = 0.f; for (int d = 0; d < 128; ++d) { const float kj = ks[j * QP + d]; dk += ks[i * QP + d] * kj; dq += qs[i * QP + d] * kj; }
                  const float e = expf(gcs[i] - gcs[j]); av = dq * e * 0.08838834764831845f; lv = j < i ? bts[i] * dk * e : 0.f; }
              Ls[i * 68 + j] = lv; As[i * 68 + j] = av; } }
        __syncthreads();
        if (tid < 256) { const int c = tid; float X[64];
            if (c < 128) {
#pragma unroll
                for (int i = 0; i < 64; ++i) X[i] = vs[i * QP + c] * bts[i]; }
            else {
#pragma unroll
                for (int i = 0; i < 64; ++i) X[i] = ks[i * QP + c - 128] * bts[i] * expf(gcs[i]); }
            fwd_subst<64, 68>(X, Ls);
            if (c < 128) { float* U = WSP(float, WS_GU) + (size_t)u * 8192 + c;
#pragma unroll
                for (int i = 0; i < 64; ++i) U[i * 128] = X[i]; }
            else { bf16_t* W = WSP(bf16_t, WS_GW) + (size_t)u * 8192 + c - 128;
#pragma unroll
                for (int i = 0; i < 64; ++i) W[i * 128] = f2bf(X[i]); }
        } else { const int t2 = tid - 256; const float gl = gcs[63];
#pragma unroll 2
            for (int e = t2; e < 8192; e += 256) { const int i = e >> 7, d = e & 127;
                WSP(bf16_t, WS_GQ)[(size_t)u * 8192 + e] = f2bf(qs[i * QP + d] * 0.08838834764831845f * expf(gcs[i]));
                WSP(bf16_t, WS_GK)[(size_t)u * 8192 + e] = f2bf(ks[i * QP + d] * expf(gl - gcs[i])); }
#pragma unroll 2
            for (int e = t2; e < 4096; e += 256) WSP(bf16_t, WS_GA)[(size_t)u * 4096 + e] = f2bf(As[(e >> 6) * 68 + (e & 63)]);
            if (t2 == 0) WSP(float, WS_GD)[u] = expf(gl); }
    }
}
__device__ __forceinline__ void ph_gdn_chain(const P& p, int l, unsigned char* smem) {
    float* Ss = (float*)smem; float* Ws = Ss + 128 * 32; float* Ks = Ws + 64 * 128; float* vn = Ks + 64 * 128;
    const int tid = tidx();
    for (int it = blockIdx.x; it < PB * 4 * 4; it += gridDim.x) {
        const int sl = it & 3, bh = it >> 2;
        __syncthreads();
        for (int e = tid; e < 4096; e += NTHR) Ss[e] = 0.f;
        for (int n = 0; n < NCH; ++n) {
            const int u = bh * NCH + n;
            __syncthreads();
            { const bf16_t* W = WSP(bf16_t, WS_GW) + (size_t)u * 8192; const bf16_t* K = WSP(bf16_t, WS_GK) + (size_t)u * 8192;
              for (int e = tid; e < 1024; e += NTHR) { const bf16x8 wv = *(const bf16x8*)(W + 8 * e), kv = *(const bf16x8*)(K + 8 * e);
#pragma unroll
                  for (int x = 0; x < 8; ++x) { Ws[8 * e + x] = bf2f((bf16_t)wv[x]); Ks[8 * e + x] = bf2f((bf16_t)kv[x]); } }
              float* SPo = WSP(float, WS_GS) + (size_t)u * 16384 + sl * 32;
              for (int e = tid; e < 4096; e += NTHR) SPo[(e >> 5) * 128 + (e & 31)] = Ss[e]; }
            __syncthreads();
            { const int i = tid >> 3, c0 = (tid & 7) * 4; f32x4 a = *(const f32x4*)(WSP(float, WS_GU) + (size_t)u * 8192 + i * 128 + sl * 32 + c0);
              for (int d = 0; d < 128; ++d) { const float w = Ws[i * 128 + d]; a -= w * *(const f32x4*)(Ss + d * 32 + c0); }
              *(f32x4*)(vn + i * 32 + c0) = a; *(f32x4*)(WSP(float, WS_GV) + (size_t)u * 8192 + i * 128 + sl * 32 + c0) = a; }
            __syncthreads();
            { const int d = tid >> 2, c0 = (tid & 3) * 8; const float dec = WSP(float, WS_GD)[u];
              f32x4 a0 = *(const f32x4*)(Ss + d * 32 + c0) * dec, a1 = *(const f32x4*)(Ss + d * 32 + c0 + 4) * dec;
              for (int i = 0; i < 64; ++i) { const float kd = Ks[i * 128 + d]; a0 += kd * *(const f32x4*)(vn + i * 32 + c0); a1 += kd * *(const f32x4*)(vn + i * 32 + c0 + 4); }
              *(f32x4*)(Ss + d * 32 + c0) = a0; *(f32x4*)(Ss + d * 32 + c0 + 4) = a1; }
        }
        __syncthreads();
        { float* o = p.out + O_PGDN + ((size_t)l * PB * 4 + bh) * 16384 + sl * 32;
          for (int e = tid; e < 4096; e += NTHR) o[(e >> 5) * 128 + (e & 31)] = Ss[e]; }
    }
}
__device__ __forceinline__ void ph_gdn_out(const P& p, int l, unsigned char* smem) {
    float* SPs = (float*)smem; float* VNs = SPs + 128 * 128; bf16_t* QGs = (bf16_t*)(VNs + 64 * 128); bf16_t* ATs = QGs + 64 * 128;
    const int tid = tidx(); const bf16_t* PR = WSP(bf16_t, WS_PROJ);
    for (int u = blockIdx.x; u < NUNIT; u += gridDim.x) {
        const int n = u % NCH, h = (u / NCH) % 4, b = u / (NCH * 4);
        __syncthreads();
        { const f32x4* s = (const f32x4*)(WSP(float, WS_GS) + (size_t)u * 16384); for (int e = tid; e < 4096; e += NTHR) ((f32x4*)SPs)[e] = s[e];
          const f32x4* v = (const f32x4*)(WSP(float, WS_GV) + (size_t)u * 8192); for (int e = tid; e < 2048; e += NTHR) ((f32x4*)VNs)[e] = v[e];
          const u32x4* q = (const u32x4*)(WSP(bf16_t, WS_GQ) + (size_t)u * 8192); for (int e = tid; e < 1024; e += NTHR) ((u32x4*)QGs)[e] = q[e];
          const u32x4* a = (const u32x4*)(WSP(bf16_t, WS_GA) + (size_t)u * 4096); for (int e = tid; e < 512; e += NTHR) ((u32x4*)ATs)[e] = a[e]; }
        __syncthreads();
        const int i = tid >> 3, cg = tid & 7; f32x4 o[4];
#pragma unroll
        for (int k = 0; k < 4; ++k) o[k] = (f32x4){0.f, 0.f, 0.f, 0.f};
        for (int d = 0; d < 128; ++d) { const float qg = bf2f(QGs[i * 128 + d]);
#pragma unroll
            for (int k = 0; k < 4; ++k) o[k] += qg * *(const f32x4*)(SPs + d * 128 + 32 * k + 4 * cg); }
        for (int j = 0; j < 64; ++j) { const float a = bf2f(ATs[i * 64 + j]);
#pragma unroll
            for (int k = 0; k < 4; ++k) o[k] += a * *(const f32x4*)(VNs + j * 128 + 32 * k + 4 * cg); }
        float sq = 0.f;
#pragma unroll
        for (int k = 0; k < 4; ++k) sq += (o[k][0] * o[k][0] + o[k][1] * o[k][1]) + (o[k][2] * o[k][2] + o[k][3] * o[k][3]);
        sq += __shfl_xor(sq, 1); sq += __shfl_xor(sq, 2); sq += __shfl_xor(sq, 4);
        const float rstd = 1.0f / sqrtf(sq * (1.0f / 128.0f) + EPS);
        const size_t row = (size_t)(b * T + n * 64 + i);
#pragma unroll
        for (int k = 0; k < 4; ++k)
#pragma unroll
            for (int e = 0; e < 4; ++e) { const int c = 32 * k + 4 * cg + e; const float z = bf2f(PR[row * NPROJ + C_Z + h * 128 + c]);
                WSP(bf16_t, WS_O)[row * D + 512 + h * 128 + c] = f2bf(o[k][e] * rstd * p.gdn_norm[l * 128 + c] * silu_f(z)); }
    }
}
__device__ __forceinline__ void ph_gdn_sample(const P& p, int l, unsigned char* smem) {
    float* qs = (float*)smem; float* ks = qs + 8 * QP; float* vs = ks + 8 * QP; float* us = vs + 8 * QP; float* wsm = us + 8 * 128; float* vn = wsm + 8 * 128;
    float* Ls = vn + 8 * 128; float* As = Ls + 8 * 8; float* gs = As + 8 * 8; float* gcs = gs + 8; float* bts = gcs + 8; float* S0 = bts + 8;
    const int tid = tidx(); const bf16_t* PR = WSP(bf16_t, WS_PROJ);
    for (int u = blockIdx.x; u < DB * 4; u += gridDim.x) {
        const int h = u & 3, b = u >> 2;
        __syncthreads();
#pragma unroll 4
        for (int e = tid; e < 16384; e += NTHR) S0[e] = p.state_gdn[(((size_t)l * DB + b) * 4 + h) * 16384 + e];
        if (tid < 384) { const int sec = tid >> 7, c = tid & 127, col = sec * 512 + h * 128 + c; float* dst = sec == 0 ? qs : sec == 1 ? ks : vs;
            const float w0 = p.conv_w[(l * 4 + 0) * 1536 + col], w1 = p.conv_w[(l * 4 + 1) * 1536 + col], w2 = p.conv_w[(l * 4 + 2) * 1536 + col], w3 = p.conv_w[(l * 4 + 3) * 1536 + col];
            const float* hist = p.state_conv + (((size_t)l * DB + b) * 3) * 1536 + col; const bf16_t* src = PR + (size_t)(MP + b * DS) * NPROJ + C_CONV + col;
            float x0 = hist[0], x1 = hist[1536], x2 = hist[2 * 1536];
            for (int i = 0; i < DS; ++i) { const float x3 = bf2f(src[(size_t)i * NPROJ]); const float y = w0 * x0 + w1 * x1 + w2 * x2 + w3 * x3; dst[i * QP + c] = silu_f(y); x0 = x1; x1 = x2; x2 = x3; } }
        else if (tid < 384 + DS) { const int i = tid - 384; const size_t row = (size_t)(MP + b * DS + i); gs[i] = WSP(float, WS_G)[row * 4 + h]; bts[i] = WSP(float, WS_BETA)[row * 4 + h]; }
        __syncthreads();
        if (tid < 64) { const int rid = tid >> 2, part = tid & 3; float* rowp = (rid < 8 ? qs + rid * QP : ks + (rid - 8) * QP) + part * 32; float s = 0.f;
            for (int d = 0; d < 32; ++d) s += rowp[d] * rowp[d];
            s += __shfl_xor(s, 1); s += __shfl_xor(s, 2); const float sc = 1.0f / sqrtf(s + EPS);
            for (int d = 0; d < 32; ++d) rowp[d] *= sc; }
        if (tid == 64) { float a = 0.f; for (int i = 0; i < DS; ++i) { a += gs[i]; gcs[i] = a; } }
        __syncthreads();
        if (tid < 64) { const int i = tid >> 3, j = tid & 7; float lv = 0.f, av = 0.f;
            if (j <= i) { float dk = 0.f, dq = 0.f; for (int d = 0; d < 128; ++d) { const float kj = ks[j * QP + d]; dk += ks[i * QP + d] * kj; dq += qs[i * QP + d] * kj; }
                const float e = expf(gcs[i] - gcs[j]); av = dq * e * 0.08838834764831845f; lv = j < i ? bts[i] * dk * e : 0.f; }
            Ls[i * 8 + j] = lv; As[i * 8 + j] = av; }
        __syncthreads();
        if (tid < 256) { const int c = tid; float X[8];
            if (c < 128) {
#pragma unroll
                for (int i = 0; i < 8; ++i) X[i] = vs[i * QP + c] * bts[i]; }
            else {
#pragma unroll
                for (int i = 0; i < 8; ++i) X[i] = ks[i * QP + c - 128] * bts[i] * expf(gcs[i]); }
            fwd_subst<8, 8>(X, Ls);
            float* dst = c < 128 ? us + c : wsm + c - 128;
#pragma unroll
            for (int i = 0; i < 8; ++i) dst[i * 128] = X[i]; }
        __syncthreads();
        const int i = tid >> 6, c2 = (tid & 63) * 2;
        { float a0 = us[i * 128 + c2], a1 = us[i * 128 + c2 + 1];
          for (int d = 0; d < 128; ++d) { const float w = wsm[i * 128 + d]; a0 -= w * S0[d * 128 + c2]; a1 -= w * S0[d * 128 + c2 + 1]; }
          vn[i * 128 + c2] = a0; vn[i * 128 + c2 + 1] = a1; }
        __syncthreads();
        { float o0 = 0.f, o1 = 0.f; const float qsc = 0.08838834764831845f * expf(gcs[i]);
          for (int d = 0; d < 128; ++d) { const float qg = qs[i * QP + d] * qsc; o0 += qg * S0[d * 128 + c2]; o1 += qg * S0[d * 128 + c2 + 1]; }
          for (int j = 0; j < DS; ++j) { const float a = As[i * 8 + j]; o0 += a * vn[j * 128 + c2]; o1 += a * vn[j * 128 + c2 + 1]; }
          const float rstd = 1.0f / sqrtf(wave_sum(o0 * o0 + o1 * o1) * (1.0f / 128.0f) + EPS);
          const size_t row = (size_t)(MP + b * DS + i);
          const float z0 = bf2f(PR[row * NPROJ + C_Z + h * 128 + c2]), z1 = bf2f(PR[row * NPROJ + C_Z + h * 128 + c2 + 1]);
          bf16_t* O = WSP(bf16_t, WS_O) + row * D + 512 + h * 128 + c2;
          O[0] = f2bf(o0 * rstd * p.gdn_norm[l * 128 + c2] * silu_f(z0)); O[1] = f2bf(o1 * rstd * p.gdn_norm[l * 128 + c2 + 1] * silu_f(z1)); }
        { const float gl = gcs[DS - 1], dec = expf(gl); float* o = p.out + O_SGDN + (((size_t)l * DB + b) * 4 + h) * 16384;
#pragma unroll 2
          for (int e = tid; e < 16384; e += NTHR) { const int d = e >> 7, c = e & 127; float s = S0[e] * dec;
              for (int j = 0; j < DS; ++j) s += ks[j * QP + d] * expf(gl - gcs[j]) * vn[j * 128 + c];
              o[e] = s; } }
    }
}

__device__ __forceinline__ void ph_final_norm(const P& p) {
    const int lane = tidx() & 63, wave = tidx() >> 6, gw = blockIdx.x * 8 + wave, ngw = gridDim.x * 8;
    for (int r = gw; r < M; r += ngw) {
        float* xr = p.out + (size_t)r * D; f32x4 v[4]; float ss = 0.f;
#pragma unroll
        for (int j = 0; j < 4; ++j) { v[j] = *(const f32x4*)(xr + 4 * lane + 256 * j); ss += (v[j][0] * v[j][0] + v[j][1] * v[j][1]) + (v[j][2] * v[j][2] + v[j][3] * v[j][3]); }
        const float rstd = 1.0f / sqrtf(wave_sum(ss) * (1.0f / D) + EPS);
#pragma unroll
        for (int j = 0; j < 4; ++j) { const f32x4 g = *(const f32x4*)(p.final_norm + 4 * lane + 256 * j); *(f32x4*)(xr + 4 * lane + 256 * j) = v[j] * rstd * g; }
    }
}

enum Phase { PH_PRO = 0, PH_NORM1, PH_GEMM_IN, PH_ROPE, PH_MIX1, PH_MIX2, PH_MIX3, PH_GEMM_OUT, PH_NORM2, PH_GEMM_GU, PH_GEMM_DN, PH_FINAL };
#ifdef __HIP_EMU__
#define LDSP(x) (x)
#else
#define LDSP(x) ((PG8_LAS unsigned char*)(x))
#endif
template <int PH> __device__ __forceinline__ void run_phase(const P& p, int l, unsigned char* smem) {
    if constexpr (PH == PH_PRO) { ph_convert(p, smem); __syncthreads(); ph_adaln(p, smem); ph_ropetab_copyx(p); }
    else if constexpr (PH == PH_NORM1) ph_norm_mod<0>(p, l);
    else if constexpr (PH == PH_GEMM_IN) {
        pg8::Gemm g{WSP(bf16_t, WS_H), WSP(bf16_t, WS_WIN) + (size_t)l * NPROJ * D, MPAD, NPROJ, D}; pg8::StaticOrder S; S.init(MPAD, NPROJ, (int)gridDim.x, (int)blockIdx.x);
        pg8::EpiStoreBf16 E{WSP(bf16_t, WS_PROJ), NPROJ};
        pg8::gemm_phase<pg8::EpiStoreBf16, pg8::StaticOrder, true, true>(LDSP(smem), g, S, E);
    }
    else if constexpr (PH == PH_ROPE) { ph_rope_out(p, l); ph_vtrans(p, smem); }
    else if constexpr (PH == PH_MIX1) { ph_attn_jobs(p); __syncthreads(); ph_attn_sample(p, l, smem); ph_ret_local(p, l, smem); ph_gdn_prep(p, l, smem); ph_ret_sample(p, l, smem); ph_gdn_sample(p, l, smem); }
    else if constexpr (PH == PH_MIX2) { ph_gdn_chain(p, l, smem); ph_ret_scan(p, l); ph_attn_combine(p); }
    else if constexpr (PH == PH_MIX3) { ph_ret_out(p, l, smem); ph_gdn_out(p, l, smem); }
    else if constexpr (PH == PH_GEMM_OUT) {
        pg8::Gemm g{WSP(bf16_t, WS_O), WSP(bf16_t, WS_WOUT) + (size_t)l * D * D, MPAD, D, D}; pg8::StaticOrder S; S.init(MPAD, D, (int)gridDim.x, (int)blockIdx.x);
        pg8::EpiResidual E{p.out, WSP(float, WS_MOD) + (size_t)l * NC * 6144 + 2048};
        pg8::gemm_phase<pg8::EpiResidual, pg8::StaticOrder, true, true>(LDSP(smem), g, S, E);
    }
    else if constexpr (PH == PH_NORM2) ph_norm_mod<1>(p, l);
    else if constexpr (PH == PH_GEMM_GU) {
        pg8::Gemm g{WSP(bf16_t, WS_H), WSP(bf16_t, WS_WGU) + (size_t)l * 2 * FF * D, MPAD, 2 * FF, D}; pg8::StaticOrder S; S.init(MPAD, 2 * FF, (int)gridDim.x, (int)blockIdx.x);
        pg8::EpiSwiglu E{WSP(bf16_t, WS_HID)};
        pg8::gemm_phase<pg8::EpiSwiglu, pg8::StaticOrder, true, true>(LDSP(smem), g, S, E);
    }
    else if constexpr (PH == PH_GEMM_DN) {
        pg8::Gemm g{WSP(bf16_t, WS_HID), WSP(bf16_t, WS_WDN) + (size_t)l * D * FF, MPAD, D, FF}; pg8::StaticOrder S; S.init(MPAD, D, (int)gridDim.x, (int)blockIdx.x);
        pg8::EpiResidual E{p.out, WSP(float, WS_MOD) + (size_t)l * NC * 6144 + 5120};
        pg8::gemm_phase<pg8::EpiResidual, pg8::StaticOrder, true, true>(LDSP(smem), g, S, E);
    }
    else if constexpr (PH == PH_FINAL) ph_final_norm(p);
}
template <int PH> __global__ void __launch_bounds__(NTHR, 2) k_phase(P p, int l) { DYN_SMEM(smem); run_phase<PH>(p, l, smem); }


#ifndef __HIP_EMU__
#define LAS __attribute__((address_space(3)))
#define XB_TMO      128
#define XB_XCNT(j)  (256  + 64 * (j))
#define XB_XSUB(j)  (1280 + 64 * (j))
#define XB_XGEN(j)  (2304 + 64 * (j))
#define XB_TOP      3328
#define XB_TOPGEN   3392
#define XCD_BAR_WORDS 3456
#define XB_SPIN_CAP (1u << 18)

__device__ __forceinline__ unsigned xb_ld(unsigned* p)              { return __hip_atomic_load(p, __ATOMIC_RELAXED, __HIP_MEMORY_SCOPE_AGENT); }
__device__ __forceinline__ unsigned xb_add(unsigned* p, unsigned v) { return __hip_atomic_fetch_add(p, v, __ATOMIC_RELAXED, __HIP_MEMORY_SCOPE_AGENT); }
__device__ __forceinline__ unsigned xb_xcc_id() { return (unsigned)__builtin_amdgcn_s_getreg((3 << 11) | 20) & 0xFu; }
#define XB_SPIN(cond, bar) do { unsigned _sp = 0; while (cond) { __builtin_amdgcn_s_sleep(1); \
    if ((++_sp & 255u) == 0u) { if (xb_ld(&(bar)[XB_TMO])) break; if (_sp > XB_SPIN_CAP) { atomicAdd(&(bar)[XB_TMO], 1u); break; } } } } while (0)

struct XcdBarrier {
    unsigned* bar; unsigned x;
    volatile LAS unsigned* st;
};

__device__ __forceinline__ XcdBarrier xcd_barrier_post(unsigned* bar, volatile LAS unsigned* st) {
    XcdBarrier b; b.bar = bar; b.x = xb_xcc_id(); b.st = st;
    if (threadIdx.x == 0) (void)xb_add(&bar[XB_XCNT(b.x)], 1u);
    return b;
}
__device__ __forceinline__ void xcd_barrier_complete(unsigned* bar, unsigned x, unsigned& nloc, unsigned& nx) {
    const unsigned G = gridDim.x * gridDim.y * gridDim.z;
    unsigned sum, cnt, mine, sp = 0u;
    for (;;) {
        sum = 0u; cnt = 0u; mine = 0u;
#pragma unroll
        for (unsigned j = 0; j < 16; ++j) { const unsigned c = xb_ld(&bar[XB_XCNT(j)]); sum += c; cnt += (c > 0u) ? 1u : 0u; mine = (j == x) ? c : mine; }
        if (sum == G) break;
        __builtin_amdgcn_s_sleep(1);
        if ((++sp & 255u) == 0u) { if (xb_ld(&bar[XB_TMO])) break; if (sp > XB_SPIN_CAP) { atomicAdd(&bar[XB_TMO], 1u); break; } }
    }
    nloc = mine > 0u ? mine : 1u; nx = cnt > 0u ? cnt : 1u;
}

__device__ __forceinline__ void xcd_barrier(const XcdBarrier& b) {
    asm volatile("s_waitcnt vmcnt(0)" ::: "memory");
    __syncthreads();
    if (threadIdx.x == 0) {
        unsigned* bar = b.bar;
        __builtin_amdgcn_s_waitcnt(0);
        unsigned nloc = b.st[0], nx = b.st[1];
        if (nloc == 0u) { xcd_barrier_complete(bar, b.x, nloc, nx); b.st[0] = nloc; b.st[1] = nx; }
        const unsigned old = xb_add(&bar[XB_XSUB(b.x)], 1u);
        const unsigned gen = old / nloc;
        if (old + 1u == (gen + 1u) * nloc) {
            __builtin_amdgcn_fence(__ATOMIC_RELEASE, "agent");
            asm volatile("s_waitcnt vmcnt(0)" ::: "memory");
            const unsigned og = xb_add(&bar[XB_TOP], 1u);
            const unsigned tg = og / nx;
            if (og + 1u == (tg + 1u) * nx) xb_add(&bar[XB_TOPGEN], 1u);
            else XB_SPIN(xb_ld(&bar[XB_TOPGEN]) == tg, bar);
            __builtin_amdgcn_fence(__ATOMIC_ACQUIRE, "agent");
            xb_add(&bar[XB_XGEN(b.x)], 1u);
            asm volatile("s_waitcnt vmcnt(0)" ::: "memory");
        } else {
            XB_SPIN(xb_ld(&bar[XB_XGEN(b.x)]) == gen, bar);
            __builtin_amdgcn_fence(__ATOMIC_ACQUIRE, "agent");
            asm volatile("s_waitcnt vmcnt(0)" ::: "memory");
        }
    }
    __syncthreads();
}

#endif

#ifndef __HIP_EMU__
#define GRID_SYNC() xcd_barrier(bar)
__global__ void __launch_bounds__(NTHR, 2) k_mega(P p_arg) {
    DYN_SMEM(smem);
#if defined(__HIP_DEVICE_COMPILE__)
#define PHASE(PH_, l_) do { const __attribute__((address_space(4))) P* kp_ = (const __attribute__((address_space(4))) P*)__builtin_amdgcn_kernarg_segment_ptr(); LAUNDER_PTR(kp_); P pl_; __builtin_memcpy(&pl_, kp_, sizeof(P)); run_phase<PH_>(pl_, l_, smem); } while (0)
#else
#define PHASE(PH_, l_) run_phase<PH_>(p_arg, l_, smem)
#endif
    cooperative_groups::grid_group grid = cooperative_groups::this_grid();
    volatile LAS unsigned* bst = (volatile LAS unsigned*)((LAS unsigned char*)smem + BAR_LDS_OFF);
    if (threadIdx.x < 4) bst[threadIdx.x] = 0u;
    __syncthreads();
    XcdBarrier bar = xcd_barrier_post((unsigned*)(p_arg.ws + WS_CTL + 4096), bst);
    PHASE(PH_PRO, 0); grid.sync();
#define LAYER(l) do { PHASE(PH_NORM1, l); GRID_SYNC(); PHASE(PH_GEMM_IN, l); GRID_SYNC(); PHASE(PH_ROPE, l); GRID_SYNC(); PHASE(PH_MIX1, l); GRID_SYNC(); PHASE(PH_MIX2, l); GRID_SYNC(); \
        PHASE(PH_MIX3, l); GRID_SYNC(); PHASE(PH_GEMM_OUT, l); GRID_SYNC(); PHASE(PH_NORM2, l); GRID_SYNC(); PHASE(PH_GEMM_GU, l); GRID_SYNC(); PHASE(PH_GEMM_DN, l); GRID_SYNC(); } while (0)
    static_assert(NL == 2, "two layers written out (a loop over the layers makes hipcc hoist every phase's constants to the loop preheader and spill)");
    LAYER(0); LAYER(1);
    PHASE(PH_FINAL, 0);
}
#endif

template <int PH> static void launch_phase(const P& p, int l, int grid, hipStream_t stream) {
#ifndef __HIP_EMU__
    static bool attr_done = false;
    if (!attr_done) { (void)hipFuncSetAttribute((const void*)k_phase<PH>, hipFuncAttributeMaxDynamicSharedMemorySize, SMEM_BYTES); attr_done = true; }
#endif
    LAUNCH(k_phase<PH>, grid, SMEM_BYTES, stream, p, l);
}

extern "C" void kernel_launch(void* const* d_in, const int* in_sizes, int n_in, void* d_out, int out_size, void* d_ws, size_t ws_size, hipStream_t stream) {
    if (n_in != 24 || (size_t)out_size != O_END || ws_size < WS_END) {
        fprintf(stderr, "kernel_launch: shape mismatch: n_in %d out_size %d (want %zu) ws %zu (want %zu)\n", n_in, out_size, (size_t)O_END, ws_size, (size_t)WS_END); return; }
    P p{};
    const float** pp = (const float**)&p;
    for (int i = 0; i < 24; ++i) pp[i] = (const float*)d_in[i];
    p.out = (float*)d_out; p.ws = (unsigned char*)d_ws;
#ifndef __HIP_EMU__
    static int grid = 0;
    if (grid == 0) {
        int dev = 0, cus = 0, per_cu = 0;
        if (hipGetDevice(&dev) != hipSuccess || hipDeviceGetAttribute(&cus, hipDeviceAttributeMultiprocessorCount, dev) != hipSuccess || cus <= 0) { fprintf(stderr, "kernel_launch: device query failed\n"); grid = -1; return; }
        if (hipFuncSetAttribute((const void*)k_mega, hipFuncAttributeMaxDynamicSharedMemorySize, SMEM_BYTES) != hipSuccess) { fprintf(stderr, "kernel_launch: hipFuncSetAttribute failed\n"); grid = -1; return; }
        if (hipOccupancyMaxActiveBlocksPerMultiprocessor(&per_cu, (const void*)k_mega, NTHR, SMEM_BYTES) != hipSuccess || per_cu < 1) { fprintf(stderr, "kernel_launch: occupancy query says %d blocks per CU\n", per_cu); grid = -1; return; }
        grid = cus;
    }
    if (grid < 0) return;
    if (hipMemsetAsync((char*)d_ws + WS_CTL, 0, 65536, stream) != hipSuccess) { fprintf(stderr, "kernel_launch: memset of the barrier words failed\n"); return; }
    { void* args[] = {(void*)&p};
      hipError_t e = hipLaunchCooperativeKernel((const void*)k_mega, dim3(grid), dim3(NTHR), args, SMEM_BYTES, stream);
      if (e != hipSuccess) fprintf(stderr, "kernel_launch: cooperative launch failed: %s (grid %d)\n", hipGetErrorString(e), grid);
      return; }
#else
    int grid = 16;
#endif
    launch_phase<PH_PRO>(p, 0, grid, stream);
    for (int l = 0; l < NL; ++l) {
        launch_phase<PH_NORM1>(p, l, grid, stream);
        launch_phase<PH_GEMM_IN>(p, l, grid, stream);
        launch_phase<PH_ROPE>(p, l, grid, stream);
        launch_phase<PH_MIX1>(p, l, grid, stream);
        launch_phase<PH_MIX2>(p, l, grid, stream);
        launch_phase<PH_MIX3>(p, l, grid, stream);
        launch_phase<PH_GEMM_OUT>(p, l, grid, stream);
        launch_phase<PH_NORM2>(p, l, grid, stream);
        launch_phase<PH_GEMM_GU>(p, l, grid, stream);
        launch_phase<PH_GEMM_DN>(p, l, grid, stream);
    }
    launch_phase<PH_FINAL>(p, 0, grid, stream);
}
```

```cpp
#ifndef __HIP_EMU__
#include <hip/hip_runtime.h>
#include <hip/hip_cooperative_groups.h>
#endif
#include <cstdio>
#include <cstdint>
#include <cmath>

#ifndef CFG_BATCH
#define CFG_BATCH 2
#endif
#ifndef CFG_SEQ
#define CFG_SEQ 8192
#endif
#ifndef CFG_DB
#define CFG_DB 32
#endif
constexpr int D = 1024, NL = 2, PB = CFG_BATCH, T = CFG_SEQ, DB = CFG_DB, DS = 8, PAST = 16384, WB = 2048;
constexpr int MP = PB * T, MS = DB * DS, M = MP + MS, MPAD = (M + 255) / 256 * 256, NC = PB + DB;
constexpr int INC = 3848, NPROJ = 3840, FF = 2816, NCH = T / 64, PWIN = T < 2048 ? T : 2048, NPOS = T + DS;
constexpr int NUNIT = PB * 4 * NCH;
constexpr float EPS = 1e-6f;
constexpr float LOG2E = 1.4426950408889634f;
static_assert(T % 512 == 0, "the attention job decomposition wants T % 512 == 0");
constexpr int C_QA = 0, C_KA = 256, C_VA = 512, C_QR = 768, C_KR = 1024, C_VR = 1280, C_GR = 1536, C_CONV = 1792, C_Z = 3328;
constexpr int SMEM_BYTES = 147456;
constexpr int NTHR = 512;
constexpr int BAR_LDS_OFF = SMEM_BYTES - 64;

typedef unsigned short bf16_t;
typedef short bf16x8 __attribute__((ext_vector_type(8)));
typedef float f32x4 __attribute__((ext_vector_type(4)));
typedef unsigned u32x4 __attribute__((ext_vector_type(4)));
typedef unsigned u32x2 __attribute__((ext_vector_type(2)));
typedef float f32x16 __attribute__((ext_vector_type(16)));

#ifdef __HIP_EMU__
#define LAUNCH(kern, grid, lds, stream, ...) emu_launch(grid, NTHR, [=]() { kern(__VA_ARGS__); })
#define DYN_SMEM(name) unsigned char* name = emu_dyn_smem()
#define WAVE_SYNC() emu_wave_bar()
#define MFMA32(a, b, c) emu_mfma32(a, b, c)
#define GLDS16(gp, lp) memcpy((unsigned char*)(lp) + (threadIdx.x & 63) * 16, (gp), 16)
#define RAW_BARRIER() __syncthreads()
#define WAIT_VM(n)
#define WAIT_LGKM0()
#define LAS
#define UNIFORM(x) (x)
#define COMPILER_FENCE()
#define MFMA16(a, b, c) emu_mfma16(a, b, c)
#else
#define WAVE_SYNC() asm volatile("s_waitcnt lgkmcnt(0)" ::: "memory")
#define MFMA32(a, b, c) __builtin_amdgcn_mfma_f32_32x32x16_bf16(a, b, c, 0, 0, 0)
#define LAS __attribute__((address_space(3)))
#define GLDS16(gp, lp) __builtin_amdgcn_global_load_lds((const unsigned*)(gp), (LAS unsigned*)(lp), 16, 0, 0)
#define RAW_BARRIER() __builtin_amdgcn_s_barrier()
#define WAIT_VM(n) asm volatile("s_waitcnt vmcnt(" #n ")" ::: "memory")
#define WAIT_LGKM0() asm volatile("s_waitcnt lgkmcnt(0)" ::: "memory")
#define UNIFORM(x) __builtin_amdgcn_readfirstlane(x)
#define COMPILER_FENCE() __builtin_amdgcn_sched_barrier(0)
#define MFMA16(a, b, c) __builtin_amdgcn_mfma_f32_16x16x32_bf16(a, b, c, 0, 0, 0)
#define LAUNCH(kern, grid, lds, stream, ...) hipLaunchKernelGGL(kern, dim3(grid), dim3(NTHR), lds, stream, __VA_ARGS__)
#define DYN_SMEM(name) extern __shared__ __attribute__((aligned(16))) unsigned char name[]
#endif

#ifdef __HIP_EMU__
__device__ __forceinline__ int tidx() { return (int)threadIdx.x; }
#define LAUNDER_PTR(x)
#else
__device__ __forceinline__ int tidx() { int t = (int)threadIdx.x; asm volatile("" : "+v"(t)); return t; }
#define LAUNDER_PTR(x) asm volatile("" : "+s"(x))
#endif
__device__ __forceinline__ float bf2f(bf16_t v) { return __builtin_bit_cast(float, (unsigned)v << 16); }
__device__ __forceinline__ bf16_t f2bf(float f) { unsigned u = __builtin_bit_cast(unsigned, f); return (bf16_t)((u + 0x7fffu + ((u >> 16) & 1u)) >> 16); }
__device__ __forceinline__ unsigned pk2(float lo, float hi) { return (unsigned)f2bf(lo) | ((unsigned)f2bf(hi) << 16); }
__device__ __forceinline__ float silu_f(float x) { return x / (1.0f + expf(-x)); }
__device__ __forceinline__ float wave_sum(float v) {
#pragma unroll
    for (int o = 1; o < 64; o <<= 1) v += __shfl_xor(v, o);
    return v;
}
__device__ __forceinline__ float wave_max(float v) {
#pragma unroll
    for (int o = 1; o < 64; o <<= 1) v = fmaxf(v, __shfl_xor(v, o));
    return v;
}

struct P {
    const float *x_prompt, *x_sample, *cache_k, *cache_v, *state_ret, *state_gdn, *state_conv, *c_prompt, *c_sample, *ada_w, *ada_b, *norm_mix, *norm_ffn,
        *w_in, *ret_norm, *conv_w, *a_log, *dt_bias, *gdn_norm, *w_out, *w_gate, *w_up, *w_down, *final_norm;
    float* out; unsigned char* ws;
};

constexpr size_t O_YP = 0, O_YS = O_YP + (size_t)MP * D, O_PWK = O_YS + (size_t)MS * D, O_PWV = O_PWK + (size_t)NL * PB * PWIN * 256,
                 O_PRET = O_PWV + (size_t)NL * PB * PWIN * 256, O_PGDN = O_PRET + (size_t)NL * PB * 4 * 4096, O_PCONV = O_PGDN + (size_t)NL * PB * 4 * 16384,
                 O_SWK = O_PCONV + (size_t)NL * PB * 3 * 1536, O_SWV = O_SWK + (size_t)NL * DB * DS * 256, O_SRET = O_SWV + (size_t)NL * DB * DS * 256,
                 O_SGDN = O_SRET + (size_t)NL * DB * 4 * 4096, O_SCONV = O_SGDN + (size_t)NL * DB * 4 * 16384, O_END = O_SCONV + (size_t)NL * DB * 3 * 1536;

constexpr size_t al256(size_t x) { return (x + 255) / 256 * 256; }
constexpr size_t WS_CTL = 0, WS_CTL_BYTES = 1u << 20;
constexpr size_t WS_MOD = WS_CTL + WS_CTL_BYTES;
constexpr size_t WS_ROPE = al256(WS_MOD + (size_t)NL * NC * 6144 * 4);
constexpr size_t WS_WIN = al256(WS_ROPE + (size_t)4 * NPOS * 32 * 4);
constexpr size_t WS_WOUT = al256(WS_WIN + (size_t)NL * NPROJ * D * 2);
constexpr size_t WS_WGU = al256(WS_WOUT + (size_t)NL * D * D * 2);
constexpr size_t WS_WDN = al256(WS_WGU + (size_t)NL * 2 * FF * D * 2);
constexpr size_t WS_H = al256(WS_WDN + (size_t)NL * D * FF * 2);
constexpr size_t WS_PROJ = al256(WS_H + (size_t)MPAD * D * 2);
constexpr size_t WS_BETA = al256(WS_PROJ + (size_t)MPAD * NPROJ * 2);
constexpr size_t WS_G = al256(WS_BETA + (size_t)M * 4 * 4);
constexpr size_t WS_O = al256(WS_G + (size_t)M * 4 * 4);
constexpr size_t WS_RU = al256(WS_O + (size_t)MPAD * D * 2);
constexpr size_t WS_RS = al256(WS_RU + (size_t)NUNIT * 4096 * 4);
constexpr size_t WS_SCR = al256(WS_RS + (size_t)NUNIT * 4096 * 4);
constexpr size_t WS_GU = WS_SCR;
constexpr size_t WS_GWK = al256(WS_GU + (size_t)NUNIT * 8192 * 4);
constexpr size_t WS_GQ = al256(WS_GWK + (size_t)NUNIT * 16384 * 2);
constexpr size_t WS_GA = al256(WS_GQ + (size_t)NUNIT * 8192 * 2);
constexpr size_t WS_GD = al256(WS_GA + (size_t)NUNIT * 4096 * 2);
constexpr size_t WS_GV = al256(WS_GD + (size_t)NUNIT * 4);
constexpr size_t WS_GS = al256(WS_GV + (size_t)NUNIT * 8192 * 2);
constexpr size_t WS_GEND = al256(WS_GS + (size_t)NUNIT * 16384 * 2);
constexpr size_t WS_KH = WS_GEND;
constexpr size_t WS_VT1 = al256(WS_KH + (size_t)MP * 256 * 2);
constexpr size_t WS_VT4 = al256(WS_VT1 + (size_t)MP * 256 * 2);
constexpr size_t WS_VT16 = al256(WS_VT4 + (size_t)MP * 256 * 2);
constexpr size_t WS_AML = al256(WS_VT16 + (size_t)MP * 256 * 2);
constexpr size_t WS_AEND = al256(WS_AML + (size_t)MP * 4 * 3 * 2 * 4);
constexpr size_t WS_APO = WS_H;
static_assert((size_t)MP * 4 * 3 * 64 * 2 <= (size_t)MPAD * D * 2, "attention partials overlay H");
constexpr size_t WS_HID = WS_SCR;
constexpr size_t WS_HEND = al256(WS_HID + (size_t)MPAD * FF * 2);
constexpr size_t WS_END = WS_AEND > WS_HEND ? WS_AEND : WS_HEND;

#define WSP(T_, off) ((T_*)(p.ws + (off)))
__device__ __forceinline__ int row_cb(int r) { return r < MP ? r / T : PB + (r - MP) / DS; }
__device__ __forceinline__ int row_pi(int r) { return r < MP ? r % T : T + (r - MP) % DS; }
namespace pg8 {
#ifdef __HIP_EMU__
#define PG8_LAS
#else
#define PG8_LAS __attribute__((address_space(3)))
#endif
typedef unsigned short bf16_t;
typedef short bf16x8 __attribute__((ext_vector_type(8)));
typedef float f32x4 __attribute__((ext_vector_type(4)));
typedef unsigned u32x4 __attribute__((ext_vector_type(4)));
constexpr int BM = 256, BK = 64, HALF = 128, HTB = HALF * BK * 2  , STAGE_BYTES = 8 * HTB, NXCD = 8, WGM = 8;

__host__ __device__ __forceinline__ int lds_byte(int r, int c) { const int st = (r >> 4) * 2 + (c >> 5), rr = r & 15, cc = c & 31, ob = rr * 64 + cc * 2; return st * 1024 + (ob ^ (((ob >> 9) & 1) << 5)); }
__host__ __device__ __forceinline__ void stage_rc(int b, int& R, int& C) { const int st = b / 1024, sb = b % 1024, swz = sb ^ (((sb >> 9) & 1) << 5); R = (st >> 1) * 16 + swz / 64; C = (st & 1) * 32 + (swz % 64) / 2; }
__host__ __device__ __forceinline__ int perm32(int rho) { const int n = rho >> 4, i = rho & 15; return 8 * (i >> 2) + 4 * n + (i & 3); }

struct Unit { int pm, pn; };
struct Gemm { const bf16_t* A; const bf16_t* Bt; int M, N, K; };

struct StaticOrder {
    int nM, nN, nwg, G, c;
    __host__ __device__ void init(int M, int N, int G_, int c_) { nM = M / BM; nN = N / BM; nwg = nM * nN; G = G_; c = c_; }
    __host__ __device__ bool next(int i, Unit& u) const {
        const long L = (long)i * G + c; if (L >= nwg) return false;
        int wgid = (int)L; { const int q = nwg / NXCD, r = nwg % NXCD, xcd = wgid % NXCD, off = wgid / NXCD; wgid = (xcd < r ? xcd * (q + 1) : r * (q + 1) + (xcd - r) * q) + off; }
        const int nig = WGM * nN, gid = wgid / nig, fm = gid * WGM, gsz = (nM - fm) < WGM ? (nM - fm) : WGM;
        u.pm = fm + ((wgid % nig) % gsz); u.pn = (wgid % nig) / gsz; return true;
    }
    __device__ __forceinline__ void a_ready(const Unit&) const {}
    __device__ __forceinline__ void done(const Unit&) const {}
};


struct EpiStoreBf16 {
    static constexpr bool PERM = true, AFTER_DRAIN = false;
    bf16_t* O; int ldc;
    __device__ __forceinline__ void operator()(const f32x4 (&acc)[2][2][4][2], const Unit& u, int wr, int wc, int fr, int fq) const {
        const int row0 = u.pm * BM + wr * 64 + fr, col0 = u.pn * BM + wc * 32 + 8 * fq;
#pragma unroll
        for (int ai = 0; ai < 2; ++ai)
#pragma unroll
            for (int m = 0; m < 4; ++m) { bf16_t* rowp = O + (size_t)(row0 + ai * HALF + m * 16) * ldc + col0;
#pragma unroll
                for (int bj = 0; bj < 2; ++bj) { const f32x4 v0 = acc[ai][bj][m][0], v1 = acc[ai][bj][m][1];
                    u32x4 w; w.x = ::pk2(v0[0], v0[1]); w.y = ::pk2(v0[2], v0[3]); w.z = ::pk2(v1[0], v1[1]); w.w = ::pk2(v1[2], v1[3]);
                    *(u32x4*)(rowp + bj * HALF) = w; } }
    }
};
struct EpiResidual {
    static constexpr bool PERM = false, AFTER_DRAIN = false;
    float* X; const float* gate;
    __device__ __forceinline__ void operator()(const f32x4 (&acc)[2][2][4][2], const Unit& u, int wr, int wc, int fr, int fq) const {
        const int row0 = u.pm * BM + wr * 64 + fr, col0 = u.pn * BM + wc * 32 + 4 * fq;
#pragma unroll
        for (int ai = 0; ai < 2; ++ai)
#pragma unroll
            for (int m = 0; m < 4; ++m) { const int row = row0 + ai * HALF + m * 16;
                if (MPAD != M && row >= M) continue;
                const float* g = gate + (size_t)::row_cb(row) * 6144 + col0; float* xp = X + (size_t)row * D + col0;
#pragma unroll
                for (int bj = 0; bj < 2; ++bj)
#pragma unroll
                    for (int n = 0; n < 2; ++n) { const f32x4 gv = *(const f32x4*)(g + bj * HALF + n * 16); f32x4* xq = (f32x4*)(xp + bj * HALF + n * 16); *xq = *xq + gv * acc[ai][bj][m][n]; } }
    }
};
struct EpiSwiglu {
    static constexpr bool PERM = true, AFTER_DRAIN = false;
    bf16_t* Hd;
    __device__ __forceinline__ void operator()(const f32x4 (&acc)[2][2][4][2], const Unit& u, int wr, int wc, int fr, int fq) const {
        const int row0 = u.pm * BM + wr * 64 + fr, col0 = u.pn * HALF + wc * 32 + 8 * fq;
#pragma unroll
        for (int ai = 0; ai < 2; ++ai)
#pragma unroll
            for (int m = 0; m < 4; ++m) { bf16_t* rowp = Hd + (size_t)(row0 + ai * HALF + m * 16) * FF + col0;
                float v[8];
#pragma unroll
                for (int n = 0; n < 2; ++n)
#pragma unroll
                    for (int j = 0; j < 4; ++j) { const float gt = acc[ai][0][m][n][j], up = acc[ai][1][m][n][j]; v[4 * n + j] = ::silu_f(gt) * up; }
                u32x4 w; w.x = ::pk2(v[0], v[1]); w.y = ::pk2(v[2], v[3]); w.z = ::pk2(v[4], v[5]); w.w = ::pk2(v[6], v[7]);
                *(u32x4*)rowp = w; }
    }
};

#ifdef __HIP_EMU__
template <class Epi, class Sched, bool ALIGN_EPI = false, bool SP2 = false>
__device__ __forceinline__ void gemm_phase(unsigned char* lds, const Gemm g, const Sched& S, const Epi& E) {
    const int tid = threadIdx.x, wid = tid >> 6, lane = tid & 63, wr = wid >> 2, wc = wid & 3, fr = lane & 15, fq = lane >> 4;
    Unit cur;
    for (int ui = 0; S.next(ui, cur); ++ui) {
        f32x4 acc[2][2][4][2];
        for (int ai = 0; ai < 2; ++ai) for (int bj = 0; bj < 2; ++bj) for (int m = 0; m < 4; ++m) for (int n = 0; n < 2; ++n) for (int j = 0; j < 4; ++j) {
            const int row = 256 * cur.pm + 128 * ai + 64 * wr + 16 * m + fr;
            const int col = Epi::PERM ? 256 * cur.pn + 128 * bj + 32 * wc + 8 * fq + 4 * n + j : 256 * cur.pn + 128 * bj + 32 * wc + 16 * n + 4 * fq + j;
            const bf16_t* a = g.A + (size_t)row * g.K; const bf16_t* b = g.Bt + (size_t)col * g.K; float s = 0.f;
            for (int k = 0; k < g.K; ++k) s += ::bf2f(a[k]) * ::bf2f(b[k]);
            acc[ai][bj][m][n][j] = s; }
        E(acc, cur, wr, wc, fr, fq);
    }
}
#else
template <class Epi, class Sched, bool ALIGN_EPI = false, bool SP2 = false>
__device__ __forceinline__ void gemm_phase(PG8_LAS unsigned char* lds, const Gemm g, const Sched& S, const Epi& E) {
    const int tid = ::tidx(), wid = __builtin_amdgcn_readfirstlane(tid >> 6), lane = tid & 63, wr = wid >> 2, wc = wid & 3, fr = lane & 15, fq = lane >> 4;
    const int K = g.K, nt = K / BK;
    unsigned voffA[2], voffB[2];
#pragma unroll
    for (int i = 0; i < 2; ++i) { int R, C; stage_rc(tid * 16 + i * 8192, R, C); const int Rb = Epi::PERM ? ((R & ~31) + perm32(R & 31)) : R;
        voffA[i] = (unsigned)(R * K + C) * 2u; voffB[i] = (unsigned)(Rb * K + C) * 2u; }
    const size_t kstep = (size_t)(BK * 2);
    const size_t hstep = (size_t)HALF * K * 2;
    const size_t tstep = 2 * hstep;
    const unsigned ldsw = (unsigned)wid * 1024u;
    const int aoff = lds_byte(wr * 64 + fr, fq * 8), boff = lds_byte(wc * 32 + fr, fq * 8);
#define PG8_SA(b, h) (((b) * 2 + (h)) * HTB)
#define PG8_SB(b, h) ((4 + (b) * 2 + (h)) * HTB)
#define PG8_STAGE(bufoff, gbase, voff) do { _Pragma("unroll") for (int _i = 0; _i < 2; ++_i) \
        __builtin_amdgcn_global_load_lds((const unsigned*)((const char*)(gbase) + (voff)[_i]), (PG8_LAS unsigned*)(lds + (bufoff) + ldsw + _i * 8192), 16, 0, 0); } while (0)
#define PG8_LDA(dst, b, h) do { _Pragma("unroll") for (int m = 0; m < 4; ++m) _Pragma("unroll") for (int k = 0; k < 2; ++k) dst[m][k] = *(const PG8_LAS bf16x8*)(lds + PG8_SA(b, h) + aoff + m * 2048 + k * 1024); } while (0)
#define PG8_LDB(dst, b, h) do { _Pragma("unroll") for (int n = 0; n < 2; ++n) _Pragma("unroll") for (int k = 0; k < 2; ++k) dst[n][k] = *(const PG8_LAS bf16x8*)(lds + PG8_SB(b, h) + boff + n * 2048 + k * 1024); } while (0)
#define PG8_MMA(ai, bj, At, Bt) do { __builtin_amdgcn_s_setprio(1); _Pragma("unroll") for (int m = 0; m < 4; ++m) _Pragma("unroll") for (int n = 0; n < 2; ++n) _Pragma("unroll") for (int k = 0; k < 2; ++k) \
        acc[ai][bj][m][n] = __builtin_amdgcn_mfma_f32_16x16x32_bf16(Bt[n][k], At[m][k], acc[ai][bj][m][n], 0, 0, 0); __builtin_amdgcn_s_setprio(0); } while (0)
#define PG8_WAIT_V(n) asm volatile("s_waitcnt vmcnt(" #n ")" ::: "memory")
#define PG8_WAIT_L(n) asm volatile("s_waitcnt lgkmcnt(" #n ")" ::: "memory")
#define PG8_BAR __builtin_amdgcn_s_barrier()
#define PG8_SCHED __builtin_amdgcn_sched_barrier(0)
    Unit cur, nxt; int ui = 0;
    if (!S.next(0, cur)) return;
    f32x4 acc[2][2][4][2];
#pragma unroll
    for (int a = 0; a < 2; ++a)
#pragma unroll
        for (int b = 0; b < 2; ++b)
#pragma unroll
            for (int m = 0; m < 4; ++m)
#pragma unroll
                for (int n = 0; n < 2; ++n) acc[a][b][m][n] = (f32x4){0.f, 0.f, 0.f, 0.f};
    bf16x8 At[4][2], B0[2][2], B1[2][2];
    const char* cA = (const char*)g.A + (size_t)cur.pm * tstep; const char* cB = (const char*)g.Bt + (size_t)cur.pn * tstep;
    S.a_ready(cur);
    if constexpr (SP2) {
        PG8_STAGE(PG8_SB(0, 0), cB, voffB); PG8_STAGE(PG8_SB(0, 1), cB + hstep, voffB); PG8_STAGE(PG8_SA(0, 0), cA, voffA); PG8_STAGE(PG8_SA(0, 1), cA + hstep, voffA);
        if (wr == 1) PG8_BAR;
        PG8_WAIT_V(2); PG8_BAR;
        PG8_STAGE(PG8_SB(1, 0), cB + kstep, voffB); PG8_STAGE(PG8_SA(1, 0), cA + kstep, voffA); PG8_STAGE(PG8_SB(1, 1), cB + hstep + kstep, voffB);
        PG8_WAIT_V(6); PG8_BAR;
    } else {
        PG8_STAGE(PG8_SB(0, 0), cB, voffB); PG8_STAGE(PG8_SA(0, 0), cA, voffA); PG8_STAGE(PG8_SB(0, 1), cB + hstep, voffB); PG8_STAGE(PG8_SA(0, 1), cA + hstep, voffA);
        if (wr == 1) PG8_BAR;
        PG8_WAIT_V(4); PG8_BAR;
        PG8_STAGE(PG8_SB(1, 0), cB + kstep, voffB); PG8_STAGE(PG8_SA(1, 0), cA + kstep, voffA); PG8_STAGE(PG8_SB(1, 1), cB + hstep + kstep, voffB);
        PG8_WAIT_V(6); PG8_BAR;
    }
    for (;;) {
        const bool has_next = S.next(ui + 1, nxt);
        const char* nA = has_next ? (const char*)g.A + (size_t)nxt.pm * tstep : cA; const char* nB = has_next ? (const char*)g.Bt + (size_t)nxt.pn * tstep : cB;
        for (int t = 0; t < nt; t += 2) {
            const bool last = (t == nt - 2);
            const char* a1 = cA + (size_t)(t + 1) * kstep;
            const char* a2 = last ? nA : cA + (size_t)(t + 2) * kstep; const char* b2 = last ? nB : cB + (size_t)(t + 2) * kstep;
            const char* a3 = a2 + kstep; const char* b3 = b2 + kstep;
            if (last && has_next) S.a_ready(nxt);
            if constexpr (SP2) {
            PG8_LDB(B0, 0, 0); PG8_LDB(B1, 0, 1); PG8_SCHED; PG8_LDA(At, 0, 0); PG8_STAGE(PG8_SA(1, 1), a1 + hstep, voffA);
            PG8_WAIT_V(8); PG8_WAIT_L(0); PG8_BAR; PG8_MMA(0, 0, At, B0); PG8_MMA(0, 1, At, B1); PG8_BAR; PG8_SCHED;
            PG8_LDA(At, 0, 1); PG8_STAGE(PG8_SB(0, 0), b2, voffB); PG8_STAGE(PG8_SB(0, 1), b2 + hstep, voffB); PG8_STAGE(PG8_SA(0, 0), a2, voffA);
            PG8_WAIT_V(8); PG8_WAIT_L(0); PG8_BAR; PG8_MMA(1, 0, At, B0); PG8_MMA(1, 1, At, B1); PG8_BAR; PG8_SCHED;
            PG8_LDB(B0, 1, 0); PG8_LDB(B1, 1, 1); PG8_SCHED; PG8_LDA(At, 1, 0); PG8_STAGE(PG8_SA(0, 1), a2 + hstep, voffA);
            PG8_WAIT_V(8); PG8_WAIT_L(0); PG8_BAR; PG8_MMA(0, 0, At, B0); PG8_MMA(0, 1, At, B1); PG8_BAR; PG8_SCHED;
            PG8_LDA(At, 1, 1); PG8_STAGE(PG8_SB(1, 0), b3, voffB); PG8_STAGE(PG8_SB(1, 1), b3 + hstep, voffB); PG8_STAGE(PG8_SA(1, 0), a3, voffA);
            PG8_WAIT_V(8); PG8_WAIT_L(0); PG8_BAR; PG8_MMA(1, 0, At, B0); PG8_MMA(1, 1, At, B1); PG8_BAR; PG8_SCHED;
            } else {
            PG8_LDB(B0, 0, 0); PG8_SCHED; PG8_LDA(At, 0, 0); PG8_STAGE(PG8_SA(1, 1), a1 + hstep, voffA);
            PG8_WAIT_L(8); PG8_BAR; PG8_WAIT_L(0); PG8_MMA(0, 0, At, B0); PG8_BAR; PG8_SCHED;
            PG8_LDB(B1, 0, 1); PG8_STAGE(PG8_SB(0, 0), b2, voffB);
            PG8_BAR; PG8_WAIT_L(0); PG8_MMA(0, 1, At, B1); PG8_BAR;
            PG8_LDA(At, 0, 1); PG8_STAGE(PG8_SA(0, 0), a2, voffA);
            PG8_BAR; PG8_WAIT_L(0); PG8_MMA(1, 0, At, B0); PG8_BAR; PG8_SCHED;
            PG8_STAGE(PG8_SB(0, 1), b2 + hstep, voffB);
            PG8_WAIT_V(6); PG8_BAR; PG8_MMA(1, 1, At, B1); PG8_BAR;
            PG8_LDB(B0, 1, 0); PG8_SCHED; PG8_LDA(At, 1, 0); PG8_STAGE(PG8_SA(0, 1), a2 + hstep, voffA);
            PG8_WAIT_L(8); PG8_BAR; PG8_WAIT_L(0); PG8_MMA(0, 0, At, B0); PG8_BAR; PG8_SCHED;
            PG8_LDB(B1, 1, 1); PG8_STAGE(PG8_SB(1, 0), b3, voffB);
            PG8_BAR; PG8_WAIT_L(0); PG8_MMA(0, 1, At, B1); PG8_BAR;
            PG8_LDA(At, 1, 1); PG8_STAGE(PG8_SA(1, 0), a3, voffA);
            PG8_BAR; PG8_WAIT_L(0); PG8_MMA(1, 0, At, B0); PG8_BAR; PG8_SCHED;
            PG8_STAGE(PG8_SB(1, 1), b3 + hstep, voffB);
            PG8_WAIT_V(6); PG8_BAR; PG8_MMA(1, 1, At, B1); PG8_BAR;
            }
        }
        if constexpr (ALIGN_EPI) { if (wr == 0) PG8_BAR; }
        if constexpr (!Epi::AFTER_DRAIN) { E(acc, cur, wr, wc, fr, fq); S.done(cur); }
        if (!has_next) break;
#pragma unroll
        for (int a = 0; a < 2; ++a)
#pragma unroll
            for (int b = 0; b < 2; ++b)
#pragma unroll
                for (int m = 0; m < 4; ++m)
#pragma unroll
                    for (int n = 0; n < 2; ++n) acc[a][b][m][n] = (f32x4){0.f, 0.f, 0.f, 0.f};
        cur = nxt; cA = nA; cB = nB; ++ui;
        if constexpr (ALIGN_EPI) { if (wr == 1) PG8_BAR; }
    }
    PG8_WAIT_V(0);
    if constexpr (!ALIGN_EPI) { if (wr == 0) PG8_BAR; }
    PG8_BAR;
    if constexpr (Epi::AFTER_DRAIN) { E.fused(acc, cur, wr, wc, fr, fq, lds, wid, lane); S.done(cur); }
#undef PG8_SA
#undef PG8_SB
#undef PG8_STAGE
#undef PG8_LDA
#undef PG8_LDB
#undef PG8_MMA
#undef PG8_WAIT_V
#undef PG8_WAIT_L
#undef PG8_BAR
#undef PG8_SCHED
}
#endif
}


__device__ __forceinline__ void transpose_item(const float* W, int ldw, bf16_t* WT, int K, int k0, int n0, int drow0, float* scr, int lane) {
#pragma unroll 8
    for (int i = 0; i < 32; ++i) { const int kk = 2 * i + (lane >> 5); scr[kk * 33 + (lane & 31)] = W[(size_t)(k0 + kk) * ldw + n0 + (lane & 31)]; }
    WAVE_SYNC();
    const int c = lane & 7;
#pragma unroll
    for (int j = 0; j < 4; ++j) { const int n = (lane >> 3) + 8 * j; const float* s = scr + (8 * c) * 33 + n;
        u32x4 o; o.x = pk2(s[0 * 33], s[1 * 33]); o.y = pk2(s[2 * 33], s[3 * 33]); o.z = pk2(s[4 * 33], s[5 * 33]); o.w = pk2(s[6 * 33], s[7 * 33]);
        *(u32x4*)(WT + (size_t)(drow0 + n) * K + k0 + 8 * c) = o; }
    WAVE_SYNC();
}
__device__ __forceinline__ void ph_convert(const P& p, unsigned char* smem) {
    const int lane = tidx() & 63, wave = tidx() >> 6;
    float* scr = (float*)smem + wave * (64 * 33 + 32);
    constexpr int I_IN = 16 * 120, I_OUT = 16 * 32, I_G = 16 * 88, I_DN = 44 * 32, I_L = I_IN + I_OUT + 2 * I_G + I_DN;
    const int gw = blockIdx.x * 8 + wave, ngw = gridDim.x * 8;
    for (int it = gw; it < NL * I_L; it += ngw) {
        const int l = it / I_L; int r = it % I_L;
        if (r < I_IN) { const int kb = r / 120, nb = r % 120; transpose_item(p.w_in + (size_t)l * D * INC, INC, WSP(bf16_t, WS_WIN) + (size_t)l * NPROJ * D, D, kb * 64, nb * 32, nb * 32, scr, lane); continue; }
        r -= I_IN;
        if (r < I_OUT) { const int kb = r / 32, nb = r % 32; transpose_item(p.w_out + (size_t)l * D * D, D, WSP(bf16_t, WS_WOUT) + (size_t)l * D * D, D, kb * 64, nb * 32, nb * 32, scr, lane); continue; }
        r -= I_OUT;
        if (r < 2 * I_G) { const int up = r / I_G; r %= I_G; const int kb = r / 88, nb = r % 88, n0 = nb * 32;
            transpose_item((up ? p.w_up : p.w_gate) + (size_t)l * D * FF, FF, WSP(bf16_t, WS_WGU) + (size_t)l * 2 * FF * D, D, kb * 64, n0, (n0 / 128) * 256 + up * 128 + (n0 % 128), scr, lane); continue; }
        r -= 2 * I_G;
        { const int kb = r / 32, nb = r % 32; transpose_item(p.w_down + (size_t)l * FF * D, D, WSP(bf16_t, WS_WDN) + (size_t)l * D * FF, FF, kb * 64, nb * 32, nb * 32, scr, lane); }
    }
}

__device__ __forceinline__ void ph_adaln(const P& p, unsigned char* smem) {
    float* sc = (float*)smem;
    float* red = sc + NC * 256;
    const int tid = tidx(), col = tid & 31, kg = tid >> 5;
    float* MOD = WSP(float, WS_MOD);
    for (int it = blockIdx.x; it < NL * 192; it += gridDim.x) {
        const int l = it / 192, cb0 = (it % 192) * 32;
        float acc[NC];
#pragma unroll
        for (int r = 0; r < NC; ++r) acc[r] = 0.f;
        for (int kc = 0; kc < 4; ++kc) {
            __syncthreads();
            for (int e = tid; e < NC * 256; e += NTHR) { const int r = e >> 8, k = e & 255; const float c = r < PB ? p.c_prompt[r * D + kc * 256 + k] : p.c_sample[(r - PB) * D + kc * 256 + k]; sc[e] = silu_f(c); }
            __syncthreads();
            for (int kk = 0; kk < 16; ++kk) { const int k = kg * 16 + kk; const float w = p.ada_w[((size_t)l * D + kc * 256 + k) * 6144 + cb0 + col];
#pragma unroll
                for (int r = 0; r < NC; ++r) acc[r] += sc[r * 256 + k] * w; }
        }
#pragma unroll
        for (int r = 0; r < NC; ++r) red[(kg * NC + r) * 32 + col] = acc[r];
        __syncthreads();
        for (int e = tid; e < NC * 32; e += NTHR) { const int r = e >> 5, c = e & 31; float s = p.ada_b[l * 6144 + cb0 + c];
            for (int g = 0; g < 16; ++g) s += red[(g * NC + r) * 32 + c];
            MOD[((size_t)l * NC + r) * 6144 + cb0 + c] = s; }
        __syncthreads();
    }
}

__device__ __forceinline__ void ph_ropetab_copyx(const P& p) {
    const size_t gt = (size_t)blockIdx.x * NTHR + tidx(), ng = (size_t)gridDim.x * NTHR;
    float* tab = WSP(float, WS_ROPE);
    for (size_t e = gt; e < (size_t)NPOS * 32; e += ng) {
        const int pi = (int)(e >> 5), i = (int)(e & 31); const double pos = pi < T ? (double)pi : (double)(PAST + pi - T);
        const double ia = exp(-log(10000.0) * (double)i / 32.0), ir = exp(-log(10000.0) * (double)i / 31.0);
        tab[e] = (float)cos(pos * ia); tab[(size_t)NPOS * 32 + e] = (float)sin(pos * ia);
        tab[(size_t)2 * NPOS * 32 + e] = (float)cos(pos * ir); tab[(size_t)3 * NPOS * 32 + e] = (float)sin(pos * ir);
    }
    const f32x4* xp = (const f32x4*)p.x_prompt; const f32x4* xs = (const f32x4*)p.x_sample; f32x4* o = (f32x4*)p.out;
    for (size_t e = gt; e < (size_t)MP * D / 4; e += ng) o[e] = xp[e];
    for (size_t e = gt; e < (size_t)MS * D / 4; e += ng) o[(size_t)MP * D / 4 + e] = xs[e];
}

template <int WHICH> __device__ __forceinline__ void ph_norm_mod(const P& p, int l) {
    const int lane = tidx() & 63, wave = tidx() >> 6, gw = blockIdx.x * 8 + wave, ngw = gridDim.x * 8;
    const float* nw = (WHICH == 0 ? p.norm_mix : p.norm_ffn) + l * D;
    bf16_t* H = WSP(bf16_t, WS_H);
    for (int r = gw; r < M; r += ngw) {
        const float* xr = p.out + (size_t)r * D; const float* mod = WSP(float, WS_MOD) + ((size_t)l * NC + row_cb(r)) * 6144 + (WHICH == 0 ? 0 : 3072);
        f32x4 v[4]; float ss = 0.f;
#pragma unroll
        for (int j = 0; j < 4; ++j) { v[j] = *(const f32x4*)(xr + 4 * lane + 256 * j); ss += (v[j][0] * v[j][0] + v[j][1] * v[j][1]) + (v[j][2] * v[j][2] + v[j][3] * v[j][3]); }
        const float rstd = 1.0f / sqrtf(wave_sum(ss) * (1.0f / D) + EPS);
        float a8[8];
#pragma unroll
        for (int c = 0; c < 8; ++c) a8[c] = 0.f;
#pragma unroll
        for (int j = 0; j < 4; ++j) { const int k = 4 * lane + 256 * j;
            const f32x4 g = *(const f32x4*)(nw + k), sh = *(const f32x4*)(mod + k), sc = *(const f32x4*)(mod + 1024 + k);
            f32x4 h;
#pragma unroll
            for (int e = 0; e < 4; ++e) h[e] = v[j][e] * rstd * g[e] * (1.0f + sc[e]) + sh[e];
            u32x2 w; w.x = pk2(h[0], h[1]); w.y = pk2(h[2], h[3]); *(u32x2*)(H + (size_t)r * D + k) = w;
            if (WHICH == 0) {
#pragma unroll
                for (int e = 0; e < 4; ++e) { const float* wr = p.w_in + ((size_t)l * D + k + e) * INC + NPROJ; const f32x4 w0 = *(const f32x4*)wr, w1 = *(const f32x4*)(wr + 4);
#pragma unroll
                    for (int c = 0; c < 4; ++c) { a8[c] += h[e] * w0[c]; a8[4 + c] += h[e] * w1[c]; } }
            }
        }
        if (WHICH == 0) {
#pragma unroll
            for (int c = 0; c < 8; ++c) a8[c] = wave_sum(a8[c]);
            if (lane < 4) { float braw = lane == 0 ? a8[0] : lane == 1 ? a8[1] : lane == 2 ? a8[2] : a8[3]; WSP(float, WS_BETA)[(size_t)r * 4 + lane] = 1.0f / (1.0f + expf(-braw)); }
            else if (lane < 8) { const int hh = lane - 4; float araw = hh == 0 ? a8[4] : hh == 1 ? a8[5] : hh == 2 ? a8[6] : a8[7];
                const float xx = araw + p.dt_bias[l * 4 + hh]; const float sp = xx > 20.f ? xx : log1pf(expf(xx));
                WSP(float, WS_G)[(size_t)r * 4 + hh] = -expf(p.a_log[l * 4 + hh]) * sp; }
        }
    }
}

__device__ __forceinline__ void ph_rope_out(const P& p, int l) {
    const size_t gt = (size_t)blockIdx.x * NTHR + tidx(), ng = (size_t)gridDim.x * NTHR;
    bf16_t* PR = WSP(bf16_t, WS_PROJ); const float* tab = WSP(float, WS_ROPE);
    for (size_t e = gt; e < (size_t)M * 512; e += ng) {
        const int r = (int)(e >> 9), rem = (int)(e & 511), sec = rem >> 7, hh = (rem & 127) >> 5, d = rem & 31;
        const int off = sec == 0 ? C_QA : sec == 1 ? C_KA : sec == 2 ? C_QR : C_KR; const float scale = sec == 0 ? 0.125f * LOG2E : sec == 3 ? 0.125f : 1.0f;
        const float* ct = tab + (size_t)(sec >= 2 ? 2 : 0) * NPOS * 32 + (size_t)row_pi(r) * 32 + d; const float c = ct[0], s = ct[(size_t)NPOS * 32];
        bf16_t* x = PR + (size_t)r * NPROJ + off + hh * 64 + d; const float x1 = bf2f(x[0]), x2 = bf2f(x[32]);
        const float o1 = (x1 * c - x2 * s) * scale, o2 = (x1 * s + x2 * c) * scale;
        x[0] = f2bf(o1); x[32] = f2bf(o2);
        if (sec == 1) {
            if (r < MP) { const int b = r / T, t = r % T; bf16_t* kh = WSP(bf16_t, WS_KH) + ((size_t)(b * 4 + hh) * T + t) * 64 + d; kh[0] = f2bf(o1); kh[32] = f2bf(o2);
                if (t >= T - PWIN) { float* o = p.out + O_PWK + (((size_t)l * PB + b) * PWIN + (t - (T - PWIN))) * 256 + hh * 64 + d; o[0] = o1; o[32] = o2; } }
            else { const int b = (r - MP) / DS, i = (r - MP) % DS; float* o = p.out + O_SWK + (((size_t)l * DB + b) * DS + i) * 256 + hh * 64 + d; o[0] = o1; o[32] = o2; }
        }
    }
    for (size_t e = gt; e < (size_t)M * 256; e += ng) {
        const int r = (int)(e >> 8), c = (int)(e & 255); const float v = bf2f(PR[(size_t)r * NPROJ + C_VA + c]);
        if (r < MP) { const int b = r / T, t = r % T; if (t >= T - PWIN) p.out[O_PWV + (((size_t)l * PB + b) * PWIN + (t - (T - PWIN))) * 256 + c] = v; }
        else { const int b = (r - MP) / DS, i = (r - MP) % DS; p.out[O_SWV + (((size_t)l * DB + b) * DS + i) * 256 + c] = v; }
    }
    for (size_t e = gt; e < (size_t)(PB + DB) * 3 * 1536; e += ng) {
        const int c = (int)(e % 1536), j = (int)((e / 1536) % 3), bb = (int)(e / (3 * 1536));
        if (bb < PB) p.out[O_PCONV + (((size_t)l * PB + bb) * 3 + j) * 1536 + c] = bf2f(PR[(size_t)(bb * T + T - 3 + j) * NPROJ + C_CONV + c]);
        else { const int b = bb - PB; p.out[O_SCONV + (((size_t)l * DB + b) * 3 + j) * 1536 + c] = bf2f(PR[(size_t)(MP + b * DS + DS - 3 + j) * NPROJ + C_CONV + c]); }
    }
}

__device__ __forceinline__ void attn_wave_sample(const P& p, int l, int r, int h, int lane, float* sw  ) {
    const bf16_t* PR = WSP(bf16_t, WS_PROJ);
    const int b = (r - MP) / DS; const int tq = WB + (r - MP) % DS;
    float q[64];
    { const bf16_t* qp = PR + (size_t)r * NPROJ + C_QA + h * 64;
#pragma unroll
      for (int j = 0; j < 8; ++j) { const bf16x8 v = *(const bf16x8*)(qp + 8 * j);
#pragma unroll
          for (int e = 0; e < 8; ++e) q[8 * j + e] = bf2f((bf16_t)v[e]); } }
    float mx = -INFINITY;
#pragma unroll 1
    for (int i = 0; i < 7; ++i) {
        const int e = lane + 64 * i;
        if (e < 387) { const int pat = e / 129, j = e % 129, dil = pat == 0 ? 1 : pat == 1 ? 4 : 16; const int rr = tq - dil * j;
            float a = 0.f;
            if (rr < WB) { const float* kp = p.cache_k + ((((size_t)l * DB + b) * WB + rr) * 4 + h) * 64;
#pragma unroll
                for (int j4 = 0; j4 < 16; ++j4) { const f32x4 kv = *(const f32x4*)(kp + 4 * j4); a += q[4 * j4] * kv[0] + q[4 * j4 + 1] * kv[1] + q[4 * j4 + 2] * kv[2] + q[4 * j4 + 3] * kv[3]; } }
            else { const bf16_t* kp = PR + (size_t)(MP + b * DS + (rr - WB)) * NPROJ + C_KA + h * 64;
#pragma unroll
                for (int j8 = 0; j8 < 8; ++j8) { const bf16x8 kv = *(const bf16x8*)(kp + 8 * j8);
#pragma unroll
                    for (int e2 = 0; e2 < 8; ++e2) a += q[8 * j8 + e2] * bf2f((bf16_t)kv[e2]); } }
            sw[e] = a; mx = fmaxf(mx, a); }
    }
    mx = wave_max(mx);
    float lsum = 0.f;
#pragma unroll 1
    for (int i = 0; i < 7; ++i) { const int e = lane + 64 * i; if (e < 387) { const float pe = exp2f(sw[e] - mx); sw[e] = pe; lsum += pe; } }
    lsum = wave_sum(lsum);
    WAVE_SYNC();
    float o = 0.f;
#pragma unroll 4
    for (int e = 0; e < 387; ++e) {
        const float pe = sw[e];
        const int pat = e / 129, j = e % 129, dil = pat == 0 ? 1 : pat == 1 ? 4 : 16; const int rr = tq - dil * j;
        float v;
        if (rr < WB) v = p.cache_v[((((size_t)l * DB + b) * WB + rr) * 4 + h) * 64 + lane];
        else v = bf2f(PR[(size_t)(MP + b * DS + (rr - WB)) * NPROJ + C_VA + h * 64 + lane]);
        o += pe * v;
    }
    WAVE_SYNC();
    WSP(bf16_t, WS_O)[(size_t)r * D + h * 64 + lane] = f2bf(o / lsum);
}
__device__ __forceinline__ void ph_attn_sample(const P& p, int l, unsigned char* smem) {
    const int lane = tidx() & 63, wave = tidx() >> 6, gw = blockIdx.x * 8 + wave, ngw = gridDim.x * 8;
    float* sw = (float*)smem + wave * 392;
    for (int it = gw; it < MS * 4; it += ngw) attn_wave_sample(p, l, MP + (it >> 2), it & 3, lane, sw);
}
__device__ __forceinline__ bf16x8 pack8(const f32x16& v, int s8) {
    u32x4 w; w.x = pk2(v[s8], v[s8 + 1]); w.y = pk2(v[s8 + 2], v[s8 + 3]); w.z = pk2(v[s8 + 4], v[s8 + 5]); w.w = pk2(v[s8 + 6], v[s8 + 7]); return __builtin_bit_cast(bf16x8, w);
}
__device__ __forceinline__ void attn_job(const P& p, int jb, int lane) {
    const int c = lane & 31, hi = lane >> 5;
    constexpr int NB = T / 512;
    const int unit = jb / 48, jj = jb % 48, pat = jj >> 4, sub = jj & 15;
    const int blk = unit % NB, h = (unit / NB) & 3, b = unit / (NB * 4), bh = b * 4 + h;
    int dil, r, qi0; const bf16_t* VT;
    if (pat == 0) { dil = 1; r = 0; qi0 = blk * 512 + sub * 32; VT = WSP(bf16_t, WS_VT1) + (size_t)bh * 64 * T; }
    else if (pat == 1) { dil = 4; r = sub >> 2; qi0 = blk * 128 + (sub & 3) * 32; VT = WSP(bf16_t, WS_VT4) + (size_t)(bh * 4 + r) * 64 * (T / 4); }
    else { dil = 16; r = sub; qi0 = blk * 32; VT = WSP(bf16_t, WS_VT16) + (size_t)(bh * 16 + r) * 64 * (T / 16); }
    const int SL = T / dil;
    const int tq = dil * (qi0 + c) + r;
    const bf16_t* qp = WSP(bf16_t, WS_PROJ) + (size_t)(b * T + tq) * NPROJ + C_QA + h * 64 + 8 * hi;
    bf16x8 qf[4];
#pragma unroll
    for (int ks = 0; ks < 4; ++ks) qf[ks] = *(const bf16x8*)(qp + 16 * ks);
    const bf16_t* KHb = WSP(bf16_t, WS_KH) + (size_t)bh * T * 64;
    f32x16 S[5];
#pragma unroll
    for (int i = 0; i < 5; ++i) {
        const int kt0 = qi0 - 128 + 32 * i;
        f32x16 acc;
#pragma unroll
        for (int e = 0; e < 16; ++e) acc[e] = 0.f;
        if (kt0 >= 0) { const bf16_t* kp = KHb + (size_t)(dil * (kt0 + c) + r) * 64 + 8 * hi;
#pragma unroll
            for (int ks = 0; ks < 4; ++ks) acc = MFMA32(*(const bf16x8*)(kp + 16 * ks), qf[ks], acc);
            if (i == 0) {
#pragma unroll
                for (int e = 0; e < 16; ++e) { const int krow = (e & 3) + 8 * (e >> 2) + 4 * hi; if (krow < c) acc[e] = -INFINITY; } }
            if (i == 4) {
#pragma unroll
                for (int e = 0; e < 16; ++e) { const int krow = (e & 3) + 8 * (e >> 2) + 4 * hi; if (krow > c) acc[e] = -INFINITY; } }
        } else {
#pragma unroll
            for (int e = 0; e < 16; ++e) acc[e] = -INFINITY; }
        S[i] = acc;
    }
    float mx = -INFINITY;
#pragma unroll
    for (int i = 0; i < 5; ++i)
#pragma unroll
        for (int e = 0; e < 16; ++e) mx = fmaxf(mx, S[i][e]);
    mx = fmaxf(mx, __shfl_xor(mx, 32));
    float lsum = 0.f;
#pragma unroll
    for (int i = 0; i < 5; ++i)
#pragma unroll
        for (int e = 0; e < 16; ++e) { const float pe = exp2f(S[i][e] - mx); S[i][e] = pe; lsum += pe; }
    lsum += __shfl_xor(lsum, 32);
    f32x16 O[2];
#pragma unroll
    for (int dt = 0; dt < 2; ++dt)
#pragma unroll
        for (int e = 0; e < 16; ++e) O[dt][e] = 0.f;
#pragma unroll
    for (int i = 0; i < 5; ++i) {
        const int kt0 = qi0 - 128 + 32 * i;
        if (kt0 >= 0) {
#pragma unroll
            for (int s2 = 0; s2 < 2; ++s2) { const bf16x8 pf = pack8(S[i], 8 * s2);
#pragma unroll
                for (int dt = 0; dt < 2; ++dt) { const bf16_t* vp = VT + (size_t)(dt * 32 + c) * SL + kt0 + 16 * s2 + 4 * hi;
                    const u32x2 lo = *(const u32x2*)vp, hh = *(const u32x2*)(vp + 8); u32x4 w; w.x = lo.x; w.y = lo.y; w.z = hh.x; w.w = hh.y;
                    O[dt] = MFMA32(__builtin_bit_cast(bf16x8, w), pf, O[dt]); } }
        }
    }
    const size_t idx = ((size_t)(b * T + tq) * 4 + h) * 3 + pat;
    bf16_t* po = WSP(bf16_t, WS_APO) + idx * 64;
#pragma unroll
    for (int dt = 0; dt < 2; ++dt)
#pragma unroll
        for (int g = 0; g < 4; ++g) { u32x2 w; w.x = pk2(O[dt][4 * g], O[dt][4 * g + 1]); w.y = pk2(O[dt][4 * g + 2], O[dt][4 * g + 3]); *(u32x2*)(po + 32 * dt + 8 * g + 4 * hi) = w; }
    if (hi == 0) { float* ml = WSP(float, WS_AML) + idx * 2; ml[0] = mx; ml[1] = lsum; }
}
__device__ __forceinline__ void ph_attn_jobs(const P& p) {
    const int lane = tidx() & 63, wave = tidx() >> 6, gw = blockIdx.x * 8 + wave, ngw = gridDim.x * 8;
    for (int jb = gw; jb < PB * 4 * (T / 512) * 48; jb += ngw) attn_job(p, jb, lane);
}
__device__ __forceinline__ void ph_attn_combine(const P& p) {
    const size_t gt = (size_t)blockIdx.x * NTHR + tidx(), ng = (size_t)gridDim.x * NTHR;
    for (size_t e = gt; e < (size_t)MP * 4 * 16; e += ng) {
        const size_t rh = e >> 4; const int dq = (int)(e & 15) * 4;
        const float* ml = WSP(float, WS_AML) + rh * 6; const float m0 = ml[0], m1 = ml[2], m2 = ml[4];
        const float mm = fmaxf(m0, fmaxf(m1, m2)); const float w0 = exp2f(m0 - mm), w1 = exp2f(m1 - mm), w2 = exp2f(m2 - mm);
        const float inv = 1.0f / (w0 * ml[1] + w1 * ml[3] + w2 * ml[5]);
        const bf16_t* po = WSP(bf16_t, WS_APO) + rh * 192 + dq;
        const u32x2 a = *(const u32x2*)po, bq = *(const u32x2*)(po + 64), cq = *(const u32x2*)(po + 128);
        float o[4];
        o[0] = w0 * bf2f((bf16_t)(a.x & 0xffff)) + w1 * bf2f((bf16_t)(bq.x & 0xffff)) + w2 * bf2f((bf16_t)(cq.x & 0xffff));
        o[1] = w0 * bf2f((bf16_t)(a.x >> 16)) + w1 * bf2f((bf16_t)(bq.x >> 16)) + w2 * bf2f((bf16_t)(cq.x >> 16));
        o[2] = w0 * bf2f((bf16_t)(a.y & 0xffff)) + w1 * bf2f((bf16_t)(bq.y & 0xffff)) + w2 * bf2f((bf16_t)(cq.y & 0xffff));
        o[3] = w0 * bf2f((bf16_t)(a.y >> 16)) + w1 * bf2f((bf16_t)(bq.y >> 16)) + w2 * bf2f((bf16_t)(cq.y >> 16));
        const size_t row = rh >> 2; const int h = (int)(rh & 3);
        u32x2 w; w.x = pk2(o[0] * inv, o[1] * inv); w.y = pk2(o[2] * inv, o[3] * inv);
        *(u32x2*)(WSP(bf16_t, WS_O) + row * D + h * 64 + dq) = w;
    }
}
__device__ __forceinline__ void ph_vtrans(const P& p, unsigned char* smem) {
    bf16_t* vt = (bf16_t*)smem;
    const int tid = tidx(); const bf16_t* PR = WSP(bf16_t, WS_PROJ);
    for (int u = blockIdx.x; u < PB * 4 * (T / 256); u += gridDim.x) {
        const int tile = u % (T / 256), bh = u / (T / 256), h = bh & 3, b = bh >> 2;
        __syncthreads();
#pragma unroll
        for (int k = 0; k < 4; ++k) { const int ch = tid + NTHR * k, t = ch >> 3, d8 = (ch & 7) * 8;
            *(u32x4*)(vt + t * 72 + d8) = *(const u32x4*)(PR + (size_t)(b * T + tile * 256 + t) * NPROJ + C_VA + h * 64 + d8); }
        __syncthreads();
#pragma unroll
        for (int k = 0; k < 4; ++k) { const int ch = tid + NTHR * k;
            { const int d = ch >> 5, t0 = (ch & 31) * 8; u32x4 w;
              w.x = (unsigned)vt[(t0 + 0) * 72 + d] | ((unsigned)vt[(t0 + 1) * 72 + d] << 16); w.y = (unsigned)vt[(t0 + 2) * 72 + d] | ((unsigned)vt[(t0 + 3) * 72 + d] << 16);
              w.z = (unsigned)vt[(t0 + 4) * 72 + d] | ((unsigned)vt[(t0 + 5) * 72 + d] << 16); w.w = (unsigned)vt[(t0 + 6) * 72 + d] | ((unsigned)vt[(t0 + 7) * 72 + d] << 16);
              *(u32x4*)(WSP(bf16_t, WS_VT1) + ((size_t)bh * 64 + d) * T + tile * 256 + t0) = w; }
            { const int r = ch >> 9, d = (ch >> 3) & 63, s0 = (ch & 7) * 8; u32x4 w;
#define VT4E(e_) ((unsigned)vt[(4 * (s0 + (e_)) + r) * 72 + d])
              w.x = VT4E(0) | (VT4E(1) << 16); w.y = VT4E(2) | (VT4E(3) << 16); w.z = VT4E(4) | (VT4E(5) << 16); w.w = VT4E(6) | (VT4E(7) << 16);
#undef VT4E
              *(u32x4*)(WSP(bf16_t, WS_VT4) + ((size_t)(bh * 4 + r) * 64 + d) * (T / 4) + tile * 64 + s0) = w; }
            { const int r = ch >> 7, d = (ch >> 1) & 63, s0 = (ch & 1) * 8; u32x4 w;
#define VT16E(e_) ((unsigned)vt[(16 * (s0 + (e_)) + r) * 72 + d])
              w.x = VT16E(0) | (VT16E(1) << 16); w.y = VT16E(2) | (VT16E(3) << 16); w.z = VT16E(4) | (VT16E(5) << 16); w.w = VT16E(6) | (VT16E(7) << 16);
#undef VT16E
              *(u32x4*)(WSP(bf16_t, WS_VT16) + ((size_t)(bh * 16 + r) * 64 + d) * (T / 16) + tile * 16 + s0) = w; }
        }
    }
}

__device__ __forceinline__ float ret_lg(int h) { return logf(1.0f - exp2f(-5.0f - (float)h)); }
__device__ __forceinline__ void ph_ret_local(const P& p, int l, unsigned char* smem) {
    float* ks = (float*)smem; float* vs = ks + 64 * 64; const int tid = tidx(); const bf16_t* PR = WSP(bf16_t, WS_PROJ);
    for (int u = blockIdx.x; u < NUNIT; u += gridDim.x) {
        const int n = u % NCH, h = (u / NCH) % 4, b = u / (NCH * 4); const float lg = ret_lg(h);
        __syncthreads();
        for (int e = tid; e < 4096; e += NTHR) { const int j = e >> 6, d = e & 63; const size_t row = (size_t)(b * T + n * 64 + j) * NPROJ;
            ks[e] = bf2f(PR[row + C_KR + h * 64 + d]) * expf(lg * (float)(63 - j)); vs[e] = bf2f(PR[row + C_VR + h * 64 + d]); }
        __syncthreads();
        const int d = tid >> 3, e0 = (tid & 7) * 8; float acc[8];
#pragma unroll
        for (int i = 0; i < 8; ++i) acc[i] = 0.f;
        for (int j = 0; j < 64; ++j) { const float kd = ks[j * 64 + d];
#pragma unroll
            for (int i = 0; i < 8; ++i) acc[i] += kd * vs[j * 64 + e0 + i]; }
        float* U = WSP(float, WS_RU) + (size_t)u * 4096 + d * 64 + e0;
#pragma unroll
        for (int i = 0; i < 8; ++i) U[i] = acc[i];
    }
}
__device__ __forceinline__ void ph_ret_scan(const P& p, int l) {
    const int gt = blockIdx.x * NTHR + tidx(), ng = gridDim.x * NTHR;
    for (int e = gt; e < PB * 4 * 4096; e += ng) {
        const int bh = e >> 12, de = e & 4095, h = bh & 3; const float cd = expf(ret_lg(h) * 64.0f);
        const float* U = WSP(float, WS_RU) + (size_t)bh * NCH * 4096 + de; float* SPv = WSP(float, WS_RS) + (size_t)bh * NCH * 4096 + de;
        float s = 0.f;
        for (int n = 0; n < NCH; ++n) { SPv[(size_t)n * 4096] = s; s = s * cd + U[(size_t)n * 4096]; }
        p.out[O_PRET + ((size_t)l * PB * 4 + bh) * 4096 + de] = s;
    }
}
__device__ __forceinline__ void ph_ret_out(const P& p, int l, unsigned char* smem) {
    float* qs = (float*)smem; float* ks = qs + 64 * 65; float* vs = ks + 64 * 65; float* ss = vs + 64 * 65; float* as = ss + 64 * 65;
    const int tid = tidx(); const bf16_t* PR = WSP(bf16_t, WS_PROJ);
    for (int u = blockIdx.x; u < NUNIT; u += gridDim.x) {
        const int n = u % NCH, h = (u / NCH) % 4, b = u / (NCH * 4); const float lg = ret_lg(h);
        __syncthreads();
        for (int e = tid; e < 4096; e += NTHR) { const int j = e >> 6, d = e & 63; const size_t row = (size_t)(b * T + n * 64 + j) * NPROJ;
            qs[j * 65 + d] = bf2f(PR[row + C_QR + h * 64 + d]); ks[j * 65 + d] = bf2f(PR[row + C_KR + h * 64 + d]); vs[j * 65 + d] = bf2f(PR[row + C_VR + h * 64 + d]);
            ss[j * 65 + d] = WSP(float, WS_RS)[(size_t)u * 4096 + e]; }
        __syncthreads();
        const int i = tid >> 3, c0 = (tid & 7) * 8;
#pragma unroll
        for (int jj = 0; jj < 8; ++jj) { const int j = c0 + jj; float a = 0.f;
            if (j <= i) { for (int d = 0; d < 64; ++d) a += qs[i * 65 + d] * ks[j * 65 + d]; a *= expf(lg * (float)(i - j)); }
            as[i * 65 + j] = a; }
        __syncthreads();
        float o[8]; float o2[8];
#pragma unroll
        for (int e = 0; e < 8; ++e) { o[e] = 0.f; o2[e] = 0.f; }
        for (int j = 0; j < 64; ++j) { const float a = as[i * 65 + j], qd = qs[i * 65 + j];
#pragma unroll
            for (int e = 0; e < 8; ++e) { o[e] += a * vs[j * 65 + c0 + e]; o2[e] += qd * ss[j * 65 + c0 + e]; } }
        const float qdec = expf(lg * (float)(i + 1)); float sq = 0.f;
#pragma unroll
        for (int e = 0; e < 8; ++e) { o[e] += o2[e] * qdec; sq += o[e] * o[e]; }
        sq += __shfl_xor(sq, 1); sq += __shfl_xor(sq, 2); sq += __shfl_xor(sq, 4);
        const float rstd = 1.0f / sqrtf(sq * (1.0f / 64.0f) + EPS);
        const size_t row = (size_t)(b * T + n * 64 + i);
#pragma unroll
        for (int e = 0; e < 8; ++e) { const float g = bf2f(PR[row * NPROJ + C_GR + h * 64 + c0 + e]);
            WSP(bf16_t, WS_O)[row * D + 256 + h * 64 + c0 + e] = f2bf(o[e] * rstd * p.ret_norm[l * 64 + c0 + e] * silu_f(g)); }
    }
}
__device__ __forceinline__ void ph_ret_sample(const P& p, int l, unsigned char* smem) {
    float* S0 = (float*)smem; float* qs = S0 + 4096; float* ks = qs + 8 * 64; float* vs = ks + 8 * 64;
    const int tid = tidx(); const bf16_t* PR = WSP(bf16_t, WS_PROJ);
    for (int u = blockIdx.x; u < DB * 4; u += gridDim.x) {
        const int h = u & 3, b = u >> 2; const float lg = ret_lg(h);
        __syncthreads();
        for (int e = tid; e < 4096; e += NTHR) S0[e] = p.state_ret[(((size_t)l * DB + b) * 4 + h) * 4096 + e];
        { const int j = tid >> 6, d = tid & 63; const size_t row = (size_t)(MP + b * DS + j) * NPROJ;
          qs[tid] = bf2f(PR[row + C_QR + h * 64 + d]); ks[tid] = bf2f(PR[row + C_KR + h * 64 + d]); vs[tid] = bf2f(PR[row + C_VR + h * 64 + d]); }
        __syncthreads();
        { const int i = tid >> 6, e = tid & 63; float o = 0.f;
          for (int j = 0; j <= i; ++j) { float a = 0.f; for (int d = 0; d < 64; ++d) a += qs[i * 64 + d] * ks[j * 64 + d]; o += a * expf(lg * (float)(i - j)) * vs[j * 64 + e]; }
          float o2 = 0.f; for (int d = 0; d < 64; ++d) o2 += qs[i * 64 + d] * S0[d * 64 + e];
          o += o2 * expf(lg * (float)(i + 1));
          const float rstd = 1.0f / sqrtf(wave_sum(o * o) * (1.0f / 64.0f) + EPS);
          const size_t row = (size_t)(MP + b * DS + i); const float g = bf2f(PR[row * NPROJ + C_GR + h * 64 + e]);
          WSP(bf16_t, WS_O)[row * D + 256 + h * 64 + e] = f2bf(o * rstd * p.ret_norm[l * 64 + e] * silu_f(g)); }
        for (int x = tid; x < 4096; x += NTHR) { const int d = x >> 6, e = x & 63; float s = S0[x] * expf(lg * (float)DS);
            for (int j = 0; j < DS; ++j) s += ks[j * 64 + d] * expf(lg * (float)(DS - 1 - j)) * vs[j * 64 + e];
            p.out[O_SRET + (((size_t)l * DB + b) * 4 + h) * 4096 + x] = s; }
    }
}

template <int CS, int LDL> __device__ __forceinline__ void fwd_subst(float (&X)[CS], const float* Ls) {
#pragma unroll
    for (int i = 1; i < CS; ++i) {
        float a = X[i];
#pragma unroll
        for (int j4 = 0; j4 < (i + 3) / 4; ++j4) { const f32x4 lv = *(const f32x4*)(Ls + i * LDL + 4 * j4);
#pragma unroll
            for (int e = 0; e < 4; ++e) if (4 * j4 + e < i) a -= lv[e] * X[4 * j4 + e]; }
        X[i] = a;
    }
}
constexpr int QP = 132;
constexpr int WSTP = 136;
__device__ __forceinline__ void ph_gdn_prep(const P& p, int l, unsigned char* smem) {
    float* Ls = (float*)smem; float* As = Ls + 64 * 68; float* gs = As + 64 * 68; float* gcs = gs + 64; float* bts = gcs + 64;
    float* qs = bts + 64; float* ks = qs + 64 * QP; float* vs = ks + 64 * QP;
    const int tid = tidx(); const bf16_t* PR = WSP(bf16_t, WS_PROJ);
    for (int u = blockIdx.x; u < NUNIT; u += gridDim.x) {
        const int n = u % NCH, h = (u / NCH) % 4, b = u / (NCH * 4);
        __syncthreads();
        if (tid < 384) { const int sec = tid >> 7, c = tid & 127, col = sec * 512 + h * 128 + c; float* dst = sec == 0 ? qs : sec == 1 ? ks : vs;
            const float w0 = p.conv_w[(l * 4 + 0) * 1536 + col], w1 = p.conv_w[(l * 4 + 1) * 1536 + col], w2 = p.conv_w[(l * 4 + 2) * 1536 + col], w3 = p.conv_w[(l * 4 + 3) * 1536 + col];
            const int t0 = n * 64; const bf16_t* src = PR + (size_t)(b * T) * NPROJ + C_CONV + col;
            float x0 = t0 >= 3 ? bf2f(src[(size_t)(t0 - 3) * NPROJ]) : 0.f, x1 = t0 >= 2 ? bf2f(src[(size_t)(t0 - 2) * NPROJ]) : 0.f, x2 = t0 >= 1 ? bf2f(src[(size_t)(t0 - 1) * NPROJ]) : 0.f;
            const bf16_t* sp = src + (size_t)t0 * NPROJ; float* dp = dst + c;
#pragma unroll 4
            for (int i = 0; i < 64; ++i) { const float x3 = bf2f(*sp); const float y = w0 * x0 + w1 * x1 + w2 * x2 + w3 * x3; *dp = silu_f(y); x0 = x1; x1 = x2; x2 = x3; sp += NPROJ; dp += QP; } }
        else if (tid < 448) { const int i = tid - 384; const size_t row = (size_t)(b * T + n * 64 + i); gs[i] = WSP(float, WS_G)[row * 4 + h]; bts[i] = WSP(float, WS_BETA)[row * 4 + h]; }
        __syncthreads();
        { const int rid = tid >> 2, part = tid & 3; float* rowp = (rid < 64 ? qs + rid * QP : ks + (rid - 64) * QP) + part * 32; float s = 0.f;
          for (int d = 0; d < 32; ++d) s += rowp[d] * rowp[d];
          s += __shfl_xor(s, 1); s += __shfl_xor(s, 2); const float sc = 1.0f / sqrtf(s + EPS);
          for (int d = 0; d < 32; ++d) rowp[d] *= sc; }
        if (tid == 0) { float a = 0.f; for (int i = 0; i < 64; ++i) { a += gs[i]; gcs[i] = a; } }
        __syncthreads();
        { const int i = tid >> 3, j0 = (tid & 7) * 8;
#pragma unroll
          for (int jj = 0; jj < 8; ++jj) { const int j = j0 + jj; float lv = 0.f, av = 0.f;
              if (j <= i) { float dk = 0.f, dq = 0.f; for (int d = 0; d < 128; ++d) { const float kj = ks[j * QP + d]; dk += ks[i * QP + d] * kj; dq += qs[i * QP + d] * kj; }
                  const float e = expf(gcs[i] - gcs[j]); av = dq * e * 0.08838834764831845f; lv = j < i ? bts[i] * dk * e : 0.f; }
              Ls[i * 68 + j] = lv; As[i * 68 + j] = av; } }
        __syncthreads();
        float X[64]; const int c = tid;
        if (tid < 256) {
            if (c < 128) {
#pragma unroll
                for (int i = 0; i < 64; ++i) X[i] = vs[i * QP + c] * bts[i]; }
            else {
#pragma unroll
                for (int i = 0; i < 64; ++i) X[i] = ks[i * QP + c - 128] * bts[i] * expf(gcs[i]); } }
        __syncthreads();
        if (tid < 256) {
            fwd_subst<64, 68>(X, Ls);
            if (c < 128) { float* U = WSP(float, WS_GU) + (size_t)u * 8192 + c * 64;
#pragma unroll
                for (int i4 = 0; i4 < 16; ++i4) *(f32x4*)(U + 4 * i4) = (f32x4){X[4 * i4], X[4 * i4 + 1], X[4 * i4 + 2], X[4 * i4 + 3]}; }
            else { bf16_t* wst = (bf16_t*)vs + (c - 128);
#pragma unroll
                for (int i = 0; i < 64; ++i) wst[i * WSTP] = f2bf(-X[i]); }
        } else { const int t2 = tid - 256; const float gl = gcs[63];
#pragma unroll 2
            for (int e = t2; e < 8192; e += 256) { const int i = e >> 7, d = e & 127;
                WSP(bf16_t, WS_GQ)[(size_t)u * 8192 + e] = f2bf(qs[i * QP + d] * 0.08838834764831845f * expf(gcs[i])); }
#pragma unroll 2
            for (int e = t2; e < 4096; e += 256) WSP(bf16_t, WS_GA)[(size_t)u * 4096 + e] = f2bf(As[(e >> 6) * 68 + (e & 63)]);
            if (t2 == 0) WSP(float, WS_GD)[u] = expf(gl); }
        __syncthreads();
        { bf16_t* dst = WSP(bf16_t, WS_GWK) + (size_t)u * 16384; const bf16_t* wst = (const bf16_t*)vs; const float gl = gcs[63];
#pragma unroll
          for (int k = 0; k < 2; ++k) { const int f = tid + NTHR * k, lane = f & 63, ks4 = (f >> 6) & 3, mt = f >> 8, q = lane >> 4, x = lane & 15;
              const bf16_t* wr = wst + (16 * mt + x) * WSTP + 32 * ks4 + 4 * q;
              u32x4 w; w.x = (unsigned)wr[0] | ((unsigned)wr[1] << 16); w.y = (unsigned)wr[2] | ((unsigned)wr[3] << 16); w.z = (unsigned)wr[16] | ((unsigned)wr[17] << 16); w.w = (unsigned)wr[18] | ((unsigned)wr[19] << 16);
              *(u32x4*)(dst + (size_t)f * 8) = w; }
#pragma unroll
          for (int k = 0; k < 2; ++k) { const int f = tid + NTHR * k, lane = f & 63, ks2 = (f >> 6) & 1, mt = f >> 7, q = lane >> 4, x = lane & 15, dk = 16 * mt + x, i0 = 32 * ks2 + 4 * q;
              float v[8];
#pragma unroll
              for (int e = 0; e < 8; ++e) { const int i = i0 + (e < 4 ? e : 12 + e); v[e] = ks[i * QP + dk] * expf(gl - gcs[i]); }
              u32x4 w; w.x = pk2(v[0], v[1]); w.y = pk2(v[2], v[3]); w.z = pk2(v[4], v[5]); w.w = pk2(v[6], v[7]);
              *(u32x4*)(dst + 8192 + (size_t)f * 8) = w; } }
    }
}
__device__ __forceinline__ bf16x8 pack_tiles(const f32x4& lo, const f32x4& hi) {
    u32x4 w; w.x = pk2(lo[0], lo[1]); w.y = pk2(lo[2], lo[3]); w.z = pk2(hi[0], hi[1]); w.w = pk2(hi[2], hi[3]); return __builtin_bit_cast(bf16x8, w);
}
constexpr int CH_SLOT = 32768, CH_NSLOT = 4;
__device__ __forceinline__ void ph_gdn_chain(const P& p, int l, unsigned char* smem) {
    const int tid = tidx(), lane = tid & 63, wave = UNIFORM(tid >> 6), j = lane & 15, q = lane >> 4;
    for (int it = blockIdx.x; it < PB * 4 * 2; it += gridDim.x) {
        const int half = it & 1, bh = it >> 1;
        const bf16_t* WK = WSP(bf16_t, WS_GWK) + (size_t)bh * NCH * 16384;
        __syncthreads();
        if (wave >= 4) {
            const int pw = wave - 4;
#pragma unroll 1
            for (int m = 0; m < 3 && m < NCH; ++m)
#pragma unroll
                for (int k = 0; k < 8; ++k) GLDS16((const unsigned char*)(WK + (size_t)m * 16384) + (pw * 8 + k) * 1024 + lane * 16, smem + m * CH_SLOT + (pw * 8 + k) * 1024);
#pragma unroll 1
            for (int n = 0; n < NCH; ++n) {
                if (n + 2 < NCH) WAIT_VM(16); else if (n + 1 < NCH) WAIT_VM(8); else WAIT_VM(0);
                RAW_BARRIER();
                const int m = n + 3;
                if (m < NCH) {
#pragma unroll
                    for (int k = 0; k < 8; ++k) GLDS16((const unsigned char*)(WK + (size_t)m * 16384) + (pw * 8 + k) * 1024 + lane * 16, smem + (m & 3) * CH_SLOT + (pw * 8 + k) * 1024); }
            }
        } else {
            const int sl = half * 4 + wave, c = 16 * sl + j;
            f32x4 S[8];
#pragma unroll
            for (int t = 0; t < 8; ++t) S[t] = (f32x4){0.f, 0.f, 0.f, 0.f};
            bf16x8 sB[4];
#pragma unroll
            for (int ks = 0; ks < 4; ++ks) sB[ks] = pack_tiles(S[2 * ks], S[2 * ks + 1]);
            const float* UT = WSP(float, WS_GU) + (size_t)bh * NCH * 8192 + c * 64 + 4 * q;
            f32x4 un[4];
#pragma unroll
            for (int mt = 0; mt < 4; ++mt) un[mt] = *(const f32x4*)(UT + 16 * mt);
            float decn = WSP(float, WS_GD)[bh * NCH];
#pragma unroll 1
            for (int n = 0; n < NCH; ++n) {
                const int u = bh * NCH + n;
                f32x4 acc[4]; const float dec = decn;
#pragma unroll
                for (int mt = 0; mt < 4; ++mt) acc[mt] = un[mt];
                if (n + 1 < NCH) {
#pragma unroll
                    for (int mt = 0; mt < 4; ++mt) un[mt] = *(const f32x4*)(UT + (size_t)(n + 1) * 8192 + 16 * mt);
                    decn = WSP(float, WS_GD)[u + 1]; }
                { bf16_t* sp = WSP(bf16_t, WS_GS) + (size_t)u * 16384 + c * 128 + 4 * q;
#pragma unroll
                  for (int t = 0; t < 8; ++t) { u32x2 w; w.x = pk2(S[t][0], S[t][1]); w.y = pk2(S[t][2], S[t][3]); *(u32x2*)(sp + 16 * t) = w; } }
                WAIT_LGKM0();
                RAW_BARRIER();
                const unsigned char* slot = smem + (n & 3) * CH_SLOT + lane * 16;
#pragma unroll
                for (int mt = 0; mt < 4; ++mt)
#pragma unroll
                    for (int ks = 0; ks < 4; ++ks) acc[mt] = MFMA16(*(const bf16x8*)(slot + (mt * 4 + ks) * 1024), sB[ks], acc[mt]);
                { bf16_t* vp = WSP(bf16_t, WS_GV) + (size_t)u * 8192 + c * 64 + 4 * q;
#pragma unroll
                  for (int mt = 0; mt < 4; ++mt) { u32x2 w; w.x = pk2(acc[mt][0], acc[mt][1]); w.y = pk2(acc[mt][2], acc[mt][3]); *(u32x2*)(vp + 16 * mt) = w; } }
                const bf16x8 vB0 = pack_tiles(acc[0], acc[1]), vB1 = pack_tiles(acc[2], acc[3]);
#pragma unroll
                for (int t = 0; t < 8; ++t) { S[t] = S[t] * dec;
                    S[t] = MFMA16(*(const bf16x8*)(slot + 16384 + (t * 2 + 0) * 1024), vB0, S[t]);
                    S[t] = MFMA16(*(const bf16x8*)(slot + 16384 + (t * 2 + 1) * 1024), vB1, S[t]); }
#pragma unroll
                for (int ks = 0; ks < 4; ++ks) sB[ks] = pack_tiles(S[2 * ks], S[2 * ks + 1]);
            }
            float* o = p.out + O_PGDN + ((size_t)l * PB * 4 + bh) * 16384 + c;
#pragma unroll
            for (int t = 0; t < 8; ++t)
#pragma unroll
                for (int e = 0; e < 4; ++e) o[(size_t)(16 * t + 4 * q + e) * 128] = S[t][e];
        }
    }
}
__device__ __forceinline__ void ph_gdn_out(const P& p, int l) {
    const int tid = tidx(), lane = tid & 63, wave = tid >> 6, j = lane & 15, q = lane >> 4, mt = wave & 3;
    const bf16_t* PR = WSP(bf16_t, WS_PROJ);
    for (int u = blockIdx.x * 2 + (wave >> 2); u < NUNIT; u += gridDim.x * 2) {
        const int n = u % NCH, h = (u / NCH) % 4, b = u / (NCH * 4);
        f32x4 acc[8];
#pragma unroll
        for (int ct = 0; ct < 8; ++ct) acc[ct] = (f32x4){0.f, 0.f, 0.f, 0.f};
        const bf16_t* qg = WSP(bf16_t, WS_GQ) + (size_t)u * 8192 + (16 * mt + j) * 128 + 8 * q;
        const bf16_t* st = WSP(bf16_t, WS_GS) + (size_t)u * 16384 + j * 128 + 8 * q;
#pragma unroll
        for (int ks = 0; ks < 4; ++ks) { const bf16x8 a = *(const bf16x8*)(qg + 32 * ks);
#pragma unroll
            for (int ct = 0; ct < 8; ++ct) acc[ct] = MFMA16(a, *(const bf16x8*)(st + (size_t)ct * 16 * 128 + 32 * ks), acc[ct]);
            COMPILER_FENCE(); }
        const bf16_t* at = WSP(bf16_t, WS_GA) + (size_t)u * 4096 + (16 * mt + j) * 64 + 8 * q;
        const bf16_t* vt = WSP(bf16_t, WS_GV) + (size_t)u * 8192 + j * 64 + 8 * q;
#pragma unroll
        for (int ks = 0; ks < 2; ++ks) { const bf16x8 a = *(const bf16x8*)(at + 32 * ks);
#pragma unroll
            for (int ct = 0; ct < 8; ++ct) acc[ct] = MFMA16(a, *(const bf16x8*)(vt + (size_t)ct * 16 * 64 + 32 * ks), acc[ct]);
            COMPILER_FENCE(); }
        float sq[4];
#pragma unroll
        for (int e = 0; e < 4; ++e) { float s = 0.f;
#pragma unroll
            for (int ct = 0; ct < 8; ++ct) s += acc[ct][e] * acc[ct][e];
            s += __shfl_xor(s, 1); s += __shfl_xor(s, 2); s += __shfl_xor(s, 4); s += __shfl_xor(s, 8); sq[e] = 1.0f / sqrtf(s * (1.0f / 128.0f) + EPS); }
#pragma unroll
        for (int e = 0; e < 4; ++e) { const size_t row = (size_t)(b * T + n * 64 + 16 * mt + 4 * q + e);
#pragma unroll
            for (int ct = 0; ct < 8; ++ct) { const int c = 16 * ct + j; const float z = bf2f(PR[row * NPROJ + C_Z + h * 128 + c]);
                WSP(bf16_t, WS_O)[row * D + 512 + h * 128 + c] = f2bf(acc[ct][e] * sq[e] * p.gdn_norm[l * 128 + c] * silu_f(z)); } }
    }
}
__device__ __forceinline__ void ph_gdn_sample(const P& p, int l, unsigned char* smem) {
    float* qs = (float*)smem; float* ks = qs + 8 * QP; float* vs = ks + 8 * QP; float* us = vs + 8 * QP; float* wsm = us + 8 * 128; float* vn = wsm + 8 * 128;
    float* Ls = vn + 8 * 128; float* As = Ls + 8 * 8; float* gs = As + 8 * 8; float* gcs = gs + 8; float* bts = gcs + 8; float* S0 = bts + 8;
    const int tid = tidx(); const bf16_t* PR = WSP(bf16_t, WS_PROJ);
    for (int u = blockIdx.x; u < DB * 4; u += gridDim.x) {
        const int h = u & 3, b = u >> 2;
        __syncthreads();
#pragma unroll 4
        for (int e = tid; e < 16384; e += NTHR) S0[e] = p.state_gdn[(((size_t)l * DB + b) * 4 + h) * 16384 + e];
        if (tid < 384) { const int sec = tid >> 7, c = tid & 127, col = sec * 512 + h * 128 + c; float* dst = sec == 0 ? qs : sec == 1 ? ks : vs;
            const float w0 = p.conv_w[(l * 4 + 0) * 1536 + col], w1 = p.conv_w[(l * 4 + 1) * 1536 + col], w2 = p.conv_w[(l * 4 + 2) * 1536 + col], w3 = p.conv_w[(l * 4 + 3) * 1536 + col];
            const float* hist = p.state_conv + (((size_t)l * DB + b) * 3) * 1536 + col; const bf16_t* src = PR + (size_t)(MP + b * DS) * NPROJ + C_CONV + col;
            float x0 = hist[0], x1 = hist[1536], x2 = hist[2 * 1536];
            for (int i = 0; i < DS; ++i) { const float x3 = bf2f(src[(size_t)i * NPROJ]); const float y = w0 * x0 + w1 * x1 + w2 * x2 + w3 * x3; dst[i * QP + c] = silu_f(y); x0 = x1; x1 = x2; x2 = x3; } }
        else if (tid < 384 + DS) { const int i = tid - 384; const size_t row = (size_t)(MP + b * DS + i); gs[i] = WSP(float, WS_G)[row * 4 + h]; bts[i] = WSP(float, WS_BETA)[row * 4 + h]; }
        __syncthreads();
        if (tid < 64) { const int rid = tid >> 2, part = tid & 3; float* rowp = (rid < 8 ? qs + rid * QP : ks + (rid - 8) * QP) + part * 32; float s = 0.f;
            for (int d = 0; d < 32; ++d) s += rowp[d] * rowp[d];
            s += __shfl_xor(s, 1); s += __shfl_xor(s, 2); const float sc = 1.0f / sqrtf(s + EPS);
            for (int d = 0; d < 32; ++d) rowp[d] *= sc; }
        if (tid == 64) { float a = 0.f; for (int i = 0; i < DS; ++i) { a += gs[i]; gcs[i] = a; } }
        __syncthreads();
        if (tid < 64) { const int i = tid >> 3, j = tid & 7; float lv = 0.f, av = 0.f;
            if (j <= i) { float dk = 0.f, dq = 0.f; for (int d = 0; d < 128; ++d) { const float kj = ks[j * QP + d]; dk += ks[i * QP + d] * kj; dq += qs[i * QP + d] * kj; }
                const float e = expf(gcs[i] - gcs[j]); av = dq * e * 0.08838834764831845f; lv = j < i ? bts[i] * dk * e : 0.f; }
            Ls[i * 8 + j] = lv; As[i * 8 + j] = av; }
        __syncthreads();
        if (tid < 256) { const int c = tid; float X[8];
            if (c < 128) {
#pragma unroll
                for (int i = 0; i < 8; ++i) X[i] = vs[i * QP + c] * bts[i]; }
            else {
#pragma unroll
                for (int i = 0; i < 8; ++i) X[i] = ks[i * QP + c - 128] * bts[i] * expf(gcs[i]); }
            fwd_subst<8, 8>(X, Ls);
            float* dst = c < 128 ? us + c : wsm + c - 128;
#pragma unroll
            for (int i = 0; i < 8; ++i) dst[i * 128] = X[i]; }
        __syncthreads();
        const int i = tid >> 6, c2 = (tid & 63) * 2;
        { float a0 = us[i * 128 + c2], a1 = us[i * 128 + c2 + 1];
          for (int d = 0; d < 128; ++d) { const float w = wsm[i * 128 + d]; a0 -= w * S0[d * 128 + c2]; a1 -= w * S0[d * 128 + c2 + 1]; }
          vn[i * 128 + c2] = a0; vn[i * 128 + c2 + 1] = a1; }
        __syncthreads();
        { float o0 = 0.f, o1 = 0.f; const float qsc = 0.08838834764831845f * expf(gcs[i]);
          for (int d = 0; d < 128; ++d) { const float qg = qs[i * QP + d] * qsc; o0 += qg * S0[d * 128 + c2]; o1 += qg * S0[d * 128 + c2 + 1]; }
          for (int j = 0; j < DS; ++j) { const float a = As[i * 8 + j]; o0 += a * vn[j * 128 + c2]; o1 += a * vn[j * 128 + c2 + 1]; }
          const float rstd = 1.0f / sqrtf(wave_sum(o0 * o0 + o1 * o1) * (1.0f / 128.0f) + EPS);
          const size_t row = (size_t)(MP + b * DS + i);
          const float z0 = bf2f(PR[row * NPROJ + C_Z + h * 128 + c2]), z1 = bf2f(PR[row * NPROJ + C_Z + h * 128 + c2 + 1]);
          bf16_t* O = WSP(bf16_t, WS_O) + row * D + 512 + h * 128 + c2;
          O[0] = f2bf(o0 * rstd * p.gdn_norm[l * 128 + c2] * silu_f(z0)); O[1] = f2bf(o1 * rstd * p.gdn_norm[l * 128 + c2 + 1] * silu_f(z1)); }
        { const float gl = gcs[DS - 1], dec = expf(gl); float* o = p.out + O_SGDN + (((size_t)l * DB + b) * 4 + h) * 16384;
#pragma unroll 2
          for (int e = tid; e < 16384; e += NTHR) { const int d = e >> 7, c = e & 127; float s = S0[e] * dec;
              for (int j = 0; j < DS; ++j) s += ks[j * QP + d] * expf(gl - gcs[j]) * vn[j * 128 + c];
              o[e] = s; } }
    }
}

__device__ __forceinline__ void ph_final_norm(const P& p) {
    const int lane = tidx() & 63, wave = tidx() >> 6, gw = blockIdx.x * 8 + wave, ngw = gridDim.x * 8;
    for (int r = gw; r < M; r += ngw) {
        float* xr = p.out + (size_t)r * D; f32x4 v[4]; float ss = 0.f;
#pragma unroll
        for (int j = 0; j < 4; ++j) { v[j] = *(const f32x4*)(xr + 4 * lane + 256 * j); ss += (v[j][0] * v[j][0] + v[j][1] * v[j][1]) + (v[j][2] * v[j][2] + v[j][3] * v[j][3]); }
        const float rstd = 1.0f / sqrtf(wave_sum(ss) * (1.0f / D) + EPS);
#pragma unroll
        for (int j = 0; j < 4; ++j) { const f32x4 g = *(const f32x4*)(p.final_norm + 4 * lane + 256 * j); *(f32x4*)(xr + 4 * lane + 256 * j) = v[j] * rstd * g; }
    }
}

enum Phase { PH_PRO = 0, PH_NORM1, PH_GEMM_IN, PH_ROPE, PH_MIX1, PH_MIX2, PH_MIX3, PH_GEMM_OUT, PH_NORM2, PH_GEMM_GU, PH_GEMM_DN, PH_FINAL };
#ifdef __HIP_EMU__
#define LDSP(x) (x)
#else
#define LDSP(x) ((PG8_LAS unsigned char*)(x))
#endif
template <int PH> __device__ __forceinline__ void run_phase(const P& p, int l, unsigned char* smem) {
    if constexpr (PH == PH_PRO) { ph_convert(p, smem); __syncthreads(); ph_adaln(p, smem); ph_ropetab_copyx(p); }
    else if constexpr (PH == PH_NORM1) ph_norm_mod<0>(p, l);
    else if constexpr (PH == PH_GEMM_IN) {
        pg8::Gemm g{WSP(bf16_t, WS_H), WSP(bf16_t, WS_WIN) + (size_t)l * NPROJ * D, MPAD, NPROJ, D}; pg8::StaticOrder S; S.init(MPAD, NPROJ, (int)gridDim.x, (int)blockIdx.x);
        pg8::EpiStoreBf16 E{WSP(bf16_t, WS_PROJ), NPROJ};
        pg8::gemm_phase<pg8::EpiStoreBf16, pg8::StaticOrder, true, true>(LDSP(smem), g, S, E);
    }
    else if constexpr (PH == PH_ROPE) { ph_rope_out(p, l); ph_vtrans(p, smem); }
    else if constexpr (PH == PH_MIX1) { ph_attn_jobs(p); __syncthreads(); ph_attn_sample(p, l, smem); ph_ret_local(p, l, smem); ph_gdn_prep(p, l, smem); ph_ret_sample(p, l, smem); ph_gdn_sample(p, l, smem); }
    else if constexpr (PH == PH_MIX2) { ph_gdn_chain(p, l, smem); ph_ret_scan(p, l); ph_attn_combine(p); }
    else if constexpr (PH == PH_MIX3) { ph_ret_out(p, l, smem); ph_gdn_out(p, l); }
    else if constexpr (PH == PH_GEMM_OUT) {
        pg8::Gemm g{WSP(bf16_t, WS_O), WSP(bf16_t, WS_WOUT) + (size_t)l * D * D, MPAD, D, D}; pg8::StaticOrder S; S.init(MPAD, D, (int)gridDim.x, (int)blockIdx.x);
        pg8::EpiResidual E{p.out, WSP(float, WS_MOD) + (size_t)l * NC * 6144 + 2048};
        pg8::gemm_phase<pg8::EpiResidual, pg8::StaticOrder, true, true>(LDSP(smem), g, S, E);
    }
    else if constexpr (PH == PH_NORM2) ph_norm_mod<1>(p, l);
    else if constexpr (PH == PH_GEMM_GU) {
        pg8::Gemm g{WSP(bf16_t, WS_H), WSP(bf16_t, WS_WGU) + (size_t)l * 2 * FF * D, MPAD, 2 * FF, D}; pg8::StaticOrder S; S.init(MPAD, 2 * FF, (int)gridDim.x, (int)blockIdx.x);
        pg8::EpiSwiglu E{WSP(bf16_t, WS_HID)};
        pg8::gemm_phase<pg8::EpiSwiglu, pg8::StaticOrder, true, true>(LDSP(smem), g, S, E);
    }
    else if constexpr (PH == PH_GEMM_DN) {
        pg8::Gemm g{WSP(bf16_t, WS_HID), WSP(bf16_t, WS_WDN) + (size_t)l * D * FF, MPAD, D, FF}; pg8::StaticOrder S; S.init(MPAD, D, (int)gridDim.x, (int)blockIdx.x);
        pg8::EpiResidual E{p.out, WSP(float, WS_MOD) + (size_t)l * NC * 6144 + 5120};
        pg8::gemm_phase<pg8::EpiResidual, pg8::StaticOrder, true, true>(LDSP(smem), g, S, E);
    }
    else if constexpr (PH == PH_FINAL) ph_final_norm(p);
}
template <int PH> __global__ void __launch_bounds__(NTHR, 2) k_phase(P p, int l) { DYN_SMEM(smem); run_phase<PH>(p, l, smem); }


#ifndef __HIP_EMU__
#define LAS __attribute__((address_space(3)))
#define XB_TMO      128
#define XB_XCNT(j)  (256  + 64 * (j))
#define XB_XSUB(j)  (1280 + 64 * (j))
#define XB_XGEN(j)  (2304 + 64 * (j))
#define XB_TOP      3328
#define XB_TOPGEN   3392
#define XCD_BAR_WORDS 3456
#define XB_SPIN_CAP (1u << 18)

__device__ __forceinline__ unsigned xb_ld(unsigned* p)              { return __hip_atomic_load(p, __ATOMIC_RELAXED, __HIP_MEMORY_SCOPE_AGENT); }
__device__ __forceinline__ unsigned xb_add(unsigned* p, unsigned v) { return __hip_atomic_fetch_add(p, v, __ATOMIC_RELAXED, __HIP_MEMORY_SCOPE_AGENT); }
__device__ __forceinline__ unsigned xb_xcc_id() { return (unsigned)__builtin_amdgcn_s_getreg((3 << 11) | 20) & 0xFu; }
#define XB_SPIN(cond, bar) do { unsigned _sp = 0; while (cond) { __builtin_amdgcn_s_sleep(1); \
    if ((++_sp & 255u) == 0u) { if (xb_ld(&(bar)[XB_TMO])) break; if (_sp > XB_SPIN_CAP) { atomicAdd(&(bar)[XB_TMO], 1u); break; } } } } while (0)

struct XcdBarrier {
    unsigned* bar; unsigned x;
    volatile LAS unsigned* st;
};

__device__ __forceinline__ XcdBarrier xcd_barrier_post(unsigned* bar, volatile LAS unsigned* st) {
    XcdBarrier b; b.bar = bar; b.x = xb_xcc_id(); b.st = st;
    if (threadIdx.x == 0) (void)xb_add(&bar[XB_XCNT(b.x)], 1u);
    return b;
}
__device__ __forceinline__ void xcd_barrier_complete(unsigned* bar, unsigned x, unsigned& nloc, unsigned& nx) {
    const unsigned G = gridDim.x * gridDim.y * gridDim.z;
    unsigned sum, cnt, mine, sp = 0u;
    for (;;) {
        sum = 0u; cnt = 0u; mine = 0u;
#pragma unroll
        for (unsigned j = 0; j < 16; ++j) { const unsigned c = xb_ld(&bar[XB_XCNT(j)]); sum += c; cnt += (c > 0u) ? 1u : 0u; mine = (j == x) ? c : mine; }
        if (sum == G) break;
        __builtin_amdgcn_s_sleep(1);
        if ((++sp & 255u) == 0u) { if (xb_ld(&bar[XB_TMO])) break; if (sp > XB_SPIN_CAP) { atomicAdd(&bar[XB_TMO], 1u); break; } }
    }
    nloc = mine > 0u ? mine : 1u; nx = cnt > 0u ? cnt : 1u;
}

__device__ __forceinline__ void xcd_barrier(const XcdBarrier& b) {
    asm volatile("s_waitcnt vmcnt(0)" ::: "memory");
    __syncthreads();
    if (threadIdx.x == 0) {
        unsigned* bar = b.bar;
        __builtin_amdgcn_s_waitcnt(0);
        unsigned nloc = b.st[0], nx = b.st[1];
        if (nloc == 0u) { xcd_barrier_complete(bar, b.x, nloc, nx); b.st[0] = nloc; b.st[1] = nx; }
        const unsigned old = xb_add(&bar[XB_XSUB(b.x)], 1u);
        const unsigned gen = old / nloc;
        if (old + 1u == (gen + 1u) * nloc) {
            __builtin_amdgcn_fence(__ATOMIC_RELEASE, "agent");
            asm volatile("s_waitcnt vmcnt(0)" ::: "memory");
            const unsigned og = xb_add(&bar[XB_TOP], 1u);
            const unsigned tg = og / nx;
            if (og + 1u == (tg + 1u) * nx) xb_add(&bar[XB_TOPGEN], 1u);
            else XB_SPIN(xb_ld(&bar[XB_TOPGEN]) == tg, bar);
            __builtin_amdgcn_fence(__ATOMIC_ACQUIRE, "agent");
            xb_add(&bar[XB_XGEN(b.x)], 1u);
            asm volatile("s_waitcnt vmcnt(0)" ::: "memory");
        } else {
            XB_SPIN(xb_ld(&bar[XB_XGEN(b.x)]) == gen, bar);
            __builtin_amdgcn_fence(__ATOMIC_ACQUIRE, "agent");
            asm volatile("s_waitcnt vmcnt(0)" ::: "memory");
        }
    }
    __syncthreads();
}

#endif

#ifndef __HIP_EMU__
#define GRID_SYNC() xcd_barrier(bar)
__global__ void __launch_bounds__(NTHR, 2) k_mega(P p_arg) {
    DYN_SMEM(smem);
#if defined(__HIP_DEVICE_COMPILE__)
#define PHASE(PH_, l_) do { const __attribute__((address_space(4))) P* kp_ = (const __attribute__((address_space(4))) P*)__builtin_amdgcn_kernarg_segment_ptr(); LAUNDER_PTR(kp_); P pl_; __builtin_memcpy(&pl_, kp_, sizeof(P)); run_phase<PH_>(pl_, l_, smem); } while (0)
#else
#define PHASE(PH_, l_) run_phase<PH_>(p_arg, l_, smem)
#endif
    cooperative_groups::grid_group grid = cooperative_groups::this_grid();
    volatile LAS unsigned* bst = (volatile LAS unsigned*)((LAS unsigned char*)smem + BAR_LDS_OFF);
    if (threadIdx.x < 4) bst[threadIdx.x] = 0u;
    __syncthreads();
    XcdBarrier bar = xcd_barrier_post((unsigned*)(p_arg.ws + WS_CTL + 4096), bst);
    PHASE(PH_PRO, 0); grid.sync();
#define LAYER(l) do { PHASE(PH_NORM1, l); GRID_SYNC(); PHASE(PH_GEMM_IN, l); GRID_SYNC(); PHASE(PH_ROPE, l); GRID_SYNC(); PHASE(PH_MIX1, l); GRID_SYNC(); PHASE(PH_MIX2, l); GRID_SYNC(); \
        PHASE(PH_MIX3, l); GRID_SYNC(); PHASE(PH_GEMM_OUT, l); GRID_SYNC(); PHASE(PH_NORM2, l); GRID_SYNC(); PHASE(PH_GEMM_GU, l); GRID_SYNC(); PHASE(PH_GEMM_DN, l); GRID_SYNC(); } while (0)
    static_assert(NL == 2, "two layers written out (a loop over the layers makes hipcc hoist every phase's constants to the loop preheader and spill)");
    LAYER(0); LAYER(1);
    PHASE(PH_FINAL, 0);
}
#endif

template <int PH> static void launch_phase(const P& p, int l, int grid, hipStream_t stream) {
#ifndef __HIP_EMU__
    static bool attr_done = false;
    if (!attr_done) { (void)hipFuncSetAttribute((const void*)k_phase<PH>, hipFuncAttributeMaxDynamicSharedMemorySize, SMEM_BYTES); attr_done = true; }
#endif
    LAUNCH(k_phase<PH>, grid, SMEM_BYTES, stream, p, l);
}

extern "C" void kernel_launch(void* const* d_in, const int* in_sizes, int n_in, void* d_out, int out_size, void* d_ws, size_t ws_size, hipStream_t stream) {
    if (n_in != 24 || (size_t)out_size != O_END || ws_size < WS_END) {
        fprintf(stderr, "kernel_launch: shape mismatch: n_in %d out_size %d (want %zu) ws %zu (want %zu)\n", n_in, out_size, (size_t)O_END, ws_size, (size_t)WS_END); return; }
    P p{};
    const float** pp = (const float**)&p;
    for (int i = 0; i < 24; ++i) pp[i] = (const float*)d_in[i];
    p.out = (float*)d_out; p.ws = (unsigned char*)d_ws;
#ifndef __HIP_EMU__
    static int grid = 0;
    if (grid == 0) {
        int dev = 0, cus = 0, per_cu = 0;
        if (hipGetDevice(&dev) != hipSuccess || hipDeviceGetAttribute(&cus, hipDeviceAttributeMultiprocessorCount, dev) != hipSuccess || cus <= 0) { fprintf(stderr, "kernel_launch: device query failed\n"); grid = -1; return; }
        if (hipFuncSetAttribute((const void*)k_mega, hipFuncAttributeMaxDynamicSharedMemorySize, SMEM_BYTES) != hipSuccess) { fprintf(stderr, "kernel_launch: hipFuncSetAttribute failed\n"); grid = -1; return; }
        if (hipOccupancyMaxActiveBlocksPerMultiprocessor(&per_cu, (const void*)k_mega, NTHR, SMEM_BYTES) != hipSuccess || per_cu < 1) { fprintf(stderr, "kernel_launch: occupancy query says %d blocks per CU\n", per_cu); grid = -1; return; }
        grid = cus;
    }
    if (grid < 0) return;
    if (hipMemsetAsync((char*)d_ws + WS_CTL, 0, 65536, stream) != hipSuccess) { fprintf(stderr, "kernel_launch: memset of the barrier words failed\n"); return; }
    { void* args[] = {(void*)&p};
      hipError_t e = hipLaunchCooperativeKernel((const void*)k_mega, dim3(grid), dim3(NTHR), args, SMEM_BYTES, stream);
      if (e != hipSuccess) fprintf(stderr, "kernel_launch: cooperative launch failed: %s (grid %d)\n", hipGetErrorString(e), grid);
      return; }
#else
    int grid = 16;
#endif
    launch_phase<PH_PRO>(p, 0, grid, stream);
    for (int l = 0; l < NL; ++l) {
        launch_phase<PH_NORM1>(p, l, grid, stream);
        launch_phase<PH_GEMM_IN>(p, l, grid, stream);
        launch_phase<PH_ROPE>(p, l, grid, stream);
        launch_phase<PH_MIX1>(p, l, grid, stream);
        launch_phase<PH_MIX2>(p, l, grid, stream);
        launch_phase<PH_MIX3>(p, l, grid, stream);
        launch_phase<PH_GEMM_OUT>(p, l, grid, stream);
        launch_phase<PH_NORM2>(p, l, grid, stream);
        launch_phase<PH_GEMM_GU>(p, l, grid, stream);
        launch_phase<PH_GEMM_DN>(p, l, grid, stream);
    }
    launch_phase<PH_FINAL>(p, 0, grid, stream);
}
```

```cpp
#ifndef __HIP_EMU__
#include <hip/hip_runtime.h>
#include <hip/hip_cooperative_groups.h>
#endif
#include <cstdio>
#include <cstdint>
#include <cmath>

#ifndef CFG_BATCH
#define CFG_BATCH 2
#endif
#ifndef CFG_SEQ
#define CFG_SEQ 8192
#endif
#ifndef CFG_DB
#define CFG_DB 32
#endif
constexpr float LOG2E = 1.4426950408889634f;
constexpr int D = 1024, NL = 2, PB = CFG_BATCH, T = CFG_SEQ, DB = CFG_DB, DS = 8, PAST = 16384, WB = 2048;
constexpr int MP = PB * T, MS = DB * DS, M = MP + MS, MPAD = (M + 255) / 256 * 256, NC = PB + DB;
constexpr int INC = 3848, NPROJ = 3840, FF = 2816, NCH = T / 64, PWIN = T < 2048 ? T : 2048, NPOS = T + DS;
constexpr int NUNIT = PB * 4 * NCH;
constexpr float EPS = 1e-6f;
static_assert(T % 512 == 0, "the attention job decomposition wants T % 512 == 0");
constexpr int C_QA = 0, C_KA = 256, C_VA = 512, C_QR = 768, C_KR = 1024, C_VR = 1280, C_GR = 1536, C_CONV = 1792, C_Z = 3328;
constexpr int SMEM_BYTES = 147456;
constexpr int NTHR = 512;
constexpr int BAR_LDS_OFF = SMEM_BYTES - 64;

typedef unsigned short bf16_t;
typedef short bf16x8 __attribute__((ext_vector_type(8)));
typedef float f32x4 __attribute__((ext_vector_type(4)));
typedef unsigned u32x4 __attribute__((ext_vector_type(4)));
typedef unsigned u32x2 __attribute__((ext_vector_type(2)));
typedef float f32x16 __attribute__((ext_vector_type(16)));

#ifdef __HIP_EMU__
#define LAUNCH(kern, grid, lds, stream, ...) emu_launch(grid, NTHR, [=]() { kern(__VA_ARGS__); })
#define DYN_SMEM(name) unsigned char* name = emu_dyn_smem()
#define WAVE_SYNC() emu_wave_bar()
#define MFMA32(a, b, c) emu_mfma32(a, b, c)
#define GLDS16(gp, lp) memcpy((unsigned char*)(lp) + (threadIdx.x & 63) * 16, (gp), 16)
#define RAW_BARRIER() __syncthreads()
#define WAIT_VM(n)
#define WAIT_LGKM0()
#define LAS
#define UNIFORM(x) (x)
#define COMPILER_FENCE()
#define LAUNDER_V(x)
#define MFMA16(a, b, c) emu_mfma16(a, b, c)
#else
#define WAVE_SYNC() asm volatile("s_waitcnt lgkmcnt(0)" ::: "memory")
#define MFMA32(a, b, c) __builtin_amdgcn_mfma_f32_32x32x16_bf16(a, b, c, 0, 0, 0)
#define LAS __attribute__((address_space(3)))
#define GLDS16(gp, lp) __builtin_amdgcn_global_load_lds((const unsigned*)(gp), (LAS unsigned*)(lp), 16, 0, 0)
#define RAW_BARRIER() __builtin_amdgcn_s_barrier()
#define WAIT_VM(n) asm volatile("s_waitcnt vmcnt(" #n ")" ::: "memory")
#define WAIT_LGKM0() asm volatile("s_waitcnt lgkmcnt(0)" ::: "memory")
#define UNIFORM(x) __builtin_amdgcn_readfirstlane(x)
#define COMPILER_FENCE() __builtin_amdgcn_sched_barrier(0)
#define LAUNDER_V(x) asm volatile("" : "+v"(x))
#define MFMA16(a, b, c) __builtin_amdgcn_mfma_f32_16x16x32_bf16(a, b, c, 0, 0, 0)
#define LAUNCH(kern, grid, lds, stream, ...) hipLaunchKernelGGL(kern, dim3(grid), dim3(NTHR), lds, stream, __VA_ARGS__)
#define DYN_SMEM(name) extern __shared__ __attribute__((aligned(16))) unsigned char name[]
#endif

#ifdef __HIP_EMU__
__device__ __forceinline__ int tidx() { return (int)threadIdx.x; }
#define LAUNDER_PTR(x)
#else
__device__ __forceinline__ int tidx() { int t = (int)threadIdx.x; asm volatile("" : "+v"(t)); return t; }
#define LAUNDER_PTR(x) asm volatile("" : "+s"(x))
#endif
__device__ __forceinline__ float bf2f(bf16_t v) { return __builtin_bit_cast(float, (unsigned)v << 16); }
__device__ __forceinline__ bf16_t f2bf(float f) { unsigned u = __builtin_bit_cast(unsigned, f); return (bf16_t)((u + 0x7fffu + ((u >> 16) & 1u)) >> 16); }
#ifdef __HIP_EMU__
__device__ __forceinline__ unsigned pk2(float lo, float hi) { return (unsigned)f2bf(lo) | ((unsigned)f2bf(hi) << 16); }
#else
typedef float f32x2_t __attribute__((ext_vector_type(2))); typedef __bf16 bf16x2_t __attribute__((ext_vector_type(2)));
__device__ __forceinline__ unsigned pk2(float lo, float hi) { f32x2_t v = {lo, hi}; bf16x2_t b = __builtin_convertvector(v, bf16x2_t); return __builtin_bit_cast(unsigned, b); }
#endif
__device__ __forceinline__ float silu_f(float x) { return x / (1.0f + expf(-x)); }
#ifdef __HIP_EMU__
__device__ __forceinline__ float silu_fast(float x) { return x / (1.0f + expf(-x)); }
#else
__device__ __forceinline__ float silu_fast(float x) { return x * __builtin_amdgcn_rcpf(1.0f + __builtin_amdgcn_exp2f(-LOG2E * x)); }
#endif
__device__ __forceinline__ float wave_sum(float v) {
#pragma unroll
    for (int o = 1; o < 64; o <<= 1) v += __shfl_xor(v, o);
    return v;
}
__device__ __forceinline__ float wave_max(float v) {
#pragma unroll
    for (int o = 1; o < 64; o <<= 1) v = fmaxf(v, __shfl_xor(v, o));
    return v;
}

struct P {
    const float *x_prompt, *x_sample, *cache_k, *cache_v, *state_ret, *state_gdn, *state_conv, *c_prompt, *c_sample, *ada_w, *ada_b, *norm_mix, *norm_ffn,
        *w_in, *ret_norm, *conv_w, *a_log, *dt_bias, *gdn_norm, *w_out, *w_gate, *w_up, *w_down, *final_norm;
    float* out; unsigned char* ws;
};

constexpr size_t O_YP = 0, O_YS = O_YP + (size_t)MP * D, O_PWK = O_YS + (size_t)MS * D, O_PWV = O_PWK + (size_t)NL * PB * PWIN * 256,
                 O_PRET = O_PWV + (size_t)NL * PB * PWIN * 256, O_PGDN = O_PRET + (size_t)NL * PB * 4 * 4096, O_PCONV = O_PGDN + (size_t)NL * PB * 4 * 16384,
                 O_SWK = O_PCONV + (size_t)NL * PB * 3 * 1536, O_SWV = O_SWK + (size_t)NL * DB * DS * 256, O_SRET = O_SWV + (size_t)NL * DB * DS * 256,
                 O_SGDN = O_SRET + (size_t)NL * DB * 4 * 4096, O_SCONV = O_SGDN + (size_t)NL * DB * 4 * 16384, O_END = O_SCONV + (size_t)NL * DB * 3 * 1536;

constexpr size_t al256(size_t x) { return (x + 255) / 256 * 256; }
constexpr size_t WS_CTL = 0, WS_CTL_BYTES = 1u << 20;
constexpr size_t WS_MOD = WS_CTL + WS_CTL_BYTES;
constexpr size_t WS_ROPE = al256(WS_MOD + (size_t)NL * NC * 6144 * 4);
constexpr size_t WS_WIN = al256(WS_ROPE + (size_t)4 * NPOS * 32 * 4);
constexpr size_t WS_WOUT = al256(WS_WIN + (size_t)NL * NPROJ * D * 2);
constexpr size_t WS_WGU = al256(WS_WOUT + (size_t)NL * D * D * 2);
constexpr size_t WS_WDN = al256(WS_WGU + (size_t)NL * 2 * FF * D * 2);
constexpr size_t WS_H = al256(WS_WDN + (size_t)NL * D * FF * 2);
constexpr size_t WS_PROJ = al256(WS_H + (size_t)MPAD * D * 2);
constexpr size_t WS_BETA = al256(WS_PROJ + (size_t)MPAD * NPROJ * 2);
constexpr size_t WS_G = al256(WS_BETA + (size_t)M * 4 * 4);
constexpr size_t WS_O = al256(WS_G + (size_t)M * 4 * 4);
constexpr size_t WS_RU = al256(WS_O + (size_t)MPAD * D * 2);
constexpr size_t WS_RS = al256(WS_RU + (size_t)NUNIT * 4096 * 4);
constexpr size_t WS_SCR = al256(WS_RS + (size_t)NUNIT * 4096 * 4);
constexpr size_t WS_GU = WS_SCR;
constexpr size_t WS_GWK = al256(WS_GU + (size_t)NUNIT * 8192 * 2);
constexpr size_t WS_GQ = al256(WS_GWK + (size_t)NUNIT * 16384 * 2);
constexpr size_t WS_GA = al256(WS_GQ + (size_t)NUNIT * 8192 * 2);
constexpr size_t WS_GD = al256(WS_GA + (size_t)NUNIT * 4096 * 2);
constexpr size_t WS_GV = al256(WS_GD + (size_t)NUNIT * 4);
constexpr size_t WS_GS = al256(WS_GV + (size_t)NUNIT * 8192 * 2);
constexpr size_t WS_GEND = al256(WS_GS + (size_t)NUNIT * 16384 * 2);
constexpr size_t WS_KH = WS_GEND;
constexpr size_t WS_VT1 = al256(WS_KH + (size_t)MP * 256 * 2);
constexpr size_t WS_VT4 = al256(WS_VT1 + (size_t)MP * 256 * 2);
constexpr size_t WS_VT16 = al256(WS_VT4 + (size_t)MP * 256 * 2);
constexpr size_t WS_AML = al256(WS_VT16 + (size_t)MP * 256 * 2);
constexpr size_t WS_AEND = al256(WS_AML + (size_t)MP * 4 * 3 * 2 * 4);
constexpr size_t WS_APO = WS_H;
static_assert((size_t)MP * 4 * 3 * 64 * 2 <= (size_t)MPAD * D * 2, "attention partials overlay H");
constexpr size_t WS_HID = WS_SCR;
constexpr size_t WS_HEND = al256(WS_HID + (size_t)MPAD * FF * 2);
constexpr size_t WS_END = WS_AEND > WS_HEND ? WS_AEND : WS_HEND;

#define WSP(T_, off) ((T_*)(p.ws + (off)))
__device__ __forceinline__ int row_cb(int r) { return r < MP ? r / T : PB + (r - MP) / DS; }
__device__ __forceinline__ int row_pi(int r) { return r < MP ? r % T : T + (r - MP) % DS; }
namespace pg8 {
#ifdef __HIP_EMU__
#define PG8_LAS
#else
#define PG8_LAS __attribute__((address_space(3)))
#endif
typedef unsigned short bf16_t;
typedef short bf16x8 __attribute__((ext_vector_type(8)));
typedef float f32x4 __attribute__((ext_vector_type(4)));
typedef unsigned u32x4 __attribute__((ext_vector_type(4)));
constexpr int BM = 256, BK = 64, HALF = 128, HTB = HALF * BK * 2  , STAGE_BYTES = 8 * HTB, NXCD = 8, WGM = 8;

__host__ __device__ __forceinline__ int lds_byte(int r, int c) { const int st = (r >> 4) * 2 + (c >> 5), rr = r & 15, cc = c & 31, ob = rr * 64 + cc * 2; return st * 1024 + (ob ^ (((ob >> 9) & 1) << 5)); }
__host__ __device__ __forceinline__ void stage_rc(int b, int& R, int& C) { const int st = b / 1024, sb = b % 1024, swz = sb ^ (((sb >> 9) & 1) << 5); R = (st >> 1) * 16 + swz / 64; C = (st & 1) * 32 + (swz % 64) / 2; }
__host__ __device__ __forceinline__ int perm32(int rho) { const int n = rho >> 4, i = rho & 15; return 8 * (i >> 2) + 4 * n + (i & 3); }

struct Unit { int pm, pn; };
struct Gemm { const bf16_t* A; const bf16_t* Bt; int M, N, K; };

struct StaticOrder {
    int nM, nN, nwg, G, c;
    __host__ __device__ void init(int M, int N, int G_, int c_) { nM = M / BM; nN = N / BM; nwg = nM * nN; G = G_; c = c_; }
    __host__ __device__ bool next(int i, Unit& u) const {
        const long L = (long)i * G + c; if (L >= nwg) return false;
        int wgid = (int)L; { const int q = nwg / NXCD, r = nwg % NXCD, xcd = wgid % NXCD, off = wgid / NXCD; wgid = (xcd < r ? xcd * (q + 1) : r * (q + 1) + (xcd - r) * q) + off; }
        const int nig = WGM * nN, gid = wgid / nig, fm = gid * WGM, gsz = (nM - fm) < WGM ? (nM - fm) : WGM;
        u.pm = fm + ((wgid % nig) % gsz); u.pn = (wgid % nig) / gsz; return true;
    }
    __device__ __forceinline__ void a_ready(const Unit&) const {}
    __device__ __forceinline__ void done(const Unit&) const {}
};


struct EpiStoreBf16 {
    static constexpr bool PERM = true, AFTER_DRAIN = false;
    bf16_t* O; int ldc;
    __device__ __forceinline__ void operator()(const f32x4 (&acc)[2][2][4][2], const Unit& u, int wr, int wc, int fr, int fq) const {
        const int row0 = u.pm * BM + wr * 64 + fr, col0 = u.pn * BM + wc * 32 + 8 * fq;
#pragma unroll
        for (int ai = 0; ai < 2; ++ai)
#pragma unroll
            for (int m = 0; m < 4; ++m) { bf16_t* rowp = O + (size_t)(row0 + ai * HALF + m * 16) * ldc + col0;
#pragma unroll
                for (int bj = 0; bj < 2; ++bj) { const f32x4 v0 = acc[ai][bj][m][0], v1 = acc[ai][bj][m][1];
                    u32x4 w; w.x = ::pk2(v0[0], v0[1]); w.y = ::pk2(v0[2], v0[3]); w.z = ::pk2(v1[0], v1[1]); w.w = ::pk2(v1[2], v1[3]);
                    *(u32x4*)(rowp + bj * HALF) = w; } }
    }
};
struct EpiResidual {
    static constexpr bool PERM = false, AFTER_DRAIN = false;
    float* X; const float* gate;
    __device__ __forceinline__ void operator()(const f32x4 (&acc)[2][2][4][2], const Unit& u, int wr, int wc, int fr, int fq) const {
        const int row0 = u.pm * BM + wr * 64 + fr, col0 = u.pn * BM + wc * 32 + 4 * fq;
#pragma unroll
        for (int ai = 0; ai < 2; ++ai)
#pragma unroll
            for (int m = 0; m < 4; ++m) { const int row = row0 + ai * HALF + m * 16;
                if (MPAD != M && row >= M) continue;
                const float* g = gate + (size_t)::row_cb(row) * 6144 + col0; float* xp = X + (size_t)row * D + col0;
#pragma unroll
                for (int bj = 0; bj < 2; ++bj)
#pragma unroll
                    for (int n = 0; n < 2; ++n) { const f32x4 gv = *(const f32x4*)(g + bj * HALF + n * 16); f32x4* xq = (f32x4*)(xp + bj * HALF + n * 16); *xq = *xq + gv * acc[ai][bj][m][n]; } }
    }
};
struct EpiSwiglu {
    static constexpr bool PERM = true, AFTER_DRAIN = false;
    bf16_t* Hd;
    __device__ __forceinline__ void operator()(const f32x4 (&acc)[2][2][4][2], const Unit& u, int wr, int wc, int fr, int fq) const {
        const int row0 = u.pm * BM + wr * 64 + fr, col0 = u.pn * HALF + wc * 32 + 8 * fq;
#pragma unroll
        for (int ai = 0; ai < 2; ++ai)
#pragma unroll
            for (int m = 0; m < 4; ++m) { bf16_t* rowp = Hd + (size_t)(row0 + ai * HALF + m * 16) * FF + col0;
                float v[8];
#pragma unroll
                for (int n = 0; n < 2; ++n)
#pragma unroll
                    for (int j = 0; j < 4; ++j) { const float gt = acc[ai][0][m][n][j], up = acc[ai][1][m][n][j]; v[4 * n + j] = ::silu_f(gt) * up; }
                u32x4 w; w.x = ::pk2(v[0], v[1]); w.y = ::pk2(v[2], v[3]); w.z = ::pk2(v[4], v[5]); w.w = ::pk2(v[6], v[7]);
                *(u32x4*)rowp = w; }
    }
};

#ifdef __HIP_EMU__
template <class Epi, class Sched, bool ALIGN_EPI = false, bool SP2 = false>
__device__ __forceinline__ void gemm_phase(unsigned char* lds, const Gemm g, const Sched& S, const Epi& E) {
    const int tid = threadIdx.x, wid = tid >> 6, lane = tid & 63, wr = wid >> 2, wc = wid & 3, fr = lane & 15, fq = lane >> 4;
    Unit cur;
    for (int ui = 0; S.next(ui, cur); ++ui) {
        f32x4 acc[2][2][4][2];
        for (int ai = 0; ai < 2; ++ai) for (int bj = 0; bj < 2; ++bj) for (int m = 0; m < 4; ++m) for (int n = 0; n < 2; ++n) for (int j = 0; j < 4; ++j) {
            const int row = 256 * cur.pm + 128 * ai + 64 * wr + 16 * m + fr;
            const int col = Epi::PERM ? 256 * cur.pn + 128 * bj + 32 * wc + 8 * fq + 4 * n + j : 256 * cur.pn + 128 * bj + 32 * wc + 16 * n + 4 * fq + j;
            const bf16_t* a = g.A + (size_t)row * g.K; const bf16_t* b = g.Bt + (size_t)col * g.K; float s = 0.f;
            for (int k = 0; k < g.K; ++k) s += ::bf2f(a[k]) * ::bf2f(b[k]);
            acc[ai][bj][m][n][j] = s; }
        E(acc, cur, wr, wc, fr, fq);
    }
}
#else
template <class Epi, class Sched, bool ALIGN_EPI = false, bool SP2 = false>
__device__ __forceinline__ void gemm_phase(PG8_LAS unsigned char* lds, const Gemm g, const Sched& S, const Epi& E) {
    const int tid = ::tidx(), wid = __builtin_amdgcn_readfirstlane(tid >> 6), lane = tid & 63, wr = wid >> 2, wc = wid & 3, fr = lane & 15, fq = lane >> 4;
    const int K = g.K, nt = K / BK;
    unsigned voffA[2], voffB[2];
#pragma unroll
    for (int i = 0; i < 2; ++i) { int R, C; stage_rc(tid * 16 + i * 8192, R, C); const int Rb = Epi::PERM ? ((R & ~31) + perm32(R & 31)) : R;
        voffA[i] = (unsigned)(R * K + C) * 2u; voffB[i] = (unsigned)(Rb * K + C) * 2u; }
    const size_t kstep = (size_t)(BK * 2);
    const size_t hstep = (size_t)HALF * K * 2;
    const size_t tstep = 2 * hstep;
    const unsigned ldsw = (unsigned)wid * 1024u;
    const int aoff = lds_byte(wr * 64 + fr, fq * 8), boff = lds_byte(wc * 32 + fr, fq * 8);
#define PG8_SA(b, h) (((b) * 2 + (h)) * HTB)
#define PG8_SB(b, h) ((4 + (b) * 2 + (h)) * HTB)
#define PG8_STAGE(bufoff, gbase, voff) do { _Pragma("unroll") for (int _i = 0; _i < 2; ++_i) \
        __builtin_amdgcn_global_load_lds((const unsigned*)((const char*)(gbase) + (voff)[_i]), (PG8_LAS unsigned*)(lds + (bufoff) + ldsw + _i * 8192), 16, 0, 0); } while (0)
#define PG8_LDA(dst, b, h) do { _Pragma("unroll") for (int m = 0; m < 4; ++m) _Pragma("unroll") for (int k = 0; k < 2; ++k) dst[m][k] = *(const PG8_LAS bf16x8*)(lds + PG8_SA(b, h) + aoff + m * 2048 + k * 1024); } while (0)
#define PG8_LDB(dst, b, h) do { _Pragma("unroll") for (int n = 0; n < 2; ++n) _Pragma("unroll") for (int k = 0; k < 2; ++k) dst[n][k] = *(const PG8_LAS bf16x8*)(lds + PG8_SB(b, h) + boff + n * 2048 + k * 1024); } while (0)
#define PG8_MMA(ai, bj, At, Bt) do { __builtin_amdgcn_s_setprio(1); _Pragma("unroll") for (int m = 0; m < 4; ++m) _Pragma("unroll") for (int n = 0; n < 2; ++n) _Pragma("unroll") for (int k = 0; k < 2; ++k) \
        acc[ai][bj][m][n] = __builtin_amdgcn_mfma_f32_16x16x32_bf16(Bt[n][k], At[m][k], acc[ai][bj][m][n], 0, 0, 0); __builtin_amdgcn_s_setprio(0); } while (0)
#define PG8_WAIT_V(n) asm volatile("s_waitcnt vmcnt(" #n ")" ::: "memory")
#define PG8_WAIT_L(n) asm volatile("s_waitcnt lgkmcnt(" #n ")" ::: "memory")
#define PG8_BAR __builtin_amdgcn_s_barrier()
#define PG8_SCHED __builtin_amdgcn_sched_barrier(0)
    Unit cur, nxt; int ui = 0;
    if (!S.next(0, cur)) return;
    f32x4 acc[2][2][4][2];
#pragma unroll
    for (int a = 0; a < 2; ++a)
#pragma unroll
        for (int b = 0; b < 2; ++b)
#pragma unroll
            for (int m = 0; m < 4; ++m)
#pragma unroll
                for (int n = 0; n < 2; ++n) acc[a][b][m][n] = (f32x4){0.f, 0.f, 0.f, 0.f};
    bf16x8 At[4][2], B0[2][2], B1[2][2];
    const char* cA = (const char*)g.A + (size_t)cur.pm * tstep; const char* cB = (const char*)g.Bt + (size_t)cur.pn * tstep;
    S.a_ready(cur);
    if constexpr (SP2) {
        PG8_STAGE(PG8_SB(0, 0), cB, voffB); PG8_STAGE(PG8_SB(0, 1), cB + hstep, voffB); PG8_STAGE(PG8_SA(0, 0), cA, voffA); PG8_STAGE(PG8_SA(0, 1), cA + hstep, voffA);
        if (wr == 1) PG8_BAR;
        PG8_WAIT_V(2); PG8_BAR;
        PG8_STAGE(PG8_SB(1, 0), cB + kstep, voffB); PG8_STAGE(PG8_SA(1, 0), cA + kstep, voffA); PG8_STAGE(PG8_SB(1, 1), cB + hstep + kstep, voffB);
        PG8_WAIT_V(6); PG8_BAR;
    } else {
        PG8_STAGE(PG8_SB(0, 0), cB, voffB); PG8_STAGE(PG8_SA(0, 0), cA, voffA); PG8_STAGE(PG8_SB(0, 1), cB + hstep, voffB); PG8_STAGE(PG8_SA(0, 1), cA + hstep, voffA);
        if (wr == 1) PG8_BAR;
        PG8_WAIT_V(4); PG8_BAR;
        PG8_STAGE(PG8_SB(1, 0), cB + kstep, voffB); PG8_STAGE(PG8_SA(1, 0), cA + kstep, voffA); PG8_STAGE(PG8_SB(1, 1), cB + hstep + kstep, voffB);
        PG8_WAIT_V(6); PG8_BAR;
    }
    for (;;) {
        const bool has_next = S.next(ui + 1, nxt);
        const char* nA = has_next ? (const char*)g.A + (size_t)nxt.pm * tstep : cA; const char* nB = has_next ? (const char*)g.Bt + (size_t)nxt.pn * tstep : cB;
        for (int t = 0; t < nt; t += 2) {
            const bool last = (t == nt - 2);
            const char* a1 = cA + (size_t)(t + 1) * kstep;
            const char* a2 = last ? nA : cA + (size_t)(t + 2) * kstep; const char* b2 = last ? nB : cB + (size_t)(t + 2) * kstep;
            const char* a3 = a2 + kstep; const char* b3 = b2 + kstep;
            if (last && has_next) S.a_ready(nxt);
            if constexpr (SP2) {
            PG8_LDB(B0, 0, 0); PG8_LDB(B1, 0, 1); PG8_SCHED; PG8_LDA(At, 0, 0); PG8_STAGE(PG8_SA(1, 1), a1 + hstep, voffA);
            PG8_WAIT_V(8); PG8_WAIT_L(0); PG8_BAR; PG8_MMA(0, 0, At, B0); PG8_MMA(0, 1, At, B1); PG8_BAR; PG8_SCHED;
            PG8_LDA(At, 0, 1); PG8_STAGE(PG8_SB(0, 0), b2, voffB); PG8_STAGE(PG8_SB(0, 1), b2 + hstep, voffB); PG8_STAGE(PG8_SA(0, 0), a2, voffA);
            PG8_WAIT_V(8); PG8_WAIT_L(0); PG8_BAR; PG8_MMA(1, 0, At, B0); PG8_MMA(1, 1, At, B1); PG8_BAR; PG8_SCHED;
            PG8_LDB(B0, 1, 0); PG8_LDB(B1, 1, 1); PG8_SCHED; PG8_LDA(At, 1, 0); PG8_STAGE(PG8_SA(0, 1), a2 + hstep, voffA);
            PG8_WAIT_V(8); PG8_WAIT_L(0); PG8_BAR; PG8_MMA(0, 0, At, B0); PG8_MMA(0, 1, At, B1); PG8_BAR; PG8_SCHED;
            PG8_LDA(At, 1, 1); PG8_STAGE(PG8_SB(1, 0), b3, voffB); PG8_STAGE(PG8_SB(1, 1), b3 + hstep, voffB); PG8_STAGE(PG8_SA(1, 0), a3, voffA);
            PG8_WAIT_V(8); PG8_WAIT_L(0); PG8_BAR; PG8_MMA(1, 0, At, B0); PG8_MMA(1, 1, At, B1); PG8_BAR; PG8_SCHED;
            } else {
            PG8_LDB(B0, 0, 0); PG8_SCHED; PG8_LDA(At, 0, 0); PG8_STAGE(PG8_SA(1, 1), a1 + hstep, voffA);
            PG8_WAIT_L(8); PG8_BAR; PG8_WAIT_L(0); PG8_MMA(0, 0, At, B0); PG8_BAR; PG8_SCHED;
            PG8_LDB(B1, 0, 1); PG8_STAGE(PG8_SB(0, 0), b2, voffB);
            PG8_BAR; PG8_WAIT_L(0); PG8_MMA(0, 1, At, B1); PG8_BAR;
            PG8_LDA(At, 0, 1); PG8_STAGE(PG8_SA(0, 0), a2, voffA);
            PG8_BAR; PG8_WAIT_L(0); PG8_MMA(1, 0, At, B0); PG8_BAR; PG8_SCHED;
            PG8_STAGE(PG8_SB(0, 1), b2 + hstep, voffB);
            PG8_WAIT_V(6); PG8_BAR; PG8_MMA(1, 1, At, B1); PG8_BAR;
            PG8_LDB(B0, 1, 0); PG8_SCHED; PG8_LDA(At, 1, 0); PG8_STAGE(PG8_SA(0, 1), a2 + hstep, voffA);
            PG8_WAIT_L(8); PG8_BAR; PG8_WAIT_L(0); PG8_MMA(0, 0, At, B0); PG8_BAR; PG8_SCHED;
            PG8_LDB(B1, 1, 1); PG8_STAGE(PG8_SB(1, 0), b3, voffB);
            PG8_BAR; PG8_WAIT_L(0); PG8_MMA(0, 1, At, B1); PG8_BAR;
            PG8_LDA(At, 1, 1); PG8_STAGE(PG8_SA(1, 0), a3, voffA);
            PG8_BAR; PG8_WAIT_L(0); PG8_MMA(1, 0, At, B0); PG8_BAR; PG8_SCHED;
            PG8_STAGE(PG8_SB(1, 1), b3 + hstep, voffB);
            PG8_WAIT_V(6); PG8_BAR; PG8_MMA(1, 1, At, B1); PG8_BAR;
            }
        }
        if constexpr (ALIGN_EPI) { if (wr == 0) PG8_BAR; }
        if constexpr (!Epi::AFTER_DRAIN) { E(acc, cur, wr, wc, fr, fq); S.done(cur); }
        if (!has_next) break;
#pragma unroll
        for (int a = 0; a < 2; ++a)
#pragma unroll
            for (int b = 0; b < 2; ++b)
#pragma unroll
                for (int m = 0; m < 4; ++m)
#pragma unroll
                    for (int n = 0; n < 2; ++n) acc[a][b][m][n] = (f32x4){0.f, 0.f, 0.f, 0.f};
        cur = nxt; cA = nA; cB = nB; ++ui;
        if constexpr (ALIGN_EPI) { if (wr == 1) PG8_BAR; }
    }
    PG8_WAIT_V(0);
    if constexpr (!ALIGN_EPI) { if (wr == 0) PG8_BAR; }
    PG8_BAR;
    if constexpr (Epi::AFTER_DRAIN) { E.fused(acc, cur, wr, wc, fr, fq, lds, wid, lane); S.done(cur); }
#undef PG8_SA
#undef PG8_SB
#undef PG8_STAGE
#undef PG8_LDA
#undef PG8_LDB
#undef PG8_MMA
#undef PG8_WAIT_V
#undef PG8_WAIT_L
#undef PG8_BAR
#undef PG8_SCHED
}
#endif
}


__device__ __forceinline__ void transpose_item(const float* W, int ldw, bf16_t* WT, int K, int k0, int n0, int drow0, float* scr, int lane) {
#pragma unroll 8
    for (int i = 0; i < 32; ++i) { const int kk = 2 * i + (lane >> 5); scr[kk * 33 + (lane & 31)] = W[(size_t)(k0 + kk) * ldw + n0 + (lane & 31)]; }
    WAVE_SYNC();
    const int c = lane & 7;
#pragma unroll
    for (int j = 0; j < 4; ++j) { const int n = (lane >> 3) + 8 * j; const float* s = scr + (8 * c) * 33 + n;
        u32x4 o; o.x = pk2(s[0 * 33], s[1 * 33]); o.y = pk2(s[2 * 33], s[3 * 33]); o.z = pk2(s[4 * 33], s[5 * 33]); o.w = pk2(s[6 * 33], s[7 * 33]);
        *(u32x4*)(WT + (size_t)(drow0 + n) * K + k0 + 8 * c) = o; }
    WAVE_SYNC();
}
__device__ __forceinline__ void ph_convert(const P& p, unsigned char* smem) {
    const int lane = tidx() & 63, wave = tidx() >> 6;
    float* scr = (float*)smem + wave * (64 * 33 + 32);
    constexpr int I_IN = 16 * 120, I_OUT = 16 * 32, I_G = 16 * 88, I_DN = 44 * 32, I_L = I_IN + I_OUT + 2 * I_G + I_DN;
    const int gw = blockIdx.x * 8 + wave, ngw = gridDim.x * 8;
    for (int it = gw; it < NL * I_L; it += ngw) {
        const int l = it / I_L; int r = it % I_L;
        if (r < I_IN) { const int kb = r / 120, nb = r % 120; transpose_item(p.w_in + (size_t)l * D * INC, INC, WSP(bf16_t, WS_WIN) + (size_t)l * NPROJ * D, D, kb * 64, nb * 32, nb * 32, scr, lane); continue; }
        r -= I_IN;
        if (r < I_OUT) { const int kb = r / 32, nb = r % 32; transpose_item(p.w_out + (size_t)l * D * D, D, WSP(bf16_t, WS_WOUT) + (size_t)l * D * D, D, kb * 64, nb * 32, nb * 32, scr, lane); continue; }
        r -= I_OUT;
        if (r < 2 * I_G) { const int up = r / I_G; r %= I_G; const int kb = r / 88, nb = r % 88, n0 = nb * 32;
            transpose_item((up ? p.w_up : p.w_gate) + (size_t)l * D * FF, FF, WSP(bf16_t, WS_WGU) + (size_t)l * 2 * FF * D, D, kb * 64, n0, (n0 / 128) * 256 + up * 128 + (n0 % 128), scr, lane); continue; }
        r -= 2 * I_G;
        { const int kb = r / 32, nb = r % 32; transpose_item(p.w_down + (size_t)l * FF * D, D, WSP(bf16_t, WS_WDN) + (size_t)l * D * FF, FF, kb * 64, nb * 32, nb * 32, scr, lane); }
    }
}

__device__ __forceinline__ void ph_adaln(const P& p, unsigned char* smem) {
    float* sc = (float*)smem;
    float* red = sc + NC * 256;
    const int tid = tidx(), col = tid & 31, kg = tid >> 5;
    float* MOD = WSP(float, WS_MOD);
    for (int it = blockIdx.x; it < NL * 192; it += gridDim.x) {
        const int l = it / 192, cb0 = (it % 192) * 32;
        float acc[NC];
#pragma unroll
        for (int r = 0; r < NC; ++r) acc[r] = 0.f;
        for (int kc = 0; kc < 4; ++kc) {
            __syncthreads();
            for (int e = tid; e < NC * 256; e += NTHR) { const int r = e >> 8, k = e & 255; const float c = r < PB ? p.c_prompt[r * D + kc * 256 + k] : p.c_sample[(r - PB) * D + kc * 256 + k]; sc[e] = silu_f(c); }
            __syncthreads();
            for (int kk = 0; kk < 16; ++kk) { const int k = kg * 16 + kk; const float w = p.ada_w[((size_t)l * D + kc * 256 + k) * 6144 + cb0 + col];
#pragma unroll
                for (int r = 0; r < NC; ++r) acc[r] += sc[r * 256 + k] * w; }
        }
#pragma unroll
        for (int r = 0; r < NC; ++r) red[(kg * NC + r) * 32 + col] = acc[r];
        __syncthreads();
        for (int e = tid; e < NC * 32; e += NTHR) { const int r = e >> 5, c = e & 31; float s = p.ada_b[l * 6144 + cb0 + c];
            for (int g = 0; g < 16; ++g) s += red[(g * NC + r) * 32 + c];
            MOD[((size_t)l * NC + r) * 6144 + cb0 + c] = s; }
        __syncthreads();
    }
}

__device__ __forceinline__ void ph_ropetab_copyx(const P& p) {
    const size_t gt = (size_t)blockIdx.x * NTHR + tidx(), ng = (size_t)gridDim.x * NTHR;
    float* tab = WSP(float, WS_ROPE);
    for (size_t e = gt; e < (size_t)NPOS * 32; e += ng) {
        const int pi = (int)(e >> 5), i = (int)(e & 31); const double pos = pi < T ? (double)pi : (double)(PAST + pi - T);
        const double ia = exp(-log(10000.0) * (double)i / 32.0), ir = exp(-log(10000.0) * (double)i / 31.0);
        tab[e] = (float)cos(pos * ia); tab[(size_t)NPOS * 32 + e] = (float)sin(pos * ia);
        tab[(size_t)2 * NPOS * 32 + e] = (float)cos(pos * ir); tab[(size_t)3 * NPOS * 32 + e] = (float)sin(pos * ir);
    }
    const f32x4* xp = (const f32x4*)p.x_prompt; const f32x4* xs = (const f32x4*)p.x_sample; f32x4* o = (f32x4*)p.out;
    for (size_t e = gt; e < (size_t)MP * D / 4; e += ng) o[e] = xp[e];
    for (size_t e = gt; e < (size_t)MS * D / 4; e += ng) o[(size_t)MP * D / 4 + e] = xs[e];
}

template <int WHICH> __device__ __forceinline__ void ph_norm_mod(const P& p, int l) {
    const int lane = tidx() & 63, wave = tidx() >> 6, gw = blockIdx.x * 8 + wave, ngw = gridDim.x * 8;
    const float* nw = (WHICH == 0 ? p.norm_mix : p.norm_ffn) + l * D;
    bf16_t* H = WSP(bf16_t, WS_H);
    for (int r = gw; r < M; r += ngw) {
        const float* xr = p.out + (size_t)r * D; const float* mod = WSP(float, WS_MOD) + ((size_t)l * NC + row_cb(r)) * 6144 + (WHICH == 0 ? 0 : 3072);
        f32x4 v[4]; float ss = 0.f;
#pragma unroll
        for (int j = 0; j < 4; ++j) { v[j] = *(const f32x4*)(xr + 4 * lane + 256 * j); ss += (v[j][0] * v[j][0] + v[j][1] * v[j][1]) + (v[j][2] * v[j][2] + v[j][3] * v[j][3]); }
        const float rstd = 1.0f / sqrtf(wave_sum(ss) * (1.0f / D) + EPS);
        float a8[8];
#pragma unroll
        for (int c = 0; c < 8; ++c) a8[c] = 0.f;
#pragma unroll
        for (int j = 0; j < 4; ++j) { const int k = 4 * lane + 256 * j;
            const f32x4 g = *(const f32x4*)(nw + k), sh = *(const f32x4*)(mod + k), sc = *(const f32x4*)(mod + 1024 + k);
            f32x4 h;
#pragma unroll
            for (int e = 0; e < 4; ++e) h[e] = v[j][e] * rstd * g[e] * (1.0f + sc[e]) + sh[e];
            u32x2 w; w.x = pk2(h[0], h[1]); w.y = pk2(h[2], h[3]); *(u32x2*)(H + (size_t)r * D + k) = w;
            if (WHICH == 0) {
#pragma unroll
                for (int e = 0; e < 4; ++e) { const float* wr = p.w_in + ((size_t)l * D + k + e) * INC + NPROJ; const f32x4 w0 = *(const f32x4*)wr, w1 = *(const f32x4*)(wr + 4);
#pragma unroll
                    for (int c = 0; c < 4; ++c) { a8[c] += h[e] * w0[c]; a8[4 + c] += h[e] * w1[c]; } }
            }
        }
        if (WHICH == 0) {
#pragma unroll
            for (int c = 0; c < 8; ++c) a8[c] = wave_sum(a8[c]);
            if (lane < 4) { float braw = lane == 0 ? a8[0] : lane == 1 ? a8[1] : lane == 2 ? a8[2] : a8[3]; WSP(float, WS_BETA)[(size_t)r * 4 + lane] = 1.0f / (1.0f + expf(-braw)); }
            else if (lane < 8) { const int hh = lane - 4; float araw = hh == 0 ? a8[4] : hh == 1 ? a8[5] : hh == 2 ? a8[6] : a8[7];
                const float xx = araw + p.dt_bias[l * 4 + hh]; const float sp = xx > 20.f ? xx : log1pf(expf(xx));
                WSP(float, WS_G)[(size_t)r * 4 + hh] = -expf(p.a_log[l * 4 + hh]) * sp; }
        }
    }
}

__device__ __forceinline__ void ph_rope_out(const P& p, int l) {
    const size_t gt = (size_t)blockIdx.x * NTHR + tidx(), ng = (size_t)gridDim.x * NTHR;
    bf16_t* PR = WSP(bf16_t, WS_PROJ); const float* tab = WSP(float, WS_ROPE);
    for (size_t e = gt; e < (size_t)M * 512; e += ng) {
        const int r = (int)(e >> 9), rem = (int)(e & 511), sec = rem >> 7, hh = (rem & 127) >> 5, d = rem & 31;
        const int off = sec == 0 ? C_QA : sec == 1 ? C_KA : sec == 2 ? C_QR : C_KR; const float scale = sec == 0 ? 0.125f * LOG2E : sec == 3 ? 0.125f : 1.0f;
        const float* ct = tab + (size_t)(sec >= 2 ? 2 : 0) * NPOS * 32 + (size_t)row_pi(r) * 32 + d; const float c = ct[0], s = ct[(size_t)NPOS * 32];
        bf16_t* x = PR + (size_t)r * NPROJ + off + hh * 64 + d; const float x1 = bf2f(x[0]), x2 = bf2f(x[32]);
        const float o1 = (x1 * c - x2 * s) * scale, o2 = (x1 * s + x2 * c) * scale;
        x[0] = f2bf(o1); x[32] = f2bf(o2);
        if (sec == 1) {
            if (r < MP) { const int b = r / T, t = r % T; bf16_t* kh = WSP(bf16_t, WS_KH) + ((size_t)(b * 4 + hh) * T + t) * 64 + d; kh[0] = f2bf(o1); kh[32] = f2bf(o2);
                if (t >= T - PWIN) { float* o = p.out + O_PWK + (((size_t)l * PB + b) * PWIN + (t - (T - PWIN))) * 256 + hh * 64 + d; o[0] = o1; o[32] = o2; } }
            else { const int b = (r - MP) / DS, i = (r - MP) % DS; float* o = p.out + O_SWK + (((size_t)l * DB + b) * DS + i) * 256 + hh * 64 + d; o[0] = o1; o[32] = o2; }
        }
    }
    for (size_t e = gt; e < (size_t)M * 256; e += ng) {
        const int r = (int)(e >> 8), c = (int)(e & 255); const float v = bf2f(PR[(size_t)r * NPROJ + C_VA + c]);
        if (r < MP) { const int b = r / T, t = r % T; if (t >= T - PWIN) p.out[O_PWV + (((size_t)l * PB + b) * PWIN + (t - (T - PWIN))) * 256 + c] = v; }
        else { const int b = (r - MP) / DS, i = (r - MP) % DS; p.out[O_SWV + (((size_t)l * DB + b) * DS + i) * 256 + c] = v; }
    }
    for (size_t e = gt; e < (size_t)(PB + DB) * 3 * 1536; e += ng) {
        const int c = (int)(e % 1536), j = (int)((e / 1536) % 3), bb = (int)(e / (3 * 1536));
        if (bb < PB) p.out[O_PCONV + (((size_t)l * PB + bb) * 3 + j) * 1536 + c] = bf2f(PR[(size_t)(bb * T + T - 3 + j) * NPROJ + C_CONV + c]);
        else { const int b = bb - PB; p.out[O_SCONV + (((size_t)l * DB + b) * 3 + j) * 1536 + c] = bf2f(PR[(size_t)(MP + b * DS + DS - 3 + j) * NPROJ + C_CONV + c]); }
    }
}

__device__ __forceinline__ void attn_wave_sample(const P& p, int l, int r, int h, int lane, float* sw  ) {
    const bf16_t* PR = WSP(bf16_t, WS_PROJ);
    const int b = (r - MP) / DS; const int tq = WB + (r - MP) % DS;
    float q[64];
    { const bf16_t* qp = PR + (size_t)r * NPROJ + C_QA + h * 64;
#pragma unroll
      for (int j = 0; j < 8; ++j) { const bf16x8 v = *(const bf16x8*)(qp + 8 * j);
#pragma unroll
          for (int e = 0; e < 8; ++e) q[8 * j + e] = bf2f((bf16_t)v[e]); } }
    float mx = -INFINITY;
#pragma unroll 1
    for (int i = 0; i < 7; ++i) {
        const int e = lane + 64 * i;
        if (e < 387) { const int pat = e / 129, j = e % 129, dil = pat == 0 ? 1 : pat == 1 ? 4 : 16; const int rr = tq - dil * j;
            float a = 0.f;
            if (rr < WB) { const float* kp = p.cache_k + ((((size_t)l * DB + b) * WB + rr) * 4 + h) * 64;
#pragma unroll
                for (int j4 = 0; j4 < 16; ++j4) { const f32x4 kv = *(const f32x4*)(kp + 4 * j4); a += q[4 * j4] * kv[0] + q[4 * j4 + 1] * kv[1] + q[4 * j4 + 2] * kv[2] + q[4 * j4 + 3] * kv[3]; } }
            else { const bf16_t* kp = PR + (size_t)(MP + b * DS + (rr - WB)) * NPROJ + C_KA + h * 64;
#pragma unroll
                for (int j8 = 0; j8 < 8; ++j8) { const bf16x8 kv = *(const bf16x8*)(kp + 8 * j8);
#pragma unroll
                    for (int e2 = 0; e2 < 8; ++e2) a += q[8 * j8 + e2] * bf2f((bf16_t)kv[e2]); } }
            sw[e] = a; mx = fmaxf(mx, a); }
    }
    mx = wave_max(mx);
    float lsum = 0.f;
#pragma unroll 1
    for (int i = 0; i < 7; ++i) { const int e = lane + 64 * i; if (e < 387) { const float pe = exp2f(sw[e] - mx); sw[e] = pe; lsum += pe; } }
    lsum = wave_sum(lsum);
    WAVE_SYNC();
    const int kg = lane >> 4, dq = lane & 15; f32x4 o4 = (f32x4){0.f, 0.f, 0.f, 0.f};
#pragma unroll 8
    for (int e = kg; e < 387; e += 4) {
        const float pe = sw[e];
        const int pat = e / 129, j = e % 129, dil = pat == 0 ? 1 : pat == 1 ? 4 : 16; const int rr = tq - dil * j;
        f32x4 v;
        if (rr < WB) v = *(const f32x4*)(p.cache_v + ((((size_t)l * DB + b) * WB + rr) * 4 + h) * 64 + 4 * dq);
        else { const u32x2 w = *(const u32x2*)(PR + (size_t)(MP + b * DS + (rr - WB)) * NPROJ + C_VA + h * 64 + 4 * dq);
            v = (f32x4){bf2f((bf16_t)(w.x & 0xffff)), bf2f((bf16_t)(w.x >> 16)), bf2f((bf16_t)(w.y & 0xffff)), bf2f((bf16_t)(w.y >> 16))}; }
        o4 += pe * v;
    }
#pragma unroll
    for (int e = 0; e < 4; ++e) { float x = o4[e]; x += __shfl_xor(x, 16); x += __shfl_xor(x, 32); o4[e] = x; }
    WAVE_SYNC();
    if (kg == 0) { const float inv = 1.0f / lsum; u32x2 w; w.x = pk2(o4[0] * inv, o4[1] * inv); w.y = pk2(o4[2] * inv, o4[3] * inv);
        *(u32x2*)(WSP(bf16_t, WS_O) + (size_t)r * D + h * 64 + 4 * dq) = w; }
}
__device__ __forceinline__ void ph_attn_sample(const P& p, int l, unsigned char* smem) {
    const int lane = tidx() & 63, wave = tidx() >> 6, gw = (gridDim.x - 1 - blockIdx.x) * 8 + wave, ngw = gridDim.x * 8;
    float* sw = (float*)smem + wave * 392;
    for (int it = gw; it < MS * 4; it += ngw) attn_wave_sample(p, l, MP + (it >> 2), it & 3, lane, sw);
}
__device__ __forceinline__ bf16x8 pack8(const f32x16& v, int s8) {
    u32x4 w; w.x = pk2(v[s8], v[s8 + 1]); w.y = pk2(v[s8 + 2], v[s8 + 3]); w.z = pk2(v[s8 + 4], v[s8 + 5]); w.w = pk2(v[s8 + 6], v[s8 + 7]); return __builtin_bit_cast(bf16x8, w);
}
__device__ __forceinline__ void attn_job(const P& p, int jb, int lane) {
    const int c = lane & 31, hi = lane >> 5;
    constexpr int NB = T / 512;
    const int unit = jb / 48, jj = jb % 48, pat = jj >> 4, sub = jj & 15;
    const int blk = unit % NB, h = (unit / NB) & 3, b = unit / (NB * 4), bh = b * 4 + h;
    int dil, r, qi0; const bf16_t* VT;
    if (pat == 0) { dil = 1; r = 0; qi0 = blk * 512 + sub * 32; VT = WSP(bf16_t, WS_VT1) + (size_t)bh * 64 * T; }
    else if (pat == 1) { dil = 4; r = sub >> 2; qi0 = blk * 128 + (sub & 3) * 32; VT = WSP(bf16_t, WS_VT4) + (size_t)(bh * 4 + r) * 64 * (T / 4); }
    else { dil = 16; r = sub; qi0 = blk * 32; VT = WSP(bf16_t, WS_VT16) + (size_t)(bh * 16 + r) * 64 * (T / 16); }
    const int SL = T / dil;
    const int tq = dil * (qi0 + c) + r;
    const bf16_t* qp = WSP(bf16_t, WS_PROJ) + (size_t)(b * T + tq) * NPROJ + C_QA + h * 64 + 8 * hi;
    bf16x8 qf[4];
#pragma unroll
    for (int ks = 0; ks < 4; ++ks) qf[ks] = *(const bf16x8*)(qp + 16 * ks);
    const bf16_t* KHb = WSP(bf16_t, WS_KH) + (size_t)bh * T * 64;
    f32x16 S[5];
#pragma unroll
    for (int i = 0; i < 5; ++i) {
        const int kt0 = qi0 - 128 + 32 * i;
        f32x16 acc;
#pragma unroll
        for (int e = 0; e < 16; ++e) acc[e] = 0.f;
        if (kt0 >= 0) { const bf16_t* kp = KHb + (size_t)(dil * (kt0 + c) + r) * 64 + 8 * hi;
#pragma unroll
            for (int ks = 0; ks < 4; ++ks) acc = MFMA32(*(const bf16x8*)(kp + 16 * ks), qf[ks], acc);
            if (i == 0) {
#pragma unroll
                for (int e = 0; e < 16; ++e) { const int krow = (e & 3) + 8 * (e >> 2) + 4 * hi; if (krow < c) acc[e] = -INFINITY; } }
            if (i == 4) {
#pragma unroll
                for (int e = 0; e < 16; ++e) { const int krow = (e & 3) + 8 * (e >> 2) + 4 * hi; if (krow > c) acc[e] = -INFINITY; } }
        } else {
#pragma unroll
            for (int e = 0; e < 16; ++e) acc[e] = -INFINITY; }
        S[i] = acc;
    }
    float mx = -INFINITY;
#pragma unroll
    for (int i = 0; i < 5; ++i)
#pragma unroll
        for (int e = 0; e < 16; ++e) mx = fmaxf(mx, S[i][e]);
    mx = fmaxf(mx, __shfl_xor(mx, 32));
    float lsum = 0.f;
#pragma unroll
    for (int i = 0; i < 5; ++i)
#pragma unroll
        for (int e = 0; e < 16; ++e) { const float pe = exp2f(S[i][e] - mx); S[i][e] = pe; lsum += pe; }
    lsum += __shfl_xor(lsum, 32);
    f32x16 O[2];
#pragma unroll
    for (int dt = 0; dt < 2; ++dt)
#pragma unroll
        for (int e = 0; e < 16; ++e) O[dt][e] = 0.f;
#pragma unroll
    for (int i = 0; i < 5; ++i) {
        const int kt0 = qi0 - 128 + 32 * i;
        if (kt0 >= 0) {
#pragma unroll
            for (int s2 = 0; s2 < 2; ++s2) { const bf16x8 pf = pack8(S[i], 8 * s2);
#pragma unroll
                for (int dt = 0; dt < 2; ++dt) { const bf16_t* vp = VT + (size_t)(dt * 32 + c) * SL + kt0 + 16 * s2 + 4 * hi;
                    const u32x2 lo = *(const u32x2*)vp, hh = *(const u32x2*)(vp + 8); u32x4 w; w.x = lo.x; w.y = lo.y; w.z = hh.x; w.w = hh.y;
                    O[dt] = MFMA32(__builtin_bit_cast(bf16x8, w), pf, O[dt]); } }
        }
    }
    const size_t idx = ((size_t)(b * T + tq) * 4 + h) * 3 + pat;
    bf16_t* po = WSP(bf16_t, WS_APO) + idx * 64;
#pragma unroll
    for (int dt = 0; dt < 2; ++dt)
#pragma unroll
        for (int g = 0; g < 4; ++g) { u32x2 w; w.x = pk2(O[dt][4 * g], O[dt][4 * g + 1]); w.y = pk2(O[dt][4 * g + 2], O[dt][4 * g + 3]); *(u32x2*)(po + 32 * dt + 8 * g + 4 * hi) = w; }
    if (hi == 0) { float* ml = WSP(float, WS_AML) + idx * 2; ml[0] = mx; ml[1] = lsum; }
}
__device__ __forceinline__ void ph_attn_jobs(const P& p) {
    const int lane = tidx() & 63, wave = tidx() >> 6, gw = blockIdx.x * 8 + wave, ngw = gridDim.x * 8;
    for (int jb = gw; jb < PB * 4 * (T / 512) * 48; jb += ngw) attn_job(p, jb, lane);
}
__device__ __forceinline__ void ph_attn_combine(const P& p) {
    const size_t gt = (size_t)blockIdx.x * NTHR + tidx(), ng = (size_t)gridDim.x * NTHR;
    for (size_t e = gt; e < (size_t)MP * 4 * 16; e += ng) {
        const size_t rh = e >> 4; const int dq = (int)(e & 15) * 4;
        const float* ml = WSP(float, WS_AML) + rh * 6; const float m0 = ml[0], m1 = ml[2], m2 = ml[4];
        const float mm = fmaxf(m0, fmaxf(m1, m2)); const float w0 = exp2f(m0 - mm), w1 = exp2f(m1 - mm), w2 = exp2f(m2 - mm);
        const float inv = 1.0f / (w0 * ml[1] + w1 * ml[3] + w2 * ml[5]);
        const bf16_t* po = WSP(bf16_t, WS_APO) + rh * 192 + dq;
        const u32x2 a = *(const u32x2*)po, bq = *(const u32x2*)(po + 64), cq = *(const u32x2*)(po + 128);
        float o[4];
        o[0] = w0 * bf2f((bf16_t)(a.x & 0xffff)) + w1 * bf2f((bf16_t)(bq.x & 0xffff)) + w2 * bf2f((bf16_t)(cq.x & 0xffff));
        o[1] = w0 * bf2f((bf16_t)(a.x >> 16)) + w1 * bf2f((bf16_t)(bq.x >> 16)) + w2 * bf2f((bf16_t)(cq.x >> 16));
        o[2] = w0 * bf2f((bf16_t)(a.y & 0xffff)) + w1 * bf2f((bf16_t)(bq.y & 0xffff)) + w2 * bf2f((bf16_t)(cq.y & 0xffff));
        o[3] = w0 * bf2f((bf16_t)(a.y >> 16)) + w1 * bf2f((bf16_t)(bq.y >> 16)) + w2 * bf2f((bf16_t)(cq.y >> 16));
        const size_t row = rh >> 2; const int h = (int)(rh & 3);
        u32x2 w; w.x = pk2(o[0] * inv, o[1] * inv); w.y = pk2(o[2] * inv, o[3] * inv);
        *(u32x2*)(WSP(bf16_t, WS_O) + row * D + h * 64 + dq) = w;
    }
}
__device__ __forceinline__ void ph_vtrans(const P& p, unsigned char* smem) {
    bf16_t* vt = (bf16_t*)smem;
    const int tid = tidx(); const bf16_t* PR = WSP(bf16_t, WS_PROJ);
    for (int u = blockIdx.x; u < PB * 4 * (T / 256); u += gridDim.x) {
        const int tile = u % (T / 256), bh = u / (T / 256), h = bh & 3, b = bh >> 2;
        __syncthreads();
#pragma unroll
        for (int k = 0; k < 4; ++k) { const int ch = tid + NTHR * k, t = ch >> 3, d8 = (ch & 7) * 8;
            *(u32x4*)(vt + t * 72 + d8) = *(const u32x4*)(PR + (size_t)(b * T + tile * 256 + t) * NPROJ + C_VA + h * 64 + d8); }
        __syncthreads();
#pragma unroll
        for (int k = 0; k < 4; ++k) { const int ch = tid + NTHR * k;
            { const int d = ch >> 5, t0 = (ch & 31) * 8; u32x4 w;
              w.x = (unsigned)vt[(t0 + 0) * 72 + d] | ((unsigned)vt[(t0 + 1) * 72 + d] << 16); w.y = (unsigned)vt[(t0 + 2) * 72 + d] | ((unsigned)vt[(t0 + 3) * 72 + d] << 16);
              w.z = (unsigned)vt[(t0 + 4) * 72 + d] | ((unsigned)vt[(t0 + 5) * 72 + d] << 16); w.w = (unsigned)vt[(t0 + 6) * 72 + d] | ((unsigned)vt[(t0 + 7) * 72 + d] << 16);
              *(u32x4*)(WSP(bf16_t, WS_VT1) + ((size_t)bh * 64 + d) * T + tile * 256 + t0) = w; }
            { const int r = ch >> 9, d = (ch >> 3) & 63, s0 = (ch & 7) * 8; u32x4 w;
#define VT4E(e_) ((unsigned)vt[(4 * (s0 + (e_)) + r) * 72 + d])
              w.x = VT4E(0) | (VT4E(1) << 16); w.y = VT4E(2) | (VT4E(3) << 16); w.z = VT4E(4) | (VT4E(5) << 16); w.w = VT4E(6) | (VT4E(7) << 16);
#undef VT4E
              *(u32x4*)(WSP(bf16_t, WS_VT4) + ((size_t)(bh * 4 + r) * 64 + d) * (T / 4) + tile * 64 + s0) = w; }
            { const int r = ch >> 7, d = (ch >> 1) & 63, s0 = (ch & 1) * 8; u32x4 w;
#define VT16E(e_) ((unsigned)vt[(16 * (s0 + (e_)) + r) * 72 + d])
              w.x = VT16E(0) | (VT16E(1) << 16); w.y = VT16E(2) | (VT16E(3) << 16); w.z = VT16E(4) | (VT16E(5) << 16); w.w = VT16E(6) | (VT16E(7) << 16);
#undef VT16E
              *(u32x4*)(WSP(bf16_t, WS_VT16) + ((size_t)(bh * 16 + r) * 64 + d) * (T / 16) + tile * 16 + s0) = w; }
        }
    }
}

__device__ __forceinline__ float ret_lg(int h) { return logf(1.0f - exp2f(-5.0f - (float)h)); }
__device__ __forceinline__ void ph_ret_local(const P& p, int l, unsigned char* smem) {
    float* ks = (float*)smem; float* vs = ks + 64 * 64; const int tid = tidx(); const bf16_t* PR = WSP(bf16_t, WS_PROJ);
    for (int u = blockIdx.x; u < NUNIT; u += gridDim.x) {
        const int n = u % NCH, h = (u / NCH) % 4, b = u / (NCH * 4); const float lg = ret_lg(h);
        __syncthreads();
        for (int e = tid; e < 4096; e += NTHR) { const int j = e >> 6, d = e & 63; const size_t row = (size_t)(b * T + n * 64 + j) * NPROJ;
            ks[e] = bf2f(PR[row + C_KR + h * 64 + d]) * expf(lg * (float)(63 - j)); vs[e] = bf2f(PR[row + C_VR + h * 64 + d]); }
        __syncthreads();
        const int d = tid >> 3, e0 = (tid & 7) * 8; float acc[8];
#pragma unroll
        for (int i = 0; i < 8; ++i) acc[i] = 0.f;
        for (int j = 0; j < 64; ++j) { const float kd = ks[j * 64 + d];
#pragma unroll
            for (int i = 0; i < 8; ++i) acc[i] += kd * vs[j * 64 + e0 + i]; }
        float* U = WSP(float, WS_RU) + (size_t)u * 4096 + d * 64 + e0;
#pragma unroll
        for (int i = 0; i < 8; ++i) U[i] = acc[i];
    }
}
__device__ __forceinline__ void ph_ret_scan(const P& p, int l) {
    const int gt = blockIdx.x * NTHR + tidx(), ng = gridDim.x * NTHR;
    for (int e = gt; e < PB * 4 * 4096; e += ng) {
        const int bh = e >> 12, de = e & 4095, h = bh & 3; const float cd = expf(ret_lg(h) * 64.0f);
        const float* U = WSP(float, WS_RU) + (size_t)bh * NCH * 4096 + de; float* SPv = WSP(float, WS_RS) + (size_t)bh * NCH * 4096 + de;
        float s = 0.f;
        for (int n0 = 0; n0 < NCH; n0 += 8) {
            float uv[8];
#pragma unroll
            for (int k = 0; k < 8; ++k) uv[k] = U[(size_t)(n0 + k) * 4096];
#pragma unroll
            for (int k = 0; k < 8; ++k) { SPv[(size_t)(n0 + k) * 4096] = s; s = s * cd + uv[k]; } }
        p.out[O_PRET + ((size_t)l * PB * 4 + bh) * 4096 + de] = s;
    }
}
__device__ __forceinline__ void ph_ret_out(const P& p, int l, unsigned char* smem) {
    float* qs = (float*)smem; float* ks = qs + 64 * 65; float* vs = ks + 64 * 65; float* ss = vs + 64 * 65; float* as = ss + 64 * 65;
    const int tid = tidx(); const bf16_t* PR = WSP(bf16_t, WS_PROJ);
    for (int u = blockIdx.x; u < NUNIT; u += gridDim.x) {
        const int n = u % NCH, h = (u / NCH) % 4, b = u / (NCH * 4); const float lg = ret_lg(h);
        __syncthreads();
        for (int e = tid; e < 4096; e += NTHR) { const int j = e >> 6, d = e & 63; const size_t row = (size_t)(b * T + n * 64 + j) * NPROJ;
            qs[j * 65 + d] = bf2f(PR[row + C_QR + h * 64 + d]); ks[j * 65 + d] = bf2f(PR[row + C_KR + h * 64 + d]); vs[j * 65 + d] = bf2f(PR[row + C_VR + h * 64 + d]);
            ss[j * 65 + d] = WSP(float, WS_RS)[(size_t)u * 4096 + e]; }
        __syncthreads();
        const int i = tid >> 3, c0 = (tid & 7) * 8;
#pragma unroll
        for (int jj = 0; jj < 8; ++jj) { const int j = c0 + jj; float a = 0.f;
            if (j <= i) { for (int d = 0; d < 64; ++d) a += qs[i * 65 + d] * ks[j * 65 + d]; a *= expf(lg * (float)(i - j)); }
            as[i * 65 + j] = a; }
        __syncthreads();
        float o[8]; float o2[8];
#pragma unroll
        for (int e = 0; e < 8; ++e) { o[e] = 0.f; o2[e] = 0.f; }
        for (int j = 0; j < 64; ++j) { const float a = as[i * 65 + j], qd = qs[i * 65 + j];
#pragma unroll
            for (int e = 0; e < 8; ++e) { o[e] += a * vs[j * 65 + c0 + e]; o2[e] += qd * ss[j * 65 + c0 + e]; } }
        const float qdec = expf(lg * (float)(i + 1)); float sq = 0.f;
#pragma unroll
        for (int e = 0; e < 8; ++e) { o[e] += o2[e] * qdec; sq += o[e] * o[e]; }
        sq += __shfl_xor(sq, 1); sq += __shfl_xor(sq, 2); sq += __shfl_xor(sq, 4);
        const float rstd = 1.0f / sqrtf(sq * (1.0f / 64.0f) + EPS);
        const size_t row = (size_t)(b * T + n * 64 + i);
#pragma unroll
        for (int e = 0; e < 8; ++e) { const float g = bf2f(PR[row * NPROJ + C_GR + h * 64 + c0 + e]);
            WSP(bf16_t, WS_O)[row * D + 256 + h * 64 + c0 + e] = f2bf(o[e] * rstd * p.ret_norm[l * 64 + c0 + e] * silu_f(g)); }
    }
}
__device__ __forceinline__ void ph_ret_sample(const P& p, int l, unsigned char* smem) {
    float* S0 = (float*)smem; float* qs = S0 + 4096; float* ks = qs + 8 * 64; float* vs = ks + 8 * 64;
    const int tid = tidx(); const bf16_t* PR = WSP(bf16_t, WS_PROJ);
    for (int u = gridDim.x - 1 - blockIdx.x; u < DB * 4; u += gridDim.x) {
        const int h = u & 3, b = u >> 2; const float lg = ret_lg(h);
        __syncthreads();
        for (int e = tid; e < 4096; e += NTHR) S0[e] = p.state_ret[(((size_t)l * DB + b) * 4 + h) * 4096 + e];
        { const int j = tid >> 6, d = tid & 63; const size_t row = (size_t)(MP + b * DS + j) * NPROJ;
          qs[tid] = bf2f(PR[row + C_QR + h * 64 + d]); ks[tid] = bf2f(PR[row + C_KR + h * 64 + d]); vs[tid] = bf2f(PR[row + C_VR + h * 64 + d]); }
        __syncthreads();
        { const int i = tid >> 6, e = tid & 63; float o = 0.f;
          for (int j = 0; j <= i; ++j) { float a = 0.f; for (int d = 0; d < 64; ++d) a += qs[i * 64 + d] * ks[j * 64 + d]; o += a * expf(lg * (float)(i - j)) * vs[j * 64 + e]; }
          float o2 = 0.f; for (int d = 0; d < 64; ++d) o2 += qs[i * 64 + d] * S0[d * 64 + e];
          o += o2 * expf(lg * (float)(i + 1));
          const float rstd = 1.0f / sqrtf(wave_sum(o * o) * (1.0f / 64.0f) + EPS);
          const size_t row = (size_t)(MP + b * DS + i); const float g = bf2f(PR[row * NPROJ + C_GR + h * 64 + e]);
          WSP(bf16_t, WS_O)[row * D + 256 + h * 64 + e] = f2bf(o * rstd * p.ret_norm[l * 64 + e] * silu_f(g)); }
        for (int x = tid; x < 4096; x += NTHR) { const int d = x >> 6, e = x & 63; float s = S0[x] * expf(lg * (float)DS);
            for (int j = 0; j < DS; ++j) s += ks[j * 64 + d] * expf(lg * (float)(DS - 1 - j)) * vs[j * 64 + e];
            p.out[O_SRET + (((size_t)l * DB + b) * 4 + h) * 4096 + x] = s; }
    }
}

template <int CS, int LDL> __device__ __forceinline__ void fwd_subst(float (&X)[CS], const float* Ls) {
#pragma unroll
    for (int i = 1; i < CS; ++i) {
        float a = X[i];
#pragma unroll
        for (int j4 = 0; j4 < (i + 3) / 4; ++j4) { const f32x4 lv = *(const f32x4*)(Ls + i * LDL + 4 * j4);
#pragma unroll
            for (int e = 0; e < 4; ++e) if (4 * j4 + e < i) a -= lv[e] * X[4 * j4 + e]; }
        X[i] = a;
    }
}
constexpr int QP = 132;
constexpr int WSTP = 136;
constexpr int RWP = 392, TP = 136;
__device__ __forceinline__ void ph_gdn_prep(const P& p, int l, unsigned char* smem) {
    float* Ls = (float*)smem; float* As = Ls + 64 * 68; float* gs = As + 64 * 68; float* gcs = gs + 64; float* bts = gcs + 64; float* part = bts + 64;
    bf16_t* raw = (bf16_t*)(part + 4 * 64); bf16_t* Khi = raw + 67 * RWP; bf16_t* Klo = Khi + 64 * TP; bf16_t* Qb = Klo + 64 * TP;
    static_assert((64 * 68 * 2 + 64 * 3 + 4 * 64) * 4 + (67 * RWP + 3 * 64 * TP) * 2 <= BAR_LDS_OFF, "gdn_prep LDS");
    const int tid = tidx(), lane = tid & 63, wave = tid >> 6; const bf16_t* PR = WSP(bf16_t, WS_PROJ);
    for (int u = blockIdx.x; u < NUNIT; u += gridDim.x) {
        const int n = u % NCH, h = (u / NCH) % 4, b = u / (NCH * 4), t0 = n * 64;
        __syncthreads();
        for (int e = tid; e < 67 * 48; e += NTHR) { const int row = e / 48, ch = e % 48, t = t0 - 3 + row; u32x4 v = (u32x4){0u, 0u, 0u, 0u};
            if (t >= 0) v = *(const u32x4*)(PR + (size_t)(b * T + t) * NPROJ + C_CONV + (ch >> 4) * 512 + h * 128 + (ch & 15) * 8);
            *(u32x4*)(raw + row * RWP + ch * 8) = v; }
        if (tid >= 384 && tid < 448) { const int i = tid - 384; const size_t row = (size_t)(b * T + t0 + i); gs[i] = WSP(float, WS_G)[row * 4 + h]; bts[i] = WSP(float, WS_BETA)[row * 4 + h]; }
        __syncthreads();
        float y[64]; const int sec = tid < 128 ? 2 : tid < 256 ? 1 : 0, c = tid & 127;
        if (tid < 384) { const int col = sec * 512 + h * 128 + c;
            const float w0 = p.conv_w[(l * 4 + 0) * 1536 + col], w1 = p.conv_w[(l * 4 + 1) * 1536 + col], w2 = p.conv_w[(l * 4 + 2) * 1536 + col], w3 = p.conv_w[(l * 4 + 3) * 1536 + col];
            const LAS bf16_t* rp = (const LAS bf16_t*)raw + sec * 128 + c; LAUNDER_V(rp); float x0 = bf2f(rp[0]), x1 = bf2f(rp[RWP]), x2 = bf2f(rp[2 * RWP]);
#pragma unroll
            for (int i = 0; i < 64; ++i) { const float x3 = bf2f(rp[(i + 3) * RWP]); y[i] = silu_fast(w0 * x0 + w1 * x1 + w2 * x2 + w3 * x3); x0 = x1; x1 = x2; x2 = x3; if ((i & 7) == 7) COMPILER_FENCE(); } }
        if (tid == 448) { float a = 0.f; for (int i = 0; i < 64; ++i) { a += gs[i]; gcs[i] = a; } }
        if (tid >= 128 && tid < 384) {
#pragma unroll
            for (int i = 0; i < 64; ++i) { const float s = wave_sum(y[i] * y[i]); if (lane == 0) part[(wave - 2) * 64 + i] = s; if ((i & 7) == 7) COMPILER_FENCE(); } }
        __syncthreads();
        if (tid >= 128 && tid < 256) { const float gl = gcs[63]; LAS bf16_t* kh = (LAS bf16_t*)Khi + c; LAS bf16_t* kl = (LAS bf16_t*)Klo + c; LAUNDER_V(kh); LAUNDER_V(kl);
#pragma unroll
            for (int i = 0; i < 64; ++i) { const float v = y[i] / sqrtf(part[i] + part[64 + i] + EPS); y[i] = v; const bf16_t hb = f2bf(v); kh[i * TP] = hb; kl[i * TP] = f2bf(v - bf2f(hb)); if ((i & 7) == 7) COMPILER_FENCE(); }
            bf16_t* dst = WSP(bf16_t, WS_GWK) + (size_t)u * 16384 + 8192; const int mt = c >> 4, x = c & 15;
#pragma unroll
            for (int ks2 = 0; ks2 < 2; ++ks2)
#pragma unroll
                for (int q = 0; q < 4; ++q) { const int i0 = 32 * ks2 + 4 * q; float v[8];
#pragma unroll
                    for (int e = 0; e < 8; ++e) { const int i = i0 + (e < 4 ? e : 12 + e); v[e] = y[i] * expf(gl - gcs[i]); }
                    u32x4 w; w.x = pk2(v[0], v[1]); w.y = pk2(v[2], v[3]); w.z = pk2(v[4], v[5]); w.w = pk2(v[6], v[7]);
                    *(u32x4*)(dst + ((size_t)((mt * 2 + ks2) * 64 + q * 16 + x)) * 8) = w; COMPILER_FENCE(); } }
        else if (tid >= 256 && tid < 384) { bf16_t* qg = WSP(bf16_t, WS_GQ) + (size_t)u * 8192 + c; LAS bf16_t* qb = (LAS bf16_t*)Qb + c; LAUNDER_V(qb);
#pragma unroll
            for (int i = 0; i < 64; ++i) { const float v = y[i] / sqrtf(part[128 + i] + part[192 + i] + EPS); qb[i * TP] = f2bf(v); qg[(i & 7) * 128] = f2bf(v * 0.08838834764831845f * expf(gcs[i])); if ((i & 7) == 7) { qg += 8 * 128; LAUNDER_V(qg); COMPILER_FENCE(); } } }
        __syncthreads();
#pragma unroll
        for (int tp = 0; tp < 2; ++tp) { const int pos = wave * 2 + tp, it = pos >> 2, jt = pos & 3, j16 = lane & 15, qd = lane >> 4;
            f32x4 lk = (f32x4){0.f, 0.f, 0.f, 0.f}, aq = (f32x4){0.f, 0.f, 0.f, 0.f};
            if (jt <= it) {
#pragma unroll
                for (int ks = 0; ks < 4; ++ks) { const int ao = (16 * it + j16) * TP + 32 * ks + 8 * qd, bo = (16 * jt + j16) * TP + 32 * ks + 8 * qd;
                    const bf16x8 ah = *(const bf16x8*)(Khi + ao), al = *(const bf16x8*)(Klo + ao), aqf = *(const bf16x8*)(Qb + ao), bh = *(const bf16x8*)(Khi + bo), bl = *(const bf16x8*)(Klo + bo);
                    lk = MFMA16(ah, bh, lk); lk = MFMA16(ah, bl, lk); lk = MFMA16(al, bh, lk); aq = MFMA16(aqf, bh, aq); } }
            const int j = 16 * jt + j16;
#pragma unroll
            for (int e = 0; e < 4; ++e) { const int i = 16 * it + 4 * qd + e; const float ex = j <= i ? expf(gcs[i] - gcs[j]) : 0.f;
                Ls[i * 68 + j] = j < i ? bts[i] * lk[e] * ex : 0.f; As[i * 68 + j] = aq[e] * ex * 0.08838834764831845f; } }
        __syncthreads();
        if (tid < 256) {
            if (tid < 128) {
#pragma unroll
                for (int i = 0; i < 64; ++i) { y[i] *= bts[i]; if ((i & 15) == 15) COMPILER_FENCE(); } }
            else {
#pragma unroll
                for (int i = 0; i < 64; ++i) { y[i] *= bts[i] * expf(gcs[i]); if ((i & 7) == 7) COMPILER_FENCE(); } }
            fwd_subst<64, 68>(y, Ls);
            if (tid < 128) { bf16_t* U = WSP(bf16_t, WS_GU) + (size_t)u * 8192 + c * 64;
#pragma unroll
                for (int i8 = 0; i8 < 8; ++i8) { u32x4 w; w.x = pk2(y[8 * i8], y[8 * i8 + 1]); w.y = pk2(y[8 * i8 + 2], y[8 * i8 + 3]); w.z = pk2(y[8 * i8 + 4], y[8 * i8 + 5]); w.w = pk2(y[8 * i8 + 6], y[8 * i8 + 7]); *(u32x4*)(U + 8 * i8) = w; } }
            else { LAS bf16_t* wst = (LAS bf16_t*)raw + c; LAUNDER_V(wst);
#pragma unroll
                for (int i = 0; i < 64; ++i) wst[i * WSTP] = f2bf(-y[i]); }
        } else { const int t2 = tid - 256;
#pragma unroll 2
            for (int e = t2; e < 4096; e += 256) WSP(bf16_t, WS_GA)[(size_t)u * 4096 + e] = f2bf(As[(e >> 6) * 68 + (e & 63)]);
            if (t2 == 0) WSP(float, WS_GD)[u] = expf(gcs[63]); }
        __syncthreads();
        { bf16_t* dst = WSP(bf16_t, WS_GWK) + (size_t)u * 16384; const bf16_t* wst = raw;
#pragma unroll
          for (int k = 0; k < 2; ++k) { const int f = tid + NTHR * k, ln = f & 63, ks4 = (f >> 6) & 3, mt = f >> 8, q = ln >> 4, x = ln & 15;
              const bf16_t* wr = wst + (16 * mt + x) * WSTP + 32 * ks4 + 4 * q;
              u32x4 w; w.x = (unsigned)wr[0] | ((unsigned)wr[1] << 16); w.y = (unsigned)wr[2] | ((unsigned)wr[3] << 16); w.z = (unsigned)wr[16] | ((unsigned)wr[17] << 16); w.w = (unsigned)wr[18] | ((unsigned)wr[19] << 16);
              *(u32x4*)(dst + (size_t)f * 8) = w; } }
    }
}
__device__ __forceinline__ bf16x8 pack_tiles(const f32x4& lo, const f32x4& hi) {
    u32x4 w; w.x = pk2(lo[0], lo[1]); w.y = pk2(lo[2], lo[3]); w.z = pk2(hi[0], hi[1]); w.w = pk2(hi[2], hi[3]); return __builtin_bit_cast(bf16x8, w);
}
constexpr int CH_SLOT = 40960, CH_NSLOT = 3;
constexpr int CH_ITEMS = PB * 4 * 2;
static_assert(NCH % 4 == 0, "the chain's loop is unrolled by four chunks");
__device__ __forceinline__ void chain_stage(const bf16_t* WK, const bf16_t* UTh, int m, int pw, int lane, unsigned char* smem) {
    unsigned char* slot = smem + (m % CH_NSLOT) * CH_SLOT;
#pragma unroll
    for (int k = 0; k < 8; ++k) GLDS16((const unsigned char*)(WK + (size_t)m * 16384) + (pw * 8 + k) * 1024 + lane * 16, slot + (pw * 8 + k) * 1024);
#pragma unroll
    for (int k = 0; k < 2; ++k) GLDS16((const unsigned char*)(UTh + (size_t)m * 8192) + (pw * 2 + k) * 1024 + lane * 16, slot + 32768 + (pw * 2 + k) * 1024);
}
__device__ __forceinline__ void ph_gdn_chain(const P& p, int l, unsigned char* smem) {
    const int tid = tidx(), lane = tid & 63, wave = UNIFORM(tid >> 6), j = lane & 15, q = lane >> 4;
    for (int it = blockIdx.x; it < CH_ITEMS; it += gridDim.x) {
        const int half = it & 1, bh = it >> 1;
        const bf16_t* WK = WSP(bf16_t, WS_GWK) + (size_t)bh * NCH * 16384;
        const bf16_t* UTh = WSP(bf16_t, WS_GU) + (size_t)bh * NCH * 8192 + half * 4096;
        __syncthreads();
        if (wave >= 4) {
            const int pw = wave - 4;
            chain_stage(WK, UTh, 0, pw, lane, smem); chain_stage(WK, UTh, 1, pw, lane, smem);
#pragma unroll 1
            for (int n = 0; n < NCH; ++n) {
                if (n + 1 < NCH) WAIT_VM(10); else WAIT_VM(0);
                RAW_BARRIER();
                if (n + 2 < NCH) chain_stage(WK, UTh, n + 2, pw, lane, smem);
            }
        } else {
            const int sl = half * 4 + wave, c = 16 * sl + j;
            f32x4 S[8];
#pragma unroll
            for (int t = 0; t < 8; ++t) S[t] = (f32x4){0.f, 0.f, 0.f, 0.f};
            bf16x8 sB[4];
#pragma unroll
            for (int ks = 0; ks < 4; ++ks) sB[ks] = pack_tiles(S[2 * ks], S[2 * ks + 1]);
            const float* DC = WSP(float, WS_GD) + bh * NCH;
            float db[4];
#pragma unroll
            for (int d = 0; d < 4; ++d) db[d] = DC[d];
#pragma unroll 1
            for (int n0 = 0; n0 < NCH; n0 += 4) {
#pragma unroll
                for (int k4 = 0; k4 < 4; ++k4) {
                    const int n = n0 + k4, u = bh * NCH + n;
                    f32x4 acc[4]; const float dec = db[k4];
                    if (n + 4 < NCH) db[k4] = DC[n + 4];
                    { bf16_t* sp = WSP(bf16_t, WS_GS) + (size_t)u * 16384 + c * 128 + 4 * q;
#pragma unroll
                      for (int t = 0; t < 8; ++t) { u32x2 w; w.x = pk2(S[t][0], S[t][1]); w.y = pk2(S[t][2], S[t][3]); *(u32x2*)(sp + 16 * t) = w; } }
                    WAIT_LGKM0();
                    RAW_BARRIER();
                    const LAS unsigned char* slot = (const LAS unsigned char*)smem + (n % CH_NSLOT) * CH_SLOT + lane * 16; LAUNDER_V(slot);
                    { const LAS unsigned char* us = (const LAS unsigned char*)smem + (n % CH_NSLOT) * CH_SLOT + 32768 + ((16 * wave + j) * 64 + 4 * q) * 2; LAUNDER_V(us);
#pragma unroll
                      for (int mt = 0; mt < 4; ++mt) { const u32x2 w = *(const LAS u32x2*)(us + 32 * mt); acc[mt] = (f32x4){bf2f((bf16_t)(w.x & 0xffff)), bf2f((bf16_t)(w.x >> 16)), bf2f((bf16_t)(w.y & 0xffff)), bf2f((bf16_t)(w.y >> 16))}; } }
                    bf16x8 fa[8], fb[8];
#pragma unroll
                    for (int i = 0; i < 8; ++i) fa[i] = *(const LAS bf16x8*)(slot + i * 1024);
#pragma unroll
                    for (int i = 0; i < 8; ++i) fb[i] = *(const LAS bf16x8*)(slot + (8 + i) * 1024);
                    COMPILER_FENCE();
#pragma unroll
                    for (int ks = 0; ks < 4; ++ks) { acc[0] = MFMA16(fa[ks], sB[ks], acc[0]); acc[1] = MFMA16(fa[4 + ks], sB[ks], acc[1]); }
                    COMPILER_FENCE();
#pragma unroll
                    for (int i = 0; i < 8; ++i) fa[i] = *(const LAS bf16x8*)(slot + 16384 + i * 1024);
#pragma unroll
                    for (int ks = 0; ks < 4; ++ks) { acc[2] = MFMA16(fb[ks], sB[ks], acc[2]); acc[3] = MFMA16(fb[4 + ks], sB[ks], acc[3]); }
                    COMPILER_FENCE();
#pragma unroll
                    for (int i = 0; i < 8; ++i) fb[i] = *(const LAS bf16x8*)(slot + 16384 + (8 + i) * 1024);
                    { bf16_t* vp = WSP(bf16_t, WS_GV) + (size_t)u * 8192 + c * 64 + 4 * q;
#pragma unroll
                      for (int mt = 0; mt < 4; ++mt) { u32x2 w; w.x = pk2(acc[mt][0], acc[mt][1]); w.y = pk2(acc[mt][2], acc[mt][3]); *(u32x2*)(vp + 16 * mt) = w; } }
                    const bf16x8 vB0 = pack_tiles(acc[0], acc[1]), vB1 = pack_tiles(acc[2], acc[3]);
#pragma unroll
                    for (int t = 0; t < 8; ++t) S[t] = S[t] * dec;
                    COMPILER_FENCE();
#pragma unroll
                    for (int t = 0; t < 4; ++t) S[t] = MFMA16(fa[2 * t], vB0, S[t]);
#pragma unroll
                    for (int t = 0; t < 4; ++t) S[t] = MFMA16(fa[2 * t + 1], vB1, S[t]);
#pragma unroll
                    for (int t = 0; t < 4; ++t) S[4 + t] = MFMA16(fb[2 * t], vB0, S[4 + t]);
#pragma unroll
                    for (int t = 0; t < 4; ++t) S[4 + t] = MFMA16(fb[2 * t + 1], vB1, S[4 + t]);
                    COMPILER_FENCE();
#pragma unroll
                    for (int ks = 0; ks < 4; ++ks) sB[ks] = pack_tiles(S[2 * ks], S[2 * ks + 1]);
                }
            }
            float* o = p.out + O_PGDN + ((size_t)l * PB * 4 + bh) * 16384 + c;
#pragma unroll
            for (int t = 0; t < 8; ++t)
#pragma unroll
                for (int e = 0; e < 4; ++e) o[(size_t)(16 * t + 4 * q + e) * 128] = S[t][e];
        }
    }
}
__device__ __forceinline__ void ph_gdn_out(const P& p, int l) {
    const int tid = tidx(), lane = tid & 63, wave = tid >> 6, j = lane & 15, q = lane >> 4, mt = wave & 3;
    const bf16_t* PR = WSP(bf16_t, WS_PROJ);
    for (int u = blockIdx.x * 2 + (wave >> 2); u < NUNIT; u += gridDim.x * 2) {
        const int n = u % NCH, h = (u / NCH) % 4, b = u / (NCH * 4);
        f32x4 acc[8];
#pragma unroll
        for (int ct = 0; ct < 8; ++ct) acc[ct] = (f32x4){0.f, 0.f, 0.f, 0.f};
        const bf16_t* qg = WSP(bf16_t, WS_GQ) + (size_t)u * 8192 + (16 * mt + j) * 128 + 8 * q;
        const bf16_t* st = WSP(bf16_t, WS_GS) + (size_t)u * 16384 + j * 128 + 8 * q;
#pragma unroll
        for (int ks = 0; ks < 4; ++ks) { const bf16x8 a = *(const bf16x8*)(qg + 32 * ks);
#pragma unroll
            for (int ct = 0; ct < 8; ++ct) acc[ct] = MFMA16(a, *(const bf16x8*)(st + (size_t)ct * 16 * 128 + 32 * ks), acc[ct]);
            COMPILER_FENCE(); }
        const bf16_t* at = WSP(bf16_t, WS_GA) + (size_t)u * 4096 + (16 * mt + j) * 64 + 8 * q;
        const bf16_t* vt = WSP(bf16_t, WS_GV) + (size_t)u * 8192 + j * 64 + 8 * q;
#pragma unroll
        for (int ks = 0; ks < 2; ++ks) { const bf16x8 a = *(const bf16x8*)(at + 32 * ks);
#pragma unroll
            for (int ct = 0; ct < 8; ++ct) acc[ct] = MFMA16(a, *(const bf16x8*)(vt + (size_t)ct * 16 * 64 + 32 * ks), acc[ct]);
            COMPILER_FENCE(); }
        float sq[4];
#pragma unroll
        for (int e = 0; e < 4; ++e) { float s = 0.f;
#pragma unroll
            for (int ct = 0; ct < 8; ++ct) s += acc[ct][e] * acc[ct][e];
            s += __shfl_xor(s, 1); s += __shfl_xor(s, 2); s += __shfl_xor(s, 4); s += __shfl_xor(s, 8); sq[e] = 1.0f / sqrtf(s * (1.0f / 128.0f) + EPS); }
#pragma unroll
        for (int e = 0; e < 4; ++e) { const size_t row = (size_t)(b * T + n * 64 + 16 * mt + 4 * q + e);
#pragma unroll
            for (int ct = 0; ct < 8; ++ct) { const int c = 16 * ct + j; const float z = bf2f(PR[row * NPROJ + C_Z + h * 128 + c]);
                WSP(bf16_t, WS_O)[row * D + 512 + h * 128 + c] = f2bf(acc[ct][e] * sq[e] * p.gdn_norm[l * 128 + c] * silu_f(z)); } }
    }
}
__device__ __forceinline__ void ph_gdn_sample(const P& p, int l, unsigned char* smem) {
    float* qs = (float*)smem; float* ks = qs + 8 * QP; float* vs = ks + 8 * QP; float* us = vs + 8 * QP; float* wsm = us + 8 * 128; float* vn = wsm + 8 * 128;
    float* Ls = vn + 8 * 128; float* As = Ls + 8 * 8; float* gs = As + 8 * 8; float* gcs = gs + 8; float* bts = gcs + 8; float* S0 = bts + 8;
    const int tid = tidx(); const bf16_t* PR = WSP(bf16_t, WS_PROJ);
    for (int u = gridDim.x - 1 - blockIdx.x; u < DB * 4; u += gridDim.x) {
        const int h = u & 3, b = u >> 2;
        __syncthreads();
#pragma unroll 4
        for (int e = tid; e < 16384; e += NTHR) S0[e] = p.state_gdn[(((size_t)l * DB + b) * 4 + h) * 16384 + e];
        if (tid < 384) { const int sec = tid >> 7, c = tid & 127, col = sec * 512 + h * 128 + c; float* dst = sec == 0 ? qs : sec == 1 ? ks : vs;
            const float w0 = p.conv_w[(l * 4 + 0) * 1536 + col], w1 = p.conv_w[(l * 4 + 1) * 1536 + col], w2 = p.conv_w[(l * 4 + 2) * 1536 + col], w3 = p.conv_w[(l * 4 + 3) * 1536 + col];
            const float* hist = p.state_conv + (((size_t)l * DB + b) * 3) * 1536 + col; const bf16_t* src = PR + (size_t)(MP + b * DS) * NPROJ + C_CONV + col;
            float x0 = hist[0], x1 = hist[1536], x2 = hist[2 * 1536];
            for (int i = 0; i < DS; ++i) { const float x3 = bf2f(src[(size_t)i * NPROJ]); const float y = w0 * x0 + w1 * x1 + w2 * x2 + w3 * x3; dst[i * QP + c] = silu_f(y); x0 = x1; x1 = x2; x2 = x3; } }
        else if (tid < 384 + DS) { const int i = tid - 384; const size_t row = (size_t)(MP + b * DS + i); gs[i] = WSP(float, WS_G)[row * 4 + h]; bts[i] = WSP(float, WS_BETA)[row * 4 + h]; }
        __syncthreads();
        if (tid < 64) { const int rid = tid >> 2, part = tid & 3; float* rowp = (rid < 8 ? qs + rid * QP : ks + (rid - 8) * QP) + part * 32; float s = 0.f;
            for (int d = 0; d < 32; ++d) s += rowp[d] * rowp[d];
            s += __shfl_xor(s, 1); s += __shfl_xor(s, 2); const float sc = 1.0f / sqrtf(s + EPS);
            for (int d = 0; d < 32; ++d) rowp[d] *= sc; }
        if (tid == 64) { float a = 0.f; for (int i = 0; i < DS; ++i) { a += gs[i]; gcs[i] = a; } }
        __syncthreads();
        if (tid < 64) { const int i = tid >> 3, j = tid & 7; float lv = 0.f, av = 0.f;
            if (j <= i) { float dk = 0.f, dq = 0.f; for (int d = 0; d < 128; ++d) { const float kj = ks[j * QP + d]; dk += ks[i * QP + d] * kj; dq += qs[i * QP + d] * kj; }
                const float e = expf(gcs[i] - gcs[j]); av = dq * e * 0.08838834764831845f; lv = j < i ? bts[i] * dk * e : 0.f; }
            Ls[i * 8 + j] = lv; As[i * 8 + j] = av; }
        __syncthreads();
        if (tid < 256) { const int c = tid; float X[8];
            if (c < 128) {
#pragma unroll
                for (int i = 0; i < 8; ++i) X[i] = vs[i * QP + c] * bts[i]; }
            else {
#pragma unroll
                for (int i = 0; i < 8; ++i) X[i] = ks[i * QP + c - 128] * bts[i] * expf(gcs[i]); }
            fwd_subst<8, 8>(X, Ls);
            float* dst = c < 128 ? us + c : wsm + c - 128;
#pragma unroll
            for (int i = 0; i < 8; ++i) dst[i * 128] = X[i]; }
        __syncthreads();
        const int i = tid >> 6, c2 = (tid & 63) * 2;
        { float a0 = us[i * 128 + c2], a1 = us[i * 128 + c2 + 1];
          for (int d = 0; d < 128; ++d) { const float w = wsm[i * 128 + d]; a0 -= w * S0[d * 128 + c2]; a1 -= w * S0[d * 128 + c2 + 1]; }
          vn[i * 128 + c2] = a0; vn[i * 128 + c2 + 1] = a1; }
        __syncthreads();
        { float o0 = 0.f, o1 = 0.f; const float qsc = 0.08838834764831845f * expf(gcs[i]);
          for (int d = 0; d < 128; ++d) { const float qg = qs[i * QP + d] * qsc; o0 += qg * S0[d * 128 + c2]; o1 += qg * S0[d * 128 + c2 + 1]; }
          for (int j = 0; j < DS; ++j) { const float a = As[i * 8 + j]; o0 += a * vn[j * 128 + c2]; o1 += a * vn[j * 128 + c2 + 1]; }
          const float rstd = 1.0f / sqrtf(wave_sum(o0 * o0 + o1 * o1) * (1.0f / 128.0f) + EPS);
          const size_t row = (size_t)(MP + b * DS + i);
          const float z0 = bf2f(PR[row * NPROJ + C_Z + h * 128 + c2]), z1 = bf2f(PR[row * NPROJ + C_Z + h * 128 + c2 + 1]);
          bf16_t* O = WSP(bf16_t, WS_O) + row * D + 512 + h * 128 + c2;
          O[0] = f2bf(o0 * rstd * p.gdn_norm[l * 128 + c2] * silu_f(z0)); O[1] = f2bf(o1 * rstd * p.gdn_norm[l * 128 + c2 + 1] * silu_f(z1)); }
        { const float gl = gcs[DS - 1], dec = expf(gl); float* o = p.out + O_SGDN + (((size_t)l * DB + b) * 4 + h) * 16384;
#pragma unroll 2
          for (int e = tid; e < 16384; e += NTHR) { const int d = e >> 7, c = e & 127; float s = S0[e] * dec;
              for (int j = 0; j < DS; ++j) s += ks[j * QP + d] * expf(gl - gcs[j]) * vn[j * 128 + c];
              o[e] = s; } }
    }
}

__device__ __forceinline__ void ph_final_norm(const P& p) {
    const int lane = tidx() & 63, wave = tidx() >> 6, gw = blockIdx.x * 8 + wave, ngw = gridDim.x * 8;
    for (int r = gw; r < M; r += ngw) {
        float* xr = p.out + (size_t)r * D; f32x4 v[4]; float ss = 0.f;
#pragma unroll
        for (int j = 0; j < 4; ++j) { v[j] = *(const f32x4*)(xr + 4 * lane + 256 * j); ss += (v[j][0] * v[j][0] + v[j][1] * v[j][1]) + (v[j][2] * v[j][2] + v[j][3] * v[j][3]); }
        const float rstd = 1.0f / sqrtf(wave_sum(ss) * (1.0f / D) + EPS);
#pragma unroll
        for (int j = 0; j < 4; ++j) { const f32x4 g = *(const f32x4*)(p.final_norm + 4 * lane + 256 * j); *(f32x4*)(xr + 4 * lane + 256 * j) = v[j] * rstd * g; }
    }
}

enum Phase { PH_PRO = 0, PH_NORM1, PH_GEMM_IN, PH_ROPE, PH_MIX1, PH_MIX2, PH_MIX3, PH_GEMM_OUT, PH_NORM2, PH_GEMM_GU, PH_GEMM_DN, PH_FINAL };
#ifdef __HIP_EMU__
#define LDSP(x) (x)
#else
#define LDSP(x) ((PG8_LAS unsigned char*)(x))
#endif
template <int PH> __device__ __forceinline__ void run_phase(const P& p, int l, unsigned char* smem) {
    if constexpr (PH == PH_PRO) { ph_convert(p, smem); __syncthreads(); ph_adaln(p, smem); ph_ropetab_copyx(p); }
    else if constexpr (PH == PH_NORM1) ph_norm_mod<0>(p, l);
    else if constexpr (PH == PH_GEMM_IN) {
        pg8::Gemm g{WSP(bf16_t, WS_H), WSP(bf16_t, WS_WIN) + (size_t)l * NPROJ * D, MPAD, NPROJ, D}; pg8::StaticOrder S; S.init(MPAD, NPROJ, (int)gridDim.x, (int)blockIdx.x);
        pg8::EpiStoreBf16 E{WSP(bf16_t, WS_PROJ), NPROJ};
        pg8::gemm_phase<pg8::EpiStoreBf16, pg8::StaticOrder, true, true>(LDSP(smem), g, S, E);
    }
    else if constexpr (PH == PH_ROPE) { ph_rope_out(p, l); ph_vtrans(p, smem); }
    else if constexpr (PH == PH_MIX1) { ph_attn_jobs(p); ph_ret_local(p, l, smem); ph_gdn_prep(p, l, smem); }
    else if constexpr (PH == PH_MIX2) { ph_gdn_chain(p, l, smem); __syncthreads(); ph_attn_sample(p, l, smem); ph_ret_sample(p, l, smem); ph_gdn_sample(p, l, smem); ph_ret_scan(p, l); ph_attn_combine(p); }
    else if constexpr (PH == PH_MIX3) { ph_ret_out(p, l, smem); ph_gdn_out(p, l); }
    else if constexpr (PH == PH_GEMM_OUT) {
        pg8::Gemm g{WSP(bf16_t, WS_O), WSP(bf16_t, WS_WOUT) + (size_t)l * D * D, MPAD, D, D}; pg8::StaticOrder S; S.init(MPAD, D, (int)gridDim.x, (int)blockIdx.x);
        pg8::EpiResidual E{p.out, WSP(float, WS_MOD) + (size_t)l * NC * 6144 + 2048};
        pg8::gemm_phase<pg8::EpiResidual, pg8::StaticOrder, true, true>(LDSP(smem), g, S, E);
    }
    else if constexpr (PH == PH_NORM2) ph_norm_mod<1>(p, l);
    else if constexpr (PH == PH_GEMM_GU) {
        pg8::Gemm g{WSP(bf16_t, WS_H), WSP(bf16_t, WS_WGU) + (size_t)l * 2 * FF * D, MPAD, 2 * FF, D}; pg8::StaticOrder S; S.init(MPAD, 2 * FF, (int)gridDim.x, (int)blockIdx.x);
        pg8::EpiSwiglu E{WSP(bf16_t, WS_HID)};
        pg8::gemm_phase<pg8::EpiSwiglu, pg8::StaticOrder, true, true>(LDSP(smem), g, S, E);
    }
    else if constexpr (PH == PH_GEMM_DN) {
        pg8::Gemm g{WSP(bf16_t, WS_HID), WSP(bf16_t, WS_WDN) + (size_t)l * D * FF, MPAD, D, FF}; pg8::StaticOrder S; S.init(MPAD, D, (int)gridDim.x, (int)blockIdx.x);
        pg8::EpiResidual E{p.out, WSP(float, WS_MOD) + (size_t)l * NC * 6144 + 5120};
        pg8::gemm_phase<pg8::EpiResidual, pg8::StaticOrder, true, true>(LDSP(smem), g, S, E);
    }
    else if constexpr (PH == PH_FINAL) ph_final_norm(p);
}
template <int PH> __global__ void __launch_bounds__(NTHR, 2) k_phase(P p, int l) { DYN_SMEM(smem); run_phase<PH>(p, l, smem); }


#ifndef __HIP_EMU__
#define LAS __attribute__((address_space(3)))
#define XB_TMO      128
#define XB_XCNT(j)  (256  + 64 * (j))
#define XB_XSUB(j)  (1280 + 64 * (j))
#define XB_XGEN(j)  (2304 + 64 * (j))
#define XB_TOP      3328
#define XB_TOPGEN   3392
#define XCD_BAR_WORDS 3456
#define XB_SPIN_CAP (1u << 18)

__device__ __forceinline__ unsigned xb_ld(unsigned* p)              { return __hip_atomic_load(p, __ATOMIC_RELAXED, __HIP_MEMORY_SCOPE_AGENT); }
__device__ __forceinline__ unsigned xb_add(unsigned* p, unsigned v) { return __hip_atomic_fetch_add(p, v, __ATOMIC_RELAXED, __HIP_MEMORY_SCOPE_AGENT); }
__device__ __forceinline__ unsigned xb_xcc_id() { return (unsigned)__builtin_amdgcn_s_getreg((3 << 11) | 20) & 0xFu; }
#define XB_SPIN(cond, bar) do { unsigned _sp = 0; while (cond) { __builtin_amdgcn_s_sleep(1); \
    if ((++_sp & 255u) == 0u) { if (xb_ld(&(bar)[XB_TMO])) break; if (_sp > XB_SPIN_CAP) { atomicAdd(&(bar)[XB_TMO], 1u); break; } } } } while (0)

struct XcdBarrier {
    unsigned* bar; unsigned x;
    volatile LAS unsigned* st;
};

__device__ __forceinline__ XcdBarrier xcd_barrier_post(unsigned* bar, volatile LAS unsigned* st) {
    XcdBarrier b; b.bar = bar; b.x = xb_xcc_id(); b.st = st;
    if (threadIdx.x == 0) (void)xb_add(&bar[XB_XCNT(b.x)], 1u);
    return b;
}
__device__ __forceinline__ void xcd_barrier_complete(unsigned* bar, unsigned x, unsigned& nloc, unsigned& nx) {
    const unsigned G = gridDim.x * gridDim.y * gridDim.z;
    unsigned sum, cnt, mine, sp = 0u;
    for (;;) {
        sum = 0u; cnt = 0u; mine = 0u;
#pragma unroll
        for (unsigned j = 0; j < 16; ++j) { const unsigned c = xb_ld(&bar[XB_XCNT(j)]); sum += c; cnt += (c > 0u) ? 1u : 0u; mine = (j == x) ? c : mine; }
        if (sum == G) break;
        __builtin_amdgcn_s_sleep(1);
        if ((++sp & 255u) == 0u) { if (xb_ld(&bar[XB_TMO])) break; if (sp > XB_SPIN_CAP) { atomicAdd(&bar[XB_TMO], 1u); break; } }
    }
    nloc = mine > 0u ? mine : 1u; nx = cnt > 0u ? cnt : 1u;
}

__device__ __forceinline__ void xcd_barrier(const XcdBarrier& b) {
    asm volatile("s_waitcnt vmcnt(0)" ::: "memory");
    __syncthreads();
    if (threadIdx.x == 0) {
        unsigned* bar = b.bar;
        __builtin_amdgcn_s_waitcnt(0);
        unsigned nloc = b.st[0], nx = b.st[1];
        if (nloc == 0u) { xcd_barrier_complete(bar, b.x, nloc, nx); b.st[0] = nloc; b.st[1] = nx; }
        const unsigned old = xb_add(&bar[XB_XSUB(b.x)], 1u);
        const unsigned gen = old / nloc;
        if (old + 1u == (gen + 1u) * nloc) {
            __builtin_amdgcn_fence(__ATOMIC_RELEASE, "agent");
            asm volatile("s_waitcnt vmcnt(0)" ::: "memory");
            const unsigned og = xb_add(&bar[XB_TOP], 1u);
            const unsigned tg = og / nx;
            if (og + 1u == (tg + 1u) * nx) xb_add(&bar[XB_TOPGEN], 1u);
            else XB_SPIN(xb_ld(&bar[XB_TOPGEN]) == tg, bar);
            __builtin_amdgcn_fence(__ATOMIC_ACQUIRE, "agent");
            xb_add(&bar[XB_XGEN(b.x)], 1u);
            asm volatile("s_waitcnt vmcnt(0)" ::: "memory");
        } else {
            XB_SPIN(xb_ld(&bar[XB_XGEN(b.x)]) == gen, bar);
            __builtin_amdgcn_fence(__ATOMIC_ACQUIRE, "agent");
            asm volatile("s_waitcnt vmcnt(0)" ::: "memory");
        }
    }
    __syncthreads();
}

#endif

#ifndef __HIP_EMU__
#define GRID_SYNC() xcd_barrier(bar)
__global__ void __launch_bounds__(NTHR, 2) k_mega(P p_arg) {
    DYN_SMEM(smem);
#if defined(__HIP_DEVICE_COMPILE__)
#define PHASE(PH_, l_) do { const __attribute__((address_space(4))) P* kp_ = (const __attribute__((address_space(4))) P*)__builtin_amdgcn_kernarg_segment_ptr(); LAUNDER_PTR(kp_); P pl_; __builtin_memcpy(&pl_, kp_, sizeof(P)); run_phase<PH_>(pl_, l_, smem); } while (0)
#else
#define PHASE(PH_, l_) run_phase<PH_>(p_arg, l_, smem)
#endif
    cooperative_groups::grid_group grid = cooperative_groups::this_grid();
    volatile LAS unsigned* bst = (volatile LAS unsigned*)((LAS unsigned char*)smem + BAR_LDS_OFF);
    if (threadIdx.x < 4) bst[threadIdx.x] = 0u;
    __syncthreads();
    XcdBarrier bar = xcd_barrier_post((unsigned*)(p_arg.ws + WS_CTL + 4096), bst);
    PHASE(PH_PRO, 0); grid.sync();
#define LAYER(l) do { PHASE(PH_NORM1, l); GRID_SYNC(); PHASE(PH_GEMM_IN, l); GRID_SYNC(); PHASE(PH_ROPE, l); GRID_SYNC(); PHASE(PH_MIX1, l); GRID_SYNC(); PHASE(PH_MIX2, l); GRID_SYNC(); \
        PHASE(PH_MIX3, l); GRID_SYNC(); PHASE(PH_GEMM_OUT, l); GRID_SYNC(); PHASE(PH_NORM2, l); GRID_SYNC(); PHASE(PH_GEMM_GU, l); GRID_SYNC(); PHASE(PH_GEMM_DN, l); GRID_SYNC(); } while (0)
    static_assert(NL == 2, "two layers written out (a loop over the layers makes hipcc hoist every phase's constants to the loop preheader and spill)");
    LAYER(0); LAYER(1);
    PHASE(PH_FINAL, 0);
}
#endif

template <int PH> static void launch_phase(const P& p, int l, int grid, hipStream_t stream) {
#ifndef __HIP_EMU__
    static bool attr_done = false;
    if (!attr_done) { (void)hipFuncSetAttribute((const void*)k_phase<PH>, hipFuncAttributeMaxDynamicSharedMemorySize, SMEM_BYTES); attr_done = true; }
#endif
    LAUNCH(k_phase<PH>, grid, SMEM_BYTES, stream, p, l);
}

extern "C" void kernel_launch(void* const* d_in, const int* in_sizes, int n_in, void* d_out, int out_size, void* d_ws, size_t ws_size, hipStream_t stream) {
    if (n_in != 24 || (size_t)out_size != O_END || ws_size < WS_END) {
        fprintf(stderr, "kernel_launch: shape mismatch: n_in %d out_size %d (want %zu) ws %zu (want %zu)\n", n_in, out_size, (size_t)O_END, ws_size, (size_t)WS_END); return; }
    P p{};
    const float** pp = (const float**)&p;
    for (int i = 0; i < 24; ++i) pp[i] = (const float*)d_in[i];
    p.out = (float*)d_out; p.ws = (unsigned char*)d_ws;
#ifndef __HIP_EMU__
    static int grid = 0;
    if (grid == 0) {
        int dev = 0, cus = 0, per_cu = 0;
        if (hipGetDevice(&dev) != hipSuccess || hipDeviceGetAttribute(&cus, hipDeviceAttributeMultiprocessorCount, dev) != hipSuccess || cus <= 0) { fprintf(stderr, "kernel_launch: device query failed\n"); grid = -1; return; }
        if (hipFuncSetAttribute((const void*)k_mega, hipFuncAttributeMaxDynamicSharedMemorySize, SMEM_BYTES) != hipSuccess) { fprintf(stderr, "kernel_launch: hipFuncSetAttribute failed\n"); grid = -1; return; }
        if (hipOccupancyMaxActiveBlocksPerMultiprocessor(&per_cu, (const void*)k_mega, NTHR, SMEM_BYTES) != hipSuccess || per_cu < 1) { fprintf(stderr, "kernel_launch: occupancy query says %d blocks per CU\n", per_cu); grid = -1; return; }
        grid = cus;
    }
    if (grid < 0) return;
    if (hipMemsetAsync((char*)d_ws + WS_CTL, 0, 65536, stream) != hipSuccess) { fprintf(stderr, "kernel_launch: memset of the barrier words failed\n"); return; }
    { void* args[] = {(void*)&p};
      hipError_t e = hipLaunchCooperativeKernel((const void*)k_mega, dim3(grid), dim3(NTHR), args, SMEM_BYTES, stream);
      if (e != hipSuccess) fprintf(stderr, "kernel_launch: cooperative launch failed: %s (grid %d)\n", hipGetErrorString(e), grid);
      return; }
#else
    int grid = 16;
#endif
    launch_phase<PH_PRO>(p, 0, grid, stream);
    for (int l = 0; l < NL; ++l) {
        launch_phase<PH_NORM1>(p, l, grid, stream);
        launch_phase<PH_GEMM_IN>(p, l, grid, stream);
        launch_phase<PH_ROPE>(p, l, grid, stream);
        launch_phase<PH_MIX1>(p, l, grid, stream);
        launch_phase<PH_MIX2>(p, l, grid, stream);
        launch_phase<PH_MIX3>(p, l, grid, stream);
        launch_phase<PH_GEMM_OUT>(p, l, grid, stream);
        launch_phase<PH_NORM2>(p, l, grid, stream);
        launch_phase<PH_GEMM_GU>(p, l, grid, stream);
        launch_phase<PH_GEMM_DN>(p, l, grid, stream);
    }
    launch_phase<PH_FINAL>(p, 0, grid, stream);
}
```

```cpp
#ifndef __HIP_EMU__
#include <hip/hip_runtime.h>
#include <hip/hip_cooperative_groups.h>
#endif
#include <cstdio>
#include <cstdint>
#include <cmath>

#ifndef CFG_BATCH
#define CFG_BATCH 2
#endif
#ifndef CFG_SEQ
#define CFG_SEQ 8192
#endif
#ifndef CFG_DB
#define CFG_DB 32
#endif
constexpr float LOG2E = 1.4426950408889634f;
constexpr int D = 1024, NL = 2, PB = CFG_BATCH, T = CFG_SEQ, DB = CFG_DB, DS = 8, PAST = 16384, WB = 2048;
constexpr int MP = PB * T, MS = DB * DS, M = MP + MS, MPAD = (M + 255) / 256 * 256, NC = PB + DB;
constexpr int INC = 3848, NPROJ = 3840, FF = 2816, NCH = T / 64, PWIN = T < 2048 ? T : 2048, NPOS = T + DS;
constexpr int NUNIT = PB * 4 * NCH;
constexpr float EPS = 1e-6f;
static_assert(T % 512 == 0, "the attention job decomposition wants T % 512 == 0");
constexpr int C_QA = 0, C_KA = 256, C_VA = 512, C_QR = 768, C_KR = 1024, C_VR = 1280, C_GR = 1536, C_CONV = 1792, C_Z = 3328;
constexpr int SMEM_BYTES = 147456;
constexpr int NTHR = 512;
constexpr int BAR_LDS_OFF = SMEM_BYTES - 64;

typedef unsigned short bf16_t;
typedef short bf16x8 __attribute__((ext_vector_type(8)));
typedef float f32x4 __attribute__((ext_vector_type(4)));
typedef unsigned u32x4 __attribute__((ext_vector_type(4)));
typedef unsigned u32x2 __attribute__((ext_vector_type(2)));
typedef float f32x16 __attribute__((ext_vector_type(16)));

#ifdef __HIP_EMU__
#define LAUNCH(kern, grid, lds, stream, ...) emu_launch(grid, NTHR, [=]() { kern(__VA_ARGS__); })
#define DYN_SMEM(name) unsigned char* name = emu_dyn_smem()
#define WAVE_SYNC() emu_wave_bar()
#define MFMA32(a, b, c) emu_mfma32(a, b, c)
#define GLDS16(gp, lp) memcpy((unsigned char*)(lp) + (threadIdx.x & 63) * 16, (gp), 16)
#define RAW_BARRIER() __syncthreads()
#define GLDS4(gp, lp) ((void)0)
#define WAIT_VM(n)
#define WAIT_LGKM0()
#define LAS
#define UNIFORM(x) (x)
#define COMPILER_FENCE()
#define LAUNDER_V(x)
#define MFMA16(a, b, c) emu_mfma16(a, b, c)
#else
#define WAVE_SYNC() asm volatile("s_waitcnt lgkmcnt(0)" ::: "memory")
#define MFMA32(a, b, c) __builtin_amdgcn_mfma_f32_32x32x16_bf16(a, b, c, 0, 0, 0)
#define LAS __attribute__((address_space(3)))
#define GLDS16(gp, lp) __builtin_amdgcn_global_load_lds((const unsigned*)(gp), (LAS unsigned*)(lp), 16, 0, 0)
#define RAW_BARRIER() __builtin_amdgcn_s_barrier()
#define GLDS4(gp, lp) __builtin_amdgcn_global_load_lds((const unsigned*)(gp), (LAS unsigned*)(lp), 4, 0, 0)
#define WAIT_VM(n) asm volatile("s_waitcnt vmcnt(" #n ")" ::: "memory")
#define WAIT_LGKM0() asm volatile("s_waitcnt lgkmcnt(0)" ::: "memory")
#define UNIFORM(x) __builtin_amdgcn_readfirstlane(x)
#define COMPILER_FENCE() __builtin_amdgcn_sched_barrier(0)
#define LAUNDER_V(x) asm volatile("" : "+v"(x))
#define MFMA16(a, b, c) __builtin_amdgcn_mfma_f32_16x16x32_bf16(a, b, c, 0, 0, 0)
#define LAUNCH(kern, grid, lds, stream, ...) hipLaunchKernelGGL(kern, dim3(grid), dim3(NTHR), lds, stream, __VA_ARGS__)
#define DYN_SMEM(name) extern __shared__ __attribute__((aligned(16))) unsigned char name[]
#endif

#ifdef __HIP_EMU__
__device__ __forceinline__ int tidx() { return (int)threadIdx.x; }
#define LAUNDER_PTR(x)
#else
__device__ __forceinline__ int tidx() { int t = (int)threadIdx.x; asm volatile("" : "+v"(t)); return t; }
#define LAUNDER_PTR(x) asm volatile("" : "+s"(x))
#endif
__device__ __forceinline__ float bf2f(bf16_t v) { return __builtin_bit_cast(float, (unsigned)v << 16); }
__device__ __forceinline__ bf16_t f2bf(float f) { unsigned u = __builtin_bit_cast(unsigned, f); return (bf16_t)((u + 0x7fffu + ((u >> 16) & 1u)) >> 16); }
#ifdef __HIP_EMU__
__device__ __forceinline__ unsigned pk2(float lo, float hi) { return (unsigned)f2bf(lo) | ((unsigned)f2bf(hi) << 16); }
#else
typedef float f32x2_t __attribute__((ext_vector_type(2))); typedef __bf16 bf16x2_t __attribute__((ext_vector_type(2)));
__device__ __forceinline__ unsigned pk2(float lo, float hi) { f32x2_t v = {lo, hi}; bf16x2_t b = __builtin_convertvector(v, bf16x2_t); return __builtin_bit_cast(unsigned, b); }
#endif
__device__ __forceinline__ float silu_f(float x) { return x / (1.0f + expf(-x)); }
#ifdef __HIP_EMU__
__device__ __forceinline__ float silu_fast(float x) { return x / (1.0f + expf(-x)); }
#else
__device__ __forceinline__ float silu_fast(float x) { return x * __builtin_amdgcn_rcpf(1.0f + __builtin_amdgcn_exp2f(-LOG2E * x)); }
#endif
__device__ __forceinline__ float wave_sum(float v) {
#pragma unroll
    for (int o = 1; o < 64; o <<= 1) v += __shfl_xor(v, o);
    return v;
}
__device__ __forceinline__ float wave_max(float v) {
#pragma unroll
    for (int o = 1; o < 64; o <<= 1) v = fmaxf(v, __shfl_xor(v, o));
    return v;
}

struct P {
    const float *x_prompt, *x_sample, *cache_k, *cache_v, *state_ret, *state_gdn, *state_conv, *c_prompt, *c_sample, *ada_w, *ada_b, *norm_mix, *norm_ffn,
        *w_in, *ret_norm, *conv_w, *a_log, *dt_bias, *gdn_norm, *w_out, *w_gate, *w_up, *w_down, *final_norm;
    float* out; unsigned char* ws;
};

constexpr size_t O_YP = 0, O_YS = O_YP + (size_t)MP * D, O_PWK = O_YS + (size_t)MS * D, O_PWV = O_PWK + (size_t)NL * PB * PWIN * 256,
                 O_PRET = O_PWV + (size_t)NL * PB * PWIN * 256, O_PGDN = O_PRET + (size_t)NL * PB * 4 * 4096, O_PCONV = O_PGDN + (size_t)NL * PB * 4 * 16384,
                 O_SWK = O_PCONV + (size_t)NL * PB * 3 * 1536, O_SWV = O_SWK + (size_t)NL * DB * DS * 256, O_SRET = O_SWV + (size_t)NL * DB * DS * 256,
                 O_SGDN = O_SRET + (size_t)NL * DB * 4 * 4096, O_SCONV = O_SGDN + (size_t)NL * DB * 4 * 16384, O_END = O_SCONV + (size_t)NL * DB * 3 * 1536;

constexpr size_t al256(size_t x) { return (x + 255) / 256 * 256; }
constexpr size_t WS_CTL = 0, WS_CTL_BYTES = 1u << 20;
constexpr size_t WS_MOD = WS_CTL + WS_CTL_BYTES;
constexpr size_t WS_ROPE = al256(WS_MOD + (size_t)NL * NC * 6144 * 4);
constexpr size_t WS_WIN = al256(WS_ROPE + (size_t)4 * NPOS * 32 * 4);
constexpr size_t WS_WOUT = al256(WS_WIN + (size_t)NL * NPROJ * D * 2);
constexpr size_t WS_WGU = al256(WS_WOUT + (size_t)NL * D * D * 2);
constexpr size_t WS_WDN = al256(WS_WGU + (size_t)NL * 2 * FF * D * 2);
constexpr size_t WS_H = al256(WS_WDN + (size_t)NL * D * FF * 2);
constexpr size_t WS_PROJ = al256(WS_H + (size_t)MPAD * D * 2);
constexpr size_t WS_BETA = al256(WS_PROJ + (size_t)MPAD * NPROJ * 2);
constexpr size_t WS_G = al256(WS_BETA + (size_t)M * 4 * 4);
constexpr size_t WS_O = al256(WS_G + (size_t)M * 4 * 4);
constexpr size_t WS_RU = al256(WS_O + (size_t)MPAD * D * 2);
constexpr size_t WS_RS = al256(WS_RU + (size_t)NUNIT * 4096 * 4);
constexpr size_t WS_SCR = al256(WS_RS + (size_t)NUNIT * 4096 * 4);
constexpr size_t WS_GU = WS_SCR;
constexpr size_t WS_GWK = al256(WS_GU + (size_t)NUNIT * 8192 * 2);
constexpr size_t WS_GQ = al256(WS_GWK + (size_t)NUNIT * 16384 * 2);
constexpr size_t WS_GA = al256(WS_GQ + (size_t)NUNIT * 8192 * 2);
constexpr size_t WS_GD = al256(WS_GA + (size_t)NUNIT * 4096 * 2);
constexpr size_t WS_GV = al256(WS_GD + (size_t)NUNIT * 4);
constexpr size_t WS_GS = al256(WS_GV + (size_t)NUNIT * 8192 * 2);
constexpr size_t WS_GEND = al256(WS_GS + (size_t)NUNIT * 16384 * 2);
constexpr size_t WS_KH = WS_GEND;
constexpr size_t WS_VT1 = al256(WS_KH + (size_t)MP * 256 * 2);
constexpr size_t WS_VT4 = al256(WS_VT1 + (size_t)MP * 256 * 2);
constexpr size_t WS_VT16 = al256(WS_VT4 + (size_t)MP * 256 * 2);
constexpr size_t WS_AML = al256(WS_VT16 + (size_t)MP * 256 * 2);
constexpr size_t WS_AEND = al256(WS_AML + (size_t)MP * 4 * 3 * 2 * 4);
constexpr size_t WS_APO = WS_H;
static_assert((size_t)MP * 4 * 3 * 64 * 2 <= (size_t)MPAD * D * 2, "attention partials overlay H");
constexpr size_t WS_HID = WS_SCR;
constexpr size_t WS_HEND = al256(WS_HID + (size_t)MPAD * FF * 2);
constexpr size_t WS_END = WS_AEND > WS_HEND ? WS_AEND : WS_HEND;

#define WSP(T_, off) ((T_*)(p.ws + (off)))
__device__ __forceinline__ int row_cb(int r) { return r < MP ? r / T : PB + (r - MP) / DS; }
__device__ __forceinline__ int row_pi(int r) { return r < MP ? r % T : T + (r - MP) % DS; }
namespace pg8 {
#ifdef __HIP_EMU__
#define PG8_LAS
#else
#define PG8_LAS __attribute__((address_space(3)))
#endif
typedef unsigned short bf16_t;
typedef short bf16x8 __attribute__((ext_vector_type(8)));
typedef float f32x4 __attribute__((ext_vector_type(4)));
typedef unsigned u32x4 __attribute__((ext_vector_type(4)));
constexpr int BM = 256, BK = 64, HALF = 128, HTB = HALF * BK * 2  , STAGE_BYTES = 8 * HTB, NXCD = 8, WGM = 8;

__host__ __device__ __forceinline__ int lds_byte(int r, int c) { const int st = (r >> 4) * 2 + (c >> 5), rr = r & 15, cc = c & 31, ob = rr * 64 + cc * 2; return st * 1024 + (ob ^ (((ob >> 9) & 1) << 5)); }
__host__ __device__ __forceinline__ void stage_rc(int b, int& R, int& C) { const int st = b / 1024, sb = b % 1024, swz = sb ^ (((sb >> 9) & 1) << 5); R = (st >> 1) * 16 + swz / 64; C = (st & 1) * 32 + (swz % 64) / 2; }
__host__ __device__ __forceinline__ int perm32(int rho) { const int n = rho >> 4, i = rho & 15; return 8 * (i >> 2) + 4 * n + (i & 3); }

struct Unit { int pm, pn; };
struct Gemm { const bf16_t* A; const bf16_t* Bt; int M, N, K; };

struct StaticOrder {
    int nM, nN, nwg, G, c;
    __host__ __device__ void init(int M, int N, int G_, int c_) { nM = M / BM; nN = N / BM; nwg = nM * nN; G = G_; c = c_; }
    __host__ __device__ bool next(int i, Unit& u) const {
        const long L = (long)i * G + c; if (L >= nwg) return false;
        int wgid = (int)L; { const int q = nwg / NXCD, r = nwg % NXCD, xcd = wgid % NXCD, off = wgid / NXCD; wgid = (xcd < r ? xcd * (q + 1) : r * (q + 1) + (xcd - r) * q) + off; }
        const int nig = WGM * nN, gid = wgid / nig, fm = gid * WGM, gsz = (nM - fm) < WGM ? (nM - fm) : WGM;
        u.pm = fm + ((wgid % nig) % gsz); u.pn = (wgid % nig) / gsz; return true;
    }
    __device__ __forceinline__ void a_ready(const Unit&) const {}
    __device__ __forceinline__ void done(const Unit&) const {}
};


struct EpiStoreBf16 {
    static constexpr bool PERM = true, AFTER_DRAIN = false;
    bf16_t* O; int ldc;
    __device__ __forceinline__ void operator()(const f32x4 (&acc)[2][2][4][2], const Unit& u, int wr, int wc, int fr, int fq) const {
        const int row0 = u.pm * BM + wr * 64 + fr, col0 = u.pn * BM + wc * 32 + 8 * fq;
#pragma unroll
        for (int ai = 0; ai < 2; ++ai)
#pragma unroll
            for (int m = 0; m < 4; ++m) { bf16_t* rowp = O + (size_t)(row0 + ai * HALF + m * 16) * ldc + col0;
#pragma unroll
                for (int bj = 0; bj < 2; ++bj) { const f32x4 v0 = acc[ai][bj][m][0], v1 = acc[ai][bj][m][1];
                    u32x4 w; w.x = ::pk2(v0[0], v0[1]); w.y = ::pk2(v0[2], v0[3]); w.z = ::pk2(v1[0], v1[1]); w.w = ::pk2(v1[2], v1[3]);
                    *(u32x4*)(rowp + bj * HALF) = w; } }
    }
};
struct EpiResidual {
    static constexpr bool PERM = false, AFTER_DRAIN = false;
    float* X; const float* gate;
    __device__ __forceinline__ void operator()(const f32x4 (&acc)[2][2][4][2], const Unit& u, int wr, int wc, int fr, int fq) const {
        const int row0 = u.pm * BM + wr * 64 + fr, col0 = u.pn * BM + wc * 32 + 4 * fq;
#pragma unroll
        for (int ai = 0; ai < 2; ++ai)
#pragma unroll
            for (int m = 0; m < 4; ++m) { const int row = row0 + ai * HALF + m * 16;
                if (MPAD != M && row >= M) continue;
                const float* g = gate + (size_t)::row_cb(row) * 6144 + col0; float* xp = X + (size_t)row * D + col0;
#pragma unroll
                for (int bj = 0; bj < 2; ++bj)
#pragma unroll
                    for (int n = 0; n < 2; ++n) { const f32x4 gv = *(const f32x4*)(g + bj * HALF + n * 16); f32x4* xq = (f32x4*)(xp + bj * HALF + n * 16); *xq = *xq + gv * acc[ai][bj][m][n]; } }
    }
};
struct EpiSwiglu {
    static constexpr bool PERM = true, AFTER_DRAIN = false;
    bf16_t* Hd;
    __device__ __forceinline__ void operator()(const f32x4 (&acc)[2][2][4][2], const Unit& u, int wr, int wc, int fr, int fq) const {
        const int row0 = u.pm * BM + wr * 64 + fr, col0 = u.pn * HALF + wc * 32 + 8 * fq;
#pragma unroll
        for (int ai = 0; ai < 2; ++ai)
#pragma unroll
            for (int m = 0; m < 4; ++m) { bf16_t* rowp = Hd + (size_t)(row0 + ai * HALF + m * 16) * FF + col0;
                float v[8];
#pragma unroll
                for (int n = 0; n < 2; ++n)
#pragma unroll
                    for (int j = 0; j < 4; ++j) { const float gt = acc[ai][0][m][n][j], up = acc[ai][1][m][n][j]; v[4 * n + j] = ::silu_f(gt) * up; }
                u32x4 w; w.x = ::pk2(v[0], v[1]); w.y = ::pk2(v[2], v[3]); w.z = ::pk2(v[4], v[5]); w.w = ::pk2(v[6], v[7]);
                *(u32x4*)rowp = w; }
    }
};

#ifdef __HIP_EMU__
template <class Epi, class Sched, bool ALIGN_EPI = false, bool SP2 = false>
__device__ __forceinline__ void gemm_phase(unsigned char* lds, const Gemm g, const Sched& S, const Epi& E) {
    const int tid = threadIdx.x, wid = tid >> 6, lane = tid & 63, wr = wid >> 2, wc = wid & 3, fr = lane & 15, fq = lane >> 4;
    Unit cur;
    for (int ui = 0; S.next(ui, cur); ++ui) {
        f32x4 acc[2][2][4][2];
        for (int ai = 0; ai < 2; ++ai) for (int bj = 0; bj < 2; ++bj) for (int m = 0; m < 4; ++m) for (int n = 0; n < 2; ++n) for (int j = 0; j < 4; ++j) {
            const int row = 256 * cur.pm + 128 * ai + 64 * wr + 16 * m + fr;
            const int col = Epi::PERM ? 256 * cur.pn + 128 * bj + 32 * wc + 8 * fq + 4 * n + j : 256 * cur.pn + 128 * bj + 32 * wc + 16 * n + 4 * fq + j;
            const bf16_t* a = g.A + (size_t)row * g.K; const bf16_t* b = g.Bt + (size_t)col * g.K; float s = 0.f;
            for (int k = 0; k < g.K; ++k) s += ::bf2f(a[k]) * ::bf2f(b[k]);
            acc[ai][bj][m][n][j] = s; }
        E(acc, cur, wr, wc, fr, fq);
    }
}
#else
template <class Epi, class Sched, bool ALIGN_EPI = false, bool SP2 = false>
__device__ __forceinline__ void gemm_phase(PG8_LAS unsigned char* lds, const Gemm g, const Sched& S, const Epi& E) {
    const int tid = ::tidx(), wid = __builtin_amdgcn_readfirstlane(tid >> 6), lane = tid & 63, wr = wid >> 2, wc = wid & 3, fr = lane & 15, fq = lane >> 4;
    const int K = g.K, nt = K / BK;
    unsigned voffA[2], voffB[2];
#pragma unroll
    for (int i = 0; i < 2; ++i) { int R, C; stage_rc(tid * 16 + i * 8192, R, C); const int Rb = Epi::PERM ? ((R & ~31) + perm32(R & 31)) : R;
        voffA[i] = (unsigned)(R * K + C) * 2u; voffB[i] = (unsigned)(Rb * K + C) * 2u; }
    const size_t kstep = (size_t)(BK * 2);
    const size_t hstep = (size_t)HALF * K * 2;
    const size_t tstep = 2 * hstep;
    const unsigned ldsw = (unsigned)wid * 1024u;
    const int aoff = lds_byte(wr * 64 + fr, fq * 8), boff = lds_byte(wc * 32 + fr, fq * 8);
#define PG8_SA(b, h) (((b) * 2 + (h)) * HTB)
#define PG8_SB(b, h) ((4 + (b) * 2 + (h)) * HTB)
#define PG8_STAGE(bufoff, gbase, voff) do { _Pragma("unroll") for (int _i = 0; _i < 2; ++_i) \
        __builtin_amdgcn_global_load_lds((const unsigned*)((const char*)(gbase) + (voff)[_i]), (PG8_LAS unsigned*)(lds + (bufoff) + ldsw + _i * 8192), 16, 0, 0); } while (0)
#define PG8_LDA(dst, b, h) do { _Pragma("unroll") for (int m = 0; m < 4; ++m) _Pragma("unroll") for (int k = 0; k < 2; ++k) dst[m][k] = *(const PG8_LAS bf16x8*)(lds + PG8_SA(b, h) + aoff + m * 2048 + k * 1024); } while (0)
#define PG8_LDB(dst, b, h) do { _Pragma("unroll") for (int n = 0; n < 2; ++n) _Pragma("unroll") for (int k = 0; k < 2; ++k) dst[n][k] = *(const PG8_LAS bf16x8*)(lds + PG8_SB(b, h) + boff + n * 2048 + k * 1024); } while (0)
#define PG8_MMA(ai, bj, At, Bt) do { __builtin_amdgcn_s_setprio(1); _Pragma("unroll") for (int m = 0; m < 4; ++m) _Pragma("unroll") for (int n = 0; n < 2; ++n) _Pragma("unroll") for (int k = 0; k < 2; ++k) \
        acc[ai][bj][m][n] = __builtin_amdgcn_mfma_f32_16x16x32_bf16(Bt[n][k], At[m][k], acc[ai][bj][m][n], 0, 0, 0); __builtin_amdgcn_s_setprio(0); } while (0)
#define PG8_WAIT_V(n) asm volatile("s_waitcnt vmcnt(" #n ")" ::: "memory")
#define PG8_WAIT_L(n) asm volatile("s_waitcnt lgkmcnt(" #n ")" ::: "memory")
#define PG8_BAR __builtin_amdgcn_s_barrier()
#define PG8_SCHED __builtin_amdgcn_sched_barrier(0)
    Unit cur, nxt; int ui = 0;
    if (!S.next(0, cur)) return;
    f32x4 acc[2][2][4][2];
#pragma unroll
    for (int a = 0; a < 2; ++a)
#pragma unroll
        for (int b = 0; b < 2; ++b)
#pragma unroll
            for (int m = 0; m < 4; ++m)
#pragma unroll
                for (int n = 0; n < 2; ++n) acc[a][b][m][n] = (f32x4){0.f, 0.f, 0.f, 0.f};
    bf16x8 At[4][2], B0[2][2], B1[2][2];
    const char* cA = (const char*)g.A + (size_t)cur.pm * tstep; const char* cB = (const char*)g.Bt + (size_t)cur.pn * tstep;
    S.a_ready(cur);
    if constexpr (SP2) {
        PG8_STAGE(PG8_SB(0, 0), cB, voffB); PG8_STAGE(PG8_SB(0, 1), cB + hstep, voffB); PG8_STAGE(PG8_SA(0, 0), cA, voffA); PG8_STAGE(PG8_SA(0, 1), cA + hstep, voffA);
        if (wr == 1) PG8_BAR;
        PG8_WAIT_V(2); PG8_BAR;
        PG8_STAGE(PG8_SB(1, 0), cB + kstep, voffB); PG8_STAGE(PG8_SA(1, 0), cA + kstep, voffA); PG8_STAGE(PG8_SB(1, 1), cB + hstep + kstep, voffB);
        PG8_WAIT_V(6); PG8_BAR;
    } else {
        PG8_STAGE(PG8_SB(0, 0), cB, voffB); PG8_STAGE(PG8_SA(0, 0), cA, voffA); PG8_STAGE(PG8_SB(0, 1), cB + hstep, voffB); PG8_STAGE(PG8_SA(0, 1), cA + hstep, voffA);
        if (wr == 1) PG8_BAR;
        PG8_WAIT_V(4); PG8_BAR;
        PG8_STAGE(PG8_SB(1, 0), cB + kstep, voffB); PG8_STAGE(PG8_SA(1, 0), cA + kstep, voffA); PG8_STAGE(PG8_SB(1, 1), cB + hstep + kstep, voffB);
        PG8_WAIT_V(6); PG8_BAR;
    }
    for (;;) {
        const bool has_next = S.next(ui + 1, nxt);
        const char* nA = has_next ? (const char*)g.A + (size_t)nxt.pm * tstep : cA; const char* nB = has_next ? (const char*)g.Bt + (size_t)nxt.pn * tstep : cB;
        for (int t = 0; t < nt; t += 2) {
            const bool last = (t == nt - 2);
            const char* a1 = cA + (size_t)(t + 1) * kstep;
            const char* a2 = last ? nA : cA + (size_t)(t + 2) * kstep; const char* b2 = last ? nB : cB + (size_t)(t + 2) * kstep;
            const char* a3 = a2 + kstep; const char* b3 = b2 + kstep;
            if (last && has_next) S.a_ready(nxt);
            if constexpr (SP2) {
            PG8_LDB(B0, 0, 0); PG8_LDB(B1, 0, 1); PG8_SCHED; PG8_LDA(At, 0, 0); PG8_STAGE(PG8_SA(1, 1), a1 + hstep, voffA);
            PG8_WAIT_V(8); PG8_WAIT_L(0); PG8_BAR; PG8_MMA(0, 0, At, B0); PG8_MMA(0, 1, At, B1); PG8_BAR; PG8_SCHED;
            PG8_LDA(At, 0, 1); PG8_STAGE(PG8_SB(0, 0), b2, voffB); PG8_STAGE(PG8_SB(0, 1), b2 + hstep, voffB); PG8_STAGE(PG8_SA(0, 0), a2, voffA);
            PG8_WAIT_V(8); PG8_WAIT_L(0); PG8_BAR; PG8_MMA(1, 0, At, B0); PG8_MMA(1, 1, At, B1); PG8_BAR; PG8_SCHED;
            PG8_LDB(B0, 1, 0); PG8_LDB(B1, 1, 1); PG8_SCHED; PG8_LDA(At, 1, 0); PG8_STAGE(PG8_SA(0, 1), a2 + hstep, voffA);
            PG8_WAIT_V(8); PG8_WAIT_L(0); PG8_BAR; PG8_MMA(0, 0, At, B0); PG8_MMA(0, 1, At, B1); PG8_BAR; PG8_SCHED;
            PG8_LDA(At, 1, 1); PG8_STAGE(PG8_SB(1, 0), b3, voffB); PG8_STAGE(PG8_SB(1, 1), b3 + hstep, voffB); PG8_STAGE(PG8_SA(1, 0), a3, voffA);
            PG8_WAIT_V(8); PG8_WAIT_L(0); PG8_BAR; PG8_MMA(1, 0, At, B0); PG8_MMA(1, 1, At, B1); PG8_BAR; PG8_SCHED;
            } else {
            PG8_LDB(B0, 0, 0); PG8_SCHED; PG8_LDA(At, 0, 0); PG8_STAGE(PG8_SA(1, 1), a1 + hstep, voffA);
            PG8_WAIT_L(8); PG8_BAR; PG8_WAIT_L(0); PG8_MMA(0, 0, At, B0); PG8_BAR; PG8_SCHED;
            PG8_LDB(B1, 0, 1); PG8_STAGE(PG8_SB(0, 0), b2, voffB);
            PG8_BAR; PG8_WAIT_L(0); PG8_MMA(0, 1, At, B1); PG8_BAR;
            PG8_LDA(At, 0, 1); PG8_STAGE(PG8_SA(0, 0), a2, voffA);
            PG8_BAR; PG8_WAIT_L(0); PG8_MMA(1, 0, At, B0); PG8_BAR; PG8_SCHED;
            PG8_STAGE(PG8_SB(0, 1), b2 + hstep, voffB);
            PG8_WAIT_V(6); PG8_BAR; PG8_MMA(1, 1, At, B1); PG8_BAR;
            PG8_LDB(B0, 1, 0); PG8_SCHED; PG8_LDA(At, 1, 0); PG8_STAGE(PG8_SA(0, 1), a2 + hstep, voffA);
            PG8_WAIT_L(8); PG8_BAR; PG8_WAIT_L(0); PG8_MMA(0, 0, At, B0); PG8_BAR; PG8_SCHED;
            PG8_LDB(B1, 1, 1); PG8_STAGE(PG8_SB(1, 0), b3, voffB);
            PG8_BAR; PG8_WAIT_L(0); PG8_MMA(0, 1, At, B1); PG8_BAR;
            PG8_LDA(At, 1, 1); PG8_STAGE(PG8_SA(1, 0), a3, voffA);
            PG8_BAR; PG8_WAIT_L(0); PG8_MMA(1, 0, At, B0); PG8_BAR; PG8_SCHED;
            PG8_STAGE(PG8_SB(1, 1), b3 + hstep, voffB);
            PG8_WAIT_V(6); PG8_BAR; PG8_MMA(1, 1, At, B1); PG8_BAR;
            }
        }
        if constexpr (ALIGN_EPI) { if (wr == 0) PG8_BAR; }
        if constexpr (!Epi::AFTER_DRAIN) { E(acc, cur, wr, wc, fr, fq); S.done(cur); }
        if (!has_next) break;
#pragma unroll
        for (int a = 0; a < 2; ++a)
#pragma unroll
            for (int b = 0; b < 2; ++b)
#pragma unroll
                for (int m = 0; m < 4; ++m)
#pragma unroll
                    for (int n = 0; n < 2; ++n) acc[a][b][m][n] = (f32x4){0.f, 0.f, 0.f, 0.f};
        cur = nxt; cA = nA; cB = nB; ++ui;
        if constexpr (ALIGN_EPI) { if (wr == 1) PG8_BAR; }
    }
    PG8_WAIT_V(0);
    if constexpr (!ALIGN_EPI) { if (wr == 0) PG8_BAR; }
    PG8_BAR;
    if constexpr (Epi::AFTER_DRAIN) { E.fused(acc, cur, wr, wc, fr, fq, lds, wid, lane); S.done(cur); }
#undef PG8_SA
#undef PG8_SB
#undef PG8_STAGE
#undef PG8_LDA
#undef PG8_LDB
#undef PG8_MMA
#undef PG8_WAIT_V
#undef PG8_WAIT_L
#undef PG8_BAR
#undef PG8_SCHED
}
#endif
}


__device__ __forceinline__ void transpose_item(const float* W, int ldw, bf16_t* WT, int K, int k0, int n0, int drow0, float* scr, int lane) {
#pragma unroll 8
    for (int i = 0; i < 32; ++i) { const int kk = 2 * i + (lane >> 5); scr[kk * 33 + (lane & 31)] = W[(size_t)(k0 + kk) * ldw + n0 + (lane & 31)]; }
    WAVE_SYNC();
    const int c = lane & 7;
#pragma unroll
    for (int j = 0; j < 4; ++j) { const int n = (lane >> 3) + 8 * j; const float* s = scr + (8 * c) * 33 + n;
        u32x4 o; o.x = pk2(s[0 * 33], s[1 * 33]); o.y = pk2(s[2 * 33], s[3 * 33]); o.z = pk2(s[4 * 33], s[5 * 33]); o.w = pk2(s[6 * 33], s[7 * 33]);
        *(u32x4*)(WT + (size_t)(drow0 + n) * K + k0 + 8 * c) = o; }
    WAVE_SYNC();
}
__device__ __forceinline__ void ph_convert(const P& p, unsigned char* smem) {
    const int lane = tidx() & 63, wave = tidx() >> 6;
    float* scr = (float*)smem + wave * (64 * 33 + 32);
    constexpr int I_IN = 16 * 120, I_OUT = 16 * 32, I_G = 16 * 88, I_DN = 44 * 32, I_L = I_IN + I_OUT + 2 * I_G + I_DN;
    const int gw = blockIdx.x * 8 + wave, ngw = gridDim.x * 8;
    for (int it = gw; it < NL * I_L; it += ngw) {
        const int l = it / I_L; int r = it % I_L;
        if (r < I_IN) { const int kb = r / 120, nb = r % 120; transpose_item(p.w_in + (size_t)l * D * INC, INC, WSP(bf16_t, WS_WIN) + (size_t)l * NPROJ * D, D, kb * 64, nb * 32, nb * 32, scr, lane); continue; }
        r -= I_IN;
        if (r < I_OUT) { const int kb = r / 32, nb = r % 32; transpose_item(p.w_out + (size_t)l * D * D, D, WSP(bf16_t, WS_WOUT) + (size_t)l * D * D, D, kb * 64, nb * 32, nb * 32, scr, lane); continue; }
        r -= I_OUT;
        if (r < 2 * I_G) { const int up = r / I_G; r %= I_G; const int kb = r / 88, nb = r % 88, n0 = nb * 32;
            transpose_item((up ? p.w_up : p.w_gate) + (size_t)l * D * FF, FF, WSP(bf16_t, WS_WGU) + (size_t)l * 2 * FF * D, D, kb * 64, n0, (n0 / 128) * 256 + up * 128 + (n0 % 128), scr, lane); continue; }
        r -= 2 * I_G;
        { const int kb = r / 32, nb = r % 32; transpose_item(p.w_down + (size_t)l * FF * D, D, WSP(bf16_t, WS_WDN) + (size_t)l * D * FF, FF, kb * 64, nb * 32, nb * 32, scr, lane); }
    }
}

__device__ __forceinline__ void ph_adaln(const P& p, unsigned char* smem) {
    float* sc = (float*)smem;
    float* red = sc + NC * 256;
    const int tid = tidx(), col = tid & 31, kg = tid >> 5;
    float* MOD = WSP(float, WS_MOD);
    for (int it = blockIdx.x; it < NL * 192; it += gridDim.x) {
        const int l = it / 192, cb0 = (it % 192) * 32;
        float acc[NC];
#pragma unroll
        for (int r = 0; r < NC; ++r) acc[r] = 0.f;
        for (int kc = 0; kc < 4; ++kc) {
            __syncthreads();
            for (int e = tid; e < NC * 256; e += NTHR) { const int r = e >> 8, k = e & 255; const float c = r < PB ? p.c_prompt[r * D + kc * 256 + k] : p.c_sample[(r - PB) * D + kc * 256 + k]; sc[e] = silu_f(c); }
            __syncthreads();
            for (int kk = 0; kk < 16; ++kk) { const int k = kg * 16 + kk; const float w = p.ada_w[((size_t)l * D + kc * 256 + k) * 6144 + cb0 + col];
#pragma unroll
                for (int r = 0; r < NC; ++r) acc[r] += sc[r * 256 + k] * w; }
        }
#pragma unroll
        for (int r = 0; r < NC; ++r) red[(kg * NC + r) * 32 + col] = acc[r];
        __syncthreads();
        for (int e = tid; e < NC * 32; e += NTHR) { const int r = e >> 5, c = e & 31; float s = p.ada_b[l * 6144 + cb0 + c];
            for (int g = 0; g < 16; ++g) s += red[(g * NC + r) * 32 + c];
            MOD[((size_t)l * NC + r) * 6144 + cb0 + c] = s; }
        __syncthreads();
    }
}

__device__ __forceinline__ void ph_ropetab_copyx(const P& p) {
    const size_t gt = (size_t)blockIdx.x * NTHR + tidx(), ng = (size_t)gridDim.x * NTHR;
    float* tab = WSP(float, WS_ROPE);
    for (size_t e = gt; e < (size_t)NPOS * 32; e += ng) {
        const int pi = (int)(e >> 5), i = (int)(e & 31); const double pos = pi < T ? (double)pi : (double)(PAST + pi - T);
        const double ia = exp(-log(10000.0) * (double)i / 32.0), ir = exp(-log(10000.0) * (double)i / 31.0);
        tab[e] = (float)cos(pos * ia); tab[(size_t)NPOS * 32 + e] = (float)sin(pos * ia);
        tab[(size_t)2 * NPOS * 32 + e] = (float)cos(pos * ir); tab[(size_t)3 * NPOS * 32 + e] = (float)sin(pos * ir);
    }
    const f32x4* xp = (const f32x4*)p.x_prompt; const f32x4* xs = (const f32x4*)p.x_sample; f32x4* o = (f32x4*)p.out;
    for (size_t e = gt; e < (size_t)MP * D / 4; e += ng) o[e] = xp[e];
    for (size_t e = gt; e < (size_t)MS * D / 4; e += ng) o[(size_t)MP * D / 4 + e] = xs[e];
}

template <int WHICH> __device__ __forceinline__ void ph_norm_mod(const P& p, int l) {
    const int lane = tidx() & 63, wave = tidx() >> 6, gw = blockIdx.x * 8 + wave, ngw = gridDim.x * 8;
    const float* nw = (WHICH == 0 ? p.norm_mix : p.norm_ffn) + l * D;
    bf16_t* H = WSP(bf16_t, WS_H);
    for (int r = gw; r < M; r += ngw) {
        const float* xr = p.out + (size_t)r * D; const float* mod = WSP(float, WS_MOD) + ((size_t)l * NC + row_cb(r)) * 6144 + (WHICH == 0 ? 0 : 3072);
        f32x4 v[4]; float ss = 0.f;
#pragma unroll
        for (int j = 0; j < 4; ++j) { v[j] = *(const f32x4*)(xr + 4 * lane + 256 * j); ss += (v[j][0] * v[j][0] + v[j][1] * v[j][1]) + (v[j][2] * v[j][2] + v[j][3] * v[j][3]); }
        const float rstd = 1.0f / sqrtf(wave_sum(ss) * (1.0f / D) + EPS);
        float a8[8];
#pragma unroll
        for (int c = 0; c < 8; ++c) a8[c] = 0.f;
#pragma unroll
        for (int j = 0; j < 4; ++j) { const int k = 4 * lane + 256 * j;
            const f32x4 g = *(const f32x4*)(nw + k), sh = *(const f32x4*)(mod + k), sc = *(const f32x4*)(mod + 1024 + k);
            f32x4 h;
#pragma unroll
            for (int e = 0; e < 4; ++e) h[e] = v[j][e] * rstd * g[e] * (1.0f + sc[e]) + sh[e];
            u32x2 w; w.x = pk2(h[0], h[1]); w.y = pk2(h[2], h[3]); *(u32x2*)(H + (size_t)r * D + k) = w;
            if (WHICH == 0) {
#pragma unroll
                for (int e = 0; e < 4; ++e) { const float* wr = p.w_in + ((size_t)l * D + k + e) * INC + NPROJ; const f32x4 w0 = *(const f32x4*)wr, w1 = *(const f32x4*)(wr + 4);
#pragma unroll
                    for (int c = 0; c < 4; ++c) { a8[c] += h[e] * w0[c]; a8[4 + c] += h[e] * w1[c]; } }
            }
        }
        if (WHICH == 0) {
#pragma unroll
            for (int c = 0; c < 8; ++c) a8[c] = wave_sum(a8[c]);
            if (lane < 4) { float braw = lane == 0 ? a8[0] : lane == 1 ? a8[1] : lane == 2 ? a8[2] : a8[3]; WSP(float, WS_BETA)[(size_t)r * 4 + lane] = 1.0f / (1.0f + expf(-braw)); }
            else if (lane < 8) { const int hh = lane - 4; float araw = hh == 0 ? a8[4] : hh == 1 ? a8[5] : hh == 2 ? a8[6] : a8[7];
                const float xx = araw + p.dt_bias[l * 4 + hh]; const float sp = xx > 20.f ? xx : log1pf(expf(xx));
                WSP(float, WS_G)[(size_t)r * 4 + hh] = -expf(p.a_log[l * 4 + hh]) * sp; }
        }
    }
}

__device__ __forceinline__ void ph_rope_out(const P& p, int l) {
    const size_t gt = (size_t)blockIdx.x * NTHR + tidx(), ng = (size_t)gridDim.x * NTHR;
    bf16_t* PR = WSP(bf16_t, WS_PROJ); const float* tab = WSP(float, WS_ROPE);
    for (size_t e = gt; e < (size_t)M * 512; e += ng) {
        const int r = (int)(e >> 9), rem = (int)(e & 511), sec = rem >> 7, hh = (rem & 127) >> 5, d = rem & 31;
        const int off = sec == 0 ? C_QA : sec == 1 ? C_KA : sec == 2 ? C_QR : C_KR; const float scale = sec == 0 ? 0.125f * LOG2E : sec == 3 ? 0.125f : 1.0f;
        const float* ct = tab + (size_t)(sec >= 2 ? 2 : 0) * NPOS * 32 + (size_t)row_pi(r) * 32 + d; const float c = ct[0], s = ct[(size_t)NPOS * 32];
        bf16_t* x = PR + (size_t)r * NPROJ + off + hh * 64 + d; const float x1 = bf2f(x[0]), x2 = bf2f(x[32]);
        const float o1 = (x1 * c - x2 * s) * scale, o2 = (x1 * s + x2 * c) * scale;
        x[0] = f2bf(o1); x[32] = f2bf(o2);
        if (sec == 1) {
            if (r < MP) { const int b = r / T, t = r % T; bf16_t* kh = WSP(bf16_t, WS_KH) + ((size_t)(b * 4 + hh) * T + t) * 64 + d; kh[0] = f2bf(o1); kh[32] = f2bf(o2);
                if (t >= T - PWIN) { float* o = p.out + O_PWK + (((size_t)l * PB + b) * PWIN + (t - (T - PWIN))) * 256 + hh * 64 + d; o[0] = o1; o[32] = o2; } }
            else { const int b = (r - MP) / DS, i = (r - MP) % DS; float* o = p.out + O_SWK + (((size_t)l * DB + b) * DS + i) * 256 + hh * 64 + d; o[0] = o1; o[32] = o2; }
        }
    }
    for (size_t e = gt; e < (size_t)M * 256; e += ng) {
        const int r = (int)(e >> 8), c = (int)(e & 255); const float v = bf2f(PR[(size_t)r * NPROJ + C_VA + c]);
        if (r < MP) { const int b = r / T, t = r % T; if (t >= T - PWIN) p.out[O_PWV + (((size_t)l * PB + b) * PWIN + (t - (T - PWIN))) * 256 + c] = v; }
        else { const int b = (r - MP) / DS, i = (r - MP) % DS; p.out[O_SWV + (((size_t)l * DB + b) * DS + i) * 256 + c] = v; }
    }
    for (size_t e = gt; e < (size_t)(PB + DB) * 3 * 1536; e += ng) {
        const int c = (int)(e % 1536), j = (int)((e / 1536) % 3), bb = (int)(e / (3 * 1536));
        if (bb < PB) p.out[O_PCONV + (((size_t)l * PB + bb) * 3 + j) * 1536 + c] = bf2f(PR[(size_t)(bb * T + T - 3 + j) * NPROJ + C_CONV + c]);
        else { const int b = bb - PB; p.out[O_SCONV + (((size_t)l * DB + b) * 3 + j) * 1536 + c] = bf2f(PR[(size_t)(MP + b * DS + DS - 3 + j) * NPROJ + C_CONV + c]); }
    }
}

__device__ __forceinline__ void attn_wave_sample(const P& p, int l, int r, int h, int lane, float* sw  ) {
    const bf16_t* PR = WSP(bf16_t, WS_PROJ);
    const int b = (r - MP) / DS; const int tq = WB + (r - MP) % DS;
    float q[64];
    { const bf16_t* qp = PR + (size_t)r * NPROJ + C_QA + h * 64;
#pragma unroll
      for (int j = 0; j < 8; ++j) { const bf16x8 v = *(const bf16x8*)(qp + 8 * j);
#pragma unroll
          for (int e = 0; e < 8; ++e) q[8 * j + e] = bf2f((bf16_t)v[e]); } }
    float mx = -INFINITY;
#pragma unroll 1
    for (int i = 0; i < 7; ++i) {
        const int e = lane + 64 * i;
        if (e < 387) { const int pat = e / 129, j = e % 129, dil = pat == 0 ? 1 : pat == 1 ? 4 : 16; const int rr = tq - dil * j;
            float a = 0.f;
            if (rr < WB) { const float* kp = p.cache_k + ((((size_t)l * DB + b) * WB + rr) * 4 + h) * 64;
#pragma unroll
                for (int j4 = 0; j4 < 16; ++j4) { const f32x4 kv = *(const f32x4*)(kp + 4 * j4); a += q[4 * j4] * kv[0] + q[4 * j4 + 1] * kv[1] + q[4 * j4 + 2] * kv[2] + q[4 * j4 + 3] * kv[3]; } }
            else { const bf16_t* kp = PR + (size_t)(MP + b * DS + (rr - WB)) * NPROJ + C_KA + h * 64;
#pragma unroll
                for (int j8 = 0; j8 < 8; ++j8) { const bf16x8 kv = *(const bf16x8*)(kp + 8 * j8);
#pragma unroll
                    for (int e2 = 0; e2 < 8; ++e2) a += q[8 * j8 + e2] * bf2f((bf16_t)kv[e2]); } }
            sw[e] = a; mx = fmaxf(mx, a); }
    }
    mx = wave_max(mx);
    float lsum = 0.f;
#pragma unroll 1
    for (int i = 0; i < 7; ++i) { const int e = lane + 64 * i; if (e < 387) { const float pe = exp2f(sw[e] - mx); sw[e] = pe; lsum += pe; } }
    lsum = wave_sum(lsum);
    WAVE_SYNC();
    const int kg = lane >> 4, dq = lane & 15; f32x4 o4 = (f32x4){0.f, 0.f, 0.f, 0.f};
#pragma unroll 8
    for (int e = kg; e < 387; e += 4) {
        const float pe = sw[e];
        const int pat = e / 129, j = e % 129, dil = pat == 0 ? 1 : pat == 1 ? 4 : 16; const int rr = tq - dil * j;
        f32x4 v;
        if (rr < WB) v = *(const f32x4*)(p.cache_v + ((((size_t)l * DB + b) * WB + rr) * 4 + h) * 64 + 4 * dq);
        else { const u32x2 w = *(const u32x2*)(PR + (size_t)(MP + b * DS + (rr - WB)) * NPROJ + C_VA + h * 64 + 4 * dq);
            v = (f32x4){bf2f((bf16_t)(w.x & 0xffff)), bf2f((bf16_t)(w.x >> 16)), bf2f((bf16_t)(w.y & 0xffff)), bf2f((bf16_t)(w.y >> 16))}; }
        o4 += pe * v;
    }
#pragma unroll
    for (int e = 0; e < 4; ++e) { float x = o4[e]; x += __shfl_xor(x, 16); x += __shfl_xor(x, 32); o4[e] = x; }
    WAVE_SYNC();
    if (kg == 0) { const float inv = 1.0f / lsum; u32x2 w; w.x = pk2(o4[0] * inv, o4[1] * inv); w.y = pk2(o4[2] * inv, o4[3] * inv);
        *(u32x2*)(WSP(bf16_t, WS_O) + (size_t)r * D + h * 64 + 4 * dq) = w; }
}
__device__ __forceinline__ void ph_attn_sample(const P& p, int l, unsigned char* smem) {
    const int lane = tidx() & 63, wave = tidx() >> 6, gw = (gridDim.x - 1 - blockIdx.x) * 8 + wave, ngw = gridDim.x * 8;
    float* sw = (float*)smem + wave * 392;
    for (int it = gw; it < MS * 4; it += ngw) attn_wave_sample(p, l, MP + (it >> 2), it & 3, lane, sw);
}
__device__ __forceinline__ bf16x8 pack8(const f32x16& v, int s8) {
    u32x4 w; w.x = pk2(v[s8], v[s8 + 1]); w.y = pk2(v[s8 + 2], v[s8 + 3]); w.z = pk2(v[s8 + 4], v[s8 + 5]); w.w = pk2(v[s8 + 6], v[s8 + 7]); return __builtin_bit_cast(bf16x8, w);
}
__device__ __forceinline__ void attn_job(const P& p, int jb, int lane) {
    const int c = lane & 31, hi = lane >> 5;
    constexpr int NB = T / 512;
    const int unit = jb / 48, jj = jb % 48, pat = jj >> 4, sub = jj & 15;
    const int blk = unit % NB, h = (unit / NB) & 3, b = unit / (NB * 4), bh = b * 4 + h;
    int dil, r, qi0; const bf16_t* VT;
    if (pat == 0) { dil = 1; r = 0; qi0 = blk * 512 + sub * 32; VT = WSP(bf16_t, WS_VT1) + (size_t)bh * 64 * T; }
    else if (pat == 1) { dil = 4; r = sub >> 2; qi0 = blk * 128 + (sub & 3) * 32; VT = WSP(bf16_t, WS_VT4) + (size_t)(bh * 4 + r) * 64 * (T / 4); }
    else { dil = 16; r = sub; qi0 = blk * 32; VT = WSP(bf16_t, WS_VT16) + (size_t)(bh * 16 + r) * 64 * (T / 16); }
    const int SL = T / dil;
    const int tq = dil * (qi0 + c) + r;
    const bf16_t* qp = WSP(bf16_t, WS_PROJ) + (size_t)(b * T + tq) * NPROJ + C_QA + h * 64 + 8 * hi;
    bf16x8 qf[4];
#pragma unroll
    for (int ks = 0; ks < 4; ++ks) qf[ks] = *(const bf16x8*)(qp + 16 * ks);
    const bf16_t* KHb = WSP(bf16_t, WS_KH) + (size_t)bh * T * 64;
    f32x16 S[5];
#pragma unroll
    for (int i = 0; i < 5; ++i) {
        const int kt0 = qi0 - 128 + 32 * i;
        f32x16 acc;
#pragma unroll
        for (int e = 0; e < 16; ++e) acc[e] = 0.f;
        if (kt0 >= 0) { const bf16_t* kp = KHb + (size_t)(dil * (kt0 + c) + r) * 64 + 8 * hi;
#pragma unroll
            for (int ks = 0; ks < 4; ++ks) acc = MFMA32(*(const bf16x8*)(kp + 16 * ks), qf[ks], acc);
            if (i == 0) {
#pragma unroll
                for (int e = 0; e < 16; ++e) { const int krow = (e & 3) + 8 * (e >> 2) + 4 * hi; if (krow < c) acc[e] = -INFINITY; } }
            if (i == 4) {
#pragma unroll
                for (int e = 0; e < 16; ++e) { const int krow = (e & 3) + 8 * (e >> 2) + 4 * hi; if (krow > c) acc[e] = -INFINITY; } }
        } else {
#pragma unroll
            for (int e = 0; e < 16; ++e) acc[e] = -INFINITY; }
        S[i] = acc;
    }
    float mx = -INFINITY;
#pragma unroll
    for (int i = 0; i < 5; ++i)
#pragma unroll
        for (int e = 0; e < 16; ++e) mx = fmaxf(mx, S[i][e]);
    mx = fmaxf(mx, __shfl_xor(mx, 32));
    float lsum = 0.f;
#pragma unroll
    for (int i = 0; i < 5; ++i)
#pragma unroll
        for (int e = 0; e < 16; ++e) { const float pe = exp2f(S[i][e] - mx); S[i][e] = pe; lsum += pe; }
    lsum += __shfl_xor(lsum, 32);
    f32x16 O[2];
#pragma unroll
    for (int dt = 0; dt < 2; ++dt)
#pragma unroll
        for (int e = 0; e < 16; ++e) O[dt][e] = 0.f;
#pragma unroll
    for (int i = 0; i < 5; ++i) {
        const int kt0 = qi0 - 128 + 32 * i;
        if (kt0 >= 0) {
#pragma unroll
            for (int s2 = 0; s2 < 2; ++s2) { const bf16x8 pf = pack8(S[i], 8 * s2);
#pragma unroll
                for (int dt = 0; dt < 2; ++dt) { const bf16_t* vp = VT + (size_t)(dt * 32 + c) * SL + kt0 + 16 * s2 + 4 * hi;
                    const u32x2 lo = *(const u32x2*)vp, hh = *(const u32x2*)(vp + 8); u32x4 w; w.x = lo.x; w.y = lo.y; w.z = hh.x; w.w = hh.y;
                    O[dt] = MFMA32(__builtin_bit_cast(bf16x8, w), pf, O[dt]); } }
        }
    }
    const size_t idx = ((size_t)(b * T + tq) * 4 + h) * 3 + pat;
    bf16_t* po = WSP(bf16_t, WS_APO) + idx * 64;
#pragma unroll
    for (int dt = 0; dt < 2; ++dt)
#pragma unroll
        for (int g = 0; g < 4; ++g) { u32x2 w; w.x = pk2(O[dt][4 * g], O[dt][4 * g + 1]); w.y = pk2(O[dt][4 * g + 2], O[dt][4 * g + 3]); *(u32x2*)(po + 32 * dt + 8 * g + 4 * hi) = w; }
    if (hi == 0) { float* ml = WSP(float, WS_AML) + idx * 2; ml[0] = mx; ml[1] = lsum; }
}
__device__ __forceinline__ void ph_attn_jobs(const P& p) {
    const int lane = tidx() & 63, wave = tidx() >> 6, gw = blockIdx.x * 8 + wave, ngw = gridDim.x * 8;
    for (int jb = gw; jb < PB * 4 * (T / 512) * 48; jb += ngw) attn_job(p, jb, lane);
}
__device__ __forceinline__ void ph_attn_combine(const P& p) {
    const size_t gt = (size_t)blockIdx.x * NTHR + tidx(), ng = (size_t)gridDim.x * NTHR;
    for (size_t e = gt; e < (size_t)MP * 4 * 16; e += ng) {
        const size_t rh = e >> 4; const int dq = (int)(e & 15) * 4;
        const float* ml = WSP(float, WS_AML) + rh * 6; const float m0 = ml[0], m1 = ml[2], m2 = ml[4];
        const float mm = fmaxf(m0, fmaxf(m1, m2)); const float w0 = exp2f(m0 - mm), w1 = exp2f(m1 - mm), w2 = exp2f(m2 - mm);
        const float inv = 1.0f / (w0 * ml[1] + w1 * ml[3] + w2 * ml[5]);
        const bf16_t* po = WSP(bf16_t, WS_APO) + rh * 192 + dq;
        const u32x2 a = *(const u32x2*)po, bq = *(const u32x2*)(po + 64), cq = *(const u32x2*)(po + 128);
        float o[4];
        o[0] = w0 * bf2f((bf16_t)(a.x & 0xffff)) + w1 * bf2f((bf16_t)(bq.x & 0xffff)) + w2 * bf2f((bf16_t)(cq.x & 0xffff));
        o[1] = w0 * bf2f((bf16_t)(a.x >> 16)) + w1 * bf2f((bf16_t)(bq.x >> 16)) + w2 * bf2f((bf16_t)(cq.x >> 16));
        o[2] = w0 * bf2f((bf16_t)(a.y & 0xffff)) + w1 * bf2f((bf16_t)(bq.y & 0xffff)) + w2 * bf2f((bf16_t)(cq.y & 0xffff));
        o[3] = w0 * bf2f((bf16_t)(a.y >> 16)) + w1 * bf2f((bf16_t)(bq.y >> 16)) + w2 * bf2f((bf16_t)(cq.y >> 16));
        const size_t row = rh >> 2; const int h = (int)(rh & 3);
        u32x2 w; w.x = pk2(o[0] * inv, o[1] * inv); w.y = pk2(o[2] * inv, o[3] * inv);
        *(u32x2*)(WSP(bf16_t, WS_O) + row * D + h * 64 + dq) = w;
    }
}
__device__ __forceinline__ void ph_vtrans(const P& p, unsigned char* smem) {
    bf16_t* vt = (bf16_t*)smem;
    const int tid = tidx(); const bf16_t* PR = WSP(bf16_t, WS_PROJ);
    for (int u = blockIdx.x; u < PB * 4 * (T / 256); u += gridDim.x) {
        const int tile = u % (T / 256), bh = u / (T / 256), h = bh & 3, b = bh >> 2;
        __syncthreads();
#pragma unroll
        for (int k = 0; k < 4; ++k) { const int ch = tid + NTHR * k, t = ch >> 3, d8 = (ch & 7) * 8;
            *(u32x4*)(vt + t * 72 + d8) = *(const u32x4*)(PR + (size_t)(b * T + tile * 256 + t) * NPROJ + C_VA + h * 64 + d8); }
        __syncthreads();
#pragma unroll
        for (int k = 0; k < 4; ++k) { const int ch = tid + NTHR * k;
            { const int d = ch >> 5, t0 = (ch & 31) * 8; u32x4 w;
              w.x = (unsigned)vt[(t0 + 0) * 72 + d] | ((unsigned)vt[(t0 + 1) * 72 + d] << 16); w.y = (unsigned)vt[(t0 + 2) * 72 + d] | ((unsigned)vt[(t0 + 3) * 72 + d] << 16);
              w.z = (unsigned)vt[(t0 + 4) * 72 + d] | ((unsigned)vt[(t0 + 5) * 72 + d] << 16); w.w = (unsigned)vt[(t0 + 6) * 72 + d] | ((unsigned)vt[(t0 + 7) * 72 + d] << 16);
              *(u32x4*)(WSP(bf16_t, WS_VT1) + ((size_t)bh * 64 + d) * T + tile * 256 + t0) = w; }
            { const int r = ch >> 9, d = (ch >> 3) & 63, s0 = (ch & 7) * 8; u32x4 w;
#define VT4E(e_) ((unsigned)vt[(4 * (s0 + (e_)) + r) * 72 + d])
              w.x = VT4E(0) | (VT4E(1) << 16); w.y = VT4E(2) | (VT4E(3) << 16); w.z = VT4E(4) | (VT4E(5) << 16); w.w = VT4E(6) | (VT4E(7) << 16);
#undef VT4E
              *(u32x4*)(WSP(bf16_t, WS_VT4) + ((size_t)(bh * 4 + r) * 64 + d) * (T / 4) + tile * 64 + s0) = w; }
            { const int r = ch >> 7, d = (ch >> 1) & 63, s0 = (ch & 1) * 8; u32x4 w;
#define VT16E(e_) ((unsigned)vt[(16 * (s0 + (e_)) + r) * 72 + d])
              w.x = VT16E(0) | (VT16E(1) << 16); w.y = VT16E(2) | (VT16E(3) << 16); w.z = VT16E(4) | (VT16E(5) << 16); w.w = VT16E(6) | (VT16E(7) << 16);
#undef VT16E
              *(u32x4*)(WSP(bf16_t, WS_VT16) + ((size_t)(bh * 16 + r) * 64 + d) * (T / 16) + tile * 16 + s0) = w; }
        }
    }
}

__device__ __forceinline__ float ret_lg(int h) { return logf(1.0f - exp2f(-5.0f - (float)h)); }
__device__ __forceinline__ void ph_ret_local(const P& p, int l, unsigned char* smem) {
    float* ks = (float*)smem; float* vs = ks + 64 * 64; const int tid = tidx(); const bf16_t* PR = WSP(bf16_t, WS_PROJ);
    for (int u = blockIdx.x; u < NUNIT; u += gridDim.x) {
        const int n = u % NCH, h = (u / NCH) % 4, b = u / (NCH * 4); const float lg = ret_lg(h);
        __syncthreads();
        for (int e = tid; e < 4096; e += NTHR) { const int j = e >> 6, d = e & 63; const size_t row = (size_t)(b * T + n * 64 + j) * NPROJ;
            ks[e] = bf2f(PR[row + C_KR + h * 64 + d]) * expf(lg * (float)(63 - j)); vs[e] = bf2f(PR[row + C_VR + h * 64 + d]); }
        __syncthreads();
        const int d = tid >> 3, e0 = (tid & 7) * 8; float acc[8];
#pragma unroll
        for (int i = 0; i < 8; ++i) acc[i] = 0.f;
        for (int j = 0; j < 64; ++j) { const float kd = ks[j * 64 + d];
#pragma unroll
            for (int i = 0; i < 8; ++i) acc[i] += kd * vs[j * 64 + e0 + i]; }
        float* U = WSP(float, WS_RU) + (size_t)u * 4096 + d * 64 + e0;
#pragma unroll
        for (int i = 0; i < 8; ++i) U[i] = acc[i];
    }
}
__device__ __forceinline__ void ph_ret_scan(const P& p, int l) {
    const int gt = blockIdx.x * NTHR + tidx(), ng = gridDim.x * NTHR;
    for (int e = gt; e < PB * 4 * 4096; e += ng) {
        const int bh = e >> 12, de = e & 4095, h = bh & 3; const float cd = expf(ret_lg(h) * 64.0f);
        const float* U = WSP(float, WS_RU) + (size_t)bh * NCH * 4096 + de; float* SPv = WSP(float, WS_RS) + (size_t)bh * NCH * 4096 + de;
        float s = 0.f;
        for (int n0 = 0; n0 < NCH; n0 += 8) {
            float uv[8];
#pragma unroll
            for (int k = 0; k < 8; ++k) uv[k] = U[(size_t)(n0 + k) * 4096];
#pragma unroll
            for (int k = 0; k < 8; ++k) { SPv[(size_t)(n0 + k) * 4096] = s; s = s * cd + uv[k]; } }
        p.out[O_PRET + ((size_t)l * PB * 4 + bh) * 4096 + de] = s;
    }
}
__device__ __forceinline__ void ph_ret_out(const P& p, int l, unsigned char* smem) {
    float* qs = (float*)smem; float* ks = qs + 64 * 65; float* vs = ks + 64 * 65; float* ss = vs + 64 * 65; float* as = ss + 64 * 65;
    const int tid = tidx(); const bf16_t* PR = WSP(bf16_t, WS_PROJ);
    for (int u = blockIdx.x; u < NUNIT; u += gridDim.x) {
        const int n = u % NCH, h = (u / NCH) % 4, b = u / (NCH * 4); const float lg = ret_lg(h);
        __syncthreads();
        for (int e = tid; e < 4096; e += NTHR) { const int j = e >> 6, d = e & 63; const size_t row = (size_t)(b * T + n * 64 + j) * NPROJ;
            qs[j * 65 + d] = bf2f(PR[row + C_QR + h * 64 + d]); ks[j * 65 + d] = bf2f(PR[row + C_KR + h * 64 + d]); vs[j * 65 + d] = bf2f(PR[row + C_VR + h * 64 + d]);
            ss[j * 65 + d] = WSP(float, WS_RS)[(size_t)u * 4096 + e]; }
        __syncthreads();
        const int i = tid >> 3, c0 = (tid & 7) * 8;
#pragma unroll
        for (int jj = 0; jj < 8; ++jj) { const int j = c0 + jj; float a = 0.f;
            if (j <= i) { for (int d = 0; d < 64; ++d) a += qs[i * 65 + d] * ks[j * 65 + d]; a *= expf(lg * (float)(i - j)); }
            as[i * 65 + j] = a; }
        __syncthreads();
        float o[8]; float o2[8];
#pragma unroll
        for (int e = 0; e < 8; ++e) { o[e] = 0.f; o2[e] = 0.f; }
        for (int j = 0; j < 64; ++j) { const float a = as[i * 65 + j], qd = qs[i * 65 + j];
#pragma unroll
            for (int e = 0; e < 8; ++e) { o[e] += a * vs[j * 65 + c0 + e]; o2[e] += qd * ss[j * 65 + c0 + e]; } }
        const float qdec = expf(lg * (float)(i + 1)); float sq = 0.f;
#pragma unroll
        for (int e = 0; e < 8; ++e) { o[e] += o2[e] * qdec; sq += o[e] * o[e]; }
        sq += __shfl_xor(sq, 1); sq += __shfl_xor(sq, 2); sq += __shfl_xor(sq, 4);
        const float rstd = 1.0f / sqrtf(sq * (1.0f / 64.0f) + EPS);
        const size_t row = (size_t)(b * T + n * 64 + i);
#pragma unroll
        for (int e = 0; e < 8; ++e) { const float g = bf2f(PR[row * NPROJ + C_GR + h * 64 + c0 + e]);
            WSP(bf16_t, WS_O)[row * D + 256 + h * 64 + c0 + e] = f2bf(o[e] * rstd * p.ret_norm[l * 64 + c0 + e] * silu_f(g)); }
    }
}
__device__ __forceinline__ void ph_ret_sample(const P& p, int l, unsigned char* smem) {
    float* S0 = (float*)smem; float* qs = S0 + 4096; float* ks = qs + 8 * 64; float* vs = ks + 8 * 64;
    const int tid = tidx(); const bf16_t* PR = WSP(bf16_t, WS_PROJ);
    for (int u = gridDim.x - 1 - blockIdx.x; u < DB * 4; u += gridDim.x) {
        const int h = u & 3, b = u >> 2; const float lg = ret_lg(h);
        __syncthreads();
        for (int e = tid; e < 4096; e += NTHR) S0[e] = p.state_ret[(((size_t)l * DB + b) * 4 + h) * 4096 + e];
        { const int j = tid >> 6, d = tid & 63; const size_t row = (size_t)(MP + b * DS + j) * NPROJ;
          qs[tid] = bf2f(PR[row + C_QR + h * 64 + d]); ks[tid] = bf2f(PR[row + C_KR + h * 64 + d]); vs[tid] = bf2f(PR[row + C_VR + h * 64 + d]); }
        __syncthreads();
        { const int i = tid >> 6, e = tid & 63; float o = 0.f;
          for (int j = 0; j <= i; ++j) { float a = 0.f; for (int d = 0; d < 64; ++d) a += qs[i * 64 + d] * ks[j * 64 + d]; o += a * expf(lg * (float)(i - j)) * vs[j * 64 + e]; }
          float o2 = 0.f; for (int d = 0; d < 64; ++d) o2 += qs[i * 64 + d] * S0[d * 64 + e];
          o += o2 * expf(lg * (float)(i + 1));
          const float rstd = 1.0f / sqrtf(wave_sum(o * o) * (1.0f / 64.0f) + EPS);
          const size_t row = (size_t)(MP + b * DS + i); const float g = bf2f(PR[row * NPROJ + C_GR + h * 64 + e]);
          WSP(bf16_t, WS_O)[row * D + 256 + h * 64 + e] = f2bf(o * rstd * p.ret_norm[l * 64 + e] * silu_f(g)); }
        for (int x = tid; x < 4096; x += NTHR) { const int d = x >> 6, e = x & 63; float s = S0[x] * expf(lg * (float)DS);
            for (int j = 0; j < DS; ++j) s += ks[j * 64 + d] * expf(lg * (float)(DS - 1 - j)) * vs[j * 64 + e];
            p.out[O_SRET + (((size_t)l * DB + b) * 4 + h) * 4096 + x] = s; }
    }
}

template <int CS, int LDL> __device__ __forceinline__ void fwd_subst(float (&X)[CS], const float* Ls) {
#pragma unroll
    for (int i = 1; i < CS; ++i) {
        float a = X[i];
#pragma unroll
        for (int j4 = 0; j4 < (i + 3) / 4; ++j4) { const f32x4 lv = *(const f32x4*)(Ls + i * LDL + 4 * j4);
#pragma unroll
            for (int e = 0; e < 4; ++e) if (4 * j4 + e < i) a -= lv[e] * X[4 * j4 + e]; }
        X[i] = a;
    }
}
constexpr int QP = 132;
constexpr int WSTP = 136;
constexpr int RWP = 392, TP = 136;
__device__ __forceinline__ void ph_gdn_prep(const P& p, int l, unsigned char* smem) {
    float* Ls = (float*)smem; float* As = Ls + 64 * 68; float* gs = As + 64 * 68; float* gcs = gs + 64; float* bts = gcs + 64; float* part = bts + 64;
    bf16_t* raw = (bf16_t*)(part + 4 * 64); bf16_t* Khi = raw + 67 * RWP; bf16_t* Klo = Khi + 64 * TP; bf16_t* Qb = Klo + 64 * TP;
    static_assert((64 * 68 * 2 + 64 * 3 + 4 * 64) * 4 + (67 * RWP + 3 * 64 * TP) * 2 <= BAR_LDS_OFF, "gdn_prep LDS");
    const int tid = tidx(), lane = tid & 63, wave = tid >> 6; const bf16_t* PR = WSP(bf16_t, WS_PROJ);
    for (int u = blockIdx.x; u < NUNIT; u += gridDim.x) {
        const int n = u % NCH, h = (u / NCH) % 4, b = u / (NCH * 4), t0 = n * 64;
        __syncthreads();
        for (int e = tid; e < 67 * 48; e += NTHR) { const int row = e / 48, ch = e % 48, t = t0 - 3 + row; u32x4 v = (u32x4){0u, 0u, 0u, 0u};
            if (t >= 0) v = *(const u32x4*)(PR + (size_t)(b * T + t) * NPROJ + C_CONV + (ch >> 4) * 512 + h * 128 + (ch & 15) * 8);
            *(u32x4*)(raw + row * RWP + ch * 8) = v; }
        if (tid >= 384 && tid < 448) { const int i = tid - 384; const size_t row = (size_t)(b * T + t0 + i); gs[i] = WSP(float, WS_G)[row * 4 + h]; bts[i] = WSP(float, WS_BETA)[row * 4 + h]; }
        __syncthreads();
        float y[64]; const int sec = tid < 128 ? 2 : tid < 256 ? 1 : 0, c = tid & 127;
        if (tid < 384) { const int col = sec * 512 + h * 128 + c;
            const float w0 = p.conv_w[(l * 4 + 0) * 1536 + col], w1 = p.conv_w[(l * 4 + 1) * 1536 + col], w2 = p.conv_w[(l * 4 + 2) * 1536 + col], w3 = p.conv_w[(l * 4 + 3) * 1536 + col];
            const LAS bf16_t* rp = (const LAS bf16_t*)raw + sec * 128 + c; LAUNDER_V(rp); float x0 = bf2f(rp[0]), x1 = bf2f(rp[RWP]), x2 = bf2f(rp[2 * RWP]);
#pragma unroll
            for (int i = 0; i < 64; ++i) { const float x3 = bf2f(rp[(i + 3) * RWP]); y[i] = silu_fast(w0 * x0 + w1 * x1 + w2 * x2 + w3 * x3); x0 = x1; x1 = x2; x2 = x3; if ((i & 7) == 7) COMPILER_FENCE(); } }
        if (tid == 448) { float a = 0.f; for (int i = 0; i < 64; ++i) { a += gs[i]; gcs[i] = a; } }
        if (tid >= 128 && tid < 384) {
#pragma unroll
            for (int i = 0; i < 64; ++i) { const float s = wave_sum(y[i] * y[i]); if (lane == 0) part[(wave - 2) * 64 + i] = s; if ((i & 7) == 7) COMPILER_FENCE(); } }
        __syncthreads();
        if (tid >= 128 && tid < 256) { const float gl = gcs[63]; LAS bf16_t* kh = (LAS bf16_t*)Khi + c; LAS bf16_t* kl = (LAS bf16_t*)Klo + c; LAUNDER_V(kh); LAUNDER_V(kl);
#pragma unroll
            for (int i = 0; i < 64; ++i) { const float v = y[i] / sqrtf(part[i] + part[64 + i] + EPS); y[i] = v; const bf16_t hb = f2bf(v); kh[i * TP] = hb; kl[i * TP] = f2bf(v - bf2f(hb)); if ((i & 7) == 7) COMPILER_FENCE(); }
            bf16_t* dst = WSP(bf16_t, WS_GWK) + (size_t)u * 16384 + 8192; const int mt = c >> 4, x = c & 15;
#pragma unroll
            for (int ks2 = 0; ks2 < 2; ++ks2)
#pragma unroll
                for (int q = 0; q < 4; ++q) { const int i0 = 32 * ks2 + 4 * q; float v[8];
#pragma unroll
                    for (int e = 0; e < 8; ++e) { const int i = i0 + (e < 4 ? e : 12 + e); v[e] = y[i] * expf(gl - gcs[i]); }
                    u32x4 w; w.x = pk2(v[0], v[1]); w.y = pk2(v[2], v[3]); w.z = pk2(v[4], v[5]); w.w = pk2(v[6], v[7]);
                    *(u32x4*)(dst + ((size_t)((mt * 2 + ks2) * 64 + q * 16 + x)) * 8) = w; COMPILER_FENCE(); } }
        else if (tid >= 256 && tid < 384) { bf16_t* qg = WSP(bf16_t, WS_GQ) + (size_t)u * 8192 + c; LAS bf16_t* qb = (LAS bf16_t*)Qb + c; LAUNDER_V(qb);
#pragma unroll
            for (int i = 0; i < 64; ++i) { const float v = y[i] / sqrtf(part[128 + i] + part[192 + i] + EPS); qb[i * TP] = f2bf(v); qg[(i & 7) * 128] = f2bf(v * 0.08838834764831845f * expf(gcs[i])); if ((i & 7) == 7) { qg += 8 * 128; LAUNDER_V(qg); COMPILER_FENCE(); } } }
        __syncthreads();
#pragma unroll
        for (int tp = 0; tp < 2; ++tp) { const int pos = wave * 2 + tp, it = pos >> 2, jt = pos & 3, j16 = lane & 15, qd = lane >> 4;
            f32x4 lk = (f32x4){0.f, 0.f, 0.f, 0.f}, aq = (f32x4){0.f, 0.f, 0.f, 0.f};
            if (jt <= it) {
#pragma unroll
                for (int ks = 0; ks < 4; ++ks) { const int ao = (16 * it + j16) * TP + 32 * ks + 8 * qd, bo = (16 * jt + j16) * TP + 32 * ks + 8 * qd;
                    const bf16x8 ah = *(const bf16x8*)(Khi + ao), al = *(const bf16x8*)(Klo + ao), aqf = *(const bf16x8*)(Qb + ao), bh = *(const bf16x8*)(Khi + bo), bl = *(const bf16x8*)(Klo + bo);
                    lk = MFMA16(ah, bh, lk); lk = MFMA16(ah, bl, lk); lk = MFMA16(al, bh, lk); aq = MFMA16(aqf, bh, aq); } }
            const int j = 16 * jt + j16;
#pragma unroll
            for (int e = 0; e < 4; ++e) { const int i = 16 * it + 4 * qd + e; const float ex = j <= i ? expf(gcs[i] - gcs[j]) : 0.f;
                Ls[i * 68 + j] = j < i ? bts[i] * lk[e] * ex : 0.f; As[i * 68 + j] = aq[e] * ex * 0.08838834764831845f; } }
        __syncthreads();
        if (tid < 256) {
            if (tid < 128) {
#pragma unroll
                for (int i = 0; i < 64; ++i) { y[i] *= bts[i]; if ((i & 15) == 15) COMPILER_FENCE(); } }
            else {
#pragma unroll
                for (int i = 0; i < 64; ++i) { y[i] *= bts[i] * expf(gcs[i]); if ((i & 7) == 7) COMPILER_FENCE(); } }
            fwd_subst<64, 68>(y, Ls);
            if (tid < 128) { bf16_t* U = WSP(bf16_t, WS_GU) + (size_t)u * 8192 + c * 64;
#pragma unroll
                for (int i8 = 0; i8 < 8; ++i8) { u32x4 w; w.x = pk2(y[8 * i8], y[8 * i8 + 1]); w.y = pk2(y[8 * i8 + 2], y[8 * i8 + 3]); w.z = pk2(y[8 * i8 + 4], y[8 * i8 + 5]); w.w = pk2(y[8 * i8 + 6], y[8 * i8 + 7]); *(u32x4*)(U + 8 * i8) = w; } }
            else { LAS bf16_t* wst = (LAS bf16_t*)raw + c; LAUNDER_V(wst);
#pragma unroll
                for (int i = 0; i < 64; ++i) wst[i * WSTP] = f2bf(-y[i]); }
        } else { const int t2 = tid - 256;
#pragma unroll 2
            for (int e = t2; e < 4096; e += 256) WSP(bf16_t, WS_GA)[(size_t)u * 4096 + e] = f2bf(As[(e >> 6) * 68 + (e & 63)]);
            if (t2 == 0) WSP(float, WS_GD)[u] = expf(gcs[63]); }
        __syncthreads();
        { bf16_t* dst = WSP(bf16_t, WS_GWK) + (size_t)u * 16384; const bf16_t* wst = raw;
#pragma unroll
          for (int k = 0; k < 2; ++k) { const int f = tid + NTHR * k, ln = f & 63, ks4 = (f >> 6) & 3, mt = f >> 8, q = ln >> 4, x = ln & 15;
              const bf16_t* wr = wst + (16 * mt + x) * WSTP + 32 * ks4 + 4 * q;
              u32x4 w; w.x = (unsigned)wr[0] | ((unsigned)wr[1] << 16); w.y = (unsigned)wr[2] | ((unsigned)wr[3] << 16); w.z = (unsigned)wr[16] | ((unsigned)wr[17] << 16); w.w = (unsigned)wr[18] | ((unsigned)wr[19] << 16);
              *(u32x4*)(dst + (size_t)f * 8) = w; } }
    }
}
__device__ __forceinline__ bf16x8 pack_tiles(const f32x4& lo, const f32x4& hi) {
    u32x4 w; w.x = pk2(lo[0], lo[1]); w.y = pk2(lo[2], lo[3]); w.z = pk2(hi[0], hi[1]); w.w = pk2(hi[2], hi[3]); return __builtin_bit_cast(bf16x8, w);
}
constexpr int CH_SLOT = 40960, CH_NSLOT = 3;
constexpr int CH_ITEMS = PB * 4 * 2;
static_assert(NCH % 4 == 0, "the chain's loop is unrolled by four chunks");
__device__ __forceinline__ void chain_stage(const bf16_t* WK, const bf16_t* UTh, int m, int pw, int lane, unsigned char* smem) {
    unsigned char* slot = smem + (m % CH_NSLOT) * CH_SLOT;
#pragma unroll
    for (int k = 0; k < 8; ++k) GLDS16((const unsigned char*)(WK + (size_t)m * 16384) + (pw * 8 + k) * 1024 + lane * 16, slot + (pw * 8 + k) * 1024);
#pragma unroll
    for (int k = 0; k < 2; ++k) GLDS16((const unsigned char*)(UTh + (size_t)m * 8192) + (pw * 2 + k) * 1024 + lane * 16, slot + 32768 + (pw * 2 + k) * 1024);
}
__device__ __forceinline__ void ph_gdn_chain(const P& p, int l, unsigned char* smem) {
    const int tid = tidx(), lane = tid & 63, wave = UNIFORM(tid >> 6), j = lane & 15, q = lane >> 4;
    for (int it = blockIdx.x; it < CH_ITEMS; it += gridDim.x) {
        const int half = it & 1, bh = it >> 1;
        const bf16_t* WK = WSP(bf16_t, WS_GWK) + (size_t)bh * NCH * 16384;
        const bf16_t* UTh = WSP(bf16_t, WS_GU) + (size_t)bh * NCH * 8192 + half * 4096;
        __syncthreads();
        if (wave >= 4) {
            const int pw = wave - 4;
            chain_stage(WK, UTh, 0, pw, lane, smem); chain_stage(WK, UTh, 1, pw, lane, smem);
#pragma unroll 1
            for (int n = 0; n < NCH; ++n) {
                if (n + 1 < NCH) WAIT_VM(10); else WAIT_VM(0);
                RAW_BARRIER();
                if (n + 2 < NCH) chain_stage(WK, UTh, n + 2, pw, lane, smem);
            }
        } else {
            const int sl = half * 4 + wave, c = 16 * sl + j;
            f32x4 S[8];
#pragma unroll
            for (int t = 0; t < 8; ++t) S[t] = (f32x4){0.f, 0.f, 0.f, 0.f};
            bf16x8 sB[4];
#pragma unroll
            for (int ks = 0; ks < 4; ++ks) sB[ks] = pack_tiles(S[2 * ks], S[2 * ks + 1]);
            const float* DC = WSP(float, WS_GD) + bh * NCH;
            float db[4];
#pragma unroll
            for (int d = 0; d < 4; ++d) db[d] = DC[d];
#pragma unroll 1
            for (int n0 = 0; n0 < NCH; n0 += 4) {
#pragma unroll
                for (int k4 = 0; k4 < 4; ++k4) {
                    const int n = n0 + k4, u = bh * NCH + n;
                    f32x4 acc[4]; const float dec = db[k4];
                    if (n + 4 < NCH) db[k4] = DC[n + 4];
                    { bf16_t* sp = WSP(bf16_t, WS_GS) + (size_t)u * 16384 + (size_t)sl * 2048 + lane * 4;
#pragma unroll
                      for (int t = 0; t < 8; ++t) { u32x2 w; w.x = pk2(S[t][0], S[t][1]); w.y = pk2(S[t][2], S[t][3]); *(u32x2*)(sp + 256 * t) = w; } }
                    WAIT_LGKM0();
                    RAW_BARRIER();
                    const LAS unsigned char* slot = (const LAS unsigned char*)smem + (n % CH_NSLOT) * CH_SLOT + lane * 16; LAUNDER_V(slot);
                    { const LAS unsigned char* us = (const LAS unsigned char*)smem + (n % CH_NSLOT) * CH_SLOT + 32768 + ((16 * wave + j) * 64 + 4 * q) * 2; LAUNDER_V(us);
#pragma unroll
                      for (int mt = 0; mt < 4; ++mt) { const u32x2 w = *(const LAS u32x2*)(us + 32 * mt); acc[mt] = (f32x4){bf2f((bf16_t)(w.x & 0xffff)), bf2f((bf16_t)(w.x >> 16)), bf2f((bf16_t)(w.y & 0xffff)), bf2f((bf16_t)(w.y >> 16))}; } }
                    bf16x8 fa[8], fb[8];
#pragma unroll
                    for (int i = 0; i < 8; ++i) fa[i] = *(const LAS bf16x8*)(slot + i * 1024);
#pragma unroll
                    for (int i = 0; i < 8; ++i) fb[i] = *(const LAS bf16x8*)(slot + (8 + i) * 1024);
                    COMPILER_FENCE();
#pragma unroll
                    for (int ks = 0; ks < 4; ++ks) { acc[0] = MFMA16(fa[ks], sB[ks], acc[0]); acc[1] = MFMA16(fa[4 + ks], sB[ks], acc[1]); }
                    COMPILER_FENCE();
#pragma unroll
                    for (int i = 0; i < 8; ++i) fa[i] = *(const LAS bf16x8*)(slot + 16384 + i * 1024);
#pragma unroll
                    for (int ks = 0; ks < 4; ++ks) { acc[2] = MFMA16(fb[ks], sB[ks], acc[2]); acc[3] = MFMA16(fb[4 + ks], sB[ks], acc[3]); }
                    COMPILER_FENCE();
#pragma unroll
                    for (int i = 0; i < 8; ++i) fb[i] = *(const LAS bf16x8*)(slot + 16384 + (8 + i) * 1024);
                    { bf16_t* vp = WSP(bf16_t, WS_GV) + (size_t)u * 8192 + (size_t)sl * 1024 + lane * 4;
#pragma unroll
                      for (int mt = 0; mt < 4; ++mt) { u32x2 w; w.x = pk2(acc[mt][0], acc[mt][1]); w.y = pk2(acc[mt][2], acc[mt][3]); *(u32x2*)(vp + 256 * mt) = w; } }
                    const bf16x8 vB0 = pack_tiles(acc[0], acc[1]), vB1 = pack_tiles(acc[2], acc[3]);
#pragma unroll
                    for (int t = 0; t < 8; ++t) S[t] = S[t] * dec;
                    COMPILER_FENCE();
#pragma unroll
                    for (int t = 0; t < 4; ++t) S[t] = MFMA16(fa[2 * t], vB0, S[t]);
#pragma unroll
                    for (int t = 0; t < 4; ++t) S[t] = MFMA16(fa[2 * t + 1], vB1, S[t]);
#pragma unroll
                    for (int t = 0; t < 4; ++t) S[4 + t] = MFMA16(fb[2 * t], vB0, S[4 + t]);
#pragma unroll
                    for (int t = 0; t < 4; ++t) S[4 + t] = MFMA16(fb[2 * t + 1], vB1, S[4 + t]);
                    COMPILER_FENCE();
#pragma unroll
                    for (int ks = 0; ks < 4; ++ks) sB[ks] = pack_tiles(S[2 * ks], S[2 * ks + 1]);
                }
            }
            float* o = p.out + O_PGDN + ((size_t)l * PB * 4 + bh) * 16384 + c;
#pragma unroll
            for (int t = 0; t < 8; ++t)
#pragma unroll
                for (int e = 0; e < 4; ++e) o[(size_t)(16 * t + 4 * q + e) * 128] = S[t][e];
        }
    }
}
__device__ __forceinline__ void ph_gdn_out(const P& p, int l) {
    const int tid = tidx(), lane = tid & 63, wave = tid >> 6, j = lane & 15, q = lane >> 4, mt = wave & 3;
    const bf16_t* PR = WSP(bf16_t, WS_PROJ);
    for (int u = blockIdx.x * 2 + (wave >> 2); u < NUNIT; u += gridDim.x * 2) {
        const int n = u % NCH, h = (u / NCH) % 4, b = u / (NCH * 4);
        f32x4 acc[8];
#pragma unroll
        for (int ct = 0; ct < 8; ++ct) acc[ct] = (f32x4){0.f, 0.f, 0.f, 0.f};
        const bf16_t* qg = WSP(bf16_t, WS_GQ) + (size_t)u * 8192 + (16 * mt + j) * 128 + 8 * q;
        const bf16_t* st = WSP(bf16_t, WS_GS) + (size_t)u * 16384 + (size_t)(q >> 1) * 256 + ((2 * (q & 1)) * 16 + j) * 4;
#pragma unroll
        for (int ks = 0; ks < 4; ++ks) { const bf16x8 a = *(const bf16x8*)(qg + 32 * ks);
#pragma unroll
            for (int ct = 0; ct < 8; ++ct) { const bf16_t* sp = st + (size_t)ct * 2048 + ks * 512; const u32x2 lo = *(const u32x2*)sp, hi = *(const u32x2*)(sp + 64); u32x4 w; w.x = lo.x; w.y = lo.y; w.z = hi.x; w.w = hi.y;
                acc[ct] = MFMA16(a, __builtin_bit_cast(bf16x8, w), acc[ct]); }
            COMPILER_FENCE(); }
        const bf16_t* at = WSP(bf16_t, WS_GA) + (size_t)u * 4096 + (16 * mt + j) * 64 + 8 * q;
        const bf16_t* vt = WSP(bf16_t, WS_GV) + (size_t)u * 8192 + (size_t)(q >> 1) * 256 + ((2 * (q & 1)) * 16 + j) * 4;
#pragma unroll
        for (int ks = 0; ks < 2; ++ks) { const bf16x8 a = *(const bf16x8*)(at + 32 * ks);
#pragma unroll
            for (int ct = 0; ct < 8; ++ct) { const bf16_t* vp = vt + (size_t)ct * 1024 + ks * 512; const u32x2 lo = *(const u32x2*)vp, hi = *(const u32x2*)(vp + 64); u32x4 w; w.x = lo.x; w.y = lo.y; w.z = hi.x; w.w = hi.y;
                acc[ct] = MFMA16(a, __builtin_bit_cast(bf16x8, w), acc[ct]); }
            COMPILER_FENCE(); }
        float sq[4];
#pragma unroll
        for (int e = 0; e < 4; ++e) { float s = 0.f;
#pragma unroll
            for (int ct = 0; ct < 8; ++ct) s += acc[ct][e] * acc[ct][e];
            s += __shfl_xor(s, 1); s += __shfl_xor(s, 2); s += __shfl_xor(s, 4); s += __shfl_xor(s, 8); sq[e] = 1.0f / sqrtf(s * (1.0f / 128.0f) + EPS); }
#pragma unroll
        for (int e = 0; e < 4; ++e) { const size_t row = (size_t)(b * T + n * 64 + 16 * mt + 4 * q + e);
#pragma unroll
            for (int ct = 0; ct < 8; ++ct) { const int c = 16 * ct + j; const float z = bf2f(PR[row * NPROJ + C_Z + h * 128 + c]);
                WSP(bf16_t, WS_O)[row * D + 512 + h * 128 + c] = f2bf(acc[ct][e] * sq[e] * p.gdn_norm[l * 128 + c] * silu_f(z)); } }
    }
}
__device__ __forceinline__ void ph_gdn_sample(const P& p, int l, unsigned char* smem) {
    float* qs = (float*)smem; float* ks = qs + 8 * QP; float* vs = ks + 8 * QP; float* us = vs + 8 * QP; float* wsm = us + 8 * 128; float* vn = wsm + 8 * 128;
    float* Ls = vn + 8 * 128; float* As = Ls + 8 * 8; float* gs = As + 8 * 8; float* gcs = gs + 8; float* bts = gcs + 8; float* S0 = bts + 8;
    const int tid = tidx(); const bf16_t* PR = WSP(bf16_t, WS_PROJ);
    for (int u = gridDim.x - 1 - blockIdx.x; u < DB * 4; u += gridDim.x) {
        const int h = u & 3, b = u >> 2;
        __syncthreads();
#pragma unroll 4
        for (int e = tid; e < 16384; e += NTHR) S0[e] = p.state_gdn[(((size_t)l * DB + b) * 4 + h) * 16384 + e];
        if (tid < 384) { const int sec = tid >> 7, c = tid & 127, col = sec * 512 + h * 128 + c; float* dst = sec == 0 ? qs : sec == 1 ? ks : vs;
            const float w0 = p.conv_w[(l * 4 + 0) * 1536 + col], w1 = p.conv_w[(l * 4 + 1) * 1536 + col], w2 = p.conv_w[(l * 4 + 2) * 1536 + col], w3 = p.conv_w[(l * 4 + 3) * 1536 + col];
            const float* hist = p.state_conv + (((size_t)l * DB + b) * 3) * 1536 + col; const bf16_t* src = PR + (size_t)(MP + b * DS) * NPROJ + C_CONV + col;
            float x0 = hist[0], x1 = hist[1536], x2 = hist[2 * 1536];
            for (int i = 0; i < DS; ++i) { const float x3 = bf2f(src[(size_t)i * NPROJ]); const float y = w0 * x0 + w1 * x1 + w2 * x2 + w3 * x3; dst[i * QP + c] = silu_f(y); x0 = x1; x1 = x2; x2 = x3; } }
        else if (tid < 384 + DS) { const int i = tid - 384; const size_t row = (size_t)(MP + b * DS + i); gs[i] = WSP(float, WS_G)[row * 4 + h]; bts[i] = WSP(float, WS_BETA)[row * 4 + h]; }
        __syncthreads();
        if (tid < 64) { const int rid = tid >> 2, part = tid & 3; float* rowp = (rid < 8 ? qs + rid * QP : ks + (rid - 8) * QP) + part * 32; float s = 0.f;
            for (int d = 0; d < 32; ++d) s += rowp[d] * rowp[d];
            s += __shfl_xor(s, 1); s += __shfl_xor(s, 2); const float sc = 1.0f / sqrtf(s + EPS);
            for (int d = 0; d < 32; ++d) rowp[d] *= sc; }
        if (tid == 64) { float a = 0.f; for (int i = 0; i < DS; ++i) { a += gs[i]; gcs[i] = a; } }
        __syncthreads();
        if (tid < 64) { const int i = tid >> 3, j = tid & 7; float lv = 0.f, av = 0.f;
            if (j <= i) { float dk = 0.f, dq = 0.f; for (int d = 0; d < 128; ++d) { const float kj = ks[j * QP + d]; dk += ks[i * QP + d] * kj; dq += qs[i * QP + d] * kj; }
                const float e = expf(gcs[i] - gcs[j]); av = dq * e * 0.08838834764831845f; lv = j < i ? bts[i] * dk * e : 0.f; }
            Ls[i * 8 + j] = lv; As[i * 8 + j] = av; }
        __syncthreads();
        if (tid < 256) { const int c = tid; float X[8];
            if (c < 128) {
#pragma unroll
                for (int i = 0; i < 8; ++i) X[i] = vs[i * QP + c] * bts[i]; }
            else {
#pragma unroll
                for (int i = 0; i < 8; ++i) X[i] = ks[i * QP + c - 128] * bts[i] * expf(gcs[i]); }
            fwd_subst<8, 8>(X, Ls);
            float* dst = c < 128 ? us + c : wsm + c - 128;
#pragma unroll
            for (int i = 0; i < 8; ++i) dst[i * 128] = X[i]; }
        __syncthreads();
        const int i = tid >> 6, c2 = (tid & 63) * 2;
        { float a0 = us[i * 128 + c2], a1 = us[i * 128 + c2 + 1];
          for (int d = 0; d < 128; ++d) { const float w = wsm[i * 128 + d]; a0 -= w * S0[d * 128 + c2]; a1 -= w * S0[d * 128 + c2 + 1]; }
          vn[i * 128 + c2] = a0; vn[i * 128 + c2 + 1] = a1; }
        __syncthreads();
        { float o0 = 0.f, o1 = 0.f; const float qsc = 0.08838834764831845f * expf(gcs[i]);
          for (int d = 0; d < 128; ++d) { const float qg = qs[i * QP + d] * qsc; o0 += qg * S0[d * 128 + c2]; o1 += qg * S0[d * 128 + c2 + 1]; }
          for (int j = 0; j < DS; ++j) { const float a = As[i * 8 + j]; o0 += a * vn[j * 128 + c2]; o1 += a * vn[j * 128 + c2 + 1]; }
          const float rstd = 1.0f / sqrtf(wave_sum(o0 * o0 + o1 * o1) * (1.0f / 128.0f) + EPS);
          const size_t row = (size_t)(MP + b * DS + i);
          const float z0 = bf2f(PR[row * NPROJ + C_Z + h * 128 + c2]), z1 = bf2f(PR[row * NPROJ + C_Z + h * 128 + c2 + 1]);
          bf16_t* O = WSP(bf16_t, WS_O) + row * D + 512 + h * 128 + c2;
          O[0] = f2bf(o0 * rstd * p.gdn_norm[l * 128 + c2] * silu_f(z0)); O[1] = f2bf(o1 * rstd * p.gdn_norm[l * 128 + c2 + 1] * silu_f(z1)); }
        { const float gl = gcs[DS - 1], dec = expf(gl); float* o = p.out + O_SGDN + (((size_t)l * DB + b) * 4 + h) * 16384;
#pragma unroll 2
          for (int e = tid; e < 16384; e += NTHR) { const int d = e >> 7, c = e & 127; float s = S0[e] * dec;
              for (int j = 0; j < DS; ++j) s += ks[j * QP + d] * expf(gl - gcs[j]) * vn[j * 128 + c];
              o[e] = s; } }
    }
}

__device__ __forceinline__ void ph_final_norm(const P& p) {
    const int lane = tidx() & 63, wave = tidx() >> 6, gw = blockIdx.x * 8 + wave, ngw = gridDim.x * 8;
    for (int r = gw; r < M; r += ngw) {
        float* xr = p.out + (size_t)r * D; f32x4 v[4]; float ss = 0.f;
#pragma unroll
        for (int j = 0; j < 4; ++j) { v[j] = *(const f32x4*)(xr + 4 * lane + 256 * j); ss += (v[j][0] * v[j][0] + v[j][1] * v[j][1]) + (v[j][2] * v[j][2] + v[j][3] * v[j][3]); }
        const float rstd = 1.0f / sqrtf(wave_sum(ss) * (1.0f / D) + EPS);
#pragma unroll
        for (int j = 0; j < 4; ++j) { const f32x4 g = *(const f32x4*)(p.final_norm + 4 * lane + 256 * j); *(f32x4*)(xr + 4 * lane + 256 * j) = v[j] * rstd * g; }
    }
}

enum Phase { PH_PRO = 0, PH_NORM1, PH_GEMM_IN, PH_ROPE, PH_MIX1, PH_MIX2, PH_MIX3, PH_GEMM_OUT, PH_NORM2, PH_GEMM_GU, PH_GEMM_DN, PH_FINAL };
#ifdef __HIP_EMU__
#define LDSP(x) (x)
#else
#define LDSP(x) ((PG8_LAS unsigned char*)(x))
#endif
template <int PH> __device__ __forceinline__ void run_phase(const P& p, int l, unsigned char* smem) {
    if constexpr (PH == PH_PRO) { ph_convert(p, smem); __syncthreads(); ph_adaln(p, smem); ph_ropetab_copyx(p); }
    else if constexpr (PH == PH_NORM1) ph_norm_mod<0>(p, l);
    else if constexpr (PH == PH_GEMM_IN) {
        pg8::Gemm g{WSP(bf16_t, WS_H), WSP(bf16_t, WS_WIN) + (size_t)l * NPROJ * D, MPAD, NPROJ, D}; pg8::StaticOrder S; S.init(MPAD, NPROJ, (int)gridDim.x, (int)blockIdx.x);
        pg8::EpiStoreBf16 E{WSP(bf16_t, WS_PROJ), NPROJ};
        pg8::gemm_phase<pg8::EpiStoreBf16, pg8::StaticOrder, true, true>(LDSP(smem), g, S, E);
    }
    else if constexpr (PH == PH_ROPE) { ph_rope_out(p, l); ph_vtrans(p, smem); }
    else if constexpr (PH == PH_MIX1) { ph_attn_jobs(p); ph_ret_local(p, l, smem); ph_gdn_prep(p, l, smem); }
    else if constexpr (PH == PH_MIX2) { ph_gdn_chain(p, l, smem); __syncthreads(); ph_attn_sample(p, l, smem); ph_ret_sample(p, l, smem); ph_gdn_sample(p, l, smem); ph_ret_scan(p, l); ph_attn_combine(p); }
    else if constexpr (PH == PH_MIX3) { ph_ret_out(p, l, smem); ph_gdn_out(p, l); }
    else if constexpr (PH == PH_GEMM_OUT) {
        pg8::Gemm g{WSP(bf16_t, WS_O), WSP(bf16_t, WS_WOUT) + (size_t)l * D * D, MPAD, D, D}; pg8::StaticOrder S; S.init(MPAD, D, (int)gridDim.x, (int)blockIdx.x);
        pg8::EpiResidual E{p.out, WSP(float, WS_MOD) + (size_t)l * NC * 6144 + 2048};
        pg8::gemm_phase<pg8::EpiResidual, pg8::StaticOrder, true, true>(LDSP(smem), g, S, E);
    }
    else if constexpr (PH == PH_NORM2) ph_norm_mod<1>(p, l);
    else if constexpr (PH == PH_GEMM_GU) {
        pg8::Gemm g{WSP(bf16_t, WS_H), WSP(bf16_t, WS_WGU) + (size_t)l * 2 * FF * D, MPAD, 2 * FF, D}; pg8::StaticOrder S; S.init(MPAD, 2 * FF, (int)gridDim.x, (int)blockIdx.x);
        pg8::EpiSwiglu E{WSP(bf16_t, WS_HID)};
        pg8::gemm_phase<pg8::EpiSwiglu, pg8::StaticOrder, true, true>(LDSP(smem), g, S, E);
    }
    else if constexpr (PH == PH_GEMM_DN) {
        pg8::Gemm g{WSP(bf16_t, WS_HID), WSP(bf16_t, WS_WDN) + (size_t)l * D * FF, MPAD, D, FF}; pg8::StaticOrder S; S.init(MPAD, D, (int)gridDim.x, (int)blockIdx.x);
        pg8::EpiResidual E{p.out, WSP(float, WS_MOD) + (size_t)l * NC * 6144 + 5120};
        pg8::gemm_phase<pg8::EpiResidual, pg8::StaticOrder, true, true>(LDSP(smem), g, S, E);
    }
    else if constexpr (PH == PH_FINAL) ph_final_norm(p);
}
template <int PH> __global__ void __launch_bounds__(NTHR, 2) k_phase(P p, int l) { DYN_SMEM(smem); run_phase<PH>(p, l, smem); }


#ifndef __HIP_EMU__
#define LAS __attribute__((address_space(3)))
#define XB_TMO      128
#define XB_XCNT(j)  (256  + 64 * (j))
#define XB_XSUB(j)  (1280 + 64 * (j))
#define XB_XGEN(j)  (2304 + 64 * (j))
#define XB_TOP      3328
#define XB_TOPGEN   3392
#define XCD_BAR_WORDS 3456
#define XB_SPIN_CAP (1u << 18)

__device__ __forceinline__ unsigned xb_ld(unsigned* p)              { return __hip_atomic_load(p, __ATOMIC_RELAXED, __HIP_MEMORY_SCOPE_AGENT); }
__device__ __forceinline__ unsigned xb_add(unsigned* p, unsigned v) { return __hip_atomic_fetch_add(p, v, __ATOMIC_RELAXED, __HIP_MEMORY_SCOPE_AGENT); }
__device__ __forceinline__ unsigned xb_xcc_id() { return (unsigned)__builtin_amdgcn_s_getreg((3 << 11) | 20) & 0xFu; }
#define XB_SPIN(cond, bar) do { unsigned _sp = 0; while (cond) { __builtin_amdgcn_s_sleep(1); \
    if ((++_sp & 255u) == 0u) { if (xb_ld(&(bar)[XB_TMO])) break; if (_sp > XB_SPIN_CAP) { atomicAdd(&(bar)[XB_TMO], 1u); break; } } } } while (0)

struct XcdBarrier {
    unsigned* bar; unsigned x;
    volatile LAS unsigned* st;
};

__device__ __forceinline__ XcdBarrier xcd_barrier_post(unsigned* bar, volatile LAS unsigned* st) {
    XcdBarrier b; b.bar = bar; b.x = xb_xcc_id(); b.st = st;
    if (threadIdx.x == 0) (void)xb_add(&bar[XB_XCNT(b.x)], 1u);
    return b;
}
__device__ __forceinline__ void xcd_barrier_complete(unsigned* bar, unsigned x, unsigned& nloc, unsigned& nx) {
    const unsigned G = gridDim.x * gridDim.y * gridDim.z;
    unsigned sum, cnt, mine, sp = 0u;
    for (;;) {
        sum = 0u; cnt = 0u; mine = 0u;
#pragma unroll
        for (unsigned j = 0; j < 16; ++j) { const unsigned c = xb_ld(&bar[XB_XCNT(j)]); sum += c; cnt += (c > 0u) ? 1u : 0u; mine = (j == x) ? c : mine; }
        if (sum == G) break;
        __builtin_amdgcn_s_sleep(1);
        if ((++sp & 255u) == 0u) { if (xb_ld(&bar[XB_TMO])) break; if (sp > XB_SPIN_CAP) { atomicAdd(&bar[XB_TMO], 1u); break; } }
    }
    nloc = mine > 0u ? mine : 1u; nx = cnt > 0u ? cnt : 1u;
}

__device__ __forceinline__ void xcd_barrier(const XcdBarrier& b) {
    asm volatile("s_waitcnt vmcnt(0)" ::: "memory");
    __syncthreads();
    if (threadIdx.x == 0) {
        unsigned* bar = b.bar;
        __builtin_amdgcn_s_waitcnt(0);
        unsigned nloc = b.st[0], nx = b.st[1];
        if (nloc == 0u) { xcd_barrier_complete(bar, b.x, nloc, nx); b.st[0] = nloc; b.st[1] = nx; }
        const unsigned old = xb_add(&bar[XB_XSUB(b.x)], 1u);
        const unsigned gen = old / nloc;
        if (old + 1u == (gen + 1u) * nloc) {
            __builtin_amdgcn_fence(__ATOMIC_RELEASE, "agent");
            asm volatile("s_waitcnt vmcnt(0)" ::: "memory");
            const unsigned og = xb_add(&bar[XB_TOP], 1u);
            const unsigned tg = og / nx;
            if (og + 1u == (tg + 1u) * nx) xb_add(&bar[XB_TOPGEN], 1u);
            else XB_SPIN(xb_ld(&bar[XB_TOPGEN]) == tg, bar);
            __builtin_amdgcn_fence(__ATOMIC_ACQUIRE, "agent");
            xb_add(&bar[XB_XGEN(b.x)], 1u);
            asm volatile("s_waitcnt vmcnt(0)" ::: "memory");
        } else {
            XB_SPIN(xb_ld(&bar[XB_XGEN(b.x)]) == gen, bar);
            __builtin_amdgcn_fence(__ATOMIC_ACQUIRE, "agent");
            asm volatile("s_waitcnt vmcnt(0)" ::: "memory");
        }
    }
    __syncthreads();
}

#endif

#ifndef __HIP_EMU__
#define GRID_SYNC() xcd_barrier(bar)
__global__ void __launch_bounds__(NTHR, 2) k_mega(P p_arg) {
    DYN_SMEM(smem);
#if defined(__HIP_DEVICE_COMPILE__)
#define PHASE(PH_, l_) do { const __attribute__((address_space(4))) P* kp_ = (const __attribute__((address_space(4))) P*)__builtin_amdgcn_kernarg_segment_ptr(); LAUNDER_PTR(kp_); P pl_; __builtin_memcpy(&pl_, kp_, sizeof(P)); run_phase<PH_>(pl_, l_, smem); } while (0)
#else
#define PHASE(PH_, l_) run_phase<PH_>(p_arg, l_, smem)
#endif
    cooperative_groups::grid_group grid = cooperative_groups::this_grid();
    volatile LAS unsigned* bst = (volatile LAS unsigned*)((LAS unsigned char*)smem + BAR_LDS_OFF);
    if (threadIdx.x < 4) bst[threadIdx.x] = 0u;
    __syncthreads();
    XcdBarrier bar = xcd_barrier_post((unsigned*)(p_arg.ws + WS_CTL + 4096), bst);
    PHASE(PH_PRO, 0); grid.sync();
#define LAYER(l) do { PHASE(PH_NORM1, l); GRID_SYNC(); PHASE(PH_GEMM_IN, l); GRID_SYNC(); PHASE(PH_ROPE, l); GRID_SYNC(); PHASE(PH_MIX1, l); GRID_SYNC(); PHASE(PH_MIX2, l); GRID_SYNC(); \
        PHASE(PH_MIX3, l); GRID_SYNC(); PHASE(PH_GEMM_OUT, l); GRID_SYNC(); PHASE(PH_NORM2, l); GRID_SYNC(); PHASE(PH_GEMM_GU, l); GRID_SYNC(); PHASE(PH_GEMM_DN, l); GRID_SYNC(); } while (0)
    static_assert(NL == 2, "two layers written out (a loop over the layers makes hipcc hoist every phase's constants to the loop preheader and spill)");
    LAYER(0); LAYER(1);
    PHASE(PH_FINAL, 0);
}
#endif

template <int PH> static void launch_phase(const P& p, int l, int grid, hipStream_t stream) {
#ifndef __HIP_EMU__
    static bool attr_done = false;
    if (!attr_done) { (void)hipFuncSetAttribute((const void*)k_phase<PH>, hipFuncAttributeMaxDynamicSharedMemorySize, SMEM_BYTES); attr_done = true; }
#endif
    LAUNCH(k_phase<PH>, grid, SMEM_BYTES, stream, p, l);
}

extern "C" void kernel_launch(void* const* d_in, const int* in_sizes, int n_in, void* d_out, int out_size, void* d_ws, size_t ws_size, hipStream_t stream) {
    if (n_in != 24 || (size_t)out_size != O_END || ws_size < WS_END) {
        fprintf(stderr, "kernel_launch: shape mismatch: n_in %d out_size %d (want %zu) ws %zu (want %zu)\n", n_in, out_size, (size_t)O_END, ws_size, (size_t)WS_END); return; }
    P p{};
    const float** pp = (const float**)&p;
    for (int i = 0; i < 24; ++i) pp[i] = (const float*)d_in[i];
    p.out = (float*)d_out; p.ws = (unsigned char*)d_ws;
#ifndef __HIP_EMU__
    static int grid = 0;
    if (grid == 0) {
        int dev = 0, cus = 0, per_cu = 0;
        if (hipGetDevice(&dev) != hipSuccess || hipDeviceGetAttribute(&cus, hipDeviceAttributeMultiprocessorCount, dev) != hipSuccess || cus <= 0) { fprintf(stderr, "kernel_launch: device query failed\n"); grid = -1; return; }
        if (hipFuncSetAttribute((const void*)k_mega, hipFuncAttributeMaxDynamicSharedMemorySize, SMEM_BYTES) != hipSuccess) { fprintf(stderr, "kernel_launch: hipFuncSetAttribute failed\n"); grid = -1; return; }
        if (hipOccupancyMaxActiveBlocksPerMultiprocessor(&per_cu, (const void*)k_mega, NTHR, SMEM_BYTES) != hipSuccess || per_cu < 1) { fprintf(stderr, "kernel_launch: occupancy query says %d blocks per CU\n", per_cu); grid = -1; return; }
        grid = cus;
    }
    if (grid < 0) return;
    if (hipMemsetAsync((char*)d_ws + WS_CTL, 0, 65536, stream) != hipSuccess) { fprintf(stderr, "kernel_launch: memset of the barrier words failed\n"); return; }
    { void* args[] = {(void*)&p};
      hipError_t e = hipLaunchCooperativeKernel((const void*)k_mega, dim3(grid), dim3(NTHR), args, SMEM_BYTES, stream);
      if (e != hipSuccess) fprintf(stderr, "kernel_launch: cooperative launch failed: %s (grid %d)\n", hipGetErrorString(e), grid);
      return; }
#else
    int grid = 16;
#endif
    launch_phase<PH_PRO>(p, 0, grid, stream);
    for (int l = 0; l < NL; ++l) {
        launch_phase<PH_NORM1>(p, l, grid, stream);
        launch_phase<PH_GEMM_IN>(p, l, grid, stream);
        launch_phase<PH_ROPE>(p, l, grid, stream);
        launch_phase<PH_MIX1>(p, l, grid, stream);
        launch_phase<PH_MIX2>(p, l, grid, stream);
        launch_phase<PH_MIX3>(p, l, grid, stream);
        launch_phase<PH_GEMM_OUT>(p, l, grid, stream);
        launch_phase<PH_NORM2>(p, l, grid, stream);
        launch_phase<PH_GEMM_GU>(p, l, grid, stream);
        launch_phase<PH_GEMM_DN>(p, l, grid, stream);
    }
    launch_phase<PH_FINAL>(p, 0, grid, stream);
}
```

```cpp
#ifndef __HIP_EMU__
#include <hip/hip_runtime.h>
#include <hip/hip_cooperative_groups.h>
#endif
#include <cstdio>
#include <cstdint>
#include <cmath>

#ifndef CFG_BATCH
#define CFG_BATCH 2
#endif
#ifndef CFG_SEQ
#define CFG_SEQ 8192
#endif
#ifndef CFG_DB
#define CFG_DB 32
#endif
constexpr float LOG2E = 1.4426950408889634f;
constexpr int D = 1024, NL = 2, PB = CFG_BATCH, T = CFG_SEQ, DB = CFG_DB, DS = 8, PAST = 16384, WB = 2048;
constexpr int MP = PB * T, MS = DB * DS, M = MP + MS, MPAD = (M + 255) / 256 * 256, NC = PB + DB;
constexpr int INC = 3848, NPROJ = 3840, FF = 2816, NCH = T / 64, PWIN = T < 2048 ? T : 2048, NPOS = T + DS;
constexpr int NUNIT = PB * 4 * NCH;
constexpr float EPS = 1e-6f;
static_assert(T % 512 == 0, "the attention job decomposition wants T % 512 == 0");
constexpr int C_QA = 0, C_KA = 256, C_VA = 512, C_QR = 768, C_KR = 1024, C_VR = 1280, C_GR = 1536, C_CONV = 1792, C_Z = 3328;
constexpr int SMEM_BYTES = 147456;
constexpr int NTHR = 512;
constexpr int BAR_LDS_OFF = SMEM_BYTES - 64;

typedef unsigned short bf16_t;
typedef short bf16x8 __attribute__((ext_vector_type(8)));
typedef float f32x4 __attribute__((ext_vector_type(4)));
typedef unsigned u32x4 __attribute__((ext_vector_type(4)));
typedef unsigned u32x2 __attribute__((ext_vector_type(2)));
typedef float f32x16 __attribute__((ext_vector_type(16)));

#ifdef __HIP_EMU__
#define LAUNCH(kern, grid, lds, stream, ...) emu_launch(grid, NTHR, [=]() { kern(__VA_ARGS__); })
#define DYN_SMEM(name) unsigned char* name = emu_dyn_smem()
#define WAVE_SYNC() emu_wave_bar()
#define MFMA32(a, b, c) emu_mfma32(a, b, c)
#define GLDS16(gp, lp) memcpy((unsigned char*)(lp) + (threadIdx.x & 63) * 16, (gp), 16)
#define RAW_BARRIER() __syncthreads()
#define GLDS4(gp, lp) ((void)0)
#define WAIT_VM(n)
#define WAIT_LGKM0()
#define LAS
#define UNIFORM(x) (x)
#define COMPILER_FENCE()
#define LAUNDER_V(x)
#define MFMA16(a, b, c) emu_mfma16(a, b, c)
#else
#define WAVE_SYNC() asm volatile("s_waitcnt lgkmcnt(0)" ::: "memory")
#define MFMA32(a, b, c) __builtin_amdgcn_mfma_f32_32x32x16_bf16(a, b, c, 0, 0, 0)
#define LAS __attribute__((address_space(3)))
#define GLDS16(gp, lp) __builtin_amdgcn_global_load_lds((const unsigned*)(gp), (LAS unsigned*)(lp), 16, 0, 0)
#define RAW_BARRIER() __builtin_amdgcn_s_barrier()
#define GLDS4(gp, lp) __builtin_amdgcn_global_load_lds((const unsigned*)(gp), (LAS unsigned*)(lp), 4, 0, 0)
#define WAIT_VM(n) asm volatile("s_waitcnt vmcnt(" #n ")" ::: "memory")
#define WAIT_LGKM0() asm volatile("s_waitcnt lgkmcnt(0)" ::: "memory")
#define UNIFORM(x) __builtin_amdgcn_readfirstlane(x)
#define COMPILER_FENCE() __builtin_amdgcn_sched_barrier(0)
#define LAUNDER_V(x) asm volatile("" : "+v"(x))
#define MFMA16(a, b, c) __builtin_amdgcn_mfma_f32_16x16x32_bf16(a, b, c, 0, 0, 0)
#define LAUNCH(kern, grid, lds, stream, ...) hipLaunchKernelGGL(kern, dim3(grid), dim3(NTHR), lds, stream, __VA_ARGS__)
#define DYN_SMEM(name) extern __shared__ __attribute__((aligned(16))) unsigned char name[]
#endif

#ifdef __HIP_EMU__
__device__ __forceinline__ int tidx() { return (int)threadIdx.x; }
#define LAUNDER_PTR(x)
#else
__device__ __forceinline__ int tidx() { int t = (int)threadIdx.x; asm volatile("" : "+v"(t)); return t; }
#define LAUNDER_PTR(x) asm volatile("" : "+s"(x))
#endif
__device__ __forceinline__ float bf2f(bf16_t v) { return __builtin_bit_cast(float, (unsigned)v << 16); }
__device__ __forceinline__ bf16_t f2bf(float f) { unsigned u = __builtin_bit_cast(unsigned, f); return (bf16_t)((u + 0x7fffu + ((u >> 16) & 1u)) >> 16); }
#ifdef __HIP_EMU__
__device__ __forceinline__ unsigned pk2(float lo, float hi) { return (unsigned)f2bf(lo) | ((unsigned)f2bf(hi) << 16); }
#else
typedef float f32x2_t __attribute__((ext_vector_type(2))); typedef __bf16 bf16x2_t __attribute__((ext_vector_type(2)));
__device__ __forceinline__ unsigned pk2(float lo, float hi) { f32x2_t v = {lo, hi}; bf16x2_t b = __builtin_convertvector(v, bf16x2_t); return __builtin_bit_cast(unsigned, b); }
#endif
__device__ __forceinline__ bf16x8 pack_tiles(const f32x4& lo, const f32x4& hi) {
    u32x4 w; w.x = pk2(lo[0], lo[1]); w.y = pk2(lo[2], lo[3]); w.z = pk2(hi[0], hi[1]); w.w = pk2(hi[2], hi[3]); return __builtin_bit_cast(bf16x8, w);
}
__device__ __forceinline__ float silu_f(float x) { return x / (1.0f + expf(-x)); }
#ifdef __HIP_EMU__
__device__ __forceinline__ float silu_fast(float x) { return x / (1.0f + expf(-x)); }
#else
__device__ __forceinline__ float silu_fast(float x) { return x * __builtin_amdgcn_rcpf(1.0f + __builtin_amdgcn_exp2f(-LOG2E * x)); }
#endif
__device__ __forceinline__ float wave_sum(float v) {
#pragma unroll
    for (int o = 1; o < 64; o <<= 1) v += __shfl_xor(v, o);
    return v;
}
__device__ __forceinline__ float wave_max(float v) {
#pragma unroll
    for (int o = 1; o < 64; o <<= 1) v = fmaxf(v, __shfl_xor(v, o));
    return v;
}

struct P {
    const float *x_prompt, *x_sample, *cache_k, *cache_v, *state_ret, *state_gdn, *state_conv, *c_prompt, *c_sample, *ada_w, *ada_b, *norm_mix, *norm_ffn,
        *w_in, *ret_norm, *conv_w, *a_log, *dt_bias, *gdn_norm, *w_out, *w_gate, *w_up, *w_down, *final_norm;
    float* out; unsigned char* ws;
};

constexpr size_t O_YP = 0, O_YS = O_YP + (size_t)MP * D, O_PWK = O_YS + (size_t)MS * D, O_PWV = O_PWK + (size_t)NL * PB * PWIN * 256,
                 O_PRET = O_PWV + (size_t)NL * PB * PWIN * 256, O_PGDN = O_PRET + (size_t)NL * PB * 4 * 4096, O_PCONV = O_PGDN + (size_t)NL * PB * 4 * 16384,
                 O_SWK = O_PCONV + (size_t)NL * PB * 3 * 1536, O_SWV = O_SWK + (size_t)NL * DB * DS * 256, O_SRET = O_SWV + (size_t)NL * DB * DS * 256,
                 O_SGDN = O_SRET + (size_t)NL * DB * 4 * 4096, O_SCONV = O_SGDN + (size_t)NL * DB * 4 * 16384, O_END = O_SCONV + (size_t)NL * DB * 3 * 1536;

constexpr size_t al256(size_t x) { return (x + 255) / 256 * 256; }
constexpr size_t WS_CTL = 0, WS_CTL_BYTES = 1u << 20;
constexpr size_t WS_MOD = WS_CTL + WS_CTL_BYTES;
constexpr size_t WS_ROPE = al256(WS_MOD + (size_t)NL * NC * 6144 * 4);
constexpr size_t WS_WIN = al256(WS_ROPE + (size_t)4 * NPOS * 32 * 4);
constexpr size_t WS_WOUT = al256(WS_WIN + (size_t)NL * NPROJ * D * 2);
constexpr size_t WS_WGU = al256(WS_WOUT + (size_t)NL * D * D * 2);
constexpr size_t WS_WDN = al256(WS_WGU + (size_t)NL * 2 * FF * D * 2);
constexpr size_t WS_H = al256(WS_WDN + (size_t)NL * D * FF * 2);
constexpr size_t WS_PROJ = al256(WS_H + (size_t)MPAD * D * 2);
constexpr size_t WS_BETA = al256(WS_PROJ + (size_t)MPAD * NPROJ * 2);
constexpr size_t WS_G = al256(WS_BETA + (size_t)M * 4 * 4);
constexpr size_t WS_O = al256(WS_G + (size_t)M * 4 * 4);
constexpr size_t WS_RU = al256(WS_O + (size_t)MPAD * D * 2);
constexpr size_t WS_RS = al256(WS_RU + (size_t)NUNIT * 4096 * 4);
constexpr size_t WS_SCR = al256(WS_RS + (size_t)NUNIT * 4096 * 4);
constexpr size_t WS_GU = WS_SCR;
constexpr size_t WS_GWK = al256(WS_GU + (size_t)NUNIT * 8192 * 2);
constexpr size_t WS_GQ = al256(WS_GWK + (size_t)NUNIT * 16384 * 2);
constexpr size_t WS_GA = al256(WS_GQ + (size_t)NUNIT * 8192 * 2);
constexpr size_t WS_GD = al256(WS_GA + (size_t)NUNIT * 4096 * 2);
constexpr size_t WS_GV = al256(WS_GD + (size_t)NUNIT * 4);
constexpr size_t WS_GS = al256(WS_GV + (size_t)NUNIT * 8192 * 2);
constexpr size_t WS_GEND = al256(WS_GS + (size_t)NUNIT * 16384 * 2);
constexpr size_t WS_KH = WS_GEND;
constexpr size_t WS_VT1 = al256(WS_KH + (size_t)MP * 256 * 2);
constexpr size_t WS_VT4 = al256(WS_VT1 + (size_t)MP * 256 * 2);
constexpr size_t WS_VT16 = al256(WS_VT4 + (size_t)MP * 256 * 2);
constexpr size_t WS_KRT = al256(WS_VT16 + (size_t)MP * 256 * 2);
constexpr size_t WS_VRT = al256(WS_KRT + (size_t)MP * 256 * 2);
constexpr size_t WS_AML = al256(WS_VRT + (size_t)MP * 256 * 2);
constexpr size_t WS_AEND = al256(WS_AML + (size_t)MP * 4 * 3 * 2 * 4);
constexpr size_t WS_APO = WS_H;
static_assert((size_t)MP * 4 * 3 * 64 * 2 <= (size_t)MPAD * D * 2, "attention partials overlay H");
constexpr size_t WS_HID = WS_SCR;
constexpr size_t WS_HEND = al256(WS_HID + (size_t)MPAD * FF * 2);
constexpr size_t WS_END = WS_AEND > WS_HEND ? WS_AEND : WS_HEND;

#define WSP(T_, off) ((T_*)(p.ws + (off)))
__device__ __forceinline__ int row_cb(int r) { return r < MP ? r / T : PB + (r - MP) / DS; }
__device__ __forceinline__ int row_pi(int r) { return r < MP ? r % T : T + (r - MP) % DS; }
namespace pg8 {
#ifdef __HIP_EMU__
#define PG8_LAS
#else
#define PG8_LAS __attribute__((address_space(3)))
#endif
typedef unsigned short bf16_t;
typedef short bf16x8 __attribute__((ext_vector_type(8)));
typedef float f32x4 __attribute__((ext_vector_type(4)));
typedef unsigned u32x4 __attribute__((ext_vector_type(4)));
constexpr int BM = 256, BK = 64, HALF = 128, HTB = HALF * BK * 2  , STAGE_BYTES = 8 * HTB, NXCD = 8, WGM = 8;

__host__ __device__ __forceinline__ int lds_byte(int r, int c) { const int st = (r >> 4) * 2 + (c >> 5), rr = r & 15, cc = c & 31, ob = rr * 64 + cc * 2; return st * 1024 + (ob ^ (((ob >> 9) & 1) << 5)); }
__host__ __device__ __forceinline__ void stage_rc(int b, int& R, int& C) { const int st = b / 1024, sb = b % 1024, swz = sb ^ (((sb >> 9) & 1) << 5); R = (st >> 1) * 16 + swz / 64; C = (st & 1) * 32 + (swz % 64) / 2; }
__host__ __device__ __forceinline__ int perm32(int rho) { const int n = rho >> 4, i = rho & 15; return 8 * (i >> 2) + 4 * n + (i & 3); }

struct Unit { int pm, pn; };
struct Gemm { const bf16_t* A; const bf16_t* Bt; int M, N, K; };

struct StaticOrder {
    int nM, nN, nwg, G, c;
    __host__ __device__ void init(int M, int N, int G_, int c_) { nM = M / BM; nN = N / BM; nwg = nM * nN; G = G_; c = c_; }
    __host__ __device__ bool next(int i, Unit& u) const {
        const long L = (long)i * G + c; if (L >= nwg) return false;
        int wgid = (int)L; { const int q = nwg / NXCD, r = nwg % NXCD, xcd = wgid % NXCD, off = wgid / NXCD; wgid = (xcd < r ? xcd * (q + 1) : r * (q + 1) + (xcd - r) * q) + off; }
        const int nig = WGM * nN, gid = wgid / nig, fm = gid * WGM, gsz = (nM - fm) < WGM ? (nM - fm) : WGM;
        u.pm = fm + ((wgid % nig) % gsz); u.pn = (wgid % nig) / gsz; return true;
    }
    __device__ __forceinline__ void a_ready(const Unit&) const {}
    __device__ __forceinline__ void done(const Unit&) const {}
};


struct EpiStoreBf16 {
    static constexpr bool PERM = true, AFTER_DRAIN = false;
    bf16_t* O; int ldc;
    __device__ __forceinline__ void operator()(const f32x4 (&acc)[2][2][4][2], const Unit& u, int wr, int wc, int fr, int fq) const {
        const int row0 = u.pm * BM + wr * 64 + fr, col0 = u.pn * BM + wc * 32 + 8 * fq;
#pragma unroll
        for (int ai = 0; ai < 2; ++ai)
#pragma unroll
            for (int m = 0; m < 4; ++m) { bf16_t* rowp = O + (size_t)(row0 + ai * HALF + m * 16) * ldc + col0;
#pragma unroll
                for (int bj = 0; bj < 2; ++bj) { const f32x4 v0 = acc[ai][bj][m][0], v1 = acc[ai][bj][m][1];
                    u32x4 w; w.x = ::pk2(v0[0], v0[1]); w.y = ::pk2(v0[2], v0[3]); w.z = ::pk2(v1[0], v1[1]); w.w = ::pk2(v1[2], v1[3]);
                    *(u32x4*)(rowp + bj * HALF) = w; } }
    }
};
struct EpiResidual {
    static constexpr bool PERM = false, AFTER_DRAIN = false;
    float* X; const float* gate;
    __device__ __forceinline__ void operator()(const f32x4 (&acc)[2][2][4][2], const Unit& u, int wr, int wc, int fr, int fq) const {
        const int row0 = u.pm * BM + wr * 64 + fr, col0 = u.pn * BM + wc * 32 + 4 * fq;
#pragma unroll
        for (int ai = 0; ai < 2; ++ai)
#pragma unroll
            for (int m = 0; m < 4; ++m) { const int row = row0 + ai * HALF + m * 16;
                if (MPAD != M && row >= M) continue;
                const float* g = gate + (size_t)::row_cb(row) * 6144 + col0; float* xp = X + (size_t)row * D + col0;
#pragma unroll
                for (int bj = 0; bj < 2; ++bj)
#pragma unroll
                    for (int n = 0; n < 2; ++n) { const f32x4 gv = *(const f32x4*)(g + bj * HALF + n * 16); f32x4* xq = (f32x4*)(xp + bj * HALF + n * 16); *xq = *xq + gv * acc[ai][bj][m][n]; } }
    }
};
struct EpiSwiglu {
    static constexpr bool PERM = true, AFTER_DRAIN = false;
    bf16_t* Hd;
    __device__ __forceinline__ void operator()(const f32x4 (&acc)[2][2][4][2], const Unit& u, int wr, int wc, int fr, int fq) const {
        const int row0 = u.pm * BM + wr * 64 + fr, col0 = u.pn * HALF + wc * 32 + 8 * fq;
#pragma unroll
        for (int ai = 0; ai < 2; ++ai)
#pragma unroll
            for (int m = 0; m < 4; ++m) { bf16_t* rowp = Hd + (size_t)(row0 + ai * HALF + m * 16) * FF + col0;
                float v[8];
#pragma unroll
                for (int n = 0; n < 2; ++n)
#pragma unroll
                    for (int j = 0; j < 4; ++j) { const float gt = acc[ai][0][m][n][j], up = acc[ai][1][m][n][j]; v[4 * n + j] = ::silu_f(gt) * up; }
                u32x4 w; w.x = ::pk2(v[0], v[1]); w.y = ::pk2(v[2], v[3]); w.z = ::pk2(v[4], v[5]); w.w = ::pk2(v[6], v[7]);
                *(u32x4*)rowp = w; }
    }
};

#ifdef __HIP_EMU__
template <class Epi, class Sched, bool ALIGN_EPI = false, bool SP2 = false>
__device__ __forceinline__ void gemm_phase(unsigned char* lds, const Gemm g, const Sched& S, const Epi& E) {
    const int tid = threadIdx.x, wid = tid >> 6, lane = tid & 63, wr = wid >> 2, wc = wid & 3, fr = lane & 15, fq = lane >> 4;
    Unit cur;
    for (int ui = 0; S.next(ui, cur); ++ui) {
        f32x4 acc[2][2][4][2];
        for (int ai = 0; ai < 2; ++ai) for (int bj = 0; bj < 2; ++bj) for (int m = 0; m < 4; ++m) for (int n = 0; n < 2; ++n) for (int j = 0; j < 4; ++j) {
            const int row = 256 * cur.pm + 128 * ai + 64 * wr + 16 * m + fr;
            const int col = Epi::PERM ? 256 * cur.pn + 128 * bj + 32 * wc + 8 * fq + 4 * n + j : 256 * cur.pn + 128 * bj + 32 * wc + 16 * n + 4 * fq + j;
            const bf16_t* a = g.A + (size_t)row * g.K; const bf16_t* b = g.Bt + (size_t)col * g.K; float s = 0.f;
            for (int k = 0; k < g.K; ++k) s += ::bf2f(a[k]) * ::bf2f(b[k]);
            acc[ai][bj][m][n][j] = s; }
        E(acc, cur, wr, wc, fr, fq);
    }
}
#else
template <class Epi, class Sched, bool ALIGN_EPI = false, bool SP2 = false>
__device__ __forceinline__ void gemm_phase(PG8_LAS unsigned char* lds, const Gemm g, const Sched& S, const Epi& E) {
    const int tid = ::tidx(), wid = __builtin_amdgcn_readfirstlane(tid >> 6), lane = tid & 63, wr = wid >> 2, wc = wid & 3, fr = lane & 15, fq = lane >> 4;
    const int K = g.K, nt = K / BK;
    unsigned voffA[2], voffB[2];
#pragma unroll
    for (int i = 0; i < 2; ++i) { int R, C; stage_rc(tid * 16 + i * 8192, R, C); const int Rb = Epi::PERM ? ((R & ~31) + perm32(R & 31)) : R;
        voffA[i] = (unsigned)(R * K + C) * 2u; voffB[i] = (unsigned)(Rb * K + C) * 2u; }
    const size_t kstep = (size_t)(BK * 2);
    const size_t hstep = (size_t)HALF * K * 2;
    const size_t tstep = 2 * hstep;
    const unsigned ldsw = (unsigned)wid * 1024u;
    const int aoff = lds_byte(wr * 64 + fr, fq * 8), boff = lds_byte(wc * 32 + fr, fq * 8);
#define PG8_SA(b, h) (((b) * 2 + (h)) * HTB)
#define PG8_SB(b, h) ((4 + (b) * 2 + (h)) * HTB)
#define PG8_STAGE(bufoff, gbase, voff) do { _Pragma("unroll") for (int _i = 0; _i < 2; ++_i) \
        __builtin_amdgcn_global_load_lds((const unsigned*)((const char*)(gbase) + (voff)[_i]), (PG8_LAS unsigned*)(lds + (bufoff) + ldsw + _i * 8192), 16, 0, 0); } while (0)
#define PG8_LDA(dst, b, h) do { _Pragma("unroll") for (int m = 0; m < 4; ++m) _Pragma("unroll") for (int k = 0; k < 2; ++k) dst[m][k] = *(const PG8_LAS bf16x8*)(lds + PG8_SA(b, h) + aoff + m * 2048 + k * 1024); } while (0)
#define PG8_LDB(dst, b, h) do { _Pragma("unroll") for (int n = 0; n < 2; ++n) _Pragma("unroll") for (int k = 0; k < 2; ++k) dst[n][k] = *(const PG8_LAS bf16x8*)(lds + PG8_SB(b, h) + boff + n * 2048 + k * 1024); } while (0)
#define PG8_MMA(ai, bj, At, Bt) do { __builtin_amdgcn_s_setprio(1); _Pragma("unroll") for (int m = 0; m < 4; ++m) _Pragma("unroll") for (int n = 0; n < 2; ++n) _Pragma("unroll") for (int k = 0; k < 2; ++k) \
        acc[ai][bj][m][n] = __builtin_amdgcn_mfma_f32_16x16x32_bf16(Bt[n][k], At[m][k], acc[ai][bj][m][n], 0, 0, 0); __builtin_amdgcn_s_setprio(0); } while (0)
#define PG8_WAIT_V(n) asm volatile("s_waitcnt vmcnt(" #n ")" ::: "memory")
#define PG8_WAIT_L(n) asm volatile("s_waitcnt lgkmcnt(" #n ")" ::: "memory")
#define PG8_BAR __builtin_amdgcn_s_barrier()
#define PG8_SCHED __builtin_amdgcn_sched_barrier(0)
    Unit cur, nxt; int ui = 0;
    if (!S.next(0, cur)) return;
    f32x4 acc[2][2][4][2];
#pragma unroll
    for (int a = 0; a < 2; ++a)
#pragma unroll
        for (int b = 0; b < 2; ++b)
#pragma unroll
            for (int m = 0; m < 4; ++m)
#pragma unroll
                for (int n = 0; n < 2; ++n) acc[a][b][m][n] = (f32x4){0.f, 0.f, 0.f, 0.f};
    bf16x8 At[4][2], B0[2][2], B1[2][2];
    const char* cA = (const char*)g.A + (size_t)cur.pm * tstep; const char* cB = (const char*)g.Bt + (size_t)cur.pn * tstep;
    S.a_ready(cur);
    if constexpr (SP2) {
        PG8_STAGE(PG8_SB(0, 0), cB, voffB); PG8_STAGE(PG8_SB(0, 1), cB + hstep, voffB); PG8_STAGE(PG8_SA(0, 0), cA, voffA); PG8_STAGE(PG8_SA(0, 1), cA + hstep, voffA);
        if (wr == 1) PG8_BAR;
        PG8_WAIT_V(2); PG8_BAR;
        PG8_STAGE(PG8_SB(1, 0), cB + kstep, voffB); PG8_STAGE(PG8_SA(1, 0), cA + kstep, voffA); PG8_STAGE(PG8_SB(1, 1), cB + hstep + kstep, voffB);
        PG8_WAIT_V(6); PG8_BAR;
    } else {
        PG8_STAGE(PG8_SB(0, 0), cB, voffB); PG8_STAGE(PG8_SA(0, 0), cA, voffA); PG8_STAGE(PG8_SB(0, 1), cB + hstep, voffB); PG8_STAGE(PG8_SA(0, 1), cA + hstep, voffA);
        if (wr == 1) PG8_BAR;
        PG8_WAIT_V(4); PG8_BAR;
        PG8_STAGE(PG8_SB(1, 0), cB + kstep, voffB); PG8_STAGE(PG8_SA(1, 0), cA + kstep, voffA); PG8_STAGE(PG8_SB(1, 1), cB + hstep + kstep, voffB);
        PG8_WAIT_V(6); PG8_BAR;
    }
    for (;;) {
        const bool has_next = S.next(ui + 1, nxt);
        const char* nA = has_next ? (const char*)g.A + (size_t)nxt.pm * tstep : cA; const char* nB = has_next ? (const char*)g.Bt + (size_t)nxt.pn * tstep : cB;
        for (int t = 0; t < nt; t += 2) {
            const bool last = (t == nt - 2);
            const char* a1 = cA + (size_t)(t + 1) * kstep;
            const char* a2 = last ? nA : cA + (size_t)(t + 2) * kstep; const char* b2 = last ? nB : cB + (size_t)(t + 2) * kstep;
            const char* a3 = a2 + kstep; const char* b3 = b2 + kstep;
            if (last && has_next) S.a_ready(nxt);
            if constexpr (SP2) {
            PG8_LDB(B0, 0, 0); PG8_LDB(B1, 0, 1); PG8_SCHED; PG8_LDA(At, 0, 0); PG8_STAGE(PG8_SA(1, 1), a1 + hstep, voffA);
            PG8_WAIT_V(8); PG8_WAIT_L(0); PG8_BAR; PG8_MMA(0, 0, At, B0); PG8_MMA(0, 1, At, B1); PG8_BAR; PG8_SCHED;
            PG8_LDA(At, 0, 1); PG8_STAGE(PG8_SB(0, 0), b2, voffB); PG8_STAGE(PG8_SB(0, 1), b2 + hstep, voffB); PG8_STAGE(PG8_SA(0, 0), a2, voffA);
            PG8_WAIT_V(8); PG8_WAIT_L(0); PG8_BAR; PG8_MMA(1, 0, At, B0); PG8_MMA(1, 1, At, B1); PG8_BAR; PG8_SCHED;
            PG8_LDB(B0, 1, 0); PG8_LDB(B1, 1, 1); PG8_SCHED; PG8_LDA(At, 1, 0); PG8_STAGE(PG8_SA(0, 1), a2 + hstep, voffA);
            PG8_WAIT_V(8); PG8_WAIT_L(0); PG8_BAR; PG8_MMA(0, 0, At, B0); PG8_MMA(0, 1, At, B1); PG8_BAR; PG8_SCHED;
            PG8_LDA(At, 1, 1); PG8_STAGE(PG8_SB(1, 0), b3, voffB); PG8_STAGE(PG8_SB(1, 1), b3 + hstep, voffB); PG8_STAGE(PG8_SA(1, 0), a3, voffA);
            PG8_WAIT_V(8); PG8_WAIT_L(0); PG8_BAR; PG8_MMA(1, 0, At, B0); PG8_MMA(1, 1, At, B1); PG8_BAR; PG8_SCHED;
            } else {
            PG8_LDB(B0, 0, 0); PG8_SCHED; PG8_LDA(At, 0, 0); PG8_STAGE(PG8_SA(1, 1), a1 + hstep, voffA);
            PG8_WAIT_L(8); PG8_BAR; PG8_WAIT_L(0); PG8_MMA(0, 0, At, B0); PG8_BAR; PG8_SCHED;
            PG8_LDB(B1, 0, 1); PG8_STAGE(PG8_SB(0, 0), b2, voffB);
            PG8_BAR; PG8_WAIT_L(0); PG8_MMA(0, 1, At, B1); PG8_BAR;
            PG8_LDA(At, 0, 1); PG8_STAGE(PG8_SA(0, 0), a2, voffA);
            PG8_BAR; PG8_WAIT_L(0); PG8_MMA(1, 0, At, B0); PG8_BAR; PG8_SCHED;
            PG8_STAGE(PG8_SB(0, 1), b2 + hstep, voffB);
            PG8_WAIT_V(6); PG8_BAR; PG8_MMA(1, 1, At, B1); PG8_BAR;
            PG8_LDB(B0, 1, 0); PG8_SCHED; PG8_LDA(At, 1, 0); PG8_STAGE(PG8_SA(0, 1), a2 + hstep, voffA);
            PG8_WAIT_L(8); PG8_BAR; PG8_WAIT_L(0); PG8_MMA(0, 0, At, B0); PG8_BAR; PG8_SCHED;
            PG8_LDB(B1, 1, 1); PG8_STAGE(PG8_SB(1, 0), b3, voffB);
            PG8_BAR; PG8_WAIT_L(0); PG8_MMA(0, 1, At, B1); PG8_BAR;
            PG8_LDA(At, 1, 1); PG8_STAGE(PG8_SA(1, 0), a3, voffA);
            PG8_BAR; PG8_WAIT_L(0); PG8_MMA(1, 0, At, B0); PG8_BAR; PG8_SCHED;
            PG8_STAGE(PG8_SB(1, 1), b3 + hstep, voffB);
            PG8_WAIT_V(6); PG8_BAR; PG8_MMA(1, 1, At, B1); PG8_BAR;
            }
        }
        if constexpr (ALIGN_EPI) { if (wr == 0) PG8_BAR; }
        if constexpr (!Epi::AFTER_DRAIN) { E(acc, cur, wr, wc, fr, fq); S.done(cur); }
        if (!has_next) break;
#pragma unroll
        for (int a = 0; a < 2; ++a)
#pragma unroll
            for (int b = 0; b < 2; ++b)
#pragma unroll
                for (int m = 0; m < 4; ++m)
#pragma unroll
                    for (int n = 0; n < 2; ++n) acc[a][b][m][n] = (f32x4){0.f, 0.f, 0.f, 0.f};
        cur = nxt; cA = nA; cB = nB; ++ui;
        if constexpr (ALIGN_EPI) { if (wr == 1) PG8_BAR; }
    }
    PG8_WAIT_V(0);
    if constexpr (!ALIGN_EPI) { if (wr == 0) PG8_BAR; }
    PG8_BAR;
    if constexpr (Epi::AFTER_DRAIN) { E.fused(acc, cur, wr, wc, fr, fq, lds, wid, lane); S.done(cur); }
#undef PG8_SA
#undef PG8_SB
#undef PG8_STAGE
#undef PG8_LDA
#undef PG8_LDB
#undef PG8_MMA
#undef PG8_WAIT_V
#undef PG8_WAIT_L
#undef PG8_BAR
#undef PG8_SCHED
}
#endif
}


__device__ __forceinline__ void transpose_item(const float* W, int ldw, bf16_t* WT, int K, int k0, int n0, int drow0, float* scr, int lane) {
#pragma unroll 8
    for (int i = 0; i < 32; ++i) { const int kk = 2 * i + (lane >> 5); scr[kk * 33 + (lane & 31)] = W[(size_t)(k0 + kk) * ldw + n0 + (lane & 31)]; }
    WAVE_SYNC();
    const int c = lane & 7;
#pragma unroll
    for (int j = 0; j < 4; ++j) { const int n = (lane >> 3) + 8 * j; const float* s = scr + (8 * c) * 33 + n;
        u32x4 o; o.x = pk2(s[0 * 33], s[1 * 33]); o.y = pk2(s[2 * 33], s[3 * 33]); o.z = pk2(s[4 * 33], s[5 * 33]); o.w = pk2(s[6 * 33], s[7 * 33]);
        *(u32x4*)(WT + (size_t)(drow0 + n) * K + k0 + 8 * c) = o; }
    WAVE_SYNC();
}
__device__ __forceinline__ void ph_convert(const P& p, unsigned char* smem) {
    const int lane = tidx() & 63, wave = tidx() >> 6;
    float* scr = (float*)smem + wave * (64 * 33 + 32);
    constexpr int I_IN = 16 * 120, I_OUT = 16 * 32, I_G = 16 * 88, I_DN = 44 * 32, I_L = I_IN + I_OUT + 2 * I_G + I_DN;
    const int gw = blockIdx.x * 8 + wave, ngw = gridDim.x * 8;
    for (int it = gw; it < NL * I_L; it += ngw) {
        const int l = it / I_L; int r = it % I_L;
        if (r < I_IN) { const int kb = r / 120, nb = r % 120; transpose_item(p.w_in + (size_t)l * D * INC, INC, WSP(bf16_t, WS_WIN) + (size_t)l * NPROJ * D, D, kb * 64, nb * 32, nb * 32, scr, lane); continue; }
        r -= I_IN;
        if (r < I_OUT) { const int kb = r / 32, nb = r % 32; transpose_item(p.w_out + (size_t)l * D * D, D, WSP(bf16_t, WS_WOUT) + (size_t)l * D * D, D, kb * 64, nb * 32, nb * 32, scr, lane); continue; }
        r -= I_OUT;
        if (r < 2 * I_G) { const int up = r / I_G; r %= I_G; const int kb = r / 88, nb = r % 88, n0 = nb * 32;
            transpose_item((up ? p.w_up : p.w_gate) + (size_t)l * D * FF, FF, WSP(bf16_t, WS_WGU) + (size_t)l * 2 * FF * D, D, kb * 64, n0, (n0 / 128) * 256 + up * 128 + (n0 % 128), scr, lane); continue; }
        r -= 2 * I_G;
        { const int kb = r / 32, nb = r % 32; transpose_item(p.w_down + (size_t)l * FF * D, D, WSP(bf16_t, WS_WDN) + (size_t)l * D * FF, FF, kb * 64, nb * 32, nb * 32, scr, lane); }
    }
}

__device__ __forceinline__ void ph_adaln(const P& p, unsigned char* smem) {
    float* sc = (float*)smem;
    float* red = sc + NC * 256;
    const int tid = tidx(), col = tid & 31, kg = tid >> 5;
    float* MOD = WSP(float, WS_MOD);
    for (int it = blockIdx.x; it < NL * 192; it += gridDim.x) {
        const int l = it / 192, cb0 = (it % 192) * 32;
        float acc[NC];
#pragma unroll
        for (int r = 0; r < NC; ++r) acc[r] = 0.f;
        for (int kc = 0; kc < 4; ++kc) {
            __syncthreads();
            for (int e = tid; e < NC * 256; e += NTHR) { const int r = e >> 8, k = e & 255; const float c = r < PB ? p.c_prompt[r * D + kc * 256 + k] : p.c_sample[(r - PB) * D + kc * 256 + k]; sc[e] = silu_f(c); }
            __syncthreads();
            for (int kk = 0; kk < 16; ++kk) { const int k = kg * 16 + kk; const float w = p.ada_w[((size_t)l * D + kc * 256 + k) * 6144 + cb0 + col];
#pragma unroll
                for (int r = 0; r < NC; ++r) acc[r] += sc[r * 256 + k] * w; }
        }
#pragma unroll
        for (int r = 0; r < NC; ++r) red[(kg * NC + r) * 32 + col] = acc[r];
        __syncthreads();
        for (int e = tid; e < NC * 32; e += NTHR) { const int r = e >> 5, c = e & 31; float s = p.ada_b[l * 6144 + cb0 + c];
            for (int g = 0; g < 16; ++g) s += red[(g * NC + r) * 32 + c];
            MOD[((size_t)l * NC + r) * 6144 + cb0 + c] = s; }
        __syncthreads();
    }
}

__device__ __forceinline__ void ph_ropetab_copyx(const P& p) {
    const size_t gt = (size_t)blockIdx.x * NTHR + tidx(), ng = (size_t)gridDim.x * NTHR;
    float* tab = WSP(float, WS_ROPE);
    for (size_t e = gt; e < (size_t)NPOS * 32; e += ng) {
        const int pi = (int)(e >> 5), i = (int)(e & 31); const double pos = pi < T ? (double)pi : (double)(PAST + pi - T);
        const double ia = exp(-log(10000.0) * (double)i / 32.0), ir = exp(-log(10000.0) * (double)i / 31.0);
        tab[e] = (float)cos(pos * ia); tab[(size_t)NPOS * 32 + e] = (float)sin(pos * ia);
        tab[(size_t)2 * NPOS * 32 + e] = (float)cos(pos * ir); tab[(size_t)3 * NPOS * 32 + e] = (float)sin(pos * ir);
    }
    const f32x4* xp = (const f32x4*)p.x_prompt; const f32x4* xs = (const f32x4*)p.x_sample; f32x4* o = (f32x4*)p.out;
    for (size_t e = gt; e < (size_t)MP * D / 4; e += ng) o[e] = xp[e];
    for (size_t e = gt; e < (size_t)MS * D / 4; e += ng) o[(size_t)MP * D / 4 + e] = xs[e];
}

template <int WHICH> __device__ __forceinline__ void ph_norm_mod(const P& p, int l) {
    const int lane = tidx() & 63, wave = tidx() >> 6, gw = blockIdx.x * 8 + wave, ngw = gridDim.x * 8;
    const float* nw = (WHICH == 0 ? p.norm_mix : p.norm_ffn) + l * D;
    bf16_t* H = WSP(bf16_t, WS_H);
    for (int r = gw; r < M; r += ngw) {
        const float* xr = p.out + (size_t)r * D; const float* mod = WSP(float, WS_MOD) + ((size_t)l * NC + row_cb(r)) * 6144 + (WHICH == 0 ? 0 : 3072);
        f32x4 v[4]; float ss = 0.f;
#pragma unroll
        for (int j = 0; j < 4; ++j) { v[j] = *(const f32x4*)(xr + 4 * lane + 256 * j); ss += (v[j][0] * v[j][0] + v[j][1] * v[j][1]) + (v[j][2] * v[j][2] + v[j][3] * v[j][3]); }
        const float rstd = 1.0f / sqrtf(wave_sum(ss) * (1.0f / D) + EPS);
        float a8[8];
#pragma unroll
        for (int c = 0; c < 8; ++c) a8[c] = 0.f;
#pragma unroll
        for (int j = 0; j < 4; ++j) { const int k = 4 * lane + 256 * j;
            const f32x4 g = *(const f32x4*)(nw + k), sh = *(const f32x4*)(mod + k), sc = *(const f32x4*)(mod + 1024 + k);
            f32x4 h;
#pragma unroll
            for (int e = 0; e < 4; ++e) h[e] = v[j][e] * rstd * g[e] * (1.0f + sc[e]) + sh[e];
            u32x2 w; w.x = pk2(h[0], h[1]); w.y = pk2(h[2], h[3]); *(u32x2*)(H + (size_t)r * D + k) = w;
            if (WHICH == 0) {
#pragma unroll
                for (int e = 0; e < 4; ++e) { const float* wr = p.w_in + ((size_t)l * D + k + e) * INC + NPROJ; const f32x4 w0 = *(const f32x4*)wr, w1 = *(const f32x4*)(wr + 4);
#pragma unroll
                    for (int c = 0; c < 4; ++c) { a8[c] += h[e] * w0[c]; a8[4 + c] += h[e] * w1[c]; } }
            }
        }
        if (WHICH == 0) {
#pragma unroll
            for (int c = 0; c < 8; ++c) a8[c] = wave_sum(a8[c]);
            if (lane < 4) { float braw = lane == 0 ? a8[0] : lane == 1 ? a8[1] : lane == 2 ? a8[2] : a8[3]; WSP(float, WS_BETA)[(size_t)r * 4 + lane] = 1.0f / (1.0f + expf(-braw)); }
            else if (lane < 8) { const int hh = lane - 4; float araw = hh == 0 ? a8[4] : hh == 1 ? a8[5] : hh == 2 ? a8[6] : a8[7];
                const float xx = araw + p.dt_bias[l * 4 + hh]; const float sp = xx > 20.f ? xx : log1pf(expf(xx));
                WSP(float, WS_G)[(size_t)r * 4 + hh] = -expf(p.a_log[l * 4 + hh]) * sp; }
        }
    }
}

__device__ __forceinline__ void ph_rope_out(const P& p, int l) {
    const size_t gt = (size_t)blockIdx.x * NTHR + tidx(), ng = (size_t)gridDim.x * NTHR;
    bf16_t* PR = WSP(bf16_t, WS_PROJ); const float* tab = WSP(float, WS_ROPE);
    for (size_t e = gt; e < (size_t)M * 512; e += ng) {
        const int r = (int)(e >> 9), rem = (int)(e & 511), sec = rem >> 7, hh = (rem & 127) >> 5, d = rem & 31;
        if (sec >= 2 && r < MP) continue;
        const int off = sec == 0 ? C_QA : sec == 1 ? C_KA : sec == 2 ? C_QR : C_KR; const float scale = sec == 0 ? 0.125f * LOG2E : sec == 3 ? 0.125f : 1.0f;
        const float* ct = tab + (size_t)(sec >= 2 ? 2 : 0) * NPOS * 32 + (size_t)row_pi(r) * 32 + d; const float c = ct[0], s = ct[(size_t)NPOS * 32];
        bf16_t* x = PR + (size_t)r * NPROJ + off + hh * 64 + d; const float x1 = bf2f(x[0]), x2 = bf2f(x[32]);
        const float o1 = (x1 * c - x2 * s) * scale, o2 = (x1 * s + x2 * c) * scale;
        x[0] = f2bf(o1); x[32] = f2bf(o2);
        if (sec == 1) {
            if (r < MP) { const int b = r / T, t = r % T; bf16_t* kh = WSP(bf16_t, WS_KH) + ((size_t)(b * 4 + hh) * T + t) * 64 + d; kh[0] = f2bf(o1); kh[32] = f2bf(o2);
                if (t >= T - PWIN) { float* o = p.out + O_PWK + (((size_t)l * PB + b) * PWIN + (t - (T - PWIN))) * 256 + hh * 64 + d; o[0] = o1; o[32] = o2; } }
            else { const int b = (r - MP) / DS, i = (r - MP) % DS; float* o = p.out + O_SWK + (((size_t)l * DB + b) * DS + i) * 256 + hh * 64 + d; o[0] = o1; o[32] = o2; }
        }
    }
    for (size_t e = gt; e < (size_t)M * 256; e += ng) {
        const int r = (int)(e >> 8), c = (int)(e & 255); const float v = bf2f(PR[(size_t)r * NPROJ + C_VA + c]);
        if (r < MP) { const int b = r / T, t = r % T; if (t >= T - PWIN) p.out[O_PWV + (((size_t)l * PB + b) * PWIN + (t - (T - PWIN))) * 256 + c] = v; }
        else { const int b = (r - MP) / DS, i = (r - MP) % DS; p.out[O_SWV + (((size_t)l * DB + b) * DS + i) * 256 + c] = v; }
    }
    for (size_t e = gt; e < (size_t)(PB + DB) * 3 * 1536; e += ng) {
        const int c = (int)(e % 1536), j = (int)((e / 1536) % 3), bb = (int)(e / (3 * 1536));
        if (bb < PB) p.out[O_PCONV + (((size_t)l * PB + bb) * 3 + j) * 1536 + c] = bf2f(PR[(size_t)(bb * T + T - 3 + j) * NPROJ + C_CONV + c]);
        else { const int b = bb - PB; p.out[O_SCONV + (((size_t)l * DB + b) * 3 + j) * 1536 + c] = bf2f(PR[(size_t)(MP + b * DS + DS - 3 + j) * NPROJ + C_CONV + c]); }
    }
}

__device__ __forceinline__ void attn_wave_sample(const P& p, int l, int r, int h, int lane, float* sw  ) {
    const bf16_t* PR = WSP(bf16_t, WS_PROJ);
    const int b = (r - MP) / DS; const int tq = WB + (r - MP) % DS;
    float q[64];
    { const bf16_t* qp = PR + (size_t)r * NPROJ + C_QA + h * 64;
#pragma unroll
      for (int j = 0; j < 8; ++j) { const bf16x8 v = *(const bf16x8*)(qp + 8 * j);
#pragma unroll
          for (int e = 0; e < 8; ++e) q[8 * j + e] = bf2f((bf16_t)v[e]); } }
    float mx = -INFINITY;
#pragma unroll 1
    for (int i = 0; i < 7; ++i) {
        const int e = lane + 64 * i;
        if (e < 387) { const int pat = e / 129, j = e % 129, dil = pat == 0 ? 1 : pat == 1 ? 4 : 16; const int rr = tq - dil * j;
            float a = 0.f;
            if (rr < WB) { const float* kp = p.cache_k + ((((size_t)l * DB + b) * WB + rr) * 4 + h) * 64;
#pragma unroll
                for (int j4 = 0; j4 < 16; ++j4) { const f32x4 kv = *(const f32x4*)(kp + 4 * j4); a += q[4 * j4] * kv[0] + q[4 * j4 + 1] * kv[1] + q[4 * j4 + 2] * kv[2] + q[4 * j4 + 3] * kv[3]; } }
            else { const bf16_t* kp = PR + (size_t)(MP + b * DS + (rr - WB)) * NPROJ + C_KA + h * 64;
#pragma unroll
                for (int j8 = 0; j8 < 8; ++j8) { const bf16x8 kv = *(const bf16x8*)(kp + 8 * j8);
#pragma unroll
                    for (int e2 = 0; e2 < 8; ++e2) a += q[8 * j8 + e2] * bf2f((bf16_t)kv[e2]); } }
            sw[e] = a; mx = fmaxf(mx, a); }
    }
    mx = wave_max(mx);
    float lsum = 0.f;
#pragma unroll 1
    for (int i = 0; i < 7; ++i) { const int e = lane + 64 * i; if (e < 387) { const float pe = exp2f(sw[e] - mx); sw[e] = pe; lsum += pe; } }
    lsum = wave_sum(lsum);
    WAVE_SYNC();
    const int kg = lane >> 4, dq = lane & 15; f32x4 o4 = (f32x4){0.f, 0.f, 0.f, 0.f};
#pragma unroll 8
    for (int e = kg; e < 387; e += 4) {
        const float pe = sw[e];
        const int pat = e / 129, j = e % 129, dil = pat == 0 ? 1 : pat == 1 ? 4 : 16; const int rr = tq - dil * j;
        f32x4 v;
        if (rr < WB) v = *(const f32x4*)(p.cache_v + ((((size_t)l * DB + b) * WB + rr) * 4 + h) * 64 + 4 * dq);
        else { const u32x2 w = *(const u32x2*)(PR + (size_t)(MP + b * DS + (rr - WB)) * NPROJ + C_VA + h * 64 + 4 * dq);
            v = (f32x4){bf2f((bf16_t)(w.x & 0xffff)), bf2f((bf16_t)(w.x >> 16)), bf2f((bf16_t)(w.y & 0xffff)), bf2f((bf16_t)(w.y >> 16))}; }
        o4 += pe * v;
    }
#pragma unroll
    for (int e = 0; e < 4; ++e) { float x = o4[e]; x += __shfl_xor(x, 16); x += __shfl_xor(x, 32); o4[e] = x; }
    WAVE_SYNC();
    if (kg == 0) { const float inv = 1.0f / lsum; u32x2 w; w.x = pk2(o4[0] * inv, o4[1] * inv); w.y = pk2(o4[2] * inv, o4[3] * inv);
        *(u32x2*)(WSP(bf16_t, WS_O) + (size_t)r * D + h * 64 + 4 * dq) = w; }
}
__device__ __forceinline__ void ph_attn_sample(const P& p, int l, unsigned char* smem) {
    const int lane = tidx() & 63, wave = tidx() >> 6, gw = (gridDim.x - 1 - blockIdx.x) * 8 + wave, ngw = gridDim.x * 8;
    float* sw = (float*)smem + wave * 392;
    for (int it = gw; it < MS * 4; it += ngw) attn_wave_sample(p, l, MP + (it >> 2), it & 3, lane, sw);
}
__device__ __forceinline__ bf16x8 pack8(const f32x16& v, int s8) {
    u32x4 w; w.x = pk2(v[s8], v[s8 + 1]); w.y = pk2(v[s8 + 2], v[s8 + 3]); w.z = pk2(v[s8 + 4], v[s8 + 5]); w.w = pk2(v[s8 + 6], v[s8 + 7]); return __builtin_bit_cast(bf16x8, w);
}
__device__ __forceinline__ void attn_job(const P& p, int jb, int lane) {
    const int c = lane & 31, hi = lane >> 5;
    constexpr int NB = T / 512;
    const int unit = jb / 48, jj = jb % 48, pat = jj >> 4, sub = jj & 15;
    const int blk = unit % NB, h = (unit / NB) & 3, b = unit / (NB * 4), bh = b * 4 + h;
    int dil, r, qi0; const bf16_t* VT;
    if (pat == 0) { dil = 1; r = 0; qi0 = blk * 512 + sub * 32; VT = WSP(bf16_t, WS_VT1) + (size_t)bh * 64 * T; }
    else if (pat == 1) { dil = 4; r = sub >> 2; qi0 = blk * 128 + (sub & 3) * 32; VT = WSP(bf16_t, WS_VT4) + (size_t)(bh * 4 + r) * 64 * (T / 4); }
    else { dil = 16; r = sub; qi0 = blk * 32; VT = WSP(bf16_t, WS_VT16) + (size_t)(bh * 16 + r) * 64 * (T / 16); }
    const int SL = T / dil;
    const int tq = dil * (qi0 + c) + r;
    const bf16_t* qp = WSP(bf16_t, WS_PROJ) + (size_t)(b * T + tq) * NPROJ + C_QA + h * 64 + 8 * hi;
    bf16x8 qf[4];
#pragma unroll
    for (int ks = 0; ks < 4; ++ks) qf[ks] = *(const bf16x8*)(qp + 16 * ks);
    const bf16_t* KHb = WSP(bf16_t, WS_KH) + (size_t)bh * T * 64;
    f32x16 S[5];
#pragma unroll
    for (int i = 0; i < 5; ++i) {
        const int kt0 = qi0 - 128 + 32 * i;
        f32x16 acc;
#pragma unroll
        for (int e = 0; e < 16; ++e) acc[e] = 0.f;
        if (kt0 >= 0) { const bf16_t* kp = KHb + (size_t)(dil * (kt0 + c) + r) * 64 + 8 * hi;
#pragma unroll
            for (int ks = 0; ks < 4; ++ks) acc = MFMA32(*(const bf16x8*)(kp + 16 * ks), qf[ks], acc);
            if (i == 0) {
#pragma unroll
                for (int e = 0; e < 16; ++e) { const int krow = (e & 3) + 8 * (e >> 2) + 4 * hi; if (krow < c) acc[e] = -INFINITY; } }
            if (i == 4) {
#pragma unroll
                for (int e = 0; e < 16; ++e) { const int krow = (e & 3) + 8 * (e >> 2) + 4 * hi; if (krow > c) acc[e] = -INFINITY; } }
        } else {
#pragma unroll
            for (int e = 0; e < 16; ++e) acc[e] = -INFINITY; }
        S[i] = acc;
    }
    float mx = -INFINITY;
#pragma unroll
    for (int i = 0; i < 5; ++i)
#pragma unroll
        for (int e = 0; e < 16; ++e) mx = fmaxf(mx, S[i][e]);
    mx = fmaxf(mx, __shfl_xor(mx, 32));
    float lsum = 0.f;
#pragma unroll
    for (int i = 0; i < 5; ++i)
#pragma unroll
        for (int e = 0; e < 16; ++e) { const float pe = exp2f(S[i][e] - mx); S[i][e] = pe; lsum += pe; }
    lsum += __shfl_xor(lsum, 32);
    f32x16 O[2];
#pragma unroll
    for (int dt = 0; dt < 2; ++dt)
#pragma unroll
        for (int e = 0; e < 16; ++e) O[dt][e] = 0.f;
#pragma unroll
    for (int i = 0; i < 5; ++i) {
        const int kt0 = qi0 - 128 + 32 * i;
        if (kt0 >= 0) {
#pragma unroll
            for (int s2 = 0; s2 < 2; ++s2) { const bf16x8 pf = pack8(S[i], 8 * s2);
#pragma unroll
                for (int dt = 0; dt < 2; ++dt) { const bf16_t* vp = VT + (size_t)(dt * 32 + c) * SL + kt0 + 16 * s2 + 4 * hi;
                    const u32x2 lo = *(const u32x2*)vp, hh = *(const u32x2*)(vp + 8); u32x4 w; w.x = lo.x; w.y = lo.y; w.z = hh.x; w.w = hh.y;
                    O[dt] = MFMA32(__builtin_bit_cast(bf16x8, w), pf, O[dt]); } }
        }
    }
    const size_t idx = ((size_t)(b * T + tq) * 4 + h) * 3 + pat;
    bf16_t* po = WSP(bf16_t, WS_APO) + idx * 64;
#pragma unroll
    for (int dt = 0; dt < 2; ++dt)
#pragma unroll
        for (int g = 0; g < 4; ++g) { u32x2 w; w.x = pk2(O[dt][4 * g], O[dt][4 * g + 1]); w.y = pk2(O[dt][4 * g + 2], O[dt][4 * g + 3]); *(u32x2*)(po + 32 * dt + 8 * g + 4 * hi) = w; }
    if (hi == 0) { float* ml = WSP(float, WS_AML) + idx * 2; ml[0] = mx; ml[1] = lsum; }
}
__device__ __forceinline__ void ph_attn_jobs(const P& p) {
    const int lane = tidx() & 63, wave = tidx() >> 6, gw = blockIdx.x * 8 + wave, ngw = gridDim.x * 8;
    for (int jb = gw; jb < PB * 4 * (T / 512) * 48; jb += ngw) attn_job(p, jb, lane);
}
__device__ __forceinline__ void ph_attn_combine(const P& p) {
    const size_t gt = (size_t)blockIdx.x * NTHR + tidx(), ng = (size_t)gridDim.x * NTHR;
    for (size_t e = gt; e < (size_t)MP * 4 * 16; e += ng) {
        const size_t rh = e >> 4; const int dq = (int)(e & 15) * 4;
        const float* ml = WSP(float, WS_AML) + rh * 6; const float m0 = ml[0], m1 = ml[2], m2 = ml[4];
        const float mm = fmaxf(m0, fmaxf(m1, m2)); const float w0 = exp2f(m0 - mm), w1 = exp2f(m1 - mm), w2 = exp2f(m2 - mm);
        const float inv = 1.0f / (w0 * ml[1] + w1 * ml[3] + w2 * ml[5]);
        const bf16_t* po = WSP(bf16_t, WS_APO) + rh * 192 + dq;
        const u32x2 a = *(const u32x2*)po, bq = *(const u32x2*)(po + 64), cq = *(const u32x2*)(po + 128);
        float o[4];
        o[0] = w0 * bf2f((bf16_t)(a.x & 0xffff)) + w1 * bf2f((bf16_t)(bq.x & 0xffff)) + w2 * bf2f((bf16_t)(cq.x & 0xffff));
        o[1] = w0 * bf2f((bf16_t)(a.x >> 16)) + w1 * bf2f((bf16_t)(bq.x >> 16)) + w2 * bf2f((bf16_t)(cq.x >> 16));
        o[2] = w0 * bf2f((bf16_t)(a.y & 0xffff)) + w1 * bf2f((bf16_t)(bq.y & 0xffff)) + w2 * bf2f((bf16_t)(cq.y & 0xffff));
        o[3] = w0 * bf2f((bf16_t)(a.y >> 16)) + w1 * bf2f((bf16_t)(bq.y >> 16)) + w2 * bf2f((bf16_t)(cq.y >> 16));
        const size_t row = rh >> 2; const int h = (int)(rh & 3);
        u32x2 w; w.x = pk2(o[0] * inv, o[1] * inv); w.y = pk2(o[2] * inv, o[3] * inv);
        *(u32x2*)(WSP(bf16_t, WS_O) + row * D + h * 64 + dq) = w;
    }
}
__device__ __forceinline__ float ret_lg(int h) { return logf(1.0f - exp2f(-5.0f - (float)h)); }
__device__ __forceinline__ void trans_write(const bf16_t* tile, bf16_t* dst  , int tile0, int tid) {
#pragma unroll
    for (int k = 0; k < 4; ++k) { const int ch = tid + NTHR * k, d = ch >> 5, t0 = (ch & 31) * 8; u32x4 w;
        w.x = (unsigned)tile[(t0 + 0) * 72 + d] | ((unsigned)tile[(t0 + 1) * 72 + d] << 16); w.y = (unsigned)tile[(t0 + 2) * 72 + d] | ((unsigned)tile[(t0 + 3) * 72 + d] << 16);
        w.z = (unsigned)tile[(t0 + 4) * 72 + d] | ((unsigned)tile[(t0 + 5) * 72 + d] << 16); w.w = (unsigned)tile[(t0 + 6) * 72 + d] | ((unsigned)tile[(t0 + 7) * 72 + d] << 16);
        *(u32x4*)(dst + (size_t)d * T + tile0 + t0) = w; }
}
__device__ __forceinline__ void ph_vtrans(const P& p, unsigned char* smem) {
    bf16_t* vt = (bf16_t*)smem; bf16_t* vr = vt + 256 * 72; bf16_t* kt = vr + 256 * 72;
    const int tid = tidx(); bf16_t* PR = WSP(bf16_t, WS_PROJ); const float* tab = WSP(float, WS_ROPE);
    for (int u = blockIdx.x; u < PB * 4 * (T / 256); u += gridDim.x) {
        const int tile = u % (T / 256), bh = u / (T / 256), h = bh & 3, b = bh >> 2; const float lg = ret_lg(h);
        __syncthreads();
#pragma unroll
        for (int k = 0; k < 4; ++k) { const int ch = tid + NTHR * k, t = ch >> 3, d8 = (ch & 7) * 8; const bf16_t* src = PR + (size_t)(b * T + tile * 256 + t) * NPROJ + h * 64 + d8;
            *(u32x4*)(vt + t * 72 + d8) = *(const u32x4*)(src + C_VA); *(u32x4*)(vr + t * 72 + d8) = *(const u32x4*)(src + C_VR); }
#pragma unroll 4
        for (int k = 0; k < 16; ++k) { const int e = tid + NTHR * k, t = e >> 5, d = e & 31, tt = tile * 256 + t; bf16_t* row = PR + (size_t)(b * T + tt) * NPROJ + h * 64 + d;
            const float c = tab[(size_t)2 * NPOS * 32 + (size_t)tt * 32 + d], sn = tab[(size_t)3 * NPOS * 32 + (size_t)tt * 32 + d]; const float gq = expf(lg * (float)(tt & 63)), gk = 0.125f / gq;
            { const float x1 = bf2f(row[C_QR]), x2 = bf2f(row[C_QR + 32]); row[C_QR] = f2bf((x1 * c - x2 * sn) * gq); row[C_QR + 32] = f2bf((x1 * sn + x2 * c) * gq); }
            { const float x1 = bf2f(row[C_KR]), x2 = bf2f(row[C_KR + 32]); const bf16_t o1 = f2bf((x1 * c - x2 * sn) * gk), o2 = f2bf((x1 * sn + x2 * c) * gk);
              row[C_KR] = o1; row[C_KR + 32] = o2; kt[t * 72 + d] = o1; kt[t * 72 + d + 32] = o2; } }
        __syncthreads();
        trans_write(vt, WSP(bf16_t, WS_VT1) + (size_t)bh * 64 * T, tile * 256, tid);
        trans_write(vr, WSP(bf16_t, WS_VRT) + (size_t)bh * 64 * T, tile * 256, tid);
        trans_write(kt, WSP(bf16_t, WS_KRT) + (size_t)bh * 64 * T, tile * 256, tid);
#pragma unroll
        for (int k = 0; k < 4; ++k) { const int ch = tid + NTHR * k;
            { const int r = ch >> 9, d = (ch >> 3) & 63, s0 = (ch & 7) * 8; u32x4 w;
#define VT4E(e_) ((unsigned)vt[(4 * (s0 + (e_)) + r) * 72 + d])
              w.x = VT4E(0) | (VT4E(1) << 16); w.y = VT4E(2) | (VT4E(3) << 16); w.z = VT4E(4) | (VT4E(5) << 16); w.w = VT4E(6) | (VT4E(7) << 16);
#undef VT4E
              *(u32x4*)(WSP(bf16_t, WS_VT4) + ((size_t)(bh * 4 + r) * 64 + d) * (T / 4) + tile * 64 + s0) = w; }
            { const int r = ch >> 7, d = (ch >> 1) & 63, s0 = (ch & 1) * 8; u32x4 w;
#define VT16E(e_) ((unsigned)vt[(16 * (s0 + (e_)) + r) * 72 + d])
              w.x = VT16E(0) | (VT16E(1) << 16); w.y = VT16E(2) | (VT16E(3) << 16); w.z = VT16E(4) | (VT16E(5) << 16); w.w = VT16E(6) | (VT16E(7) << 16);
#undef VT16E
              *(u32x4*)(WSP(bf16_t, WS_VT16) + ((size_t)(bh * 16 + r) * 64 + d) * (T / 16) + tile * 16 + s0) = w; }
        }
    }
}

__device__ __forceinline__ void ph_ret_local(const P& p, int l) {
    const int tid = tidx(), lane = tid & 63, wave = tid >> 6, x = lane & 15, q = lane >> 4, dt = wave >> 1;
    for (int u = blockIdx.x; u < NUNIT; u += gridDim.x) {
        const int n = u % NCH, bh = u / NCH, h = bh & 3, t0 = n * 64; const float g63 = expf(ret_lg(h) * 63.0f);
        const bf16_t* ka = WSP(bf16_t, WS_KRT) + ((size_t)bh * 64 + 16 * dt + x) * T + t0 + 8 * q;
#pragma unroll
        for (int k = 0; k < 2; ++k) { const int et = 2 * (wave & 1) + k; const bf16_t* vb = WSP(bf16_t, WS_VRT) + ((size_t)bh * 64 + 16 * et + x) * T + t0 + 8 * q;
            f32x4 acc = (f32x4){0.f, 0.f, 0.f, 0.f};
#pragma unroll
            for (int ks = 0; ks < 2; ++ks) acc = MFMA16(*(const bf16x8*)(ka + 32 * ks), *(const bf16x8*)(vb + 32 * ks), acc);
            *(f32x4*)(WSP(float, WS_RU) + (size_t)u * 4096 + (16 * et + x) * 64 + 16 * dt + 4 * q) = acc * g63; }
    }
}
__device__ __forceinline__ void ph_ret_scan(const P& p, int l) {
    const int gt = blockIdx.x * NTHR + tidx(), ng = gridDim.x * NTHR;
    for (int e = gt; e < PB * 4 * 4096; e += ng) {
        const int bh = e >> 12, ed = e & 4095, h = bh & 3; const float cd = expf(ret_lg(h) * 64.0f);
        const float* U = WSP(float, WS_RU) + (size_t)bh * NCH * 4096 + ed; bf16_t* SPv = WSP(bf16_t, WS_RS) + (size_t)bh * NCH * 4096 + ed;
        float s = 0.f;
        for (int n0 = 0; n0 < NCH; n0 += 8) {
            float uv[8];
#pragma unroll
            for (int k = 0; k < 8; ++k) uv[k] = U[(size_t)(n0 + k) * 4096];
#pragma unroll
            for (int k = 0; k < 8; ++k) { SPv[(size_t)(n0 + k) * 4096] = f2bf(s); s = s * cd + uv[k]; } }
        p.out[O_PRET + ((size_t)l * PB * 4 + bh) * 4096 + (ed & 63) * 64 + (ed >> 6)] = s;
    }
}
__device__ __forceinline__ void ph_ret_out(const P& p, int l) {
    const int tid = tidx(), lane = tid & 63, wave = tid >> 6, x = lane & 15, q = lane >> 4, it = UNIFORM(wave & 3);
    const bf16_t* PR = WSP(bf16_t, WS_PROJ);
    for (int u = blockIdx.x * 2 + (wave >> 2); u < NUNIT; u += gridDim.x * 2) {
        const int n = u % NCH, bh = u / NCH, h = bh & 3, b = bh >> 2, t0 = n * 64; const float gam = expf(ret_lg(h));
        const size_t rowi = (size_t)(b * T + t0 + 16 * it + x);
        bf16x8 qf[2];
#pragma unroll
        for (int ks = 0; ks < 2; ++ks) qf[ks] = *(const bf16x8*)(PR + rowi * NPROJ + C_QR + h * 64 + 32 * ks + 8 * q);
        f32x4 at[4];
#pragma unroll
        for (int jt = 0; jt < 4; ++jt) { at[jt] = (f32x4){0.f, 0.f, 0.f, 0.f};
            if (jt <= it) { const bf16_t* kp = PR + (size_t)(b * T + t0 + 16 * jt + x) * NPROJ + C_KR + h * 64 + 8 * q;
#pragma unroll
                for (int ks = 0; ks < 2; ++ks) at[jt] = MFMA16(*(const bf16x8*)(kp + 32 * ks), qf[ks], at[jt]);
                if (jt == it) {
#pragma unroll
                    for (int e = 0; e < 4; ++e) if (4 * q + e > x) at[jt][e] = 0.f; } } }
        const bf16x8 pb0 = pack_tiles(at[0], at[1]), pb1 = pack_tiles(at[2], at[3]);
        f32x4 o[4], os[4];
#pragma unroll
        for (int et = 0; et < 4; ++et) { o[et] = (f32x4){0.f, 0.f, 0.f, 0.f}; os[et] = (f32x4){0.f, 0.f, 0.f, 0.f};
            const bf16_t* vp = WSP(bf16_t, WS_VRT) + ((size_t)bh * 64 + 16 * et + x) * T + t0 + 4 * q;
            { const u32x2 lo = *(const u32x2*)vp, hi = *(const u32x2*)(vp + 16); u32x4 w; w.x = lo.x; w.y = lo.y; w.z = hi.x; w.w = hi.y; o[et] = MFMA16(__builtin_bit_cast(bf16x8, w), pb0, o[et]); }
            if (it >= 2) { const u32x2 lo = *(const u32x2*)(vp + 32), hi = *(const u32x2*)(vp + 48); u32x4 w; w.x = lo.x; w.y = lo.y; w.z = hi.x; w.w = hi.y; o[et] = MFMA16(__builtin_bit_cast(bf16x8, w), pb1, o[et]); }
            const bf16_t* sp = WSP(bf16_t, WS_RS) + (size_t)u * 4096 + (16 * et + x) * 64 + 8 * q;
#pragma unroll
            for (int ks = 0; ks < 2; ++ks) os[et] = MFMA16(*(const bf16x8*)(sp + 32 * ks), qf[ks], os[et]);
            o[et] = o[et] + os[et] * gam; }
        float sq = 0.f;
#pragma unroll
        for (int et = 0; et < 4; ++et) sq += (o[et][0] * o[et][0] + o[et][1] * o[et][1]) + (o[et][2] * o[et][2] + o[et][3] * o[et][3]);
        sq += __shfl_xor(sq, 16); sq += __shfl_xor(sq, 32);
        const float rstd = 1.0f / sqrtf(sq * (1.0f / 64.0f) + EPS);
#pragma unroll
        for (int et = 0; et < 4; ++et) { const int e0 = 16 * et + 4 * q; const u32x2 gw = *(const u32x2*)(PR + rowi * NPROJ + C_GR + h * 64 + e0); const f32x4 nw = *(const f32x4*)(p.ret_norm + l * 64 + e0);
            const float g0 = bf2f((bf16_t)(gw.x & 0xffff)), g1 = bf2f((bf16_t)(gw.x >> 16)), g2 = bf2f((bf16_t)(gw.y & 0xffff)), g3 = bf2f((bf16_t)(gw.y >> 16));
            u32x2 w; w.x = pk2(o[et][0] * rstd * nw[0] * silu_f(g0), o[et][1] * rstd * nw[1] * silu_f(g1)); w.y = pk2(o[et][2] * rstd * nw[2] * silu_f(g2), o[et][3] * rstd * nw[3] * silu_f(g3));
            *(u32x2*)(WSP(bf16_t, WS_O) + rowi * D + 256 + h * 64 + e0) = w; }
    }
}
__device__ __forceinline__ void ph_ret_sample(const P& p, int l, unsigned char* smem) {
    float* S0 = (float*)smem; float* qs = S0 + 4096; float* ks = qs + 8 * 64; float* vs = ks + 8 * 64;
    const int tid = tidx(); const bf16_t* PR = WSP(bf16_t, WS_PROJ);
    for (int u = gridDim.x - 1 - blockIdx.x; u < DB * 4; u += gridDim.x) {
        const int h = u & 3, b = u >> 2; const float lg = ret_lg(h);
        __syncthreads();
        for (int e = tid; e < 4096; e += NTHR) S0[e] = p.state_ret[(((size_t)l * DB + b) * 4 + h) * 4096 + e];
        { const int j = tid >> 6, d = tid & 63; const size_t row = (size_t)(MP + b * DS + j) * NPROJ;
          qs[tid] = bf2f(PR[row + C_QR + h * 64 + d]); ks[tid] = bf2f(PR[row + C_KR + h * 64 + d]); vs[tid] = bf2f(PR[row + C_VR + h * 64 + d]); }
        __syncthreads();
        { const int i = tid >> 6, e = tid & 63; float o = 0.f;
          for (int j = 0; j <= i; ++j) { float a = 0.f; for (int d = 0; d < 64; ++d) a += qs[i * 64 + d] * ks[j * 64 + d]; o += a * expf(lg * (float)(i - j)) * vs[j * 64 + e]; }
          float o2 = 0.f; for (int d = 0; d < 64; ++d) o2 += qs[i * 64 + d] * S0[d * 64 + e];
          o += o2 * expf(lg * (float)(i + 1));
          const float rstd = 1.0f / sqrtf(wave_sum(o * o) * (1.0f / 64.0f) + EPS);
          const size_t row = (size_t)(MP + b * DS + i); const float g = bf2f(PR[row * NPROJ + C_GR + h * 64 + e]);
          WSP(bf16_t, WS_O)[row * D + 256 + h * 64 + e] = f2bf(o * rstd * p.ret_norm[l * 64 + e] * silu_f(g)); }
        for (int x = tid; x < 4096; x += NTHR) { const int d = x >> 6, e = x & 63; float s = S0[x] * expf(lg * (float)DS);
            for (int j = 0; j < DS; ++j) s += ks[j * 64 + d] * expf(lg * (float)(DS - 1 - j)) * vs[j * 64 + e];
            p.out[O_SRET + (((size_t)l * DB + b) * 4 + h) * 4096 + x] = s; }
    }
}

template <int CS, int LDL> __device__ __forceinline__ void fwd_subst(float (&X)[CS], const float* Ls) {
#pragma unroll
    for (int i = 1; i < CS; ++i) {
        float a = X[i];
#pragma unroll
        for (int j4 = 0; j4 < (i + 3) / 4; ++j4) { const f32x4 lv = *(const f32x4*)(Ls + i * LDL + 4 * j4);
#pragma unroll
            for (int e = 0; e < 4; ++e) if (4 * j4 + e < i) a -= lv[e] * X[4 * j4 + e]; }
        X[i] = a;
    }
}
constexpr int QP = 132;
constexpr int WSTP = 136;
constexpr int RWP = 392, TP = 136;
__device__ __forceinline__ void ph_gdn_prep(const P& p, int l, unsigned char* smem) {
    float* Ls = (float*)smem; float* As = Ls + 64 * 68; float* gs = As + 64 * 68; float* gcs = gs + 64; float* bts = gcs + 64; float* part = bts + 64;
    bf16_t* raw = (bf16_t*)(part + 4 * 64); bf16_t* Khi = raw + 67 * RWP; bf16_t* Klo = Khi + 64 * TP; bf16_t* Qb = Klo + 64 * TP;
    static_assert((64 * 68 * 2 + 64 * 3 + 4 * 64) * 4 + (67 * RWP + 3 * 64 * TP) * 2 <= BAR_LDS_OFF, "gdn_prep LDS");
    const int tid = tidx(), lane = tid & 63, wave = tid >> 6; const bf16_t* PR = WSP(bf16_t, WS_PROJ);
    for (int u = blockIdx.x; u < NUNIT; u += gridDim.x) {
        const int n = u % NCH, h = (u / NCH) % 4, b = u / (NCH * 4), t0 = n * 64;
        __syncthreads();
        for (int e = tid; e < 67 * 48; e += NTHR) { const int row = e / 48, ch = e % 48, t = t0 - 3 + row; u32x4 v = (u32x4){0u, 0u, 0u, 0u};
            if (t >= 0) v = *(const u32x4*)(PR + (size_t)(b * T + t) * NPROJ + C_CONV + (ch >> 4) * 512 + h * 128 + (ch & 15) * 8);
            *(u32x4*)(raw + row * RWP + ch * 8) = v; }
        if (tid >= 384 && tid < 448) { const int i = tid - 384; const size_t row = (size_t)(b * T + t0 + i); gs[i] = WSP(float, WS_G)[row * 4 + h]; bts[i] = WSP(float, WS_BETA)[row * 4 + h]; }
        __syncthreads();
        float y[64]; const int sec = tid < 128 ? 2 : tid < 256 ? 1 : 0, c = tid & 127;
        if (tid < 384) { const int col = sec * 512 + h * 128 + c;
            const float w0 = p.conv_w[(l * 4 + 0) * 1536 + col], w1 = p.conv_w[(l * 4 + 1) * 1536 + col], w2 = p.conv_w[(l * 4 + 2) * 1536 + col], w3 = p.conv_w[(l * 4 + 3) * 1536 + col];
            const LAS bf16_t* rp = (const LAS bf16_t*)raw + sec * 128 + c; LAUNDER_V(rp); float x0 = bf2f(rp[0]), x1 = bf2f(rp[RWP]), x2 = bf2f(rp[2 * RWP]);
#pragma unroll
            for (int i = 0; i < 64; ++i) { const float x3 = bf2f(rp[(i + 3) * RWP]); y[i] = silu_fast(w0 * x0 + w1 * x1 + w2 * x2 + w3 * x3); x0 = x1; x1 = x2; x2 = x3; if ((i & 7) == 7) COMPILER_FENCE(); } }
        if (tid == 448) { float a = 0.f; for (int i = 0; i < 64; ++i) { a += gs[i]; gcs[i] = a; } }
        if (tid >= 128 && tid < 384) {
#pragma unroll
            for (int i = 0; i < 64; ++i) { const float s = wave_sum(y[i] * y[i]); if (lane == 0) part[(wave - 2) * 64 + i] = s; if ((i & 7) == 7) COMPILER_FENCE(); } }
        __syncthreads();
        if (tid >= 128 && tid < 256) { const float gl = gcs[63]; LAS bf16_t* kh = (LAS bf16_t*)Khi + c; LAS bf16_t* kl = (LAS bf16_t*)Klo + c; LAUNDER_V(kh); LAUNDER_V(kl);
#pragma unroll
            for (int i = 0; i < 64; ++i) { const float v = y[i] / sqrtf(part[i] + part[64 + i] + EPS); y[i] = v; const bf16_t hb = f2bf(v); kh[i * TP] = hb; kl[i * TP] = f2bf(v - bf2f(hb)); if ((i & 7) == 7) COMPILER_FENCE(); }
            bf16_t* dst = WSP(bf16_t, WS_GWK) + (size_t)u * 16384 + 8192; const int mt = c >> 4, x = c & 15;
#pragma unroll
            for (int ks2 = 0; ks2 < 2; ++ks2)
#pragma unroll
                for (int q = 0; q < 4; ++q) { const int i0 = 32 * ks2 + 4 * q; float v[8];
#pragma unroll
                    for (int e = 0; e < 8; ++e) { const int i = i0 + (e < 4 ? e : 12 + e); v[e] = y[i] * expf(gl - gcs[i]); }
                    u32x4 w; w.x = pk2(v[0], v[1]); w.y = pk2(v[2], v[3]); w.z = pk2(v[4], v[5]); w.w = pk2(v[6], v[7]);
                    *(u32x4*)(dst + ((size_t)((mt * 2 + ks2) * 64 + q * 16 + x)) * 8) = w; COMPILER_FENCE(); } }
        else if (tid >= 256 && tid < 384) { bf16_t* qg = WSP(bf16_t, WS_GQ) + (size_t)u * 8192 + c; LAS bf16_t* qb = (LAS bf16_t*)Qb + c; LAUNDER_V(qb);
#pragma unroll
            for (int i = 0; i < 64; ++i) { const float v = y[i] / sqrtf(part[128 + i] + part[192 + i] + EPS); qb[i * TP] = f2bf(v); qg[(i & 7) * 128] = f2bf(v * 0.08838834764831845f * expf(gcs[i])); if ((i & 7) == 7) { qg += 8 * 128; LAUNDER_V(qg); COMPILER_FENCE(); } } }
        __syncthreads();
#pragma unroll
        for (int tp = 0; tp < 2; ++tp) { const int pos = wave * 2 + tp, it = pos >> 2, jt = pos & 3, j16 = lane & 15, qd = lane >> 4;
            f32x4 lk = (f32x4){0.f, 0.f, 0.f, 0.f}, aq = (f32x4){0.f, 0.f, 0.f, 0.f};
            if (jt <= it) {
#pragma unroll
                for (int ks = 0; ks < 4; ++ks) { const int ao = (16 * it + j16) * TP + 32 * ks + 8 * qd, bo = (16 * jt + j16) * TP + 32 * ks + 8 * qd;
                    const bf16x8 ah = *(const bf16x8*)(Khi + ao), al = *(const bf16x8*)(Klo + ao), aqf = *(const bf16x8*)(Qb + ao), bh = *(const bf16x8*)(Khi + bo), bl = *(const bf16x8*)(Klo + bo);
                    lk = MFMA16(ah, bh, lk); lk = MFMA16(ah, bl, lk); lk = MFMA16(al, bh, lk); aq = MFMA16(aqf, bh, aq); } }
            const int j = 16 * jt + j16;
#pragma unroll
            for (int e = 0; e < 4; ++e) { const int i = 16 * it + 4 * qd + e; const float ex = j <= i ? expf(gcs[i] - gcs[j]) : 0.f;
                Ls[i * 68 + j] = j < i ? bts[i] * lk[e] * ex : 0.f; As[i * 68 + j] = aq[e] * ex * 0.08838834764831845f; } }
        __syncthreads();
        if (tid < 256) {
            if (tid < 128) {
#pragma unroll
                for (int i = 0; i < 64; ++i) { y[i] *= bts[i]; if ((i & 15) == 15) COMPILER_FENCE(); } }
            else {
#pragma unroll
                for (int i = 0; i < 64; ++i) { y[i] *= bts[i] * expf(gcs[i]); if ((i & 7) == 7) COMPILER_FENCE(); } }
            fwd_subst<64, 68>(y, Ls);
            if (tid < 128) { bf16_t* U = WSP(bf16_t, WS_GU) + (size_t)u * 8192 + c * 64;
#pragma unroll
                for (int i8 = 0; i8 < 8; ++i8) { u32x4 w; w.x = pk2(y[8 * i8], y[8 * i8 + 1]); w.y = pk2(y[8 * i8 + 2], y[8 * i8 + 3]); w.z = pk2(y[8 * i8 + 4], y[8 * i8 + 5]); w.w = pk2(y[8 * i8 + 6], y[8 * i8 + 7]); *(u32x4*)(U + 8 * i8) = w; } }
            else { LAS bf16_t* wst = (LAS bf16_t*)raw + c; LAUNDER_V(wst);
#pragma unroll
                for (int i = 0; i < 64; ++i) wst[i * WSTP] = f2bf(-y[i]); }
        } else { const int t2 = tid - 256;
#pragma unroll 2
            for (int e = t2; e < 4096; e += 256) WSP(bf16_t, WS_GA)[(size_t)u * 4096 + e] = f2bf(As[(e >> 6) * 68 + (e & 63)]);
            if (t2 == 0) WSP(float, WS_GD)[u] = expf(gcs[63]); }
        __syncthreads();
        { bf16_t* dst = WSP(bf16_t, WS_GWK) + (size_t)u * 16384; const bf16_t* wst = raw;
#pragma unroll
          for (int k = 0; k < 2; ++k) { const int f = tid + NTHR * k, ln = f & 63, ks4 = (f >> 6) & 3, mt = f >> 8, q = ln >> 4, x = ln & 15;
              const bf16_t* wr = wst + (16 * mt + x) * WSTP + 32 * ks4 + 4 * q;
              u32x4 w; w.x = (unsigned)wr[0] | ((unsigned)wr[1] << 16); w.y = (unsigned)wr[2] | ((unsigned)wr[3] << 16); w.z = (unsigned)wr[16] | ((unsigned)wr[17] << 16); w.w = (unsigned)wr[18] | ((unsigned)wr[19] << 16);
              *(u32x4*)(dst + (size_t)f * 8) = w; } }
    }
}
constexpr int CH_SLOT = 40960, CH_NSLOT = 3;
constexpr int CH_ITEMS = PB * 4 * 2;
static_assert(NCH % 4 == 0, "the chain's loop is unrolled by four chunks");
__device__ __forceinline__ void chain_stage(const bf16_t* WK, const bf16_t* UTh, int m, int pw, int lane, unsigned char* smem) {
    unsigned char* slot = smem + (m % CH_NSLOT) * CH_SLOT;
#pragma unroll
    for (int k = 0; k < 8; ++k) GLDS16((const unsigned char*)(WK + (size_t)m * 16384) + (pw * 8 + k) * 1024 + lane * 16, slot + (pw * 8 + k) * 1024);
#pragma unroll
    for (int k = 0; k < 2; ++k) GLDS16((const unsigned char*)(UTh + (size_t)m * 8192) + (pw * 2 + k) * 1024 + lane * 16, slot + 32768 + (pw * 2 + k) * 1024);
}
__device__ __forceinline__ void ph_gdn_chain(const P& p, int l, unsigned char* smem) {
    const int tid = tidx(), lane = tid & 63, wave = UNIFORM(tid >> 6), j = lane & 15, q = lane >> 4;
    for (int it = blockIdx.x; it < CH_ITEMS; it += gridDim.x) {
        const int half = it & 1, bh = it >> 1;
        const bf16_t* WK = WSP(bf16_t, WS_GWK) + (size_t)bh * NCH * 16384;
        const bf16_t* UTh = WSP(bf16_t, WS_GU) + (size_t)bh * NCH * 8192 + half * 4096;
        __syncthreads();
        if (wave >= 4) {
            const int pw = wave - 4;
            chain_stage(WK, UTh, 0, pw, lane, smem); chain_stage(WK, UTh, 1, pw, lane, smem);
#pragma unroll 1
            for (int n = 0; n < NCH; ++n) {
                if (n + 1 < NCH) WAIT_VM(10); else WAIT_VM(0);
                RAW_BARRIER();
                if (n + 2 < NCH) chain_stage(WK, UTh, n + 2, pw, lane, smem);
            }
        } else {
            const int sl = half * 4 + wave, c = 16 * sl + j;
            f32x4 S[8];
#pragma unroll
            for (int t = 0; t < 8; ++t) S[t] = (f32x4){0.f, 0.f, 0.f, 0.f};
            bf16x8 sB[4];
#pragma unroll
            for (int ks = 0; ks < 4; ++ks) sB[ks] = pack_tiles(S[2 * ks], S[2 * ks + 1]);
            const float* DC = WSP(float, WS_GD) + bh * NCH;
            float db[4];
#pragma unroll
            for (int d = 0; d < 4; ++d) db[d] = DC[d];
#pragma unroll 1
            for (int n0 = 0; n0 < NCH; n0 += 4) {
#pragma unroll
                for (int k4 = 0; k4 < 4; ++k4) {
                    const int n = n0 + k4, u = bh * NCH + n;
                    f32x4 acc[4]; const float dec = db[k4];
                    if (n + 4 < NCH) db[k4] = DC[n + 4];
                    { bf16_t* sp = WSP(bf16_t, WS_GS) + (size_t)u * 16384 + (size_t)sl * 2048 + lane * 4;
#pragma unroll
                      for (int t = 0; t < 8; ++t) { u32x2 w; w.x = pk2(S[t][0], S[t][1]); w.y = pk2(S[t][2], S[t][3]); *(u32x2*)(sp + 256 * t) = w; } }
                    WAIT_LGKM0();
                    RAW_BARRIER();
                    const LAS unsigned char* slot = (const LAS unsigned char*)smem + (n % CH_NSLOT) * CH_SLOT + lane * 16; LAUNDER_V(slot);
                    { const LAS unsigned char* us = (const LAS unsigned char*)smem + (n % CH_NSLOT) * CH_SLOT + 32768 + ((16 * wave + j) * 64 + 4 * q) * 2; LAUNDER_V(us);
#pragma unroll
                      for (int mt = 0; mt < 4; ++mt) { const u32x2 w = *(const LAS u32x2*)(us + 32 * mt); acc[mt] = (f32x4){bf2f((bf16_t)(w.x & 0xffff)), bf2f((bf16_t)(w.x >> 16)), bf2f((bf16_t)(w.y & 0xffff)), bf2f((bf16_t)(w.y >> 16))}; } }
                    bf16x8 fa[8], fb[8];
#pragma unroll
                    for (int i = 0; i < 8; ++i) fa[i] = *(const LAS bf16x8*)(slot + i * 1024);
#pragma unroll
                    for (int i = 0; i < 8; ++i) fb[i] = *(const LAS bf16x8*)(slot + (8 + i) * 1024);
                    COMPILER_FENCE();
#pragma unroll
                    for (int ks = 0; ks < 4; ++ks) { acc[0] = MFMA16(fa[ks], sB[ks], acc[0]); acc[1] = MFMA16(fa[4 + ks], sB[ks], acc[1]); }
                    COMPILER_FENCE();
#pragma unroll
                    for (int i = 0; i < 8; ++i) fa[i] = *(const LAS bf16x8*)(slot + 16384 + i * 1024);
#pragma unroll
                    for (int ks = 0; ks < 4; ++ks) { acc[2] = MFMA16(fb[ks], sB[ks], acc[2]); acc[3] = MFMA16(fb[4 + ks], sB[ks], acc[3]); }
                    COMPILER_FENCE();
#pragma unroll
                    for (int i = 0; i < 8; ++i) fb[i] = *(const LAS bf16x8*)(slot + 16384 + (8 + i) * 1024);
                    { bf16_t* vp = WSP(bf16_t, WS_GV) + (size_t)u * 8192 + (size_t)sl * 1024 + lane * 4;
#pragma unroll
                      for (int mt = 0; mt < 4; ++mt) { u32x2 w; w.x = pk2(acc[mt][0], acc[mt][1]); w.y = pk2(acc[mt][2], acc[mt][3]); *(u32x2*)(vp + 256 * mt) = w; } }
                    const bf16x8 vB0 = pack_tiles(acc[0], acc[1]), vB1 = pack_tiles(acc[2], acc[3]);
#pragma unroll
                    for (int t = 0; t < 8; ++t) S[t] = S[t] * dec;
                    COMPILER_FENCE();
#pragma unroll
                    for (int t = 0; t < 4; ++t) S[t] = MFMA16(fa[2 * t], vB0, S[t]);
#pragma unroll
                    for (int t = 0; t < 4; ++t) S[t] = MFMA16(fa[2 * t + 1], vB1, S[t]);
#pragma unroll
                    for (int t = 0; t < 4; ++t) S[4 + t] = MFMA16(fb[2 * t], vB0, S[4 + t]);
#pragma unroll
                    for (int t = 0; t < 4; ++t) S[4 + t] = MFMA16(fb[2 * t + 1], vB1, S[4 + t]);
                    COMPILER_FENCE();
#pragma unroll
                    for (int ks = 0; ks < 4; ++ks) sB[ks] = pack_tiles(S[2 * ks], S[2 * ks + 1]);
                }
            }
            float* o = p.out + O_PGDN + ((size_t)l * PB * 4 + bh) * 16384 + c;
#pragma unroll
            for (int t = 0; t < 8; ++t)
#pragma unroll
                for (int e = 0; e < 4; ++e) o[(size_t)(16 * t + 4 * q + e) * 128] = S[t][e];
        }
    }
}
__device__ __forceinline__ void ph_gdn_out(const P& p, int l) {
    const int tid = tidx(), lane = tid & 63, wave = tid >> 6, j = lane & 15, q = lane >> 4, mt = wave & 3;
    const bf16_t* PR = WSP(bf16_t, WS_PROJ);
    for (int u = blockIdx.x * 2 + (wave >> 2); u < NUNIT; u += gridDim.x * 2) {
        const int n = u % NCH, h = (u / NCH) % 4, b = u / (NCH * 4);
        f32x4 acc[8];
#pragma unroll
        for (int ct = 0; ct < 8; ++ct) acc[ct] = (f32x4){0.f, 0.f, 0.f, 0.f};
        const bf16_t* qg = WSP(bf16_t, WS_GQ) + (size_t)u * 8192 + (16 * mt + j) * 128 + 8 * q;
        const bf16_t* st = WSP(bf16_t, WS_GS) + (size_t)u * 16384 + (size_t)(q >> 1) * 256 + ((2 * (q & 1)) * 16 + j) * 4;
#pragma unroll
        for (int ks = 0; ks < 4; ++ks) { const bf16x8 a = *(const bf16x8*)(qg + 32 * ks);
#pragma unroll
            for (int ct = 0; ct < 8; ++ct) { const bf16_t* sp = st + (size_t)ct * 2048 + ks * 512; const u32x2 lo = *(const u32x2*)sp, hi = *(const u32x2*)(sp + 64); u32x4 w; w.x = lo.x; w.y = lo.y; w.z = hi.x; w.w = hi.y;
                acc[ct] = MFMA16(a, __builtin_bit_cast(bf16x8, w), acc[ct]); }
            COMPILER_FENCE(); }
        const bf16_t* at = WSP(bf16_t, WS_GA) + (size_t)u * 4096 + (16 * mt + j) * 64 + 8 * q;
        const bf16_t* vt = WSP(bf16_t, WS_GV) + (size_t)u * 8192 + (size_t)(q >> 1) * 256 + ((2 * (q & 1)) * 16 + j) * 4;
#pragma unroll
        for (int ks = 0; ks < 2; ++ks) { const bf16x8 a = *(const bf16x8*)(at + 32 * ks);
#pragma unroll
            for (int ct = 0; ct < 8; ++ct) { const bf16_t* vp = vt + (size_t)ct * 1024 + ks * 512; const u32x2 lo = *(const u32x2*)vp, hi = *(const u32x2*)(vp + 64); u32x4 w; w.x = lo.x; w.y = lo.y; w.z = hi.x; w.w = hi.y;
                acc[ct] = MFMA16(a, __builtin_bit_cast(bf16x8, w), acc[ct]); }
            COMPILER_FENCE(); }
        float sq[4];
#pragma unroll
        for (int e = 0; e < 4; ++e) { float s = 0.f;
#pragma unroll
            for (int ct = 0; ct < 8; ++ct) s += acc[ct][e] * acc[ct][e];
            s += __shfl_xor(s, 1); s += __shfl_xor(s, 2); s += __shfl_xor(s, 4); s += __shfl_xor(s, 8); sq[e] = 1.0f / sqrtf(s * (1.0f / 128.0f) + EPS); }
#pragma unroll
        for (int e = 0; e < 4; ++e) { const size_t row = (size_t)(b * T + n * 64 + 16 * mt + 4 * q + e);
#pragma unroll
            for (int ct = 0; ct < 8; ++ct) { const int c = 16 * ct + j; const float z = bf2f(PR[row * NPROJ + C_Z + h * 128 + c]);
                WSP(bf16_t, WS_O)[row * D + 512 + h * 128 + c] = f2bf(acc[ct][e] * sq[e] * p.gdn_norm[l * 128 + c] * silu_f(z)); } }
    }
}
__device__ __forceinline__ void ph_gdn_sample(const P& p, int l, unsigned char* smem) {
    float* qs = (float*)smem; float* ks = qs + 8 * QP; float* vs = ks + 8 * QP; float* us = vs + 8 * QP; float* wsm = us + 8 * 128; float* vn = wsm + 8 * 128;
    float* Ls = vn + 8 * 128; float* As = Ls + 8 * 8; float* gs = As + 8 * 8; float* gcs = gs + 8; float* bts = gcs + 8; float* S0 = bts + 8;
    const int tid = tidx(); const bf16_t* PR = WSP(bf16_t, WS_PROJ);
    for (int u = gridDim.x - 1 - blockIdx.x; u < DB * 4; u += gridDim.x) {
        const int h = u & 3, b = u >> 2;
        __syncthreads();
#pragma unroll 4
        for (int e = tid; e < 16384; e += NTHR) S0[e] = p.state_gdn[(((size_t)l * DB + b) * 4 + h) * 16384 + e];
        if (tid < 384) { const int sec = tid >> 7, c = tid & 127, col = sec * 512 + h * 128 + c; float* dst = sec == 0 ? qs : sec == 1 ? ks : vs;
            const float w0 = p.conv_w[(l * 4 + 0) * 1536 + col], w1 = p.conv_w[(l * 4 + 1) * 1536 + col], w2 = p.conv_w[(l * 4 + 2) * 1536 + col], w3 = p.conv_w[(l * 4 + 3) * 1536 + col];
            const float* hist = p.state_conv + (((size_t)l * DB + b) * 3) * 1536 + col; const bf16_t* src = PR + (size_t)(MP + b * DS) * NPROJ + C_CONV + col;
            float x0 = hist[0], x1 = hist[1536], x2 = hist[2 * 1536];
            for (int i = 0; i < DS; ++i) { const float x3 = bf2f(src[(size_t)i * NPROJ]); const float y = w0 * x0 + w1 * x1 + w2 * x2 + w3 * x3; dst[i * QP + c] = silu_f(y); x0 = x1; x1 = x2; x2 = x3; } }
        else if (tid < 384 + DS) { const int i = tid - 384; const size_t row = (size_t)(MP + b * DS + i); gs[i] = WSP(float, WS_G)[row * 4 + h]; bts[i] = WSP(float, WS_BETA)[row * 4 + h]; }
        __syncthreads();
        if (tid < 64) { const int rid = tid >> 2, part = tid & 3; float* rowp = (rid < 8 ? qs + rid * QP : ks + (rid - 8) * QP) + part * 32; float s = 0.f;
            for (int d = 0; d < 32; ++d) s += rowp[d] * rowp[d];
            s += __shfl_xor(s, 1); s += __shfl_xor(s, 2); const float sc = 1.0f / sqrtf(s + EPS);
            for (int d = 0; d < 32; ++d) rowp[d] *= sc; }
        if (tid == 64) { float a = 0.f; for (int i = 0; i < DS; ++i) { a += gs[i]; gcs[i] = a; } }
        __syncthreads();
        if (tid < 64) { const int i = tid >> 3, j = tid & 7; float lv = 0.f, av = 0.f;
            if (j <= i) { float dk = 0.f, dq = 0.f; for (int d = 0; d < 128; ++d) { const float kj = ks[j * QP + d]; dk += ks[i * QP + d] * kj; dq += qs[i * QP + d] * kj; }
                const float e = expf(gcs[i] - gcs[j]); av = dq * e * 0.08838834764831845f; lv = j < i ? bts[i] * dk * e : 0.f; }
            Ls[i * 8 + j] = lv; As[i * 8 + j] = av; }
        __syncthreads();
        if (tid < 256) { const int c = tid; float X[8];
            if (c < 128) {
#pragma unroll
                for (int i = 0; i < 8; ++i) X[i] = vs[i * QP + c] * bts[i]; }
            else {
#pragma unroll
                for (int i = 0; i < 8; ++i) X[i] = ks[i * QP + c - 128] * bts[i] * expf(gcs[i]); }
            fwd_subst<8, 8>(X, Ls);
            float* dst = c < 128 ? us + c : wsm + c - 128;
#pragma unroll
            for (int i = 0; i < 8; ++i) dst[i * 128] = X[i]; }
        __syncthreads();
        const int i = tid >> 6, c2 = (tid & 63) * 2;
        { float a0 = us[i * 128 + c2], a1 = us[i * 128 + c2 + 1];
          for (int d = 0; d < 128; ++d) { const float w = wsm[i * 128 + d]; a0 -= w * S0[d * 128 + c2]; a1 -= w * S0[d * 128 + c2 + 1]; }
          vn[i * 128 + c2] = a0; vn[i * 128 + c2 + 1] = a1; }
        __syncthreads();
        { float o0 = 0.f, o1 = 0.f; const float qsc = 0.08838834764831845f * expf(gcs[i]);
          for (int d = 0; d < 128; ++d) { const float qg = qs[i * QP + d] * qsc; o0 += qg * S0[d * 128 + c2]; o1 += qg * S0[d * 128 + c2 + 1]; }
          for (int j = 0; j < DS; ++j) { const float a = As[i * 8 + j]; o0 += a * vn[j * 128 + c2]; o1 += a * vn[j * 128 + c2 + 1]; }
          const float rstd = 1.0f / sqrtf(wave_sum(o0 * o0 + o1 * o1) * (1.0f / 128.0f) + EPS);
          const size_t row = (size_t)(MP + b * DS + i);
          const float z0 = bf2f(PR[row * NPROJ + C_Z + h * 128 + c2]), z1 = bf2f(PR[row * NPROJ + C_Z + h * 128 + c2 + 1]);
          bf16_t* O = WSP(bf16_t, WS_O) + row * D + 512 + h * 128 + c2;
          O[0] = f2bf(o0 * rstd * p.gdn_norm[l * 128 + c2] * silu_f(z0)); O[1] = f2bf(o1 * rstd * p.gdn_norm[l * 128 + c2 + 1] * silu_f(z1)); }
        { const float gl = gcs[DS - 1], dec = expf(gl); float* o = p.out + O_SGDN + (((size_t)l * DB + b) * 4 + h) * 16384;
#pragma unroll 2
          for (int e = tid; e < 16384; e += NTHR) { const int d = e >> 7, c = e & 127; float s = S0[e] * dec;
              for (int j = 0; j < DS; ++j) s += ks[j * QP + d] * expf(gl - gcs[j]) * vn[j * 128 + c];
              o[e] = s; } }
    }
}

__device__ __forceinline__ void ph_final_norm(const P& p) {
    const int lane = tidx() & 63, wave = tidx() >> 6, gw = blockIdx.x * 8 + wave, ngw = gridDim.x * 8;
    for (int r = gw; r < M; r += ngw) {
        float* xr = p.out + (size_t)r * D; f32x4 v[4]; float ss = 0.f;
#pragma unroll
        for (int j = 0; j < 4; ++j) { v[j] = *(const f32x4*)(xr + 4 * lane + 256 * j); ss += (v[j][0] * v[j][0] + v[j][1] * v[j][1]) + (v[j][2] * v[j][2] + v[j][3] * v[j][3]); }
        const float rstd = 1.0f / sqrtf(wave_sum(ss) * (1.0f / D) + EPS);
#pragma unroll
        for (int j = 0; j < 4; ++j) { const f32x4 g = *(const f32x4*)(p.final_norm + 4 * lane + 256 * j); *(f32x4*)(xr + 4 * lane + 256 * j) = v[j] * rstd * g; }
    }
}

enum Phase { PH_PRO = 0, PH_NORM1, PH_GEMM_IN, PH_ROPE, PH_MIX1, PH_MIX2, PH_MIX3, PH_GEMM_OUT, PH_NORM2, PH_GEMM_GU, PH_GEMM_DN, PH_FINAL };
#ifdef __HIP_EMU__
#define LDSP(x) (x)
#else
#define LDSP(x) ((PG8_LAS unsigned char*)(x))
#endif
template <int PH> __device__ __forceinline__ void run_phase(const P& p, int l, unsigned char* smem) {
    if constexpr (PH == PH_PRO) { ph_convert(p, smem); __syncthreads(); ph_adaln(p, smem); ph_ropetab_copyx(p); }
    else if constexpr (PH == PH_NORM1) ph_norm_mod<0>(p, l);
    else if constexpr (PH == PH_GEMM_IN) {
        pg8::Gemm g{WSP(bf16_t, WS_H), WSP(bf16_t, WS_WIN) + (size_t)l * NPROJ * D, MPAD, NPROJ, D}; pg8::StaticOrder S; S.init(MPAD, NPROJ, (int)gridDim.x, (int)blockIdx.x);
        pg8::EpiStoreBf16 E{WSP(bf16_t, WS_PROJ), NPROJ};
        pg8::gemm_phase<pg8::EpiStoreBf16, pg8::StaticOrder, true, true>(LDSP(smem), g, S, E);
    }
    else if constexpr (PH == PH_ROPE) { ph_rope_out(p, l); ph_vtrans(p, smem); }
    else if constexpr (PH == PH_MIX1) { ph_attn_jobs(p); ph_ret_local(p, l); ph_gdn_prep(p, l, smem); }
    else if constexpr (PH == PH_MIX2) { ph_gdn_chain(p, l, smem); __syncthreads(); ph_attn_sample(p, l, smem); ph_ret_sample(p, l, smem); ph_gdn_sample(p, l, smem); ph_ret_scan(p, l); ph_attn_combine(p); }
    else if constexpr (PH == PH_MIX3) { ph_ret_out(p, l); ph_gdn_out(p, l); }
    else if constexpr (PH == PH_GEMM_OUT) {
        pg8::Gemm g{WSP(bf16_t, WS_O), WSP(bf16_t, WS_WOUT) + (size_t)l * D * D, MPAD, D, D}; pg8::StaticOrder S; S.init(MPAD, D, (int)gridDim.x, (int)blockIdx.x);
        pg8::EpiResidual E{p.out, WSP(float, WS_MOD) + (size_t)l * NC * 6144 + 2048};
        pg8::gemm_phase<pg8::EpiResidual, pg8::StaticOrder, true, true>(LDSP(smem), g, S, E);
    }
    else if constexpr (PH == PH_NORM2) ph_norm_mod<1>(p, l);
    else if constexpr (PH == PH_GEMM_GU) {
        pg8::Gemm g{WSP(bf16_t, WS_H), WSP(bf16_t, WS_WGU) + (size_t)l * 2 * FF * D, MPAD, 2 * FF, D}; pg8::StaticOrder S; S.init(MPAD, 2 * FF, (int)gridDim.x, (int)blockIdx.x);
        pg8::EpiSwiglu E{WSP(bf16_t, WS_HID)};
        pg8::gemm_phase<pg8::EpiSwiglu, pg8::StaticOrder, true, true>(LDSP(smem), g, S, E);
    }
    else if constexpr (PH == PH_GEMM_DN) {
        pg8::Gemm g{WSP(bf16_t, WS_HID), WSP(bf16_t, WS_WDN) + (size_t)l * D * FF, MPAD, D, FF}; pg8::StaticOrder S; S.init(MPAD, D, (int)gridDim.x, (int)blockIdx.x);
        pg8::EpiResidual E{p.out, WSP(float, WS_MOD) + (size_t)l * NC * 6144 + 5120};
        pg8::gemm_phase<pg8::EpiResidual, pg8::StaticOrder, true, true>(LDSP(smem), g, S, E);
    }
    else if constexpr (PH == PH_FINAL) ph_final_norm(p);
}
template <int PH> __global__ void __launch_bounds__(NTHR, 2) k_phase(P p, int l) { DYN_SMEM(smem); run_phase<PH>(p, l, smem); }


#ifndef __HIP_EMU__
#define LAS __attribute__((address_space(3)))
#define XB_TMO      128
#define XB_XCNT(j)  (256  + 64 * (j))
#define XB_XSUB(j)  (1280 + 64 * (j))
#define XB_XGEN(j)  (2304 + 64 * (j))
#define XB_TOP      3328
#define XB_TOPGEN   3392
#define XCD_BAR_WORDS 3456
#define XB_SPIN_CAP (1u << 18)

__device__ __forceinline__ unsigned xb_ld(unsigned* p)              { return __hip_atomic_load(p, __ATOMIC_RELAXED, __HIP_MEMORY_SCOPE_AGENT); }
__device__ __forceinline__ unsigned xb_add(unsigned* p, unsigned v) { return __hip_atomic_fetch_add(p, v, __ATOMIC_RELAXED, __HIP_MEMORY_SCOPE_AGENT); }
__device__ __forceinline__ unsigned xb_xcc_id() { return (unsigned)__builtin_amdgcn_s_getreg((3 << 11) | 20) & 0xFu; }
#define XB_SPIN(cond, bar) do { unsigned _sp = 0; while (cond) { __builtin_amdgcn_s_sleep(1); \
    if ((++_sp & 255u) == 0u) { if (xb_ld(&(bar)[XB_TMO])) break; if (_sp > XB_SPIN_CAP) { atomicAdd(&(bar)[XB_TMO], 1u); break; } } } } while (0)

struct XcdBarrier {
    unsigned* bar; unsigned x;
    volatile LAS unsigned* st;
};

__device__ __forceinline__ XcdBarrier xcd_barrier_post(unsigned* bar, volatile LAS unsigned* st) {
    XcdBarrier b; b.bar = bar; b.x = xb_xcc_id(); b.st = st;
    if (threadIdx.x == 0) (void)xb_add(&bar[XB_XCNT(b.x)], 1u);
    return b;
}
__device__ __forceinline__ void xcd_barrier_complete(unsigned* bar, unsigned x, unsigned& nloc, unsigned& nx) {
    const unsigned G = gridDim.x * gridDim.y * gridDim.z;
    unsigned sum, cnt, mine, sp = 0u;
    for (;;) {
        sum = 0u; cnt = 0u; mine = 0u;
#pragma unroll
        for (unsigned j = 0; j < 16; ++j) { const unsigned c = xb_ld(&bar[XB_XCNT(j)]); sum += c; cnt += (c > 0u) ? 1u : 0u; mine = (j == x) ? c : mine; }
        if (sum == G) break;
        __builtin_amdgcn_s_sleep(1);
        if ((++sp & 255u) == 0u) { if (xb_ld(&bar[XB_TMO])) break; if (sp > XB_SPIN_CAP) { atomicAdd(&bar[XB_TMO], 1u); break; } }
    }
    nloc = mine > 0u ? mine : 1u; nx = cnt > 0u ? cnt : 1u;
}

__device__ __forceinline__ void xcd_barrier(const XcdBarrier& b) {
    asm volatile("s_waitcnt vmcnt(0)" ::: "memory");
    __syncthreads();
    if (threadIdx.x == 0) {
        unsigned* bar = b.bar;
        __builtin_amdgcn_s_waitcnt(0);
        unsigned nloc = b.st[0], nx = b.st[1];
        if (nloc == 0u) { xcd_barrier_complete(bar, b.x, nloc, nx); b.st[0] = nloc; b.st[1] = nx; }
        const unsigned old = xb_add(&bar[XB_XSUB(b.x)], 1u);
        const unsigned gen = old / nloc;
        if (old + 1u == (gen + 1u) * nloc) {
            __builtin_amdgcn_fence(__ATOMIC_RELEASE, "agent");
            asm volatile("s_waitcnt vmcnt(0)" ::: "memory");
            const unsigned og = xb_add(&bar[XB_TOP], 1u);
            const unsigned tg = og / nx;
            if (og + 1u == (tg + 1u) * nx) xb_add(&bar[XB_TOPGEN], 1u);
            else XB_SPIN(xb_ld(&bar[XB_TOPGEN]) == tg, bar);
            __builtin_amdgcn_fence(__ATOMIC_ACQUIRE, "agent");
            xb_add(&bar[XB_XGEN(b.x)], 1u);
            asm volatile("s_waitcnt vmcnt(0)" ::: "memory");
        } else {
            XB_SPIN(xb_ld(&bar[XB_XGEN(b.x)]) == gen, bar);
            __builtin_amdgcn_fence(__ATOMIC_ACQUIRE, "agent");
            asm volatile("s_waitcnt vmcnt(0)" ::: "memory");
        }
    }
    __syncthreads();
}

#endif

#ifndef __HIP_EMU__
#define GRID_SYNC() xcd_barrier(bar)
__global__ void __launch_bounds__(NTHR, 2) k_mega(P p_arg) {
    DYN_SMEM(smem);
#if defined(__HIP_DEVICE_COMPILE__)
#define PHASE(PH_, l_) do { const __attribute__((address_space(4))) P* kp_ = (const __attribute__((address_space(4))) P*)__builtin_amdgcn_kernarg_segment_ptr(); LAUNDER_PTR(kp_); P pl_; __builtin_memcpy(&pl_, kp_, sizeof(P)); run_phase<PH_>(pl_, l_, smem); } while (0)
#else
#define PHASE(PH_, l_) run_phase<PH_>(p_arg, l_, smem)
#endif
    cooperative_groups::grid_group grid = cooperative_groups::this_grid();
    volatile LAS unsigned* bst = (volatile LAS unsigned*)((LAS unsigned char*)smem + BAR_LDS_OFF);
    if (threadIdx.x < 4) bst[threadIdx.x] = 0u;
    __syncthreads();
    XcdBarrier bar = xcd_barrier_post((unsigned*)(p_arg.ws + WS_CTL + 4096), bst);
    PHASE(PH_PRO, 0); grid.sync();
#define LAYER(l) do { PHASE(PH_NORM1, l); GRID_SYNC(); PHASE(PH_GEMM_IN, l); GRID_SYNC(); PHASE(PH_ROPE, l); GRID_SYNC(); PHASE(PH_MIX1, l); GRID_SYNC(); PHASE(PH_MIX2, l); GRID_SYNC(); \
        PHASE(PH_MIX3, l); GRID_SYNC(); PHASE(PH_GEMM_OUT, l); GRID_SYNC(); PHASE(PH_NORM2, l); GRID_SYNC(); PHASE(PH_GEMM_GU, l); GRID_SYNC(); PHASE(PH_GEMM_DN, l); GRID_SYNC(); } while (0)
    static_assert(NL == 2, "two layers written out (a loop over the layers makes hipcc hoist every phase's constants to the loop preheader and spill)");
    LAYER(0); LAYER(1);
    PHASE(PH_FINAL, 0);
}
#endif

template <int PH> static void launch_phase(const P& p, int l, int grid, hipStream_t stream) {
#ifndef __HIP_EMU__
    static bool attr_done = false;
    if (!attr_done) { (void)hipFuncSetAttribute((const void*)k_phase<PH>, hipFuncAttributeMaxDynamicSharedMemorySize, SMEM_BYTES); attr_done = true; }
#endif
    LAUNCH(k_phase<PH>, grid, SMEM_BYTES, stream, p, l);
}

extern "C" void kernel_launch(void* const* d_in, const int* in_sizes, int n_in, void* d_out, int out_size, void* d_ws, size_t ws_size, hipStream_t stream) {
    if (n_in != 24 || (size_t)out_size != O_END || ws_size < WS_END) {
        fprintf(stderr, "kernel_launch: shape mismatch: n_in %d out_size %d (want %zu) ws %zu (want %zu)\n", n_in, out_size, (size_t)O_END, ws_size, (size_t)WS_END); return; }
    P p{};
    const float** pp = (const float**)&p;
    for (int i = 0; i < 24; ++i) pp[i] = (const float*)d_in[i];
    p.out = (float*)d_out; p.ws = (unsigned char*)d_ws;
#ifndef __HIP_EMU__
    static int grid = 0;
    if (grid == 0) {
        int dev = 0, cus = 0, per_cu = 0;
        if (hipGetDevice(&dev) != hipSuccess || hipDeviceGetAttribute(&cus, hipDeviceAttributeMultiprocessorCount, dev) != hipSuccess || cus <= 0) { fprintf(stderr, "kernel_launch: device query failed\n"); grid = -1; return; }
        if (hipFuncSetAttribute((const void*)k_mega, hipFuncAttributeMaxDynamicSharedMemorySize, SMEM_BYTES) != hipSuccess) { fprintf(stderr, "kernel_launch: hipFuncSetAttribute failed\n"); grid = -1; return; }
        if (hipOccupancyMaxActiveBlocksPerMultiprocessor(&per_cu, (const void*)k_mega, NTHR, SMEM_BYTES) != hipSuccess || per_cu < 1) { fprintf(stderr, "kernel_launch: occupancy query says %d blocks per CU\n", per_cu); grid = -1; return; }
        grid = cus;
    }
    if (grid < 0) return;
    if (hipMemsetAsync((char*)d_ws + WS_CTL, 0, 65536, stream) != hipSuccess) { fprintf(stderr, "kernel_launch: memset of the barrier words failed\n"); return; }
    { void* args[] = {(void*)&p};
      hipError_t e = hipLaunchCooperativeKernel((const void*)k_mega, dim3(grid), dim3(NTHR), args, SMEM_BYTES, stream);
      if (e != hipSuccess) fprintf(stderr, "kernel_launch: cooperative launch failed: %s (grid %d)\n", hipGetErrorString(e), grid);
      return; }
#else
    int grid = 16;
#endif
    launch_phase<PH_PRO>(p, 0, grid, stream);
    for (int l = 0; l < NL; ++l) {
        launch_phase<PH_NORM1>(p, l, grid, stream);
        launch_phase<PH_GEMM_IN>(p, l, grid, stream);
        launch_phase<PH_ROPE>(p, l, grid, stream);
        launch_phase<PH_MIX1>(p, l, grid, stream);
        launch_phase<PH_MIX2>(p, l, grid, stream);
        launch_phase<PH_MIX3>(p, l, grid, stream);
        launch_phase<PH_GEMM_OUT>(p, l, grid, stream);
        launch_phase<PH_NORM2>(p, l, grid, stream);
        launch_phase<PH_GEMM_GU>(p, l, grid, stream);
        launch_phase<PH_GEMM_DN>(p, l, grid, stream);
    }
    launch_phase<PH_FINAL>(p, 0, grid, stream);
}
```

```cpp
#ifndef __HIP_EMU__
#include <hip/hip_runtime.h>
#include <hip/hip_cooperative_groups.h>
#endif
#include <cstdio>
#include <cstdint>
#include <cmath>

#ifndef CFG_BATCH
#define CFG_BATCH 2
#endif
#ifndef CFG_SEQ
#define CFG_SEQ 8192
#endif
#ifndef CFG_DB
#define CFG_DB 32
#endif
constexpr float LOG2E = 1.4426950408889634f;
constexpr int D = 1024, NL = 2, PB = CFG_BATCH, T = CFG_SEQ, DB = CFG_DB, DS = 8, PAST = 16384, WB = 2048;
constexpr int MP = PB * T, MS = DB * DS, M = MP + MS, MPAD = (M + 255) / 256 * 256, NC = PB + DB;
constexpr int INC = 3848, NPROJ = 3840, FF = 2816, NCH = T / 64, PWIN = T < 2048 ? T : 2048, NPOS = T + DS;
constexpr int NUNIT = PB * 4 * NCH;
constexpr float EPS = 1e-6f;
static_assert(T % 512 == 0, "the attention job decomposition wants T % 512 == 0");
constexpr int C_QA = 0, C_KA = 256, C_VA = 512, C_QR = 768, C_KR = 1024, C_VR = 1280, C_GR = 1536, C_CONV = 1792, C_Z = 3328;
constexpr int SMEM_BYTES = 147456;
constexpr int NTHR = 512;
constexpr int BAR_LDS_OFF = SMEM_BYTES - 64;

typedef unsigned short bf16_t;
typedef short bf16x8 __attribute__((ext_vector_type(8)));
typedef float f32x4 __attribute__((ext_vector_type(4)));
typedef unsigned u32x4 __attribute__((ext_vector_type(4)));
typedef unsigned u32x2 __attribute__((ext_vector_type(2)));
typedef float f32x16 __attribute__((ext_vector_type(16)));

#ifdef __HIP_EMU__
#define LAUNCH(kern, grid, lds, stream, ...) emu_launch(grid, NTHR, [=]() { kern(__VA_ARGS__); })
#define DYN_SMEM(name) unsigned char* name = emu_dyn_smem()
#define WAVE_SYNC() emu_wave_bar()
#define MFMA32(a, b, c) emu_mfma32(a, b, c)
#define GLDS16(gp, lp) memcpy((unsigned char*)(lp) + (threadIdx.x & 63) * 16, (gp), 16)
#define RAW_BARRIER() __syncthreads()
#define GLDS4(gp, lp) ((void)0)
#define WAIT_VM(n)
#define WAIT_LGKM0()
#define LAS
#define UNIFORM(x) (x)
#define COMPILER_FENCE()
#define LAUNDER_V(x)
#define MFMA16(a, b, c) emu_mfma16(a, b, c)
#else
#define WAVE_SYNC() asm volatile("s_waitcnt lgkmcnt(0)" ::: "memory")
#define MFMA32(a, b, c) __builtin_amdgcn_mfma_f32_32x32x16_bf16(a, b, c, 0, 0, 0)
#define LAS __attribute__((address_space(3)))
#define GLDS16(gp, lp) __builtin_amdgcn_global_load_lds((const unsigned*)(gp), (LAS unsigned*)(lp), 16, 0, 0)
#define RAW_BARRIER() __builtin_amdgcn_s_barrier()
#define GLDS4(gp, lp) __builtin_amdgcn_global_load_lds((const unsigned*)(gp), (LAS unsigned*)(lp), 4, 0, 0)
#define WAIT_VM(n) asm volatile("s_waitcnt vmcnt(" #n ")" ::: "memory")
#define WAIT_LGKM0() asm volatile("s_waitcnt lgkmcnt(0)" ::: "memory")
#define UNIFORM(x) __builtin_amdgcn_readfirstlane(x)
#define COMPILER_FENCE() __builtin_amdgcn_sched_barrier(0)
#define LAUNDER_V(x) asm volatile("" : "+v"(x))
#define MFMA16(a, b, c) __builtin_amdgcn_mfma_f32_16x16x32_bf16(a, b, c, 0, 0, 0)
#define LAUNCH(kern, grid, lds, stream, ...) hipLaunchKernelGGL(kern, dim3(grid), dim3(NTHR), lds, stream, __VA_ARGS__)
#define DYN_SMEM(name) extern __shared__ __attribute__((aligned(16))) unsigned char name[]
#endif

#ifdef __HIP_EMU__
__device__ __forceinline__ int tidx() { return (int)threadIdx.x; }
#define LAUNDER_PTR(x)
#else
__device__ __forceinline__ int tidx() { int t = (int)threadIdx.x; asm volatile("" : "+v"(t)); return t; }
#define LAUNDER_PTR(x) asm volatile("" : "+s"(x))
#endif
__device__ __forceinline__ float bf2f(bf16_t v) { return __builtin_bit_cast(float, (unsigned)v << 16); }
__device__ __forceinline__ bf16_t f2bf(float f) { unsigned u = __builtin_bit_cast(unsigned, f); return (bf16_t)((u + 0x7fffu + ((u >> 16) & 1u)) >> 16); }
#ifdef __HIP_EMU__
__device__ __forceinline__ unsigned pk2(float lo, float hi) { return (unsigned)f2bf(lo) | ((unsigned)f2bf(hi) << 16); }
#else
typedef float f32x2_t __attribute__((ext_vector_type(2))); typedef __bf16 bf16x2_t __attribute__((ext_vector_type(2)));
__device__ __forceinline__ unsigned pk2(float lo, float hi) { f32x2_t v = {lo, hi}; bf16x2_t b = __builtin_convertvector(v, bf16x2_t); return __builtin_bit_cast(unsigned, b); }
#endif
__device__ __forceinline__ bf16x8 pack_tiles(const f32x4& lo, const f32x4& hi) {
    u32x4 w; w.x = pk2(lo[0], lo[1]); w.y = pk2(lo[2], lo[3]); w.z = pk2(hi[0], hi[1]); w.w = pk2(hi[2], hi[3]); return __builtin_bit_cast(bf16x8, w);
}
__device__ __forceinline__ float silu_f(float x) { return x / (1.0f + expf(-x)); }
#ifdef __HIP_EMU__
__device__ __forceinline__ float silu_fast(float x) { return x / (1.0f + expf(-x)); }
#else
__device__ __forceinline__ float silu_fast(float x) { return x * __builtin_amdgcn_rcpf(1.0f + __builtin_amdgcn_exp2f(-LOG2E * x)); }
#endif
__device__ __forceinline__ float wave_sum(float v) {
#pragma unroll
    for (int o = 1; o < 64; o <<= 1) v += __shfl_xor(v, o);
    return v;
}
__device__ __forceinline__ float wave_max(float v) {
#pragma unroll
    for (int o = 1; o < 64; o <<= 1) v = fmaxf(v, __shfl_xor(v, o));
    return v;
}

struct P {
    const float *x_prompt, *x_sample, *cache_k, *cache_v, *state_ret, *state_gdn, *state_conv, *c_prompt, *c_sample, *ada_w, *ada_b, *norm_mix, *norm_ffn,
        *w_in, *ret_norm, *conv_w, *a_log, *dt_bias, *gdn_norm, *w_out, *w_gate, *w_up, *w_down, *final_norm;
    float* out; unsigned char* ws;
};

constexpr size_t O_YP = 0, O_YS = O_YP + (size_t)MP * D, O_PWK = O_YS + (size_t)MS * D, O_PWV = O_PWK + (size_t)NL * PB * PWIN * 256,
                 O_PRET = O_PWV + (size_t)NL * PB * PWIN * 256, O_PGDN = O_PRET + (size_t)NL * PB * 4 * 4096, O_PCONV = O_PGDN + (size_t)NL * PB * 4 * 16384,
                 O_SWK = O_PCONV + (size_t)NL * PB * 3 * 1536, O_SWV = O_SWK + (size_t)NL * DB * DS * 256, O_SRET = O_SWV + (size_t)NL * DB * DS * 256,
                 O_SGDN = O_SRET + (size_t)NL * DB * 4 * 4096, O_SCONV = O_SGDN + (size_t)NL * DB * 4 * 16384, O_END = O_SCONV + (size_t)NL * DB * 3 * 1536;

constexpr size_t al256(size_t x) { return (x + 255) / 256 * 256; }
constexpr size_t WS_CTL = 0, WS_CTL_BYTES = 1u << 20;
constexpr size_t WS_MOD = WS_CTL + WS_CTL_BYTES;
constexpr size_t WS_ROPE = al256(WS_MOD + (size_t)NL * NC * 6144 * 4);
constexpr size_t WS_WIN = al256(WS_ROPE + (size_t)4 * NPOS * 32 * 4);
constexpr size_t WS_WOUT = al256(WS_WIN + (size_t)NL * NPROJ * D * 2);
constexpr size_t WS_WGU = al256(WS_WOUT + (size_t)NL * D * D * 2);
constexpr size_t WS_WDN = al256(WS_WGU + (size_t)NL * 2 * FF * D * 2);
constexpr size_t WS_H = al256(WS_WDN + (size_t)NL * D * FF * 2);
constexpr size_t WS_PROJ = al256(WS_H + (size_t)MPAD * D * 2);
constexpr size_t WS_BETA = al256(WS_PROJ + (size_t)MPAD * NPROJ * 2);
constexpr size_t WS_G = al256(WS_BETA + (size_t)M * 4 * 4);
constexpr size_t WS_O = al256(WS_G + (size_t)M * 4 * 4);
constexpr size_t WS_RU = al256(WS_O + (size_t)MPAD * D * 2);
constexpr size_t WS_RS = al256(WS_RU + (size_t)NUNIT * 4096 * 4);
constexpr size_t WS_SCR = al256(WS_RS + (size_t)NUNIT * 4096 * 4);
constexpr size_t WS_GU = WS_SCR;
constexpr size_t WS_GWK = al256(WS_GU + (size_t)NUNIT * 8192 * 2);
constexpr size_t WS_GQ = al256(WS_GWK + (size_t)NUNIT * 16384 * 2);
constexpr size_t WS_GA = al256(WS_GQ + (size_t)NUNIT * 8192 * 2);
constexpr size_t WS_GD = al256(WS_GA + (size_t)NUNIT * 4096 * 2);
constexpr size_t WS_GV = al256(WS_GD + (size_t)NUNIT * 4);
constexpr size_t WS_GS = al256(WS_GV + (size_t)NUNIT * 8192 * 2);
constexpr size_t WS_GEND = al256(WS_GS + (size_t)NUNIT * 16384 * 2);
constexpr size_t WS_KH = WS_GEND;
constexpr size_t WS_VT1 = al256(WS_KH + (size_t)MP * 256 * 2);
constexpr size_t WS_VT4 = al256(WS_VT1 + (size_t)MP * 256 * 2);
constexpr size_t WS_VT16 = al256(WS_VT4 + (size_t)MP * 256 * 2);
constexpr size_t WS_KRT = al256(WS_VT16 + (size_t)MP * 256 * 2);
constexpr size_t WS_VRT = al256(WS_KRT + (size_t)MP * 256 * 2);
constexpr size_t WS_AML = al256(WS_VRT + (size_t)MP * 256 * 2);
constexpr size_t WS_AEND = al256(WS_AML + (size_t)MP * 4 * 3 * 2 * 4);
constexpr size_t WS_APO = WS_H;
static_assert((size_t)MP * 4 * 3 * 64 * 2 <= (size_t)MPAD * D * 2, "attention partials overlay H");
constexpr size_t WS_HID = WS_SCR;
constexpr size_t WS_HEND = al256(WS_HID + (size_t)MPAD * FF * 2);
constexpr size_t WS_END = WS_AEND > WS_HEND ? WS_AEND : WS_HEND;

#define WSP(T_, off) ((T_*)(p.ws + (off)))
__device__ __forceinline__ int row_cb(int r) { return r < MP ? r / T : PB + (r - MP) / DS; }
__device__ __forceinline__ int row_pi(int r) { return r < MP ? r % T : T + (r - MP) % DS; }
namespace pg8 {
#ifdef __HIP_EMU__
#define PG8_LAS
#else
#define PG8_LAS __attribute__((address_space(3)))
#endif
typedef unsigned short bf16_t;
typedef short bf16x8 __attribute__((ext_vector_type(8)));
typedef float f32x4 __attribute__((ext_vector_type(4)));
typedef unsigned u32x4 __attribute__((ext_vector_type(4)));
constexpr int BM = 256, BK = 64, HALF = 128, HTB = HALF * BK * 2  , STAGE_BYTES = 8 * HTB, NXCD = 8, WGM = 8;

__host__ __device__ __forceinline__ int lds_byte(int r, int c) { const int st = (r >> 4) * 2 + (c >> 5), rr = r & 15, cc = c & 31, ob = rr * 64 + cc * 2; return st * 1024 + (ob ^ (((ob >> 9) & 1) << 5)); }
__host__ __device__ __forceinline__ void stage_rc(int b, int& R, int& C) { const int st = b / 1024, sb = b % 1024, swz = sb ^ (((sb >> 9) & 1) << 5); R = (st >> 1) * 16 + swz / 64; C = (st & 1) * 32 + (swz % 64) / 2; }
__host__ __device__ __forceinline__ int perm32(int rho) { const int n = rho >> 4, i = rho & 15; return 8 * (i >> 2) + 4 * n + (i & 3); }

struct Unit { int pm, pn; };
struct Gemm { const bf16_t* A; const bf16_t* Bt; int M, N, K; };

struct StaticOrder {
    int nM, nN, nwg, G, c;
    __host__ __device__ void init(int M, int N, int G_, int c_) { nM = M / BM; nN = N / BM; nwg = nM * nN; G = G_; c = c_; }
    __host__ __device__ bool next(int i, Unit& u) const {
        const long L = (long)i * G + c; if (L >= nwg) return false;
        int wgid = (int)L; { const int q = nwg / NXCD, r = nwg % NXCD, xcd = wgid % NXCD, off = wgid / NXCD; wgid = (xcd < r ? xcd * (q + 1) : r * (q + 1) + (xcd - r) * q) + off; }
        const int nig = WGM * nN, gid = wgid / nig, fm = gid * WGM, gsz = (nM - fm) < WGM ? (nM - fm) : WGM;
        u.pm = fm + ((wgid % nig) % gsz); u.pn = (wgid % nig) / gsz; return true;
    }
    __device__ __forceinline__ void a_ready(const Unit&) const {}
    __device__ __forceinline__ void done(const Unit&) const {}
};


struct EpiStoreBf16 {
    static constexpr bool PERM = true, AFTER_DRAIN = false;
    bf16_t* O; int ldc;
    __device__ __forceinline__ void operator()(const f32x4 (&acc)[2][2][4][2], const Unit& u, int wr, int wc, int fr, int fq) const {
        const int row0 = u.pm * BM + wr * 64 + fr, col0 = u.pn * BM + wc * 32 + 8 * fq;
#pragma unroll
        for (int ai = 0; ai < 2; ++ai)
#pragma unroll
            for (int m = 0; m < 4; ++m) { bf16_t* rowp = O + (size_t)(row0 + ai * HALF + m * 16) * ldc + col0;
#pragma unroll
                for (int bj = 0; bj < 2; ++bj) { const f32x4 v0 = acc[ai][bj][m][0], v1 = acc[ai][bj][m][1];
                    u32x4 w; w.x = ::pk2(v0[0], v0[1]); w.y = ::pk2(v0[2], v0[3]); w.z = ::pk2(v1[0], v1[1]); w.w = ::pk2(v1[2], v1[3]);
                    *(u32x4*)(rowp + bj * HALF) = w; } }
    }
};
struct EpiResidual {
    static constexpr bool PERM = false, AFTER_DRAIN = false;
    float* X; const float* gate; const float* Xin;
    __device__ __forceinline__ void operator()(const f32x4 (&acc)[2][2][4][2], const Unit& u, int wr, int wc, int fr, int fq) const {
        const int row0 = u.pm * BM + wr * 64 + fr, col0 = u.pn * BM + wc * 32 + 4 * fq;
#pragma unroll
        for (int ai = 0; ai < 2; ++ai)
#pragma unroll
            for (int m = 0; m < 4; ++m) { const int row = row0 + ai * HALF + m * 16;
                if (MPAD != M && row >= M) continue;
                const float* g = gate + (size_t)::row_cb(row) * 6144 + col0; float* xp = X + (size_t)row * D + col0; const float* xi = Xin + (size_t)row * D + col0;
#pragma unroll
                for (int bj = 0; bj < 2; ++bj)
#pragma unroll
                    for (int n = 0; n < 2; ++n) { const f32x4 gv = *(const f32x4*)(g + bj * HALF + n * 16); f32x4* xq = (f32x4*)(xp + bj * HALF + n * 16); *xq = *(const f32x4*)(xi + bj * HALF + n * 16) + gv * acc[ai][bj][m][n]; } }
    }
};
struct EpiSwiglu {
    static constexpr bool PERM = true, AFTER_DRAIN = false;
    bf16_t* Hd;
    __device__ __forceinline__ void operator()(const f32x4 (&acc)[2][2][4][2], const Unit& u, int wr, int wc, int fr, int fq) const {
        const int row0 = u.pm * BM + wr * 64 + fr, col0 = u.pn * HALF + wc * 32 + 8 * fq;
#pragma unroll
        for (int ai = 0; ai < 2; ++ai)
#pragma unroll
            for (int m = 0; m < 4; ++m) { bf16_t* rowp = Hd + (size_t)(row0 + ai * HALF + m * 16) * FF + col0;
                float v[8];
#pragma unroll
                for (int n = 0; n < 2; ++n)
#pragma unroll
                    for (int j = 0; j < 4; ++j) { const float gt = acc[ai][0][m][n][j], up = acc[ai][1][m][n][j]; v[4 * n + j] = ::silu_f(gt) * up; }
                u32x4 w; w.x = ::pk2(v[0], v[1]); w.y = ::pk2(v[2], v[3]); w.z = ::pk2(v[4], v[5]); w.w = ::pk2(v[6], v[7]);
                *(u32x4*)rowp = w; }
    }
};

#ifdef __HIP_EMU__
template <class Epi, class Sched, bool ALIGN_EPI = false, bool SP2 = false>
__device__ __forceinline__ void gemm_phase(unsigned char* lds, const Gemm g, const Sched& S, const Epi& E) {
    const int tid = threadIdx.x, wid = tid >> 6, lane = tid & 63, wr = wid >> 2, wc = wid & 3, fr = lane & 15, fq = lane >> 4;
    Unit cur;
    for (int ui = 0; S.next(ui, cur); ++ui) {
        f32x4 acc[2][2][4][2];
        for (int ai = 0; ai < 2; ++ai) for (int bj = 0; bj < 2; ++bj) for (int m = 0; m < 4; ++m) for (int n = 0; n < 2; ++n) for (int j = 0; j < 4; ++j) {
            const int row = 256 * cur.pm + 128 * ai + 64 * wr + 16 * m + fr;
            const int col = Epi::PERM ? 256 * cur.pn + 128 * bj + 32 * wc + 8 * fq + 4 * n + j : 256 * cur.pn + 128 * bj + 32 * wc + 16 * n + 4 * fq + j;
            const bf16_t* a = g.A + (size_t)row * g.K; const bf16_t* b = g.Bt + (size_t)col * g.K; float s = 0.f;
            for (int k = 0; k < g.K; ++k) s += ::bf2f(a[k]) * ::bf2f(b[k]);
            acc[ai][bj][m][n][j] = s; }
        E(acc, cur, wr, wc, fr, fq);
    }
}
#else
template <class Epi, class Sched, bool ALIGN_EPI = false, bool SP2 = false>
__device__ __forceinline__ void gemm_phase(PG8_LAS unsigned char* lds, const Gemm g, const Sched& S, const Epi& E) {
    const int tid = ::tidx(), wid = __builtin_amdgcn_readfirstlane(tid >> 6), lane = tid & 63, wr = wid >> 2, wc = wid & 3, fr = lane & 15, fq = lane >> 4;
    const int K = g.K, nt = K / BK;
    unsigned voffA[2], voffB[2];
#pragma unroll
    for (int i = 0; i < 2; ++i) { int R, C; stage_rc(tid * 16 + i * 8192, R, C); const int Rb = Epi::PERM ? ((R & ~31) + perm32(R & 31)) : R;
        voffA[i] = (unsigned)(R * K + C) * 2u; voffB[i] = (unsigned)(Rb * K + C) * 2u; }
    const size_t kstep = (size_t)(BK * 2);
    const size_t hstep = (size_t)HALF * K * 2;
    const size_t tstep = 2 * hstep;
    const unsigned ldsw = (unsigned)wid * 1024u;
    const int aoff = lds_byte(wr * 64 + fr, fq * 8), boff = lds_byte(wc * 32 + fr, fq * 8);
#define PG8_SA(b, h) (((b) * 2 + (h)) * HTB)
#define PG8_SB(b, h) ((4 + (b) * 2 + (h)) * HTB)
#define PG8_STAGE(bufoff, gbase, voff) do { _Pragma("unroll") for (int _i = 0; _i < 2; ++_i) \
        __builtin_amdgcn_global_load_lds((const unsigned*)((const char*)(gbase) + (voff)[_i]), (PG8_LAS unsigned*)(lds + (bufoff) + ldsw + _i * 8192), 16, 0, 0); } while (0)
#define PG8_LDA(dst, b, h) do { _Pragma("unroll") for (int m = 0; m < 4; ++m) _Pragma("unroll") for (int k = 0; k < 2; ++k) dst[m][k] = *(const PG8_LAS bf16x8*)(lds + PG8_SA(b, h) + aoff + m * 2048 + k * 1024); } while (0)
#define PG8_LDB(dst, b, h) do { _Pragma("unroll") for (int n = 0; n < 2; ++n) _Pragma("unroll") for (int k = 0; k < 2; ++k) dst[n][k] = *(const PG8_LAS bf16x8*)(lds + PG8_SB(b, h) + boff + n * 2048 + k * 1024); } while (0)
#define PG8_MMA(ai, bj, At, Bt) do { __builtin_amdgcn_s_setprio(1); _Pragma("unroll") for (int m = 0; m < 4; ++m) _Pragma("unroll") for (int n = 0; n < 2; ++n) _Pragma("unroll") for (int k = 0; k < 2; ++k) \
        acc[ai][bj][m][n] = __builtin_amdgcn_mfma_f32_16x16x32_bf16(Bt[n][k], At[m][k], acc[ai][bj][m][n], 0, 0, 0); __builtin_amdgcn_s_setprio(0); } while (0)
#define PG8_WAIT_V(n) asm volatile("s_waitcnt vmcnt(" #n ")" ::: "memory")
#define PG8_WAIT_L(n) asm volatile("s_waitcnt lgkmcnt(" #n ")" ::: "memory")
#define PG8_BAR __builtin_amdgcn_s_barrier()
#define PG8_SCHED __builtin_amdgcn_sched_barrier(0)
    Unit cur, nxt; int ui = 0;
    if (!S.next(0, cur)) return;
    f32x4 acc[2][2][4][2];
#pragma unroll
    for (int a = 0; a < 2; ++a)
#pragma unroll
        for (int b = 0; b < 2; ++b)
#pragma unroll
            for (int m = 0; m < 4; ++m)
#pragma unroll
                for (int n = 0; n < 2; ++n) acc[a][b][m][n] = (f32x4){0.f, 0.f, 0.f, 0.f};
    bf16x8 At[4][2], B0[2][2], B1[2][2];
    const char* cA = (const char*)g.A + (size_t)cur.pm * tstep; const char* cB = (const char*)g.Bt + (size_t)cur.pn * tstep;
    S.a_ready(cur);
    if constexpr (SP2) {
        PG8_STAGE(PG8_SB(0, 0), cB, voffB); PG8_STAGE(PG8_SB(0, 1), cB + hstep, voffB); PG8_STAGE(PG8_SA(0, 0), cA, voffA); PG8_STAGE(PG8_SA(0, 1), cA + hstep, voffA);
        if (wr == 1) PG8_BAR;
        PG8_WAIT_V(2); PG8_BAR;
        PG8_STAGE(PG8_SB(1, 0), cB + kstep, voffB); PG8_STAGE(PG8_SA(1, 0), cA + kstep, voffA); PG8_STAGE(PG8_SB(1, 1), cB + hstep + kstep, voffB);
        PG8_WAIT_V(6); PG8_BAR;
    } else {
        PG8_STAGE(PG8_SB(0, 0), cB, voffB); PG8_STAGE(PG8_SA(0, 0), cA, voffA); PG8_STAGE(PG8_SB(0, 1), cB + hstep, voffB); PG8_STAGE(PG8_SA(0, 1), cA + hstep, voffA);
        if (wr == 1) PG8_BAR;
        PG8_WAIT_V(4); PG8_BAR;
        PG8_STAGE(PG8_SB(1, 0), cB + kstep, voffB); PG8_STAGE(PG8_SA(1, 0), cA + kstep, voffA); PG8_STAGE(PG8_SB(1, 1), cB + hstep + kstep, voffB);
        PG8_WAIT_V(6); PG8_BAR;
    }
    for (;;) {
        const bool has_next = S.next(ui + 1, nxt);
        const char* nA = has_next ? (const char*)g.A + (size_t)nxt.pm * tstep : cA; const char* nB = has_next ? (const char*)g.Bt + (size_t)nxt.pn * tstep : cB;
        for (int t = 0; t < nt; t += 2) {
            const bool last = (t == nt - 2);
            const char* a1 = cA + (size_t)(t + 1) * kstep;
            const char* a2 = last ? nA : cA + (size_t)(t + 2) * kstep; const char* b2 = last ? nB : cB + (size_t)(t + 2) * kstep;
            const char* a3 = a2 + kstep; const char* b3 = b2 + kstep;
            if (last && has_next) S.a_ready(nxt);
            if constexpr (SP2) {
            PG8_LDB(B0, 0, 0); PG8_LDB(B1, 0, 1); PG8_SCHED; PG8_LDA(At, 0, 0); PG8_STAGE(PG8_SA(1, 1), a1 + hstep, voffA);
            PG8_WAIT_V(8); PG8_WAIT_L(0); PG8_BAR; PG8_MMA(0, 0, At, B0); PG8_MMA(0, 1, At, B1); PG8_BAR; PG8_SCHED;
            PG8_LDA(At, 0, 1); PG8_STAGE(PG8_SB(0, 0), b2, voffB); PG8_STAGE(PG8_SB(0, 1), b2 + hstep, voffB); PG8_STAGE(PG8_SA(0, 0), a2, voffA);
            PG8_WAIT_V(8); PG8_WAIT_L(0); PG8_BAR; PG8_MMA(1, 0, At, B0); PG8_MMA(1, 1, At, B1); PG8_BAR; PG8_SCHED;
            PG8_LDB(B0, 1, 0); PG8_LDB(B1, 1, 1); PG8_SCHED; PG8_LDA(At, 1, 0); PG8_STAGE(PG8_SA(0, 1), a2 + hstep, voffA);
            PG8_WAIT_V(8); PG8_WAIT_L(0); PG8_BAR; PG8_MMA(0, 0, At, B0); PG8_MMA(0, 1, At, B1); PG8_BAR; PG8_SCHED;
            PG8_LDA(At, 1, 1); PG8_STAGE(PG8_SB(1, 0), b3, voffB); PG8_STAGE(PG8_SB(1, 1), b3 + hstep, voffB); PG8_STAGE(PG8_SA(1, 0), a3, voffA);
            PG8_WAIT_V(8); PG8_WAIT_L(0); PG8_BAR; PG8_MMA(1, 0, At, B0); PG8_MMA(1, 1, At, B1); PG8_BAR; PG8_SCHED;
            } else {
            PG8_LDB(B0, 0, 0); PG8_SCHED; PG8_LDA(At, 0, 0); PG8_STAGE(PG8_SA(1, 1), a1 + hstep, voffA);
            PG8_WAIT_L(8); PG8_BAR; PG8_WAIT_L(0); PG8_MMA(0, 0, At, B0); PG8_BAR; PG8_SCHED;
            PG8_LDB(B1, 0, 1); PG8_STAGE(PG8_SB(0, 0), b2, voffB);
            PG8_BAR; PG8_WAIT_L(0); PG8_MMA(0, 1, At, B1); PG8_BAR;
            PG8_LDA(At, 0, 1); PG8_STAGE(PG8_SA(0, 0), a2, voffA);
            PG8_BAR; PG8_WAIT_L(0); PG8_MMA(1, 0, At, B0); PG8_BAR; PG8_SCHED;
            PG8_STAGE(PG8_SB(0, 1), b2 + hstep, voffB);
            PG8_WAIT_V(6); PG8_BAR; PG8_MMA(1, 1, At, B1); PG8_BAR;
            PG8_LDB(B0, 1, 0); PG8_SCHED; PG8_LDA(At, 1, 0); PG8_STAGE(PG8_SA(0, 1), a2 + hstep, voffA);
            PG8_WAIT_L(8); PG8_BAR; PG8_WAIT_L(0); PG8_MMA(0, 0, At, B0); PG8_BAR; PG8_SCHED;
            PG8_LDB(B1, 1, 1); PG8_STAGE(PG8_SB(1, 0), b3, voffB);
            PG8_BAR; PG8_WAIT_L(0); PG8_MMA(0, 1, At, B1); PG8_BAR;
            PG8_LDA(At, 1, 1); PG8_STAGE(PG8_SA(1, 0), a3, voffA);
            PG8_BAR; PG8_WAIT_L(0); PG8_MMA(1, 0, At, B0); PG8_BAR; PG8_SCHED;
            PG8_STAGE(PG8_SB(1, 1), b3 + hstep, voffB);
            PG8_WAIT_V(6); PG8_BAR; PG8_MMA(1, 1, At, B1); PG8_BAR;
            }
        }
        if constexpr (ALIGN_EPI) { if (wr == 0) PG8_BAR; }
        if constexpr (!Epi::AFTER_DRAIN) { E(acc, cur, wr, wc, fr, fq); S.done(cur); }
        if (!has_next) break;
#pragma unroll
        for (int a = 0; a < 2; ++a)
#pragma unroll
            for (int b = 0; b < 2; ++b)
#pragma unroll
                for (int m = 0; m < 4; ++m)
#pragma unroll
                    for (int n = 0; n < 2; ++n) acc[a][b][m][n] = (f32x4){0.f, 0.f, 0.f, 0.f};
        cur = nxt; cA = nA; cB = nB; ++ui;
        if constexpr (ALIGN_EPI) { if (wr == 1) PG8_BAR; }
    }
    PG8_WAIT_V(0);
    if constexpr (!ALIGN_EPI) { if (wr == 0) PG8_BAR; }
    PG8_BAR;
    if constexpr (Epi::AFTER_DRAIN) { E.fused(acc, cur, wr, wc, fr, fq, lds, wid, lane); S.done(cur); }
#undef PG8_SA
#undef PG8_SB
#undef PG8_STAGE
#undef PG8_LDA
#undef PG8_LDB
#undef PG8_MMA
#undef PG8_WAIT_V
#undef PG8_WAIT_L
#undef PG8_BAR
#undef PG8_SCHED
}
#endif
}


__device__ __forceinline__ void transpose_item(const float* W, int ldw, bf16_t* WT, int K, int k0, int n0, int drow0, float* scr, int lane) {
#pragma unroll 8
    for (int i = 0; i < 32; ++i) { const int kk = 2 * i + (lane >> 5); scr[kk * 33 + (lane & 31)] = W[(size_t)(k0 + kk) * ldw + n0 + (lane & 31)]; }
    WAVE_SYNC();
    const int c = lane & 7;
#pragma unroll
    for (int j = 0; j < 4; ++j) { const int n = (lane >> 3) + 8 * j; const float* s = scr + (8 * c) * 33 + n;
        u32x4 o; o.x = pk2(s[0 * 33], s[1 * 33]); o.y = pk2(s[2 * 33], s[3 * 33]); o.z = pk2(s[4 * 33], s[5 * 33]); o.w = pk2(s[6 * 33], s[7 * 33]);
        *(u32x4*)(WT + (size_t)(drow0 + n) * K + k0 + 8 * c) = o; }
    WAVE_SYNC();
}
__device__ __forceinline__ void ph_convert(const P& p, unsigned char* smem) {
    const int lane = tidx() & 63, wave = tidx() >> 6;
    float* scr = (float*)smem + wave * (64 * 33 + 32);
    constexpr int I_IN = 16 * 120, I_OUT = 16 * 32, I_G = 16 * 88, I_DN = 44 * 32, I_L = I_IN + I_OUT + 2 * I_G + I_DN;
    const int gw = blockIdx.x * 8 + wave, ngw = gridDim.x * 8;
    for (int it = gw; it < NL * I_L; it += ngw) {
        const int l = it / I_L; int r = it % I_L;
        if (r < I_IN) { const int kb = r / 120, nb = r % 120; transpose_item(p.w_in + (size_t)l * D * INC, INC, WSP(bf16_t, WS_WIN) + (size_t)l * NPROJ * D, D, kb * 64, nb * 32, nb * 32, scr, lane); continue; }
        r -= I_IN;
        if (r < I_OUT) { const int kb = r / 32, nb = r % 32; transpose_item(p.w_out + (size_t)l * D * D, D, WSP(bf16_t, WS_WOUT) + (size_t)l * D * D, D, kb * 64, nb * 32, nb * 32, scr, lane); continue; }
        r -= I_OUT;
        if (r < 2 * I_G) { const int up = r / I_G; r %= I_G; const int kb = r / 88, nb = r % 88, n0 = nb * 32;
            transpose_item((up ? p.w_up : p.w_gate) + (size_t)l * D * FF, FF, WSP(bf16_t, WS_WGU) + (size_t)l * 2 * FF * D, D, kb * 64, n0, (n0 / 128) * 256 + up * 128 + (n0 % 128), scr, lane); continue; }
        r -= 2 * I_G;
        { const int kb = r / 32, nb = r % 32; transpose_item(p.w_down + (size_t)l * FF * D, D, WSP(bf16_t, WS_WDN) + (size_t)l * D * FF, FF, kb * 64, nb * 32, nb * 32, scr, lane); }
    }
}

__device__ __forceinline__ void ph_adaln(const P& p, unsigned char* smem) {
    float* sc = (float*)smem;
    float* red = sc + NC * 256;
    const int tid = tidx(), col = tid & 31, kg = tid >> 5;
    float* MOD = WSP(float, WS_MOD);
    for (int it = blockIdx.x; it < NL * 192; it += gridDim.x) {
        const int l = it / 192, cb0 = (it % 192) * 32;
        float acc[NC];
#pragma unroll
        for (int r = 0; r < NC; ++r) acc[r] = 0.f;
        for (int kc = 0; kc < 4; ++kc) {
            __syncthreads();
            for (int e = tid; e < NC * 256; e += NTHR) { const int r = e >> 8, k = e & 255; const float c = r < PB ? p.c_prompt[r * D + kc * 256 + k] : p.c_sample[(r - PB) * D + kc * 256 + k]; sc[e] = silu_f(c); }
            __syncthreads();
            for (int kk = 0; kk < 16; ++kk) { const int k = kg * 16 + kk; const float w = p.ada_w[((size_t)l * D + kc * 256 + k) * 6144 + cb0 + col];
#pragma unroll
                for (int r = 0; r < NC; ++r) acc[r] += sc[r * 256 + k] * w; }
        }
#pragma unroll
        for (int r = 0; r < NC; ++r) red[(kg * NC + r) * 32 + col] = acc[r];
        __syncthreads();
        for (int e = tid; e < NC * 32; e += NTHR) { const int r = e >> 5, c = e & 31; float s = p.ada_b[l * 6144 + cb0 + c];
            for (int g = 0; g < 16; ++g) s += red[(g * NC + r) * 32 + c];
            MOD[((size_t)l * NC + r) * 6144 + cb0 + c] = s; }
        __syncthreads();
    }
}

__device__ __forceinline__ void ph_ropetab_copyx(const P& p) {
    const size_t gt = (size_t)blockIdx.x * NTHR + tidx(), ng = (size_t)gridDim.x * NTHR;
    float* tab = WSP(float, WS_ROPE);
    for (size_t e = gt; e < (size_t)NPOS * 32; e += ng) {
        const int pi = (int)(e >> 5), i = (int)(e & 31); const double pos = pi < T ? (double)pi : (double)(PAST + pi - T);
        const double ia = exp(-log(10000.0) * (double)i / 32.0), ir = exp(-log(10000.0) * (double)i / 31.0);
        tab[e] = (float)cos(pos * ia); tab[(size_t)NPOS * 32 + e] = (float)sin(pos * ia);
        tab[(size_t)2 * NPOS * 32 + e] = (float)cos(pos * ir); tab[(size_t)3 * NPOS * 32 + e] = (float)sin(pos * ir);
    }
}

template <int WHICH> __device__ __forceinline__ void ph_norm_mod(const P& p, int l) {
    const int lane = tidx() & 63, wave = tidx() >> 6, gw = blockIdx.x * 8 + wave, ngw = gridDim.x * 8;
    const float* nw = (WHICH == 0 ? p.norm_mix : p.norm_ffn) + l * D;
    bf16_t* H = WSP(bf16_t, WS_H);
    for (int r = gw; r < M; r += ngw) {
        const float* xr = (WHICH == 0 && l == 0) ? (r < MP ? p.x_prompt + (size_t)r * D : p.x_sample + (size_t)(r - MP) * D) : p.out + (size_t)r * D;
        const float* mod = WSP(float, WS_MOD) + ((size_t)l * NC + row_cb(r)) * 6144 + (WHICH == 0 ? 0 : 3072);
        f32x4 v[4]; float ss = 0.f;
#pragma unroll
        for (int j = 0; j < 4; ++j) { v[j] = *(const f32x4*)(xr + 4 * lane + 256 * j); ss += (v[j][0] * v[j][0] + v[j][1] * v[j][1]) + (v[j][2] * v[j][2] + v[j][3] * v[j][3]); }
        const float rstd = 1.0f / sqrtf(wave_sum(ss) * (1.0f / D) + EPS);
        float a8[8];
#pragma unroll
        for (int c = 0; c < 8; ++c) a8[c] = 0.f;
#pragma unroll
        for (int j = 0; j < 4; ++j) { const int k = 4 * lane + 256 * j;
            const f32x4 g = *(const f32x4*)(nw + k), sh = *(const f32x4*)(mod + k), sc = *(const f32x4*)(mod + 1024 + k);
            f32x4 h;
#pragma unroll
            for (int e = 0; e < 4; ++e) h[e] = v[j][e] * rstd * g[e] * (1.0f + sc[e]) + sh[e];
            u32x2 w; w.x = pk2(h[0], h[1]); w.y = pk2(h[2], h[3]); *(u32x2*)(H + (size_t)r * D + k) = w;
            if (WHICH == 0) {
#pragma unroll
                for (int e = 0; e < 4; ++e) { const float* wr = p.w_in + ((size_t)l * D + k + e) * INC + NPROJ; const f32x4 w0 = *(const f32x4*)wr, w1 = *(const f32x4*)(wr + 4);
#pragma unroll
                    for (int c = 0; c < 4; ++c) { a8[c] += h[e] * w0[c]; a8[4 + c] += h[e] * w1[c]; } }
            }
        }
        if (WHICH == 0) {
#pragma unroll
            for (int c = 0; c < 8; ++c) a8[c] = wave_sum(a8[c]);
            if (lane < 4) { float braw = lane == 0 ? a8[0] : lane == 1 ? a8[1] : lane == 2 ? a8[2] : a8[3]; WSP(float, WS_BETA)[(size_t)r * 4 + lane] = 1.0f / (1.0f + expf(-braw)); }
            else if (lane < 8) { const int hh = lane - 4; float araw = hh == 0 ? a8[4] : hh == 1 ? a8[5] : hh == 2 ? a8[6] : a8[7];
                const float xx = araw + p.dt_bias[l * 4 + hh]; const float sp = xx > 20.f ? xx : log1pf(expf(xx));
                WSP(float, WS_G)[(size_t)r * 4 + hh] = -expf(p.a_log[l * 4 + hh]) * sp; }
        }
    }
}

__device__ __forceinline__ void ph_rope_out(const P& p, int l) {
    const size_t gt = (size_t)blockIdx.x * NTHR + tidx(), ng = (size_t)gridDim.x * NTHR;
    bf16_t* PR = WSP(bf16_t, WS_PROJ); const float* tab = WSP(float, WS_ROPE);
    for (size_t e = gt; e < (size_t)M * 512; e += ng) {
        const int r = (int)(e >> 9), rem = (int)(e & 511), sec = rem >> 7, hh = (rem & 127) >> 5, d = rem & 31;
        if (sec >= 2 && r < MP) continue;
        const int off = sec == 0 ? C_QA : sec == 1 ? C_KA : sec == 2 ? C_QR : C_KR; const float scale = sec == 0 ? 0.125f * LOG2E : sec == 3 ? 0.125f : 1.0f;
        const float* ct = tab + (size_t)(sec >= 2 ? 2 : 0) * NPOS * 32 + (size_t)row_pi(r) * 32 + d; const float c = ct[0], s = ct[(size_t)NPOS * 32];
        bf16_t* x = PR + (size_t)r * NPROJ + off + hh * 64 + d; const float x1 = bf2f(x[0]), x2 = bf2f(x[32]);
        const float o1 = (x1 * c - x2 * s) * scale, o2 = (x1 * s + x2 * c) * scale;
        x[0] = f2bf(o1); x[32] = f2bf(o2);
        if (sec == 1) {
            if (r < MP) { const int b = r / T, t = r % T; bf16_t* kh = WSP(bf16_t, WS_KH) + ((size_t)(b * 4 + hh) * T + t) * 64 + d; kh[0] = f2bf(o1); kh[32] = f2bf(o2);
                if (t >= T - PWIN) { float* o = p.out + O_PWK + (((size_t)l * PB + b) * PWIN + (t - (T - PWIN))) * 256 + hh * 64 + d; o[0] = o1; o[32] = o2; } }
            else { const int b = (r - MP) / DS, i = (r - MP) % DS; float* o = p.out + O_SWK + (((size_t)l * DB + b) * DS + i) * 256 + hh * 64 + d; o[0] = o1; o[32] = o2; }
        }
    }
    for (size_t e = gt; e < (size_t)M * 256; e += ng) {
        const int r = (int)(e >> 8), c = (int)(e & 255); const float v = bf2f(PR[(size_t)r * NPROJ + C_VA + c]);
        if (r < MP) { const int b = r / T, t = r % T; if (t >= T - PWIN) p.out[O_PWV + (((size_t)l * PB + b) * PWIN + (t - (T - PWIN))) * 256 + c] = v; }
        else { const int b = (r - MP) / DS, i = (r - MP) % DS; p.out[O_SWV + (((size_t)l * DB + b) * DS + i) * 256 + c] = v; }
    }
    for (size_t e = gt; e < (size_t)(PB + DB) * 3 * 1536; e += ng) {
        const int c = (int)(e % 1536), j = (int)((e / 1536) % 3), bb = (int)(e / (3 * 1536));
        if (bb < PB) p.out[O_PCONV + (((size_t)l * PB + bb) * 3 + j) * 1536 + c] = bf2f(PR[(size_t)(bb * T + T - 3 + j) * NPROJ + C_CONV + c]);
        else { const int b = bb - PB; p.out[O_SCONV + (((size_t)l * DB + b) * 3 + j) * 1536 + c] = bf2f(PR[(size_t)(MP + b * DS + DS - 3 + j) * NPROJ + C_CONV + c]); }
    }
}

__device__ __forceinline__ void attn_wave_sample(const P& p, int l, int r, int h, int lane, float* sw  ) {
    const bf16_t* PR = WSP(bf16_t, WS_PROJ);
    const int b = (r - MP) / DS; const int tq = WB + (r - MP) % DS;
    float q[64];
    { const bf16_t* qp = PR + (size_t)r * NPROJ + C_QA + h * 64;
#pragma unroll
      for (int j = 0; j < 8; ++j) { const bf16x8 v = *(const bf16x8*)(qp + 8 * j);
#pragma unroll
          for (int e = 0; e < 8; ++e) q[8 * j + e] = bf2f((bf16_t)v[e]); } }
    float mx = -INFINITY;
#pragma unroll 1
    for (int i = 0; i < 7; ++i) {
        const int e = lane + 64 * i;
        if (e < 387) { const int pat = e / 129, j = e % 129, dil = pat == 0 ? 1 : pat == 1 ? 4 : 16; const int rr = tq - dil * j;
            float a = 0.f;
            if (rr < WB) { const float* kp = p.cache_k + ((((size_t)l * DB + b) * WB + rr) * 4 + h) * 64;
#pragma unroll
                for (int j4 = 0; j4 < 16; ++j4) { const f32x4 kv = *(const f32x4*)(kp + 4 * j4); a += q[4 * j4] * kv[0] + q[4 * j4 + 1] * kv[1] + q[4 * j4 + 2] * kv[2] + q[4 * j4 + 3] * kv[3]; } }
            else { const bf16_t* kp = PR + (size_t)(MP + b * DS + (rr - WB)) * NPROJ + C_KA + h * 64;
#pragma unroll
                for (int j8 = 0; j8 < 8; ++j8) { const bf16x8 kv = *(const bf16x8*)(kp + 8 * j8);
#pragma unroll
                    for (int e2 = 0; e2 < 8; ++e2) a += q[8 * j8 + e2] * bf2f((bf16_t)kv[e2]); } }
            sw[e] = a; mx = fmaxf(mx, a); }
    }
    mx = wave_max(mx);
    float lsum = 0.f;
#pragma unroll 1
    for (int i = 0; i < 7; ++i) { const int e = lane + 64 * i; if (e < 387) { const float pe = exp2f(sw[e] - mx); sw[e] = pe; lsum += pe; } }
    lsum = wave_sum(lsum);
    WAVE_SYNC();
    const int kg = lane >> 4, dq = lane & 15; f32x4 o4 = (f32x4){0.f, 0.f, 0.f, 0.f};
#pragma unroll 8
    for (int e = kg; e < 387; e += 4) {
        const float pe = sw[e];
        const int pat = e / 129, j = e % 129, dil = pat == 0 ? 1 : pat == 1 ? 4 : 16; const int rr = tq - dil * j;
        f32x4 v;
        if (rr < WB) v = *(const f32x4*)(p.cache_v + ((((size_t)l * DB + b) * WB + rr) * 4 + h) * 64 + 4 * dq);
        else { const u32x2 w = *(const u32x2*)(PR + (size_t)(MP + b * DS + (rr - WB)) * NPROJ + C_VA + h * 64 + 4 * dq);
            v = (f32x4){bf2f((bf16_t)(w.x & 0xffff)), bf2f((bf16_t)(w.x >> 16)), bf2f((bf16_t)(w.y & 0xffff)), bf2f((bf16_t)(w.y >> 16))}; }
        o4 += pe * v;
    }
#pragma unroll
    for (int e = 0; e < 4; ++e) { float x = o4[e]; x += __shfl_xor(x, 16); x += __shfl_xor(x, 32); o4[e] = x; }
    WAVE_SYNC();
    if (kg == 0) { const float inv = 1.0f / lsum; u32x2 w; w.x = pk2(o4[0] * inv, o4[1] * inv); w.y = pk2(o4[2] * inv, o4[3] * inv);
        *(u32x2*)(WSP(bf16_t, WS_O) + (size_t)r * D + h * 64 + 4 * dq) = w; }
}
__device__ __forceinline__ void ph_attn_sample(const P& p, int l, unsigned char* smem) {
    const int lane = tidx() & 63, wave = tidx() >> 6, gw = (gridDim.x - 1 - blockIdx.x) * 8 + wave, ngw = gridDim.x * 8;
    float* sw = (float*)smem + wave * 392;
    for (int it = gw; it < MS * 4; it += ngw) attn_wave_sample(p, l, MP + (it >> 2), it & 3, lane, sw);
}
__device__ __forceinline__ bf16x8 pack8(const f32x16& v, int s8) {
    u32x4 w; w.x = pk2(v[s8], v[s8 + 1]); w.y = pk2(v[s8 + 2], v[s8 + 3]); w.z = pk2(v[s8 + 4], v[s8 + 5]); w.w = pk2(v[s8 + 6], v[s8 + 7]); return __builtin_bit_cast(bf16x8, w);
}
__device__ __forceinline__ void attn_job(const P& p, int jb, int lane) {
    const int c = lane & 31, hi = lane >> 5;
    constexpr int NB = T / 512;
    const int unit = jb / 48, jj = jb % 48, pat = jj >> 4, sub = jj & 15;
    const int blk = unit % NB, h = (unit / NB) & 3, b = unit / (NB * 4), bh = b * 4 + h;
    int dil, r, qi0; const bf16_t* VT;
    if (pat == 0) { dil = 1; r = 0; qi0 = blk * 512 + sub * 32; VT = WSP(bf16_t, WS_VT1) + (size_t)bh * 64 * T; }
    else if (pat == 1) { dil = 4; r = sub >> 2; qi0 = blk * 128 + (sub & 3) * 32; VT = WSP(bf16_t, WS_VT4) + (size_t)(bh * 4 + r) * 64 * (T / 4); }
    else { dil = 16; r = sub; qi0 = blk * 32; VT = WSP(bf16_t, WS_VT16) + (size_t)(bh * 16 + r) * 64 * (T / 16); }
    const int SL = T / dil;
    const int tq = dil * (qi0 + c) + r;
    const bf16_t* qp = WSP(bf16_t, WS_PROJ) + (size_t)(b * T + tq) * NPROJ + C_QA + h * 64 + 8 * hi;
    bf16x8 qf[4];
#pragma unroll
    for (int ks = 0; ks < 4; ++ks) qf[ks] = *(const bf16x8*)(qp + 16 * ks);
    const bf16_t* KHb = WSP(bf16_t, WS_KH) + (size_t)bh * T * 64;
    f32x16 S[5];
#pragma unroll
    for (int i = 0; i < 5; ++i) {
        const int kt0 = qi0 - 128 + 32 * i;
        f32x16 acc;
#pragma unroll
        for (int e = 0; e < 16; ++e) acc[e] = 0.f;
        if (kt0 >= 0) { const bf16_t* kp = KHb + (size_t)(dil * (kt0 + c) + r) * 64 + 8 * hi;
#pragma unroll
            for (int ks = 0; ks < 4; ++ks) acc = MFMA32(*(const bf16x8*)(kp + 16 * ks), qf[ks], acc);
            if (i == 0) {
#pragma unroll
                for (int e = 0; e < 16; ++e) { const int krow = (e & 3) + 8 * (e >> 2) + 4 * hi; if (krow < c) acc[e] = -INFINITY; } }
            if (i == 4) {
#pragma unroll
                for (int e = 0; e < 16; ++e) { const int krow = (e & 3) + 8 * (e >> 2) + 4 * hi; if (krow > c) acc[e] = -INFINITY; } }
        } else {
#pragma unroll
            for (int e = 0; e < 16; ++e) acc[e] = -INFINITY; }
        S[i] = acc;
    }
    float mx = -INFINITY;
#pragma unroll
    for (int i = 0; i < 5; ++i)
#pragma unroll
        for (int e = 0; e < 16; ++e) mx = fmaxf(mx, S[i][e]);
    mx = fmaxf(mx, __shfl_xor(mx, 32));
    float lsum = 0.f;
#pragma unroll
    for (int i = 0; i < 5; ++i)
#pragma unroll
        for (int e = 0; e < 16; ++e) { const float pe = exp2f(S[i][e] - mx); S[i][e] = pe; lsum += pe; }
    lsum += __shfl_xor(lsum, 32);
    f32x16 O[2];
#pragma unroll
    for (int dt = 0; dt < 2; ++dt)
#pragma unroll
        for (int e = 0; e < 16; ++e) O[dt][e] = 0.f;
#pragma unroll
    for (int i = 0; i < 5; ++i) {
        const int kt0 = qi0 - 128 + 32 * i;
        if (kt0 >= 0) {
#pragma unroll
            for (int s2 = 0; s2 < 2; ++s2) { const bf16x8 pf = pack8(S[i], 8 * s2);
#pragma unroll
                for (int dt = 0; dt < 2; ++dt) { const bf16_t* vp = VT + (size_t)(dt * 32 + c) * SL + kt0 + 16 * s2 + 4 * hi;
                    const u32x2 lo = *(const u32x2*)vp, hh = *(const u32x2*)(vp + 8); u32x4 w; w.x = lo.x; w.y = lo.y; w.z = hh.x; w.w = hh.y;
                    O[dt] = MFMA32(__builtin_bit_cast(bf16x8, w), pf, O[dt]); } }
        }
    }
    const size_t idx = ((size_t)(b * T + tq) * 4 + h) * 3 + pat;
    bf16_t* po = WSP(bf16_t, WS_APO) + idx * 64;
#pragma unroll
    for (int dt = 0; dt < 2; ++dt)
#pragma unroll
        for (int g = 0; g < 4; ++g) { u32x2 w; w.x = pk2(O[dt][4 * g], O[dt][4 * g + 1]); w.y = pk2(O[dt][4 * g + 2], O[dt][4 * g + 3]); *(u32x2*)(po + 32 * dt + 8 * g + 4 * hi) = w; }
    if (hi == 0) { float* ml = WSP(float, WS_AML) + idx * 2; ml[0] = mx; ml[1] = lsum; }
}
__device__ __forceinline__ void ph_attn_jobs(const P& p) {
    const int lane = tidx() & 63, wave = tidx() >> 6, gw = blockIdx.x * 8 + wave, ngw = gridDim.x * 8;
    for (int jb = gw; jb < PB * 4 * (T / 512) * 48; jb += ngw) attn_job(p, jb, lane);
}
__device__ __forceinline__ void ph_attn_combine(const P& p) {
    const size_t gt = (size_t)blockIdx.x * NTHR + tidx(), ng = (size_t)gridDim.x * NTHR;
    for (size_t e = gt; e < (size_t)MP * 4 * 16; e += ng) {
        const size_t rh = e >> 4; const int dq = (int)(e & 15) * 4;
        const float* ml = WSP(float, WS_AML) + rh * 6; const float m0 = ml[0], m1 = ml[2], m2 = ml[4];
        const float mm = fmaxf(m0, fmaxf(m1, m2)); const float w0 = exp2f(m0 - mm), w1 = exp2f(m1 - mm), w2 = exp2f(m2 - mm);
        const float inv = 1.0f / (w0 * ml[1] + w1 * ml[3] + w2 * ml[5]);
        const bf16_t* po = WSP(bf16_t, WS_APO) + rh * 192 + dq;
        const u32x2 a = *(const u32x2*)po, bq = *(const u32x2*)(po + 64), cq = *(const u32x2*)(po + 128);
        float o[4];
        o[0] = w0 * bf2f((bf16_t)(a.x & 0xffff)) + w1 * bf2f((bf16_t)(bq.x & 0xffff)) + w2 * bf2f((bf16_t)(cq.x & 0xffff));
        o[1] = w0 * bf2f((bf16_t)(a.x >> 16)) + w1 * bf2f((bf16_t)(bq.x >> 16)) + w2 * bf2f((bf16_t)(cq.x >> 16));
        o[2] = w0 * bf2f((bf16_t)(a.y & 0xffff)) + w1 * bf2f((bf16_t)(bq.y & 0xffff)) + w2 * bf2f((bf16_t)(cq.y & 0xffff));
        o[3] = w0 * bf2f((bf16_t)(a.y >> 16)) + w1 * bf2f((bf16_t)(bq.y >> 16)) + w2 * bf2f((bf16_t)(cq.y >> 16));
        const size_t row = rh >> 2; const int h = (int)(rh & 3);
        u32x2 w; w.x = pk2(o[0] * inv, o[1] * inv); w.y = pk2(o[2] * inv, o[3] * inv);
        *(u32x2*)(WSP(bf16_t, WS_O) + row * D + h * 64 + dq) = w;
    }
}
__device__ __forceinline__ float ret_lg(int h) { return logf(1.0f - exp2f(-5.0f - (float)h)); }
__device__ __forceinline__ void trans_write(const bf16_t* tile, bf16_t* dst  , int tile0, int tid) {
#pragma unroll
    for (int k = 0; k < 4; ++k) { const int ch = tid + NTHR * k, d = ch >> 5, t0 = (ch & 31) * 8; u32x4 w;
        w.x = (unsigned)tile[(t0 + 0) * 72 + d] | ((unsigned)tile[(t0 + 1) * 72 + d] << 16); w.y = (unsigned)tile[(t0 + 2) * 72 + d] | ((unsigned)tile[(t0 + 3) * 72 + d] << 16);
        w.z = (unsigned)tile[(t0 + 4) * 72 + d] | ((unsigned)tile[(t0 + 5) * 72 + d] << 16); w.w = (unsigned)tile[(t0 + 6) * 72 + d] | ((unsigned)tile[(t0 + 7) * 72 + d] << 16);
        *(u32x4*)(dst + (size_t)d * T + tile0 + t0) = w; }
}
__device__ __forceinline__ void ph_vtrans(const P& p, unsigned char* smem) {
    bf16_t* vt = (bf16_t*)smem; bf16_t* vr = vt + 256 * 72; bf16_t* kt = vr + 256 * 72;
    const int tid = tidx(); bf16_t* PR = WSP(bf16_t, WS_PROJ); const float* tab = WSP(float, WS_ROPE);
    for (int u = blockIdx.x; u < PB * 4 * (T / 256); u += gridDim.x) {
        const int tile = u % (T / 256), bh = u / (T / 256), h = bh & 3, b = bh >> 2; const float lg = ret_lg(h);
        __syncthreads();
#pragma unroll
        for (int k = 0; k < 4; ++k) { const int ch = tid + NTHR * k, t = ch >> 3, d8 = (ch & 7) * 8; const bf16_t* src = PR + (size_t)(b * T + tile * 256 + t) * NPROJ + h * 64 + d8;
            *(u32x4*)(vt + t * 72 + d8) = *(const u32x4*)(src + C_VA); *(u32x4*)(vr + t * 72 + d8) = *(const u32x4*)(src + C_VR); }
#pragma unroll 4
        for (int k = 0; k < 16; ++k) { const int e = tid + NTHR * k, t = e >> 5, d = e & 31, tt = tile * 256 + t; bf16_t* row = PR + (size_t)(b * T + tt) * NPROJ + h * 64 + d;
            const float c = tab[(size_t)2 * NPOS * 32 + (size_t)tt * 32 + d], sn = tab[(size_t)3 * NPOS * 32 + (size_t)tt * 32 + d]; const float gq = expf(lg * (float)(tt & 63)), gk = 0.125f / gq;
            { const float x1 = bf2f(row[C_QR]), x2 = bf2f(row[C_QR + 32]); row[C_QR] = f2bf((x1 * c - x2 * sn) * gq); row[C_QR + 32] = f2bf((x1 * sn + x2 * c) * gq); }
            { const float x1 = bf2f(row[C_KR]), x2 = bf2f(row[C_KR + 32]); const bf16_t o1 = f2bf((x1 * c - x2 * sn) * gk), o2 = f2bf((x1 * sn + x2 * c) * gk);
              row[C_KR] = o1; row[C_KR + 32] = o2; kt[t * 72 + d] = o1; kt[t * 72 + d + 32] = o2; } }
        __syncthreads();
        trans_write(vt, WSP(bf16_t, WS_VT1) + (size_t)bh * 64 * T, tile * 256, tid);
        trans_write(vr, WSP(bf16_t, WS_VRT) + (size_t)bh * 64 * T, tile * 256, tid);
        trans_write(kt, WSP(bf16_t, WS_KRT) + (size_t)bh * 64 * T, tile * 256, tid);
#pragma unroll
        for (int k = 0; k < 4; ++k) { const int ch = tid + NTHR * k;
            { const int r = ch >> 9, d = (ch >> 3) & 63, s0 = (ch & 7) * 8; u32x4 w;
#define VT4E(e_) ((unsigned)vt[(4 * (s0 + (e_)) + r) * 72 + d])
              w.x = VT4E(0) | (VT4E(1) << 16); w.y = VT4E(2) | (VT4E(3) << 16); w.z = VT4E(4) | (VT4E(5) << 16); w.w = VT4E(6) | (VT4E(7) << 16);
#undef VT4E
              *(u32x4*)(WSP(bf16_t, WS_VT4) + ((size_t)(bh * 4 + r) * 64 + d) * (T / 4) + tile * 64 + s0) = w; }
            { const int r = ch >> 7, d = (ch >> 1) & 63, s0 = (ch & 1) * 8; u32x4 w;
#define VT16E(e_) ((unsigned)vt[(16 * (s0 + (e_)) + r) * 72 + d])
              w.x = VT16E(0) | (VT16E(1) << 16); w.y = VT16E(2) | (VT16E(3) << 16); w.z = VT16E(4) | (VT16E(5) << 16); w.w = VT16E(6) | (VT16E(7) << 16);
#undef VT16E
              *(u32x4*)(WSP(bf16_t, WS_VT16) + ((size_t)(bh * 16 + r) * 64 + d) * (T / 16) + tile * 16 + s0) = w; }
        }
    }
}

__device__ __forceinline__ void ph_ret_local(const P& p, int l) {
    const int tid = tidx(), lane = tid & 63, wave = tid >> 6, x = lane & 15, q = lane >> 4, dt = wave >> 1;
    for (int u = blockIdx.x; u < NUNIT; u += gridDim.x) {
        const int n = u % NCH, bh = u / NCH, h = bh & 3, t0 = n * 64; const float g63 = expf(ret_lg(h) * 63.0f);
        const bf16_t* ka = WSP(bf16_t, WS_KRT) + ((size_t)bh * 64 + 16 * dt + x) * T + t0 + 8 * q;
#pragma unroll
        for (int k = 0; k < 2; ++k) { const int et = 2 * (wave & 1) + k; const bf16_t* vb = WSP(bf16_t, WS_VRT) + ((size_t)bh * 64 + 16 * et + x) * T + t0 + 8 * q;
            f32x4 acc = (f32x4){0.f, 0.f, 0.f, 0.f};
#pragma unroll
            for (int ks = 0; ks < 2; ++ks) acc = MFMA16(*(const bf16x8*)(ka + 32 * ks), *(const bf16x8*)(vb + 32 * ks), acc);
            *(f32x4*)(WSP(float, WS_RU) + (size_t)u * 4096 + (16 * et + x) * 64 + 16 * dt + 4 * q) = acc * g63; }
    }
}
__device__ __forceinline__ void ph_ret_scan(const P& p, int l) {
    const int gt = blockIdx.x * NTHR + tidx(), ng = gridDim.x * NTHR;
    for (int e = gt; e < PB * 4 * 4096; e += ng) {
        const int bh = e >> 12, ed = e & 4095, h = bh & 3; const float cd = expf(ret_lg(h) * 64.0f);
        const float* U = WSP(float, WS_RU) + (size_t)bh * NCH * 4096 + ed; bf16_t* SPv = WSP(bf16_t, WS_RS) + (size_t)bh * NCH * 4096 + ed;
        float s = 0.f;
        for (int n0 = 0; n0 < NCH; n0 += 8) {
            float uv[8];
#pragma unroll
            for (int k = 0; k < 8; ++k) uv[k] = U[(size_t)(n0 + k) * 4096];
#pragma unroll
            for (int k = 0; k < 8; ++k) { SPv[(size_t)(n0 + k) * 4096] = f2bf(s); s = s * cd + uv[k]; } }
        p.out[O_PRET + ((size_t)l * PB * 4 + bh) * 4096 + (ed & 63) * 64 + (ed >> 6)] = s;
    }
}
__device__ __forceinline__ void ph_ret_out(const P& p, int l) {
    const int tid = tidx(), lane = tid & 63, wave = tid >> 6, x = lane & 15, q = lane >> 4, it = UNIFORM(wave & 3);
    const bf16_t* PR = WSP(bf16_t, WS_PROJ);
    for (int u = blockIdx.x * 2 + (wave >> 2); u < NUNIT; u += gridDim.x * 2) {
        const int n = u % NCH, bh = u / NCH, h = bh & 3, b = bh >> 2, t0 = n * 64; const float gam = expf(ret_lg(h));
        const size_t rowi = (size_t)(b * T + t0 + 16 * it + x);
        bf16x8 qf[2];
#pragma unroll
        for (int ks = 0; ks < 2; ++ks) qf[ks] = *(const bf16x8*)(PR + rowi * NPROJ + C_QR + h * 64 + 32 * ks + 8 * q);
        f32x4 at[4];
#pragma unroll
        for (int jt = 0; jt < 4; ++jt) { at[jt] = (f32x4){0.f, 0.f, 0.f, 0.f};
            if (jt <= it) { const bf16_t* kp = PR + (size_t)(b * T + t0 + 16 * jt + x) * NPROJ + C_KR + h * 64 + 8 * q;
#pragma unroll
                for (int ks = 0; ks < 2; ++ks) at[jt] = MFMA16(*(const bf16x8*)(kp + 32 * ks), qf[ks], at[jt]);
                if (jt == it) {
#pragma unroll
                    for (int e = 0; e < 4; ++e) if (4 * q + e > x) at[jt][e] = 0.f; } } }
        const bf16x8 pb0 = pack_tiles(at[0], at[1]), pb1 = pack_tiles(at[2], at[3]);
        f32x4 o[4], os[4];
#pragma unroll
        for (int et = 0; et < 4; ++et) { o[et] = (f32x4){0.f, 0.f, 0.f, 0.f}; os[et] = (f32x4){0.f, 0.f, 0.f, 0.f};
            const bf16_t* vp = WSP(bf16_t, WS_VRT) + ((size_t)bh * 64 + 16 * et + x) * T + t0 + 4 * q;
            { const u32x2 lo = *(const u32x2*)vp, hi = *(const u32x2*)(vp + 16); u32x4 w; w.x = lo.x; w.y = lo.y; w.z = hi.x; w.w = hi.y; o[et] = MFMA16(__builtin_bit_cast(bf16x8, w), pb0, o[et]); }
            if (it >= 2) { const u32x2 lo = *(const u32x2*)(vp + 32), hi = *(const u32x2*)(vp + 48); u32x4 w; w.x = lo.x; w.y = lo.y; w.z = hi.x; w.w = hi.y; o[et] = MFMA16(__builtin_bit_cast(bf16x8, w), pb1, o[et]); }
            const bf16_t* sp = WSP(bf16_t, WS_RS) + (size_t)u * 4096 + (16 * et + x) * 64 + 8 * q;
#pragma unroll
            for (int ks = 0; ks < 2; ++ks) os[et] = MFMA16(*(const bf16x8*)(sp + 32 * ks), qf[ks], os[et]);
            o[et] = o[et] + os[et] * gam; }
        float sq = 0.f;
#pragma unroll
        for (int et = 0; et < 4; ++et) sq += (o[et][0] * o[et][0] + o[et][1] * o[et][1]) + (o[et][2] * o[et][2] + o[et][3] * o[et][3]);
        sq += __shfl_xor(sq, 16); sq += __shfl_xor(sq, 32);
        const float rstd = 1.0f / sqrtf(sq * (1.0f / 64.0f) + EPS);
#pragma unroll
        for (int et = 0; et < 4; ++et) { const int e0 = 16 * et + 4 * q; const u32x2 gw = *(const u32x2*)(PR + rowi * NPROJ + C_GR + h * 64 + e0); const f32x4 nw = *(const f32x4*)(p.ret_norm + l * 64 + e0);
            const float g0 = bf2f((bf16_t)(gw.x & 0xffff)), g1 = bf2f((bf16_t)(gw.x >> 16)), g2 = bf2f((bf16_t)(gw.y & 0xffff)), g3 = bf2f((bf16_t)(gw.y >> 16));
            u32x2 w; w.x = pk2(o[et][0] * rstd * nw[0] * silu_f(g0), o[et][1] * rstd * nw[1] * silu_f(g1)); w.y = pk2(o[et][2] * rstd * nw[2] * silu_f(g2), o[et][3] * rstd * nw[3] * silu_f(g3));
            *(u32x2*)(WSP(bf16_t, WS_O) + rowi * D + 256 + h * 64 + e0) = w; }
    }
}
__device__ __forceinline__ void ph_ret_sample(const P& p, int l, unsigned char* smem) {
    float* S0 = (float*)smem; float* qs = S0 + 4096; float* ks = qs + 8 * 64; float* vs = ks + 8 * 64;
    const int tid = tidx(); const bf16_t* PR = WSP(bf16_t, WS_PROJ);
    for (int u = gridDim.x - 1 - blockIdx.x; u < DB * 4; u += gridDim.x) {
        const int h = u & 3, b = u >> 2; const float lg = ret_lg(h);
        __syncthreads();
        for (int e = tid; e < 4096; e += NTHR) S0[e] = p.state_ret[(((size_t)l * DB + b) * 4 + h) * 4096 + e];
        { const int j = tid >> 6, d = tid & 63; const size_t row = (size_t)(MP + b * DS + j) * NPROJ;
          qs[tid] = bf2f(PR[row + C_QR + h * 64 + d]); ks[tid] = bf2f(PR[row + C_KR + h * 64 + d]); vs[tid] = bf2f(PR[row + C_VR + h * 64 + d]); }
        __syncthreads();
        { const int i = tid >> 6, e = tid & 63; float o = 0.f;
          for (int j = 0; j <= i; ++j) { float a = 0.f; for (int d = 0; d < 64; ++d) a += qs[i * 64 + d] * ks[j * 64 + d]; o += a * expf(lg * (float)(i - j)) * vs[j * 64 + e]; }
          float o2 = 0.f; for (int d = 0; d < 64; ++d) o2 += qs[i * 64 + d] * S0[d * 64 + e];
          o += o2 * expf(lg * (float)(i + 1));
          const float rstd = 1.0f / sqrtf(wave_sum(o * o) * (1.0f / 64.0f) + EPS);
          const size_t row = (size_t)(MP + b * DS + i); const float g = bf2f(PR[row * NPROJ + C_GR + h * 64 + e]);
          WSP(bf16_t, WS_O)[row * D + 256 + h * 64 + e] = f2bf(o * rstd * p.ret_norm[l * 64 + e] * silu_f(g)); }
        for (int x = tid; x < 4096; x += NTHR) { const int d = x >> 6, e = x & 63; float s = S0[x] * expf(lg * (float)DS);
            for (int j = 0; j < DS; ++j) s += ks[j * 64 + d] * expf(lg * (float)(DS - 1 - j)) * vs[j * 64 + e];
            p.out[O_SRET + (((size_t)l * DB + b) * 4 + h) * 4096 + x] = s; }
    }
}

template <int CS, int LDL> __device__ __forceinline__ void fwd_subst(float (&X)[CS], const float* Ls) {
#pragma unroll
    for (int i = 1; i < CS; ++i) {
        float a = X[i];
#pragma unroll
        for (int j4 = 0; j4 < (i + 3) / 4; ++j4) { const f32x4 lv = *(const f32x4*)(Ls + i * LDL + 4 * j4);
#pragma unroll
            for (int e = 0; e < 4; ++e) if (4 * j4 + e < i) a -= lv[e] * X[4 * j4 + e]; }
        X[i] = a;
    }
}
constexpr int QP = 132;
constexpr int WSTP = 136;
constexpr int RWP = 392, TP = 136;
__device__ __forceinline__ void ph_gdn_prep(const P& p, int l, unsigned char* smem) {
    float* Ls = (float*)smem; float* As = Ls + 64 * 68; float* gs = As + 64 * 68; float* gcs = gs + 64; float* bts = gcs + 64; float* part = bts + 64;
    bf16_t* raw = (bf16_t*)(part + 4 * 64); bf16_t* Khi = raw + 67 * RWP; bf16_t* Klo = Khi + 64 * TP; bf16_t* Qb = Klo + 64 * TP;
    static_assert((64 * 68 * 2 + 64 * 3 + 4 * 64) * 4 + (67 * RWP + 3 * 64 * TP) * 2 <= BAR_LDS_OFF, "gdn_prep LDS");
    const int tid = tidx(), lane = tid & 63, wave = tid >> 6; const bf16_t* PR = WSP(bf16_t, WS_PROJ);
    for (int u = blockIdx.x; u < NUNIT; u += gridDim.x) {
        const int n = u % NCH, h = (u / NCH) % 4, b = u / (NCH * 4), t0 = n * 64;
        __syncthreads();
        for (int e = tid; e < 67 * 48; e += NTHR) { const int row = e / 48, ch = e % 48, t = t0 - 3 + row; u32x4 v = (u32x4){0u, 0u, 0u, 0u};
            if (t >= 0) v = *(const u32x4*)(PR + (size_t)(b * T + t) * NPROJ + C_CONV + (ch >> 4) * 512 + h * 128 + (ch & 15) * 8);
            *(u32x4*)(raw + row * RWP + ch * 8) = v; }
        if (tid >= 384 && tid < 448) { const int i = tid - 384; const size_t row = (size_t)(b * T + t0 + i); gs[i] = WSP(float, WS_G)[row * 4 + h]; bts[i] = WSP(float, WS_BETA)[row * 4 + h]; }
        __syncthreads();
        float y[64]; const int sec = tid < 128 ? 2 : tid < 256 ? 1 : 0, c = tid & 127;
        if (tid < 384) { const int col = sec * 512 + h * 128 + c;
            const float w0 = p.conv_w[(l * 4 + 0) * 1536 + col], w1 = p.conv_w[(l * 4 + 1) * 1536 + col], w2 = p.conv_w[(l * 4 + 2) * 1536 + col], w3 = p.conv_w[(l * 4 + 3) * 1536 + col];
            const LAS bf16_t* rp = (const LAS bf16_t*)raw + sec * 128 + c; LAUNDER_V(rp); float x0 = bf2f(rp[0]), x1 = bf2f(rp[RWP]), x2 = bf2f(rp[2 * RWP]);
#pragma unroll
            for (int i = 0; i < 64; ++i) { const float x3 = bf2f(rp[(i + 3) * RWP]); y[i] = silu_fast(w0 * x0 + w1 * x1 + w2 * x2 + w3 * x3); x0 = x1; x1 = x2; x2 = x3; if ((i & 7) == 7) COMPILER_FENCE(); } }
        if (tid >= 448) { if (tid == 448) { float a = 0.f; for (int i = 0; i < 64; ++i) { a += gs[i]; gcs[i] = a; } }
            WAVE_SYNC(); const int i = tid - 448; part[128 + i] = expf(gcs[i]); part[192 + i] = expf(gcs[63] - gcs[i]); }
#pragma unroll
        for (int pass = 0; pass < 2; ++pass) {
            if (tid >= 128 + 128 * pass && tid < 256 + 128 * pass) { LAS float* sq = (LAS float*)Ls + c; LAUNDER_V(sq);
#pragma unroll
                for (int i = 0; i < 64; ++i) sq[i * 132] = y[i] * y[i]; }
            __syncthreads();
            { const int i = tid >> 3, pt = tid & 7; const float* rp2 = Ls + i * 132 + pt * 16; float a = 0.f;
#pragma unroll
              for (int k = 0; k < 16; ++k) a += rp2[k];
              a += __shfl_xor(a, 1); a += __shfl_xor(a, 2); a += __shfl_xor(a, 4);
              if (pt == 0) part[64 * pass + i] = 1.0f / sqrtf(a + EPS); }
            __syncthreads();
        }
        if (tid >= 128 && tid < 256) { LAS bf16_t* kh = (LAS bf16_t*)Khi + c; LAS bf16_t* kl = (LAS bf16_t*)Klo + c; LAUNDER_V(kh); LAUNDER_V(kl);
#pragma unroll
            for (int i = 0; i < 64; ++i) { const float v = y[i] * part[i]; y[i] = v; const bf16_t hb = f2bf(v); kh[i * TP] = hb; kl[i * TP] = f2bf(v - bf2f(hb)); if ((i & 7) == 7) COMPILER_FENCE(); }
            bf16_t* dst = WSP(bf16_t, WS_GWK) + (size_t)u * 16384 + 8192; const int mt = c >> 4, x = c & 15;
#pragma unroll
            for (int ks2 = 0; ks2 < 2; ++ks2)
#pragma unroll
                for (int q = 0; q < 4; ++q) { const int i0 = 32 * ks2 + 4 * q; float v[8];
#pragma unroll
                    for (int e = 0; e < 8; ++e) { const int i = i0 + (e < 4 ? e : 12 + e); v[e] = y[i] * part[192 + i]; }
                    u32x4 w; w.x = pk2(v[0], v[1]); w.y = pk2(v[2], v[3]); w.z = pk2(v[4], v[5]); w.w = pk2(v[6], v[7]);
                    *(u32x4*)(dst + ((size_t)((mt * 2 + ks2) * 64 + q * 16 + x)) * 8) = w; COMPILER_FENCE(); } }
        else if (tid >= 256 && tid < 384) { bf16_t* qg = WSP(bf16_t, WS_GQ) + (size_t)u * 8192 + c; LAS bf16_t* qb = (LAS bf16_t*)Qb + c; LAUNDER_V(qb);
#pragma unroll
            for (int i = 0; i < 64; ++i) { const float v = y[i] * part[64 + i]; qb[i * TP] = f2bf(v); qg[(i & 7) * 128] = f2bf(v * 0.08838834764831845f * part[128 + i]); if ((i & 7) == 7) { qg += 8 * 128; LAUNDER_V(qg); COMPILER_FENCE(); } } }
        __syncthreads();
#pragma unroll
        for (int tp = 0; tp < 2; ++tp) { const int pos = wave * 2 + tp, it = pos >> 2, jt = pos & 3, j16 = lane & 15, qd = lane >> 4;
            f32x4 lk = (f32x4){0.f, 0.f, 0.f, 0.f}, aq = (f32x4){0.f, 0.f, 0.f, 0.f};
            if (jt <= it) {
#pragma unroll
                for (int ks = 0; ks < 4; ++ks) { const int ao = (16 * it + j16) * TP + 32 * ks + 8 * qd, bo = (16 * jt + j16) * TP + 32 * ks + 8 * qd;
                    const bf16x8 ah = *(const bf16x8*)(Khi + ao), al = *(const bf16x8*)(Klo + ao), aqf = *(const bf16x8*)(Qb + ao), bh = *(const bf16x8*)(Khi + bo), bl = *(const bf16x8*)(Klo + bo);
                    lk = MFMA16(ah, bh, lk); lk = MFMA16(ah, bl, lk); lk = MFMA16(al, bh, lk); aq = MFMA16(aqf, bh, aq); } }
            const int j = 16 * jt + j16;
#pragma unroll
            for (int e = 0; e < 4; ++e) { const int i = 16 * it + 4 * qd + e; const float ex = j <= i ? expf(gcs[i] - gcs[j]) : 0.f;
                Ls[i * 68 + j] = j < i ? bts[i] * lk[e] * ex : 0.f; As[i * 68 + j] = aq[e] * ex * 0.08838834764831845f; } }
        __syncthreads();
        if (tid < 256) {
            if (tid < 128) {
#pragma unroll
                for (int i = 0; i < 64; ++i) { y[i] *= bts[i]; if ((i & 15) == 15) COMPILER_FENCE(); } }
            else {
#pragma unroll
                for (int i = 0; i < 64; ++i) { y[i] *= bts[i] * part[128 + i]; if ((i & 15) == 15) COMPILER_FENCE(); } }
            fwd_subst<64, 68>(y, Ls);
            if (tid < 128) { bf16_t* U = WSP(bf16_t, WS_GU) + (size_t)u * 8192 + c * 64;
#pragma unroll
                for (int i8 = 0; i8 < 8; ++i8) { u32x4 w; w.x = pk2(y[8 * i8], y[8 * i8 + 1]); w.y = pk2(y[8 * i8 + 2], y[8 * i8 + 3]); w.z = pk2(y[8 * i8 + 4], y[8 * i8 + 5]); w.w = pk2(y[8 * i8 + 6], y[8 * i8 + 7]); *(u32x4*)(U + 8 * i8) = w; } }
            else { LAS bf16_t* wst = (LAS bf16_t*)raw + c; LAUNDER_V(wst);
#pragma unroll
                for (int i = 0; i < 64; ++i) wst[i * WSTP] = f2bf(-y[i]); }
        } else { const int t2 = tid - 256;
#pragma unroll 2
            for (int e = t2; e < 4096; e += 256) WSP(bf16_t, WS_GA)[(size_t)u * 4096 + e] = f2bf(As[(e >> 6) * 68 + (e & 63)]);
            if (t2 == 0) WSP(float, WS_GD)[u] = expf(gcs[63]); }
        __syncthreads();
        { bf16_t* dst = WSP(bf16_t, WS_GWK) + (size_t)u * 16384; const bf16_t* wst = raw;
#pragma unroll
          for (int k = 0; k < 2; ++k) { const int f = tid + NTHR * k, ln = f & 63, ks4 = (f >> 6) & 3, mt = f >> 8, q = ln >> 4, x = ln & 15;
              const bf16_t* wr = wst + (16 * mt + x) * WSTP + 32 * ks4 + 4 * q;
              u32x4 w; w.x = (unsigned)wr[0] | ((unsigned)wr[1] << 16); w.y = (unsigned)wr[2] | ((unsigned)wr[3] << 16); w.z = (unsigned)wr[16] | ((unsigned)wr[17] << 16); w.w = (unsigned)wr[18] | ((unsigned)wr[19] << 16);
              *(u32x4*)(dst + (size_t)f * 8) = w; } }
    }
}
constexpr int CH_SLOT = 40960, CH_NSLOT = 3;
constexpr int CH_ITEMS = PB * 4 * 2;
static_assert(NCH % 4 == 0, "the chain's loop is unrolled by four chunks");
__device__ __forceinline__ void chain_stage(const bf16_t* WK, const bf16_t* UTh, int m, int pw, int lane, unsigned char* smem) {
    unsigned char* slot = smem + (m % CH_NSLOT) * CH_SLOT;
#pragma unroll
    for (int k = 0; k < 8; ++k) GLDS16((const unsigned char*)(WK + (size_t)m * 16384) + (pw * 8 + k) * 1024 + lane * 16, slot + (pw * 8 + k) * 1024);
#pragma unroll
    for (int k = 0; k < 2; ++k) GLDS16((const unsigned char*)(UTh + (size_t)m * 8192) + (pw * 2 + k) * 1024 + lane * 16, slot + 32768 + (pw * 2 + k) * 1024);
}
__device__ __forceinline__ void ph_gdn_chain(const P& p, int l, unsigned char* smem) {
    const int tid = tidx(), lane = tid & 63, wave = UNIFORM(tid >> 6), j = lane & 15, q = lane >> 4;
    for (int it = blockIdx.x; it < CH_ITEMS; it += gridDim.x) {
        const int half = it & 1, bh = it >> 1;
        const bf16_t* WK = WSP(bf16_t, WS_GWK) + (size_t)bh * NCH * 16384;
        const bf16_t* UTh = WSP(bf16_t, WS_GU) + (size_t)bh * NCH * 8192 + half * 4096;
        __syncthreads();
        if (wave >= 4) {
            const int pw = wave - 4;
            chain_stage(WK, UTh, 0, pw, lane, smem); chain_stage(WK, UTh, 1, pw, lane, smem);
#pragma unroll 1
            for (int n = 0; n < NCH; ++n) {
                if (n + 1 < NCH) WAIT_VM(10); else WAIT_VM(0);
                RAW_BARRIER();
                if (n + 2 < NCH) chain_stage(WK, UTh, n + 2, pw, lane, smem);
            }
        } else {
            const int sl = half * 4 + wave, c = 16 * sl + j;
            f32x4 S[8];
#pragma unroll
            for (int t = 0; t < 8; ++t) S[t] = (f32x4){0.f, 0.f, 0.f, 0.f};
            bf16x8 sB[4];
#pragma unroll
            for (int ks = 0; ks < 4; ++ks) sB[ks] = pack_tiles(S[2 * ks], S[2 * ks + 1]);
            const float* DC = WSP(float, WS_GD) + bh * NCH;
            float db[4];
#pragma unroll
            for (int d = 0; d < 4; ++d) db[d] = DC[d];
#pragma unroll 1
            for (int n0 = 0; n0 < NCH; n0 += 4) {
#pragma unroll
                for (int k4 = 0; k4 < 4; ++k4) {
                    const int n = n0 + k4, u = bh * NCH + n;
                    f32x4 acc[4]; const float dec = db[k4];
                    if (n + 4 < NCH) db[k4] = DC[n + 4];
                    { bf16_t* sp = WSP(bf16_t, WS_GS) + (size_t)u * 16384 + (size_t)sl * 2048 + lane * 4;
#pragma unroll
                      for (int t = 0; t < 8; ++t) { u32x2 w; w.x = pk2(S[t][0], S[t][1]); w.y = pk2(S[t][2], S[t][3]); *(u32x2*)(sp + 256 * t) = w; } }
                    WAIT_LGKM0();
                    RAW_BARRIER();
                    const LAS unsigned char* slot = (const LAS unsigned char*)smem + (n % CH_NSLOT) * CH_SLOT + lane * 16; LAUNDER_V(slot);
                    { const LAS unsigned char* us = (const LAS unsigned char*)smem + (n % CH_NSLOT) * CH_SLOT + 32768 + ((16 * wave + j) * 64 + 4 * q) * 2; LAUNDER_V(us);
#pragma unroll
                      for (int mt = 0; mt < 4; ++mt) { const u32x2 w = *(const LAS u32x2*)(us + 32 * mt); acc[mt] = (f32x4){bf2f((bf16_t)(w.x & 0xffff)), bf2f((bf16_t)(w.x >> 16)), bf2f((bf16_t)(w.y & 0xffff)), bf2f((bf16_t)(w.y >> 16))}; } }
                    bf16x8 fa[8], fb[8];
#pragma unroll
                    for (int i = 0; i < 8; ++i) fa[i] = *(const LAS bf16x8*)(slot + i * 1024);
#pragma unroll
                    for (int i = 0; i < 8; ++i) fb[i] = *(const LAS bf16x8*)(slot + (8 + i) * 1024);
                    COMPILER_FENCE();
#pragma unroll
                    for (int ks = 0; ks < 4; ++ks) { acc[0] = MFMA16(fa[ks], sB[ks], acc[0]); acc[1] = MFMA16(fa[4 + ks], sB[ks], acc[1]); }
                    COMPILER_FENCE();
#pragma unroll
                    for (int i = 0; i < 8; ++i) fa[i] = *(const LAS bf16x8*)(slot + 16384 + i * 1024);
#pragma unroll
                    for (int ks = 0; ks < 4; ++ks) { acc[2] = MFMA16(fb[ks], sB[ks], acc[2]); acc[3] = MFMA16(fb[4 + ks], sB[ks], acc[3]); }
                    COMPILER_FENCE();
#pragma unroll
                    for (int i = 0; i < 8; ++i) fb[i] = *(const LAS bf16x8*)(slot + 16384 + (8 + i) * 1024);
                    { bf16_t* vp = WSP(bf16_t, WS_GV) + (size_t)u * 8192 + (size_t)sl * 1024 + lane * 4;
#pragma unroll
                      for (int mt = 0; mt < 4; ++mt) { u32x2 w; w.x = pk2(acc[mt][0], acc[mt][1]); w.y = pk2(acc[mt][2], acc[mt][3]); *(u32x2*)(vp + 256 * mt) = w; } }
                    const bf16x8 vB0 = pack_tiles(acc[0], acc[1]), vB1 = pack_tiles(acc[2], acc[3]);
#pragma unroll
                    for (int t = 0; t < 8; ++t) S[t] = S[t] * dec;
                    COMPILER_FENCE();
#pragma unroll
                    for (int t = 0; t < 4; ++t) S[t] = MFMA16(fa[2 * t], vB0, S[t]);
#pragma unroll
                    for (int t = 0; t < 4; ++t) S[t] = MFMA16(fa[2 * t + 1], vB1, S[t]);
#pragma unroll
                    for (int t = 0; t < 4; ++t) S[4 + t] = MFMA16(fb[2 * t], vB0, S[4 + t]);
#pragma unroll
                    for (int t = 0; t < 4; ++t) S[4 + t] = MFMA16(fb[2 * t + 1], vB1, S[4 + t]);
                    COMPILER_FENCE();
#pragma unroll
                    for (int ks = 0; ks < 4; ++ks) sB[ks] = pack_tiles(S[2 * ks], S[2 * ks + 1]);
                }
            }
            float* o = p.out + O_PGDN + ((size_t)l * PB * 4 + bh) * 16384 + c;
#pragma unroll
            for (int t = 0; t < 8; ++t)
#pragma unroll
                for (int e = 0; e < 4; ++e) o[(size_t)(16 * t + 4 * q + e) * 128] = S[t][e];
        }
    }
}
__device__ __forceinline__ void ph_gdn_out(const P& p, int l) {
    const int tid = tidx(), lane = tid & 63, wave = tid >> 6, j = lane & 15, q = lane >> 4, mt = wave & 3;
    const bf16_t* PR = WSP(bf16_t, WS_PROJ);
    for (int u = blockIdx.x * 2 + (wave >> 2); u < NUNIT; u += gridDim.x * 2) {
        const int n = u % NCH, h = (u / NCH) % 4, b = u / (NCH * 4);
        f32x4 acc[8];
#pragma unroll
        for (int ct = 0; ct < 8; ++ct) acc[ct] = (f32x4){0.f, 0.f, 0.f, 0.f};
        const bf16_t* qg = WSP(bf16_t, WS_GQ) + (size_t)u * 8192 + (16 * mt + j) * 128 + 8 * q;
        const bf16_t* st = WSP(bf16_t, WS_GS) + (size_t)u * 16384 + (size_t)(q >> 1) * 256 + ((2 * (q & 1)) * 16 + j) * 4;
#pragma unroll
        for (int ks = 0; ks < 4; ++ks) { const bf16x8 a = *(const bf16x8*)(qg + 32 * ks);
#pragma unroll
            for (int ct = 0; ct < 8; ++ct) { const bf16_t* sp = st + (size_t)ct * 2048 + ks * 512; const u32x2 lo = *(const u32x2*)sp, hi = *(const u32x2*)(sp + 64); u32x4 w; w.x = lo.x; w.y = lo.y; w.z = hi.x; w.w = hi.y;
                acc[ct] = MFMA16(a, __builtin_bit_cast(bf16x8, w), acc[ct]); }
            COMPILER_FENCE(); }
        const bf16_t* at = WSP(bf16_t, WS_GA) + (size_t)u * 4096 + (16 * mt + j) * 64 + 8 * q;
        const bf16_t* vt = WSP(bf16_t, WS_GV) + (size_t)u * 8192 + (size_t)(q >> 1) * 256 + ((2 * (q & 1)) * 16 + j) * 4;
#pragma unroll
        for (int ks = 0; ks < 2; ++ks) { const bf16x8 a = *(const bf16x8*)(at + 32 * ks);
#pragma unroll
            for (int ct = 0; ct < 8; ++ct) { const bf16_t* vp = vt + (size_t)ct * 1024 + ks * 512; const u32x2 lo = *(const u32x2*)vp, hi = *(const u32x2*)(vp + 64); u32x4 w; w.x = lo.x; w.y = lo.y; w.z = hi.x; w.w = hi.y;
                acc[ct] = MFMA16(a, __builtin_bit_cast(bf16x8, w), acc[ct]); }
            COMPILER_FENCE(); }
        float sq[4];
#pragma unroll
        for (int e = 0; e < 4; ++e) { float s = 0.f;
#pragma unroll
            for (int ct = 0; ct < 8; ++ct) s += acc[ct][e] * acc[ct][e];
            s += __shfl_xor(s, 1); s += __shfl_xor(s, 2); s += __shfl_xor(s, 4); s += __shfl_xor(s, 8); sq[e] = 1.0f / sqrtf(s * (1.0f / 128.0f) + EPS); }
#pragma unroll
        for (int e = 0; e < 4; ++e) { const size_t row = (size_t)(b * T + n * 64 + 16 * mt + 4 * q + e);
#pragma unroll
            for (int ct = 0; ct < 8; ++ct) { const int c = 16 * ct + j; const float z = bf2f(PR[row * NPROJ + C_Z + h * 128 + c]);
                WSP(bf16_t, WS_O)[row * D + 512 + h * 128 + c] = f2bf(acc[ct][e] * sq[e] * p.gdn_norm[l * 128 + c] * silu_f(z)); } }
    }
}
__device__ __forceinline__ void ph_gdn_sample(const P& p, int l, unsigned char* smem) {
    float* qs = (float*)smem; float* ks = qs + 8 * QP; float* vs = ks + 8 * QP; float* us = vs + 8 * QP; float* wsm = us + 8 * 128; float* vn = wsm + 8 * 128;
    float* Ls = vn + 8 * 128; float* As = Ls + 8 * 8; float* gs = As + 8 * 8; float* gcs = gs + 8; float* bts = gcs + 8; float* S0 = bts + 8;
    const int tid = tidx(); const bf16_t* PR = WSP(bf16_t, WS_PROJ);
    for (int u = gridDim.x - 1 - blockIdx.x; u < DB * 4; u += gridDim.x) {
        const int h = u & 3, b = u >> 2;
        __syncthreads();
#pragma unroll 4
        for (int e = tid; e < 16384; e += NTHR) S0[e] = p.state_gdn[(((size_t)l * DB + b) * 4 + h) * 16384 + e];
        if (tid < 384) { const int sec = tid >> 7, c = tid & 127, col = sec * 512 + h * 128 + c; float* dst = sec == 0 ? qs : sec == 1 ? ks : vs;
            const float w0 = p.conv_w[(l * 4 + 0) * 1536 + col], w1 = p.conv_w[(l * 4 + 1) * 1536 + col], w2 = p.conv_w[(l * 4 + 2) * 1536 + col], w3 = p.conv_w[(l * 4 + 3) * 1536 + col];
            const float* hist = p.state_conv + (((size_t)l * DB + b) * 3) * 1536 + col; const bf16_t* src = PR + (size_t)(MP + b * DS) * NPROJ + C_CONV + col;
            float x0 = hist[0], x1 = hist[1536], x2 = hist[2 * 1536];
            for (int i = 0; i < DS; ++i) { const float x3 = bf2f(src[(size_t)i * NPROJ]); const float y = w0 * x0 + w1 * x1 + w2 * x2 + w3 * x3; dst[i * QP + c] = silu_f(y); x0 = x1; x1 = x2; x2 = x3; } }
        else if (tid < 384 + DS) { const int i = tid - 384; const size_t row = (size_t)(MP + b * DS + i); gs[i] = WSP(float, WS_G)[row * 4 + h]; bts[i] = WSP(float, WS_BETA)[row * 4 + h]; }
        __syncthreads();
        if (tid < 64) { const int rid = tid >> 2, part = tid & 3; float* rowp = (rid < 8 ? qs + rid * QP : ks + (rid - 8) * QP) + part * 32; float s = 0.f;
            for (int d = 0; d < 32; ++d) s += rowp[d] * rowp[d];
            s += __shfl_xor(s, 1); s += __shfl_xor(s, 2); const float sc = 1.0f / sqrtf(s + EPS);
            for (int d = 0; d < 32; ++d) rowp[d] *= sc; }
        if (tid == 64) { float a = 0.f; for (int i = 0; i < DS; ++i) { a += gs[i]; gcs[i] = a; } }
        __syncthreads();
        if (tid < 64) { const int i = tid >> 3, j = tid & 7; float lv = 0.f, av = 0.f;
            if (j <= i) { float dk = 0.f, dq = 0.f; for (int d = 0; d < 128; ++d) { const float kj = ks[j * QP + d]; dk += ks[i * QP + d] * kj; dq += qs[i * QP + d] * kj; }
                const float e = expf(gcs[i] - gcs[j]); av = dq * e * 0.08838834764831845f; lv = j < i ? bts[i] * dk * e : 0.f; }
            Ls[i * 8 + j] = lv; As[i * 8 + j] = av; }
        __syncthreads();
        if (tid < 256) { const int c = tid; float X[8];
            if (c < 128) {
#pragma unroll
                for (int i = 0; i < 8; ++i) X[i] = vs[i * QP + c] * bts[i]; }
            else {
#pragma unroll
                for (int i = 0; i < 8; ++i) X[i] = ks[i * QP + c - 128] * bts[i] * expf(gcs[i]); }
            fwd_subst<8, 8>(X, Ls);
            float* dst = c < 128 ? us + c : wsm + c - 128;
#pragma unroll
            for (int i = 0; i < 8; ++i) dst[i * 128] = X[i]; }
        __syncthreads();
        const int i = tid >> 6, c2 = (tid & 63) * 2;
        { float a0 = us[i * 128 + c2], a1 = us[i * 128 + c2 + 1];
          for (int d = 0; d < 128; ++d) { const float w = wsm[i * 128 + d]; a0 -= w * S0[d * 128 + c2]; a1 -= w * S0[d * 128 + c2 + 1]; }
          vn[i * 128 + c2] = a0; vn[i * 128 + c2 + 1] = a1; }
        __syncthreads();
        { float o0 = 0.f, o1 = 0.f; const float qsc = 0.08838834764831845f * expf(gcs[i]);
          for (int d = 0; d < 128; ++d) { const float qg = qs[i * QP + d] * qsc; o0 += qg * S0[d * 128 + c2]; o1 += qg * S0[d * 128 + c2 + 1]; }
          for (int j = 0; j < DS; ++j) { const float a = As[i * 8 + j]; o0 += a * vn[j * 128 + c2]; o1 += a * vn[j * 128 + c2 + 1]; }
          const float rstd = 1.0f / sqrtf(wave_sum(o0 * o0 + o1 * o1) * (1.0f / 128.0f) + EPS);
          const size_t row = (size_t)(MP + b * DS + i);
          const float z0 = bf2f(PR[row * NPROJ + C_Z + h * 128 + c2]), z1 = bf2f(PR[row * NPROJ + C_Z + h * 128 + c2 + 1]);
          bf16_t* O = WSP(bf16_t, WS_O) + row * D + 512 + h * 128 + c2;
          O[0] = f2bf(o0 * rstd * p.gdn_norm[l * 128 + c2] * silu_f(z0)); O[1] = f2bf(o1 * rstd * p.gdn_norm[l * 128 + c2 + 1] * silu_f(z1)); }
        { const float gl = gcs[DS - 1], dec = expf(gl); float* o = p.out + O_SGDN + (((size_t)l * DB + b) * 4 + h) * 16384;
#pragma unroll 2
          for (int e = tid; e < 16384; e += NTHR) { const int d = e >> 7, c = e & 127; float s = S0[e] * dec;
              for (int j = 0; j < DS; ++j) s += ks[j * QP + d] * expf(gl - gcs[j]) * vn[j * 128 + c];
              o[e] = s; } }
    }
}


template <int K> __device__ __forceinline__ void ph_gemm_small(const P& p, const bf16_t* A  , const bf16_t* Bt  , const float* gate, const float* xs_in  , unsigned char* smem) {
    static_assert(MS % 16 == 0 && K % 256 == 0, "small GEMM shape");
    constexpr int KW = K / 8, NKS = KW / 32;
    const int tid = tidx(), lane = tid & 63, wave = tid >> 6, x = lane & 15, q = lane >> 4;
    float* red = (float*)smem;
    for (int it = blockIdx.x; it < (MS / 16) * 16; it += gridDim.x) {
        const int rt = it % (MS / 16), cg = it / (MS / 16);
        const bf16_t* ap = A + (size_t)(16 * rt + x) * K + wave * KW + 8 * q;
        const bf16_t* bp = Bt + (size_t)(64 * cg + x) * K + wave * KW + 8 * q;
        f32x4 acc[4];
#pragma unroll
        for (int ct = 0; ct < 4; ++ct) acc[ct] = (f32x4){0.f, 0.f, 0.f, 0.f};
#pragma unroll
        for (int ks = 0; ks < NKS; ++ks) { const bf16x8 a = *(const bf16x8*)(ap + 32 * ks);
#pragma unroll
            for (int ct = 0; ct < 4; ++ct) acc[ct] = MFMA16(a, *(const bf16x8*)(bp + (size_t)ct * 16 * K + 32 * ks), acc[ct]); }
        __syncthreads();
#pragma unroll
        for (int ct = 0; ct < 4; ++ct) *(f32x4*)(red + ((wave * 4 + ct) * 64 + lane) * 4) = acc[ct];
        __syncthreads();
        if (wave < 4) { f32x4 s = (f32x4){0.f, 0.f, 0.f, 0.f};
#pragma unroll
            for (int w = 0; w < 8; ++w) s += *(const f32x4*)(red + ((w * 4 + wave) * 64 + lane) * 4);
            const int col = 64 * cg + 16 * wave + x;
#pragma unroll
            for (int e = 0; e < 4; ++e) { const int row = MP + 16 * rt + 4 * q + e; float* xp = p.out + (size_t)row * D + col; const float xin = xs_in ? xs_in[(size_t)(row - MP) * D + col] : *xp; *xp = xin + gate[(size_t)row_cb(row) * 6144 + col] * s[e]; } }
    }
}

__device__ __forceinline__ void ph_final_norm(const P& p) {
    const int lane = tidx() & 63, wave = tidx() >> 6, gw = blockIdx.x * 8 + wave, ngw = gridDim.x * 8;
    for (int r = gw; r < M; r += ngw) {
        float* xr = p.out + (size_t)r * D; f32x4 v[4]; float ss = 0.f;
#pragma unroll
        for (int j = 0; j < 4; ++j) { v[j] = *(const f32x4*)(xr + 4 * lane + 256 * j); ss += (v[j][0] * v[j][0] + v[j][1] * v[j][1]) + (v[j][2] * v[j][2] + v[j][3] * v[j][3]); }
        const float rstd = 1.0f / sqrtf(wave_sum(ss) * (1.0f / D) + EPS);
#pragma unroll
        for (int j = 0; j < 4; ++j) { const f32x4 g = *(const f32x4*)(p.final_norm + 4 * lane + 256 * j); *(f32x4*)(xr + 4 * lane + 256 * j) = v[j] * rstd * g; }
    }
}

enum Phase { PH_PRO = 0, PH_NORM1, PH_GEMM_IN, PH_ROPE, PH_MIX1, PH_MIX2, PH_MIX3, PH_GEMM_OUT, PH_NORM2, PH_GEMM_GU, PH_GEMM_DN, PH_FINAL };
#ifdef __HIP_EMU__
#define LDSP(x) (x)
#else
#define LDSP(x) ((PG8_LAS unsigned char*)(x))
#endif
template <int PH> __device__ __forceinline__ void run_phase(const P& p, int l, unsigned char* smem) {
    if constexpr (PH == PH_PRO) { ph_convert(p, smem); __syncthreads(); ph_adaln(p, smem); ph_ropetab_copyx(p); }
    else if constexpr (PH == PH_NORM1) ph_norm_mod<0>(p, l);
    else if constexpr (PH == PH_GEMM_IN) {
        pg8::Gemm g{WSP(bf16_t, WS_H), WSP(bf16_t, WS_WIN) + (size_t)l * NPROJ * D, MPAD, NPROJ, D}; pg8::StaticOrder S; S.init(MPAD, NPROJ, (int)gridDim.x, (int)blockIdx.x);
        pg8::EpiStoreBf16 E{WSP(bf16_t, WS_PROJ), NPROJ};
        pg8::gemm_phase<pg8::EpiStoreBf16, pg8::StaticOrder, true, true>(LDSP(smem), g, S, E);
    }
    else if constexpr (PH == PH_ROPE) { ph_rope_out(p, l); ph_vtrans(p, smem); }
    else if constexpr (PH == PH_MIX1) { ph_attn_jobs(p); ph_ret_local(p, l); ph_gdn_prep(p, l, smem); }
    else if constexpr (PH == PH_MIX2) { ph_gdn_chain(p, l, smem); __syncthreads(); ph_attn_sample(p, l, smem); ph_ret_sample(p, l, smem); ph_gdn_sample(p, l, smem); ph_ret_scan(p, l); ph_attn_combine(p); }
    else if constexpr (PH == PH_MIX3) { ph_ret_out(p, l); ph_gdn_out(p, l); }
    else if constexpr (PH == PH_GEMM_OUT) {
        ph_gemm_small<D>(p, WSP(bf16_t, WS_O) + (size_t)MP * D, WSP(bf16_t, WS_WOUT) + (size_t)l * D * D, WSP(float, WS_MOD) + (size_t)l * NC * 6144 + 2048, l == 0 ? p.x_sample : nullptr, smem); __syncthreads();
        pg8::Gemm g{WSP(bf16_t, WS_O), WSP(bf16_t, WS_WOUT) + (size_t)l * D * D, MP, D, D}; pg8::StaticOrder S; S.init(MP, D, (int)gridDim.x, (int)blockIdx.x);
        pg8::EpiResidual E{p.out, WSP(float, WS_MOD) + (size_t)l * NC * 6144 + 2048, l == 0 ? p.x_prompt : p.out};
        pg8::gemm_phase<pg8::EpiResidual, pg8::StaticOrder, true, true>(LDSP(smem), g, S, E);
    }
    else if constexpr (PH == PH_NORM2) ph_norm_mod<1>(p, l);
    else if constexpr (PH == PH_GEMM_GU) {
        pg8::Gemm g{WSP(bf16_t, WS_H), WSP(bf16_t, WS_WGU) + (size_t)l * 2 * FF * D, MPAD, 2 * FF, D}; pg8::StaticOrder S; S.init(MPAD, 2 * FF, (int)gridDim.x, (int)blockIdx.x);
        pg8::EpiSwiglu E{WSP(bf16_t, WS_HID)};
        pg8::gemm_phase<pg8::EpiSwiglu, pg8::StaticOrder, true, true>(LDSP(smem), g, S, E);
    }
    else if constexpr (PH == PH_GEMM_DN) {
        ph_gemm_small<FF>(p, WSP(bf16_t, WS_HID) + (size_t)MP * FF, WSP(bf16_t, WS_WDN) + (size_t)l * D * FF, WSP(float, WS_MOD) + (size_t)l * NC * 6144 + 5120, nullptr, smem); __syncthreads();
        pg8::Gemm g{WSP(bf16_t, WS_HID), WSP(bf16_t, WS_WDN) + (size_t)l * D * FF, MP, D, FF}; pg8::StaticOrder S; S.init(MP, D, (int)gridDim.x, (int)blockIdx.x);
        pg8::EpiResidual E{p.out, WSP(float, WS_MOD) + (size_t)l * NC * 6144 + 5120, p.out};
        pg8::gemm_phase<pg8::EpiResidual, pg8::StaticOrder, true, true>(LDSP(smem), g, S, E);
    }
    else if constexpr (PH == PH_FINAL) ph_final_norm(p);
}
template <int PH> __global__ void __launch_bounds__(NTHR, 2) k_phase(P p, int l) { DYN_SMEM(smem); run_phase<PH>(p, l, smem); }


#ifndef __HIP_EMU__
#define LAS __attribute__((address_space(3)))
#define XB_TMO      128
#define XB_XCNT(j)  (256  + 64 * (j))
#define XB_XSUB(j)  (1280 + 64 * (j))
#define XB_XGEN(j)  (2304 + 64 * (j))
#define XB_TOP      3328
#define XB_TOPGEN   3392
#define XCD_BAR_WORDS 3456
#define XB_SPIN_CAP (1u << 18)

__device__ __forceinline__ unsigned xb_ld(unsigned* p)              { return __hip_atomic_load(p, __ATOMIC_RELAXED, __HIP_MEMORY_SCOPE_AGENT); }
__device__ __forceinline__ unsigned xb_add(unsigned* p, unsigned v) { return __hip_atomic_fetch_add(p, v, __ATOMIC_RELAXED, __HIP_MEMORY_SCOPE_AGENT); }
__device__ __forceinline__ unsigned xb_xcc_id() { return (unsigned)__builtin_amdgcn_s_getreg((3 << 11) | 20) & 0xFu; }
#define XB_SPIN(cond, bar) do { unsigned _sp = 0; while (cond) { __builtin_amdgcn_s_sleep(1); \
    if ((++_sp & 255u) == 0u) { if (xb_ld(&(bar)[XB_TMO])) break; if (_sp > XB_SPIN_CAP) { atomicAdd(&(bar)[XB_TMO], 1u); break; } } } } while (0)

struct XcdBarrier {
    unsigned* bar; unsigned x;
    volatile LAS unsigned* st;
};

__device__ __forceinline__ XcdBarrier xcd_barrier_post(unsigned* bar, volatile LAS unsigned* st) {
    XcdBarrier b; b.bar = bar; b.x = xb_xcc_id(); b.st = st;
    if (threadIdx.x == 0) (void)xb_add(&bar[XB_XCNT(b.x)], 1u);
    return b;
}
__device__ __forceinline__ void xcd_barrier_complete(unsigned* bar, unsigned x, unsigned& nloc, unsigned& nx) {
    const unsigned G = gridDim.x * gridDim.y * gridDim.z;
    unsigned sum, cnt, mine, sp = 0u;
    for (;;) {
        sum = 0u; cnt = 0u; mine = 0u;
#pragma unroll
        for (unsigned j = 0; j < 16; ++j) { const unsigned c = xb_ld(&bar[XB_XCNT(j)]); sum += c; cnt += (c > 0u) ? 1u : 0u; mine = (j == x) ? c : mine; }
        if (sum == G) break;
        __builtin_amdgcn_s_sleep(1);
        if ((++sp & 255u) == 0u) { if (xb_ld(&bar[XB_TMO])) break; if (sp > XB_SPIN_CAP) { atomicAdd(&bar[XB_TMO], 1u); break; } }
    }
    nloc = mine > 0u ? mine : 1u; nx = cnt > 0u ? cnt : 1u;
}

__device__ __forceinline__ void xcd_barrier(const XcdBarrier& b) {
    asm volatile("s_waitcnt vmcnt(0)" ::: "memory");
    __syncthreads();
    if (threadIdx.x == 0) {
        unsigned* bar = b.bar;
        __builtin_amdgcn_s_waitcnt(0);
        unsigned nloc = b.st[0], nx = b.st[1];
        if (nloc == 0u) { xcd_barrier_complete(bar, b.x, nloc, nx); b.st[0] = nloc; b.st[1] = nx; }
        const unsigned old = xb_add(&bar[XB_XSUB(b.x)], 1u);
        const unsigned gen = old / nloc;
        if (old + 1u == (gen + 1u) * nloc) {
            __builtin_amdgcn_fence(__ATOMIC_RELEASE, "agent");
            asm volatile("s_waitcnt vmcnt(0)" ::: "memory");
            const unsigned og = xb_add(&bar[XB_TOP], 1u);
            const unsigned tg = og / nx;
            if (og + 1u == (tg + 1u) * nx) xb_add(&bar[XB_TOPGEN], 1u);
            else XB_SPIN(xb_ld(&bar[XB_TOPGEN]) == tg, bar);
            __builtin_amdgcn_fence(__ATOMIC_ACQUIRE, "agent");
            xb_add(&bar[XB_XGEN(b.x)], 1u);
            asm volatile("s_waitcnt vmcnt(0)" ::: "memory");
        } else {
            XB_SPIN(xb_ld(&bar[XB_XGEN(b.x)]) == gen, bar);
            __builtin_amdgcn_fence(__ATOMIC_ACQUIRE, "agent");
            asm volatile("s_waitcnt vmcnt(0)" ::: "memory");
        }
    }
    __syncthreads();
}

#endif

#ifndef __HIP_EMU__
#define GRID_SYNC() xcd_barrier(bar)
__global__ void __launch_bounds__(NTHR, 2) k_mega(P p_arg) {
    DYN_SMEM(smem);
#if defined(__HIP_DEVICE_COMPILE__)
#define PHASE(PH_, l_) do { const __attribute__((address_space(4))) P* kp_ = (const __attribute__((address_space(4))) P*)__builtin_amdgcn_kernarg_segment_ptr(); LAUNDER_PTR(kp_); P pl_; __builtin_memcpy(&pl_, kp_, sizeof(P)); run_phase<PH_>(pl_, l_, smem); } while (0)
#else
#define PHASE(PH_, l_) run_phase<PH_>(p_arg, l_, smem)
#endif
    cooperative_groups::grid_group grid = cooperative_groups::this_grid();
    volatile LAS unsigned* bst = (volatile LAS unsigned*)((LAS unsigned char*)smem + BAR_LDS_OFF);
    if (threadIdx.x < 4) bst[threadIdx.x] = 0u;
    __syncthreads();
    XcdBarrier bar = xcd_barrier_post((unsigned*)(p_arg.ws + WS_CTL + 4096), bst);
    PHASE(PH_PRO, 0); grid.sync();
#define LAYER(l) do { PHASE(PH_NORM1, l); GRID_SYNC(); PHASE(PH_GEMM_IN, l); GRID_SYNC(); PHASE(PH_ROPE, l); GRID_SYNC(); PHASE(PH_MIX1, l); GRID_SYNC(); PHASE(PH_MIX2, l); GRID_SYNC(); \
        PHASE(PH_MIX3, l); GRID_SYNC(); PHASE(PH_GEMM_OUT, l); GRID_SYNC(); PHASE(PH_NORM2, l); GRID_SYNC(); PHASE(PH_GEMM_GU, l); GRID_SYNC(); PHASE(PH_GEMM_DN, l); GRID_SYNC(); } while (0)
    static_assert(NL == 2, "two layers written out (a loop over the layers makes hipcc hoist every phase's constants to the loop preheader and spill)");
    LAYER(0); LAYER(1);
    PHASE(PH_FINAL, 0);
}
#endif

template <int PH> static void launch_phase(const P& p, int l, int grid, hipStream_t stream) {
#ifndef __HIP_EMU__
    static bool attr_done = false;
    if (!attr_done) { (void)hipFuncSetAttribute((const void*)k_phase<PH>, hipFuncAttributeMaxDynamicSharedMemorySize, SMEM_BYTES); attr_done = true; }
#endif
    LAUNCH(k_phase<PH>, grid, SMEM_BYTES, stream, p, l);
}

extern "C" void kernel_launch(void* const* d_in, const int* in_sizes, int n_in, void* d_out, int out_size, void* d_ws, size_t ws_size, hipStream_t stream) {
    if (n_in != 24 || (size_t)out_size != O_END || ws_size < WS_END) {
        fprintf(stderr, "kernel_launch: shape mismatch: n_in %d out_size %d (want %zu) ws %zu (want %zu)\n", n_in, out_size, (size_t)O_END, ws_size, (size_t)WS_END); return; }
    P p{};
    const float** pp = (const float**)&p;
    for (int i = 0; i < 24; ++i) pp[i] = (const float*)d_in[i];
    p.out = (float*)d_out; p.ws = (unsigned char*)d_ws;
#ifndef __HIP_EMU__
    static int grid = 0;
    if (grid == 0) {
        int dev = 0, cus = 0, per_cu = 0;
        if (hipGetDevice(&dev) != hipSuccess || hipDeviceGetAttribute(&cus, hipDeviceAttributeMultiprocessorCount, dev) != hipSuccess || cus <= 0) { fprintf(stderr, "kernel_launch: device query failed\n"); grid = -1; return; }
        if (hipFuncSetAttribute((const void*)k_mega, hipFuncAttributeMaxDynamicSharedMemorySize, SMEM_BYTES) != hipSuccess) { fprintf(stderr, "kernel_launch: hipFuncSetAttribute failed\n"); grid = -1; return; }
        if (hipOccupancyMaxActiveBlocksPerMultiprocessor(&per_cu, (const void*)k_mega, NTHR, SMEM_BYTES) != hipSuccess || per_cu < 1) { fprintf(stderr, "kernel_launch: occupancy query says %d blocks per CU\n", per_cu); grid = -1; return; }
        grid = cus;
    }
    if (grid < 0) return;
    if (hipMemsetAsync((char*)d_ws + WS_CTL, 0, 65536, stream) != hipSuccess) { fprintf(stderr, "kernel_launch: memset of the barrier words failed\n"); return; }
    { void* args[] = {(void*)&p};
      hipError_t e = hipLaunchCooperativeKernel((const void*)k_mega, dim3(grid), dim3(NTHR), args, SMEM_BYTES, stream);
      if (e != hipSuccess) fprintf(stderr, "kernel_launch: cooperative launch failed: %s (grid %d)\n", hipGetErrorString(e), grid);
      return; }
#else
    int grid = 16;
#endif
    launch_phase<PH_PRO>(p, 0, grid, stream);
    for (int l = 0; l < NL; ++l) {
        launch_phase<PH_NORM1>(p, l, grid, stream);
        launch_phase<PH_GEMM_IN>(p, l, grid, stream);
        launch_phase<PH_ROPE>(p, l, grid, stream);
        launch_phase<PH_MIX1>(p, l, grid, stream);
        launch_phase<PH_MIX2>(p, l, grid, stream);
        launch_phase<PH_MIX3>(p, l, grid, stream);
        launch_phase<PH_GEMM_OUT>(p, l, grid, stream);
        launch_phase<PH_NORM2>(p, l, grid, stream);
        launch_phase<PH_GEMM_GU>(p, l, grid, stream);
        launch_phase<PH_GEMM_DN>(p, l, grid, stream);
    }
    launch_phase<PH_FINAL>(p, 0, grid, stream);
}
```

```cpp
#ifndef __HIP_EMU__
#include <hip/hip_runtime.h>
#include <hip/hip_cooperative_groups.h>
#endif
#include <cstdio>
#include <cstdint>
#include <cmath>

#ifndef CFG_BATCH
#define CFG_BATCH 2
#endif
#ifndef CFG_SEQ
#define CFG_SEQ 8192
#endif
#ifndef CFG_DB
#define CFG_DB 32
#endif
constexpr float LOG2E = 1.4426950408889634f;
constexpr int D = 1024, NL = 2, PB = CFG_BATCH, T = CFG_SEQ, DB = CFG_DB, DS = 8, PAST = 16384, WB = 2048;
constexpr int MP = PB * T, MS = DB * DS, M = MP + MS, MPAD = (M + 255) / 256 * 256, NC = PB + DB;
constexpr int INC = 3848, NPROJ = 3840, FF = 2816, NCH = T / 64, PWIN = T < 2048 ? T : 2048, NPOS = T + DS;
constexpr int NUNIT = PB * 4 * NCH;
constexpr float EPS = 1e-6f;
static_assert(T % 512 == 0, "the attention job decomposition wants T % 512 == 0");
constexpr int C_QA = 0, C_KA = 256, C_VA = 512, C_QR = 768, C_KR = 1024, C_VR = 1280, C_GR = 1536, C_CONV = 1792, C_Z = 3328;
constexpr int SMEM_BYTES = 147456;
constexpr int NTHR = 512;
constexpr int BAR_LDS_OFF = SMEM_BYTES - 64;

typedef unsigned short bf16_t;
typedef short bf16x8 __attribute__((ext_vector_type(8)));
typedef float f32x4 __attribute__((ext_vector_type(4)));
typedef unsigned u32x4 __attribute__((ext_vector_type(4)));
typedef unsigned u32x2 __attribute__((ext_vector_type(2)));
typedef float f32x16 __attribute__((ext_vector_type(16)));

#ifdef __HIP_EMU__
#define LAUNCH(kern, grid, lds, stream, ...) emu_launch(grid, NTHR, [=]() { kern(__VA_ARGS__); })
#define DYN_SMEM(name) unsigned char* name = emu_dyn_smem()
#define WAVE_SYNC() emu_wave_bar()
#define MFMA32(a, b, c) emu_mfma32(a, b, c)
#define GLDS16(gp, lp) memcpy((unsigned char*)(lp) + (threadIdx.x & 63) * 16, (gp), 16)
#define RAW_BARRIER() __syncthreads()
#define GLDS4(gp, lp) ((void)0)
#define WAIT_VM(n)
#define WAIT_LGKM0()
#define LAS
#define UNIFORM(x) (x)
#define COMPILER_FENCE()
#define LAUNDER_V(x)
#define MFMA16(a, b, c) emu_mfma16(a, b, c)
#else
#define WAVE_SYNC() asm volatile("s_waitcnt lgkmcnt(0)" ::: "memory")
#define MFMA32(a, b, c) __builtin_amdgcn_mfma_f32_32x32x16_bf16(a, b, c, 0, 0, 0)
#define LAS __attribute__((address_space(3)))
#define GLDS16(gp, lp) __builtin_amdgcn_global_load_lds((const unsigned*)(gp), (LAS unsigned*)(lp), 16, 0, 0)
#define RAW_BARRIER() __builtin_amdgcn_s_barrier()
#define GLDS4(gp, lp) __builtin_amdgcn_global_load_lds((const unsigned*)(gp), (LAS unsigned*)(lp), 4, 0, 0)
#define WAIT_VM(n) asm volatile("s_waitcnt vmcnt(" #n ")" ::: "memory")
#define WAIT_LGKM0() asm volatile("s_waitcnt lgkmcnt(0)" ::: "memory")
#define UNIFORM(x) __builtin_amdgcn_readfirstlane(x)
#define COMPILER_FENCE() __builtin_amdgcn_sched_barrier(0)
#define LAUNDER_V(x) asm volatile("" : "+v"(x))
#define MFMA16(a, b, c) __builtin_amdgcn_mfma_f32_16x16x32_bf16(a, b, c, 0, 0, 0)
#define LAUNCH(kern, grid, lds, stream, ...) hipLaunchKernelGGL(kern, dim3(grid), dim3(NTHR), lds, stream, __VA_ARGS__)
#define DYN_SMEM(name) extern __shared__ __attribute__((aligned(16))) unsigned char name[]
#endif

#ifdef __HIP_EMU__
__device__ __forceinline__ int tidx() { return (int)threadIdx.x; }
#define LAUNDER_PTR(x)
#else
__device__ __forceinline__ int tidx() { int t = (int)threadIdx.x; asm volatile("" : "+v"(t)); return t; }
#define LAUNDER_PTR(x) asm volatile("" : "+s"(x))
#endif
__device__ __forceinline__ float bf2f(bf16_t v) { return __builtin_bit_cast(float, (unsigned)v << 16); }
__device__ __forceinline__ bf16_t f2bf(float f) { unsigned u = __builtin_bit_cast(unsigned, f); return (bf16_t)((u + 0x7fffu + ((u >> 16) & 1u)) >> 16); }
#ifdef __HIP_EMU__
__device__ __forceinline__ unsigned pk2(float lo, float hi) { return (unsigned)f2bf(lo) | ((unsigned)f2bf(hi) << 16); }
#else
typedef float f32x2_t __attribute__((ext_vector_type(2))); typedef __bf16 bf16x2_t __attribute__((ext_vector_type(2)));
__device__ __forceinline__ unsigned pk2(float lo, float hi) { f32x2_t v = {lo, hi}; bf16x2_t b = __builtin_convertvector(v, bf16x2_t); return __builtin_bit_cast(unsigned, b); }
#endif
__device__ __forceinline__ bf16x8 pack_tiles(const f32x4& lo, const f32x4& hi) {
    u32x4 w; w.x = pk2(lo[0], lo[1]); w.y = pk2(lo[2], lo[3]); w.z = pk2(hi[0], hi[1]); w.w = pk2(hi[2], hi[3]); return __builtin_bit_cast(bf16x8, w);
}
__device__ __forceinline__ float silu_f(float x) { return x / (1.0f + expf(-x)); }
#ifdef __HIP_EMU__
__device__ __forceinline__ float silu_fast(float x) { return x / (1.0f + expf(-x)); }
#else
__device__ __forceinline__ float silu_fast(float x) { return x * __builtin_amdgcn_rcpf(1.0f + __builtin_amdgcn_exp2f(-LOG2E * x)); }
#endif
__device__ __forceinline__ float wave_sum(float v) {
#pragma unroll
    for (int o = 1; o < 64; o <<= 1) v += __shfl_xor(v, o);
    return v;
}
__device__ __forceinline__ float wave_max(float v) {
#pragma unroll
    for (int o = 1; o < 64; o <<= 1) v = fmaxf(v, __shfl_xor(v, o));
    return v;
}

struct P {
    const float *x_prompt, *x_sample, *cache_k, *cache_v, *state_ret, *state_gdn, *state_conv, *c_prompt, *c_sample, *ada_w, *ada_b, *norm_mix, *norm_ffn,
        *w_in, *ret_norm, *conv_w, *a_log, *dt_bias, *gdn_norm, *w_out, *w_gate, *w_up, *w_down, *final_norm;
    float* out; unsigned char* ws;
};

constexpr size_t O_YP = 0, O_YS = O_YP + (size_t)MP * D, O_PWK = O_YS + (size_t)MS * D, O_PWV = O_PWK + (size_t)NL * PB * PWIN * 256,
                 O_PRET = O_PWV + (size_t)NL * PB * PWIN * 256, O_PGDN = O_PRET + (size_t)NL * PB * 4 * 4096, O_PCONV = O_PGDN + (size_t)NL * PB * 4 * 16384,
                 O_SWK = O_PCONV + (size_t)NL * PB * 3 * 1536, O_SWV = O_SWK + (size_t)NL * DB * DS * 256, O_SRET = O_SWV + (size_t)NL * DB * DS * 256,
                 O_SGDN = O_SRET + (size_t)NL * DB * 4 * 4096, O_SCONV = O_SGDN + (size_t)NL * DB * 4 * 16384, O_END = O_SCONV + (size_t)NL * DB * 3 * 1536;

constexpr size_t al256(size_t x) { return (x + 255) / 256 * 256; }
constexpr size_t WS_CTL = 0, WS_CTL_BYTES = 1u << 20;
constexpr size_t WS_MOD = WS_CTL + WS_CTL_BYTES;
constexpr size_t WS_W8 = al256(WS_MOD + (size_t)NL * NC * 6144 * 4);
constexpr size_t WS_ROPE = al256(WS_W8 + (size_t)NL * D * 8 * 4);
constexpr size_t WS_WIN = al256(WS_ROPE + (size_t)4 * NPOS * 32 * 4);
constexpr size_t WS_WOUT = al256(WS_WIN + (size_t)NL * NPROJ * D * 2);
constexpr size_t WS_WGU = al256(WS_WOUT + (size_t)NL * D * D * 2);
constexpr size_t WS_WDN = al256(WS_WGU + (size_t)NL * 2 * FF * D * 2);
constexpr size_t WS_H = al256(WS_WDN + (size_t)NL * D * FF * 2);
constexpr size_t WS_PROJ = al256(WS_H + (size_t)MPAD * D * 2);
constexpr size_t WS_BETA = al256(WS_PROJ + (size_t)MPAD * NPROJ * 2);
constexpr size_t WS_G = al256(WS_BETA + (size_t)M * 4 * 4);
constexpr size_t WS_O = al256(WS_G + (size_t)M * 4 * 4);
constexpr size_t WS_RU = al256(WS_O + (size_t)MPAD * D * 2);
constexpr size_t WS_RS = al256(WS_RU + (size_t)NUNIT * 4096 * 4);
constexpr size_t WS_SCR = al256(WS_RS + (size_t)NUNIT * 4096 * 4);
constexpr size_t WS_GU = WS_SCR;
constexpr size_t WS_GWK = al256(WS_GU + (size_t)NUNIT * 8192 * 2);
constexpr size_t WS_GQ = al256(WS_GWK + (size_t)NUNIT * 16384 * 2);
constexpr size_t WS_GA = al256(WS_GQ + (size_t)NUNIT * 8192 * 2);
constexpr size_t WS_GD = al256(WS_GA + (size_t)NUNIT * 4096 * 2);
constexpr size_t WS_GV = al256(WS_GD + (size_t)NUNIT * 4);
constexpr size_t WS_GS = al256(WS_GV + (size_t)NUNIT * 8192 * 2);
constexpr size_t WS_GEND = al256(WS_GS + (size_t)NUNIT * 16384 * 2);
constexpr size_t WS_KH = WS_GEND;
constexpr size_t WS_VT1 = al256(WS_KH + (size_t)MP * 256 * 2);
constexpr size_t WS_VT4 = al256(WS_VT1 + (size_t)MP * 256 * 2);
constexpr size_t WS_VT16 = al256(WS_VT4 + (size_t)MP * 256 * 2);
constexpr size_t WS_KRT = al256(WS_VT16 + (size_t)MP * 256 * 2);
constexpr size_t WS_VRT = al256(WS_KRT + (size_t)MP * 256 * 2);
constexpr size_t WS_AML = al256(WS_VRT + (size_t)MP * 256 * 2);
constexpr size_t WS_AEND = al256(WS_AML + (size_t)MP * 4 * 3 * 2 * 4);
constexpr size_t WS_APO = WS_H;
static_assert((size_t)MP * 4 * 3 * 64 * 2 <= (size_t)MPAD * D * 2, "attention partials overlay H");
constexpr size_t WS_HID = WS_SCR;
constexpr size_t WS_HEND = al256(WS_HID + (size_t)MPAD * FF * 2);
constexpr size_t WS_END = WS_AEND > WS_HEND ? WS_AEND : WS_HEND;

#define WSP(T_, off) ((T_*)(p.ws + (off)))
__device__ __forceinline__ int row_cb(int r) { return r < MP ? r / T : PB + (r - MP) / DS; }
__device__ __forceinline__ int row_pi(int r) { return r < MP ? r % T : T + (r - MP) % DS; }
namespace pg8 {
#ifdef __HIP_EMU__
#define PG8_LAS
#else
#define PG8_LAS __attribute__((address_space(3)))
#endif
typedef unsigned short bf16_t;
typedef short bf16x8 __attribute__((ext_vector_type(8)));
typedef float f32x4 __attribute__((ext_vector_type(4)));
typedef unsigned u32x4 __attribute__((ext_vector_type(4)));
constexpr int BM = 256, BK = 64, HALF = 128, HTB = HALF * BK * 2  , STAGE_BYTES = 8 * HTB, NXCD = 8, WGM = 8;

__host__ __device__ __forceinline__ int lds_byte(int r, int c) { const int st = (r >> 4) * 2 + (c >> 5), rr = r & 15, cc = c & 31, ob = rr * 64 + cc * 2; return st * 1024 + (ob ^ (((ob >> 9) & 1) << 5)); }
__host__ __device__ __forceinline__ void stage_rc(int b, int& R, int& C) { const int st = b / 1024, sb = b % 1024, swz = sb ^ (((sb >> 9) & 1) << 5); R = (st >> 1) * 16 + swz / 64; C = (st & 1) * 32 + (swz % 64) / 2; }
__host__ __device__ __forceinline__ int perm32(int rho) { const int n = rho >> 4, i = rho & 15; return 8 * (i >> 2) + 4 * n + (i & 3); }

struct Unit { int pm, pn; };
struct Gemm { const bf16_t* A; const bf16_t* Bt; int M, N, K; };

struct StaticOrder {
    int nM, nN, nwg, G, c;
    __host__ __device__ void init(int M, int N, int G_, int c_) { nM = M / BM; nN = N / BM; nwg = nM * nN; G = G_; c = c_; }
    __host__ __device__ bool next(int i, Unit& u) const {
        const long L = (long)i * G + c; if (L >= nwg) return false;
        int wgid = (int)L; { const int q = nwg / NXCD, r = nwg % NXCD, xcd = wgid % NXCD, off = wgid / NXCD; wgid = (xcd < r ? xcd * (q + 1) : r * (q + 1) + (xcd - r) * q) + off; }
        const int nig = WGM * nN, gid = wgid / nig, fm = gid * WGM, gsz = (nM - fm) < WGM ? (nM - fm) : WGM;
        u.pm = fm + ((wgid % nig) % gsz); u.pn = (wgid % nig) / gsz; return true;
    }
    __device__ __forceinline__ void a_ready(const Unit&) const {}
    __device__ __forceinline__ void done(const Unit&) const {}
};


struct EpiStoreBf16 {
    static constexpr bool PERM = true, AFTER_DRAIN = false;
    bf16_t* O; int ldc;
    __device__ __forceinline__ void operator()(const f32x4 (&acc)[2][2][4][2], const Unit& u, int wr, int wc, int fr, int fq) const {
        const int row0 = u.pm * BM + wr * 64 + fr, col0 = u.pn * BM + wc * 32 + 8 * fq;
#pragma unroll
        for (int ai = 0; ai < 2; ++ai)
#pragma unroll
            for (int m = 0; m < 4; ++m) { bf16_t* rowp = O + (size_t)(row0 + ai * HALF + m * 16) * ldc + col0;
#pragma unroll
                for (int bj = 0; bj < 2; ++bj) { const f32x4 v0 = acc[ai][bj][m][0], v1 = acc[ai][bj][m][1];
                    u32x4 w; w.x = ::pk2(v0[0], v0[1]); w.y = ::pk2(v0[2], v0[3]); w.z = ::pk2(v1[0], v1[1]); w.w = ::pk2(v1[2], v1[3]);
                    *(u32x4*)(rowp + bj * HALF) = w; } }
    }
};
struct EpiResidual {
    static constexpr bool PERM = false, AFTER_DRAIN = false;
    float* X; const float* gate; const float* Xin;
    __device__ __forceinline__ void operator()(const f32x4 (&acc)[2][2][4][2], const Unit& u, int wr, int wc, int fr, int fq) const {
        const int row0 = u.pm * BM + wr * 64 + fr, col0 = u.pn * BM + wc * 32 + 4 * fq;
#pragma unroll
        for (int ai = 0; ai < 2; ++ai)
#pragma unroll
            for (int m = 0; m < 4; ++m) { const int row = row0 + ai * HALF + m * 16;
                if (MPAD != M && row >= M) continue;
                const float* g = gate + (size_t)::row_cb(row) * 6144 + col0; float* xp = X + (size_t)row * D + col0; const float* xi = Xin + (size_t)row * D + col0;
#pragma unroll
                for (int bj = 0; bj < 2; ++bj)
#pragma unroll
                    for (int n = 0; n < 2; ++n) { const f32x4 gv = *(const f32x4*)(g + bj * HALF + n * 16); f32x4* xq = (f32x4*)(xp + bj * HALF + n * 16); *xq = *(const f32x4*)(xi + bj * HALF + n * 16) + gv * acc[ai][bj][m][n]; } }
    }
};
struct EpiSwiglu {
    static constexpr bool PERM = true, AFTER_DRAIN = false;
    bf16_t* Hd;
    __device__ __forceinline__ void operator()(const f32x4 (&acc)[2][2][4][2], const Unit& u, int wr, int wc, int fr, int fq) const {
        const int row0 = u.pm * BM + wr * 64 + fr, col0 = u.pn * HALF + wc * 32 + 8 * fq;
#pragma unroll
        for (int ai = 0; ai < 2; ++ai)
#pragma unroll
            for (int m = 0; m < 4; ++m) { bf16_t* rowp = Hd + (size_t)(row0 + ai * HALF + m * 16) * FF + col0;
                float v[8];
#pragma unroll
                for (int n = 0; n < 2; ++n)
#pragma unroll
                    for (int j = 0; j < 4; ++j) { const float gt = acc[ai][0][m][n][j], up = acc[ai][1][m][n][j]; v[4 * n + j] = ::silu_f(gt) * up; }
                u32x4 w; w.x = ::pk2(v[0], v[1]); w.y = ::pk2(v[2], v[3]); w.z = ::pk2(v[4], v[5]); w.w = ::pk2(v[6], v[7]);
                *(u32x4*)rowp = w; }
    }
};

#ifdef __HIP_EMU__
template <class Epi, class Sched, bool ALIGN_EPI = false, bool SP2 = false>
__device__ __forceinline__ void gemm_phase(unsigned char* lds, const Gemm g, const Sched& S, const Epi& E) {
    const int tid = threadIdx.x, wid = tid >> 6, lane = tid & 63, wr = wid >> 2, wc = wid & 3, fr = lane & 15, fq = lane >> 4;
    Unit cur;
    for (int ui = 0; S.next(ui, cur); ++ui) {
        f32x4 acc[2][2][4][2];
        for (int ai = 0; ai < 2; ++ai) for (int bj = 0; bj < 2; ++bj) for (int m = 0; m < 4; ++m) for (int n = 0; n < 2; ++n) for (int j = 0; j < 4; ++j) {
            const int row = 256 * cur.pm + 128 * ai + 64 * wr + 16 * m + fr;
            const int col = Epi::PERM ? 256 * cur.pn + 128 * bj + 32 * wc + 8 * fq + 4 * n + j : 256 * cur.pn + 128 * bj + 32 * wc + 16 * n + 4 * fq + j;
            const bf16_t* a = g.A + (size_t)row * g.K; const bf16_t* b = g.Bt + (size_t)col * g.K; float s = 0.f;
            for (int k = 0; k < g.K; ++k) s += ::bf2f(a[k]) * ::bf2f(b[k]);
            acc[ai][bj][m][n][j] = s; }
        E(acc, cur, wr, wc, fr, fq);
    }
}
#else
template <class Epi, class Sched, bool ALIGN_EPI = false, bool SP2 = false>
__device__ __forceinline__ void gemm_phase(PG8_LAS unsigned char* lds, const Gemm g, const Sched& S, const Epi& E) {
    const int tid = ::tidx(), wid = __builtin_amdgcn_readfirstlane(tid >> 6), lane = tid & 63, wr = wid >> 2, wc = wid & 3, fr = lane & 15, fq = lane >> 4;
    const int K = g.K, nt = K / BK;
    unsigned voffA[2], voffB[2];
#pragma unroll
    for (int i = 0; i < 2; ++i) { int R, C; stage_rc(tid * 16 + i * 8192, R, C); const int Rb = Epi::PERM ? ((R & ~31) + perm32(R & 31)) : R;
        voffA[i] = (unsigned)(R * K + C) * 2u; voffB[i] = (unsigned)(Rb * K + C) * 2u; }
    const size_t kstep = (size_t)(BK * 2);
    const size_t hstep = (size_t)HALF * K * 2;
    const size_t tstep = 2 * hstep;
    const unsigned ldsw = (unsigned)wid * 1024u;
    const int aoff = lds_byte(wr * 64 + fr, fq * 8), boff = lds_byte(wc * 32 + fr, fq * 8);
#define PG8_SA(b, h) (((b) * 2 + (h)) * HTB)
#define PG8_SB(b, h) ((4 + (b) * 2 + (h)) * HTB)
#define PG8_STAGE(bufoff, gbase, voff) do { _Pragma("unroll") for (int _i = 0; _i < 2; ++_i) \
        __builtin_amdgcn_global_load_lds((const unsigned*)((const char*)(gbase) + (voff)[_i]), (PG8_LAS unsigned*)(lds + (bufoff) + ldsw + _i * 8192), 16, 0, 0); } while (0)
#define PG8_LDA(dst, b, h) do { _Pragma("unroll") for (int m = 0; m < 4; ++m) _Pragma("unroll") for (int k = 0; k < 2; ++k) dst[m][k] = *(const PG8_LAS bf16x8*)(lds + PG8_SA(b, h) + aoff + m * 2048 + k * 1024); } while (0)
#define PG8_LDB(dst, b, h) do { _Pragma("unroll") for (int n = 0; n < 2; ++n) _Pragma("unroll") for (int k = 0; k < 2; ++k) dst[n][k] = *(const PG8_LAS bf16x8*)(lds + PG8_SB(b, h) + boff + n * 2048 + k * 1024); } while (0)
#define PG8_MMA(ai, bj, At, Bt) do { __builtin_amdgcn_s_setprio(1); _Pragma("unroll") for (int m = 0; m < 4; ++m) _Pragma("unroll") for (int n = 0; n < 2; ++n) _Pragma("unroll") for (int k = 0; k < 2; ++k) \
        acc[ai][bj][m][n] = __builtin_amdgcn_mfma_f32_16x16x32_bf16(Bt[n][k], At[m][k], acc[ai][bj][m][n], 0, 0, 0); __builtin_amdgcn_s_setprio(0); } while (0)
#define PG8_WAIT_V(n) asm volatile("s_waitcnt vmcnt(" #n ")" ::: "memory")
#define PG8_WAIT_L(n) asm volatile("s_waitcnt lgkmcnt(" #n ")" ::: "memory")
#define PG8_BAR __builtin_amdgcn_s_barrier()
#define PG8_SCHED __builtin_amdgcn_sched_barrier(0)
    Unit cur, nxt; int ui = 0;
    if (!S.next(0, cur)) return;
    f32x4 acc[2][2][4][2];
#pragma unroll
    for (int a = 0; a < 2; ++a)
#pragma unroll
        for (int b = 0; b < 2; ++b)
#pragma unroll
            for (int m = 0; m < 4; ++m)
#pragma unroll
                for (int n = 0; n < 2; ++n) acc[a][b][m][n] = (f32x4){0.f, 0.f, 0.f, 0.f};
    bf16x8 At[4][2], B0[2][2], B1[2][2];
    const char* cA = (const char*)g.A + (size_t)cur.pm * tstep; const char* cB = (const char*)g.Bt + (size_t)cur.pn * tstep;
    S.a_ready(cur);
    if constexpr (SP2) {
        PG8_STAGE(PG8_SB(0, 0), cB, voffB); PG8_STAGE(PG8_SB(0, 1), cB + hstep, voffB); PG8_STAGE(PG8_SA(0, 0), cA, voffA); PG8_STAGE(PG8_SA(0, 1), cA + hstep, voffA);
        if (wr == 1) PG8_BAR;
        PG8_WAIT_V(2); PG8_BAR;
        PG8_STAGE(PG8_SB(1, 0), cB + kstep, voffB); PG8_STAGE(PG8_SA(1, 0), cA + kstep, voffA); PG8_STAGE(PG8_SB(1, 1), cB + hstep + kstep, voffB);
        PG8_WAIT_V(6); PG8_BAR;
    } else {
        PG8_STAGE(PG8_SB(0, 0), cB, voffB); PG8_STAGE(PG8_SA(0, 0), cA, voffA); PG8_STAGE(PG8_SB(0, 1), cB + hstep, voffB); PG8_STAGE(PG8_SA(0, 1), cA + hstep, voffA);
        if (wr == 1) PG8_BAR;
        PG8_WAIT_V(4); PG8_BAR;
        PG8_STAGE(PG8_SB(1, 0), cB + kstep, voffB); PG8_STAGE(PG8_SA(1, 0), cA + kstep, voffA); PG8_STAGE(PG8_SB(1, 1), cB + hstep + kstep, voffB);
        PG8_WAIT_V(6); PG8_BAR;
    }
    for (;;) {
        const bool has_next = S.next(ui + 1, nxt);
        const char* nA = has_next ? (const char*)g.A + (size_t)nxt.pm * tstep : cA; const char* nB = has_next ? (const char*)g.Bt + (size_t)nxt.pn * tstep : cB;
        for (int t = 0; t < nt; t += 2) {
            const bool last = (t == nt - 2);
            const char* a1 = cA + (size_t)(t + 1) * kstep;
            const char* a2 = last ? nA : cA + (size_t)(t + 2) * kstep; const char* b2 = last ? nB : cB + (size_t)(t + 2) * kstep;
            const char* a3 = a2 + kstep; const char* b3 = b2 + kstep;
            if (last && has_next) S.a_ready(nxt);
            if constexpr (SP2) {
            PG8_LDB(B0, 0, 0); PG8_LDB(B1, 0, 1); PG8_SCHED; PG8_LDA(At, 0, 0); PG8_STAGE(PG8_SA(1, 1), a1 + hstep, voffA);
            PG8_WAIT_V(8); PG8_WAIT_L(0); PG8_BAR; PG8_MMA(0, 0, At, B0); PG8_MMA(0, 1, At, B1); PG8_BAR; PG8_SCHED;
            PG8_LDA(At, 0, 1); PG8_STAGE(PG8_SB(0, 0), b2, voffB); PG8_STAGE(PG8_SB(0, 1), b2 + hstep, voffB); PG8_STAGE(PG8_SA(0, 0), a2, voffA);
            PG8_WAIT_V(8); PG8_WAIT_L(0); PG8_BAR; PG8_MMA(1, 0, At, B0); PG8_MMA(1, 1, At, B1); PG8_BAR; PG8_SCHED;
            PG8_LDB(B0, 1, 0); PG8_LDB(B1, 1, 1); PG8_SCHED; PG8_LDA(At, 1, 0); PG8_STAGE(PG8_SA(0, 1), a2 + hstep, voffA);
            PG8_WAIT_V(8); PG8_WAIT_L(0); PG8_BAR; PG8_MMA(0, 0, At, B0); PG8_MMA(0, 1, At, B1); PG8_BAR; PG8_SCHED;
            PG8_LDA(At, 1, 1); PG8_STAGE(PG8_SB(1, 0), b3, voffB); PG8_STAGE(PG8_SB(1, 1), b3 + hstep, voffB); PG8_STAGE(PG8_SA(1, 0), a3, voffA);
            PG8_WAIT_V(8); PG8_WAIT_L(0); PG8_BAR; PG8_MMA(1, 0, At, B0); PG8_MMA(1, 1, At, B1); PG8_BAR; PG8_SCHED;
            } else {
            PG8_LDB(B0, 0, 0); PG8_SCHED; PG8_LDA(At, 0, 0); PG8_STAGE(PG8_SA(1, 1), a1 + hstep, voffA);
            PG8_WAIT_L(8); PG8_BAR; PG8_WAIT_L(0); PG8_MMA(0, 0, At, B0); PG8_BAR; PG8_SCHED;
            PG8_LDB(B1, 0, 1); PG8_STAGE(PG8_SB(0, 0), b2, voffB);
            PG8_BAR; PG8_WAIT_L(0); PG8_MMA(0, 1, At, B1); PG8_BAR;
            PG8_LDA(At, 0, 1); PG8_STAGE(PG8_SA(0, 0), a2, voffA);
            PG8_BAR; PG8_WAIT_L(0); PG8_MMA(1, 0, At, B0); PG8_BAR; PG8_SCHED;
            PG8_STAGE(PG8_SB(0, 1), b2 + hstep, voffB);
            PG8_WAIT_V(6); PG8_BAR; PG8_MMA(1, 1, At, B1); PG8_BAR;
            PG8_LDB(B0, 1, 0); PG8_SCHED; PG8_LDA(At, 1, 0); PG8_STAGE(PG8_SA(0, 1), a2 + hstep, voffA);
            PG8_WAIT_L(8); PG8_BAR; PG8_WAIT_L(0); PG8_MMA(0, 0, At, B0); PG8_BAR; PG8_SCHED;
            PG8_LDB(B1, 1, 1); PG8_STAGE(PG8_SB(1, 0), b3, voffB);
            PG8_BAR; PG8_WAIT_L(0); PG8_MMA(0, 1, At, B1); PG8_BAR;
            PG8_LDA(At, 1, 1); PG8_STAGE(PG8_SA(1, 0), a3, voffA);
            PG8_BAR; PG8_WAIT_L(0); PG8_MMA(1, 0, At, B0); PG8_BAR; PG8_SCHED;
            PG8_STAGE(PG8_SB(1, 1), b3 + hstep, voffB);
            PG8_WAIT_V(6); PG8_BAR; PG8_MMA(1, 1, At, B1); PG8_BAR;
            }
        }
        if constexpr (ALIGN_EPI) { if (wr == 0) PG8_BAR; }
        if constexpr (!Epi::AFTER_DRAIN) { E(acc, cur, wr, wc, fr, fq); S.done(cur); }
        if (!has_next) break;
#pragma unroll
        for (int a = 0; a < 2; ++a)
#pragma unroll
            for (int b = 0; b < 2; ++b)
#pragma unroll
                for (int m = 0; m < 4; ++m)
#pragma unroll
                    for (int n = 0; n < 2; ++n) acc[a][b][m][n] = (f32x4){0.f, 0.f, 0.f, 0.f};
        cur = nxt; cA = nA; cB = nB; ++ui;
        if constexpr (ALIGN_EPI) { if (wr == 1) PG8_BAR; }
    }
    PG8_WAIT_V(0);
    if constexpr (!ALIGN_EPI) { if (wr == 0) PG8_BAR; }
    PG8_BAR;
    if constexpr (Epi::AFTER_DRAIN) { E.fused(acc, cur, wr, wc, fr, fq, lds, wid, lane); S.done(cur); }
#undef PG8_SA
#undef PG8_SB
#undef PG8_STAGE
#undef PG8_LDA
#undef PG8_LDB
#undef PG8_MMA
#undef PG8_WAIT_V
#undef PG8_WAIT_L
#undef PG8_BAR
#undef PG8_SCHED
}
#endif
}


__device__ __forceinline__ void transpose_item(const float* W, int ldw, bf16_t* WT, int K, int k0, int n0, int drow0, float* scr, int lane) {
#pragma unroll 8
    for (int i = 0; i < 32; ++i) { const int kk = 2 * i + (lane >> 5); scr[kk * 33 + (lane & 31)] = W[(size_t)(k0 + kk) * ldw + n0 + (lane & 31)]; }
    WAVE_SYNC();
    const int c = lane & 7;
#pragma unroll
    for (int j = 0; j < 4; ++j) { const int n = (lane >> 3) + 8 * j; const float* s = scr + (8 * c) * 33 + n;
        u32x4 o; o.x = pk2(s[0 * 33], s[1 * 33]); o.y = pk2(s[2 * 33], s[3 * 33]); o.z = pk2(s[4 * 33], s[5 * 33]); o.w = pk2(s[6 * 33], s[7 * 33]);
        *(u32x4*)(WT + (size_t)(drow0 + n) * K + k0 + 8 * c) = o; }
    WAVE_SYNC();
}
__device__ __forceinline__ void ph_convert(const P& p, unsigned char* smem) {
    const int lane = tidx() & 63, wave = tidx() >> 6;
    float* scr = (float*)smem + wave * (64 * 33 + 32);
    constexpr int I_IN = 16 * 120, I_OUT = 16 * 32, I_G = 16 * 88, I_DN = 44 * 32, I_L = I_IN + I_OUT + 2 * I_G + I_DN;
    const int gw = blockIdx.x * 8 + wave, ngw = gridDim.x * 8;
    for (int it = gw; it < NL * I_L; it += ngw) {
        const int l = it / I_L; int r = it % I_L;
        if (r < I_IN) { const int kb = r / 120, nb = r % 120; transpose_item(p.w_in + (size_t)l * D * INC, INC, WSP(bf16_t, WS_WIN) + (size_t)l * NPROJ * D, D, kb * 64, nb * 32, nb * 32, scr, lane); continue; }
        r -= I_IN;
        if (r < I_OUT) { const int kb = r / 32, nb = r % 32; transpose_item(p.w_out + (size_t)l * D * D, D, WSP(bf16_t, WS_WOUT) + (size_t)l * D * D, D, kb * 64, nb * 32, nb * 32, scr, lane); continue; }
        r -= I_OUT;
        if (r < 2 * I_G) { const int up = r / I_G; r %= I_G; const int kb = r / 88, nb = r % 88, n0 = nb * 32;
            transpose_item((up ? p.w_up : p.w_gate) + (size_t)l * D * FF, FF, WSP(bf16_t, WS_WGU) + (size_t)l * 2 * FF * D, D, kb * 64, n0, (n0 / 128) * 256 + up * 128 + (n0 % 128), scr, lane); continue; }
        r -= 2 * I_G;
        { const int kb = r / 32, nb = r % 32; transpose_item(p.w_down + (size_t)l * FF * D, D, WSP(bf16_t, WS_WDN) + (size_t)l * D * FF, FF, kb * 64, nb * 32, nb * 32, scr, lane); }
    }
}

__device__ __forceinline__ void ph_adaln(const P& p, unsigned char* smem) {
    float* sc = (float*)smem;
    float* red = sc + NC * 256;
    const int tid = tidx(), col = tid & 31, kg = tid >> 5;
    float* MOD = WSP(float, WS_MOD);
    for (int it = blockIdx.x; it < NL * 192; it += gridDim.x) {
        const int l = it / 192, cb0 = (it % 192) * 32;
        float acc[NC];
#pragma unroll
        for (int r = 0; r < NC; ++r) acc[r] = 0.f;
        for (int kc = 0; kc < 4; ++kc) {
            __syncthreads();
            for (int e = tid; e < NC * 256; e += NTHR) { const int r = e >> 8, k = e & 255; const float c = r < PB ? p.c_prompt[r * D + kc * 256 + k] : p.c_sample[(r - PB) * D + kc * 256 + k]; sc[e] = silu_f(c); }
            __syncthreads();
            for (int kk = 0; kk < 16; ++kk) { const int k = kg * 16 + kk; const float w = p.ada_w[((size_t)l * D + kc * 256 + k) * 6144 + cb0 + col];
#pragma unroll
                for (int r = 0; r < NC; ++r) acc[r] += sc[r * 256 + k] * w; }
        }
#pragma unroll
        for (int r = 0; r < NC; ++r) red[(kg * NC + r) * 32 + col] = acc[r];
        __syncthreads();
        for (int e = tid; e < NC * 32; e += NTHR) { const int r = e >> 5, c = e & 31; float s = p.ada_b[l * 6144 + cb0 + c];
            for (int g = 0; g < 16; ++g) s += red[(g * NC + r) * 32 + c];
            MOD[((size_t)l * NC + r) * 6144 + cb0 + c] = s; }
        __syncthreads();
    }
}

__device__ __forceinline__ void ph_ropetab_copyx(const P& p) {
    const size_t gt = (size_t)blockIdx.x * NTHR + tidx(), ng = (size_t)gridDim.x * NTHR;
    float* tab = WSP(float, WS_ROPE);
    for (size_t e = gt; e < (size_t)NL * D * 8; e += ng) WSP(float, WS_W8)[e] = p.w_in[(e >> 3) * INC + NPROJ + (e & 7)];
    for (size_t e = gt; e < (size_t)NPOS * 32; e += ng) {
        const int pi = (int)(e >> 5), i = (int)(e & 31); const double pos = pi < T ? (double)pi : (double)(PAST + pi - T);
        const double ia = exp(-log(10000.0) * (double)i / 32.0), ir = exp(-log(10000.0) * (double)i / 31.0);
        tab[e] = (float)cos(pos * ia); tab[(size_t)NPOS * 32 + e] = (float)sin(pos * ia);
        tab[(size_t)2 * NPOS * 32 + e] = (float)cos(pos * ir); tab[(size_t)3 * NPOS * 32 + e] = (float)sin(pos * ir);
    }
}

template <int WHICH> __device__ __forceinline__ void ph_norm_mod(const P& p, int l) {
    const int lane = tidx() & 63, wave = tidx() >> 6, gw = blockIdx.x * 8 + wave, ngw = gridDim.x * 8;
    const float* nw = (WHICH == 0 ? p.norm_mix : p.norm_ffn) + l * D;
    bf16_t* H = WSP(bf16_t, WS_H);
    for (int r = gw; r < M; r += ngw) {
        const float* xr = (WHICH == 0 && l == 0) ? (r < MP ? p.x_prompt + (size_t)r * D : p.x_sample + (size_t)(r - MP) * D) : p.out + (size_t)r * D;
        const float* mod = WSP(float, WS_MOD) + ((size_t)l * NC + row_cb(r)) * 6144 + (WHICH == 0 ? 0 : 3072);
        f32x4 v[4]; float ss = 0.f;
#pragma unroll
        for (int j = 0; j < 4; ++j) { v[j] = *(const f32x4*)(xr + 4 * lane + 256 * j); ss += (v[j][0] * v[j][0] + v[j][1] * v[j][1]) + (v[j][2] * v[j][2] + v[j][3] * v[j][3]); }
        const float rstd = 1.0f / sqrtf(wave_sum(ss) * (1.0f / D) + EPS);
        float a8[8];
#pragma unroll
        for (int c = 0; c < 8; ++c) a8[c] = 0.f;
#pragma unroll
        for (int j = 0; j < 4; ++j) { const int k = 4 * lane + 256 * j;
            const f32x4 g = *(const f32x4*)(nw + k), sh = *(const f32x4*)(mod + k), sc = *(const f32x4*)(mod + 1024 + k);
            f32x4 h;
#pragma unroll
            for (int e = 0; e < 4; ++e) h[e] = v[j][e] * rstd * g[e] * (1.0f + sc[e]) + sh[e];
            u32x2 w; w.x = pk2(h[0], h[1]); w.y = pk2(h[2], h[3]); *(u32x2*)(H + (size_t)r * D + k) = w;
            if (WHICH == 0) {
#pragma unroll
                for (int e = 0; e < 4; ++e) { const float* wr = WSP(float, WS_W8) + ((size_t)l * D + k + e) * 8; const f32x4 w0 = *(const f32x4*)wr, w1 = *(const f32x4*)(wr + 4);
#pragma unroll
                    for (int c = 0; c < 4; ++c) { a8[c] += h[e] * w0[c]; a8[4 + c] += h[e] * w1[c]; } }
            }
        }
        if (WHICH == 0) {
#pragma unroll
            for (int c = 0; c < 8; ++c) a8[c] = wave_sum(a8[c]);
            if (lane < 4) { float braw = lane == 0 ? a8[0] : lane == 1 ? a8[1] : lane == 2 ? a8[2] : a8[3]; WSP(float, WS_BETA)[(size_t)r * 4 + lane] = 1.0f / (1.0f + expf(-braw)); }
            else if (lane < 8) { const int hh = lane - 4; float araw = hh == 0 ? a8[4] : hh == 1 ? a8[5] : hh == 2 ? a8[6] : a8[7];
                const float xx = araw + p.dt_bias[l * 4 + hh]; const float sp = xx > 20.f ? xx : log1pf(expf(xx));
                WSP(float, WS_G)[(size_t)r * 4 + hh] = -expf(p.a_log[l * 4 + hh]) * sp; }
        }
    }
}

__device__ __forceinline__ void unpack8(const u32x4 w, float (&f)[8]) {
    f[0] = __builtin_bit_cast(float, w.x << 16); f[1] = __builtin_bit_cast(float, w.x & 0xffff0000u); f[2] = __builtin_bit_cast(float, w.y << 16); f[3] = __builtin_bit_cast(float, w.y & 0xffff0000u);
    f[4] = __builtin_bit_cast(float, w.z << 16); f[5] = __builtin_bit_cast(float, w.z & 0xffff0000u); f[6] = __builtin_bit_cast(float, w.w << 16); f[7] = __builtin_bit_cast(float, w.w & 0xffff0000u);
}
__device__ __forceinline__ u32x4 pack8f(const float (&f)[8]) { u32x4 w; w.x = pk2(f[0], f[1]); w.y = pk2(f[2], f[3]); w.z = pk2(f[4], f[5]); w.w = pk2(f[6], f[7]); return w; }
__device__ __forceinline__ void ph_rope_out(const P& p, int l) {
    const size_t gt = (size_t)blockIdx.x * NTHR + tidx(), ng = (size_t)gridDim.x * NTHR;
    bf16_t* PR = WSP(bf16_t, WS_PROJ); const float* tab = WSP(float, WS_ROPE);
    for (size_t e = gt; e < (size_t)M * 64; e += ng) {
        const int r = (int)(e >> 6), rem = (int)(e & 63), sec = rem >> 4, hh = (rem >> 2) & 3, d = (rem & 3) * 8;
        if (sec >= 2 && r < MP) continue;
        const int off = sec == 0 ? C_QA : sec == 1 ? C_KA : sec == 2 ? C_QR : C_KR; const float scale = sec == 0 ? 0.125f * LOG2E : sec == 3 ? 0.125f : 1.0f;
        const float* ct = tab + (size_t)(sec >= 2 ? 2 : 0) * NPOS * 32 + (size_t)row_pi(r) * 32 + d; const float* st = ct + (size_t)NPOS * 32;
        const f32x4 c0 = *(const f32x4*)ct, c1 = *(const f32x4*)(ct + 4), s0 = *(const f32x4*)st, s1 = *(const f32x4*)(st + 4);
        bf16_t* x = PR + (size_t)r * NPROJ + off + hh * 64 + d; float x1[8], x2[8], o1[8], o2[8];
        unpack8(*(const u32x4*)x, x1); unpack8(*(const u32x4*)(x + 32), x2);
#pragma unroll
        for (int k = 0; k < 8; ++k) { const float c = k < 4 ? c0[k & 3] : c1[k & 3], sn = k < 4 ? s0[k & 3] : s1[k & 3]; o1[k] = (x1[k] * c - x2[k] * sn) * scale; o2[k] = (x1[k] * sn + x2[k] * c) * scale; }
        const u32x4 w1 = pack8f(o1), w2 = pack8f(o2);
        *(u32x4*)x = w1; *(u32x4*)(x + 32) = w2;
        if (sec == 1) {
            float* o = nullptr;
            if (r < MP) { const int b = r / T, t = r % T; bf16_t* kh = WSP(bf16_t, WS_KH) + ((size_t)(b * 4 + hh) * T + t) * 64 + d; *(u32x4*)kh = w1; *(u32x4*)(kh + 32) = w2;
                if (t >= T - PWIN) o = p.out + O_PWK + (((size_t)l * PB + b) * PWIN + (t - (T - PWIN))) * 256 + hh * 64 + d; }
            else { const int b = (r - MP) / DS, i = (r - MP) % DS; o = p.out + O_SWK + (((size_t)l * DB + b) * DS + i) * 256 + hh * 64 + d; }
            if (o) { *(f32x4*)o = (f32x4){o1[0], o1[1], o1[2], o1[3]}; *(f32x4*)(o + 4) = (f32x4){o1[4], o1[5], o1[6], o1[7]}; *(f32x4*)(o + 32) = (f32x4){o2[0], o2[1], o2[2], o2[3]}; *(f32x4*)(o + 36) = (f32x4){o2[4], o2[5], o2[6], o2[7]}; }
        }
    }
    for (size_t e = gt; e < (size_t)M * 32; e += ng) {
        const int r = (int)(e >> 5), c = (int)(e & 31) * 8; float* o = nullptr;
        if (r < MP) { const int b = r / T, t = r % T; if (t >= T - PWIN) o = p.out + O_PWV + (((size_t)l * PB + b) * PWIN + (t - (T - PWIN))) * 256 + c; }
        else { const int b = (r - MP) / DS, i = (r - MP) % DS; o = p.out + O_SWV + (((size_t)l * DB + b) * DS + i) * 256 + c; }
        if (o) { float v[8]; unpack8(*(const u32x4*)(PR + (size_t)r * NPROJ + C_VA + c), v); *(f32x4*)o = (f32x4){v[0], v[1], v[2], v[3]}; *(f32x4*)(o + 4) = (f32x4){v[4], v[5], v[6], v[7]}; }
    }
    for (size_t e = gt; e < (size_t)(PB + DB) * 3 * 1536; e += ng) {
        const int c = (int)(e % 1536), j = (int)((e / 1536) % 3), bb = (int)(e / (3 * 1536));
        if (bb < PB) p.out[O_PCONV + (((size_t)l * PB + bb) * 3 + j) * 1536 + c] = bf2f(PR[(size_t)(bb * T + T - 3 + j) * NPROJ + C_CONV + c]);
        else { const int b = bb - PB; p.out[O_SCONV + (((size_t)l * DB + b) * 3 + j) * 1536 + c] = bf2f(PR[(size_t)(MP + b * DS + DS - 3 + j) * NPROJ + C_CONV + c]); }
    }
}

__device__ __forceinline__ void attn_wave_sample(const P& p, int l, int r, int h, int lane, float* sw  ) {
    const bf16_t* PR = WSP(bf16_t, WS_PROJ);
    const int b = (r - MP) / DS; const int tq = WB + (r - MP) % DS;
    float q[64];
    { const bf16_t* qp = PR + (size_t)r * NPROJ + C_QA + h * 64;
#pragma unroll
      for (int j = 0; j < 8; ++j) { const bf16x8 v = *(const bf16x8*)(qp + 8 * j);
#pragma unroll
          for (int e = 0; e < 8; ++e) q[8 * j + e] = bf2f((bf16_t)v[e]); } }
    float mx = -INFINITY;
#pragma unroll 1
    for (int i = 0; i < 7; ++i) {
        const int e = lane + 64 * i;
        if (e < 387) { const int pat = e / 129, j = e % 129, dil = pat == 0 ? 1 : pat == 1 ? 4 : 16; const int rr = tq - dil * j;
            float a = 0.f;
            if (rr < WB) { const float* kp = p.cache_k + ((((size_t)l * DB + b) * WB + rr) * 4 + h) * 64;
#pragma unroll
                for (int j4 = 0; j4 < 16; ++j4) { const f32x4 kv = *(const f32x4*)(kp + 4 * j4); a += q[4 * j4] * kv[0] + q[4 * j4 + 1] * kv[1] + q[4 * j4 + 2] * kv[2] + q[4 * j4 + 3] * kv[3]; } }
            else { const bf16_t* kp = PR + (size_t)(MP + b * DS + (rr - WB)) * NPROJ + C_KA + h * 64;
#pragma unroll
                for (int j8 = 0; j8 < 8; ++j8) { const bf16x8 kv = *(const bf16x8*)(kp + 8 * j8);
#pragma unroll
                    for (int e2 = 0; e2 < 8; ++e2) a += q[8 * j8 + e2] * bf2f((bf16_t)kv[e2]); } }
            sw[e] = a; mx = fmaxf(mx, a); }
    }
    mx = wave_max(mx);
    float lsum = 0.f;
#pragma unroll 1
    for (int i = 0; i < 7; ++i) { const int e = lane + 64 * i; if (e < 387) { const float pe = exp2f(sw[e] - mx); sw[e] = pe; lsum += pe; } }
    lsum = wave_sum(lsum);
    WAVE_SYNC();
    const int kg = lane >> 4, dq = lane & 15; f32x4 o4 = (f32x4){0.f, 0.f, 0.f, 0.f};
#pragma unroll 8
    for (int e = kg; e < 387; e += 4) {
        const float pe = sw[e];
        const int pat = e / 129, j = e % 129, dil = pat == 0 ? 1 : pat == 1 ? 4 : 16; const int rr = tq - dil * j;
        f32x4 v;
        if (rr < WB) v = *(const f32x4*)(p.cache_v + ((((size_t)l * DB + b) * WB + rr) * 4 + h) * 64 + 4 * dq);
        else { const u32x2 w = *(const u32x2*)(PR + (size_t)(MP + b * DS + (rr - WB)) * NPROJ + C_VA + h * 64 + 4 * dq);
            v = (f32x4){bf2f((bf16_t)(w.x & 0xffff)), bf2f((bf16_t)(w.x >> 16)), bf2f((bf16_t)(w.y & 0xffff)), bf2f((bf16_t)(w.y >> 16))}; }
        o4 += pe * v;
    }
#pragma unroll
    for (int e = 0; e < 4; ++e) { float x = o4[e]; x += __shfl_xor(x, 16); x += __shfl_xor(x, 32); o4[e] = x; }
    WAVE_SYNC();
    if (kg == 0) { const float inv = 1.0f / lsum; u32x2 w; w.x = pk2(o4[0] * inv, o4[1] * inv); w.y = pk2(o4[2] * inv, o4[3] * inv);
        *(u32x2*)(WSP(bf16_t, WS_O) + (size_t)r * D + h * 64 + 4 * dq) = w; }
}
__device__ __forceinline__ void ph_attn_sample(const P& p, int l, unsigned char* smem) {
    const int lane = tidx() & 63, wave = tidx() >> 6, gw = (gridDim.x - 1 - blockIdx.x) * 8 + wave, ngw = gridDim.x * 8;
    float* sw = (float*)smem + wave * 392;
    for (int it = gw; it < MS * 4; it += ngw) attn_wave_sample(p, l, MP + (it >> 2), it & 3, lane, sw);
}
__device__ __forceinline__ bf16x8 pack8(const f32x16& v, int s8) {
    u32x4 w; w.x = pk2(v[s8], v[s8 + 1]); w.y = pk2(v[s8 + 2], v[s8 + 3]); w.z = pk2(v[s8 + 4], v[s8 + 5]); w.w = pk2(v[s8 + 6], v[s8 + 7]); return __builtin_bit_cast(bf16x8, w);
}
__device__ __forceinline__ void attn_job(const P& p, int jb, int lane) {
    const int c = lane & 31, hi = lane >> 5;
    constexpr int NB = T / 512;
    const int unit = jb / 48, jj = jb % 48, pat = jj >> 4, sub = jj & 15;
    const int blk = unit % NB, h = (unit / NB) & 3, b = unit / (NB * 4), bh = b * 4 + h;
    int dil, r, qi0; const bf16_t* VT;
    if (pat == 0) { dil = 1; r = 0; qi0 = blk * 512 + sub * 32; VT = WSP(bf16_t, WS_VT1) + (size_t)bh * 64 * T; }
    else if (pat == 1) { dil = 4; r = sub >> 2; qi0 = blk * 128 + (sub & 3) * 32; VT = WSP(bf16_t, WS_VT4) + (size_t)(bh * 4 + r) * 64 * (T / 4); }
    else { dil = 16; r = sub; qi0 = blk * 32; VT = WSP(bf16_t, WS_VT16) + (size_t)(bh * 16 + r) * 64 * (T / 16); }
    const int SL = T / dil;
    const int tq = dil * (qi0 + c) + r;
    const bf16_t* qp = WSP(bf16_t, WS_PROJ) + (size_t)(b * T + tq) * NPROJ + C_QA + h * 64 + 8 * hi;
    bf16x8 qf[4];
#pragma unroll
    for (int ks = 0; ks < 4; ++ks) qf[ks] = *(const bf16x8*)(qp + 16 * ks);
    const bf16_t* KHb = WSP(bf16_t, WS_KH) + (size_t)bh * T * 64;
    f32x16 S[5];
#pragma unroll
    for (int i = 0; i < 5; ++i) {
        const int kt0 = qi0 - 128 + 32 * i;
        f32x16 acc;
#pragma unroll
        for (int e = 0; e < 16; ++e) acc[e] = 0.f;
        if (kt0 >= 0) { const bf16_t* kp = KHb + (size_t)(dil * (kt0 + c) + r) * 64 + 8 * hi;
#pragma unroll
            for (int ks = 0; ks < 4; ++ks) acc = MFMA32(*(const bf16x8*)(kp + 16 * ks), qf[ks], acc);
            if (i == 0) {
#pragma unroll
                for (int e = 0; e < 16; ++e) { const int krow = (e & 3) + 8 * (e >> 2) + 4 * hi; if (krow < c) acc[e] = -INFINITY; } }
            if (i == 4) {
#pragma unroll
                for (int e = 0; e < 16; ++e) { const int krow = (e & 3) + 8 * (e >> 2) + 4 * hi; if (krow > c) acc[e] = -INFINITY; } }
        } else {
#pragma unroll
            for (int e = 0; e < 16; ++e) acc[e] = -INFINITY; }
        S[i] = acc;
    }
    float mx = -INFINITY;
#pragma unroll
    for (int i = 0; i < 5; ++i)
#pragma unroll
        for (int e = 0; e < 16; ++e) mx = fmaxf(mx, S[i][e]);
    mx = fmaxf(mx, __shfl_xor(mx, 32));
    float lsum = 0.f;
#pragma unroll
    for (int i = 0; i < 5; ++i)
#pragma unroll
        for (int e = 0; e < 16; ++e) { const float pe = exp2f(S[i][e] - mx); S[i][e] = pe; lsum += pe; }
    lsum += __shfl_xor(lsum, 32);
    f32x16 O[2];
#pragma unroll
    for (int dt = 0; dt < 2; ++dt)
#pragma unroll
        for (int e = 0; e < 16; ++e) O[dt][e] = 0.f;
#pragma unroll
    for (int i = 0; i < 5; ++i) {
        const int kt0 = qi0 - 128 + 32 * i;
        if (kt0 >= 0) {
#pragma unroll
            for (int s2 = 0; s2 < 2; ++s2) { const bf16x8 pf = pack8(S[i], 8 * s2);
#pragma unroll
                for (int dt = 0; dt < 2; ++dt) { const bf16_t* vp = VT + (size_t)(dt * 32 + c) * SL + kt0 + 16 * s2 + 4 * hi;
                    const u32x2 lo = *(const u32x2*)vp, hh = *(const u32x2*)(vp + 8); u32x4 w; w.x = lo.x; w.y = lo.y; w.z = hh.x; w.w = hh.y;
                    O[dt] = MFMA32(__builtin_bit_cast(bf16x8, w), pf, O[dt]); } }
        }
    }
    const size_t idx = ((size_t)(b * T + tq) * 4 + h) * 3 + pat;
    bf16_t* po = WSP(bf16_t, WS_APO) + idx * 64;
#pragma unroll
    for (int dt = 0; dt < 2; ++dt)
#pragma unroll
        for (int g = 0; g < 4; ++g) { u32x2 w; w.x = pk2(O[dt][4 * g], O[dt][4 * g + 1]); w.y = pk2(O[dt][4 * g + 2], O[dt][4 * g + 3]); *(u32x2*)(po + 32 * dt + 8 * g + 4 * hi) = w; }
    if (hi == 0) { float* ml = WSP(float, WS_AML) + idx * 2; ml[0] = mx; ml[1] = lsum; }
}
__device__ __forceinline__ void ph_attn_jobs(const P& p) {
    const int lane = tidx() & 63, wave = tidx() >> 6, gw = blockIdx.x * 8 + wave, ngw = gridDim.x * 8;
    for (int jb = gw; jb < PB * 4 * (T / 512) * 48; jb += ngw) attn_job(p, jb, lane);
}
__device__ __forceinline__ void ph_attn_combine(const P& p) {
    const size_t gt = (size_t)blockIdx.x * NTHR + tidx(), ng = (size_t)gridDim.x * NTHR;
    for (size_t e = gt; e < (size_t)MP * 4 * 16; e += ng) {
        const size_t rh = e >> 4; const int dq = (int)(e & 15) * 4;
        const float* ml = WSP(float, WS_AML) + rh * 6; const float m0 = ml[0], m1 = ml[2], m2 = ml[4];
        const float mm = fmaxf(m0, fmaxf(m1, m2)); const float w0 = exp2f(m0 - mm), w1 = exp2f(m1 - mm), w2 = exp2f(m2 - mm);
        const float inv = 1.0f / (w0 * ml[1] + w1 * ml[3] + w2 * ml[5]);
        const bf16_t* po = WSP(bf16_t, WS_APO) + rh * 192 + dq;
        const u32x2 a = *(const u32x2*)po, bq = *(const u32x2*)(po + 64), cq = *(const u32x2*)(po + 128);
        float o[4];
        o[0] = w0 * bf2f((bf16_t)(a.x & 0xffff)) + w1 * bf2f((bf16_t)(bq.x & 0xffff)) + w2 * bf2f((bf16_t)(cq.x & 0xffff));
        o[1] = w0 * bf2f((bf16_t)(a.x >> 16)) + w1 * bf2f((bf16_t)(bq.x >> 16)) + w2 * bf2f((bf16_t)(cq.x >> 16));
        o[2] = w0 * bf2f((bf16_t)(a.y & 0xffff)) + w1 * bf2f((bf16_t)(bq.y & 0xffff)) + w2 * bf2f((bf16_t)(cq.y & 0xffff));
        o[3] = w0 * bf2f((bf16_t)(a.y >> 16)) + w1 * bf2f((bf16_t)(bq.y >> 16)) + w2 * bf2f((bf16_t)(cq.y >> 16));
        const size_t row = rh >> 2; const int h = (int)(rh & 3);
        u32x2 w; w.x = pk2(o[0] * inv, o[1] * inv); w.y = pk2(o[2] * inv, o[3] * inv);
        *(u32x2*)(WSP(bf16_t, WS_O) + row * D + h * 64 + dq) = w;
    }
}
__device__ __forceinline__ float ret_lg(int h) { return logf(1.0f - exp2f(-5.0f - (float)h)); }
__device__ __forceinline__ void trans_write(const bf16_t* tile, bf16_t* dst  , int tile0, int tid) {
#pragma unroll
    for (int k = 0; k < 4; ++k) { const int ch = tid + NTHR * k, d = ch >> 5, t0 = (ch & 31) * 8; u32x4 w;
        w.x = (unsigned)tile[(t0 + 0) * 72 + d] | ((unsigned)tile[(t0 + 1) * 72 + d] << 16); w.y = (unsigned)tile[(t0 + 2) * 72 + d] | ((unsigned)tile[(t0 + 3) * 72 + d] << 16);
        w.z = (unsigned)tile[(t0 + 4) * 72 + d] | ((unsigned)tile[(t0 + 5) * 72 + d] << 16); w.w = (unsigned)tile[(t0 + 6) * 72 + d] | ((unsigned)tile[(t0 + 7) * 72 + d] << 16);
        *(u32x4*)(dst + (size_t)d * T + tile0 + t0) = w; COMPILER_FENCE(); }
}
__device__ __forceinline__ void ph_vtrans(const P& p, unsigned char* smem) {
    bf16_t* vt = (bf16_t*)smem; bf16_t* vr = vt + 256 * 72; bf16_t* kt = vr + 256 * 72;
    const int tid = tidx(); bf16_t* PR = WSP(bf16_t, WS_PROJ); const float* tab = WSP(float, WS_ROPE);
    for (int u = blockIdx.x; u < PB * 4 * (T / 256); u += gridDim.x) {
        const int tile = u % (T / 256), bh = u / (T / 256), h = bh & 3, b = bh >> 2; const float lg = ret_lg(h);
        __syncthreads();
#pragma unroll
        for (int k = 0; k < 4; ++k) { const int ch = tid + NTHR * k, t = ch >> 3, d8 = (ch & 7) * 8; const bf16_t* src = PR + (size_t)(b * T + tile * 256 + t) * NPROJ + h * 64 + d8;
            *(u32x4*)(vt + t * 72 + d8) = *(const u32x4*)(src + C_VA); *(u32x4*)(vr + t * 72 + d8) = *(const u32x4*)(src + C_VR); }
#pragma unroll
        for (int k = 0; k < 2; ++k) { const int e = tid + NTHR * k, t = e >> 2, d = (e & 3) * 8, tt = tile * 256 + t; bf16_t* row = PR + (size_t)(b * T + tt) * NPROJ + h * 64 + d;
            const float* ct = tab + (size_t)2 * NPOS * 32 + (size_t)tt * 32 + d; const float* st = ct + (size_t)NPOS * 32;
            const f32x4 c0 = *(const f32x4*)ct, c1 = *(const f32x4*)(ct + 4), s0 = *(const f32x4*)st, s1 = *(const f32x4*)(st + 4);
            const float gq = expf(lg * (float)(tt & 63)), gk = 0.125f / gq; float x1[8], x2[8], o1[8], o2[8];
            unpack8(*(const u32x4*)(row + C_QR), x1); unpack8(*(const u32x4*)(row + C_QR + 32), x2);
#pragma unroll
            for (int i = 0; i < 8; ++i) { const float c = i < 4 ? c0[i & 3] : c1[i & 3], sn = i < 4 ? s0[i & 3] : s1[i & 3]; o1[i] = (x1[i] * c - x2[i] * sn) * gq; o2[i] = (x1[i] * sn + x2[i] * c) * gq; }
            *(u32x4*)(row + C_QR) = pack8f(o1); *(u32x4*)(row + C_QR + 32) = pack8f(o2);
            unpack8(*(const u32x4*)(row + C_KR), x1); unpack8(*(const u32x4*)(row + C_KR + 32), x2);
#pragma unroll
            for (int i = 0; i < 8; ++i) { const float c = i < 4 ? c0[i & 3] : c1[i & 3], sn = i < 4 ? s0[i & 3] : s1[i & 3]; o1[i] = (x1[i] * c - x2[i] * sn) * gk; o2[i] = (x1[i] * sn + x2[i] * c) * gk; }
            const u32x4 w1 = pack8f(o1), w2 = pack8f(o2);
            *(u32x4*)(row + C_KR) = w1; *(u32x4*)(row + C_KR + 32) = w2; *(u32x4*)(kt + t * 72 + d) = w1; *(u32x4*)(kt + t * 72 + d + 32) = w2; COMPILER_FENCE(); }
        __syncthreads();
        trans_write(vt, WSP(bf16_t, WS_VT1) + (size_t)bh * 64 * T, tile * 256, tid);
        trans_write(vr, WSP(bf16_t, WS_VRT) + (size_t)bh * 64 * T, tile * 256, tid);
        trans_write(kt, WSP(bf16_t, WS_KRT) + (size_t)bh * 64 * T, tile * 256, tid);
#pragma unroll
        for (int k = 0; k < 4; ++k) { const int ch = tid + NTHR * k;
            { const int r = ch >> 9, d = (ch >> 3) & 63, s0 = (ch & 7) * 8; u32x4 w;
#define VT4E(e_) ((unsigned)vt[(4 * (s0 + (e_)) + r) * 72 + d])
              w.x = VT4E(0) | (VT4E(1) << 16); w.y = VT4E(2) | (VT4E(3) << 16); w.z = VT4E(4) | (VT4E(5) << 16); w.w = VT4E(6) | (VT4E(7) << 16);
#undef VT4E
              *(u32x4*)(WSP(bf16_t, WS_VT4) + ((size_t)(bh * 4 + r) * 64 + d) * (T / 4) + tile * 64 + s0) = w; COMPILER_FENCE(); }
            { const int r = ch >> 7, d = (ch >> 1) & 63, s0 = (ch & 1) * 8; u32x4 w;
#define VT16E(e_) ((unsigned)vt[(16 * (s0 + (e_)) + r) * 72 + d])
              w.x = VT16E(0) | (VT16E(1) << 16); w.y = VT16E(2) | (VT16E(3) << 16); w.z = VT16E(4) | (VT16E(5) << 16); w.w = VT16E(6) | (VT16E(7) << 16);
#undef VT16E
              *(u32x4*)(WSP(bf16_t, WS_VT16) + ((size_t)(bh * 16 + r) * 64 + d) * (T / 16) + tile * 16 + s0) = w; COMPILER_FENCE(); }
        }
    }
}

__device__ __forceinline__ void ph_ret_local(const P& p, int l) {
    const int tid = tidx(), lane = tid & 63, wave = tid >> 6, x = lane & 15, q = lane >> 4, dt = wave >> 1;
    for (int u = blockIdx.x; u < NUNIT; u += gridDim.x) {
        const int n = u % NCH, bh = u / NCH, h = bh & 3, t0 = n * 64; const float g63 = expf(ret_lg(h) * 63.0f);
        const bf16_t* ka = WSP(bf16_t, WS_KRT) + ((size_t)bh * 64 + 16 * dt + x) * T + t0 + 8 * q;
#pragma unroll
        for (int k = 0; k < 2; ++k) { const int et = 2 * (wave & 1) + k; const bf16_t* vb = WSP(bf16_t, WS_VRT) + ((size_t)bh * 64 + 16 * et + x) * T + t0 + 8 * q;
            f32x4 acc = (f32x4){0.f, 0.f, 0.f, 0.f};
#pragma unroll
            for (int ks = 0; ks < 2; ++ks) acc = MFMA16(*(const bf16x8*)(ka + 32 * ks), *(const bf16x8*)(vb + 32 * ks), acc);
            *(f32x4*)(WSP(float, WS_RU) + (size_t)u * 4096 + (16 * et + x) * 64 + 16 * dt + 4 * q) = acc * g63; }
    }
}
__device__ __forceinline__ void ph_ret_scan(const P& p, int l) {
    const int gt = blockIdx.x * NTHR + tidx(), ng = gridDim.x * NTHR;
    for (int e = gt; e < PB * 4 * 4096; e += ng) {
        const int bh = e >> 12, ed = e & 4095, h = bh & 3; const float cd = expf(ret_lg(h) * 64.0f);
        const float* U = WSP(float, WS_RU) + (size_t)bh * NCH * 4096 + ed; bf16_t* SPv = WSP(bf16_t, WS_RS) + (size_t)bh * NCH * 4096 + ed;
        float s = 0.f;
        for (int n0 = 0; n0 < NCH; n0 += 8) {
            float uv[8];
#pragma unroll
            for (int k = 0; k < 8; ++k) uv[k] = U[(size_t)(n0 + k) * 4096];
#pragma unroll
            for (int k = 0; k < 8; ++k) { SPv[(size_t)(n0 + k) * 4096] = f2bf(s); s = s * cd + uv[k]; } }
        p.out[O_PRET + ((size_t)l * PB * 4 + bh) * 4096 + (ed & 63) * 64 + (ed >> 6)] = s;
    }
}
__device__ __forceinline__ void ph_ret_out(const P& p, int l) {
    const int tid = tidx(), lane = tid & 63, wave = tid >> 6, x = lane & 15, q = lane >> 4, it = UNIFORM(wave & 3);
    const bf16_t* PR = WSP(bf16_t, WS_PROJ);
    for (int u = blockIdx.x * 2 + (wave >> 2); u < NUNIT; u += gridDim.x * 2) {
        const int n = u % NCH, bh = u / NCH, h = bh & 3, b = bh >> 2, t0 = n * 64; const float gam = expf(ret_lg(h));
        const size_t rowi = (size_t)(b * T + t0 + 16 * it + x);
        bf16x8 qf[2];
#pragma unroll
        for (int ks = 0; ks < 2; ++ks) qf[ks] = *(const bf16x8*)(PR + rowi * NPROJ + C_QR + h * 64 + 32 * ks + 8 * q);
        f32x4 at[4];
#pragma unroll
        for (int jt = 0; jt < 4; ++jt) { at[jt] = (f32x4){0.f, 0.f, 0.f, 0.f};
            if (jt <= it) { const bf16_t* kp = PR + (size_t)(b * T + t0 + 16 * jt + x) * NPROJ + C_KR + h * 64 + 8 * q;
#pragma unroll
                for (int ks = 0; ks < 2; ++ks) at[jt] = MFMA16(*(const bf16x8*)(kp + 32 * ks), qf[ks], at[jt]);
                if (jt == it) {
#pragma unroll
                    for (int e = 0; e < 4; ++e) if (4 * q + e > x) at[jt][e] = 0.f; } } }
        const bf16x8 pb0 = pack_tiles(at[0], at[1]), pb1 = pack_tiles(at[2], at[3]);
        f32x4 o[4], os[4];
#pragma unroll
        for (int et = 0; et < 4; ++et) { o[et] = (f32x4){0.f, 0.f, 0.f, 0.f}; os[et] = (f32x4){0.f, 0.f, 0.f, 0.f};
            const bf16_t* vp = WSP(bf16_t, WS_VRT) + ((size_t)bh * 64 + 16 * et + x) * T + t0 + 4 * q;
            { const u32x2 lo = *(const u32x2*)vp, hi = *(const u32x2*)(vp + 16); u32x4 w; w.x = lo.x; w.y = lo.y; w.z = hi.x; w.w = hi.y; o[et] = MFMA16(__builtin_bit_cast(bf16x8, w), pb0, o[et]); }
            if (it >= 2) { const u32x2 lo = *(const u32x2*)(vp + 32), hi = *(const u32x2*)(vp + 48); u32x4 w; w.x = lo.x; w.y = lo.y; w.z = hi.x; w.w = hi.y; o[et] = MFMA16(__builtin_bit_cast(bf16x8, w), pb1, o[et]); }
            const bf16_t* sp = WSP(bf16_t, WS_RS) + (size_t)u * 4096 + (16 * et + x) * 64 + 8 * q;
#pragma unroll
            for (int ks = 0; ks < 2; ++ks) os[et] = MFMA16(*(const bf16x8*)(sp + 32 * ks), qf[ks], os[et]);
            o[et] = o[et] + os[et] * gam; }
        float sq = 0.f;
#pragma unroll
        for (int et = 0; et < 4; ++et) sq += (o[et][0] * o[et][0] + o[et][1] * o[et][1]) + (o[et][2] * o[et][2] + o[et][3] * o[et][3]);
        sq += __shfl_xor(sq, 16); sq += __shfl_xor(sq, 32);
        const float rstd = 1.0f / sqrtf(sq * (1.0f / 64.0f) + EPS);
#pragma unroll
        for (int et = 0; et < 4; ++et) { const int e0 = 16 * et + 4 * q; const u32x2 gw = *(const u32x2*)(PR + rowi * NPROJ + C_GR + h * 64 + e0); const f32x4 nw = *(const f32x4*)(p.ret_norm + l * 64 + e0);
            const float g0 = bf2f((bf16_t)(gw.x & 0xffff)), g1 = bf2f((bf16_t)(gw.x >> 16)), g2 = bf2f((bf16_t)(gw.y & 0xffff)), g3 = bf2f((bf16_t)(gw.y >> 16));
            u32x2 w; w.x = pk2(o[et][0] * rstd * nw[0] * silu_f(g0), o[et][1] * rstd * nw[1] * silu_f(g1)); w.y = pk2(o[et][2] * rstd * nw[2] * silu_f(g2), o[et][3] * rstd * nw[3] * silu_f(g3));
            *(u32x2*)(WSP(bf16_t, WS_O) + rowi * D + 256 + h * 64 + e0) = w; }
    }
}
__device__ __forceinline__ void ph_ret_sample(const P& p, int l, unsigned char* smem) {
    float* S0 = (float*)smem; float* qs = S0 + 4096; float* ks = qs + 8 * 64; float* vs = ks + 8 * 64;
    const int tid = tidx(); const bf16_t* PR = WSP(bf16_t, WS_PROJ);
    for (int u = gridDim.x - 1 - blockIdx.x; u < DB * 4; u += gridDim.x) {
        const int h = u & 3, b = u >> 2; const float lg = ret_lg(h);
        __syncthreads();
        for (int e = tid; e < 4096; e += NTHR) S0[e] = p.state_ret[(((size_t)l * DB + b) * 4 + h) * 4096 + e];
        { const int j = tid >> 6, d = tid & 63; const size_t row = (size_t)(MP + b * DS + j) * NPROJ;
          qs[tid] = bf2f(PR[row + C_QR + h * 64 + d]); ks[tid] = bf2f(PR[row + C_KR + h * 64 + d]); vs[tid] = bf2f(PR[row + C_VR + h * 64 + d]); }
        __syncthreads();
        { const int i = tid >> 6, e = tid & 63; float o = 0.f;
          for (int j = 0; j <= i; ++j) { float a = 0.f; for (int d = 0; d < 64; ++d) a += qs[i * 64 + d] * ks[j * 64 + d]; o += a * expf(lg * (float)(i - j)) * vs[j * 64 + e]; }
          float o2 = 0.f; for (int d = 0; d < 64; ++d) o2 += qs[i * 64 + d] * S0[d * 64 + e];
          o += o2 * expf(lg * (float)(i + 1));
          const float rstd = 1.0f / sqrtf(wave_sum(o * o) * (1.0f / 64.0f) + EPS);
          const size_t row = (size_t)(MP + b * DS + i); const float g = bf2f(PR[row * NPROJ + C_GR + h * 64 + e]);
          WSP(bf16_t, WS_O)[row * D + 256 + h * 64 + e] = f2bf(o * rstd * p.ret_norm[l * 64 + e] * silu_f(g)); }
        for (int x = tid; x < 4096; x += NTHR) { const int d = x >> 6, e = x & 63; float s = S0[x] * expf(lg * (float)DS);
            for (int j = 0; j < DS; ++j) s += ks[j * 64 + d] * expf(lg * (float)(DS - 1 - j)) * vs[j * 64 + e];
            p.out[O_SRET + (((size_t)l * DB + b) * 4 + h) * 4096 + x] = s; }
    }
}

template <int CS, int LDL> __device__ __forceinline__ void fwd_subst(float (&X)[CS], const float* Ls) {
#pragma unroll
    for (int i = 1; i < CS; ++i) {
        float a = X[i];
#pragma unroll
        for (int j4 = 0; j4 < (i + 3) / 4; ++j4) { const f32x4 lv = *(const f32x4*)(Ls + i * LDL + 4 * j4);
#pragma unroll
            for (int e = 0; e < 4; ++e) if (4 * j4 + e < i) a -= lv[e] * X[4 * j4 + e]; }
        X[i] = a;
    }
}
constexpr int QP = 132;
constexpr int WSTP = 136;
constexpr int RWP = 392, TP = 136;
__device__ __forceinline__ void ph_gdn_prep(const P& p, int l, unsigned char* smem) {
    float* Ls = (float*)smem; float* As = Ls + 64 * 68; float* gs = As + 64 * 68; float* gcs = gs + 64; float* bts = gcs + 64; float* part = bts + 64;
    bf16_t* raw = (bf16_t*)(part + 4 * 64); bf16_t* Khi = raw + 67 * RWP; bf16_t* Klo = Khi + 64 * TP; bf16_t* Qb = Klo + 64 * TP;
    static_assert((64 * 68 * 2 + 64 * 3 + 4 * 64) * 4 + (67 * RWP + 3 * 64 * TP) * 2 <= BAR_LDS_OFF, "gdn_prep LDS");
    const int tid = tidx(), lane = tid & 63, wave = tid >> 6; const bf16_t* PR = WSP(bf16_t, WS_PROJ);
    for (int u = blockIdx.x; u < NUNIT; u += gridDim.x) {
        const int n = u % NCH, h = (u / NCH) % 4, b = u / (NCH * 4), t0 = n * 64;
        __syncthreads();
        for (int e = tid; e < 67 * 48; e += NTHR) { const int row = e / 48, ch = e % 48, t = t0 - 3 + row; u32x4 v = (u32x4){0u, 0u, 0u, 0u};
            if (t >= 0) v = *(const u32x4*)(PR + (size_t)(b * T + t) * NPROJ + C_CONV + (ch >> 4) * 512 + h * 128 + (ch & 15) * 8);
            *(u32x4*)(raw + row * RWP + ch * 8) = v; }
        if (tid >= 384 && tid < 448) { const int i = tid - 384; const size_t row = (size_t)(b * T + t0 + i); gs[i] = WSP(float, WS_G)[row * 4 + h]; bts[i] = WSP(float, WS_BETA)[row * 4 + h]; }
        __syncthreads();
        float y[64]; const int sec = tid < 128 ? 2 : tid < 256 ? 1 : 0, c = tid & 127;
        if (tid < 384) { const int col = sec * 512 + h * 128 + c;
            const float w0 = p.conv_w[(l * 4 + 0) * 1536 + col], w1 = p.conv_w[(l * 4 + 1) * 1536 + col], w2 = p.conv_w[(l * 4 + 2) * 1536 + col], w3 = p.conv_w[(l * 4 + 3) * 1536 + col];
            const LAS bf16_t* rp = (const LAS bf16_t*)raw + sec * 128 + c; LAUNDER_V(rp); float x0 = bf2f(rp[0]), x1 = bf2f(rp[RWP]), x2 = bf2f(rp[2 * RWP]);
#pragma unroll
            for (int i = 0; i < 64; ++i) { const float x3 = bf2f(rp[(i + 3) * RWP]); y[i] = silu_fast(w0 * x0 + w1 * x1 + w2 * x2 + w3 * x3); x0 = x1; x1 = x2; x2 = x3; if ((i & 7) == 7) COMPILER_FENCE(); } }
        if (tid >= 448) { if (tid == 448) { float a = 0.f; for (int i = 0; i < 64; ++i) { a += gs[i]; gcs[i] = a; } }
            WAVE_SYNC(); const int i = tid - 448; part[128 + i] = expf(gcs[i]); part[192 + i] = expf(gcs[63] - gcs[i]); }
#pragma unroll
        for (int pass = 0; pass < 2; ++pass) {
            if (tid >= 128 + 128 * pass && tid < 256 + 128 * pass) { LAS float* sq = (LAS float*)Ls + c; LAUNDER_V(sq);
#pragma unroll
                for (int i = 0; i < 64; ++i) sq[i * 132] = y[i] * y[i]; }
            __syncthreads();
            { const int i = tid >> 3, pt = tid & 7; const float* rp2 = Ls + i * 132 + pt * 16; float a = 0.f;
#pragma unroll
              for (int k = 0; k < 16; ++k) a += rp2[k];
              a += __shfl_xor(a, 1); a += __shfl_xor(a, 2); a += __shfl_xor(a, 4);
              if (pt == 0) part[64 * pass + i] = 1.0f / sqrtf(a + EPS); }
            __syncthreads();
        }
        if (tid >= 128 && tid < 256) { LAS bf16_t* kh = (LAS bf16_t*)Khi + c; LAS bf16_t* kl = (LAS bf16_t*)Klo + c; LAUNDER_V(kh); LAUNDER_V(kl);
#pragma unroll
            for (int i = 0; i < 64; ++i) { const float v = y[i] * part[i]; y[i] = v; const bf16_t hb = f2bf(v); kh[i * TP] = hb; kl[i * TP] = f2bf(v - bf2f(hb)); if ((i & 7) == 7) COMPILER_FENCE(); }
            bf16_t* dst = WSP(bf16_t, WS_GWK) + (size_t)u * 16384 + 8192; const int mt = c >> 4, x = c & 15;
#pragma unroll
            for (int ks2 = 0; ks2 < 2; ++ks2)
#pragma unroll
                for (int q = 0; q < 4; ++q) { const int i0 = 32 * ks2 + 4 * q; float v[8];
#pragma unroll
                    for (int e = 0; e < 8; ++e) { const int i = i0 + (e < 4 ? e : 12 + e); v[e] = y[i] * part[192 + i]; }
                    u32x4 w; w.x = pk2(v[0], v[1]); w.y = pk2(v[2], v[3]); w.z = pk2(v[4], v[5]); w.w = pk2(v[6], v[7]);
                    *(u32x4*)(dst + ((size_t)((mt * 2 + ks2) * 64 + q * 16 + x)) * 8) = w; COMPILER_FENCE(); } }
        else if (tid >= 256 && tid < 384) { bf16_t* qg = WSP(bf16_t, WS_GQ) + (size_t)u * 8192 + c; LAS bf16_t* qb = (LAS bf16_t*)Qb + c; LAUNDER_V(qb);
#pragma unroll
            for (int i = 0; i < 64; ++i) { const float v = y[i] * part[64 + i]; qb[i * TP] = f2bf(v); qg[(i & 7) * 128] = f2bf(v * 0.08838834764831845f * part[128 + i]); if ((i & 7) == 7) { qg += 8 * 128; LAUNDER_V(qg); COMPILER_FENCE(); } } }
        __syncthreads();
#pragma unroll
        for (int tp = 0; tp < 2; ++tp) { const int pos = wave * 2 + tp, it = pos >> 2, jt = pos & 3, j16 = lane & 15, qd = lane >> 4;
            f32x4 lk = (f32x4){0.f, 0.f, 0.f, 0.f}, aq = (f32x4){0.f, 0.f, 0.f, 0.f};
            if (jt <= it) {
#pragma unroll
                for (int ks = 0; ks < 4; ++ks) { const int ao = (16 * it + j16) * TP + 32 * ks + 8 * qd, bo = (16 * jt + j16) * TP + 32 * ks + 8 * qd;
                    const bf16x8 ah = *(const bf16x8*)(Khi + ao), al = *(const bf16x8*)(Klo + ao), aqf = *(const bf16x8*)(Qb + ao), bh = *(const bf16x8*)(Khi + bo), bl = *(const bf16x8*)(Klo + bo);
                    lk = MFMA16(ah, bh, lk); lk = MFMA16(ah, bl, lk); lk = MFMA16(al, bh, lk); aq = MFMA16(aqf, bh, aq); } }
            const int j = 16 * jt + j16;
#pragma unroll
            for (int e = 0; e < 4; ++e) { const int i = 16 * it + 4 * qd + e; const float ex = j <= i ? expf(gcs[i] - gcs[j]) : 0.f;
                Ls[i * 68 + j] = j < i ? bts[i] * lk[e] * ex : 0.f; As[i * 68 + j] = aq[e] * ex * 0.08838834764831845f; } }
        __syncthreads();
        if (tid < 256) {
            if (tid < 128) {
#pragma unroll
                for (int i = 0; i < 64; ++i) { y[i] *= bts[i]; if ((i & 15) == 15) COMPILER_FENCE(); } }
            else {
#pragma unroll
                for (int i = 0; i < 64; ++i) { y[i] *= bts[i] * part[128 + i]; if ((i & 15) == 15) COMPILER_FENCE(); } }
            fwd_subst<64, 68>(y, Ls);
            if (tid < 128) { bf16_t* U = WSP(bf16_t, WS_GU) + (size_t)u * 8192 + c * 64;
#pragma unroll
                for (int i8 = 0; i8 < 8; ++i8) { u32x4 w; w.x = pk2(y[8 * i8], y[8 * i8 + 1]); w.y = pk2(y[8 * i8 + 2], y[8 * i8 + 3]); w.z = pk2(y[8 * i8 + 4], y[8 * i8 + 5]); w.w = pk2(y[8 * i8 + 6], y[8 * i8 + 7]); *(u32x4*)(U + 8 * i8) = w; } }
            else { LAS bf16_t* wst = (LAS bf16_t*)raw + c; LAUNDER_V(wst);
#pragma unroll
                for (int i = 0; i < 64; ++i) wst[i * WSTP] = f2bf(-y[i]); }
        } else { const int t2 = tid - 256;
#pragma unroll 2
            for (int e = t2; e < 4096; e += 256) WSP(bf16_t, WS_GA)[(size_t)u * 4096 + e] = f2bf(As[(e >> 6) * 68 + (e & 63)]);
            if (t2 == 0) WSP(float, WS_GD)[u] = expf(gcs[63]); }
        __syncthreads();
        { bf16_t* dst = WSP(bf16_t, WS_GWK) + (size_t)u * 16384; const bf16_t* wst = raw;
#pragma unroll
          for (int k = 0; k < 2; ++k) { const int f = tid + NTHR * k, ln = f & 63, ks4 = (f >> 6) & 3, mt = f >> 8, q = ln >> 4, x = ln & 15;
              const bf16_t* wr = wst + (16 * mt + x) * WSTP + 32 * ks4 + 4 * q;
              u32x4 w; w.x = (unsigned)wr[0] | ((unsigned)wr[1] << 16); w.y = (unsigned)wr[2] | ((unsigned)wr[3] << 16); w.z = (unsigned)wr[16] | ((unsigned)wr[17] << 16); w.w = (unsigned)wr[18] | ((unsigned)wr[19] << 16);
              *(u32x4*)(dst + (size_t)f * 8) = w; } }
    }
}
constexpr int CH_SLOT = 40960, CH_NSLOT = 3;
constexpr int CH_ITEMS = PB * 4 * 2;
static_assert(NCH % 4 == 0, "the chain's loop is unrolled by four chunks");
__device__ __forceinline__ void chain_stage(const bf16_t* WK, const bf16_t* UTh, int m, int pw, int lane, unsigned char* smem) {
    unsigned char* slot = smem + (m % CH_NSLOT) * CH_SLOT;
#pragma unroll
    for (int k = 0; k < 8; ++k) GLDS16((const unsigned char*)(WK + (size_t)m * 16384) + (pw * 8 + k) * 1024 + lane * 16, slot + (pw * 8 + k) * 1024);
#pragma unroll
    for (int k = 0; k < 2; ++k) GLDS16((const unsigned char*)(UTh + (size_t)m * 8192) + (pw * 2 + k) * 1024 + lane * 16, slot + 32768 + (pw * 2 + k) * 1024);
}
__device__ __forceinline__ void ph_gdn_chain(const P& p, int l, unsigned char* smem) {
    const int tid = tidx(), lane = tid & 63, wave = UNIFORM(tid >> 6), j = lane & 15, q = lane >> 4;
    for (int it = blockIdx.x; it < CH_ITEMS; it += gridDim.x) {
        const int half = it & 1, bh = it >> 1;
        const bf16_t* WK = WSP(bf16_t, WS_GWK) + (size_t)bh * NCH * 16384;
        const bf16_t* UTh = WSP(bf16_t, WS_GU) + (size_t)bh * NCH * 8192 + half * 4096;
        __syncthreads();
        if (wave >= 4) {
            const int pw = wave - 4;
            chain_stage(WK, UTh, 0, pw, lane, smem); chain_stage(WK, UTh, 1, pw, lane, smem);
#pragma unroll 1
            for (int n = 0; n < NCH; ++n) {
                if (n + 1 < NCH) WAIT_VM(10); else WAIT_VM(0);
                RAW_BARRIER();
                if (n + 2 < NCH) chain_stage(WK, UTh, n + 2, pw, lane, smem);
            }
        } else {
            const int sl = half * 4 + wave, c = 16 * sl + j;
            f32x4 S[8];
#pragma unroll
            for (int t = 0; t < 8; ++t) S[t] = (f32x4){0.f, 0.f, 0.f, 0.f};
            bf16x8 sB[4];
#pragma unroll
            for (int ks = 0; ks < 4; ++ks) sB[ks] = pack_tiles(S[2 * ks], S[2 * ks + 1]);
            const float* DC = WSP(float, WS_GD) + bh * NCH;
            float db[4];
#pragma unroll
            for (int d = 0; d < 4; ++d) db[d] = DC[d];
#pragma unroll 1
            for (int n0 = 0; n0 < NCH; n0 += 4) {
#pragma unroll
                for (int k4 = 0; k4 < 4; ++k4) {
                    const int n = n0 + k4, u = bh * NCH + n;
                    f32x4 acc[4]; const float dec = db[k4];
                    if (n + 4 < NCH) db[k4] = DC[n + 4];
                    { bf16_t* sp = WSP(bf16_t, WS_GS) + (size_t)u * 16384 + (size_t)sl * 2048 + lane * 4;
#pragma unroll
                      for (int t = 0; t < 8; ++t) { u32x2 w; w.x = pk2(S[t][0], S[t][1]); w.y = pk2(S[t][2], S[t][3]); *(u32x2*)(sp + 256 * t) = w; } }
                    WAIT_LGKM0();
                    RAW_BARRIER();
                    const LAS unsigned char* slot = (const LAS unsigned char*)smem + (n % CH_NSLOT) * CH_SLOT + lane * 16; LAUNDER_V(slot);
                    { const LAS unsigned char* us = (const LAS unsigned char*)smem + (n % CH_NSLOT) * CH_SLOT + 32768 + ((16 * wave + j) * 64 + 4 * q) * 2; LAUNDER_V(us);
#pragma unroll
                      for (int mt = 0; mt < 4; ++mt) { const u32x2 w = *(const LAS u32x2*)(us + 32 * mt); acc[mt] = (f32x4){bf2f((bf16_t)(w.x & 0xffff)), bf2f((bf16_t)(w.x >> 16)), bf2f((bf16_t)(w.y & 0xffff)), bf2f((bf16_t)(w.y >> 16))}; } }
                    bf16x8 fa[8], fb[8];
#pragma unroll
                    for (int i = 0; i < 8; ++i) fa[i] = *(const LAS bf16x8*)(slot + i * 1024);
#pragma unroll
                    for (int i = 0; i < 8; ++i) fb[i] = *(const LAS bf16x8*)(slot + (8 + i) * 1024);
                    COMPILER_FENCE();
#pragma unroll
                    for (int ks = 0; ks < 4; ++ks) { acc[0] = MFMA16(fa[ks], sB[ks], acc[0]); acc[1] = MFMA16(fa[4 + ks], sB[ks], acc[1]); }
                    COMPILER_FENCE();
#pragma unroll
                    for (int i = 0; i < 8; ++i) fa[i] = *(const LAS bf16x8*)(slot + 16384 + i * 1024);
#pragma unroll
                    for (int ks = 0; ks < 4; ++ks) { acc[2] = MFMA16(fb[ks], sB[ks], acc[2]); acc[3] = MFMA16(fb[4 + ks], sB[ks], acc[3]); }
                    COMPILER_FENCE();
#pragma unroll
                    for (int i = 0; i < 8; ++i) fb[i] = *(const LAS bf16x8*)(slot + 16384 + (8 + i) * 1024);
                    { bf16_t* vp = WSP(bf16_t, WS_GV) + (size_t)u * 8192 + (size_t)sl * 1024 + lane * 4;
#pragma unroll
                      for (int mt = 0; mt < 4; ++mt) { u32x2 w; w.x = pk2(acc[mt][0], acc[mt][1]); w.y = pk2(acc[mt][2], acc[mt][3]); *(u32x2*)(vp + 256 * mt) = w; } }
                    const bf16x8 vB0 = pack_tiles(acc[0], acc[1]), vB1 = pack_tiles(acc[2], acc[3]);
#pragma unroll
                    for (int t = 0; t < 8; ++t) S[t] = S[t] * dec;
                    COMPILER_FENCE();
#pragma unroll
                    for (int t = 0; t < 4; ++t) S[t] = MFMA16(fa[2 * t], vB0, S[t]);
#pragma unroll
                    for (int t = 0; t < 4; ++t) S[t] = MFMA16(fa[2 * t + 1], vB1, S[t]);
#pragma unroll
                    for (int t = 0; t < 4; ++t) S[4 + t] = MFMA16(fb[2 * t], vB0, S[4 + t]);
#pragma unroll
                    for (int t = 0; t < 4; ++t) S[4 + t] = MFMA16(fb[2 * t + 1], vB1, S[4 + t]);
                    COMPILER_FENCE();
#pragma unroll
                    for (int ks = 0; ks < 4; ++ks) sB[ks] = pack_tiles(S[2 * ks], S[2 * ks + 1]);
                }
            }
            float* o = p.out + O_PGDN + ((size_t)l * PB * 4 + bh) * 16384 + c;
#pragma unroll
            for (int t = 0; t < 8; ++t)
#pragma unroll
                for (int e = 0; e < 4; ++e) o[(size_t)(16 * t + 4 * q + e) * 128] = S[t][e];
        }
    }
}
__device__ __forceinline__ void ph_gdn_out(const P& p, int l) {
    const int tid = tidx(), lane = tid & 63, wave = tid >> 6, j = lane & 15, q = lane >> 4, mt = wave & 3;
    const bf16_t* PR = WSP(bf16_t, WS_PROJ);
    for (int u = blockIdx.x * 2 + (wave >> 2); u < NUNIT; u += gridDim.x * 2) {
        const int n = u % NCH, h = (u / NCH) % 4, b = u / (NCH * 4);
        f32x4 acc[8];
#pragma unroll
        for (int ct = 0; ct < 8; ++ct) acc[ct] = (f32x4){0.f, 0.f, 0.f, 0.f};
        const bf16_t* qg = WSP(bf16_t, WS_GQ) + (size_t)u * 8192 + (16 * mt + j) * 128 + 8 * q;
        const bf16_t* st = WSP(bf16_t, WS_GS) + (size_t)u * 16384 + (size_t)(q >> 1) * 256 + ((2 * (q & 1)) * 16 + j) * 4;
#pragma unroll
        for (int ks = 0; ks < 4; ++ks) { const bf16x8 a = *(const bf16x8*)(qg + 32 * ks);
#pragma unroll
            for (int ct = 0; ct < 8; ++ct) { const bf16_t* sp = st + (size_t)ct * 2048 + ks * 512; const u32x2 lo = *(const u32x2*)sp, hi = *(const u32x2*)(sp + 64); u32x4 w; w.x = lo.x; w.y = lo.y; w.z = hi.x; w.w = hi.y;
                acc[ct] = MFMA16(a, __builtin_bit_cast(bf16x8, w), acc[ct]); }
            COMPILER_FENCE(); }
        const bf16_t* at = WSP(bf16_t, WS_GA) + (size_t)u * 4096 + (16 * mt + j) * 64 + 8 * q;
        const bf16_t* vt = WSP(bf16_t, WS_GV) + (size_t)u * 8192 + (size_t)(q >> 1) * 256 + ((2 * (q & 1)) * 16 + j) * 4;
#pragma unroll
        for (int ks = 0; ks < 2; ++ks) { const bf16x8 a = *(const bf16x8*)(at + 32 * ks);
#pragma unroll
            for (int ct = 0; ct < 8; ++ct) { const bf16_t* vp = vt + (size_t)ct * 1024 + ks * 512; const u32x2 lo = *(const u32x2*)vp, hi = *(const u32x2*)(vp + 64); u32x4 w; w.x = lo.x; w.y = lo.y; w.z = hi.x; w.w = hi.y;
                acc[ct] = MFMA16(a, __builtin_bit_cast(bf16x8, w), acc[ct]); }
            COMPILER_FENCE(); }
        float sq[4];
#pragma unroll
        for (int e = 0; e < 4; ++e) { float s = 0.f;
#pragma unroll
            for (int ct = 0; ct < 8; ++ct) s += acc[ct][e] * acc[ct][e];
            s += __shfl_xor(s, 1); s += __shfl_xor(s, 2); s += __shfl_xor(s, 4); s += __shfl_xor(s, 8); sq[e] = 1.0f / sqrtf(s * (1.0f / 128.0f) + EPS); }
#pragma unroll
        for (int e = 0; e < 4; ++e) { const size_t row = (size_t)(b * T + n * 64 + 16 * mt + 4 * q + e);
#pragma unroll
            for (int ct = 0; ct < 8; ++ct) { const int c = 16 * ct + j; const float z = bf2f(PR[row * NPROJ + C_Z + h * 128 + c]);
                WSP(bf16_t, WS_O)[row * D + 512 + h * 128 + c] = f2bf(acc[ct][e] * sq[e] * p.gdn_norm[l * 128 + c] * silu_f(z)); } }
    }
}
__device__ __forceinline__ void ph_gdn_sample(const P& p, int l, unsigned char* smem) {
    float* qs = (float*)smem; float* ks = qs + 8 * QP; float* vs = ks + 8 * QP; float* us = vs + 8 * QP; float* wsm = us + 8 * 128; float* vn = wsm + 8 * 128;
    float* Ls = vn + 8 * 128; float* As = Ls + 8 * 8; float* gs = As + 8 * 8; float* gcs = gs + 8; float* bts = gcs + 8; float* S0 = bts + 8;
    const int tid = tidx(); const bf16_t* PR = WSP(bf16_t, WS_PROJ);
    for (int u = gridDim.x - 1 - blockIdx.x; u < DB * 4; u += gridDim.x) {
        const int h = u & 3, b = u >> 2;
        __syncthreads();
#pragma unroll 4
        for (int e = tid; e < 16384; e += NTHR) S0[e] = p.state_gdn[(((size_t)l * DB + b) * 4 + h) * 16384 + e];
        if (tid < 384) { const int sec = tid >> 7, c = tid & 127, col = sec * 512 + h * 128 + c; float* dst = sec == 0 ? qs : sec == 1 ? ks : vs;
            const float w0 = p.conv_w[(l * 4 + 0) * 1536 + col], w1 = p.conv_w[(l * 4 + 1) * 1536 + col], w2 = p.conv_w[(l * 4 + 2) * 1536 + col], w3 = p.conv_w[(l * 4 + 3) * 1536 + col];
            const float* hist = p.state_conv + (((size_t)l * DB + b) * 3) * 1536 + col; const bf16_t* src = PR + (size_t)(MP + b * DS) * NPROJ + C_CONV + col;
            float x0 = hist[0], x1 = hist[1536], x2 = hist[2 * 1536];
            for (int i = 0; i < DS; ++i) { const float x3 = bf2f(src[(size_t)i * NPROJ]); const float y = w0 * x0 + w1 * x1 + w2 * x2 + w3 * x3; dst[i * QP + c] = silu_f(y); x0 = x1; x1 = x2; x2 = x3; } }
        else if (tid < 384 + DS) { const int i = tid - 384; const size_t row = (size_t)(MP + b * DS + i); gs[i] = WSP(float, WS_G)[row * 4 + h]; bts[i] = WSP(float, WS_BETA)[row * 4 + h]; }
        __syncthreads();
        if (tid < 64) { const int rid = tid >> 2, part = tid & 3; float* rowp = (rid < 8 ? qs + rid * QP : ks + (rid - 8) * QP) + part * 32; float s = 0.f;
            for (int d = 0; d < 32; ++d) s += rowp[d] * rowp[d];
            s += __shfl_xor(s, 1); s += __shfl_xor(s, 2); const float sc = 1.0f / sqrtf(s + EPS);
            for (int d = 0; d < 32; ++d) rowp[d] *= sc; }
        if (tid == 64) { float a = 0.f; for (int i = 0; i < DS; ++i) { a += gs[i]; gcs[i] = a; } }
        __syncthreads();
        if (tid < 64) { const int i = tid >> 3, j = tid & 7; float lv = 0.f, av = 0.f;
            if (j <= i) { float dk = 0.f, dq = 0.f; for (int d = 0; d < 128; ++d) { const float kj = ks[j * QP + d]; dk += ks[i * QP + d] * kj; dq += qs[i * QP + d] * kj; }
                const float e = expf(gcs[i] - gcs[j]); av = dq * e * 0.08838834764831845f; lv = j < i ? bts[i] * dk * e : 0.f; }
            Ls[i * 8 + j] = lv; As[i * 8 + j] = av; }
        __syncthreads();
        if (tid < 256) { const int c = tid; float X[8];
            if (c < 128) {
#pragma unroll
                for (int i = 0; i < 8; ++i) X[i] = vs[i * QP + c] * bts[i]; }
            else {
#pragma unroll
                for (int i = 0; i < 8; ++i) X[i] = ks[i * QP + c - 128] * bts[i] * expf(gcs[i]); }
            fwd_subst<8, 8>(X, Ls);
            float* dst = c < 128 ? us + c : wsm + c - 128;
#pragma unroll
            for (int i = 0; i < 8; ++i) dst[i * 128] = X[i]; }
        __syncthreads();
        const int i = tid >> 6, c2 = (tid & 63) * 2;
        { float a0 = us[i * 128 + c2], a1 = us[i * 128 + c2 + 1];
          for (int d = 0; d < 128; ++d) { const float w = wsm[i * 128 + d]; a0 -= w * S0[d * 128 + c2]; a1 -= w * S0[d * 128 + c2 + 1]; }
          vn[i * 128 + c2] = a0; vn[i * 128 + c2 + 1] = a1; }
        __syncthreads();
        { float o0 = 0.f, o1 = 0.f; const float qsc = 0.08838834764831845f * expf(gcs[i]);
          for (int d = 0; d < 128; ++d) { const float qg = qs[i * QP + d] * qsc; o0 += qg * S0[d * 128 + c2]; o1 += qg * S0[d * 128 + c2 + 1]; }
          for (int j = 0; j < DS; ++j) { const float a = As[i * 8 + j]; o0 += a * vn[j * 128 + c2]; o1 += a * vn[j * 128 + c2 + 1]; }
          const float rstd = 1.0f / sqrtf(wave_sum(o0 * o0 + o1 * o1) * (1.0f / 128.0f) + EPS);
          const size_t row = (size_t)(MP + b * DS + i);
          const float z0 = bf2f(PR[row * NPROJ + C_Z + h * 128 + c2]), z1 = bf2f(PR[row * NPROJ + C_Z + h * 128 + c2 + 1]);
          bf16_t* O = WSP(bf16_t, WS_O) + row * D + 512 + h * 128 + c2;
          O[0] = f2bf(o0 * rstd * p.gdn_norm[l * 128 + c2] * silu_f(z0)); O[1] = f2bf(o1 * rstd * p.gdn_norm[l * 128 + c2 + 1] * silu_f(z1)); }
        { const float gl = gcs[DS - 1], dec = expf(gl); float* o = p.out + O_SGDN + (((size_t)l * DB + b) * 4 + h) * 16384;
#pragma unroll 2
          for (int e = tid; e < 16384; e += NTHR) { const int d = e >> 7, c = e & 127; float s = S0[e] * dec;
              for (int j = 0; j < DS; ++j) s += ks[j * QP + d] * expf(gl - gcs[j]) * vn[j * 128 + c];
              o[e] = s; } }
    }
}


template <int K> __device__ __forceinline__ void ph_gemm_small(const P& p, const bf16_t* A  , const bf16_t* Bt  , const float* gate, const float* xs_in  , unsigned char* smem) {
    static_assert(MS % 16 == 0 && K % 256 == 0, "small GEMM shape");
    constexpr int KW = K / 8, NKS = KW / 32;
    const int tid = tidx(), lane = tid & 63, wave = tid >> 6, x = lane & 15, q = lane >> 4;
    float* red = (float*)smem;
    for (int it = blockIdx.x; it < (MS / 16) * 16; it += gridDim.x) {
        const int rt = it % (MS / 16), cg = it / (MS / 16);
        const bf16_t* ap = A + (size_t)(16 * rt + x) * K + wave * KW + 8 * q;
        const bf16_t* bp = Bt + (size_t)(64 * cg + x) * K + wave * KW + 8 * q;
        f32x4 acc[4];
#pragma unroll
        for (int ct = 0; ct < 4; ++ct) acc[ct] = (f32x4){0.f, 0.f, 0.f, 0.f};
#pragma unroll
        for (int ks = 0; ks < NKS; ++ks) { const bf16x8 a = *(const bf16x8*)(ap + 32 * ks);
#pragma unroll
            for (int ct = 0; ct < 4; ++ct) acc[ct] = MFMA16(a, *(const bf16x8*)(bp + (size_t)ct * 16 * K + 32 * ks), acc[ct]); }
        __syncthreads();
#pragma unroll
        for (int ct = 0; ct < 4; ++ct) *(f32x4*)(red + ((wave * 4 + ct) * 64 + lane) * 4) = acc[ct];
        __syncthreads();
        if (wave < 4) { f32x4 s = (f32x4){0.f, 0.f, 0.f, 0.f};
#pragma unroll
            for (int w = 0; w < 8; ++w) s += *(const f32x4*)(red + ((w * 4 + wave) * 64 + lane) * 4);
            const int col = 64 * cg + 16 * wave + x;
#pragma unroll
            for (int e = 0; e < 4; ++e) { const int row = MP + 16 * rt + 4 * q + e; float* xp = p.out + (size_t)row * D + col; const float xin = xs_in ? xs_in[(size_t)(row - MP) * D + col] : *xp; *xp = xin + gate[(size_t)row_cb(row) * 6144 + col] * s[e]; } }
    }
}

__device__ __forceinline__ void ph_final_norm(const P& p) {
    const int lane = tidx() & 63, wave = tidx() >> 6, gw = blockIdx.x * 8 + wave, ngw = gridDim.x * 8;
    for (int r = gw; r < M; r += ngw) {
        float* xr = p.out + (size_t)r * D; f32x4 v[4]; float ss = 0.f;
#pragma unroll
        for (int j = 0; j < 4; ++j) { v[j] = *(const f32x4*)(xr + 4 * lane + 256 * j); ss += (v[j][0] * v[j][0] + v[j][1] * v[j][1]) + (v[j][2] * v[j][2] + v[j][3] * v[j][3]); }
        const float rstd = 1.0f / sqrtf(wave_sum(ss) * (1.0f / D) + EPS);
#pragma unroll
        for (int j = 0; j < 4; ++j) { const f32x4 g = *(const f32x4*)(p.final_norm + 4 * lane + 256 * j); *(f32x4*)(xr + 4 * lane + 256 * j) = v[j] * rstd * g; }
    }
}

enum Phase { PH_PRO = 0, PH_NORM1, PH_GEMM_IN, PH_ROPE, PH_MIX1, PH_MIX2, PH_MIX3, PH_GEMM_OUT, PH_NORM2, PH_GEMM_GU, PH_GEMM_DN, PH_FINAL };
#ifdef __HIP_EMU__
#define LDSP(x) (x)
#else
#define LDSP(x) ((PG8_LAS unsigned char*)(x))
#endif
template <int PH> __device__ __forceinline__ void run_phase(const P& p, int l, unsigned char* smem) {
    if constexpr (PH == PH_PRO) { ph_convert(p, smem); __syncthreads(); ph_adaln(p, smem); ph_ropetab_copyx(p); }
    else if constexpr (PH == PH_NORM1) ph_norm_mod<0>(p, l);
    else if constexpr (PH == PH_GEMM_IN) {
        pg8::Gemm g{WSP(bf16_t, WS_H), WSP(bf16_t, WS_WIN) + (size_t)l * NPROJ * D, MPAD, NPROJ, D}; pg8::StaticOrder S; S.init(MPAD, NPROJ, (int)gridDim.x, (int)blockIdx.x);
        pg8::EpiStoreBf16 E{WSP(bf16_t, WS_PROJ), NPROJ};
        pg8::gemm_phase<pg8::EpiStoreBf16, pg8::StaticOrder, true, true>(LDSP(smem), g, S, E);
    }
    else if constexpr (PH == PH_ROPE) { ph_rope_out(p, l); ph_vtrans(p, smem); }
    else if constexpr (PH == PH_MIX1) { ph_attn_jobs(p); ph_ret_local(p, l); ph_gdn_prep(p, l, smem); }
    else if constexpr (PH == PH_MIX2) { ph_gdn_chain(p, l, smem); __syncthreads(); ph_attn_sample(p, l, smem); ph_ret_sample(p, l, smem); ph_gdn_sample(p, l, smem); ph_ret_scan(p, l); ph_attn_combine(p); }
    else if constexpr (PH == PH_MIX3) { ph_ret_out(p, l); ph_gdn_out(p, l); }
    else if constexpr (PH == PH_GEMM_OUT) {
        ph_gemm_small<D>(p, WSP(bf16_t, WS_O) + (size_t)MP * D, WSP(bf16_t, WS_WOUT) + (size_t)l * D * D, WSP(float, WS_MOD) + (size_t)l * NC * 6144 + 2048, l == 0 ? p.x_sample : nullptr, smem); __syncthreads();
        pg8::Gemm g{WSP(bf16_t, WS_O), WSP(bf16_t, WS_WOUT) + (size_t)l * D * D, MP, D, D}; pg8::StaticOrder S; S.init(MP, D, (int)gridDim.x, (int)blockIdx.x);
        pg8::EpiResidual E{p.out, WSP(float, WS_MOD) + (size_t)l * NC * 6144 + 2048, l == 0 ? p.x_prompt : p.out};
        pg8::gemm_phase<pg8::EpiResidual, pg8::StaticOrder, true, true>(LDSP(smem), g, S, E);
    }
    else if constexpr (PH == PH_NORM2) ph_norm_mod<1>(p, l);
    else if constexpr (PH == PH_GEMM_GU) {
        pg8::Gemm g{WSP(bf16_t, WS_H), WSP(bf16_t, WS_WGU) + (size_t)l * 2 * FF * D, MPAD, 2 * FF, D}; pg8::StaticOrder S; S.init(MPAD, 2 * FF, (int)gridDim.x, (int)blockIdx.x);
        pg8::EpiSwiglu E{WSP(bf16_t, WS_HID)};
        pg8::gemm_phase<pg8::EpiSwiglu, pg8::StaticOrder, true, true>(LDSP(smem), g, S, E);
    }
    else if constexpr (PH == PH_GEMM_DN) {
        ph_gemm_small<FF>(p, WSP(bf16_t, WS_HID) + (size_t)MP * FF, WSP(bf16_t, WS_WDN) + (size_t)l * D * FF, WSP(float, WS_MOD) + (size_t)l * NC * 6144 + 5120, nullptr, smem); __syncthreads();
        pg8::Gemm g{WSP(bf16_t, WS_HID), WSP(bf16_t, WS_WDN) + (size_t)l * D * FF, MP, D, FF}; pg8::StaticOrder S; S.init(MP, D, (int)gridDim.x, (int)blockIdx.x);
        pg8::EpiResidual E{p.out, WSP(float, WS_MOD) + (size_t)l * NC * 6144 + 5120, p.out};
        pg8::gemm_phase<pg8::EpiResidual, pg8::StaticOrder, true, true>(LDSP(smem), g, S, E);
    }
    else if constexpr (PH == PH_FINAL) ph_final_norm(p);
}
template <int PH> __global__ void __launch_bounds__(NTHR, 2) k_phase(P p, int l) { DYN_SMEM(smem); run_phase<PH>(p, l, smem); }


#ifndef __HIP_EMU__
#define LAS __attribute__((address_space(3)))
#define XB_TMO      128
#define XB_XCNT(j)  (256  + 64 * (j))
#define XB_XSUB(j)  (1280 + 64 * (j))
#define XB_XGEN(j)  (2304 + 64 * (j))
#define XB_TOP      3328
#define XB_TOPGEN   3392
#define XCD_BAR_WORDS 3456
#define XB_SPIN_CAP (1u << 18)

__device__ __forceinline__ unsigned xb_ld(unsigned* p)              { return __hip_atomic_load(p, __ATOMIC_RELAXED, __HIP_MEMORY_SCOPE_AGENT); }
__device__ __forceinline__ unsigned xb_add(unsigned* p, unsigned v) { return __hip_atomic_fetch_add(p, v, __ATOMIC_RELAXED, __HIP_MEMORY_SCOPE_AGENT); }
__device__ __forceinline__ unsigned xb_xcc_id() { return (unsigned)__builtin_amdgcn_s_getreg((3 << 11) | 20) & 0xFu; }
#define XB_SPIN(cond, bar) do { unsigned _sp = 0; while (cond) { __builtin_amdgcn_s_sleep(1); \
    if ((++_sp & 255u) == 0u) { if (xb_ld(&(bar)[XB_TMO])) break; if (_sp > XB_SPIN_CAP) { atomicAdd(&(bar)[XB_TMO], 1u); break; } } } } while (0)

struct XcdBarrier {
    unsigned* bar; unsigned x;
    volatile LAS unsigned* st;
};

__device__ __forceinline__ XcdBarrier xcd_barrier_post(unsigned* bar, volatile LAS unsigned* st) {
    XcdBarrier b; b.bar = bar; b.x = xb_xcc_id(); b.st = st;
    if (threadIdx.x == 0) (void)xb_add(&bar[XB_XCNT(b.x)], 1u);
    return b;
}
__device__ __forceinline__ void xcd_barrier_complete(unsigned* bar, unsigned x, unsigned& nloc, unsigned& nx) {
    const unsigned G = gridDim.x * gridDim.y * gridDim.z;
    unsigned sum, cnt, mine, sp = 0u;
    for (;;) {
        sum = 0u; cnt = 0u; mine = 0u;
#pragma unroll
        for (unsigned j = 0; j < 16; ++j) { const unsigned c = xb_ld(&bar[XB_XCNT(j)]); sum += c; cnt += (c > 0u) ? 1u : 0u; mine = (j == x) ? c : mine; }
        if (sum == G) break;
        __builtin_amdgcn_s_sleep(1);
        if ((++sp & 255u) == 0u) { if (xb_ld(&bar[XB_TMO])) break; if (sp > XB_SPIN_CAP) { atomicAdd(&bar[XB_TMO], 1u); break; } }
    }
    nloc = mine > 0u ? mine : 1u; nx = cnt > 0u ? cnt : 1u;
}

__device__ __forceinline__ void xcd_barrier(const XcdBarrier& b) {
    asm volatile("s_waitcnt vmcnt(0)" ::: "memory");
    __syncthreads();
    if (threadIdx.x == 0) {
        unsigned* bar = b.bar;
        __builtin_amdgcn_s_waitcnt(0);
        unsigned nloc = b.st[0], nx = b.st[1];
        if (nloc == 0u) { xcd_barrier_complete(bar, b.x, nloc, nx); b.st[0] = nloc; b.st[1] = nx; }
        const unsigned old = xb_add(&bar[XB_XSUB(b.x)], 1u);
        const unsigned gen = old / nloc;
        if (old + 1u == (gen + 1u) * nloc) {
            __builtin_amdgcn_fence(__ATOMIC_RELEASE, "agent");
            asm volatile("s_waitcnt vmcnt(0)" ::: "memory");
            const unsigned og = xb_add(&bar[XB_TOP], 1u);
            const unsigned tg = og / nx;
            if (og + 1u == (tg + 1u) * nx) xb_add(&bar[XB_TOPGEN], 1u);
            else XB_SPIN(xb_ld(&bar[XB_TOPGEN]) == tg, bar);
            __builtin_amdgcn_fence(__ATOMIC_ACQUIRE, "agent");
            xb_add(&bar[XB_XGEN(b.x)], 1u);
            asm volatile("s_waitcnt vmcnt(0)" ::: "memory");
        } else {
            XB_SPIN(xb_ld(&bar[XB_XGEN(b.x)]) == gen, bar);
            __builtin_amdgcn_fence(__ATOMIC_ACQUIRE, "agent");
            asm volatile("s_waitcnt vmcnt(0)" ::: "memory");
        }
    }
    __syncthreads();
}

#endif

#ifndef __HIP_EMU__
#define GRID_SYNC() xcd_barrier(bar)
__global__ void __launch_bounds__(NTHR, 2) k_mega(P p_arg) {
    DYN_SMEM(smem);
#if defined(__HIP_DEVICE_COMPILE__)
#define PHASE(PH_, l_) do { const __attribute__((address_space(4))) P* kp_ = (const __attribute__((address_space(4))) P*)__builtin_amdgcn_kernarg_segment_ptr(); LAUNDER_PTR(kp_); P pl_; __builtin_memcpy(&pl_, kp_, sizeof(P)); run_phase<PH_>(pl_, l_, smem); } while (0)
#else
#define PHASE(PH_, l_) run_phase<PH_>(p_arg, l_, smem)
#endif
    cooperative_groups::grid_group grid = cooperative_groups::this_grid();
    volatile LAS unsigned* bst = (volatile LAS unsigned*)((LAS unsigned char*)smem + BAR_LDS_OFF);
    if (threadIdx.x < 4) bst[threadIdx.x] = 0u;
    __syncthreads();
    XcdBarrier bar = xcd_barrier_post((unsigned*)(p_arg.ws + WS_CTL + 4096), bst);
    PHASE(PH_PRO, 0); grid.sync();
#define LAYER(l) do { PHASE(PH_NORM1, l); GRID_SYNC(); PHASE(PH_GEMM_IN, l); GRID_SYNC(); PHASE(PH_ROPE, l); GRID_SYNC(); PHASE(PH_MIX1, l); GRID_SYNC(); PHASE(PH_MIX2, l); GRID_SYNC(); \
        PHASE(PH_MIX3, l); GRID_SYNC(); PHASE(PH_GEMM_OUT, l); GRID_SYNC(); PHASE(PH_NORM2, l); GRID_SYNC(); PHASE(PH_GEMM_GU, l); GRID_SYNC(); PHASE(PH_GEMM_DN, l); GRID_SYNC(); } while (0)
    static_assert(NL == 2, "two layers written out (a loop over the layers makes hipcc hoist every phase's constants to the loop preheader and spill)");
    LAYER(0); LAYER(1);
    PHASE(PH_FINAL, 0);
}
#endif

template <int PH> static void launch_phase(const P& p, int l, int grid, hipStream_t stream) {
#ifndef __HIP_EMU__
    static bool attr_done = false;
    if (!attr_done) { (void)hipFuncSetAttribute((const void*)k_phase<PH>, hipFuncAttributeMaxDynamicSharedMemorySize, SMEM_BYTES); attr_done = true; }
#endif
    LAUNCH(k_phase<PH>, grid, SMEM_BYTES, stream, p, l);
}

extern "C" void kernel_launch(void* const* d_in, const int* in_sizes, int n_in, void* d_out, int out_size, void* d_ws, size_t ws_size, hipStream_t stream) {
    if (n_in != 24 || (size_t)out_size != O_END || ws_size < WS_END) {
        fprintf(stderr, "kernel_launch: shape mismatch: n_in %d out_size %d (want %zu) ws %zu (want %zu)\n", n_in, out_size, (size_t)O_END, ws_size, (size_t)WS_END); return; }
    P p{};
    const float** pp = (const float**)&p;
    for (int i = 0; i < 24; ++i) pp[i] = (const float*)d_in[i];
    p.out = (float*)d_out; p.ws = (unsigned char*)d_ws;
#ifndef __HIP_EMU__
    static int grid = 0;
    if (grid == 0) {
        int dev = 0, cus = 0, per_cu = 0;
        if (hipGetDevice(&dev) != hipSuccess || hipDeviceGetAttribute(&cus, hipDeviceAttributeMultiprocessorCount, dev) != hipSuccess || cus <= 0) { fprintf(stderr, "kernel_launch: device query failed\n"); grid = -1; return; }
        if (hipFuncSetAttribute((const void*)k_mega, hipFuncAttributeMaxDynamicSharedMemorySize, SMEM_BYTES) != hipSuccess) { fprintf(stderr, "kernel_launch: hipFuncSetAttribute failed\n"); grid = -1; return; }
        if (hipOccupancyMaxActiveBlocksPerMultiprocessor(&per_cu, (const void*)k_mega, NTHR, SMEM_BYTES) != hipSuccess || per_cu < 1) { fprintf(stderr, "kernel_launch: occupancy query says %d blocks per CU\n", per_cu); grid = -1; return; }
        grid = cus;
    }
    if (grid < 0) return;
    if (hipMemsetAsync((char*)d_ws + WS_CTL, 0, 65536, stream) != hipSuccess) { fprintf(stderr, "kernel_launch: memset of the barrier words failed\n"); return; }
    { void* args[] = {(void*)&p};
      hipError_t e = hipLaunchCooperativeKernel((const void*)k_mega, dim3(grid), dim3(NTHR), args, SMEM_BYTES, stream);
      if (e != hipSuccess) fprintf(stderr, "kernel_launch: cooperative launch failed: %s (grid %d)\n", hipGetErrorString(e), grid);
      return; }
#else
    int grid = 16;
#endif
    launch_phase<PH_PRO>(p, 0, grid, stream);
    for (int l = 0; l < NL; ++l) {
        launch_phase<PH_NORM1>(p, l, grid, stream);
        launch_phase<PH_GEMM_IN>(p, l, grid, stream);
        launch_phase<PH_ROPE>(p, l, grid, stream);
        launch_phase<PH_MIX1>(p, l, grid, stream);
        launch_phase<PH_MIX2>(p, l, grid, stream);
        launch_phase<PH_MIX3>(p, l, grid, stream);
        launch_phase<PH_GEMM_OUT>(p, l, grid, stream);
        launch_phase<PH_NORM2>(p, l, grid, stream);
        launch_phase<PH_GEMM_GU>(p, l, grid, stream);
        launch_phase<PH_GEMM_DN>(p, l, grid, stream);
    }
    launch_phase<PH_FINAL>(p, 0, grid, stream);
}
```

```cpp
#ifndef __HIP_EMU__
#include <hip/hip_runtime.h>
#include <hip/hip_cooperative_groups.h>
#endif
#include <cstdio>
#include <cstdint>
#include <cmath>

#ifndef CFG_BATCH
#define CFG_BATCH 2
#endif
#ifndef CFG_SEQ
#define CFG_SEQ 8192
#endif
#ifndef CFG_DB
#define CFG_DB 32
#endif
constexpr float LOG2E = 1.4426950408889634f;
constexpr int D = 1024, NL = 2, PB = CFG_BATCH, T = CFG_SEQ, DB = CFG_DB, DS = 8, PAST = 16384, WB = 2048;
constexpr int MP = PB * T, MS = DB * DS, M = MP + MS, MPAD = (M + 255) / 256 * 256, NC = PB + DB;
constexpr int INC = 3848, NPROJ = 3840, FF = 2816, NCH = T / 64, PWIN = T < 2048 ? T : 2048, NPOS = T + DS;
constexpr int NUNIT = PB * 4 * NCH;
constexpr float EPS = 1e-6f;
static_assert(T % 512 == 0, "the attention job decomposition wants T % 512 == 0");
constexpr int C_QA = 0, C_KA = 256, C_VA = 512, C_QR = 768, C_KR = 1024, C_VR = 1280, C_GR = 1536, C_CONV = 1792, C_Z = 3328;
constexpr int SMEM_BYTES = 147456;
constexpr int NTHR = 512;
constexpr int BAR_LDS_OFF = SMEM_BYTES - 64;

typedef unsigned short bf16_t;
typedef short bf16x8 __attribute__((ext_vector_type(8)));
typedef float f32x4 __attribute__((ext_vector_type(4)));
typedef unsigned u32x4 __attribute__((ext_vector_type(4)));
typedef unsigned u32x2 __attribute__((ext_vector_type(2)));
typedef float f32x16 __attribute__((ext_vector_type(16)));

#ifdef __HIP_EMU__
#define LAUNCH(kern, grid, lds, stream, ...) emu_launch(grid, NTHR, [=]() { kern(__VA_ARGS__); })
#define DYN_SMEM(name) unsigned char* name = emu_dyn_smem()
#define WAVE_SYNC() emu_wave_bar()
#define MFMA32(a, b, c) emu_mfma32(a, b, c)
#define GLDS16(gp, lp) memcpy((unsigned char*)(lp) + (threadIdx.x & 63) * 16, (gp), 16)
#define RAW_BARRIER() __syncthreads()
#define GLDS4(gp, lp) ((void)0)
#define WAIT_VM(n)
#define WAIT_LGKM0()
#define LAS
#define UNIFORM(x) (x)
#define COMPILER_FENCE()
#define LAUNDER_V(x)
#define MFMA16(a, b, c) emu_mfma16(a, b, c)
#else
#define WAVE_SYNC() asm volatile("s_waitcnt lgkmcnt(0)" ::: "memory")
#define MFMA32(a, b, c) __builtin_amdgcn_mfma_f32_32x32x16_bf16(a, b, c, 0, 0, 0)
#define LAS __attribute__((address_space(3)))
#define GLDS16(gp, lp) __builtin_amdgcn_global_load_lds((const unsigned*)(gp), (LAS unsigned*)(lp), 16, 0, 0)
#define RAW_BARRIER() __builtin_amdgcn_s_barrier()
#define GLDS4(gp, lp) __builtin_amdgcn_global_load_lds((const unsigned*)(gp), (LAS unsigned*)(lp), 4, 0, 0)
#define WAIT_VM(n) asm volatile("s_waitcnt vmcnt(" #n ")" ::: "memory")
#define WAIT_LGKM0() asm volatile("s_waitcnt lgkmcnt(0)" ::: "memory")
#define UNIFORM(x) __builtin_amdgcn_readfirstlane(x)
#define COMPILER_FENCE() __builtin_amdgcn_sched_barrier(0)
#define LAUNDER_V(x) asm volatile("" : "+v"(x))
#define MFMA16(a, b, c) __builtin_amdgcn_mfma_f32_16x16x32_bf16(a, b, c, 0, 0, 0)
#define LAUNCH(kern, grid, lds, stream, ...) hipLaunchKernelGGL(kern, dim3(grid), dim3(NTHR), lds, stream, __VA_ARGS__)
#define DYN_SMEM(name) extern __shared__ __attribute__((aligned(16))) unsigned char name[]
#endif

#ifdef __HIP_EMU__
__device__ __forceinline__ int tidx() { return (int)threadIdx.x; }
#define LAUNDER_PTR(x)
#else
__device__ __forceinline__ int tidx() { int t = (int)threadIdx.x; asm volatile("" : "+v"(t)); return t; }
#define LAUNDER_PTR(x) asm volatile("" : "+s"(x))
#endif
__device__ __forceinline__ float bf2f(bf16_t v) { return __builtin_bit_cast(float, (unsigned)v << 16); }
__device__ __forceinline__ bf16_t f2bf(float f) { unsigned u = __builtin_bit_cast(unsigned, f); return (bf16_t)((u + 0x7fffu + ((u >> 16) & 1u)) >> 16); }
#ifdef __HIP_EMU__
__device__ __forceinline__ unsigned pk2(float lo, float hi) { return (unsigned)f2bf(lo) | ((unsigned)f2bf(hi) << 16); }
#else
typedef float f32x2_t __attribute__((ext_vector_type(2))); typedef __bf16 bf16x2_t __attribute__((ext_vector_type(2)));
__device__ __forceinline__ unsigned pk2(float lo, float hi) { f32x2_t v = {lo, hi}; bf16x2_t b = __builtin_convertvector(v, bf16x2_t); return __builtin_bit_cast(unsigned, b); }
#endif
__device__ __forceinline__ bf16x8 pack_tiles(const f32x4& lo, const f32x4& hi) {
    u32x4 w; w.x = pk2(lo[0], lo[1]); w.y = pk2(lo[2], lo[3]); w.z = pk2(hi[0], hi[1]); w.w = pk2(hi[2], hi[3]); return __builtin_bit_cast(bf16x8, w);
}
__device__ __forceinline__ float silu_f(float x) { return x / (1.0f + expf(-x)); }
#ifdef __HIP_EMU__
__device__ __forceinline__ float silu_fast(float x) { return x / (1.0f + expf(-x)); }
#else
__device__ __forceinline__ float silu_fast(float x) { return x * __builtin_amdgcn_rcpf(1.0f + __builtin_amdgcn_exp2f(-LOG2E * x)); }
#endif
__device__ __forceinline__ float wave_sum(float v) {
#pragma unroll
    for (int o = 1; o < 64; o <<= 1) v += __shfl_xor(v, o);
    return v;
}
__device__ __forceinline__ float wave_max(float v) {
#pragma unroll
    for (int o = 1; o < 64; o <<= 1) v = fmaxf(v, __shfl_xor(v, o));
    return v;
}

struct P {
    const float *x_prompt, *x_sample, *cache_k, *cache_v, *state_ret, *state_gdn, *state_conv, *c_prompt, *c_sample, *ada_w, *ada_b, *norm_mix, *norm_ffn,
        *w_in, *ret_norm, *conv_w, *a_log, *dt_bias, *gdn_norm, *w_out, *w_gate, *w_up, *w_down, *final_norm;
    float* out; unsigned char* ws;
};

constexpr size_t O_YP = 0, O_YS = O_YP + (size_t)MP * D, O_PWK = O_YS + (size_t)MS * D, O_PWV = O_PWK + (size_t)NL * PB * PWIN * 256,
                 O_PRET = O_PWV + (size_t)NL * PB * PWIN * 256, O_PGDN = O_PRET + (size_t)NL * PB * 4 * 4096, O_PCONV = O_PGDN + (size_t)NL * PB * 4 * 16384,
                 O_SWK = O_PCONV + (size_t)NL * PB * 3 * 1536, O_SWV = O_SWK + (size_t)NL * DB * DS * 256, O_SRET = O_SWV + (size_t)NL * DB * DS * 256,
                 O_SGDN = O_SRET + (size_t)NL * DB * 4 * 4096, O_SCONV = O_SGDN + (size_t)NL * DB * 4 * 16384, O_END = O_SCONV + (size_t)NL * DB * 3 * 1536;

constexpr size_t al256(size_t x) { return (x + 255) / 256 * 256; }
constexpr size_t WS_CTL = 0, WS_CTL_BYTES = 1u << 20;
constexpr size_t WS_MOD = WS_CTL + WS_CTL_BYTES;
constexpr size_t WS_W8 = al256(WS_MOD + (size_t)NL * NC * 6144 * 4);
constexpr size_t WS_ROPE = al256(WS_W8 + (size_t)NL * D * 8 * 4);
constexpr size_t WS_WIN = al256(WS_ROPE + (size_t)4 * NPOS * 32 * 4);
constexpr size_t WS_WOUT = al256(WS_WIN + (size_t)NL * NPROJ * D * 2);
constexpr size_t WS_WGU = al256(WS_WOUT + (size_t)NL * D * D * 2);
constexpr size_t WS_WDN = al256(WS_WGU + (size_t)NL * 2 * FF * D * 2);
constexpr size_t WS_H = al256(WS_WDN + (size_t)NL * D * FF * 2);
constexpr size_t WS_PROJ = al256(WS_H + (size_t)MPAD * D * 2);
constexpr size_t WS_BETA = al256(WS_PROJ + (size_t)MPAD * NPROJ * 2);
constexpr size_t WS_G = al256(WS_BETA + (size_t)M * 4 * 4);
constexpr size_t WS_O = al256(WS_G + (size_t)M * 4 * 4);
constexpr size_t WS_RU = al256(WS_O + (size_t)MPAD * D * 2);
constexpr size_t WS_RS = al256(WS_RU + (size_t)NUNIT * 4096 * 4);
constexpr size_t WS_SCR = al256(WS_RS + (size_t)NUNIT * 4096 * 4);
constexpr size_t WS_GU = WS_SCR;
constexpr size_t WS_GWK = al256(WS_GU + (size_t)NUNIT * 8192 * 2);
constexpr size_t WS_GQ = al256(WS_GWK + (size_t)NUNIT * 16384 * 2);
constexpr size_t WS_GA = al256(WS_GQ + (size_t)NUNIT * 8192 * 2);
constexpr size_t WS_GD = al256(WS_GA + (size_t)NUNIT * 4096 * 2);
constexpr size_t WS_GV = al256(WS_GD + (size_t)NUNIT * 4);
constexpr size_t WS_GS = al256(WS_GV + (size_t)NUNIT * 8192 * 2);
constexpr size_t WS_GEND = al256(WS_GS + (size_t)NUNIT * 16384 * 2);
constexpr size_t ATT_CLS = (size_t)PB * 4 * (T / 32) * 2048;
constexpr size_t WS_KF = WS_GEND;
constexpr size_t WS_VF = al256(WS_KF + 3 * ATT_CLS * 2);
constexpr size_t WS_KRT = al256(WS_VF + 3 * ATT_CLS * 2);
constexpr size_t WS_VRT = al256(WS_KRT + (size_t)MP * 256 * 2);
constexpr size_t WS_AML = al256(WS_VRT + (size_t)MP * 256 * 2);
constexpr size_t WS_AEND = al256(WS_AML + (size_t)MP * 4 * 3 * 2 * 4);
constexpr size_t WS_APO = WS_H;
static_assert((size_t)MP * 4 * 3 * 64 * 2 <= (size_t)MPAD * D * 2, "attention partials overlay H");
constexpr size_t WS_HID = WS_SCR;
constexpr size_t WS_HEND = al256(WS_HID + (size_t)MPAD * FF * 2);
constexpr size_t WS_END = WS_AEND > WS_HEND ? WS_AEND : WS_HEND;

#define WSP(T_, off) ((T_*)(p.ws + (off)))
__device__ __forceinline__ int row_cb(int r) { return r < MP ? r / T : PB + (r - MP) / DS; }
__device__ __forceinline__ int row_pi(int r) { return r < MP ? r % T : T + (r - MP) % DS; }
namespace pg8 {
#ifdef __HIP_EMU__
#define PG8_LAS
#else
#define PG8_LAS __attribute__((address_space(3)))
#endif
typedef unsigned short bf16_t;
typedef short bf16x8 __attribute__((ext_vector_type(8)));
typedef float f32x4 __attribute__((ext_vector_type(4)));
typedef unsigned u32x4 __attribute__((ext_vector_type(4)));
constexpr int BM = 256, BK = 64, HALF = 128, HTB = HALF * BK * 2  , STAGE_BYTES = 8 * HTB, NXCD = 8, WGM = 8;

__host__ __device__ __forceinline__ int lds_byte(int r, int c) { const int st = (r >> 4) * 2 + (c >> 5), rr = r & 15, cc = c & 31, ob = rr * 64 + cc * 2; return st * 1024 + (ob ^ (((ob >> 9) & 1) << 5)); }
__host__ __device__ __forceinline__ void stage_rc(int b, int& R, int& C) { const int st = b / 1024, sb = b % 1024, swz = sb ^ (((sb >> 9) & 1) << 5); R = (st >> 1) * 16 + swz / 64; C = (st & 1) * 32 + (swz % 64) / 2; }
__host__ __device__ __forceinline__ int perm32(int rho) { const int n = rho >> 4, i = rho & 15; return 8 * (i >> 2) + 4 * n + (i & 3); }

struct Unit { int pm, pn; };
struct Gemm { const bf16_t* A; const bf16_t* Bt; int M, N, K; };

struct StaticOrder {
    int nM, nN, nwg, G, c;
    __host__ __device__ void init(int M, int N, int G_, int c_) { nM = M / BM; nN = N / BM; nwg = nM * nN; G = G_; c = c_; }
    __host__ __device__ bool next(int i, Unit& u) const {
        const long L = (long)i * G + c; if (L >= nwg) return false;
        int wgid = (int)L; { const int q = nwg / NXCD, r = nwg % NXCD, xcd = wgid % NXCD, off = wgid / NXCD; wgid = (xcd < r ? xcd * (q + 1) : r * (q + 1) + (xcd - r) * q) + off; }
        const int nig = WGM * nN, gid = wgid / nig, fm = gid * WGM, gsz = (nM - fm) < WGM ? (nM - fm) : WGM;
        u.pm = fm + ((wgid % nig) % gsz); u.pn = (wgid % nig) / gsz; return true;
    }
    __device__ __forceinline__ void a_ready(const Unit&) const {}
    __device__ __forceinline__ void done(const Unit&) const {}
};


struct EpiStoreBf16 {
    static constexpr bool PERM = true, AFTER_DRAIN = false;
    bf16_t* O; int ldc;
    __device__ __forceinline__ void operator()(const f32x4 (&acc)[2][2][4][2], const Unit& u, int wr, int wc, int fr, int fq) const {
        const int row0 = u.pm * BM + wr * 64 + fr, col0 = u.pn * BM + wc * 32 + 8 * fq;
#pragma unroll
        for (int ai = 0; ai < 2; ++ai)
#pragma unroll
            for (int m = 0; m < 4; ++m) { bf16_t* rowp = O + (size_t)(row0 + ai * HALF + m * 16) * ldc + col0;
#pragma unroll
                for (int bj = 0; bj < 2; ++bj) { const f32x4 v0 = acc[ai][bj][m][0], v1 = acc[ai][bj][m][1];
                    u32x4 w; w.x = ::pk2(v0[0], v0[1]); w.y = ::pk2(v0[2], v0[3]); w.z = ::pk2(v1[0], v1[1]); w.w = ::pk2(v1[2], v1[3]);
                    *(u32x4*)(rowp + bj * HALF) = w; } }
    }
};
struct EpiResidual {
    static constexpr bool PERM = false, AFTER_DRAIN = false;
    float* X; const float* gate; const float* Xin;
    __device__ __forceinline__ void operator()(const f32x4 (&acc)[2][2][4][2], const Unit& u, int wr, int wc, int fr, int fq) const {
        const int row0 = u.pm * BM + wr * 64 + fr, col0 = u.pn * BM + wc * 32 + 4 * fq;
#pragma unroll
        for (int ai = 0; ai < 2; ++ai)
#pragma unroll
            for (int m = 0; m < 4; ++m) { const int row = row0 + ai * HALF + m * 16;
                if (MPAD != M && row >= M) continue;
                const float* g = gate + (size_t)::row_cb(row) * 6144 + col0; float* xp = X + (size_t)row * D + col0; const float* xi = Xin + (size_t)row * D + col0;
#pragma unroll
                for (int bj = 0; bj < 2; ++bj)
#pragma unroll
                    for (int n = 0; n < 2; ++n) { const f32x4 gv = *(const f32x4*)(g + bj * HALF + n * 16); f32x4* xq = (f32x4*)(xp + bj * HALF + n * 16); *xq = *(const f32x4*)(xi + bj * HALF + n * 16) + gv * acc[ai][bj][m][n]; } }
    }
};
struct EpiSwiglu {
    static constexpr bool PERM = true, AFTER_DRAIN = false;
    bf16_t* Hd;
    __device__ __forceinline__ void operator()(const f32x4 (&acc)[2][2][4][2], const Unit& u, int wr, int wc, int fr, int fq) const {
        const int row0 = u.pm * BM + wr * 64 + fr, col0 = u.pn * HALF + wc * 32 + 8 * fq;
#pragma unroll
        for (int ai = 0; ai < 2; ++ai)
#pragma unroll
            for (int m = 0; m < 4; ++m) { bf16_t* rowp = Hd + (size_t)(row0 + ai * HALF + m * 16) * FF + col0;
                float v[8];
#pragma unroll
                for (int n = 0; n < 2; ++n)
#pragma unroll
                    for (int j = 0; j < 4; ++j) { const float gt = acc[ai][0][m][n][j], up = acc[ai][1][m][n][j]; v[4 * n + j] = ::silu_f(gt) * up; }
                u32x4 w; w.x = ::pk2(v[0], v[1]); w.y = ::pk2(v[2], v[3]); w.z = ::pk2(v[4], v[5]); w.w = ::pk2(v[6], v[7]);
                *(u32x4*)rowp = w; }
    }
};

#ifdef __HIP_EMU__
template <class Epi, class Sched, bool ALIGN_EPI = false, bool SP2 = false>
__device__ __forceinline__ void gemm_phase(unsigned char* lds, const Gemm g, const Sched& S, const Epi& E) {
    const int tid = threadIdx.x, wid = tid >> 6, lane = tid & 63, wr = wid >> 2, wc = wid & 3, fr = lane & 15, fq = lane >> 4;
    Unit cur;
    for (int ui = 0; S.next(ui, cur); ++ui) {
        f32x4 acc[2][2][4][2];
        for (int ai = 0; ai < 2; ++ai) for (int bj = 0; bj < 2; ++bj) for (int m = 0; m < 4; ++m) for (int n = 0; n < 2; ++n) for (int j = 0; j < 4; ++j) {
            const int row = 256 * cur.pm + 128 * ai + 64 * wr + 16 * m + fr;
            const int col = Epi::PERM ? 256 * cur.pn + 128 * bj + 32 * wc + 8 * fq + 4 * n + j : 256 * cur.pn + 128 * bj + 32 * wc + 16 * n + 4 * fq + j;
            const bf16_t* a = g.A + (size_t)row * g.K; const bf16_t* b = g.Bt + (size_t)col * g.K; float s = 0.f;
            for (int k = 0; k < g.K; ++k) s += ::bf2f(a[k]) * ::bf2f(b[k]);
            acc[ai][bj][m][n][j] = s; }
        E(acc, cur, wr, wc, fr, fq);
    }
}
#else
template <class Epi, class Sched, bool ALIGN_EPI = false, bool SP2 = false>
__device__ __forceinline__ void gemm_phase(PG8_LAS unsigned char* lds, const Gemm g, const Sched& S, const Epi& E) {
    const int tid = ::tidx(), wid = __builtin_amdgcn_readfirstlane(tid >> 6), lane = tid & 63, wr = wid >> 2, wc = wid & 3, fr = lane & 15, fq = lane >> 4;
    const int K = g.K, nt = K / BK;
    unsigned voffA[2], voffB[2];
#pragma unroll
    for (int i = 0; i < 2; ++i) { int R, C; stage_rc(tid * 16 + i * 8192, R, C); const int Rb = Epi::PERM ? ((R & ~31) + perm32(R & 31)) : R;
        voffA[i] = (unsigned)(R * K + C) * 2u; voffB[i] = (unsigned)(Rb * K + C) * 2u; }
    const size_t kstep = (size_t)(BK * 2);
    const size_t hstep = (size_t)HALF * K * 2;
    const size_t tstep = 2 * hstep;
    const unsigned ldsw = (unsigned)wid * 1024u;
    const int aoff = lds_byte(wr * 64 + fr, fq * 8), boff = lds_byte(wc * 32 + fr, fq * 8);
#define PG8_SA(b, h) (((b) * 2 + (h)) * HTB)
#define PG8_SB(b, h) ((4 + (b) * 2 + (h)) * HTB)
#define PG8_STAGE(bufoff, gbase, voff) do { _Pragma("unroll") for (int _i = 0; _i < 2; ++_i) \
        __builtin_amdgcn_global_load_lds((const unsigned*)((const char*)(gbase) + (voff)[_i]), (PG8_LAS unsigned*)(lds + (bufoff) + ldsw + _i * 8192), 16, 0, 0); } while (0)
#define PG8_LDA(dst, b, h) do { _Pragma("unroll") for (int m = 0; m < 4; ++m) _Pragma("unroll") for (int k = 0; k < 2; ++k) dst[m][k] = *(const PG8_LAS bf16x8*)(lds + PG8_SA(b, h) + aoff + m * 2048 + k * 1024); } while (0)
#define PG8_LDB(dst, b, h) do { _Pragma("unroll") for (int n = 0; n < 2; ++n) _Pragma("unroll") for (int k = 0; k < 2; ++k) dst[n][k] = *(const PG8_LAS bf16x8*)(lds + PG8_SB(b, h) + boff + n * 2048 + k * 1024); } while (0)
#define PG8_MMA(ai, bj, At, Bt) do { __builtin_amdgcn_s_setprio(1); _Pragma("unroll") for (int m = 0; m < 4; ++m) _Pragma("unroll") for (int n = 0; n < 2; ++n) _Pragma("unroll") for (int k = 0; k < 2; ++k) \
        acc[ai][bj][m][n] = __builtin_amdgcn_mfma_f32_16x16x32_bf16(Bt[n][k], At[m][k], acc[ai][bj][m][n], 0, 0, 0); __builtin_amdgcn_s_setprio(0); } while (0)
#define PG8_WAIT_V(n) asm volatile("s_waitcnt vmcnt(" #n ")" ::: "memory")
#define PG8_WAIT_L(n) asm volatile("s_waitcnt lgkmcnt(" #n ")" ::: "memory")
#define PG8_BAR __builtin_amdgcn_s_barrier()
#define PG8_SCHED __builtin_amdgcn_sched_barrier(0)
    Unit cur, nxt; int ui = 0;
    if (!S.next(0, cur)) return;
    f32x4 acc[2][2][4][2];
#pragma unroll
    for (int a = 0; a < 2; ++a)
#pragma unroll
        for (int b = 0; b < 2; ++b)
#pragma unroll
            for (int m = 0; m < 4; ++m)
#pragma unroll
                for (int n = 0; n < 2; ++n) acc[a][b][m][n] = (f32x4){0.f, 0.f, 0.f, 0.f};
    bf16x8 At[4][2], B0[2][2], B1[2][2];
    const char* cA = (const char*)g.A + (size_t)cur.pm * tstep; const char* cB = (const char*)g.Bt + (size_t)cur.pn * tstep;
    S.a_ready(cur);
    if constexpr (SP2) {
        PG8_STAGE(PG8_SB(0, 0), cB, voffB); PG8_STAGE(PG8_SB(0, 1), cB + hstep, voffB); PG8_STAGE(PG8_SA(0, 0), cA, voffA); PG8_STAGE(PG8_SA(0, 1), cA + hstep, voffA);
        if (wr == 1) PG8_BAR;
        PG8_WAIT_V(2); PG8_BAR;
        PG8_STAGE(PG8_SB(1, 0), cB + kstep, voffB); PG8_STAGE(PG8_SA(1, 0), cA + kstep, voffA); PG8_STAGE(PG8_SB(1, 1), cB + hstep + kstep, voffB);
        PG8_WAIT_V(6); PG8_BAR;
    } else {
        PG8_STAGE(PG8_SB(0, 0), cB, voffB); PG8_STAGE(PG8_SA(0, 0), cA, voffA); PG8_STAGE(PG8_SB(0, 1), cB + hstep, voffB); PG8_STAGE(PG8_SA(0, 1), cA + hstep, voffA);
        if (wr == 1) PG8_BAR;
        PG8_WAIT_V(4); PG8_BAR;
        PG8_STAGE(PG8_SB(1, 0), cB + kstep, voffB); PG8_STAGE(PG8_SA(1, 0), cA + kstep, voffA); PG8_STAGE(PG8_SB(1, 1), cB + hstep + kstep, voffB);
        PG8_WAIT_V(6); PG8_BAR;
    }
    for (;;) {
        const bool has_next = S.next(ui + 1, nxt);
        const char* nA = has_next ? (const char*)g.A + (size_t)nxt.pm * tstep : cA; const char* nB = has_next ? (const char*)g.Bt + (size_t)nxt.pn * tstep : cB;
        for (int t = 0; t < nt; t += 2) {
            const bool last = (t == nt - 2);
            const char* a1 = cA + (size_t)(t + 1) * kstep;
            const char* a2 = last ? nA : cA + (size_t)(t + 2) * kstep; const char* b2 = last ? nB : cB + (size_t)(t + 2) * kstep;
            const char* a3 = a2 + kstep; const char* b3 = b2 + kstep;
            if (last && has_next) S.a_ready(nxt);
            if constexpr (SP2) {
            PG8_LDB(B0, 0, 0); PG8_LDB(B1, 0, 1); PG8_SCHED; PG8_LDA(At, 0, 0); PG8_STAGE(PG8_SA(1, 1), a1 + hstep, voffA);
            PG8_WAIT_V(8); PG8_WAIT_L(0); PG8_BAR; PG8_MMA(0, 0, At, B0); PG8_MMA(0, 1, At, B1); PG8_BAR; PG8_SCHED;
            PG8_LDA(At, 0, 1); PG8_STAGE(PG8_SB(0, 0), b2, voffB); PG8_STAGE(PG8_SB(0, 1), b2 + hstep, voffB); PG8_STAGE(PG8_SA(0, 0), a2, voffA);
            PG8_WAIT_V(8); PG8_WAIT_L(0); PG8_BAR; PG8_MMA(1, 0, At, B0); PG8_MMA(1, 1, At, B1); PG8_BAR; PG8_SCHED;
            PG8_LDB(B0, 1, 0); PG8_LDB(B1, 1, 1); PG8_SCHED; PG8_LDA(At, 1, 0); PG8_STAGE(PG8_SA(0, 1), a2 + hstep, voffA);
            PG8_WAIT_V(8); PG8_WAIT_L(0); PG8_BAR; PG8_MMA(0, 0, At, B0); PG8_MMA(0, 1, At, B1); PG8_BAR; PG8_SCHED;
            PG8_LDA(At, 1, 1); PG8_STAGE(PG8_SB(1, 0), b3, voffB); PG8_STAGE(PG8_SB(1, 1), b3 + hstep, voffB); PG8_STAGE(PG8_SA(1, 0), a3, voffA);
            PG8_WAIT_V(8); PG8_WAIT_L(0); PG8_BAR; PG8_MMA(1, 0, At, B0); PG8_MMA(1, 1, At, B1); PG8_BAR; PG8_SCHED;
            } else {
            PG8_LDB(B0, 0, 0); PG8_SCHED; PG8_LDA(At, 0, 0); PG8_STAGE(PG8_SA(1, 1), a1 + hstep, voffA);
            PG8_WAIT_L(8); PG8_BAR; PG8_WAIT_L(0); PG8_MMA(0, 0, At, B0); PG8_BAR; PG8_SCHED;
            PG8_LDB(B1, 0, 1); PG8_STAGE(PG8_SB(0, 0), b2, voffB);
            PG8_BAR; PG8_WAIT_L(0); PG8_MMA(0, 1, At, B1); PG8_BAR;
            PG8_LDA(At, 0, 1); PG8_STAGE(PG8_SA(0, 0), a2, voffA);
            PG8_BAR; PG8_WAIT_L(0); PG8_MMA(1, 0, At, B0); PG8_BAR; PG8_SCHED;
            PG8_STAGE(PG8_SB(0, 1), b2 + hstep, voffB);
            PG8_WAIT_V(6); PG8_BAR; PG8_MMA(1, 1, At, B1); PG8_BAR;
            PG8_LDB(B0, 1, 0); PG8_SCHED; PG8_LDA(At, 1, 0); PG8_STAGE(PG8_SA(0, 1), a2 + hstep, voffA);
            PG8_WAIT_L(8); PG8_BAR; PG8_WAIT_L(0); PG8_MMA(0, 0, At, B0); PG8_BAR; PG8_SCHED;
            PG8_LDB(B1, 1, 1); PG8_STAGE(PG8_SB(1, 0), b3, voffB);
            PG8_BAR; PG8_WAIT_L(0); PG8_MMA(0, 1, At, B1); PG8_BAR;
            PG8_LDA(At, 1, 1); PG8_STAGE(PG8_SA(1, 0), a3, voffA);
            PG8_BAR; PG8_WAIT_L(0); PG8_MMA(1, 0, At, B0); PG8_BAR; PG8_SCHED;
            PG8_STAGE(PG8_SB(1, 1), b3 + hstep, voffB);
            PG8_WAIT_V(6); PG8_BAR; PG8_MMA(1, 1, At, B1); PG8_BAR;
            }
        }
        if constexpr (ALIGN_EPI) { if (wr == 0) PG8_BAR; }
        if constexpr (!Epi::AFTER_DRAIN) { E(acc, cur, wr, wc, fr, fq); S.done(cur); }
        if (!has_next) break;
#pragma unroll
        for (int a = 0; a < 2; ++a)
#pragma unroll
            for (int b = 0; b < 2; ++b)
#pragma unroll
                for (int m = 0; m < 4; ++m)
#pragma unroll
                    for (int n = 0; n < 2; ++n) acc[a][b][m][n] = (f32x4){0.f, 0.f, 0.f, 0.f};
        cur = nxt; cA = nA; cB = nB; ++ui;
        if constexpr (ALIGN_EPI) { if (wr == 1) PG8_BAR; }
    }
    PG8_WAIT_V(0);
    if constexpr (!ALIGN_EPI) { if (wr == 0) PG8_BAR; }
    PG8_BAR;
    if constexpr (Epi::AFTER_DRAIN) { E.fused(acc, cur, wr, wc, fr, fq, lds, wid, lane); S.done(cur); }
#undef PG8_SA
#undef PG8_SB
#undef PG8_STAGE
#undef PG8_LDA
#undef PG8_LDB
#undef PG8_MMA
#undef PG8_WAIT_V
#undef PG8_WAIT_L
#undef PG8_BAR
#undef PG8_SCHED
}
#endif
}


__device__ __forceinline__ void transpose_item(const float* W, int ldw, bf16_t* WT, int K, int k0, int n0, int drow0, float* scr, int lane) {
#pragma unroll 8
    for (int i = 0; i < 32; ++i) { const int kk = 2 * i + (lane >> 5); scr[kk * 33 + (lane & 31)] = W[(size_t)(k0 + kk) * ldw + n0 + (lane & 31)]; }
    WAVE_SYNC();
    const int c = lane & 7;
#pragma unroll
    for (int j = 0; j < 4; ++j) { const int n = (lane >> 3) + 8 * j; const float* s = scr + (8 * c) * 33 + n;
        u32x4 o; o.x = pk2(s[0 * 33], s[1 * 33]); o.y = pk2(s[2 * 33], s[3 * 33]); o.z = pk2(s[4 * 33], s[5 * 33]); o.w = pk2(s[6 * 33], s[7 * 33]);
        *(u32x4*)(WT + (size_t)(drow0 + n) * K + k0 + 8 * c) = o; }
    WAVE_SYNC();
}
__device__ __forceinline__ void ph_convert(const P& p, unsigned char* smem) {
    const int lane = tidx() & 63, wave = tidx() >> 6;
    float* scr = (float*)smem + wave * (64 * 33 + 32);
    constexpr int I_IN = 16 * 120, I_OUT = 16 * 32, I_G = 16 * 88, I_DN = 44 * 32, I_L = I_IN + I_OUT + 2 * I_G + I_DN;
    const int gw = blockIdx.x * 8 + wave, ngw = gridDim.x * 8;
    for (int it = gw; it < NL * I_L; it += ngw) {
        const int l = it / I_L; int r = it % I_L;
        if (r < I_IN) { const int kb = r / 120, nb = r % 120; transpose_item(p.w_in + (size_t)l * D * INC, INC, WSP(bf16_t, WS_WIN) + (size_t)l * NPROJ * D, D, kb * 64, nb * 32, nb * 32, scr, lane); continue; }
        r -= I_IN;
        if (r < I_OUT) { const int kb = r / 32, nb = r % 32; transpose_item(p.w_out + (size_t)l * D * D, D, WSP(bf16_t, WS_WOUT) + (size_t)l * D * D, D, kb * 64, nb * 32, nb * 32, scr, lane); continue; }
        r -= I_OUT;
        if (r < 2 * I_G) { const int up = r / I_G; r %= I_G; const int kb = r / 88, nb = r % 88, n0 = nb * 32;
            transpose_item((up ? p.w_up : p.w_gate) + (size_t)l * D * FF, FF, WSP(bf16_t, WS_WGU) + (size_t)l * 2 * FF * D, D, kb * 64, n0, (n0 / 128) * 256 + up * 128 + (n0 % 128), scr, lane); continue; }
        r -= 2 * I_G;
        { const int kb = r / 32, nb = r % 32; transpose_item(p.w_down + (size_t)l * FF * D, D, WSP(bf16_t, WS_WDN) + (size_t)l * D * FF, FF, kb * 64, nb * 32, nb * 32, scr, lane); }
    }
}

__device__ __forceinline__ void ph_adaln(const P& p, unsigned char* smem) {
    float* sc = (float*)smem;
    float* red = sc + NC * 256;
    const int tid = tidx(), col = tid & 31, kg = tid >> 5;
    float* MOD = WSP(float, WS_MOD);
    for (int it = blockIdx.x; it < NL * 192; it += gridDim.x) {
        const int l = it / 192, cb0 = (it % 192) * 32;
        float acc[NC];
#pragma unroll
        for (int r = 0; r < NC; ++r) acc[r] = 0.f;
        for (int kc = 0; kc < 4; ++kc) {
            __syncthreads();
            for (int e = tid; e < NC * 256; e += NTHR) { const int r = e >> 8, k = e & 255; const float c = r < PB ? p.c_prompt[r * D + kc * 256 + k] : p.c_sample[(r - PB) * D + kc * 256 + k]; sc[e] = silu_f(c); }
            __syncthreads();
            for (int kk = 0; kk < 16; ++kk) { const int k = kg * 16 + kk; const float w = p.ada_w[((size_t)l * D + kc * 256 + k) * 6144 + cb0 + col];
#pragma unroll
                for (int r = 0; r < NC; ++r) acc[r] += sc[r * 256 + k] * w; }
        }
#pragma unroll
        for (int r = 0; r < NC; ++r) red[(kg * NC + r) * 32 + col] = acc[r];
        __syncthreads();
        for (int e = tid; e < NC * 32; e += NTHR) { const int r = e >> 5, c = e & 31; float s = p.ada_b[l * 6144 + cb0 + c];
            for (int g = 0; g < 16; ++g) s += red[(g * NC + r) * 32 + c];
            MOD[((size_t)l * NC + r) * 6144 + cb0 + c] = s; }
        __syncthreads();
    }
}

__device__ __forceinline__ void ph_ropetab_copyx(const P& p) {
    const size_t gt = (size_t)blockIdx.x * NTHR + tidx(), ng = (size_t)gridDim.x * NTHR;
    float* tab = WSP(float, WS_ROPE);
    for (size_t e = gt; e < (size_t)NL * D * 8; e += ng) { const size_t lk = e >> 3; const int c = (int)(e & 7); WSP(float, WS_W8)[((lk >> 10) * 8 + c) * D + (lk & 1023)] = p.w_in[lk * INC + NPROJ + c]; }
    for (size_t e = gt; e < (size_t)NPOS * 32; e += ng) {
        const int pi = (int)(e >> 5), i = (int)(e & 31); const double pos = pi < T ? (double)pi : (double)(PAST + pi - T);
        const double ia = exp(-log(10000.0) * (double)i / 32.0), ir = exp(-log(10000.0) * (double)i / 31.0);
        tab[e] = (float)cos(pos * ia); tab[(size_t)NPOS * 32 + e] = (float)sin(pos * ia);
        tab[(size_t)2 * NPOS * 32 + e] = (float)cos(pos * ir); tab[(size_t)3 * NPOS * 32 + e] = (float)sin(pos * ir);
    }
}

template <int WHICH> __device__ __forceinline__ void ph_norm_mod(const P& p, int l) {
    const int lane = tidx() & 63, wave = tidx() >> 6, gw = blockIdx.x * 8 + wave, ngw = gridDim.x * 8;
    const float* nw = (WHICH == 0 ? p.norm_mix : p.norm_ffn) + l * D;
    bf16_t* H = WSP(bf16_t, WS_H);
    for (int r = gw; r < M; r += ngw) {
        const float* xr = (WHICH == 0 && l == 0) ? (r < MP ? p.x_prompt + (size_t)r * D : p.x_sample + (size_t)(r - MP) * D) : p.out + (size_t)r * D;
        const float* mod = WSP(float, WS_MOD) + ((size_t)l * NC + row_cb(r)) * 6144 + (WHICH == 0 ? 0 : 3072);
        f32x4 v[4]; float ss = 0.f;
#pragma unroll
        for (int j = 0; j < 4; ++j) { v[j] = *(const f32x4*)(xr + 4 * lane + 256 * j); ss += (v[j][0] * v[j][0] + v[j][1] * v[j][1]) + (v[j][2] * v[j][2] + v[j][3] * v[j][3]); }
        const float rstd = 1.0f / sqrtf(wave_sum(ss) * (1.0f / D) + EPS);
        float a8[8];
#pragma unroll
        for (int c = 0; c < 8; ++c) a8[c] = 0.f;
#pragma unroll
        for (int j = 0; j < 4; ++j) { const int k = 4 * lane + 256 * j;
            const f32x4 g = *(const f32x4*)(nw + k), sh = *(const f32x4*)(mod + k), sc = *(const f32x4*)(mod + 1024 + k);
            f32x4 h;
#pragma unroll
            for (int e = 0; e < 4; ++e) h[e] = v[j][e] * rstd * g[e] * (1.0f + sc[e]) + sh[e];
            u32x2 w; w.x = pk2(h[0], h[1]); w.y = pk2(h[2], h[3]); *(u32x2*)(H + (size_t)r * D + k) = w;
            if (WHICH == 0) {
#pragma unroll
                for (int c = 0; c < 8; ++c) { const f32x4 wv = *(const f32x4*)(WSP(float, WS_W8) + ((size_t)l * 8 + c) * D + k); a8[c] += (h[0] * wv[0] + h[1] * wv[1]) + (h[2] * wv[2] + h[3] * wv[3]); }
            }
        }
        if (WHICH == 0) {
#pragma unroll
            for (int c = 0; c < 8; ++c) a8[c] = wave_sum(a8[c]);
            if (lane < 4) { float braw = lane == 0 ? a8[0] : lane == 1 ? a8[1] : lane == 2 ? a8[2] : a8[3]; WSP(float, WS_BETA)[(size_t)r * 4 + lane] = 1.0f / (1.0f + expf(-braw)); }
            else if (lane < 8) { const int hh = lane - 4; float araw = hh == 0 ? a8[4] : hh == 1 ? a8[5] : hh == 2 ? a8[6] : a8[7];
                const float xx = araw + p.dt_bias[l * 4 + hh]; const float sp = xx > 20.f ? xx : log1pf(expf(xx));
                WSP(float, WS_G)[(size_t)r * 4 + hh] = -expf(p.a_log[l * 4 + hh]) * sp; }
        }
    }
}

__device__ __forceinline__ void unpack8(const u32x4 w, float (&f)[8]) {
    f[0] = __builtin_bit_cast(float, w.x << 16); f[1] = __builtin_bit_cast(float, w.x & 0xffff0000u); f[2] = __builtin_bit_cast(float, w.y << 16); f[3] = __builtin_bit_cast(float, w.y & 0xffff0000u);
    f[4] = __builtin_bit_cast(float, w.z << 16); f[5] = __builtin_bit_cast(float, w.z & 0xffff0000u); f[6] = __builtin_bit_cast(float, w.w << 16); f[7] = __builtin_bit_cast(float, w.w & 0xffff0000u);
}
__device__ __forceinline__ u32x4 pack8f(const float (&f)[8]) { u32x4 w; w.x = pk2(f[0], f[1]); w.y = pk2(f[2], f[3]); w.z = pk2(f[4], f[5]); w.w = pk2(f[6], f[7]); return w; }
__device__ __forceinline__ void ph_rope_out(const P& p, int l) {
    const size_t gt = (size_t)blockIdx.x * NTHR + tidx(), ng = (size_t)gridDim.x * NTHR;
    bf16_t* PR = WSP(bf16_t, WS_PROJ); const float* tab = WSP(float, WS_ROPE);
    for (size_t e = gt; e < (size_t)MS * 64; e += ng) {
        const int r = MP + (int)(e >> 6), rem = (int)(e & 63), sec = rem >> 4, hh = (rem >> 2) & 3, d = (rem & 3) * 8;
        const int off = sec == 0 ? C_QA : sec == 1 ? C_KA : sec == 2 ? C_QR : C_KR; const float scale = sec == 0 ? 0.125f * LOG2E : sec == 3 ? 0.125f : 1.0f;
        const float* ct = tab + (size_t)(sec >= 2 ? 2 : 0) * NPOS * 32 + (size_t)row_pi(r) * 32 + d; const float* st = ct + (size_t)NPOS * 32;
        const f32x4 c0 = *(const f32x4*)ct, c1 = *(const f32x4*)(ct + 4), s0 = *(const f32x4*)st, s1 = *(const f32x4*)(st + 4);
        bf16_t* x = PR + (size_t)r * NPROJ + off + hh * 64 + d; float x1[8], x2[8], o1[8], o2[8];
        unpack8(*(const u32x4*)x, x1); unpack8(*(const u32x4*)(x + 32), x2);
#pragma unroll
        for (int k = 0; k < 8; ++k) { const float c = k < 4 ? c0[k & 3] : c1[k & 3], sn = k < 4 ? s0[k & 3] : s1[k & 3]; o1[k] = (x1[k] * c - x2[k] * sn) * scale; o2[k] = (x1[k] * sn + x2[k] * c) * scale; }
        *(u32x4*)x = pack8f(o1); *(u32x4*)(x + 32) = pack8f(o2);
        if (sec == 1) { const int b = (r - MP) / DS, i = (r - MP) % DS; float* o = p.out + O_SWK + (((size_t)l * DB + b) * DS + i) * 256 + hh * 64 + d;
            *(f32x4*)o = (f32x4){o1[0], o1[1], o1[2], o1[3]}; *(f32x4*)(o + 4) = (f32x4){o1[4], o1[5], o1[6], o1[7]}; *(f32x4*)(o + 32) = (f32x4){o2[0], o2[1], o2[2], o2[3]}; *(f32x4*)(o + 36) = (f32x4){o2[4], o2[5], o2[6], o2[7]}; }
    }
    for (size_t e = gt; e < (size_t)MS * 32; e += ng) {
        const int r = MP + (int)(e >> 5), c = (int)(e & 31) * 8; const int b = (r - MP) / DS, i = (r - MP) % DS; float* o = p.out + O_SWV + (((size_t)l * DB + b) * DS + i) * 256 + c;
        float v[8]; unpack8(*(const u32x4*)(PR + (size_t)r * NPROJ + C_VA + c), v); *(f32x4*)o = (f32x4){v[0], v[1], v[2], v[3]}; *(f32x4*)(o + 4) = (f32x4){v[4], v[5], v[6], v[7]};
    }
    for (size_t e = gt; e < (size_t)(PB + DB) * 3 * 1536; e += ng) {
        const int c = (int)(e % 1536), j = (int)((e / 1536) % 3), bb = (int)(e / (3 * 1536));
        if (bb < PB) p.out[O_PCONV + (((size_t)l * PB + bb) * 3 + j) * 1536 + c] = bf2f(PR[(size_t)(bb * T + T - 3 + j) * NPROJ + C_CONV + c]);
        else { const int b = bb - PB; p.out[O_SCONV + (((size_t)l * DB + b) * 3 + j) * 1536 + c] = bf2f(PR[(size_t)(MP + b * DS + DS - 3 + j) * NPROJ + C_CONV + c]); }
    }
}

__device__ __forceinline__ void attn_wave_sample(const P& p, int l, int r, int h, int lane, float* sw  ) {
    const bf16_t* PR = WSP(bf16_t, WS_PROJ);
    const int b = (r - MP) / DS; const int tq = WB + (r - MP) % DS;
    float q[64];
    { const bf16_t* qp = PR + (size_t)r * NPROJ + C_QA + h * 64;
#pragma unroll
      for (int j = 0; j < 8; ++j) { const bf16x8 v = *(const bf16x8*)(qp + 8 * j);
#pragma unroll
          for (int e = 0; e < 8; ++e) q[8 * j + e] = bf2f((bf16_t)v[e]); } }
    float mx = -INFINITY;
#pragma unroll 1
    for (int i = 0; i < 7; ++i) {
        const int e = lane + 64 * i;
        if (e < 387) { const int pat = e / 129, j = e % 129, dil = pat == 0 ? 1 : pat == 1 ? 4 : 16; const int rr = tq - dil * j;
            float a = 0.f;
            if (rr < WB) { const float* kp = p.cache_k + ((((size_t)l * DB + b) * WB + rr) * 4 + h) * 64;
#pragma unroll
                for (int j4 = 0; j4 < 16; ++j4) { const f32x4 kv = *(const f32x4*)(kp + 4 * j4); a += q[4 * j4] * kv[0] + q[4 * j4 + 1] * kv[1] + q[4 * j4 + 2] * kv[2] + q[4 * j4 + 3] * kv[3]; } }
            else { const bf16_t* kp = PR + (size_t)(MP + b * DS + (rr - WB)) * NPROJ + C_KA + h * 64;
#pragma unroll
                for (int j8 = 0; j8 < 8; ++j8) { const bf16x8 kv = *(const bf16x8*)(kp + 8 * j8);
#pragma unroll
                    for (int e2 = 0; e2 < 8; ++e2) a += q[8 * j8 + e2] * bf2f((bf16_t)kv[e2]); } }
            sw[e] = a; mx = fmaxf(mx, a); }
    }
    mx = wave_max(mx);
    float lsum = 0.f;
#pragma unroll 1
    for (int i = 0; i < 7; ++i) { const int e = lane + 64 * i; if (e < 387) { const float pe = exp2f(sw[e] - mx); sw[e] = pe; lsum += pe; } }
    lsum = wave_sum(lsum);
    WAVE_SYNC();
    const int kg = lane >> 4, dq = lane & 15; f32x4 o4 = (f32x4){0.f, 0.f, 0.f, 0.f};
#pragma unroll 8
    for (int e = kg; e < 387; e += 4) {
        const float pe = sw[e];
        const int pat = e / 129, j = e % 129, dil = pat == 0 ? 1 : pat == 1 ? 4 : 16; const int rr = tq - dil * j;
        f32x4 v;
        if (rr < WB) v = *(const f32x4*)(p.cache_v + ((((size_t)l * DB + b) * WB + rr) * 4 + h) * 64 + 4 * dq);
        else { const u32x2 w = *(const u32x2*)(PR + (size_t)(MP + b * DS + (rr - WB)) * NPROJ + C_VA + h * 64 + 4 * dq);
            v = (f32x4){bf2f((bf16_t)(w.x & 0xffff)), bf2f((bf16_t)(w.x >> 16)), bf2f((bf16_t)(w.y & 0xffff)), bf2f((bf16_t)(w.y >> 16))}; }
        o4 += pe * v;
    }
#pragma unroll
    for (int e = 0; e < 4; ++e) { float x = o4[e]; x += __shfl_xor(x, 16); x += __shfl_xor(x, 32); o4[e] = x; }
    WAVE_SYNC();
    if (kg == 0) { const float inv = 1.0f / lsum; u32x2 w; w.x = pk2(o4[0] * inv, o4[1] * inv); w.y = pk2(o4[2] * inv, o4[3] * inv);
        *(u32x2*)(WSP(bf16_t, WS_O) + (size_t)r * D + h * 64 + 4 * dq) = w; }
}
__device__ __forceinline__ void ph_attn_sample(const P& p, int l, unsigned char* smem) {
    const int lane = tidx() & 63, wave = tidx() >> 6, gw = (gridDim.x - 1 - blockIdx.x) * 8 + wave, ngw = gridDim.x * 8;
    float* sw = (float*)smem + wave * 392;
    for (int it = gw; it < MS * 4; it += ngw) attn_wave_sample(p, l, MP + (it >> 2), it & 3, lane, sw);
}
__device__ __forceinline__ bf16x8 pack8(const f32x16& v, int s8) {
    u32x4 w; w.x = pk2(v[s8], v[s8 + 1]); w.y = pk2(v[s8 + 2], v[s8 + 3]); w.z = pk2(v[s8 + 4], v[s8 + 5]); w.w = pk2(v[s8 + 6], v[s8 + 7]); return __builtin_bit_cast(bf16x8, w);
}
__device__ __forceinline__ void attn_job(const P& p, int jb, int lane) {
    const int c = lane & 31, hi = lane >> 5;
    constexpr int NB = T / 512;
    const int unit = jb / 48, jj = jb % 48, pat = jj >> 4, sub = jj & 15;
    const int blk = unit % NB, h = (unit / NB) & 3, b = unit / (NB * 4), bh = b * 4 + h;
    int dil, r, qi0, cls, tb;
    if (pat == 0) { dil = 1; r = 0; qi0 = blk * 512 + sub * 32; cls = 0; tb = 0; }
    else if (pat == 1) { dil = 4; r = sub >> 2; qi0 = blk * 128 + (sub & 3) * 32; cls = 1; tb = r * (T / 128); }
    else { dil = 16; r = sub; qi0 = blk * 32; cls = 2; tb = r * (T / 512); }
    const bf16_t* KF = WSP(bf16_t, WS_KF) + cls * ATT_CLS + ((size_t)bh * (T / 32) + tb) * 2048 + lane * 8;
    const bf16_t* VF = WSP(bf16_t, WS_VF) + cls * ATT_CLS + ((size_t)bh * (T / 32) + tb) * 2048 + lane * 8;
    const int tq = dil * (qi0 + c) + r;
    const bf16_t* qp = WSP(bf16_t, WS_PROJ) + (size_t)(b * T + tq) * NPROJ + C_QA + h * 64 + 8 * hi;
    bf16x8 qf[4];
#pragma unroll
    for (int ks = 0; ks < 4; ++ks) qf[ks] = *(const bf16x8*)(qp + 16 * ks);
    f32x16 S[5];
#pragma unroll
    for (int i = 0; i < 5; ++i) {
        const int kt0 = qi0 - 128 + 32 * i;
        f32x16 acc;
#pragma unroll
        for (int e = 0; e < 16; ++e) acc[e] = 0.f;
        if (kt0 >= 0) { const bf16_t* kp = KF + (size_t)(kt0 >> 5) * 2048;
#pragma unroll
            for (int ks = 0; ks < 4; ++ks) acc = MFMA32(*(const bf16x8*)(kp + 512 * ks), qf[ks], acc);
            if (i == 0) {
#pragma unroll
                for (int e = 0; e < 16; ++e) { const int krow = (e & 3) + 8 * (e >> 2) + 4 * hi; if (krow < c) acc[e] = -INFINITY; } }
            if (i == 4) {
#pragma unroll
                for (int e = 0; e < 16; ++e) { const int krow = (e & 3) + 8 * (e >> 2) + 4 * hi; if (krow > c) acc[e] = -INFINITY; } }
        } else {
#pragma unroll
            for (int e = 0; e < 16; ++e) acc[e] = -INFINITY; }
        S[i] = acc;
    }
    float mx = -INFINITY;
#pragma unroll
    for (int i = 0; i < 5; ++i)
#pragma unroll
        for (int e = 0; e < 16; ++e) mx = fmaxf(mx, S[i][e]);
    mx = fmaxf(mx, __shfl_xor(mx, 32));
    float lsum = 0.f;
#pragma unroll
    for (int i = 0; i < 5; ++i)
#pragma unroll
        for (int e = 0; e < 16; ++e) { const float pe = exp2f(S[i][e] - mx); S[i][e] = pe; lsum += pe; }
    lsum += __shfl_xor(lsum, 32);
    f32x16 O[2];
#pragma unroll
    for (int dt = 0; dt < 2; ++dt)
#pragma unroll
        for (int e = 0; e < 16; ++e) O[dt][e] = 0.f;
#pragma unroll
    for (int i = 0; i < 5; ++i) {
        const int kt0 = qi0 - 128 + 32 * i;
        if (kt0 >= 0) {
#pragma unroll
            for (int s2 = 0; s2 < 2; ++s2) { const bf16x8 pf = pack8(S[i], 8 * s2);
#pragma unroll
                for (int dt = 0; dt < 2; ++dt) O[dt] = MFMA32(*(const bf16x8*)(VF + (size_t)(kt0 >> 5) * 2048 + (dt * 2 + s2) * 512), pf, O[dt]); }
        }
    }
    const size_t idx = ((size_t)(b * T + tq) * 4 + h) * 3 + pat;
    bf16_t* po = WSP(bf16_t, WS_APO) + idx * 64;
#pragma unroll
    for (int dt = 0; dt < 2; ++dt)
#pragma unroll
        for (int g = 0; g < 4; ++g) { u32x2 w; w.x = pk2(O[dt][4 * g], O[dt][4 * g + 1]); w.y = pk2(O[dt][4 * g + 2], O[dt][4 * g + 3]); *(u32x2*)(po + 32 * dt + 8 * g + 4 * hi) = w; }
    if (hi == 0) { float* ml = WSP(float, WS_AML) + idx * 2; ml[0] = mx; ml[1] = lsum; }
}
__device__ __forceinline__ void ph_attn_jobs(const P& p) {
    const int lane = tidx() & 63, wave = tidx() >> 6, gw = blockIdx.x * 8 + wave, ngw = gridDim.x * 8;
    for (int jb = gw; jb < PB * 4 * (T / 512) * 48; jb += ngw) attn_job(p, jb, lane);
}
__device__ __forceinline__ void ph_attn_combine(const P& p) {
    const size_t gt = (size_t)blockIdx.x * NTHR + tidx(), ng = (size_t)gridDim.x * NTHR;
    for (size_t e = gt; e < (size_t)MP * 4 * 16; e += ng) {
        const size_t rh = e >> 4; const int dq = (int)(e & 15) * 4;
        const float* ml = WSP(float, WS_AML) + rh * 6; const float m0 = ml[0], m1 = ml[2], m2 = ml[4];
        const float mm = fmaxf(m0, fmaxf(m1, m2)); const float w0 = exp2f(m0 - mm), w1 = exp2f(m1 - mm), w2 = exp2f(m2 - mm);
        const float inv = 1.0f / (w0 * ml[1] + w1 * ml[3] + w2 * ml[5]);
        const bf16_t* po = WSP(bf16_t, WS_APO) + rh * 192 + dq;
        const u32x2 a = *(const u32x2*)po, bq = *(const u32x2*)(po + 64), cq = *(const u32x2*)(po + 128);
        float o[4];
        o[0] = w0 * bf2f((bf16_t)(a.x & 0xffff)) + w1 * bf2f((bf16_t)(bq.x & 0xffff)) + w2 * bf2f((bf16_t)(cq.x & 0xffff));
        o[1] = w0 * bf2f((bf16_t)(a.x >> 16)) + w1 * bf2f((bf16_t)(bq.x >> 16)) + w2 * bf2f((bf16_t)(cq.x >> 16));
        o[2] = w0 * bf2f((bf16_t)(a.y & 0xffff)) + w1 * bf2f((bf16_t)(bq.y & 0xffff)) + w2 * bf2f((bf16_t)(cq.y & 0xffff));
        o[3] = w0 * bf2f((bf16_t)(a.y >> 16)) + w1 * bf2f((bf16_t)(bq.y >> 16)) + w2 * bf2f((bf16_t)(cq.y >> 16));
        const size_t row = rh >> 2; const int h = (int)(rh & 3);
        u32x2 w; w.x = pk2(o[0] * inv, o[1] * inv); w.y = pk2(o[2] * inv, o[3] * inv);
        *(u32x2*)(WSP(bf16_t, WS_O) + row * D + h * 64 + dq) = w;
    }
}
__device__ __forceinline__ float ret_lg(int h) { return logf(1.0f - exp2f(-5.0f - (float)h)); }
constexpr int TPK = 72, TPT = 65;
__device__ __forceinline__ void trans_write(const bf16_t* tile, bf16_t* dst  , int tile0, int tid) {
#pragma unroll
    for (int k = 0; k < 4; ++k) { const int ch = tid + NTHR * k, d = ch >> 5, t0 = (ch & 31) * 8; u32x4 w;
        w.x = (unsigned)tile[(t0 + 0) * TPT + d] | ((unsigned)tile[(t0 + 1) * TPT + d] << 16); w.y = (unsigned)tile[(t0 + 2) * TPT + d] | ((unsigned)tile[(t0 + 3) * TPT + d] << 16);
        w.z = (unsigned)tile[(t0 + 4) * TPT + d] | ((unsigned)tile[(t0 + 5) * TPT + d] << 16); w.w = (unsigned)tile[(t0 + 6) * TPT + d] | ((unsigned)tile[(t0 + 7) * TPT + d] << 16);
        *(u32x4*)(dst + (size_t)d * T + tile0 + t0) = w; COMPILER_FENCE(); }
}
__device__ __forceinline__ void store8_b16(bf16_t* dst, const u32x4 w) {
    dst[0] = (bf16_t)(w.x & 0xffff); dst[1] = (bf16_t)(w.x >> 16); dst[2] = (bf16_t)(w.y & 0xffff); dst[3] = (bf16_t)(w.y >> 16);
    dst[4] = (bf16_t)(w.z & 0xffff); dst[5] = (bf16_t)(w.z >> 16); dst[6] = (bf16_t)(w.w & 0xffff); dst[7] = (bf16_t)(w.w >> 16);
}
__device__ __forceinline__ void ph_vtrans(const P& p, int l, unsigned char* smem) {
    bf16_t* ka = (bf16_t*)smem; bf16_t* va = ka + 256 * TPK; bf16_t* vr = va + 256 * TPK; bf16_t* kr = vr + 256 * TPT;
    static_assert((2 * 256 * TPK + 2 * 256 * TPT) * 2 <= BAR_LDS_OFF, "transpose unit LDS");
    const int tid = tidx(); bf16_t* PR = WSP(bf16_t, WS_PROJ); const float* tab = WSP(float, WS_ROPE);
    for (int u = blockIdx.x; u < PB * 4 * (T / 256); u += gridDim.x) {
        const int tile = u % (T / 256), bh = u / (T / 256), h = bh & 3, b = bh >> 2; const float lg = ret_lg(h);
        __syncthreads();
#pragma unroll 1
        for (int k = 0; k < 2; ++k) { const int e = tid + NTHR * k, t = e >> 2, d = (e & 3) * 8, tt = tile * 256 + t; bf16_t* row = PR + (size_t)(b * T + tt) * NPROJ + h * 64 + d;
            float x1[8], x2[8], o1[8], o2[8];
            { const float* ct = tab + (size_t)tt * 32 + d; const float* st = ct + (size_t)NPOS * 32;
              const f32x4 c0 = *(const f32x4*)ct, c1 = *(const f32x4*)(ct + 4), s0 = *(const f32x4*)st, s1 = *(const f32x4*)(st + 4);
              unpack8(*(const u32x4*)(row + C_QA), x1); unpack8(*(const u32x4*)(row + C_QA + 32), x2);
#pragma unroll
              for (int i = 0; i < 8; ++i) { const float c = i < 4 ? c0[i & 3] : c1[i & 3], sn = i < 4 ? s0[i & 3] : s1[i & 3]; o1[i] = (x1[i] * c - x2[i] * sn) * (0.125f * LOG2E); o2[i] = (x1[i] * sn + x2[i] * c) * (0.125f * LOG2E); }
              *(u32x4*)(row + C_QA) = pack8f(o1); *(u32x4*)(row + C_QA + 32) = pack8f(o2);
              unpack8(*(const u32x4*)(row + C_KA), x1); unpack8(*(const u32x4*)(row + C_KA + 32), x2);
#pragma unroll
              for (int i = 0; i < 8; ++i) { const float c = i < 4 ? c0[i & 3] : c1[i & 3], sn = i < 4 ? s0[i & 3] : s1[i & 3]; o1[i] = x1[i] * c - x2[i] * sn; o2[i] = x1[i] * sn + x2[i] * c; }
              *(u32x4*)(ka + t * TPK + d) = pack8f(o1); *(u32x4*)(ka + t * TPK + d + 32) = pack8f(o2);
              if (tt >= T - PWIN) { float* o = p.out + O_PWK + (((size_t)l * PB + b) * PWIN + (tt - (T - PWIN))) * 256 + h * 64 + d;
                  *(f32x4*)o = (f32x4){o1[0], o1[1], o1[2], o1[3]}; *(f32x4*)(o + 4) = (f32x4){o1[4], o1[5], o1[6], o1[7]}; *(f32x4*)(o + 32) = (f32x4){o2[0], o2[1], o2[2], o2[3]}; *(f32x4*)(o + 36) = (f32x4){o2[4], o2[5], o2[6], o2[7]}; } }
            COMPILER_FENCE();
            { const float* ct = tab + (size_t)2 * NPOS * 32 + (size_t)tt * 32 + d; const float* st = ct + (size_t)NPOS * 32;
              const f32x4 c0 = *(const f32x4*)ct, c1 = *(const f32x4*)(ct + 4), s0 = *(const f32x4*)st, s1 = *(const f32x4*)(st + 4);
              const float gq = expf(lg * (float)(tt & 63)), gk = 0.125f / gq;
              unpack8(*(const u32x4*)(row + C_QR), x1); unpack8(*(const u32x4*)(row + C_QR + 32), x2);
#pragma unroll
              for (int i = 0; i < 8; ++i) { const float c = i < 4 ? c0[i & 3] : c1[i & 3], sn = i < 4 ? s0[i & 3] : s1[i & 3]; o1[i] = (x1[i] * c - x2[i] * sn) * gq; o2[i] = (x1[i] * sn + x2[i] * c) * gq; }
              *(u32x4*)(row + C_QR) = pack8f(o1); *(u32x4*)(row + C_QR + 32) = pack8f(o2);
              unpack8(*(const u32x4*)(row + C_KR), x1); unpack8(*(const u32x4*)(row + C_KR + 32), x2);
#pragma unroll
              for (int i = 0; i < 8; ++i) { const float c = i < 4 ? c0[i & 3] : c1[i & 3], sn = i < 4 ? s0[i & 3] : s1[i & 3]; o1[i] = (x1[i] * c - x2[i] * sn) * gk; o2[i] = (x1[i] * sn + x2[i] * c) * gk; }
              const u32x4 w1 = pack8f(o1), w2 = pack8f(o2);
              *(u32x4*)(row + C_KR) = w1; *(u32x4*)(row + C_KR + 32) = w2; store8_b16(kr + t * TPT + d, w1); store8_b16(kr + t * TPT + d + 32, w2); }
            COMPILER_FENCE(); }
#pragma unroll
        for (int k = 0; k < 4; ++k) { const int ch = tid + NTHR * k, t = ch >> 3, d8 = (ch & 7) * 8, tt = tile * 256 + t; const bf16_t* src = PR + (size_t)(b * T + tt) * NPROJ + h * 64 + d8;
            const u32x4 wv = *(const u32x4*)(src + C_VA); *(u32x4*)(va + t * TPK + d8) = wv; store8_b16(vr + t * TPT + d8, *(const u32x4*)(src + C_VR));
            if (tt >= T - PWIN) { float v[8]; unpack8(wv, v); float* o = p.out + O_PWV + (((size_t)l * PB + b) * PWIN + (tt - (T - PWIN))) * 256 + h * 64 + d8;
                *(f32x4*)o = (f32x4){v[0], v[1], v[2], v[3]}; *(f32x4*)(o + 4) = (f32x4){v[4], v[5], v[6], v[7]}; }
            COMPILER_FENCE(); }
        __syncthreads();
#pragma unroll
        for (int cls = 0; cls < 3; ++cls) {
            bf16_t* KFc = WSP(bf16_t, WS_KF) + cls * ATT_CLS + (size_t)bh * (T / 32) * 2048; bf16_t* VFc = WSP(bf16_t, WS_VF) + cls * ATT_CLS + (size_t)bh * (T / 32) * 2048;
#pragma unroll 1
            for (int k = 0; k < 4; ++k) { const int f = tid + NTHR * k, lane = f & 63, c31 = lane & 31, hi = lane >> 5;
                { int g, ks, tl, gtile; bool ok = true;
                  if (cls == 0) { ks = (f >> 6) & 3; g = f >> 8; tl = 32 * g + c31; gtile = tile * 8 + g; }
                  else if (cls == 1) { ks = (f >> 6) & 3; g = f >> 8; const int r = g >> 1, st = g & 1; tl = 4 * (32 * st + c31) + r; gtile = r * (T / 128) + tile * 2 + st; }
                  else { const int r = f >> 7, s16 = f & 15, h2 = (f >> 4) & 1; ks = (f >> 5) & 3; tl = 16 * s16 + r; gtile = r * (T / 512) + (tile >> 1); g = 0; (void)ok;
                      const int slot = 16 * (tile & 1) + s16;
                      *(u32x4*)(KFc + ((size_t)gtile * 4 + ks) * 512 + (slot + 32 * h2) * 8) = *(const u32x4*)(ka + tl * TPK + 16 * ks + 8 * h2); }
                  if (cls < 2) { *(u32x4*)(KFc + ((size_t)gtile * 4 + ks) * 512 + lane * 8) = *(const u32x4*)(ka + tl * TPK + 16 * ks + 8 * hi); } }
                { int dt, s2, gtile, r = 0, st = 0, g = 0;
                  if (cls == 0) { s2 = (f >> 6) & 1; dt = (f >> 7) & 1; g = f >> 8; gtile = tile * 8 + g; }
                  else if (cls == 1) { s2 = (f >> 6) & 1; dt = (f >> 7) & 1; g = f >> 8; r = g >> 1; st = g & 1; gtile = r * (T / 128) + tile * 2 + st; }
                  else { dt = (f >> 6) & 1; r = f >> 7; s2 = tile & 1; gtile = r * (T / 512) + (tile >> 1); }
                  unsigned short e8[8];
#pragma unroll
                  for (int jj = 0; jj < 8; ++jj) { const int kk = 16 * s2 + 8 * (jj >> 2) + 4 * hi + (jj & 3);
                      const int tl = cls == 0 ? 32 * g + kk : cls == 1 ? 4 * (32 * st + kk) + r : 16 * (kk & 15) + r;
                      e8[jj] = va[tl * TPK + 32 * dt + c31]; }
                  u32x4 w; w.x = (unsigned)e8[0] | ((unsigned)e8[1] << 16); w.y = (unsigned)e8[2] | ((unsigned)e8[3] << 16); w.z = (unsigned)e8[4] | ((unsigned)e8[5] << 16); w.w = (unsigned)e8[6] | ((unsigned)e8[7] << 16);
                  *(u32x4*)(VFc + ((size_t)gtile * 4 + dt * 2 + s2) * 512 + lane * 8) = w; }
                COMPILER_FENCE(); }
        }
        trans_write(vr, WSP(bf16_t, WS_VRT) + (size_t)bh * 64 * T, tile * 256, tid);
        trans_write(kr, WSP(bf16_t, WS_KRT) + (size_t)bh * 64 * T, tile * 256, tid);
    }
}

__device__ __forceinline__ void ph_ret_local(const P& p, int l) {
    const int tid = tidx(), lane = tid & 63, wave = tid >> 6, x = lane & 15, q = lane >> 4, dt = wave >> 1;
    for (int u = blockIdx.x; u < NUNIT; u += gridDim.x) {
        const int n = u % NCH, bh = u / NCH, h = bh & 3, t0 = n * 64; const float g63 = expf(ret_lg(h) * 63.0f);
        const bf16_t* ka = WSP(bf16_t, WS_KRT) + ((size_t)bh * 64 + 16 * dt + x) * T + t0 + 8 * q;
#pragma unroll
        for (int k = 0; k < 2; ++k) { const int et = 2 * (wave & 1) + k; const bf16_t* vb = WSP(bf16_t, WS_VRT) + ((size_t)bh * 64 + 16 * et + x) * T + t0 + 8 * q;
            f32x4 acc = (f32x4){0.f, 0.f, 0.f, 0.f};
#pragma unroll
            for (int ks = 0; ks < 2; ++ks) acc = MFMA16(*(const bf16x8*)(ka + 32 * ks), *(const bf16x8*)(vb + 32 * ks), acc);
            *(f32x4*)(WSP(float, WS_RU) + (size_t)u * 4096 + (16 * et + x) * 64 + 16 * dt + 4 * q) = acc * g63; }
    }
}
__device__ __forceinline__ void ph_ret_scan(const P& p, int l) {
    const int gt = blockIdx.x * NTHR + tidx(), ng = gridDim.x * NTHR;
    for (int e = gt; e < PB * 4 * 4096; e += ng) {
        const int bh = e >> 12, ed = e & 4095, h = bh & 3; const float cd = expf(ret_lg(h) * 64.0f);
        const float* U = WSP(float, WS_RU) + (size_t)bh * NCH * 4096 + ed; bf16_t* SPv = WSP(bf16_t, WS_RS) + (size_t)bh * NCH * 4096 + ed;
        float s = 0.f;
        for (int n0 = 0; n0 < NCH; n0 += 8) {
            float uv[8];
#pragma unroll
            for (int k = 0; k < 8; ++k) uv[k] = U[(size_t)(n0 + k) * 4096];
#pragma unroll
            for (int k = 0; k < 8; ++k) { SPv[(size_t)(n0 + k) * 4096] = f2bf(s); s = s * cd + uv[k]; } }
        p.out[O_PRET + ((size_t)l * PB * 4 + bh) * 4096 + (ed & 63) * 64 + (ed >> 6)] = s;
    }
}
__device__ __forceinline__ void ph_ret_out(const P& p, int l) {
    const int tid = tidx(), lane = tid & 63, wave = tid >> 6, x = lane & 15, q = lane >> 4, it = UNIFORM(wave & 3);
    const bf16_t* PR = WSP(bf16_t, WS_PROJ);
    for (int u = blockIdx.x * 2 + (wave >> 2); u < NUNIT; u += gridDim.x * 2) {
        const int n = u % NCH, bh = u / NCH, h = bh & 3, b = bh >> 2, t0 = n * 64; const float gam = expf(ret_lg(h));
        const size_t rowi = (size_t)(b * T + t0 + 16 * it + x);
        bf16x8 qf[2];
#pragma unroll
        for (int ks = 0; ks < 2; ++ks) qf[ks] = *(const bf16x8*)(PR + rowi * NPROJ + C_QR + h * 64 + 32 * ks + 8 * q);
        f32x4 at[4];
#pragma unroll
        for (int jt = 0; jt < 4; ++jt) { at[jt] = (f32x4){0.f, 0.f, 0.f, 0.f};
            if (jt <= it) { const bf16_t* kp = PR + (size_t)(b * T + t0 + 16 * jt + x) * NPROJ + C_KR + h * 64 + 8 * q;
#pragma unroll
                for (int ks = 0; ks < 2; ++ks) at[jt] = MFMA16(*(const bf16x8*)(kp + 32 * ks), qf[ks], at[jt]);
                if (jt == it) {
#pragma unroll
                    for (int e = 0; e < 4; ++e) if (4 * q + e > x) at[jt][e] = 0.f; } } }
        const bf16x8 pb0 = pack_tiles(at[0], at[1]), pb1 = pack_tiles(at[2], at[3]);
        f32x4 o[4], os[4];
#pragma unroll
        for (int et = 0; et < 4; ++et) { o[et] = (f32x4){0.f, 0.f, 0.f, 0.f}; os[et] = (f32x4){0.f, 0.f, 0.f, 0.f};
            const bf16_t* vp = WSP(bf16_t, WS_VRT) + ((size_t)bh * 64 + 16 * et + x) * T + t0 + 4 * q;
            { const u32x2 lo = *(const u32x2*)vp, hi = *(const u32x2*)(vp + 16); u32x4 w; w.x = lo.x; w.y = lo.y; w.z = hi.x; w.w = hi.y; o[et] = MFMA16(__builtin_bit_cast(bf16x8, w), pb0, o[et]); }
            if (it >= 2) { const u32x2 lo = *(const u32x2*)(vp + 32), hi = *(const u32x2*)(vp + 48); u32x4 w; w.x = lo.x; w.y = lo.y; w.z = hi.x; w.w = hi.y; o[et] = MFMA16(__builtin_bit_cast(bf16x8, w), pb1, o[et]); }
            const bf16_t* sp = WSP(bf16_t, WS_RS) + (size_t)u * 4096 + (16 * et + x) * 64 + 8 * q;
#pragma unroll
            for (int ks = 0; ks < 2; ++ks) os[et] = MFMA16(*(const bf16x8*)(sp + 32 * ks), qf[ks], os[et]);
            o[et] = o[et] + os[et] * gam; }
        float sq = 0.f;
#pragma unroll
        for (int et = 0; et < 4; ++et) sq += (o[et][0] * o[et][0] + o[et][1] * o[et][1]) + (o[et][2] * o[et][2] + o[et][3] * o[et][3]);
        sq += __shfl_xor(sq, 16); sq += __shfl_xor(sq, 32);
        const float rstd = 1.0f / sqrtf(sq * (1.0f / 64.0f) + EPS);
#pragma unroll
        for (int et = 0; et < 4; ++et) { const int e0 = 16 * et + 4 * q; const u32x2 gw = *(const u32x2*)(PR + rowi * NPROJ + C_GR + h * 64 + e0); const f32x4 nw = *(const f32x4*)(p.ret_norm + l * 64 + e0);
            const float g0 = bf2f((bf16_t)(gw.x & 0xffff)), g1 = bf2f((bf16_t)(gw.x >> 16)), g2 = bf2f((bf16_t)(gw.y & 0xffff)), g3 = bf2f((bf16_t)(gw.y >> 16));
            u32x2 w; w.x = pk2(o[et][0] * rstd * nw[0] * silu_f(g0), o[et][1] * rstd * nw[1] * silu_f(g1)); w.y = pk2(o[et][2] * rstd * nw[2] * silu_f(g2), o[et][3] * rstd * nw[3] * silu_f(g3));
            *(u32x2*)(WSP(bf16_t, WS_O) + rowi * D + 256 + h * 64 + e0) = w; }
    }
}
__device__ __forceinline__ void ph_ret_sample(const P& p, int l, unsigned char* smem) {
    float* S0 = (float*)smem; float* qs = S0 + 4096; float* ks = qs + 8 * 64; float* vs = ks + 8 * 64;
    const int tid = tidx(); const bf16_t* PR = WSP(bf16_t, WS_PROJ);
    for (int u = gridDim.x - 1 - blockIdx.x; u < DB * 4; u += gridDim.x) {
        const int h = u & 3, b = u >> 2; const float lg = ret_lg(h);
        __syncthreads();
        for (int e = tid; e < 4096; e += NTHR) S0[e] = p.state_ret[(((size_t)l * DB + b) * 4 + h) * 4096 + e];
        { const int j = tid >> 6, d = tid & 63; const size_t row = (size_t)(MP + b * DS + j) * NPROJ;
          qs[tid] = bf2f(PR[row + C_QR + h * 64 + d]); ks[tid] = bf2f(PR[row + C_KR + h * 64 + d]); vs[tid] = bf2f(PR[row + C_VR + h * 64 + d]); }
        __syncthreads();
        { const int i = tid >> 6, e = tid & 63; float o = 0.f;
          for (int j = 0; j <= i; ++j) { float a = 0.f; for (int d = 0; d < 64; ++d) a += qs[i * 64 + d] * ks[j * 64 + d]; o += a * expf(lg * (float)(i - j)) * vs[j * 64 + e]; }
          float o2 = 0.f; for (int d = 0; d < 64; ++d) o2 += qs[i * 64 + d] * S0[d * 64 + e];
          o += o2 * expf(lg * (float)(i + 1));
          const float rstd = 1.0f / sqrtf(wave_sum(o * o) * (1.0f / 64.0f) + EPS);
          const size_t row = (size_t)(MP + b * DS + i); const float g = bf2f(PR[row * NPROJ + C_GR + h * 64 + e]);
          WSP(bf16_t, WS_O)[row * D + 256 + h * 64 + e] = f2bf(o * rstd * p.ret_norm[l * 64 + e] * silu_f(g)); }
        for (int x = tid; x < 4096; x += NTHR) { const int d = x >> 6, e = x & 63; float s = S0[x] * expf(lg * (float)DS);
            for (int j = 0; j < DS; ++j) s += ks[j * 64 + d] * expf(lg * (float)(DS - 1 - j)) * vs[j * 64 + e];
            p.out[O_SRET + (((size_t)l * DB + b) * 4 + h) * 4096 + x] = s; }
    }
}

template <int CS, int LDL> __device__ __forceinline__ void fwd_subst(float (&X)[CS], const float* Ls) {
#pragma unroll
    for (int i = 1; i < CS; ++i) {
        float a = X[i];
#pragma unroll
        for (int j4 = 0; j4 < (i + 3) / 4; ++j4) { const f32x4 lv = *(const f32x4*)(Ls + i * LDL + 4 * j4);
#pragma unroll
            for (int e = 0; e < 4; ++e) if (4 * j4 + e < i) a -= lv[e] * X[4 * j4 + e]; }
        X[i] = a;
    }
}
constexpr int QP = 132;
constexpr int WSTP = 136;
constexpr int RWP = 392, TP = 136;
__device__ __forceinline__ void ph_gdn_prep(const P& p, int l, unsigned char* smem) {
    float* Ls = (float*)smem; float* As = Ls + 64 * 68; float* gs = As + 64 * 68; float* gcs = gs + 64; float* bts = gcs + 64; float* part = bts + 64;
    bf16_t* raw = (bf16_t*)(part + 4 * 64); bf16_t* Khi = raw + 67 * RWP; bf16_t* Klo = Khi + 64 * TP; bf16_t* Qb = Klo + 64 * TP;
    static_assert((64 * 68 * 2 + 64 * 3 + 4 * 64) * 4 + (67 * RWP + 3 * 64 * TP) * 2 <= BAR_LDS_OFF, "gdn_prep LDS");
    const int tid = tidx(), lane = tid & 63, wave = tid >> 6; const bf16_t* PR = WSP(bf16_t, WS_PROJ);
    for (int u = blockIdx.x; u < NUNIT; u += gridDim.x) {
        const int n = u % NCH, h = (u / NCH) % 4, b = u / (NCH * 4), t0 = n * 64;
        __syncthreads();
        for (int e = tid; e < 67 * 48; e += NTHR) { const int row = e / 48, ch = e % 48, t = t0 - 3 + row; u32x4 v = (u32x4){0u, 0u, 0u, 0u};
            if (t >= 0) v = *(const u32x4*)(PR + (size_t)(b * T + t) * NPROJ + C_CONV + (ch >> 4) * 512 + h * 128 + (ch & 15) * 8);
            *(u32x4*)(raw + row * RWP + ch * 8) = v; }
        if (tid >= 384 && tid < 448) { const int i = tid - 384; const size_t row = (size_t)(b * T + t0 + i); gs[i] = WSP(float, WS_G)[row * 4 + h]; bts[i] = WSP(float, WS_BETA)[row * 4 + h]; }
        __syncthreads();
        float y[64]; const int sec = tid < 128 ? 2 : tid < 256 ? 1 : 0, c = tid & 127;
        if (tid < 384) { const int col = sec * 512 + h * 128 + c;
            const float w0 = p.conv_w[(l * 4 + 0) * 1536 + col], w1 = p.conv_w[(l * 4 + 1) * 1536 + col], w2 = p.conv_w[(l * 4 + 2) * 1536 + col], w3 = p.conv_w[(l * 4 + 3) * 1536 + col];
            const LAS bf16_t* rp = (const LAS bf16_t*)raw + sec * 128 + c; LAUNDER_V(rp); float x0 = bf2f(rp[0]), x1 = bf2f(rp[RWP]), x2 = bf2f(rp[2 * RWP]);
#pragma unroll
            for (int i = 0; i < 64; ++i) { const float x3 = bf2f(rp[(i + 3) * RWP]); y[i] = silu_fast(w0 * x0 + w1 * x1 + w2 * x2 + w3 * x3); x0 = x1; x1 = x2; x2 = x3; if ((i & 7) == 7) COMPILER_FENCE(); } }
        if (tid >= 448) { if (tid == 448) { float a = 0.f; for (int i = 0; i < 64; ++i) { a += gs[i]; gcs[i] = a; } }
            WAVE_SYNC(); const int i = tid - 448; part[128 + i] = expf(gcs[i]); part[192 + i] = expf(gcs[63] - gcs[i]); }
#pragma unroll
        for (int pass = 0; pass < 2; ++pass) {
            if (tid >= 128 + 128 * pass && tid < 256 + 128 * pass) { LAS float* sq = (LAS float*)Ls + c; LAUNDER_V(sq);
#pragma unroll
                for (int i = 0; i < 64; ++i) sq[i * 132] = y[i] * y[i]; }
            __syncthreads();
            { const int i = tid >> 3, pt = tid & 7; const float* rp2 = Ls + i * 132 + pt * 16; float a = 0.f;
#pragma unroll
              for (int k = 0; k < 16; ++k) a += rp2[k];
              a += __shfl_xor(a, 1); a += __shfl_xor(a, 2); a += __shfl_xor(a, 4);
              if (pt == 0) part[64 * pass + i] = 1.0f / sqrtf(a + EPS); }
            __syncthreads();
        }
        if (tid >= 128 && tid < 256) { LAS bf16_t* kh = (LAS bf16_t*)Khi + c; LAS bf16_t* kl = (LAS bf16_t*)Klo + c; LAUNDER_V(kh); LAUNDER_V(kl);
#pragma unroll
            for (int i = 0; i < 64; ++i) { const float v = y[i] * part[i]; y[i] = v; const bf16_t hb = f2bf(v); kh[i * TP] = hb; kl[i * TP] = f2bf(v - bf2f(hb)); if ((i & 7) == 7) COMPILER_FENCE(); }
            bf16_t* dst = WSP(bf16_t, WS_GWK) + (size_t)u * 16384 + 8192; const int mt = c >> 4, x = c & 15;
#pragma unroll
            for (int ks2 = 0; ks2 < 2; ++ks2)
#pragma unroll
                for (int q = 0; q < 4; ++q) { const int i0 = 32 * ks2 + 4 * q; float v[8];
#pragma unroll
                    for (int e = 0; e < 8; ++e) { const int i = i0 + (e < 4 ? e : 12 + e); v[e] = y[i] * part[192 + i]; }
                    u32x4 w; w.x = pk2(v[0], v[1]); w.y = pk2(v[2], v[3]); w.z = pk2(v[4], v[5]); w.w = pk2(v[6], v[7]);
                    *(u32x4*)(dst + ((size_t)((mt * 2 + ks2) * 64 + q * 16 + x)) * 8) = w; COMPILER_FENCE(); } }
        else if (tid >= 256 && tid < 384) { bf16_t* qg = WSP(bf16_t, WS_GQ) + (size_t)u * 8192 + c; LAS bf16_t* qb = (LAS bf16_t*)Qb + c; LAUNDER_V(qb);
#pragma unroll
            for (int i = 0; i < 64; ++i) { const float v = y[i] * part[64 + i]; qb[i * TP] = f2bf(v); qg[(i & 7) * 128] = f2bf(v * 0.08838834764831845f * part[128 + i]); if ((i & 7) == 7) { qg += 8 * 128; LAUNDER_V(qg); COMPILER_FENCE(); } } }
        __syncthreads();
#pragma unroll
        for (int tp = 0; tp < 2; ++tp) { const int pos = wave * 2 + tp, it = pos >> 2, jt = pos & 3, j16 = lane & 15, qd = lane >> 4;
            f32x4 lk = (f32x4){0.f, 0.f, 0.f, 0.f}, aq = (f32x4){0.f, 0.f, 0.f, 0.f};
            if (jt <= it) {
#pragma unroll
                for (int ks = 0; ks < 4; ++ks) { const int ao = (16 * it + j16) * TP + 32 * ks + 8 * qd, bo = (16 * jt + j16) * TP + 32 * ks + 8 * qd;
                    const bf16x8 ah = *(const bf16x8*)(Khi + ao), al = *(const bf16x8*)(Klo + ao), aqf = *(const bf16x8*)(Qb + ao), bh = *(const bf16x8*)(Khi + bo), bl = *(const bf16x8*)(Klo + bo);
                    lk = MFMA16(ah, bh, lk); lk = MFMA16(ah, bl, lk); lk = MFMA16(al, bh, lk); aq = MFMA16(aqf, bh, aq); } }
            const int j = 16 * jt + j16;
#pragma unroll
            for (int e = 0; e < 4; ++e) { const int i = 16 * it + 4 * qd + e; const float ex = j <= i ? expf(gcs[i] - gcs[j]) : 0.f;
                Ls[i * 68 + j] = j < i ? bts[i] * lk[e] * ex : 0.f; As[i * 68 + j] = aq[e] * ex * 0.08838834764831845f; } }
        __syncthreads();
        if (tid < 256) {
            if (tid < 128) {
#pragma unroll
                for (int i = 0; i < 64; ++i) { y[i] *= bts[i]; if ((i & 15) == 15) COMPILER_FENCE(); } }
            else {
#pragma unroll
                for (int i = 0; i < 64; ++i) { y[i] *= bts[i] * part[128 + i]; if ((i & 15) == 15) COMPILER_FENCE(); } }
            fwd_subst<64, 68>(y, Ls);
            if (tid < 128) { bf16_t* U = WSP(bf16_t, WS_GU) + (size_t)u * 8192 + c * 64;
#pragma unroll
                for (int i8 = 0; i8 < 8; ++i8) { u32x4 w; w.x = pk2(y[8 * i8], y[8 * i8 + 1]); w.y = pk2(y[8 * i8 + 2], y[8 * i8 + 3]); w.z = pk2(y[8 * i8 + 4], y[8 * i8 + 5]); w.w = pk2(y[8 * i8 + 6], y[8 * i8 + 7]); *(u32x4*)(U + 8 * i8) = w; } }
            else { LAS bf16_t* wst = (LAS bf16_t*)raw + c; LAUNDER_V(wst);
#pragma unroll
                for (int i = 0; i < 64; ++i) wst[i * WSTP] = f2bf(-y[i]); }
        } else { const int t2 = tid - 256;
#pragma unroll 2
            for (int e = t2; e < 4096; e += 256) WSP(bf16_t, WS_GA)[(size_t)u * 4096 + e] = f2bf(As[(e >> 6) * 68 + (e & 63)]);
            if (t2 == 0) WSP(float, WS_GD)[u] = expf(gcs[63]); }
        __syncthreads();
        { bf16_t* dst = WSP(bf16_t, WS_GWK) + (size_t)u * 16384; const bf16_t* wst = raw;
#pragma unroll
          for (int k = 0; k < 2; ++k) { const int f = tid + NTHR * k, ln = f & 63, ks4 = (f >> 6) & 3, mt = f >> 8, q = ln >> 4, x = ln & 15;
              const bf16_t* wr = wst + (16 * mt + x) * WSTP + 32 * ks4 + 4 * q;
              u32x4 w; w.x = (unsigned)wr[0] | ((unsigned)wr[1] << 16); w.y = (unsigned)wr[2] | ((unsigned)wr[3] << 16); w.z = (unsigned)wr[16] | ((unsigned)wr[17] << 16); w.w = (unsigned)wr[18] | ((unsigned)wr[19] << 16);
              *(u32x4*)(dst + (size_t)f * 8) = w; } }
    }
}
constexpr int CH_SLOT = 40960, CH_NSLOT = 3;
constexpr int CH_ITEMS = PB * 4 * 2;
static_assert(NCH % 4 == 0, "the chain's loop is unrolled by four chunks");
__device__ __forceinline__ void chain_stage(const bf16_t* WK, const bf16_t* UTh, int m, int pw, int lane, unsigned char* smem) {
    unsigned char* slot = smem + (m % CH_NSLOT) * CH_SLOT;
#pragma unroll
    for (int k = 0; k < 8; ++k) GLDS16((const unsigned char*)(WK + (size_t)m * 16384) + (pw * 8 + k) * 1024 + lane * 16, slot + (pw * 8 + k) * 1024);
#pragma unroll
    for (int k = 0; k < 2; ++k) GLDS16((const unsigned char*)(UTh + (size_t)m * 8192) + (pw * 2 + k) * 1024 + lane * 16, slot + 32768 + (pw * 2 + k) * 1024);
}
__device__ __forceinline__ void ph_gdn_chain(const P& p, int l, unsigned char* smem) {
    const int tid = tidx(), lane = tid & 63, wave = UNIFORM(tid >> 6), j = lane & 15, q = lane >> 4;
    for (int it = blockIdx.x; it < CH_ITEMS; it += gridDim.x) {
        const int half = it & 1, bh = it >> 1;
        const bf16_t* WK = WSP(bf16_t, WS_GWK) + (size_t)bh * NCH * 16384;
        const bf16_t* UTh = WSP(bf16_t, WS_GU) + (size_t)bh * NCH * 8192 + half * 4096;
        __syncthreads();
        if (wave >= 4) {
            const int pw = wave - 4;
            chain_stage(WK, UTh, 0, pw, lane, smem); chain_stage(WK, UTh, 1, pw, lane, smem);
#pragma unroll 1
            for (int n = 0; n < NCH; ++n) {
                if (n + 1 < NCH) WAIT_VM(10); else WAIT_VM(0);
                RAW_BARRIER();
                if (n + 2 < NCH) chain_stage(WK, UTh, n + 2, pw, lane, smem);
            }
        } else {
            const int sl = half * 4 + wave, c = 16 * sl + j;
            f32x4 S[8];
#pragma unroll
            for (int t = 0; t < 8; ++t) S[t] = (f32x4){0.f, 0.f, 0.f, 0.f};
            bf16x8 sB[4];
#pragma unroll
            for (int ks = 0; ks < 4; ++ks) sB[ks] = pack_tiles(S[2 * ks], S[2 * ks + 1]);
            const float* DC = WSP(float, WS_GD) + bh * NCH;
            float db[4];
#pragma unroll
            for (int d = 0; d < 4; ++d) db[d] = DC[d];
#pragma unroll 1
            for (int n0 = 0; n0 < NCH; n0 += 4) {
#pragma unroll
                for (int k4 = 0; k4 < 4; ++k4) {
                    const int n = n0 + k4, u = bh * NCH + n;
                    f32x4 acc[4]; const float dec = db[k4];
                    if (n + 4 < NCH) db[k4] = DC[n + 4];
                    { bf16_t* sp = WSP(bf16_t, WS_GS) + (size_t)u * 16384 + (size_t)sl * 2048 + lane * 4;
#pragma unroll
                      for (int t = 0; t < 8; ++t) { u32x2 w; w.x = pk2(S[t][0], S[t][1]); w.y = pk2(S[t][2], S[t][3]); *(u32x2*)(sp + 256 * t) = w; } }
                    WAIT_LGKM0();
                    RAW_BARRIER();
                    const LAS unsigned char* slot = (const LAS unsigned char*)smem + (n % CH_NSLOT) * CH_SLOT + lane * 16; LAUNDER_V(slot);
                    { const LAS unsigned char* us = (const LAS unsigned char*)smem + (n % CH_NSLOT) * CH_SLOT + 32768 + ((16 * wave + j) * 64 + 4 * q) * 2; LAUNDER_V(us);
#pragma unroll
                      for (int mt = 0; mt < 4; ++mt) { const u32x2 w = *(const LAS u32x2*)(us + 32 * mt); acc[mt] = (f32x4){bf2f((bf16_t)(w.x & 0xffff)), bf2f((bf16_t)(w.x >> 16)), bf2f((bf16_t)(w.y & 0xffff)), bf2f((bf16_t)(w.y >> 16))}; } }
                    bf16x8 fa[8], fb[8];
#pragma unroll
                    for (int i = 0; i < 8; ++i) fa[i] = *(const LAS bf16x8*)(slot + i * 1024);
#pragma unroll
                    for (int i = 0; i < 8; ++i) fb[i] = *(const LAS bf16x8*)(slot + (8 + i) * 1024);
                    COMPILER_FENCE();
#pragma unroll
                    for (int ks = 0; ks < 4; ++ks) { acc[0] = MFMA16(fa[ks], sB[ks], acc[0]); acc[1] = MFMA16(fa[4 + ks], sB[ks], acc[1]); }
                    COMPILER_FENCE();
#pragma unroll
                    for (int i = 0; i < 8; ++i) fa[i] = *(const LAS bf16x8*)(slot + 16384 + i * 1024);
#pragma unroll
                    for (int ks = 0; ks < 4; ++ks) { acc[2] = MFMA16(fb[ks], sB[ks], acc[2]); acc[3] = MFMA16(fb[4 + ks], sB[ks], acc[3]); }
                    COMPILER_FENCE();
#pragma unroll
                    for (int i = 0; i < 8; ++i) fb[i] = *(const LAS bf16x8*)(slot + 16384 + (8 + i) * 1024);
                    { bf16_t* vp = WSP(bf16_t, WS_GV) + (size_t)u * 8192 + (size_t)sl * 1024 + lane * 4;
#pragma unroll
                      for (int mt = 0; mt < 4; ++mt) { u32x2 w; w.x = pk2(acc[mt][0], acc[mt][1]); w.y = pk2(acc[mt][2], acc[mt][3]); *(u32x2*)(vp + 256 * mt) = w; } }
                    const bf16x8 vB0 = pack_tiles(acc[0], acc[1]), vB1 = pack_tiles(acc[2], acc[3]);
#pragma unroll
                    for (int t = 0; t < 8; ++t) S[t] = S[t] * dec;
                    COMPILER_FENCE();
#pragma unroll
                    for (int t = 0; t < 4; ++t) S[t] = MFMA16(fa[2 * t], vB0, S[t]);
#pragma unroll
                    for (int t = 0; t < 4; ++t) S[t] = MFMA16(fa[2 * t + 1], vB1, S[t]);
#pragma unroll
                    for (int t = 0; t < 4; ++t) S[4 + t] = MFMA16(fb[2 * t], vB0, S[4 + t]);
#pragma unroll
                    for (int t = 0; t < 4; ++t) S[4 + t] = MFMA16(fb[2 * t + 1], vB1, S[4 + t]);
                    COMPILER_FENCE();
#pragma unroll
                    for (int ks = 0; ks < 4; ++ks) sB[ks] = pack_tiles(S[2 * ks], S[2 * ks + 1]);
                }
            }
            float* o = p.out + O_PGDN + ((size_t)l * PB * 4 + bh) * 16384 + c;
#pragma unroll
            for (int t = 0; t < 8; ++t)
#pragma unroll
                for (int e = 0; e < 4; ++e) o[(size_t)(16 * t + 4 * q + e) * 128] = S[t][e];
        }
    }
}
__device__ __forceinline__ void ph_gdn_out(const P& p, int l) {
    const int tid = tidx(), lane = tid & 63, wave = tid >> 6, j = lane & 15, q = lane >> 4, mt = wave & 3;
    const bf16_t* PR = WSP(bf16_t, WS_PROJ);
    for (int u = blockIdx.x * 2 + (wave >> 2); u < NUNIT; u += gridDim.x * 2) {
        const int n = u % NCH, h = (u / NCH) % 4, b = u / (NCH * 4);
        f32x4 acc[8];
#pragma unroll
        for (int ct = 0; ct < 8; ++ct) acc[ct] = (f32x4){0.f, 0.f, 0.f, 0.f};
        const bf16_t* qg = WSP(bf16_t, WS_GQ) + (size_t)u * 8192 + (16 * mt + j) * 128 + 8 * q;
        const bf16_t* st = WSP(bf16_t, WS_GS) + (size_t)u * 16384 + (size_t)(q >> 1) * 256 + ((2 * (q & 1)) * 16 + j) * 4;
#pragma unroll
        for (int ks = 0; ks < 4; ++ks) { const bf16x8 a = *(const bf16x8*)(qg + 32 * ks);
#pragma unroll
            for (int ct = 0; ct < 8; ++ct) { const bf16_t* sp = st + (size_t)ct * 2048 + ks * 512; const u32x2 lo = *(const u32x2*)sp, hi = *(const u32x2*)(sp + 64); u32x4 w; w.x = lo.x; w.y = lo.y; w.z = hi.x; w.w = hi.y;
                acc[ct] = MFMA16(a, __builtin_bit_cast(bf16x8, w), acc[ct]); }
            COMPILER_FENCE(); }
        const bf16_t* at = WSP(bf16_t, WS_GA) + (size_t)u * 4096 + (16 * mt + j) * 64 + 8 * q;
        const bf16_t* vt = WSP(bf16_t, WS_GV) + (size_t)u * 8192 + (size_t)(q >> 1) * 256 + ((2 * (q & 1)) * 16 + j) * 4;
#pragma unroll
        for (int ks = 0; ks < 2; ++ks) { const bf16x8 a = *(const bf16x8*)(at + 32 * ks);
#pragma unroll
            for (int ct = 0; ct < 8; ++ct) { const bf16_t* vp = vt + (size_t)ct * 1024 + ks * 512; const u32x2 lo = *(const u32x2*)vp, hi = *(const u32x2*)(vp + 64); u32x4 w; w.x = lo.x; w.y = lo.y; w.z = hi.x; w.w = hi.y;
                acc[ct] = MFMA16(a, __builtin_bit_cast(bf16x8, w), acc[ct]); }
            COMPILER_FENCE(); }
        float sq[4];
#pragma unroll
        for (int e = 0; e < 4; ++e) { float s = 0.f;
#pragma unroll
            for (int ct = 0; ct < 8; ++ct) s += acc[ct][e] * acc[ct][e];
            s += __shfl_xor(s, 1); s += __shfl_xor(s, 2); s += __shfl_xor(s, 4); s += __shfl_xor(s, 8); sq[e] = 1.0f / sqrtf(s * (1.0f / 128.0f) + EPS); }
#pragma unroll
        for (int e = 0; e < 4; ++e) { const size_t row = (size_t)(b * T + n * 64 + 16 * mt + 4 * q + e);
#pragma unroll
            for (int ct = 0; ct < 8; ++ct) { const int c = 16 * ct + j; const float z = bf2f(PR[row * NPROJ + C_Z + h * 128 + c]);
                WSP(bf16_t, WS_O)[row * D + 512 + h * 128 + c] = f2bf(acc[ct][e] * sq[e] * p.gdn_norm[l * 128 + c] * silu_f(z)); } }
    }
}
__device__ __forceinline__ void ph_gdn_sample(const P& p, int l, unsigned char* smem) {
    float* qs = (float*)smem; float* ks = qs + 8 * QP; float* vs = ks + 8 * QP; float* us = vs + 8 * QP; float* wsm = us + 8 * 128; float* vn = wsm + 8 * 128;
    float* Ls = vn + 8 * 128; float* As = Ls + 8 * 8; float* gs = As + 8 * 8; float* gcs = gs + 8; float* bts = gcs + 8; float* S0 = bts + 8;
    const int tid = tidx(); const bf16_t* PR = WSP(bf16_t, WS_PROJ);
    for (int u = gridDim.x - 1 - blockIdx.x; u < DB * 4; u += gridDim.x) {
        const int h = u & 3, b = u >> 2;
        __syncthreads();
#pragma unroll 4
        for (int e = tid; e < 16384; e += NTHR) S0[e] = p.state_gdn[(((size_t)l * DB + b) * 4 + h) * 16384 + e];
        if (tid < 384) { const int sec = tid >> 7, c = tid & 127, col = sec * 512 + h * 128 + c; float* dst = sec == 0 ? qs : sec == 1 ? ks : vs;
            const float w0 = p.conv_w[(l * 4 + 0) * 1536 + col], w1 = p.conv_w[(l * 4 + 1) * 1536 + col], w2 = p.conv_w[(l * 4 + 2) * 1536 + col], w3 = p.conv_w[(l * 4 + 3) * 1536 + col];
            const float* hist = p.state_conv + (((size_t)l * DB + b) * 3) * 1536 + col; const bf16_t* src = PR + (size_t)(MP + b * DS) * NPROJ + C_CONV + col;
            float x0 = hist[0], x1 = hist[1536], x2 = hist[2 * 1536];
            for (int i = 0; i < DS; ++i) { const float x3 = bf2f(src[(size_t)i * NPROJ]); const float y = w0 * x0 + w1 * x1 + w2 * x2 + w3 * x3; dst[i * QP + c] = silu_f(y); x0 = x1; x1 = x2; x2 = x3; } }
        else if (tid < 384 + DS) { const int i = tid - 384; const size_t row = (size_t)(MP + b * DS + i); gs[i] = WSP(float, WS_G)[row * 4 + h]; bts[i] = WSP(float, WS_BETA)[row * 4 + h]; }
        __syncthreads();
        if (tid < 64) { const int rid = tid >> 2, part = tid & 3; float* rowp = (rid < 8 ? qs + rid * QP : ks + (rid - 8) * QP) + part * 32; float s = 0.f;
            for (int d = 0; d < 32; ++d) s += rowp[d] * rowp[d];
            s += __shfl_xor(s, 1); s += __shfl_xor(s, 2); const float sc = 1.0f / sqrtf(s + EPS);
            for (int d = 0; d < 32; ++d) rowp[d] *= sc; }
        if (tid == 64) { float a = 0.f; for (int i = 0; i < DS; ++i) { a += gs[i]; gcs[i] = a; } }
        __syncthreads();
        if (tid < 64) { const int i = tid >> 3, j = tid & 7; float lv = 0.f, av = 0.f;
            if (j <= i) { float dk = 0.f, dq = 0.f; for (int d = 0; d < 128; ++d) { const float kj = ks[j * QP + d]; dk += ks[i * QP + d] * kj; dq += qs[i * QP + d] * kj; }
                const float e = expf(gcs[i] - gcs[j]); av = dq * e * 0.08838834764831845f; lv = j < i ? bts[i] * dk * e : 0.f; }
            Ls[i * 8 + j] = lv; As[i * 8 + j] = av; }
        __syncthreads();
        if (tid < 256) { const int c = tid; float X[8];
            if (c < 128) {
#pragma unroll
                for (int i = 0; i < 8; ++i) X[i] = vs[i * QP + c] * bts[i]; }
            else {
#pragma unroll
                for (int i = 0; i < 8; ++i) X[i] = ks[i * QP + c - 128] * bts[i] * expf(gcs[i]); }
            fwd_subst<8, 8>(X, Ls);
            float* dst = c < 128 ? us + c : wsm + c - 128;
#pragma unroll
            for (int i = 0; i < 8; ++i) dst[i * 128] = X[i]; }
        __syncthreads();
        const int i = tid >> 6, c2 = (tid & 63) * 2;
        { float a0 = us[i * 128 + c2], a1 = us[i * 128 + c2 + 1];
          for (int d = 0; d < 128; ++d) { const float w = wsm[i * 128 + d]; a0 -= w * S0[d * 128 + c2]; a1 -= w * S0[d * 128 + c2 + 1]; }
          vn[i * 128 + c2] = a0; vn[i * 128 + c2 + 1] = a1; }
        __syncthreads();
        { float o0 = 0.f, o1 = 0.f; const float qsc = 0.08838834764831845f * expf(gcs[i]);
          for (int d = 0; d < 128; ++d) { const float qg = qs[i * QP + d] * qsc; o0 += qg * S0[d * 128 + c2]; o1 += qg * S0[d * 128 + c2 + 1]; }
          for (int j = 0; j < DS; ++j) { const float a = As[i * 8 + j]; o0 += a * vn[j * 128 + c2]; o1 += a * vn[j * 128 + c2 + 1]; }
          const float rstd = 1.0f / sqrtf(wave_sum(o0 * o0 + o1 * o1) * (1.0f / 128.0f) + EPS);
          const size_t row = (size_t)(MP + b * DS + i);
          const float z0 = bf2f(PR[row * NPROJ + C_Z + h * 128 + c2]), z1 = bf2f(PR[row * NPROJ + C_Z + h * 128 + c2 + 1]);
          bf16_t* O = WSP(bf16_t, WS_O) + row * D + 512 + h * 128 + c2;
          O[0] = f2bf(o0 * rstd * p.gdn_norm[l * 128 + c2] * silu_f(z0)); O[1] = f2bf(o1 * rstd * p.gdn_norm[l * 128 + c2 + 1] * silu_f(z1)); }
        { const float gl = gcs[DS - 1], dec = expf(gl); float* o = p.out + O_SGDN + (((size_t)l * DB + b) * 4 + h) * 16384;
#pragma unroll 2
          for (int e = tid; e < 16384; e += NTHR) { const int d = e >> 7, c = e & 127; float s = S0[e] * dec;
              for (int j = 0; j < DS; ++j) s += ks[j * QP + d] * expf(gl - gcs[j]) * vn[j * 128 + c];
              o[e] = s; } }
    }
}


template <int K> __device__ __forceinline__ void ph_gemm_small(const P& p, const bf16_t* A  , const bf16_t* Bt  , const float* gate, const float* xs_in  , unsigned char* smem) {
    static_assert(MS % 16 == 0 && K % 256 == 0, "small GEMM shape");
    constexpr int KW = K / 8, NKS = KW / 32;
    const int tid = tidx(), lane = tid & 63, wave = tid >> 6, x = lane & 15, q = lane >> 4;
    float* red = (float*)smem;
    for (int it = blockIdx.x; it < (MS / 16) * 16; it += gridDim.x) {
        const int rt = it % (MS / 16), cg = it / (MS / 16);
        const bf16_t* ap = A + (size_t)(16 * rt + x) * K + wave * KW + 8 * q;
        const bf16_t* bp = Bt + (size_t)(64 * cg + x) * K + wave * KW + 8 * q;
        f32x4 acc[4];
#pragma unroll
        for (int ct = 0; ct < 4; ++ct) acc[ct] = (f32x4){0.f, 0.f, 0.f, 0.f};
#pragma unroll
        for (int ks = 0; ks < NKS; ++ks) { const bf16x8 a = *(const bf16x8*)(ap + 32 * ks);
#pragma unroll
            for (int ct = 0; ct < 4; ++ct) acc[ct] = MFMA16(a, *(const bf16x8*)(bp + (size_t)ct * 16 * K + 32 * ks), acc[ct]); }
        __syncthreads();
#pragma unroll
        for (int ct = 0; ct < 4; ++ct) *(f32x4*)(red + ((wave * 4 + ct) * 64 + lane) * 4) = acc[ct];
        __syncthreads();
        if (wave < 4) { f32x4 s = (f32x4){0.f, 0.f, 0.f, 0.f};
#pragma unroll
            for (int w = 0; w < 8; ++w) s += *(const f32x4*)(red + ((w * 4 + wave) * 64 + lane) * 4);
            const int col = 64 * cg + 16 * wave + x;
#pragma unroll
            for (int e = 0; e < 4; ++e) { const int row = MP + 16 * rt + 4 * q + e; float* xp = p.out + (size_t)row * D + col; const float xin = xs_in ? xs_in[(size_t)(row - MP) * D + col] : *xp; *xp = xin + gate[(size_t)row_cb(row) * 6144 + col] * s[e]; } }
    }
}

__device__ __forceinline__ void ph_final_norm(const P& p) {
    const int lane = tidx() & 63, wave = tidx() >> 6, gw = blockIdx.x * 8 + wave, ngw = gridDim.x * 8;
    for (int r = gw; r < M; r += ngw) {
        float* xr = p.out + (size_t)r * D; f32x4 v[4]; float ss = 0.f;
#pragma unroll
        for (int j = 0; j < 4; ++j) { v[j] = *(const f32x4*)(xr + 4 * lane + 256 * j); ss += (v[j][0] * v[j][0] + v[j][1] * v[j][1]) + (v[j][2] * v[j][2] + v[j][3] * v[j][3]); }
        const float rstd = 1.0f / sqrtf(wave_sum(ss) * (1.0f / D) + EPS);
#pragma unroll
        for (int j = 0; j < 4; ++j) { const f32x4 g = *(const f32x4*)(p.final_norm + 4 * lane + 256 * j); *(f32x4*)(xr + 4 * lane + 256 * j) = v[j] * rstd * g; }
    }
}

enum Phase { PH_PRO = 0, PH_NORM1, PH_GEMM_IN, PH_ROPE, PH_MIX1, PH_MIX2, PH_MIX3, PH_GEMM_OUT, PH_NORM2, PH_GEMM_GU, PH_GEMM_DN, PH_FINAL };
#ifdef __HIP_EMU__
#define LDSP(x) (x)
#else
#define LDSP(x) ((PG8_LAS unsigned char*)(x))
#endif
template <int PH> __device__ __forceinline__ void run_phase(const P& p, int l, unsigned char* smem) {
    if constexpr (PH == PH_PRO) { ph_convert(p, smem); __syncthreads(); ph_adaln(p, smem); ph_ropetab_copyx(p); }
    else if constexpr (PH == PH_NORM1) ph_norm_mod<0>(p, l);
    else if constexpr (PH == PH_GEMM_IN) {
        pg8::Gemm g{WSP(bf16_t, WS_H), WSP(bf16_t, WS_WIN) + (size_t)l * NPROJ * D, MPAD, NPROJ, D}; pg8::StaticOrder S; S.init(MPAD, NPROJ, (int)gridDim.x, (int)blockIdx.x);
        pg8::EpiStoreBf16 E{WSP(bf16_t, WS_PROJ), NPROJ};
        pg8::gemm_phase<pg8::EpiStoreBf16, pg8::StaticOrder, true, true>(LDSP(smem), g, S, E);
    }
    else if constexpr (PH == PH_ROPE) { ph_rope_out(p, l); ph_vtrans(p, l, smem); }
    else if constexpr (PH == PH_MIX1) { ph_attn_jobs(p); ph_ret_local(p, l); ph_gdn_prep(p, l, smem); }
    else if constexpr (PH == PH_MIX2) { ph_gdn_chain(p, l, smem); __syncthreads(); ph_attn_sample(p, l, smem); ph_ret_sample(p, l, smem); ph_gdn_sample(p, l, smem); ph_ret_scan(p, l); ph_attn_combine(p); }
    else if constexpr (PH == PH_MIX3) { ph_ret_out(p, l); ph_gdn_out(p, l); }
    else if constexpr (PH == PH_GEMM_OUT) {
        ph_gemm_small<D>(p, WSP(bf16_t, WS_O) + (size_t)MP * D, WSP(bf16_t, WS_WOUT) + (size_t)l * D * D, WSP(float, WS_MOD) + (size_t)l * NC * 6144 + 2048, l == 0 ? p.x_sample : nullptr, smem); __syncthreads();
        pg8::Gemm g{WSP(bf16_t, WS_O), WSP(bf16_t, WS_WOUT) + (size_t)l * D * D, MP, D, D}; pg8::StaticOrder S; S.init(MP, D, (int)gridDim.x, (int)blockIdx.x);
        pg8::EpiResidual E{p.out, WSP(float, WS_MOD) + (size_t)l * NC * 6144 + 2048, l == 0 ? p.x_prompt : p.out};
        pg8::gemm_phase<pg8::EpiResidual, pg8::StaticOrder, true, true>(LDSP(smem), g, S, E);
    }
    else if constexpr (PH == PH_NORM2) ph_norm_mod<1>(p, l);
    else if constexpr (PH == PH_GEMM_GU) {
        pg8::Gemm g{WSP(bf16_t, WS_H), WSP(bf16_t, WS_WGU) + (size_t)l * 2 * FF * D, MPAD, 2 * FF, D}; pg8::StaticOrder S; S.init(MPAD, 2 * FF, (int)gridDim.x, (int)blockIdx.x);
        pg8::EpiSwiglu E{WSP(bf16_t, WS_HID)};
        pg8::gemm_phase<pg8::EpiSwiglu, pg8::StaticOrder, true, true>(LDSP(smem), g, S, E);
    }
    else if constexpr (PH == PH_GEMM_DN) {
        ph_gemm_small<FF>(p, WSP(bf16_t, WS_HID) + (size_t)MP * FF, WSP(bf16_t, WS_WDN) + (size_t)l * D * FF, WSP(float, WS_MOD) + (size_t)l * NC * 6144 + 5120, nullptr, smem); __syncthreads();
        pg8::Gemm g{WSP(bf16_t, WS_HID), WSP(bf16_t, WS_WDN) + (size_t)l * D * FF, MP, D, FF}; pg8::StaticOrder S; S.init(MP, D, (int)gridDim.x, (int)blockIdx.x);
        pg8::EpiResidual E{p.out, WSP(float, WS_MOD) + (size_t)l * NC * 6144 + 5120, p.out};
        pg8::gemm_phase<pg8::EpiResidual, pg8::StaticOrder, true, true>(LDSP(smem), g, S, E);
    }
    else if constexpr (PH == PH_FINAL) ph_final_norm(p);
}
template <int PH> __global__ void __launch_bounds__(NTHR, 2) k_phase(P p, int l) { DYN_SMEM(smem); run_phase<PH>(p, l, smem); }


#ifndef __HIP_EMU__
#define LAS __attribute__((address_space(3)))
#define XB_TMO      128
#define XB_XCNT(j)  (256  + 64 * (j))
#define XB_XSUB(j)  (1280 + 64 * (j))
#define XB_XGEN(j)  (2304 + 64 * (j))
#define XB_TOP      3328
#define XB_TOPGEN   3392
#define XCD_BAR_WORDS 3456
#define XB_SPIN_CAP (1u << 18)

__device__ __forceinline__ unsigned xb_ld(unsigned* p)              { return __hip_atomic_load(p, __ATOMIC_RELAXED, __HIP_MEMORY_SCOPE_AGENT); }
__device__ __forceinline__ unsigned xb_add(unsigned* p, unsigned v) { return __hip_atomic_fetch_add(p, v, __ATOMIC_RELAXED, __HIP_MEMORY_SCOPE_AGENT); }
__device__ __forceinline__ unsigned xb_xcc_id() { return (unsigned)__builtin_amdgcn_s_getreg((3 << 11) | 20) & 0xFu; }
#define XB_SPIN(cond, bar) do { unsigned _sp = 0; while (cond) { __builtin_amdgcn_s_sleep(1); \
    if ((++_sp & 255u) == 0u) { if (xb_ld(&(bar)[XB_TMO])) break; if (_sp > XB_SPIN_CAP) { atomicAdd(&(bar)[XB_TMO], 1u); break; } } } } while (0)

struct XcdBarrier {
    unsigned* bar; unsigned x;
    volatile LAS unsigned* st;
};

__device__ __forceinline__ XcdBarrier xcd_barrier_post(unsigned* bar, volatile LAS unsigned* st) {
    XcdBarrier b; b.bar = bar; b.x = xb_xcc_id(); b.st = st;
    if (threadIdx.x == 0) (void)xb_add(&bar[XB_XCNT(b.x)], 1u);
    return b;
}
__device__ __forceinline__ void xcd_barrier_complete(unsigned* bar, unsigned x, unsigned& nloc, unsigned& nx) {
    const unsigned G = gridDim.x * gridDim.y * gridDim.z;
    unsigned sum, cnt, mine, sp = 0u;
    for (;;) {
        sum = 0u; cnt = 0u; mine = 0u;
#pragma unroll
        for (unsigned j = 0; j < 16; ++j) { const unsigned c = xb_ld(&bar[XB_XCNT(j)]); sum += c; cnt += (c > 0u) ? 1u : 0u; mine = (j == x) ? c : mine; }
        if (sum == G) break;
        __builtin_amdgcn_s_sleep(1);
        if ((++sp & 255u) == 0u) { if (xb_ld(&bar[XB_TMO])) break; if (sp > XB_SPIN_CAP) { atomicAdd(&bar[XB_TMO], 1u); break; } }
    }
    nloc = mine > 0u ? mine : 1u; nx = cnt > 0u ? cnt : 1u;
}

__device__ __forceinline__ void xcd_barrier(const XcdBarrier& b) {
    asm volatile("s_waitcnt vmcnt(0)" ::: "memory");
    __syncthreads();
    if (threadIdx.x == 0) {
        unsigned* bar = b.bar;
        __builtin_amdgcn_s_waitcnt(0);
        unsigned nloc = b.st[0], nx = b.st[1];
        if (nloc == 0u) { xcd_barrier_complete(bar, b.x, nloc, nx); b.st[0] = nloc; b.st[1] = nx; }
        const unsigned old = xb_add(&bar[XB_XSUB(b.x)], 1u);
        const unsigned gen = old / nloc;
        if (old + 1u == (gen + 1u) * nloc) {
            __builtin_amdgcn_fence(__ATOMIC_RELEASE, "agent");
            asm volatile("s_waitcnt vmcnt(0)" ::: "memory");
            const unsigned og = xb_add(&bar[XB_TOP], 1u);
            const unsigned tg = og / nx;
            if (og + 1u == (tg + 1u) * nx) xb_add(&bar[XB_TOPGEN], 1u);
            else XB_SPIN(xb_ld(&bar[XB_TOPGEN]) == tg, bar);
            __builtin_amdgcn_fence(__ATOMIC_ACQUIRE, "agent");
            xb_add(&bar[XB_XGEN(b.x)], 1u);
            asm volatile("s_waitcnt vmcnt(0)" ::: "memory");
        } else {
            XB_SPIN(xb_ld(&bar[XB_XGEN(b.x)]) == gen, bar);
            __builtin_amdgcn_fence(__ATOMIC_ACQUIRE, "agent");
            asm volatile("s_waitcnt vmcnt(0)" ::: "memory");
        }
    }
    __syncthreads();
}

#endif

#ifndef __HIP_EMU__
#define GRID_SYNC() xcd_barrier(bar)
__global__ void __launch_bounds__(NTHR, 2) k_mega(P p_arg) {
    DYN_SMEM(smem);
#if defined(__HIP_DEVICE_COMPILE__)
#define PHASE(PH_, l_) do { const __attribute__((address_space(4))) P* kp_ = (const __attribute__((address_space(4))) P*)__builtin_amdgcn_kernarg_segment_ptr(); LAUNDER_PTR(kp_); P pl_; __builtin_memcpy(&pl_, kp_, sizeof(P)); run_phase<PH_>(pl_, l_, smem); } while (0)
#else
#define PHASE(PH_, l_) run_phase<PH_>(p_arg, l_, smem)
#endif
    cooperative_groups::grid_group grid = cooperative_groups::this_grid();
    volatile LAS unsigned* bst = (volatile LAS unsigned*)((LAS unsigned char*)smem + BAR_LDS_OFF);
    if (threadIdx.x < 4) bst[threadIdx.x] = 0u;
    __syncthreads();
    XcdBarrier bar = xcd_barrier_post((unsigned*)(p_arg.ws + WS_CTL + 4096), bst);
    PHASE(PH_PRO, 0); grid.sync();
#define LAYER(l) do { PHASE(PH_NORM1, l); GRID_SYNC(); PHASE(PH_GEMM_IN, l); GRID_SYNC(); PHASE(PH_ROPE, l); GRID_SYNC(); PHASE(PH_MIX1, l); GRID_SYNC(); PHASE(PH_MIX2, l); GRID_SYNC(); \
        PHASE(PH_MIX3, l); GRID_SYNC(); PHASE(PH_GEMM_OUT, l); GRID_SYNC(); PHASE(PH_NORM2, l); GRID_SYNC(); PHASE(PH_GEMM_GU, l); GRID_SYNC(); PHASE(PH_GEMM_DN, l); GRID_SYNC(); } while (0)
    static_assert(NL == 2, "two layers written out (a loop over the layers makes hipcc hoist every phase's constants to the loop preheader and spill)");
    LAYER(0); LAYER(1);
    PHASE(PH_FINAL, 0);
}
#endif

template <int PH> static void launch_phase(const P& p, int l, int grid, hipStream_t stream) {
#ifndef __HIP_EMU__
    static bool attr_done = false;
    if (!attr_done) { (void)hipFuncSetAttribute((const void*)k_phase<PH>, hipFuncAttributeMaxDynamicSharedMemorySize, SMEM_BYTES); attr_done = true; }
#endif
    LAUNCH(k_phase<PH>, grid, SMEM_BYTES, stream, p, l);
}

extern "C" void kernel_launch(void* const* d_in, const int* in_sizes, int n_in, void* d_out, int out_size, void* d_ws, size_t ws_size, hipStream_t stream) {
    if (n_in != 24 || (size_t)out_size != O_END || ws_size < WS_END) {
        fprintf(stderr, "kernel_launch: shape mismatch: n_in %d out_size %d (want %zu) ws %zu (want %zu)\n", n_in, out_size, (size_t)O_END, ws_size, (size_t)WS_END); return; }
    P p{};
    const float** pp = (const float**)&p;
    for (int i = 0; i < 24; ++i) pp[i] = (const float*)d_in[i];
    p.out = (float*)d_out; p.ws = (unsigned char*)d_ws;
#ifndef __HIP_EMU__
    static int grid = 0;
    if (grid == 0) {
        int dev = 0, cus = 0, per_cu = 0;
        if (hipGetDevice(&dev) != hipSuccess || hipDeviceGetAttribute(&cus, hipDeviceAttributeMultiprocessorCount, dev) != hipSuccess || cus <= 0) { fprintf(stderr, "kernel_launch: device query failed\n"); grid = -1; return; }
        if (hipFuncSetAttribute((const void*)k_mega, hipFuncAttributeMaxDynamicSharedMemorySize, SMEM_BYTES) != hipSuccess) { fprintf(stderr, "kernel_launch: hipFuncSetAttribute failed\n"); grid = -1; return; }
        if (hipOccupancyMaxActiveBlocksPerMultiprocessor(&per_cu, (const void*)k_mega, NTHR, SMEM_BYTES) != hipSuccess || per_cu < 1) { fprintf(stderr, "kernel_launch: occupancy query says %d blocks per CU\n", per_cu); grid = -1; return; }
        grid = cus;
    }
    if (grid < 0) return;
    if (hipMemsetAsync((char*)d_ws + WS_CTL, 0, 65536, stream) != hipSuccess) { fprintf(stderr, "kernel_launch: memset of the barrier words failed\n"); return; }
    { void* args[] = {(void*)&p};
      hipError_t e = hipLaunchCooperativeKernel((const void*)k_mega, dim3(grid), dim3(NTHR), args, SMEM_BYTES, stream);
      if (e != hipSuccess) fprintf(stderr, "kernel_launch: cooperative launch failed: %s (grid %d)\n", hipGetErrorString(e), grid);
      return; }
#else
    int grid = 16;
#endif
    launch_phase<PH_PRO>(p, 0, grid, stream);
    for (int l = 0; l < NL; ++l) {
        launch_phase<PH_NORM1>(p, l, grid, stream);
        launch_phase<PH_GEMM_IN>(p, l, grid, stream);
        launch_phase<PH_ROPE>(p, l, grid, stream);
        launch_phase<PH_MIX1>(p, l, grid, stream);
        launch_phase<PH_MIX2>(p, l, grid, stream);
        launch_phase<PH_MIX3>(p, l, grid, stream);
        launch_phase<PH_GEMM_OUT>(p, l, grid, stream);
        launch_phase<PH_NORM2>(p, l, grid, stream);
        launch_phase<PH_GEMM_GU>(p, l, grid, stream);
        launch_phase<PH_GEMM_DN>(p, l, grid, stream);
    }
    launch_phase<PH_FINAL>(p, 0, grid, stream);
}
```

```cpp
#ifndef __HIP_EMU__
#include <hip/hip_runtime.h>
#include <hip/hip_cooperative_groups.h>
#endif
#include <cstdio>
#include <cstdint>
#include <cmath>

#ifndef CFG_BATCH
#define CFG_BATCH 2
#endif
#ifndef CFG_SEQ
#define CFG_SEQ 8192
#endif
#ifndef CFG_DB
#define CFG_DB 32
#endif
constexpr float LOG2E = 1.4426950408889634f;
constexpr int D = 1024, NL = 2, PB = CFG_BATCH, T = CFG_SEQ, DB = CFG_DB, DS = 8, PAST = 16384, WB = 2048;
constexpr int MP = PB * T, MS = DB * DS, M = MP + MS, MPAD = (M + 255) / 256 * 256, NC = PB + DB;
constexpr int INC = 3848, NPROJ = 3840, FF = 2816, NCH = T / 64, PWIN = T < 2048 ? T : 2048, NPOS = T + DS;
constexpr int NUNIT = PB * 4 * NCH;
constexpr float EPS = 1e-6f;
static_assert(T % 512 == 0, "the attention job decomposition wants T % 512 == 0");
constexpr int C_QA = 0, C_KA = 256, C_VA = 512, C_QR = 768, C_KR = 1024, C_VR = 1280, C_GR = 1536, C_CONV = 1792, C_Z = 3328;
constexpr int SMEM_BYTES = 147456;
constexpr int NTHR = 512;
constexpr int BAR_LDS_OFF = SMEM_BYTES - 64;

typedef unsigned short bf16_t;
typedef short bf16x8 __attribute__((ext_vector_type(8)));
typedef float f32x4 __attribute__((ext_vector_type(4)));
typedef unsigned u32x4 __attribute__((ext_vector_type(4)));
typedef unsigned u32x2 __attribute__((ext_vector_type(2)));
typedef float f32x16 __attribute__((ext_vector_type(16)));

#ifdef __HIP_EMU__
#define LAUNCH(kern, grid, lds, stream, ...) emu_launch(grid, NTHR, [=]() { kern(__VA_ARGS__); })
#define DYN_SMEM(name) unsigned char* name = emu_dyn_smem()
#define WAVE_SYNC() emu_wave_bar()
#define MFMA32(a, b, c) emu_mfma32(a, b, c)
#define GLDS16(gp, lp) memcpy((unsigned char*)(lp) + (threadIdx.x & 63) * 16, (gp), 16)
#define RAW_BARRIER() __syncthreads()
#define GLDS4(gp, lp) ((void)0)
#define WAIT_VM(n)
#define WAIT_LGKM0()
#define LAS
#define UNIFORM(x) (x)
#define COMPILER_FENCE()
#define LAUNDER_V(x)
#define MFMA16(a, b, c) emu_mfma16(a, b, c)
#else
#define WAVE_SYNC() asm volatile("s_waitcnt lgkmcnt(0)" ::: "memory")
#define MFMA32(a, b, c) __builtin_amdgcn_mfma_f32_32x32x16_bf16(a, b, c, 0, 0, 0)
#define LAS __attribute__((address_space(3)))
#define GLDS16(gp, lp) __builtin_amdgcn_global_load_lds((const unsigned*)(gp), (LAS unsigned*)(lp), 16, 0, 0)
#define RAW_BARRIER() __builtin_amdgcn_s_barrier()
#define GLDS4(gp, lp) __builtin_amdgcn_global_load_lds((const unsigned*)(gp), (LAS unsigned*)(lp), 4, 0, 0)
#define WAIT_VM(n) asm volatile("s_waitcnt vmcnt(" #n ")" ::: "memory")
#define WAIT_LGKM0() asm volatile("s_waitcnt lgkmcnt(0)" ::: "memory")
#define UNIFORM(x) __builtin_amdgcn_readfirstlane(x)
#define COMPILER_FENCE() __builtin_amdgcn_sched_barrier(0)
#define LAUNDER_V(x) asm volatile("" : "+v"(x))
#define MFMA16(a, b, c) __builtin_amdgcn_mfma_f32_16x16x32_bf16(a, b, c, 0, 0, 0)
#define LAUNCH(kern, grid, lds, stream, ...) hipLaunchKernelGGL(kern, dim3(grid), dim3(NTHR), lds, stream, __VA_ARGS__)
#define DYN_SMEM(name) extern __shared__ __attribute__((aligned(16))) unsigned char name[]
#endif

#ifdef __HIP_EMU__
__device__ __forceinline__ int tidx() { return (int)threadIdx.x; }
#define LAUNDER_PTR(x)
#else
__device__ __forceinline__ int tidx() { int t = (int)threadIdx.x; asm volatile("" : "+v"(t)); return t; }
#define LAUNDER_PTR(x) asm volatile("" : "+s"(x))
#endif
__device__ __forceinline__ float bf2f(bf16_t v) { return __builtin_bit_cast(float, (unsigned)v << 16); }
__device__ __forceinline__ bf16_t f2bf(float f) { unsigned u = __builtin_bit_cast(unsigned, f); return (bf16_t)((u + 0x7fffu + ((u >> 16) & 1u)) >> 16); }
#ifdef __HIP_EMU__
__device__ __forceinline__ unsigned pk2(float lo, float hi) { return (unsigned)f2bf(lo) | ((unsigned)f2bf(hi) << 16); }
#else
typedef float f32x2_t __attribute__((ext_vector_type(2))); typedef __bf16 bf16x2_t __attribute__((ext_vector_type(2)));
__device__ __forceinline__ unsigned pk2(float lo, float hi) { f32x2_t v = {lo, hi}; bf16x2_t b = __builtin_convertvector(v, bf16x2_t); return __builtin_bit_cast(unsigned, b); }
#endif
__device__ __forceinline__ bf16x8 pack_tiles(const f32x4& lo, const f32x4& hi) {
    u32x4 w; w.x = pk2(lo[0], lo[1]); w.y = pk2(lo[2], lo[3]); w.z = pk2(hi[0], hi[1]); w.w = pk2(hi[2], hi[3]); return __builtin_bit_cast(bf16x8, w);
}
__device__ __forceinline__ float silu_f(float x) { return x / (1.0f + expf(-x)); }
#ifdef __HIP_EMU__
__device__ __forceinline__ float silu_fast(float x) { return x / (1.0f + expf(-x)); }
#else
__device__ __forceinline__ float silu_fast(float x) { return x * __builtin_amdgcn_rcpf(1.0f + __builtin_amdgcn_exp2f(-LOG2E * x)); }
#endif
__device__ __forceinline__ float wave_sum(float v) {
#pragma unroll
    for (int o = 1; o < 64; o <<= 1) v += __shfl_xor(v, o);
    return v;
}
__device__ __forceinline__ float wave_max(float v) {
#pragma unroll
    for (int o = 1; o < 64; o <<= 1) v = fmaxf(v, __shfl_xor(v, o));
    return v;
}

struct P {
    const float *x_prompt, *x_sample, *cache_k, *cache_v, *state_ret, *state_gdn, *state_conv, *c_prompt, *c_sample, *ada_w, *ada_b, *norm_mix, *norm_ffn,
        *w_in, *ret_norm, *conv_w, *a_log, *dt_bias, *gdn_norm, *w_out, *w_gate, *w_up, *w_down, *final_norm;
    float* out; unsigned char* ws;
};

constexpr size_t O_YP = 0, O_YS = O_YP + (size_t)MP * D, O_PWK = O_YS + (size_t)MS * D, O_PWV = O_PWK + (size_t)NL * PB * PWIN * 256,
                 O_PRET = O_PWV + (size_t)NL * PB * PWIN * 256, O_PGDN = O_PRET + (size_t)NL * PB * 4 * 4096, O_PCONV = O_PGDN + (size_t)NL * PB * 4 * 16384,
                 O_SWK = O_PCONV + (size_t)NL * PB * 3 * 1536, O_SWV = O_SWK + (size_t)NL * DB * DS * 256, O_SRET = O_SWV + (size_t)NL * DB * DS * 256,
                 O_SGDN = O_SRET + (size_t)NL * DB * 4 * 4096, O_SCONV = O_SGDN + (size_t)NL * DB * 4 * 16384, O_END = O_SCONV + (size_t)NL * DB * 3 * 1536;

constexpr size_t al256(size_t x) { return (x + 255) / 256 * 256; }
constexpr size_t WS_CTL = 0, WS_CTL_BYTES = 1u << 20;
constexpr size_t WS_MOD = WS_CTL + WS_CTL_BYTES;
constexpr size_t WS_W8 = al256(WS_MOD + (size_t)NL * NC * 6144 * 4);
constexpr size_t WS_ROPE = al256(WS_W8 + (size_t)NL * D * 8 * 4);
constexpr size_t WS_WIN = al256(WS_ROPE + (size_t)4 * NPOS * 32 * 4);
constexpr size_t WS_WOUT = al256(WS_WIN + (size_t)NL * NPROJ * D * 2);
constexpr size_t WS_WGU = al256(WS_WOUT + (size_t)NL * D * D * 2);
constexpr size_t WS_WDN = al256(WS_WGU + (size_t)NL * 2 * FF * D * 2);
constexpr size_t WS_H = al256(WS_WDN + (size_t)NL * D * FF * 2);
constexpr size_t WS_PROJ = al256(WS_H + (size_t)MPAD * D * 2);
constexpr size_t WS_BETA = al256(WS_PROJ + (size_t)MPAD * NPROJ * 2);
constexpr size_t WS_G = al256(WS_BETA + (size_t)M * 4 * 4);
constexpr size_t WS_O = al256(WS_G + (size_t)M * 4 * 4);
constexpr size_t WS_RU = al256(WS_O + (size_t)MPAD * D * 2);
constexpr size_t WS_RS = al256(WS_RU + (size_t)NUNIT * 4096 * 4);
constexpr size_t WS_SCR = al256(WS_RS + (size_t)NUNIT * 4096 * 4);
constexpr size_t WS_GU = WS_SCR;
constexpr size_t WS_GWK = al256(WS_GU + (size_t)NUNIT * 8192 * 2);
constexpr size_t WS_GQ = al256(WS_GWK + (size_t)NUNIT * 16384 * 2);
constexpr size_t WS_GA = al256(WS_GQ + (size_t)NUNIT * 8192 * 2);
constexpr size_t WS_GD = al256(WS_GA + (size_t)NUNIT * 4096 * 2);
constexpr size_t WS_GV = al256(WS_GD + (size_t)NUNIT * 4);
constexpr size_t WS_GS = al256(WS_GV + (size_t)NUNIT * 8192 * 2);
constexpr size_t WS_GEND = al256(WS_GS + (size_t)NUNIT * 16384 * 2);
constexpr size_t ATT_CLS = (size_t)PB * 4 * (T / 32) * 2048;
constexpr size_t WS_KF = WS_GEND;
constexpr size_t WS_VF = al256(WS_KF + 3 * ATT_CLS * 2);
constexpr size_t WS_KRT = al256(WS_VF + 3 * ATT_CLS * 2);
constexpr size_t WS_VRT = al256(WS_KRT + (size_t)MP * 256 * 2);
constexpr size_t WS_AML = al256(WS_VRT + (size_t)MP * 256 * 2);
constexpr size_t WS_AEND = al256(WS_AML + (size_t)MP * 4 * 3 * 2 * 4);
constexpr size_t WS_APO = WS_H;
static_assert((size_t)MP * 4 * 3 * 64 * 2 <= (size_t)MPAD * D * 2, "attention partials overlay H");
constexpr size_t WS_HID = WS_SCR;
constexpr size_t WS_HEND = al256(WS_HID + (size_t)MPAD * FF * 2);
constexpr size_t WS_END = WS_AEND > WS_HEND ? WS_AEND : WS_HEND;

#define WSP(T_, off) ((T_*)(p.ws + (off)))
__device__ __forceinline__ int row_cb(int r) { return r < MP ? r / T : PB + (r - MP) / DS; }
__device__ __forceinline__ int row_pi(int r) { return r < MP ? r % T : T + (r - MP) % DS; }
namespace pg8 {
#ifdef __HIP_EMU__
#define PG8_LAS
#else
#define PG8_LAS __attribute__((address_space(3)))
#endif
typedef unsigned short bf16_t;
typedef short bf16x8 __attribute__((ext_vector_type(8)));
typedef float f32x4 __attribute__((ext_vector_type(4)));
typedef unsigned u32x4 __attribute__((ext_vector_type(4)));
constexpr int BM = 256, BK = 64, HALF = 128, HTB = HALF * BK * 2  , STAGE_BYTES = 8 * HTB, NXCD = 8, WGM = 8;

__host__ __device__ __forceinline__ int lds_byte(int r, int c) { const int st = (r >> 4) * 2 + (c >> 5), rr = r & 15, cc = c & 31, ob = rr * 64 + cc * 2; return st * 1024 + (ob ^ (((ob >> 9) & 1) << 5)); }
__host__ __device__ __forceinline__ void stage_rc(int b, int& R, int& C) { const int st = b / 1024, sb = b % 1024, swz = sb ^ (((sb >> 9) & 1) << 5); R = (st >> 1) * 16 + swz / 64; C = (st & 1) * 32 + (swz % 64) / 2; }
__host__ __device__ __forceinline__ int perm32(int rho) { const int n = rho >> 4, i = rho & 15; return 8 * (i >> 2) + 4 * n + (i & 3); }

struct Unit { int pm, pn; };
struct Gemm { const bf16_t* A; const bf16_t* Bt; int M, N, K; };

struct StaticOrder {
    int nM, nN, nwg, G, c;
    __host__ __device__ void init(int M, int N, int G_, int c_) { nM = M / BM; nN = N / BM; nwg = nM * nN; G = G_; c = c_; }
    __host__ __device__ bool next(int i, Unit& u) const {
        const long L = (long)i * G + c; if (L >= nwg) return false;
        int wgid = (int)L; { const int q = nwg / NXCD, r = nwg % NXCD, xcd = wgid % NXCD, off = wgid / NXCD; wgid = (xcd < r ? xcd * (q + 1) : r * (q + 1) + (xcd - r) * q) + off; }
        const int nig = WGM * nN, gid = wgid / nig, fm = gid * WGM, gsz = (nM - fm) < WGM ? (nM - fm) : WGM;
        u.pm = fm + ((wgid % nig) % gsz); u.pn = (wgid % nig) / gsz; return true;
    }
    __device__ __forceinline__ void a_ready(const Unit&) const {}
    __device__ __forceinline__ void done(const Unit&) const {}
};


struct EpiStoreBf16 {
    static constexpr bool PERM = true, AFTER_DRAIN = false;
    bf16_t* O; int ldc;
    __device__ __forceinline__ void operator()(const f32x4 (&acc)[2][2][4][2], const Unit& u, int wr, int wc, int fr, int fq) const {
        const int row0 = u.pm * BM + wr * 64 + fr, col0 = u.pn * BM + wc * 32 + 8 * fq;
#pragma unroll
        for (int ai = 0; ai < 2; ++ai)
#pragma unroll
            for (int m = 0; m < 4; ++m) { bf16_t* rowp = O + (size_t)(row0 + ai * HALF + m * 16) * ldc + col0;
#pragma unroll
                for (int bj = 0; bj < 2; ++bj) { const f32x4 v0 = acc[ai][bj][m][0], v1 = acc[ai][bj][m][1];
                    u32x4 w; w.x = ::pk2(v0[0], v0[1]); w.y = ::pk2(v0[2], v0[3]); w.z = ::pk2(v1[0], v1[1]); w.w = ::pk2(v1[2], v1[3]);
                    *(u32x4*)(rowp + bj * HALF) = w; } }
    }
};
struct EpiResidual {
    static constexpr bool PERM = false, AFTER_DRAIN = false;
    float* X; const float* gate; const float* Xin;
    __device__ __forceinline__ void operator()(const f32x4 (&acc)[2][2][4][2], const Unit& u, int wr, int wc, int fr, int fq) const {
        const int row0 = u.pm * BM + wr * 64 + fr, col0 = u.pn * BM + wc * 32 + 4 * fq;
#pragma unroll
        for (int ai = 0; ai < 2; ++ai)
#pragma unroll
            for (int m = 0; m < 4; ++m) { const int row = row0 + ai * HALF + m * 16;
                if (MPAD != M && row >= M) continue;
                const float* g = gate + (size_t)::row_cb(row) * 6144 + col0; float* xp = X + (size_t)row * D + col0; const float* xi = Xin + (size_t)row * D + col0;
#pragma unroll
                for (int bj = 0; bj < 2; ++bj)
#pragma unroll
                    for (int n = 0; n < 2; ++n) { const f32x4 gv = *(const f32x4*)(g + bj * HALF + n * 16); f32x4* xq = (f32x4*)(xp + bj * HALF + n * 16); *xq = *(const f32x4*)(xi + bj * HALF + n * 16) + gv * acc[ai][bj][m][n]; } }
    }
};
struct EpiSwiglu {
    static constexpr bool PERM = true, AFTER_DRAIN = false;
    bf16_t* Hd;
    __device__ __forceinline__ void operator()(const f32x4 (&acc)[2][2][4][2], const Unit& u, int wr, int wc, int fr, int fq) const {
        const int row0 = u.pm * BM + wr * 64 + fr, col0 = u.pn * HALF + wc * 32 + 8 * fq;
#pragma unroll
        for (int ai = 0; ai < 2; ++ai)
#pragma unroll
            for (int m = 0; m < 4; ++m) { bf16_t* rowp = Hd + (size_t)(row0 + ai * HALF + m * 16) * FF + col0;
                float v[8];
#pragma unroll
                for (int n = 0; n < 2; ++n)
#pragma unroll
                    for (int j = 0; j < 4; ++j) { const float gt = acc[ai][0][m][n][j], up = acc[ai][1][m][n][j]; v[4 * n + j] = ::silu_f(gt) * up; }
                u32x4 w; w.x = ::pk2(v[0], v[1]); w.y = ::pk2(v[2], v[3]); w.z = ::pk2(v[4], v[5]); w.w = ::pk2(v[6], v[7]);
                *(u32x4*)rowp = w; }
    }
};

#ifdef __HIP_EMU__
template <class Epi, class Sched, bool ALIGN_EPI = false, bool SP2 = false>
__device__ __forceinline__ void gemm_phase(unsigned char* lds, const Gemm g, const Sched& S, const Epi& E) {
    const int tid = threadIdx.x, wid = tid >> 6, lane = tid & 63, wr = wid >> 2, wc = wid & 3, fr = lane & 15, fq = lane >> 4;
    Unit cur;
    for (int ui = 0; S.next(ui, cur); ++ui) {
        f32x4 acc[2][2][4][2];
        for (int ai = 0; ai < 2; ++ai) for (int bj = 0; bj < 2; ++bj) for (int m = 0; m < 4; ++m) for (int n = 0; n < 2; ++n) for (int j = 0; j < 4; ++j) {
            const int row = 256 * cur.pm + 128 * ai + 64 * wr + 16 * m + fr;
            const int col = Epi::PERM ? 256 * cur.pn + 128 * bj + 32 * wc + 8 * fq + 4 * n + j : 256 * cur.pn + 128 * bj + 32 * wc + 16 * n + 4 * fq + j;
            const bf16_t* a = g.A + (size_t)row * g.K; const bf16_t* b = g.Bt + (size_t)col * g.K; float s = 0.f;
            for (int k = 0; k < g.K; ++k) s += ::bf2f(a[k]) * ::bf2f(b[k]);
            acc[ai][bj][m][n][j] = s; }
        E(acc, cur, wr, wc, fr, fq);
    }
}
#else
template <class Epi, class Sched, bool ALIGN_EPI = false, bool SP2 = false>
__device__ __forceinline__ void gemm_phase(PG8_LAS unsigned char* lds, const Gemm g, const Sched& S, const Epi& E) {
    const int tid = ::tidx(), wid = __builtin_amdgcn_readfirstlane(tid >> 6), lane = tid & 63, wr = wid >> 2, wc = wid & 3, fr = lane & 15, fq = lane >> 4;
    const int K = g.K, nt = K / BK;
    unsigned voffA[2], voffB[2];
#pragma unroll
    for (int i = 0; i < 2; ++i) { int R, C; stage_rc(tid * 16 + i * 8192, R, C); const int Rb = Epi::PERM ? ((R & ~31) + perm32(R & 31)) : R;
        voffA[i] = (unsigned)(R * K + C) * 2u; voffB[i] = (unsigned)(Rb * K + C) * 2u; }
    const size_t kstep = (size_t)(BK * 2);
    const size_t hstep = (size_t)HALF * K * 2;
    const size_t tstep = 2 * hstep;
    const unsigned ldsw = (unsigned)wid * 1024u;
    const int aoff = lds_byte(wr * 64 + fr, fq * 8), boff = lds_byte(wc * 32 + fr, fq * 8);
#define PG8_SA(b, h) (((b) * 2 + (h)) * HTB)
#define PG8_SB(b, h) ((4 + (b) * 2 + (h)) * HTB)
#define PG8_STAGE(bufoff, gbase, voff) do { _Pragma("unroll") for (int _i = 0; _i < 2; ++_i) \
        __builtin_amdgcn_global_load_lds((const unsigned*)((const char*)(gbase) + (voff)[_i]), (PG8_LAS unsigned*)(lds + (bufoff) + ldsw + _i * 8192), 16, 0, 0); } while (0)
#define PG8_LDA(dst, b, h) do { _Pragma("unroll") for (int m = 0; m < 4; ++m) _Pragma("unroll") for (int k = 0; k < 2; ++k) dst[m][k] = *(const PG8_LAS bf16x8*)(lds + PG8_SA(b, h) + aoff + m * 2048 + k * 1024); } while (0)
#define PG8_LDB(dst, b, h) do { _Pragma("unroll") for (int n = 0; n < 2; ++n) _Pragma("unroll") for (int k = 0; k < 2; ++k) dst[n][k] = *(const PG8_LAS bf16x8*)(lds + PG8_SB(b, h) + boff + n * 2048 + k * 1024); } while (0)
#define PG8_MMA(ai, bj, At, Bt) do { __builtin_amdgcn_s_setprio(1); _Pragma("unroll") for (int m = 0; m < 4; ++m) _Pragma("unroll") for (int n = 0; n < 2; ++n) _Pragma("unroll") for (int k = 0; k < 2; ++k) \
        acc[ai][bj][m][n] = __builtin_amdgcn_mfma_f32_16x16x32_bf16(Bt[n][k], At[m][k], acc[ai][bj][m][n], 0, 0, 0); __builtin_amdgcn_s_setprio(0); } while (0)
#define PG8_WAIT_V(n) asm volatile("s_waitcnt vmcnt(" #n ")" ::: "memory")
#define PG8_WAIT_L(n) asm volatile("s_waitcnt lgkmcnt(" #n ")" ::: "memory")
#define PG8_BAR __builtin_amdgcn_s_barrier()
#define PG8_SCHED __builtin_amdgcn_sched_barrier(0)
    Unit cur, nxt; int ui = 0;
    if (!S.next(0, cur)) return;
    f32x4 acc[2][2][4][2];
#pragma unroll
    for (int a = 0; a < 2; ++a)
#pragma unroll
        for (int b = 0; b < 2; ++b)
#pragma unroll
            for (int m = 0; m < 4; ++m)
#pragma unroll
                for (int n = 0; n < 2; ++n) acc[a][b][m][n] = (f32x4){0.f, 0.f, 0.f, 0.f};
    bf16x8 At[4][2], B0[2][2], B1[2][2];
    const char* cA = (const char*)g.A + (size_t)cur.pm * tstep; const char* cB = (const char*)g.Bt + (size_t)cur.pn * tstep;
    S.a_ready(cur);
    if constexpr (SP2) {
        PG8_STAGE(PG8_SB(0, 0), cB, voffB); PG8_STAGE(PG8_SB(0, 1), cB + hstep, voffB); PG8_STAGE(PG8_SA(0, 0), cA, voffA); PG8_STAGE(PG8_SA(0, 1), cA + hstep, voffA);
        if (wr == 1) PG8_BAR;
        PG8_WAIT_V(2); PG8_BAR;
        PG8_STAGE(PG8_SB(1, 0), cB + kstep, voffB); PG8_STAGE(PG8_SA(1, 0), cA + kstep, voffA); PG8_STAGE(PG8_SB(1, 1), cB + hstep + kstep, voffB);
        PG8_WAIT_V(6); PG8_BAR;
    } else {
        PG8_STAGE(PG8_SB(0, 0), cB, voffB); PG8_STAGE(PG8_SA(0, 0), cA, voffA); PG8_STAGE(PG8_SB(0, 1), cB + hstep, voffB); PG8_STAGE(PG8_SA(0, 1), cA + hstep, voffA);
        if (wr == 1) PG8_BAR;
        PG8_WAIT_V(4); PG8_BAR;
        PG8_STAGE(PG8_SB(1, 0), cB + kstep, voffB); PG8_STAGE(PG8_SA(1, 0), cA + kstep, voffA); PG8_STAGE(PG8_SB(1, 1), cB + hstep + kstep, voffB);
        PG8_WAIT_V(6); PG8_BAR;
    }
    for (;;) {
        const bool has_next = S.next(ui + 1, nxt);
        const char* nA = has_next ? (const char*)g.A + (size_t)nxt.pm * tstep : cA; const char* nB = has_next ? (const char*)g.Bt + (size_t)nxt.pn * tstep : cB;
        for (int t = 0; t < nt; t += 2) {
            const bool last = (t == nt - 2);
            const char* a1 = cA + (size_t)(t + 1) * kstep;
            const char* a2 = last ? nA : cA + (size_t)(t + 2) * kstep; const char* b2 = last ? nB : cB + (size_t)(t + 2) * kstep;
            const char* a3 = a2 + kstep; const char* b3 = b2 + kstep;
            if (last && has_next) S.a_ready(nxt);
            if constexpr (SP2) {
            PG8_LDB(B0, 0, 0); PG8_LDB(B1, 0, 1); PG8_SCHED; PG8_LDA(At, 0, 0); PG8_STAGE(PG8_SA(1, 1), a1 + hstep, voffA);
            PG8_WAIT_V(8); PG8_WAIT_L(0); PG8_BAR; PG8_MMA(0, 0, At, B0); PG8_MMA(0, 1, At, B1); PG8_BAR; PG8_SCHED;
            PG8_LDA(At, 0, 1); PG8_STAGE(PG8_SB(0, 0), b2, voffB); PG8_STAGE(PG8_SB(0, 1), b2 + hstep, voffB); PG8_STAGE(PG8_SA(0, 0), a2, voffA);
            PG8_WAIT_V(8); PG8_WAIT_L(0); PG8_BAR; PG8_MMA(1, 0, At, B0); PG8_MMA(1, 1, At, B1); PG8_BAR; PG8_SCHED;
            PG8_LDB(B0, 1, 0); PG8_LDB(B1, 1, 1); PG8_SCHED; PG8_LDA(At, 1, 0); PG8_STAGE(PG8_SA(0, 1), a2 + hstep, voffA);
            PG8_WAIT_V(8); PG8_WAIT_L(0); PG8_BAR; PG8_MMA(0, 0, At, B0); PG8_MMA(0, 1, At, B1); PG8_BAR; PG8_SCHED;
            PG8_LDA(At, 1, 1); PG8_STAGE(PG8_SB(1, 0), b3, voffB); PG8_STAGE(PG8_SB(1, 1), b3 + hstep, voffB); PG8_STAGE(PG8_SA(1, 0), a3, voffA);
            PG8_WAIT_V(8); PG8_WAIT_L(0); PG8_BAR; PG8_MMA(1, 0, At, B0); PG8_MMA(1, 1, At, B1); PG8_BAR; PG8_SCHED;
            } else {
            PG8_LDB(B0, 0, 0); PG8_SCHED; PG8_LDA(At, 0, 0); PG8_STAGE(PG8_SA(1, 1), a1 + hstep, voffA);
            PG8_WAIT_L(8); PG8_BAR; PG8_WAIT_L(0); PG8_MMA(0, 0, At, B0); PG8_BAR; PG8_SCHED;
            PG8_LDB(B1, 0, 1); PG8_STAGE(PG8_SB(0, 0), b2, voffB);
            PG8_BAR; PG8_WAIT_L(0); PG8_MMA(0, 1, At, B1); PG8_BAR;
            PG8_LDA(At, 0, 1); PG8_STAGE(PG8_SA(0, 0), a2, voffA);
            PG8_BAR; PG8_WAIT_L(0); PG8_MMA(1, 0, At, B0); PG8_BAR; PG8_SCHED;
            PG8_STAGE(PG8_SB(0, 1), b2 + hstep, voffB);
            PG8_WAIT_V(6); PG8_BAR; PG8_MMA(1, 1, At, B1); PG8_BAR;
            PG8_LDB(B0, 1, 0); PG8_SCHED; PG8_LDA(At, 1, 0); PG8_STAGE(PG8_SA(0, 1), a2 + hstep, voffA);
            PG8_WAIT_L(8); PG8_BAR; PG8_WAIT_L(0); PG8_MMA(0, 0, At, B0); PG8_BAR; PG8_SCHED;
            PG8_LDB(B1, 1, 1); PG8_STAGE(PG8_SB(1, 0), b3, voffB);
            PG8_BAR; PG8_WAIT_L(0); PG8_MMA(0, 1, At, B1); PG8_BAR;
            PG8_LDA(At, 1, 1); PG8_STAGE(PG8_SA(1, 0), a3, voffA);
            PG8_BAR; PG8_WAIT_L(0); PG8_MMA(1, 0, At, B0); PG8_BAR; PG8_SCHED;
            PG8_STAGE(PG8_SB(1, 1), b3 + hstep, voffB);
            PG8_WAIT_V(6); PG8_BAR; PG8_MMA(1, 1, At, B1); PG8_BAR;
            }
        }
        if constexpr (ALIGN_EPI) { if (wr == 0) PG8_BAR; }
        if constexpr (!Epi::AFTER_DRAIN) { E(acc, cur, wr, wc, fr, fq); S.done(cur); }
        if (!has_next) break;
#pragma unroll
        for (int a = 0; a < 2; ++a)
#pragma unroll
            for (int b = 0; b < 2; ++b)
#pragma unroll
                for (int m = 0; m < 4; ++m)
#pragma unroll
                    for (int n = 0; n < 2; ++n) acc[a][b][m][n] = (f32x4){0.f, 0.f, 0.f, 0.f};
        cur = nxt; cA = nA; cB = nB; ++ui;
        if constexpr (ALIGN_EPI) { if (wr == 1) PG8_BAR; }
    }
    PG8_WAIT_V(0);
    if constexpr (!ALIGN_EPI) { if (wr == 0) PG8_BAR; }
    PG8_BAR;
    if constexpr (Epi::AFTER_DRAIN) { E.fused(acc, cur, wr, wc, fr, fq, lds, wid, lane); S.done(cur); }
#undef PG8_SA
#undef PG8_SB
#undef PG8_STAGE
#undef PG8_LDA
#undef PG8_LDB
#undef PG8_MMA
#undef PG8_WAIT_V
#undef PG8_WAIT_L
#undef PG8_BAR
#undef PG8_SCHED
}
#endif
}


__device__ __forceinline__ void transpose_item(const float* W, int ldw, bf16_t* WT, int K, int k0, int n0, int drow0, float* scr, int lane) {
    float wv[32];
#pragma unroll
    for (int i = 0; i < 32; ++i) wv[i] = W[(size_t)(k0 + 2 * i + (lane >> 5)) * ldw + n0 + (lane & 31)];
#pragma unroll
    for (int i = 0; i < 32; ++i) scr[(2 * i + (lane >> 5)) * 33 + (lane & 31)] = wv[i];
    WAVE_SYNC();
    const int c = lane & 7;
#pragma unroll
    for (int j = 0; j < 4; ++j) { const int n = (lane >> 3) + 8 * j; const float* s = scr + (8 * c) * 33 + n;
        u32x4 o; o.x = pk2(s[0 * 33], s[1 * 33]); o.y = pk2(s[2 * 33], s[3 * 33]); o.z = pk2(s[4 * 33], s[5 * 33]); o.w = pk2(s[6 * 33], s[7 * 33]);
        *(u32x4*)(WT + (size_t)(drow0 + n) * K + k0 + 8 * c) = o; }
    WAVE_SYNC();
}
__device__ __forceinline__ void ph_convert(const P& p, unsigned char* smem) {
    const int lane = tidx() & 63, wave = tidx() >> 6;
    float* scr = (float*)smem + wave * (64 * 33 + 32);
    constexpr int I_IN = 16 * 120, I_OUT = 16 * 32, I_G = 16 * 88, I_DN = 44 * 32, I_L = I_IN + I_OUT + 2 * I_G + I_DN;
    const int gw = blockIdx.x * 8 + wave, ngw = gridDim.x * 8;
    for (int it = gw; it < NL * I_L; it += ngw) {
        const int l = it / I_L; int r = it % I_L;
        if (r < I_IN) { const int kb = r / 120, nb = r % 120; transpose_item(p.w_in + (size_t)l * D * INC, INC, WSP(bf16_t, WS_WIN) + (size_t)l * NPROJ * D, D, kb * 64, nb * 32, nb * 32, scr, lane); continue; }
        r -= I_IN;
        if (r < I_OUT) { const int kb = r / 32, nb = r % 32; transpose_item(p.w_out + (size_t)l * D * D, D, WSP(bf16_t, WS_WOUT) + (size_t)l * D * D, D, kb * 64, nb * 32, nb * 32, scr, lane); continue; }
        r -= I_OUT;
        if (r < 2 * I_G) { const int up = r / I_G; r %= I_G; const int kb = r / 88, nb = r % 88, n0 = nb * 32;
            transpose_item((up ? p.w_up : p.w_gate) + (size_t)l * D * FF, FF, WSP(bf16_t, WS_WGU) + (size_t)l * 2 * FF * D, D, kb * 64, n0, (n0 / 128) * 256 + up * 128 + (n0 % 128), scr, lane); continue; }
        r -= 2 * I_G;
        { const int kb = r / 32, nb = r % 32; transpose_item(p.w_down + (size_t)l * FF * D, D, WSP(bf16_t, WS_WDN) + (size_t)l * D * FF, FF, kb * 64, nb * 32, nb * 32, scr, lane); }
    }
}

__device__ __forceinline__ void ph_adaln(const P& p, unsigned char* smem) {
    float* sc = (float*)smem;
    float* red = sc + NC * 256;
    const int tid = tidx(), col = tid & 31, kg = tid >> 5;
    float* MOD = WSP(float, WS_MOD);
    for (int it = blockIdx.x; it < NL * 192; it += gridDim.x) {
        const int l = it / 192, cb0 = (it % 192) * 32;
        float acc[NC];
#pragma unroll
        for (int r = 0; r < NC; ++r) acc[r] = 0.f;
        for (int kc = 0; kc < 4; ++kc) {
            __syncthreads();
            for (int e = tid; e < NC * 256; e += NTHR) { const int r = e >> 8, k = e & 255; const float c = r < PB ? p.c_prompt[r * D + kc * 256 + k] : p.c_sample[(r - PB) * D + kc * 256 + k]; sc[e] = silu_f(c); }
            __syncthreads();
            for (int kk = 0; kk < 16; ++kk) { const int k = kg * 16 + kk; const float w = p.ada_w[((size_t)l * D + kc * 256 + k) * 6144 + cb0 + col];
#pragma unroll
                for (int r = 0; r < NC; ++r) acc[r] += sc[r * 256 + k] * w; }
        }
#pragma unroll
        for (int r = 0; r < NC; ++r) red[(kg * NC + r) * 32 + col] = acc[r];
        __syncthreads();
        for (int e = tid; e < NC * 32; e += NTHR) { const int r = e >> 5, c = e & 31; float s = p.ada_b[l * 6144 + cb0 + c];
            for (int g = 0; g < 16; ++g) s += red[(g * NC + r) * 32 + c];
            MOD[((size_t)l * NC + r) * 6144 + cb0 + c] = s; }
        __syncthreads();
    }
}

__device__ __forceinline__ void ph_ropetab_copyx(const P& p) {
    const size_t gt = (size_t)blockIdx.x * NTHR + tidx(), ng = (size_t)gridDim.x * NTHR;
    float* tab = WSP(float, WS_ROPE);
    for (size_t e = gt; e < (size_t)NL * D * 8; e += ng) { const size_t lk = e >> 3; const int c = (int)(e & 7); WSP(float, WS_W8)[((lk >> 10) * 8 + c) * D + (lk & 1023)] = p.w_in[lk * INC + NPROJ + c]; }
    for (size_t e = gt; e < (size_t)NPOS * 32; e += ng) {
        const int pi = (int)(e >> 5), i = (int)(e & 31); const double pos = pi < T ? (double)pi : (double)(PAST + pi - T);
        const double ia = exp(-log(10000.0) * (double)i / 32.0), ir = exp(-log(10000.0) * (double)i / 31.0);
        tab[e] = (float)cos(pos * ia); tab[(size_t)NPOS * 32 + e] = (float)sin(pos * ia);
        tab[(size_t)2 * NPOS * 32 + e] = (float)cos(pos * ir); tab[(size_t)3 * NPOS * 32 + e] = (float)sin(pos * ir);
    }
}

template <int WHICH> __device__ __forceinline__ void ph_norm_mod(const P& p, int l) {
    const int lane = tidx() & 63, wave = tidx() >> 6, gw = blockIdx.x * 8 + wave, ngw = gridDim.x * 8;
    const float* nw = (WHICH == 0 ? p.norm_mix : p.norm_ffn) + l * D;
    bf16_t* H = WSP(bf16_t, WS_H);
    for (int r = gw; r < M; r += ngw) {
        const float* xr = (WHICH == 0 && l == 0) ? (r < MP ? p.x_prompt + (size_t)r * D : p.x_sample + (size_t)(r - MP) * D) : p.out + (size_t)r * D;
        const float* mod = WSP(float, WS_MOD) + ((size_t)l * NC + row_cb(r)) * 6144 + (WHICH == 0 ? 0 : 3072);
        f32x4 v[4]; float ss = 0.f;
#pragma unroll
        for (int j = 0; j < 4; ++j) { v[j] = *(const f32x4*)(xr + 4 * lane + 256 * j); ss += (v[j][0] * v[j][0] + v[j][1] * v[j][1]) + (v[j][2] * v[j][2] + v[j][3] * v[j][3]); }
        const float rstd = 1.0f / sqrtf(wave_sum(ss) * (1.0f / D) + EPS);
        float a8[8];
#pragma unroll
        for (int c = 0; c < 8; ++c) a8[c] = 0.f;
#pragma unroll
        for (int j = 0; j < 4; ++j) { const int k = 4 * lane + 256 * j;
            const f32x4 g = *(const f32x4*)(nw + k), sh = *(const f32x4*)(mod + k), sc = *(const f32x4*)(mod + 1024 + k);
            f32x4 h;
#pragma unroll
            for (int e = 0; e < 4; ++e) h[e] = v[j][e] * rstd * g[e] * (1.0f + sc[e]) + sh[e];
            u32x2 w; w.x = pk2(h[0], h[1]); w.y = pk2(h[2], h[3]); *(u32x2*)(H + (size_t)r * D + k) = w;
            if (WHICH == 0) {
#pragma unroll
                for (int c = 0; c < 8; ++c) { const f32x4 wv = *(const f32x4*)(WSP(float, WS_W8) + ((size_t)l * 8 + c) * D + k); a8[c] += (h[0] * wv[0] + h[1] * wv[1]) + (h[2] * wv[2] + h[3] * wv[3]); }
            }
        }
        if (WHICH == 0) {
            float b4[4];
#pragma unroll
            for (int c = 0; c < 4; ++c) { const float keep = lane < 32 ? a8[c] : a8[4 + c], send = lane < 32 ? a8[4 + c] : a8[c]; b4[c] = keep + __shfl_xor(send, 32); }
            float b2[2];
#pragma unroll
            for (int c = 0; c < 2; ++c) { const bool lo = (lane & 16) == 0; const float keep = lo ? b4[c] : b4[2 + c], send = lo ? b4[2 + c] : b4[c]; b2[c] = keep + __shfl_xor(send, 16); }
            float b1; { const bool lo = (lane & 8) == 0; const float keep = lo ? b2[0] : b2[1], send = lo ? b2[1] : b2[0]; b1 = keep + __shfl_xor(send, 8); }
            b1 += __shfl_xor(b1, 4); b1 += __shfl_xor(b1, 2); b1 += __shfl_xor(b1, 1);
            if ((lane & 7) == 0) { const int c = (lane >> 5) * 4 + ((lane >> 4) & 1) * 2 + ((lane >> 3) & 1);
                if (c < 4) WSP(float, WS_BETA)[(size_t)r * 4 + c] = 1.0f / (1.0f + expf(-b1));
                else { const int hh = c - 4; const float xx = b1 + p.dt_bias[l * 4 + hh]; const float sp = xx > 20.f ? xx : log1pf(expf(xx)); WSP(float, WS_G)[(size_t)r * 4 + hh] = -expf(p.a_log[l * 4 + hh]) * sp; } }
        }
    }
}

__device__ __forceinline__ void unpack8(const u32x4 w, float (&f)[8]) {
    f[0] = __builtin_bit_cast(float, w.x << 16); f[1] = __builtin_bit_cast(float, w.x & 0xffff0000u); f[2] = __builtin_bit_cast(float, w.y << 16); f[3] = __builtin_bit_cast(float, w.y & 0xffff0000u);
    f[4] = __builtin_bit_cast(float, w.z << 16); f[5] = __builtin_bit_cast(float, w.z & 0xffff0000u); f[6] = __builtin_bit_cast(float, w.w << 16); f[7] = __builtin_bit_cast(float, w.w & 0xffff0000u);
}
__device__ __forceinline__ u32x4 pack8f(const float (&f)[8]) { u32x4 w; w.x = pk2(f[0], f[1]); w.y = pk2(f[2], f[3]); w.z = pk2(f[4], f[5]); w.w = pk2(f[6], f[7]); return w; }
__device__ __forceinline__ void ph_rope_out(const P& p, int l) {
    const size_t gt = (size_t)blockIdx.x * NTHR + tidx(), ng = (size_t)gridDim.x * NTHR;
    bf16_t* PR = WSP(bf16_t, WS_PROJ); const float* tab = WSP(float, WS_ROPE);
    for (size_t e = gt; e < (size_t)MS * 64; e += ng) {
        const int r = MP + (int)(e >> 6), rem = (int)(e & 63), sec = rem >> 4, hh = (rem >> 2) & 3, d = (rem & 3) * 8;
        const int off = sec == 0 ? C_QA : sec == 1 ? C_KA : sec == 2 ? C_QR : C_KR; const float scale = sec == 0 ? 0.125f * LOG2E : sec == 3 ? 0.125f : 1.0f;
        const float* ct = tab + (size_t)(sec >= 2 ? 2 : 0) * NPOS * 32 + (size_t)row_pi(r) * 32 + d; const float* st = ct + (size_t)NPOS * 32;
        const f32x4 c0 = *(const f32x4*)ct, c1 = *(const f32x4*)(ct + 4), s0 = *(const f32x4*)st, s1 = *(const f32x4*)(st + 4);
        bf16_t* x = PR + (size_t)r * NPROJ + off + hh * 64 + d; float x1[8], x2[8], o1[8], o2[8];
        unpack8(*(const u32x4*)x, x1); unpack8(*(const u32x4*)(x + 32), x2);
#pragma unroll
        for (int k = 0; k < 8; ++k) { const float c = k < 4 ? c0[k & 3] : c1[k & 3], sn = k < 4 ? s0[k & 3] : s1[k & 3]; o1[k] = (x1[k] * c - x2[k] * sn) * scale; o2[k] = (x1[k] * sn + x2[k] * c) * scale; }
        *(u32x4*)x = pack8f(o1); *(u32x4*)(x + 32) = pack8f(o2);
        if (sec == 1) { const int b = (r - MP) / DS, i = (r - MP) % DS; float* o = p.out + O_SWK + (((size_t)l * DB + b) * DS + i) * 256 + hh * 64 + d;
            *(f32x4*)o = (f32x4){o1[0], o1[1], o1[2], o1[3]}; *(f32x4*)(o + 4) = (f32x4){o1[4], o1[5], o1[6], o1[7]}; *(f32x4*)(o + 32) = (f32x4){o2[0], o2[1], o2[2], o2[3]}; *(f32x4*)(o + 36) = (f32x4){o2[4], o2[5], o2[6], o2[7]}; }
    }
    for (size_t e = gt; e < (size_t)MS * 32; e += ng) {
        const int r = MP + (int)(e >> 5), c = (int)(e & 31) * 8; const int b = (r - MP) / DS, i = (r - MP) % DS; float* o = p.out + O_SWV + (((size_t)l * DB + b) * DS + i) * 256 + c;
        float v[8]; unpack8(*(const u32x4*)(PR + (size_t)r * NPROJ + C_VA + c), v); *(f32x4*)o = (f32x4){v[0], v[1], v[2], v[3]}; *(f32x4*)(o + 4) = (f32x4){v[4], v[5], v[6], v[7]};
    }
    for (size_t e = gt; e < (size_t)(PB + DB) * 3 * 1536; e += ng) {
        const int c = (int)(e % 1536), j = (int)((e / 1536) % 3), bb = (int)(e / (3 * 1536));
        if (bb < PB) p.out[O_PCONV + (((size_t)l * PB + bb) * 3 + j) * 1536 + c] = bf2f(PR[(size_t)(bb * T + T - 3 + j) * NPROJ + C_CONV + c]);
        else { const int b = bb - PB; p.out[O_SCONV + (((size_t)l * DB + b) * 3 + j) * 1536 + c] = bf2f(PR[(size_t)(MP + b * DS + DS - 3 + j) * NPROJ + C_CONV + c]); }
    }
}

__device__ __forceinline__ void attn_wave_sample(const P& p, int l, int r, int h, int lane, float* sw  ) {
    const bf16_t* PR = WSP(bf16_t, WS_PROJ);
    const int b = (r - MP) / DS; const int tq = WB + (r - MP) % DS;
    float q[64];
    { const bf16_t* qp = PR + (size_t)r * NPROJ + C_QA + h * 64;
#pragma unroll
      for (int j = 0; j < 8; ++j) { const bf16x8 v = *(const bf16x8*)(qp + 8 * j);
#pragma unroll
          for (int e = 0; e < 8; ++e) q[8 * j + e] = bf2f((bf16_t)v[e]); } }
    float mx = -INFINITY;
#pragma unroll 1
    for (int i = 0; i < 7; ++i) {
        const int e = lane + 64 * i;
        if (e < 387) { const int pat = e / 129, j = e % 129, dil = pat == 0 ? 1 : pat == 1 ? 4 : 16; const int rr = tq - dil * j;
            float a = 0.f;
            if (rr < WB) { const float* kp = p.cache_k + ((((size_t)l * DB + b) * WB + rr) * 4 + h) * 64;
#pragma unroll
                for (int j4 = 0; j4 < 16; ++j4) { const f32x4 kv = *(const f32x4*)(kp + 4 * j4); a += q[4 * j4] * kv[0] + q[4 * j4 + 1] * kv[1] + q[4 * j4 + 2] * kv[2] + q[4 * j4 + 3] * kv[3]; } }
            else { const bf16_t* kp = PR + (size_t)(MP + b * DS + (rr - WB)) * NPROJ + C_KA + h * 64;
#pragma unroll
                for (int j8 = 0; j8 < 8; ++j8) { const bf16x8 kv = *(const bf16x8*)(kp + 8 * j8);
#pragma unroll
                    for (int e2 = 0; e2 < 8; ++e2) a += q[8 * j8 + e2] * bf2f((bf16_t)kv[e2]); } }
            sw[e] = a; mx = fmaxf(mx, a); }
    }
    mx = wave_max(mx);
    float lsum = 0.f;
#pragma unroll 1
    for (int i = 0; i < 7; ++i) { const int e = lane + 64 * i; if (e < 387) { const float pe = exp2f(sw[e] - mx); sw[e] = pe; lsum += pe; } }
    lsum = wave_sum(lsum);
    WAVE_SYNC();
    const int kg = lane >> 4, dq = lane & 15; f32x4 o4 = (f32x4){0.f, 0.f, 0.f, 0.f};
#pragma unroll 8
    for (int e = kg; e < 387; e += 4) {
        const float pe = sw[e];
        const int pat = e / 129, j = e % 129, dil = pat == 0 ? 1 : pat == 1 ? 4 : 16; const int rr = tq - dil * j;
        f32x4 v;
        if (rr < WB) v = *(const f32x4*)(p.cache_v + ((((size_t)l * DB + b) * WB + rr) * 4 + h) * 64 + 4 * dq);
        else { const u32x2 w = *(const u32x2*)(PR + (size_t)(MP + b * DS + (rr - WB)) * NPROJ + C_VA + h * 64 + 4 * dq);
            v = (f32x4){bf2f((bf16_t)(w.x & 0xffff)), bf2f((bf16_t)(w.x >> 16)), bf2f((bf16_t)(w.y & 0xffff)), bf2f((bf16_t)(w.y >> 16))}; }
        o4 += pe * v;
    }
#pragma unroll
    for (int e = 0; e < 4; ++e) { float x = o4[e]; x += __shfl_xor(x, 16); x += __shfl_xor(x, 32); o4[e] = x; }
    WAVE_SYNC();
    if (kg == 0) { const float inv = 1.0f / lsum; u32x2 w; w.x = pk2(o4[0] * inv, o4[1] * inv); w.y = pk2(o4[2] * inv, o4[3] * inv);
        *(u32x2*)(WSP(bf16_t, WS_O) + (size_t)r * D + h * 64 + 4 * dq) = w; }
}
__device__ __forceinline__ void ph_attn_sample(const P& p, int l, unsigned char* smem) {
    const int lane = tidx() & 63, wave = tidx() >> 6, gw = (gridDim.x - 1 - blockIdx.x) * 8 + wave, ngw = gridDim.x * 8;
    float* sw = (float*)smem + wave * 392;
    for (int it = gw; it < MS * 4; it += ngw) attn_wave_sample(p, l, MP + (it >> 2), it & 3, lane, sw);
}
__device__ __forceinline__ bf16x8 pack8(const f32x16& v, int s8) {
    u32x4 w; w.x = pk2(v[s8], v[s8 + 1]); w.y = pk2(v[s8 + 2], v[s8 + 3]); w.z = pk2(v[s8 + 4], v[s8 + 5]); w.w = pk2(v[s8 + 6], v[s8 + 7]); return __builtin_bit_cast(bf16x8, w);
}
__device__ __forceinline__ void attn_job(const P& p, int jb, int lane) {
    const int c = lane & 31, hi = lane >> 5;
    constexpr int NB = T / 512;
    const int unit = jb / 48, jj = jb % 48, pat = jj >> 4, sub = jj & 15;
    const int blk = unit % NB, h = (unit / NB) & 3, b = unit / (NB * 4), bh = b * 4 + h;
    int dil, r, qi0, cls, tb;
    if (pat == 0) { dil = 1; r = 0; qi0 = blk * 512 + sub * 32; cls = 0; tb = 0; }
    else if (pat == 1) { dil = 4; r = sub >> 2; qi0 = blk * 128 + (sub & 3) * 32; cls = 1; tb = r * (T / 128); }
    else { dil = 16; r = sub; qi0 = blk * 32; cls = 2; tb = r * (T / 512); }
    const bf16_t* KF = WSP(bf16_t, WS_KF) + cls * ATT_CLS + ((size_t)bh * (T / 32) + tb) * 2048 + lane * 8;
    const bf16_t* VF = WSP(bf16_t, WS_VF) + cls * ATT_CLS + ((size_t)bh * (T / 32) + tb) * 2048 + lane * 8;
    const int tq = dil * (qi0 + c) + r;
    const bf16_t* qp = WSP(bf16_t, WS_PROJ) + (size_t)(b * T + tq) * NPROJ + C_QA + h * 64 + 8 * hi;
    bf16x8 qf[4];
#pragma unroll
    for (int ks = 0; ks < 4; ++ks) qf[ks] = *(const bf16x8*)(qp + 16 * ks);
    f32x16 S[5];
#pragma unroll
    for (int i = 0; i < 5; ++i) {
        const int kt0 = qi0 - 128 + 32 * i;
        f32x16 acc;
#pragma unroll
        for (int e = 0; e < 16; ++e) acc[e] = 0.f;
        if (kt0 >= 0) { const bf16_t* kp = KF + (size_t)(kt0 >> 5) * 2048;
#pragma unroll
            for (int ks = 0; ks < 4; ++ks) acc = MFMA32(*(const bf16x8*)(kp + 512 * ks), qf[ks], acc);
            if (i == 0) {
#pragma unroll
                for (int e = 0; e < 16; ++e) { const int krow = (e & 3) + 8 * (e >> 2) + 4 * hi; if (krow < c) acc[e] = -INFINITY; } }
            if (i == 4) {
#pragma unroll
                for (int e = 0; e < 16; ++e) { const int krow = (e & 3) + 8 * (e >> 2) + 4 * hi; if (krow > c) acc[e] = -INFINITY; } }
        } else {
#pragma unroll
            for (int e = 0; e < 16; ++e) acc[e] = -INFINITY; }
        S[i] = acc;
    }
    float mx = -INFINITY;
#pragma unroll
    for (int i = 0; i < 5; ++i)
#pragma unroll
        for (int e = 0; e < 16; ++e) mx = fmaxf(mx, S[i][e]);
    mx = fmaxf(mx, __shfl_xor(mx, 32));
    float lsum = 0.f;
#pragma unroll
    for (int i = 0; i < 5; ++i)
#pragma unroll
        for (int e = 0; e < 16; ++e) { const float pe = exp2f(S[i][e] - mx); S[i][e] = pe; lsum += pe; }
    lsum += __shfl_xor(lsum, 32);
    f32x16 O[2];
#pragma unroll
    for (int dt = 0; dt < 2; ++dt)
#pragma unroll
        for (int e = 0; e < 16; ++e) O[dt][e] = 0.f;
#pragma unroll
    for (int i = 0; i < 5; ++i) {
        const int kt0 = qi0 - 128 + 32 * i;
        if (kt0 >= 0) {
#pragma unroll
            for (int s2 = 0; s2 < 2; ++s2) { const bf16x8 pf = pack8(S[i], 8 * s2);
#pragma unroll
                for (int dt = 0; dt < 2; ++dt) O[dt] = MFMA32(*(const bf16x8*)(VF + (size_t)(kt0 >> 5) * 2048 + (dt * 2 + s2) * 512), pf, O[dt]); }
        }
    }
    const size_t idx = ((size_t)(b * T + tq) * 4 + h) * 3 + pat;
    bf16_t* po = WSP(bf16_t, WS_APO) + idx * 64;
#pragma unroll
    for (int dt = 0; dt < 2; ++dt)
#pragma unroll
        for (int g = 0; g < 4; ++g) { u32x2 w; w.x = pk2(O[dt][4 * g], O[dt][4 * g + 1]); w.y = pk2(O[dt][4 * g + 2], O[dt][4 * g + 3]); *(u32x2*)(po + 32 * dt + 8 * g + 4 * hi) = w; }
    if (hi == 0) { float* ml = WSP(float, WS_AML) + idx * 2; ml[0] = mx; ml[1] = lsum; }
}
__device__ __forceinline__ void ph_attn_jobs(const P& p, int b0, int b1) {
    if ((int)blockIdx.x < b0 || (int)blockIdx.x >= b1) return;
    const int lane = tidx() & 63, wave = tidx() >> 6, gw = ((int)blockIdx.x - b0) * 8 + wave, ngw = (b1 - b0) * 8;
    for (int jb = gw; jb < PB * 4 * (T / 512) * 48; jb += ngw) attn_job(p, jb, lane);
}
__device__ __forceinline__ void ph_attn_combine(const P& p) {
    const size_t gt = (size_t)blockIdx.x * NTHR + tidx(), ng = (size_t)gridDim.x * NTHR;
    for (size_t e = gt; e < (size_t)MP * 4 * 16; e += ng) {
        const size_t rh = e >> 4; const int dq = (int)(e & 15) * 4;
        const float* ml = WSP(float, WS_AML) + rh * 6; const float m0 = ml[0], m1 = ml[2], m2 = ml[4];
        const float mm = fmaxf(m0, fmaxf(m1, m2)); const float w0 = exp2f(m0 - mm), w1 = exp2f(m1 - mm), w2 = exp2f(m2 - mm);
        const float inv = 1.0f / (w0 * ml[1] + w1 * ml[3] + w2 * ml[5]);
        const bf16_t* po = WSP(bf16_t, WS_APO) + rh * 192 + dq;
        const u32x2 a = *(const u32x2*)po, bq = *(const u32x2*)(po + 64), cq = *(const u32x2*)(po + 128);
        float o[4];
        o[0] = w0 * bf2f((bf16_t)(a.x & 0xffff)) + w1 * bf2f((bf16_t)(bq.x & 0xffff)) + w2 * bf2f((bf16_t)(cq.x & 0xffff));
        o[1] = w0 * bf2f((bf16_t)(a.x >> 16)) + w1 * bf2f((bf16_t)(bq.x >> 16)) + w2 * bf2f((bf16_t)(cq.x >> 16));
        o[2] = w0 * bf2f((bf16_t)(a.y & 0xffff)) + w1 * bf2f((bf16_t)(bq.y & 0xffff)) + w2 * bf2f((bf16_t)(cq.y & 0xffff));
        o[3] = w0 * bf2f((bf16_t)(a.y >> 16)) + w1 * bf2f((bf16_t)(bq.y >> 16)) + w2 * bf2f((bf16_t)(cq.y >> 16));
        const size_t row = rh >> 2; const int h = (int)(rh & 3);
        u32x2 w; w.x = pk2(o[0] * inv, o[1] * inv); w.y = pk2(o[2] * inv, o[3] * inv);
        *(u32x2*)(WSP(bf16_t, WS_O) + row * D + h * 64 + dq) = w;
    }
}
__device__ __forceinline__ float ret_lg(int h) { return logf(1.0f - exp2f(-5.0f - (float)h)); }
constexpr int TPK = 72, TPT = 65;
__device__ __forceinline__ void trans_write(const bf16_t* tile, bf16_t* dst  , int tile0, int tid) {
#pragma unroll
    for (int k = 0; k < 4; ++k) { const int ch = tid + NTHR * k, d = ch >> 5, t0 = (ch & 31) * 8; u32x4 w;
        w.x = (unsigned)tile[(t0 + 0) * TPT + d] | ((unsigned)tile[(t0 + 1) * TPT + d] << 16); w.y = (unsigned)tile[(t0 + 2) * TPT + d] | ((unsigned)tile[(t0 + 3) * TPT + d] << 16);
        w.z = (unsigned)tile[(t0 + 4) * TPT + d] | ((unsigned)tile[(t0 + 5) * TPT + d] << 16); w.w = (unsigned)tile[(t0 + 6) * TPT + d] | ((unsigned)tile[(t0 + 7) * TPT + d] << 16);
        *(u32x4*)(dst + (size_t)d * T + tile0 + t0) = w; COMPILER_FENCE(); }
}
__device__ __forceinline__ void store8_b16(bf16_t* dst, const u32x4 w) {
    dst[0] = (bf16_t)(w.x & 0xffff); dst[1] = (bf16_t)(w.x >> 16); dst[2] = (bf16_t)(w.y & 0xffff); dst[3] = (bf16_t)(w.y >> 16);
    dst[4] = (bf16_t)(w.z & 0xffff); dst[5] = (bf16_t)(w.z >> 16); dst[6] = (bf16_t)(w.w & 0xffff); dst[7] = (bf16_t)(w.w >> 16);
}
__device__ __forceinline__ void ph_vtrans(const P& p, int l, unsigned char* smem) {
    bf16_t* ka = (bf16_t*)smem; bf16_t* va = ka + 256 * TPK; bf16_t* vr = va + 256 * TPK; bf16_t* kr = vr + 256 * TPT;
    static_assert((2 * 256 * TPK + 2 * 256 * TPT) * 2 <= BAR_LDS_OFF, "transpose unit LDS");
    const int tid = tidx(); bf16_t* PR = WSP(bf16_t, WS_PROJ); const float* tab = WSP(float, WS_ROPE);
    for (int u = blockIdx.x; u < PB * 4 * (T / 256); u += gridDim.x) {
        const int tile = u % (T / 256), bh = u / (T / 256), h = bh & 3, b = bh >> 2; const float lg = ret_lg(h);
        __syncthreads();
#pragma unroll 1
        for (int k = 0; k < 2; ++k) { const int e = tid + NTHR * k, t = e >> 2, d = (e & 3) * 8, tt = tile * 256 + t; bf16_t* row = PR + (size_t)(b * T + tt) * NPROJ + h * 64 + d;
            float x1[8], x2[8], o1[8], o2[8];
            { const float* ct = tab + (size_t)tt * 32 + d; const float* st = ct + (size_t)NPOS * 32;
              const f32x4 c0 = *(const f32x4*)ct, c1 = *(const f32x4*)(ct + 4), s0 = *(const f32x4*)st, s1 = *(const f32x4*)(st + 4);
              unpack8(*(const u32x4*)(row + C_QA), x1); unpack8(*(const u32x4*)(row + C_QA + 32), x2);
#pragma unroll
              for (int i = 0; i < 8; ++i) { const float c = i < 4 ? c0[i & 3] : c1[i & 3], sn = i < 4 ? s0[i & 3] : s1[i & 3]; o1[i] = (x1[i] * c - x2[i] * sn) * (0.125f * LOG2E); o2[i] = (x1[i] * sn + x2[i] * c) * (0.125f * LOG2E); }
              *(u32x4*)(row + C_QA) = pack8f(o1); *(u32x4*)(row + C_QA + 32) = pack8f(o2);
              unpack8(*(const u32x4*)(row + C_KA), x1); unpack8(*(const u32x4*)(row + C_KA + 32), x2);
#pragma unroll
              for (int i = 0; i < 8; ++i) { const float c = i < 4 ? c0[i & 3] : c1[i & 3], sn = i < 4 ? s0[i & 3] : s1[i & 3]; o1[i] = x1[i] * c - x2[i] * sn; o2[i] = x1[i] * sn + x2[i] * c; }
              *(u32x4*)(ka + t * TPK + d) = pack8f(o1); *(u32x4*)(ka + t * TPK + d + 32) = pack8f(o2);
              if (tt >= T - PWIN) { float* o = p.out + O_PWK + (((size_t)l * PB + b) * PWIN + (tt - (T - PWIN))) * 256 + h * 64 + d;
                  *(f32x4*)o = (f32x4){o1[0], o1[1], o1[2], o1[3]}; *(f32x4*)(o + 4) = (f32x4){o1[4], o1[5], o1[6], o1[7]}; *(f32x4*)(o + 32) = (f32x4){o2[0], o2[1], o2[2], o2[3]}; *(f32x4*)(o + 36) = (f32x4){o2[4], o2[5], o2[6], o2[7]}; } }
            COMPILER_FENCE();
            { const float* ct = tab + (size_t)2 * NPOS * 32 + (size_t)tt * 32 + d; const float* st = ct + (size_t)NPOS * 32;
              const f32x4 c0 = *(const f32x4*)ct, c1 = *(const f32x4*)(ct + 4), s0 = *(const f32x4*)st, s1 = *(const f32x4*)(st + 4);
              const float gq = expf(lg * (float)(tt & 63)), gk = 0.125f / gq;
              unpack8(*(const u32x4*)(row + C_QR), x1); unpack8(*(const u32x4*)(row + C_QR + 32), x2);
#pragma unroll
              for (int i = 0; i < 8; ++i) { const float c = i < 4 ? c0[i & 3] : c1[i & 3], sn = i < 4 ? s0[i & 3] : s1[i & 3]; o1[i] = (x1[i] * c - x2[i] * sn) * gq; o2[i] = (x1[i] * sn + x2[i] * c) * gq; }
              *(u32x4*)(row + C_QR) = pack8f(o1); *(u32x4*)(row + C_QR + 32) = pack8f(o2);
              unpack8(*(const u32x4*)(row + C_KR), x1); unpack8(*(const u32x4*)(row + C_KR + 32), x2);
#pragma unroll
              for (int i = 0; i < 8; ++i) { const float c = i < 4 ? c0[i & 3] : c1[i & 3], sn = i < 4 ? s0[i & 3] : s1[i & 3]; o1[i] = (x1[i] * c - x2[i] * sn) * gk; o2[i] = (x1[i] * sn + x2[i] * c) * gk; }
              const u32x4 w1 = pack8f(o1), w2 = pack8f(o2);
              *(u32x4*)(row + C_KR) = w1; *(u32x4*)(row + C_KR + 32) = w2; store8_b16(kr + t * TPT + d, w1); store8_b16(kr + t * TPT + d + 32, w2); }
            COMPILER_FENCE(); }
#pragma unroll
        for (int k = 0; k < 4; ++k) { const int ch = tid + NTHR * k, t = ch >> 3, d8 = (ch & 7) * 8, tt = tile * 256 + t; const bf16_t* src = PR + (size_t)(b * T + tt) * NPROJ + h * 64 + d8;
            const u32x4 wv = *(const u32x4*)(src + C_VA); *(u32x4*)(va + t * TPK + d8) = wv; store8_b16(vr + t * TPT + d8, *(const u32x4*)(src + C_VR));
            if (tt >= T - PWIN) { float v[8]; unpack8(wv, v); float* o = p.out + O_PWV + (((size_t)l * PB + b) * PWIN + (tt - (T - PWIN))) * 256 + h * 64 + d8;
                *(f32x4*)o = (f32x4){v[0], v[1], v[2], v[3]}; *(f32x4*)(o + 4) = (f32x4){v[4], v[5], v[6], v[7]}; }
            COMPILER_FENCE(); }
        __syncthreads();
#pragma unroll
        for (int cls = 0; cls < 3; ++cls) {
            bf16_t* KFc = WSP(bf16_t, WS_KF) + cls * ATT_CLS + (size_t)bh * (T / 32) * 2048; bf16_t* VFc = WSP(bf16_t, WS_VF) + cls * ATT_CLS + (size_t)bh * (T / 32) * 2048;
#pragma unroll 1
            for (int k = 0; k < 4; ++k) { const int f = tid + NTHR * k, lane = f & 63, c31 = lane & 31, hi = lane >> 5;
                { int g, ks, tl, gtile; bool ok = true;
                  if (cls == 0) { ks = (f >> 6) & 3; g = f >> 8; tl = 32 * g + c31; gtile = tile * 8 + g; }
                  else if (cls == 1) { ks = (f >> 6) & 3; g = f >> 8; const int r = g >> 1, st = g & 1; tl = 4 * (32 * st + c31) + r; gtile = r * (T / 128) + tile * 2 + st; }
                  else { const int r = f >> 7, s16 = f & 15, h2 = (f >> 4) & 1; ks = (f >> 5) & 3; tl = 16 * s16 + r; gtile = r * (T / 512) + (tile >> 1); g = 0; (void)ok;
                      const int slot = 16 * (tile & 1) + s16;
                      *(u32x4*)(KFc + ((size_t)gtile * 4 + ks) * 512 + (slot + 32 * h2) * 8) = *(const u32x4*)(ka + tl * TPK + 16 * ks + 8 * h2); }
                  if (cls < 2) { *(u32x4*)(KFc + ((size_t)gtile * 4 + ks) * 512 + lane * 8) = *(const u32x4*)(ka + tl * TPK + 16 * ks + 8 * hi); } }
                { int dt, s2, gtile, r = 0, st = 0, g = 0;
                  if (cls == 0) { s2 = (f >> 6) & 1; dt = (f >> 7) & 1; g = f >> 8; gtile = tile * 8 + g; }
                  else if (cls == 1) { s2 = (f >> 6) & 1; dt = (f >> 7) & 1; g = f >> 8; r = g >> 1; st = g & 1; gtile = r * (T / 128) + tile * 2 + st; }
                  else { dt = (f >> 6) & 1; r = f >> 7; s2 = tile & 1; gtile = r * (T / 512) + (tile >> 1); }
                  unsigned short e8[8];
#pragma unroll
                  for (int jj = 0; jj < 8; ++jj) { const int kk = 16 * s2 + 8 * (jj >> 2) + 4 * hi + (jj & 3);
                      const int tl = cls == 0 ? 32 * g + kk : cls == 1 ? 4 * (32 * st + kk) + r : 16 * (kk & 15) + r;
                      e8[jj] = va[tl * TPK + 32 * dt + c31]; }
                  u32x4 w; w.x = (unsigned)e8[0] | ((unsigned)e8[1] << 16); w.y = (unsigned)e8[2] | ((unsigned)e8[3] << 16); w.z = (unsigned)e8[4] | ((unsigned)e8[5] << 16); w.w = (unsigned)e8[6] | ((unsigned)e8[7] << 16);
                  *(u32x4*)(VFc + ((size_t)gtile * 4 + dt * 2 + s2) * 512 + lane * 8) = w; }
                COMPILER_FENCE(); }
        }
        trans_write(vr, WSP(bf16_t, WS_VRT) + (size_t)bh * 64 * T, tile * 256, tid);
        trans_write(kr, WSP(bf16_t, WS_KRT) + (size_t)bh * 64 * T, tile * 256, tid);
    }
}

constexpr int CH_ITEMS = PB * 4 * 2;
__device__ __forceinline__ void ph_ret_local(const P& p, int l) {
    const int tid = tidx(), lane = tid & 63, wave = tid >> 6, x = lane & 15, q = lane >> 4, dt = wave >> 1;
    for (int u = blockIdx.x; u < NUNIT; u += gridDim.x) {
        const int n = u % NCH, bh = u / NCH, h = bh & 3, t0 = n * 64; const float g63 = expf(ret_lg(h) * 63.0f);
        const bf16_t* ka = WSP(bf16_t, WS_KRT) + ((size_t)bh * 64 + 16 * dt + x) * T + t0 + 8 * q;
#pragma unroll
        for (int k = 0; k < 2; ++k) { const int et = 2 * (wave & 1) + k; const bf16_t* vb = WSP(bf16_t, WS_VRT) + ((size_t)bh * 64 + 16 * et + x) * T + t0 + 8 * q;
            f32x4 acc = (f32x4){0.f, 0.f, 0.f, 0.f};
#pragma unroll
            for (int ks = 0; ks < 2; ++ks) acc = MFMA16(*(const bf16x8*)(ka + 32 * ks), *(const bf16x8*)(vb + 32 * ks), acc);
            *(f32x4*)(WSP(float, WS_RU) + (size_t)u * 4096 + (16 * et + x) * 64 + 16 * dt + 4 * q) = acc * g63; }
    }
}
__device__ __forceinline__ void ph_ret_scan(const P& p, int l) {
    const int G = (int)gridDim.x, skip = G > 2 * CH_ITEMS ? CH_ITEMS : 0;
    if ((int)blockIdx.x < skip) return;
    const int gt = ((int)blockIdx.x - skip) * NTHR + tidx(), ng = (G - skip) * NTHR;
    for (int e = gt; e < PB * 4 * 4096; e += ng) {
        const int bh = e >> 12, ed = e & 4095, h = bh & 3; const float cd = expf(ret_lg(h) * 64.0f);
        const float* U = WSP(float, WS_RU) + (size_t)bh * NCH * 4096 + ed; bf16_t* SPv = WSP(bf16_t, WS_RS) + (size_t)bh * NCH * 4096 + ed;
        float s = 0.f;
        for (int n0 = 0; n0 < NCH; n0 += 8) {
            float uv[8];
#pragma unroll
            for (int k = 0; k < 8; ++k) uv[k] = U[(size_t)(n0 + k) * 4096];
#pragma unroll
            for (int k = 0; k < 8; ++k) { SPv[(size_t)(n0 + k) * 4096] = f2bf(s); s = s * cd + uv[k]; } }
        p.out[O_PRET + ((size_t)l * PB * 4 + bh) * 4096 + (ed & 63) * 64 + (ed >> 6)] = s;
    }
}
__device__ __forceinline__ void ph_ret_out(const P& p, int l) {
    const int tid = tidx(), lane = tid & 63, wave = tid >> 6, x = lane & 15, q = lane >> 4, it = UNIFORM(wave & 3);
    const bf16_t* PR = WSP(bf16_t, WS_PROJ);
    for (int u = blockIdx.x * 2 + (wave >> 2); u < NUNIT; u += gridDim.x * 2) {
        const int n = u % NCH, bh = u / NCH, h = bh & 3, b = bh >> 2, t0 = n * 64; const float gam = expf(ret_lg(h));
        const size_t rowi = (size_t)(b * T + t0 + 16 * it + x);
        bf16x8 qf[2];
#pragma unroll
        for (int ks = 0; ks < 2; ++ks) qf[ks] = *(const bf16x8*)(PR + rowi * NPROJ + C_QR + h * 64 + 32 * ks + 8 * q);
        f32x4 at[4];
#pragma unroll
        for (int jt = 0; jt < 4; ++jt) { at[jt] = (f32x4){0.f, 0.f, 0.f, 0.f};
            if (jt <= it) { const bf16_t* kp = PR + (size_t)(b * T + t0 + 16 * jt + x) * NPROJ + C_KR + h * 64 + 8 * q;
#pragma unroll
                for (int ks = 0; ks < 2; ++ks) at[jt] = MFMA16(*(const bf16x8*)(kp + 32 * ks), qf[ks], at[jt]);
                if (jt == it) {
#pragma unroll
                    for (int e = 0; e < 4; ++e) if (4 * q + e > x) at[jt][e] = 0.f; } } }
        const bf16x8 pb0 = pack_tiles(at[0], at[1]), pb1 = pack_tiles(at[2], at[3]);
        f32x4 o[4], os[4];
#pragma unroll
        for (int et = 0; et < 4; ++et) { o[et] = (f32x4){0.f, 0.f, 0.f, 0.f}; os[et] = (f32x4){0.f, 0.f, 0.f, 0.f};
            const bf16_t* vp = WSP(bf16_t, WS_VRT) + ((size_t)bh * 64 + 16 * et + x) * T + t0 + 4 * q;
            { const u32x2 lo = *(const u32x2*)vp, hi = *(const u32x2*)(vp + 16); u32x4 w; w.x = lo.x; w.y = lo.y; w.z = hi.x; w.w = hi.y; o[et] = MFMA16(__builtin_bit_cast(bf16x8, w), pb0, o[et]); }
            if (it >= 2) { const u32x2 lo = *(const u32x2*)(vp + 32), hi = *(const u32x2*)(vp + 48); u32x4 w; w.x = lo.x; w.y = lo.y; w.z = hi.x; w.w = hi.y; o[et] = MFMA16(__builtin_bit_cast(bf16x8, w), pb1, o[et]); }
            const bf16_t* sp = WSP(bf16_t, WS_RS) + (size_t)u * 4096 + (16 * et + x) * 64 + 8 * q;
#pragma unroll
            for (int ks = 0; ks < 2; ++ks) os[et] = MFMA16(*(const bf16x8*)(sp + 32 * ks), qf[ks], os[et]);
            o[et] = o[et] + os[et] * gam; }
        float sq = 0.f;
#pragma unroll
        for (int et = 0; et < 4; ++et) sq += (o[et][0] * o[et][0] + o[et][1] * o[et][1]) + (o[et][2] * o[et][2] + o[et][3] * o[et][3]);
        sq += __shfl_xor(sq, 16); sq += __shfl_xor(sq, 32);
        const float rstd = 1.0f / sqrtf(sq * (1.0f / 64.0f) + EPS);
#pragma unroll
        for (int et = 0; et < 4; ++et) { const int e0 = 16 * et + 4 * q; const u32x2 gw = *(const u32x2*)(PR + rowi * NPROJ + C_GR + h * 64 + e0); const f32x4 nw = *(const f32x4*)(p.ret_norm + l * 64 + e0);
            const float g0 = bf2f((bf16_t)(gw.x & 0xffff)), g1 = bf2f((bf16_t)(gw.x >> 16)), g2 = bf2f((bf16_t)(gw.y & 0xffff)), g3 = bf2f((bf16_t)(gw.y >> 16));
            u32x2 w; w.x = pk2(o[et][0] * rstd * nw[0] * silu_f(g0), o[et][1] * rstd * nw[1] * silu_f(g1)); w.y = pk2(o[et][2] * rstd * nw[2] * silu_f(g2), o[et][3] * rstd * nw[3] * silu_f(g3));
            *(u32x2*)(WSP(bf16_t, WS_O) + rowi * D + 256 + h * 64 + e0) = w; }
    }
}
__device__ __forceinline__ void ph_ret_sample(const P& p, int l, unsigned char* smem) {
    float* S0 = (float*)smem; float* qs = S0 + 4096; float* ks = qs + 8 * 64; float* vs = ks + 8 * 64;
    const int tid = tidx(); const bf16_t* PR = WSP(bf16_t, WS_PROJ);
    for (int u = gridDim.x - 1 - blockIdx.x; u < DB * 4; u += gridDim.x) {
        const int h = u & 3, b = u >> 2; const float lg = ret_lg(h);
        __syncthreads();
        for (int e = tid; e < 4096; e += NTHR) S0[e] = p.state_ret[(((size_t)l * DB + b) * 4 + h) * 4096 + e];
        { const int j = tid >> 6, d = tid & 63; const size_t row = (size_t)(MP + b * DS + j) * NPROJ;
          qs[tid] = bf2f(PR[row + C_QR + h * 64 + d]); ks[tid] = bf2f(PR[row + C_KR + h * 64 + d]); vs[tid] = bf2f(PR[row + C_VR + h * 64 + d]); }
        __syncthreads();
        { const int i = tid >> 6, e = tid & 63; float o = 0.f;
          for (int j = 0; j <= i; ++j) { float a = 0.f; for (int d = 0; d < 64; ++d) a += qs[i * 64 + d] * ks[j * 64 + d]; o += a * expf(lg * (float)(i - j)) * vs[j * 64 + e]; }
          float o2 = 0.f; for (int d = 0; d < 64; ++d) o2 += qs[i * 64 + d] * S0[d * 64 + e];
          o += o2 * expf(lg * (float)(i + 1));
          const float rstd = 1.0f / sqrtf(wave_sum(o * o) * (1.0f / 64.0f) + EPS);
          const size_t row = (size_t)(MP + b * DS + i); const float g = bf2f(PR[row * NPROJ + C_GR + h * 64 + e]);
          WSP(bf16_t, WS_O)[row * D + 256 + h * 64 + e] = f2bf(o * rstd * p.ret_norm[l * 64 + e] * silu_f(g)); }
        for (int x = tid; x < 4096; x += NTHR) { const int d = x >> 6, e = x & 63; float s = S0[x] * expf(lg * (float)DS);
            for (int j = 0; j < DS; ++j) s += ks[j * 64 + d] * expf(lg * (float)(DS - 1 - j)) * vs[j * 64 + e];
            p.out[O_SRET + (((size_t)l * DB + b) * 4 + h) * 4096 + x] = s; }
    }
}

template <int CS, int LDL> __device__ __forceinline__ void fwd_subst(float (&X)[CS], const float* Ls) {
#pragma unroll
    for (int i = 1; i < CS; ++i) {
        float a = X[i];
#pragma unroll
        for (int j4 = 0; j4 < (i + 3) / 4; ++j4) { const f32x4 lv = *(const f32x4*)(Ls + i * LDL + 4 * j4);
#pragma unroll
            for (int e = 0; e < 4; ++e) if (4 * j4 + e < i) a -= lv[e] * X[4 * j4 + e]; }
        X[i] = a;
    }
}
constexpr int QP = 132;
constexpr int WSTP = 136;
constexpr int RWP = 392, TP = 136;
__device__ __forceinline__ void ph_gdn_prep(const P& p, int l, unsigned char* smem) {
    float* Ls = (float*)smem; float* As = Ls + 64 * 68; float* gs = As + 64 * 68; float* gcs = gs + 64; float* bts = gcs + 64; float* part = bts + 64;
    bf16_t* raw = (bf16_t*)(part + 4 * 64); bf16_t* Khi = raw + 67 * RWP; bf16_t* Klo = Khi + 64 * TP; bf16_t* Qb = Klo + 64 * TP;
    static_assert((64 * 68 * 2 + 64 * 3 + 4 * 64) * 4 + (67 * RWP + 3 * 64 * TP) * 2 <= BAR_LDS_OFF, "gdn_prep LDS");
    const int tid = tidx(), lane = tid & 63, wave = tid >> 6; const bf16_t* PR = WSP(bf16_t, WS_PROJ);
    for (int u = blockIdx.x; u < NUNIT; u += gridDim.x) {
        const int n = u % NCH, h = (u / NCH) % 4, b = u / (NCH * 4), t0 = n * 64;
        __syncthreads();
        for (int e = tid; e < 67 * 48; e += NTHR) { const int row = e / 48, ch = e % 48, t = t0 - 3 + row; u32x4 v = (u32x4){0u, 0u, 0u, 0u};
            if (t >= 0) v = *(const u32x4*)(PR + (size_t)(b * T + t) * NPROJ + C_CONV + (ch >> 4) * 512 + h * 128 + (ch & 15) * 8);
            *(u32x4*)(raw + row * RWP + ch * 8) = v; }
        if (tid >= 384 && tid < 448) { const int i = tid - 384; const size_t row = (size_t)(b * T + t0 + i); gs[i] = WSP(float, WS_G)[row * 4 + h]; bts[i] = WSP(float, WS_BETA)[row * 4 + h]; }
        __syncthreads();
        float y[64]; const int sec = tid < 128 ? 2 : tid < 256 ? 1 : 0, c = tid & 127;
        if (tid < 384) { const int col = sec * 512 + h * 128 + c;
            const float w0 = p.conv_w[(l * 4 + 0) * 1536 + col], w1 = p.conv_w[(l * 4 + 1) * 1536 + col], w2 = p.conv_w[(l * 4 + 2) * 1536 + col], w3 = p.conv_w[(l * 4 + 3) * 1536 + col];
            const LAS bf16_t* rp = (const LAS bf16_t*)raw + sec * 128 + c; LAUNDER_V(rp); float x0 = bf2f(rp[0]), x1 = bf2f(rp[RWP]), x2 = bf2f(rp[2 * RWP]);
#pragma unroll
            for (int i = 0; i < 64; ++i) { const float x3 = bf2f(rp[(i + 3) * RWP]); y[i] = silu_fast(w0 * x0 + w1 * x1 + w2 * x2 + w3 * x3); x0 = x1; x1 = x2; x2 = x3; if ((i & 7) == 7) COMPILER_FENCE(); } }
        if (tid >= 448) { if (tid == 448) { float a = 0.f; for (int i = 0; i < 64; ++i) { a += gs[i]; gcs[i] = a; } }
            WAVE_SYNC(); const int i = tid - 448; part[128 + i] = expf(gcs[i]); part[192 + i] = expf(gcs[63] - gcs[i]); }
#pragma unroll
        for (int pass = 0; pass < 2; ++pass) {
            if (tid >= 128 + 128 * pass && tid < 256 + 128 * pass) { LAS float* sq = (LAS float*)Ls + c; LAUNDER_V(sq);
#pragma unroll
                for (int i = 0; i < 64; ++i) sq[i * 132] = y[i] * y[i]; }
            __syncthreads();
            { const int i = tid >> 3, pt = tid & 7; const float* rp2 = Ls + i * 132 + pt * 16; float a = 0.f;
#pragma unroll
              for (int k = 0; k < 16; ++k) a += rp2[k];
              a += __shfl_xor(a, 1); a += __shfl_xor(a, 2); a += __shfl_xor(a, 4);
              if (pt == 0) part[64 * pass + i] = 1.0f / sqrtf(a + EPS); }
            __syncthreads();
        }
        if (tid >= 128 && tid < 256) { LAS bf16_t* kh = (LAS bf16_t*)Khi + c; LAS bf16_t* kl = (LAS bf16_t*)Klo + c; LAUNDER_V(kh); LAUNDER_V(kl);
#pragma unroll
            for (int i = 0; i < 64; ++i) { const float v = y[i] * part[i]; y[i] = v; const bf16_t hb = f2bf(v); kh[i * TP] = hb; kl[i * TP] = f2bf(v - bf2f(hb)); if ((i & 7) == 7) COMPILER_FENCE(); }
            bf16_t* dst = WSP(bf16_t, WS_GWK) + (size_t)u * 16384 + 8192; const int mt = c >> 4, x = c & 15;
#pragma unroll
            for (int ks2 = 0; ks2 < 2; ++ks2)
#pragma unroll
                for (int q = 0; q < 4; ++q) { const int i0 = 32 * ks2 + 4 * q; float v[8];
#pragma unroll
                    for (int e = 0; e < 8; ++e) { const int i = i0 + (e < 4 ? e : 12 + e); v[e] = y[i] * part[192 + i]; }
                    u32x4 w; w.x = pk2(v[0], v[1]); w.y = pk2(v[2], v[3]); w.z = pk2(v[4], v[5]); w.w = pk2(v[6], v[7]);
                    *(u32x4*)(dst + ((size_t)((mt * 2 + ks2) * 64 + q * 16 + x)) * 8) = w; COMPILER_FENCE(); } }
        else if (tid >= 256 && tid < 384) { bf16_t* qg = WSP(bf16_t, WS_GQ) + (size_t)u * 8192 + c; LAS bf16_t* qb = (LAS bf16_t*)Qb + c; LAUNDER_V(qb);
#pragma unroll
            for (int i = 0; i < 64; ++i) { const float v = y[i] * part[64 + i]; qb[i * TP] = f2bf(v); qg[(i & 7) * 128] = f2bf(v * 0.08838834764831845f * part[128 + i]); if ((i & 7) == 7) { qg += 8 * 128; LAUNDER_V(qg); COMPILER_FENCE(); } } }
        __syncthreads();
#pragma unroll
        for (int tp = 0; tp < 2; ++tp) { const int pos = wave * 2 + tp, it = pos >> 2, jt = pos & 3, j16 = lane & 15, qd = lane >> 4;
            f32x4 lk = (f32x4){0.f, 0.f, 0.f, 0.f}, aq = (f32x4){0.f, 0.f, 0.f, 0.f};
            if (jt <= it) {
#pragma unroll
                for (int ks = 0; ks < 4; ++ks) { const int ao = (16 * it + j16) * TP + 32 * ks + 8 * qd, bo = (16 * jt + j16) * TP + 32 * ks + 8 * qd;
                    const bf16x8 ah = *(const bf16x8*)(Khi + ao), al = *(const bf16x8*)(Klo + ao), aqf = *(const bf16x8*)(Qb + ao), bh = *(const bf16x8*)(Khi + bo), bl = *(const bf16x8*)(Klo + bo);
                    lk = MFMA16(ah, bh, lk); lk = MFMA16(ah, bl, lk); lk = MFMA16(al, bh, lk); aq = MFMA16(aqf, bh, aq); } }
            const int j = 16 * jt + j16;
#pragma unroll
            for (int e = 0; e < 4; ++e) { const int i = 16 * it + 4 * qd + e; const float ex = j <= i ? expf(gcs[i] - gcs[j]) : 0.f;
                Ls[i * 68 + j] = j < i ? bts[i] * lk[e] * ex : 0.f; As[i * 68 + j] = aq[e] * ex * 0.08838834764831845f; } }
        __syncthreads();
        if (tid < 256) {
            if (tid < 128) {
#pragma unroll
                for (int i = 0; i < 64; ++i) { y[i] *= bts[i]; if ((i & 15) == 15) COMPILER_FENCE(); } }
            else {
#pragma unroll
                for (int i = 0; i < 64; ++i) { y[i] *= bts[i] * part[128 + i]; if ((i & 15) == 15) COMPILER_FENCE(); } }
            fwd_subst<64, 68>(y, Ls);
            if (tid < 128) { bf16_t* U = WSP(bf16_t, WS_GU) + (size_t)u * 8192 + c * 64;
#pragma unroll
                for (int i8 = 0; i8 < 8; ++i8) { u32x4 w; w.x = pk2(y[8 * i8], y[8 * i8 + 1]); w.y = pk2(y[8 * i8 + 2], y[8 * i8 + 3]); w.z = pk2(y[8 * i8 + 4], y[8 * i8 + 5]); w.w = pk2(y[8 * i8 + 6], y[8 * i8 + 7]); *(u32x4*)(U + 8 * i8) = w; } }
            else { LAS bf16_t* wst = (LAS bf16_t*)raw + c; LAUNDER_V(wst);
#pragma unroll
                for (int i = 0; i < 64; ++i) wst[i * WSTP] = f2bf(-y[i]); }
        } else { const int t2 = tid - 256;
#pragma unroll 2
            for (int e = t2; e < 4096; e += 256) WSP(bf16_t, WS_GA)[(size_t)u * 4096 + e] = f2bf(As[(e >> 6) * 68 + (e & 63)]);
            if (t2 == 0) WSP(float, WS_GD)[u] = expf(gcs[63]); }
        __syncthreads();
        { bf16_t* dst = WSP(bf16_t, WS_GWK) + (size_t)u * 16384; const bf16_t* wst = raw;
#pragma unroll
          for (int k = 0; k < 2; ++k) { const int f = tid + NTHR * k, ln = f & 63, ks4 = (f >> 6) & 3, mt = f >> 8, q = ln >> 4, x = ln & 15;
              const bf16_t* wr = wst + (16 * mt + x) * WSTP + 32 * ks4 + 4 * q;
              u32x4 w; w.x = (unsigned)wr[0] | ((unsigned)wr[1] << 16); w.y = (unsigned)wr[2] | ((unsigned)wr[3] << 16); w.z = (unsigned)wr[16] | ((unsigned)wr[17] << 16); w.w = (unsigned)wr[18] | ((unsigned)wr[19] << 16);
              *(u32x4*)(dst + (size_t)f * 8) = w; } }
    }
}
constexpr int CH_SLOT = 40960, CH_NSLOT = 3;
static_assert(NCH % 4 == 0, "the chain's loop is unrolled by four chunks");
__device__ __forceinline__ void chain_stage(const bf16_t* WK, const bf16_t* UTh, int m, int pw, int lane, unsigned char* smem) {
    unsigned char* slot = smem + (m % CH_NSLOT) * CH_SLOT;
#pragma unroll
    for (int k = 0; k < 8; ++k) GLDS16((const unsigned char*)(WK + (size_t)m * 16384) + (pw * 8 + k) * 1024 + lane * 16, slot + (pw * 8 + k) * 1024);
#pragma unroll
    for (int k = 0; k < 2; ++k) GLDS16((const unsigned char*)(UTh + (size_t)m * 8192) + (pw * 2 + k) * 1024 + lane * 16, slot + 32768 + (pw * 2 + k) * 1024);
}
__device__ __forceinline__ void ph_gdn_chain(const P& p, int l, unsigned char* smem) {
    const int tid = tidx(), lane = tid & 63, wave = UNIFORM(tid >> 6), j = lane & 15, q = lane >> 4;
    for (int it = blockIdx.x; it < CH_ITEMS; it += gridDim.x) {
        const int half = it & 1, bh = it >> 1;
        const bf16_t* WK = WSP(bf16_t, WS_GWK) + (size_t)bh * NCH * 16384;
        const bf16_t* UTh = WSP(bf16_t, WS_GU) + (size_t)bh * NCH * 8192 + half * 4096;
        __syncthreads();
        if (wave >= 4) {
            const int pw = wave - 4;
            chain_stage(WK, UTh, 0, pw, lane, smem); chain_stage(WK, UTh, 1, pw, lane, smem);
#pragma unroll 1
            for (int n = 0; n < NCH; ++n) {
                if (n + 1 < NCH) WAIT_VM(10); else WAIT_VM(0);
                RAW_BARRIER();
                if (n + 2 < NCH) chain_stage(WK, UTh, n + 2, pw, lane, smem);
            }
        } else {
            const int sl = half * 4 + wave, c = 16 * sl + j;
            f32x4 S[8];
#pragma unroll
            for (int t = 0; t < 8; ++t) S[t] = (f32x4){0.f, 0.f, 0.f, 0.f};
            bf16x8 sB[4];
#pragma unroll
            for (int ks = 0; ks < 4; ++ks) sB[ks] = pack_tiles(S[2 * ks], S[2 * ks + 1]);
            const float* DC = WSP(float, WS_GD) + bh * NCH;
            float db[4];
#pragma unroll
            for (int d = 0; d < 4; ++d) db[d] = DC[d];
#pragma unroll 1
            for (int n0 = 0; n0 < NCH; n0 += 4) {
#pragma unroll
                for (int k4 = 0; k4 < 4; ++k4) {
                    const int n = n0 + k4, u = bh * NCH + n;
                    f32x4 acc[4]; const float dec = db[k4];
                    if (n + 4 < NCH) db[k4] = DC[n + 4];
                    { bf16_t* sp = WSP(bf16_t, WS_GS) + (size_t)u * 16384 + (size_t)sl * 2048 + lane * 4;
#pragma unroll
                      for (int t = 0; t < 8; ++t) { u32x2 w; w.x = pk2(S[t][0], S[t][1]); w.y = pk2(S[t][2], S[t][3]); *(u32x2*)(sp + 256 * t) = w; } }
                    WAIT_LGKM0();
                    RAW_BARRIER();
                    const LAS unsigned char* slot = (const LAS unsigned char*)smem + (n % CH_NSLOT) * CH_SLOT + lane * 16; LAUNDER_V(slot);
                    { const LAS unsigned char* us = (const LAS unsigned char*)smem + (n % CH_NSLOT) * CH_SLOT + 32768 + ((16 * wave + j) * 64 + 4 * q) * 2; LAUNDER_V(us);
#pragma unroll
                      for (int mt = 0; mt < 4; ++mt) { const u32x2 w = *(const LAS u32x2*)(us + 32 * mt); acc[mt] = (f32x4){bf2f((bf16_t)(w.x & 0xffff)), bf2f((bf16_t)(w.x >> 16)), bf2f((bf16_t)(w.y & 0xffff)), bf2f((bf16_t)(w.y >> 16))}; } }
                    bf16x8 fa[8], fb[8];
#pragma unroll
                    for (int i = 0; i < 8; ++i) fa[i] = *(const LAS bf16x8*)(slot + i * 1024);
#pragma unroll
                    for (int i = 0; i < 8; ++i) fb[i] = *(const LAS bf16x8*)(slot + (8 + i) * 1024);
                    COMPILER_FENCE();
#pragma unroll
                    for (int ks = 0; ks < 4; ++ks) { acc[0] = MFMA16(fa[ks], sB[ks], acc[0]); acc[1] = MFMA16(fa[4 + ks], sB[ks], acc[1]); }
                    COMPILER_FENCE();
#pragma unroll
                    for (int i = 0; i < 8; ++i) fa[i] = *(const LAS bf16x8*)(slot + 16384 + i * 1024);
#pragma unroll
                    for (int ks = 0; ks < 4; ++ks) { acc[2] = MFMA16(fb[ks], sB[ks], acc[2]); acc[3] = MFMA16(fb[4 + ks], sB[ks], acc[3]); }
                    COMPILER_FENCE();
#pragma unroll
                    for (int i = 0; i < 8; ++i) fb[i] = *(const LAS bf16x8*)(slot + 16384 + (8 + i) * 1024);
                    { bf16_t* vp = WSP(bf16_t, WS_GV) + (size_t)u * 8192 + (size_t)sl * 1024 + lane * 4;
#pragma unroll
                      for (int mt = 0; mt < 4; ++mt) { u32x2 w; w.x = pk2(acc[mt][0], acc[mt][1]); w.y = pk2(acc[mt][2], acc[mt][3]); *(u32x2*)(vp + 256 * mt) = w; } }
                    const bf16x8 vB0 = pack_tiles(acc[0], acc[1]), vB1 = pack_tiles(acc[2], acc[3]);
#pragma unroll
                    for (int t = 0; t < 8; ++t) S[t] = S[t] * dec;
                    COMPILER_FENCE();
#pragma unroll
                    for (int t = 0; t < 4; ++t) S[t] = MFMA16(fa[2 * t], vB0, S[t]);
#pragma unroll
                    for (int t = 0; t < 4; ++t) S[t] = MFMA16(fa[2 * t + 1], vB1, S[t]);
#pragma unroll
                    for (int t = 0; t < 4; ++t) S[4 + t] = MFMA16(fb[2 * t], vB0, S[4 + t]);
#pragma unroll
                    for (int t = 0; t < 4; ++t) S[4 + t] = MFMA16(fb[2 * t + 1], vB1, S[4 + t]);
                    COMPILER_FENCE();
#pragma unroll
                    for (int ks = 0; ks < 4; ++ks) sB[ks] = pack_tiles(S[2 * ks], S[2 * ks + 1]);
                }
            }
            float* o = p.out + O_PGDN + ((size_t)l * PB * 4 + bh) * 16384 + c;
#pragma unroll
            for (int t = 0; t < 8; ++t)
#pragma unroll
                for (int e = 0; e < 4; ++e) o[(size_t)(16 * t + 4 * q + e) * 128] = S[t][e];
        }
    }
}
__device__ __forceinline__ void ph_gdn_out(const P& p, int l) {
    const int tid = tidx(), lane = tid & 63, wave = tid >> 6, j = lane & 15, q = lane >> 4, mt = wave & 3;
    const bf16_t* PR = WSP(bf16_t, WS_PROJ);
    for (int u = blockIdx.x * 2 + (wave >> 2); u < NUNIT; u += gridDim.x * 2) {
        const int n = u % NCH, h = (u / NCH) % 4, b = u / (NCH * 4);
        f32x4 acc[8];
#pragma unroll
        for (int ct = 0; ct < 8; ++ct) acc[ct] = (f32x4){0.f, 0.f, 0.f, 0.f};
        const bf16_t* qg = WSP(bf16_t, WS_GQ) + (size_t)u * 8192 + (16 * mt + j) * 128 + 8 * q;
        const bf16_t* st = WSP(bf16_t, WS_GS) + (size_t)u * 16384 + (size_t)(q >> 1) * 256 + ((2 * (q & 1)) * 16 + j) * 4;
#pragma unroll
        for (int ks = 0; ks < 4; ++ks) { const bf16x8 a = *(const bf16x8*)(qg + 32 * ks);
#pragma unroll
            for (int ct = 0; ct < 8; ++ct) { const bf16_t* sp = st + (size_t)ct * 2048 + ks * 512; const u32x2 lo = *(const u32x2*)sp, hi = *(const u32x2*)(sp + 64); u32x4 w; w.x = lo.x; w.y = lo.y; w.z = hi.x; w.w = hi.y;
                acc[ct] = MFMA16(a, __builtin_bit_cast(bf16x8, w), acc[ct]); }
            COMPILER_FENCE(); }
        const bf16_t* at = WSP(bf16_t, WS_GA) + (size_t)u * 4096 + (16 * mt + j) * 64 + 8 * q;
        const bf16_t* vt = WSP(bf16_t, WS_GV) + (size_t)u * 8192 + (size_t)(q >> 1) * 256 + ((2 * (q & 1)) * 16 + j) * 4;
#pragma unroll
        for (int ks = 0; ks < 2; ++ks) { const bf16x8 a = *(const bf16x8*)(at + 32 * ks);
#pragma unroll
            for (int ct = 0; ct < 8; ++ct) { const bf16_t* vp = vt + (size_t)ct * 1024 + ks * 512; const u32x2 lo = *(const u32x2*)vp, hi = *(const u32x2*)(vp + 64); u32x4 w; w.x = lo.x; w.y = lo.y; w.z = hi.x; w.w = hi.y;
                acc[ct] = MFMA16(a, __builtin_bit_cast(bf16x8, w), acc[ct]); }
            COMPILER_FENCE(); }
        float sq[4];
#pragma unroll
        for (int e = 0; e < 4; ++e) { float s = 0.f;
#pragma unroll
            for (int ct = 0; ct < 8; ++ct) s += acc[ct][e] * acc[ct][e];
            s += __shfl_xor(s, 1); s += __shfl_xor(s, 2); s += __shfl_xor(s, 4); s += __shfl_xor(s, 8); sq[e] = 1.0f / sqrtf(s * (1.0f / 128.0f) + EPS); }
#pragma unroll
        for (int e = 0; e < 4; ++e) { const size_t row = (size_t)(b * T + n * 64 + 16 * mt + 4 * q + e);
#pragma unroll
            for (int ct = 0; ct < 8; ++ct) { const int c = 16 * ct + j; const float z = bf2f(PR[row * NPROJ + C_Z + h * 128 + c]);
                WSP(bf16_t, WS_O)[row * D + 512 + h * 128 + c] = f2bf(acc[ct][e] * sq[e] * p.gdn_norm[l * 128 + c] * silu_f(z)); } }
    }
}
__device__ __forceinline__ void ph_gdn_sample(const P& p, int l, unsigned char* smem) {
    float* qs = (float*)smem; float* ks = qs + 8 * QP; float* vs = ks + 8 * QP; float* us = vs + 8 * QP; float* wsm = us + 8 * 128; float* vn = wsm + 8 * 128;
    float* Ls = vn + 8 * 128; float* As = Ls + 8 * 8; float* gs = As + 8 * 8; float* gcs = gs + 8; float* bts = gcs + 8; float* S0 = bts + 8;
    const int tid = tidx(); const bf16_t* PR = WSP(bf16_t, WS_PROJ);
    for (int u = gridDim.x - 1 - blockIdx.x; u < DB * 4; u += gridDim.x) {
        const int h = u & 3, b = u >> 2;
        __syncthreads();
#pragma unroll 4
        for (int e = tid; e < 16384; e += NTHR) S0[e] = p.state_gdn[(((size_t)l * DB + b) * 4 + h) * 16384 + e];
        if (tid < 384) { const int sec = tid >> 7, c = tid & 127, col = sec * 512 + h * 128 + c; float* dst = sec == 0 ? qs : sec == 1 ? ks : vs;
            const float w0 = p.conv_w[(l * 4 + 0) * 1536 + col], w1 = p.conv_w[(l * 4 + 1) * 1536 + col], w2 = p.conv_w[(l * 4 + 2) * 1536 + col], w3 = p.conv_w[(l * 4 + 3) * 1536 + col];
            const float* hist = p.state_conv + (((size_t)l * DB + b) * 3) * 1536 + col; const bf16_t* src = PR + (size_t)(MP + b * DS) * NPROJ + C_CONV + col;
            float x0 = hist[0], x1 = hist[1536], x2 = hist[2 * 1536];
            for (int i = 0; i < DS; ++i) { const float x3 = bf2f(src[(size_t)i * NPROJ]); const float y = w0 * x0 + w1 * x1 + w2 * x2 + w3 * x3; dst[i * QP + c] = silu_f(y); x0 = x1; x1 = x2; x2 = x3; } }
        else if (tid < 384 + DS) { const int i = tid - 384; const size_t row = (size_t)(MP + b * DS + i); gs[i] = WSP(float, WS_G)[row * 4 + h]; bts[i] = WSP(float, WS_BETA)[row * 4 + h]; }
        __syncthreads();
        if (tid < 64) { const int rid = tid >> 2, part = tid & 3; float* rowp = (rid < 8 ? qs + rid * QP : ks + (rid - 8) * QP) + part * 32; float s = 0.f;
            for (int d = 0; d < 32; ++d) s += rowp[d] * rowp[d];
            s += __shfl_xor(s, 1); s += __shfl_xor(s, 2); const float sc = 1.0f / sqrtf(s + EPS);
            for (int d = 0; d < 32; ++d) rowp[d] *= sc; }
        if (tid == 64) { float a = 0.f; for (int i = 0; i < DS; ++i) { a += gs[i]; gcs[i] = a; } }
        __syncthreads();
        if (tid < 64) { const int i = tid >> 3, j = tid & 7; float lv = 0.f, av = 0.f;
            if (j <= i) { float dk = 0.f, dq = 0.f; for (int d = 0; d < 128; ++d) { const float kj = ks[j * QP + d]; dk += ks[i * QP + d] * kj; dq += qs[i * QP + d] * kj; }
                const float e = expf(gcs[i] - gcs[j]); av = dq * e * 0.08838834764831845f; lv = j < i ? bts[i] * dk * e : 0.f; }
            Ls[i * 8 + j] = lv; As[i * 8 + j] = av; }
        __syncthreads();
        if (tid < 256) { const int c = tid; float X[8];
            if (c < 128) {
#pragma unroll
                for (int i = 0; i < 8; ++i) X[i] = vs[i * QP + c] * bts[i]; }
            else {
#pragma unroll
                for (int i = 0; i < 8; ++i) X[i] = ks[i * QP + c - 128] * bts[i] * expf(gcs[i]); }
            fwd_subst<8, 8>(X, Ls);
            float* dst = c < 128 ? us + c : wsm + c - 128;
#pragma unroll
            for (int i = 0; i < 8; ++i) dst[i * 128] = X[i]; }
        __syncthreads();
        const int i = tid >> 6, c2 = (tid & 63) * 2;
        { float a0 = us[i * 128 + c2], a1 = us[i * 128 + c2 + 1];
          for (int d = 0; d < 128; ++d) { const float w = wsm[i * 128 + d]; a0 -= w * S0[d * 128 + c2]; a1 -= w * S0[d * 128 + c2 + 1]; }
          vn[i * 128 + c2] = a0; vn[i * 128 + c2 + 1] = a1; }
        __syncthreads();
        { float o0 = 0.f, o1 = 0.f; const float qsc = 0.08838834764831845f * expf(gcs[i]);
          for (int d = 0; d < 128; ++d) { const float qg = qs[i * QP + d] * qsc; o0 += qg * S0[d * 128 + c2]; o1 += qg * S0[d * 128 + c2 + 1]; }
          for (int j = 0; j < DS; ++j) { const float a = As[i * 8 + j]; o0 += a * vn[j * 128 + c2]; o1 += a * vn[j * 128 + c2 + 1]; }
          const float rstd = 1.0f / sqrtf(wave_sum(o0 * o0 + o1 * o1) * (1.0f / 128.0f) + EPS);
          const size_t row = (size_t)(MP + b * DS + i);
          const float z0 = bf2f(PR[row * NPROJ + C_Z + h * 128 + c2]), z1 = bf2f(PR[row * NPROJ + C_Z + h * 128 + c2 + 1]);
          bf16_t* O = WSP(bf16_t, WS_O) + row * D + 512 + h * 128 + c2;
          O[0] = f2bf(o0 * rstd * p.gdn_norm[l * 128 + c2] * silu_f(z0)); O[1] = f2bf(o1 * rstd * p.gdn_norm[l * 128 + c2 + 1] * silu_f(z1)); }
        { const float gl = gcs[DS - 1], dec = expf(gl); float* o = p.out + O_SGDN + (((size_t)l * DB + b) * 4 + h) * 16384;
#pragma unroll 2
          for (int e = tid; e < 16384; e += NTHR) { const int d = e >> 7, c = e & 127; float s = S0[e] * dec;
              for (int j = 0; j < DS; ++j) s += ks[j * QP + d] * expf(gl - gcs[j]) * vn[j * 128 + c];
              o[e] = s; } }
    }
}


template <int K> __device__ __forceinline__ void ph_gemm_small(const P& p, const bf16_t* A  , const bf16_t* Bt  , const float* gate, const float* xs_in  , unsigned char* smem) {
    static_assert(MS % 16 == 0 && K % 256 == 0, "small GEMM shape");
    constexpr int KW = K / 8, NKS = KW / 32;
    const int tid = tidx(), lane = tid & 63, wave = tid >> 6, x = lane & 15, q = lane >> 4;
    float* red = (float*)smem;
    for (int it = blockIdx.x; it < (MS / 16) * 16; it += gridDim.x) {
        const int rt = it % (MS / 16), cg = it / (MS / 16);
        const bf16_t* ap = A + (size_t)(16 * rt + x) * K + wave * KW + 8 * q;
        const bf16_t* bp = Bt + (size_t)(64 * cg + x) * K + wave * KW + 8 * q;
        f32x4 acc[4];
#pragma unroll
        for (int ct = 0; ct < 4; ++ct) acc[ct] = (f32x4){0.f, 0.f, 0.f, 0.f};
#pragma unroll
        for (int ks = 0; ks < NKS; ++ks) { const bf16x8 a = *(const bf16x8*)(ap + 32 * ks);
#pragma unroll
            for (int ct = 0; ct < 4; ++ct) acc[ct] = MFMA16(a, *(const bf16x8*)(bp + (size_t)ct * 16 * K + 32 * ks), acc[ct]); }
        __syncthreads();
#pragma unroll
        for (int ct = 0; ct < 4; ++ct) *(f32x4*)(red + ((wave * 4 + ct) * 64 + lane) * 4) = acc[ct];
        __syncthreads();
        if (wave < 4) { f32x4 s = (f32x4){0.f, 0.f, 0.f, 0.f};
#pragma unroll
            for (int w = 0; w < 8; ++w) s += *(const f32x4*)(red + ((w * 4 + wave) * 64 + lane) * 4);
            const int col = 64 * cg + 16 * wave + x;
#pragma unroll
            for (int e = 0; e < 4; ++e) { const int row = MP + 16 * rt + 4 * q + e; float* xp = p.out + (size_t)row * D + col; const float xin = xs_in ? xs_in[(size_t)(row - MP) * D + col] : *xp; *xp = xin + gate[(size_t)row_cb(row) * 6144 + col] * s[e]; } }
    }
}

__device__ __forceinline__ void ph_final_norm(const P& p) {
    const int lane = tidx() & 63, wave = tidx() >> 6, gw = blockIdx.x * 8 + wave, ngw = gridDim.x * 8;
    for (int r = gw; r < M; r += ngw) {
        float* xr = p.out + (size_t)r * D; f32x4 v[4]; float ss = 0.f;
#pragma unroll
        for (int j = 0; j < 4; ++j) { v[j] = *(const f32x4*)(xr + 4 * lane + 256 * j); ss += (v[j][0] * v[j][0] + v[j][1] * v[j][1]) + (v[j][2] * v[j][2] + v[j][3] * v[j][3]); }
        const float rstd = 1.0f / sqrtf(wave_sum(ss) * (1.0f / D) + EPS);
#pragma unroll
        for (int j = 0; j < 4; ++j) { const f32x4 g = *(const f32x4*)(p.final_norm + 4 * lane + 256 * j); *(f32x4*)(xr + 4 * lane + 256 * j) = v[j] * rstd * g; }
    }
}

enum Phase { PH_PRO = 0, PH_NORM1, PH_GEMM_IN, PH_ROPE, PH_MIX1, PH_MIX2, PH_MIX3, PH_GEMM_OUT, PH_NORM2, PH_GEMM_GU, PH_GEMM_DN, PH_FINAL };
#ifdef __HIP_EMU__
#define LDSP(x) (x)
#else
#define LDSP(x) ((PG8_LAS unsigned char*)(x))
#endif
template <int PH> __device__ __forceinline__ void run_phase(const P& p, int l, unsigned char* smem) {
    if constexpr (PH == PH_PRO) { ph_convert(p, smem); __syncthreads(); ph_adaln(p, smem); ph_ropetab_copyx(p); }
    else if constexpr (PH == PH_NORM1) ph_norm_mod<0>(p, l);
    else if constexpr (PH == PH_GEMM_IN) {
        pg8::Gemm g{WSP(bf16_t, WS_H), WSP(bf16_t, WS_WIN) + (size_t)l * NPROJ * D, MPAD, NPROJ, D}; pg8::StaticOrder S; S.init(MPAD, NPROJ, (int)gridDim.x, (int)blockIdx.x);
        pg8::EpiStoreBf16 E{WSP(bf16_t, WS_PROJ), NPROJ};
        pg8::gemm_phase<pg8::EpiStoreBf16, pg8::StaticOrder, true, true>(LDSP(smem), g, S, E);
    }
    else if constexpr (PH == PH_ROPE) { ph_rope_out(p, l); ph_vtrans(p, l, smem); }
    else if constexpr (PH == PH_MIX1) { ph_ret_local(p, l); ph_gdn_prep(p, l, smem); }
    else if constexpr (PH == PH_MIX2) { ph_gdn_chain(p, l, smem); { const int G = (int)gridDim.x; const bool split = G >= CH_ITEMS + DB * 4 + 16; ph_attn_jobs(p, split ? CH_ITEMS : 0, split ? G - DB * 4 : G); }
        __syncthreads(); ph_attn_sample(p, l, smem); ph_ret_sample(p, l, smem); ph_gdn_sample(p, l, smem); ph_ret_scan(p, l); }
    else if constexpr (PH == PH_MIX3) { ph_attn_combine(p); ph_ret_out(p, l); ph_gdn_out(p, l); }
    else if constexpr (PH == PH_GEMM_OUT) {
        ph_gemm_small<D>(p, WSP(bf16_t, WS_O) + (size_t)MP * D, WSP(bf16_t, WS_WOUT) + (size_t)l * D * D, WSP(float, WS_MOD) + (size_t)l * NC * 6144 + 2048, l == 0 ? p.x_sample : nullptr, smem); __syncthreads();
        pg8::Gemm g{WSP(bf16_t, WS_O), WSP(bf16_t, WS_WOUT) + (size_t)l * D * D, MP, D, D}; pg8::StaticOrder S; S.init(MP, D, (int)gridDim.x, (int)blockIdx.x);
        pg8::EpiResidual E{p.out, WSP(float, WS_MOD) + (size_t)l * NC * 6144 + 2048, l == 0 ? p.x_prompt : p.out};
        pg8::gemm_phase<pg8::EpiResidual, pg8::StaticOrder, true, true>(LDSP(smem), g, S, E);
    }
    else if constexpr (PH == PH_NORM2) ph_norm_mod<1>(p, l);
    else if constexpr (PH == PH_GEMM_GU) {
        pg8::Gemm g{WSP(bf16_t, WS_H), WSP(bf16_t, WS_WGU) + (size_t)l * 2 * FF * D, MPAD, 2 * FF, D}; pg8::StaticOrder S; S.init(MPAD, 2 * FF, (int)gridDim.x, (int)blockIdx.x);
        pg8::EpiSwiglu E{WSP(bf16_t, WS_HID)};
        pg8::gemm_phase<pg8::EpiSwiglu, pg8::StaticOrder, true, true>(LDSP(smem), g, S, E);
    }
    else if constexpr (PH == PH_GEMM_DN) {
        ph_gemm_small<FF>(p, WSP(bf16_t, WS_HID) + (size_t)MP * FF, WSP(bf16_t, WS_WDN) + (size_t)l * D * FF, WSP(float, WS_MOD) + (size_t)l * NC * 6144 + 5120, nullptr, smem); __syncthreads();
        pg8::Gemm g{WSP(bf16_t, WS_HID), WSP(bf16_t, WS_WDN) + (size_t)l * D * FF, MP, D, FF}; pg8::StaticOrder S; S.init(MP, D, (int)gridDim.x, (int)blockIdx.x);
        pg8::EpiResidual E{p.out, WSP(float, WS_MOD) + (size_t)l * NC * 6144 + 5120, p.out};
        pg8::gemm_phase<pg8::EpiResidual, pg8::StaticOrder, true, true>(LDSP(smem), g, S, E);
    }
    else if constexpr (PH == PH_FINAL) ph_final_norm(p);
}
template <int PH> __global__ void __launch_bounds__(NTHR, 2) k_phase(P p, int l) { DYN_SMEM(smem); run_phase<PH>(p, l, smem); }


#ifndef __HIP_EMU__
#define LAS __attribute__((address_space(3)))
#define XB_TMO      128
#define XB_XCNT(j)  (256  + 64 * (j))
#define XB_XSUB(j)  (1280 + 64 * (j))
#define XB_XGEN(j)  (2304 + 64 * (j))
#define XB_TOP      3328
#define XB_TOPGEN   3392
#define XCD_BAR_WORDS 3456
#define XB_SPIN_CAP (1u << 18)

__device__ __forceinline__ unsigned xb_ld(unsigned* p)              { return __hip_atomic_load(p, __ATOMIC_RELAXED, __HIP_MEMORY_SCOPE_AGENT); }
__device__ __forceinline__ unsigned xb_add(unsigned* p, unsigned v) { return __hip_atomic_fetch_add(p, v, __ATOMIC_RELAXED, __HIP_MEMORY_SCOPE_AGENT); }
__device__ __forceinline__ unsigned xb_xcc_id() { return (unsigned)__builtin_amdgcn_s_getreg((3 << 11) | 20) & 0xFu; }
#define XB_SPIN(cond, bar) do { unsigned _sp = 0; while (cond) { __builtin_amdgcn_s_sleep(1); \
    if ((++_sp & 255u) == 0u) { if (xb_ld(&(bar)[XB_TMO])) break; if (_sp > XB_SPIN_CAP) { atomicAdd(&(bar)[XB_TMO], 1u); break; } } } } while (0)

struct XcdBarrier {
    unsigned* bar; unsigned x;
    volatile LAS unsigned* st;
};

__device__ __forceinline__ XcdBarrier xcd_barrier_post(unsigned* bar, volatile LAS unsigned* st) {
    XcdBarrier b; b.bar = bar; b.x = xb_xcc_id(); b.st = st;
    if (threadIdx.x == 0) (void)xb_add(&bar[XB_XCNT(b.x)], 1u);
    return b;
}
__device__ __forceinline__ void xcd_barrier_complete(unsigned* bar, unsigned x, unsigned& nloc, unsigned& nx) {
    const unsigned G = gridDim.x * gridDim.y * gridDim.z;
    unsigned sum, cnt, mine, sp = 0u;
    for (;;) {
        sum = 0u; cnt = 0u; mine = 0u;
#pragma unroll
        for (unsigned j = 0; j < 16; ++j) { const unsigned c = xb_ld(&bar[XB_XCNT(j)]); sum += c; cnt += (c > 0u) ? 1u : 0u; mine = (j == x) ? c : mine; }
        if (sum == G) break;
        __builtin_amdgcn_s_sleep(1);
        if ((++sp & 255u) == 0u) { if (xb_ld(&bar[XB_TMO])) break; if (sp > XB_SPIN_CAP) { atomicAdd(&bar[XB_TMO], 1u); break; } }
    }
    nloc = mine > 0u ? mine : 1u; nx = cnt > 0u ? cnt : 1u;
}

__device__ __forceinline__ void xcd_barrier(const XcdBarrier& b) {
    asm volatile("s_waitcnt vmcnt(0)" ::: "memory");
    __syncthreads();
    if (threadIdx.x == 0) {
        unsigned* bar = b.bar;
        __builtin_amdgcn_s_waitcnt(0);
        unsigned nloc = b.st[0], nx = b.st[1];
        if (nloc == 0u) { xcd_barrier_complete(bar, b.x, nloc, nx); b.st[0] = nloc; b.st[1] = nx; }
        const unsigned old = xb_add(&bar[XB_XSUB(b.x)], 1u);
        const unsigned gen = old / nloc;
        if (old + 1u == (gen + 1u) * nloc) {
            __builtin_amdgcn_fence(__ATOMIC_RELEASE, "agent");
            asm volatile("s_waitcnt vmcnt(0)" ::: "memory");
            const unsigned og = xb_add(&bar[XB_TOP], 1u);
            const unsigned tg = og / nx;
            if (og + 1u == (tg + 1u) * nx) xb_add(&bar[XB_TOPGEN], 1u);
            else XB_SPIN(xb_ld(&bar[XB_TOPGEN]) == tg, bar);
            __builtin_amdgcn_fence(__ATOMIC_ACQUIRE, "agent");
            xb_add(&bar[XB_XGEN(b.x)], 1u);
            asm volatile("s_waitcnt vmcnt(0)" ::: "memory");
        } else {
            XB_SPIN(xb_ld(&bar[XB_XGEN(b.x)]) == gen, bar);
            __builtin_amdgcn_fence(__ATOMIC_ACQUIRE, "agent");
            asm volatile("s_waitcnt vmcnt(0)" ::: "memory");
        }
    }
    __syncthreads();
}

#endif

#ifndef __HIP_EMU__
#define GRID_SYNC() xcd_barrier(bar)
__global__ void __launch_bounds__(NTHR, 2) k_mega(P p_arg) {
    DYN_SMEM(smem);
#if defined(__HIP_DEVICE_COMPILE__)
#define PHASE(PH_, l_) do { const __attribute__((address_space(4))) P* kp_ = (const __attribute__((address_space(4))) P*)__builtin_amdgcn_kernarg_segment_ptr(); LAUNDER_PTR(kp_); P pl_; __builtin_memcpy(&pl_, kp_, sizeof(P)); run_phase<PH_>(pl_, l_, smem); } while (0)
#else
#define PHASE(PH_, l_) run_phase<PH_>(p_arg, l_, smem)
#endif
    cooperative_groups::grid_group grid = cooperative_groups::this_grid();
    volatile LAS unsigned* bst = (volatile LAS unsigned*)((LAS unsigned char*)smem + BAR_LDS_OFF);
    if (threadIdx.x < 4) bst[threadIdx.x] = 0u;
    __syncthreads();
    XcdBarrier bar = xcd_barrier_post((unsigned*)(p_arg.ws + WS_CTL + 4096), bst);
    PHASE(PH_PRO, 0); grid.sync();
#define LAYER(l) do { PHASE(PH_NORM1, l); GRID_SYNC(); PHASE(PH_GEMM_IN, l); GRID_SYNC(); PHASE(PH_ROPE, l); GRID_SYNC(); PHASE(PH_MIX1, l); GRID_SYNC(); PHASE(PH_MIX2, l); GRID_SYNC(); \
        PHASE(PH_MIX3, l); GRID_SYNC(); PHASE(PH_GEMM_OUT, l); GRID_SYNC(); PHASE(PH_NORM2, l); GRID_SYNC(); PHASE(PH_GEMM_GU, l); GRID_SYNC(); PHASE(PH_GEMM_DN, l); GRID_SYNC(); } while (0)
    static_assert(NL == 2, "two layers written out (a loop over the layers makes hipcc hoist every phase's constants to the loop preheader and spill)");
    LAYER(0); LAYER(1);
    PHASE(PH_FINAL, 0);
}
#endif

template <int PH> static void launch_phase(const P& p, int l, int grid, hipStream_t stream) {
#ifndef __HIP_EMU__
    static bool attr_done = false;
    if (!attr_done) { (void)hipFuncSetAttribute((const void*)k_phase<PH>, hipFuncAttributeMaxDynamicSharedMemorySize, SMEM_BYTES); attr_done = true; }
#endif
    LAUNCH(k_phase<PH>, grid, SMEM_BYTES, stream, p, l);
}

extern "C" void kernel_launch(void* const* d_in, const int* in_sizes, int n_in, void* d_out, int out_size, void* d_ws, size_t ws_size, hipStream_t stream) {
    if (n_in != 24 || (size_t)out_size != O_END || ws_size < WS_END) {
        fprintf(stderr, "kernel_launch: shape mismatch: n_in %d out_size %d (want %zu) ws %zu (want %zu)\n", n_in, out_size, (size_t)O_END, ws_size, (size_t)WS_END); return; }
    P p{};
    const float** pp = (const float**)&p;
    for (int i = 0; i < 24; ++i) pp[i] = (const float*)d_in[i];
    p.out = (float*)d_out; p.ws = (unsigned char*)d_ws;
#ifndef __HIP_EMU__
    static int grid = 0;
    if (grid == 0) {
        int dev = 0, cus = 0, per_cu = 0;
        if (hipGetDevice(&dev) != hipSuccess || hipDeviceGetAttribute(&cus, hipDeviceAttributeMultiprocessorCount, dev) != hipSuccess || cus <= 0) { fprintf(stderr, "kernel_launch: device query failed\n"); grid = -1; return; }
        if (hipFuncSetAttribute((const void*)k_mega, hipFuncAttributeMaxDynamicSharedMemorySize, SMEM_BYTES) != hipSuccess) { fprintf(stderr, "kernel_launch: hipFuncSetAttribute failed\n"); grid = -1; return; }
        if (hipOccupancyMaxActiveBlocksPerMultiprocessor(&per_cu, (const void*)k_mega, NTHR, SMEM_BYTES) != hipSuccess || per_cu < 1) { fprintf(stderr, "kernel_launch: occupancy query says %d blocks per CU\n", per_cu); grid = -1; return; }
        grid = cus;
    }
    if (grid < 0) return;
    if (hipMemsetAsync((char*)d_ws + WS_CTL, 0, 65536, stream) != hipSuccess) { fprintf(stderr, "kernel_launch: memset of the barrier words failed\n"); return; }
    { void* args[] = {(void*)&p};
      hipError_t e = hipLaunchCooperativeKernel((const void*)k_mega, dim3(grid), dim3(NTHR), args, SMEM_BYTES, stream);
      if (e != hipSuccess) fprintf(stderr, "kernel_launch: cooperative launch failed: %s (grid %d)\n", hipGetErrorString(e), grid);
      return; }
#else
    int grid = 16;
#endif
    launch_phase<PH_PRO>(p, 0, grid, stream);
    for (int l = 0; l < NL; ++l) {
        launch_phase<PH_NORM1>(p, l, grid, stream);
        launch_phase<PH_GEMM_IN>(p, l, grid, stream);
        launch_phase<PH_ROPE>(p, l, grid, stream);
        launch_phase<PH_MIX1>(p, l, grid, stream);
        launch_phase<PH_MIX2>(p, l, grid, stream);
        launch_phase<PH_MIX3>(p, l, grid, stream);
        launch_phase<PH_GEMM_OUT>(p, l, grid, stream);
        launch_phase<PH_NORM2>(p, l, grid, stream);
        launch_phase<PH_GEMM_GU>(p, l, grid, stream);
        launch_phase<PH_GEMM_DN>(p, l, grid, stream);
    }
    launch_phase<PH_FINAL>(p, 0, grid, stream);
}
```

```cpp
#ifndef __HIP_EMU__
#include <hip/hip_runtime.h>
#include <hip/hip_cooperative_groups.h>
#endif
#include <cstdio>
#include <cstdint>
#include <cmath>

#ifndef CFG_BATCH
#define CFG_BATCH 2
#endif
#ifndef CFG_SEQ
#define CFG_SEQ 8192
#endif
#ifndef CFG_DB
#define CFG_DB 32
#endif
constexpr float LOG2E = 1.4426950408889634f;
constexpr int D = 1024, NL = 2, PB = CFG_BATCH, T = CFG_SEQ, DB = CFG_DB, DS = 8, PAST = 16384, WB = 2048;
constexpr int MP = PB * T, MS = DB * DS, M = MP + MS, MPAD = (M + 255) / 256 * 256, NC = PB + DB;
constexpr int INC = 3848, NPROJ = 3840, FF = 2816, NCH = T / 64, PWIN = T < 2048 ? T : 2048, NPOS = T + DS;
constexpr int NUNIT = PB * 4 * NCH;
constexpr float EPS = 1e-6f;
static_assert(T % 512 == 0, "the attention job decomposition wants T % 512 == 0");
constexpr int C_QA = 0, C_KA = 256, C_VA = 512, C_QR = 768, C_KR = 1024, C_VR = 1280, C_GR = 1536, C_CONV = 1792, C_Z = 3328;
constexpr int SMEM_BYTES = 147456;
constexpr int NTHR = 512;
constexpr int BAR_LDS_OFF = SMEM_BYTES - 64;

typedef unsigned short bf16_t;
typedef short bf16x8 __attribute__((ext_vector_type(8)));
typedef float f32x4 __attribute__((ext_vector_type(4)));
typedef unsigned u32x4 __attribute__((ext_vector_type(4)));
typedef unsigned u32x2 __attribute__((ext_vector_type(2)));
typedef float f32x16 __attribute__((ext_vector_type(16)));

#ifdef __HIP_EMU__
#define LAUNCH(kern, grid, lds, stream, ...) emu_launch(grid, NTHR, [=]() { kern(__VA_ARGS__); })
#define DYN_SMEM(name) unsigned char* name = emu_dyn_smem()
#define WAVE_SYNC() emu_wave_bar()
#define MFMA32(a, b, c) emu_mfma32(a, b, c)
#define GLDS16(gp, lp) memcpy((unsigned char*)(lp) + (threadIdx.x & 63) * 16, (gp), 16)
#define RAW_BARRIER() __syncthreads()
#define GLDS4(gp, lp) ((void)0)
#define WAIT_VM(n)
#define WAIT_LGKM0()
#define LAS
#define UNIFORM(x) (x)
#define COMPILER_FENCE()
#define LAUNDER_V(x)
#define MFMA16(a, b, c) emu_mfma16(a, b, c)
#else
#define WAVE_SYNC() asm volatile("s_waitcnt lgkmcnt(0)" ::: "memory")
#define MFMA32(a, b, c) __builtin_amdgcn_mfma_f32_32x32x16_bf16(a, b, c, 0, 0, 0)
#define LAS __attribute__((address_space(3)))
#define GLDS16(gp, lp) __builtin_amdgcn_global_load_lds((const unsigned*)(gp), (LAS unsigned*)(lp), 16, 0, 0)
#define RAW_BARRIER() __builtin_amdgcn_s_barrier()
#define GLDS4(gp, lp) __builtin_amdgcn_global_load_lds((const unsigned*)(gp), (LAS unsigned*)(lp), 4, 0, 0)
#define WAIT_VM(n) asm volatile("s_waitcnt vmcnt(" #n ")" ::: "memory")
#define WAIT_LGKM0() asm volatile("s_waitcnt lgkmcnt(0)" ::: "memory")
#define UNIFORM(x) __builtin_amdgcn_readfirstlane(x)
#define COMPILER_FENCE() __builtin_amdgcn_sched_barrier(0)
#define LAUNDER_V(x) asm volatile("" : "+v"(x))
#define MFMA16(a, b, c) __builtin_amdgcn_mfma_f32_16x16x32_bf16(a, b, c, 0, 0, 0)
#define LAUNCH(kern, grid, lds, stream, ...) hipLaunchKernelGGL(kern, dim3(grid), dim3(NTHR), lds, stream, __VA_ARGS__)
#define DYN_SMEM(name) extern __shared__ __attribute__((aligned(16))) unsigned char name[]
#endif

#ifdef __HIP_EMU__
__device__ __forceinline__ int tidx() { return (int)threadIdx.x; }
#define LAUNDER_PTR(x)
#else
__device__ __forceinline__ int tidx() { int t = (int)threadIdx.x; asm volatile("" : "+v"(t)); return t; }
#define LAUNDER_PTR(x) asm volatile("" : "+s"(x))
#endif
__device__ __forceinline__ float bf2f(bf16_t v) { return __builtin_bit_cast(float, (unsigned)v << 16); }
__device__ __forceinline__ bf16_t f2bf(float f) { unsigned u = __builtin_bit_cast(unsigned, f); return (bf16_t)((u + 0x7fffu + ((u >> 16) & 1u)) >> 16); }
#ifdef __HIP_EMU__
__device__ __forceinline__ unsigned pk2(float lo, float hi) { return (unsigned)f2bf(lo) | ((unsigned)f2bf(hi) << 16); }
#else
typedef float f32x2_t __attribute__((ext_vector_type(2))); typedef __bf16 bf16x2_t __attribute__((ext_vector_type(2)));
__device__ __forceinline__ unsigned pk2(float lo, float hi) { f32x2_t v = {lo, hi}; bf16x2_t b = __builtin_convertvector(v, bf16x2_t); return __builtin_bit_cast(unsigned, b); }
#endif
__device__ __forceinline__ bf16x8 pack_tiles(const f32x4& lo, const f32x4& hi) {
    u32x4 w; w.x = pk2(lo[0], lo[1]); w.y = pk2(lo[2], lo[3]); w.z = pk2(hi[0], hi[1]); w.w = pk2(hi[2], hi[3]); return __builtin_bit_cast(bf16x8, w);
}
__device__ __forceinline__ float silu_f(float x) { return x / (1.0f + expf(-x)); }
#ifdef __HIP_EMU__
__device__ __forceinline__ float silu_fast(float x) { return x / (1.0f + expf(-x)); }
#else
__device__ __forceinline__ float silu_fast(float x) { return x * __builtin_amdgcn_rcpf(1.0f + __builtin_amdgcn_exp2f(-LOG2E * x)); }
#endif
__device__ __forceinline__ float wave_sum(float v) {
#pragma unroll
    for (int o = 1; o < 64; o <<= 1) v += __shfl_xor(v, o);
    return v;
}
__device__ __forceinline__ float wave_max(float v) {
#pragma unroll
    for (int o = 1; o < 64; o <<= 1) v = fmaxf(v, __shfl_xor(v, o));
    return v;
}

struct P {
    const float *x_prompt, *x_sample, *cache_k, *cache_v, *state_ret, *state_gdn, *state_conv, *c_prompt, *c_sample, *ada_w, *ada_b, *norm_mix, *norm_ffn,
        *w_in, *ret_norm, *conv_w, *a_log, *dt_bias, *gdn_norm, *w_out, *w_gate, *w_up, *w_down, *final_norm;
    float* out; unsigned char* ws;
};

constexpr size_t O_YP = 0, O_YS = O_YP + (size_t)MP * D, O_PWK = O_YS + (size_t)MS * D, O_PWV = O_PWK + (size_t)NL * PB * PWIN * 256,
                 O_PRET = O_PWV + (size_t)NL * PB * PWIN * 256, O_PGDN = O_PRET + (size_t)NL * PB * 4 * 4096, O_PCONV = O_PGDN + (size_t)NL * PB * 4 * 16384,
                 O_SWK = O_PCONV + (size_t)NL * PB * 3 * 1536, O_SWV = O_SWK + (size_t)NL * DB * DS * 256, O_SRET = O_SWV + (size_t)NL * DB * DS * 256,
                 O_SGDN = O_SRET + (size_t)NL * DB * 4 * 4096, O_SCONV = O_SGDN + (size_t)NL * DB * 4 * 16384, O_END = O_SCONV + (size_t)NL * DB * 3 * 1536;

constexpr size_t al256(size_t x) { return (x + 255) / 256 * 256; }
constexpr size_t WS_CTL = 0, WS_CTL_BYTES = 1u << 20;
constexpr size_t WS_MOD = WS_CTL + WS_CTL_BYTES;
constexpr size_t WS_W8 = al256(WS_MOD + (size_t)NL * NC * 6144 * 4);
constexpr size_t WS_ROPE = al256(WS_W8 + (size_t)NL * D * 8 * 4);
constexpr size_t WS_WIN = al256(WS_ROPE + (size_t)4 * NPOS * 32 * 4);
constexpr size_t WS_WOUT = al256(WS_WIN + (size_t)NL * NPROJ * D * 2);
constexpr size_t WS_WGU = al256(WS_WOUT + (size_t)NL * D * D * 2);
constexpr size_t WS_WDN = al256(WS_WGU + (size_t)NL * 2 * FF * D * 2);
constexpr size_t WS_H = al256(WS_WDN + (size_t)NL * D * FF * 2);
constexpr size_t WS_PROJ = al256(WS_H + (size_t)MPAD * D * 2);
constexpr size_t WS_BETA = al256(WS_PROJ + (size_t)MPAD * NPROJ * 2);
constexpr size_t WS_G = al256(WS_BETA + (size_t)M * 4 * 4);
constexpr size_t WS_O = al256(WS_G + (size_t)M * 4 * 4);
constexpr size_t WS_RU = al256(WS_O + (size_t)MPAD * D * 2);
constexpr size_t WS_RS = al256(WS_RU + (size_t)NUNIT * 4096 * 4);
constexpr size_t WS_SCR = al256(WS_RS + (size_t)NUNIT * 4096 * 4);
constexpr size_t WS_GU = WS_SCR;
constexpr size_t WS_GWK = al256(WS_GU + (size_t)NUNIT * 8192 * 2);
constexpr size_t WS_GQ = al256(WS_GWK + (size_t)NUNIT * 16384 * 2);
constexpr size_t WS_GA = al256(WS_GQ + (size_t)NUNIT * 8192 * 2);
constexpr size_t WS_GD = al256(WS_GA + (size_t)NUNIT * 4096 * 2);
constexpr size_t WS_GV = al256(WS_GD + (size_t)NUNIT * 4);
constexpr size_t WS_GS = al256(WS_GV + (size_t)NUNIT * 8192 * 2);
constexpr size_t WS_GEND = al256(WS_GS + (size_t)NUNIT * 16384 * 2);
constexpr size_t ATT_CLS = (size_t)PB * 4 * (T / 32) * 2048;
constexpr size_t WS_KF = WS_GEND;
constexpr size_t WS_VF = al256(WS_KF + 3 * ATT_CLS * 2);
constexpr size_t WS_KRT = al256(WS_VF + 3 * ATT_CLS * 2);
constexpr size_t WS_VRT = al256(WS_KRT + (size_t)MP * 256 * 2);
constexpr size_t WS_AML = al256(WS_VRT + (size_t)MP * 256 * 2);
constexpr size_t WS_AEND = al256(WS_AML + (size_t)MP * 4 * 3 * 2 * 4);
constexpr size_t WS_APO = WS_H;
static_assert((size_t)MP * 4 * 3 * 64 * 2 <= (size_t)MPAD * D * 2, "attention partials overlay H");
constexpr size_t WS_HID = WS_SCR;
constexpr size_t WS_HEND = al256(WS_HID + (size_t)MPAD * FF * 2);
constexpr size_t WS_END = WS_AEND > WS_HEND ? WS_AEND : WS_HEND;

#define WSP(T_, off) ((T_*)(p.ws + (off)))
__device__ __forceinline__ int row_cb(int r) { return r < MP ? r / T : PB + (r - MP) / DS; }
__device__ __forceinline__ int row_pi(int r) { return r < MP ? r % T : T + (r - MP) % DS; }
namespace pg8 {
#ifdef __HIP_EMU__
#define PG8_LAS
#else
#define PG8_LAS __attribute__((address_space(3)))
#endif
typedef unsigned short bf16_t;
typedef short bf16x8 __attribute__((ext_vector_type(8)));
typedef float f32x4 __attribute__((ext_vector_type(4)));
typedef unsigned u32x4 __attribute__((ext_vector_type(4)));
constexpr int BM = 256, BK = 64, HALF = 128, HTB = HALF * BK * 2  , STAGE_BYTES = 8 * HTB, NXCD = 8, WGM = 8;

__host__ __device__ __forceinline__ int lds_byte(int r, int c) { const int st = (r >> 4) * 2 + (c >> 5), rr = r & 15, cc = c & 31, ob = rr * 64 + cc * 2; return st * 1024 + (ob ^ (((ob >> 9) & 1) << 5)); }
__host__ __device__ __forceinline__ void stage_rc(int b, int& R, int& C) { const int st = b / 1024, sb = b % 1024, swz = sb ^ (((sb >> 9) & 1) << 5); R = (st >> 1) * 16 + swz / 64; C = (st & 1) * 32 + (swz % 64) / 2; }
__host__ __device__ __forceinline__ int perm32(int rho) { const int n = rho >> 4, i = rho & 15; return 8 * (i >> 2) + 4 * n + (i & 3); }

struct Unit { int pm, pn; };
struct Gemm { const bf16_t* A; const bf16_t* Bt; int M, N, K; };

struct StaticOrder {
    int nM, nN, nwg, G, c;
    __host__ __device__ void init(int M, int N, int G_, int c_) { nM = M / BM; nN = N / BM; nwg = nM * nN; G = G_; c = c_; }
    __host__ __device__ bool next(int i, Unit& u) const {
        const long L = (long)i * G + c; if (L >= nwg) return false;
        int wgid = (int)L; { const int q = nwg / NXCD, r = nwg % NXCD, xcd = wgid % NXCD, off = wgid / NXCD; wgid = (xcd < r ? xcd * (q + 1) : r * (q + 1) + (xcd - r) * q) + off; }
        const int nig = WGM * nN, gid = wgid / nig, fm = gid * WGM, gsz = (nM - fm) < WGM ? (nM - fm) : WGM;
        u.pm = fm + ((wgid % nig) % gsz); u.pn = (wgid % nig) / gsz; return true;
    }
    __device__ __forceinline__ void a_ready(const Unit&) const {}
    __device__ __forceinline__ void done(const Unit&) const {}
};


struct EpiStoreBf16 {
    static constexpr bool PERM = true, AFTER_DRAIN = false;
    bf16_t* O; int ldc;
    __device__ __forceinline__ void operator()(const f32x4 (&acc)[2][2][4][2], const Unit& u, int wr, int wc, int fr, int fq) const {
        const int row0 = u.pm * BM + wr * 64 + fr, col0 = u.pn * BM + wc * 32 + 8 * fq;
#pragma unroll
        for (int ai = 0; ai < 2; ++ai)
#pragma unroll
            for (int m = 0; m < 4; ++m) { bf16_t* rowp = O + (size_t)(row0 + ai * HALF + m * 16) * ldc + col0;
#pragma unroll
                for (int bj = 0; bj < 2; ++bj) { const f32x4 v0 = acc[ai][bj][m][0], v1 = acc[ai][bj][m][1];
                    u32x4 w; w.x = ::pk2(v0[0], v0[1]); w.y = ::pk2(v0[2], v0[3]); w.z = ::pk2(v1[0], v1[1]); w.w = ::pk2(v1[2], v1[3]);
                    *(u32x4*)(rowp + bj * HALF) = w; } }
    }
};
struct EpiResidual {
    static constexpr bool PERM = false, AFTER_DRAIN = false;
    float* X; const float* gate; const float* Xin;
    __device__ __forceinline__ void operator()(const f32x4 (&acc)[2][2][4][2], const Unit& u, int wr, int wc, int fr, int fq) const {
        const int row0 = u.pm * BM + wr * 64 + fr, col0 = u.pn * BM + wc * 32 + 4 * fq;
#pragma unroll
        for (int ai = 0; ai < 2; ++ai)
#pragma unroll
            for (int m = 0; m < 4; ++m) { const int row = row0 + ai * HALF + m * 16;
                if (MPAD != M && row >= M) continue;
                const float* g = gate + (size_t)::row_cb(row) * 6144 + col0; float* xp = X + (size_t)row * D + col0; const float* xi = Xin + (size_t)row * D + col0;
#pragma unroll
                for (int bj = 0; bj < 2; ++bj)
#pragma unroll
                    for (int n = 0; n < 2; ++n) { const f32x4 gv = *(const f32x4*)(g + bj * HALF + n * 16); f32x4* xq = (f32x4*)(xp + bj * HALF + n * 16); *xq = *(const f32x4*)(xi + bj * HALF + n * 16) + gv * acc[ai][bj][m][n]; } }
    }
};
struct EpiSwiglu {
    static constexpr bool PERM = true, AFTER_DRAIN = false;
    bf16_t* Hd;
    __device__ __forceinline__ void operator()(const f32x4 (&acc)[2][2][4][2], const Unit& u, int wr, int wc, int fr, int fq) const {
        const int row0 = u.pm * BM + wr * 64 + fr, col0 = u.pn * HALF + wc * 32 + 8 * fq;
#pragma unroll
        for (int ai = 0; ai < 2; ++ai)
#pragma unroll
            for (int m = 0; m < 4; ++m) { bf16_t* rowp = Hd + (size_t)(row0 + ai * HALF + m * 16) * FF + col0;
                float v[8];
#pragma unroll
                for (int n = 0; n < 2; ++n)
#pragma unroll
                    for (int j = 0; j < 4; ++j) { const float gt = acc[ai][0][m][n][j], up = acc[ai][1][m][n][j]; v[4 * n + j] = ::silu_f(gt) * up; }
                u32x4 w; w.x = ::pk2(v[0], v[1]); w.y = ::pk2(v[2], v[3]); w.z = ::pk2(v[4], v[5]); w.w = ::pk2(v[6], v[7]);
                *(u32x4*)rowp = w; }
    }
};

#ifdef __HIP_EMU__
template <class Epi, class Sched, bool ALIGN_EPI = false, bool SP2 = false>
__device__ __forceinline__ void gemm_phase(unsigned char* lds, const Gemm g, const Sched& S, const Epi& E) {
    const int tid = threadIdx.x, wid = tid >> 6, lane = tid & 63, wr = wid >> 2, wc = wid & 3, fr = lane & 15, fq = lane >> 4;
    Unit cur;
    for (int ui = 0; S.next(ui, cur); ++ui) {
        f32x4 acc[2][2][4][2];
        for (int ai = 0; ai < 2; ++ai) for (int bj = 0; bj < 2; ++bj) for (int m = 0; m < 4; ++m) for (int n = 0; n < 2; ++n) for (int j = 0; j < 4; ++j) {
            const int row = 256 * cur.pm + 128 * ai + 64 * wr + 16 * m + fr;
            const int col = Epi::PERM ? 256 * cur.pn + 128 * bj + 32 * wc + 8 * fq + 4 * n + j : 256 * cur.pn + 128 * bj + 32 * wc + 16 * n + 4 * fq + j;
            const bf16_t* a = g.A + (size_t)row * g.K; const bf16_t* b = g.Bt + (size_t)col * g.K; float s = 0.f;
            for (int k = 0; k < g.K; ++k) s += ::bf2f(a[k]) * ::bf2f(b[k]);
            acc[ai][bj][m][n][j] = s; }
        E(acc, cur, wr, wc, fr, fq);
    }
}
#else
template <class Epi, class Sched, bool ALIGN_EPI = false, bool SP2 = false>
__device__ __forceinline__ void gemm_phase(PG8_LAS unsigned char* lds, const Gemm g, const Sched& S, const Epi& E) {
    const int tid = ::tidx(), wid = __builtin_amdgcn_readfirstlane(tid >> 6), lane = tid & 63, wr = wid >> 2, wc = wid & 3, fr = lane & 15, fq = lane >> 4;
    const int K = g.K, nt = K / BK;
    unsigned voffA[2], voffB[2];
#pragma unroll
    for (int i = 0; i < 2; ++i) { int R, C; stage_rc(tid * 16 + i * 8192, R, C); const int Rb = Epi::PERM ? ((R & ~31) + perm32(R & 31)) : R;
        voffA[i] = (unsigned)(R * K + C) * 2u; voffB[i] = (unsigned)(Rb * K + C) * 2u; }
    const size_t kstep = (size_t)(BK * 2);
    const size_t hstep = (size_t)HALF * K * 2;
    const size_t tstep = 2 * hstep;
    const unsigned ldsw = (unsigned)wid * 1024u;
    const int aoff = lds_byte(wr * 64 + fr, fq * 8), boff = lds_byte(wc * 32 + fr, fq * 8);
#define PG8_SA(b, h) (((b) * 2 + (h)) * HTB)
#define PG8_SB(b, h) ((4 + (b) * 2 + (h)) * HTB)
#define PG8_STAGE(bufoff, gbase, voff) do { _Pragma("unroll") for (int _i = 0; _i < 2; ++_i) \
        __builtin_amdgcn_global_load_lds((const unsigned*)((const char*)(gbase) + (voff)[_i]), (PG8_LAS unsigned*)(lds + (bufoff) + ldsw + _i * 8192), 16, 0, 0); } while (0)
#define PG8_LDA(dst, b, h) do { _Pragma("unroll") for (int m = 0; m < 4; ++m) _Pragma("unroll") for (int k = 0; k < 2; ++k) dst[m][k] = *(const PG8_LAS bf16x8*)(lds + PG8_SA(b, h) + aoff + m * 2048 + k * 1024); } while (0)
#define PG8_LDB(dst, b, h) do { _Pragma("unroll") for (int n = 0; n < 2; ++n) _Pragma("unroll") for (int k = 0; k < 2; ++k) dst[n][k] = *(const PG8_LAS bf16x8*)(lds + PG8_SB(b, h) + boff + n * 2048 + k * 1024); } while (0)
#define PG8_MMA(ai, bj, At, Bt) do { __builtin_amdgcn_s_setprio(1); _Pragma("unroll") for (int m = 0; m < 4; ++m) _Pragma("unroll") for (int n = 0; n < 2; ++n) _Pragma("unroll") for (int k = 0; k < 2; ++k) \
        acc[ai][bj][m][n] = __builtin_amdgcn_mfma_f32_16x16x32_bf16(Bt[n][k], At[m][k], acc[ai][bj][m][n], 0, 0, 0); __builtin_amdgcn_s_setprio(0); } while (0)
#define PG8_WAIT_V(n) asm volatile("s_waitcnt vmcnt(" #n ")" ::: "memory")
#define PG8_WAIT_L(n) asm volatile("s_waitcnt lgkmcnt(" #n ")" ::: "memory")
#define PG8_BAR __builtin_amdgcn_s_barrier()
#define PG8_SCHED __builtin_amdgcn_sched_barrier(0)
    Unit cur, nxt; int ui = 0;
    if (!S.next(0, cur)) return;
    f32x4 acc[2][2][4][2];
#pragma unroll
    for (int a = 0; a < 2; ++a)
#pragma unroll
        for (int b = 0; b < 2; ++b)
#pragma unroll
            for (int m = 0; m < 4; ++m)
#pragma unroll
                for (int n = 0; n < 2; ++n) acc[a][b][m][n] = (f32x4){0.f, 0.f, 0.f, 0.f};
    bf16x8 At[4][2], B0[2][2], B1[2][2];
    const char* cA = (const char*)g.A + (size_t)cur.pm * tstep; const char* cB = (const char*)g.Bt + (size_t)cur.pn * tstep;
    S.a_ready(cur);
    if constexpr (SP2) {
        PG8_STAGE(PG8_SB(0, 0), cB, voffB); PG8_STAGE(PG8_SB(0, 1), cB + hstep, voffB); PG8_STAGE(PG8_SA(0, 0), cA, voffA); PG8_STAGE(PG8_SA(0, 1), cA + hstep, voffA);
        if (wr == 1) PG8_BAR;
        PG8_WAIT_V(2); PG8_BAR;
        PG8_STAGE(PG8_SB(1, 0), cB + kstep, voffB); PG8_STAGE(PG8_SA(1, 0), cA + kstep, voffA); PG8_STAGE(PG8_SB(1, 1), cB + hstep + kstep, voffB);
        PG8_WAIT_V(6); PG8_BAR;
    } else {
        PG8_STAGE(PG8_SB(0, 0), cB, voffB); PG8_STAGE(PG8_SA(0, 0), cA, voffA); PG8_STAGE(PG8_SB(0, 1), cB + hstep, voffB); PG8_STAGE(PG8_SA(0, 1), cA + hstep, voffA);
        if (wr == 1) PG8_BAR;
        PG8_WAIT_V(4); PG8_BAR;
        PG8_STAGE(PG8_SB(1, 0), cB + kstep, voffB); PG8_STAGE(PG8_SA(1, 0), cA + kstep, voffA); PG8_STAGE(PG8_SB(1, 1), cB + hstep + kstep, voffB);
        PG8_WAIT_V(6); PG8_BAR;
    }
    for (;;) {
        const bool has_next = S.next(ui + 1, nxt);
        const char* nA = has_next ? (const char*)g.A + (size_t)nxt.pm * tstep : cA; const char* nB = has_next ? (const char*)g.Bt + (size_t)nxt.pn * tstep : cB;
        for (int t = 0; t < nt; t += 2) {
            const bool last = (t == nt - 2);
            const char* a1 = cA + (size_t)(t + 1) * kstep;
            const char* a2 = last ? nA : cA + (size_t)(t + 2) * kstep; const char* b2 = last ? nB : cB + (size_t)(t + 2) * kstep;
            const char* a3 = a2 + kstep; const char* b3 = b2 + kstep;
            if (last && has_next) S.a_ready(nxt);
            if constexpr (SP2) {
            PG8_LDB(B0, 0, 0); PG8_LDB(B1, 0, 1); PG8_SCHED; PG8_LDA(At, 0, 0); PG8_STAGE(PG8_SA(1, 1), a1 + hstep, voffA);
            PG8_WAIT_V(8); PG8_WAIT_L(0); PG8_BAR; PG8_MMA(0, 0, At, B0); PG8_MMA(0, 1, At, B1); PG8_BAR; PG8_SCHED;
            PG8_LDA(At, 0, 1); PG8_STAGE(PG8_SB(0, 0), b2, voffB); PG8_STAGE(PG8_SB(0, 1), b2 + hstep, voffB); PG8_STAGE(PG8_SA(0, 0), a2, voffA);
            PG8_WAIT_V(8); PG8_WAIT_L(0); PG8_BAR; PG8_MMA(1, 0, At, B0); PG8_MMA(1, 1, At, B1); PG8_BAR; PG8_SCHED;
            PG8_LDB(B0, 1, 0); PG8_LDB(B1, 1, 1); PG8_SCHED; PG8_LDA(At, 1, 0); PG8_STAGE(PG8_SA(0, 1), a2 + hstep, voffA);
            PG8_WAIT_V(8); PG8_WAIT_L(0); PG8_BAR; PG8_MMA(0, 0, At, B0); PG8_MMA(0, 1, At, B1); PG8_BAR; PG8_SCHED;
            PG8_LDA(At, 1, 1); PG8_STAGE(PG8_SB(1, 0), b3, voffB); PG8_STAGE(PG8_SB(1, 1), b3 + hstep, voffB); PG8_STAGE(PG8_SA(1, 0), a3, voffA);
            PG8_WAIT_V(8); PG8_WAIT_L(0); PG8_BAR; PG8_MMA(1, 0, At, B0); PG8_MMA(1, 1, At, B1); PG8_BAR; PG8_SCHED;
            } else {
            PG8_LDB(B0, 0, 0); PG8_SCHED; PG8_LDA(At, 0, 0); PG8_STAGE(PG8_SA(1, 1), a1 + hstep, voffA);
            PG8_WAIT_L(8); PG8_BAR; PG8_WAIT_L(0); PG8_MMA(0, 0, At, B0); PG8_BAR; PG8_SCHED;
            PG8_LDB(B1, 0, 1); PG8_STAGE(PG8_SB(0, 0), b2, voffB);
            PG8_BAR; PG8_WAIT_L(0); PG8_MMA(0, 1, At, B1); PG8_BAR;
            PG8_LDA(At, 0, 1); PG8_STAGE(PG8_SA(0, 0), a2, voffA);
            PG8_BAR; PG8_WAIT_L(0); PG8_MMA(1, 0, At, B0); PG8_BAR; PG8_SCHED;
            PG8_STAGE(PG8_SB(0, 1), b2 + hstep, voffB);
            PG8_WAIT_V(6); PG8_BAR; PG8_MMA(1, 1, At, B1); PG8_BAR;
            PG8_LDB(B0, 1, 0); PG8_SCHED; PG8_LDA(At, 1, 0); PG8_STAGE(PG8_SA(0, 1), a2 + hstep, voffA);
            PG8_WAIT_L(8); PG8_BAR; PG8_WAIT_L(0); PG8_MMA(0, 0, At, B0); PG8_BAR; PG8_SCHED;
            PG8_LDB(B1, 1, 1); PG8_STAGE(PG8_SB(1, 0), b3, voffB);
            PG8_BAR; PG8_WAIT_L(0); PG8_MMA(0, 1, At, B1); PG8_BAR;
            PG8_LDA(At, 1, 1); PG8_STAGE(PG8_SA(1, 0), a3, voffA);
            PG8_BAR; PG8_WAIT_L(0); PG8_MMA(1, 0, At, B0); PG8_BAR; PG8_SCHED;
            PG8_STAGE(PG8_SB(1, 1), b3 + hstep, voffB);
            PG8_WAIT_V(6); PG8_BAR; PG8_MMA(1, 1, At, B1); PG8_BAR;
            }
        }
        if constexpr (ALIGN_EPI) { if (wr == 0) PG8_BAR; }
        if constexpr (!Epi::AFTER_DRAIN) { E(acc, cur, wr, wc, fr, fq); S.done(cur); }
        if (!has_next) break;
#pragma unroll
        for (int a = 0; a < 2; ++a)
#pragma unroll
            for (int b = 0; b < 2; ++b)
#pragma unroll
                for (int m = 0; m < 4; ++m)
#pragma unroll
                    for (int n = 0; n < 2; ++n) acc[a][b][m][n] = (f32x4){0.f, 0.f, 0.f, 0.f};
        cur = nxt; cA = nA; cB = nB; ++ui;
        if constexpr (ALIGN_EPI) { if (wr == 1) PG8_BAR; }
    }
    PG8_WAIT_V(0);
    if constexpr (!ALIGN_EPI) { if (wr == 0) PG8_BAR; }
    PG8_BAR;
    if constexpr (Epi::AFTER_DRAIN) { E.fused(acc, cur, wr, wc, fr, fq, lds, wid, lane); S.done(cur); }
#undef PG8_SA
#undef PG8_SB
#undef PG8_STAGE
#undef PG8_LDA
#undef PG8_LDB
#undef PG8_MMA
#undef PG8_WAIT_V
#undef PG8_WAIT_L
#undef PG8_BAR
#undef PG8_SCHED
}
#endif
}


__device__ __forceinline__ void transpose_item(const float* W, int ldw, bf16_t* WT, int K, int k0, int n0, int drow0, float* scr, int lane) {
    float wv[32];
#pragma unroll
    for (int i = 0; i < 32; ++i) wv[i] = W[(size_t)(k0 + 2 * i + (lane >> 5)) * ldw + n0 + (lane & 31)];
#pragma unroll
    for (int i = 0; i < 32; ++i) scr[(2 * i + (lane >> 5)) * 33 + (lane & 31)] = wv[i];
    WAVE_SYNC();
    const int c = lane & 7;
#pragma unroll
    for (int j = 0; j < 4; ++j) { const int n = (lane >> 3) + 8 * j; const float* s = scr + (8 * c) * 33 + n;
        u32x4 o; o.x = pk2(s[0 * 33], s[1 * 33]); o.y = pk2(s[2 * 33], s[3 * 33]); o.z = pk2(s[4 * 33], s[5 * 33]); o.w = pk2(s[6 * 33], s[7 * 33]);
        *(u32x4*)(WT + (size_t)(drow0 + n) * K + k0 + 8 * c) = o; }
    WAVE_SYNC();
}
constexpr int CV_IN = 16 * 120, CV_OUT = 16 * 32, CV_G = 16 * 88, CV_DN = 44 * 32, CV_L = CV_IN + CV_OUT + 2 * CV_G + CV_DN;
__device__ __forceinline__ void ph_convert(const P& p, unsigned char* smem, int i0, int i1, int b0) {
    if ((int)blockIdx.x < b0) return;
    const int lane = tidx() & 63, wave = tidx() >> 6;
    float* scr = (float*)smem + wave * (64 * 33 + 32);
    constexpr int I_IN = CV_IN, I_OUT = CV_OUT, I_G = CV_G, I_L = CV_L;
    const int gw = ((int)blockIdx.x - b0) * 8 + wave, ngw = ((int)gridDim.x - b0) * 8;
    for (int it = i0 + gw; it < i1; it += ngw) {
        const int l = it / I_L; int r = it % I_L;
        if (r < I_IN) { const int kb = r / 120, nb = r % 120; transpose_item(p.w_in + (size_t)l * D * INC, INC, WSP(bf16_t, WS_WIN) + (size_t)l * NPROJ * D, D, kb * 64, nb * 32, nb * 32, scr, lane); continue; }
        r -= I_IN;
        if (r < I_OUT) { const int kb = r / 32, nb = r % 32; transpose_item(p.w_out + (size_t)l * D * D, D, WSP(bf16_t, WS_WOUT) + (size_t)l * D * D, D, kb * 64, nb * 32, nb * 32, scr, lane); continue; }
        r -= I_OUT;
        if (r < 2 * I_G) { const int up = r / I_G; r %= I_G; const int kb = r / 88, nb = r % 88, n0 = nb * 32;
            transpose_item((up ? p.w_up : p.w_gate) + (size_t)l * D * FF, FF, WSP(bf16_t, WS_WGU) + (size_t)l * 2 * FF * D, D, kb * 64, n0, (n0 / 128) * 256 + up * 128 + (n0 % 128), scr, lane); continue; }
        r -= 2 * I_G;
        { const int kb = r / 32, nb = r % 32; transpose_item(p.w_down + (size_t)l * FF * D, D, WSP(bf16_t, WS_WDN) + (size_t)l * D * FF, FF, kb * 64, nb * 32, nb * 32, scr, lane); }
    }
}

__device__ __forceinline__ void ph_adaln(const P& p, unsigned char* smem, int l0, int l1, int b0) {
    if ((int)blockIdx.x < b0) return;
    float* sc = (float*)smem;
    float* red = sc + NC * 256;
    const int tid = tidx(), col = tid & 31, kg = tid >> 5;
    float* MOD = WSP(float, WS_MOD);
    for (int it = l0 * 192 + (int)blockIdx.x - b0; it < l1 * 192; it += (int)gridDim.x - b0) {
        const int l = it / 192, cb0 = (it % 192) * 32;
        float acc[NC];
#pragma unroll
        for (int r = 0; r < NC; ++r) acc[r] = 0.f;
        for (int kc = 0; kc < 4; ++kc) {
            __syncthreads();
            for (int e = tid; e < NC * 256; e += NTHR) { const int r = e >> 8, k = e & 255; const float c = r < PB ? p.c_prompt[r * D + kc * 256 + k] : p.c_sample[(r - PB) * D + kc * 256 + k]; sc[e] = silu_f(c); }
            __syncthreads();
            for (int kk = 0; kk < 16; ++kk) { const int k = kg * 16 + kk; const float w = p.ada_w[((size_t)l * D + kc * 256 + k) * 6144 + cb0 + col];
#pragma unroll
                for (int r = 0; r < NC; ++r) acc[r] += sc[r * 256 + k] * w; }
        }
#pragma unroll
        for (int r = 0; r < NC; ++r) red[(kg * NC + r) * 32 + col] = acc[r];
        __syncthreads();
        for (int e = tid; e < NC * 32; e += NTHR) { const int r = e >> 5, c = e & 31; float s = p.ada_b[l * 6144 + cb0 + c];
            for (int g = 0; g < 16; ++g) s += red[(g * NC + r) * 32 + c];
            MOD[((size_t)l * NC + r) * 6144 + cb0 + c] = s; }
        __syncthreads();
    }
}

__device__ __forceinline__ void ph_ropetab_copyx(const P& p) {
    const size_t gt = (size_t)blockIdx.x * NTHR + tidx(), ng = (size_t)gridDim.x * NTHR;
    float* tab = WSP(float, WS_ROPE);
    for (size_t e = gt; e < (size_t)NL * D * 8; e += ng) { const size_t lk = e >> 3; const int c = (int)(e & 7); WSP(float, WS_W8)[((lk >> 10) * 8 + c) * D + (lk & 1023)] = p.w_in[lk * INC + NPROJ + c]; }
    for (size_t e = gt; e < (size_t)NPOS * 32; e += ng) {
        const int pi = (int)(e >> 5), i = (int)(e & 31); const double pos = pi < T ? (double)pi : (double)(PAST + pi - T);
        const double ia = exp(-log(10000.0) * (double)i / 32.0), ir = exp(-log(10000.0) * (double)i / 31.0);
        tab[e] = (float)cos(pos * ia); tab[(size_t)NPOS * 32 + e] = (float)sin(pos * ia);
        tab[(size_t)2 * NPOS * 32 + e] = (float)cos(pos * ir); tab[(size_t)3 * NPOS * 32 + e] = (float)sin(pos * ir);
    }
}

template <int WHICH> __device__ __forceinline__ void ph_norm_mod(const P& p, int l) {
    const int lane = tidx() & 63, wave = tidx() >> 6, gw = blockIdx.x * 8 + wave, ngw = gridDim.x * 8;
    const float* nw = (WHICH == 0 ? p.norm_mix : p.norm_ffn) + l * D;
    bf16_t* H = WSP(bf16_t, WS_H);
    for (int r = gw; r < M; r += ngw) {
        const float* xr = (WHICH == 0 && l == 0) ? (r < MP ? p.x_prompt + (size_t)r * D : p.x_sample + (size_t)(r - MP) * D) : p.out + (size_t)r * D;
        const float* mod = WSP(float, WS_MOD) + ((size_t)l * NC + row_cb(r)) * 6144 + (WHICH == 0 ? 0 : 3072);
        f32x4 v[4]; float ss = 0.f;
#pragma unroll
        for (int j = 0; j < 4; ++j) { v[j] = *(const f32x4*)(xr + 4 * lane + 256 * j); ss += (v[j][0] * v[j][0] + v[j][1] * v[j][1]) + (v[j][2] * v[j][2] + v[j][3] * v[j][3]); }
        const float rstd = 1.0f / sqrtf(wave_sum(ss) * (1.0f / D) + EPS);
        float a8[8];
#pragma unroll
        for (int c = 0; c < 8; ++c) a8[c] = 0.f;
#pragma unroll
        for (int j = 0; j < 4; ++j) { const int k = 4 * lane + 256 * j;
            const f32x4 g = *(const f32x4*)(nw + k), sh = *(const f32x4*)(mod + k), sc = *(const f32x4*)(mod + 1024 + k);
            f32x4 h;
#pragma unroll
            for (int e = 0; e < 4; ++e) h[e] = v[j][e] * rstd * g[e] * (1.0f + sc[e]) + sh[e];
            u32x2 w; w.x = pk2(h[0], h[1]); w.y = pk2(h[2], h[3]); *(u32x2*)(H + (size_t)r * D + k) = w;
            if (WHICH == 0) {
#pragma unroll
                for (int c = 0; c < 8; ++c) { const f32x4 wv = *(const f32x4*)(WSP(float, WS_W8) + ((size_t)l * 8 + c) * D + k); a8[c] += (h[0] * wv[0] + h[1] * wv[1]) + (h[2] * wv[2] + h[3] * wv[3]); }
            }
        }
        if (WHICH == 0) {
            float b4[4];
#pragma unroll
            for (int c = 0; c < 4; ++c) { const float keep = lane < 32 ? a8[c] : a8[4 + c], send = lane < 32 ? a8[4 + c] : a8[c]; b4[c] = keep + __shfl_xor(send, 32); }
            float b2[2];
#pragma unroll
            for (int c = 0; c < 2; ++c) { const bool lo = (lane & 16) == 0; const float keep = lo ? b4[c] : b4[2 + c], send = lo ? b4[2 + c] : b4[c]; b2[c] = keep + __shfl_xor(send, 16); }
            float b1; { const bool lo = (lane & 8) == 0; const float keep = lo ? b2[0] : b2[1], send = lo ? b2[1] : b2[0]; b1 = keep + __shfl_xor(send, 8); }
            b1 += __shfl_xor(b1, 4); b1 += __shfl_xor(b1, 2); b1 += __shfl_xor(b1, 1);
            if ((lane & 7) == 0) { const int c = (lane >> 5) * 4 + ((lane >> 4) & 1) * 2 + ((lane >> 3) & 1);
                if (c < 4) WSP(float, WS_BETA)[(size_t)r * 4 + c] = 1.0f / (1.0f + expf(-b1));
                else { const int hh = c - 4; const float xx = b1 + p.dt_bias[l * 4 + hh]; const float sp = xx > 20.f ? xx : log1pf(expf(xx)); WSP(float, WS_G)[(size_t)r * 4 + hh] = -expf(p.a_log[l * 4 + hh]) * sp; } }
        }
    }
}

__device__ __forceinline__ void unpack8(const u32x4 w, float (&f)[8]) {
    f[0] = __builtin_bit_cast(float, w.x << 16); f[1] = __builtin_bit_cast(float, w.x & 0xffff0000u); f[2] = __builtin_bit_cast(float, w.y << 16); f[3] = __builtin_bit_cast(float, w.y & 0xffff0000u);
    f[4] = __builtin_bit_cast(float, w.z << 16); f[5] = __builtin_bit_cast(float, w.z & 0xffff0000u); f[6] = __builtin_bit_cast(float, w.w << 16); f[7] = __builtin_bit_cast(float, w.w & 0xffff0000u);
}
__device__ __forceinline__ u32x4 pack8f(const float (&f)[8]) { u32x4 w; w.x = pk2(f[0], f[1]); w.y = pk2(f[2], f[3]); w.z = pk2(f[4], f[5]); w.w = pk2(f[6], f[7]); return w; }
__device__ __forceinline__ void ph_rope_out(const P& p, int l) {
    const size_t gt = (size_t)blockIdx.x * NTHR + tidx(), ng = (size_t)gridDim.x * NTHR;
    bf16_t* PR = WSP(bf16_t, WS_PROJ); const float* tab = WSP(float, WS_ROPE);
    for (size_t e = gt; e < (size_t)MS * 64; e += ng) {
        const int r = MP + (int)(e >> 6), rem = (int)(e & 63), sec = rem >> 4, hh = (rem >> 2) & 3, d = (rem & 3) * 8;
        const int off = sec == 0 ? C_QA : sec == 1 ? C_KA : sec == 2 ? C_QR : C_KR; const float scale = sec == 0 ? 0.125f * LOG2E : sec == 3 ? 0.125f : 1.0f;
        const float* ct = tab + (size_t)(sec >= 2 ? 2 : 0) * NPOS * 32 + (size_t)row_pi(r) * 32 + d; const float* st = ct + (size_t)NPOS * 32;
        const f32x4 c0 = *(const f32x4*)ct, c1 = *(const f32x4*)(ct + 4), s0 = *(const f32x4*)st, s1 = *(const f32x4*)(st + 4);
        bf16_t* x = PR + (size_t)r * NPROJ + off + hh * 64 + d; float x1[8], x2[8], o1[8], o2[8];
        unpack8(*(const u32x4*)x, x1); unpack8(*(const u32x4*)(x + 32), x2);
#pragma unroll
        for (int k = 0; k < 8; ++k) { const float c = k < 4 ? c0[k & 3] : c1[k & 3], sn = k < 4 ? s0[k & 3] : s1[k & 3]; o1[k] = (x1[k] * c - x2[k] * sn) * scale; o2[k] = (x1[k] * sn + x2[k] * c) * scale; }
        *(u32x4*)x = pack8f(o1); *(u32x4*)(x + 32) = pack8f(o2);
        if (sec == 1) { const int b = (r - MP) / DS, i = (r - MP) % DS; float* o = p.out + O_SWK + (((size_t)l * DB + b) * DS + i) * 256 + hh * 64 + d;
            *(f32x4*)o = (f32x4){o1[0], o1[1], o1[2], o1[3]}; *(f32x4*)(o + 4) = (f32x4){o1[4], o1[5], o1[6], o1[7]}; *(f32x4*)(o + 32) = (f32x4){o2[0], o2[1], o2[2], o2[3]}; *(f32x4*)(o + 36) = (f32x4){o2[4], o2[5], o2[6], o2[7]}; }
    }
    for (size_t e = gt; e < (size_t)MS * 32; e += ng) {
        const int r = MP + (int)(e >> 5), c = (int)(e & 31) * 8; const int b = (r - MP) / DS, i = (r - MP) % DS; float* o = p.out + O_SWV + (((size_t)l * DB + b) * DS + i) * 256 + c;
        float v[8]; unpack8(*(const u32x4*)(PR + (size_t)r * NPROJ + C_VA + c), v); *(f32x4*)o = (f32x4){v[0], v[1], v[2], v[3]}; *(f32x4*)(o + 4) = (f32x4){v[4], v[5], v[6], v[7]};
    }
    for (size_t e = gt; e < (size_t)(PB + DB) * 3 * 1536; e += ng) {
        const int c = (int)(e % 1536), j = (int)((e / 1536) % 3), bb = (int)(e / (3 * 1536));
        if (bb < PB) p.out[O_PCONV + (((size_t)l * PB + bb) * 3 + j) * 1536 + c] = bf2f(PR[(size_t)(bb * T + T - 3 + j) * NPROJ + C_CONV + c]);
        else { const int b = bb - PB; p.out[O_SCONV + (((size_t)l * DB + b) * 3 + j) * 1536 + c] = bf2f(PR[(size_t)(MP + b * DS + DS - 3 + j) * NPROJ + C_CONV + c]); }
    }
}

__device__ __forceinline__ void attn_wave_sample(const P& p, int l, int r, int h, int lane, float* sw  ) {
    const bf16_t* PR = WSP(bf16_t, WS_PROJ);
    const int b = (r - MP) / DS; const int tq = WB + (r - MP) % DS;
    float q[64];
    { const bf16_t* qp = PR + (size_t)r * NPROJ + C_QA + h * 64;
#pragma unroll
      for (int j = 0; j < 8; ++j) { const bf16x8 v = *(const bf16x8*)(qp + 8 * j);
#pragma unroll
          for (int e = 0; e < 8; ++e) q[8 * j + e] = bf2f((bf16_t)v[e]); } }
    float mx = -INFINITY;
#pragma unroll 1
    for (int i = 0; i < 7; ++i) {
        const int e = lane + 64 * i;
        if (e < 387) { const int pat = e / 129, j = e % 129, dil = pat == 0 ? 1 : pat == 1 ? 4 : 16; const int rr = tq - dil * j;
            float a = 0.f;
            if (rr < WB) { const float* kp = p.cache_k + ((((size_t)l * DB + b) * WB + rr) * 4 + h) * 64;
#pragma unroll
                for (int j4 = 0; j4 < 16; ++j4) { const f32x4 kv = *(const f32x4*)(kp + 4 * j4); a += q[4 * j4] * kv[0] + q[4 * j4 + 1] * kv[1] + q[4 * j4 + 2] * kv[2] + q[4 * j4 + 3] * kv[3]; } }
            else { const bf16_t* kp = PR + (size_t)(MP + b * DS + (rr - WB)) * NPROJ + C_KA + h * 64;
#pragma unroll
                for (int j8 = 0; j8 < 8; ++j8) { const bf16x8 kv = *(const bf16x8*)(kp + 8 * j8);
#pragma unroll
                    for (int e2 = 0; e2 < 8; ++e2) a += q[8 * j8 + e2] * bf2f((bf16_t)kv[e2]); } }
            sw[e] = a; mx = fmaxf(mx, a); }
    }
    mx = wave_max(mx);
    float lsum = 0.f;
#pragma unroll 1
    for (int i = 0; i < 7; ++i) { const int e = lane + 64 * i; if (e < 387) { const float pe = exp2f(sw[e] - mx); sw[e] = pe; lsum += pe; } }
    lsum = wave_sum(lsum);
    WAVE_SYNC();
    const int kg = lane >> 4, dq = lane & 15; f32x4 o4 = (f32x4){0.f, 0.f, 0.f, 0.f};
#pragma unroll 8
    for (int e = kg; e < 387; e += 4) {
        const float pe = sw[e];
        const int pat = e / 129, j = e % 129, dil = pat == 0 ? 1 : pat == 1 ? 4 : 16; const int rr = tq - dil * j;
        f32x4 v;
        if (rr < WB) v = *(const f32x4*)(p.cache_v + ((((size_t)l * DB + b) * WB + rr) * 4 + h) * 64 + 4 * dq);
        else { const u32x2 w = *(const u32x2*)(PR + (size_t)(MP + b * DS + (rr - WB)) * NPROJ + C_VA + h * 64 + 4 * dq);
            v = (f32x4){bf2f((bf16_t)(w.x & 0xffff)), bf2f((bf16_t)(w.x >> 16)), bf2f((bf16_t)(w.y & 0xffff)), bf2f((bf16_t)(w.y >> 16))}; }
        o4 += pe * v;
    }
#pragma unroll
    for (int e = 0; e < 4; ++e) { float x = o4[e]; x += __shfl_xor(x, 16); x += __shfl_xor(x, 32); o4[e] = x; }
    WAVE_SYNC();
    if (kg == 0) { const float inv = 1.0f / lsum; u32x2 w; w.x = pk2(o4[0] * inv, o4[1] * inv); w.y = pk2(o4[2] * inv, o4[3] * inv);
        *(u32x2*)(WSP(bf16_t, WS_O) + (size_t)r * D + h * 64 + 4 * dq) = w; }
}
__device__ __forceinline__ void ph_attn_sample(const P& p, int l, unsigned char* smem) {
    const int lane = tidx() & 63, wave = tidx() >> 6, gw = (gridDim.x - 1 - blockIdx.x) * 8 + wave, ngw = gridDim.x * 8;
    float* sw = (float*)smem + wave * 392;
    for (int it = gw; it < MS * 4; it += ngw) attn_wave_sample(p, l, MP + (it >> 2), it & 3, lane, sw);
}
__device__ __forceinline__ bf16x8 pack8(const f32x16& v, int s8) {
    u32x4 w; w.x = pk2(v[s8], v[s8 + 1]); w.y = pk2(v[s8 + 2], v[s8 + 3]); w.z = pk2(v[s8 + 4], v[s8 + 5]); w.w = pk2(v[s8 + 6], v[s8 + 7]); return __builtin_bit_cast(bf16x8, w);
}
__device__ __forceinline__ void attn_job(const P& p, int jb, int lane) {
    const int c = lane & 31, hi = lane >> 5;
    constexpr int NB = T / 512;
    const int unit = jb / 48, jj = jb % 48, pat = jj >> 4, sub = jj & 15;
    const int blk = unit % NB, h = (unit / NB) & 3, b = unit / (NB * 4), bh = b * 4 + h;
    int dil, r, qi0, cls, tb;
    if (pat == 0) { dil = 1; r = 0; qi0 = blk * 512 + sub * 32; cls = 0; tb = 0; }
    else if (pat == 1) { dil = 4; r = sub >> 2; qi0 = blk * 128 + (sub & 3) * 32; cls = 1; tb = r * (T / 128); }
    else { dil = 16; r = sub; qi0 = blk * 32; cls = 2; tb = r * (T / 512); }
    const bf16_t* KF = WSP(bf16_t, WS_KF) + cls * ATT_CLS + ((size_t)bh * (T / 32) + tb) * 2048 + lane * 8;
    const bf16_t* VF = WSP(bf16_t, WS_VF) + cls * ATT_CLS + ((size_t)bh * (T / 32) + tb) * 2048 + lane * 8;
    const int tq = dil * (qi0 + c) + r;
    const bf16_t* qp = WSP(bf16_t, WS_PROJ) + (size_t)(b * T + tq) * NPROJ + C_QA + h * 64 + 8 * hi;
    bf16x8 qf[4];
#pragma unroll
    for (int ks = 0; ks < 4; ++ks) qf[ks] = *(const bf16x8*)(qp + 16 * ks);
    f32x16 S[5];
#pragma unroll
    for (int i = 0; i < 5; ++i) {
        const int kt0 = qi0 - 128 + 32 * i;
        f32x16 acc;
#pragma unroll
        for (int e = 0; e < 16; ++e) acc[e] = 0.f;
        if (kt0 >= 0) { const bf16_t* kp = KF + (size_t)(kt0 >> 5) * 2048;
#pragma unroll
            for (int ks = 0; ks < 4; ++ks) acc = MFMA32(*(const bf16x8*)(kp + 512 * ks), qf[ks], acc);
            if (i == 0) {
#pragma unroll
                for (int e = 0; e < 16; ++e) { const int krow = (e & 3) + 8 * (e >> 2) + 4 * hi; if (krow < c) acc[e] = -INFINITY; } }
            if (i == 4) {
#pragma unroll
                for (int e = 0; e < 16; ++e) { const int krow = (e & 3) + 8 * (e >> 2) + 4 * hi; if (krow > c) acc[e] = -INFINITY; } }
        } else {
#pragma unroll
            for (int e = 0; e < 16; ++e) acc[e] = -INFINITY; }
        S[i] = acc;
    }
    float mx = -INFINITY;
#pragma unroll
    for (int i = 0; i < 5; ++i)
#pragma unroll
        for (int e = 0; e < 16; ++e) mx = fmaxf(mx, S[i][e]);
    mx = fmaxf(mx, __shfl_xor(mx, 32));
    float lsum = 0.f;
#pragma unroll
    for (int i = 0; i < 5; ++i)
#pragma unroll
        for (int e = 0; e < 16; ++e) { const float pe = exp2f(S[i][e] - mx); S[i][e] = pe; lsum += pe; }
    lsum += __shfl_xor(lsum, 32);
    f32x16 O[2];
#pragma unroll
    for (int dt = 0; dt < 2; ++dt)
#pragma unroll
        for (int e = 0; e < 16; ++e) O[dt][e] = 0.f;
#pragma unroll
    for (int i = 0; i < 5; ++i) {
        const int kt0 = qi0 - 128 + 32 * i;
        if (kt0 >= 0) {
#pragma unroll
            for (int s2 = 0; s2 < 2; ++s2) { const bf16x8 pf = pack8(S[i], 8 * s2);
#pragma unroll
                for (int dt = 0; dt < 2; ++dt) O[dt] = MFMA32(*(const bf16x8*)(VF + (size_t)(kt0 >> 5) * 2048 + (dt * 2 + s2) * 512), pf, O[dt]); }
        }
    }
    const size_t idx = ((size_t)(b * T + tq) * 4 + h) * 3 + pat;
    bf16_t* po = WSP(bf16_t, WS_APO) + idx * 64;
#pragma unroll
    for (int dt = 0; dt < 2; ++dt)
#pragma unroll
        for (int g = 0; g < 4; ++g) { u32x2 w; w.x = pk2(O[dt][4 * g], O[dt][4 * g + 1]); w.y = pk2(O[dt][4 * g + 2], O[dt][4 * g + 3]); *(u32x2*)(po + 32 * dt + 8 * g + 4 * hi) = w; }
    if (hi == 0) { float* ml = WSP(float, WS_AML) + idx * 2; ml[0] = mx; ml[1] = lsum; }
}
__device__ __forceinline__ void ph_attn_jobs(const P& p, int b0, int b1) {
    if ((int)blockIdx.x < b0 || (int)blockIdx.x >= b1) return;
    const int lane = tidx() & 63, wave = tidx() >> 6, gw = ((int)blockIdx.x - b0) * 8 + wave, ngw = (b1 - b0) * 8;
    for (int jb = gw; jb < PB * 4 * (T / 512) * 48; jb += ngw) attn_job(p, jb, lane);
}
__device__ __forceinline__ void ph_attn_combine(const P& p) {
    const size_t gt = (size_t)blockIdx.x * NTHR + tidx(), ng = (size_t)gridDim.x * NTHR;
    for (size_t e = gt; e < (size_t)MP * 4 * 16; e += ng) {
        const size_t rh = e >> 4; const int dq = (int)(e & 15) * 4;
        const float* ml = WSP(float, WS_AML) + rh * 6; const float m0 = ml[0], m1 = ml[2], m2 = ml[4];
        const float mm = fmaxf(m0, fmaxf(m1, m2)); const float w0 = exp2f(m0 - mm), w1 = exp2f(m1 - mm), w2 = exp2f(m2 - mm);
        const float inv = 1.0f / (w0 * ml[1] + w1 * ml[3] + w2 * ml[5]);
        const bf16_t* po = WSP(bf16_t, WS_APO) + rh * 192 + dq;
        const u32x2 a = *(const u32x2*)po, bq = *(const u32x2*)(po + 64), cq = *(const u32x2*)(po + 128);
        float o[4];
        o[0] = w0 * bf2f((bf16_t)(a.x & 0xffff)) + w1 * bf2f((bf16_t)(bq.x & 0xffff)) + w2 * bf2f((bf16_t)(cq.x & 0xffff));
        o[1] = w0 * bf2f((bf16_t)(a.x >> 16)) + w1 * bf2f((bf16_t)(bq.x >> 16)) + w2 * bf2f((bf16_t)(cq.x >> 16));
        o[2] = w0 * bf2f((bf16_t)(a.y & 0xffff)) + w1 * bf2f((bf16_t)(bq.y & 0xffff)) + w2 * bf2f((bf16_t)(cq.y & 0xffff));
        o[3] = w0 * bf2f((bf16_t)(a.y >> 16)) + w1 * bf2f((bf16_t)(bq.y >> 16)) + w2 * bf2f((bf16_t)(cq.y >> 16));
        const size_t row = rh >> 2; const int h = (int)(rh & 3);
        u32x2 w; w.x = pk2(o[0] * inv, o[1] * inv); w.y = pk2(o[2] * inv, o[3] * inv);
        *(u32x2*)(WSP(bf16_t, WS_O) + row * D + h * 64 + dq) = w;
    }
}
__device__ __forceinline__ float ret_lg(int h) { return logf(1.0f - exp2f(-5.0f - (float)h)); }
constexpr int TPK = 72, TPT = 65;
__device__ __forceinline__ void trans_write(const bf16_t* tile, bf16_t* dst  , int tile0, int tid) {
#pragma unroll
    for (int k = 0; k < 4; ++k) { const int ch = tid + NTHR * k, d = ch >> 5, t0 = (ch & 31) * 8; u32x4 w;
        w.x = (unsigned)tile[(t0 + 0) * TPT + d] | ((unsigned)tile[(t0 + 1) * TPT + d] << 16); w.y = (unsigned)tile[(t0 + 2) * TPT + d] | ((unsigned)tile[(t0 + 3) * TPT + d] << 16);
        w.z = (unsigned)tile[(t0 + 4) * TPT + d] | ((unsigned)tile[(t0 + 5) * TPT + d] << 16); w.w = (unsigned)tile[(t0 + 6) * TPT + d] | ((unsigned)tile[(t0 + 7) * TPT + d] << 16);
        *(u32x4*)(dst + (size_t)d * T + tile0 + t0) = w; COMPILER_FENCE(); }
}
__device__ __forceinline__ void store8_b16(bf16_t* dst, const u32x4 w) {
    dst[0] = (bf16_t)(w.x & 0xffff); dst[1] = (bf16_t)(w.x >> 16); dst[2] = (bf16_t)(w.y & 0xffff); dst[3] = (bf16_t)(w.y >> 16);
    dst[4] = (bf16_t)(w.z & 0xffff); dst[5] = (bf16_t)(w.z >> 16); dst[6] = (bf16_t)(w.w & 0xffff); dst[7] = (bf16_t)(w.w >> 16);
}
__device__ __forceinline__ void ph_vtrans(const P& p, int l, unsigned char* smem) {
    bf16_t* ka = (bf16_t*)smem; bf16_t* va = ka + 256 * TPK; bf16_t* vr = va + 256 * TPK; bf16_t* kr = vr + 256 * TPT;
    static_assert((2 * 256 * TPK + 2 * 256 * TPT) * 2 <= BAR_LDS_OFF, "transpose unit LDS");
    const int tid = tidx(); bf16_t* PR = WSP(bf16_t, WS_PROJ); const float* tab = WSP(float, WS_ROPE);
    for (int u = blockIdx.x; u < PB * 4 * (T / 256); u += gridDim.x) {
        const int tile = u % (T / 256), bh = u / (T / 256), h = bh & 3, b = bh >> 2; const float lg = ret_lg(h);
        __syncthreads();
#pragma unroll 1
        for (int k = 0; k < 2; ++k) { const int e = tid + NTHR * k, t = e >> 2, d = (e & 3) * 8, tt = tile * 256 + t; bf16_t* row = PR + (size_t)(b * T + tt) * NPROJ + h * 64 + d;
            float x1[8], x2[8], o1[8], o2[8];
            { const float* ct = tab + (size_t)tt * 32 + d; const float* st = ct + (size_t)NPOS * 32;
              const f32x4 c0 = *(const f32x4*)ct, c1 = *(const f32x4*)(ct + 4), s0 = *(const f32x4*)st, s1 = *(const f32x4*)(st + 4);
              unpack8(*(const u32x4*)(row + C_QA), x1); unpack8(*(const u32x4*)(row + C_QA + 32), x2);
#pragma unroll
              for (int i = 0; i < 8; ++i) { const float c = i < 4 ? c0[i & 3] : c1[i & 3], sn = i < 4 ? s0[i & 3] : s1[i & 3]; o1[i] = (x1[i] * c - x2[i] * sn) * (0.125f * LOG2E); o2[i] = (x1[i] * sn + x2[i] * c) * (0.125f * LOG2E); }
              *(u32x4*)(row + C_QA) = pack8f(o1); *(u32x4*)(row + C_QA + 32) = pack8f(o2);
              unpack8(*(const u32x4*)(row + C_KA), x1); unpack8(*(const u32x4*)(row + C_KA + 32), x2);
#pragma unroll
              for (int i = 0; i < 8; ++i) { const float c = i < 4 ? c0[i & 3] : c1[i & 3], sn = i < 4 ? s0[i & 3] : s1[i & 3]; o1[i] = x1[i] * c - x2[i] * sn; o2[i] = x1[i] * sn + x2[i] * c; }
              *(u32x4*)(ka + t * TPK + d) = pack8f(o1); *(u32x4*)(ka + t * TPK + d + 32) = pack8f(o2);
              if (tt >= T - PWIN) { float* o = p.out + O_PWK + (((size_t)l * PB + b) * PWIN + (tt - (T - PWIN))) * 256 + h * 64 + d;
                  *(f32x4*)o = (f32x4){o1[0], o1[1], o1[2], o1[3]}; *(f32x4*)(o + 4) = (f32x4){o1[4], o1[5], o1[6], o1[7]}; *(f32x4*)(o + 32) = (f32x4){o2[0], o2[1], o2[2], o2[3]}; *(f32x4*)(o + 36) = (f32x4){o2[4], o2[5], o2[6], o2[7]}; } }
            COMPILER_FENCE();
            { const float* ct = tab + (size_t)2 * NPOS * 32 + (size_t)tt * 32 + d; const float* st = ct + (size_t)NPOS * 32;
              const f32x4 c0 = *(const f32x4*)ct, c1 = *(const f32x4*)(ct + 4), s0 = *(const f32x4*)st, s1 = *(const f32x4*)(st + 4);
              const float gq = expf(lg * (float)(tt & 63)), gk = 0.125f / gq;
              unpack8(*(const u32x4*)(row + C_QR), x1); unpack8(*(const u32x4*)(row + C_QR + 32), x2);
#pragma unroll
              for (int i = 0; i < 8; ++i) { const float c = i < 4 ? c0[i & 3] : c1[i & 3], sn = i < 4 ? s0[i & 3] : s1[i & 3]; o1[i] = (x1[i] * c - x2[i] * sn) * gq; o2[i] = (x1[i] * sn + x2[i] * c) * gq; }
              *(u32x4*)(row + C_QR) = pack8f(o1); *(u32x4*)(row + C_QR + 32) = pack8f(o2);
              unpack8(*(const u32x4*)(row + C_KR), x1); unpack8(*(const u32x4*)(row + C_KR + 32), x2);
#pragma unroll
              for (int i = 0; i < 8; ++i) { const float c = i < 4 ? c0[i & 3] : c1[i & 3], sn = i < 4 ? s0[i & 3] : s1[i & 3]; o1[i] = (x1[i] * c - x2[i] * sn) * gk; o2[i] = (x1[i] * sn + x2[i] * c) * gk; }
              const u32x4 w1 = pack8f(o1), w2 = pack8f(o2);
              *(u32x4*)(row + C_KR) = w1; *(u32x4*)(row + C_KR + 32) = w2; store8_b16(kr + t * TPT + d, w1); store8_b16(kr + t * TPT + d + 32, w2); }
            COMPILER_FENCE(); }
#pragma unroll
        for (int k = 0; k < 4; ++k) { const int ch = tid + NTHR * k, t = ch >> 3, d8 = (ch & 7) * 8, tt = tile * 256 + t; const bf16_t* src = PR + (size_t)(b * T + tt) * NPROJ + h * 64 + d8;
            const u32x4 wv = *(const u32x4*)(src + C_VA); *(u32x4*)(va + t * TPK + d8) = wv; store8_b16(vr + t * TPT + d8, *(const u32x4*)(src + C_VR));
            if (tt >= T - PWIN) { float v[8]; unpack8(wv, v); float* o = p.out + O_PWV + (((size_t)l * PB + b) * PWIN + (tt - (T - PWIN))) * 256 + h * 64 + d8;
                *(f32x4*)o = (f32x4){v[0], v[1], v[2], v[3]}; *(f32x4*)(o + 4) = (f32x4){v[4], v[5], v[6], v[7]}; }
            COMPILER_FENCE(); }
        __syncthreads();
#pragma unroll
        for (int cls = 0; cls < 3; ++cls) {
            bf16_t* KFc = WSP(bf16_t, WS_KF) + cls * ATT_CLS + (size_t)bh * (T / 32) * 2048; bf16_t* VFc = WSP(bf16_t, WS_VF) + cls * ATT_CLS + (size_t)bh * (T / 32) * 2048;
#pragma unroll 1
            for (int k = 0; k < 4; ++k) { const int f = tid + NTHR * k, lane = f & 63, c31 = lane & 31, hi = lane >> 5;
                { int g, ks, tl, gtile; bool ok = true;
                  if (cls == 0) { ks = (f >> 6) & 3; g = f >> 8; tl = 32 * g + c31; gtile = tile * 8 + g; }
                  else if (cls == 1) { ks = (f >> 6) & 3; g = f >> 8; const int r = g >> 1, st = g & 1; tl = 4 * (32 * st + c31) + r; gtile = r * (T / 128) + tile * 2 + st; }
                  else { const int r = f >> 7, s16 = f & 15, h2 = (f >> 4) & 1; ks = (f >> 5) & 3; tl = 16 * s16 + r; gtile = r * (T / 512) + (tile >> 1); g = 0; (void)ok;
                      const int slot = 16 * (tile & 1) + s16;
                      *(u32x4*)(KFc + ((size_t)gtile * 4 + ks) * 512 + (slot + 32 * h2) * 8) = *(const u32x4*)(ka + tl * TPK + 16 * ks + 8 * h2); }
                  if (cls < 2) { *(u32x4*)(KFc + ((size_t)gtile * 4 + ks) * 512 + lane * 8) = *(const u32x4*)(ka + tl * TPK + 16 * ks + 8 * hi); } }
                { int dt, s2, gtile, r = 0, st = 0, g = 0;
                  if (cls == 0) { s2 = (f >> 6) & 1; dt = (f >> 7) & 1; g = f >> 8; gtile = tile * 8 + g; }
                  else if (cls == 1) { s2 = (f >> 6) & 1; dt = (f >> 7) & 1; g = f >> 8; r = g >> 1; st = g & 1; gtile = r * (T / 128) + tile * 2 + st; }
                  else { dt = (f >> 6) & 1; r = f >> 7; s2 = tile & 1; gtile = r * (T / 512) + (tile >> 1); }
                  unsigned short e8[8];
#pragma unroll
                  for (int jj = 0; jj < 8; ++jj) { const int kk = 16 * s2 + 8 * (jj >> 2) + 4 * hi + (jj & 3);
                      const int tl = cls == 0 ? 32 * g + kk : cls == 1 ? 4 * (32 * st + kk) + r : 16 * (kk & 15) + r;
                      e8[jj] = va[tl * TPK + 32 * dt + c31]; }
                  u32x4 w; w.x = (unsigned)e8[0] | ((unsigned)e8[1] << 16); w.y = (unsigned)e8[2] | ((unsigned)e8[3] << 16); w.z = (unsigned)e8[4] | ((unsigned)e8[5] << 16); w.w = (unsigned)e8[6] | ((unsigned)e8[7] << 16);
                  *(u32x4*)(VFc + ((size_t)gtile * 4 + dt * 2 + s2) * 512 + lane * 8) = w; }
                COMPILER_FENCE(); }
        }
        trans_write(vr, WSP(bf16_t, WS_VRT) + (size_t)bh * 64 * T, tile * 256, tid);
        trans_write(kr, WSP(bf16_t, WS_KRT) + (size_t)bh * 64 * T, tile * 256, tid);
    }
}

constexpr int CH_ITEMS = PB * 4 * 2;
__device__ __forceinline__ void ph_ret_local(const P& p, int l) {
    const int tid = tidx(), lane = tid & 63, wave = tid >> 6, x = lane & 15, q = lane >> 4, dt = wave >> 1;
    for (int u = blockIdx.x; u < NUNIT; u += gridDim.x) {
        const int n = u % NCH, bh = u / NCH, h = bh & 3, t0 = n * 64; const float g63 = expf(ret_lg(h) * 63.0f);
        const bf16_t* ka = WSP(bf16_t, WS_KRT) + ((size_t)bh * 64 + 16 * dt + x) * T + t0 + 8 * q;
#pragma unroll
        for (int k = 0; k < 2; ++k) { const int et = 2 * (wave & 1) + k; const bf16_t* vb = WSP(bf16_t, WS_VRT) + ((size_t)bh * 64 + 16 * et + x) * T + t0 + 8 * q;
            f32x4 acc = (f32x4){0.f, 0.f, 0.f, 0.f};
#pragma unroll
            for (int ks = 0; ks < 2; ++ks) acc = MFMA16(*(const bf16x8*)(ka + 32 * ks), *(const bf16x8*)(vb + 32 * ks), acc);
            *(f32x4*)(WSP(float, WS_RU) + (size_t)u * 4096 + (16 * et + x) * 64 + 16 * dt + 4 * q) = acc * g63; }
    }
}
__device__ __forceinline__ void ph_ret_scan(const P& p, int l) {
    const int G = (int)gridDim.x, skip = G > 2 * CH_ITEMS ? CH_ITEMS : 0;
    if ((int)blockIdx.x < skip) return;
    const int gt = ((int)blockIdx.x - skip) * NTHR + tidx(), ng = (G - skip) * NTHR;
    for (int e = gt; e < PB * 4 * 4096; e += ng) {
        const int bh = e >> 12, ed = e & 4095, h = bh & 3; const float cd = expf(ret_lg(h) * 64.0f);
        const float* U = WSP(float, WS_RU) + (size_t)bh * NCH * 4096 + ed; bf16_t* SPv = WSP(bf16_t, WS_RS) + (size_t)bh * NCH * 4096 + ed;
        float s = 0.f;
        for (int n0 = 0; n0 < NCH; n0 += 8) {
            float uv[8];
#pragma unroll
            for (int k = 0; k < 8; ++k) uv[k] = U[(size_t)(n0 + k) * 4096];
#pragma unroll
            for (int k = 0; k < 8; ++k) { SPv[(size_t)(n0 + k) * 4096] = f2bf(s); s = s * cd + uv[k]; } }
        p.out[O_PRET + ((size_t)l * PB * 4 + bh) * 4096 + (ed & 63) * 64 + (ed >> 6)] = s;
    }
}
__device__ __forceinline__ void ph_ret_out(const P& p, int l) {
    const int tid = tidx(), lane = tid & 63, wave = tid >> 6, x = lane & 15, q = lane >> 4, it = UNIFORM(wave & 3);
    const bf16_t* PR = WSP(bf16_t, WS_PROJ);
    for (int u = blockIdx.x * 2 + (wave >> 2); u < NUNIT; u += gridDim.x * 2) {
        const int n = u % NCH, bh = u / NCH, h = bh & 3, b = bh >> 2, t0 = n * 64; const float gam = expf(ret_lg(h));
        const size_t rowi = (size_t)(b * T + t0 + 16 * it + x);
        bf16x8 qf[2];
#pragma unroll
        for (int ks = 0; ks < 2; ++ks) qf[ks] = *(const bf16x8*)(PR + rowi * NPROJ + C_QR + h * 64 + 32 * ks + 8 * q);
        f32x4 at[4];
#pragma unroll
        for (int jt = 0; jt < 4; ++jt) { at[jt] = (f32x4){0.f, 0.f, 0.f, 0.f};
            if (jt <= it) { const bf16_t* kp = PR + (size_t)(b * T + t0 + 16 * jt + x) * NPROJ + C_KR + h * 64 + 8 * q;
#pragma unroll
                for (int ks = 0; ks < 2; ++ks) at[jt] = MFMA16(*(const bf16x8*)(kp + 32 * ks), qf[ks], at[jt]);
                if (jt == it) {
#pragma unroll
                    for (int e = 0; e < 4; ++e) if (4 * q + e > x) at[jt][e] = 0.f; } } }
        const bf16x8 pb0 = pack_tiles(at[0], at[1]), pb1 = pack_tiles(at[2], at[3]);
        f32x4 o[4], os[4];
#pragma unroll
        for (int et = 0; et < 4; ++et) { o[et] = (f32x4){0.f, 0.f, 0.f, 0.f}; os[et] = (f32x4){0.f, 0.f, 0.f, 0.f};
            const bf16_t* vp = WSP(bf16_t, WS_VRT) + ((size_t)bh * 64 + 16 * et + x) * T + t0 + 4 * q;
            { const u32x2 lo = *(const u32x2*)vp, hi = *(const u32x2*)(vp + 16); u32x4 w; w.x = lo.x; w.y = lo.y; w.z = hi.x; w.w = hi.y; o[et] = MFMA16(__builtin_bit_cast(bf16x8, w), pb0, o[et]); }
            if (it >= 2) { const u32x2 lo = *(const u32x2*)(vp + 32), hi = *(const u32x2*)(vp + 48); u32x4 w; w.x = lo.x; w.y = lo.y; w.z = hi.x; w.w = hi.y; o[et] = MFMA16(__builtin_bit_cast(bf16x8, w), pb1, o[et]); }
            const bf16_t* sp = WSP(bf16_t, WS_RS) + (size_t)u * 4096 + (16 * et + x) * 64 + 8 * q;
#pragma unroll
            for (int ks = 0; ks < 2; ++ks) os[et] = MFMA16(*(const bf16x8*)(sp + 32 * ks), qf[ks], os[et]);
            o[et] = o[et] + os[et] * gam; }
        float sq = 0.f;
#pragma unroll
        for (int et = 0; et < 4; ++et) sq += (o[et][0] * o[et][0] + o[et][1] * o[et][1]) + (o[et][2] * o[et][2] + o[et][3] * o[et][3]);
        sq += __shfl_xor(sq, 16); sq += __shfl_xor(sq, 32);
        const float rstd = 1.0f / sqrtf(sq * (1.0f / 64.0f) + EPS);
#pragma unroll
        for (int et = 0; et < 4; ++et) { const int e0 = 16 * et + 4 * q; const u32x2 gw = *(const u32x2*)(PR + rowi * NPROJ + C_GR + h * 64 + e0); const f32x4 nw = *(const f32x4*)(p.ret_norm + l * 64 + e0);
            const float g0 = bf2f((bf16_t)(gw.x & 0xffff)), g1 = bf2f((bf16_t)(gw.x >> 16)), g2 = bf2f((bf16_t)(gw.y & 0xffff)), g3 = bf2f((bf16_t)(gw.y >> 16));
            u32x2 w; w.x = pk2(o[et][0] * rstd * nw[0] * silu_f(g0), o[et][1] * rstd * nw[1] * silu_f(g1)); w.y = pk2(o[et][2] * rstd * nw[2] * silu_f(g2), o[et][3] * rstd * nw[3] * silu_f(g3));
            *(u32x2*)(WSP(bf16_t, WS_O) + rowi * D + 256 + h * 64 + e0) = w; }
    }
}
__device__ __forceinline__ void ph_ret_sample(const P& p, int l, unsigned char* smem) {
    float* S0 = (float*)smem; float* qs = S0 + 4096; float* ks = qs + 8 * 64; float* vs = ks + 8 * 64;
    const int tid = tidx(); const bf16_t* PR = WSP(bf16_t, WS_PROJ);
    for (int u = gridDim.x - 1 - blockIdx.x; u < DB * 4; u += gridDim.x) {
        const int h = u & 3, b = u >> 2; const float lg = ret_lg(h);
        __syncthreads();
        for (int e = tid; e < 4096; e += NTHR) S0[e] = p.state_ret[(((size_t)l * DB + b) * 4 + h) * 4096 + e];
        { const int j = tid >> 6, d = tid & 63; const size_t row = (size_t)(MP + b * DS + j) * NPROJ;
          qs[tid] = bf2f(PR[row + C_QR + h * 64 + d]); ks[tid] = bf2f(PR[row + C_KR + h * 64 + d]); vs[tid] = bf2f(PR[row + C_VR + h * 64 + d]); }
        __syncthreads();
        { const int i = tid >> 6, e = tid & 63; float o = 0.f;
          for (int j = 0; j <= i; ++j) { float a = 0.f; for (int d = 0; d < 64; ++d) a += qs[i * 64 + d] * ks[j * 64 + d]; o += a * expf(lg * (float)(i - j)) * vs[j * 64 + e]; }
          float o2 = 0.f; for (int d = 0; d < 64; ++d) o2 += qs[i * 64 + d] * S0[d * 64 + e];
          o += o2 * expf(lg * (float)(i + 1));
          const float rstd = 1.0f / sqrtf(wave_sum(o * o) * (1.0f / 64.0f) + EPS);
          const size_t row = (size_t)(MP + b * DS + i); const float g = bf2f(PR[row * NPROJ + C_GR + h * 64 + e]);
          WSP(bf16_t, WS_O)[row * D + 256 + h * 64 + e] = f2bf(o * rstd * p.ret_norm[l * 64 + e] * silu_f(g)); }
        for (int x = tid; x < 4096; x += NTHR) { const int d = x >> 6, e = x & 63; float s = S0[x] * expf(lg * (float)DS);
            for (int j = 0; j < DS; ++j) s += ks[j * 64 + d] * expf(lg * (float)(DS - 1 - j)) * vs[j * 64 + e];
            p.out[O_SRET + (((size_t)l * DB + b) * 4 + h) * 4096 + x] = s; }
    }
}

template <int CS, int LDL> __device__ __forceinline__ void fwd_subst(float (&X)[CS], const float* Ls) {
#pragma unroll
    for (int i = 1; i < CS; ++i) {
        float a[4] = {X[i], 0.f, 0.f, 0.f};
#pragma unroll
        for (int j4 = 0; j4 < (i + 3) / 4; ++j4) { const f32x4 lv = *(const f32x4*)(Ls + i * LDL + 4 * j4);
#pragma unroll
            for (int e = 0; e < 4; ++e) if (4 * j4 + e < i) a[e] -= lv[e] * X[4 * j4 + e]; }
        X[i] = (a[0] + a[1]) + (a[2] + a[3]);
    }
}
constexpr int QP = 132;
constexpr int WSTP = 136;
constexpr int RWP = 392, TP = 136;
__device__ __forceinline__ void ph_gdn_prep(const P& p, int l, unsigned char* smem) {
    float* Ls = (float*)smem; float* As = Ls + 64 * 68; float* gs = As + 64 * 68; float* gcs = gs + 64; float* bts = gcs + 64; float* part = bts + 64;
    bf16_t* raw = (bf16_t*)(part + 4 * 64); bf16_t* Khi = raw + 67 * RWP; bf16_t* Klo = Khi + 64 * TP; bf16_t* Qb = Klo + 64 * TP;
    static_assert((64 * 68 * 2 + 64 * 3 + 4 * 64) * 4 + (67 * RWP + 3 * 64 * TP) * 2 <= BAR_LDS_OFF, "gdn_prep LDS");
    const int tid = tidx(), lane = tid & 63, wave = tid >> 6; const bf16_t* PR = WSP(bf16_t, WS_PROJ);
    for (int u = blockIdx.x; u < NUNIT; u += gridDim.x) {
        const int n = u % NCH, h = (u / NCH) % 4, b = u / (NCH * 4), t0 = n * 64;
        __syncthreads();
        for (int e = tid; e < 67 * 48; e += NTHR) { const int row = e / 48, ch = e % 48, t = t0 - 3 + row; u32x4 v = (u32x4){0u, 0u, 0u, 0u};
            if (t >= 0) v = *(const u32x4*)(PR + (size_t)(b * T + t) * NPROJ + C_CONV + (ch >> 4) * 512 + h * 128 + (ch & 15) * 8);
            *(u32x4*)(raw + row * RWP + ch * 8) = v; }
        if (tid >= 384 && tid < 448) { const int i = tid - 384; const size_t row = (size_t)(b * T + t0 + i); gs[i] = WSP(float, WS_G)[row * 4 + h]; bts[i] = WSP(float, WS_BETA)[row * 4 + h]; }
        __syncthreads();
        float y[64]; const int sec = tid < 128 ? 2 : tid < 256 ? 1 : 0, c = tid & 127;
        if (tid < 384) { const int col = sec * 512 + h * 128 + c;
            const float w0 = p.conv_w[(l * 4 + 0) * 1536 + col], w1 = p.conv_w[(l * 4 + 1) * 1536 + col], w2 = p.conv_w[(l * 4 + 2) * 1536 + col], w3 = p.conv_w[(l * 4 + 3) * 1536 + col];
            const LAS bf16_t* rp = (const LAS bf16_t*)raw + sec * 128 + c; LAUNDER_V(rp); float x0 = bf2f(rp[0]), x1 = bf2f(rp[RWP]), x2 = bf2f(rp[2 * RWP]);
#pragma unroll
            for (int i = 0; i < 64; ++i) { const float x3 = bf2f(rp[(i + 3) * RWP]); y[i] = silu_fast(w0 * x0 + w1 * x1 + w2 * x2 + w3 * x3); x0 = x1; x1 = x2; x2 = x3; if ((i & 7) == 7) COMPILER_FENCE(); } }
        if (tid >= 448) { if (tid == 448) { float a = 0.f; for (int i = 0; i < 64; ++i) { a += gs[i]; gcs[i] = a; } }
            WAVE_SYNC(); const int i = tid - 448; part[128 + i] = expf(gcs[i]); part[192 + i] = expf(gcs[63] - gcs[i]); }
#pragma unroll
        for (int pass = 0; pass < 2; ++pass) {
            if (tid >= 128 + 128 * pass && tid < 256 + 128 * pass) { LAS float* sq = (LAS float*)Ls + c; LAUNDER_V(sq);
#pragma unroll
                for (int i = 0; i < 64; ++i) sq[i * 132] = y[i] * y[i]; }
            __syncthreads();
            { const int i = tid >> 3, pt = tid & 7; const float* rp2 = Ls + i * 132 + pt * 16; float a = 0.f;
#pragma unroll
              for (int k = 0; k < 16; ++k) a += rp2[k];
              a += __shfl_xor(a, 1); a += __shfl_xor(a, 2); a += __shfl_xor(a, 4);
              if (pt == 0) part[64 * pass + i] = 1.0f / sqrtf(a + EPS); }
            __syncthreads();
        }
        if (tid >= 128 && tid < 256) { LAS bf16_t* kh = (LAS bf16_t*)Khi + c; LAS bf16_t* kl = (LAS bf16_t*)Klo + c; LAUNDER_V(kh); LAUNDER_V(kl);
#pragma unroll
            for (int i = 0; i < 64; ++i) { const float v = y[i] * part[i]; y[i] = v; const bf16_t hb = f2bf(v); kh[i * TP] = hb; kl[i * TP] = f2bf(v - bf2f(hb)); if ((i & 7) == 7) COMPILER_FENCE(); }
            bf16_t* dst = WSP(bf16_t, WS_GWK) + (size_t)u * 16384 + 8192; const int mt = c >> 4, x = c & 15;
#pragma unroll
            for (int ks2 = 0; ks2 < 2; ++ks2)
#pragma unroll
                for (int q = 0; q < 4; ++q) { const int i0 = 32 * ks2 + 4 * q; float v[8];
#pragma unroll
                    for (int e = 0; e < 8; ++e) { const int i = i0 + (e < 4 ? e : 12 + e); v[e] = y[i] * part[192 + i]; }
                    u32x4 w; w.x = pk2(v[0], v[1]); w.y = pk2(v[2], v[3]); w.z = pk2(v[4], v[5]); w.w = pk2(v[6], v[7]);
                    *(u32x4*)(dst + ((size_t)((mt * 2 + ks2) * 64 + q * 16 + x)) * 8) = w; COMPILER_FENCE(); } }
        else if (tid >= 256 && tid < 384) { bf16_t* qg = WSP(bf16_t, WS_GQ) + (size_t)u * 8192 + c; LAS bf16_t* qb = (LAS bf16_t*)Qb + c; LAUNDER_V(qb);
#pragma unroll
            for (int i = 0; i < 64; ++i) { const float v = y[i] * part[64 + i]; qb[i * TP] = f2bf(v); qg[(i & 7) * 128] = f2bf(v * 0.08838834764831845f * part[128 + i]); if ((i & 7) == 7) { qg += 8 * 128; LAUNDER_V(qg); COMPILER_FENCE(); } } }
        __syncthreads();
#pragma unroll
        for (int tp = 0; tp < 2; ++tp) { const int pos = wave * 2 + tp, it = pos >> 2, jt = pos & 3, j16 = lane & 15, qd = lane >> 4;
            f32x4 lk = (f32x4){0.f, 0.f, 0.f, 0.f}, aq = (f32x4){0.f, 0.f, 0.f, 0.f};
            if (jt <= it) {
#pragma unroll
                for (int ks = 0; ks < 4; ++ks) { const int ao = (16 * it + j16) * TP + 32 * ks + 8 * qd, bo = (16 * jt + j16) * TP + 32 * ks + 8 * qd;
                    const bf16x8 ah = *(const bf16x8*)(Khi + ao), al = *(const bf16x8*)(Klo + ao), aqf = *(const bf16x8*)(Qb + ao), bh = *(const bf16x8*)(Khi + bo), bl = *(const bf16x8*)(Klo + bo);
                    lk = MFMA16(ah, bh, lk); lk = MFMA16(ah, bl, lk); lk = MFMA16(al, bh, lk); aq = MFMA16(aqf, bh, aq); } }
            const int j = 16 * jt + j16;
#pragma unroll
            for (int e = 0; e < 4; ++e) { const int i = 16 * it + 4 * qd + e; const float ex = j <= i ? expf(gcs[i] - gcs[j]) : 0.f;
                Ls[i * 68 + j] = j < i ? bts[i] * lk[e] * ex : 0.f; As[i * 68 + j] = aq[e] * ex * 0.08838834764831845f; } }
        __syncthreads();
        if (tid < 256) {
            if (tid < 128) {
#pragma unroll
                for (int i = 0; i < 64; ++i) { y[i] *= bts[i]; if ((i & 15) == 15) COMPILER_FENCE(); } }
            else {
#pragma unroll
                for (int i = 0; i < 64; ++i) { y[i] *= bts[i] * part[128 + i]; if ((i & 15) == 15) COMPILER_FENCE(); } }
            fwd_subst<64, 68>(y, Ls);
            if (tid < 128) { bf16_t* U = WSP(bf16_t, WS_GU) + (size_t)u * 8192 + c * 64;
#pragma unroll
                for (int i8 = 0; i8 < 8; ++i8) { u32x4 w; w.x = pk2(y[8 * i8], y[8 * i8 + 1]); w.y = pk2(y[8 * i8 + 2], y[8 * i8 + 3]); w.z = pk2(y[8 * i8 + 4], y[8 * i8 + 5]); w.w = pk2(y[8 * i8 + 6], y[8 * i8 + 7]); *(u32x4*)(U + 8 * i8) = w; } }
            else { LAS bf16_t* wst = (LAS bf16_t*)raw + c; LAUNDER_V(wst);
#pragma unroll
                for (int i = 0; i < 64; ++i) wst[i * WSTP] = f2bf(-y[i]); }
        } else { const int t2 = tid - 256;
#pragma unroll 2
            for (int e = t2; e < 4096; e += 256) WSP(bf16_t, WS_GA)[(size_t)u * 4096 + e] = f2bf(As[(e >> 6) * 68 + (e & 63)]);
            if (t2 == 0) WSP(float, WS_GD)[u] = expf(gcs[63]); }
        __syncthreads();
        { bf16_t* dst = WSP(bf16_t, WS_GWK) + (size_t)u * 16384; const bf16_t* wst = raw;
#pragma unroll
          for (int k = 0; k < 2; ++k) { const int f = tid + NTHR * k, ln = f & 63, ks4 = (f >> 6) & 3, mt = f >> 8, q = ln >> 4, x = ln & 15;
              const bf16_t* wr = wst + (16 * mt + x) * WSTP + 32 * ks4 + 4 * q;
              u32x4 w; w.x = (unsigned)wr[0] | ((unsigned)wr[1] << 16); w.y = (unsigned)wr[2] | ((unsigned)wr[3] << 16); w.z = (unsigned)wr[16] | ((unsigned)wr[17] << 16); w.w = (unsigned)wr[18] | ((unsigned)wr[19] << 16);
              *(u32x4*)(dst + (size_t)f * 8) = w; } }
    }
}
constexpr int CH_SLOT = 40960, CH_NSLOT = 3;
static_assert(NCH % 4 == 0, "the chain's loop is unrolled by four chunks");
__device__ __forceinline__ void chain_stage(const bf16_t* WK, const bf16_t* UTh, int m, int pw, int lane, unsigned char* smem) {
    unsigned char* slot = smem + (m % CH_NSLOT) * CH_SLOT;
#pragma unroll
    for (int k = 0; k < 8; ++k) GLDS16((const unsigned char*)(WK + (size_t)m * 16384) + (pw * 8 + k) * 1024 + lane * 16, slot + (pw * 8 + k) * 1024);
#pragma unroll
    for (int k = 0; k < 2; ++k) GLDS16((const unsigned char*)(UTh + (size_t)m * 8192) + (pw * 2 + k) * 1024 + lane * 16, slot + 32768 + (pw * 2 + k) * 1024);
}
__device__ __forceinline__ void ph_gdn_chain(const P& p, int l, unsigned char* smem) {
    const int tid = tidx(), lane = tid & 63, wave = UNIFORM(tid >> 6), j = lane & 15, q = lane >> 4;
    for (int it = blockIdx.x; it < CH_ITEMS; it += gridDim.x) {
        const int half = it & 1, bh = it >> 1;
        const bf16_t* WK = WSP(bf16_t, WS_GWK) + (size_t)bh * NCH * 16384;
        const bf16_t* UTh = WSP(bf16_t, WS_GU) + (size_t)bh * NCH * 8192 + half * 4096;
        __syncthreads();
        if (wave >= 4) {
            const int pw = wave - 4;
            chain_stage(WK, UTh, 0, pw, lane, smem); chain_stage(WK, UTh, 1, pw, lane, smem);
#pragma unroll 1
            for (int n = 0; n < NCH; ++n) {
                if (n + 1 < NCH) WAIT_VM(10); else WAIT_VM(0);
                RAW_BARRIER();
                if (n + 2 < NCH) chain_stage(WK, UTh, n + 2, pw, lane, smem);
            }
        } else {
            const int sl = half * 4 + wave, c = 16 * sl + j;
            f32x4 S[8];
#pragma unroll
            for (int t = 0; t < 8; ++t) S[t] = (f32x4){0.f, 0.f, 0.f, 0.f};
            bf16x8 sB[4];
#pragma unroll
            for (int ks = 0; ks < 4; ++ks) sB[ks] = pack_tiles(S[2 * ks], S[2 * ks + 1]);
            const float* DC = WSP(float, WS_GD) + bh * NCH;
            float db[4];
#pragma unroll
            for (int d = 0; d < 4; ++d) db[d] = DC[d];
#pragma unroll 1
            for (int n0 = 0; n0 < NCH; n0 += 4) {
#pragma unroll
                for (int k4 = 0; k4 < 4; ++k4) {
                    const int n = n0 + k4, u = bh * NCH + n;
                    f32x4 acc[4]; const float dec = db[k4];
                    if (n + 4 < NCH) db[k4] = DC[n + 4];
                    { bf16_t* sp = WSP(bf16_t, WS_GS) + (size_t)u * 16384 + (size_t)sl * 2048 + lane * 4;
#pragma unroll
                      for (int t = 0; t < 8; ++t) { u32x2 w; w.x = pk2(S[t][0], S[t][1]); w.y = pk2(S[t][2], S[t][3]); *(u32x2*)(sp + 256 * t) = w; } }
                    WAIT_LGKM0();
                    RAW_BARRIER();
                    const LAS unsigned char* slot = (const LAS unsigned char*)smem + (n % CH_NSLOT) * CH_SLOT + lane * 16; LAUNDER_V(slot);
                    { const LAS unsigned char* us = (const LAS unsigned char*)smem + (n % CH_NSLOT) * CH_SLOT + 32768 + ((16 * wave + j) * 64 + 4 * q) * 2; LAUNDER_V(us);
#pragma unroll
                      for (int mt = 0; mt < 4; ++mt) { const u32x2 w = *(const LAS u32x2*)(us + 32 * mt); acc[mt] = (f32x4){bf2f((bf16_t)(w.x & 0xffff)), bf2f((bf16_t)(w.x >> 16)), bf2f((bf16_t)(w.y & 0xffff)), bf2f((bf16_t)(w.y >> 16))}; } }
                    bf16x8 fa[8], fb[8];
#pragma unroll
                    for (int i = 0; i < 8; ++i) fa[i] = *(const LAS bf16x8*)(slot + i * 1024);
#pragma unroll
                    for (int i = 0; i < 8; ++i) fb[i] = *(const LAS bf16x8*)(slot + (8 + i) * 1024);
                    COMPILER_FENCE();
#pragma unroll
                    for (int ks = 0; ks < 4; ++ks) { acc[0] = MFMA16(fa[ks], sB[ks], acc[0]); acc[1] = MFMA16(fa[4 + ks], sB[ks], acc[1]); }
                    COMPILER_FENCE();
#pragma unroll
                    for (int i = 0; i < 8; ++i) fa[i] = *(const LAS bf16x8*)(slot + 16384 + i * 1024);
#pragma unroll
                    for (int ks = 0; ks < 4; ++ks) { acc[2] = MFMA16(fb[ks], sB[ks], acc[2]); acc[3] = MFMA16(fb[4 + ks], sB[ks], acc[3]); }
                    COMPILER_FENCE();
#pragma unroll
                    for (int i = 0; i < 8; ++i) fb[i] = *(const LAS bf16x8*)(slot + 16384 + (8 + i) * 1024);
                    { bf16_t* vp = WSP(bf16_t, WS_GV) + (size_t)u * 8192 + (size_t)sl * 1024 + lane * 4;
#pragma unroll
                      for (int mt = 0; mt < 4; ++mt) { u32x2 w; w.x = pk2(acc[mt][0], acc[mt][1]); w.y = pk2(acc[mt][2], acc[mt][3]); *(u32x2*)(vp + 256 * mt) = w; } }
                    const bf16x8 vB0 = pack_tiles(acc[0], acc[1]), vB1 = pack_tiles(acc[2], acc[3]);
#pragma unroll
                    for (int t = 0; t < 8; ++t) S[t] = S[t] * dec;
                    COMPILER_FENCE();
#pragma unroll
                    for (int t = 0; t < 4; ++t) S[t] = MFMA16(fa[2 * t], vB0, S[t]);
#pragma unroll
                    for (int t = 0; t < 4; ++t) S[t] = MFMA16(fa[2 * t + 1], vB1, S[t]);
#pragma unroll
                    for (int t = 0; t < 4; ++t) S[4 + t] = MFMA16(fb[2 * t], vB0, S[4 + t]);
#pragma unroll
                    for (int t = 0; t < 4; ++t) S[4 + t] = MFMA16(fb[2 * t + 1], vB1, S[4 + t]);
                    COMPILER_FENCE();
#pragma unroll
                    for (int ks = 0; ks < 4; ++ks) sB[ks] = pack_tiles(S[2 * ks], S[2 * ks + 1]);
                }
            }
            float* o = p.out + O_PGDN + ((size_t)l * PB * 4 + bh) * 16384 + c;
#pragma unroll
            for (int t = 0; t < 8; ++t)
#pragma unroll
                for (int e = 0; e < 4; ++e) o[(size_t)(16 * t + 4 * q + e) * 128] = S[t][e];
        }
    }
}
__device__ __forceinline__ void ph_gdn_out(const P& p, int l) {
    const int tid = tidx(), lane = tid & 63, wave = tid >> 6, j = lane & 15, q = lane >> 4, mt = wave & 3;
    const bf16_t* PR = WSP(bf16_t, WS_PROJ);
    for (int u = blockIdx.x * 2 + (wave >> 2); u < NUNIT; u += gridDim.x * 2) {
        const int n = u % NCH, h = (u / NCH) % 4, b = u / (NCH * 4);
        f32x4 acc[8];
#pragma unroll
        for (int ct = 0; ct < 8; ++ct) acc[ct] = (f32x4){0.f, 0.f, 0.f, 0.f};
        const bf16_t* qg = WSP(bf16_t, WS_GQ) + (size_t)u * 8192 + (16 * mt + j) * 128 + 8 * q;
        const bf16_t* st = WSP(bf16_t, WS_GS) + (size_t)u * 16384 + (size_t)(q >> 1) * 256 + ((2 * (q & 1)) * 16 + j) * 4;
#pragma unroll
        for (int ks = 0; ks < 4; ++ks) { const bf16x8 a = *(const bf16x8*)(qg + 32 * ks);
#pragma unroll
            for (int ct = 0; ct < 8; ++ct) { const bf16_t* sp = st + (size_t)ct * 2048 + ks * 512; const u32x2 lo = *(const u32x2*)sp, hi = *(const u32x2*)(sp + 64); u32x4 w; w.x = lo.x; w.y = lo.y; w.z = hi.x; w.w = hi.y;
                acc[ct] = MFMA16(a, __builtin_bit_cast(bf16x8, w), acc[ct]); }
            COMPILER_FENCE(); }
        const bf16_t* at = WSP(bf16_t, WS_GA) + (size_t)u * 4096 + (16 * mt + j) * 64 + 8 * q;
        const bf16_t* vt = WSP(bf16_t, WS_GV) + (size_t)u * 8192 + (size_t)(q >> 1) * 256 + ((2 * (q & 1)) * 16 + j) * 4;
#pragma unroll
        for (int ks = 0; ks < 2; ++ks) { const bf16x8 a = *(const bf16x8*)(at + 32 * ks);
#pragma unroll
            for (int ct = 0; ct < 8; ++ct) { const bf16_t* vp = vt + (size_t)ct * 1024 + ks * 512; const u32x2 lo = *(const u32x2*)vp, hi = *(const u32x2*)(vp + 64); u32x4 w; w.x = lo.x; w.y = lo.y; w.z = hi.x; w.w = hi.y;
                acc[ct] = MFMA16(a, __builtin_bit_cast(bf16x8, w), acc[ct]); }
            COMPILER_FENCE(); }
        float sq[4];
#pragma unroll
        for (int e = 0; e < 4; ++e) { float s = 0.f;
#pragma unroll
            for (int ct = 0; ct < 8; ++ct) s += acc[ct][e] * acc[ct][e];
            s += __shfl_xor(s, 1); s += __shfl_xor(s, 2); s += __shfl_xor(s, 4); s += __shfl_xor(s, 8); sq[e] = 1.0f / sqrtf(s * (1.0f / 128.0f) + EPS); }
#pragma unroll
        for (int e = 0; e < 4; ++e) { const size_t row = (size_t)(b * T + n * 64 + 16 * mt + 4 * q + e);
#pragma unroll
            for (int ct = 0; ct < 8; ++ct) { const int c = 16 * ct + j; const float z = bf2f(PR[row * NPROJ + C_Z + h * 128 + c]);
                WSP(bf16_t, WS_O)[row * D + 512 + h * 128 + c] = f2bf(acc[ct][e] * sq[e] * p.gdn_norm[l * 128 + c] * silu_f(z)); } }
    }
}
__device__ __forceinline__ void ph_gdn_sample(const P& p, int l, unsigned char* smem) {
    float* qs = (float*)smem; float* ks = qs + 8 * QP; float* vs = ks + 8 * QP; float* us = vs + 8 * QP; float* wsm = us + 8 * 128; float* vn = wsm + 8 * 128;
    float* Ls = vn + 8 * 128; float* As = Ls + 8 * 8; float* gs = As + 8 * 8; float* gcs = gs + 8; float* bts = gcs + 8; float* S0 = bts + 8;
    const int tid = tidx(); const bf16_t* PR = WSP(bf16_t, WS_PROJ);
    for (int u = gridDim.x - 1 - blockIdx.x; u < DB * 4; u += gridDim.x) {
        const int h = u & 3, b = u >> 2;
        __syncthreads();
#pragma unroll 4
        for (int e = tid; e < 16384; e += NTHR) S0[e] = p.state_gdn[(((size_t)l * DB + b) * 4 + h) * 16384 + e];
        if (tid < 384) { const int sec = tid >> 7, c = tid & 127, col = sec * 512 + h * 128 + c; float* dst = sec == 0 ? qs : sec == 1 ? ks : vs;
            const float w0 = p.conv_w[(l * 4 + 0) * 1536 + col], w1 = p.conv_w[(l * 4 + 1) * 1536 + col], w2 = p.conv_w[(l * 4 + 2) * 1536 + col], w3 = p.conv_w[(l * 4 + 3) * 1536 + col];
            const float* hist = p.state_conv + (((size_t)l * DB + b) * 3) * 1536 + col; const bf16_t* src = PR + (size_t)(MP + b * DS) * NPROJ + C_CONV + col;
            float x0 = hist[0], x1 = hist[1536], x2 = hist[2 * 1536];
            for (int i = 0; i < DS; ++i) { const float x3 = bf2f(src[(size_t)i * NPROJ]); const float y = w0 * x0 + w1 * x1 + w2 * x2 + w3 * x3; dst[i * QP + c] = silu_f(y); x0 = x1; x1 = x2; x2 = x3; } }
        else if (tid < 384 + DS) { const int i = tid - 384; const size_t row = (size_t)(MP + b * DS + i); gs[i] = WSP(float, WS_G)[row * 4 + h]; bts[i] = WSP(float, WS_BETA)[row * 4 + h]; }
        __syncthreads();
        if (tid < 64) { const int rid = tid >> 2, part = tid & 3; float* rowp = (rid < 8 ? qs + rid * QP : ks + (rid - 8) * QP) + part * 32; float s = 0.f;
            for (int d = 0; d < 32; ++d) s += rowp[d] * rowp[d];
            s += __shfl_xor(s, 1); s += __shfl_xor(s, 2); const float sc = 1.0f / sqrtf(s + EPS);
            for (int d = 0; d < 32; ++d) rowp[d] *= sc; }
        if (tid == 64) { float a = 0.f; for (int i = 0; i < DS; ++i) { a += gs[i]; gcs[i] = a; } }
        __syncthreads();
        if (tid < 64) { const int i = tid >> 3, j = tid & 7; float lv = 0.f, av = 0.f;
            if (j <= i) { float dk = 0.f, dq = 0.f; for (int d = 0; d < 128; ++d) { const float kj = ks[j * QP + d]; dk += ks[i * QP + d] * kj; dq += qs[i * QP + d] * kj; }
                const float e = expf(gcs[i] - gcs[j]); av = dq * e * 0.08838834764831845f; lv = j < i ? bts[i] * dk * e : 0.f; }
            Ls[i * 8 + j] = lv; As[i * 8 + j] = av; }
        __syncthreads();
        if (tid < 256) { const int c = tid; float X[8];
            if (c < 128) {
#pragma unroll
                for (int i = 0; i < 8; ++i) X[i] = vs[i * QP + c] * bts[i]; }
            else {
#pragma unroll
                for (int i = 0; i < 8; ++i) X[i] = ks[i * QP + c - 128] * bts[i] * expf(gcs[i]); }
            fwd_subst<8, 8>(X, Ls);
            float* dst = c < 128 ? us + c : wsm + c - 128;
#pragma unroll
            for (int i = 0; i < 8; ++i) dst[i * 128] = X[i]; }
        __syncthreads();
        const int i = tid >> 6, c2 = (tid & 63) * 2;
        { float a0 = us[i * 128 + c2], a1 = us[i * 128 + c2 + 1];
          for (int d = 0; d < 128; ++d) { const float w = wsm[i * 128 + d]; a0 -= w * S0[d * 128 + c2]; a1 -= w * S0[d * 128 + c2 + 1]; }
          vn[i * 128 + c2] = a0; vn[i * 128 + c2 + 1] = a1; }
        __syncthreads();
        { float o0 = 0.f, o1 = 0.f; const float qsc = 0.08838834764831845f * expf(gcs[i]);
          for (int d = 0; d < 128; ++d) { const float qg = qs[i * QP + d] * qsc; o0 += qg * S0[d * 128 + c2]; o1 += qg * S0[d * 128 + c2 + 1]; }
          for (int j = 0; j < DS; ++j) { const float a = As[i * 8 + j]; o0 += a * vn[j * 128 + c2]; o1 += a * vn[j * 128 + c2 + 1]; }
          const float rstd = 1.0f / sqrtf(wave_sum(o0 * o0 + o1 * o1) * (1.0f / 128.0f) + EPS);
          const size_t row = (size_t)(MP + b * DS + i);
          const float z0 = bf2f(PR[row * NPROJ + C_Z + h * 128 + c2]), z1 = bf2f(PR[row * NPROJ + C_Z + h * 128 + c2 + 1]);
          bf16_t* O = WSP(bf16_t, WS_O) + row * D + 512 + h * 128 + c2;
          O[0] = f2bf(o0 * rstd * p.gdn_norm[l * 128 + c2] * silu_f(z0)); O[1] = f2bf(o1 * rstd * p.gdn_norm[l * 128 + c2 + 1] * silu_f(z1)); }
        { const float gl = gcs[DS - 1], dec = expf(gl); float* o = p.out + O_SGDN + (((size_t)l * DB + b) * 4 + h) * 16384;
#pragma unroll 2
          for (int e = tid; e < 16384; e += NTHR) { const int d = e >> 7, c = e & 127; float s = S0[e] * dec;
              for (int j = 0; j < DS; ++j) s += ks[j * QP + d] * expf(gl - gcs[j]) * vn[j * 128 + c];
              o[e] = s; } }
    }
}


template <int K> __device__ __forceinline__ void ph_gemm_small(const P& p, const bf16_t* A  , const bf16_t* Bt  , const float* gate, const float* xs_in  , unsigned char* smem) {
    static_assert(MS % 16 == 0 && K % 256 == 0, "small GEMM shape");
    constexpr int KW = K / 8, NKS = KW / 32;
    const int tid = tidx(), lane = tid & 63, wave = tid >> 6, x = lane & 15, q = lane >> 4;
    float* red = (float*)smem;
    for (int it = blockIdx.x; it < (MS / 16) * 16; it += gridDim.x) {
        const int rt = it % (MS / 16), cg = it / (MS / 16);
        const bf16_t* ap = A + (size_t)(16 * rt + x) * K + wave * KW + 8 * q;
        const bf16_t* bp = Bt + (size_t)(64 * cg + x) * K + wave * KW + 8 * q;
        f32x4 acc[4];
#pragma unroll
        for (int ct = 0; ct < 4; ++ct) acc[ct] = (f32x4){0.f, 0.f, 0.f, 0.f};
#pragma unroll
        for (int ks = 0; ks < NKS; ++ks) { const bf16x8 a = *(const bf16x8*)(ap + 32 * ks);
#pragma unroll
            for (int ct = 0; ct < 4; ++ct) acc[ct] = MFMA16(a, *(const bf16x8*)(bp + (size_t)ct * 16 * K + 32 * ks), acc[ct]); }
        __syncthreads();
#pragma unroll
        for (int ct = 0; ct < 4; ++ct) *(f32x4*)(red + ((wave * 4 + ct) * 64 + lane) * 4) = acc[ct];
        __syncthreads();
        if (wave < 4) { f32x4 s = (f32x4){0.f, 0.f, 0.f, 0.f};
#pragma unroll
            for (int w = 0; w < 8; ++w) s += *(const f32x4*)(red + ((w * 4 + wave) * 64 + lane) * 4);
            const int col = 64 * cg + 16 * wave + x;
#pragma unroll
            for (int e = 0; e < 4; ++e) { const int row = MP + 16 * rt + 4 * q + e; float* xp = p.out + (size_t)row * D + col; const float xin = xs_in ? xs_in[(size_t)(row - MP) * D + col] : *xp; *xp = xin + gate[(size_t)row_cb(row) * 6144 + col] * s[e]; } }
    }
}

__device__ __forceinline__ void ph_final_norm(const P& p) {
    const int lane = tidx() & 63, wave = tidx() >> 6, gw = blockIdx.x * 8 + wave, ngw = gridDim.x * 8;
    for (int r = gw; r < M; r += ngw) {
        float* xr = p.out + (size_t)r * D; f32x4 v[4]; float ss = 0.f;
#pragma unroll
        for (int j = 0; j < 4; ++j) { v[j] = *(const f32x4*)(xr + 4 * lane + 256 * j); ss += (v[j][0] * v[j][0] + v[j][1] * v[j][1]) + (v[j][2] * v[j][2] + v[j][3] * v[j][3]); }
        const float rstd = 1.0f / sqrtf(wave_sum(ss) * (1.0f / D) + EPS);
#pragma unroll
        for (int j = 0; j < 4; ++j) { const f32x4 g = *(const f32x4*)(p.final_norm + 4 * lane + 256 * j); *(f32x4*)(xr + 4 * lane + 256 * j) = v[j] * rstd * g; }
    }
}

enum Phase { PH_PRO = 0, PH_NORM1, PH_GEMM_IN, PH_ROPE, PH_MIX1, PH_MIX2, PH_MIX3, PH_GEMM_OUT, PH_NORM2, PH_GEMM_GU, PH_GEMM_DN, PH_FINAL };
#ifdef __HIP_EMU__
#define LDSP(x) (x)
#else
#define LDSP(x) ((PG8_LAS unsigned char*)(x))
#endif
template <int PH> __device__ __forceinline__ void run_phase(const P& p, int l, unsigned char* smem) {
    if constexpr (PH == PH_PRO) { ph_convert(p, smem, 0, CV_IN, 0); __syncthreads(); ph_adaln(p, smem, 0, 1, 0); ph_ropetab_copyx(p); }
    else if constexpr (PH == PH_NORM1) ph_norm_mod<0>(p, l);
    else if constexpr (PH == PH_GEMM_IN) {
        pg8::Gemm g{WSP(bf16_t, WS_H), WSP(bf16_t, WS_WIN) + (size_t)l * NPROJ * D, MPAD, NPROJ, D}; pg8::StaticOrder S; S.init(MPAD, NPROJ, (int)gridDim.x, (int)blockIdx.x);
        pg8::EpiStoreBf16 E{WSP(bf16_t, WS_PROJ), NPROJ};
        pg8::gemm_phase<pg8::EpiStoreBf16, pg8::StaticOrder, true, true>(LDSP(smem), g, S, E);
    }
    else if constexpr (PH == PH_ROPE) { ph_rope_out(p, l); ph_vtrans(p, l, smem); }
    else if constexpr (PH == PH_MIX1) { ph_ret_local(p, l); ph_gdn_prep(p, l, smem); }
    else if constexpr (PH == PH_MIX2) { ph_gdn_chain(p, l, smem); { const int G = (int)gridDim.x; const bool split = G >= CH_ITEMS + DB * 4 + 16; ph_attn_jobs(p, split ? CH_ITEMS : 0, split ? G - DB * 4 : G); }
        __syncthreads(); ph_attn_sample(p, l, smem); ph_ret_sample(p, l, smem); ph_gdn_sample(p, l, smem); ph_ret_scan(p, l);
        if (l + 1 < NL) { const int b0 = (int)gridDim.x > 2 * CH_ITEMS ? CH_ITEMS : 0; __syncthreads(); ph_convert(p, smem, l == 0 ? CV_IN : (l + 1) * CV_L, (l + 2) * CV_L, b0); __syncthreads(); ph_adaln(p, smem, l + 1, l + 2, b0); } }
    else if constexpr (PH == PH_MIX3) { ph_attn_combine(p); ph_ret_out(p, l); ph_gdn_out(p, l); }
    else if constexpr (PH == PH_GEMM_OUT) {
        ph_gemm_small<D>(p, WSP(bf16_t, WS_O) + (size_t)MP * D, WSP(bf16_t, WS_WOUT) + (size_t)l * D * D, WSP(float, WS_MOD) + (size_t)l * NC * 6144 + 2048, l == 0 ? p.x_sample : nullptr, smem); __syncthreads();
        pg8::Gemm g{WSP(bf16_t, WS_O), WSP(bf16_t, WS_WOUT) + (size_t)l * D * D, MP, D, D}; pg8::StaticOrder S; S.init(MP, D, (int)gridDim.x, (int)blockIdx.x);
        pg8::EpiResidual E{p.out, WSP(float, WS_MOD) + (size_t)l * NC * 6144 + 2048, l == 0 ? p.x_prompt : p.out};
        pg8::gemm_phase<pg8::EpiResidual, pg8::StaticOrder, true, true>(LDSP(smem), g, S, E);
    }
    else if constexpr (PH == PH_NORM2) ph_norm_mod<1>(p, l);
    else if constexpr (PH == PH_GEMM_GU) {
        pg8::Gemm g{WSP(bf16_t, WS_H), WSP(bf16_t, WS_WGU) + (size_t)l * 2 * FF * D, MPAD, 2 * FF, D}; pg8::StaticOrder S; S.init(MPAD, 2 * FF, (int)gridDim.x, (int)blockIdx.x);
        pg8::EpiSwiglu E{WSP(bf16_t, WS_HID)};
        pg8::gemm_phase<pg8::EpiSwiglu, pg8::StaticOrder, true, true>(LDSP(smem), g, S, E);
    }
    else if constexpr (PH == PH_GEMM_DN) {
        ph_gemm_small<FF>(p, WSP(bf16_t, WS_HID) + (size_t)MP * FF, WSP(bf16_t, WS_WDN) + (size_t)l * D * FF, WSP(float, WS_MOD) + (size_t)l * NC * 6144 + 5120, nullptr, smem); __syncthreads();
        pg8::Gemm g{WSP(bf16_t, WS_HID), WSP(bf16_t, WS_WDN) + (size_t)l * D * FF, MP, D, FF}; pg8::StaticOrder S; S.init(MP, D, (int)gridDim.x, (int)blockIdx.x);
        pg8::EpiResidual E{p.out, WSP(float, WS_MOD) + (size_t)l * NC * 6144 + 5120, p.out};
        pg8::gemm_phase<pg8::EpiResidual, pg8::StaticOrder, true, true>(LDSP(smem), g, S, E);
    }
    else if constexpr (PH == PH_FINAL) ph_final_norm(p);
}
template <int PH> __global__ void __launch_bounds__(NTHR, 2) k_phase(P p, int l) { DYN_SMEM(smem); run_phase<PH>(p, l, smem); }


#ifndef __HIP_EMU__
#define LAS __attribute__((address_space(3)))
#define XB_TMO      128
#define XB_XCNT(j)  (256  + 64 * (j))
#define XB_XSUB(j)  (1280 + 64 * (j))
#define XB_XGEN(j)  (2304 + 64 * (j))
#define XB_TOP      3328
#define XB_TOPGEN   3392
#define XCD_BAR_WORDS 3456
#define XB_SPIN_CAP (1u << 18)

__device__ __forceinline__ unsigned xb_ld(unsigned* p)              { return __hip_atomic_load(p, __ATOMIC_RELAXED, __HIP_MEMORY_SCOPE_AGENT); }
__device__ __forceinline__ unsigned xb_add(unsigned* p, unsigned v) { return __hip_atomic_fetch_add(p, v, __ATOMIC_RELAXED, __HIP_MEMORY_SCOPE_AGENT); }
__device__ __forceinline__ unsigned xb_xcc_id() { return (unsigned)__builtin_amdgcn_s_getreg((3 << 11) | 20) & 0xFu; }
#define XB_SPIN(cond, bar) do { unsigned _sp = 0; while (cond) { __builtin_amdgcn_s_sleep(1); \
    if ((++_sp & 255u) == 0u) { if (xb_ld(&(bar)[XB_TMO])) break; if (_sp > XB_SPIN_CAP) { atomicAdd(&(bar)[XB_TMO], 1u); break; } } } } while (0)

struct XcdBarrier {
    unsigned* bar; unsigned x;
    volatile LAS unsigned* st;
};

__device__ __forceinline__ XcdBarrier xcd_barrier_post(unsigned* bar, volatile LAS unsigned* st) {
    XcdBarrier b; b.bar = bar; b.x = xb_xcc_id(); b.st = st;
    if (threadIdx.x == 0) (void)xb_add(&bar[XB_XCNT(b.x)], 1u);
    return b;
}
__device__ __forceinline__ void xcd_barrier_complete(unsigned* bar, unsigned x, unsigned& nloc, unsigned& nx) {
    const unsigned G = gridDim.x * gridDim.y * gridDim.z;
    unsigned sum, cnt, mine, sp = 0u;
    for (;;) {
        sum = 0u; cnt = 0u; mine = 0u;
#pragma unroll
        for (unsigned j = 0; j < 16; ++j) { const unsigned c = xb_ld(&bar[XB_XCNT(j)]); sum += c; cnt += (c > 0u) ? 1u : 0u; mine = (j == x) ? c : mine; }
        if (sum == G) break;
        __builtin_amdgcn_s_sleep(1);
        if ((++sp & 255u) == 0u) { if (xb_ld(&bar[XB_TMO])) break; if (sp > XB_SPIN_CAP) { atomicAdd(&bar[XB_TMO], 1u); break; } }
    }
    nloc = mine > 0u ? mine : 1u; nx = cnt > 0u ? cnt : 1u;
}

__device__ __forceinline__ void xcd_barrier(const XcdBarrier& b) {
    asm volatile("s_waitcnt vmcnt(0)" ::: "memory");
    __syncthreads();
    if (threadIdx.x == 0) {
        unsigned* bar = b.bar;
        __builtin_amdgcn_s_waitcnt(0);
        unsigned nloc = b.st[0], nx = b.st[1];
        if (nloc == 0u) { xcd_barrier_complete(bar, b.x, nloc, nx); b.st[0] = nloc; b.st[1] = nx; }
        const unsigned old = xb_add(&bar[XB_XSUB(b.x)], 1u);
        const unsigned gen = old / nloc;
        if (old + 1u == (gen + 1u) * nloc) {
            __builtin_amdgcn_fence(__ATOMIC_RELEASE, "agent");
            asm volatile("s_waitcnt vmcnt(0)" ::: "memory");
            const unsigned og = xb_add(&bar[XB_TOP], 1u);
            const unsigned tg = og / nx;
            if (og + 1u == (tg + 1u) * nx) xb_add(&bar[XB_TOPGEN], 1u);
            else XB_SPIN(xb_ld(&bar[XB_TOPGEN]) == tg, bar);
            __builtin_amdgcn_fence(__ATOMIC_ACQUIRE, "agent");
            xb_add(&bar[XB_XGEN(b.x)], 1u);
            asm volatile("s_waitcnt vmcnt(0)" ::: "memory");
        } else {
            XB_SPIN(xb_ld(&bar[XB_XGEN(b.x)]) == gen, bar);
            __builtin_amdgcn_fence(__ATOMIC_ACQUIRE, "agent");
            asm volatile("s_waitcnt vmcnt(0)" ::: "memory");
        }
    }
    __syncthreads();
}

#endif

#ifndef __HIP_EMU__
#define GRID_SYNC() xcd_barrier(bar)
__global__ void __launch_bounds__(NTHR, 2) k_mega(P p_arg) {
    DYN_SMEM(smem);
#if defined(__HIP_DEVICE_COMPILE__)
#define PHASE(PH_, l_) do { const __attribute__((address_space(4))) P* kp_ = (const __attribute__((address_space(4))) P*)__builtin_amdgcn_kernarg_segment_ptr(); LAUNDER_PTR(kp_); P pl_; __builtin_memcpy(&pl_, kp_, sizeof(P)); run_phase<PH_>(pl_, l_, smem); } while (0)
#else
#define PHASE(PH_, l_) run_phase<PH_>(p_arg, l_, smem)
#endif
    cooperative_groups::grid_group grid = cooperative_groups::this_grid();
    volatile LAS unsigned* bst = (volatile LAS unsigned*)((LAS unsigned char*)smem + BAR_LDS_OFF);
    if (threadIdx.x < 4) bst[threadIdx.x] = 0u;
    __syncthreads();
    XcdBarrier bar = xcd_barrier_post((unsigned*)(p_arg.ws + WS_CTL + 4096), bst);
    PHASE(PH_PRO, 0); grid.sync();
#define LAYER(l) do { PHASE(PH_NORM1, l); GRID_SYNC(); PHASE(PH_GEMM_IN, l); GRID_SYNC(); PHASE(PH_ROPE, l); GRID_SYNC(); PHASE(PH_MIX1, l); GRID_SYNC(); PHASE(PH_MIX2, l); GRID_SYNC(); \
        PHASE(PH_MIX3, l); GRID_SYNC(); PHASE(PH_GEMM_OUT, l); GRID_SYNC(); PHASE(PH_NORM2, l); GRID_SYNC(); PHASE(PH_GEMM_GU, l); GRID_SYNC(); PHASE(PH_GEMM_DN, l); GRID_SYNC(); } while (0)
    static_assert(NL == 2, "two layers written out (a loop over the layers makes hipcc hoist every phase's constants to the loop preheader and spill)");
    LAYER(0); LAYER(1);
    PHASE(PH_FINAL, 0);
}
#endif

template <int PH> static void launch_phase(const P& p, int l, int grid, hipStream_t stream) {
#ifndef __HIP_EMU__
    static bool attr_done = false;
    if (!attr_done) { (void)hipFuncSetAttribute((const void*)k_phase<PH>, hipFuncAttributeMaxDynamicSharedMemorySize, SMEM_BYTES); attr_done = true; }
#endif
    LAUNCH(k_phase<PH>, grid, SMEM_BYTES, stream, p, l);
}

extern "C" void kernel_launch(void* const* d_in, const int* in_sizes, int n_in, void* d_out, int out_size, void* d_ws, size_t ws_size, hipStream_t stream) {
    if (n_in != 24 || (size_t)out_size != O_END || ws_size < WS_END) {
        fprintf(stderr, "kernel_launch: shape mismatch: n_in %d out_size %d (want %zu) ws %zu (want %zu)\n", n_in, out_size, (size_t)O_END, ws_size, (size_t)WS_END); return; }
    P p{};
    const float** pp = (const float**)&p;
    for (int i = 0; i < 24; ++i) pp[i] = (const float*)d_in[i];
    p.out = (float*)d_out; p.ws = (unsigned char*)d_ws;
#ifndef __HIP_EMU__
    static int grid = 0;
    if (grid == 0) {
        int dev = 0, cus = 0, per_cu = 0;
        if (hipGetDevice(&dev) != hipSuccess || hipDeviceGetAttribute(&cus, hipDeviceAttributeMultiprocessorCount, dev) != hipSuccess || cus <= 0) { fprintf(stderr, "kernel_launch: device query failed\n"); grid = -1; return; }
        if (hipFuncSetAttribute((const void*)k_mega, hipFuncAttributeMaxDynamicSharedMemorySize, SMEM_BYTES) != hipSuccess) { fprintf(stderr, "kernel_launch: hipFuncSetAttribute failed\n"); grid = -1; return; }
        if (hipOccupancyMaxActiveBlocksPerMultiprocessor(&per_cu, (const void*)k_mega, NTHR, SMEM_BYTES) != hipSuccess || per_cu < 1) { fprintf(stderr, "kernel_launch: occupancy query says %d blocks per CU\n", per_cu); grid = -1; return; }
        grid = cus;
    }
    if (grid < 0) return;
    if (hipMemsetAsync((char*)d_ws + WS_CTL, 0, 65536, stream) != hipSuccess) { fprintf(stderr, "kernel_launch: memset of the barrier words failed\n"); return; }
    { void* args[] = {(void*)&p};
      hipError_t e = hipLaunchCooperativeKernel((const void*)k_mega, dim3(grid), dim3(NTHR), args, SMEM_BYTES, stream);
      if (e != hipSuccess) fprintf(stderr, "kernel_launch: cooperative launch failed: %s (grid %d)\n", hipGetErrorString(e), grid);
      return; }
#else
    int grid = 16;
#endif
    launch_phase<PH_PRO>(p, 0, grid, stream);
    for (int l = 0; l < NL; ++l) {
        launch_phase<PH_NORM1>(p, l, grid, stream);
        launch_phase<PH_GEMM_IN>(p, l, grid, stream);
        launch_phase<PH_ROPE>(p, l, grid, stream);
        launch_phase<PH_MIX1>(p, l, grid, stream);
        launch_phase<PH_MIX2>(p, l, grid, stream);
        launch_phase<PH_MIX3>(p, l, grid, stream);
        launch_phase<PH_GEMM_OUT>(p, l, grid, stream);
        launch_phase<PH_NORM2>(p, l, grid, stream);
        launch_phase<PH_GEMM_GU>(p, l, grid, stream);
        launch_phase<PH_GEMM_DN>(p, l, grid, stream);
    }
    launch_phase<PH_FINAL>(p, 0, grid, stream);
}
```

```cpp
#ifndef __HIP_EMU__
#include <hip/hip_runtime.h>
#include <hip/hip_cooperative_groups.h>
#endif
#include <cstdio>
#include <cstdint>
#include <cmath>

#ifndef CFG_BATCH
#define CFG_BATCH 2
#endif
#ifndef CFG_SEQ
#define CFG_SEQ 8192
#endif
#ifndef CFG_DB
#define CFG_DB 32
#endif
constexpr float LOG2E = 1.4426950408889634f;
constexpr int D = 1024, NL = 2, PB = CFG_BATCH, T = CFG_SEQ, DB = CFG_DB, DS = 8, PAST = 16384, WB = 2048;
constexpr int MP = PB * T, MS = DB * DS, M = MP + MS, MPAD = (M + 255) / 256 * 256, NC = PB + DB;
constexpr int INC = 3848, NPROJ = 3840, FF = 2816, NCH = T / 64, PWIN = T < 2048 ? T : 2048, NPOS = T + DS;
constexpr int NUNIT = PB * 4 * NCH;
constexpr float EPS = 1e-6f;
static_assert(T % 512 == 0, "the attention job decomposition wants T % 512 == 0");
constexpr int C_QA = 0, C_KA = 256, C_VA = 512, C_QR = 768, C_KR = 1024, C_VR = 1280, C_GR = 1536, C_CONV = 1792, C_Z = 3328;
constexpr int SMEM_BYTES = 148480;
constexpr int NTHR = 512;
constexpr int BAR_LDS_OFF = SMEM_BYTES - 64;

typedef unsigned short bf16_t;
typedef short bf16x8 __attribute__((ext_vector_type(8)));
typedef float f32x4 __attribute__((ext_vector_type(4)));
typedef unsigned u32x4 __attribute__((ext_vector_type(4)));
typedef unsigned u32x2 __attribute__((ext_vector_type(2)));
typedef float f32x16 __attribute__((ext_vector_type(16)));

#ifdef __HIP_EMU__
#define LAUNCH(kern, grid, lds, stream, ...) emu_launch(grid, NTHR, [=]() { kern(__VA_ARGS__); })
#define DYN_SMEM(name) unsigned char* name = emu_dyn_smem()
#define WAVE_SYNC() emu_wave_bar()
#define MFMA32(a, b, c) emu_mfma32(a, b, c)
#define GLDS16(gp, lp) memcpy((unsigned char*)(lp) + (threadIdx.x & 63) * 16, (gp), 16)
#define RAW_BARRIER() __syncthreads()
#define GLDS4(gp, lp) ((void)0)
#define WAIT_VM(n)
#define WAIT_LGKM0()
#define LAS
#define UNIFORM(x) (x)
#define COMPILER_FENCE()
#define LAUNDER_V(x)
#define MFMA16(a, b, c) emu_mfma16(a, b, c)
#else
#define WAVE_SYNC() asm volatile("s_waitcnt lgkmcnt(0)" ::: "memory")
#define MFMA32(a, b, c) __builtin_amdgcn_mfma_f32_32x32x16_bf16(a, b, c, 0, 0, 0)
#define LAS __attribute__((address_space(3)))
#define GLDS16(gp, lp) __builtin_amdgcn_global_load_lds((const unsigned*)(gp), (LAS unsigned*)(lp), 16, 0, 0)
#define RAW_BARRIER() __builtin_amdgcn_s_barrier()
#define GLDS4(gp, lp) __builtin_amdgcn_global_load_lds((const unsigned*)(gp), (LAS unsigned*)(lp), 4, 0, 0)
#define WAIT_VM(n) asm volatile("s_waitcnt vmcnt(" #n ")" ::: "memory")
#define WAIT_LGKM0() asm volatile("s_waitcnt lgkmcnt(0)" ::: "memory")
#define UNIFORM(x) __builtin_amdgcn_readfirstlane(x)
#define COMPILER_FENCE() __builtin_amdgcn_sched_barrier(0)
#define LAUNDER_V(x) asm volatile("" : "+v"(x))
#define MFMA16(a, b, c) __builtin_amdgcn_mfma_f32_16x16x32_bf16(a, b, c, 0, 0, 0)
#define LAUNCH(kern, grid, lds, stream, ...) hipLaunchKernelGGL(kern, dim3(grid), dim3(NTHR), lds, stream, __VA_ARGS__)
#define DYN_SMEM(name) extern __shared__ __attribute__((aligned(16))) unsigned char name[]
#endif

#ifdef __HIP_EMU__
__device__ __forceinline__ int tidx() { return (int)threadIdx.x; }
#define LAUNDER_PTR(x)
#else
__device__ __forceinline__ int tidx() { int t = (int)threadIdx.x; asm volatile("" : "+v"(t)); return t; }
#define LAUNDER_PTR(x) asm volatile("" : "+s"(x))
#endif
__device__ __forceinline__ float bf2f(bf16_t v) { return __builtin_bit_cast(float, (unsigned)v << 16); }
__device__ __forceinline__ bf16_t f2bf(float f) { unsigned u = __builtin_bit_cast(unsigned, f); return (bf16_t)((u + 0x7fffu + ((u >> 16) & 1u)) >> 16); }
#ifdef __HIP_EMU__
__device__ __forceinline__ unsigned pk2(float lo, float hi) { return (unsigned)f2bf(lo) | ((unsigned)f2bf(hi) << 16); }
#else
typedef float f32x2_t __attribute__((ext_vector_type(2))); typedef __bf16 bf16x2_t __attribute__((ext_vector_type(2)));
__device__ __forceinline__ unsigned pk2(float lo, float hi) { f32x2_t v = {lo, hi}; bf16x2_t b = __builtin_convertvector(v, bf16x2_t); return __builtin_bit_cast(unsigned, b); }
#endif
__device__ __forceinline__ bf16x8 pack_tiles(const f32x4& lo, const f32x4& hi) {
    u32x4 w; w.x = pk2(lo[0], lo[1]); w.y = pk2(lo[2], lo[3]); w.z = pk2(hi[0], hi[1]); w.w = pk2(hi[2], hi[3]); return __builtin_bit_cast(bf16x8, w);
}
__device__ __forceinline__ float silu_f(float x) { return x / (1.0f + expf(-x)); }
#ifdef __HIP_EMU__
__device__ __forceinline__ float silu_fast(float x) { return x / (1.0f + expf(-x)); }
#else
__device__ __forceinline__ float silu_fast(float x) { return x * __builtin_amdgcn_rcpf(1.0f + __builtin_amdgcn_exp2f(-LOG2E * x)); }
#endif
__device__ __forceinline__ float wave_sum(float v) {
#pragma unroll
    for (int o = 1; o < 64; o <<= 1) v += __shfl_xor(v, o);
    return v;
}
__device__ __forceinline__ float wave_max(float v) {
#pragma unroll
    for (int o = 1; o < 64; o <<= 1) v = fmaxf(v, __shfl_xor(v, o));
    return v;
}

struct P {
    const float *x_prompt, *x_sample, *cache_k, *cache_v, *state_ret, *state_gdn, *state_conv, *c_prompt, *c_sample, *ada_w, *ada_b, *norm_mix, *norm_ffn,
        *w_in, *ret_norm, *conv_w, *a_log, *dt_bias, *gdn_norm, *w_out, *w_gate, *w_up, *w_down, *final_norm;
    float* out; unsigned char* ws;
};

constexpr size_t O_YP = 0, O_YS = O_YP + (size_t)MP * D, O_PWK = O_YS + (size_t)MS * D, O_PWV = O_PWK + (size_t)NL * PB * PWIN * 256,
                 O_PRET = O_PWV + (size_t)NL * PB * PWIN * 256, O_PGDN = O_PRET + (size_t)NL * PB * 4 * 4096, O_PCONV = O_PGDN + (size_t)NL * PB * 4 * 16384,
                 O_SWK = O_PCONV + (size_t)NL * PB * 3 * 1536, O_SWV = O_SWK + (size_t)NL * DB * DS * 256, O_SRET = O_SWV + (size_t)NL * DB * DS * 256,
                 O_SGDN = O_SRET + (size_t)NL * DB * 4 * 4096, O_SCONV = O_SGDN + (size_t)NL * DB * 4 * 16384, O_END = O_SCONV + (size_t)NL * DB * 3 * 1536;

constexpr size_t al256(size_t x) { return (x + 255) / 256 * 256; }
constexpr size_t WS_CTL = 0, WS_CTL_BYTES = 1u << 20;
constexpr size_t WS_MOD = WS_CTL + WS_CTL_BYTES;
constexpr size_t WS_W8 = al256(WS_MOD + (size_t)NL * NC * 6144 * 4);
constexpr size_t WS_ROPE = al256(WS_W8 + (size_t)NL * D * 8 * 4);
constexpr size_t WS_WIN = al256(WS_ROPE + (size_t)4 * NPOS * 32 * 4);
constexpr size_t WS_WOUT = al256(WS_WIN + (size_t)NL * NPROJ * D * 2);
constexpr size_t WS_WGU = al256(WS_WOUT + (size_t)NL * D * D * 2);
constexpr size_t WS_WDN = al256(WS_WGU + (size_t)NL * 2 * FF * D * 2);
constexpr size_t WS_H = al256(WS_WDN + (size_t)NL * D * FF * 2);
constexpr size_t WS_PROJ = al256(WS_H + (size_t)MPAD * D * 2);
constexpr size_t WS_BETA = al256(WS_PROJ + (size_t)MPAD * NPROJ * 2);
constexpr size_t WS_G = al256(WS_BETA + (size_t)M * 4 * 4);
constexpr size_t WS_O = al256(WS_G + (size_t)M * 4 * 4);
constexpr size_t WS_RU = al256(WS_O + (size_t)MPAD * D * 2);
constexpr size_t WS_RS = al256(WS_RU + (size_t)NUNIT * 4096 * 4);
constexpr size_t WS_SCR = al256(WS_RS + (size_t)NUNIT * 4096 * 4);
constexpr size_t WS_GU = WS_SCR;
constexpr size_t WS_GWK = al256(WS_GU + (size_t)NUNIT * 8192 * 2);
constexpr size_t WS_GQ = al256(WS_GWK + (size_t)NUNIT * 16384 * 2);
constexpr size_t WS_GA = al256(WS_GQ + (size_t)NUNIT * 8192 * 2);
constexpr size_t WS_GD = al256(WS_GA + (size_t)NUNIT * 4096 * 2);
constexpr size_t WS_GV = al256(WS_GD + (size_t)NUNIT * 4);
constexpr size_t WS_GS = al256(WS_GV + (size_t)NUNIT * 8192 * 2);
constexpr size_t WS_GEND = al256(WS_GS + (size_t)NUNIT * 16384 * 2);
constexpr size_t ATT_CLS = (size_t)PB * 4 * (T / 32) * 2048;
constexpr size_t WS_KF = WS_GEND;
constexpr size_t WS_VF = al256(WS_KF + 3 * ATT_CLS * 2);
constexpr size_t WS_KRT = al256(WS_VF + 3 * ATT_CLS * 2);
constexpr size_t WS_VRT = al256(WS_KRT + (size_t)MP * 256 * 2);
constexpr size_t WS_AML = al256(WS_VRT + (size_t)MP * 256 * 2);
constexpr size_t WS_AEND = al256(WS_AML + (size_t)MP * 4 * 3 * 2 * 4);
constexpr size_t WS_APO = WS_H;
static_assert((size_t)MP * 4 * 3 * 64 * 2 <= (size_t)MPAD * D * 2, "attention partials overlay H");
constexpr size_t WS_HID = WS_SCR;
constexpr size_t WS_HEND = al256(WS_HID + (size_t)MPAD * FF * 2);
constexpr size_t WS_END = WS_AEND > WS_HEND ? WS_AEND : WS_HEND;

#define WSP(T_, off) ((T_*)(p.ws + (off)))
__device__ __forceinline__ int row_cb(int r) { return r < MP ? r / T : PB + (r - MP) / DS; }
__device__ __forceinline__ int row_pi(int r) { return r < MP ? r % T : T + (r - MP) % DS; }
namespace pg8 {
#ifdef __HIP_EMU__
#define PG8_LAS
#else
#define PG8_LAS __attribute__((address_space(3)))
#endif
typedef unsigned short bf16_t;
typedef short bf16x8 __attribute__((ext_vector_type(8)));
typedef float f32x4 __attribute__((ext_vector_type(4)));
typedef unsigned u32x4 __attribute__((ext_vector_type(4)));
constexpr int BM = 256, BK = 64, HALF = 128, HTB = HALF * BK * 2  , STAGE_BYTES = 8 * HTB, NXCD = 8, WGM = 8;

__host__ __device__ __forceinline__ int lds_byte(int r, int c) { const int st = (r >> 4) * 2 + (c >> 5), rr = r & 15, cc = c & 31, ob = rr * 64 + cc * 2; return st * 1024 + (ob ^ (((ob >> 9) & 1) << 5)); }
__host__ __device__ __forceinline__ void stage_rc(int b, int& R, int& C) { const int st = b / 1024, sb = b % 1024, swz = sb ^ (((sb >> 9) & 1) << 5); R = (st >> 1) * 16 + swz / 64; C = (st & 1) * 32 + (swz % 64) / 2; }
__host__ __device__ __forceinline__ int perm32(int rho) { const int n = rho >> 4, i = rho & 15; return 8 * (i >> 2) + 4 * n + (i & 3); }

struct Unit { int pm, pn; };
struct Gemm { const bf16_t* A; const bf16_t* Bt; int M, N, K; };

struct StaticOrder {
    int nM, nN, nwg, G, c;
    __host__ __device__ void init(int M, int N, int G_, int c_) { nM = M / BM; nN = N / BM; nwg = nM * nN; G = G_; c = c_; }
    __host__ __device__ bool next(int i, Unit& u) const {
        const long L = (long)i * G + c; if (L >= nwg) return false;
        int wgid = (int)L; { const int q = nwg / NXCD, r = nwg % NXCD, xcd = wgid % NXCD, off = wgid / NXCD; wgid = (xcd < r ? xcd * (q + 1) : r * (q + 1) + (xcd - r) * q) + off; }
        const int nig = WGM * nN, gid = wgid / nig, fm = gid * WGM, gsz = (nM - fm) < WGM ? (nM - fm) : WGM;
        u.pm = fm + ((wgid % nig) % gsz); u.pn = (wgid % nig) / gsz; return true;
    }
    __device__ __forceinline__ void a_ready(const Unit&) const {}
    __device__ __forceinline__ void done(const Unit&) const {}
};


struct EpiStoreBf16 {
    static constexpr bool PERM = true, AFTER_DRAIN = false;
    bf16_t* O; int ldc;
    __device__ __forceinline__ void operator()(const f32x4 (&acc)[2][2][4][2], const Unit& u, int wr, int wc, int fr, int fq) const {
        const int row0 = u.pm * BM + wr * 64 + fr, col0 = u.pn * BM + wc * 32 + 8 * fq;
#pragma unroll
        for (int ai = 0; ai < 2; ++ai)
#pragma unroll
            for (int m = 0; m < 4; ++m) { bf16_t* rowp = O + (size_t)(row0 + ai * HALF + m * 16) * ldc + col0;
#pragma unroll
                for (int bj = 0; bj < 2; ++bj) { const f32x4 v0 = acc[ai][bj][m][0], v1 = acc[ai][bj][m][1];
                    u32x4 w; w.x = ::pk2(v0[0], v0[1]); w.y = ::pk2(v0[2], v0[3]); w.z = ::pk2(v1[0], v1[1]); w.w = ::pk2(v1[2], v1[3]);
                    *(u32x4*)(rowp + bj * HALF) = w; } }
    }
};
struct EpiResidual {
    static constexpr bool PERM = false, AFTER_DRAIN = false;
    float* X; const float* gate; const float* Xin;
    __device__ __forceinline__ void operator()(const f32x4 (&acc)[2][2][4][2], const Unit& u, int wr, int wc, int fr, int fq) const {
        const int row0 = u.pm * BM + wr * 64 + fr, col0 = u.pn * BM + wc * 32 + 4 * fq;
#pragma unroll
        for (int ai = 0; ai < 2; ++ai)
#pragma unroll
            for (int m = 0; m < 4; ++m) { const int row = row0 + ai * HALF + m * 16;
                if (MPAD != M && row >= M) continue;
                const float* g = gate + (size_t)::row_cb(row) * 6144 + col0; float* xp = X + (size_t)row * D + col0; const float* xi = Xin + (size_t)row * D + col0;
#pragma unroll
                for (int bj = 0; bj < 2; ++bj)
#pragma unroll
                    for (int n = 0; n < 2; ++n) { const f32x4 gv = *(const f32x4*)(g + bj * HALF + n * 16); f32x4* xq = (f32x4*)(xp + bj * HALF + n * 16); *xq = *(const f32x4*)(xi + bj * HALF + n * 16) + gv * acc[ai][bj][m][n]; } }
    }
};
struct EpiSwiglu {
    static constexpr bool PERM = true, AFTER_DRAIN = false;
    bf16_t* Hd;
    __device__ __forceinline__ void operator()(const f32x4 (&acc)[2][2][4][2], const Unit& u, int wr, int wc, int fr, int fq) const {
        const int row0 = u.pm * BM + wr * 64 + fr, col0 = u.pn * HALF + wc * 32 + 8 * fq;
#pragma unroll
        for (int ai = 0; ai < 2; ++ai)
#pragma unroll
            for (int m = 0; m < 4; ++m) { bf16_t* rowp = Hd + (size_t)(row0 + ai * HALF + m * 16) * FF + col0;
                float v[8];
#pragma unroll
                for (int n = 0; n < 2; ++n)
#pragma unroll
                    for (int j = 0; j < 4; ++j) { const float gt = acc[ai][0][m][n][j], up = acc[ai][1][m][n][j]; v[4 * n + j] = ::silu_fast(gt) * up; }
                u32x4 w; w.x = ::pk2(v[0], v[1]); w.y = ::pk2(v[2], v[3]); w.z = ::pk2(v[4], v[5]); w.w = ::pk2(v[6], v[7]);
                *(u32x4*)rowp = w; }
    }
};

#ifdef __HIP_EMU__
template <class Epi, class Sched, bool ALIGN_EPI = false, bool SP2 = false>
__device__ __forceinline__ void gemm_phase(unsigned char* lds, const Gemm g, const Sched& S, const Epi& E) {
    const int tid = threadIdx.x, wid = tid >> 6, lane = tid & 63, wr = wid >> 2, wc = wid & 3, fr = lane & 15, fq = lane >> 4;
    Unit cur;
    for (int ui = 0; S.next(ui, cur); ++ui) {
        f32x4 acc[2][2][4][2];
        for (int ai = 0; ai < 2; ++ai) for (int bj = 0; bj < 2; ++bj) for (int m = 0; m < 4; ++m) for (int n = 0; n < 2; ++n) for (int j = 0; j < 4; ++j) {
            const int row = 256 * cur.pm + 128 * ai + 64 * wr + 16 * m + fr;
            const int col = Epi::PERM ? 256 * cur.pn + 128 * bj + 32 * wc + 8 * fq + 4 * n + j : 256 * cur.pn + 128 * bj + 32 * wc + 16 * n + 4 * fq + j;
            const bf16_t* a = g.A + (size_t)row * g.K; const bf16_t* b = g.Bt + (size_t)col * g.K; float s = 0.f;
            for (int k = 0; k < g.K; ++k) s += ::bf2f(a[k]) * ::bf2f(b[k]);
            acc[ai][bj][m][n][j] = s; }
        E(acc, cur, wr, wc, fr, fq);
    }
}
#else
template <class Epi, class Sched, bool ALIGN_EPI = false, bool SP2 = false>
__device__ __forceinline__ void gemm_phase(PG8_LAS unsigned char* lds, const Gemm g, const Sched& S, const Epi& E) {
    const int tid = ::tidx(), wid = __builtin_amdgcn_readfirstlane(tid >> 6), lane = tid & 63, wr = wid >> 2, wc = wid & 3, fr = lane & 15, fq = lane >> 4;
    const int K = g.K, nt = K / BK;
    unsigned voffA[2], voffB[2];
#pragma unroll
    for (int i = 0; i < 2; ++i) { int R, C; stage_rc(tid * 16 + i * 8192, R, C); const int Rb = Epi::PERM ? ((R & ~31) + perm32(R & 31)) : R;
        voffA[i] = (unsigned)(R * K + C) * 2u; voffB[i] = (unsigned)(Rb * K + C) * 2u; }
    const size_t kstep = (size_t)(BK * 2);
    const size_t hstep = (size_t)HALF * K * 2;
    const size_t tstep = 2 * hstep;
    const unsigned ldsw = (unsigned)wid * 1024u;
    const int aoff = lds_byte(wr * 64 + fr, fq * 8), boff = lds_byte(wc * 32 + fr, fq * 8);
#define PG8_SA(b, h) (((b) * 2 + (h)) * HTB)
#define PG8_SB(b, h) ((4 + (b) * 2 + (h)) * HTB)
#define PG8_STAGE(bufoff, gbase, voff) do { _Pragma("unroll") for (int _i = 0; _i < 2; ++_i) \
        __builtin_amdgcn_global_load_lds((const unsigned*)((const char*)(gbase) + (voff)[_i]), (PG8_LAS unsigned*)(lds + (bufoff) + ldsw + _i * 8192), 16, 0, 0); } while (0)
#define PG8_LDA(dst, b, h) do { _Pragma("unroll") for (int m = 0; m < 4; ++m) _Pragma("unroll") for (int k = 0; k < 2; ++k) dst[m][k] = *(const PG8_LAS bf16x8*)(lds + PG8_SA(b, h) + aoff + m * 2048 + k * 1024); } while (0)
#define PG8_LDB(dst, b, h) do { _Pragma("unroll") for (int n = 0; n < 2; ++n) _Pragma("unroll") for (int k = 0; k < 2; ++k) dst[n][k] = *(const PG8_LAS bf16x8*)(lds + PG8_SB(b, h) + boff + n * 2048 + k * 1024); } while (0)
#define PG8_MMA(ai, bj, At, Bt) do { __builtin_amdgcn_s_setprio(1); _Pragma("unroll") for (int m = 0; m < 4; ++m) _Pragma("unroll") for (int n = 0; n < 2; ++n) _Pragma("unroll") for (int k = 0; k < 2; ++k) \
        acc[ai][bj][m][n] = __builtin_amdgcn_mfma_f32_16x16x32_bf16(Bt[n][k], At[m][k], acc[ai][bj][m][n], 0, 0, 0); __builtin_amdgcn_s_setprio(0); } while (0)
#define PG8_WAIT_V(n) asm volatile("s_waitcnt vmcnt(" #n ")" ::: "memory")
#define PG8_WAIT_L(n) asm volatile("s_waitcnt lgkmcnt(" #n ")" ::: "memory")
#define PG8_BAR __builtin_amdgcn_s_barrier()
#define PG8_SCHED __builtin_amdgcn_sched_barrier(0)
    Unit cur, nxt; int ui = 0;
    if (!S.next(0, cur)) return;
    f32x4 acc[2][2][4][2];
#pragma unroll
    for (int a = 0; a < 2; ++a)
#pragma unroll
        for (int b = 0; b < 2; ++b)
#pragma unroll
            for (int m = 0; m < 4; ++m)
#pragma unroll
                for (int n = 0; n < 2; ++n) acc[a][b][m][n] = (f32x4){0.f, 0.f, 0.f, 0.f};
    bf16x8 At[4][2], B0[2][2], B1[2][2];
    const char* cA = (const char*)g.A + (size_t)cur.pm * tstep; const char* cB = (const char*)g.Bt + (size_t)cur.pn * tstep;
    S.a_ready(cur);
    if constexpr (SP2) {
        PG8_STAGE(PG8_SB(0, 0), cB, voffB); PG8_STAGE(PG8_SB(0, 1), cB + hstep, voffB); PG8_STAGE(PG8_SA(0, 0), cA, voffA); PG8_STAGE(PG8_SA(0, 1), cA + hstep, voffA);
        if (wr == 1) PG8_BAR;
        PG8_WAIT_V(2); PG8_BAR;
        PG8_STAGE(PG8_SB(1, 0), cB + kstep, voffB); PG8_STAGE(PG8_SA(1, 0), cA + kstep, voffA); PG8_STAGE(PG8_SB(1, 1), cB + hstep + kstep, voffB);
        PG8_WAIT_V(6); PG8_BAR;
    } else {
        PG8_STAGE(PG8_SB(0, 0), cB, voffB); PG8_STAGE(PG8_SA(0, 0), cA, voffA); PG8_STAGE(PG8_SB(0, 1), cB + hstep, voffB); PG8_STAGE(PG8_SA(0, 1), cA + hstep, voffA);
        if (wr == 1) PG8_BAR;
        PG8_WAIT_V(4); PG8_BAR;
        PG8_STAGE(PG8_SB(1, 0), cB + kstep, voffB); PG8_STAGE(PG8_SA(1, 0), cA + kstep, voffA); PG8_STAGE(PG8_SB(1, 1), cB + hstep + kstep, voffB);
        PG8_WAIT_V(6); PG8_BAR;
    }
    for (;;) {
        const bool has_next = S.next(ui + 1, nxt);
        const char* nA = has_next ? (const char*)g.A + (size_t)nxt.pm * tstep : cA; const char* nB = has_next ? (const char*)g.Bt + (size_t)nxt.pn * tstep : cB;
        for (int t = 0; t < nt; t += 2) {
            const bool last = (t == nt - 2);
            const char* a1 = cA + (size_t)(t + 1) * kstep;
            const char* a2 = last ? nA : cA + (size_t)(t + 2) * kstep; const char* b2 = last ? nB : cB + (size_t)(t + 2) * kstep;
            const char* a3 = a2 + kstep; const char* b3 = b2 + kstep;
            if (last && has_next) S.a_ready(nxt);
            if constexpr (SP2) {
            PG8_LDB(B0, 0, 0); PG8_LDB(B1, 0, 1); PG8_SCHED; PG8_LDA(At, 0, 0); PG8_STAGE(PG8_SA(1, 1), a1 + hstep, voffA);
            PG8_WAIT_V(8); PG8_WAIT_L(0); PG8_BAR; PG8_MMA(0, 0, At, B0); PG8_MMA(0, 1, At, B1); PG8_BAR; PG8_SCHED;
            PG8_LDA(At, 0, 1); PG8_STAGE(PG8_SB(0, 0), b2, voffB); PG8_STAGE(PG8_SB(0, 1), b2 + hstep, voffB); PG8_STAGE(PG8_SA(0, 0), a2, voffA);
            PG8_WAIT_V(8); PG8_WAIT_L(0); PG8_BAR; PG8_MMA(1, 0, At, B0); PG8_MMA(1, 1, At, B1); PG8_BAR; PG8_SCHED;
            PG8_LDB(B0, 1, 0); PG8_LDB(B1, 1, 1); PG8_SCHED; PG8_LDA(At, 1, 0); PG8_STAGE(PG8_SA(0, 1), a2 + hstep, voffA);
            PG8_WAIT_V(8); PG8_WAIT_L(0); PG8_BAR; PG8_MMA(0, 0, At, B0); PG8_MMA(0, 1, At, B1); PG8_BAR; PG8_SCHED;
            PG8_LDA(At, 1, 1); PG8_STAGE(PG8_SB(1, 0), b3, voffB); PG8_STAGE(PG8_SB(1, 1), b3 + hstep, voffB); PG8_STAGE(PG8_SA(1, 0), a3, voffA);
            PG8_WAIT_V(8); PG8_WAIT_L(0); PG8_BAR; PG8_MMA(1, 0, At, B0); PG8_MMA(1, 1, At, B1); PG8_BAR; PG8_SCHED;
            } else {
            PG8_LDB(B0, 0, 0); PG8_SCHED; PG8_LDA(At, 0, 0); PG8_STAGE(PG8_SA(1, 1), a1 + hstep, voffA);
            PG8_WAIT_L(8); PG8_BAR; PG8_WAIT_L(0); PG8_MMA(0, 0, At, B0); PG8_BAR; PG8_SCHED;
            PG8_LDB(B1, 0, 1); PG8_STAGE(PG8_SB(0, 0), b2, voffB);
            PG8_BAR; PG8_WAIT_L(0); PG8_MMA(0, 1, At, B1); PG8_BAR;
            PG8_LDA(At, 0, 1); PG8_STAGE(PG8_SA(0, 0), a2, voffA);
            PG8_BAR; PG8_WAIT_L(0); PG8_MMA(1, 0, At, B0); PG8_BAR; PG8_SCHED;
            PG8_STAGE(PG8_SB(0, 1), b2 + hstep, voffB);
            PG8_WAIT_V(6); PG8_BAR; PG8_MMA(1, 1, At, B1); PG8_BAR;
            PG8_LDB(B0, 1, 0); PG8_SCHED; PG8_LDA(At, 1, 0); PG8_STAGE(PG8_SA(0, 1), a2 + hstep, voffA);
            PG8_WAIT_L(8); PG8_BAR; PG8_WAIT_L(0); PG8_MMA(0, 0, At, B0); PG8_BAR; PG8_SCHED;
            PG8_LDB(B1, 1, 1); PG8_STAGE(PG8_SB(1, 0), b3, voffB);
            PG8_BAR; PG8_WAIT_L(0); PG8_MMA(0, 1, At, B1); PG8_BAR;
            PG8_LDA(At, 1, 1); PG8_STAGE(PG8_SA(1, 0), a3, voffA);
            PG8_BAR; PG8_WAIT_L(0); PG8_MMA(1, 0, At, B0); PG8_BAR; PG8_SCHED;
            PG8_STAGE(PG8_SB(1, 1), b3 + hstep, voffB);
            PG8_WAIT_V(6); PG8_BAR; PG8_MMA(1, 1, At, B1); PG8_BAR;
            }
        }
        if constexpr (ALIGN_EPI) { if (wr == 0) PG8_BAR; }
        if constexpr (!Epi::AFTER_DRAIN) { E(acc, cur, wr, wc, fr, fq); S.done(cur); }
        if (!has_next) break;
#pragma unroll
        for (int a = 0; a < 2; ++a)
#pragma unroll
            for (int b = 0; b < 2; ++b)
#pragma unroll
                for (int m = 0; m < 4; ++m)
#pragma unroll
                    for (int n = 0; n < 2; ++n) acc[a][b][m][n] = (f32x4){0.f, 0.f, 0.f, 0.f};
        cur = nxt; cA = nA; cB = nB; ++ui;
        if constexpr (ALIGN_EPI) { if (wr == 1) PG8_BAR; }
    }
    PG8_WAIT_V(0);
    if constexpr (!ALIGN_EPI) { if (wr == 0) PG8_BAR; }
    PG8_BAR;
    if constexpr (Epi::AFTER_DRAIN) { E.fused(acc, cur, wr, wc, fr, fq, lds, wid, lane); S.done(cur); }
#undef PG8_SA
#undef PG8_SB
#undef PG8_STAGE
#undef PG8_LDA
#undef PG8_LDB
#undef PG8_MMA
#undef PG8_WAIT_V
#undef PG8_WAIT_L
#undef PG8_BAR
#undef PG8_SCHED
}
#endif
}


__device__ __forceinline__ void transpose_item(const float* W, int ldw, bf16_t* WT, int K, int k0, int n0, int drow0, float* scr, int lane) {
    float wv[32];
#pragma unroll
    for (int i = 0; i < 32; ++i) wv[i] = W[(size_t)(k0 + 2 * i + (lane >> 5)) * ldw + n0 + (lane & 31)];
#pragma unroll
    for (int i = 0; i < 32; ++i) scr[(2 * i + (lane >> 5)) * 33 + (lane & 31)] = wv[i];
    WAVE_SYNC();
    const int c = lane & 7;
#pragma unroll
    for (int j = 0; j < 4; ++j) { const int n = (lane >> 3) + 8 * j; const float* s = scr + (8 * c) * 33 + n;
        u32x4 o; o.x = pk2(s[0 * 33], s[1 * 33]); o.y = pk2(s[2 * 33], s[3 * 33]); o.z = pk2(s[4 * 33], s[5 * 33]); o.w = pk2(s[6 * 33], s[7 * 33]);
        *(u32x4*)(WT + (size_t)(drow0 + n) * K + k0 + 8 * c) = o; }
    WAVE_SYNC();
}
constexpr int CV_IN = 16 * 120, CV_OUT = 16 * 32, CV_G = 16 * 88, CV_DN = 44 * 32, CV_L = CV_IN + CV_OUT + 2 * CV_G + CV_DN;
__device__ __forceinline__ void ph_convert(const P& p, unsigned char* smem, int i0, int i1, int b0) {
    if ((int)blockIdx.x < b0) return;
    const int lane = tidx() & 63, wave = tidx() >> 6;
    float* scr = (float*)smem + wave * (64 * 33 + 32);
    constexpr int I_IN = CV_IN, I_OUT = CV_OUT, I_G = CV_G, I_L = CV_L;
    const int gw = ((int)blockIdx.x - b0) * 8 + wave, ngw = ((int)gridDim.x - b0) * 8;
    for (int it = i0 + gw; it < i1; it += ngw) {
        const int l = it / I_L; int r = it % I_L;
        if (r < I_IN) { const int kb = r / 120, nb = r % 120; transpose_item(p.w_in + (size_t)l * D * INC, INC, WSP(bf16_t, WS_WIN) + (size_t)l * NPROJ * D, D, kb * 64, nb * 32, nb * 32, scr, lane); continue; }
        r -= I_IN;
        if (r < I_OUT) { const int kb = r / 32, nb = r % 32; transpose_item(p.w_out + (size_t)l * D * D, D, WSP(bf16_t, WS_WOUT) + (size_t)l * D * D, D, kb * 64, nb * 32, nb * 32, scr, lane); continue; }
        r -= I_OUT;
        if (r < 2 * I_G) { const int up = r / I_G; r %= I_G; const int kb = r / 88, nb = r % 88, n0 = nb * 32;
            transpose_item((up ? p.w_up : p.w_gate) + (size_t)l * D * FF, FF, WSP(bf16_t, WS_WGU) + (size_t)l * 2 * FF * D, D, kb * 64, n0, (n0 / 128) * 256 + up * 128 + (n0 % 128), scr, lane); continue; }
        r -= 2 * I_G;
        { const int kb = r / 32, nb = r % 32; transpose_item(p.w_down + (size_t)l * FF * D, D, WSP(bf16_t, WS_WDN) + (size_t)l * D * FF, FF, kb * 64, nb * 32, nb * 32, scr, lane); }
    }
}

__device__ __forceinline__ void ph_adaln(const P& p, unsigned char* smem, int l0, int l1, int b0) {
    if ((int)blockIdx.x < b0) return;
    float* sc = (float*)smem;
    float* red = sc + NC * 256;
    const int tid = tidx(), col = tid & 31, kg = tid >> 5;
    float* MOD = WSP(float, WS_MOD);
    for (int it = l0 * 192 + (int)blockIdx.x - b0; it < l1 * 192; it += (int)gridDim.x - b0) {
        const int l = it / 192, cb0 = (it % 192) * 32;
        float acc[NC];
#pragma unroll
        for (int r = 0; r < NC; ++r) acc[r] = 0.f;
        for (int kc = 0; kc < 4; ++kc) {
            __syncthreads();
            for (int e = tid; e < NC * 256; e += NTHR) { const int r = e >> 8, k = e & 255; const float c = r < PB ? p.c_prompt[r * D + kc * 256 + k] : p.c_sample[(r - PB) * D + kc * 256 + k]; sc[e] = silu_f(c); }
            __syncthreads();
            for (int kk = 0; kk < 16; ++kk) { const int k = kg * 16 + kk; const float w = p.ada_w[((size_t)l * D + kc * 256 + k) * 6144 + cb0 + col];
#pragma unroll
                for (int r = 0; r < NC; ++r) acc[r] += sc[r * 256 + k] * w; }
        }
#pragma unroll
        for (int r = 0; r < NC; ++r) red[(kg * NC + r) * 32 + col] = acc[r];
        __syncthreads();
        for (int e = tid; e < NC * 32; e += NTHR) { const int r = e >> 5, c = e & 31; float s = p.ada_b[l * 6144 + cb0 + c];
            for (int g = 0; g < 16; ++g) s += red[(g * NC + r) * 32 + c];
            MOD[((size_t)l * NC + r) * 6144 + cb0 + c] = s; }
        __syncthreads();
    }
}

__device__ __forceinline__ void ph_ropetab_copyx(const P& p) {
    const size_t gt = (size_t)blockIdx.x * NTHR + tidx(), ng = (size_t)gridDim.x * NTHR;
    float* tab = WSP(float, WS_ROPE);
    for (size_t e = gt; e < (size_t)NL * D * 8; e += ng) { const size_t lk = e >> 3; const int c = (int)(e & 7); WSP(float, WS_W8)[((lk >> 10) * 8 + c) * D + (lk & 1023)] = p.w_in[lk * INC + NPROJ + c]; }
    for (size_t e = gt; e < (size_t)NPOS * 32; e += ng) {
        const int pi = (int)(e >> 5), i = (int)(e & 31); const double pos = pi < T ? (double)pi : (double)(PAST + pi - T);
        const double ia = exp(-log(10000.0) * (double)i / 32.0), ir = exp(-log(10000.0) * (double)i / 31.0);
        tab[e] = (float)cos(pos * ia); tab[(size_t)NPOS * 32 + e] = (float)sin(pos * ia);
        tab[(size_t)2 * NPOS * 32 + e] = (float)cos(pos * ir); tab[(size_t)3 * NPOS * 32 + e] = (float)sin(pos * ir);
    }
}

template <int WHICH> __device__ __forceinline__ void ph_norm_mod(const P& p, int l) {
    const int lane = tidx() & 63, wave = tidx() >> 6, gw = blockIdx.x * 8 + wave, ngw = gridDim.x * 8;
    const float* nw = (WHICH == 0 ? p.norm_mix : p.norm_ffn) + l * D;
    bf16_t* H = WSP(bf16_t, WS_H);
    for (int r = gw; r < M; r += ngw) {
        const float* xr = (WHICH == 0 && l == 0) ? (r < MP ? p.x_prompt + (size_t)r * D : p.x_sample + (size_t)(r - MP) * D) : p.out + (size_t)r * D;
        const float* mod = WSP(float, WS_MOD) + ((size_t)l * NC + row_cb(r)) * 6144 + (WHICH == 0 ? 0 : 3072);
        f32x4 v[4]; float ss = 0.f;
#pragma unroll
        for (int j = 0; j < 4; ++j) { v[j] = *(const f32x4*)(xr + 4 * lane + 256 * j); ss += (v[j][0] * v[j][0] + v[j][1] * v[j][1]) + (v[j][2] * v[j][2] + v[j][3] * v[j][3]); }
        const float rstd = 1.0f / sqrtf(wave_sum(ss) * (1.0f / D) + EPS);
        float a8[8];
#pragma unroll
        for (int c = 0; c < 8; ++c) a8[c] = 0.f;
#pragma unroll
        for (int j = 0; j < 4; ++j) { const int k = 4 * lane + 256 * j;
            const f32x4 g = *(const f32x4*)(nw + k), sh = *(const f32x4*)(mod + k), sc = *(const f32x4*)(mod + 1024 + k);
            f32x4 h;
#pragma unroll
            for (int e = 0; e < 4; ++e) h[e] = v[j][e] * rstd * g[e] * (1.0f + sc[e]) + sh[e];
            u32x2 w; w.x = pk2(h[0], h[1]); w.y = pk2(h[2], h[3]); *(u32x2*)(H + (size_t)r * D + k) = w;
            if (WHICH == 0) {
#pragma unroll
                for (int c = 0; c < 8; ++c) { const f32x4 wv = *(const f32x4*)(WSP(float, WS_W8) + ((size_t)l * 8 + c) * D + k); a8[c] += (h[0] * wv[0] + h[1] * wv[1]) + (h[2] * wv[2] + h[3] * wv[3]); }
            }
        }
        if (WHICH == 0) {
            float b4[4];
#pragma unroll
            for (int c = 0; c < 4; ++c) { const float keep = lane < 32 ? a8[c] : a8[4 + c], send = lane < 32 ? a8[4 + c] : a8[c]; b4[c] = keep + __shfl_xor(send, 32); }
            float b2[2];
#pragma unroll
            for (int c = 0; c < 2; ++c) { const bool lo = (lane & 16) == 0; const float keep = lo ? b4[c] : b4[2 + c], send = lo ? b4[2 + c] : b4[c]; b2[c] = keep + __shfl_xor(send, 16); }
            float b1; { const bool lo = (lane & 8) == 0; const float keep = lo ? b2[0] : b2[1], send = lo ? b2[1] : b2[0]; b1 = keep + __shfl_xor(send, 8); }
            b1 += __shfl_xor(b1, 4); b1 += __shfl_xor(b1, 2); b1 += __shfl_xor(b1, 1);
            if ((lane & 7) == 0) { const int c = (lane >> 5) * 4 + ((lane >> 4) & 1) * 2 + ((lane >> 3) & 1);
                if (c < 4) WSP(float, WS_BETA)[(size_t)r * 4 + c] = 1.0f / (1.0f + expf(-b1));
                else { const int hh = c - 4; const float xx = b1 + p.dt_bias[l * 4 + hh]; const float sp = xx > 20.f ? xx : log1pf(expf(xx)); WSP(float, WS_G)[(size_t)r * 4 + hh] = -expf(p.a_log[l * 4 + hh]) * sp; } }
        }
    }
}

__device__ __forceinline__ void unpack8(const u32x4 w, float (&f)[8]) {
    f[0] = __builtin_bit_cast(float, w.x << 16); f[1] = __builtin_bit_cast(float, w.x & 0xffff0000u); f[2] = __builtin_bit_cast(float, w.y << 16); f[3] = __builtin_bit_cast(float, w.y & 0xffff0000u);
    f[4] = __builtin_bit_cast(float, w.z << 16); f[5] = __builtin_bit_cast(float, w.z & 0xffff0000u); f[6] = __builtin_bit_cast(float, w.w << 16); f[7] = __builtin_bit_cast(float, w.w & 0xffff0000u);
}
__device__ __forceinline__ u32x4 pack8f(const float (&f)[8]) { u32x4 w; w.x = pk2(f[0], f[1]); w.y = pk2(f[2], f[3]); w.z = pk2(f[4], f[5]); w.w = pk2(f[6], f[7]); return w; }
__device__ __forceinline__ void ph_rope_out(const P& p, int l) {
    const size_t gt = (size_t)blockIdx.x * NTHR + tidx(), ng = (size_t)gridDim.x * NTHR;
    bf16_t* PR = WSP(bf16_t, WS_PROJ); const float* tab = WSP(float, WS_ROPE);
    for (size_t e = gt; e < (size_t)MS * 64; e += ng) {
        const int r = MP + (int)(e >> 6), rem = (int)(e & 63), sec = rem >> 4, hh = (rem >> 2) & 3, d = (rem & 3) * 8;
        const int off = sec == 0 ? C_QA : sec == 1 ? C_KA : sec == 2 ? C_QR : C_KR; const float scale = sec == 0 ? 0.125f * LOG2E : sec == 3 ? 0.125f : 1.0f;
        const float* ct = tab + (size_t)(sec >= 2 ? 2 : 0) * NPOS * 32 + (size_t)row_pi(r) * 32 + d; const float* st = ct + (size_t)NPOS * 32;
        const f32x4 c0 = *(const f32x4*)ct, c1 = *(const f32x4*)(ct + 4), s0 = *(const f32x4*)st, s1 = *(const f32x4*)(st + 4);
        bf16_t* x = PR + (size_t)r * NPROJ + off + hh * 64 + d; float x1[8], x2[8], o1[8], o2[8];
        unpack8(*(const u32x4*)x, x1); unpack8(*(const u32x4*)(x + 32), x2);
#pragma unroll
        for (int k = 0; k < 8; ++k) { const float c = k < 4 ? c0[k & 3] : c1[k & 3], sn = k < 4 ? s0[k & 3] : s1[k & 3]; o1[k] = (x1[k] * c - x2[k] * sn) * scale; o2[k] = (x1[k] * sn + x2[k] * c) * scale; }
        *(u32x4*)x = pack8f(o1); *(u32x4*)(x + 32) = pack8f(o2);
        if (sec == 1) { const int b = (r - MP) / DS, i = (r - MP) % DS; float* o = p.out + O_SWK + (((size_t)l * DB + b) * DS + i) * 256 + hh * 64 + d;
            *(f32x4*)o = (f32x4){o1[0], o1[1], o1[2], o1[3]}; *(f32x4*)(o + 4) = (f32x4){o1[4], o1[5], o1[6], o1[7]}; *(f32x4*)(o + 32) = (f32x4){o2[0], o2[1], o2[2], o2[3]}; *(f32x4*)(o + 36) = (f32x4){o2[4], o2[5], o2[6], o2[7]}; }
    }
    for (size_t e = gt; e < (size_t)MS * 32; e += ng) {
        const int r = MP + (int)(e >> 5), c = (int)(e & 31) * 8; const int b = (r - MP) / DS, i = (r - MP) % DS; float* o = p.out + O_SWV + (((size_t)l * DB + b) * DS + i) * 256 + c;
        float v[8]; unpack8(*(const u32x4*)(PR + (size_t)r * NPROJ + C_VA + c), v); *(f32x4*)o = (f32x4){v[0], v[1], v[2], v[3]}; *(f32x4*)(o + 4) = (f32x4){v[4], v[5], v[6], v[7]};
    }
    for (size_t e = gt; e < (size_t)(PB + DB) * 3 * 1536; e += ng) {
        const int c = (int)(e % 1536), j = (int)((e / 1536) % 3), bb = (int)(e / (3 * 1536));
        if (bb < PB) p.out[O_PCONV + (((size_t)l * PB + bb) * 3 + j) * 1536 + c] = bf2f(PR[(size_t)(bb * T + T - 3 + j) * NPROJ + C_CONV + c]);
        else { const int b = bb - PB; p.out[O_SCONV + (((size_t)l * DB + b) * 3 + j) * 1536 + c] = bf2f(PR[(size_t)(MP + b * DS + DS - 3 + j) * NPROJ + C_CONV + c]); }
    }
}

__device__ __forceinline__ void attn_wave_sample(const P& p, int l, int r, int h, int lane, float* sw  ) {
    const bf16_t* PR = WSP(bf16_t, WS_PROJ);
    const int b = (r - MP) / DS; const int tq = WB + (r - MP) % DS;
    float q[64];
    { const bf16_t* qp = PR + (size_t)r * NPROJ + C_QA + h * 64;
#pragma unroll
      for (int j = 0; j < 8; ++j) { const bf16x8 v = *(const bf16x8*)(qp + 8 * j);
#pragma unroll
          for (int e = 0; e < 8; ++e) q[8 * j + e] = bf2f((bf16_t)v[e]); } }
    float mx = -INFINITY;
#pragma unroll 1
    for (int i = 0; i < 7; ++i) {
        const int e = lane + 64 * i;
        if (e < 387) { const int pat = e / 129, j = e % 129, dil = pat == 0 ? 1 : pat == 1 ? 4 : 16; const int rr = tq - dil * j;
            float a = 0.f;
            if (rr < WB) { const float* kp = p.cache_k + ((((size_t)l * DB + b) * WB + rr) * 4 + h) * 64;
#pragma unroll
                for (int j4 = 0; j4 < 16; ++j4) { const f32x4 kv = *(const f32x4*)(kp + 4 * j4); a += q[4 * j4] * kv[0] + q[4 * j4 + 1] * kv[1] + q[4 * j4 + 2] * kv[2] + q[4 * j4 + 3] * kv[3]; } }
            else { const bf16_t* kp = PR + (size_t)(MP + b * DS + (rr - WB)) * NPROJ + C_KA + h * 64;
#pragma unroll
                for (int j8 = 0; j8 < 8; ++j8) { const bf16x8 kv = *(const bf16x8*)(kp + 8 * j8);
#pragma unroll
                    for (int e2 = 0; e2 < 8; ++e2) a += q[8 * j8 + e2] * bf2f((bf16_t)kv[e2]); } }
            sw[e] = a; mx = fmaxf(mx, a); }
    }
    mx = wave_max(mx);
    float lsum = 0.f;
#pragma unroll 1
    for (int i = 0; i < 7; ++i) { const int e = lane + 64 * i; if (e < 387) { const float pe = exp2f(sw[e] - mx); sw[e] = pe; lsum += pe; } }
    lsum = wave_sum(lsum);
    WAVE_SYNC();
    const int kg = lane >> 4, dq = lane & 15; f32x4 o4 = (f32x4){0.f, 0.f, 0.f, 0.f};
#pragma unroll 16
    for (int e = kg; e < 387; e += 4) {
        const float pe = sw[e];
        const int pat = e / 129, j = e % 129, dil = pat == 0 ? 1 : pat == 1 ? 4 : 16; const int rr = tq - dil * j;
        f32x4 v;
        if (rr < WB) v = *(const f32x4*)(p.cache_v + ((((size_t)l * DB + b) * WB + rr) * 4 + h) * 64 + 4 * dq);
        else { const u32x2 w = *(const u32x2*)(PR + (size_t)(MP + b * DS + (rr - WB)) * NPROJ + C_VA + h * 64 + 4 * dq);
            v = (f32x4){bf2f((bf16_t)(w.x & 0xffff)), bf2f((bf16_t)(w.x >> 16)), bf2f((bf16_t)(w.y & 0xffff)), bf2f((bf16_t)(w.y >> 16))}; }
        o4 += pe * v;
    }
#pragma unroll
    for (int e = 0; e < 4; ++e) { float x = o4[e]; x += __shfl_xor(x, 16); x += __shfl_xor(x, 32); o4[e] = x; }
    WAVE_SYNC();
    if (kg == 0) { const float inv = 1.0f / lsum; u32x2 w; w.x = pk2(o4[0] * inv, o4[1] * inv); w.y = pk2(o4[2] * inv, o4[3] * inv);
        *(u32x2*)(WSP(bf16_t, WS_O) + (size_t)r * D + h * 64 + 4 * dq) = w; }
}
__device__ __forceinline__ void ph_attn_sample(const P& p, int l, unsigned char* smem) {
    const int lane = tidx() & 63, wave = tidx() >> 6, gw = (gridDim.x - 1 - blockIdx.x) * 8 + wave, ngw = gridDim.x * 8;
    float* sw = (float*)smem + wave * 392;
    for (int it = gw; it < MS * 4; it += ngw) attn_wave_sample(p, l, MP + (it >> 2), it & 3, lane, sw);
}
__device__ __forceinline__ bf16x8 pack8(const f32x16& v, int s8) {
    u32x4 w; w.x = pk2(v[s8], v[s8 + 1]); w.y = pk2(v[s8 + 2], v[s8 + 3]); w.z = pk2(v[s8 + 4], v[s8 + 5]); w.w = pk2(v[s8 + 6], v[s8 + 7]); return __builtin_bit_cast(bf16x8, w);
}
__device__ __forceinline__ void attn_job(const P& p, int jb, int lane) {
    const int c = lane & 31, hi = lane >> 5;
    constexpr int NB = T / 512;
    const int unit = jb / 48, jj = jb % 48, pat = jj >> 4, sub = jj & 15;
    const int blk = unit % NB, h = (unit / NB) & 3, b = unit / (NB * 4), bh = b * 4 + h;
    int dil, r, qi0, cls, tb;
    if (pat == 0) { dil = 1; r = 0; qi0 = blk * 512 + sub * 32; cls = 0; tb = 0; }
    else if (pat == 1) { dil = 4; r = sub >> 2; qi0 = blk * 128 + (sub & 3) * 32; cls = 1; tb = r * (T / 128); }
    else { dil = 16; r = sub; qi0 = blk * 32; cls = 2; tb = r * (T / 512); }
    const bf16_t* KF = WSP(bf16_t, WS_KF) + cls * ATT_CLS + ((size_t)bh * (T / 32) + tb) * 2048 + lane * 8;
    const bf16_t* VF = WSP(bf16_t, WS_VF) + cls * ATT_CLS + ((size_t)bh * (T / 32) + tb) * 2048 + lane * 8;
    const int tq = dil * (qi0 + c) + r;
    const bf16_t* qp = WSP(bf16_t, WS_PROJ) + (size_t)(b * T + tq) * NPROJ + C_QA + h * 64 + 8 * hi;
    bf16x8 qf[4];
#pragma unroll
    for (int ks = 0; ks < 4; ++ks) qf[ks] = *(const bf16x8*)(qp + 16 * ks);
    f32x16 S[5];
#pragma unroll
    for (int i = 0; i < 5; ++i) {
        const int kt0 = qi0 - 128 + 32 * i;
        f32x16 acc;
#pragma unroll
        for (int e = 0; e < 16; ++e) acc[e] = 0.f;
        if (kt0 >= 0) { const bf16_t* kp = KF + (size_t)(kt0 >> 5) * 2048;
#pragma unroll
            for (int ks = 0; ks < 4; ++ks) acc = MFMA32(*(const bf16x8*)(kp + 512 * ks), qf[ks], acc);
            if (i == 0) {
#pragma unroll
                for (int e = 0; e < 16; ++e) { const int krow = (e & 3) + 8 * (e >> 2) + 4 * hi; if (krow < c) acc[e] = -INFINITY; } }
            if (i == 4) {
#pragma unroll
                for (int e = 0; e < 16; ++e) { const int krow = (e & 3) + 8 * (e >> 2) + 4 * hi; if (krow > c) acc[e] = -INFINITY; } }
        } else {
#pragma unroll
            for (int e = 0; e < 16; ++e) acc[e] = -INFINITY; }
        S[i] = acc;
    }
    float mx = -INFINITY;
#pragma unroll
    for (int i = 0; i < 5; ++i)
#pragma unroll
        for (int e = 0; e < 16; ++e) mx = fmaxf(mx, S[i][e]);
    mx = fmaxf(mx, __shfl_xor(mx, 32));
    float lsum = 0.f;
#pragma unroll
    for (int i = 0; i < 5; ++i)
#pragma unroll
        for (int e = 0; e < 16; ++e) { const float pe = exp2f(S[i][e] - mx); S[i][e] = pe; lsum += pe; }
    lsum += __shfl_xor(lsum, 32);
    f32x16 O[2];
#pragma unroll
    for (int dt = 0; dt < 2; ++dt)
#pragma unroll
        for (int e = 0; e < 16; ++e) O[dt][e] = 0.f;
#pragma unroll
    for (int i = 0; i < 5; ++i) {
        const int kt0 = qi0 - 128 + 32 * i;
        if (kt0 >= 0) {
#pragma unroll
            for (int s2 = 0; s2 < 2; ++s2) { const bf16x8 pf = pack8(S[i], 8 * s2);
#pragma unroll
                for (int dt = 0; dt < 2; ++dt) O[dt] = MFMA32(*(const bf16x8*)(VF + (size_t)(kt0 >> 5) * 2048 + (dt * 2 + s2) * 512), pf, O[dt]); }
        }
    }
    const size_t idx = ((size_t)(b * T + tq) * 4 + h) * 3 + pat;
    bf16_t* po = WSP(bf16_t, WS_APO) + idx * 64;
#pragma unroll
    for (int dt = 0; dt < 2; ++dt)
#pragma unroll
        for (int g = 0; g < 4; ++g) { u32x2 w; w.x = pk2(O[dt][4 * g], O[dt][4 * g + 1]); w.y = pk2(O[dt][4 * g + 2], O[dt][4 * g + 3]); *(u32x2*)(po + 32 * dt + 8 * g + 4 * hi) = w; }
    if (hi == 0) { float* ml = WSP(float, WS_AML) + idx * 2; ml[0] = mx; ml[1] = lsum; }
}
__device__ __forceinline__ void ph_attn_jobs(const P& p, int nc, int b1, int r0) {
    const int bid = (int)blockIdx.x; if (bid >= b1) return;
    const int lane = tidx() & 63, wave = tidx() >> 6, nn = (b1 - nc) * 8, ncw = nc * 8; constexpr int NJ = PB * 4 * (T / 512) * 48;
    const bool late = bid < nc; const int wi = late ? bid * 8 + wave : (bid - nc) * 8 + wave;
    for (int r = late ? r0 : 0;; ++r) { const int base = r * nn + (r > r0 ? (r - r0) * ncw : 0); const int jb = base + (late ? nn + wi : wi);
        if (base >= NJ) break;
        if (jb < NJ) attn_job(p, jb, lane); }
}
__device__ __forceinline__ void ph_attn_combine(const P& p) {
    const size_t gt = (size_t)blockIdx.x * NTHR + tidx(), ng = (size_t)gridDim.x * NTHR;
    for (size_t e = gt; e < (size_t)MP * 4 * 16; e += ng) {
        const size_t rh = e >> 4; const int dq = (int)(e & 15) * 4;
        const float* ml = WSP(float, WS_AML) + rh * 6; const float m0 = ml[0], m1 = ml[2], m2 = ml[4];
        const float mm = fmaxf(m0, fmaxf(m1, m2)); const float w0 = exp2f(m0 - mm), w1 = exp2f(m1 - mm), w2 = exp2f(m2 - mm);
        const float inv = 1.0f / (w0 * ml[1] + w1 * ml[3] + w2 * ml[5]);
        const bf16_t* po = WSP(bf16_t, WS_APO) + rh * 192 + dq;
        const u32x2 a = *(const u32x2*)po, bq = *(const u32x2*)(po + 64), cq = *(const u32x2*)(po + 128);
        float o[4];
        o[0] = w0 * bf2f((bf16_t)(a.x & 0xffff)) + w1 * bf2f((bf16_t)(bq.x & 0xffff)) + w2 * bf2f((bf16_t)(cq.x & 0xffff));
        o[1] = w0 * bf2f((bf16_t)(a.x >> 16)) + w1 * bf2f((bf16_t)(bq.x >> 16)) + w2 * bf2f((bf16_t)(cq.x >> 16));
        o[2] = w0 * bf2f((bf16_t)(a.y & 0xffff)) + w1 * bf2f((bf16_t)(bq.y & 0xffff)) + w2 * bf2f((bf16_t)(cq.y & 0xffff));
        o[3] = w0 * bf2f((bf16_t)(a.y >> 16)) + w1 * bf2f((bf16_t)(bq.y >> 16)) + w2 * bf2f((bf16_t)(cq.y >> 16));
        const size_t row = rh >> 2; const int h = (int)(rh & 3);
        u32x2 w; w.x = pk2(o[0] * inv, o[1] * inv); w.y = pk2(o[2] * inv, o[3] * inv);
        *(u32x2*)(WSP(bf16_t, WS_O) + row * D + h * 64 + dq) = w;
    }
}
__device__ __forceinline__ float ret_lg(int h) { return logf(1.0f - exp2f(-5.0f - (float)h)); }
constexpr int TPK = 72, TPT = 65;
__device__ __forceinline__ void trans_write(const bf16_t* tile, bf16_t* dst  , int tile0, int tid) {
#pragma unroll
    for (int k = 0; k < 4; ++k) { const int ch = tid + NTHR * k, d = ch >> 5, t0 = (ch & 31) * 8; u32x4 w;
        w.x = (unsigned)tile[(t0 + 0) * TPT + d] | ((unsigned)tile[(t0 + 1) * TPT + d] << 16); w.y = (unsigned)tile[(t0 + 2) * TPT + d] | ((unsigned)tile[(t0 + 3) * TPT + d] << 16);
        w.z = (unsigned)tile[(t0 + 4) * TPT + d] | ((unsigned)tile[(t0 + 5) * TPT + d] << 16); w.w = (unsigned)tile[(t0 + 6) * TPT + d] | ((unsigned)tile[(t0 + 7) * TPT + d] << 16);
        *(u32x4*)(dst + (size_t)d * T + tile0 + t0) = w; COMPILER_FENCE(); }
}
__device__ __forceinline__ void store8_b16(bf16_t* dst, const u32x4 w) {
    dst[0] = (bf16_t)(w.x & 0xffff); dst[1] = (bf16_t)(w.x >> 16); dst[2] = (bf16_t)(w.y & 0xffff); dst[3] = (bf16_t)(w.y >> 16);
    dst[4] = (bf16_t)(w.z & 0xffff); dst[5] = (bf16_t)(w.z >> 16); dst[6] = (bf16_t)(w.w & 0xffff); dst[7] = (bf16_t)(w.w >> 16);
}
__device__ __forceinline__ void ph_vtrans(const P& p, int l, unsigned char* smem) {
    bf16_t* ka = (bf16_t*)smem; bf16_t* va = ka + 256 * TPK; bf16_t* vr = va + 256 * TPK; bf16_t* kr = vr + 256 * TPT;
    static_assert((2 * 256 * TPK + 2 * 256 * TPT) * 2 <= BAR_LDS_OFF, "transpose unit LDS");
    const int tid = tidx(); bf16_t* PR = WSP(bf16_t, WS_PROJ); const float* tab = WSP(float, WS_ROPE);
    for (int u = blockIdx.x; u < PB * 4 * (T / 256); u += gridDim.x) {
        const int tile = u % (T / 256), bh = u / (T / 256), h = bh & 3, b = bh >> 2; const float lg = ret_lg(h);
        __syncthreads();
#pragma unroll 1
        for (int k = 0; k < 2; ++k) { const int e = tid + NTHR * k, t = e >> 2, d = (e & 3) * 8, tt = tile * 256 + t; bf16_t* row = PR + (size_t)(b * T + tt) * NPROJ + h * 64 + d;
            float x1[8], x2[8], o1[8], o2[8];
            { const float* ct = tab + (size_t)tt * 32 + d; const float* st = ct + (size_t)NPOS * 32;
              const f32x4 c0 = *(const f32x4*)ct, c1 = *(const f32x4*)(ct + 4), s0 = *(const f32x4*)st, s1 = *(const f32x4*)(st + 4);
              unpack8(*(const u32x4*)(row + C_QA), x1); unpack8(*(const u32x4*)(row + C_QA + 32), x2);
#pragma unroll
              for (int i = 0; i < 8; ++i) { const float c = i < 4 ? c0[i & 3] : c1[i & 3], sn = i < 4 ? s0[i & 3] : s1[i & 3]; o1[i] = (x1[i] * c - x2[i] * sn) * (0.125f * LOG2E); o2[i] = (x1[i] * sn + x2[i] * c) * (0.125f * LOG2E); }
              *(u32x4*)(row + C_QA) = pack8f(o1); *(u32x4*)(row + C_QA + 32) = pack8f(o2);
              unpack8(*(const u32x4*)(row + C_KA), x1); unpack8(*(const u32x4*)(row + C_KA + 32), x2);
#pragma unroll
              for (int i = 0; i < 8; ++i) { const float c = i < 4 ? c0[i & 3] : c1[i & 3], sn = i < 4 ? s0[i & 3] : s1[i & 3]; o1[i] = x1[i] * c - x2[i] * sn; o2[i] = x1[i] * sn + x2[i] * c; }
              *(u32x4*)(ka + t * TPK + d) = pack8f(o1); *(u32x4*)(ka + t * TPK + d + 32) = pack8f(o2);
              if (tt >= T - PWIN) { float* o = p.out + O_PWK + (((size_t)l * PB + b) * PWIN + (tt - (T - PWIN))) * 256 + h * 64 + d;
                  *(f32x4*)o = (f32x4){o1[0], o1[1], o1[2], o1[3]}; *(f32x4*)(o + 4) = (f32x4){o1[4], o1[5], o1[6], o1[7]}; *(f32x4*)(o + 32) = (f32x4){o2[0], o2[1], o2[2], o2[3]}; *(f32x4*)(o + 36) = (f32x4){o2[4], o2[5], o2[6], o2[7]}; } }
            COMPILER_FENCE();
            { const float* ct = tab + (size_t)2 * NPOS * 32 + (size_t)tt * 32 + d; const float* st = ct + (size_t)NPOS * 32;
              const f32x4 c0 = *(const f32x4*)ct, c1 = *(const f32x4*)(ct + 4), s0 = *(const f32x4*)st, s1 = *(const f32x4*)(st + 4);
              const float gq = expf(lg * (float)(tt & 63)), gk = 0.125f / gq;
              unpack8(*(const u32x4*)(row + C_QR), x1); unpack8(*(const u32x4*)(row + C_QR + 32), x2);
#pragma unroll
              for (int i = 0; i < 8; ++i) { const float c = i < 4 ? c0[i & 3] : c1[i & 3], sn = i < 4 ? s0[i & 3] : s1[i & 3]; o1[i] = (x1[i] * c - x2[i] * sn) * gq; o2[i] = (x1[i] * sn + x2[i] * c) * gq; }
              *(u32x4*)(row + C_QR) = pack8f(o1); *(u32x4*)(row + C_QR + 32) = pack8f(o2);
              unpack8(*(const u32x4*)(row + C_KR), x1); unpack8(*(const u32x4*)(row + C_KR + 32), x2);
#pragma unroll
              for (int i = 0; i < 8; ++i) { const float c = i < 4 ? c0[i & 3] : c1[i & 3], sn = i < 4 ? s0[i & 3] : s1[i & 3]; o1[i] = (x1[i] * c - x2[i] * sn) * gk; o2[i] = (x1[i] * sn + x2[i] * c) * gk; }
              const u32x4 w1 = pack8f(o1), w2 = pack8f(o2);
              *(u32x4*)(row + C_KR) = w1; *(u32x4*)(row + C_KR + 32) = w2; store8_b16(kr + t * TPT + d, w1); store8_b16(kr + t * TPT + d + 32, w2); }
            COMPILER_FENCE(); }
#pragma unroll
        for (int k = 0; k < 4; ++k) { const int ch = tid + NTHR * k, t = ch >> 3, d8 = (ch & 7) * 8, tt = tile * 256 + t; const bf16_t* src = PR + (size_t)(b * T + tt) * NPROJ + h * 64 + d8;
            const u32x4 wv = *(const u32x4*)(src + C_VA); *(u32x4*)(va + t * TPK + d8) = wv; store8_b16(vr + t * TPT + d8, *(const u32x4*)(src + C_VR));
            if (tt >= T - PWIN) { float v[8]; unpack8(wv, v); float* o = p.out + O_PWV + (((size_t)l * PB + b) * PWIN + (tt - (T - PWIN))) * 256 + h * 64 + d8;
                *(f32x4*)o = (f32x4){v[0], v[1], v[2], v[3]}; *(f32x4*)(o + 4) = (f32x4){v[4], v[5], v[6], v[7]}; }
            COMPILER_FENCE(); }
        __syncthreads();
#pragma unroll
        for (int cls = 0; cls < 3; ++cls) {
            bf16_t* KFc = WSP(bf16_t, WS_KF) + cls * ATT_CLS + (size_t)bh * (T / 32) * 2048; bf16_t* VFc = WSP(bf16_t, WS_VF) + cls * ATT_CLS + (size_t)bh * (T / 32) * 2048;
#pragma unroll 1
            for (int k = 0; k < 4; ++k) { const int f = tid + NTHR * k, lane = f & 63, c31 = lane & 31, hi = lane >> 5;
                { int g, ks, tl, gtile; bool ok = true;
                  if (cls == 0) { ks = (f >> 6) & 3; g = f >> 8; tl = 32 * g + c31; gtile = tile * 8 + g; }
                  else if (cls == 1) { ks = (f >> 6) & 3; g = f >> 8; const int r = g >> 1, st = g & 1; tl = 4 * (32 * st + c31) + r; gtile = r * (T / 128) + tile * 2 + st; }
                  else { const int r = f >> 7, s16 = f & 15, h2 = (f >> 4) & 1; ks = (f >> 5) & 3; tl = 16 * s16 + r; gtile = r * (T / 512) + (tile >> 1); g = 0; (void)ok;
                      const int slot = 16 * (tile & 1) + s16;
                      *(u32x4*)(KFc + ((size_t)gtile * 4 + ks) * 512 + (slot + 32 * h2) * 8) = *(const u32x4*)(ka + tl * TPK + 16 * ks + 8 * h2); }
                  if (cls < 2) { *(u32x4*)(KFc + ((size_t)gtile * 4 + ks) * 512 + lane * 8) = *(const u32x4*)(ka + tl * TPK + 16 * ks + 8 * hi); } }
                { int dt, s2, gtile, r = 0, st = 0, g = 0;
                  if (cls == 0) { s2 = (f >> 6) & 1; dt = (f >> 7) & 1; g = f >> 8; gtile = tile * 8 + g; }
                  else if (cls == 1) { s2 = (f >> 6) & 1; dt = (f >> 7) & 1; g = f >> 8; r = g >> 1; st = g & 1; gtile = r * (T / 128) + tile * 2 + st; }
                  else { dt = (f >> 6) & 1; r = f >> 7; s2 = tile & 1; gtile = r * (T / 512) + (tile >> 1); }
                  unsigned short e8[8];
#pragma unroll
                  for (int jj = 0; jj < 8; ++jj) { const int kk = 16 * s2 + 8 * (jj >> 2) + 4 * hi + (jj & 3);
                      const int tl = cls == 0 ? 32 * g + kk : cls == 1 ? 4 * (32 * st + kk) + r : 16 * (kk & 15) + r;
                      e8[jj] = va[tl * TPK + 32 * dt + c31]; }
                  u32x4 w; w.x = (unsigned)e8[0] | ((unsigned)e8[1] << 16); w.y = (unsigned)e8[2] | ((unsigned)e8[3] << 16); w.z = (unsigned)e8[4] | ((unsigned)e8[5] << 16); w.w = (unsigned)e8[6] | ((unsigned)e8[7] << 16);
                  *(u32x4*)(VFc + ((size_t)gtile * 4 + dt * 2 + s2) * 512 + lane * 8) = w; }
                COMPILER_FENCE(); }
        }
        trans_write(vr, WSP(bf16_t, WS_VRT) + (size_t)bh * 64 * T, tile * 256, tid);
        trans_write(kr, WSP(bf16_t, WS_KRT) + (size_t)bh * 64 * T, tile * 256, tid);
    }
}

constexpr int CH_ITEMS = PB * 4 * 4;
__device__ __forceinline__ void ph_ret_local(const P& p, int l) {
    const int tid = tidx(), lane = tid & 63, wave = tid >> 6, x = lane & 15, q = lane >> 4, dt = wave >> 1;
    for (int u = blockIdx.x; u < NUNIT; u += gridDim.x) {
        const int n = u % NCH, bh = u / NCH, h = bh & 3, t0 = n * 64; const float g63 = expf(ret_lg(h) * 63.0f);
        const bf16_t* ka = WSP(bf16_t, WS_KRT) + ((size_t)bh * 64 + 16 * dt + x) * T + t0 + 8 * q;
#pragma unroll
        for (int k = 0; k < 2; ++k) { const int et = 2 * (wave & 1) + k; const bf16_t* vb = WSP(bf16_t, WS_VRT) + ((size_t)bh * 64 + 16 * et + x) * T + t0 + 8 * q;
            f32x4 acc = (f32x4){0.f, 0.f, 0.f, 0.f};
#pragma unroll
            for (int ks = 0; ks < 2; ++ks) acc = MFMA16(*(const bf16x8*)(ka + 32 * ks), *(const bf16x8*)(vb + 32 * ks), acc);
            *(f32x4*)(WSP(float, WS_RU) + (size_t)u * 4096 + (16 * et + x) * 64 + 16 * dt + 4 * q) = acc * g63; }
    }
}
__device__ __forceinline__ void ph_ret_scan(const P& p, int l) {
    const int G = (int)gridDim.x, skip = G > 2 * CH_ITEMS ? CH_ITEMS : 0;
    if ((int)blockIdx.x < skip) return;
    const int gt = ((int)blockIdx.x - skip) * NTHR + tidx(), ng = (G - skip) * NTHR;
    for (int e = gt; e < PB * 4 * 4096; e += ng) {
        const int bh = e >> 12, ed = e & 4095, h = bh & 3; const float cd = expf(ret_lg(h) * 64.0f);
        const float* U = WSP(float, WS_RU) + (size_t)bh * NCH * 4096 + ed; bf16_t* SPv = WSP(bf16_t, WS_RS) + (size_t)bh * NCH * 4096 + ed;
        float s = 0.f;
        static_assert(NCH % 8 == 0, "scan batches");
        constexpr int SB = NCH % 32 == 0 ? 32 : 8;
        for (int n0 = 0; n0 < NCH; n0 += SB) {
            float uv[SB];
#pragma unroll
            for (int k = 0; k < SB; ++k) uv[k] = U[(size_t)(n0 + k) * 4096];
#pragma unroll
            for (int k = 0; k < SB; ++k) { SPv[(size_t)(n0 + k) * 4096] = f2bf(s); s = s * cd + uv[k]; } }
        p.out[O_PRET + ((size_t)l * PB * 4 + bh) * 4096 + (ed & 63) * 64 + (ed >> 6)] = s;
    }
}
__device__ __forceinline__ void ph_ret_out(const P& p, int l) {
    const int tid = tidx(), lane = tid & 63, wave = tid >> 6, x = lane & 15, q = lane >> 4, it = UNIFORM(wave & 3);
    const bf16_t* PR = WSP(bf16_t, WS_PROJ);
    for (int u = blockIdx.x * 2 + (wave >> 2); u < NUNIT; u += gridDim.x * 2) {
        const int n = u % NCH, bh = u / NCH, h = bh & 3, b = bh >> 2, t0 = n * 64; const float gam = expf(ret_lg(h));
        const size_t rowi = (size_t)(b * T + t0 + 16 * it + x);
        bf16x8 qf[2];
#pragma unroll
        for (int ks = 0; ks < 2; ++ks) qf[ks] = *(const bf16x8*)(PR + rowi * NPROJ + C_QR + h * 64 + 32 * ks + 8 * q);
        f32x4 at[4];
#pragma unroll
        for (int jt = 0; jt < 4; ++jt) { at[jt] = (f32x4){0.f, 0.f, 0.f, 0.f};
            if (jt <= it) { const bf16_t* kp = PR + (size_t)(b * T + t0 + 16 * jt + x) * NPROJ + C_KR + h * 64 + 8 * q;
#pragma unroll
                for (int ks = 0; ks < 2; ++ks) at[jt] = MFMA16(*(const bf16x8*)(kp + 32 * ks), qf[ks], at[jt]);
                if (jt == it) {
#pragma unroll
                    for (int e = 0; e < 4; ++e) if (4 * q + e > x) at[jt][e] = 0.f; } } }
        const bf16x8 pb0 = pack_tiles(at[0], at[1]), pb1 = pack_tiles(at[2], at[3]);
        f32x4 o[4], os[4];
#pragma unroll
        for (int et = 0; et < 4; ++et) { o[et] = (f32x4){0.f, 0.f, 0.f, 0.f}; os[et] = (f32x4){0.f, 0.f, 0.f, 0.f};
            const bf16_t* vp = WSP(bf16_t, WS_VRT) + ((size_t)bh * 64 + 16 * et + x) * T + t0 + 4 * q;
            { const u32x2 lo = *(const u32x2*)vp, hi = *(const u32x2*)(vp + 16); u32x4 w; w.x = lo.x; w.y = lo.y; w.z = hi.x; w.w = hi.y; o[et] = MFMA16(__builtin_bit_cast(bf16x8, w), pb0, o[et]); }
            if (it >= 2) { const u32x2 lo = *(const u32x2*)(vp + 32), hi = *(const u32x2*)(vp + 48); u32x4 w; w.x = lo.x; w.y = lo.y; w.z = hi.x; w.w = hi.y; o[et] = MFMA16(__builtin_bit_cast(bf16x8, w), pb1, o[et]); }
            const bf16_t* sp = WSP(bf16_t, WS_RS) + (size_t)u * 4096 + (16 * et + x) * 64 + 8 * q;
#pragma unroll
            for (int ks = 0; ks < 2; ++ks) os[et] = MFMA16(*(const bf16x8*)(sp + 32 * ks), qf[ks], os[et]);
            o[et] = o[et] + os[et] * gam; }
        float sq = 0.f;
#pragma unroll
        for (int et = 0; et < 4; ++et) sq += (o[et][0] * o[et][0] + o[et][1] * o[et][1]) + (o[et][2] * o[et][2] + o[et][3] * o[et][3]);
        sq += __shfl_xor(sq, 16); sq += __shfl_xor(sq, 32);
        const float rstd = 1.0f / sqrtf(sq * (1.0f / 64.0f) + EPS);
#pragma unroll
        for (int et = 0; et < 4; ++et) { const int e0 = 16 * et + 4 * q; const u32x2 gw = *(const u32x2*)(PR + rowi * NPROJ + C_GR + h * 64 + e0); const f32x4 nw = *(const f32x4*)(p.ret_norm + l * 64 + e0);
            const float g0 = bf2f((bf16_t)(gw.x & 0xffff)), g1 = bf2f((bf16_t)(gw.x >> 16)), g2 = bf2f((bf16_t)(gw.y & 0xffff)), g3 = bf2f((bf16_t)(gw.y >> 16));
            u32x2 w; w.x = pk2(o[et][0] * rstd * nw[0] * silu_fast(g0), o[et][1] * rstd * nw[1] * silu_fast(g1)); w.y = pk2(o[et][2] * rstd * nw[2] * silu_fast(g2), o[et][3] * rstd * nw[3] * silu_fast(g3));
            *(u32x2*)(WSP(bf16_t, WS_O) + rowi * D + 256 + h * 64 + e0) = w; }
    }
}
__device__ __forceinline__ void ph_ret_sample(const P& p, int l, unsigned char* smem) {
    float* S0 = (float*)smem; float* qs = S0 + 4096; float* ks = qs + 8 * 64; float* vs = ks + 8 * 64;
    const int tid = tidx(); const bf16_t* PR = WSP(bf16_t, WS_PROJ);
    for (int u = gridDim.x - 1 - blockIdx.x; u < DB * 4; u += gridDim.x) {
        const int h = u & 3, b = u >> 2; const float lg = ret_lg(h);
        __syncthreads();
        for (int e = tid; e < 4096; e += NTHR) S0[e] = p.state_ret[(((size_t)l * DB + b) * 4 + h) * 4096 + e];
        { const int j = tid >> 6, d = tid & 63; const size_t row = (size_t)(MP + b * DS + j) * NPROJ;
          qs[tid] = bf2f(PR[row + C_QR + h * 64 + d]); ks[tid] = bf2f(PR[row + C_KR + h * 64 + d]); vs[tid] = bf2f(PR[row + C_VR + h * 64 + d]); }
        __syncthreads();
        { const int i = tid >> 6, e = tid & 63; float o = 0.f;
          for (int j = 0; j <= i; ++j) { float a = 0.f; for (int d = 0; d < 64; ++d) a += qs[i * 64 + d] * ks[j * 64 + d]; o += a * expf(lg * (float)(i - j)) * vs[j * 64 + e]; }
          float o2 = 0.f; for (int d = 0; d < 64; ++d) o2 += qs[i * 64 + d] * S0[d * 64 + e];
          o += o2 * expf(lg * (float)(i + 1));
          const float rstd = 1.0f / sqrtf(wave_sum(o * o) * (1.0f / 64.0f) + EPS);
          const size_t row = (size_t)(MP + b * DS + i); const float g = bf2f(PR[row * NPROJ + C_GR + h * 64 + e]);
          WSP(bf16_t, WS_O)[row * D + 256 + h * 64 + e] = f2bf(o * rstd * p.ret_norm[l * 64 + e] * silu_f(g)); }
        for (int x = tid; x < 4096; x += NTHR) { const int d = x >> 6, e = x & 63; float s = S0[x] * expf(lg * (float)DS);
            for (int j = 0; j < DS; ++j) s += ks[j * 64 + d] * expf(lg * (float)(DS - 1 - j)) * vs[j * 64 + e];
            p.out[O_SRET + (((size_t)l * DB + b) * 4 + h) * 4096 + x] = s; }
    }
}

template <int CS, int LDL> __device__ __forceinline__ void fwd_subst(float (&X)[CS], const float* Ls) {
#pragma unroll
    for (int i = 1; i < CS; ++i) {
        float a[4] = {X[i], 0.f, 0.f, 0.f};
#pragma unroll
        for (int j4 = 0; j4 < (i + 3) / 4; ++j4) { const f32x4 lv = *(const f32x4*)(Ls + i * LDL + 4 * j4);
#pragma unroll
            for (int e = 0; e < 4; ++e) if (4 * j4 + e < i) a[e] -= lv[e] * X[4 * j4 + e]; }
        X[i] = (a[0] + a[1]) + (a[2] + a[3]);
    }
}
constexpr int QP = 132;
constexpr int WSTP = 136;
constexpr int RWP = 392, TP = 136;
__device__ __forceinline__ void ph_gdn_prep(const P& p, int l, unsigned char* smem) {
    float* Ls = (float*)smem; float* As = Ls + 64 * 68; float* gs = As + 64 * 68; float* gcs = gs + 64; float* bts = gcs + 64; float* part = bts + 64;
    bf16_t* raw = (bf16_t*)(part + 4 * 64); bf16_t* Khi = raw + 67 * RWP; bf16_t* Klo = Khi + 64 * TP; bf16_t* Qb = Klo + 64 * TP;
    static_assert((64 * 68 * 2 + 64 * 3 + 4 * 64) * 4 + (67 * RWP + 3 * 64 * TP) * 2 <= BAR_LDS_OFF, "gdn_prep LDS");
    const int tid = tidx(), lane = tid & 63, wave = tid >> 6; const bf16_t* PR = WSP(bf16_t, WS_PROJ);
    for (int u = blockIdx.x; u < NUNIT; u += gridDim.x) {
        const int n = u % NCH, h = (u / NCH) % 4, b = u / (NCH * 4), t0 = n * 64;
        __syncthreads();
        for (int e = tid; e < 67 * 48; e += NTHR) { const int row = e / 48, ch = e % 48, t = t0 - 3 + row; u32x4 v = (u32x4){0u, 0u, 0u, 0u};
            if (t >= 0) v = *(const u32x4*)(PR + (size_t)(b * T + t) * NPROJ + C_CONV + (ch >> 4) * 512 + h * 128 + (ch & 15) * 8);
            *(u32x4*)(raw + row * RWP + ch * 8) = v; }
        if (tid >= 384 && tid < 448) { const int i = tid - 384; const size_t row = (size_t)(b * T + t0 + i); gs[i] = WSP(float, WS_G)[row * 4 + h]; bts[i] = WSP(float, WS_BETA)[row * 4 + h]; }
        __syncthreads();
        float y[64]; const int sec = tid < 128 ? 2 : tid < 256 ? 1 : 0, c = tid & 127;
        if (tid < 384) { const int col = sec * 512 + h * 128 + c;
            const float w0 = p.conv_w[(l * 4 + 0) * 1536 + col], w1 = p.conv_w[(l * 4 + 1) * 1536 + col], w2 = p.conv_w[(l * 4 + 2) * 1536 + col], w3 = p.conv_w[(l * 4 + 3) * 1536 + col];
            const LAS bf16_t* rp = (const LAS bf16_t*)raw + sec * 128 + c; LAUNDER_V(rp); float x0 = bf2f(rp[0]), x1 = bf2f(rp[RWP]), x2 = bf2f(rp[2 * RWP]);
#pragma unroll
            for (int i = 0; i < 64; ++i) { const float x3 = bf2f(rp[(i + 3) * RWP]); y[i] = silu_fast(w0 * x0 + w1 * x1 + w2 * x2 + w3 * x3); x0 = x1; x1 = x2; x2 = x3; if ((i & 7) == 7) COMPILER_FENCE(); } }
        if (tid >= 448) { if (tid == 448) { float a = 0.f; for (int i = 0; i < 64; ++i) { a += gs[i]; gcs[i] = a; } }
            WAVE_SYNC(); const int i = tid - 448; part[128 + i] = expf(gcs[i]); part[192 + i] = expf(gcs[63] - gcs[i]); }
#pragma unroll
        for (int pass = 0; pass < 2; ++pass) {
            if (tid >= 128 + 128 * pass && tid < 256 + 128 * pass) { LAS float* sq = (LAS float*)Ls + c; LAUNDER_V(sq);
#pragma unroll
                for (int i = 0; i < 64; ++i) sq[i * 132] = y[i] * y[i]; }
            __syncthreads();
            { const int i = tid >> 3, pt = tid & 7; const float* rp2 = Ls + i * 132 + pt * 16; float a = 0.f;
#pragma unroll
              for (int k = 0; k < 16; ++k) a += rp2[k];
              a += __shfl_xor(a, 1); a += __shfl_xor(a, 2); a += __shfl_xor(a, 4);
              if (pt == 0) part[64 * pass + i] = 1.0f / sqrtf(a + EPS); }
            __syncthreads();
        }
        if (tid >= 128 && tid < 256) { LAS bf16_t* kh = (LAS bf16_t*)Khi + c; LAS bf16_t* kl = (LAS bf16_t*)Klo + c; LAUNDER_V(kh); LAUNDER_V(kl);
#pragma unroll
            for (int i = 0; i < 64; ++i) { const float v = y[i] * part[i]; y[i] = v; const bf16_t hb = f2bf(v); kh[i * TP] = hb; kl[i * TP] = f2bf(v - bf2f(hb)); if ((i & 7) == 7) COMPILER_FENCE(); }
            bf16_t* dst = WSP(bf16_t, WS_GWK) + (size_t)u * 16384 + 8192; const int mt = c >> 4, x = c & 15;
#pragma unroll
            for (int ks2 = 0; ks2 < 2; ++ks2)
#pragma unroll
                for (int q = 0; q < 4; ++q) { const int i0 = 32 * ks2 + 4 * q; float v[8];
#pragma unroll
                    for (int e = 0; e < 8; ++e) { const int i = i0 + (e < 4 ? e : 12 + e); v[e] = y[i] * part[192 + i]; }
                    u32x4 w; w.x = pk2(v[0], v[1]); w.y = pk2(v[2], v[3]); w.z = pk2(v[4], v[5]); w.w = pk2(v[6], v[7]);
                    *(u32x4*)(dst + ((size_t)((mt * 2 + ks2) * 64 + q * 16 + x)) * 8) = w; COMPILER_FENCE(); } }
        else if (tid >= 256 && tid < 384) { bf16_t* qg = WSP(bf16_t, WS_GQ) + (size_t)u * 8192 + c; LAS bf16_t* qb = (LAS bf16_t*)Qb + c; LAUNDER_V(qb);
#pragma unroll
            for (int i = 0; i < 64; ++i) { const float v = y[i] * part[64 + i]; qb[i * TP] = f2bf(v); qg[(i & 7) * 128] = f2bf(v * 0.08838834764831845f * part[128 + i]); if ((i & 7) == 7) { qg += 8 * 128; LAUNDER_V(qg); COMPILER_FENCE(); } } }
        __syncthreads();
#pragma unroll
        for (int tp = 0; tp < 2; ++tp) { const int pos = wave * 2 + tp, it = pos >> 2, jt = pos & 3, j16 = lane & 15, qd = lane >> 4;
            f32x4 lk = (f32x4){0.f, 0.f, 0.f, 0.f}, aq = (f32x4){0.f, 0.f, 0.f, 0.f};
            if (jt <= it) {
#pragma unroll
                for (int ks = 0; ks < 4; ++ks) { const int ao = (16 * it + j16) * TP + 32 * ks + 8 * qd, bo = (16 * jt + j16) * TP + 32 * ks + 8 * qd;
                    const bf16x8 ah = *(const bf16x8*)(Khi + ao), al = *(const bf16x8*)(Klo + ao), aqf = *(const bf16x8*)(Qb + ao), bh = *(const bf16x8*)(Khi + bo), bl = *(const bf16x8*)(Klo + bo);
                    lk = MFMA16(ah, bh, lk); lk = MFMA16(ah, bl, lk); lk = MFMA16(al, bh, lk); aq = MFMA16(aqf, bh, aq); } }
            const int j = 16 * jt + j16;
#pragma unroll
            for (int e = 0; e < 4; ++e) { const int i = 16 * it + 4 * qd + e; const float ex = j <= i ? expf(gcs[i] - gcs[j]) : 0.f;
                Ls[i * 68 + j] = j < i ? bts[i] * lk[e] * ex : 0.f; As[i * 68 + j] = aq[e] * ex * 0.08838834764831845f; } }
        __syncthreads();
        if (tid < 256) {
            if (tid < 128) {
#pragma unroll
                for (int i = 0; i < 64; ++i) { y[i] *= bts[i]; if ((i & 15) == 15) COMPILER_FENCE(); } }
            else {
#pragma unroll
                for (int i = 0; i < 64; ++i) { y[i] *= bts[i] * part[128 + i]; if ((i & 15) == 15) COMPILER_FENCE(); } }
            fwd_subst<64, 68>(y, Ls);
            if (tid < 128) { bf16_t* U = WSP(bf16_t, WS_GU) + (size_t)u * 8192 + c * 64;
#pragma unroll
                for (int i8 = 0; i8 < 8; ++i8) { u32x4 w; w.x = pk2(y[8 * i8], y[8 * i8 + 1]); w.y = pk2(y[8 * i8 + 2], y[8 * i8 + 3]); w.z = pk2(y[8 * i8 + 4], y[8 * i8 + 5]); w.w = pk2(y[8 * i8 + 6], y[8 * i8 + 7]); *(u32x4*)(U + 8 * i8) = w; } }
            else { LAS bf16_t* wst = (LAS bf16_t*)raw + c; LAUNDER_V(wst);
#pragma unroll
                for (int i = 0; i < 64; ++i) wst[i * WSTP] = f2bf(-y[i]); }
        } else { const int t2 = tid - 256;
#pragma unroll 2
            for (int e = t2; e < 4096; e += 256) WSP(bf16_t, WS_GA)[(size_t)u * 4096 + e] = f2bf(As[(e >> 6) * 68 + (e & 63)]);
            if (t2 == 0) WSP(float, WS_GD)[u] = expf(gcs[63]); }
        __syncthreads();
        { bf16_t* dst = WSP(bf16_t, WS_GWK) + (size_t)u * 16384; const bf16_t* wst = raw;
#pragma unroll
          for (int k = 0; k < 2; ++k) { const int f = tid + NTHR * k, ln = f & 63, ks4 = (f >> 6) & 3, mt = f >> 8, q = ln >> 4, x = ln & 15;
              const bf16_t* wr = wst + (16 * mt + x) * WSTP + 32 * ks4 + 4 * q;
              u32x4 w; w.x = (unsigned)wr[0] | ((unsigned)wr[1] << 16); w.y = (unsigned)wr[2] | ((unsigned)wr[3] << 16); w.z = (unsigned)wr[16] | ((unsigned)wr[17] << 16); w.w = (unsigned)wr[18] | ((unsigned)wr[19] << 16);
              *(u32x4*)(dst + (size_t)f * 8) = w; } }
    }
}
constexpr int CH_SLOT = 36864, CH_NSLOT = 4;
static_assert(NCH % 4 == 0 && CH_NSLOT * CH_SLOT <= BAR_LDS_OFF, "chain ring");
__device__ __forceinline__ void chain_stage(const bf16_t* WK, const bf16_t* UTq, int m, int pw, int lane, unsigned char* smem) {
    unsigned char* slot = smem + (m % CH_NSLOT) * CH_SLOT;
#pragma unroll
    for (int k = 0; k < 6; ++k) { const int pc = pw * 6 + k;
        if (pc < 32) GLDS16((const unsigned char*)(WK + (size_t)m * 16384) + pc * 1024 + lane * 16, slot + pc * 1024);
        else GLDS16((const unsigned char*)(UTq + (size_t)m * 8192) + (pc - 32) * 1024 + lane * 16, slot + pc * 1024); }
}
__device__ __forceinline__ void ph_gdn_chain(const P& p, int l, unsigned char* smem) {
    const int tid = tidx(), lane = tid & 63, wave = UNIFORM(tid >> 6), j = lane & 15, q = lane >> 4;
    for (int it = blockIdx.x; it < CH_ITEMS; it += gridDim.x) {
        const int qt = it & 3, bh = it >> 2;
        const bf16_t* WK = WSP(bf16_t, WS_GWK) + (size_t)bh * NCH * 16384;
        const bf16_t* UTq = WSP(bf16_t, WS_GU) + (size_t)bh * NCH * 8192 + qt * 2048;
        __syncthreads();
        if (wave >= 2) {
            const int pw = wave - 2;
            chain_stage(WK, UTq, 0, pw, lane, smem); chain_stage(WK, UTq, 1, pw, lane, smem); chain_stage(WK, UTq, 2, pw, lane, smem);
#pragma unroll 1
            for (int n = 0; n < NCH; ++n) {
                if (n + 2 < NCH) WAIT_VM(12); else if (n + 1 < NCH) WAIT_VM(6); else WAIT_VM(0);
                RAW_BARRIER();
                if (n + 3 < NCH) chain_stage(WK, UTq, n + 3, pw, lane, smem);
            }
        } else {
            const int sl = qt * 2 + wave, c = 16 * sl + j;
            f32x4 S[8];
#pragma unroll
            for (int t = 0; t < 8; ++t) S[t] = (f32x4){0.f, 0.f, 0.f, 0.f};
            bf16x8 sB[4];
#pragma unroll
            for (int ks = 0; ks < 4; ++ks) sB[ks] = pack_tiles(S[2 * ks], S[2 * ks + 1]);
            const float* DC = WSP(float, WS_GD) + bh * NCH;
            float db[4];
#pragma unroll
            for (int d = 0; d < 4; ++d) db[d] = DC[d];
#pragma unroll 1
            for (int n0 = 0; n0 < NCH; n0 += 4) {
#pragma unroll
                for (int k4 = 0; k4 < 4; ++k4) {
                    const int n = n0 + k4, u = bh * NCH + n;
                    f32x4 acc[4]; const float dec = db[k4];
                    if (n + 4 < NCH) db[k4] = DC[n + 4];
                    { bf16_t* sp = WSP(bf16_t, WS_GS) + (size_t)u * 16384 + (size_t)sl * 2048 + lane * 8;
#pragma unroll
                      for (int tp = 0; tp < 4; ++tp) *(bf16x8*)(sp + 512 * tp) = sB[tp]; }
                    WAIT_LGKM0();
                    RAW_BARRIER();
                    const LAS unsigned char* slot = (const LAS unsigned char*)smem + (n % CH_NSLOT) * CH_SLOT + lane * 16; LAUNDER_V(slot);
                    { const LAS unsigned char* us = (const LAS unsigned char*)smem + (n % CH_NSLOT) * CH_SLOT + 32768 + ((16 * wave + j) * 64 + 4 * q) * 2; LAUNDER_V(us);
#pragma unroll
                      for (int mt = 0; mt < 4; ++mt) { const u32x2 w = *(const LAS u32x2*)(us + 32 * mt); acc[mt] = (f32x4){bf2f((bf16_t)(w.x & 0xffff)), bf2f((bf16_t)(w.x >> 16)), bf2f((bf16_t)(w.y & 0xffff)), bf2f((bf16_t)(w.y >> 16))}; } }
                    bf16x8 fa[8], fb[8];
#pragma unroll
                    for (int i = 0; i < 8; ++i) fa[i] = *(const LAS bf16x8*)(slot + i * 1024);
#pragma unroll
                    for (int i = 0; i < 8; ++i) fb[i] = *(const LAS bf16x8*)(slot + (8 + i) * 1024);
                    COMPILER_FENCE();
#pragma unroll
                    for (int ks = 0; ks < 4; ++ks) { acc[0] = MFMA16(fa[ks], sB[ks], acc[0]); acc[1] = MFMA16(fa[4 + ks], sB[ks], acc[1]); }
                    COMPILER_FENCE();
#pragma unroll
                    for (int i = 0; i < 8; ++i) fa[i] = *(const LAS bf16x8*)(slot + 16384 + i * 1024);
#pragma unroll
                    for (int ks = 0; ks < 4; ++ks) { acc[2] = MFMA16(fb[ks], sB[ks], acc[2]); acc[3] = MFMA16(fb[4 + ks], sB[ks], acc[3]); }
                    COMPILER_FENCE();
#pragma unroll
                    for (int i = 0; i < 8; ++i) fb[i] = *(const LAS bf16x8*)(slot + 16384 + (8 + i) * 1024);
                    const bf16x8 vB0 = pack_tiles(acc[0], acc[1]), vB1 = pack_tiles(acc[2], acc[3]);
                    { bf16_t* vp = WSP(bf16_t, WS_GV) + (size_t)u * 8192 + (size_t)sl * 1024 + lane * 8;
                      *(bf16x8*)vp = vB0; *(bf16x8*)(vp + 512) = vB1; }
#pragma unroll
                    for (int t = 0; t < 8; ++t) S[t] = S[t] * dec;
                    COMPILER_FENCE();
#pragma unroll
                    for (int t = 0; t < 4; ++t) S[t] = MFMA16(fa[2 * t], vB0, S[t]);
#pragma unroll
                    for (int t = 0; t < 4; ++t) S[t] = MFMA16(fa[2 * t + 1], vB1, S[t]);
#pragma unroll
                    for (int t = 0; t < 4; ++t) S[4 + t] = MFMA16(fb[2 * t], vB0, S[4 + t]);
#pragma unroll
                    for (int t = 0; t < 4; ++t) S[4 + t] = MFMA16(fb[2 * t + 1], vB1, S[4 + t]);
                    COMPILER_FENCE();
#pragma unroll
                    for (int ks = 0; ks < 4; ++ks) sB[ks] = pack_tiles(S[2 * ks], S[2 * ks + 1]);
                }
            }
            float* o = p.out + O_PGDN + ((size_t)l * PB * 4 + bh) * 16384 + c;
#pragma unroll
            for (int t = 0; t < 8; ++t)
#pragma unroll
                for (int e = 0; e < 4; ++e) o[(size_t)(16 * t + 4 * q + e) * 128] = S[t][e];
        }
    }
}
__device__ __forceinline__ void ph_gdn_out(const P& p, int l) {
    const int tid = tidx(), lane = tid & 63, wave = tid >> 6, j = lane & 15, q = lane >> 4, mt = wave & 3;
    const bf16_t* PR = WSP(bf16_t, WS_PROJ);
    for (int u = blockIdx.x * 2 + (wave >> 2); u < NUNIT; u += gridDim.x * 2) {
        const int n = u % NCH, h = (u / NCH) % 4, b = u / (NCH * 4);
        f32x4 acc[8];
#pragma unroll
        for (int ct = 0; ct < 8; ++ct) acc[ct] = (f32x4){0.f, 0.f, 0.f, 0.f};
        const bf16_t* qg = WSP(bf16_t, WS_GQ) + (size_t)u * 8192 + (16 * mt + j) * 128 + 8 * q;
        const bf16_t* st = WSP(bf16_t, WS_GS) + (size_t)u * 16384 + ((2 * (q & 1)) * 16 + j) * 8 + (q >> 1) * 4;
#pragma unroll
        for (int ks = 0; ks < 4; ++ks) { const bf16x8 a = *(const bf16x8*)(qg + 32 * ks);
#pragma unroll
            for (int ct = 0; ct < 8; ++ct) { const bf16_t* sp = st + (size_t)ct * 2048 + ks * 512; const u32x2 lo = *(const u32x2*)sp, hi = *(const u32x2*)(sp + 128); u32x4 w; w.x = lo.x; w.y = lo.y; w.z = hi.x; w.w = hi.y;
                acc[ct] = MFMA16(a, __builtin_bit_cast(bf16x8, w), acc[ct]); }
            COMPILER_FENCE(); }
        const bf16_t* at = WSP(bf16_t, WS_GA) + (size_t)u * 4096 + (16 * mt + j) * 64 + 8 * q;
        const bf16_t* vt = WSP(bf16_t, WS_GV) + (size_t)u * 8192 + ((2 * (q & 1)) * 16 + j) * 8 + (q >> 1) * 4;
#pragma unroll
        for (int ks = 0; ks < 2; ++ks) { const bf16x8 a = *(const bf16x8*)(at + 32 * ks);
#pragma unroll
            for (int ct = 0; ct < 8; ++ct) { const bf16_t* vp = vt + (size_t)ct * 1024 + ks * 512; const u32x2 lo = *(const u32x2*)vp, hi = *(const u32x2*)(vp + 128); u32x4 w; w.x = lo.x; w.y = lo.y; w.z = hi.x; w.w = hi.y;
                acc[ct] = MFMA16(a, __builtin_bit_cast(bf16x8, w), acc[ct]); }
            COMPILER_FENCE(); }
        float sq[4];
#pragma unroll
        for (int e = 0; e < 4; ++e) { float s = 0.f;
#pragma unroll
            for (int ct = 0; ct < 8; ++ct) s += acc[ct][e] * acc[ct][e];
            s += __shfl_xor(s, 1); s += __shfl_xor(s, 2); s += __shfl_xor(s, 4); s += __shfl_xor(s, 8); sq[e] = 1.0f / sqrtf(s * (1.0f / 128.0f) + EPS); }
#pragma unroll
        for (int e = 0; e < 4; ++e) { const size_t row = (size_t)(b * T + n * 64 + 16 * mt + 4 * q + e);
#pragma unroll
            for (int ct = 0; ct < 8; ++ct) { const int c = 16 * ct + j; const float z = bf2f(PR[row * NPROJ + C_Z + h * 128 + c]);
                WSP(bf16_t, WS_O)[row * D + 512 + h * 128 + c] = f2bf(acc[ct][e] * sq[e] * p.gdn_norm[l * 128 + c] * silu_fast(z)); } }
    }
}
__device__ __forceinline__ void ph_gdn_sample(const P& p, int l, unsigned char* smem) {
    float* qs = (float*)smem; float* ks = qs + 8 * QP; float* vs = ks + 8 * QP; float* us = vs + 8 * QP; float* wsm = us + 8 * 128; float* vn = wsm + 8 * 128;
    float* Ls = vn + 8 * 128; float* As = Ls + 8 * 8; float* gs = As + 8 * 8; float* gcs = gs + 8; float* bts = gcs + 8; float* S0 = bts + 8;
    const int tid = tidx(); const bf16_t* PR = WSP(bf16_t, WS_PROJ);
    for (int u = gridDim.x - 1 - blockIdx.x; u < DB * 4; u += gridDim.x) {
        const int h = u & 3, b = u >> 2;
        __syncthreads();
#pragma unroll 4
        for (int e = tid; e < 16384; e += NTHR) S0[e] = p.state_gdn[(((size_t)l * DB + b) * 4 + h) * 16384 + e];
        if (tid < 384) { const int sec = tid >> 7, c = tid & 127, col = sec * 512 + h * 128 + c; float* dst = sec == 0 ? qs : sec == 1 ? ks : vs;
            const float w0 = p.conv_w[(l * 4 + 0) * 1536 + col], w1 = p.conv_w[(l * 4 + 1) * 1536 + col], w2 = p.conv_w[(l * 4 + 2) * 1536 + col], w3 = p.conv_w[(l * 4 + 3) * 1536 + col];
            const float* hist = p.state_conv + (((size_t)l * DB + b) * 3) * 1536 + col; const bf16_t* src = PR + (size_t)(MP + b * DS) * NPROJ + C_CONV + col;
            float x0 = hist[0], x1 = hist[1536], x2 = hist[2 * 1536];
            for (int i = 0; i < DS; ++i) { const float x3 = bf2f(src[(size_t)i * NPROJ]); const float y = w0 * x0 + w1 * x1 + w2 * x2 + w3 * x3; dst[i * QP + c] = silu_f(y); x0 = x1; x1 = x2; x2 = x3; } }
        else if (tid < 384 + DS) { const int i = tid - 384; const size_t row = (size_t)(MP + b * DS + i); gs[i] = WSP(float, WS_G)[row * 4 + h]; bts[i] = WSP(float, WS_BETA)[row * 4 + h]; }
        __syncthreads();
        if (tid < 64) { const int rid = tid >> 2, part = tid & 3; float* rowp = (rid < 8 ? qs + rid * QP : ks + (rid - 8) * QP) + part * 32; float s = 0.f;
            for (int d = 0; d < 32; ++d) s += rowp[d] * rowp[d];
            s += __shfl_xor(s, 1); s += __shfl_xor(s, 2); const float sc = 1.0f / sqrtf(s + EPS);
            for (int d = 0; d < 32; ++d) rowp[d] *= sc; }
        if (tid == 64) { float a = 0.f; for (int i = 0; i < DS; ++i) { a += gs[i]; gcs[i] = a; } }
        __syncthreads();
        if (tid < 64) { const int i = tid >> 3, j = tid & 7; float lv = 0.f, av = 0.f;
            if (j <= i) { float dk = 0.f, dq = 0.f; for (int d = 0; d < 128; ++d) { const float kj = ks[j * QP + d]; dk += ks[i * QP + d] * kj; dq += qs[i * QP + d] * kj; }
                const float e = expf(gcs[i] - gcs[j]); av = dq * e * 0.08838834764831845f; lv = j < i ? bts[i] * dk * e : 0.f; }
            Ls[i * 8 + j] = lv; As[i * 8 + j] = av; }
        __syncthreads();
        if (tid < 256) { const int c = tid; float X[8];
            if (c < 128) {
#pragma unroll
                for (int i = 0; i < 8; ++i) X[i] = vs[i * QP + c] * bts[i]; }
            else {
#pragma unroll
                for (int i = 0; i < 8; ++i) X[i] = ks[i * QP + c - 128] * bts[i] * expf(gcs[i]); }
            fwd_subst<8, 8>(X, Ls);
            float* dst = c < 128 ? us + c : wsm + c - 128;
#pragma unroll
            for (int i = 0; i < 8; ++i) dst[i * 128] = X[i]; }
        __syncthreads();
        const int i = tid >> 6, c2 = (tid & 63) * 2;
        { float a0 = us[i * 128 + c2], a1 = us[i * 128 + c2 + 1];
          for (int d = 0; d < 128; ++d) { const float w = wsm[i * 128 + d]; a0 -= w * S0[d * 128 + c2]; a1 -= w * S0[d * 128 + c2 + 1]; }
          vn[i * 128 + c2] = a0; vn[i * 128 + c2 + 1] = a1; }
        __syncthreads();
        { float o0 = 0.f, o1 = 0.f; const float qsc = 0.08838834764831845f * expf(gcs[i]);
          for (int d = 0; d < 128; ++d) { const float qg = qs[i * QP + d] * qsc; o0 += qg * S0[d * 128 + c2]; o1 += qg * S0[d * 128 + c2 + 1]; }
          for (int j = 0; j < DS; ++j) { const float a = As[i * 8 + j]; o0 += a * vn[j * 128 + c2]; o1 += a * vn[j * 128 + c2 + 1]; }
          const float rstd = 1.0f / sqrtf(wave_sum(o0 * o0 + o1 * o1) * (1.0f / 128.0f) + EPS);
          const size_t row = (size_t)(MP + b * DS + i);
          const float z0 = bf2f(PR[row * NPROJ + C_Z + h * 128 + c2]), z1 = bf2f(PR[row * NPROJ + C_Z + h * 128 + c2 + 1]);
          bf16_t* O = WSP(bf16_t, WS_O) + row * D + 512 + h * 128 + c2;
          O[0] = f2bf(o0 * rstd * p.gdn_norm[l * 128 + c2] * silu_f(z0)); O[1] = f2bf(o1 * rstd * p.gdn_norm[l * 128 + c2 + 1] * silu_f(z1)); }
        { const float gl = gcs[DS - 1], dec = expf(gl); float* o = p.out + O_SGDN + (((size_t)l * DB + b) * 4 + h) * 16384;
#pragma unroll 2
          for (int e = tid; e < 16384; e += NTHR) { const int d = e >> 7, c = e & 127; float s = S0[e] * dec;
              for (int j = 0; j < DS; ++j) s += ks[j * QP + d] * expf(gl - gcs[j]) * vn[j * 128 + c];
              o[e] = s; } }
    }
}


template <int K> __device__ __forceinline__ void ph_gemm_small(const P& p, const bf16_t* A  , const bf16_t* Bt  , const float* gate, const float* xs_in  , unsigned char* smem) {
    static_assert(MS % 16 == 0 && K % 256 == 0, "small GEMM shape");
    constexpr int KW = K / 8, NKS = KW / 32;
    const int tid = tidx(), lane = tid & 63, wave = tid >> 6, x = lane & 15, q = lane >> 4;
    float* red = (float*)smem;
    for (int it = blockIdx.x; it < (MS / 16) * 16; it += gridDim.x) {
        const int rt = it % (MS / 16), cg = it / (MS / 16);
        const bf16_t* ap = A + (size_t)(16 * rt + x) * K + wave * KW + 8 * q;
        const bf16_t* bp = Bt + (size_t)(64 * cg + x) * K + wave * KW + 8 * q;
        f32x4 acc[4];
#pragma unroll
        for (int ct = 0; ct < 4; ++ct) acc[ct] = (f32x4){0.f, 0.f, 0.f, 0.f};
#pragma unroll
        for (int ks = 0; ks < NKS; ++ks) { const bf16x8 a = *(const bf16x8*)(ap + 32 * ks);
#pragma unroll
            for (int ct = 0; ct < 4; ++ct) acc[ct] = MFMA16(a, *(const bf16x8*)(bp + (size_t)ct * 16 * K + 32 * ks), acc[ct]); }
        __syncthreads();
#pragma unroll
        for (int ct = 0; ct < 4; ++ct) *(f32x4*)(red + ((wave * 4 + ct) * 64 + lane) * 4) = acc[ct];
        __syncthreads();
        if (wave < 4) { f32x4 s = (f32x4){0.f, 0.f, 0.f, 0.f};
#pragma unroll
            for (int w = 0; w < 8; ++w) s += *(const f32x4*)(red + ((w * 4 + wave) * 64 + lane) * 4);
            const int col = 64 * cg + 16 * wave + x;
#pragma unroll
            for (int e = 0; e < 4; ++e) { const int row = MP + 16 * rt + 4 * q + e; float* xp = p.out + (size_t)row * D + col; const float xin = xs_in ? xs_in[(size_t)(row - MP) * D + col] : *xp; *xp = xin + gate[(size_t)row_cb(row) * 6144 + col] * s[e]; } }
    }
}

__device__ __forceinline__ void ph_final_norm(const P& p) {
    const int lane = tidx() & 63, wave = tidx() >> 6, gw = blockIdx.x * 8 + wave, ngw = gridDim.x * 8;
    for (int r = gw; r < M; r += ngw) {
        float* xr = p.out + (size_t)r * D; f32x4 v[4]; float ss = 0.f;
#pragma unroll
        for (int j = 0; j < 4; ++j) { v[j] = *(const f32x4*)(xr + 4 * lane + 256 * j); ss += (v[j][0] * v[j][0] + v[j][1] * v[j][1]) + (v[j][2] * v[j][2] + v[j][3] * v[j][3]); }
        const float rstd = 1.0f / sqrtf(wave_sum(ss) * (1.0f / D) + EPS);
#pragma unroll
        for (int j = 0; j < 4; ++j) { const f32x4 g = *(const f32x4*)(p.final_norm + 4 * lane + 256 * j); *(f32x4*)(xr + 4 * lane + 256 * j) = v[j] * rstd * g; }
    }
}

enum Phase { PH_PRO = 0, PH_NORM1, PH_GEMM_IN, PH_ROPE, PH_MIX1, PH_MIX2, PH_MIX3, PH_GEMM_OUT, PH_NORM2, PH_GEMM_GU, PH_GEMM_DN, PH_FINAL };
#ifdef __HIP_EMU__
#define LDSP(x) (x)
#else
#define LDSP(x) ((PG8_LAS unsigned char*)(x))
#endif
template <int PH> __device__ __forceinline__ void run_phase(const P& p, int l, unsigned char* smem) {
    if constexpr (PH == PH_PRO) { ph_convert(p, smem, 0, CV_IN, 0); __syncthreads(); ph_adaln(p, smem, 0, 1, 0); ph_ropetab_copyx(p); }
    else if constexpr (PH == PH_NORM1) ph_norm_mod<0>(p, l);
    else if constexpr (PH == PH_GEMM_IN) {
        pg8::Gemm g{WSP(bf16_t, WS_H), WSP(bf16_t, WS_WIN) + (size_t)l * NPROJ * D, MPAD, NPROJ, D}; pg8::StaticOrder S; S.init(MPAD, NPROJ, (int)gridDim.x, (int)blockIdx.x);
        pg8::EpiStoreBf16 E{WSP(bf16_t, WS_PROJ), NPROJ};
        pg8::gemm_phase<pg8::EpiStoreBf16, pg8::StaticOrder, true, true>(LDSP(smem), g, S, E);
    }
    else if constexpr (PH == PH_ROPE) { ph_rope_out(p, l); ph_vtrans(p, l, smem); }
    else if constexpr (PH == PH_MIX1) { ph_ret_local(p, l); ph_gdn_prep(p, l, smem); }
    else if constexpr (PH == PH_MIX2) { ph_gdn_chain(p, l, smem); { const int G = (int)gridDim.x; const bool split = G >= CH_ITEMS + DB * 4 + 16; ph_attn_jobs(p, split ? CH_ITEMS : 0, split ? G - DB * 4 : G, split ? 3 : 0); }
        __syncthreads(); ph_attn_sample(p, l, smem); ph_ret_sample(p, l, smem); ph_gdn_sample(p, l, smem); ph_ret_scan(p, l);
        if (l + 1 < NL) { const int b0 = (int)gridDim.x > 2 * CH_ITEMS ? CH_ITEMS : 0; __syncthreads(); ph_convert(p, smem, l == 0 ? CV_IN : (l + 1) * CV_L, (l + 2) * CV_L, b0); __syncthreads(); ph_adaln(p, smem, l + 1, l + 2, b0); } }
    else if constexpr (PH == PH_MIX3) { ph_attn_combine(p); ph_ret_out(p, l); ph_gdn_out(p, l); }
    else if constexpr (PH == PH_GEMM_OUT) {
        ph_gemm_small<D>(p, WSP(bf16_t, WS_O) + (size_t)MP * D, WSP(bf16_t, WS_WOUT) + (size_t)l * D * D, WSP(float, WS_MOD) + (size_t)l * NC * 6144 + 2048, l == 0 ? p.x_sample : nullptr, smem); __syncthreads();
        pg8::Gemm g{WSP(bf16_t, WS_O), WSP(bf16_t, WS_WOUT) + (size_t)l * D * D, MP, D, D}; pg8::StaticOrder S; S.init(MP, D, (int)gridDim.x, (int)blockIdx.x);
        pg8::EpiResidual E{p.out, WSP(float, WS_MOD) + (size_t)l * NC * 6144 + 2048, l == 0 ? p.x_prompt : p.out};
        pg8::gemm_phase<pg8::EpiResidual, pg8::StaticOrder, true, true>(LDSP(smem), g, S, E);
    }
    else if constexpr (PH == PH_NORM2) ph_norm_mod<1>(p, l);
    else if constexpr (PH == PH_GEMM_GU) {
        pg8::Gemm g{WSP(bf16_t, WS_H), WSP(bf16_t, WS_WGU) + (size_t)l * 2 * FF * D, MPAD, 2 * FF, D}; pg8::StaticOrder S; S.init(MPAD, 2 * FF, (int)gridDim.x, (int)blockIdx.x);
        pg8::EpiSwiglu E{WSP(bf16_t, WS_HID)};
        pg8::gemm_phase<pg8::EpiSwiglu, pg8::StaticOrder, true, true>(LDSP(smem), g, S, E);
    }
    else if constexpr (PH == PH_GEMM_DN) {
        ph_gemm_small<FF>(p, WSP(bf16_t, WS_HID) + (size_t)MP * FF, WSP(bf16_t, WS_WDN) + (size_t)l * D * FF, WSP(float, WS_MOD) + (size_t)l * NC * 6144 + 5120, nullptr, smem); __syncthreads();
        pg8::Gemm g{WSP(bf16_t, WS_HID), WSP(bf16_t, WS_WDN) + (size_t)l * D * FF, MP, D, FF}; pg8::StaticOrder S; S.init(MP, D, (int)gridDim.x, (int)blockIdx.x);
        pg8::EpiResidual E{p.out, WSP(float, WS_MOD) + (size_t)l * NC * 6144 + 5120, p.out};
        pg8::gemm_phase<pg8::EpiResidual, pg8::StaticOrder, true, true>(LDSP(smem), g, S, E);
    }
    else if constexpr (PH == PH_FINAL) ph_final_norm(p);
}
template <int PH> __global__ void __launch_bounds__(NTHR, 2) k_phase(P p, int l) { DYN_SMEM(smem); run_phase<PH>(p, l, smem); }


#ifndef __HIP_EMU__
#define LAS __attribute__((address_space(3)))
#define XB_TMO      128
#define XB_XCNT(j)  (256  + 64 * (j))
#define XB_XSUB(j)  (1280 + 64 * (j))
#define XB_XGEN(j)  (2304 + 64 * (j))
#define XB_TOP      3328
#define XB_TOPGEN   3392
#define XCD_BAR_WORDS 3456
#define XB_SPIN_CAP (1u << 18)

__device__ __forceinline__ unsigned xb_ld(unsigned* p)              { return __hip_atomic_load(p, __ATOMIC_RELAXED, __HIP_MEMORY_SCOPE_AGENT); }
__device__ __forceinline__ unsigned xb_add(unsigned* p, unsigned v) { return __hip_atomic_fetch_add(p, v, __ATOMIC_RELAXED, __HIP_MEMORY_SCOPE_AGENT); }
__device__ __forceinline__ unsigned xb_xcc_id() { return (unsigned)__builtin_amdgcn_s_getreg((3 << 11) | 20) & 0xFu; }
#define XB_SPIN(cond, bar) do { unsigned _sp = 0; while (cond) { __builtin_amdgcn_s_sleep(1); \
    if ((++_sp & 255u) == 0u) { if (xb_ld(&(bar)[XB_TMO])) break; if (_sp > XB_SPIN_CAP) { atomicAdd(&(bar)[XB_TMO], 1u); break; } } } } while (0)

struct XcdBarrier {
    unsigned* bar; unsigned x;
    volatile LAS unsigned* st;
};

__device__ __forceinline__ XcdBarrier xcd_barrier_post(unsigned* bar, volatile LAS unsigned* st) {
    XcdBarrier b; b.bar = bar; b.x = xb_xcc_id(); b.st = st;
    if (threadIdx.x == 0) (void)xb_add(&bar[XB_XCNT(b.x)], 1u);
    return b;
}
__device__ __forceinline__ void xcd_barrier_complete(unsigned* bar, unsigned x, unsigned& nloc, unsigned& nx) {
    const unsigned G = gridDim.x * gridDim.y * gridDim.z;
    unsigned sum, cnt, mine, sp = 0u;
    for (;;) {
        sum = 0u; cnt = 0u; mine = 0u;
#pragma unroll
        for (unsigned j = 0; j < 16; ++j) { const unsigned c = xb_ld(&bar[XB_XCNT(j)]); sum += c; cnt += (c > 0u) ? 1u : 0u; mine = (j == x) ? c : mine; }
        if (sum == G) break;
        __builtin_amdgcn_s_sleep(1);
        if ((++sp & 255u) == 0u) { if (xb_ld(&bar[XB_TMO])) break; if (sp > XB_SPIN_CAP) { atomicAdd(&bar[XB_TMO], 1u); break; } }
    }
    nloc = mine > 0u ? mine : 1u; nx = cnt > 0u ? cnt : 1u;
}

__device__ __forceinline__ void xcd_barrier(const XcdBarrier& b) {
    asm volatile("s_waitcnt vmcnt(0)" ::: "memory");
    __syncthreads();
    if (threadIdx.x == 0) {
        unsigned* bar = b.bar;
        __builtin_amdgcn_s_waitcnt(0);
        unsigned nloc = b.st[0], nx = b.st[1];
        if (nloc == 0u) { xcd_barrier_complete(bar, b.x, nloc, nx); b.st[0] = nloc; b.st[1] = nx; }
        const unsigned old = xb_add(&bar[XB_XSUB(b.x)], 1u);
        const unsigned gen = old / nloc;
        if (old + 1u == (gen + 1u) * nloc) {
            __builtin_amdgcn_fence(__ATOMIC_RELEASE, "agent");
            asm volatile("s_waitcnt vmcnt(0)" ::: "memory");
            const unsigned og = xb_add(&bar[XB_TOP], 1u);
            const unsigned tg = og / nx;
            if (og + 1u == (tg + 1u) * nx) xb_add(&bar[XB_TOPGEN], 1u);
            else XB_SPIN(xb_ld(&bar[XB_TOPGEN]) == tg, bar);
            __builtin_amdgcn_fence(__ATOMIC_ACQUIRE, "agent");
            xb_add(&bar[XB_XGEN(b.x)], 1u);
            asm volatile("s_waitcnt vmcnt(0)" ::: "memory");
        } else {
            XB_SPIN(xb_ld(&bar[XB_XGEN(b.x)]) == gen, bar);
            __builtin_amdgcn_fence(__ATOMIC_ACQUIRE, "agent");
            asm volatile("s_waitcnt vmcnt(0)" ::: "memory");
        }
    }
    __syncthreads();
}

#endif

#ifndef __HIP_EMU__
#define GRID_SYNC() xcd_barrier(bar)
__global__ void __launch_bounds__(NTHR, 2) k_mega(P p_arg) {
    DYN_SMEM(smem);
#if defined(__HIP_DEVICE_COMPILE__)
#define PHASE(PH_, l_) do { const __attribute__((address_space(4))) P* kp_ = (const __attribute__((address_space(4))) P*)__builtin_amdgcn_kernarg_segment_ptr(); LAUNDER_PTR(kp_); P pl_; __builtin_memcpy(&pl_, kp_, sizeof(P)); run_phase<PH_>(pl_, l_, smem); } while (0)
#else
#define PHASE(PH_, l_) run_phase<PH_>(p_arg, l_, smem)
#endif
    cooperative_groups::grid_group grid = cooperative_groups::this_grid();
    volatile LAS unsigned* bst = (volatile LAS unsigned*)((LAS unsigned char*)smem + BAR_LDS_OFF);
    if (threadIdx.x < 4) bst[threadIdx.x] = 0u;
    __syncthreads();
    XcdBarrier bar = xcd_barrier_post((unsigned*)(p_arg.ws + WS_CTL + 4096), bst);
    PHASE(PH_PRO, 0); grid.sync();
#define LAYER(l) do { PHASE(PH_NORM1, l); GRID_SYNC(); PHASE(PH_GEMM_IN, l); GRID_SYNC(); PHASE(PH_ROPE, l); GRID_SYNC(); PHASE(PH_MIX1, l); GRID_SYNC(); PHASE(PH_MIX2, l); GRID_SYNC(); \
        PHASE(PH_MIX3, l); GRID_SYNC(); PHASE(PH_GEMM_OUT, l); GRID_SYNC(); PHASE(PH_NORM2, l); GRID_SYNC(); PHASE(PH_GEMM_GU, l); GRID_SYNC(); PHASE(PH_GEMM_DN, l); GRID_SYNC(); } while (0)
    static_assert(NL == 2, "two layers written out (a loop over the layers makes hipcc hoist every phase's constants to the loop preheader and spill)");
    LAYER(0); LAYER(1);
    PHASE(PH_FINAL, 0);
}
#endif

template <int PH> static void launch_phase(const P& p, int l, int grid, hipStream_t stream) {
#ifndef __HIP_EMU__
    static bool attr_done = false;
    if (!attr_done) { (void)hipFuncSetAttribute((const void*)k_phase<PH>, hipFuncAttributeMaxDynamicSharedMemorySize, SMEM_BYTES); attr_done = true; }
#endif
    LAUNCH(k_phase<PH>, grid, SMEM_BYTES, stream, p, l);
}

extern "C" void kernel_launch(void* const* d_in, const int* in_sizes, int n_in, void* d_out, int out_size, void* d_ws, size_t ws_size, hipStream_t stream) {
    if (n_in != 24 || (size_t)out_size != O_END || ws_size < WS_END) {
        fprintf(stderr, "kernel_launch: shape mismatch: n_in %d out_size %d (want %zu) ws %zu (want %zu)\n", n_in, out_size, (size_t)O_END, ws_size, (size_t)WS_END); return; }
    P p{};
    const float** pp = (const float**)&p;
    for (int i = 0; i < 24; ++i) pp[i] = (const float*)d_in[i];
    p.out = (float*)d_out; p.ws = (unsigned char*)d_ws;
#ifndef __HIP_EMU__
    static int grid = 0;
    if (grid == 0) {
        int dev = 0, cus = 0, per_cu = 0;
        if (hipGetDevice(&dev) != hipSuccess || hipDeviceGetAttribute(&cus, hipDeviceAttributeMultiprocessorCount, dev) != hipSuccess || cus <= 0) { fprintf(stderr, "kernel_launch: device query failed\n"); grid = -1; return; }
        if (hipFuncSetAttribute((const void*)k_mega, hipFuncAttributeMaxDynamicSharedMemorySize, SMEM_BYTES) != hipSuccess) { fprintf(stderr, "kernel_launch: hipFuncSetAttribute failed\n"); grid = -1; return; }
        if (hipOccupancyMaxActiveBlocksPerMultiprocessor(&per_cu, (const void*)k_mega, NTHR, SMEM_BYTES) != hipSuccess || per_cu < 1) { fprintf(stderr, "kernel_launch: occupancy query says %d blocks per CU\n", per_cu); grid = -1; return; }
        grid = cus;
    }
    if (grid < 0) return;
    if (hipMemsetAsync((char*)d_ws + WS_CTL, 0, 65536, stream) != hipSuccess) { fprintf(stderr, "kernel_launch: memset of the barrier words failed\n"); return; }
    { void* args[] = {(void*)&p};
      hipError_t e = hipLaunchCooperativeKernel((const void*)k_mega, dim3(grid), dim3(NTHR), args, SMEM_BYTES, stream);
      if (e != hipSuccess) fprintf(stderr, "kernel_launch: cooperative launch failed: %s (grid %d)\n", hipGetErrorString(e), grid);
      return; }
#else
    int grid = 16;
#endif
    launch_phase<PH_PRO>(p, 0, grid, stream);
    for (int l = 0; l < NL; ++l) {
        launch_phase<PH_NORM1>(p, l, grid, stream);
        launch_phase<PH_GEMM_IN>(p, l, grid, stream);
        launch_phase<PH_ROPE>(p, l, grid, stream);
        launch_phase<PH_MIX1>(p, l, grid, stream);
        launch_phase<PH_MIX2>(p, l, grid, stream);
        launch_phase<PH_MIX3>(p, l, grid, stream);
        launch_phase<PH_GEMM_OUT>(p, l, grid, stream);
        launch_phase<PH_NORM2>(p, l, grid, stream);
        launch_phase<PH_GEMM_GU>(p, l, grid, stream);
        launch_phase<PH_GEMM_DN>(p, l, grid, stream);
    }
    launch_phase<PH_FINAL>(p, 0, grid, stream);
}
```

```cpp
#ifndef __HIP_EMU__
#include <hip/hip_runtime.h>
#include <hip/hip_cooperative_groups.h>
#endif
#include <cstdio>
#include <cstdint>
#include <cmath>

#ifndef CFG_BATCH
#define CFG_BATCH 2
#endif
#ifndef CFG_SEQ
#define CFG_SEQ 8192
#endif
#ifndef CFG_DB
#define CFG_DB 32
#endif
constexpr float LOG2E = 1.4426950408889634f;
constexpr int D = 1024, NL = 2, PB = CFG_BATCH, T = CFG_SEQ, DB = CFG_DB, DS = 8, PAST = 16384, WB = 2048;
constexpr int MP = PB * T, MS = DB * DS, M = MP + MS, MPAD = (M + 255) / 256 * 256, NC = PB + DB;
constexpr int INC = 3848, NPROJ = 3840, FF = 2816, NCH = T / 64, PWIN = T < 2048 ? T : 2048, NPOS = T + DS;
constexpr int NUNIT = PB * 4 * NCH;
constexpr float EPS = 1e-6f;
static_assert(T % 512 == 0, "the attention job decomposition wants T % 512 == 0");
constexpr int C_QA = 0, C_KA = 256, C_VA = 512, C_QR = 768, C_KR = 1024, C_VR = 1280, C_GR = 1536, C_CONV = 1792, C_Z = 3328;
constexpr int SMEM_BYTES = 148480;
constexpr int NTHR = 512;
constexpr int BAR_LDS_OFF = SMEM_BYTES - 64;

typedef unsigned short bf16_t;
typedef short bf16x8 __attribute__((ext_vector_type(8)));
typedef float f32x4 __attribute__((ext_vector_type(4)));
typedef unsigned u32x4 __attribute__((ext_vector_type(4)));
typedef unsigned u32x2 __attribute__((ext_vector_type(2)));
typedef float f32x16 __attribute__((ext_vector_type(16)));

#ifdef __HIP_EMU__
#define LAUNCH(kern, grid, lds, stream, ...) emu_launch(grid, NTHR, [=]() { kern(__VA_ARGS__); })
#define DYN_SMEM(name) unsigned char* name = emu_dyn_smem()
#define WAVE_SYNC() emu_wave_bar()
#define MFMA32(a, b, c) emu_mfma32(a, b, c)
#define GLDS16(gp, lp) memcpy((unsigned char*)(lp) + (threadIdx.x & 63) * 16, (gp), 16)
#define RAW_BARRIER() __syncthreads()
#define GLDS4(gp, lp) ((void)0)
#define WAIT_VM(n)
#define WAIT_LGKM0()
#define LAS
#define UNIFORM(x) (x)
#define COMPILER_FENCE()
#define LAUNDER_V(x)
#define MFMA16(a, b, c) emu_mfma16(a, b, c)
#else
#define WAVE_SYNC() asm volatile("s_waitcnt lgkmcnt(0)" ::: "memory")
#define MFMA32(a, b, c) __builtin_amdgcn_mfma_f32_32x32x16_bf16(a, b, c, 0, 0, 0)
#define LAS __attribute__((address_space(3)))
#define GLDS16(gp, lp) __builtin_amdgcn_global_load_lds((const unsigned*)(gp), (LAS unsigned*)(lp), 16, 0, 0)
#define RAW_BARRIER() __builtin_amdgcn_s_barrier()
#define GLDS4(gp, lp) __builtin_amdgcn_global_load_lds((const unsigned*)(gp), (LAS unsigned*)(lp), 4, 0, 0)
#define WAIT_VM(n) asm volatile("s_waitcnt vmcnt(" #n ")" ::: "memory")
#define WAIT_LGKM0() asm volatile("s_waitcnt lgkmcnt(0)" ::: "memory")
#define UNIFORM(x) __builtin_amdgcn_readfirstlane(x)
#define COMPILER_FENCE() __builtin_amdgcn_sched_barrier(0)
#define LAUNDER_V(x) asm volatile("" : "+v"(x))
#define MFMA16(a, b, c) __builtin_amdgcn_mfma_f32_16x16x32_bf16(a, b, c, 0, 0, 0)
#define LAUNCH(kern, grid, lds, stream, ...) hipLaunchKernelGGL(kern, dim3(grid), dim3(NTHR), lds, stream, __VA_ARGS__)
#define DYN_SMEM(name) extern __shared__ __attribute__((aligned(16))) unsigned char name[]
#endif

#ifdef __HIP_EMU__
__device__ __forceinline__ int tidx() { return (int)threadIdx.x; }
#define LAUNDER_PTR(x)
#else
__device__ __forceinline__ int tidx() { int t = (int)threadIdx.x; asm volatile("" : "+v"(t)); return t; }
#define LAUNDER_PTR(x) asm volatile("" : "+s"(x))
#endif
__device__ __forceinline__ float bf2f(bf16_t v) { return __builtin_bit_cast(float, (unsigned)v << 16); }
__device__ __forceinline__ bf16_t f2bf(float f) { unsigned u = __builtin_bit_cast(unsigned, f); return (bf16_t)((u + 0x7fffu + ((u >> 16) & 1u)) >> 16); }
#ifdef __HIP_EMU__
__device__ __forceinline__ unsigned pk2(float lo, float hi) { return (unsigned)f2bf(lo) | ((unsigned)f2bf(hi) << 16); }
#else
typedef float f32x2_t __attribute__((ext_vector_type(2))); typedef __bf16 bf16x2_t __attribute__((ext_vector_type(2)));
__device__ __forceinline__ unsigned pk2(float lo, float hi) { f32x2_t v = {lo, hi}; bf16x2_t b = __builtin_convertvector(v, bf16x2_t); return __builtin_bit_cast(unsigned, b); }
#endif
__device__ __forceinline__ bf16x8 pack_tiles(const f32x4& lo, const f32x4& hi) {
    u32x4 w; w.x = pk2(lo[0], lo[1]); w.y = pk2(lo[2], lo[3]); w.z = pk2(hi[0], hi[1]); w.w = pk2(hi[2], hi[3]); return __builtin_bit_cast(bf16x8, w);
}
__device__ __forceinline__ float silu_f(float x) { return x / (1.0f + expf(-x)); }
#ifdef __HIP_EMU__
__device__ __forceinline__ float silu_fast(float x) { return x / (1.0f + expf(-x)); }
#else
__device__ __forceinline__ float silu_fast(float x) { return x * __builtin_amdgcn_rcpf(1.0f + __builtin_amdgcn_exp2f(-LOG2E * x)); }
#endif
__device__ __forceinline__ float wave_sum(float v) {
#pragma unroll
    for (int o = 1; o < 64; o <<= 1) v += __shfl_xor(v, o);
    return v;
}
__device__ __forceinline__ float wave_max(float v) {
#pragma unroll
    for (int o = 1; o < 64; o <<= 1) v = fmaxf(v, __shfl_xor(v, o));
    return v;
}

struct P {
    const float *x_prompt, *x_sample, *cache_k, *cache_v, *state_ret, *state_gdn, *state_conv, *c_prompt, *c_sample, *ada_w, *ada_b, *norm_mix, *norm_ffn,
        *w_in, *ret_norm, *conv_w, *a_log, *dt_bias, *gdn_norm, *w_out, *w_gate, *w_up, *w_down, *final_norm;
    float* out; unsigned char* ws;
};

constexpr size_t O_YP = 0, O_YS = O_YP + (size_t)MP * D, O_PWK = O_YS + (size_t)MS * D, O_PWV = O_PWK + (size_t)NL * PB * PWIN * 256,
                 O_PRET = O_PWV + (size_t)NL * PB * PWIN * 256, O_PGDN = O_PRET + (size_t)NL * PB * 4 * 4096, O_PCONV = O_PGDN + (size_t)NL * PB * 4 * 16384,
                 O_SWK = O_PCONV + (size_t)NL * PB * 3 * 1536, O_SWV = O_SWK + (size_t)NL * DB * DS * 256, O_SRET = O_SWV + (size_t)NL * DB * DS * 256,
                 O_SGDN = O_SRET + (size_t)NL * DB * 4 * 4096, O_SCONV = O_SGDN + (size_t)NL * DB * 4 * 16384, O_END = O_SCONV + (size_t)NL * DB * 3 * 1536;

constexpr size_t al256(size_t x) { return (x + 255) / 256 * 256; }
constexpr size_t WS_CTL = 0, WS_CTL_BYTES = 1u << 20;
constexpr size_t WS_MOD = WS_CTL + WS_CTL_BYTES;
constexpr size_t WS_W8 = al256(WS_MOD + (size_t)NL * NC * 6144 * 4);
constexpr size_t WS_ROPE = al256(WS_W8 + (size_t)NL * D * 8 * 4);
constexpr size_t WS_WIN = al256(WS_ROPE + (size_t)4 * NPOS * 32 * 4);
constexpr size_t WS_WOUT = al256(WS_WIN + (size_t)NL * NPROJ * D * 2);
constexpr size_t WS_WGU = al256(WS_WOUT + (size_t)NL * D * D * 2);
constexpr size_t WS_WDN = al256(WS_WGU + (size_t)NL * 2 * FF * D * 2);
constexpr size_t WS_H = al256(WS_WDN + (size_t)NL * D * FF * 2);
constexpr size_t WS_PROJ = al256(WS_H + (size_t)MPAD * D * 2);
constexpr size_t WS_BETA = al256(WS_PROJ + (size_t)MPAD * NPROJ * 2);
constexpr size_t WS_G = al256(WS_BETA + (size_t)M * 4 * 4);
constexpr size_t WS_O = al256(WS_G + (size_t)M * 4 * 4);
constexpr size_t WS_RU = al256(WS_O + (size_t)MPAD * D * 2);
constexpr size_t WS_RS = al256(WS_RU + (size_t)NUNIT * 4096 * 4);
constexpr size_t WS_SCR = al256(WS_RS + (size_t)NUNIT * 4096 * 4);
constexpr size_t WS_GU = WS_SCR;
constexpr size_t WS_GWK = al256(WS_GU + (size_t)NUNIT * 8192 * 2);
constexpr size_t WS_GQ = al256(WS_GWK + (size_t)NUNIT * 16384 * 2);
constexpr size_t WS_GA = al256(WS_GQ + (size_t)NUNIT * 8192 * 2);
constexpr size_t WS_GD = al256(WS_GA + (size_t)NUNIT * 4096 * 2);
constexpr size_t WS_GV = al256(WS_GD + (size_t)NUNIT * 4);
constexpr size_t WS_GS = al256(WS_GV + (size_t)NUNIT * 8192 * 2);
constexpr size_t WS_GEND = al256(WS_GS + (size_t)NUNIT * 16384 * 2);
constexpr size_t ATT_CLS = (size_t)PB * 4 * (T / 32) * 2048;
constexpr size_t WS_KF = WS_GEND;
constexpr size_t WS_VF = al256(WS_KF + 3 * ATT_CLS * 2);
constexpr size_t WS_KRT = al256(WS_VF + 3 * ATT_CLS * 2);
constexpr size_t WS_VRT = al256(WS_KRT + (size_t)MP * 256 * 2);
constexpr size_t WS_AML = al256(WS_VRT + (size_t)MP * 256 * 2);
constexpr size_t WS_AEND = al256(WS_AML + (size_t)MP * 4 * 3 * 2 * 4);
constexpr size_t WS_APO = WS_H;
static_assert((size_t)MP * 4 * 3 * 64 * 2 <= (size_t)MPAD * D * 2, "attention partials overlay H");
constexpr size_t WS_HID = WS_SCR;
constexpr size_t WS_HEND = al256(WS_HID + (size_t)MPAD * FF * 2);
constexpr size_t WS_END = WS_AEND > WS_HEND ? WS_AEND : WS_HEND;

#define WSP(T_, off) ((T_*)(p.ws + (off)))
__device__ __forceinline__ int row_cb(int r) { return r < MP ? r / T : PB + (r - MP) / DS; }
__device__ __forceinline__ int row_pi(int r) { return r < MP ? r % T : T + (r - MP) % DS; }
namespace pg8 {
#ifdef __HIP_EMU__
#define PG8_LAS
#else
#define PG8_LAS __attribute__((address_space(3)))
#endif
typedef unsigned short bf16_t;
typedef short bf16x8 __attribute__((ext_vector_type(8)));
typedef float f32x4 __attribute__((ext_vector_type(4)));
typedef unsigned u32x4 __attribute__((ext_vector_type(4)));
constexpr int BM = 256, BK = 64, HALF = 128, HTB = HALF * BK * 2  , STAGE_BYTES = 8 * HTB, NXCD = 8, WGM = 8;

__host__ __device__ __forceinline__ int lds_byte(int r, int c) { const int st = (r >> 4) * 2 + (c >> 5), rr = r & 15, cc = c & 31, ob = rr * 64 + cc * 2; return st * 1024 + (ob ^ (((ob >> 9) & 1) << 5)); }
__host__ __device__ __forceinline__ void stage_rc(int b, int& R, int& C) { const int st = b / 1024, sb = b % 1024, swz = sb ^ (((sb >> 9) & 1) << 5); R = (st >> 1) * 16 + swz / 64; C = (st & 1) * 32 + (swz % 64) / 2; }
__host__ __device__ __forceinline__ int perm32(int rho) { const int n = rho >> 4, i = rho & 15; return 8 * (i >> 2) + 4 * n + (i & 3); }

struct Unit { int pm, pn; };
struct Gemm { const bf16_t* A; const bf16_t* Bt; int M, N, K; };

struct StaticOrder {
    int nM, nN, nwg, G, c;
    __host__ __device__ void init(int M, int N, int G_, int c_) { nM = M / BM; nN = N / BM; nwg = nM * nN; G = G_; c = c_; }
    __host__ __device__ bool next(int i, Unit& u) const {
        const long L = (long)i * G + c; if (L >= nwg) return false;
        int wgid = (int)L; { const int q = nwg / NXCD, r = nwg % NXCD, xcd = wgid % NXCD, off = wgid / NXCD; wgid = (xcd < r ? xcd * (q + 1) : r * (q + 1) + (xcd - r) * q) + off; }
        const int nig = WGM * nN, gid = wgid / nig, fm = gid * WGM, gsz = (nM - fm) < WGM ? (nM - fm) : WGM;
        u.pm = fm + ((wgid % nig) % gsz); u.pn = (wgid % nig) / gsz; return true;
    }
    __device__ __forceinline__ void a_ready(const Unit&) const {}
    __device__ __forceinline__ void done(const Unit&) const {}
};


struct EpiStoreBf16 {
    static constexpr bool PERM = true, AFTER_DRAIN = false;
    bf16_t* O; int ldc;
    __device__ __forceinline__ void operator()(const f32x4 (&acc)[2][2][4][2], const Unit& u, int wr, int wc, int fr, int fq) const {
        const int row0 = u.pm * BM + wr * 64 + fr, col0 = u.pn * BM + wc * 32 + 8 * fq;
#pragma unroll
        for (int ai = 0; ai < 2; ++ai)
#pragma unroll
            for (int m = 0; m < 4; ++m) { bf16_t* rowp = O + (size_t)(row0 + ai * HALF + m * 16) * ldc + col0;
#pragma unroll
                for (int bj = 0; bj < 2; ++bj) { const f32x4 v0 = acc[ai][bj][m][0], v1 = acc[ai][bj][m][1];
                    u32x4 w; w.x = ::pk2(v0[0], v0[1]); w.y = ::pk2(v0[2], v0[3]); w.z = ::pk2(v1[0], v1[1]); w.w = ::pk2(v1[2], v1[3]);
                    *(u32x4*)(rowp + bj * HALF) = w; } }
    }
};
struct EpiResidual {
    static constexpr bool PERM = false, AFTER_DRAIN = false;
    float* X; const float* gate; const float* Xin;
    __device__ __forceinline__ void operator()(const f32x4 (&acc)[2][2][4][2], const Unit& u, int wr, int wc, int fr, int fq) const {
        const int row0 = u.pm * BM + wr * 64 + fr, col0 = u.pn * BM + wc * 32 + 4 * fq;
#pragma unroll
        for (int ai = 0; ai < 2; ++ai)
#pragma unroll
            for (int m = 0; m < 4; ++m) { const int row = row0 + ai * HALF + m * 16;
                if (MPAD != M && row >= M) continue;
                const float* g = gate + (size_t)::row_cb(row) * 6144 + col0; float* xp = X + (size_t)row * D + col0; const float* xi = Xin + (size_t)row * D + col0;
#pragma unroll
                for (int bj = 0; bj < 2; ++bj)
#pragma unroll
                    for (int n = 0; n < 2; ++n) { const f32x4 gv = *(const f32x4*)(g + bj * HALF + n * 16); f32x4* xq = (f32x4*)(xp + bj * HALF + n * 16); *xq = *(const f32x4*)(xi + bj * HALF + n * 16) + gv * acc[ai][bj][m][n]; } }
    }
};
struct EpiSwiglu {
    static constexpr bool PERM = true, AFTER_DRAIN = false;
    bf16_t* Hd;
    __device__ __forceinline__ void operator()(const f32x4 (&acc)[2][2][4][2], const Unit& u, int wr, int wc, int fr, int fq) const {
        const int row0 = u.pm * BM + wr * 64 + fr, col0 = u.pn * HALF + wc * 32 + 8 * fq;
#pragma unroll
        for (int ai = 0; ai < 2; ++ai)
#pragma unroll
            for (int m = 0; m < 4; ++m) { bf16_t* rowp = Hd + (size_t)(row0 + ai * HALF + m * 16) * FF + col0;
                float v[8];
#pragma unroll
                for (int n = 0; n < 2; ++n)
#pragma unroll
                    for (int j = 0; j < 4; ++j) { const float gt = acc[ai][0][m][n][j], up = acc[ai][1][m][n][j]; v[4 * n + j] = ::silu_fast(gt) * up; }
                u32x4 w; w.x = ::pk2(v[0], v[1]); w.y = ::pk2(v[2], v[3]); w.z = ::pk2(v[4], v[5]); w.w = ::pk2(v[6], v[7]);
                *(u32x4*)rowp = w; }
    }
};

#ifdef __HIP_EMU__
template <class Epi, class Sched, bool ALIGN_EPI = false, bool SP2 = false>
__device__ __forceinline__ void gemm_phase(unsigned char* lds, const Gemm g, const Sched& S, const Epi& E) {
    const int tid = threadIdx.x, wid = tid >> 6, lane = tid & 63, wr = wid >> 2, wc = wid & 3, fr = lane & 15, fq = lane >> 4;
    Unit cur;
    for (int ui = 0; S.next(ui, cur); ++ui) {
        f32x4 acc[2][2][4][2];
        for (int ai = 0; ai < 2; ++ai) for (int bj = 0; bj < 2; ++bj) for (int m = 0; m < 4; ++m) for (int n = 0; n < 2; ++n) for (int j = 0; j < 4; ++j) {
            const int row = 256 * cur.pm + 128 * ai + 64 * wr + 16 * m + fr;
            const int col = Epi::PERM ? 256 * cur.pn + 128 * bj + 32 * wc + 8 * fq + 4 * n + j : 256 * cur.pn + 128 * bj + 32 * wc + 16 * n + 4 * fq + j;
            const bf16_t* a = g.A + (size_t)row * g.K; const bf16_t* b = g.Bt + (size_t)col * g.K; float s = 0.f;
            for (int k = 0; k < g.K; ++k) s += ::bf2f(a[k]) * ::bf2f(b[k]);
            acc[ai][bj][m][n][j] = s; }
        E(acc, cur, wr, wc, fr, fq);
    }
}
#else
template <class Epi, class Sched, bool ALIGN_EPI = false, bool SP2 = false>
__device__ __forceinline__ void gemm_phase(PG8_LAS unsigned char* lds, const Gemm g, const Sched& S, const Epi& E) {
    const int tid = ::tidx(), wid = __builtin_amdgcn_readfirstlane(tid >> 6), lane = tid & 63, wr = wid >> 2, wc = wid & 3, fr = lane & 15, fq = lane >> 4;
    const int K = g.K, nt = K / BK;
    unsigned voffA[2], voffB[2];
#pragma unroll
    for (int i = 0; i < 2; ++i) { int R, C; stage_rc(tid * 16 + i * 8192, R, C); const int Rb = Epi::PERM ? ((R & ~31) + perm32(R & 31)) : R;
        voffA[i] = (unsigned)(R * K + C) * 2u; voffB[i] = (unsigned)(Rb * K + C) * 2u; }
    const size_t kstep = (size_t)(BK * 2);
    const size_t hstep = (size_t)HALF * K * 2;
    const size_t tstep = 2 * hstep;
    const unsigned ldsw = (unsigned)wid * 1024u;
    const int aoff = lds_byte(wr * 64 + fr, fq * 8), boff = lds_byte(wc * 32 + fr, fq * 8);
#define PG8_SA(b, h) (((b) * 2 + (h)) * HTB)
#define PG8_SB(b, h) ((4 + (b) * 2 + (h)) * HTB)
#define PG8_STAGE(bufoff, gbase, voff) do { _Pragma("unroll") for (int _i = 0; _i < 2; ++_i) \
        __builtin_amdgcn_global_load_lds((const unsigned*)((const char*)(gbase) + (voff)[_i]), (PG8_LAS unsigned*)(lds + (bufoff) + ldsw + _i * 8192), 16, 0, 0); } while (0)
#define PG8_LDA(dst, b, h) do { _Pragma("unroll") for (int m = 0; m < 4; ++m) _Pragma("unroll") for (int k = 0; k < 2; ++k) dst[m][k] = *(const PG8_LAS bf16x8*)(lds + PG8_SA(b, h) + aoff + m * 2048 + k * 1024); } while (0)
#define PG8_LDB(dst, b, h) do { _Pragma("unroll") for (int n = 0; n < 2; ++n) _Pragma("unroll") for (int k = 0; k < 2; ++k) dst[n][k] = *(const PG8_LAS bf16x8*)(lds + PG8_SB(b, h) + boff + n * 2048 + k * 1024); } while (0)
#define PG8_MMA(ai, bj, At, Bt) do { __builtin_amdgcn_s_setprio(1); _Pragma("unroll") for (int m = 0; m < 4; ++m) _Pragma("unroll") for (int n = 0; n < 2; ++n) _Pragma("unroll") for (int k = 0; k < 2; ++k) \
        acc[ai][bj][m][n] = __builtin_amdgcn_mfma_f32_16x16x32_bf16(Bt[n][k], At[m][k], acc[ai][bj][m][n], 0, 0, 0); __builtin_amdgcn_s_setprio(0); } while (0)
#define PG8_WAIT_V(n) asm volatile("s_waitcnt vmcnt(" #n ")" ::: "memory")
#define PG8_WAIT_L(n) asm volatile("s_waitcnt lgkmcnt(" #n ")" ::: "memory")
#define PG8_BAR __builtin_amdgcn_s_barrier()
#define PG8_SCHED __builtin_amdgcn_sched_barrier(0)
    Unit cur, nxt; int ui = 0;
    if (!S.next(0, cur)) return;
    f32x4 acc[2][2][4][2];
#pragma unroll
    for (int a = 0; a < 2; ++a)
#pragma unroll
        for (int b = 0; b < 2; ++b)
#pragma unroll
            for (int m = 0; m < 4; ++m)
#pragma unroll
                for (int n = 0; n < 2; ++n) acc[a][b][m][n] = (f32x4){0.f, 0.f, 0.f, 0.f};
    bf16x8 At[4][2], B0[2][2], B1[2][2];
    const char* cA = (const char*)g.A + (size_t)cur.pm * tstep; const char* cB = (const char*)g.Bt + (size_t)cur.pn * tstep;
    S.a_ready(cur);
    if constexpr (SP2) {
        PG8_STAGE(PG8_SB(0, 0), cB, voffB); PG8_STAGE(PG8_SB(0, 1), cB + hstep, voffB); PG8_STAGE(PG8_SA(0, 0), cA, voffA); PG8_STAGE(PG8_SA(0, 1), cA + hstep, voffA);
        if (wr == 1) PG8_BAR;
        PG8_WAIT_V(2); PG8_BAR;
        PG8_STAGE(PG8_SB(1, 0), cB + kstep, voffB); PG8_STAGE(PG8_SA(1, 0), cA + kstep, voffA); PG8_STAGE(PG8_SB(1, 1), cB + hstep + kstep, voffB);
        PG8_WAIT_V(6); PG8_BAR;
    } else {
        PG8_STAGE(PG8_SB(0, 0), cB, voffB); PG8_STAGE(PG8_SA(0, 0), cA, voffA); PG8_STAGE(PG8_SB(0, 1), cB + hstep, voffB); PG8_STAGE(PG8_SA(0, 1), cA + hstep, voffA);
        if (wr == 1) PG8_BAR;
        PG8_WAIT_V(4); PG8_BAR;
        PG8_STAGE(PG8_SB(1, 0), cB + kstep, voffB); PG8_STAGE(PG8_SA(1, 0), cA + kstep, voffA); PG8_STAGE(PG8_SB(1, 1), cB + hstep + kstep, voffB);
        PG8_WAIT_V(6); PG8_BAR;
    }
    for (;;) {
        const bool has_next = S.next(ui + 1, nxt);
        const char* nA = has_next ? (const char*)g.A + (size_t)nxt.pm * tstep : cA; const char* nB = has_next ? (const char*)g.Bt + (size_t)nxt.pn * tstep : cB;
        for (int t = 0; t < nt; t += 2) {
            const bool last = (t == nt - 2);
            const char* a1 = cA + (size_t)(t + 1) * kstep;
            const char* a2 = last ? nA : cA + (size_t)(t + 2) * kstep; const char* b2 = last ? nB : cB + (size_t)(t + 2) * kstep;
            const char* a3 = a2 + kstep; const char* b3 = b2 + kstep;
            if (last && has_next) S.a_ready(nxt);
            if constexpr (SP2) {
            PG8_LDB(B0, 0, 0); PG8_LDB(B1, 0, 1); PG8_SCHED; PG8_LDA(At, 0, 0); PG8_STAGE(PG8_SA(1, 1), a1 + hstep, voffA);
            PG8_WAIT_V(8); PG8_WAIT_L(0); PG8_BAR; PG8_MMA(0, 0, At, B0); PG8_MMA(0, 1, At, B1); PG8_BAR; PG8_SCHED;
            PG8_LDA(At, 0, 1); PG8_STAGE(PG8_SB(0, 0), b2, voffB); PG8_STAGE(PG8_SB(0, 1), b2 + hstep, voffB); PG8_STAGE(PG8_SA(0, 0), a2, voffA);
            PG8_WAIT_V(8); PG8_WAIT_L(0); PG8_BAR; PG8_MMA(1, 0, At, B0); PG8_MMA(1, 1, At, B1); PG8_BAR; PG8_SCHED;
            PG8_LDB(B0, 1, 0); PG8_LDB(B1, 1, 1); PG8_SCHED; PG8_LDA(At, 1, 0); PG8_STAGE(PG8_SA(0, 1), a2 + hstep, voffA);
            PG8_WAIT_V(8); PG8_WAIT_L(0); PG8_BAR; PG8_MMA(0, 0, At, B0); PG8_MMA(0, 1, At, B1); PG8_BAR; PG8_SCHED;
            PG8_LDA(At, 1, 1); PG8_STAGE(PG8_SB(1, 0), b3, voffB); PG8_STAGE(PG8_SB(1, 1), b3 + hstep, voffB); PG8_STAGE(PG8_SA(1, 0), a3, voffA);
            PG8_WAIT_V(8); PG8_WAIT_L(0); PG8_BAR; PG8_MMA(1, 0, At, B0); PG8_MMA(1, 1, At, B1); PG8_BAR; PG8_SCHED;
            } else {
            PG8_LDB(B0, 0, 0); PG8_SCHED; PG8_LDA(At, 0, 0); PG8_STAGE(PG8_SA(1, 1), a1 + hstep, voffA);
            PG8_WAIT_L(8); PG8_BAR; PG8_WAIT_L(0); PG8_MMA(0, 0, At, B0); PG8_BAR; PG8_SCHED;
            PG8_LDB(B1, 0, 1); PG8_STAGE(PG8_SB(0, 0), b2, voffB);
            PG8_BAR; PG8_WAIT_L(0); PG8_MMA(0, 1, At, B1); PG8_BAR;
            PG8_LDA(At, 0, 1); PG8_STAGE(PG8_SA(0, 0), a2, voffA);
            PG8_BAR; PG8_WAIT_L(0); PG8_MMA(1, 0, At, B0); PG8_BAR; PG8_SCHED;
            PG8_STAGE(PG8_SB(0, 1), b2 + hstep, voffB);
            PG8_WAIT_V(6); PG8_BAR; PG8_MMA(1, 1, At, B1); PG8_BAR;
            PG8_LDB(B0, 1, 0); PG8_SCHED; PG8_LDA(At, 1, 0); PG8_STAGE(PG8_SA(0, 1), a2 + hstep, voffA);
            PG8_WAIT_L(8); PG8_BAR; PG8_WAIT_L(0); PG8_MMA(0, 0, At, B0); PG8_BAR; PG8_SCHED;
            PG8_LDB(B1, 1, 1); PG8_STAGE(PG8_SB(1, 0), b3, voffB);
            PG8_BAR; PG8_WAIT_L(0); PG8_MMA(0, 1, At, B1); PG8_BAR;
            PG8_LDA(At, 1, 1); PG8_STAGE(PG8_SA(1, 0), a3, voffA);
            PG8_BAR; PG8_WAIT_L(0); PG8_MMA(1, 0, At, B0); PG8_BAR; PG8_SCHED;
            PG8_STAGE(PG8_SB(1, 1), b3 + hstep, voffB);
            PG8_WAIT_V(6); PG8_BAR; PG8_MMA(1, 1, At, B1); PG8_BAR;
            }
        }
        if constexpr (ALIGN_EPI) { if (wr == 0) PG8_BAR; }
        if constexpr (!Epi::AFTER_DRAIN) { E(acc, cur, wr, wc, fr, fq); S.done(cur); }
        if (!has_next) break;
#pragma unroll
        for (int a = 0; a < 2; ++a)
#pragma unroll
            for (int b = 0; b < 2; ++b)
#pragma unroll
                for (int m = 0; m < 4; ++m)
#pragma unroll
                    for (int n = 0; n < 2; ++n) acc[a][b][m][n] = (f32x4){0.f, 0.f, 0.f, 0.f};
        cur = nxt; cA = nA; cB = nB; ++ui;
        if constexpr (ALIGN_EPI) { if (wr == 1) PG8_BAR; }
    }
    PG8_WAIT_V(0);
    if constexpr (!ALIGN_EPI) { if (wr == 0) PG8_BAR; }
    PG8_BAR;
    if constexpr (Epi::AFTER_DRAIN) { E.fused(acc, cur, wr, wc, fr, fq, lds, wid, lane); S.done(cur); }
#undef PG8_SA
#undef PG8_SB
#undef PG8_STAGE
#undef PG8_LDA
#undef PG8_LDB
#undef PG8_MMA
#undef PG8_WAIT_V
#undef PG8_WAIT_L
#undef PG8_BAR
#undef PG8_SCHED
}
#endif
}


__device__ __forceinline__ void transpose_item(const float* W, int ldw, bf16_t* WT, int K, int k0, int n0, int drow0, float* scr, int lane) {
    float wv[32];
#pragma unroll
    for (int i = 0; i < 32; ++i) wv[i] = W[(size_t)(k0 + 2 * i + (lane >> 5)) * ldw + n0 + (lane & 31)];
#pragma unroll
    for (int i = 0; i < 32; ++i) scr[(2 * i + (lane >> 5)) * 33 + (lane & 31)] = wv[i];
    WAVE_SYNC();
    const int c = lane & 7;
#pragma unroll
    for (int j = 0; j < 4; ++j) { const int n = (lane >> 3) + 8 * j; const float* s = scr + (8 * c) * 33 + n;
        u32x4 o; o.x = pk2(s[0 * 33], s[1 * 33]); o.y = pk2(s[2 * 33], s[3 * 33]); o.z = pk2(s[4 * 33], s[5 * 33]); o.w = pk2(s[6 * 33], s[7 * 33]);
        *(u32x4*)(WT + (size_t)(drow0 + n) * K + k0 + 8 * c) = o; }
    WAVE_SYNC();
}
constexpr int CV_IN = 16 * 120, CV_OUT = 16 * 32, CV_G = 16 * 88, CV_DN = 44 * 32, CV_L = CV_IN + CV_OUT + 2 * CV_G + CV_DN;
__device__ __forceinline__ void ph_convert(const P& p, unsigned char* smem, int i0, int i1, int b0) {
    if ((int)blockIdx.x < b0) return;
    const int lane = tidx() & 63, wave = tidx() >> 6;
    float* scr = (float*)smem + wave * (64 * 33 + 32);
    constexpr int I_IN = CV_IN, I_OUT = CV_OUT, I_G = CV_G, I_L = CV_L;
    const int gw = ((int)blockIdx.x - b0) * 8 + wave, ngw = ((int)gridDim.x - b0) * 8;
    for (int it = i0 + gw; it < i1; it += ngw) {
        const int l = it / I_L; int r = it % I_L;
        if (r < I_IN) { const int kb = r / 120, nb = r % 120; transpose_item(p.w_in + (size_t)l * D * INC, INC, WSP(bf16_t, WS_WIN) + (size_t)l * NPROJ * D, D, kb * 64, nb * 32, nb * 32, scr, lane); continue; }
        r -= I_IN;
        if (r < I_OUT) { const int kb = r / 32, nb = r % 32; transpose_item(p.w_out + (size_t)l * D * D, D, WSP(bf16_t, WS_WOUT) + (size_t)l * D * D, D, kb * 64, nb * 32, nb * 32, scr, lane); continue; }
        r -= I_OUT;
        if (r < 2 * I_G) { const int up = r / I_G; r %= I_G; const int kb = r / 88, nb = r % 88, n0 = nb * 32;
            transpose_item((up ? p.w_up : p.w_gate) + (size_t)l * D * FF, FF, WSP(bf16_t, WS_WGU) + (size_t)l * 2 * FF * D, D, kb * 64, n0, (n0 / 128) * 256 + up * 128 + (n0 % 128), scr, lane); continue; }
        r -= 2 * I_G;
        { const int kb = r / 32, nb = r % 32; transpose_item(p.w_down + (size_t)l * FF * D, D, WSP(bf16_t, WS_WDN) + (size_t)l * D * FF, FF, kb * 64, nb * 32, nb * 32, scr, lane); }
    }
}

__device__ __forceinline__ void ph_adaln(const P& p, unsigned char* smem, int l0, int l1, int b0) {
    if ((int)blockIdx.x < b0) return;
    float* sc = (float*)smem;
    float* red = sc + NC * 256;
    const int tid = tidx(), col = tid & 31, kg = tid >> 5;
    float* MOD = WSP(float, WS_MOD);
    for (int it = l0 * 192 + (int)blockIdx.x - b0; it < l1 * 192; it += (int)gridDim.x - b0) {
        const int l = it / 192, cb0 = (it % 192) * 32;
        float acc[NC];
#pragma unroll
        for (int r = 0; r < NC; ++r) acc[r] = 0.f;
        for (int kc = 0; kc < 4; ++kc) {
            __syncthreads();
            for (int e = tid; e < NC * 256; e += NTHR) { const int r = e >> 8, k = e & 255; const float c = r < PB ? p.c_prompt[r * D + kc * 256 + k] : p.c_sample[(r - PB) * D + kc * 256 + k]; sc[e] = silu_f(c); }
            __syncthreads();
            for (int kk = 0; kk < 16; ++kk) { const int k = kg * 16 + kk; const float w = p.ada_w[((size_t)l * D + kc * 256 + k) * 6144 + cb0 + col];
#pragma unroll
                for (int r = 0; r < NC; ++r) acc[r] += sc[r * 256 + k] * w; }
        }
#pragma unroll
        for (int r = 0; r < NC; ++r) red[(kg * NC + r) * 32 + col] = acc[r];
        __syncthreads();
        for (int e = tid; e < NC * 32; e += NTHR) { const int r = e >> 5, c = e & 31; float s = p.ada_b[l * 6144 + cb0 + c];
            for (int g = 0; g < 16; ++g) s += red[(g * NC + r) * 32 + c];
            MOD[((size_t)l * NC + r) * 6144 + cb0 + c] = s; }
        __syncthreads();
    }
}

__device__ __forceinline__ void ph_ropetab_copyx(const P& p) {
    const size_t gt = (size_t)blockIdx.x * NTHR + tidx(), ng = (size_t)gridDim.x * NTHR;
    float* tab = WSP(float, WS_ROPE);
    for (size_t e = gt; e < (size_t)NL * D * 8; e += ng) { const size_t lk = e >> 3; const int c = (int)(e & 7); WSP(float, WS_W8)[((lk >> 10) * 8 + c) * D + (lk & 1023)] = p.w_in[lk * INC + NPROJ + c]; }
    for (size_t e = gt; e < (size_t)NPOS * 32; e += ng) {
        const int pi = (int)(e >> 5), i = (int)(e & 31); const double pos = pi < T ? (double)pi : (double)(PAST + pi - T);
        const double ia = exp(-log(10000.0) * (double)i / 32.0), ir = exp(-log(10000.0) * (double)i / 31.0);
        tab[e] = (float)cos(pos * ia); tab[(size_t)NPOS * 32 + e] = (float)sin(pos * ia);
        tab[(size_t)2 * NPOS * 32 + e] = (float)cos(pos * ir); tab[(size_t)3 * NPOS * 32 + e] = (float)sin(pos * ir);
    }
}

template <int WHICH> __device__ __forceinline__ void ph_norm_mod(const P& p, int l) {
    const int lane = tidx() & 63, wave = tidx() >> 6, gw = blockIdx.x * 8 + wave, ngw = gridDim.x * 8;
    const float* nw = (WHICH == 0 ? p.norm_mix : p.norm_ffn) + l * D;
    bf16_t* H = WSP(bf16_t, WS_H);
    for (int r = gw; r < M; r += ngw) {
        const float* xr = (WHICH == 0 && l == 0) ? (r < MP ? p.x_prompt + (size_t)r * D : p.x_sample + (size_t)(r - MP) * D) : p.out + (size_t)r * D;
        const float* mod = WSP(float, WS_MOD) + ((size_t)l * NC + row_cb(r)) * 6144 + (WHICH == 0 ? 0 : 3072);
        f32x4 v[4]; float ss = 0.f;
#pragma unroll
        for (int j = 0; j < 4; ++j) { v[j] = *(const f32x4*)(xr + 4 * lane + 256 * j); ss += (v[j][0] * v[j][0] + v[j][1] * v[j][1]) + (v[j][2] * v[j][2] + v[j][3] * v[j][3]); }
        const float rstd = 1.0f / sqrtf(wave_sum(ss) * (1.0f / D) + EPS);
        float a8[8];
#pragma unroll
        for (int c = 0; c < 8; ++c) a8[c] = 0.f;
#pragma unroll
        for (int j = 0; j < 4; ++j) { const int k = 4 * lane + 256 * j;
            const f32x4 g = *(const f32x4*)(nw + k), sh = *(const f32x4*)(mod + k), sc = *(const f32x4*)(mod + 1024 + k);
            f32x4 h;
#pragma unroll
            for (int e = 0; e < 4; ++e) h[e] = v[j][e] * rstd * g[e] * (1.0f + sc[e]) + sh[e];
            u32x2 w; w.x = pk2(h[0], h[1]); w.y = pk2(h[2], h[3]); *(u32x2*)(H + (size_t)r * D + k) = w;
            if (WHICH == 0) {
#pragma unroll
                for (int c = 0; c < 8; ++c) { const f32x4 wv = *(const f32x4*)(WSP(float, WS_W8) + ((size_t)l * 8 + c) * D + k); a8[c] += (h[0] * wv[0] + h[1] * wv[1]) + (h[2] * wv[2] + h[3] * wv[3]); }
            }
        }
        if (WHICH == 0) {
            float b4[4];
#pragma unroll
            for (int c = 0; c < 4; ++c) { const float keep = lane < 32 ? a8[c] : a8[4 + c], send = lane < 32 ? a8[4 + c] : a8[c]; b4[c] = keep + __shfl_xor(send, 32); }
            float b2[2];
#pragma unroll
            for (int c = 0; c < 2; ++c) { const bool lo = (lane & 16) == 0; const float keep = lo ? b4[c] : b4[2 + c], send = lo ? b4[2 + c] : b4[c]; b2[c] = keep + __shfl_xor(send, 16); }
            float b1; { const bool lo = (lane & 8) == 0; const float keep = lo ? b2[0] : b2[1], send = lo ? b2[1] : b2[0]; b1 = keep + __shfl_xor(send, 8); }
            b1 += __shfl_xor(b1, 4); b1 += __shfl_xor(b1, 2); b1 += __shfl_xor(b1, 1);
            if ((lane & 7) == 0) { const int c = (lane >> 5) * 4 + ((lane >> 4) & 1) * 2 + ((lane >> 3) & 1);
                if (c < 4) WSP(float, WS_BETA)[(size_t)r * 4 + c] = 1.0f / (1.0f + expf(-b1));
                else { const int hh = c - 4; const float xx = b1 + p.dt_bias[l * 4 + hh]; const float sp = xx > 20.f ? xx : log1pf(expf(xx)); WSP(float, WS_G)[(size_t)r * 4 + hh] = -expf(p.a_log[l * 4 + hh]) * sp; } }
        }
    }
}

__device__ __forceinline__ void unpack8(const u32x4 w, float (&f)[8]) {
    f[0] = __builtin_bit_cast(float, w.x << 16); f[1] = __builtin_bit_cast(float, w.x & 0xffff0000u); f[2] = __builtin_bit_cast(float, w.y << 16); f[3] = __builtin_bit_cast(float, w.y & 0xffff0000u);
    f[4] = __builtin_bit_cast(float, w.z << 16); f[5] = __builtin_bit_cast(float, w.z & 0xffff0000u); f[6] = __builtin_bit_cast(float, w.w << 16); f[7] = __builtin_bit_cast(float, w.w & 0xffff0000u);
}
__device__ __forceinline__ u32x4 pack8f(const float (&f)[8]) { u32x4 w; w.x = pk2(f[0], f[1]); w.y = pk2(f[2], f[3]); w.z = pk2(f[4], f[5]); w.w = pk2(f[6], f[7]); return w; }
__device__ __forceinline__ void ph_rope_out(const P& p, int l) {
    const size_t gt = (size_t)blockIdx.x * NTHR + tidx(), ng = (size_t)gridDim.x * NTHR;
    bf16_t* PR = WSP(bf16_t, WS_PROJ); const float* tab = WSP(float, WS_ROPE);
    for (size_t e = gt; e < (size_t)MS * 64; e += ng) {
        const int r = MP + (int)(e >> 6), rem = (int)(e & 63), sec = rem >> 4, hh = (rem >> 2) & 3, d = (rem & 3) * 8;
        const int off = sec == 0 ? C_QA : sec == 1 ? C_KA : sec == 2 ? C_QR : C_KR; const float scale = sec == 0 ? 0.125f * LOG2E : sec == 3 ? 0.125f : 1.0f;
        const float* ct = tab + (size_t)(sec >= 2 ? 2 : 0) * NPOS * 32 + (size_t)row_pi(r) * 32 + d; const float* st = ct + (size_t)NPOS * 32;
        const f32x4 c0 = *(const f32x4*)ct, c1 = *(const f32x4*)(ct + 4), s0 = *(const f32x4*)st, s1 = *(const f32x4*)(st + 4);
        bf16_t* x = PR + (size_t)r * NPROJ + off + hh * 64 + d; float x1[8], x2[8], o1[8], o2[8];
        unpack8(*(const u32x4*)x, x1); unpack8(*(const u32x4*)(x + 32), x2);
#pragma unroll
        for (int k = 0; k < 8; ++k) { const float c = k < 4 ? c0[k & 3] : c1[k & 3], sn = k < 4 ? s0[k & 3] : s1[k & 3]; o1[k] = (x1[k] * c - x2[k] * sn) * scale; o2[k] = (x1[k] * sn + x2[k] * c) * scale; }
        *(u32x4*)x = pack8f(o1); *(u32x4*)(x + 32) = pack8f(o2);
        if (sec == 1) { const int b = (r - MP) / DS, i = (r - MP) % DS; float* o = p.out + O_SWK + (((size_t)l * DB + b) * DS + i) * 256 + hh * 64 + d;
            *(f32x4*)o = (f32x4){o1[0], o1[1], o1[2], o1[3]}; *(f32x4*)(o + 4) = (f32x4){o1[4], o1[5], o1[6], o1[7]}; *(f32x4*)(o + 32) = (f32x4){o2[0], o2[1], o2[2], o2[3]}; *(f32x4*)(o + 36) = (f32x4){o2[4], o2[5], o2[6], o2[7]}; }
    }
    for (size_t e = gt; e < (size_t)MS * 32; e += ng) {
        const int r = MP + (int)(e >> 5), c = (int)(e & 31) * 8; const int b = (r - MP) / DS, i = (r - MP) % DS; float* o = p.out + O_SWV + (((size_t)l * DB + b) * DS + i) * 256 + c;
        float v[8]; unpack8(*(const u32x4*)(PR + (size_t)r * NPROJ + C_VA + c), v); *(f32x4*)o = (f32x4){v[0], v[1], v[2], v[3]}; *(f32x4*)(o + 4) = (f32x4){v[4], v[5], v[6], v[7]};
    }
    for (size_t e = gt; e < (size_t)(PB + DB) * 3 * 1536; e += ng) {
        const int c = (int)(e % 1536), j = (int)((e / 1536) % 3), bb = (int)(e / (3 * 1536));
        if (bb < PB) p.out[O_PCONV + (((size_t)l * PB + bb) * 3 + j) * 1536 + c] = bf2f(PR[(size_t)(bb * T + T - 3 + j) * NPROJ + C_CONV + c]);
        else { const int b = bb - PB; p.out[O_SCONV + (((size_t)l * DB + b) * 3 + j) * 1536 + c] = bf2f(PR[(size_t)(MP + b * DS + DS - 3 + j) * NPROJ + C_CONV + c]); }
    }
}

__device__ __forceinline__ void attn_wave_sample(const P& p, int l, int r, int h, int lane, float* sw  ) {
    const bf16_t* PR = WSP(bf16_t, WS_PROJ);
    const int b = (r - MP) / DS; const int tq = WB + (r - MP) % DS;
    float q[64];
    { const bf16_t* qp = PR + (size_t)r * NPROJ + C_QA + h * 64;
#pragma unroll
      for (int j = 0; j < 8; ++j) { const bf16x8 v = *(const bf16x8*)(qp + 8 * j);
#pragma unroll
          for (int e = 0; e < 8; ++e) q[8 * j + e] = bf2f((bf16_t)v[e]); } }
    float mx = -INFINITY;
#pragma unroll 1
    for (int i = 0; i < 7; ++i) {
        const int e = lane + 64 * i;
        if (e < 387) { const int pat = e / 129, j = e % 129, dil = pat == 0 ? 1 : pat == 1 ? 4 : 16; const int rr = tq - dil * j;
            float a = 0.f;
            if (rr < WB) { const float* kp = p.cache_k + ((((size_t)l * DB + b) * WB + rr) * 4 + h) * 64;
#pragma unroll
                for (int j4 = 0; j4 < 16; ++j4) { const f32x4 kv = *(const f32x4*)(kp + 4 * j4); a += q[4 * j4] * kv[0] + q[4 * j4 + 1] * kv[1] + q[4 * j4 + 2] * kv[2] + q[4 * j4 + 3] * kv[3]; } }
            else { const bf16_t* kp = PR + (size_t)(MP + b * DS + (rr - WB)) * NPROJ + C_KA + h * 64;
#pragma unroll
                for (int j8 = 0; j8 < 8; ++j8) { const bf16x8 kv = *(const bf16x8*)(kp + 8 * j8);
#pragma unroll
                    for (int e2 = 0; e2 < 8; ++e2) a += q[8 * j8 + e2] * bf2f((bf16_t)kv[e2]); } }
            sw[e] = a; mx = fmaxf(mx, a); }
    }
    mx = wave_max(mx);
    float lsum = 0.f;
#pragma unroll 1
    for (int i = 0; i < 7; ++i) { const int e = lane + 64 * i; if (e < 387) { const float pe = exp2f(sw[e] - mx); sw[e] = pe; lsum += pe; } }
    lsum = wave_sum(lsum);
    WAVE_SYNC();
    const int kg = lane >> 4, dq = lane & 15; f32x4 o4 = (f32x4){0.f, 0.f, 0.f, 0.f};
#pragma unroll 16
    for (int e = kg; e < 387; e += 4) {
        const float pe = sw[e];
        const int pat = e / 129, j = e % 129, dil = pat == 0 ? 1 : pat == 1 ? 4 : 16; const int rr = tq - dil * j;
        f32x4 v;
        if (rr < WB) v = *(const f32x4*)(p.cache_v + ((((size_t)l * DB + b) * WB + rr) * 4 + h) * 64 + 4 * dq);
        else { const u32x2 w = *(const u32x2*)(PR + (size_t)(MP + b * DS + (rr - WB)) * NPROJ + C_VA + h * 64 + 4 * dq);
            v = (f32x4){bf2f((bf16_t)(w.x & 0xffff)), bf2f((bf16_t)(w.x >> 16)), bf2f((bf16_t)(w.y & 0xffff)), bf2f((bf16_t)(w.y >> 16))}; }
        o4 += pe * v;
    }
#pragma unroll
    for (int e = 0; e < 4; ++e) { float x = o4[e]; x += __shfl_xor(x, 16); x += __shfl_xor(x, 32); o4[e] = x; }
    WAVE_SYNC();
    if (kg == 0) { const float inv = 1.0f / lsum; u32x2 w; w.x = pk2(o4[0] * inv, o4[1] * inv); w.y = pk2(o4[2] * inv, o4[3] * inv);
        *(u32x2*)(WSP(bf16_t, WS_O) + (size_t)r * D + h * 64 + 4 * dq) = w; }
}
__device__ __forceinline__ void ph_attn_sample(const P& p, int l, unsigned char* smem) {
    const int lane = tidx() & 63, wave = tidx() >> 6, gw = (gridDim.x - 1 - blockIdx.x) * 8 + wave, ngw = gridDim.x * 8;
    float* sw = (float*)smem + wave * 392;
    for (int it = gw; it < MS * 4; it += ngw) attn_wave_sample(p, l, MP + (it >> 2), it & 3, lane, sw);
}
__device__ __forceinline__ bf16x8 pack8(const f32x16& v, int s8) {
    u32x4 w; w.x = pk2(v[s8], v[s8 + 1]); w.y = pk2(v[s8 + 2], v[s8 + 3]); w.z = pk2(v[s8 + 4], v[s8 + 5]); w.w = pk2(v[s8 + 6], v[s8 + 7]); return __builtin_bit_cast(bf16x8, w);
}
__device__ __forceinline__ void attn_job(const P& p, int jb, int lane) {
    const int c = lane & 31, hi = lane >> 5;
    constexpr int NB = T / 512;
    const int unit = jb / 48, jj = jb % 48, pat = jj >> 4, sub = jj & 15;
    const int blk = unit % NB, h = (unit / NB) & 3, b = unit / (NB * 4), bh = b * 4 + h;
    int dil, r, qi0, cls, tb;
    if (pat == 0) { dil = 1; r = 0; qi0 = blk * 512 + sub * 32; cls = 0; tb = 0; }
    else if (pat == 1) { dil = 4; r = sub >> 2; qi0 = blk * 128 + (sub & 3) * 32; cls = 1; tb = r * (T / 128); }
    else { dil = 16; r = sub; qi0 = blk * 32; cls = 2; tb = r * (T / 512); }
    const bf16_t* KF = WSP(bf16_t, WS_KF) + cls * ATT_CLS + ((size_t)bh * (T / 32) + tb) * 2048 + lane * 8;
    const bf16_t* VF = WSP(bf16_t, WS_VF) + cls * ATT_CLS + ((size_t)bh * (T / 32) + tb) * 2048 + lane * 8;
    const int tq = dil * (qi0 + c) + r;
    const bf16_t* qp = WSP(bf16_t, WS_PROJ) + (size_t)(b * T + tq) * NPROJ + C_QA + h * 64 + 8 * hi;
    bf16x8 qf[4];
#pragma unroll
    for (int ks = 0; ks < 4; ++ks) qf[ks] = *(const bf16x8*)(qp + 16 * ks);
    f32x16 S[5];
#pragma unroll
    for (int i = 0; i < 5; ++i) {
        const int kt0 = qi0 - 128 + 32 * i;
        f32x16 acc;
#pragma unroll
        for (int e = 0; e < 16; ++e) acc[e] = 0.f;
        if (kt0 >= 0) { const bf16_t* kp = KF + (size_t)(kt0 >> 5) * 2048;
#pragma unroll
            for (int ks = 0; ks < 4; ++ks) acc = MFMA32(*(const bf16x8*)(kp + 512 * ks), qf[ks], acc);
            if (i == 0) {
#pragma unroll
                for (int e = 0; e < 16; ++e) { const int krow = (e & 3) + 8 * (e >> 2) + 4 * hi; if (krow < c) acc[e] = -INFINITY; } }
            if (i == 4) {
#pragma unroll
                for (int e = 0; e < 16; ++e) { const int krow = (e & 3) + 8 * (e >> 2) + 4 * hi; if (krow > c) acc[e] = -INFINITY; } }
        } else {
#pragma unroll
            for (int e = 0; e < 16; ++e) acc[e] = -INFINITY; }
        S[i] = acc;
    }
    float mx = -INFINITY;
#pragma unroll
    for (int i = 0; i < 5; ++i)
#pragma unroll
        for (int e = 0; e < 16; ++e) mx = fmaxf(mx, S[i][e]);
    mx = fmaxf(mx, __shfl_xor(mx, 32));
    float lsum = 0.f;
#pragma unroll
    for (int i = 0; i < 5; ++i)
#pragma unroll
        for (int e = 0; e < 16; ++e) { const float pe = exp2f(S[i][e] - mx); S[i][e] = pe; lsum += pe; }
    lsum += __shfl_xor(lsum, 32);
    f32x16 O[2];
#pragma unroll
    for (int dt = 0; dt < 2; ++dt)
#pragma unroll
        for (int e = 0; e < 16; ++e) O[dt][e] = 0.f;
#pragma unroll
    for (int i = 0; i < 5; ++i) {
        const int kt0 = qi0 - 128 + 32 * i;
        if (kt0 >= 0) {
#pragma unroll
            for (int s2 = 0; s2 < 2; ++s2) { const bf16x8 pf = pack8(S[i], 8 * s2);
#pragma unroll
                for (int dt = 0; dt < 2; ++dt) O[dt] = MFMA32(*(const bf16x8*)(VF + (size_t)(kt0 >> 5) * 2048 + (dt * 2 + s2) * 512), pf, O[dt]); }
        }
    }
    const size_t idx = ((size_t)(b * T + tq) * 4 + h) * 3 + pat;
    bf16_t* po = WSP(bf16_t, WS_APO) + idx * 64;
#pragma unroll
    for (int dt = 0; dt < 2; ++dt)
#pragma unroll
        for (int g = 0; g < 4; ++g) { u32x2 w; w.x = pk2(O[dt][4 * g], O[dt][4 * g + 1]); w.y = pk2(O[dt][4 * g + 2], O[dt][4 * g + 3]); *(u32x2*)(po + 32 * dt + 8 * g + 4 * hi) = w; }
    if (hi == 0) { float* ml = WSP(float, WS_AML) + idx * 2; ml[0] = mx; ml[1] = lsum; }
}
__device__ __forceinline__ void ph_attn_jobs(const P& p, int nc, int b1, int r0) {
    const int bid = (int)blockIdx.x; if (bid >= b1) return;
    const int lane = tidx() & 63, wave = tidx() >> 6, nn = (b1 - nc) * 8, ncw = nc * 8; constexpr int NJ = PB * 4 * (T / 512) * 48;
    const bool late = bid < nc; const int wi = late ? bid * 8 + wave : (bid - nc) * 8 + wave;
    for (int r = late ? r0 : 0;; ++r) { const int base = r * nn + (r > r0 ? (r - r0) * ncw : 0); const int jb = base + (late ? nn + wi : wi);
        if (base >= NJ) break;
        if (jb < NJ) attn_job(p, jb, lane); }
}
__device__ __forceinline__ void ph_attn_combine(const P& p) {
    const size_t gt = (size_t)blockIdx.x * NTHR + tidx(), ng = (size_t)gridDim.x * NTHR;
    for (size_t e = gt; e < (size_t)MP * 4 * 16; e += ng) {
        const size_t rh = e >> 4; const int dq = (int)(e & 15) * 4;
        const float* ml = WSP(float, WS_AML) + rh * 6; const float m0 = ml[0], m1 = ml[2], m2 = ml[4];
        const float mm = fmaxf(m0, fmaxf(m1, m2)); const float w0 = exp2f(m0 - mm), w1 = exp2f(m1 - mm), w2 = exp2f(m2 - mm);
        const float inv = 1.0f / (w0 * ml[1] + w1 * ml[3] + w2 * ml[5]);
        const bf16_t* po = WSP(bf16_t, WS_APO) + rh * 192 + dq;
        const u32x2 a = *(const u32x2*)po, bq = *(const u32x2*)(po + 64), cq = *(const u32x2*)(po + 128);
        float o[4];
        o[0] = w0 * bf2f((bf16_t)(a.x & 0xffff)) + w1 * bf2f((bf16_t)(bq.x & 0xffff)) + w2 * bf2f((bf16_t)(cq.x & 0xffff));
        o[1] = w0 * bf2f((bf16_t)(a.x >> 16)) + w1 * bf2f((bf16_t)(bq.x >> 16)) + w2 * bf2f((bf16_t)(cq.x >> 16));
        o[2] = w0 * bf2f((bf16_t)(a.y & 0xffff)) + w1 * bf2f((bf16_t)(bq.y & 0xffff)) + w2 * bf2f((bf16_t)(cq.y & 0xffff));
        o[3] = w0 * bf2f((bf16_t)(a.y >> 16)) + w1 * bf2f((bf16_t)(bq.y >> 16)) + w2 * bf2f((bf16_t)(cq.y >> 16));
        const size_t row = rh >> 2; const int h = (int)(rh & 3);
        u32x2 w; w.x = pk2(o[0] * inv, o[1] * inv); w.y = pk2(o[2] * inv, o[3] * inv);
        *(u32x2*)(WSP(bf16_t, WS_O) + row * D + h * 64 + dq) = w;
    }
}
__device__ __forceinline__ float ret_lg(int h) { return logf(1.0f - exp2f(-5.0f - (float)h)); }
constexpr int TPK = 72, TPT = 65;
__device__ __forceinline__ void trans_write(const bf16_t* tile, bf16_t* dst  , int tile0, int tid) {
#pragma unroll
    for (int k = 0; k < 4; ++k) { const int ch = tid + NTHR * k, d = ch >> 5, t0 = (ch & 31) * 8; u32x4 w;
        w.x = (unsigned)tile[(t0 + 0) * TPT + d] | ((unsigned)tile[(t0 + 1) * TPT + d] << 16); w.y = (unsigned)tile[(t0 + 2) * TPT + d] | ((unsigned)tile[(t0 + 3) * TPT + d] << 16);
        w.z = (unsigned)tile[(t0 + 4) * TPT + d] | ((unsigned)tile[(t0 + 5) * TPT + d] << 16); w.w = (unsigned)tile[(t0 + 6) * TPT + d] | ((unsigned)tile[(t0 + 7) * TPT + d] << 16);
        *(u32x4*)(dst + (size_t)d * T + tile0 + t0) = w; COMPILER_FENCE(); }
}
__device__ __forceinline__ void store8_b16(bf16_t* dst, const u32x4 w) {
    dst[0] = (bf16_t)(w.x & 0xffff); dst[1] = (bf16_t)(w.x >> 16); dst[2] = (bf16_t)(w.y & 0xffff); dst[3] = (bf16_t)(w.y >> 16);
    dst[4] = (bf16_t)(w.z & 0xffff); dst[5] = (bf16_t)(w.z >> 16); dst[6] = (bf16_t)(w.w & 0xffff); dst[7] = (bf16_t)(w.w >> 16);
}
__device__ __forceinline__ void ph_vtrans(const P& p, int l, unsigned char* smem) {
    bf16_t* ka = (bf16_t*)smem; bf16_t* va = ka + 256 * TPK; bf16_t* vr = va + 256 * TPK; bf16_t* kr = vr + 256 * TPT;
    static_assert((2 * 256 * TPK + 2 * 256 * TPT) * 2 <= BAR_LDS_OFF, "transpose unit LDS");
    const int tid = tidx(); bf16_t* PR = WSP(bf16_t, WS_PROJ); const float* tab = WSP(float, WS_ROPE);
    for (int u = blockIdx.x; u < PB * 4 * (T / 256); u += gridDim.x) {
        const int tile = u % (T / 256), bh = u / (T / 256), h = bh & 3, b = bh >> 2; const float lg = ret_lg(h);
        __syncthreads();
#pragma unroll 1
        for (int k = 0; k < 2; ++k) { const int e = tid + NTHR * k, t = e >> 2, d = (e & 3) * 8, tt = tile * 256 + t; bf16_t* row = PR + (size_t)(b * T + tt) * NPROJ + h * 64 + d;
            float x1[8], x2[8], o1[8], o2[8];
            { const float* ct = tab + (size_t)tt * 32 + d; const float* st = ct + (size_t)NPOS * 32;
              const f32x4 c0 = *(const f32x4*)ct, c1 = *(const f32x4*)(ct + 4), s0 = *(const f32x4*)st, s1 = *(const f32x4*)(st + 4);
              unpack8(*(const u32x4*)(row + C_QA), x1); unpack8(*(const u32x4*)(row + C_QA + 32), x2);
#pragma unroll
              for (int i = 0; i < 8; ++i) { const float c = i < 4 ? c0[i & 3] : c1[i & 3], sn = i < 4 ? s0[i & 3] : s1[i & 3]; o1[i] = (x1[i] * c - x2[i] * sn) * (0.125f * LOG2E); o2[i] = (x1[i] * sn + x2[i] * c) * (0.125f * LOG2E); }
              *(u32x4*)(row + C_QA) = pack8f(o1); *(u32x4*)(row + C_QA + 32) = pack8f(o2);
              unpack8(*(const u32x4*)(row + C_KA), x1); unpack8(*(const u32x4*)(row + C_KA + 32), x2);
#pragma unroll
              for (int i = 0; i < 8; ++i) { const float c = i < 4 ? c0[i & 3] : c1[i & 3], sn = i < 4 ? s0[i & 3] : s1[i & 3]; o1[i] = x1[i] * c - x2[i] * sn; o2[i] = x1[i] * sn + x2[i] * c; }
              *(u32x4*)(ka + t * TPK + d) = pack8f(o1); *(u32x4*)(ka + t * TPK + d + 32) = pack8f(o2);
              if (tt >= T - PWIN) { float* o = p.out + O_PWK + (((size_t)l * PB + b) * PWIN + (tt - (T - PWIN))) * 256 + h * 64 + d;
                  *(f32x4*)o = (f32x4){o1[0], o1[1], o1[2], o1[3]}; *(f32x4*)(o + 4) = (f32x4){o1[4], o1[5], o1[6], o1[7]}; *(f32x4*)(o + 32) = (f32x4){o2[0], o2[1], o2[2], o2[3]}; *(f32x4*)(o + 36) = (f32x4){o2[4], o2[5], o2[6], o2[7]}; } }
            COMPILER_FENCE();
            { const float* ct = tab + (size_t)2 * NPOS * 32 + (size_t)tt * 32 + d; const float* st = ct + (size_t)NPOS * 32;
              const f32x4 c0 = *(const f32x4*)ct, c1 = *(const f32x4*)(ct + 4), s0 = *(const f32x4*)st, s1 = *(const f32x4*)(st + 4);
              const float gq = expf(lg * (float)(tt & 63)), gk = 0.125f / gq;
              unpack8(*(const u32x4*)(row + C_QR), x1); unpack8(*(const u32x4*)(row + C_QR + 32), x2);
#pragma unroll
              for (int i = 0; i < 8; ++i) { const float c = i < 4 ? c0[i & 3] : c1[i & 3], sn = i < 4 ? s0[i & 3] : s1[i & 3]; o1[i] = (x1[i] * c - x2[i] * sn) * gq; o2[i] = (x1[i] * sn + x2[i] * c) * gq; }
              *(u32x4*)(row + C_QR) = pack8f(o1); *(u32x4*)(row + C_QR + 32) = pack8f(o2);
              unpack8(*(const u32x4*)(row + C_KR), x1); unpack8(*(const u32x4*)(row + C_KR + 32), x2);
#pragma unroll
              for (int i = 0; i < 8; ++i) { const float c = i < 4 ? c0[i & 3] : c1[i & 3], sn = i < 4 ? s0[i & 3] : s1[i & 3]; o1[i] = (x1[i] * c - x2[i] * sn) * gk; o2[i] = (x1[i] * sn + x2[i] * c) * gk; }
              const u32x4 w1 = pack8f(o1), w2 = pack8f(o2);
              *(u32x4*)(row + C_KR) = w1; *(u32x4*)(row + C_KR + 32) = w2; store8_b16(kr + t * TPT + d, w1); store8_b16(kr + t * TPT + d + 32, w2); }
            COMPILER_FENCE(); }
#pragma unroll
        for (int k = 0; k < 4; ++k) { const int ch = tid + NTHR * k, t = ch >> 3, d8 = (ch & 7) * 8, tt = tile * 256 + t; const bf16_t* src = PR + (size_t)(b * T + tt) * NPROJ + h * 64 + d8;
            const u32x4 wv = *(const u32x4*)(src + C_VA); *(u32x4*)(va + t * TPK + d8) = wv; store8_b16(vr + t * TPT + d8, *(const u32x4*)(src + C_VR));
            if (tt >= T - PWIN) { float v[8]; unpack8(wv, v); float* o = p.out + O_PWV + (((size_t)l * PB + b) * PWIN + (tt - (T - PWIN))) * 256 + h * 64 + d8;
                *(f32x4*)o = (f32x4){v[0], v[1], v[2], v[3]}; *(f32x4*)(o + 4) = (f32x4){v[4], v[5], v[6], v[7]}; }
            COMPILER_FENCE(); }
        __syncthreads();
#pragma unroll
        for (int cls = 0; cls < 3; ++cls) {
            bf16_t* KFc = WSP(bf16_t, WS_KF) + cls * ATT_CLS + (size_t)bh * (T / 32) * 2048; bf16_t* VFc = WSP(bf16_t, WS_VF) + cls * ATT_CLS + (size_t)bh * (T / 32) * 2048;
#pragma unroll 1
            for (int k = 0; k < 4; ++k) { const int f = tid + NTHR * k, lane = f & 63, c31 = lane & 31, hi = lane >> 5;
                { int g, ks, tl, gtile; bool ok = true;
                  if (cls == 0) { ks = (f >> 6) & 3; g = f >> 8; tl = 32 * g + c31; gtile = tile * 8 + g; }
                  else if (cls == 1) { ks = (f >> 6) & 3; g = f >> 8; const int r = g >> 1, st = g & 1; tl = 4 * (32 * st + c31) + r; gtile = r * (T / 128) + tile * 2 + st; }
                  else { const int r = f >> 7, s16 = f & 15, h2 = (f >> 4) & 1; ks = (f >> 5) & 3; tl = 16 * s16 + r; gtile = r * (T / 512) + (tile >> 1); g = 0; (void)ok;
                      const int slot = 16 * (tile & 1) + s16;
                      *(u32x4*)(KFc + ((size_t)gtile * 4 + ks) * 512 + (slot + 32 * h2) * 8) = *(const u32x4*)(ka + tl * TPK + 16 * ks + 8 * h2); }
                  if (cls < 2) { *(u32x4*)(KFc + ((size_t)gtile * 4 + ks) * 512 + lane * 8) = *(const u32x4*)(ka + tl * TPK + 16 * ks + 8 * hi); } }
                { int dt, s2, gtile, r = 0, st = 0, g = 0;
                  if (cls == 0) { s2 = (f >> 6) & 1; dt = (f >> 7) & 1; g = f >> 8; gtile = tile * 8 + g; }
                  else if (cls == 1) { s2 = (f >> 6) & 1; dt = (f >> 7) & 1; g = f >> 8; r = g >> 1; st = g & 1; gtile = r * (T / 128) + tile * 2 + st; }
                  else { dt = (f >> 6) & 1; r = f >> 7; s2 = tile & 1; gtile = r * (T / 512) + (tile >> 1); }
                  unsigned short e8[8];
#pragma unroll
                  for (int jj = 0; jj < 8; ++jj) { const int kk = 16 * s2 + 8 * (jj >> 2) + 4 * hi + (jj & 3);
                      const int tl = cls == 0 ? 32 * g + kk : cls == 1 ? 4 * (32 * st + kk) + r : 16 * (kk & 15) + r;
                      e8[jj] = va[tl * TPK + 32 * dt + c31]; }
                  u32x4 w; w.x = (unsigned)e8[0] | ((unsigned)e8[1] << 16); w.y = (unsigned)e8[2] | ((unsigned)e8[3] << 16); w.z = (unsigned)e8[4] | ((unsigned)e8[5] << 16); w.w = (unsigned)e8[6] | ((unsigned)e8[7] << 16);
                  *(u32x4*)(VFc + ((size_t)gtile * 4 + dt * 2 + s2) * 512 + lane * 8) = w; }
                COMPILER_FENCE(); }
        }
        trans_write(vr, WSP(bf16_t, WS_VRT) + (size_t)bh * 64 * T, tile * 256, tid);
        trans_write(kr, WSP(bf16_t, WS_KRT) + (size_t)bh * 64 * T, tile * 256, tid);
    }
}

constexpr int CH_ITEMS = PB * 4 * 4;
__device__ __forceinline__ void ph_ret_local(const P& p, int l) {
    const int tid = tidx(), lane = tid & 63, wave = tid >> 6, x = lane & 15, q = lane >> 4, dt = wave >> 1;
    for (int u = blockIdx.x; u < NUNIT; u += gridDim.x) {
        const int n = u % NCH, bh = u / NCH, h = bh & 3, t0 = n * 64; const float g63 = expf(ret_lg(h) * 63.0f);
        const bf16_t* ka = WSP(bf16_t, WS_KRT) + ((size_t)bh * 64 + 16 * dt + x) * T + t0 + 8 * q;
#pragma unroll
        for (int k = 0; k < 2; ++k) { const int et = 2 * (wave & 1) + k; const bf16_t* vb = WSP(bf16_t, WS_VRT) + ((size_t)bh * 64 + 16 * et + x) * T + t0 + 8 * q;
            f32x4 acc = (f32x4){0.f, 0.f, 0.f, 0.f};
#pragma unroll
            for (int ks = 0; ks < 2; ++ks) acc = MFMA16(*(const bf16x8*)(ka + 32 * ks), *(const bf16x8*)(vb + 32 * ks), acc);
            *(f32x4*)(WSP(float, WS_RU) + (size_t)u * 4096 + (16 * et + x) * 64 + 16 * dt + 4 * q) = acc * g63; }
    }
}
__device__ __forceinline__ void ph_ret_scan(const P& p, int l) {
    const int G = (int)gridDim.x, skip = G > 2 * CH_ITEMS ? CH_ITEMS : 0;
    if ((int)blockIdx.x < skip) return;
    const int gt = ((int)blockIdx.x - skip) * NTHR + tidx(), ng = (G - skip) * NTHR;
    for (int e = gt; e < PB * 4 * 4096; e += ng) {
        const int bh = e >> 12, ed = e & 4095, h = bh & 3; const float cd = expf(ret_lg(h) * 64.0f);
        const float* U = WSP(float, WS_RU) + (size_t)bh * NCH * 4096 + ed; bf16_t* SPv = WSP(bf16_t, WS_RS) + (size_t)bh * NCH * 4096 + ed;
        float s = 0.f;
        static_assert(NCH % 8 == 0, "scan batches");
        constexpr int SB = NCH % 32 == 0 ? 32 : 8;
        for (int n0 = 0; n0 < NCH; n0 += SB) {
            float uv[SB];
#pragma unroll
            for (int k = 0; k < SB; ++k) uv[k] = U[(size_t)(n0 + k) * 4096];
#pragma unroll
            for (int k = 0; k < SB; ++k) { SPv[(size_t)(n0 + k) * 4096] = f2bf(s); s = s * cd + uv[k]; } }
        p.out[O_PRET + ((size_t)l * PB * 4 + bh) * 4096 + (ed & 63) * 64 + (ed >> 6)] = s;
    }
}
__device__ __forceinline__ void ph_ret_out(const P& p, int l) {
    const int tid = tidx(), lane = tid & 63, wave = tid >> 6, x = lane & 15, q = lane >> 4, it = UNIFORM(wave & 3);
    const bf16_t* PR = WSP(bf16_t, WS_PROJ);
    for (int u = blockIdx.x * 2 + (wave >> 2); u < NUNIT; u += gridDim.x * 2) {
        const int n = u % NCH, bh = u / NCH, h = bh & 3, b = bh >> 2, t0 = n * 64; const float gam = expf(ret_lg(h));
        const size_t rowi = (size_t)(b * T + t0 + 16 * it + x);
        bf16x8 qf[2];
#pragma unroll
        for (int ks = 0; ks < 2; ++ks) qf[ks] = *(const bf16x8*)(PR + rowi * NPROJ + C_QR + h * 64 + 32 * ks + 8 * q);
        f32x4 at[4];
#pragma unroll
        for (int jt = 0; jt < 4; ++jt) { at[jt] = (f32x4){0.f, 0.f, 0.f, 0.f};
            if (jt <= it) { const bf16_t* kp = PR + (size_t)(b * T + t0 + 16 * jt + x) * NPROJ + C_KR + h * 64 + 8 * q;
#pragma unroll
                for (int ks = 0; ks < 2; ++ks) at[jt] = MFMA16(*(const bf16x8*)(kp + 32 * ks), qf[ks], at[jt]);
                if (jt == it) {
#pragma unroll
                    for (int e = 0; e < 4; ++e) if (4 * q + e > x) at[jt][e] = 0.f; } } }
        const bf16x8 pb0 = pack_tiles(at[0], at[1]), pb1 = pack_tiles(at[2], at[3]);
        f32x4 o[4], os[4];
#pragma unroll
        for (int et = 0; et < 4; ++et) { o[et] = (f32x4){0.f, 0.f, 0.f, 0.f}; os[et] = (f32x4){0.f, 0.f, 0.f, 0.f};
            const bf16_t* vp = WSP(bf16_t, WS_VRT) + ((size_t)bh * 64 + 16 * et + x) * T + t0 + 4 * q;
            { const u32x2 lo = *(const u32x2*)vp, hi = *(const u32x2*)(vp + 16); u32x4 w; w.x = lo.x; w.y = lo.y; w.z = hi.x; w.w = hi.y; o[et] = MFMA16(__builtin_bit_cast(bf16x8, w), pb0, o[et]); }
            if (it >= 2) { const u32x2 lo = *(const u32x2*)(vp + 32), hi = *(const u32x2*)(vp + 48); u32x4 w; w.x = lo.x; w.y = lo.y; w.z = hi.x; w.w = hi.y; o[et] = MFMA16(__builtin_bit_cast(bf16x8, w), pb1, o[et]); }
            const bf16_t* sp = WSP(bf16_t, WS_RS) + (size_t)u * 4096 + (16 * et + x) * 64 + 8 * q;
#pragma unroll
            for (int ks = 0; ks < 2; ++ks) os[et] = MFMA16(*(const bf16x8*)(sp + 32 * ks), qf[ks], os[et]);
            o[et] = o[et] + os[et] * gam; }
        float sq = 0.f;
#pragma unroll
        for (int et = 0; et < 4; ++et) sq += (o[et][0] * o[et][0] + o[et][1] * o[et][1]) + (o[et][2] * o[et][2] + o[et][3] * o[et][3]);
        sq += __shfl_xor(sq, 16); sq += __shfl_xor(sq, 32);
        const float rstd = 1.0f / sqrtf(sq * (1.0f / 64.0f) + EPS);
#pragma unroll
        for (int et = 0; et < 4; ++et) { const int e0 = 16 * et + 4 * q; const u32x2 gw = *(const u32x2*)(PR + rowi * NPROJ + C_GR + h * 64 + e0); const f32x4 nw = *(const f32x4*)(p.ret_norm + l * 64 + e0);
            const float g0 = bf2f((bf16_t)(gw.x & 0xffff)), g1 = bf2f((bf16_t)(gw.x >> 16)), g2 = bf2f((bf16_t)(gw.y & 0xffff)), g3 = bf2f((bf16_t)(gw.y >> 16));
            u32x2 w; w.x = pk2(o[et][0] * rstd * nw[0] * silu_fast(g0), o[et][1] * rstd * nw[1] * silu_fast(g1)); w.y = pk2(o[et][2] * rstd * nw[2] * silu_fast(g2), o[et][3] * rstd * nw[3] * silu_fast(g3));
            *(u32x2*)(WSP(bf16_t, WS_O) + rowi * D + 256 + h * 64 + e0) = w; }
    }
}
__device__ __forceinline__ void ph_ret_sample(const P& p, int l, unsigned char* smem) {
    float* S0 = (float*)smem; float* qs = S0 + 4096; float* ks = qs + 8 * 64; float* vs = ks + 8 * 64;
    const int tid = tidx(); const bf16_t* PR = WSP(bf16_t, WS_PROJ);
    for (int u = gridDim.x - 1 - blockIdx.x; u < DB * 4; u += gridDim.x) {
        const int h = u & 3, b = u >> 2; const float lg = ret_lg(h);
        __syncthreads();
        for (int e = tid; e < 4096; e += NTHR) S0[e] = p.state_ret[(((size_t)l * DB + b) * 4 + h) * 4096 + e];
        { const int j = tid >> 6, d = tid & 63; const size_t row = (size_t)(MP + b * DS + j) * NPROJ;
          qs[tid] = bf2f(PR[row + C_QR + h * 64 + d]); ks[tid] = bf2f(PR[row + C_KR + h * 64 + d]); vs[tid] = bf2f(PR[row + C_VR + h * 64 + d]); }
        __syncthreads();
        { const int i = tid >> 6, e = tid & 63; float o = 0.f;
          for (int j = 0; j <= i; ++j) { float a = 0.f; for (int d = 0; d < 64; ++d) a += qs[i * 64 + d] * ks[j * 64 + d]; o += a * expf(lg * (float)(i - j)) * vs[j * 64 + e]; }
          float o2 = 0.f; for (int d = 0; d < 64; ++d) o2 += qs[i * 64 + d] * S0[d * 64 + e];
          o += o2 * expf(lg * (float)(i + 1));
          const float rstd = 1.0f / sqrtf(wave_sum(o * o) * (1.0f / 64.0f) + EPS);
          const size_t row = (size_t)(MP + b * DS + i); const float g = bf2f(PR[row * NPROJ + C_GR + h * 64 + e]);
          WSP(bf16_t, WS_O)[row * D + 256 + h * 64 + e] = f2bf(o * rstd * p.ret_norm[l * 64 + e] * silu_f(g)); }
        for (int x = tid; x < 4096; x += NTHR) { const int d = x >> 6, e = x & 63; float s = S0[x] * expf(lg * (float)DS);
            for (int j = 0; j < DS; ++j) s += ks[j * 64 + d] * expf(lg * (float)(DS - 1 - j)) * vs[j * 64 + e];
            p.out[O_SRET + (((size_t)l * DB + b) * 4 + h) * 4096 + x] = s; }
    }
}

template <int CS, int LDL> __device__ __forceinline__ void fwd_subst(float (&X)[CS], const float* Ls) {
#pragma unroll
    for (int i = 1; i < CS; ++i) {
        float a[4] = {X[i], 0.f, 0.f, 0.f};
#pragma unroll
        for (int j4 = 0; j4 < (i + 3) / 4; ++j4) { const f32x4 lv = *(const f32x4*)(Ls + i * LDL + 4 * j4);
#pragma unroll
            for (int e = 0; e < 4; ++e) if (4 * j4 + e < i) a[e] -= lv[e] * X[4 * j4 + e]; }
        X[i] = (a[0] + a[1]) + (a[2] + a[3]);
    }
}
constexpr int QP = 132;
constexpr int WSTP = 136;
constexpr int RWP = 392, TP = 136;
__device__ __forceinline__ void ph_gdn_prep(const P& p, int l, unsigned char* smem) {
    float* Ls = (float*)smem; float* As = Ls + 64 * 68; float* gs = As + 64 * 68; float* gcs = gs + 64; float* bts = gcs + 64; float* part = bts + 64;
    bf16_t* raw = (bf16_t*)(part + 4 * 64); bf16_t* Khi = raw + 67 * RWP; bf16_t* Klo = Khi + 64 * TP; bf16_t* Qb = Klo + 64 * TP;
    static_assert((64 * 68 * 2 + 64 * 3 + 4 * 64) * 4 + (67 * RWP + 3 * 64 * TP) * 2 <= BAR_LDS_OFF, "gdn_prep LDS");
    const int tid = tidx(), lane = tid & 63, wave = tid >> 6; const bf16_t* PR = WSP(bf16_t, WS_PROJ);
    for (int u = blockIdx.x; u < NUNIT; u += gridDim.x) {
        const int n = u % NCH, h = (u / NCH) % 4, b = u / (NCH * 4), t0 = n * 64;
        __syncthreads();
        for (int e = tid; e < 67 * 48; e += NTHR) { const int row = e / 48, ch = e % 48, t = t0 - 3 + row; u32x4 v = (u32x4){0u, 0u, 0u, 0u};
            if (t >= 0) v = *(const u32x4*)(PR + (size_t)(b * T + t) * NPROJ + C_CONV + (ch >> 4) * 512 + h * 128 + (ch & 15) * 8);
            *(u32x4*)(raw + row * RWP + ch * 8) = v; }
        if (tid >= 384 && tid < 448) { const int i = tid - 384; const size_t row = (size_t)(b * T + t0 + i); gs[i] = WSP(float, WS_G)[row * 4 + h]; bts[i] = WSP(float, WS_BETA)[row * 4 + h]; }
        __syncthreads();
        float y[64]; const int sec = tid < 128 ? 2 : tid < 256 ? 1 : 0, c = tid & 127;
        if (tid < 384) { const int col = sec * 512 + h * 128 + c;
            const float w0 = p.conv_w[(l * 4 + 0) * 1536 + col], w1 = p.conv_w[(l * 4 + 1) * 1536 + col], w2 = p.conv_w[(l * 4 + 2) * 1536 + col], w3 = p.conv_w[(l * 4 + 3) * 1536 + col];
            const LAS bf16_t* rp = (const LAS bf16_t*)raw + sec * 128 + c; LAUNDER_V(rp); float x0 = bf2f(rp[0]), x1 = bf2f(rp[RWP]), x2 = bf2f(rp[2 * RWP]);
#pragma unroll
            for (int i = 0; i < 64; ++i) { const float x3 = bf2f(rp[(i + 3) * RWP]); y[i] = silu_fast(w0 * x0 + w1 * x1 + w2 * x2 + w3 * x3); x0 = x1; x1 = x2; x2 = x3; if ((i & 7) == 7) COMPILER_FENCE(); } }
        if (tid >= 448) { if (tid == 448) { float a = 0.f; for (int i = 0; i < 64; ++i) { a += gs[i]; gcs[i] = a; } }
            WAVE_SYNC(); const int i = tid - 448; part[128 + i] = expf(gcs[i]); part[192 + i] = expf(gcs[63] - gcs[i]); }
#pragma unroll
        for (int pass = 0; pass < 2; ++pass) {
            if (tid >= 128 + 128 * pass && tid < 256 + 128 * pass) { LAS float* sq = (LAS float*)Ls + c; LAUNDER_V(sq);
#pragma unroll
                for (int i = 0; i < 64; ++i) sq[i * 132] = y[i] * y[i]; }
            __syncthreads();
            { const int i = tid >> 3, pt = tid & 7; const float* rp2 = Ls + i * 132 + pt * 16; float a = 0.f;
#pragma unroll
              for (int k = 0; k < 16; ++k) a += rp2[k];
              a += __shfl_xor(a, 1); a += __shfl_xor(a, 2); a += __shfl_xor(a, 4);
              if (pt == 0) part[64 * pass + i] = 1.0f / sqrtf(a + EPS); }
            __syncthreads();
        }
        if (tid >= 128 && tid < 256) { LAS bf16_t* kh = (LAS bf16_t*)Khi + c; LAS bf16_t* kl = (LAS bf16_t*)Klo + c; LAUNDER_V(kh); LAUNDER_V(kl);
#pragma unroll
            for (int i = 0; i < 64; ++i) { const float v = y[i] * part[i]; y[i] = v; const bf16_t hb = f2bf(v); kh[i * TP] = hb; kl[i * TP] = f2bf(v - bf2f(hb)); if ((i & 7) == 7) COMPILER_FENCE(); }
            bf16_t* dst = WSP(bf16_t, WS_GWK) + (size_t)u * 16384 + 8192; const int mt = c >> 4, x = c & 15;
#pragma unroll
            for (int ks2 = 0; ks2 < 2; ++ks2)
#pragma unroll
                for (int q = 0; q < 4; ++q) { const int i0 = 32 * ks2 + 4 * q; float v[8];
#pragma unroll
                    for (int e = 0; e < 8; ++e) { const int i = i0 + (e < 4 ? e : 12 + e); v[e] = y[i] * part[192 + i]; }
                    u32x4 w; w.x = pk2(v[0], v[1]); w.y = pk2(v[2], v[3]); w.z = pk2(v[4], v[5]); w.w = pk2(v[6], v[7]);
                    *(u32x4*)(dst + ((size_t)((mt * 2 + ks2) * 64 + q * 16 + x)) * 8) = w; COMPILER_FENCE(); } }
        else if (tid >= 256 && tid < 384) { bf16_t* qg = WSP(bf16_t, WS_GQ) + (size_t)u * 8192 + c; LAS bf16_t* qb = (LAS bf16_t*)Qb + c; LAUNDER_V(qb);
#pragma unroll
            for (int i = 0; i < 64; ++i) { const float v = y[i] * part[64 + i]; qb[i * TP] = f2bf(v); qg[(i & 7) * 128] = f2bf(v * 0.08838834764831845f * part[128 + i]); if ((i & 7) == 7) { qg += 8 * 128; LAUNDER_V(qg); COMPILER_FENCE(); } } }
        __syncthreads();
#pragma unroll
        for (int tp = 0; tp < 2; ++tp) { const int pos = wave * 2 + tp, it = pos >> 2, jt = pos & 3, j16 = lane & 15, qd = lane >> 4;
            f32x4 lk = (f32x4){0.f, 0.f, 0.f, 0.f}, aq = (f32x4){0.f, 0.f, 0.f, 0.f};
            if (jt <= it) {
#pragma unroll
                for (int ks = 0; ks < 4; ++ks) { const int ao = (16 * it + j16) * TP + 32 * ks + 8 * qd, bo = (16 * jt + j16) * TP + 32 * ks + 8 * qd;
                    const bf16x8 ah = *(const bf16x8*)(Khi + ao), al = *(const bf16x8*)(Klo + ao), aqf = *(const bf16x8*)(Qb + ao), bh = *(const bf16x8*)(Khi + bo), bl = *(const bf16x8*)(Klo + bo);
                    lk = MFMA16(ah, bh, lk); lk = MFMA16(ah, bl, lk); lk = MFMA16(al, bh, lk); aq = MFMA16(aqf, bh, aq); } }
            const int j = 16 * jt + j16;
#pragma unroll
            for (int e = 0; e < 4; ++e) { const int i = 16 * it + 4 * qd + e; const float ex = j <= i ? expf(gcs[i] - gcs[j]) : 0.f;
                Ls[i * 68 + j] = j < i ? bts[i] * lk[e] * ex : 0.f; As[i * 68 + j] = aq[e] * ex * 0.08838834764831845f; } }
        __syncthreads();
        if (tid < 256) {
            if (tid < 128) {
#pragma unroll
                for (int i = 0; i < 64; ++i) { y[i] *= bts[i]; if ((i & 15) == 15) COMPILER_FENCE(); } }
            else {
#pragma unroll
                for (int i = 0; i < 64; ++i) { y[i] *= bts[i] * part[128 + i]; if ((i & 15) == 15) COMPILER_FENCE(); } }
            fwd_subst<64, 68>(y, Ls);
            if (tid < 128) { bf16_t* U = WSP(bf16_t, WS_GU) + (size_t)u * 8192 + c * 64;
#pragma unroll
                for (int i8 = 0; i8 < 8; ++i8) { u32x4 w; w.x = pk2(y[8 * i8], y[8 * i8 + 1]); w.y = pk2(y[8 * i8 + 2], y[8 * i8 + 3]); w.z = pk2(y[8 * i8 + 4], y[8 * i8 + 5]); w.w = pk2(y[8 * i8 + 6], y[8 * i8 + 7]); *(u32x4*)(U + 8 * i8) = w; } }
            else { LAS bf16_t* wst = (LAS bf16_t*)raw + c; LAUNDER_V(wst);
#pragma unroll
                for (int i = 0; i < 64; ++i) wst[i * WSTP] = f2bf(-y[i]); }
        } else { const int t2 = tid - 256;
#pragma unroll 2
            for (int e = t2; e < 4096; e += 256) WSP(bf16_t, WS_GA)[(size_t)u * 4096 + e] = f2bf(As[(e >> 6) * 68 + (e & 63)]);
            if (t2 == 0) WSP(float, WS_GD)[u] = expf(gcs[63]); }
        __syncthreads();
        { bf16_t* dst = WSP(bf16_t, WS_GWK) + (size_t)u * 16384; const bf16_t* wst = raw;
#pragma unroll
          for (int k = 0; k < 2; ++k) { const int f = tid + NTHR * k, ln = f & 63, ks4 = (f >> 6) & 3, mt = f >> 8, q = ln >> 4, x = ln & 15;
              const bf16_t* wr = wst + (16 * mt + x) * WSTP + 32 * ks4 + 4 * q;
              u32x4 w; w.x = (unsigned)wr[0] | ((unsigned)wr[1] << 16); w.y = (unsigned)wr[2] | ((unsigned)wr[3] << 16); w.z = (unsigned)wr[16] | ((unsigned)wr[17] << 16); w.w = (unsigned)wr[18] | ((unsigned)wr[19] << 16);
              *(u32x4*)(dst + (size_t)f * 8) = w; } }
    }
}
constexpr int CH_SLOT = 36864, CH_NSLOT = 4;
static_assert(NCH % 4 == 0 && CH_NSLOT * CH_SLOT <= BAR_LDS_OFF, "chain ring");
__device__ __forceinline__ void chain_stage(const bf16_t* WK, const bf16_t* UTq, int m, int pw, int lane, unsigned char* smem) {
    unsigned char* slot = smem + (m % CH_NSLOT) * CH_SLOT;
#pragma unroll
    for (int k = 0; k < 6; ++k) { const int pc = pw * 6 + k;
        if (pc < 32) GLDS16((const unsigned char*)(WK + (size_t)m * 16384) + pc * 1024 + lane * 16, slot + pc * 1024);
        else GLDS16((const unsigned char*)(UTq + (size_t)m * 8192) + (pc - 32) * 1024 + lane * 16, slot + pc * 1024); }
}
__device__ __forceinline__ void ph_gdn_chain(const P& p, int l, unsigned char* smem) {
    const int tid = tidx(), lane = tid & 63, wave = UNIFORM(tid >> 6), j = lane & 15, q = lane >> 4;
    for (int it = blockIdx.x; it < CH_ITEMS; it += gridDim.x) {
        const int qt = it & 3, bh = it >> 2;
        const bf16_t* WK = WSP(bf16_t, WS_GWK) + (size_t)bh * NCH * 16384;
        const bf16_t* UTq = WSP(bf16_t, WS_GU) + (size_t)bh * NCH * 8192 + qt * 2048;
        __syncthreads();
        if (wave >= 2) {
            const int pw = wave - 2;
            chain_stage(WK, UTq, 0, pw, lane, smem); chain_stage(WK, UTq, 1, pw, lane, smem); chain_stage(WK, UTq, 2, pw, lane, smem);
#pragma unroll 1
            for (int n = 0; n < NCH; ++n) {
                if (n + 2 < NCH) WAIT_VM(12); else if (n + 1 < NCH) WAIT_VM(6); else WAIT_VM(0);
                RAW_BARRIER();
                if (n + 3 < NCH) chain_stage(WK, UTq, n + 3, pw, lane, smem);
            }
        } else {
            const int sl = qt * 2 + wave, c = 16 * sl + j;
            f32x4 S[8];
#pragma unroll
            for (int t = 0; t < 8; ++t) S[t] = (f32x4){0.f, 0.f, 0.f, 0.f};
            bf16x8 sB[4];
#pragma unroll
            for (int ks = 0; ks < 4; ++ks) sB[ks] = pack_tiles(S[2 * ks], S[2 * ks + 1]);
            const float* DC = WSP(float, WS_GD) + bh * NCH;
            float db[4];
#pragma unroll
            for (int d = 0; d < 4; ++d) db[d] = DC[d];
#pragma unroll 1
            for (int n0 = 0; n0 < NCH; n0 += 4) {
#pragma unroll
                for (int k4 = 0; k4 < 4; ++k4) {
                    const int n = n0 + k4, u = bh * NCH + n;
                    f32x4 acc[4]; const float dec = db[k4];
                    if (n + 4 < NCH) db[k4] = DC[n + 4];
                    { bf16_t* sp = WSP(bf16_t, WS_GS) + (size_t)u * 16384 + (size_t)sl * 2048 + lane * 8;
#pragma unroll
                      for (int tp = 0; tp < 4; ++tp) *(bf16x8*)(sp + 512 * tp) = sB[tp]; }
                    WAIT_LGKM0();
                    RAW_BARRIER();
                    const LAS unsigned char* slot = (const LAS unsigned char*)smem + (n % CH_NSLOT) * CH_SLOT + lane * 16; LAUNDER_V(slot);
                    { const LAS unsigned char* us = (const LAS unsigned char*)smem + (n % CH_NSLOT) * CH_SLOT + 32768 + ((16 * wave + j) * 64 + 4 * q) * 2; LAUNDER_V(us);
#pragma unroll
                      for (int mt = 0; mt < 4; ++mt) { const u32x2 w = *(const LAS u32x2*)(us + 32 * mt); acc[mt] = (f32x4){bf2f((bf16_t)(w.x & 0xffff)), bf2f((bf16_t)(w.x >> 16)), bf2f((bf16_t)(w.y & 0xffff)), bf2f((bf16_t)(w.y >> 16))}; } }
                    bf16x8 fa[8], fb[8];
#pragma unroll
                    for (int i = 0; i < 8; ++i) fa[i] = *(const LAS bf16x8*)(slot + i * 1024);
#pragma unroll
                    for (int i = 0; i < 8; ++i) fb[i] = *(const LAS bf16x8*)(slot + (8 + i) * 1024);
                    COMPILER_FENCE();
#pragma unroll
                    for (int ks = 0; ks < 4; ++ks) { acc[0] = MFMA16(fa[ks], sB[ks], acc[0]); acc[1] = MFMA16(fa[4 + ks], sB[ks], acc[1]); }
                    COMPILER_FENCE();
#pragma unroll
                    for (int i = 0; i < 8; ++i) fa[i] = *(const LAS bf16x8*)(slot + 16384 + i * 1024);
#pragma unroll
                    for (int ks = 0; ks < 4; ++ks) { acc[2] = MFMA16(fb[ks], sB[ks], acc[2]); acc[3] = MFMA16(fb[4 + ks], sB[ks], acc[3]); }
                    COMPILER_FENCE();
#pragma unroll
                    for (int i = 0; i < 8; ++i) fb[i] = *(const LAS bf16x8*)(slot + 16384 + (8 + i) * 1024);
                    const bf16x8 vB0 = pack_tiles(acc[0], acc[1]), vB1 = pack_tiles(acc[2], acc[3]);
                    { bf16_t* vp = WSP(bf16_t, WS_GV) + (size_t)u * 8192 + (size_t)sl * 1024 + lane * 8;
                      *(bf16x8*)vp = vB0; *(bf16x8*)(vp + 512) = vB1; }
#pragma unroll
                    for (int t = 0; t < 8; ++t) S[t] = S[t] * dec;
                    COMPILER_FENCE();
#pragma unroll
                    for (int t = 0; t < 4; ++t) S[t] = MFMA16(fa[2 * t], vB0, S[t]);
#pragma unroll
                    for (int t = 0; t < 4; ++t) S[t] = MFMA16(fa[2 * t + 1], vB1, S[t]);
#pragma unroll
                    for (int t = 0; t < 4; ++t) S[4 + t] = MFMA16(fb[2 * t], vB0, S[4 + t]);
#pragma unroll
                    for (int t = 0; t < 4; ++t) S[4 + t] = MFMA16(fb[2 * t + 1], vB1, S[4 + t]);
                    COMPILER_FENCE();
#pragma unroll
                    for (int ks = 0; ks < 4; ++ks) sB[ks] = pack_tiles(S[2 * ks], S[2 * ks + 1]);
                }
            }
            float* o = p.out + O_PGDN + ((size_t)l * PB * 4 + bh) * 16384 + c;
#pragma unroll
            for (int t = 0; t < 8; ++t)
#pragma unroll
                for (int e = 0; e < 4; ++e) o[(size_t)(16 * t + 4 * q + e) * 128] = S[t][e];
        }
    }
}
__device__ __forceinline__ void ph_gdn_out(const P& p, int l, unsigned char* smem) {
    const int tid = tidx(), lane = tid & 63, wave = tid >> 6, j = lane & 15, q = lane >> 4, mt = wave & 3;
    const bf16_t* PR = WSP(bf16_t, WS_PROJ);
    for (int u = blockIdx.x * 2 + (wave >> 2); u < NUNIT; u += gridDim.x * 2) {
        const int n = u % NCH, h = (u / NCH) % 4, b = u / (NCH * 4);
        f32x4 acc[8];
#pragma unroll
        for (int ct = 0; ct < 8; ++ct) acc[ct] = (f32x4){0.f, 0.f, 0.f, 0.f};
        const bf16_t* qg = WSP(bf16_t, WS_GQ) + (size_t)u * 8192 + (16 * mt + j) * 128 + 8 * q;
        const bf16_t* st = WSP(bf16_t, WS_GS) + (size_t)u * 16384 + ((2 * (q & 1)) * 16 + j) * 8 + (q >> 1) * 4;
#pragma unroll
        for (int ks = 0; ks < 4; ++ks) { const bf16x8 a = *(const bf16x8*)(qg + 32 * ks);
#pragma unroll
            for (int ct = 0; ct < 8; ++ct) { const bf16_t* sp = st + (size_t)ct * 2048 + ks * 512; const u32x2 lo = *(const u32x2*)sp, hi = *(const u32x2*)(sp + 128); u32x4 w; w.x = lo.x; w.y = lo.y; w.z = hi.x; w.w = hi.y;
                acc[ct] = MFMA16(a, __builtin_bit_cast(bf16x8, w), acc[ct]); }
            COMPILER_FENCE(); }
        const bf16_t* at = WSP(bf16_t, WS_GA) + (size_t)u * 4096 + (16 * mt + j) * 64 + 8 * q;
        const bf16_t* vt = WSP(bf16_t, WS_GV) + (size_t)u * 8192 + ((2 * (q & 1)) * 16 + j) * 8 + (q >> 1) * 4;
#pragma unroll
        for (int ks = 0; ks < 2; ++ks) { const bf16x8 a = *(const bf16x8*)(at + 32 * ks);
#pragma unroll
            for (int ct = 0; ct < 8; ++ct) { const bf16_t* vp = vt + (size_t)ct * 1024 + ks * 512; const u32x2 lo = *(const u32x2*)vp, hi = *(const u32x2*)(vp + 128); u32x4 w; w.x = lo.x; w.y = lo.y; w.z = hi.x; w.w = hi.y;
                acc[ct] = MFMA16(a, __builtin_bit_cast(bf16x8, w), acc[ct]); }
            COMPILER_FENCE(); }
        float sq[4];
#pragma unroll
        for (int e = 0; e < 4; ++e) { float s = 0.f;
#pragma unroll
            for (int ct = 0; ct < 8; ++ct) s += acc[ct][e] * acc[ct][e];
            s += __shfl_xor(s, 1); s += __shfl_xor(s, 2); s += __shfl_xor(s, 4); s += __shfl_xor(s, 8); sq[e] = 1.0f / sqrtf(s * (1.0f / 128.0f) + EPS); }
        float* stg = (float*)smem + wave * (16 * 132);
#pragma unroll
        for (int e = 0; e < 4; ++e)
#pragma unroll
            for (int ct = 0; ct < 8; ++ct) stg[(4 * q + e) * 132 + 16 * ct + j] = acc[ct][e] * sq[e];
        WAVE_SYNC();
        { const int rr = lane >> 2, cg = lane & 3; const size_t row = (size_t)(b * T + n * 64 + 16 * mt + rr);
#pragma unroll
          for (int k4 = 0; k4 < 4; ++k4) { const int c0 = cg * 32 + k4 * 8; const f32x4 o0 = *(const f32x4*)(stg + rr * 132 + c0), o1 = *(const f32x4*)(stg + rr * 132 + c0 + 4);
              float z[8]; unpack8(*(const u32x4*)(PR + row * NPROJ + C_Z + h * 128 + c0), z); const f32x4 n0 = *(const f32x4*)(p.gdn_norm + l * 128 + c0), n1 = *(const f32x4*)(p.gdn_norm + l * 128 + c0 + 4);
              float r8[8];
#pragma unroll
              for (int i = 0; i < 4; ++i) { r8[i] = o0[i] * n0[i] * silu_fast(z[i]); r8[4 + i] = o1[i] * n1[i] * silu_fast(z[4 + i]); }
              *(u32x4*)(WSP(bf16_t, WS_O) + row * D + 512 + h * 128 + c0) = pack8f(r8); } }
        WAVE_SYNC();
    }
}
__device__ __forceinline__ void ph_gdn_sample(const P& p, int l, unsigned char* smem) {
    float* qs = (float*)smem; float* ks = qs + 8 * QP; float* vs = ks + 8 * QP; float* us = vs + 8 * QP; float* wsm = us + 8 * 128; float* vn = wsm + 8 * 128;
    float* Ls = vn + 8 * 128; float* As = Ls + 8 * 8; float* gs = As + 8 * 8; float* gcs = gs + 8; float* bts = gcs + 8; float* S0 = bts + 8;
    const int tid = tidx(); const bf16_t* PR = WSP(bf16_t, WS_PROJ);
    for (int u = gridDim.x - 1 - blockIdx.x; u < DB * 4; u += gridDim.x) {
        const int h = u & 3, b = u >> 2;
        __syncthreads();
#pragma unroll 4
        for (int e = tid; e < 16384; e += NTHR) S0[e] = p.state_gdn[(((size_t)l * DB + b) * 4 + h) * 16384 + e];
        if (tid < 384) { const int sec = tid >> 7, c = tid & 127, col = sec * 512 + h * 128 + c; float* dst = sec == 0 ? qs : sec == 1 ? ks : vs;
            const float w0 = p.conv_w[(l * 4 + 0) * 1536 + col], w1 = p.conv_w[(l * 4 + 1) * 1536 + col], w2 = p.conv_w[(l * 4 + 2) * 1536 + col], w3 = p.conv_w[(l * 4 + 3) * 1536 + col];
            const float* hist = p.state_conv + (((size_t)l * DB + b) * 3) * 1536 + col; const bf16_t* src = PR + (size_t)(MP + b * DS) * NPROJ + C_CONV + col;
            float x0 = hist[0], x1 = hist[1536], x2 = hist[2 * 1536];
            for (int i = 0; i < DS; ++i) { const float x3 = bf2f(src[(size_t)i * NPROJ]); const float y = w0 * x0 + w1 * x1 + w2 * x2 + w3 * x3; dst[i * QP + c] = silu_f(y); x0 = x1; x1 = x2; x2 = x3; } }
        else if (tid < 384 + DS) { const int i = tid - 384; const size_t row = (size_t)(MP + b * DS + i); gs[i] = WSP(float, WS_G)[row * 4 + h]; bts[i] = WSP(float, WS_BETA)[row * 4 + h]; }
        __syncthreads();
        if (tid < 64) { const int rid = tid >> 2, part = tid & 3; float* rowp = (rid < 8 ? qs + rid * QP : ks + (rid - 8) * QP) + part * 32; float s = 0.f;
            for (int d = 0; d < 32; ++d) s += rowp[d] * rowp[d];
            s += __shfl_xor(s, 1); s += __shfl_xor(s, 2); const float sc = 1.0f / sqrtf(s + EPS);
            for (int d = 0; d < 32; ++d) rowp[d] *= sc; }
        if (tid == 64) { float a = 0.f; for (int i = 0; i < DS; ++i) { a += gs[i]; gcs[i] = a; } }
        __syncthreads();
        if (tid < 64) { const int i = tid >> 3, j = tid & 7; float lv = 0.f, av = 0.f;
            if (j <= i) { float dk = 0.f, dq = 0.f; for (int d = 0; d < 128; ++d) { const float kj = ks[j * QP + d]; dk += ks[i * QP + d] * kj; dq += qs[i * QP + d] * kj; }
                const float e = expf(gcs[i] - gcs[j]); av = dq * e * 0.08838834764831845f; lv = j < i ? bts[i] * dk * e : 0.f; }
            Ls[i * 8 + j] = lv; As[i * 8 + j] = av; }
        __syncthreads();
        if (tid < 256) { const int c = tid; float X[8];
            if (c < 128) {
#pragma unroll
                for (int i = 0; i < 8; ++i) X[i] = vs[i * QP + c] * bts[i]; }
            else {
#pragma unroll
                for (int i = 0; i < 8; ++i) X[i] = ks[i * QP + c - 128] * bts[i] * expf(gcs[i]); }
            fwd_subst<8, 8>(X, Ls);
            float* dst = c < 128 ? us + c : wsm + c - 128;
#pragma unroll
            for (int i = 0; i < 8; ++i) dst[i * 128] = X[i]; }
        __syncthreads();
        const int i = tid >> 6, c2 = (tid & 63) * 2;
        { float a0 = us[i * 128 + c2], a1 = us[i * 128 + c2 + 1];
          for (int d = 0; d < 128; ++d) { const float w = wsm[i * 128 + d]; a0 -= w * S0[d * 128 + c2]; a1 -= w * S0[d * 128 + c2 + 1]; }
          vn[i * 128 + c2] = a0; vn[i * 128 + c2 + 1] = a1; }
        __syncthreads();
        { float o0 = 0.f, o1 = 0.f; const float qsc = 0.08838834764831845f * expf(gcs[i]);
          for (int d = 0; d < 128; ++d) { const float qg = qs[i * QP + d] * qsc; o0 += qg * S0[d * 128 + c2]; o1 += qg * S0[d * 128 + c2 + 1]; }
          for (int j = 0; j < DS; ++j) { const float a = As[i * 8 + j]; o0 += a * vn[j * 128 + c2]; o1 += a * vn[j * 128 + c2 + 1]; }
          const float rstd = 1.0f / sqrtf(wave_sum(o0 * o0 + o1 * o1) * (1.0f / 128.0f) + EPS);
          const size_t row = (size_t)(MP + b * DS + i);
          const float z0 = bf2f(PR[row * NPROJ + C_Z + h * 128 + c2]), z1 = bf2f(PR[row * NPROJ + C_Z + h * 128 + c2 + 1]);
          bf16_t* O = WSP(bf16_t, WS_O) + row * D + 512 + h * 128 + c2;
          O[0] = f2bf(o0 * rstd * p.gdn_norm[l * 128 + c2] * silu_f(z0)); O[1] = f2bf(o1 * rstd * p.gdn_norm[l * 128 + c2 + 1] * silu_f(z1)); }
        { const float gl = gcs[DS - 1], dec = expf(gl); float* o = p.out + O_SGDN + (((size_t)l * DB + b) * 4 + h) * 16384;
#pragma unroll 2
          for (int e = tid; e < 16384; e += NTHR) { const int d = e >> 7, c = e & 127; float s = S0[e] * dec;
              for (int j = 0; j < DS; ++j) s += ks[j * QP + d] * expf(gl - gcs[j]) * vn[j * 128 + c];
              o[e] = s; } }
    }
}


template <int K> __device__ __forceinline__ void ph_gemm_small(const P& p, const bf16_t* A  , const bf16_t* Bt  , const float* gate, const float* xs_in  , unsigned char* smem) {
    static_assert(MS % 16 == 0 && K % 256 == 0, "small GEMM shape");
    constexpr int KW = K / 8, NKS = KW / 32;
    const int tid = tidx(), lane = tid & 63, wave = tid >> 6, x = lane & 15, q = lane >> 4;
    float* red = (float*)smem;
    for (int it = blockIdx.x; it < (MS / 16) * 16; it += gridDim.x) {
        const int rt = it % (MS / 16), cg = it / (MS / 16);
        const bf16_t* ap = A + (size_t)(16 * rt + x) * K + wave * KW + 8 * q;
        const bf16_t* bp = Bt + (size_t)(64 * cg + x) * K + wave * KW + 8 * q;
        f32x4 acc[4];
#pragma unroll
        for (int ct = 0; ct < 4; ++ct) acc[ct] = (f32x4){0.f, 0.f, 0.f, 0.f};
#pragma unroll
        for (int ks = 0; ks < NKS; ++ks) { const bf16x8 a = *(const bf16x8*)(ap + 32 * ks);
#pragma unroll
            for (int ct = 0; ct < 4; ++ct) acc[ct] = MFMA16(a, *(const bf16x8*)(bp + (size_t)ct * 16 * K + 32 * ks), acc[ct]); }
        __syncthreads();
#pragma unroll
        for (int ct = 0; ct < 4; ++ct) *(f32x4*)(red + ((wave * 4 + ct) * 64 + lane) * 4) = acc[ct];
        __syncthreads();
        if (wave < 4) { f32x4 s = (f32x4){0.f, 0.f, 0.f, 0.f};
#pragma unroll
            for (int w = 0; w < 8; ++w) s += *(const f32x4*)(red + ((w * 4 + wave) * 64 + lane) * 4);
            const int col = 64 * cg + 16 * wave + x;
#pragma unroll
            for (int e = 0; e < 4; ++e) { const int row = MP + 16 * rt + 4 * q + e; float* xp = p.out + (size_t)row * D + col; const float xin = xs_in ? xs_in[(size_t)(row - MP) * D + col] : *xp; *xp = xin + gate[(size_t)row_cb(row) * 6144 + col] * s[e]; } }
    }
}

__device__ __forceinline__ void ph_final_norm(const P& p) {
    const int lane = tidx() & 63, wave = tidx() >> 6, gw = blockIdx.x * 8 + wave, ngw = gridDim.x * 8;
    for (int r = gw; r < M; r += ngw) {
        float* xr = p.out + (size_t)r * D; f32x4 v[4]; float ss = 0.f;
#pragma unroll
        for (int j = 0; j < 4; ++j) { v[j] = *(const f32x4*)(xr + 4 * lane + 256 * j); ss += (v[j][0] * v[j][0] + v[j][1] * v[j][1]) + (v[j][2] * v[j][2] + v[j][3] * v[j][3]); }
        const float rstd = 1.0f / sqrtf(wave_sum(ss) * (1.0f / D) + EPS);
#pragma unroll
        for (int j = 0; j < 4; ++j) { const f32x4 g = *(const f32x4*)(p.final_norm + 4 * lane + 256 * j); *(f32x4*)(xr + 4 * lane + 256 * j) = v[j] * rstd * g; }
    }
}

enum Phase { PH_PRO = 0, PH_NORM1, PH_GEMM_IN, PH_ROPE, PH_MIX1, PH_MIX2, PH_MIX3, PH_GEMM_OUT, PH_NORM2, PH_GEMM_GU, PH_GEMM_DN, PH_FINAL };
#ifdef __HIP_EMU__
#define LDSP(x) (x)
#else
#define LDSP(x) ((PG8_LAS unsigned char*)(x))
#endif
template <int PH> __device__ __forceinline__ void run_phase(const P& p, int l, unsigned char* smem) {
    if constexpr (PH == PH_PRO) { ph_convert(p, smem, 0, CV_IN, 0); __syncthreads(); ph_adaln(p, smem, 0, 1, 0); ph_ropetab_copyx(p); }
    else if constexpr (PH == PH_NORM1) ph_norm_mod<0>(p, l);
    else if constexpr (PH == PH_GEMM_IN) {
        pg8::Gemm g{WSP(bf16_t, WS_H), WSP(bf16_t, WS_WIN) + (size_t)l * NPROJ * D, MPAD, NPROJ, D}; pg8::StaticOrder S; S.init(MPAD, NPROJ, (int)gridDim.x, (int)blockIdx.x);
        pg8::EpiStoreBf16 E{WSP(bf16_t, WS_PROJ), NPROJ};
        pg8::gemm_phase<pg8::EpiStoreBf16, pg8::StaticOrder, true, true>(LDSP(smem), g, S, E);
    }
    else if constexpr (PH == PH_ROPE) { ph_rope_out(p, l); ph_vtrans(p, l, smem); }
    else if constexpr (PH == PH_MIX1) { ph_ret_local(p, l); ph_gdn_prep(p, l, smem); }
    else if constexpr (PH == PH_MIX2) { ph_gdn_chain(p, l, smem); { const int G = (int)gridDim.x; const bool split = G >= CH_ITEMS + DB * 4 + 16; ph_attn_jobs(p, split ? CH_ITEMS : 0, split ? G - DB * 4 : G, split ? 3 : 0); }
        __syncthreads(); ph_attn_sample(p, l, smem); ph_ret_sample(p, l, smem); ph_gdn_sample(p, l, smem); ph_ret_scan(p, l);
        if (l + 1 < NL) { const int b0 = (int)gridDim.x > 2 * CH_ITEMS ? CH_ITEMS : 0; __syncthreads(); ph_convert(p, smem, l == 0 ? CV_IN : (l + 1) * CV_L, (l + 2) * CV_L, b0); __syncthreads(); ph_adaln(p, smem, l + 1, l + 2, b0); } }
    else if constexpr (PH == PH_MIX3) { ph_attn_combine(p); ph_ret_out(p, l); ph_gdn_out(p, l, smem); }
    else if constexpr (PH == PH_GEMM_OUT) {
        ph_gemm_small<D>(p, WSP(bf16_t, WS_O) + (size_t)MP * D, WSP(bf16_t, WS_WOUT) + (size_t)l * D * D, WSP(float, WS_MOD) + (size_t)l * NC * 6144 + 2048, l == 0 ? p.x_sample : nullptr, smem); __syncthreads();
        pg8::Gemm g{WSP(bf16_t, WS_O), WSP(bf16_t, WS_WOUT) + (size_t)l * D * D, MP, D, D}; pg8::StaticOrder S; S.init(MP, D, (int)gridDim.x, (int)blockIdx.x);
        pg8::EpiResidual E{p.out, WSP(float, WS_MOD) + (size_t)l * NC * 6144 + 2048, l == 0 ? p.x_prompt : p.out};
        pg8::gemm_phase<pg8::EpiResidual, pg8::StaticOrder, true, true>(LDSP(smem), g, S, E);
    }
    else if constexpr (PH == PH_NORM2) ph_norm_mod<1>(p, l);
    else if constexpr (PH == PH_GEMM_GU) {
        pg8::Gemm g{WSP(bf16_t, WS_H), WSP(bf16_t, WS_WGU) + (size_t)l * 2 * FF * D, MPAD, 2 * FF, D}; pg8::StaticOrder S; S.init(MPAD, 2 * FF, (int)gridDim.x, (int)blockIdx.x);
        pg8::EpiSwiglu E{WSP(bf16_t, WS_HID)};
        pg8::gemm_phase<pg8::EpiSwiglu, pg8::StaticOrder, true, true>(LDSP(smem), g, S, E);
    }
    else if constexpr (PH == PH_GEMM_DN) {
        ph_gemm_small<FF>(p, WSP(bf16_t, WS_HID) + (size_t)MP * FF, WSP(bf16_t, WS_WDN) + (size_t)l * D * FF, WSP(float, WS_MOD) + (size_t)l * NC * 6144 + 5120, nullptr, smem); __syncthreads();
        pg8::Gemm g{WSP(bf16_t, WS_HID), WSP(bf16_t, WS_WDN) + (size_t)l * D * FF, MP, D, FF}; pg8::StaticOrder S; S.init(MP, D, (int)gridDim.x, (int)blockIdx.x);
        pg8::EpiResidual E{p.out, WSP(float, WS_MOD) + (size_t)l * NC * 6144 + 5120, p.out};
        pg8::gemm_phase<pg8::EpiResidual, pg8::StaticOrder, true, true>(LDSP(smem), g, S, E);
    }
    else if constexpr (PH == PH_FINAL) ph_final_norm(p);
}
template <int PH> __global__ void __launch_bounds__(NTHR, 2) k_phase(P p, int l) { DYN_SMEM(smem); run_phase<PH>(p, l, smem); }


#ifndef __HIP_EMU__
#define LAS __attribute__((address_space(3)))
#define XB_TMO      128
#define XB_XCNT(j)  (256  + 64 * (j))
#define XB_XSUB(j)  (1280 + 64 * (j))
#define XB_XGEN(j)  (2304 + 64 * (j))
#define XB_TOP      3328
#define XB_TOPGEN   3392
#define XCD_BAR_WORDS 3456
#define XB_SPIN_CAP (1u << 18)

__device__ __forceinline__ unsigned xb_ld(unsigned* p)              { return __hip_atomic_load(p, __ATOMIC_RELAXED, __HIP_MEMORY_SCOPE_AGENT); }
__device__ __forceinline__ unsigned xb_add(unsigned* p, unsigned v) { return __hip_atomic_fetch_add(p, v, __ATOMIC_RELAXED, __HIP_MEMORY_SCOPE_AGENT); }
__device__ __forceinline__ unsigned xb_xcc_id() { return (unsigned)__builtin_amdgcn_s_getreg((3 << 11) | 20) & 0xFu; }
#define XB_SPIN(cond, bar) do { unsigned _sp = 0; while (cond) { __builtin_amdgcn_s_sleep(1); \
    if ((++_sp & 255u) == 0u) { if (xb_ld(&(bar)[XB_TMO])) break; if (_sp > XB_SPIN_CAP) { atomicAdd(&(bar)[XB_TMO], 1u); break; } } } } while (0)

struct XcdBarrier {
    unsigned* bar; unsigned x;
    volatile LAS unsigned* st;
};

__device__ __forceinline__ XcdBarrier xcd_barrier_post(unsigned* bar, volatile LAS unsigned* st) {
    XcdBarrier b; b.bar = bar; b.x = xb_xcc_id(); b.st = st;
    if (threadIdx.x == 0) (void)xb_add(&bar[XB_XCNT(b.x)], 1u);
    return b;
}
__device__ __forceinline__ void xcd_barrier_complete(unsigned* bar, unsigned x, unsigned& nloc, unsigned& nx) {
    const unsigned G = gridDim.x * gridDim.y * gridDim.z;
    unsigned sum, cnt, mine, sp = 0u;
    for (;;) {
        sum = 0u; cnt = 0u; mine = 0u;
#pragma unroll
        for (unsigned j = 0; j < 16; ++j) { const unsigned c = xb_ld(&bar[XB_XCNT(j)]); sum += c; cnt += (c > 0u) ? 1u : 0u; mine = (j == x) ? c : mine; }
        if (sum == G) break;
        __builtin_amdgcn_s_sleep(1);
        if ((++sp & 255u) == 0u) { if (xb_ld(&bar[XB_TMO])) break; if (sp > XB_SPIN_CAP) { atomicAdd(&bar[XB_TMO], 1u); break; } }
    }
    nloc = mine > 0u ? mine : 1u; nx = cnt > 0u ? cnt : 1u;
}

__device__ __forceinline__ void xcd_barrier(const XcdBarrier& b) {
    asm volatile("s_waitcnt vmcnt(0)" ::: "memory");
    __syncthreads();
    if (threadIdx.x == 0) {
        unsigned* bar = b.bar;
        __builtin_amdgcn_s_waitcnt(0);
        unsigned nloc = b.st[0], nx = b.st[1];
        if (nloc == 0u) { xcd_barrier_complete(bar, b.x, nloc, nx); b.st[0] = nloc; b.st[1] = nx; }
        const unsigned old = xb_add(&bar[XB_XSUB(b.x)], 1u);
        const unsigned gen = old / nloc;
        if (old + 1u == (gen + 1u) * nloc) {
            __builtin_amdgcn_fence(__ATOMIC_RELEASE, "agent");
            asm volatile("s_waitcnt vmcnt(0)" ::: "memory");
            const unsigned og = xb_add(&bar[XB_TOP], 1u);
            const unsigned tg = og / nx;
            if (og + 1u == (tg + 1u) * nx) xb_add(&bar[XB_TOPGEN], 1u);
            else XB_SPIN(xb_ld(&bar[XB_TOPGEN]) == tg, bar);
            __builtin_amdgcn_fence(__ATOMIC_ACQUIRE, "agent");
            xb_add(&bar[XB_XGEN(b.x)], 1u);
            asm volatile("s_waitcnt vmcnt(0)" ::: "memory");
        } else {
            XB_SPIN(xb_ld(&bar[XB_XGEN(b.x)]) == gen, bar);
            __builtin_amdgcn_fence(__ATOMIC_ACQUIRE, "agent");
            asm volatile("s_waitcnt vmcnt(0)" ::: "memory");
        }
    }
    __syncthreads();
}

#endif

#ifndef __HIP_EMU__
#define GRID_SYNC() xcd_barrier(bar)
__global__ void __launch_bounds__(NTHR, 2) k_mega(P p_arg) {
    DYN_SMEM(smem);
#if defined(__HIP_DEVICE_COMPILE__)
#define PHASE(PH_, l_) do { const __attribute__((address_space(4))) P* kp_ = (const __attribute__((address_space(4))) P*)__builtin_amdgcn_kernarg_segment_ptr(); LAUNDER_PTR(kp_); P pl_; __builtin_memcpy(&pl_, kp_, sizeof(P)); run_phase<PH_>(pl_, l_, smem); } while (0)
#else
#define PHASE(PH_, l_) run_phase<PH_>(p_arg, l_, smem)
#endif
    cooperative_groups::grid_group grid = cooperative_groups::this_grid();
    volatile LAS unsigned* bst = (volatile LAS unsigned*)((LAS unsigned char*)smem + BAR_LDS_OFF);
    if (threadIdx.x < 4) bst[threadIdx.x] = 0u;
    __syncthreads();
    XcdBarrier bar = xcd_barrier_post((unsigned*)(p_arg.ws + WS_CTL + 4096), bst);
    PHASE(PH_PRO, 0); grid.sync();
#define LAYER(l) do { PHASE(PH_NORM1, l); GRID_SYNC(); PHASE(PH_GEMM_IN, l); GRID_SYNC(); PHASE(PH_ROPE, l); GRID_SYNC(); PHASE(PH_MIX1, l); GRID_SYNC(); PHASE(PH_MIX2, l); GRID_SYNC(); \
        PHASE(PH_MIX3, l); GRID_SYNC(); PHASE(PH_GEMM_OUT, l); GRID_SYNC(); PHASE(PH_NORM2, l); GRID_SYNC(); PHASE(PH_GEMM_GU, l); GRID_SYNC(); PHASE(PH_GEMM_DN, l); GRID_SYNC(); } while (0)
    static_assert(NL == 2, "two layers written out (a loop over the layers makes hipcc hoist every phase's constants to the loop preheader and spill)");
    LAYER(0); LAYER(1);
    PHASE(PH_FINAL, 0);
}
#endif

template <int PH> static void launch_phase(const P& p, int l, int grid, hipStream_t stream) {
#ifndef __HIP_EMU__
    static bool attr_done = false;
    if (!attr_done) { (void)hipFuncSetAttribute((const void*)k_phase<PH>, hipFuncAttributeMaxDynamicSharedMemorySize, SMEM_BYTES); attr_done = true; }
#endif
    LAUNCH(k_phase<PH>, grid, SMEM_BYTES, stream, p, l);
}

extern "C" void kernel_launch(void* const* d_in, const int* in_sizes, int n_in, void* d_out, int out_size, void* d_ws, size_t ws_size, hipStream_t stream) {
    if (n_in != 24 || (size_t)out_size != O_END || ws_size < WS_END) {
        fprintf(stderr, "kernel_launch: shape mismatch: n_in %d out_size %d (want %zu) ws %zu (want %zu)\n", n_in, out_size, (size_t)O_END, ws_size, (size_t)WS_END); return; }
    P p{};
    const float** pp = (const float**)&p;
    for (int i = 0; i < 24; ++i) pp[i] = (const float*)d_in[i];
    p.out = (float*)d_out; p.ws = (unsigned char*)d_ws;
#ifndef __HIP_EMU__
    static int grid = 0;
    if (grid == 0) {
        int dev = 0, cus = 0, per_cu = 0;
        if (hipGetDevice(&dev) != hipSuccess || hipDeviceGetAttribute(&cus, hipDeviceAttributeMultiprocessorCount, dev) != hipSuccess || cus <= 0) { fprintf(stderr, "kernel_launch: device query failed\n"); grid = -1; return; }
        if (hipFuncSetAttribute((const void*)k_mega, hipFuncAttributeMaxDynamicSharedMemorySize, SMEM_BYTES) != hipSuccess) { fprintf(stderr, "kernel_launch: hipFuncSetAttribute failed\n"); grid = -1; return; }
        if (hipOccupancyMaxActiveBlocksPerMultiprocessor(&per_cu, (const void*)k_mega, NTHR, SMEM_BYTES) != hipSuccess || per_cu < 1) { fprintf(stderr, "kernel_launch: occupancy query says %d blocks per CU\n", per_cu); grid = -1; return; }
        grid = cus;
    }
    if (grid < 0) return;
    if (hipMemsetAsync((char*)d_ws + WS_CTL, 0, 65536, stream) != hipSuccess) { fprintf(stderr, "kernel_launch: memset of the barrier words failed\n"); return; }
    { void* args[] = {(void*)&p};
      hipError_t e = hipLaunchCooperativeKernel((const void*)k_mega, dim3(grid), dim3(NTHR), args, SMEM_BYTES, stream);
      if (e != hipSuccess) fprintf(stderr, "kernel_launch: cooperative launch failed: %s (grid %d)\n", hipGetErrorString(e), grid);
      return; }
#else
    int grid = 16;
#endif
    launch_phase<PH_PRO>(p, 0, grid, stream);
    for (int l = 0; l < NL; ++l) {
        launch_phase<PH_NORM1>(p, l, grid, stream);
        launch_phase<PH_GEMM_IN>(p, l, grid, stream);
        launch_phase<PH_ROPE>(p, l, grid, stream);
        launch_phase<PH_MIX1>(p, l, grid, stream);
        launch_phase<PH_MIX2>(p, l, grid, stream);
        launch_phase<PH_MIX3>(p, l, grid, stream);
        launch_phase<PH_GEMM_OUT>(p, l, grid, stream);
        launch_phase<PH_NORM2>(p, l, grid, stream);
        launch_phase<PH_GEMM_GU>(p, l, grid, stream);
        launch_phase<PH_GEMM_DN>(p, l, grid, stream);
    }
    launch_phase<PH_FINAL>(p, 0, grid, stream);
}
```

```cpp
#ifndef __HIP_EMU__
#include <hip/hip_runtime.h>
#include <hip/hip_cooperative_groups.h>
#endif
#include <cstdio>
#include <cstdint>
#include <cmath>

#ifndef CFG_BATCH
#define CFG_BATCH 2
#endif
#ifndef CFG_SEQ
#define CFG_SEQ 8192
#endif
#ifndef CFG_DB
#define CFG_DB 32
#endif
constexpr float LOG2E = 1.4426950408889634f;
constexpr int D = 1024, NL = 2, PB = CFG_BATCH, T = CFG_SEQ, DB = CFG_DB, DS = 8, PAST = 16384, WB = 2048;
constexpr int MP = PB * T, MS = DB * DS, M = MP + MS, MPAD = (M + 255) / 256 * 256, NC = PB + DB;
constexpr int INC = 3848, NPROJ = 3840, FF = 2816, NCH = T / 64, PWIN = T < 2048 ? T : 2048, NPOS = T + DS;
constexpr int NUNIT = PB * 4 * NCH;
constexpr float EPS = 1e-6f;
static_assert(T % 512 == 0, "the attention job decomposition wants T % 512 == 0");
constexpr int C_QA = 0, C_KA = 256, C_VA = 512, C_QR = 768, C_KR = 1024, C_VR = 1280, C_GR = 1536, C_CONV = 1792, C_Z = 3328;
constexpr int SMEM_BYTES = 148480;
constexpr int NTHR = 512;
constexpr int BAR_LDS_OFF = SMEM_BYTES - 64;

typedef unsigned short bf16_t;
typedef short bf16x8 __attribute__((ext_vector_type(8)));
typedef float f32x4 __attribute__((ext_vector_type(4)));
typedef unsigned u32x4 __attribute__((ext_vector_type(4)));
typedef unsigned u32x2 __attribute__((ext_vector_type(2)));
typedef float f32x16 __attribute__((ext_vector_type(16)));

#ifdef __HIP_EMU__
#define LAUNCH(kern, grid, lds, stream, ...) emu_launch(grid, NTHR, [=]() { kern(__VA_ARGS__); })
#define DYN_SMEM(name) unsigned char* name = emu_dyn_smem()
#define WAVE_SYNC() emu_wave_bar()
#define MFMA32(a, b, c) emu_mfma32(a, b, c)
#define GLDS16(gp, lp) memcpy((unsigned char*)(lp) + (threadIdx.x & 63) * 16, (gp), 16)
#define RAW_BARRIER() __syncthreads()
#define GLDS4(gp, lp) ((void)0)
#define WAIT_VM(n)
#define WAIT_LGKM0()
#define LAS
#define UNIFORM(x) (x)
#define COMPILER_FENCE()
#define LAUNDER_V(x)
#define MFMA16(a, b, c) emu_mfma16(a, b, c)
#else
#define WAVE_SYNC() asm volatile("s_waitcnt lgkmcnt(0)" ::: "memory")
#define MFMA32(a, b, c) __builtin_amdgcn_mfma_f32_32x32x16_bf16(a, b, c, 0, 0, 0)
#define LAS __attribute__((address_space(3)))
#define GLDS16(gp, lp) __builtin_amdgcn_global_load_lds((const unsigned*)(gp), (LAS unsigned*)(lp), 16, 0, 0)
#define RAW_BARRIER() __builtin_amdgcn_s_barrier()
#define GLDS4(gp, lp) __builtin_amdgcn_global_load_lds((const unsigned*)(gp), (LAS unsigned*)(lp), 4, 0, 0)
#define WAIT_VM(n) asm volatile("s_waitcnt vmcnt(" #n ")" ::: "memory")
#define WAIT_LGKM0() asm volatile("s_waitcnt lgkmcnt(0)" ::: "memory")
#define UNIFORM(x) __builtin_amdgcn_readfirstlane(x)
#define COMPILER_FENCE() __builtin_amdgcn_sched_barrier(0)
#define LAUNDER_V(x) asm volatile("" : "+v"(x))
#define MFMA16(a, b, c) __builtin_amdgcn_mfma_f32_16x16x32_bf16(a, b, c, 0, 0, 0)
#define LAUNCH(kern, grid, lds, stream, ...) hipLaunchKernelGGL(kern, dim3(grid), dim3(NTHR), lds, stream, __VA_ARGS__)
#define DYN_SMEM(name) extern __shared__ __attribute__((aligned(16))) unsigned char name[]
#endif

#ifdef __HIP_EMU__
__device__ __forceinline__ int tidx() { return (int)threadIdx.x; }
#define LAUNDER_PTR(x)
#else
__device__ __forceinline__ int tidx() { int t = (int)threadIdx.x; asm volatile("" : "+v"(t)); return t; }
#define LAUNDER_PTR(x) asm volatile("" : "+s"(x))
#endif
__device__ __forceinline__ float bf2f(bf16_t v) { return __builtin_bit_cast(float, (unsigned)v << 16); }
__device__ __forceinline__ bf16_t f2bf(float f) { unsigned u = __builtin_bit_cast(unsigned, f); return (bf16_t)((u + 0x7fffu + ((u >> 16) & 1u)) >> 16); }
#ifdef __HIP_EMU__
__device__ __forceinline__ unsigned pk2(float lo, float hi) { return (unsigned)f2bf(lo) | ((unsigned)f2bf(hi) << 16); }
#else
typedef float f32x2_t __attribute__((ext_vector_type(2))); typedef __bf16 bf16x2_t __attribute__((ext_vector_type(2)));
__device__ __forceinline__ unsigned pk2(float lo, float hi) { f32x2_t v = {lo, hi}; bf16x2_t b = __builtin_convertvector(v, bf16x2_t); return __builtin_bit_cast(unsigned, b); }
#endif
__device__ __forceinline__ bf16x8 pack_tiles(const f32x4& lo, const f32x4& hi) {
    u32x4 w; w.x = pk2(lo[0], lo[1]); w.y = pk2(lo[2], lo[3]); w.z = pk2(hi[0], hi[1]); w.w = pk2(hi[2], hi[3]); return __builtin_bit_cast(bf16x8, w);
}
__device__ __forceinline__ float silu_f(float x) { return x / (1.0f + expf(-x)); }
#ifdef __HIP_EMU__
__device__ __forceinline__ float silu_fast(float x) { return x / (1.0f + expf(-x)); }
#else
__device__ __forceinline__ float silu_fast(float x) { return x * __builtin_amdgcn_rcpf(1.0f + __builtin_amdgcn_exp2f(-LOG2E * x)); }
#endif
__device__ __forceinline__ float wave_sum(float v) {
#pragma unroll
    for (int o = 1; o < 64; o <<= 1) v += __shfl_xor(v, o);
    return v;
}
__device__ __forceinline__ float wave_max(float v) {
#pragma unroll
    for (int o = 1; o < 64; o <<= 1) v = fmaxf(v, __shfl_xor(v, o));
    return v;
}

struct P {
    const float *x_prompt, *x_sample, *cache_k, *cache_v, *state_ret, *state_gdn, *state_conv, *c_prompt, *c_sample, *ada_w, *ada_b, *norm_mix, *norm_ffn,
        *w_in, *ret_norm, *conv_w, *a_log, *dt_bias, *gdn_norm, *w_out, *w_gate, *w_up, *w_down, *final_norm;
    float* out; unsigned char* ws;
};

constexpr size_t O_YP = 0, O_YS = O_YP + (size_t)MP * D, O_PWK = O_YS + (size_t)MS * D, O_PWV = O_PWK + (size_t)NL * PB * PWIN * 256,
                 O_PRET = O_PWV + (size_t)NL * PB * PWIN * 256, O_PGDN = O_PRET + (size_t)NL * PB * 4 * 4096, O_PCONV = O_PGDN + (size_t)NL * PB * 4 * 16384,
                 O_SWK = O_PCONV + (size_t)NL * PB * 3 * 1536, O_SWV = O_SWK + (size_t)NL * DB * DS * 256, O_SRET = O_SWV + (size_t)NL * DB * DS * 256,
                 O_SGDN = O_SRET + (size_t)NL * DB * 4 * 4096, O_SCONV = O_SGDN + (size_t)NL * DB * 4 * 16384, O_END = O_SCONV + (size_t)NL * DB * 3 * 1536;

constexpr size_t al256(size_t x) { return (x + 255) / 256 * 256; }
constexpr size_t WS_CTL = 0, WS_CTL_BYTES = 1u << 20;
constexpr size_t WS_MOD = WS_CTL + WS_CTL_BYTES;
constexpr size_t WS_W8 = al256(WS_MOD + (size_t)NL * NC * 6144 * 4);
constexpr size_t WS_ROPE = al256(WS_W8 + (size_t)NL * D * 8 * 4);
constexpr size_t WS_WIN = al256(WS_ROPE + (size_t)4 * NPOS * 32 * 4);
constexpr size_t WS_WOUT = al256(WS_WIN + (size_t)NL * NPROJ * D * 2);
constexpr size_t WS_WGU = al256(WS_WOUT + (size_t)NL * D * D * 2);
constexpr size_t WS_WDN = al256(WS_WGU + (size_t)NL * 2 * FF * D * 2);
constexpr size_t WS_H = al256(WS_WDN + (size_t)NL * D * FF * 2);
constexpr size_t WS_PROJ = al256(WS_H + (size_t)MPAD * D * 2);
constexpr size_t WS_BETA = al256(WS_PROJ + (size_t)MPAD * NPROJ * 2);
constexpr size_t WS_G = al256(WS_BETA + (size_t)M * 4 * 4);
constexpr size_t WS_O = al256(WS_G + (size_t)M * 4 * 4);
constexpr size_t WS_RU = al256(WS_O + (size_t)MPAD * D * 2);
constexpr size_t WS_RS = al256(WS_RU + (size_t)NUNIT * 4096 * 4);
constexpr size_t WS_SCR = al256(WS_RS + (size_t)NUNIT * 4096 * 4);
constexpr size_t WS_GU = WS_SCR;
constexpr size_t WS_GWK = al256(WS_GU + (size_t)NUNIT * 8192 * 2);
constexpr size_t WS_GQ = al256(WS_GWK + (size_t)NUNIT * 16384 * 2);
constexpr size_t WS_GA = al256(WS_GQ + (size_t)NUNIT * 8192 * 2);
constexpr size_t WS_GD = al256(WS_GA + (size_t)NUNIT * 4096 * 2);
constexpr size_t WS_GV = al256(WS_GD + (size_t)NUNIT * 4);
constexpr size_t WS_GS = al256(WS_GV + (size_t)NUNIT * 8192 * 2);
constexpr size_t WS_GEND = al256(WS_GS + (size_t)NUNIT * 16384 * 2);
constexpr size_t ATT_CLS = (size_t)PB * 4 * (T / 32) * 2048;
constexpr size_t WS_KF = WS_GEND;
constexpr size_t WS_VF = al256(WS_KF + 3 * ATT_CLS * 2);
constexpr size_t WS_KRT = al256(WS_VF + 3 * ATT_CLS * 2);
constexpr size_t WS_VRT = al256(WS_KRT + (size_t)MP * 256 * 2);
constexpr size_t WS_AML = al256(WS_VRT + (size_t)MP * 256 * 2);
constexpr size_t WS_AEND = al256(WS_AML + (size_t)MP * 4 * 3 * 2 * 4);
constexpr size_t WS_APO = WS_H;
static_assert((size_t)MP * 4 * 3 * 64 * 2 <= (size_t)MPAD * D * 2, "attention partials overlay H");
constexpr size_t WS_HID = WS_SCR;
constexpr size_t WS_HEND = al256(WS_HID + (size_t)MPAD * FF * 2);
constexpr size_t WS_END = WS_AEND > WS_HEND ? WS_AEND : WS_HEND;

#define WSP(T_, off) ((T_*)(p.ws + (off)))
__device__ __forceinline__ int row_cb(int r) { return r < MP ? r / T : PB + (r - MP) / DS; }
__device__ __forceinline__ int row_pi(int r) { return r < MP ? r % T : T + (r - MP) % DS; }
namespace pg8 {
#ifdef __HIP_EMU__
#define PG8_LAS
#else
#define PG8_LAS __attribute__((address_space(3)))
#endif
typedef unsigned short bf16_t;
typedef short bf16x8 __attribute__((ext_vector_type(8)));
typedef float f32x4 __attribute__((ext_vector_type(4)));
typedef unsigned u32x4 __attribute__((ext_vector_type(4)));
constexpr int BM = 256, BK = 64, HALF = 128, HTB = HALF * BK * 2  , STAGE_BYTES = 8 * HTB, NXCD = 8, WGM = 8;

__host__ __device__ __forceinline__ int lds_byte(int r, int c) { const int st = (r >> 4) * 2 + (c >> 5), rr = r & 15, cc = c & 31, ob = rr * 64 + cc * 2; return st * 1024 + (ob ^ (((ob >> 9) & 1) << 5)); }
__host__ __device__ __forceinline__ void stage_rc(int b, int& R, int& C) { const int st = b / 1024, sb = b % 1024, swz = sb ^ (((sb >> 9) & 1) << 5); R = (st >> 1) * 16 + swz / 64; C = (st & 1) * 32 + (swz % 64) / 2; }
__host__ __device__ __forceinline__ int perm32(int rho) { const int n = rho >> 4, i = rho & 15; return 8 * (i >> 2) + 4 * n + (i & 3); }

struct Unit { int pm, pn; };
struct Gemm { const bf16_t* A; const bf16_t* Bt; int M, N, K; };

struct StaticOrder {
    int nM, nN, nwg, G, c;
    __host__ __device__ void init(int M, int N, int G_, int c_) { nM = M / BM; nN = N / BM; nwg = nM * nN; G = G_; c = c_; }
    __host__ __device__ bool next(int i, Unit& u) const {
        const long L = (long)i * G + c; if (L >= nwg) return false;
        int wgid = (int)L; { const int q = nwg / NXCD, r = nwg % NXCD, xcd = wgid % NXCD, off = wgid / NXCD; wgid = (xcd < r ? xcd * (q + 1) : r * (q + 1) + (xcd - r) * q) + off; }
        const int nig = WGM * nN, gid = wgid / nig, fm = gid * WGM, gsz = (nM - fm) < WGM ? (nM - fm) : WGM;
        u.pm = fm + ((wgid % nig) % gsz); u.pn = (wgid % nig) / gsz; return true;
    }
    __device__ __forceinline__ void a_ready(const Unit&) const {}
    __device__ __forceinline__ void done(const Unit&) const {}
};


struct EpiStoreBf16 {
    static constexpr bool PERM = true, AFTER_DRAIN = false;
    bf16_t* O; int ldc;
    __device__ __forceinline__ void operator()(const f32x4 (&acc)[2][2][4][2], const Unit& u, int wr, int wc, int fr, int fq) const {
        const int row0 = u.pm * BM + wr * 64 + fr, col0 = u.pn * BM + wc * 32 + 8 * fq;
#pragma unroll
        for (int ai = 0; ai < 2; ++ai)
#pragma unroll
            for (int m = 0; m < 4; ++m) { bf16_t* rowp = O + (size_t)(row0 + ai * HALF + m * 16) * ldc + col0;
#pragma unroll
                for (int bj = 0; bj < 2; ++bj) { const f32x4 v0 = acc[ai][bj][m][0], v1 = acc[ai][bj][m][1];
                    u32x4 w; w.x = ::pk2(v0[0], v0[1]); w.y = ::pk2(v0[2], v0[3]); w.z = ::pk2(v1[0], v1[1]); w.w = ::pk2(v1[2], v1[3]);
                    *(u32x4*)(rowp + bj * HALF) = w; } }
    }
};
struct EpiResidual {
    static constexpr bool PERM = false, AFTER_DRAIN = false;
    float* X; const float* gate; const float* Xin;
    __device__ __forceinline__ void operator()(const f32x4 (&acc)[2][2][4][2], const Unit& u, int wr, int wc, int fr, int fq) const {
        const int row0 = u.pm * BM + wr * 64 + fr, col0 = u.pn * BM + wc * 32 + 4 * fq;
#pragma unroll
        for (int ai = 0; ai < 2; ++ai)
#pragma unroll
            for (int m = 0; m < 4; ++m) { const int row = row0 + ai * HALF + m * 16;
                if (MPAD != M && row >= M) continue;
                const float* g = gate + (size_t)::row_cb(row) * 6144 + col0; float* xp = X + (size_t)row * D + col0; const float* xi = Xin + (size_t)row * D + col0;
#pragma unroll
                for (int bj = 0; bj < 2; ++bj)
#pragma unroll
                    for (int n = 0; n < 2; ++n) { const f32x4 gv = *(const f32x4*)(g + bj * HALF + n * 16); f32x4* xq = (f32x4*)(xp + bj * HALF + n * 16); *xq = *(const f32x4*)(xi + bj * HALF + n * 16) + gv * acc[ai][bj][m][n]; } }
    }
};
struct EpiSwiglu {
    static constexpr bool PERM = true, AFTER_DRAIN = false;
    bf16_t* Hd;
    __device__ __forceinline__ void operator()(const f32x4 (&acc)[2][2][4][2], const Unit& u, int wr, int wc, int fr, int fq) const {
        const int row0 = u.pm * BM + wr * 64 + fr, col0 = u.pn * HALF + wc * 32 + 8 * fq;
#pragma unroll
        for (int ai = 0; ai < 2; ++ai)
#pragma unroll
            for (int m = 0; m < 4; ++m) { bf16_t* rowp = Hd + (size_t)(row0 + ai * HALF + m * 16) * FF + col0;
                float v[8];
#pragma unroll
                for (int n = 0; n < 2; ++n)
#pragma unroll
                    for (int j = 0; j < 4; ++j) { const float gt = acc[ai][0][m][n][j], up = acc[ai][1][m][n][j]; v[4 * n + j] = ::silu_fast(gt) * up; }
                u32x4 w; w.x = ::pk2(v[0], v[1]); w.y = ::pk2(v[2], v[3]); w.z = ::pk2(v[4], v[5]); w.w = ::pk2(v[6], v[7]);
                *(u32x4*)rowp = w; }
    }
};

#ifdef __HIP_EMU__
template <class Epi, class Sched, bool ALIGN_EPI = false, bool SP2 = false>
__device__ __forceinline__ void gemm_phase(unsigned char* lds, const Gemm g, const Sched& S, const Epi& E) {
    const int tid = threadIdx.x, wid = tid >> 6, lane = tid & 63, wr = wid >> 2, wc = wid & 3, fr = lane & 15, fq = lane >> 4;
    Unit cur;
    for (int ui = 0; S.next(ui, cur); ++ui) {
        f32x4 acc[2][2][4][2];
        for (int ai = 0; ai < 2; ++ai) for (int bj = 0; bj < 2; ++bj) for (int m = 0; m < 4; ++m) for (int n = 0; n < 2; ++n) for (int j = 0; j < 4; ++j) {
            const int row = 256 * cur.pm + 128 * ai + 64 * wr + 16 * m + fr;
            const int col = Epi::PERM ? 256 * cur.pn + 128 * bj + 32 * wc + 8 * fq + 4 * n + j : 256 * cur.pn + 128 * bj + 32 * wc + 16 * n + 4 * fq + j;
            const bf16_t* a = g.A + (size_t)row * g.K; const bf16_t* b = g.Bt + (size_t)col * g.K; float s = 0.f;
            for (int k = 0; k < g.K; ++k) s += ::bf2f(a[k]) * ::bf2f(b[k]);
            acc[ai][bj][m][n][j] = s; }
        E(acc, cur, wr, wc, fr, fq);
    }
}
#else
template <class Epi, class Sched, bool ALIGN_EPI = false, bool SP2 = false>
__device__ __forceinline__ void gemm_phase(PG8_LAS unsigned char* lds, const Gemm g, const Sched& S, const Epi& E) {
    const int tid = ::tidx(), wid = __builtin_amdgcn_readfirstlane(tid >> 6), lane = tid & 63, wr = wid >> 2, wc = wid & 3, fr = lane & 15, fq = lane >> 4;
    const int K = g.K, nt = K / BK;
    unsigned voffA[2], voffB[2];
#pragma unroll
    for (int i = 0; i < 2; ++i) { int R, C; stage_rc(tid * 16 + i * 8192, R, C); const int Rb = Epi::PERM ? ((R & ~31) + perm32(R & 31)) : R;
        voffA[i] = (unsigned)(R * K + C) * 2u; voffB[i] = (unsigned)(Rb * K + C) * 2u; }
    const size_t kstep = (size_t)(BK * 2);
    const size_t hstep = (size_t)HALF * K * 2;
    const size_t tstep = 2 * hstep;
    const unsigned ldsw = (unsigned)wid * 1024u;
    const int aoff = lds_byte(wr * 64 + fr, fq * 8), boff = lds_byte(wc * 32 + fr, fq * 8);
#define PG8_SA(b, h) (((b) * 2 + (h)) * HTB)
#define PG8_SB(b, h) ((4 + (b) * 2 + (h)) * HTB)
#define PG8_STAGE(bufoff, gbase, voff) do { _Pragma("unroll") for (int _i = 0; _i < 2; ++_i) \
        __builtin_amdgcn_global_load_lds((const unsigned*)((const char*)(gbase) + (voff)[_i]), (PG8_LAS unsigned*)(lds + (bufoff) + ldsw + _i * 8192), 16, 0, 0); } while (0)
#define PG8_LDA(dst, b, h) do { _Pragma("unroll") for (int m = 0; m < 4; ++m) _Pragma("unroll") for (int k = 0; k < 2; ++k) dst[m][k] = *(const PG8_LAS bf16x8*)(lds + PG8_SA(b, h) + aoff + m * 2048 + k * 1024); } while (0)
#define PG8_LDB(dst, b, h) do { _Pragma("unroll") for (int n = 0; n < 2; ++n) _Pragma("unroll") for (int k = 0; k < 2; ++k) dst[n][k] = *(const PG8_LAS bf16x8*)(lds + PG8_SB(b, h) + boff + n * 2048 + k * 1024); } while (0)
#define PG8_MMA(ai, bj, At, Bt) do { __builtin_amdgcn_s_setprio(1); _Pragma("unroll") for (int m = 0; m < 4; ++m) _Pragma("unroll") for (int n = 0; n < 2; ++n) _Pragma("unroll") for (int k = 0; k < 2; ++k) \
        acc[ai][bj][m][n] = __builtin_amdgcn_mfma_f32_16x16x32_bf16(Bt[n][k], At[m][k], acc[ai][bj][m][n], 0, 0, 0); __builtin_amdgcn_s_setprio(0); } while (0)
#define PG8_WAIT_V(n) asm volatile("s_waitcnt vmcnt(" #n ")" ::: "memory")
#define PG8_WAIT_L(n) asm volatile("s_waitcnt lgkmcnt(" #n ")" ::: "memory")
#define PG8_BAR __builtin_amdgcn_s_barrier()
#define PG8_SCHED __builtin_amdgcn_sched_barrier(0)
    Unit cur, nxt; int ui = 0;
    if (!S.next(0, cur)) return;
    f32x4 acc[2][2][4][2];
#pragma unroll
    for (int a = 0; a < 2; ++a)
#pragma unroll
        for (int b = 0; b < 2; ++b)
#pragma unroll
            for (int m = 0; m < 4; ++m)
#pragma unroll
                for (int n = 0; n < 2; ++n) acc[a][b][m][n] = (f32x4){0.f, 0.f, 0.f, 0.f};
    bf16x8 At[4][2], B0[2][2], B1[2][2];
    const char* cA = (const char*)g.A + (size_t)cur.pm * tstep; const char* cB = (const char*)g.Bt + (size_t)cur.pn * tstep;
    S.a_ready(cur);
    if constexpr (SP2) {
        PG8_STAGE(PG8_SB(0, 0), cB, voffB); PG8_STAGE(PG8_SB(0, 1), cB + hstep, voffB); PG8_STAGE(PG8_SA(0, 0), cA, voffA); PG8_STAGE(PG8_SA(0, 1), cA + hstep, voffA);
        if (wr == 1) PG8_BAR;
        PG8_WAIT_V(2); PG8_BAR;
        PG8_STAGE(PG8_SB(1, 0), cB + kstep, voffB); PG8_STAGE(PG8_SA(1, 0), cA + kstep, voffA); PG8_STAGE(PG8_SB(1, 1), cB + hstep + kstep, voffB);
        PG8_WAIT_V(6); PG8_BAR;
    } else {
        PG8_STAGE(PG8_SB(0, 0), cB, voffB); PG8_STAGE(PG8_SA(0, 0), cA, voffA); PG8_STAGE(PG8_SB(0, 1), cB + hstep, voffB); PG8_STAGE(PG8_SA(0, 1), cA + hstep, voffA);
        if (wr == 1) PG8_BAR;
        PG8_WAIT_V(4); PG8_BAR;
        PG8_STAGE(PG8_SB(1, 0), cB + kstep, voffB); PG8_STAGE(PG8_SA(1, 0), cA + kstep, voffA); PG8_STAGE(PG8_SB(1, 1), cB + hstep + kstep, voffB);
        PG8_WAIT_V(6); PG8_BAR;
    }
    for (;;) {
        const bool has_next = S.next(ui + 1, nxt);
        const char* nA = has_next ? (const char*)g.A + (size_t)nxt.pm * tstep : cA; const char* nB = has_next ? (const char*)g.Bt + (size_t)nxt.pn * tstep : cB;
        for (int t = 0; t < nt; t += 2) {
            const bool last = (t == nt - 2);
            const char* a1 = cA + (size_t)(t + 1) * kstep;
            const char* a2 = last ? nA : cA + (size_t)(t + 2) * kstep; const char* b2 = last ? nB : cB + (size_t)(t + 2) * kstep;
            const char* a3 = a2 + kstep; const char* b3 = b2 + kstep;
            if (last && has_next) S.a_ready(nxt);
            if constexpr (SP2) {
            PG8_LDB(B0, 0, 0); PG8_LDB(B1, 0, 1); PG8_SCHED; PG8_LDA(At, 0, 0); PG8_STAGE(PG8_SA(1, 1), a1 + hstep, voffA);
            PG8_WAIT_V(8); PG8_WAIT_L(0); PG8_BAR; PG8_MMA(0, 0, At, B0); PG8_MMA(0, 1, At, B1); PG8_BAR; PG8_SCHED;
            PG8_LDA(At, 0, 1); PG8_STAGE(PG8_SB(0, 0), b2, voffB); PG8_STAGE(PG8_SB(0, 1), b2 + hstep, voffB); PG8_STAGE(PG8_SA(0, 0), a2, voffA);
            PG8_WAIT_V(8); PG8_WAIT_L(0); PG8_BAR; PG8_MMA(1, 0, At, B0); PG8_MMA(1, 1, At, B1); PG8_BAR; PG8_SCHED;
            PG8_LDB(B0, 1, 0); PG8_LDB(B1, 1, 1); PG8_SCHED; PG8_LDA(At, 1, 0); PG8_STAGE(PG8_SA(0, 1), a2 + hstep, voffA);
            PG8_WAIT_V(8); PG8_WAIT_L(0); PG8_BAR; PG8_MMA(0, 0, At, B0); PG8_MMA(0, 1, At, B1); PG8_BAR; PG8_SCHED;
            PG8_LDA(At, 1, 1); PG8_STAGE(PG8_SB(1, 0), b3, voffB); PG8_STAGE(PG8_SB(1, 1), b3 + hstep, voffB); PG8_STAGE(PG8_SA(1, 0), a3, voffA);
            PG8_WAIT_V(8); PG8_WAIT_L(0); PG8_BAR; PG8_MMA(1, 0, At, B0); PG8_MMA(1, 1, At, B1); PG8_BAR; PG8_SCHED;
            } else {
            PG8_LDB(B0, 0, 0); PG8_SCHED; PG8_LDA(At, 0, 0); PG8_STAGE(PG8_SA(1, 1), a1 + hstep, voffA);
            PG8_WAIT_L(8); PG8_BAR; PG8_WAIT_L(0); PG8_MMA(0, 0, At, B0); PG8_BAR; PG8_SCHED;
            PG8_LDB(B1, 0, 1); PG8_STAGE(PG8_SB(0, 0), b2, voffB);
            PG8_BAR; PG8_WAIT_L(0); PG8_MMA(0, 1, At, B1); PG8_BAR;
            PG8_LDA(At, 0, 1); PG8_STAGE(PG8_SA(0, 0), a2, voffA);
            PG8_BAR; PG8_WAIT_L(0); PG8_MMA(1, 0, At, B0); PG8_BAR; PG8_SCHED;
            PG8_STAGE(PG8_SB(0, 1), b2 + hstep, voffB);
            PG8_WAIT_V(6); PG8_BAR; PG8_MMA(1, 1, At, B1); PG8_BAR;
            PG8_LDB(B0, 1, 0); PG8_SCHED; PG8_LDA(At, 1, 0); PG8_STAGE(PG8_SA(0, 1), a2 + hstep, voffA);
            PG8_WAIT_L(8); PG8_BAR; PG8_WAIT_L(0); PG8_MMA(0, 0, At, B0); PG8_BAR; PG8_SCHED;
            PG8_LDB(B1, 1, 1); PG8_STAGE(PG8_SB(1, 0), b3, voffB);
            PG8_BAR; PG8_WAIT_L(0); PG8_MMA(0, 1, At, B1); PG8_BAR;
            PG8_LDA(At, 1, 1); PG8_STAGE(PG8_SA(1, 0), a3, voffA);
            PG8_BAR; PG8_WAIT_L(0); PG8_MMA(1, 0, At, B0); PG8_BAR; PG8_SCHED;
            PG8_STAGE(PG8_SB(1, 1), b3 + hstep, voffB);
            PG8_WAIT_V(6); PG8_BAR; PG8_MMA(1, 1, At, B1); PG8_BAR;
            }
        }
        if constexpr (ALIGN_EPI) { if (wr == 0) PG8_BAR; }
        if constexpr (!Epi::AFTER_DRAIN) { E(acc, cur, wr, wc, fr, fq); S.done(cur); }
        if (!has_next) break;
#pragma unroll
        for (int a = 0; a < 2; ++a)
#pragma unroll
            for (int b = 0; b < 2; ++b)
#pragma unroll
                for (int m = 0; m < 4; ++m)
#pragma unroll
                    for (int n = 0; n < 2; ++n) acc[a][b][m][n] = (f32x4){0.f, 0.f, 0.f, 0.f};
        cur = nxt; cA = nA; cB = nB; ++ui;
        if constexpr (ALIGN_EPI) { if (wr == 1) PG8_BAR; }
    }
    PG8_WAIT_V(0);
    if constexpr (!ALIGN_EPI) { if (wr == 0) PG8_BAR; }
    PG8_BAR;
    if constexpr (Epi::AFTER_DRAIN) { E.fused(acc, cur, wr, wc, fr, fq, lds, wid, lane); S.done(cur); }
#undef PG8_SA
#undef PG8_SB
#undef PG8_STAGE
#undef PG8_LDA
#undef PG8_LDB
#undef PG8_MMA
#undef PG8_WAIT_V
#undef PG8_WAIT_L
#undef PG8_BAR
#undef PG8_SCHED
}
#endif
}


__device__ __forceinline__ void transpose_item(const float* W, int ldw, bf16_t* WT, int K, int k0, int n0, int drow0, float* scr, int lane) {
    float wv[32];
#pragma unroll
    for (int i = 0; i < 32; ++i) wv[i] = W[(size_t)(k0 + 2 * i + (lane >> 5)) * ldw + n0 + (lane & 31)];
#pragma unroll
    for (int i = 0; i < 32; ++i) scr[(2 * i + (lane >> 5)) * 33 + (lane & 31)] = wv[i];
    WAVE_SYNC();
    const int c = lane & 7;
#pragma unroll
    for (int j = 0; j < 4; ++j) { const int n = (lane >> 3) + 8 * j; const float* s = scr + (8 * c) * 33 + n;
        u32x4 o; o.x = pk2(s[0 * 33], s[1 * 33]); o.y = pk2(s[2 * 33], s[3 * 33]); o.z = pk2(s[4 * 33], s[5 * 33]); o.w = pk2(s[6 * 33], s[7 * 33]);
        *(u32x4*)(WT + (size_t)(drow0 + n) * K + k0 + 8 * c) = o; }
    WAVE_SYNC();
}
constexpr int CV_IN = 16 * 120, CV_OUT = 16 * 32, CV_G = 16 * 88, CV_DN = 44 * 32, CV_L = CV_IN + CV_OUT + 2 * CV_G + CV_DN;
__device__ __forceinline__ void ph_convert(const P& p, unsigned char* smem, int i0, int i1, int b0, int b1) {
    if ((int)blockIdx.x < b0 || (int)blockIdx.x >= b1) return;
    const int lane = tidx() & 63, wave = tidx() >> 6;
    float* scr = (float*)smem + wave * (64 * 33 + 32);
    constexpr int I_IN = CV_IN, I_OUT = CV_OUT, I_G = CV_G, I_L = CV_L;
    const int gw = ((int)blockIdx.x - b0) * 8 + wave, ngw = (b1 - b0) * 8;
    for (int it = i0 + gw; it < i1; it += ngw) {
        const int l = it / I_L; int r = it % I_L;
        if (r < I_IN) { const int kb = r / 120, nb = r % 120; transpose_item(p.w_in + (size_t)l * D * INC, INC, WSP(bf16_t, WS_WIN) + (size_t)l * NPROJ * D, D, kb * 64, nb * 32, nb * 32, scr, lane); continue; }
        r -= I_IN;
        if (r < I_OUT) { const int kb = r / 32, nb = r % 32; transpose_item(p.w_out + (size_t)l * D * D, D, WSP(bf16_t, WS_WOUT) + (size_t)l * D * D, D, kb * 64, nb * 32, nb * 32, scr, lane); continue; }
        r -= I_OUT;
        if (r < 2 * I_G) { const int up = r / I_G; r %= I_G; const int kb = r / 88, nb = r % 88, n0 = nb * 32;
            transpose_item((up ? p.w_up : p.w_gate) + (size_t)l * D * FF, FF, WSP(bf16_t, WS_WGU) + (size_t)l * 2 * FF * D, D, kb * 64, n0, (n0 / 128) * 256 + up * 128 + (n0 % 128), scr, lane); continue; }
        r -= 2 * I_G;
        { const int kb = r / 32, nb = r % 32; transpose_item(p.w_down + (size_t)l * FF * D, D, WSP(bf16_t, WS_WDN) + (size_t)l * D * FF, FF, kb * 64, nb * 32, nb * 32, scr, lane); }
    }
}

__device__ __forceinline__ void ph_adaln(const P& p, unsigned char* smem, int l0, int l1, int b0, int b1) {
    if ((int)blockIdx.x < b0 || (int)blockIdx.x >= b1) return;
    float* sc = (float*)smem;
    float* red = sc + NC * 256;
    const int tid = tidx(), col = tid & 31, kg = tid >> 5;
    float* MOD = WSP(float, WS_MOD);
    for (int it = l0 * 192 + (int)blockIdx.x - b0; it < l1 * 192; it += b1 - b0) {
        const int l = it / 192, cb0 = (it % 192) * 32;
        float acc[NC];
#pragma unroll
        for (int r = 0; r < NC; ++r) acc[r] = 0.f;
        for (int kc = 0; kc < 4; ++kc) {
            __syncthreads();
            for (int e = tid; e < NC * 256; e += NTHR) { const int r = e >> 8, k = e & 255; const float c = r < PB ? p.c_prompt[r * D + kc * 256 + k] : p.c_sample[(r - PB) * D + kc * 256 + k]; sc[e] = silu_f(c); }
            __syncthreads();
            for (int kk = 0; kk < 16; ++kk) { const int k = kg * 16 + kk; const float w = p.ada_w[((size_t)l * D + kc * 256 + k) * 6144 + cb0 + col];
#pragma unroll
                for (int r = 0; r < NC; ++r) acc[r] += sc[r * 256 + k] * w; }
        }
#pragma unroll
        for (int r = 0; r < NC; ++r) red[(kg * NC + r) * 32 + col] = acc[r];
        __syncthreads();
        for (int e = tid; e < NC * 32; e += NTHR) { const int r = e >> 5, c = e & 31; float s = p.ada_b[l * 6144 + cb0 + c];
            for (int g = 0; g < 16; ++g) s += red[(g * NC + r) * 32 + c];
            MOD[((size_t)l * NC + r) * 6144 + cb0 + c] = s; }
        __syncthreads();
    }
}

__device__ __forceinline__ void ph_ropetab_copyx(const P& p) {
    const size_t gt = (size_t)blockIdx.x * NTHR + tidx(), ng = (size_t)gridDim.x * NTHR;
    float* tab = WSP(float, WS_ROPE);
    for (size_t e = gt; e < (size_t)NL * D * 8; e += ng) { const size_t lk = e >> 3; const int c = (int)(e & 7); WSP(float, WS_W8)[((lk >> 10) * 8 + c) * D + (lk & 1023)] = p.w_in[lk * INC + NPROJ + c]; }
    for (size_t e = gt; e < (size_t)NPOS * 32; e += ng) {
        const int pi = (int)(e >> 5), i = (int)(e & 31); const double pos = pi < T ? (double)pi : (double)(PAST + pi - T);
        const double ia = exp(-log(10000.0) * (double)i / 32.0), ir = exp(-log(10000.0) * (double)i / 31.0);
        tab[e] = (float)cos(pos * ia); tab[(size_t)NPOS * 32 + e] = (float)sin(pos * ia);
        tab[(size_t)2 * NPOS * 32 + e] = (float)cos(pos * ir); tab[(size_t)3 * NPOS * 32 + e] = (float)sin(pos * ir);
    }
}

template <int WHICH> __device__ __forceinline__ void ph_norm_mod(const P& p, int l) {
    const int lane = tidx() & 63, wave = tidx() >> 6, gw = blockIdx.x * 8 + wave, ngw = gridDim.x * 8;
    const float* nw = (WHICH == 0 ? p.norm_mix : p.norm_ffn) + l * D;
    bf16_t* H = WSP(bf16_t, WS_H);
    for (int r = gw; r < M; r += ngw) {
        const float* xr = (WHICH == 0 && l == 0) ? (r < MP ? p.x_prompt + (size_t)r * D : p.x_sample + (size_t)(r - MP) * D) : p.out + (size_t)r * D;
        const float* mod = WSP(float, WS_MOD) + ((size_t)l * NC + row_cb(r)) * 6144 + (WHICH == 0 ? 0 : 3072);
        f32x4 v[4]; float ss = 0.f;
#pragma unroll
        for (int j = 0; j < 4; ++j) { v[j] = *(const f32x4*)(xr + 4 * lane + 256 * j); ss += (v[j][0] * v[j][0] + v[j][1] * v[j][1]) + (v[j][2] * v[j][2] + v[j][3] * v[j][3]); }
        const float rstd = 1.0f / sqrtf(wave_sum(ss) * (1.0f / D) + EPS);
        float a8[8];
#pragma unroll
        for (int c = 0; c < 8; ++c) a8[c] = 0.f;
#pragma unroll
        for (int j = 0; j < 4; ++j) { const int k = 4 * lane + 256 * j;
            const f32x4 g = *(const f32x4*)(nw + k), sh = *(const f32x4*)(mod + k), sc = *(const f32x4*)(mod + 1024 + k);
            f32x4 h;
#pragma unroll
            for (int e = 0; e < 4; ++e) h[e] = v[j][e] * rstd * g[e] * (1.0f + sc[e]) + sh[e];
            u32x2 w; w.x = pk2(h[0], h[1]); w.y = pk2(h[2], h[3]); *(u32x2*)(H + (size_t)r * D + k) = w;
            if (WHICH == 0) {
#pragma unroll
                for (int c = 0; c < 8; ++c) { const f32x4 wv = *(const f32x4*)(WSP(float, WS_W8) + ((size_t)l * 8 + c) * D + k); a8[c] += (h[0] * wv[0] + h[1] * wv[1]) + (h[2] * wv[2] + h[3] * wv[3]); }
            }
        }
        if (WHICH == 0) {
            float b4[4];
#pragma unroll
            for (int c = 0; c < 4; ++c) { const float keep = lane < 32 ? a8[c] : a8[4 + c], send = lane < 32 ? a8[4 + c] : a8[c]; b4[c] = keep + __shfl_xor(send, 32); }
            float b2[2];
#pragma unroll
            for (int c = 0; c < 2; ++c) { const bool lo = (lane & 16) == 0; const float keep = lo ? b4[c] : b4[2 + c], send = lo ? b4[2 + c] : b4[c]; b2[c] = keep + __shfl_xor(send, 16); }
            float b1; { const bool lo = (lane & 8) == 0; const float keep = lo ? b2[0] : b2[1], send = lo ? b2[1] : b2[0]; b1 = keep + __shfl_xor(send, 8); }
            b1 += __shfl_xor(b1, 4); b1 += __shfl_xor(b1, 2); b1 += __shfl_xor(b1, 1);
            if ((lane & 7) == 0) { const int c = (lane >> 5) * 4 + ((lane >> 4) & 1) * 2 + ((lane >> 3) & 1);
                if (c < 4) WSP(float, WS_BETA)[(size_t)r * 4 + c] = 1.0f / (1.0f + expf(-b1));
                else { const int hh = c - 4; const float xx = b1 + p.dt_bias[l * 4 + hh]; const float sp = xx > 20.f ? xx : log1pf(expf(xx)); WSP(float, WS_G)[(size_t)r * 4 + hh] = -expf(p.a_log[l * 4 + hh]) * sp; } }
        }
    }
}

__device__ __forceinline__ void unpack8(const u32x4 w, float (&f)[8]) {
    f[0] = __builtin_bit_cast(float, w.x << 16); f[1] = __builtin_bit_cast(float, w.x & 0xffff0000u); f[2] = __builtin_bit_cast(float, w.y << 16); f[3] = __builtin_bit_cast(float, w.y & 0xffff0000u);
    f[4] = __builtin_bit_cast(float, w.z << 16); f[5] = __builtin_bit_cast(float, w.z & 0xffff0000u); f[6] = __builtin_bit_cast(float, w.w << 16); f[7] = __builtin_bit_cast(float, w.w & 0xffff0000u);
}
__device__ __forceinline__ u32x4 pack8f(const float (&f)[8]) { u32x4 w; w.x = pk2(f[0], f[1]); w.y = pk2(f[2], f[3]); w.z = pk2(f[4], f[5]); w.w = pk2(f[6], f[7]); return w; }
__device__ __forceinline__ void ph_rope_out(const P& p, int l) {
    const size_t gt = (size_t)blockIdx.x * NTHR + tidx(), ng = (size_t)gridDim.x * NTHR;
    bf16_t* PR = WSP(bf16_t, WS_PROJ); const float* tab = WSP(float, WS_ROPE);
    for (size_t e = gt; e < (size_t)MS * 64; e += ng) {
        const int r = MP + (int)(e >> 6), rem = (int)(e & 63), sec = rem >> 4, hh = (rem >> 2) & 3, d = (rem & 3) * 8;
        const int off = sec == 0 ? C_QA : sec == 1 ? C_KA : sec == 2 ? C_QR : C_KR; const float scale = sec == 0 ? 0.125f * LOG2E : sec == 3 ? 0.125f : 1.0f;
        const float* ct = tab + (size_t)(sec >= 2 ? 2 : 0) * NPOS * 32 + (size_t)row_pi(r) * 32 + d; const float* st = ct + (size_t)NPOS * 32;
        const f32x4 c0 = *(const f32x4*)ct, c1 = *(const f32x4*)(ct + 4), s0 = *(const f32x4*)st, s1 = *(const f32x4*)(st + 4);
        bf16_t* x = PR + (size_t)r * NPROJ + off + hh * 64 + d; float x1[8], x2[8], o1[8], o2[8];
        unpack8(*(const u32x4*)x, x1); unpack8(*(const u32x4*)(x + 32), x2);
#pragma unroll
        for (int k = 0; k < 8; ++k) { const float c = k < 4 ? c0[k & 3] : c1[k & 3], sn = k < 4 ? s0[k & 3] : s1[k & 3]; o1[k] = (x1[k] * c - x2[k] * sn) * scale; o2[k] = (x1[k] * sn + x2[k] * c) * scale; }
        *(u32x4*)x = pack8f(o1); *(u32x4*)(x + 32) = pack8f(o2);
        if (sec == 1) { const int b = (r - MP) / DS, i = (r - MP) % DS; float* o = p.out + O_SWK + (((size_t)l * DB + b) * DS + i) * 256 + hh * 64 + d;
            *(f32x4*)o = (f32x4){o1[0], o1[1], o1[2], o1[3]}; *(f32x4*)(o + 4) = (f32x4){o1[4], o1[5], o1[6], o1[7]}; *(f32x4*)(o + 32) = (f32x4){o2[0], o2[1], o2[2], o2[3]}; *(f32x4*)(o + 36) = (f32x4){o2[4], o2[5], o2[6], o2[7]}; }
    }
    for (size_t e = gt; e < (size_t)MS * 32; e += ng) {
        const int r = MP + (int)(e >> 5), c = (int)(e & 31) * 8; const int b = (r - MP) / DS, i = (r - MP) % DS; float* o = p.out + O_SWV + (((size_t)l * DB + b) * DS + i) * 256 + c;
        float v[8]; unpack8(*(const u32x4*)(PR + (size_t)r * NPROJ + C_VA + c), v); *(f32x4*)o = (f32x4){v[0], v[1], v[2], v[3]}; *(f32x4*)(o + 4) = (f32x4){v[4], v[5], v[6], v[7]};
    }
    for (size_t e = gt; e < (size_t)(PB + DB) * 3 * 1536; e += ng) {
        const int c = (int)(e % 1536), j = (int)((e / 1536) % 3), bb = (int)(e / (3 * 1536));
        if (bb < PB) p.out[O_PCONV + (((size_t)l * PB + bb) * 3 + j) * 1536 + c] = bf2f(PR[(size_t)(bb * T + T - 3 + j) * NPROJ + C_CONV + c]);
        else { const int b = bb - PB; p.out[O_SCONV + (((size_t)l * DB + b) * 3 + j) * 1536 + c] = bf2f(PR[(size_t)(MP + b * DS + DS - 3 + j) * NPROJ + C_CONV + c]); }
    }
}

__device__ __forceinline__ void attn_wave_sample(const P& p, int l, int r, int h, int lane, float* sw  ) {
    const bf16_t* PR = WSP(bf16_t, WS_PROJ);
    const int b = (r - MP) / DS; const int tq = WB + (r - MP) % DS;
    const int kg = lane >> 4, dq = lane & 15;
    f32x4 q4; { const u32x2 w = *(const u32x2*)(PR + (size_t)r * NPROJ + C_QA + h * 64 + 4 * dq); q4 = (f32x4){bf2f((bf16_t)(w.x & 0xffff)), bf2f((bf16_t)(w.x >> 16)), bf2f((bf16_t)(w.y & 0xffff)), bf2f((bf16_t)(w.y >> 16))}; }
    float mx = -INFINITY;
#pragma unroll 8
    for (int e = kg; e < 388; e += 4) {
        const int ee = e < 387 ? e : 386; const int pat = ee / 129, j = ee % 129, dil = pat == 0 ? 1 : pat == 1 ? 4 : 16; const int rr = tq - dil * j;
        f32x4 kv;
        if (rr < WB) kv = *(const f32x4*)(p.cache_k + ((((size_t)l * DB + b) * WB + rr) * 4 + h) * 64 + 4 * dq);
        else { const u32x2 w = *(const u32x2*)(PR + (size_t)(MP + b * DS + (rr - WB)) * NPROJ + C_KA + h * 64 + 4 * dq);
            kv = (f32x4){bf2f((bf16_t)(w.x & 0xffff)), bf2f((bf16_t)(w.x >> 16)), bf2f((bf16_t)(w.y & 0xffff)), bf2f((bf16_t)(w.y >> 16))}; }
        float a = (q4[0] * kv[0] + q4[1] * kv[1]) + (q4[2] * kv[2] + q4[3] * kv[3]);
        a += __shfl_xor(a, 1); a += __shfl_xor(a, 2); a += __shfl_xor(a, 4); a += __shfl_xor(a, 8);
        if (e < 387) { if (dq == 0) sw[e] = a; mx = fmaxf(mx, a); }
    }
    WAVE_SYNC();
    mx = wave_max(mx);
    float lsum = 0.f;
#pragma unroll 1
    for (int i = 0; i < 7; ++i) { const int e = lane + 64 * i; if (e < 387) { const float pe = exp2f(sw[e] - mx); sw[e] = pe; lsum += pe; } }
    lsum = wave_sum(lsum);
    WAVE_SYNC();
    f32x4 o4 = (f32x4){0.f, 0.f, 0.f, 0.f};
#pragma unroll 16
    for (int e = kg; e < 387; e += 4) {
        const float pe = sw[e];
        const int pat = e / 129, j = e % 129, dil = pat == 0 ? 1 : pat == 1 ? 4 : 16; const int rr = tq - dil * j;
        f32x4 v;
        if (rr < WB) v = *(const f32x4*)(p.cache_v + ((((size_t)l * DB + b) * WB + rr) * 4 + h) * 64 + 4 * dq);
        else { const u32x2 w = *(const u32x2*)(PR + (size_t)(MP + b * DS + (rr - WB)) * NPROJ + C_VA + h * 64 + 4 * dq);
            v = (f32x4){bf2f((bf16_t)(w.x & 0xffff)), bf2f((bf16_t)(w.x >> 16)), bf2f((bf16_t)(w.y & 0xffff)), bf2f((bf16_t)(w.y >> 16))}; }
        o4 += pe * v;
    }
#pragma unroll
    for (int e = 0; e < 4; ++e) { float x = o4[e]; x += __shfl_xor(x, 16); x += __shfl_xor(x, 32); o4[e] = x; }
    WAVE_SYNC();
    if (kg == 0) { const float inv = 1.0f / lsum; u32x2 w; w.x = pk2(o4[0] * inv, o4[1] * inv); w.y = pk2(o4[2] * inv, o4[3] * inv);
        *(u32x2*)(WSP(bf16_t, WS_O) + (size_t)r * D + h * 64 + 4 * dq) = w; }
}
__device__ __forceinline__ void ph_attn_sample(const P& p, int l, unsigned char* smem) {
    const int lane = tidx() & 63, wave = tidx() >> 6, gw = (gridDim.x - 1 - blockIdx.x) * 8 + wave, ngw = gridDim.x * 8;
    float* sw = (float*)smem + wave * 392;
    for (int it = gw; it < MS * 4; it += ngw) attn_wave_sample(p, l, MP + (it >> 2), it & 3, lane, sw);
}
__device__ __forceinline__ bf16x8 pack8(const f32x16& v, int s8) {
    u32x4 w; w.x = pk2(v[s8], v[s8 + 1]); w.y = pk2(v[s8 + 2], v[s8 + 3]); w.z = pk2(v[s8 + 4], v[s8 + 5]); w.w = pk2(v[s8 + 6], v[s8 + 7]); return __builtin_bit_cast(bf16x8, w);
}
__device__ __forceinline__ void attn_job(const P& p, int jb, int lane) {
    const int c = lane & 31, hi = lane >> 5;
    constexpr int NB = T / 512;
    const int unit = jb / 48, jj = jb % 48, pat = jj >> 4, sub = jj & 15;
    const int blk = unit % NB, h = (unit / NB) & 3, b = unit / (NB * 4), bh = b * 4 + h;
    int dil, r, qi0, cls, tb;
    if (pat == 0) { dil = 1; r = 0; qi0 = blk * 512 + sub * 32; cls = 0; tb = 0; }
    else if (pat == 1) { dil = 4; r = sub >> 2; qi0 = blk * 128 + (sub & 3) * 32; cls = 1; tb = r * (T / 128); }
    else { dil = 16; r = sub; qi0 = blk * 32; cls = 2; tb = r * (T / 512); }
    const bf16_t* KF = WSP(bf16_t, WS_KF) + cls * ATT_CLS + ((size_t)bh * (T / 32) + tb) * 2048 + lane * 8;
    const bf16_t* VF = WSP(bf16_t, WS_VF) + cls * ATT_CLS + ((size_t)bh * (T / 32) + tb) * 2048 + lane * 8;
    const int tq = dil * (qi0 + c) + r;
    const bf16_t* qp = WSP(bf16_t, WS_PROJ) + (size_t)(b * T + tq) * NPROJ + C_QA + h * 64 + 8 * hi;
    bf16x8 qf[4];
#pragma unroll
    for (int ks = 0; ks < 4; ++ks) qf[ks] = *(const bf16x8*)(qp + 16 * ks);
    bf16x8 kf[5][4];
#pragma unroll
    for (int i = 0; i < 5; ++i) { const int kt0 = qi0 - 128 + 32 * i; const bf16_t* kp = KF + (size_t)(kt0 >= 0 ? (kt0 >> 5) : 0) * 2048;
#pragma unroll
        for (int ks = 0; ks < 4; ++ks) kf[i][ks] = *(const bf16x8*)(kp + 512 * ks); }
    f32x16 S[5];
#pragma unroll
    for (int i = 0; i < 5; ++i) {
        const int kt0 = qi0 - 128 + 32 * i;
        f32x16 acc;
#pragma unroll
        for (int e = 0; e < 16; ++e) acc[e] = 0.f;
#pragma unroll
        for (int ks = 0; ks < 4; ++ks) acc = MFMA32(kf[i][ks], qf[ks], acc);
#pragma unroll
        for (int e = 0; e < 16; ++e) { const int krow = (e & 3) + 8 * (e >> 2) + 4 * hi;
            const bool dead = kt0 < 0 || (i == 0 && krow < c) || (i == 4 && krow > c); if (dead) acc[e] = -INFINITY; }
        S[i] = acc;
    }
    float mx = -INFINITY;
#pragma unroll
    for (int i = 0; i < 5; ++i)
#pragma unroll
        for (int e = 0; e < 16; ++e) mx = fmaxf(mx, S[i][e]);
    mx = fmaxf(mx, __shfl_xor(mx, 32));
    float lsum = 0.f;
#pragma unroll
    for (int i = 0; i < 5; ++i)
#pragma unroll
        for (int e = 0; e < 16; ++e) { const float pe = exp2f(S[i][e] - mx); S[i][e] = pe; lsum += pe; }
    lsum += __shfl_xor(lsum, 32);
    bf16x8 pf[5][2];
#pragma unroll
    for (int i = 0; i < 5; ++i) { pf[i][0] = pack8(S[i], 0); pf[i][1] = pack8(S[i], 8); }
    f32x16 O[2];
#pragma unroll
    for (int dt = 0; dt < 2; ++dt)
#pragma unroll
        for (int e = 0; e < 16; ++e) O[dt][e] = 0.f;
#pragma unroll
    for (int i = 0; i < 5; ++i) {
        const int kt0 = qi0 - 128 + 32 * i; const bf16_t* vp = VF + (size_t)(kt0 >= 0 ? (kt0 >> 5) : 0) * 2048;
#pragma unroll
        for (int s2 = 0; s2 < 2; ++s2)
#pragma unroll
            for (int dt = 0; dt < 2; ++dt) O[dt] = MFMA32(*(const bf16x8*)(vp + (dt * 2 + s2) * 512), pf[i][s2], O[dt]);
    }
    const size_t idx = ((size_t)(b * T + tq) * 4 + h) * 3 + pat;
    bf16_t* po = WSP(bf16_t, WS_APO) + idx * 64;
#pragma unroll
    for (int dt = 0; dt < 2; ++dt)
#pragma unroll
        for (int g = 0; g < 4; ++g) { u32x2 w; w.x = pk2(O[dt][4 * g], O[dt][4 * g + 1]); w.y = pk2(O[dt][4 * g + 2], O[dt][4 * g + 3]); *(u32x2*)(po + 32 * dt + 8 * g + 4 * hi) = w; }
    if (hi == 0) { float* ml = WSP(float, WS_AML) + idx * 2; ml[0] = mx; ml[1] = lsum; }
}
__device__ __forceinline__ void ph_attn_jobs(const P& p, int nc, int b1, int r0) {
    const int bid = (int)blockIdx.x; if (bid >= b1) return;
    const int lane = tidx() & 63, wave = tidx() >> 6, nn = (b1 - nc) * 8, ncw = nc * 8; constexpr int NJ = PB * 4 * (T / 512) * 48;
    const bool late = bid < nc; const int wi = late ? bid * 8 + wave : (bid - nc) * 8 + wave;
    for (int r = late ? r0 : 0;; ++r) { const int base = r * nn + (r > r0 ? (r - r0) * ncw : 0); const int jb = base + (late ? nn + wi : wi);
        if (base >= NJ) break;
        if (jb < NJ) attn_job(p, jb, lane); }
}
__device__ __forceinline__ void ph_attn_combine(const P& p) {
    const size_t gt = (size_t)blockIdx.x * NTHR + tidx(), ng = (size_t)gridDim.x * NTHR;
    for (size_t e = gt; e < (size_t)MP * 4 * 16; e += ng) {
        const size_t rh = e >> 4; const int dq = (int)(e & 15) * 4;
        const float* ml = WSP(float, WS_AML) + rh * 6; const float m0 = ml[0], m1 = ml[2], m2 = ml[4];
        const float mm = fmaxf(m0, fmaxf(m1, m2)); const float w0 = exp2f(m0 - mm), w1 = exp2f(m1 - mm), w2 = exp2f(m2 - mm);
        const float inv = 1.0f / (w0 * ml[1] + w1 * ml[3] + w2 * ml[5]);
        const bf16_t* po = WSP(bf16_t, WS_APO) + rh * 192 + dq;
        const u32x2 a = *(const u32x2*)po, bq = *(const u32x2*)(po + 64), cq = *(const u32x2*)(po + 128);
        float o[4];
        o[0] = w0 * bf2f((bf16_t)(a.x & 0xffff)) + w1 * bf2f((bf16_t)(bq.x & 0xffff)) + w2 * bf2f((bf16_t)(cq.x & 0xffff));
        o[1] = w0 * bf2f((bf16_t)(a.x >> 16)) + w1 * bf2f((bf16_t)(bq.x >> 16)) + w2 * bf2f((bf16_t)(cq.x >> 16));
        o[2] = w0 * bf2f((bf16_t)(a.y & 0xffff)) + w1 * bf2f((bf16_t)(bq.y & 0xffff)) + w2 * bf2f((bf16_t)(cq.y & 0xffff));
        o[3] = w0 * bf2f((bf16_t)(a.y >> 16)) + w1 * bf2f((bf16_t)(bq.y >> 16)) + w2 * bf2f((bf16_t)(cq.y >> 16));
        const size_t row = rh >> 2; const int h = (int)(rh & 3);
        u32x2 w; w.x = pk2(o[0] * inv, o[1] * inv); w.y = pk2(o[2] * inv, o[3] * inv);
        *(u32x2*)(WSP(bf16_t, WS_O) + row * D + h * 64 + dq) = w;
    }
}
__device__ __forceinline__ float ret_lg(int h) { return logf(1.0f - exp2f(-5.0f - (float)h)); }
constexpr int TPK = 72, TPT = 65;
__device__ __forceinline__ void trans_write(const bf16_t* tile, bf16_t* dst  , int tile0, int tid) {
#pragma unroll
    for (int k = 0; k < 4; ++k) { const int ch = tid + NTHR * k, d = ch >> 5, t0 = (ch & 31) * 8; u32x4 w;
        w.x = (unsigned)tile[(t0 + 0) * TPT + d] | ((unsigned)tile[(t0 + 1) * TPT + d] << 16); w.y = (unsigned)tile[(t0 + 2) * TPT + d] | ((unsigned)tile[(t0 + 3) * TPT + d] << 16);
        w.z = (unsigned)tile[(t0 + 4) * TPT + d] | ((unsigned)tile[(t0 + 5) * TPT + d] << 16); w.w = (unsigned)tile[(t0 + 6) * TPT + d] | ((unsigned)tile[(t0 + 7) * TPT + d] << 16);
        *(u32x4*)(dst + (size_t)d * T + tile0 + t0) = w; COMPILER_FENCE(); }
}
__device__ __forceinline__ void store8_b16(bf16_t* dst, const u32x4 w) {
    dst[0] = (bf16_t)(w.x & 0xffff); dst[1] = (bf16_t)(w.x >> 16); dst[2] = (bf16_t)(w.y & 0xffff); dst[3] = (bf16_t)(w.y >> 16);
    dst[4] = (bf16_t)(w.z & 0xffff); dst[5] = (bf16_t)(w.z >> 16); dst[6] = (bf16_t)(w.w & 0xffff); dst[7] = (bf16_t)(w.w >> 16);
}
__device__ __forceinline__ void ph_vtrans(const P& p, int l, unsigned char* smem) {
    bf16_t* ka = (bf16_t*)smem; bf16_t* va = ka + 256 * TPK; bf16_t* vr = va + 256 * TPK; bf16_t* kr = vr + 256 * TPT;
    static_assert((2 * 256 * TPK + 2 * 256 * TPT) * 2 <= BAR_LDS_OFF, "transpose unit LDS");
    const int tid = tidx(); bf16_t* PR = WSP(bf16_t, WS_PROJ); const float* tab = WSP(float, WS_ROPE);
    for (int u = blockIdx.x; u < PB * 4 * (T / 256); u += gridDim.x) {
        const int tile = u % (T / 256), bh = u / (T / 256), h = bh & 3, b = bh >> 2; const float lg = ret_lg(h);
        __syncthreads();
#pragma unroll 1
        for (int k = 0; k < 2; ++k) { const int e = tid + NTHR * k, t = e >> 2, d = (e & 3) * 8, tt = tile * 256 + t; bf16_t* row = PR + (size_t)(b * T + tt) * NPROJ + h * 64 + d;
            float x1[8], x2[8], o1[8], o2[8];
            { const float* ct = tab + (size_t)tt * 32 + d; const float* st = ct + (size_t)NPOS * 32;
              const f32x4 c0 = *(const f32x4*)ct, c1 = *(const f32x4*)(ct + 4), s0 = *(const f32x4*)st, s1 = *(const f32x4*)(st + 4);
              unpack8(*(const u32x4*)(row + C_QA), x1); unpack8(*(const u32x4*)(row + C_QA + 32), x2);
#pragma unroll
              for (int i = 0; i < 8; ++i) { const float c = i < 4 ? c0[i & 3] : c1[i & 3], sn = i < 4 ? s0[i & 3] : s1[i & 3]; o1[i] = (x1[i] * c - x2[i] * sn) * (0.125f * LOG2E); o2[i] = (x1[i] * sn + x2[i] * c) * (0.125f * LOG2E); }
              *(u32x4*)(row + C_QA) = pack8f(o1); *(u32x4*)(row + C_QA + 32) = pack8f(o2);
              unpack8(*(const u32x4*)(row + C_KA), x1); unpack8(*(const u32x4*)(row + C_KA + 32), x2);
#pragma unroll
              for (int i = 0; i < 8; ++i) { const float c = i < 4 ? c0[i & 3] : c1[i & 3], sn = i < 4 ? s0[i & 3] : s1[i & 3]; o1[i] = x1[i] * c - x2[i] * sn; o2[i] = x1[i] * sn + x2[i] * c; }
              *(u32x4*)(ka + t * TPK + d) = pack8f(o1); *(u32x4*)(ka + t * TPK + d + 32) = pack8f(o2);
              if (tt >= T - PWIN) { float* o = p.out + O_PWK + (((size_t)l * PB + b) * PWIN + (tt - (T - PWIN))) * 256 + h * 64 + d;
                  *(f32x4*)o = (f32x4){o1[0], o1[1], o1[2], o1[3]}; *(f32x4*)(o + 4) = (f32x4){o1[4], o1[5], o1[6], o1[7]}; *(f32x4*)(o + 32) = (f32x4){o2[0], o2[1], o2[2], o2[3]}; *(f32x4*)(o + 36) = (f32x4){o2[4], o2[5], o2[6], o2[7]}; } }
            COMPILER_FENCE();
            { const float* ct = tab + (size_t)2 * NPOS * 32 + (size_t)tt * 32 + d; const float* st = ct + (size_t)NPOS * 32;
              const f32x4 c0 = *(const f32x4*)ct, c1 = *(const f32x4*)(ct + 4), s0 = *(const f32x4*)st, s1 = *(const f32x4*)(st + 4);
              const float gq = expf(lg * (float)(tt & 63)), gk = 0.125f / gq;
              unpack8(*(const u32x4*)(row + C_QR), x1); unpack8(*(const u32x4*)(row + C_QR + 32), x2);
#pragma unroll
              for (int i = 0; i < 8; ++i) { const float c = i < 4 ? c0[i & 3] : c1[i & 3], sn = i < 4 ? s0[i & 3] : s1[i & 3]; o1[i] = (x1[i] * c - x2[i] * sn) * gq; o2[i] = (x1[i] * sn + x2[i] * c) * gq; }
              *(u32x4*)(row + C_QR) = pack8f(o1); *(u32x4*)(row + C_QR + 32) = pack8f(o2);
              unpack8(*(const u32x4*)(row + C_KR), x1); unpack8(*(const u32x4*)(row + C_KR + 32), x2);
#pragma unroll
              for (int i = 0; i < 8; ++i) { const float c = i < 4 ? c0[i & 3] : c1[i & 3], sn = i < 4 ? s0[i & 3] : s1[i & 3]; o1[i] = (x1[i] * c - x2[i] * sn) * gk; o2[i] = (x1[i] * sn + x2[i] * c) * gk; }
              const u32x4 w1 = pack8f(o1), w2 = pack8f(o2);
              *(u32x4*)(row + C_KR) = w1; *(u32x4*)(row + C_KR + 32) = w2; store8_b16(kr + t * TPT + d, w1); store8_b16(kr + t * TPT + d + 32, w2); }
            COMPILER_FENCE(); }
#pragma unroll
        for (int k = 0; k < 4; ++k) { const int ch = tid + NTHR * k, t = ch >> 3, d8 = (ch & 7) * 8, tt = tile * 256 + t; const bf16_t* src = PR + (size_t)(b * T + tt) * NPROJ + h * 64 + d8;
            const u32x4 wv = *(const u32x4*)(src + C_VA); *(u32x4*)(va + t * TPK + d8) = wv; store8_b16(vr + t * TPT + d8, *(const u32x4*)(src + C_VR));
            if (tt >= T - PWIN) { float v[8]; unpack8(wv, v); float* o = p.out + O_PWV + (((size_t)l * PB + b) * PWIN + (tt - (T - PWIN))) * 256 + h * 64 + d8;
                *(f32x4*)o = (f32x4){v[0], v[1], v[2], v[3]}; *(f32x4*)(o + 4) = (f32x4){v[4], v[5], v[6], v[7]}; }
            COMPILER_FENCE(); }
        __syncthreads();
#pragma unroll
        for (int cls = 0; cls < 3; ++cls) {
            bf16_t* KFc = WSP(bf16_t, WS_KF) + cls * ATT_CLS + (size_t)bh * (T / 32) * 2048; bf16_t* VFc = WSP(bf16_t, WS_VF) + cls * ATT_CLS + (size_t)bh * (T / 32) * 2048;
#pragma unroll 1
            for (int k = 0; k < 4; ++k) { const int f = tid + NTHR * k, lane = f & 63, c31 = lane & 31, hi = lane >> 5;
                { int g, ks, tl, gtile; bool ok = true;
                  if (cls == 0) { ks = (f >> 6) & 3; g = f >> 8; tl = 32 * g + c31; gtile = tile * 8 + g; }
                  else if (cls == 1) { ks = (f >> 6) & 3; g = f >> 8; const int r = g >> 1, st = g & 1; tl = 4 * (32 * st + c31) + r; gtile = r * (T / 128) + tile * 2 + st; }
                  else { const int r = f >> 7, s16 = f & 15, h2 = (f >> 4) & 1; ks = (f >> 5) & 3; tl = 16 * s16 + r; gtile = r * (T / 512) + (tile >> 1); g = 0; (void)ok;
                      const int slot = 16 * (tile & 1) + s16;
                      *(u32x4*)(KFc + ((size_t)gtile * 4 + ks) * 512 + (slot + 32 * h2) * 8) = *(const u32x4*)(ka + tl * TPK + 16 * ks + 8 * h2); }
                  if (cls < 2) { *(u32x4*)(KFc + ((size_t)gtile * 4 + ks) * 512 + lane * 8) = *(const u32x4*)(ka + tl * TPK + 16 * ks + 8 * hi); } }
                { int dt, s2, gtile, r = 0, st = 0, g = 0;
                  if (cls == 0) { s2 = (f >> 6) & 1; dt = (f >> 7) & 1; g = f >> 8; gtile = tile * 8 + g; }
                  else if (cls == 1) { s2 = (f >> 6) & 1; dt = (f >> 7) & 1; g = f >> 8; r = g >> 1; st = g & 1; gtile = r * (T / 128) + tile * 2 + st; }
                  else { dt = (f >> 6) & 1; r = f >> 7; s2 = tile & 1; gtile = r * (T / 512) + (tile >> 1); }
                  unsigned short e8[8];
#pragma unroll
                  for (int jj = 0; jj < 8; ++jj) { const int kk = 16 * s2 + 8 * (jj >> 2) + 4 * hi + (jj & 3);
                      const int tl = cls == 0 ? 32 * g + kk : cls == 1 ? 4 * (32 * st + kk) + r : 16 * (kk & 15) + r;
                      e8[jj] = va[tl * TPK + 32 * dt + c31]; }
                  u32x4 w; w.x = (unsigned)e8[0] | ((unsigned)e8[1] << 16); w.y = (unsigned)e8[2] | ((unsigned)e8[3] << 16); w.z = (unsigned)e8[4] | ((unsigned)e8[5] << 16); w.w = (unsigned)e8[6] | ((unsigned)e8[7] << 16);
                  *(u32x4*)(VFc + ((size_t)gtile * 4 + dt * 2 + s2) * 512 + lane * 8) = w; }
                COMPILER_FENCE(); }
        }
        trans_write(vr, WSP(bf16_t, WS_VRT) + (size_t)bh * 64 * T, tile * 256, tid);
        trans_write(kr, WSP(bf16_t, WS_KRT) + (size_t)bh * 64 * T, tile * 256, tid);
    }
}

constexpr int CH_ITEMS = PB * 4 * 4;
__device__ __forceinline__ void ph_ret_local(const P& p, int l) {
    const int tid = tidx(), lane = tid & 63, wave = tid >> 6, x = lane & 15, q = lane >> 4, dt = wave >> 1;
    for (int u = blockIdx.x; u < NUNIT; u += gridDim.x) {
        const int n = u % NCH, bh = u / NCH, h = bh & 3, t0 = n * 64; const float g63 = expf(ret_lg(h) * 63.0f);
        const bf16_t* ka = WSP(bf16_t, WS_KRT) + ((size_t)bh * 64 + 16 * dt + x) * T + t0 + 8 * q;
#pragma unroll
        for (int k = 0; k < 2; ++k) { const int et = 2 * (wave & 1) + k; const bf16_t* vb = WSP(bf16_t, WS_VRT) + ((size_t)bh * 64 + 16 * et + x) * T + t0 + 8 * q;
            f32x4 acc = (f32x4){0.f, 0.f, 0.f, 0.f};
#pragma unroll
            for (int ks = 0; ks < 2; ++ks) acc = MFMA16(*(const bf16x8*)(ka + 32 * ks), *(const bf16x8*)(vb + 32 * ks), acc);
            *(f32x4*)(WSP(float, WS_RU) + (size_t)u * 4096 + (16 * et + x) * 64 + 16 * dt + 4 * q) = acc * g63; }
    }
}
__device__ __forceinline__ void ph_ret_scan(const P& p, int l) {
    const int G = (int)gridDim.x, skip = G > 2 * CH_ITEMS ? CH_ITEMS : 0;
    if ((int)blockIdx.x < skip) return;
    const int gt = ((int)blockIdx.x - skip) * NTHR + tidx(), ng = (G - skip) * NTHR;
    for (int e = gt; e < PB * 4 * 4096; e += ng) {
        const int bh = e >> 12, ed = e & 4095, h = bh & 3; const float cd = expf(ret_lg(h) * 64.0f);
        const float* U = WSP(float, WS_RU) + (size_t)bh * NCH * 4096 + ed; bf16_t* SPv = WSP(bf16_t, WS_RS) + (size_t)bh * NCH * 4096 + ed;
        float s = 0.f;
        static_assert(NCH % 8 == 0, "scan batches");
        constexpr int SB = NCH % 32 == 0 ? 32 : 8;
        for (int n0 = 0; n0 < NCH; n0 += SB) {
            float uv[SB];
#pragma unroll
            for (int k = 0; k < SB; ++k) uv[k] = U[(size_t)(n0 + k) * 4096];
#pragma unroll
            for (int k = 0; k < SB; ++k) { SPv[(size_t)(n0 + k) * 4096] = f2bf(s); s = s * cd + uv[k]; } }
        p.out[O_PRET + ((size_t)l * PB * 4 + bh) * 4096 + (ed & 63) * 64 + (ed >> 6)] = s;
    }
}
__device__ __forceinline__ void ph_ret_out(const P& p, int l) {
    const int tid = tidx(), lane = tid & 63, wave = tid >> 6, x = lane & 15, q = lane >> 4, it = UNIFORM(wave & 3);
    const bf16_t* PR = WSP(bf16_t, WS_PROJ);
    for (int u = blockIdx.x * 2 + (wave >> 2); u < NUNIT; u += gridDim.x * 2) {
        const int n = u % NCH, bh = u / NCH, h = bh & 3, b = bh >> 2, t0 = n * 64; const float gam = expf(ret_lg(h));
        const size_t rowi = (size_t)(b * T + t0 + 16 * it + x);
        bf16x8 qf[2];
#pragma unroll
        for (int ks = 0; ks < 2; ++ks) qf[ks] = *(const bf16x8*)(PR + rowi * NPROJ + C_QR + h * 64 + 32 * ks + 8 * q);
        f32x4 at[4];
#pragma unroll
        for (int jt = 0; jt < 4; ++jt) { at[jt] = (f32x4){0.f, 0.f, 0.f, 0.f};
            if (jt <= it) { const bf16_t* kp = PR + (size_t)(b * T + t0 + 16 * jt + x) * NPROJ + C_KR + h * 64 + 8 * q;
#pragma unroll
                for (int ks = 0; ks < 2; ++ks) at[jt] = MFMA16(*(const bf16x8*)(kp + 32 * ks), qf[ks], at[jt]);
                if (jt == it) {
#pragma unroll
                    for (int e = 0; e < 4; ++e) if (4 * q + e > x) at[jt][e] = 0.f; } } }
        const bf16x8 pb0 = pack_tiles(at[0], at[1]), pb1 = pack_tiles(at[2], at[3]);
        f32x4 o[4], os[4];
#pragma unroll
        for (int et = 0; et < 4; ++et) { o[et] = (f32x4){0.f, 0.f, 0.f, 0.f}; os[et] = (f32x4){0.f, 0.f, 0.f, 0.f};
            const bf16_t* vp = WSP(bf16_t, WS_VRT) + ((size_t)bh * 64 + 16 * et + x) * T + t0 + 4 * q;
            { const u32x2 lo = *(const u32x2*)vp, hi = *(const u32x2*)(vp + 16); u32x4 w; w.x = lo.x; w.y = lo.y; w.z = hi.x; w.w = hi.y; o[et] = MFMA16(__builtin_bit_cast(bf16x8, w), pb0, o[et]); }
            if (it >= 2) { const u32x2 lo = *(const u32x2*)(vp + 32), hi = *(const u32x2*)(vp + 48); u32x4 w; w.x = lo.x; w.y = lo.y; w.z = hi.x; w.w = hi.y; o[et] = MFMA16(__builtin_bit_cast(bf16x8, w), pb1, o[et]); }
            const bf16_t* sp = WSP(bf16_t, WS_RS) + (size_t)u * 4096 + (16 * et + x) * 64 + 8 * q;
#pragma unroll
            for (int ks = 0; ks < 2; ++ks) os[et] = MFMA16(*(const bf16x8*)(sp + 32 * ks), qf[ks], os[et]);
            o[et] = o[et] + os[et] * gam; }
        float sq = 0.f;
#pragma unroll
        for (int et = 0; et < 4; ++et) sq += (o[et][0] * o[et][0] + o[et][1] * o[et][1]) + (o[et][2] * o[et][2] + o[et][3] * o[et][3]);
        sq += __shfl_xor(sq, 16); sq += __shfl_xor(sq, 32);
        const float rstd = 1.0f / sqrtf(sq * (1.0f / 64.0f) + EPS);
#pragma unroll
        for (int et = 0; et < 4; ++et) { const int e0 = 16 * et + 4 * q; const u32x2 gw = *(const u32x2*)(PR + rowi * NPROJ + C_GR + h * 64 + e0); const f32x4 nw = *(const f32x4*)(p.ret_norm + l * 64 + e0);
            const float g0 = bf2f((bf16_t)(gw.x & 0xffff)), g1 = bf2f((bf16_t)(gw.x >> 16)), g2 = bf2f((bf16_t)(gw.y & 0xffff)), g3 = bf2f((bf16_t)(gw.y >> 16));
            u32x2 w; w.x = pk2(o[et][0] * rstd * nw[0] * silu_fast(g0), o[et][1] * rstd * nw[1] * silu_fast(g1)); w.y = pk2(o[et][2] * rstd * nw[2] * silu_fast(g2), o[et][3] * rstd * nw[3] * silu_fast(g3));
            *(u32x2*)(WSP(bf16_t, WS_O) + rowi * D + 256 + h * 64 + e0) = w; }
    }
}
__device__ __forceinline__ void ph_ret_sample(const P& p, int l, unsigned char* smem) {
    float* S0 = (float*)smem; float* qs = S0 + 4096; float* ks = qs + 8 * 64; float* vs = ks + 8 * 64;
    const int tid = tidx(); const bf16_t* PR = WSP(bf16_t, WS_PROJ);
    for (int u = gridDim.x - 1 - blockIdx.x; u < DB * 4; u += gridDim.x) {
        const int h = u & 3, b = u >> 2; const float lg = ret_lg(h);
        __syncthreads();
        for (int e = tid; e < 4096; e += NTHR) S0[e] = p.state_ret[(((size_t)l * DB + b) * 4 + h) * 4096 + e];
        { const int j = tid >> 6, d = tid & 63; const size_t row = (size_t)(MP + b * DS + j) * NPROJ;
          qs[tid] = bf2f(PR[row + C_QR + h * 64 + d]); ks[tid] = bf2f(PR[row + C_KR + h * 64 + d]); vs[tid] = bf2f(PR[row + C_VR + h * 64 + d]); }
        __syncthreads();
        { const int i = tid >> 6, e = tid & 63; float o = 0.f;
          for (int j = 0; j <= i; ++j) { float a = 0.f; for (int d = 0; d < 64; ++d) a += qs[i * 64 + d] * ks[j * 64 + d]; o += a * expf(lg * (float)(i - j)) * vs[j * 64 + e]; }
          float o2 = 0.f; for (int d = 0; d < 64; ++d) o2 += qs[i * 64 + d] * S0[d * 64 + e];
          o += o2 * expf(lg * (float)(i + 1));
          const float rstd = 1.0f / sqrtf(wave_sum(o * o) * (1.0f / 64.0f) + EPS);
          const size_t row = (size_t)(MP + b * DS + i); const float g = bf2f(PR[row * NPROJ + C_GR + h * 64 + e]);
          WSP(bf16_t, WS_O)[row * D + 256 + h * 64 + e] = f2bf(o * rstd * p.ret_norm[l * 64 + e] * silu_f(g)); }
        for (int x = tid; x < 4096; x += NTHR) { const int d = x >> 6, e = x & 63; float s = S0[x] * expf(lg * (float)DS);
            for (int j = 0; j < DS; ++j) s += ks[j * 64 + d] * expf(lg * (float)(DS - 1 - j)) * vs[j * 64 + e];
            p.out[O_SRET + (((size_t)l * DB + b) * 4 + h) * 4096 + x] = s; }
    }
}

template <int CS, int LDL> __device__ __forceinline__ void fwd_subst(float (&X)[CS], const float* Ls) {
#pragma unroll
    for (int i = 1; i < CS; ++i) {
        float a[4] = {X[i], 0.f, 0.f, 0.f};
#pragma unroll
        for (int j4 = 0; j4 < (i + 3) / 4; ++j4) { const f32x4 lv = *(const f32x4*)(Ls + i * LDL + 4 * j4);
#pragma unroll
            for (int e = 0; e < 4; ++e) if (4 * j4 + e < i) a[e] -= lv[e] * X[4 * j4 + e]; }
        X[i] = (a[0] + a[1]) + (a[2] + a[3]);
    }
}
constexpr int QP = 132;
constexpr int WSTP = 136;
constexpr int RWP = 392, TP = 136;
__device__ __forceinline__ void ph_gdn_prep(const P& p, int l, unsigned char* smem) {
    float* Ls = (float*)smem; float* As = Ls + 64 * 68; float* gs = As + 64 * 68; float* gcs = gs + 64; float* bts = gcs + 64; float* part = bts + 64;
    bf16_t* raw = (bf16_t*)(part + 4 * 64); bf16_t* Khi = raw + 67 * RWP; bf16_t* Klo = Khi + 64 * TP; bf16_t* Qb = Klo + 64 * TP;
    static_assert((64 * 68 * 2 + 64 * 3 + 4 * 64) * 4 + (67 * RWP + 3 * 64 * TP) * 2 <= BAR_LDS_OFF, "gdn_prep LDS");
    const int tid = tidx(), lane = tid & 63, wave = tid >> 6; const bf16_t* PR = WSP(bf16_t, WS_PROJ);
    for (int u = blockIdx.x; u < NUNIT; u += gridDim.x) {
        const int n = u % NCH, h = (u / NCH) % 4, b = u / (NCH * 4), t0 = n * 64;
        __syncthreads();
        for (int e = tid; e < 67 * 48; e += NTHR) { const int row = e / 48, ch = e % 48, t = t0 - 3 + row; u32x4 v = (u32x4){0u, 0u, 0u, 0u};
            if (t >= 0) v = *(const u32x4*)(PR + (size_t)(b * T + t) * NPROJ + C_CONV + (ch >> 4) * 512 + h * 128 + (ch & 15) * 8);
            *(u32x4*)(raw + row * RWP + ch * 8) = v; }
        if (tid >= 384 && tid < 448) { const int i = tid - 384; const size_t row = (size_t)(b * T + t0 + i); gs[i] = WSP(float, WS_G)[row * 4 + h]; bts[i] = WSP(float, WS_BETA)[row * 4 + h]; }
        __syncthreads();
        float y[64]; const int sec = tid < 128 ? 2 : tid < 256 ? 1 : 0, c = tid & 127;
        if (tid < 384) { const int col = sec * 512 + h * 128 + c;
            const float w0 = p.conv_w[(l * 4 + 0) * 1536 + col], w1 = p.conv_w[(l * 4 + 1) * 1536 + col], w2 = p.conv_w[(l * 4 + 2) * 1536 + col], w3 = p.conv_w[(l * 4 + 3) * 1536 + col];
            const LAS bf16_t* rp = (const LAS bf16_t*)raw + sec * 128 + c; LAUNDER_V(rp); float x0 = bf2f(rp[0]), x1 = bf2f(rp[RWP]), x2 = bf2f(rp[2 * RWP]);
#pragma unroll
            for (int i = 0; i < 64; ++i) { const float x3 = bf2f(rp[(i + 3) * RWP]); y[i] = silu_fast(w0 * x0 + w1 * x1 + w2 * x2 + w3 * x3); x0 = x1; x1 = x2; x2 = x3; if ((i & 7) == 7) COMPILER_FENCE(); } }
        if (tid >= 448) { if (tid == 448) { float a = 0.f; for (int i = 0; i < 64; ++i) { a += gs[i]; gcs[i] = a; } }
            WAVE_SYNC(); const int i = tid - 448; part[128 + i] = expf(gcs[i]); part[192 + i] = expf(gcs[63] - gcs[i]); }
#pragma unroll
        for (int pass = 0; pass < 2; ++pass) {
            if (tid >= 128 + 128 * pass && tid < 256 + 128 * pass) { LAS float* sq = (LAS float*)Ls + c; LAUNDER_V(sq);
#pragma unroll
                for (int i = 0; i < 64; ++i) sq[i * 132] = y[i] * y[i]; }
            __syncthreads();
            { const int i = tid >> 3, pt = tid & 7; const float* rp2 = Ls + i * 132 + pt * 16; float a = 0.f;
#pragma unroll
              for (int k = 0; k < 16; ++k) a += rp2[k];
              a += __shfl_xor(a, 1); a += __shfl_xor(a, 2); a += __shfl_xor(a, 4);
              if (pt == 0) part[64 * pass + i] = 1.0f / sqrtf(a + EPS); }
            __syncthreads();
        }
        if (tid >= 128 && tid < 256) { LAS bf16_t* kh = (LAS bf16_t*)Khi + c; LAS bf16_t* kl = (LAS bf16_t*)Klo + c; LAUNDER_V(kh); LAUNDER_V(kl);
#pragma unroll
            for (int i = 0; i < 64; ++i) { const float v = y[i] * part[i]; y[i] = v; const bf16_t hb = f2bf(v); kh[i * TP] = hb; kl[i * TP] = f2bf(v - bf2f(hb)); if ((i & 7) == 7) COMPILER_FENCE(); }
            bf16_t* dst = WSP(bf16_t, WS_GWK) + (size_t)u * 16384 + 8192; const int mt = c >> 4, x = c & 15;
#pragma unroll
            for (int ks2 = 0; ks2 < 2; ++ks2)
#pragma unroll
                for (int q = 0; q < 4; ++q) { const int i0 = 32 * ks2 + 4 * q; float v[8];
#pragma unroll
                    for (int e = 0; e < 8; ++e) { const int i = i0 + (e < 4 ? e : 12 + e); v[e] = y[i] * part[192 + i]; }
                    u32x4 w; w.x = pk2(v[0], v[1]); w.y = pk2(v[2], v[3]); w.z = pk2(v[4], v[5]); w.w = pk2(v[6], v[7]);
                    *(u32x4*)(dst + ((size_t)((mt * 2 + ks2) * 64 + q * 16 + x)) * 8) = w; COMPILER_FENCE(); } }
        else if (tid >= 256 && tid < 384) { bf16_t* qg = WSP(bf16_t, WS_GQ) + (size_t)u * 8192 + c; LAS bf16_t* qb = (LAS bf16_t*)Qb + c; LAUNDER_V(qb);
#pragma unroll
            for (int i = 0; i < 64; ++i) { const float v = y[i] * part[64 + i]; qb[i * TP] = f2bf(v); qg[(i & 7) * 128] = f2bf(v * 0.08838834764831845f * part[128 + i]); if ((i & 7) == 7) { qg += 8 * 128; LAUNDER_V(qg); COMPILER_FENCE(); } } }
        __syncthreads();
#pragma unroll
        for (int tp = 0; tp < 2; ++tp) { const int pos = wave * 2 + tp, it = pos >> 2, jt = pos & 3, j16 = lane & 15, qd = lane >> 4;
            f32x4 lk = (f32x4){0.f, 0.f, 0.f, 0.f}, aq = (f32x4){0.f, 0.f, 0.f, 0.f};
            if (jt <= it) {
#pragma unroll
                for (int ks = 0; ks < 4; ++ks) { const int ao = (16 * it + j16) * TP + 32 * ks + 8 * qd, bo = (16 * jt + j16) * TP + 32 * ks + 8 * qd;
                    const bf16x8 ah = *(const bf16x8*)(Khi + ao), al = *(const bf16x8*)(Klo + ao), aqf = *(const bf16x8*)(Qb + ao), bh = *(const bf16x8*)(Khi + bo), bl = *(const bf16x8*)(Klo + bo);
                    lk = MFMA16(ah, bh, lk); lk = MFMA16(ah, bl, lk); lk = MFMA16(al, bh, lk); aq = MFMA16(aqf, bh, aq); } }
            const int j = 16 * jt + j16;
#pragma unroll
            for (int e = 0; e < 4; ++e) { const int i = 16 * it + 4 * qd + e; const float ex = j <= i ? expf(gcs[i] - gcs[j]) : 0.f;
                Ls[i * 68 + j] = j < i ? bts[i] * lk[e] * ex : 0.f; As[i * 68 + j] = aq[e] * ex * 0.08838834764831845f; } }
        __syncthreads();
        if (tid < 256) {
            if (tid < 128) {
#pragma unroll
                for (int i = 0; i < 64; ++i) { y[i] *= bts[i]; if ((i & 15) == 15) COMPILER_FENCE(); } }
            else {
#pragma unroll
                for (int i = 0; i < 64; ++i) { y[i] *= bts[i] * part[128 + i]; if ((i & 15) == 15) COMPILER_FENCE(); } }
            fwd_subst<64, 68>(y, Ls);
            if (tid < 128) { bf16_t* U = WSP(bf16_t, WS_GU) + (size_t)u * 8192 + c * 64;
#pragma unroll
                for (int i8 = 0; i8 < 8; ++i8) { u32x4 w; w.x = pk2(y[8 * i8], y[8 * i8 + 1]); w.y = pk2(y[8 * i8 + 2], y[8 * i8 + 3]); w.z = pk2(y[8 * i8 + 4], y[8 * i8 + 5]); w.w = pk2(y[8 * i8 + 6], y[8 * i8 + 7]); *(u32x4*)(U + 8 * i8) = w; } }
            else { LAS bf16_t* wst = (LAS bf16_t*)raw + c; LAUNDER_V(wst);
#pragma unroll
                for (int i = 0; i < 64; ++i) wst[i * WSTP] = f2bf(-y[i]); }
        } else { const int t2 = tid - 256;
#pragma unroll 2
            for (int e = t2; e < 4096; e += 256) WSP(bf16_t, WS_GA)[(size_t)u * 4096 + e] = f2bf(As[(e >> 6) * 68 + (e & 63)]);
            if (t2 == 0) WSP(float, WS_GD)[u] = expf(gcs[63]); }
        __syncthreads();
        { bf16_t* dst = WSP(bf16_t, WS_GWK) + (size_t)u * 16384; const bf16_t* wst = raw;
#pragma unroll
          for (int k = 0; k < 2; ++k) { const int f = tid + NTHR * k, ln = f & 63, ks4 = (f >> 6) & 3, mt = f >> 8, q = ln >> 4, x = ln & 15;
              const bf16_t* wr = wst + (16 * mt + x) * WSTP + 32 * ks4 + 4 * q;
              u32x4 w; w.x = (unsigned)wr[0] | ((unsigned)wr[1] << 16); w.y = (unsigned)wr[2] | ((unsigned)wr[3] << 16); w.z = (unsigned)wr[16] | ((unsigned)wr[17] << 16); w.w = (unsigned)wr[18] | ((unsigned)wr[19] << 16);
              *(u32x4*)(dst + (size_t)f * 8) = w; } }
    }
}
constexpr int CH_SLOT = 36864, CH_NSLOT = 4;
static_assert(NCH % 4 == 0 && CH_NSLOT * CH_SLOT <= BAR_LDS_OFF, "chain ring");
__device__ __forceinline__ void chain_stage(const bf16_t* WK, const bf16_t* UTq, int m, int pw, int lane, unsigned char* smem) {
    unsigned char* slot = smem + (m % CH_NSLOT) * CH_SLOT;
#pragma unroll
    for (int k = 0; k < 6; ++k) { const int pc = pw * 6 + k;
        if (pc < 32) GLDS16((const unsigned char*)(WK + (size_t)m * 16384) + pc * 1024 + lane * 16, slot + pc * 1024);
        else GLDS16((const unsigned char*)(UTq + (size_t)m * 8192) + (pc - 32) * 1024 + lane * 16, slot + pc * 1024); }
}
__device__ __forceinline__ void ph_gdn_chain(const P& p, int l, unsigned char* smem) {
    const int tid = tidx(), lane = tid & 63, wave = UNIFORM(tid >> 6), j = lane & 15, q = lane >> 4;
    for (int it = blockIdx.x; it < CH_ITEMS; it += gridDim.x) {
        const int qt = it & 3, bh = it >> 2;
        const bf16_t* WK = WSP(bf16_t, WS_GWK) + (size_t)bh * NCH * 16384;
        const bf16_t* UTq = WSP(bf16_t, WS_GU) + (size_t)bh * NCH * 8192 + qt * 2048;
        __syncthreads();
        if (wave >= 2) {
            const int pw = wave - 2;
            chain_stage(WK, UTq, 0, pw, lane, smem); chain_stage(WK, UTq, 1, pw, lane, smem); chain_stage(WK, UTq, 2, pw, lane, smem);
#pragma unroll 1
            for (int n = 0; n < NCH; ++n) {
                if (n + 2 < NCH) WAIT_VM(12); else if (n + 1 < NCH) WAIT_VM(6); else WAIT_VM(0);
                RAW_BARRIER();
                if (n + 3 < NCH) chain_stage(WK, UTq, n + 3, pw, lane, smem);
            }
        } else {
            const int sl = qt * 2 + wave, c = 16 * sl + j;
            f32x4 S[8];
#pragma unroll
            for (int t = 0; t < 8; ++t) S[t] = (f32x4){0.f, 0.f, 0.f, 0.f};
            bf16x8 sB[4];
#pragma unroll
            for (int ks = 0; ks < 4; ++ks) sB[ks] = pack_tiles(S[2 * ks], S[2 * ks + 1]);
            const float* DC = WSP(float, WS_GD) + bh * NCH;
            float db[4];
#pragma unroll
            for (int d = 0; d < 4; ++d) db[d] = DC[d];
#pragma unroll 1
            for (int n0 = 0; n0 < NCH; n0 += 4) {
#pragma unroll
                for (int k4 = 0; k4 < 4; ++k4) {
                    const int n = n0 + k4, u = bh * NCH + n;
                    f32x4 acc[4]; const float dec = db[k4];
                    if (n + 4 < NCH) db[k4] = DC[n + 4];
                    { bf16_t* sp = WSP(bf16_t, WS_GS) + (size_t)u * 16384 + (size_t)sl * 2048 + lane * 8;
#pragma unroll
                      for (int tp = 0; tp < 4; ++tp) *(bf16x8*)(sp + 512 * tp) = sB[tp]; }
                    WAIT_LGKM0();
                    RAW_BARRIER();
                    const LAS unsigned char* slot = (const LAS unsigned char*)smem + (n % CH_NSLOT) * CH_SLOT + lane * 16; LAUNDER_V(slot);
                    { const LAS unsigned char* us = (const LAS unsigned char*)smem + (n % CH_NSLOT) * CH_SLOT + 32768 + ((16 * wave + j) * 64 + 4 * q) * 2; LAUNDER_V(us);
#pragma unroll
                      for (int mt = 0; mt < 4; ++mt) { const u32x2 w = *(const LAS u32x2*)(us + 32 * mt); acc[mt] = (f32x4){bf2f((bf16_t)(w.x & 0xffff)), bf2f((bf16_t)(w.x >> 16)), bf2f((bf16_t)(w.y & 0xffff)), bf2f((bf16_t)(w.y >> 16))}; } }
                    bf16x8 fa[8], fb[8];
#pragma unroll
                    for (int i = 0; i < 8; ++i) fa[i] = *(const LAS bf16x8*)(slot + i * 1024);
#pragma unroll
                    for (int i = 0; i < 8; ++i) fb[i] = *(const LAS bf16x8*)(slot + (8 + i) * 1024);
                    COMPILER_FENCE();
#pragma unroll
                    for (int ks = 0; ks < 4; ++ks) { acc[0] = MFMA16(fa[ks], sB[ks], acc[0]); acc[1] = MFMA16(fa[4 + ks], sB[ks], acc[1]); }
                    COMPILER_FENCE();
#pragma unroll
                    for (int i = 0; i < 8; ++i) fa[i] = *(const LAS bf16x8*)(slot + 16384 + i * 1024);
#pragma unroll
                    for (int ks = 0; ks < 4; ++ks) { acc[2] = MFMA16(fb[ks], sB[ks], acc[2]); acc[3] = MFMA16(fb[4 + ks], sB[ks], acc[3]); }
                    COMPILER_FENCE();
#pragma unroll
                    for (int i = 0; i < 8; ++i) fb[i] = *(const LAS bf16x8*)(slot + 16384 + (8 + i) * 1024);
                    const bf16x8 vB0 = pack_tiles(acc[0], acc[1]), vB1 = pack_tiles(acc[2], acc[3]);
                    { bf16_t* vp = WSP(bf16_t, WS_GV) + (size_t)u * 8192 + (size_t)sl * 1024 + lane * 8;
                      *(bf16x8*)vp = vB0; *(bf16x8*)(vp + 512) = vB1; }
#pragma unroll
                    for (int t = 0; t < 8; ++t) S[t] = S[t] * dec;
                    COMPILER_FENCE();
#pragma unroll
                    for (int t = 0; t < 4; ++t) S[t] = MFMA16(fa[2 * t], vB0, S[t]);
#pragma unroll
                    for (int t = 0; t < 4; ++t) S[t] = MFMA16(fa[2 * t + 1], vB1, S[t]);
#pragma unroll
                    for (int t = 0; t < 4; ++t) S[4 + t] = MFMA16(fb[2 * t], vB0, S[4 + t]);
#pragma unroll
                    for (int t = 0; t < 4; ++t) S[4 + t] = MFMA16(fb[2 * t + 1], vB1, S[4 + t]);
                    COMPILER_FENCE();
#pragma unroll
                    for (int ks = 0; ks < 4; ++ks) sB[ks] = pack_tiles(S[2 * ks], S[2 * ks + 1]);
                }
            }
            float* o = p.out + O_PGDN + ((size_t)l * PB * 4 + bh) * 16384 + c;
#pragma unroll
            for (int t = 0; t < 8; ++t)
#pragma unroll
                for (int e = 0; e < 4; ++e) o[(size_t)(16 * t + 4 * q + e) * 128] = S[t][e];
        }
    }
}
__device__ __forceinline__ void ph_gdn_out(const P& p, int l, unsigned char* smem) {
    const int tid = tidx(), lane = tid & 63, wave = tid >> 6, j = lane & 15, q = lane >> 4, mt = wave & 3;
    const bf16_t* PR = WSP(bf16_t, WS_PROJ);
    for (int u = blockIdx.x * 2 + (wave >> 2); u < NUNIT; u += gridDim.x * 2) {
        const int n = u % NCH, h = (u / NCH) % 4, b = u / (NCH * 4);
        f32x4 acc[8];
#pragma unroll
        for (int ct = 0; ct < 8; ++ct) acc[ct] = (f32x4){0.f, 0.f, 0.f, 0.f};
        const bf16_t* qg = WSP(bf16_t, WS_GQ) + (size_t)u * 8192 + (16 * mt + j) * 128 + 8 * q;
        const bf16_t* st = WSP(bf16_t, WS_GS) + (size_t)u * 16384 + ((2 * (q & 1)) * 16 + j) * 8 + (q >> 1) * 4;
#pragma unroll
        for (int ks = 0; ks < 4; ++ks) { const bf16x8 a = *(const bf16x8*)(qg + 32 * ks);
#pragma unroll
            for (int ct = 0; ct < 8; ++ct) { const bf16_t* sp = st + (size_t)ct * 2048 + ks * 512; const u32x2 lo = *(const u32x2*)sp, hi = *(const u32x2*)(sp + 128); u32x4 w; w.x = lo.x; w.y = lo.y; w.z = hi.x; w.w = hi.y;
                acc[ct] = MFMA16(a, __builtin_bit_cast(bf16x8, w), acc[ct]); }
            COMPILER_FENCE(); }
        const bf16_t* at = WSP(bf16_t, WS_GA) + (size_t)u * 4096 + (16 * mt + j) * 64 + 8 * q;
        const bf16_t* vt = WSP(bf16_t, WS_GV) + (size_t)u * 8192 + ((2 * (q & 1)) * 16 + j) * 8 + (q >> 1) * 4;
#pragma unroll
        for (int ks = 0; ks < 2; ++ks) { const bf16x8 a = *(const bf16x8*)(at + 32 * ks);
#pragma unroll
            for (int ct = 0; ct < 8; ++ct) { const bf16_t* vp = vt + (size_t)ct * 1024 + ks * 512; const u32x2 lo = *(const u32x2*)vp, hi = *(const u32x2*)(vp + 128); u32x4 w; w.x = lo.x; w.y = lo.y; w.z = hi.x; w.w = hi.y;
                acc[ct] = MFMA16(a, __builtin_bit_cast(bf16x8, w), acc[ct]); }
            COMPILER_FENCE(); }
        float sq[4];
#pragma unroll
        for (int e = 0; e < 4; ++e) { float s = 0.f;
#pragma unroll
            for (int ct = 0; ct < 8; ++ct) s += acc[ct][e] * acc[ct][e];
            s += __shfl_xor(s, 1); s += __shfl_xor(s, 2); s += __shfl_xor(s, 4); s += __shfl_xor(s, 8); sq[e] = 1.0f / sqrtf(s * (1.0f / 128.0f) + EPS); }
        float* stg = (float*)smem + wave * (16 * 132);
#pragma unroll
        for (int e = 0; e < 4; ++e)
#pragma unroll
            for (int ct = 0; ct < 8; ++ct) stg[(4 * q + e) * 132 + 16 * ct + j] = acc[ct][e] * sq[e];
        WAVE_SYNC();
        { const int rr = lane >> 2, cg = lane & 3; const size_t row = (size_t)(b * T + n * 64 + 16 * mt + rr);
#pragma unroll
          for (int k4 = 0; k4 < 4; ++k4) { const int c0 = cg * 32 + k4 * 8; const f32x4 o0 = *(const f32x4*)(stg + rr * 132 + c0), o1 = *(const f32x4*)(stg + rr * 132 + c0 + 4);
              float z[8]; unpack8(*(const u32x4*)(PR + row * NPROJ + C_Z + h * 128 + c0), z); const f32x4 n0 = *(const f32x4*)(p.gdn_norm + l * 128 + c0), n1 = *(const f32x4*)(p.gdn_norm + l * 128 + c0 + 4);
              float r8[8];
#pragma unroll
              for (int i = 0; i < 4; ++i) { r8[i] = o0[i] * n0[i] * silu_fast(z[i]); r8[4 + i] = o1[i] * n1[i] * silu_fast(z[4 + i]); }
              *(u32x4*)(WSP(bf16_t, WS_O) + row * D + 512 + h * 128 + c0) = pack8f(r8); } }
        WAVE_SYNC();
    }
}
__device__ __forceinline__ void ph_gdn_sample(const P& p, int l, unsigned char* smem) {
    float* qs = (float*)smem; float* ks = qs + 8 * QP; float* vs = ks + 8 * QP; float* us = vs + 8 * QP; float* wsm = us + 8 * 128; float* vn = wsm + 8 * 128;
    float* Ls = vn + 8 * 128; float* As = Ls + 8 * 8; float* gs = As + 8 * 8; float* gcs = gs + 8; float* bts = gcs + 8; float* S0 = bts + 8;
    const int tid = tidx(); const bf16_t* PR = WSP(bf16_t, WS_PROJ);
    for (int u = gridDim.x - 1 - blockIdx.x; u < DB * 4; u += gridDim.x) {
        const int h = u & 3, b = u >> 2;
        __syncthreads();
#pragma unroll 4
        for (int e = tid; e < 16384; e += NTHR) S0[e] = p.state_gdn[(((size_t)l * DB + b) * 4 + h) * 16384 + e];
        if (tid < 384) { const int sec = tid >> 7, c = tid & 127, col = sec * 512 + h * 128 + c; float* dst = sec == 0 ? qs : sec == 1 ? ks : vs;
            const float w0 = p.conv_w[(l * 4 + 0) * 1536 + col], w1 = p.conv_w[(l * 4 + 1) * 1536 + col], w2 = p.conv_w[(l * 4 + 2) * 1536 + col], w3 = p.conv_w[(l * 4 + 3) * 1536 + col];
            const float* hist = p.state_conv + (((size_t)l * DB + b) * 3) * 1536 + col; const bf16_t* src = PR + (size_t)(MP + b * DS) * NPROJ + C_CONV + col;
            float x0 = hist[0], x1 = hist[1536], x2 = hist[2 * 1536];
            for (int i = 0; i < DS; ++i) { const float x3 = bf2f(src[(size_t)i * NPROJ]); const float y = w0 * x0 + w1 * x1 + w2 * x2 + w3 * x3; dst[i * QP + c] = silu_f(y); x0 = x1; x1 = x2; x2 = x3; } }
        else if (tid < 384 + DS) { const int i = tid - 384; const size_t row = (size_t)(MP + b * DS + i); gs[i] = WSP(float, WS_G)[row * 4 + h]; bts[i] = WSP(float, WS_BETA)[row * 4 + h]; }
        __syncthreads();
        if (tid < 64) { const int rid = tid >> 2, part = tid & 3; float* rowp = (rid < 8 ? qs + rid * QP : ks + (rid - 8) * QP) + part * 32; float s = 0.f;
            for (int d = 0; d < 32; ++d) s += rowp[d] * rowp[d];
            s += __shfl_xor(s, 1); s += __shfl_xor(s, 2); const float sc = 1.0f / sqrtf(s + EPS);
            for (int d = 0; d < 32; ++d) rowp[d] *= sc; }
        if (tid == 64) { float a = 0.f; for (int i = 0; i < DS; ++i) { a += gs[i]; gcs[i] = a; } }
        __syncthreads();
        if (tid < 64) { const int i = tid >> 3, j = tid & 7; float lv = 0.f, av = 0.f;
            if (j <= i) { float dk = 0.f, dq = 0.f; for (int d = 0; d < 128; ++d) { const float kj = ks[j * QP + d]; dk += ks[i * QP + d] * kj; dq += qs[i * QP + d] * kj; }
                const float e = expf(gcs[i] - gcs[j]); av = dq * e * 0.08838834764831845f; lv = j < i ? bts[i] * dk * e : 0.f; }
            Ls[i * 8 + j] = lv; As[i * 8 + j] = av; }
        __syncthreads();
        if (tid < 256) { const int c = tid; float X[8];
            if (c < 128) {
#pragma unroll
                for (int i = 0; i < 8; ++i) X[i] = vs[i * QP + c] * bts[i]; }
            else {
#pragma unroll
                for (int i = 0; i < 8; ++i) X[i] = ks[i * QP + c - 128] * bts[i] * expf(gcs[i]); }
            fwd_subst<8, 8>(X, Ls);
            float* dst = c < 128 ? us + c : wsm + c - 128;
#pragma unroll
            for (int i = 0; i < 8; ++i) dst[i * 128] = X[i]; }
        __syncthreads();
        const int i = tid >> 6, c2 = (tid & 63) * 2;
        { float a0 = us[i * 128 + c2], a1 = us[i * 128 + c2 + 1];
          for (int d = 0; d < 128; ++d) { const float w = wsm[i * 128 + d]; a0 -= w * S0[d * 128 + c2]; a1 -= w * S0[d * 128 + c2 + 1]; }
          vn[i * 128 + c2] = a0; vn[i * 128 + c2 + 1] = a1; }
        __syncthreads();
        { float o0 = 0.f, o1 = 0.f; const float qsc = 0.08838834764831845f * expf(gcs[i]);
          for (int d = 0; d < 128; ++d) { const float qg = qs[i * QP + d] * qsc; o0 += qg * S0[d * 128 + c2]; o1 += qg * S0[d * 128 + c2 + 1]; }
          for (int j = 0; j < DS; ++j) { const float a = As[i * 8 + j]; o0 += a * vn[j * 128 + c2]; o1 += a * vn[j * 128 + c2 + 1]; }
          const float rstd = 1.0f / sqrtf(wave_sum(o0 * o0 + o1 * o1) * (1.0f / 128.0f) + EPS);
          const size_t row = (size_t)(MP + b * DS + i);
          const float z0 = bf2f(PR[row * NPROJ + C_Z + h * 128 + c2]), z1 = bf2f(PR[row * NPROJ + C_Z + h * 128 + c2 + 1]);
          bf16_t* O = WSP(bf16_t, WS_O) + row * D + 512 + h * 128 + c2;
          O[0] = f2bf(o0 * rstd * p.gdn_norm[l * 128 + c2] * silu_f(z0)); O[1] = f2bf(o1 * rstd * p.gdn_norm[l * 128 + c2 + 1] * silu_f(z1)); }
        { const float gl = gcs[DS - 1], dec = expf(gl); float* o = p.out + O_SGDN + (((size_t)l * DB + b) * 4 + h) * 16384;
#pragma unroll 2
          for (int e = tid; e < 16384; e += NTHR) { const int d = e >> 7, c = e & 127; float s = S0[e] * dec;
              for (int j = 0; j < DS; ++j) s += ks[j * QP + d] * expf(gl - gcs[j]) * vn[j * 128 + c];
              o[e] = s; } }
    }
}


template <int K> __device__ __forceinline__ void ph_gemm_small(const P& p, const bf16_t* A  , const bf16_t* Bt  , const float* gate, const float* xs_in  , unsigned char* smem) {
    static_assert(MS % 16 == 0 && K % 256 == 0, "small GEMM shape");
    constexpr int KW = K / 8, NKS = KW / 32;
    const int tid = tidx(), lane = tid & 63, wave = tid >> 6, x = lane & 15, q = lane >> 4;
    float* red = (float*)smem;
    for (int it = blockIdx.x; it < (MS / 16) * 16; it += gridDim.x) {
        const int rt = it % (MS / 16), cg = it / (MS / 16);
        const bf16_t* ap = A + (size_t)(16 * rt + x) * K + wave * KW + 8 * q;
        const bf16_t* bp = Bt + (size_t)(64 * cg + x) * K + wave * KW + 8 * q;
        f32x4 acc[4];
#pragma unroll
        for (int ct = 0; ct < 4; ++ct) acc[ct] = (f32x4){0.f, 0.f, 0.f, 0.f};
#pragma unroll
        for (int ks = 0; ks < NKS; ++ks) { const bf16x8 a = *(const bf16x8*)(ap + 32 * ks);
#pragma unroll
            for (int ct = 0; ct < 4; ++ct) acc[ct] = MFMA16(a, *(const bf16x8*)(bp + (size_t)ct * 16 * K + 32 * ks), acc[ct]); }
        __syncthreads();
#pragma unroll
        for (int ct = 0; ct < 4; ++ct) *(f32x4*)(red + ((wave * 4 + ct) * 64 + lane) * 4) = acc[ct];
        __syncthreads();
        if (wave < 4) { f32x4 s = (f32x4){0.f, 0.f, 0.f, 0.f};
#pragma unroll
            for (int w = 0; w < 8; ++w) s += *(const f32x4*)(red + ((w * 4 + wave) * 64 + lane) * 4);
            const int col = 64 * cg + 16 * wave + x;
#pragma unroll
            for (int e = 0; e < 4; ++e) { const int row = MP + 16 * rt + 4 * q + e; float* xp = p.out + (size_t)row * D + col; const float xin = xs_in ? xs_in[(size_t)(row - MP) * D + col] : *xp; *xp = xin + gate[(size_t)row_cb(row) * 6144 + col] * s[e]; } }
    }
}

__device__ __forceinline__ void ph_final_norm(const P& p) {
    const int lane = tidx() & 63, wave = tidx() >> 6, gw = blockIdx.x * 8 + wave, ngw = gridDim.x * 8;
    for (int r = gw; r < M; r += ngw) {
        float* xr = p.out + (size_t)r * D; f32x4 v[4]; float ss = 0.f;
#pragma unroll
        for (int j = 0; j < 4; ++j) { v[j] = *(const f32x4*)(xr + 4 * lane + 256 * j); ss += (v[j][0] * v[j][0] + v[j][1] * v[j][1]) + (v[j][2] * v[j][2] + v[j][3] * v[j][3]); }
        const float rstd = 1.0f / sqrtf(wave_sum(ss) * (1.0f / D) + EPS);
#pragma unroll
        for (int j = 0; j < 4; ++j) { const f32x4 g = *(const f32x4*)(p.final_norm + 4 * lane + 256 * j); *(f32x4*)(xr + 4 * lane + 256 * j) = v[j] * rstd * g; }
    }
}

enum Phase { PH_PRO = 0, PH_NORM1, PH_GEMM_IN, PH_ROPE, PH_MIX1, PH_MIX2, PH_MIX3, PH_GEMM_OUT, PH_NORM2, PH_GEMM_GU, PH_GEMM_DN, PH_FINAL };
#ifdef __HIP_EMU__
#define LDSP(x) (x)
#else
#define LDSP(x) ((PG8_LAS unsigned char*)(x))
#endif
template <int PH> __device__ __forceinline__ void run_phase(const P& p, int l, unsigned char* smem) {
    if constexpr (PH == PH_PRO) { ph_convert(p, smem, 0, CV_IN, 0, (int)gridDim.x); __syncthreads(); ph_adaln(p, smem, 0, 1, 0, (int)gridDim.x); ph_ropetab_copyx(p); }
    else if constexpr (PH == PH_NORM1) ph_norm_mod<0>(p, l);
    else if constexpr (PH == PH_GEMM_IN) {
        pg8::Gemm g{WSP(bf16_t, WS_H), WSP(bf16_t, WS_WIN) + (size_t)l * NPROJ * D, MPAD, NPROJ, D}; pg8::StaticOrder S; S.init(MPAD, NPROJ, (int)gridDim.x, (int)blockIdx.x);
        pg8::EpiStoreBf16 E{WSP(bf16_t, WS_PROJ), NPROJ};
        pg8::gemm_phase<pg8::EpiStoreBf16, pg8::StaticOrder, true, true>(LDSP(smem), g, S, E);
    }
    else if constexpr (PH == PH_ROPE) { ph_rope_out(p, l); ph_vtrans(p, l, smem); }
    else if constexpr (PH == PH_MIX1) { ph_ret_local(p, l); ph_gdn_prep(p, l, smem); }
    else if constexpr (PH == PH_MIX2) { ph_gdn_chain(p, l, smem); { const int G = (int)gridDim.x; const bool split = G >= CH_ITEMS + DB * 4 + 16; ph_attn_jobs(p, split ? CH_ITEMS : 0, split ? G - DB * 4 : G, split ? 3 : 0); }
        __syncthreads(); ph_attn_sample(p, l, smem); ph_ret_sample(p, l, smem); ph_gdn_sample(p, l, smem); ph_ret_scan(p, l);
        if (l + 1 < NL) { const int G = (int)gridDim.x; const bool split = G >= CH_ITEMS + DB * 4 + 16; const int b0 = split ? CH_ITEMS : 0;
            __syncthreads(); ph_convert(p, smem, l == 0 ? CV_IN : (l + 1) * CV_L, (l + 2) * CV_L, b0, G); __syncthreads(); ph_adaln(p, smem, l + 1, l + 2, b0, G); } }
    else if constexpr (PH == PH_MIX3) { ph_attn_combine(p); ph_ret_out(p, l); ph_gdn_out(p, l, smem); }
    else if constexpr (PH == PH_GEMM_OUT) {
        ph_gemm_small<D>(p, WSP(bf16_t, WS_O) + (size_t)MP * D, WSP(bf16_t, WS_WOUT) + (size_t)l * D * D, WSP(float, WS_MOD) + (size_t)l * NC * 6144 + 2048, l == 0 ? p.x_sample : nullptr, smem); __syncthreads();
        pg8::Gemm g{WSP(bf16_t, WS_O), WSP(bf16_t, WS_WOUT) + (size_t)l * D * D, MP, D, D}; pg8::StaticOrder S; S.init(MP, D, (int)gridDim.x, (int)blockIdx.x);
        pg8::EpiResidual E{p.out, WSP(float, WS_MOD) + (size_t)l * NC * 6144 + 2048, l == 0 ? p.x_prompt : p.out};
        pg8::gemm_phase<pg8::EpiResidual, pg8::StaticOrder, true, true>(LDSP(smem), g, S, E);
    }
    else if constexpr (PH == PH_NORM2) ph_norm_mod<1>(p, l);
    else if constexpr (PH == PH_GEMM_GU) {
        pg8::Gemm g{WSP(bf16_t, WS_H), WSP(bf16_t, WS_WGU) + (size_t)l * 2 * FF * D, MPAD, 2 * FF, D}; pg8::StaticOrder S; S.init(MPAD, 2 * FF, (int)gridDim.x, (int)blockIdx.x);
        pg8::EpiSwiglu E{WSP(bf16_t, WS_HID)};
        pg8::gemm_phase<pg8::EpiSwiglu, pg8::StaticOrder, true, true>(LDSP(smem), g, S, E);
    }
    else if constexpr (PH == PH_GEMM_DN) {
        ph_gemm_small<FF>(p, WSP(bf16_t, WS_HID) + (size_t)MP * FF, WSP(bf16_t, WS_WDN) + (size_t)l * D * FF, WSP(float, WS_MOD) + (size_t)l * NC * 6144 + 5120, nullptr, smem); __syncthreads();
        pg8::Gemm g{WSP(bf16_t, WS_HID), WSP(bf16_t, WS_WDN) + (size_t)l * D * FF, MP, D, FF}; pg8::StaticOrder S; S.init(MP, D, (int)gridDim.x, (int)blockIdx.x);
        pg8::EpiResidual E{p.out, WSP(float, WS_MOD) + (size_t)l * NC * 6144 + 5120, p.out};
        pg8::gemm_phase<pg8::EpiResidual, pg8::StaticOrder, true, true>(LDSP(smem), g, S, E);
    }
    else if constexpr (PH == PH_FINAL) ph_final_norm(p);
}
template <int PH> __global__ void __launch_bounds__(NTHR, 2) k_phase(P p, int l) { DYN_SMEM(smem); run_phase<PH>(p, l, smem); }


#ifndef __HIP_EMU__
#define LAS __attribute__((address_space(3)))
#define XB_TMO      128
#define XB_XCNT(j)  (256  + 64 * (j))
#define XB_XSUB(j)  (1280 + 64 * (j))
#define XB_XGEN(j)  (2304 + 64 * (j))
#define XB_TOP      3328
#define XB_TOPGEN   3392
#define XCD_BAR_WORDS 3456
#define XB_SPIN_CAP (1u << 18)

__device__ __forceinline__ unsigned xb_ld(unsigned* p)              { return __hip_atomic_load(p, __ATOMIC_RELAXED, __HIP_MEMORY_SCOPE_AGENT); }
__device__ __forceinline__ unsigned xb_add(unsigned* p, unsigned v) { return __hip_atomic_fetch_add(p, v, __ATOMIC_RELAXED, __HIP_MEMORY_SCOPE_AGENT); }
__device__ __forceinline__ unsigned xb_xcc_id() { return (unsigned)__builtin_amdgcn_s_getreg((3 << 11) | 20) & 0xFu; }
#define XB_SPIN(cond, bar) do { unsigned _sp = 0; while (cond) { __builtin_amdgcn_s_sleep(1); \
    if ((++_sp & 255u) == 0u) { if (xb_ld(&(bar)[XB_TMO])) break; if (_sp > XB_SPIN_CAP) { atomicAdd(&(bar)[XB_TMO], 1u); break; } } } } while (0)

struct XcdBarrier {
    unsigned* bar; unsigned x;
    volatile LAS unsigned* st;
};

__device__ __forceinline__ XcdBarrier xcd_barrier_post(unsigned* bar, volatile LAS unsigned* st) {
    XcdBarrier b; b.bar = bar; b.x = xb_xcc_id(); b.st = st;
    if (threadIdx.x == 0) (void)xb_add(&bar[XB_XCNT(b.x)], 1u);
    return b;
}
__device__ __forceinline__ void xcd_barrier_complete(unsigned* bar, unsigned x, unsigned& nloc, unsigned& nx) {
    const unsigned G = gridDim.x * gridDim.y * gridDim.z;
    unsigned sum, cnt, mine, sp = 0u;
    for (;;) {
        sum = 0u; cnt = 0u; mine = 0u;
#pragma unroll
        for (unsigned j = 0; j < 16; ++j) { const unsigned c = xb_ld(&bar[XB_XCNT(j)]); sum += c; cnt += (c > 0u) ? 1u : 0u; mine = (j == x) ? c : mine; }
        if (sum == G) break;
        __builtin_amdgcn_s_sleep(1);
        if ((++sp & 255u) == 0u) { if (xb_ld(&bar[XB_TMO])) break; if (sp > XB_SPIN_CAP) { atomicAdd(&bar[XB_TMO], 1u); break; } }
    }
    nloc = mine > 0u ? mine : 1u; nx = cnt > 0u ? cnt : 1u;
}

__device__ __forceinline__ void xcd_barrier(const XcdBarrier& b) {
    asm volatile("s_waitcnt vmcnt(0)" ::: "memory");
    __syncthreads();
    if (threadIdx.x == 0) {
        unsigned* bar = b.bar;
        __builtin_amdgcn_s_waitcnt(0);
        unsigned nloc = b.st[0], nx = b.st[1];
        if (nloc == 0u) { xcd_barrier_complete(bar, b.x, nloc, nx); b.st[0] = nloc; b.st[1] = nx; }
        const unsigned old = xb_add(&bar[XB_XSUB(b.x)], 1u);
        const unsigned gen = old / nloc;
        if (old + 1u == (gen + 1u) * nloc) {
            __builtin_amdgcn_fence(__ATOMIC_RELEASE, "agent");
            asm volatile("s_waitcnt vmcnt(0)" ::: "memory");
            const unsigned og = xb_add(&bar[XB_TOP], 1u);
            const unsigned tg = og / nx;
            if (og + 1u == (tg + 1u) * nx) xb_add(&bar[XB_TOPGEN], 1u);
            else XB_SPIN(xb_ld(&bar[XB_TOPGEN]) == tg, bar);
            __builtin_amdgcn_fence(__ATOMIC_ACQUIRE, "agent");
            xb_add(&bar[XB_XGEN(b.x)], 1u);
            asm volatile("s_waitcnt vmcnt(0)" ::: "memory");
        } else {
            XB_SPIN(xb_ld(&bar[XB_XGEN(b.x)]) == gen, bar);
            __builtin_amdgcn_fence(__ATOMIC_ACQUIRE, "agent");
            asm volatile("s_waitcnt vmcnt(0)" ::: "memory");
        }
    }
    __syncthreads();
}

#endif

#ifndef __HIP_EMU__
#define GRID_SYNC() xcd_barrier(bar)
__global__ void __launch_bounds__(NTHR, 2) k_mega(P p_arg) {
    DYN_SMEM(smem);
#if defined(__HIP_DEVICE_COMPILE__)
#define PHASE(PH_, l_) do { const __attribute__((address_space(4))) P* kp_ = (const __attribute__((address_space(4))) P*)__builtin_amdgcn_kernarg_segment_ptr(); LAUNDER_PTR(kp_); P pl_; __builtin_memcpy(&pl_, kp_, sizeof(P)); run_phase<PH_>(pl_, l_, smem); } while (0)
#else
#define PHASE(PH_, l_) run_phase<PH_>(p_arg, l_, smem)
#endif
    cooperative_groups::grid_group grid = cooperative_groups::this_grid();
    volatile LAS unsigned* bst = (volatile LAS unsigned*)((LAS unsigned char*)smem + BAR_LDS_OFF);
    if (threadIdx.x < 4) bst[threadIdx.x] = 0u;
    __syncthreads();
    XcdBarrier bar = xcd_barrier_post((unsigned*)(p_arg.ws + WS_CTL + 4096), bst);
    PHASE(PH_PRO, 0); grid.sync();
#define LAYER(l) do { PHASE(PH_NORM1, l); GRID_SYNC(); PHASE(PH_GEMM_IN, l); GRID_SYNC(); PHASE(PH_ROPE, l); GRID_SYNC(); PHASE(PH_MIX1, l); GRID_SYNC(); PHASE(PH_MIX2, l); GRID_SYNC(); \
        PHASE(PH_MIX3, l); GRID_SYNC(); PHASE(PH_GEMM_OUT, l); GRID_SYNC(); PHASE(PH_NORM2, l); GRID_SYNC(); PHASE(PH_GEMM_GU, l); GRID_SYNC(); PHASE(PH_GEMM_DN, l); GRID_SYNC(); } while (0)
    static_assert(NL == 2, "two layers written out (a loop over the layers makes hipcc hoist every phase's constants to the loop preheader and spill)");
    LAYER(0); LAYER(1);
    PHASE(PH_FINAL, 0);
}
#endif

template <int PH> static void launch_phase(const P& p, int l, int grid, hipStream_t stream) {
#ifndef __HIP_EMU__
    static bool attr_done = false;
    if (!attr_done) { (void)hipFuncSetAttribute((const void*)k_phase<PH>, hipFuncAttributeMaxDynamicSharedMemorySize, SMEM_BYTES); attr_done = true; }
#endif
    LAUNCH(k_phase<PH>, grid, SMEM_BYTES, stream, p, l);
}

extern "C" void kernel_launch(void* const* d_in, const int* in_sizes, int n_in, void* d_out, int out_size, void* d_ws, size_t ws_size, hipStream_t stream) {
    if (n_in != 24 || (size_t)out_size != O_END || ws_size < WS_END) {
        fprintf(stderr, "kernel_launch: shape mismatch: n_in %d out_size %d (want %zu) ws %zu (want %zu)\n", n_in, out_size, (size_t)O_END, ws_size, (size_t)WS_END); return; }
    P p{};
    const float** pp = (const float**)&p;
    for (int i = 0; i < 24; ++i) pp[i] = (const float*)d_in[i];
    p.out = (float*)d_out; p.ws = (unsigned char*)d_ws;
#ifndef __HIP_EMU__
    static int grid = 0;
    if (grid == 0) {
        int dev = 0, cus = 0, per_cu = 0;
        if (hipGetDevice(&dev) != hipSuccess || hipDeviceGetAttribute(&cus, hipDeviceAttributeMultiprocessorCount, dev) != hipSuccess || cus <= 0) { fprintf(stderr, "kernel_launch: device query failed\n"); grid = -1; return; }
        if (hipFuncSetAttribute((const void*)k_mega, hipFuncAttributeMaxDynamicSharedMemorySize, SMEM_BYTES) != hipSuccess) { fprintf(stderr, "kernel_launch: hipFuncSetAttribute failed\n"); grid = -1; return; }
        if (hipOccupancyMaxActiveBlocksPerMultiprocessor(&per_cu, (const void*)k_mega, NTHR, SMEM_BYTES) != hipSuccess || per_cu < 1) { fprintf(stderr, "kernel_launch: occupancy query says %d blocks per CU\n", per_cu); grid = -1; return; }
        grid = cus;
    }
    if (grid < 0) return;
    if (hipMemsetAsync((char*)d_ws + WS_CTL, 0, 65536, stream) != hipSuccess) { fprintf(stderr, "kernel_launch: memset of the barrier words failed\n"); return; }
    { void* args[] = {(void*)&p};
      hipError_t e = hipLaunchCooperativeKernel((const void*)k_mega, dim3(grid), dim3(NTHR), args, SMEM_BYTES, stream);
      if (e != hipSuccess) fprintf(stderr, "kernel_launch: cooperative launch failed: %s (grid %d)\n", hipGetErrorString(e), grid);
      return; }
#else
    int grid = 16;
#endif
    launch_phase<PH_PRO>(p, 0, grid, stream);
    for (int l = 0; l < NL; ++l) {
        launch_phase<PH_NORM1>(p, l, grid, stream);
        launch_phase<PH_GEMM_IN>(p, l, grid, stream);
        launch_phase<PH_ROPE>(p, l, grid, stream);
        launch_phase<PH_MIX1>(p, l, grid, stream);
        launch_phase<PH_MIX2>(p, l, grid, stream);
        launch_phase<PH_MIX3>(p, l, grid, stream);
        launch_phase<PH_GEMM_OUT>(p, l, grid, stream);
        launch_phase<PH_NORM2>(p, l, grid, stream);
        launch_phase<PH_GEMM_GU>(p, l, grid, stream);
        launch_phase<PH_GEMM_DN>(p, l, grid, stream);
    }
    launch_phase<PH_FINAL>(p, 0, grid, stream);
}
```

```cpp
#ifndef __HIP_EMU__
#include <hip/hip_runtime.h>
#include <hip/hip_cooperative_groups.h>
#endif
#include <cstdio>
#include <cstdint>
#include <cmath>

#ifndef CFG_BATCH
#define CFG_BATCH 2
#endif
#ifndef CFG_SEQ
#define CFG_SEQ 8192
#endif
#ifndef CFG_DB
#define CFG_DB 32
#endif
constexpr float LOG2E = 1.4426950408889634f;
constexpr int D = 1024, NL = 2, PB = CFG_BATCH, T = CFG_SEQ, DB = CFG_DB, DS = 8, PAST = 16384, WB = 2048;
constexpr int MP = PB * T, MS = DB * DS, M = MP + MS, MPAD = (M + 255) / 256 * 256, NC = PB + DB;
constexpr int INC = 3848, NPROJ = 3840, FF = 2816, NCH = T / 64, PWIN = T < 2048 ? T : 2048, NPOS = T + DS;
constexpr int NUNIT = PB * 4 * NCH;
constexpr float EPS = 1e-6f;
static_assert(T % 512 == 0, "the attention job decomposition wants T % 512 == 0");
constexpr int C_QA = 0, C_KA = 256, C_VA = 512, C_QR = 768, C_KR = 1024, C_VR = 1280, C_GR = 1536, C_CONV = 1792, C_Z = 3328;
constexpr int SMEM_BYTES = 148480;
constexpr int NTHR = 512;
constexpr int BAR_LDS_OFF = SMEM_BYTES - 64;

typedef unsigned short bf16_t;
typedef short bf16x8 __attribute__((ext_vector_type(8)));
typedef float f32x4 __attribute__((ext_vector_type(4)));
typedef unsigned u32x4 __attribute__((ext_vector_type(4)));
typedef unsigned u32x2 __attribute__((ext_vector_type(2)));
typedef float f32x16 __attribute__((ext_vector_type(16)));

#ifdef __HIP_EMU__
#define LAUNCH(kern, grid, lds, stream, ...) emu_launch(grid, NTHR, [=]() { kern(__VA_ARGS__); })
#define DYN_SMEM(name) unsigned char* name = emu_dyn_smem()
#define WAVE_SYNC() emu_wave_bar()
#define MFMA32(a, b, c) emu_mfma32(a, b, c)
#define GLDS16(gp, lp) memcpy((unsigned char*)(lp) + (threadIdx.x & 63) * 16, (gp), 16)
#define RAW_BARRIER() __syncthreads()
#define GLDS4(gp, lp) ((void)0)
#define WAIT_VM(n)
#define WAIT_LGKM0()
#define LAS
#define UNIFORM(x) (x)
#define COMPILER_FENCE()
#define LAUNDER_V(x)
#define MFMA16(a, b, c) emu_mfma16(a, b, c)
#else
#define WAVE_SYNC() asm volatile("s_waitcnt lgkmcnt(0)" ::: "memory")
#define MFMA32(a, b, c) __builtin_amdgcn_mfma_f32_32x32x16_bf16(a, b, c, 0, 0, 0)
#define LAS __attribute__((address_space(3)))
#define GLDS16(gp, lp) __builtin_amdgcn_global_load_lds((const unsigned*)(gp), (LAS unsigned*)(lp), 16, 0, 0)
#define RAW_BARRIER() __builtin_amdgcn_s_barrier()
#define GLDS4(gp, lp) __builtin_amdgcn_global_load_lds((const unsigned*)(gp), (LAS unsigned*)(lp), 4, 0, 0)
#define WAIT_VM(n) asm volatile("s_waitcnt vmcnt(" #n ")" ::: "memory")
#define WAIT_LGKM0() asm volatile("s_waitcnt lgkmcnt(0)" ::: "memory")
#define UNIFORM(x) __builtin_amdgcn_readfirstlane(x)
#define COMPILER_FENCE() __builtin_amdgcn_sched_barrier(0)
#define LAUNDER_V(x) asm volatile("" : "+v"(x))
#define MFMA16(a, b, c) __builtin_amdgcn_mfma_f32_16x16x32_bf16(a, b, c, 0, 0, 0)
#define LAUNCH(kern, grid, lds, stream, ...) hipLaunchKernelGGL(kern, dim3(grid), dim3(NTHR), lds, stream, __VA_ARGS__)
#define DYN_SMEM(name) extern __shared__ __attribute__((aligned(16))) unsigned char name[]
#endif

#ifdef __HIP_EMU__
__device__ __forceinline__ int tidx() { return (int)threadIdx.x; }
#define LAUNDER_PTR(x)
#else
__device__ __forceinline__ int tidx() { int t = (int)threadIdx.x; asm volatile("" : "+v"(t)); return t; }
#define LAUNDER_PTR(x) asm volatile("" : "+s"(x))
#endif
__device__ __forceinline__ float bf2f(bf16_t v) { return __builtin_bit_cast(float, (unsigned)v << 16); }
__device__ __forceinline__ bf16_t f2bf(float f) { unsigned u = __builtin_bit_cast(unsigned, f); return (bf16_t)((u + 0x7fffu + ((u >> 16) & 1u)) >> 16); }
#ifdef __HIP_EMU__
__device__ __forceinline__ unsigned pk2(float lo, float hi) { return (unsigned)f2bf(lo) | ((unsigned)f2bf(hi) << 16); }
#else
typedef float f32x2_t __attribute__((ext_vector_type(2))); typedef __bf16 bf16x2_t __attribute__((ext_vector_type(2)));
__device__ __forceinline__ unsigned pk2(float lo, float hi) { f32x2_t v = {lo, hi}; bf16x2_t b = __builtin_convertvector(v, bf16x2_t); return __builtin_bit_cast(unsigned, b); }
#endif
__device__ __forceinline__ bf16x8 pack_tiles(const f32x4& lo, const f32x4& hi) {
    u32x4 w; w.x = pk2(lo[0], lo[1]); w.y = pk2(lo[2], lo[3]); w.z = pk2(hi[0], hi[1]); w.w = pk2(hi[2], hi[3]); return __builtin_bit_cast(bf16x8, w);
}
__device__ __forceinline__ float silu_f(float x) { return x / (1.0f + expf(-x)); }
#ifdef __HIP_EMU__
__device__ __forceinline__ float silu_fast(float x) { return x / (1.0f + expf(-x)); }
#else
__device__ __forceinline__ float silu_fast(float x) { return x * __builtin_amdgcn_rcpf(1.0f + __builtin_amdgcn_exp2f(-LOG2E * x)); }
#endif
__device__ __forceinline__ float wave_sum(float v) {
#pragma unroll
    for (int o = 1; o < 64; o <<= 1) v += __shfl_xor(v, o);
    return v;
}
__device__ __forceinline__ float wave_max(float v) {
#pragma unroll
    for (int o = 1; o < 64; o <<= 1) v = fmaxf(v, __shfl_xor(v, o));
    return v;
}

struct P {
    const float *x_prompt, *x_sample, *cache_k, *cache_v, *state_ret, *state_gdn, *state_conv, *c_prompt, *c_sample, *ada_w, *ada_b, *norm_mix, *norm_ffn,
        *w_in, *ret_norm, *conv_w, *a_log, *dt_bias, *gdn_norm, *w_out, *w_gate, *w_up, *w_down, *final_norm;
    float* out; unsigned char* ws;
};

constexpr size_t O_YP = 0, O_YS = O_YP + (size_t)MP * D, O_PWK = O_YS + (size_t)MS * D, O_PWV = O_PWK + (size_t)NL * PB * PWIN * 256,
                 O_PRET = O_PWV + (size_t)NL * PB * PWIN * 256, O_PGDN = O_PRET + (size_t)NL * PB * 4 * 4096, O_PCONV = O_PGDN + (size_t)NL * PB * 4 * 16384,
                 O_SWK = O_PCONV + (size_t)NL * PB * 3 * 1536, O_SWV = O_SWK + (size_t)NL * DB * DS * 256, O_SRET = O_SWV + (size_t)NL * DB * DS * 256,
                 O_SGDN = O_SRET + (size_t)NL * DB * 4 * 4096, O_SCONV = O_SGDN + (size_t)NL * DB * 4 * 16384, O_END = O_SCONV + (size_t)NL * DB * 3 * 1536;

constexpr size_t al256(size_t x) { return (x + 255) / 256 * 256; }
constexpr size_t WS_CTL = 0, WS_CTL_BYTES = 1u << 20;
constexpr size_t WS_MOD = WS_CTL + WS_CTL_BYTES;
constexpr size_t WS_W8 = al256(WS_MOD + (size_t)NL * NC * 6144 * 4);
constexpr size_t WS_ROPE = al256(WS_W8 + (size_t)NL * D * 8 * 4);
constexpr size_t WS_WIN = al256(WS_ROPE + (size_t)4 * NPOS * 32 * 4);
constexpr size_t WS_WOUT = al256(WS_WIN + (size_t)NL * NPROJ * D * 2);
constexpr size_t WS_WGU = al256(WS_WOUT + (size_t)NL * D * D * 2);
constexpr size_t WS_WDN = al256(WS_WGU + (size_t)NL * 2 * FF * D * 2);
constexpr size_t WS_H = al256(WS_WDN + (size_t)NL * D * FF * 2);
constexpr size_t WS_PROJ = al256(WS_H + (size_t)MPAD * D * 2);
constexpr size_t WS_BETA = al256(WS_PROJ + (size_t)MPAD * NPROJ * 2);
constexpr size_t WS_G = al256(WS_BETA + (size_t)M * 4 * 4);
constexpr size_t WS_O = al256(WS_G + (size_t)M * 4 * 4);
constexpr size_t WS_RU = al256(WS_O + (size_t)MPAD * D * 2);
constexpr size_t WS_RS = al256(WS_RU + (size_t)NUNIT * 4096 * 4);
constexpr size_t WS_SCR = al256(WS_RS + (size_t)NUNIT * 4096 * 4);
constexpr size_t WS_GU = WS_SCR;
constexpr size_t WS_GWK = al256(WS_GU + (size_t)NUNIT * 8192 * 2);
constexpr size_t WS_GQ = al256(WS_GWK + (size_t)NUNIT * 16384 * 2);
constexpr size_t WS_GA = al256(WS_GQ + (size_t)NUNIT * 8192 * 2);
constexpr size_t WS_GD = al256(WS_GA + (size_t)NUNIT * 4096 * 2);
constexpr size_t WS_GV = al256(WS_GD + (size_t)NUNIT * 4);
constexpr size_t WS_GS = al256(WS_GV + (size_t)NUNIT * 8192 * 2);
constexpr size_t WS_GEND = al256(WS_GS + (size_t)NUNIT * 16384 * 2);
constexpr size_t ATT_CLS = (size_t)PB * 4 * (T / 32) * 2048;
constexpr size_t WS_KF = WS_GEND;
constexpr size_t WS_VF = al256(WS_KF + 3 * ATT_CLS * 2);
constexpr size_t WS_KRT = al256(WS_VF + 3 * ATT_CLS * 2);
constexpr size_t WS_VRT = al256(WS_KRT + (size_t)MP * 256 * 2);
constexpr size_t WS_AML = al256(WS_VRT + (size_t)MP * 256 * 2);
constexpr size_t WS_AEND = al256(WS_AML + (size_t)MP * 4 * 3 * 2 * 4);
constexpr size_t WS_APO = WS_H;
static_assert((size_t)MP * 4 * 3 * 64 * 2 <= (size_t)MPAD * D * 2, "attention partials overlay H");
constexpr size_t WS_HID = WS_SCR;
constexpr size_t WS_HEND = al256(WS_HID + (size_t)MPAD * FF * 2);
constexpr size_t WS_END = WS_AEND > WS_HEND ? WS_AEND : WS_HEND;

#define WSP(T_, off) ((T_*)(p.ws + (off)))
__device__ __forceinline__ int row_cb(int r) { return r < MP ? r / T : PB + (r - MP) / DS; }
__device__ __forceinline__ int row_pi(int r) { return r < MP ? r % T : T + (r - MP) % DS; }
namespace pg8 {
#ifdef __HIP_EMU__
#define PG8_LAS
#else
#define PG8_LAS __attribute__((address_space(3)))
#endif
typedef unsigned short bf16_t;
typedef short bf16x8 __attribute__((ext_vector_type(8)));
typedef float f32x4 __attribute__((ext_vector_type(4)));
typedef unsigned u32x4 __attribute__((ext_vector_type(4)));
constexpr int BM = 256, BK = 64, HALF = 128, HTB = HALF * BK * 2  , STAGE_BYTES = 8 * HTB, NXCD = 8, WGM = 8;

__host__ __device__ __forceinline__ int lds_byte(int r, int c) { const int st = (r >> 4) * 2 + (c >> 5), rr = r & 15, cc = c & 31, ob = rr * 64 + cc * 2; return st * 1024 + (ob ^ (((ob >> 9) & 1) << 5)); }
__host__ __device__ __forceinline__ void stage_rc(int b, int& R, int& C) { const int st = b / 1024, sb = b % 1024, swz = sb ^ (((sb >> 9) & 1) << 5); R = (st >> 1) * 16 + swz / 64; C = (st & 1) * 32 + (swz % 64) / 2; }
__host__ __device__ __forceinline__ int perm32(int rho) { const int n = rho >> 4, i = rho & 15; return 8 * (i >> 2) + 4 * n + (i & 3); }

struct Unit { int pm, pn; };
struct Gemm { const bf16_t* A; const bf16_t* Bt; int M, N, K; };

struct StaticOrder {
    int nM, nN, nwg, G, c;
    __host__ __device__ void init(int M, int N, int G_, int c_) { nM = M / BM; nN = N / BM; nwg = nM * nN; G = G_; c = c_; }
    __host__ __device__ bool next(int i, Unit& u) const {
        const long L = (long)i * G + c; if (L >= nwg) return false;
        int wgid = (int)L; { const int q = nwg / NXCD, r = nwg % NXCD, xcd = wgid % NXCD, off = wgid / NXCD; wgid = (xcd < r ? xcd * (q + 1) : r * (q + 1) + (xcd - r) * q) + off; }
        const int nig = WGM * nN, gid = wgid / nig, fm = gid * WGM, gsz = (nM - fm) < WGM ? (nM - fm) : WGM;
        u.pm = fm + ((wgid % nig) % gsz); u.pn = (wgid % nig) / gsz; return true;
    }
    __device__ __forceinline__ void a_ready(const Unit&) const {}
    __device__ __forceinline__ void done(const Unit&) const {}
};


struct EpiStoreBf16 {
    static constexpr bool PERM = true, AFTER_DRAIN = false;
    bf16_t* O; int ldc;
    __device__ __forceinline__ void operator()(const f32x4 (&acc)[2][2][4][2], const Unit& u, int wr, int wc, int fr, int fq) const {
        const int row0 = u.pm * BM + wr * 64 + fr, col0 = u.pn * BM + wc * 32 + 8 * fq;
#pragma unroll
        for (int ai = 0; ai < 2; ++ai)
#pragma unroll
            for (int m = 0; m < 4; ++m) { bf16_t* rowp = O + (size_t)(row0 + ai * HALF + m * 16) * ldc + col0;
#pragma unroll
                for (int bj = 0; bj < 2; ++bj) { const f32x4 v0 = acc[ai][bj][m][0], v1 = acc[ai][bj][m][1];
                    u32x4 w; w.x = ::pk2(v0[0], v0[1]); w.y = ::pk2(v0[2], v0[3]); w.z = ::pk2(v1[0], v1[1]); w.w = ::pk2(v1[2], v1[3]);
                    *(u32x4*)(rowp + bj * HALF) = w; } }
    }
};
struct EpiResidual {
    static constexpr bool PERM = false, AFTER_DRAIN = false;
    float* X; const float* gate; const float* Xin;
    __device__ __forceinline__ void operator()(const f32x4 (&acc)[2][2][4][2], const Unit& u, int wr, int wc, int fr, int fq) const {
        const int row0 = u.pm * BM + wr * 64 + fr, col0 = u.pn * BM + wc * 32 + 4 * fq;
#pragma unroll
        for (int ai = 0; ai < 2; ++ai)
#pragma unroll
            for (int m = 0; m < 4; ++m) { const int row = row0 + ai * HALF + m * 16;
                if (MPAD != M && row >= M) continue;
                const float* g = gate + (size_t)::row_cb(row) * 6144 + col0; float* xp = X + (size_t)row * D + col0; const float* xi = Xin + (size_t)row * D + col0;
#pragma unroll
                for (int bj = 0; bj < 2; ++bj)
#pragma unroll
                    for (int n = 0; n < 2; ++n) { const f32x4 gv = *(const f32x4*)(g + bj * HALF + n * 16); f32x4* xq = (f32x4*)(xp + bj * HALF + n * 16); *xq = *(const f32x4*)(xi + bj * HALF + n * 16) + gv * acc[ai][bj][m][n]; } }
    }
};
struct EpiSwiglu {
    static constexpr bool PERM = true, AFTER_DRAIN = false;
    bf16_t* Hd;
    __device__ __forceinline__ void operator()(const f32x4 (&acc)[2][2][4][2], const Unit& u, int wr, int wc, int fr, int fq) const {
        const int row0 = u.pm * BM + wr * 64 + fr, col0 = u.pn * HALF + wc * 32 + 8 * fq;
#pragma unroll
        for (int ai = 0; ai < 2; ++ai)
#pragma unroll
            for (int m = 0; m < 4; ++m) { bf16_t* rowp = Hd + (size_t)(row0 + ai * HALF + m * 16) * FF + col0;
                float v[8];
#pragma unroll
                for (int n = 0; n < 2; ++n)
#pragma unroll
                    for (int j = 0; j < 4; ++j) { const float gt = acc[ai][0][m][n][j], up = acc[ai][1][m][n][j]; v[4 * n + j] = ::silu_fast(gt) * up; }
                u32x4 w; w.x = ::pk2(v[0], v[1]); w.y = ::pk2(v[2], v[3]); w.z = ::pk2(v[4], v[5]); w.w = ::pk2(v[6], v[7]);
                *(u32x4*)rowp = w; }
    }
};

#ifdef __HIP_EMU__
template <class Epi, class Sched, bool ALIGN_EPI = false, bool SP2 = false>
__device__ __forceinline__ void gemm_phase(unsigned char* lds, const Gemm g, const Sched& S, const Epi& E) {
    const int tid = threadIdx.x, wid = tid >> 6, lane = tid & 63, wr = wid >> 2, wc = wid & 3, fr = lane & 15, fq = lane >> 4;
    Unit cur;
    for (int ui = 0; S.next(ui, cur); ++ui) {
        f32x4 acc[2][2][4][2];
        for (int ai = 0; ai < 2; ++ai) for (int bj = 0; bj < 2; ++bj) for (int m = 0; m < 4; ++m) for (int n = 0; n < 2; ++n) for (int j = 0; j < 4; ++j) {
            const int row = 256 * cur.pm + 128 * ai + 64 * wr + 16 * m + fr;
            const int col = Epi::PERM ? 256 * cur.pn + 128 * bj + 32 * wc + 8 * fq + 4 * n + j : 256 * cur.pn + 128 * bj + 32 * wc + 16 * n + 4 * fq + j;
            const bf16_t* a = g.A + (size_t)row * g.K; const bf16_t* b = g.Bt + (size_t)col * g.K; float s = 0.f;
            for (int k = 0; k < g.K; ++k) s += ::bf2f(a[k]) * ::bf2f(b[k]);
            acc[ai][bj][m][n][j] = s; }
        E(acc, cur, wr, wc, fr, fq);
    }
}
#else
template <class Epi, class Sched, bool ALIGN_EPI = false, bool SP2 = false>
__device__ __forceinline__ void gemm_phase(PG8_LAS unsigned char* lds, const Gemm g, const Sched& S, const Epi& E) {
    const int tid = ::tidx(), wid = __builtin_amdgcn_readfirstlane(tid >> 6), lane = tid & 63, wr = wid >> 2, wc = wid & 3, fr = lane & 15, fq = lane >> 4;
    const int K = g.K, nt = K / BK;
    unsigned voffA[2], voffB[2];
#pragma unroll
    for (int i = 0; i < 2; ++i) { int R, C; stage_rc(tid * 16 + i * 8192, R, C); const int Rb = Epi::PERM ? ((R & ~31) + perm32(R & 31)) : R;
        voffA[i] = (unsigned)(R * K + C) * 2u; voffB[i] = (unsigned)(Rb * K + C) * 2u; }
    const size_t kstep = (size_t)(BK * 2);
    const size_t hstep = (size_t)HALF * K * 2;
    const size_t tstep = 2 * hstep;
    const unsigned ldsw = (unsigned)wid * 1024u;
    const int aoff = lds_byte(wr * 64 + fr, fq * 8), boff = lds_byte(wc * 32 + fr, fq * 8);
#define PG8_SA(b, h) (((b) * 2 + (h)) * HTB)
#define PG8_SB(b, h) ((4 + (b) * 2 + (h)) * HTB)
#define PG8_STAGE(bufoff, gbase, voff) do { _Pragma("unroll") for (int _i = 0; _i < 2; ++_i) \
        __builtin_amdgcn_global_load_lds((const unsigned*)((const char*)(gbase) + (voff)[_i]), (PG8_LAS unsigned*)(lds + (bufoff) + ldsw + _i * 8192), 16, 0, 0); } while (0)
#define PG8_LDA(dst, b, h) do { _Pragma("unroll") for (int m = 0; m < 4; ++m) _Pragma("unroll") for (int k = 0; k < 2; ++k) dst[m][k] = *(const PG8_LAS bf16x8*)(lds + PG8_SA(b, h) + aoff + m * 2048 + k * 1024); } while (0)
#define PG8_LDB(dst, b, h) do { _Pragma("unroll") for (int n = 0; n < 2; ++n) _Pragma("unroll") for (int k = 0; k < 2; ++k) dst[n][k] = *(const PG8_LAS bf16x8*)(lds + PG8_SB(b, h) + boff + n * 2048 + k * 1024); } while (0)
#define PG8_MMA(ai, bj, At, Bt) do { __builtin_amdgcn_s_setprio(1); _Pragma("unroll") for (int m = 0; m < 4; ++m) _Pragma("unroll") for (int n = 0; n < 2; ++n) _Pragma("unroll") for (int k = 0; k < 2; ++k) \
        acc[ai][bj][m][n] = __builtin_amdgcn_mfma_f32_16x16x32_bf16(Bt[n][k], At[m][k], acc[ai][bj][m][n], 0, 0, 0); __builtin_amdgcn_s_setprio(0); } while (0)
#define PG8_WAIT_V(n) asm volatile("s_waitcnt vmcnt(" #n ")" ::: "memory")
#define PG8_WAIT_L(n) asm volatile("s_waitcnt lgkmcnt(" #n ")" ::: "memory")
#define PG8_BAR __builtin_amdgcn_s_barrier()
#define PG8_SCHED __builtin_amdgcn_sched_barrier(0)
    Unit cur, nxt; int ui = 0;
    if (!S.next(0, cur)) return;
    f32x4 acc[2][2][4][2];
#pragma unroll
    for (int a = 0; a < 2; ++a)
#pragma unroll
        for (int b = 0; b < 2; ++b)
#pragma unroll
            for (int m = 0; m < 4; ++m)
#pragma unroll
                for (int n = 0; n < 2; ++n) acc[a][b][m][n] = (f32x4){0.f, 0.f, 0.f, 0.f};
    bf16x8 At[4][2], B0[2][2], B1[2][2];
    const char* cA = (const char*)g.A + (size_t)cur.pm * tstep; const char* cB = (const char*)g.Bt + (size_t)cur.pn * tstep;
    S.a_ready(cur);
    if constexpr (SP2) {
        PG8_STAGE(PG8_SB(0, 0), cB, voffB); PG8_STAGE(PG8_SB(0, 1), cB + hstep, voffB); PG8_STAGE(PG8_SA(0, 0), cA, voffA); PG8_STAGE(PG8_SA(0, 1), cA + hstep, voffA);
        if (wr == 1) PG8_BAR;
        PG8_WAIT_V(2); PG8_BAR;
        PG8_STAGE(PG8_SB(1, 0), cB + kstep, voffB); PG8_STAGE(PG8_SA(1, 0), cA + kstep, voffA); PG8_STAGE(PG8_SB(1, 1), cB + hstep + kstep, voffB);
        PG8_WAIT_V(6); PG8_BAR;
    } else {
        PG8_STAGE(PG8_SB(0, 0), cB, voffB); PG8_STAGE(PG8_SA(0, 0), cA, voffA); PG8_STAGE(PG8_SB(0, 1), cB + hstep, voffB); PG8_STAGE(PG8_SA(0, 1), cA + hstep, voffA);
        if (wr == 1) PG8_BAR;
        PG8_WAIT_V(4); PG8_BAR;
        PG8_STAGE(PG8_SB(1, 0), cB + kstep, voffB); PG8_STAGE(PG8_SA(1, 0), cA + kstep, voffA); PG8_STAGE(PG8_SB(1, 1), cB + hstep + kstep, voffB);
        PG8_WAIT_V(6); PG8_BAR;
    }
    for (;;) {
        const bool has_next = S.next(ui + 1, nxt);
        const char* nA = has_next ? (const char*)g.A + (size_t)nxt.pm * tstep : cA; const char* nB = has_next ? (const char*)g.Bt + (size_t)nxt.pn * tstep : cB;
        for (int t = 0; t < nt; t += 2) {
            const bool last = (t == nt - 2);
            const char* a1 = cA + (size_t)(t + 1) * kstep;
            const char* a2 = last ? nA : cA + (size_t)(t + 2) * kstep; const char* b2 = last ? nB : cB + (size_t)(t + 2) * kstep;
            const char* a3 = a2 + kstep; const char* b3 = b2 + kstep;
            if (last && has_next) S.a_ready(nxt);
            if constexpr (SP2) {
            PG8_LDB(B0, 0, 0); PG8_LDB(B1, 0, 1); PG8_SCHED; PG8_LDA(At, 0, 0); PG8_STAGE(PG8_SA(1, 1), a1 + hstep, voffA);
            PG8_WAIT_V(8); PG8_WAIT_L(0); PG8_BAR; PG8_MMA(0, 0, At, B0); PG8_MMA(0, 1, At, B1); PG8_BAR; PG8_SCHED;
            PG8_LDA(At, 0, 1); PG8_STAGE(PG8_SB(0, 0), b2, voffB); PG8_STAGE(PG8_SB(0, 1), b2 + hstep, voffB); PG8_STAGE(PG8_SA(0, 0), a2, voffA);
            PG8_WAIT_V(8); PG8_WAIT_L(0); PG8_BAR; PG8_MMA(1, 0, At, B0); PG8_MMA(1, 1, At, B1); PG8_BAR; PG8_SCHED;
            PG8_LDB(B0, 1, 0); PG8_LDB(B1, 1, 1); PG8_SCHED; PG8_LDA(At, 1, 0); PG8_STAGE(PG8_SA(0, 1), a2 + hstep, voffA);
            PG8_WAIT_V(8); PG8_WAIT_L(0); PG8_BAR; PG8_MMA(0, 0, At, B0); PG8_MMA(0, 1, At, B1); PG8_BAR; PG8_SCHED;
            PG8_LDA(At, 1, 1); PG8_STAGE(PG8_SB(1, 0), b3, voffB); PG8_STAGE(PG8_SB(1, 1), b3 + hstep, voffB); PG8_STAGE(PG8_SA(1, 0), a3, voffA);
            PG8_WAIT_V(8); PG8_WAIT_L(0); PG8_BAR; PG8_MMA(1, 0, At, B0); PG8_MMA(1, 1, At, B1); PG8_BAR; PG8_SCHED;
            } else {
            PG8_LDB(B0, 0, 0); PG8_SCHED; PG8_LDA(At, 0, 0); PG8_STAGE(PG8_SA(1, 1), a1 + hstep, voffA);
            PG8_WAIT_L(8); PG8_BAR; PG8_WAIT_L(0); PG8_MMA(0, 0, At, B0); PG8_BAR; PG8_SCHED;
            PG8_LDB(B1, 0, 1); PG8_STAGE(PG8_SB(0, 0), b2, voffB);
            PG8_BAR; PG8_WAIT_L(0); PG8_MMA(0, 1, At, B1); PG8_BAR;
            PG8_LDA(At, 0, 1); PG8_STAGE(PG8_SA(0, 0), a2, voffA);
            PG8_BAR; PG8_WAIT_L(0); PG8_MMA(1, 0, At, B0); PG8_BAR; PG8_SCHED;
            PG8_STAGE(PG8_SB(0, 1), b2 + hstep, voffB);
            PG8_WAIT_V(6); PG8_BAR; PG8_MMA(1, 1, At, B1); PG8_BAR;
            PG8_LDB(B0, 1, 0); PG8_SCHED; PG8_LDA(At, 1, 0); PG8_STAGE(PG8_SA(0, 1), a2 + hstep, voffA);
            PG8_WAIT_L(8); PG8_BAR; PG8_WAIT_L(0); PG8_MMA(0, 0, At, B0); PG8_BAR; PG8_SCHED;
            PG8_LDB(B1, 1, 1); PG8_STAGE(PG8_SB(1, 0), b3, voffB);
            PG8_BAR; PG8_WAIT_L(0); PG8_MMA(0, 1, At, B1); PG8_BAR;
            PG8_LDA(At, 1, 1); PG8_STAGE(PG8_SA(1, 0), a3, voffA);
            PG8_BAR; PG8_WAIT_L(0); PG8_MMA(1, 0, At, B0); PG8_BAR; PG8_SCHED;
            PG8_STAGE(PG8_SB(1, 1), b3 + hstep, voffB);
            PG8_WAIT_V(6); PG8_BAR; PG8_MMA(1, 1, At, B1); PG8_BAR;
            }
        }
        if constexpr (ALIGN_EPI) { if (wr == 0) PG8_BAR; }
        if constexpr (!Epi::AFTER_DRAIN) { E(acc, cur, wr, wc, fr, fq); S.done(cur); }
        if (!has_next) break;
#pragma unroll
        for (int a = 0; a < 2; ++a)
#pragma unroll
            for (int b = 0; b < 2; ++b)
#pragma unroll
                for (int m = 0; m < 4; ++m)
#pragma unroll
                    for (int n = 0; n < 2; ++n) acc[a][b][m][n] = (f32x4){0.f, 0.f, 0.f, 0.f};
        cur = nxt; cA = nA; cB = nB; ++ui;
        if constexpr (ALIGN_EPI) { if (wr == 1) PG8_BAR; }
    }
    PG8_WAIT_V(0);
    if constexpr (!ALIGN_EPI) { if (wr == 0) PG8_BAR; }
    PG8_BAR;
    if constexpr (Epi::AFTER_DRAIN) { E.fused(acc, cur, wr, wc, fr, fq, lds, wid, lane); S.done(cur); }
#undef PG8_SA
#undef PG8_SB
#undef PG8_STAGE
#undef PG8_LDA
#undef PG8_LDB
#undef PG8_MMA
#undef PG8_WAIT_V
#undef PG8_WAIT_L
#undef PG8_BAR
#undef PG8_SCHED
}
#endif
}


__device__ __forceinline__ void transpose_item(const float* W, int ldw, bf16_t* WT, int K, int k0, int n0, int drow0, float* scr, int lane) {
    float wv[32];
#pragma unroll
    for (int i = 0; i < 32; ++i) wv[i] = W[(size_t)(k0 + 2 * i + (lane >> 5)) * ldw + n0 + (lane & 31)];
#pragma unroll
    for (int i = 0; i < 32; ++i) scr[(2 * i + (lane >> 5)) * 33 + (lane & 31)] = wv[i];
    WAVE_SYNC();
    const int c = lane & 7;
#pragma unroll
    for (int j = 0; j < 4; ++j) { const int n = (lane >> 3) + 8 * j; const float* s = scr + (8 * c) * 33 + n;
        u32x4 o; o.x = pk2(s[0 * 33], s[1 * 33]); o.y = pk2(s[2 * 33], s[3 * 33]); o.z = pk2(s[4 * 33], s[5 * 33]); o.w = pk2(s[6 * 33], s[7 * 33]);
        *(u32x4*)(WT + (size_t)(drow0 + n) * K + k0 + 8 * c) = o; }
    WAVE_SYNC();
}
constexpr int CV_IN = 16 * 120, CV_OUT = 16 * 32, CV_G = 16 * 88, CV_DN = 44 * 32, CV_L = CV_IN + CV_OUT + 2 * CV_G + CV_DN;
__device__ __forceinline__ void ph_convert(const P& p, unsigned char* smem, int i0, int i1, int b0, int b1) {
    if ((int)blockIdx.x < b0 || (int)blockIdx.x >= b1) return;
    const int lane = tidx() & 63, wave = tidx() >> 6;
    float* scr = (float*)smem + wave * (64 * 33 + 32);
    constexpr int I_IN = CV_IN, I_OUT = CV_OUT, I_G = CV_G, I_L = CV_L;
    const int gw = ((int)blockIdx.x - b0) * 8 + wave, ngw = (b1 - b0) * 8;
    for (int it = i0 + gw; it < i1; it += ngw) {
        const int l = it / I_L; int r = it % I_L;
        if (r < I_IN) { const int kb = r / 120, nb = r % 120; transpose_item(p.w_in + (size_t)l * D * INC, INC, WSP(bf16_t, WS_WIN) + (size_t)l * NPROJ * D, D, kb * 64, nb * 32, nb * 32, scr, lane); continue; }
        r -= I_IN;
        if (r < I_OUT) { const int kb = r / 32, nb = r % 32; transpose_item(p.w_out + (size_t)l * D * D, D, WSP(bf16_t, WS_WOUT) + (size_t)l * D * D, D, kb * 64, nb * 32, nb * 32, scr, lane); continue; }
        r -= I_OUT;
        if (r < 2 * I_G) { const int up = r / I_G; r %= I_G; const int kb = r / 88, nb = r % 88, n0 = nb * 32;
            transpose_item((up ? p.w_up : p.w_gate) + (size_t)l * D * FF, FF, WSP(bf16_t, WS_WGU) + (size_t)l * 2 * FF * D, D, kb * 64, n0, (n0 / 128) * 256 + up * 128 + (n0 % 128), scr, lane); continue; }
        r -= 2 * I_G;
        { const int kb = r / 32, nb = r % 32; transpose_item(p.w_down + (size_t)l * FF * D, D, WSP(bf16_t, WS_WDN) + (size_t)l * D * FF, FF, kb * 64, nb * 32, nb * 32, scr, lane); }
    }
}

__device__ __forceinline__ void ph_adaln(const P& p, unsigned char* smem, int l0, int l1, int b0, int b1) {
    if ((int)blockIdx.x < b0 || (int)blockIdx.x >= b1) return;
    float* sc = (float*)smem;
    float* red = sc + NC * 256;
    const int tid = tidx(), col = tid & 31, kg = tid >> 5;
    float* MOD = WSP(float, WS_MOD);
    for (int it = l0 * 192 + (int)blockIdx.x - b0; it < l1 * 192; it += b1 - b0) {
        const int l = it / 192, cb0 = (it % 192) * 32;
        float acc[NC];
#pragma unroll
        for (int r = 0; r < NC; ++r) acc[r] = 0.f;
        for (int kc = 0; kc < 4; ++kc) {
            __syncthreads();
            for (int e = tid; e < NC * 256; e += NTHR) { const int r = e >> 8, k = e & 255; const float c = r < PB ? p.c_prompt[r * D + kc * 256 + k] : p.c_sample[(r - PB) * D + kc * 256 + k]; sc[e] = silu_f(c); }
            __syncthreads();
            for (int kk = 0; kk < 16; ++kk) { const int k = kg * 16 + kk; const float w = p.ada_w[((size_t)l * D + kc * 256 + k) * 6144 + cb0 + col];
#pragma unroll
                for (int r = 0; r < NC; ++r) acc[r] += sc[r * 256 + k] * w; }
        }
#pragma unroll
        for (int r = 0; r < NC; ++r) red[(kg * NC + r) * 32 + col] = acc[r];
        __syncthreads();
        for (int e = tid; e < NC * 32; e += NTHR) { const int r = e >> 5, c = e & 31; float s = p.ada_b[l * 6144 + cb0 + c];
            for (int g = 0; g < 16; ++g) s += red[(g * NC + r) * 32 + c];
            MOD[((size_t)l * NC + r) * 6144 + cb0 + c] = s; }
        __syncthreads();
    }
}

__device__ __forceinline__ void ph_ropetab_copyx(const P& p) {
    const size_t gt = (size_t)blockIdx.x * NTHR + tidx(), ng = (size_t)gridDim.x * NTHR;
    float* tab = WSP(float, WS_ROPE);
    for (size_t e = gt; e < (size_t)NL * D * 8; e += ng) { const size_t lk = e >> 3; const int c = (int)(e & 7); WSP(float, WS_W8)[((lk >> 10) * 8 + c) * D + (lk & 1023)] = p.w_in[lk * INC + NPROJ + c]; }
    for (size_t e = gt; e < (size_t)NPOS * 32; e += ng) {
        const int pi = (int)(e >> 5), i = (int)(e & 31); const double pos = pi < T ? (double)pi : (double)(PAST + pi - T);
        const double ia = exp(-log(10000.0) * (double)i / 32.0), ir = exp(-log(10000.0) * (double)i / 31.0);
        tab[e] = (float)cos(pos * ia); tab[(size_t)NPOS * 32 + e] = (float)sin(pos * ia);
        tab[(size_t)2 * NPOS * 32 + e] = (float)cos(pos * ir); tab[(size_t)3 * NPOS * 32 + e] = (float)sin(pos * ir);
    }
}

template <int WHICH> __device__ __forceinline__ void ph_norm_mod(const P& p, int l, unsigned char* smem) {
    const int lane = tidx() & 63, wave = tidx() >> 6, gw = blockIdx.x * 8 + wave, ngw = gridDim.x * 8;
    const float* nw = (WHICH == 0 ? p.norm_mix : p.norm_ffn) + l * D;
    bf16_t* H = WSP(bf16_t, WS_H);
    const float* w8s = (const float*)smem;
    if (WHICH == 0) { __syncthreads();
        for (int e = tidx(); e < 8 * D / 4; e += NTHR) ((f32x4*)smem)[e] = ((const f32x4*)(WSP(float, WS_W8) + (size_t)l * 8 * D))[e];
        __syncthreads(); }
    f32x4 gw4[4];
#pragma unroll
    for (int j = 0; j < 4; ++j) gw4[j] = *(const f32x4*)(nw + 4 * lane + 256 * j);
    for (int r = gw; r < M; r += ngw) {
        const float* xr = (WHICH == 0 && l == 0) ? (r < MP ? p.x_prompt + (size_t)r * D : p.x_sample + (size_t)(r - MP) * D) : p.out + (size_t)r * D;
        const float* mod = WSP(float, WS_MOD) + ((size_t)l * NC + row_cb(r)) * 6144 + (WHICH == 0 ? 0 : 3072);
        f32x4 v[4]; float ss = 0.f;
#pragma unroll
        for (int j = 0; j < 4; ++j) { v[j] = *(const f32x4*)(xr + 4 * lane + 256 * j); ss += (v[j][0] * v[j][0] + v[j][1] * v[j][1]) + (v[j][2] * v[j][2] + v[j][3] * v[j][3]); }
        const float rstd = 1.0f / sqrtf(wave_sum(ss) * (1.0f / D) + EPS);
        float a8[8];
#pragma unroll
        for (int c = 0; c < 8; ++c) a8[c] = 0.f;
#pragma unroll
        for (int j = 0; j < 4; ++j) { const int k = 4 * lane + 256 * j;
            const f32x4 g = gw4[j], sh = *(const f32x4*)(mod + k), sc = *(const f32x4*)(mod + 1024 + k);
            f32x4 h;
#pragma unroll
            for (int e = 0; e < 4; ++e) h[e] = v[j][e] * rstd * g[e] * (1.0f + sc[e]) + sh[e];
            u32x2 w; w.x = pk2(h[0], h[1]); w.y = pk2(h[2], h[3]); *(u32x2*)(H + (size_t)r * D + k) = w;
            if (WHICH == 0) {
#pragma unroll
                for (int c = 0; c < 8; ++c) { const f32x4 wv = *(const f32x4*)(w8s + c * D + k); a8[c] += (h[0] * wv[0] + h[1] * wv[1]) + (h[2] * wv[2] + h[3] * wv[3]); }
            }
        }
        if (WHICH == 0) {
            float b4[4];
#pragma unroll
            for (int c = 0; c < 4; ++c) { const float keep = lane < 32 ? a8[c] : a8[4 + c], send = lane < 32 ? a8[4 + c] : a8[c]; b4[c] = keep + __shfl_xor(send, 32); }
            float b2[2];
#pragma unroll
            for (int c = 0; c < 2; ++c) { const bool lo = (lane & 16) == 0; const float keep = lo ? b4[c] : b4[2 + c], send = lo ? b4[2 + c] : b4[c]; b2[c] = keep + __shfl_xor(send, 16); }
            float b1; { const bool lo = (lane & 8) == 0; const float keep = lo ? b2[0] : b2[1], send = lo ? b2[1] : b2[0]; b1 = keep + __shfl_xor(send, 8); }
            b1 += __shfl_xor(b1, 4); b1 += __shfl_xor(b1, 2); b1 += __shfl_xor(b1, 1);
            if ((lane & 7) == 0) { const int c = (lane >> 5) * 4 + ((lane >> 4) & 1) * 2 + ((lane >> 3) & 1);
                if (c < 4) WSP(float, WS_BETA)[(size_t)r * 4 + c] = 1.0f / (1.0f + expf(-b1));
                else { const int hh = c - 4; const float xx = b1 + p.dt_bias[l * 4 + hh]; const float sp = xx > 20.f ? xx : log1pf(expf(xx)); WSP(float, WS_G)[(size_t)r * 4 + hh] = -expf(p.a_log[l * 4 + hh]) * sp; } }
        }
    }
}

__device__ __forceinline__ void unpack8(const u32x4 w, float (&f)[8]) {
    f[0] = __builtin_bit_cast(float, w.x << 16); f[1] = __builtin_bit_cast(float, w.x & 0xffff0000u); f[2] = __builtin_bit_cast(float, w.y << 16); f[3] = __builtin_bit_cast(float, w.y & 0xffff0000u);
    f[4] = __builtin_bit_cast(float, w.z << 16); f[5] = __builtin_bit_cast(float, w.z & 0xffff0000u); f[6] = __builtin_bit_cast(float, w.w << 16); f[7] = __builtin_bit_cast(float, w.w & 0xffff0000u);
}
__device__ __forceinline__ u32x4 pack8f(const float (&f)[8]) { u32x4 w; w.x = pk2(f[0], f[1]); w.y = pk2(f[2], f[3]); w.z = pk2(f[4], f[5]); w.w = pk2(f[6], f[7]); return w; }
__device__ __forceinline__ void ph_rope_out(const P& p, int l) {
    const size_t gt = (size_t)blockIdx.x * NTHR + tidx(), ng = (size_t)gridDim.x * NTHR;
    bf16_t* PR = WSP(bf16_t, WS_PROJ); const float* tab = WSP(float, WS_ROPE);
    for (size_t e = gt; e < (size_t)MS * 64; e += ng) {
        const int r = MP + (int)(e >> 6), rem = (int)(e & 63), sec = rem >> 4, hh = (rem >> 2) & 3, d = (rem & 3) * 8;
        const int off = sec == 0 ? C_QA : sec == 1 ? C_KA : sec == 2 ? C_QR : C_KR; const float scale = sec == 0 ? 0.125f * LOG2E : sec == 3 ? 0.125f : 1.0f;
        const float* ct = tab + (size_t)(sec >= 2 ? 2 : 0) * NPOS * 32 + (size_t)row_pi(r) * 32 + d; const float* st = ct + (size_t)NPOS * 32;
        const f32x4 c0 = *(const f32x4*)ct, c1 = *(const f32x4*)(ct + 4), s0 = *(const f32x4*)st, s1 = *(const f32x4*)(st + 4);
        bf16_t* x = PR + (size_t)r * NPROJ + off + hh * 64 + d; float x1[8], x2[8], o1[8], o2[8];
        unpack8(*(const u32x4*)x, x1); unpack8(*(const u32x4*)(x + 32), x2);
#pragma unroll
        for (int k = 0; k < 8; ++k) { const float c = k < 4 ? c0[k & 3] : c1[k & 3], sn = k < 4 ? s0[k & 3] : s1[k & 3]; o1[k] = (x1[k] * c - x2[k] * sn) * scale; o2[k] = (x1[k] * sn + x2[k] * c) * scale; }
        *(u32x4*)x = pack8f(o1); *(u32x4*)(x + 32) = pack8f(o2);
        if (sec == 1) { const int b = (r - MP) / DS, i = (r - MP) % DS; float* o = p.out + O_SWK + (((size_t)l * DB + b) * DS + i) * 256 + hh * 64 + d;
            *(f32x4*)o = (f32x4){o1[0], o1[1], o1[2], o1[3]}; *(f32x4*)(o + 4) = (f32x4){o1[4], o1[5], o1[6], o1[7]}; *(f32x4*)(o + 32) = (f32x4){o2[0], o2[1], o2[2], o2[3]}; *(f32x4*)(o + 36) = (f32x4){o2[4], o2[5], o2[6], o2[7]}; }
    }
    for (size_t e = gt; e < (size_t)MS * 32; e += ng) {
        const int r = MP + (int)(e >> 5), c = (int)(e & 31) * 8; const int b = (r - MP) / DS, i = (r - MP) % DS; float* o = p.out + O_SWV + (((size_t)l * DB + b) * DS + i) * 256 + c;
        float v[8]; unpack8(*(const u32x4*)(PR + (size_t)r * NPROJ + C_VA + c), v); *(f32x4*)o = (f32x4){v[0], v[1], v[2], v[3]}; *(f32x4*)(o + 4) = (f32x4){v[4], v[5], v[6], v[7]};
    }
    for (size_t e = gt; e < (size_t)(PB + DB) * 3 * 1536; e += ng) {
        const int c = (int)(e % 1536), j = (int)((e / 1536) % 3), bb = (int)(e / (3 * 1536));
        if (bb < PB) p.out[O_PCONV + (((size_t)l * PB + bb) * 3 + j) * 1536 + c] = bf2f(PR[(size_t)(bb * T + T - 3 + j) * NPROJ + C_CONV + c]);
        else { const int b = bb - PB; p.out[O_SCONV + (((size_t)l * DB + b) * 3 + j) * 1536 + c] = bf2f(PR[(size_t)(MP + b * DS + DS - 3 + j) * NPROJ + C_CONV + c]); }
    }
}

__device__ __forceinline__ void attn_wave_sample(const P& p, int l, int r, int h, int lane, float* sw  ) {
    const bf16_t* PR = WSP(bf16_t, WS_PROJ);
    const int b = (r - MP) / DS; const int tq = WB + (r - MP) % DS;
    const int kg = lane >> 4, dq = lane & 15;
    f32x4 q4; { const u32x2 w = *(const u32x2*)(PR + (size_t)r * NPROJ + C_QA + h * 64 + 4 * dq); q4 = (f32x4){bf2f((bf16_t)(w.x & 0xffff)), bf2f((bf16_t)(w.x >> 16)), bf2f((bf16_t)(w.y & 0xffff)), bf2f((bf16_t)(w.y >> 16))}; }
    float mx = -INFINITY;
#pragma unroll 8
    for (int e = kg; e < 388; e += 4) {
        const int ee = e < 387 ? e : 386; const int pat = ee / 129, j = ee % 129, dil = pat == 0 ? 1 : pat == 1 ? 4 : 16; const int rr = tq - dil * j;
        f32x4 kv;
        if (rr < WB) kv = *(const f32x4*)(p.cache_k + ((((size_t)l * DB + b) * WB + rr) * 4 + h) * 64 + 4 * dq);
        else { const u32x2 w = *(const u32x2*)(PR + (size_t)(MP + b * DS + (rr - WB)) * NPROJ + C_KA + h * 64 + 4 * dq);
            kv = (f32x4){bf2f((bf16_t)(w.x & 0xffff)), bf2f((bf16_t)(w.x >> 16)), bf2f((bf16_t)(w.y & 0xffff)), bf2f((bf16_t)(w.y >> 16))}; }
        float a = (q4[0] * kv[0] + q4[1] * kv[1]) + (q4[2] * kv[2] + q4[3] * kv[3]);
        a += __shfl_xor(a, 1); a += __shfl_xor(a, 2); a += __shfl_xor(a, 4); a += __shfl_xor(a, 8);
        if (e < 387) { if (dq == 0) sw[e] = a; mx = fmaxf(mx, a); }
    }
    WAVE_SYNC();
    mx = wave_max(mx);
    float lsum = 0.f;
#pragma unroll 1
    for (int i = 0; i < 7; ++i) { const int e = lane + 64 * i; if (e < 387) { const float pe = exp2f(sw[e] - mx); sw[e] = pe; lsum += pe; } }
    lsum = wave_sum(lsum);
    WAVE_SYNC();
    f32x4 o4 = (f32x4){0.f, 0.f, 0.f, 0.f};
#pragma unroll 16
    for (int e = kg; e < 387; e += 4) {
        const float pe = sw[e];
        const int pat = e / 129, j = e % 129, dil = pat == 0 ? 1 : pat == 1 ? 4 : 16; const int rr = tq - dil * j;
        f32x4 v;
        if (rr < WB) v = *(const f32x4*)(p.cache_v + ((((size_t)l * DB + b) * WB + rr) * 4 + h) * 64 + 4 * dq);
        else { const u32x2 w = *(const u32x2*)(PR + (size_t)(MP + b * DS + (rr - WB)) * NPROJ + C_VA + h * 64 + 4 * dq);
            v = (f32x4){bf2f((bf16_t)(w.x & 0xffff)), bf2f((bf16_t)(w.x >> 16)), bf2f((bf16_t)(w.y & 0xffff)), bf2f((bf16_t)(w.y >> 16))}; }
        o4 += pe * v;
    }
#pragma unroll
    for (int e = 0; e < 4; ++e) { float x = o4[e]; x += __shfl_xor(x, 16); x += __shfl_xor(x, 32); o4[e] = x; }
    WAVE_SYNC();
    if (kg == 0) { const float inv = 1.0f / lsum; u32x2 w; w.x = pk2(o4[0] * inv, o4[1] * inv); w.y = pk2(o4[2] * inv, o4[3] * inv);
        *(u32x2*)(WSP(bf16_t, WS_O) + (size_t)r * D + h * 64 + 4 * dq) = w; }
}
__device__ __forceinline__ void ph_attn_sample(const P& p, int l, unsigned char* smem) {
    const int lane = tidx() & 63, wave = tidx() >> 6, gw = (gridDim.x - 1 - blockIdx.x) * 8 + wave, ngw = gridDim.x * 8;
    float* sw = (float*)smem + wave * 392;
    for (int it = gw; it < MS * 4; it += ngw) attn_wave_sample(p, l, MP + (it >> 2), it & 3, lane, sw);
}
__device__ __forceinline__ bf16x8 pack8(const f32x16& v, int s8) {
    u32x4 w; w.x = pk2(v[s8], v[s8 + 1]); w.y = pk2(v[s8 + 2], v[s8 + 3]); w.z = pk2(v[s8 + 4], v[s8 + 5]); w.w = pk2(v[s8 + 6], v[s8 + 7]); return __builtin_bit_cast(bf16x8, w);
}
__device__ __forceinline__ void attn_job(const P& p, int jb, int lane) {
    const int c = lane & 31, hi = lane >> 5;
    constexpr int NB = T / 512;
    const int unit = jb / 48, jj = jb % 48, pat = jj >> 4, sub = jj & 15;
    const int blk = unit % NB, h = (unit / NB) & 3, b = unit / (NB * 4), bh = b * 4 + h;
    int dil, r, qi0, cls, tb;
    if (pat == 0) { dil = 1; r = 0; qi0 = blk * 512 + sub * 32; cls = 0; tb = 0; }
    else if (pat == 1) { dil = 4; r = sub >> 2; qi0 = blk * 128 + (sub & 3) * 32; cls = 1; tb = r * (T / 128); }
    else { dil = 16; r = sub; qi0 = blk * 32; cls = 2; tb = r * (T / 512); }
    const bf16_t* KF = WSP(bf16_t, WS_KF) + cls * ATT_CLS + ((size_t)bh * (T / 32) + tb) * 2048 + lane * 8;
    const bf16_t* VF = WSP(bf16_t, WS_VF) + cls * ATT_CLS + ((size_t)bh * (T / 32) + tb) * 2048 + lane * 8;
    const int tq = dil * (qi0 + c) + r;
    const bf16_t* qp = WSP(bf16_t, WS_PROJ) + (size_t)(b * T + tq) * NPROJ + C_QA + h * 64 + 8 * hi;
    bf16x8 qf[4];
#pragma unroll
    for (int ks = 0; ks < 4; ++ks) qf[ks] = *(const bf16x8*)(qp + 16 * ks);
    bf16x8 kf[5][4];
#pragma unroll
    for (int i = 0; i < 5; ++i) { const int kt0 = qi0 - 128 + 32 * i; const bf16_t* kp = KF + (size_t)(kt0 >= 0 ? (kt0 >> 5) : 0) * 2048;
#pragma unroll
        for (int ks = 0; ks < 4; ++ks) kf[i][ks] = *(const bf16x8*)(kp + 512 * ks); }
    f32x16 S[5];
#pragma unroll
    for (int i = 0; i < 5; ++i) {
        const int kt0 = qi0 - 128 + 32 * i;
        f32x16 acc;
#pragma unroll
        for (int e = 0; e < 16; ++e) acc[e] = 0.f;
#pragma unroll
        for (int ks = 0; ks < 4; ++ks) acc = MFMA32(kf[i][ks], qf[ks], acc);
#pragma unroll
        for (int e = 0; e < 16; ++e) { const int krow = (e & 3) + 8 * (e >> 2) + 4 * hi;
            const bool dead = kt0 < 0 || (i == 0 && krow < c) || (i == 4 && krow > c); if (dead) acc[e] = -INFINITY; }
        S[i] = acc;
    }
    float mx = -INFINITY;
#pragma unroll
    for (int i = 0; i < 5; ++i)
#pragma unroll
        for (int e = 0; e < 16; ++e) mx = fmaxf(mx, S[i][e]);
    mx = fmaxf(mx, __shfl_xor(mx, 32));
    float lsum = 0.f;
#pragma unroll
    for (int i = 0; i < 5; ++i)
#pragma unroll
        for (int e = 0; e < 16; ++e) { const float pe = exp2f(S[i][e] - mx); S[i][e] = pe; lsum += pe; }
    lsum += __shfl_xor(lsum, 32);
    bf16x8 pf[5][2];
#pragma unroll
    for (int i = 0; i < 5; ++i) { pf[i][0] = pack8(S[i], 0); pf[i][1] = pack8(S[i], 8); }
    f32x16 O[2];
#pragma unroll
    for (int dt = 0; dt < 2; ++dt)
#pragma unroll
        for (int e = 0; e < 16; ++e) O[dt][e] = 0.f;
#pragma unroll
    for (int i = 0; i < 5; ++i) {
        const int kt0 = qi0 - 128 + 32 * i; const bf16_t* vp = VF + (size_t)(kt0 >= 0 ? (kt0 >> 5) : 0) * 2048;
#pragma unroll
        for (int s2 = 0; s2 < 2; ++s2)
#pragma unroll
            for (int dt = 0; dt < 2; ++dt) O[dt] = MFMA32(*(const bf16x8*)(vp + (dt * 2 + s2) * 512), pf[i][s2], O[dt]);
    }
    const size_t idx = ((size_t)(b * T + tq) * 4 + h) * 3 + pat;
    bf16_t* po = WSP(bf16_t, WS_APO) + idx * 64;
#pragma unroll
    for (int dt = 0; dt < 2; ++dt)
#pragma unroll
        for (int g = 0; g < 4; ++g) { u32x2 w; w.x = pk2(O[dt][4 * g], O[dt][4 * g + 1]); w.y = pk2(O[dt][4 * g + 2], O[dt][4 * g + 3]); *(u32x2*)(po + 32 * dt + 8 * g + 4 * hi) = w; }
    if (hi == 0) { float* ml = WSP(float, WS_AML) + idx * 2; ml[0] = mx; ml[1] = lsum; }
}
__device__ __forceinline__ void ph_attn_jobs(const P& p, int nc, int b1, int r0) {
    const int bid = (int)blockIdx.x; if (bid >= b1) return;
    const int lane = tidx() & 63, wave = tidx() >> 6, nn = (b1 - nc) * 8, ncw = nc * 8; constexpr int NJ = PB * 4 * (T / 512) * 48;
    const bool late = bid < nc; const int wi = late ? bid * 8 + wave : (bid - nc) * 8 + wave;
    for (int r = late ? r0 : 0;; ++r) { const int base = r * nn + (r > r0 ? (r - r0) * ncw : 0); const int jb = base + (late ? nn + wi : wi);
        if (base >= NJ) break;
        if (jb < NJ) attn_job(p, jb, lane); }
}
__device__ __forceinline__ void ph_attn_combine(const P& p) {
    const size_t gt = (size_t)blockIdx.x * NTHR + tidx(), ng = (size_t)gridDim.x * NTHR;
    for (size_t e = gt; e < (size_t)MP * 4 * 16; e += ng) {
        const size_t rh = e >> 4; const int dq = (int)(e & 15) * 4;
        const float* ml = WSP(float, WS_AML) + rh * 6; const float m0 = ml[0], m1 = ml[2], m2 = ml[4];
        const float mm = fmaxf(m0, fmaxf(m1, m2)); const float w0 = exp2f(m0 - mm), w1 = exp2f(m1 - mm), w2 = exp2f(m2 - mm);
        const float inv = 1.0f / (w0 * ml[1] + w1 * ml[3] + w2 * ml[5]);
        const bf16_t* po = WSP(bf16_t, WS_APO) + rh * 192 + dq;
        const u32x2 a = *(const u32x2*)po, bq = *(const u32x2*)(po + 64), cq = *(const u32x2*)(po + 128);
        float o[4];
        o[0] = w0 * bf2f((bf16_t)(a.x & 0xffff)) + w1 * bf2f((bf16_t)(bq.x & 0xffff)) + w2 * bf2f((bf16_t)(cq.x & 0xffff));
        o[1] = w0 * bf2f((bf16_t)(a.x >> 16)) + w1 * bf2f((bf16_t)(bq.x >> 16)) + w2 * bf2f((bf16_t)(cq.x >> 16));
        o[2] = w0 * bf2f((bf16_t)(a.y & 0xffff)) + w1 * bf2f((bf16_t)(bq.y & 0xffff)) + w2 * bf2f((bf16_t)(cq.y & 0xffff));
        o[3] = w0 * bf2f((bf16_t)(a.y >> 16)) + w1 * bf2f((bf16_t)(bq.y >> 16)) + w2 * bf2f((bf16_t)(cq.y >> 16));
        const size_t row = rh >> 2; const int h = (int)(rh & 3);
        u32x2 w; w.x = pk2(o[0] * inv, o[1] * inv); w.y = pk2(o[2] * inv, o[3] * inv);
        *(u32x2*)(WSP(bf16_t, WS_O) + row * D + h * 64 + dq) = w;
    }
}
__device__ __forceinline__ float ret_lg(int h) { return logf(1.0f - exp2f(-5.0f - (float)h)); }
constexpr int TPK = 72, TPT = 65;
__device__ __forceinline__ void trans_write(const bf16_t* tile, bf16_t* dst  , int tile0, int tid) {
#pragma unroll
    for (int k = 0; k < 4; ++k) { const int ch = tid + NTHR * k, d = ch >> 5, t0 = (ch & 31) * 8; u32x4 w;
        w.x = (unsigned)tile[(t0 + 0) * TPT + d] | ((unsigned)tile[(t0 + 1) * TPT + d] << 16); w.y = (unsigned)tile[(t0 + 2) * TPT + d] | ((unsigned)tile[(t0 + 3) * TPT + d] << 16);
        w.z = (unsigned)tile[(t0 + 4) * TPT + d] | ((unsigned)tile[(t0 + 5) * TPT + d] << 16); w.w = (unsigned)tile[(t0 + 6) * TPT + d] | ((unsigned)tile[(t0 + 7) * TPT + d] << 16);
        *(u32x4*)(dst + (size_t)d * T + tile0 + t0) = w; COMPILER_FENCE(); }
}
__device__ __forceinline__ void store8_b16(bf16_t* dst, const u32x4 w) {
    dst[0] = (bf16_t)(w.x & 0xffff); dst[1] = (bf16_t)(w.x >> 16); dst[2] = (bf16_t)(w.y & 0xffff); dst[3] = (bf16_t)(w.y >> 16);
    dst[4] = (bf16_t)(w.z & 0xffff); dst[5] = (bf16_t)(w.z >> 16); dst[6] = (bf16_t)(w.w & 0xffff); dst[7] = (bf16_t)(w.w >> 16);
}
__device__ __forceinline__ void ph_vtrans(const P& p, int l, unsigned char* smem) {
    bf16_t* ka = (bf16_t*)smem; bf16_t* va = ka + 256 * TPK; bf16_t* vr = va + 256 * TPK; bf16_t* kr = vr + 256 * TPT;
    static_assert((2 * 256 * TPK + 2 * 256 * TPT) * 2 <= BAR_LDS_OFF, "transpose unit LDS");
    const int tid = tidx(); bf16_t* PR = WSP(bf16_t, WS_PROJ); const float* tab = WSP(float, WS_ROPE);
    for (int u = blockIdx.x; u < PB * 4 * (T / 256); u += gridDim.x) {
        const int tile = u % (T / 256), bh = u / (T / 256), h = bh & 3, b = bh >> 2; const float lg = ret_lg(h);
        __syncthreads();
#pragma unroll 1
        for (int k = 0; k < 2; ++k) { const int e = tid + NTHR * k, t = e >> 2, d = (e & 3) * 8, tt = tile * 256 + t; bf16_t* row = PR + (size_t)(b * T + tt) * NPROJ + h * 64 + d;
            float x1[8], x2[8], o1[8], o2[8];
            { const float* ct = tab + (size_t)tt * 32 + d; const float* st = ct + (size_t)NPOS * 32;
              const f32x4 c0 = *(const f32x4*)ct, c1 = *(const f32x4*)(ct + 4), s0 = *(const f32x4*)st, s1 = *(const f32x4*)(st + 4);
              unpack8(*(const u32x4*)(row + C_QA), x1); unpack8(*(const u32x4*)(row + C_QA + 32), x2);
#pragma unroll
              for (int i = 0; i < 8; ++i) { const float c = i < 4 ? c0[i & 3] : c1[i & 3], sn = i < 4 ? s0[i & 3] : s1[i & 3]; o1[i] = (x1[i] * c - x2[i] * sn) * (0.125f * LOG2E); o2[i] = (x1[i] * sn + x2[i] * c) * (0.125f * LOG2E); }
              *(u32x4*)(row + C_QA) = pack8f(o1); *(u32x4*)(row + C_QA + 32) = pack8f(o2);
              unpack8(*(const u32x4*)(row + C_KA), x1); unpack8(*(const u32x4*)(row + C_KA + 32), x2);
#pragma unroll
              for (int i = 0; i < 8; ++i) { const float c = i < 4 ? c0[i & 3] : c1[i & 3], sn = i < 4 ? s0[i & 3] : s1[i & 3]; o1[i] = x1[i] * c - x2[i] * sn; o2[i] = x1[i] * sn + x2[i] * c; }
              *(u32x4*)(ka + t * TPK + d) = pack8f(o1); *(u32x4*)(ka + t * TPK + d + 32) = pack8f(o2);
              if (tt >= T - PWIN) { float* o = p.out + O_PWK + (((size_t)l * PB + b) * PWIN + (tt - (T - PWIN))) * 256 + h * 64 + d;
                  *(f32x4*)o = (f32x4){o1[0], o1[1], o1[2], o1[3]}; *(f32x4*)(o + 4) = (f32x4){o1[4], o1[5], o1[6], o1[7]}; *(f32x4*)(o + 32) = (f32x4){o2[0], o2[1], o2[2], o2[3]}; *(f32x4*)(o + 36) = (f32x4){o2[4], o2[5], o2[6], o2[7]}; } }
            COMPILER_FENCE();
            { const float* ct = tab + (size_t)2 * NPOS * 32 + (size_t)tt * 32 + d; const float* st = ct + (size_t)NPOS * 32;
              const f32x4 c0 = *(const f32x4*)ct, c1 = *(const f32x4*)(ct + 4), s0 = *(const f32x4*)st, s1 = *(const f32x4*)(st + 4);
              const float gq = expf(lg * (float)(tt & 63)), gk = 0.125f / gq;
              unpack8(*(const u32x4*)(row + C_QR), x1); unpack8(*(const u32x4*)(row + C_QR + 32), x2);
#pragma unroll
              for (int i = 0; i < 8; ++i) { const float c = i < 4 ? c0[i & 3] : c1[i & 3], sn = i < 4 ? s0[i & 3] : s1[i & 3]; o1[i] = (x1[i] * c - x2[i] * sn) * gq; o2[i] = (x1[i] * sn + x2[i] * c) * gq; }
              *(u32x4*)(row + C_QR) = pack8f(o1); *(u32x4*)(row + C_QR + 32) = pack8f(o2);
              unpack8(*(const u32x4*)(row + C_KR), x1); unpack8(*(const u32x4*)(row + C_KR + 32), x2);
#pragma unroll
              for (int i = 0; i < 8; ++i) { const float c = i < 4 ? c0[i & 3] : c1[i & 3], sn = i < 4 ? s0[i & 3] : s1[i & 3]; o1[i] = (x1[i] * c - x2[i] * sn) * gk; o2[i] = (x1[i] * sn + x2[i] * c) * gk; }
              const u32x4 w1 = pack8f(o1), w2 = pack8f(o2);
              *(u32x4*)(row + C_KR) = w1; *(u32x4*)(row + C_KR + 32) = w2; store8_b16(kr + t * TPT + d, w1); store8_b16(kr + t * TPT + d + 32, w2); }
            COMPILER_FENCE(); }
#pragma unroll
        for (int k = 0; k < 4; ++k) { const int ch = tid + NTHR * k, t = ch >> 3, d8 = (ch & 7) * 8, tt = tile * 256 + t; const bf16_t* src = PR + (size_t)(b * T + tt) * NPROJ + h * 64 + d8;
            const u32x4 wv = *(const u32x4*)(src + C_VA); *(u32x4*)(va + t * TPK + d8) = wv; store8_b16(vr + t * TPT + d8, *(const u32x4*)(src + C_VR));
            if (tt >= T - PWIN) { float v[8]; unpack8(wv, v); float* o = p.out + O_PWV + (((size_t)l * PB + b) * PWIN + (tt - (T - PWIN))) * 256 + h * 64 + d8;
                *(f32x4*)o = (f32x4){v[0], v[1], v[2], v[3]}; *(f32x4*)(o + 4) = (f32x4){v[4], v[5], v[6], v[7]}; }
            COMPILER_FENCE(); }
        __syncthreads();
#pragma unroll
        for (int cls = 0; cls < 3; ++cls) {
            bf16_t* KFc = WSP(bf16_t, WS_KF) + cls * ATT_CLS + (size_t)bh * (T / 32) * 2048; bf16_t* VFc = WSP(bf16_t, WS_VF) + cls * ATT_CLS + (size_t)bh * (T / 32) * 2048;
#pragma unroll 1
            for (int k = 0; k < 4; ++k) { const int f = tid + NTHR * k, lane = f & 63, c31 = lane & 31, hi = lane >> 5;
                { int g, ks, tl, gtile; bool ok = true;
                  if (cls == 0) { ks = (f >> 6) & 3; g = f >> 8; tl = 32 * g + c31; gtile = tile * 8 + g; }
                  else if (cls == 1) { ks = (f >> 6) & 3; g = f >> 8; const int r = g >> 1, st = g & 1; tl = 4 * (32 * st + c31) + r; gtile = r * (T / 128) + tile * 2 + st; }
                  else { const int r = f >> 7, s16 = f & 15, h2 = (f >> 4) & 1; ks = (f >> 5) & 3; tl = 16 * s16 + r; gtile = r * (T / 512) + (tile >> 1); g = 0; (void)ok;
                      const int slot = 16 * (tile & 1) + s16;
                      *(u32x4*)(KFc + ((size_t)gtile * 4 + ks) * 512 + (slot + 32 * h2) * 8) = *(const u32x4*)(ka + tl * TPK + 16 * ks + 8 * h2); }
                  if (cls < 2) { *(u32x4*)(KFc + ((size_t)gtile * 4 + ks) * 512 + lane * 8) = *(const u32x4*)(ka + tl * TPK + 16 * ks + 8 * hi); } }
                { int dt, s2, gtile, r = 0, st = 0, g = 0;
                  if (cls == 0) { s2 = (f >> 6) & 1; dt = (f >> 7) & 1; g = f >> 8; gtile = tile * 8 + g; }
                  else if (cls == 1) { s2 = (f >> 6) & 1; dt = (f >> 7) & 1; g = f >> 8; r = g >> 1; st = g & 1; gtile = r * (T / 128) + tile * 2 + st; }
                  else { dt = (f >> 6) & 1; r = f >> 7; s2 = tile & 1; gtile = r * (T / 512) + (tile >> 1); }
                  unsigned short e8[8];
#pragma unroll
                  for (int jj = 0; jj < 8; ++jj) { const int kk = 16 * s2 + 8 * (jj >> 2) + 4 * hi + (jj & 3);
                      const int tl = cls == 0 ? 32 * g + kk : cls == 1 ? 4 * (32 * st + kk) + r : 16 * (kk & 15) + r;
                      e8[jj] = va[tl * TPK + 32 * dt + c31]; }
                  u32x4 w; w.x = (unsigned)e8[0] | ((unsigned)e8[1] << 16); w.y = (unsigned)e8[2] | ((unsigned)e8[3] << 16); w.z = (unsigned)e8[4] | ((unsigned)e8[5] << 16); w.w = (unsigned)e8[6] | ((unsigned)e8[7] << 16);
                  *(u32x4*)(VFc + ((size_t)gtile * 4 + dt * 2 + s2) * 512 + lane * 8) = w; }
                COMPILER_FENCE(); }
        }
        trans_write(vr, WSP(bf16_t, WS_VRT) + (size_t)bh * 64 * T, tile * 256, tid);
        trans_write(kr, WSP(bf16_t, WS_KRT) + (size_t)bh * 64 * T, tile * 256, tid);
    }
}

constexpr int CH_ITEMS = PB * 4 * 4;
__device__ __forceinline__ void ph_ret_local(const P& p, int l) {
    const int tid = tidx(), lane = tid & 63, wave = tid >> 6, x = lane & 15, q = lane >> 4, dt = wave >> 1;
    for (int u = blockIdx.x; u < NUNIT; u += gridDim.x) {
        const int n = u % NCH, bh = u / NCH, h = bh & 3, t0 = n * 64; const float g63 = expf(ret_lg(h) * 63.0f);
        const bf16_t* ka = WSP(bf16_t, WS_KRT) + ((size_t)bh * 64 + 16 * dt + x) * T + t0 + 8 * q;
#pragma unroll
        for (int k = 0; k < 2; ++k) { const int et = 2 * (wave & 1) + k; const bf16_t* vb = WSP(bf16_t, WS_VRT) + ((size_t)bh * 64 + 16 * et + x) * T + t0 + 8 * q;
            f32x4 acc = (f32x4){0.f, 0.f, 0.f, 0.f};
#pragma unroll
            for (int ks = 0; ks < 2; ++ks) acc = MFMA16(*(const bf16x8*)(ka + 32 * ks), *(const bf16x8*)(vb + 32 * ks), acc);
            *(f32x4*)(WSP(float, WS_RU) + (size_t)u * 4096 + (16 * et + x) * 64 + 16 * dt + 4 * q) = acc * g63; }
    }
}
__device__ __forceinline__ void ph_ret_scan(const P& p, int l) {
    const int G = (int)gridDim.x, skip = G > 2 * CH_ITEMS ? CH_ITEMS : 0;
    if ((int)blockIdx.x < skip) return;
    const int gt = ((int)blockIdx.x - skip) * NTHR + tidx(), ng = (G - skip) * NTHR;
    for (int e = gt; e < PB * 4 * 4096; e += ng) {
        const int bh = e >> 12, ed = e & 4095, h = bh & 3; const float cd = expf(ret_lg(h) * 64.0f);
        const float* U = WSP(float, WS_RU) + (size_t)bh * NCH * 4096 + ed; bf16_t* SPv = WSP(bf16_t, WS_RS) + (size_t)bh * NCH * 4096 + ed;
        float s = 0.f;
        static_assert(NCH % 8 == 0, "scan batches");
        constexpr int SB = NCH % 32 == 0 ? 32 : 8;
        for (int n0 = 0; n0 < NCH; n0 += SB) {
            float uv[SB];
#pragma unroll
            for (int k = 0; k < SB; ++k) uv[k] = U[(size_t)(n0 + k) * 4096];
#pragma unroll
            for (int k = 0; k < SB; ++k) { SPv[(size_t)(n0 + k) * 4096] = f2bf(s); s = s * cd + uv[k]; } }
        p.out[O_PRET + ((size_t)l * PB * 4 + bh) * 4096 + (ed & 63) * 64 + (ed >> 6)] = s;
    }
}
__device__ __forceinline__ void ph_ret_out(const P& p, int l) {
    const int tid = tidx(), lane = tid & 63, wave = tid >> 6, x = lane & 15, q = lane >> 4, it = UNIFORM(wave & 3);
    const bf16_t* PR = WSP(bf16_t, WS_PROJ);
    for (int u = blockIdx.x * 2 + (wave >> 2); u < NUNIT; u += gridDim.x * 2) {
        const int n = u % NCH, bh = u / NCH, h = bh & 3, b = bh >> 2, t0 = n * 64; const float gam = expf(ret_lg(h));
        const size_t rowi = (size_t)(b * T + t0 + 16 * it + x);
        bf16x8 qf[2];
#pragma unroll
        for (int ks = 0; ks < 2; ++ks) qf[ks] = *(const bf16x8*)(PR + rowi * NPROJ + C_QR + h * 64 + 32 * ks + 8 * q);
        f32x4 at[4];
#pragma unroll
        for (int jt = 0; jt < 4; ++jt) { at[jt] = (f32x4){0.f, 0.f, 0.f, 0.f};
            if (jt <= it) { const bf16_t* kp = PR + (size_t)(b * T + t0 + 16 * jt + x) * NPROJ + C_KR + h * 64 + 8 * q;
#pragma unroll
                for (int ks = 0; ks < 2; ++ks) at[jt] = MFMA16(*(const bf16x8*)(kp + 32 * ks), qf[ks], at[jt]);
                if (jt == it) {
#pragma unroll
                    for (int e = 0; e < 4; ++e) if (4 * q + e > x) at[jt][e] = 0.f; } } }
        const bf16x8 pb0 = pack_tiles(at[0], at[1]), pb1 = pack_tiles(at[2], at[3]);
        f32x4 o[4], os[4];
#pragma unroll
        for (int et = 0; et < 4; ++et) { o[et] = (f32x4){0.f, 0.f, 0.f, 0.f}; os[et] = (f32x4){0.f, 0.f, 0.f, 0.f};
            const bf16_t* vp = WSP(bf16_t, WS_VRT) + ((size_t)bh * 64 + 16 * et + x) * T + t0 + 4 * q;
            { const u32x2 lo = *(const u32x2*)vp, hi = *(const u32x2*)(vp + 16); u32x4 w; w.x = lo.x; w.y = lo.y; w.z = hi.x; w.w = hi.y; o[et] = MFMA16(__builtin_bit_cast(bf16x8, w), pb0, o[et]); }
            if (it >= 2) { const u32x2 lo = *(const u32x2*)(vp + 32), hi = *(const u32x2*)(vp + 48); u32x4 w; w.x = lo.x; w.y = lo.y; w.z = hi.x; w.w = hi.y; o[et] = MFMA16(__builtin_bit_cast(bf16x8, w), pb1, o[et]); }
            const bf16_t* sp = WSP(bf16_t, WS_RS) + (size_t)u * 4096 + (16 * et + x) * 64 + 8 * q;
#pragma unroll
            for (int ks = 0; ks < 2; ++ks) os[et] = MFMA16(*(const bf16x8*)(sp + 32 * ks), qf[ks], os[et]);
            o[et] = o[et] + os[et] * gam; }
        float sq = 0.f;
#pragma unroll
        for (int et = 0; et < 4; ++et) sq += (o[et][0] * o[et][0] + o[et][1] * o[et][1]) + (o[et][2] * o[et][2] + o[et][3] * o[et][3]);
        sq += __shfl_xor(sq, 16); sq += __shfl_xor(sq, 32);
        const float rstd = 1.0f / sqrtf(sq * (1.0f / 64.0f) + EPS);
#pragma unroll
        for (int et = 0; et < 4; ++et) { const int e0 = 16 * et + 4 * q; const u32x2 gw = *(const u32x2*)(PR + rowi * NPROJ + C_GR + h * 64 + e0); const f32x4 nw = *(const f32x4*)(p.ret_norm + l * 64 + e0);
            const float g0 = bf2f((bf16_t)(gw.x & 0xffff)), g1 = bf2f((bf16_t)(gw.x >> 16)), g2 = bf2f((bf16_t)(gw.y & 0xffff)), g3 = bf2f((bf16_t)(gw.y >> 16));
            u32x2 w; w.x = pk2(o[et][0] * rstd * nw[0] * silu_fast(g0), o[et][1] * rstd * nw[1] * silu_fast(g1)); w.y = pk2(o[et][2] * rstd * nw[2] * silu_fast(g2), o[et][3] * rstd * nw[3] * silu_fast(g3));
            *(u32x2*)(WSP(bf16_t, WS_O) + rowi * D + 256 + h * 64 + e0) = w; }
    }
}
__device__ __forceinline__ void ph_ret_sample(const P& p, int l, unsigned char* smem) {
    float* S0 = (float*)smem; float* qs = S0 + 4096; float* ks = qs + 8 * 64; float* vs = ks + 8 * 64;
    const int tid = tidx(); const bf16_t* PR = WSP(bf16_t, WS_PROJ);
    for (int u = gridDim.x - 1 - blockIdx.x; u < DB * 4; u += gridDim.x) {
        const int h = u & 3, b = u >> 2; const float lg = ret_lg(h);
        __syncthreads();
        for (int e = tid; e < 4096; e += NTHR) S0[e] = p.state_ret[(((size_t)l * DB + b) * 4 + h) * 4096 + e];
        { const int j = tid >> 6, d = tid & 63; const size_t row = (size_t)(MP + b * DS + j) * NPROJ;
          qs[tid] = bf2f(PR[row + C_QR + h * 64 + d]); ks[tid] = bf2f(PR[row + C_KR + h * 64 + d]); vs[tid] = bf2f(PR[row + C_VR + h * 64 + d]); }
        __syncthreads();
        { const int i = tid >> 6, e = tid & 63; float o = 0.f;
          for (int j = 0; j <= i; ++j) { float a = 0.f; for (int d = 0; d < 64; ++d) a += qs[i * 64 + d] * ks[j * 64 + d]; o += a * expf(lg * (float)(i - j)) * vs[j * 64 + e]; }
          float o2 = 0.f; for (int d = 0; d < 64; ++d) o2 += qs[i * 64 + d] * S0[d * 64 + e];
          o += o2 * expf(lg * (float)(i + 1));
          const float rstd = 1.0f / sqrtf(wave_sum(o * o) * (1.0f / 64.0f) + EPS);
          const size_t row = (size_t)(MP + b * DS + i); const float g = bf2f(PR[row * NPROJ + C_GR + h * 64 + e]);
          WSP(bf16_t, WS_O)[row * D + 256 + h * 64 + e] = f2bf(o * rstd * p.ret_norm[l * 64 + e] * silu_f(g)); }
        for (int x = tid; x < 4096; x += NTHR) { const int d = x >> 6, e = x & 63; float s = S0[x] * expf(lg * (float)DS);
            for (int j = 0; j < DS; ++j) s += ks[j * 64 + d] * expf(lg * (float)(DS - 1 - j)) * vs[j * 64 + e];
            p.out[O_SRET + (((size_t)l * DB + b) * 4 + h) * 4096 + x] = s; }
    }
}

template <int CS, int LDL> __device__ __forceinline__ void fwd_subst(float (&X)[CS], const float* Ls) {
#pragma unroll
    for (int i = 1; i < CS; ++i) {
        float a[4] = {X[i], 0.f, 0.f, 0.f};
#pragma unroll
        for (int j4 = 0; j4 < (i + 3) / 4; ++j4) { const f32x4 lv = *(const f32x4*)(Ls + i * LDL + 4 * j4);
#pragma unroll
            for (int e = 0; e < 4; ++e) if (4 * j4 + e < i) a[e] -= lv[e] * X[4 * j4 + e]; }
        X[i] = (a[0] + a[1]) + (a[2] + a[3]);
    }
}
constexpr int QP = 132;
constexpr int WSTP = 136;
constexpr int RWP = 392, TP = 136;
__device__ __forceinline__ void ph_gdn_prep(const P& p, int l, unsigned char* smem) {
    float* Ls = (float*)smem; float* As = Ls + 64 * 68; float* gs = As + 64 * 68; float* gcs = gs + 64; float* bts = gcs + 64; float* part = bts + 64;
    bf16_t* raw = (bf16_t*)(part + 4 * 64); bf16_t* Khi = raw + 67 * RWP; bf16_t* Klo = Khi + 64 * TP; bf16_t* Qb = Klo + 64 * TP;
    static_assert((64 * 68 * 2 + 64 * 3 + 4 * 64) * 4 + (67 * RWP + 3 * 64 * TP) * 2 <= BAR_LDS_OFF, "gdn_prep LDS");
    const int tid = tidx(), lane = tid & 63, wave = tid >> 6; const bf16_t* PR = WSP(bf16_t, WS_PROJ);
    for (int u = blockIdx.x; u < NUNIT; u += gridDim.x) {
        const int n = u % NCH, h = (u / NCH) % 4, b = u / (NCH * 4), t0 = n * 64;
        __syncthreads();
        for (int e = tid; e < 67 * 48; e += NTHR) { const int row = e / 48, ch = e % 48, t = t0 - 3 + row; u32x4 v = (u32x4){0u, 0u, 0u, 0u};
            if (t >= 0) v = *(const u32x4*)(PR + (size_t)(b * T + t) * NPROJ + C_CONV + (ch >> 4) * 512 + h * 128 + (ch & 15) * 8);
            *(u32x4*)(raw + row * RWP + ch * 8) = v; }
        if (tid >= 384 && tid < 448) { const int i = tid - 384; const size_t row = (size_t)(b * T + t0 + i); gs[i] = WSP(float, WS_G)[row * 4 + h]; bts[i] = WSP(float, WS_BETA)[row * 4 + h]; }
        __syncthreads();
        float y[64]; const int sec = tid < 128 ? 2 : tid < 256 ? 1 : 0, c = tid & 127;
        if (tid < 384) { const int col = sec * 512 + h * 128 + c;
            const float w0 = p.conv_w[(l * 4 + 0) * 1536 + col], w1 = p.conv_w[(l * 4 + 1) * 1536 + col], w2 = p.conv_w[(l * 4 + 2) * 1536 + col], w3 = p.conv_w[(l * 4 + 3) * 1536 + col];
            const LAS bf16_t* rp = (const LAS bf16_t*)raw + sec * 128 + c; LAUNDER_V(rp); float x0 = bf2f(rp[0]), x1 = bf2f(rp[RWP]), x2 = bf2f(rp[2 * RWP]);
#pragma unroll
            for (int i = 0; i < 64; ++i) { const float x3 = bf2f(rp[(i + 3) * RWP]); y[i] = silu_fast(w0 * x0 + w1 * x1 + w2 * x2 + w3 * x3); x0 = x1; x1 = x2; x2 = x3; if ((i & 7) == 7) COMPILER_FENCE(); } }
        if (tid >= 448) { if (tid == 448) { float a = 0.f; for (int i = 0; i < 64; ++i) { a += gs[i]; gcs[i] = a; } }
            WAVE_SYNC(); const int i = tid - 448; part[128 + i] = expf(gcs[i]); part[192 + i] = expf(gcs[63] - gcs[i]); }
#pragma unroll
        for (int pass = 0; pass < 2; ++pass) {
            if (tid >= 128 + 128 * pass && tid < 256 + 128 * pass) { LAS float* sq = (LAS float*)Ls + c; LAUNDER_V(sq);
#pragma unroll
                for (int i = 0; i < 64; ++i) sq[i * 132] = y[i] * y[i]; }
            __syncthreads();
            { const int i = tid >> 3, pt = tid & 7; const float* rp2 = Ls + i * 132 + pt * 16; float a = 0.f;
#pragma unroll
              for (int k = 0; k < 16; ++k) a += rp2[k];
              a += __shfl_xor(a, 1); a += __shfl_xor(a, 2); a += __shfl_xor(a, 4);
              if (pt == 0) part[64 * pass + i] = 1.0f / sqrtf(a + EPS); }
            __syncthreads();
        }
        if (tid >= 128 && tid < 256) { LAS bf16_t* kh = (LAS bf16_t*)Khi + c; LAS bf16_t* kl = (LAS bf16_t*)Klo + c; LAUNDER_V(kh); LAUNDER_V(kl);
#pragma unroll
            for (int i = 0; i < 64; ++i) { const float v = y[i] * part[i]; y[i] = v; const bf16_t hb = f2bf(v); kh[i * TP] = hb; kl[i * TP] = f2bf(v - bf2f(hb)); if ((i & 7) == 7) COMPILER_FENCE(); }
            bf16_t* dst = WSP(bf16_t, WS_GWK) + (size_t)u * 16384 + 8192; const int mt = c >> 4, x = c & 15;
#pragma unroll
            for (int ks2 = 0; ks2 < 2; ++ks2)
#pragma unroll
                for (int q = 0; q < 4; ++q) { const int i0 = 32 * ks2 + 4 * q; float v[8];
#pragma unroll
                    for (int e = 0; e < 8; ++e) { const int i = i0 + (e < 4 ? e : 12 + e); v[e] = y[i] * part[192 + i]; }
                    u32x4 w; w.x = pk2(v[0], v[1]); w.y = pk2(v[2], v[3]); w.z = pk2(v[4], v[5]); w.w = pk2(v[6], v[7]);
                    *(u32x4*)(dst + ((size_t)((mt * 2 + ks2) * 64 + q * 16 + x)) * 8) = w; COMPILER_FENCE(); } }
        else if (tid >= 256 && tid < 384) { bf16_t* qg = WSP(bf16_t, WS_GQ) + (size_t)u * 8192 + c; LAS bf16_t* qb = (LAS bf16_t*)Qb + c; LAUNDER_V(qb);
#pragma unroll
            for (int i = 0; i < 64; ++i) { const float v = y[i] * part[64 + i]; qb[i * TP] = f2bf(v); qg[(i & 7) * 128] = f2bf(v * 0.08838834764831845f * part[128 + i]); if ((i & 7) == 7) { qg += 8 * 128; LAUNDER_V(qg); COMPILER_FENCE(); } } }
        __syncthreads();
#pragma unroll
        for (int tp = 0; tp < 2; ++tp) { const int pos = wave * 2 + tp, it = pos >> 2, jt = pos & 3, j16 = lane & 15, qd = lane >> 4;
            f32x4 lk = (f32x4){0.f, 0.f, 0.f, 0.f}, aq = (f32x4){0.f, 0.f, 0.f, 0.f};
            if (jt <= it) {
#pragma unroll
                for (int ks = 0; ks < 4; ++ks) { const int ao = (16 * it + j16) * TP + 32 * ks + 8 * qd, bo = (16 * jt + j16) * TP + 32 * ks + 8 * qd;
                    const bf16x8 ah = *(const bf16x8*)(Khi + ao), al = *(const bf16x8*)(Klo + ao), aqf = *(const bf16x8*)(Qb + ao), bh = *(const bf16x8*)(Khi + bo), bl = *(const bf16x8*)(Klo + bo);
                    lk = MFMA16(ah, bh, lk); lk = MFMA16(ah, bl, lk); lk = MFMA16(al, bh, lk); aq = MFMA16(aqf, bh, aq); } }
            const int j = 16 * jt + j16;
#pragma unroll
            for (int e = 0; e < 4; ++e) { const int i = 16 * it + 4 * qd + e; const float ex = j <= i ? expf(gcs[i] - gcs[j]) : 0.f;
                Ls[i * 68 + j] = j < i ? bts[i] * lk[e] * ex : 0.f; As[i * 68 + j] = aq[e] * ex * 0.08838834764831845f; } }
        __syncthreads();
        if (tid < 256) {
            if (tid < 128) {
#pragma unroll
                for (int i = 0; i < 64; ++i) { y[i] *= bts[i]; if ((i & 15) == 15) COMPILER_FENCE(); } }
            else {
#pragma unroll
                for (int i = 0; i < 64; ++i) { y[i] *= bts[i] * part[128 + i]; if ((i & 15) == 15) COMPILER_FENCE(); } }
            fwd_subst<64, 68>(y, Ls);
            if (tid < 128) { bf16_t* U = WSP(bf16_t, WS_GU) + (size_t)u * 8192 + c * 64;
#pragma unroll
                for (int i8 = 0; i8 < 8; ++i8) { u32x4 w; w.x = pk2(y[8 * i8], y[8 * i8 + 1]); w.y = pk2(y[8 * i8 + 2], y[8 * i8 + 3]); w.z = pk2(y[8 * i8 + 4], y[8 * i8 + 5]); w.w = pk2(y[8 * i8 + 6], y[8 * i8 + 7]); *(u32x4*)(U + 8 * i8) = w; } }
            else { LAS bf16_t* wst = (LAS bf16_t*)raw + c; LAUNDER_V(wst);
#pragma unroll
                for (int i = 0; i < 64; ++i) wst[i * WSTP] = f2bf(-y[i]); }
        } else { const int t2 = tid - 256;
#pragma unroll 2
            for (int e = t2; e < 4096; e += 256) WSP(bf16_t, WS_GA)[(size_t)u * 4096 + e] = f2bf(As[(e >> 6) * 68 + (e & 63)]);
            if (t2 == 0) WSP(float, WS_GD)[u] = expf(gcs[63]); }
        __syncthreads();
        { bf16_t* dst = WSP(bf16_t, WS_GWK) + (size_t)u * 16384; const bf16_t* wst = raw;
#pragma unroll
          for (int k = 0; k < 2; ++k) { const int f = tid + NTHR * k, ln = f & 63, ks4 = (f >> 6) & 3, mt = f >> 8, q = ln >> 4, x = ln & 15;
              const bf16_t* wr = wst + (16 * mt + x) * WSTP + 32 * ks4 + 4 * q;
              u32x4 w; w.x = (unsigned)wr[0] | ((unsigned)wr[1] << 16); w.y = (unsigned)wr[2] | ((unsigned)wr[3] << 16); w.z = (unsigned)wr[16] | ((unsigned)wr[17] << 16); w.w = (unsigned)wr[18] | ((unsigned)wr[19] << 16);
              *(u32x4*)(dst + (size_t)f * 8) = w; } }
    }
}
constexpr int CH_SLOT = 36864, CH_NSLOT = 4;
static_assert(NCH % 4 == 0 && CH_NSLOT * CH_SLOT <= BAR_LDS_OFF, "chain ring");
__device__ __forceinline__ void chain_stage(const bf16_t* WK, const bf16_t* UTq, int m, int pw, int lane, unsigned char* smem) {
    unsigned char* slot = smem + (m % CH_NSLOT) * CH_SLOT;
#pragma unroll
    for (int k = 0; k < 6; ++k) { const int pc = pw * 6 + k;
        if (pc < 32) GLDS16((const unsigned char*)(WK + (size_t)m * 16384) + pc * 1024 + lane * 16, slot + pc * 1024);
        else GLDS16((const unsigned char*)(UTq + (size_t)m * 8192) + (pc - 32) * 1024 + lane * 16, slot + pc * 1024); }
}
__device__ __forceinline__ void ph_gdn_chain(const P& p, int l, unsigned char* smem) {
    const int tid = tidx(), lane = tid & 63, wave = UNIFORM(tid >> 6), j = lane & 15, q = lane >> 4;
    for (int it = blockIdx.x; it < CH_ITEMS; it += gridDim.x) {
        const int qt = it & 3, bh = it >> 2;
        const bf16_t* WK = WSP(bf16_t, WS_GWK) + (size_t)bh * NCH * 16384;
        const bf16_t* UTq = WSP(bf16_t, WS_GU) + (size_t)bh * NCH * 8192 + qt * 2048;
        __syncthreads();
        if (wave >= 2) {
            const int pw = wave - 2;
            chain_stage(WK, UTq, 0, pw, lane, smem); chain_stage(WK, UTq, 1, pw, lane, smem); chain_stage(WK, UTq, 2, pw, lane, smem);
#pragma unroll 1
            for (int n = 0; n < NCH; ++n) {
                if (n + 2 < NCH) WAIT_VM(12); else if (n + 1 < NCH) WAIT_VM(6); else WAIT_VM(0);
                RAW_BARRIER();
                if (n + 3 < NCH) chain_stage(WK, UTq, n + 3, pw, lane, smem);
            }
        } else {
            const int sl = qt * 2 + wave, c = 16 * sl + j;
            f32x4 S[8];
#pragma unroll
            for (int t = 0; t < 8; ++t) S[t] = (f32x4){0.f, 0.f, 0.f, 0.f};
            bf16x8 sB[4];
#pragma unroll
            for (int ks = 0; ks < 4; ++ks) sB[ks] = pack_tiles(S[2 * ks], S[2 * ks + 1]);
            const float* DC = WSP(float, WS_GD) + bh * NCH;
            float db[4];
#pragma unroll
            for (int d = 0; d < 4; ++d) db[d] = DC[d];
#pragma unroll 1
            for (int n0 = 0; n0 < NCH; n0 += 4) {
#pragma unroll
                for (int k4 = 0; k4 < 4; ++k4) {
                    const int n = n0 + k4, u = bh * NCH + n;
                    f32x4 acc[4]; const float dec = db[k4];
                    if (n + 4 < NCH) db[k4] = DC[n + 4];
                    { bf16_t* sp = WSP(bf16_t, WS_GS) + (size_t)u * 16384 + (size_t)sl * 2048 + lane * 8;
#pragma unroll
                      for (int tp = 0; tp < 4; ++tp) *(bf16x8*)(sp + 512 * tp) = sB[tp]; }
                    WAIT_LGKM0();
                    RAW_BARRIER();
                    const LAS unsigned char* slot = (const LAS unsigned char*)smem + (n % CH_NSLOT) * CH_SLOT + lane * 16; LAUNDER_V(slot);
                    { const LAS unsigned char* us = (const LAS unsigned char*)smem + (n % CH_NSLOT) * CH_SLOT + 32768 + ((16 * wave + j) * 64 + 4 * q) * 2; LAUNDER_V(us);
#pragma unroll
                      for (int mt = 0; mt < 4; ++mt) { const u32x2 w = *(const LAS u32x2*)(us + 32 * mt); acc[mt] = (f32x4){bf2f((bf16_t)(w.x & 0xffff)), bf2f((bf16_t)(w.x >> 16)), bf2f((bf16_t)(w.y & 0xffff)), bf2f((bf16_t)(w.y >> 16))}; } }
                    bf16x8 fa[8], fb[8];
#pragma unroll
                    for (int i = 0; i < 8; ++i) fa[i] = *(const LAS bf16x8*)(slot + i * 1024);
#pragma unroll
                    for (int i = 0; i < 8; ++i) fb[i] = *(const LAS bf16x8*)(slot + (8 + i) * 1024);
                    COMPILER_FENCE();
#pragma unroll
                    for (int ks = 0; ks < 4; ++ks) { acc[0] = MFMA16(fa[ks], sB[ks], acc[0]); acc[1] = MFMA16(fa[4 + ks], sB[ks], acc[1]); }
                    COMPILER_FENCE();
#pragma unroll
                    for (int i = 0; i < 8; ++i) fa[i] = *(const LAS bf16x8*)(slot + 16384 + i * 1024);
#pragma unroll
                    for (int ks = 0; ks < 4; ++ks) { acc[2] = MFMA16(fb[ks], sB[ks], acc[2]); acc[3] = MFMA16(fb[4 + ks], sB[ks], acc[3]); }
                    COMPILER_FENCE();
#pragma unroll
                    for (int i = 0; i < 8; ++i) fb[i] = *(const LAS bf16x8*)(slot + 16384 + (8 + i) * 1024);
                    const bf16x8 vB0 = pack_tiles(acc[0], acc[1]), vB1 = pack_tiles(acc[2], acc[3]);
                    { bf16_t* vp = WSP(bf16_t, WS_GV) + (size_t)u * 8192 + (size_t)sl * 1024 + lane * 8;
                      *(bf16x8*)vp = vB0; *(bf16x8*)(vp + 512) = vB1; }
#pragma unroll
                    for (int t = 0; t < 8; ++t) S[t] = S[t] * dec;
                    COMPILER_FENCE();
#pragma unroll
                    for (int t = 0; t < 4; ++t) S[t] = MFMA16(fa[2 * t], vB0, S[t]);
#pragma unroll
                    for (int t = 0; t < 4; ++t) S[t] = MFMA16(fa[2 * t + 1], vB1, S[t]);
#pragma unroll
                    for (int t = 0; t < 4; ++t) S[4 + t] = MFMA16(fb[2 * t], vB0, S[4 + t]);
#pragma unroll
                    for (int t = 0; t < 4; ++t) S[4 + t] = MFMA16(fb[2 * t + 1], vB1, S[4 + t]);
                    COMPILER_FENCE();
#pragma unroll
                    for (int ks = 0; ks < 4; ++ks) sB[ks] = pack_tiles(S[2 * ks], S[2 * ks + 1]);
                }
            }
            float* o = p.out + O_PGDN + ((size_t)l * PB * 4 + bh) * 16384 + c;
#pragma unroll
            for (int t = 0; t < 8; ++t)
#pragma unroll
                for (int e = 0; e < 4; ++e) o[(size_t)(16 * t + 4 * q + e) * 128] = S[t][e];
        }
    }
}
__device__ __forceinline__ void ph_gdn_out(const P& p, int l, unsigned char* smem) {
    const int tid = tidx(), lane = tid & 63, wave = tid >> 6, j = lane & 15, q = lane >> 4, mt = wave & 3;
    const bf16_t* PR = WSP(bf16_t, WS_PROJ);
    for (int u = blockIdx.x * 2 + (wave >> 2); u < NUNIT; u += gridDim.x * 2) {
        const int n = u % NCH, h = (u / NCH) % 4, b = u / (NCH * 4);
        f32x4 acc[8];
#pragma unroll
        for (int ct = 0; ct < 8; ++ct) acc[ct] = (f32x4){0.f, 0.f, 0.f, 0.f};
        const bf16_t* qg = WSP(bf16_t, WS_GQ) + (size_t)u * 8192 + (16 * mt + j) * 128 + 8 * q;
        const bf16_t* st = WSP(bf16_t, WS_GS) + (size_t)u * 16384 + ((2 * (q & 1)) * 16 + j) * 8 + (q >> 1) * 4;
#pragma unroll
        for (int ks = 0; ks < 4; ++ks) { const bf16x8 a = *(const bf16x8*)(qg + 32 * ks);
#pragma unroll
            for (int ct = 0; ct < 8; ++ct) { const bf16_t* sp = st + (size_t)ct * 2048 + ks * 512; const u32x2 lo = *(const u32x2*)sp, hi = *(const u32x2*)(sp + 128); u32x4 w; w.x = lo.x; w.y = lo.y; w.z = hi.x; w.w = hi.y;
                acc[ct] = MFMA16(a, __builtin_bit_cast(bf16x8, w), acc[ct]); }
            COMPILER_FENCE(); }
        const bf16_t* at = WSP(bf16_t, WS_GA) + (size_t)u * 4096 + (16 * mt + j) * 64 + 8 * q;
        const bf16_t* vt = WSP(bf16_t, WS_GV) + (size_t)u * 8192 + ((2 * (q & 1)) * 16 + j) * 8 + (q >> 1) * 4;
#pragma unroll
        for (int ks = 0; ks < 2; ++ks) { const bf16x8 a = *(const bf16x8*)(at + 32 * ks);
#pragma unroll
            for (int ct = 0; ct < 8; ++ct) { const bf16_t* vp = vt + (size_t)ct * 1024 + ks * 512; const u32x2 lo = *(const u32x2*)vp, hi = *(const u32x2*)(vp + 128); u32x4 w; w.x = lo.x; w.y = lo.y; w.z = hi.x; w.w = hi.y;
                acc[ct] = MFMA16(a, __builtin_bit_cast(bf16x8, w), acc[ct]); }
            COMPILER_FENCE(); }
        float sq[4];
#pragma unroll
        for (int e = 0; e < 4; ++e) { float s = 0.f;
#pragma unroll
            for (int ct = 0; ct < 8; ++ct) s += acc[ct][e] * acc[ct][e];
            s += __shfl_xor(s, 1); s += __shfl_xor(s, 2); s += __shfl_xor(s, 4); s += __shfl_xor(s, 8); sq[e] = 1.0f / sqrtf(s * (1.0f / 128.0f) + EPS); }
        float* stg = (float*)smem + wave * (16 * 132);
#pragma unroll
        for (int e = 0; e < 4; ++e)
#pragma unroll
            for (int ct = 0; ct < 8; ++ct) stg[(4 * q + e) * 132 + 16 * ct + j] = acc[ct][e] * sq[e];
        WAVE_SYNC();
        { const int rr = lane >> 2, cg = lane & 3; const size_t row = (size_t)(b * T + n * 64 + 16 * mt + rr);
#pragma unroll
          for (int k4 = 0; k4 < 4; ++k4) { const int c0 = cg * 32 + k4 * 8; const f32x4 o0 = *(const f32x4*)(stg + rr * 132 + c0), o1 = *(const f32x4*)(stg + rr * 132 + c0 + 4);
              float z[8]; unpack8(*(const u32x4*)(PR + row * NPROJ + C_Z + h * 128 + c0), z); const f32x4 n0 = *(const f32x4*)(p.gdn_norm + l * 128 + c0), n1 = *(const f32x4*)(p.gdn_norm + l * 128 + c0 + 4);
              float r8[8];
#pragma unroll
              for (int i = 0; i < 4; ++i) { r8[i] = o0[i] * n0[i] * silu_fast(z[i]); r8[4 + i] = o1[i] * n1[i] * silu_fast(z[4 + i]); }
              *(u32x4*)(WSP(bf16_t, WS_O) + row * D + 512 + h * 128 + c0) = pack8f(r8); } }
        WAVE_SYNC();
    }
}
__device__ __forceinline__ void ph_gdn_sample(const P& p, int l, unsigned char* smem) {
    float* qs = (float*)smem; float* ks = qs + 8 * QP; float* vs = ks + 8 * QP; float* us = vs + 8 * QP; float* wsm = us + 8 * 128; float* vn = wsm + 8 * 128;
    float* Ls = vn + 8 * 128; float* As = Ls + 8 * 8; float* gs = As + 8 * 8; float* gcs = gs + 8; float* bts = gcs + 8; float* S0 = bts + 8;
    const int tid = tidx(); const bf16_t* PR = WSP(bf16_t, WS_PROJ);
    for (int u = gridDim.x - 1 - blockIdx.x; u < DB * 4; u += gridDim.x) {
        const int h = u & 3, b = u >> 2;
        __syncthreads();
#pragma unroll 4
        for (int e = tid; e < 16384; e += NTHR) S0[e] = p.state_gdn[(((size_t)l * DB + b) * 4 + h) * 16384 + e];
        if (tid < 384) { const int sec = tid >> 7, c = tid & 127, col = sec * 512 + h * 128 + c; float* dst = sec == 0 ? qs : sec == 1 ? ks : vs;
            const float w0 = p.conv_w[(l * 4 + 0) * 1536 + col], w1 = p.conv_w[(l * 4 + 1) * 1536 + col], w2 = p.conv_w[(l * 4 + 2) * 1536 + col], w3 = p.conv_w[(l * 4 + 3) * 1536 + col];
            const float* hist = p.state_conv + (((size_t)l * DB + b) * 3) * 1536 + col; const bf16_t* src = PR + (size_t)(MP + b * DS) * NPROJ + C_CONV + col;
            float x0 = hist[0], x1 = hist[1536], x2 = hist[2 * 1536];
            for (int i = 0; i < DS; ++i) { const float x3 = bf2f(src[(size_t)i * NPROJ]); const float y = w0 * x0 + w1 * x1 + w2 * x2 + w3 * x3; dst[i * QP + c] = silu_f(y); x0 = x1; x1 = x2; x2 = x3; } }
        else if (tid < 384 + DS) { const int i = tid - 384; const size_t row = (size_t)(MP + b * DS + i); gs[i] = WSP(float, WS_G)[row * 4 + h]; bts[i] = WSP(float, WS_BETA)[row * 4 + h]; }
        __syncthreads();
        if (tid < 64) { const int rid = tid >> 2, part = tid & 3; float* rowp = (rid < 8 ? qs + rid * QP : ks + (rid - 8) * QP) + part * 32; float s = 0.f;
            for (int d = 0; d < 32; ++d) s += rowp[d] * rowp[d];
            s += __shfl_xor(s, 1); s += __shfl_xor(s, 2); const float sc = 1.0f / sqrtf(s + EPS);
            for (int d = 0; d < 32; ++d) rowp[d] *= sc; }
        if (tid == 64) { float a = 0.f; for (int i = 0; i < DS; ++i) { a += gs[i]; gcs[i] = a; } }
        __syncthreads();
        if (tid < 64) { const int i = tid >> 3, j = tid & 7; float lv = 0.f, av = 0.f;
            if (j <= i) { float dk = 0.f, dq = 0.f; for (int d = 0; d < 128; ++d) { const float kj = ks[j * QP + d]; dk += ks[i * QP + d] * kj; dq += qs[i * QP + d] * kj; }
                const float e = expf(gcs[i] - gcs[j]); av = dq * e * 0.08838834764831845f; lv = j < i ? bts[i] * dk * e : 0.f; }
            Ls[i * 8 + j] = lv; As[i * 8 + j] = av; }
        __syncthreads();
        if (tid < 256) { const int c = tid; float X[8];
            if (c < 128) {
#pragma unroll
                for (int i = 0; i < 8; ++i) X[i] = vs[i * QP + c] * bts[i]; }
            else {
#pragma unroll
                for (int i = 0; i < 8; ++i) X[i] = ks[i * QP + c - 128] * bts[i] * expf(gcs[i]); }
            fwd_subst<8, 8>(X, Ls);
            float* dst = c < 128 ? us + c : wsm + c - 128;
#pragma unroll
            for (int i = 0; i < 8; ++i) dst[i * 128] = X[i]; }
        __syncthreads();
        const int i = tid >> 6, c2 = (tid & 63) * 2;
        { float a0 = us[i * 128 + c2], a1 = us[i * 128 + c2 + 1];
          for (int d = 0; d < 128; ++d) { const float w = wsm[i * 128 + d]; a0 -= w * S0[d * 128 + c2]; a1 -= w * S0[d * 128 + c2 + 1]; }
          vn[i * 128 + c2] = a0; vn[i * 128 + c2 + 1] = a1; }
        __syncthreads();
        { float o0 = 0.f, o1 = 0.f; const float qsc = 0.08838834764831845f * expf(gcs[i]);
          for (int d = 0; d < 128; ++d) { const float qg = qs[i * QP + d] * qsc; o0 += qg * S0[d * 128 + c2]; o1 += qg * S0[d * 128 + c2 + 1]; }
          for (int j = 0; j < DS; ++j) { const float a = As[i * 8 + j]; o0 += a * vn[j * 128 + c2]; o1 += a * vn[j * 128 + c2 + 1]; }
          const float rstd = 1.0f / sqrtf(wave_sum(o0 * o0 + o1 * o1) * (1.0f / 128.0f) + EPS);
          const size_t row = (size_t)(MP + b * DS + i);
          const float z0 = bf2f(PR[row * NPROJ + C_Z + h * 128 + c2]), z1 = bf2f(PR[row * NPROJ + C_Z + h * 128 + c2 + 1]);
          bf16_t* O = WSP(bf16_t, WS_O) + row * D + 512 + h * 128 + c2;
          O[0] = f2bf(o0 * rstd * p.gdn_norm[l * 128 + c2] * silu_f(z0)); O[1] = f2bf(o1 * rstd * p.gdn_norm[l * 128 + c2 + 1] * silu_f(z1)); }
        { const float gl = gcs[DS - 1], dec = expf(gl); float* o = p.out + O_SGDN + (((size_t)l * DB + b) * 4 + h) * 16384;
#pragma unroll 2
          for (int e = tid; e < 16384; e += NTHR) { const int d = e >> 7, c = e & 127; float s = S0[e] * dec;
              for (int j = 0; j < DS; ++j) s += ks[j * QP + d] * expf(gl - gcs[j]) * vn[j * 128 + c];
              o[e] = s; } }
    }
}


template <int K> __device__ __forceinline__ void ph_gemm_small(const P& p, const bf16_t* A  , const bf16_t* Bt  , const float* gate, const float* xs_in  , unsigned char* smem) {
    static_assert(MS % 16 == 0 && K % 256 == 0, "small GEMM shape");
    constexpr int KW = K / 8, NKS = KW / 32;
    const int tid = tidx(), lane = tid & 63, wave = tid >> 6, x = lane & 15, q = lane >> 4;
    float* red = (float*)smem;
    for (int it = blockIdx.x; it < (MS / 16) * 16; it += gridDim.x) {
        const int rt = it % (MS / 16), cg = it / (MS / 16);
        const bf16_t* ap = A + (size_t)(16 * rt + x) * K + wave * KW + 8 * q;
        const bf16_t* bp = Bt + (size_t)(64 * cg + x) * K + wave * KW + 8 * q;
        f32x4 acc[4];
#pragma unroll
        for (int ct = 0; ct < 4; ++ct) acc[ct] = (f32x4){0.f, 0.f, 0.f, 0.f};
#pragma unroll
        for (int ks = 0; ks < NKS; ++ks) { const bf16x8 a = *(const bf16x8*)(ap + 32 * ks);
#pragma unroll
            for (int ct = 0; ct < 4; ++ct) acc[ct] = MFMA16(a, *(const bf16x8*)(bp + (size_t)ct * 16 * K + 32 * ks), acc[ct]); }
        __syncthreads();
#pragma unroll
        for (int ct = 0; ct < 4; ++ct) *(f32x4*)(red + ((wave * 4 + ct) * 64 + lane) * 4) = acc[ct];
        __syncthreads();
        if (wave < 4) { f32x4 s = (f32x4){0.f, 0.f, 0.f, 0.f};
#pragma unroll
            for (int w = 0; w < 8; ++w) s += *(const f32x4*)(red + ((w * 4 + wave) * 64 + lane) * 4);
            const int col = 64 * cg + 16 * wave + x;
#pragma unroll
            for (int e = 0; e < 4; ++e) { const int row = MP + 16 * rt + 4 * q + e; float* xp = p.out + (size_t)row * D + col; const float xin = xs_in ? xs_in[(size_t)(row - MP) * D + col] : *xp; *xp = xin + gate[(size_t)row_cb(row) * 6144 + col] * s[e]; } }
    }
}

__device__ __forceinline__ void ph_final_norm(const P& p) {
    const int lane = tidx() & 63, wave = tidx() >> 6, gw = blockIdx.x * 8 + wave, ngw = gridDim.x * 8;
    for (int r = gw; r < M; r += ngw) {
        float* xr = p.out + (size_t)r * D; f32x4 v[4]; float ss = 0.f;
#pragma unroll
        for (int j = 0; j < 4; ++j) { v[j] = *(const f32x4*)(xr + 4 * lane + 256 * j); ss += (v[j][0] * v[j][0] + v[j][1] * v[j][1]) + (v[j][2] * v[j][2] + v[j][3] * v[j][3]); }
        const float rstd = 1.0f / sqrtf(wave_sum(ss) * (1.0f / D) + EPS);
#pragma unroll
        for (int j = 0; j < 4; ++j) { const f32x4 g = *(const f32x4*)(p.final_norm + 4 * lane + 256 * j); *(f32x4*)(xr + 4 * lane + 256 * j) = v[j] * rstd * g; }
    }
}

enum Phase { PH_PRO = 0, PH_NORM1, PH_GEMM_IN, PH_ROPE, PH_MIX1, PH_MIX2, PH_MIX3, PH_GEMM_OUT, PH_NORM2, PH_GEMM_GU, PH_GEMM_DN, PH_FINAL };
#ifdef __HIP_EMU__
#define LDSP(x) (x)
#else
#define LDSP(x) ((PG8_LAS unsigned char*)(x))
#endif
template <int PH> __device__ __forceinline__ void run_phase(const P& p, int l, unsigned char* smem) {
    if constexpr (PH == PH_PRO) { ph_convert(p, smem, 0, CV_IN, 0, (int)gridDim.x); __syncthreads(); ph_adaln(p, smem, 0, 1, 0, (int)gridDim.x); ph_ropetab_copyx(p); }
    else if constexpr (PH == PH_NORM1) ph_norm_mod<0>(p, l, smem);
    else if constexpr (PH == PH_GEMM_IN) {
        pg8::Gemm g{WSP(bf16_t, WS_H), WSP(bf16_t, WS_WIN) + (size_t)l * NPROJ * D, MPAD, NPROJ, D}; pg8::StaticOrder S; S.init(MPAD, NPROJ, (int)gridDim.x, (int)blockIdx.x);
        pg8::EpiStoreBf16 E{WSP(bf16_t, WS_PROJ), NPROJ};
        pg8::gemm_phase<pg8::EpiStoreBf16, pg8::StaticOrder, true, true>(LDSP(smem), g, S, E);
    }
    else if constexpr (PH == PH_ROPE) { ph_rope_out(p, l); ph_vtrans(p, l, smem); }
    else if constexpr (PH == PH_MIX1) { ph_ret_local(p, l); ph_gdn_prep(p, l, smem); }
    else if constexpr (PH == PH_MIX2) { ph_gdn_chain(p, l, smem); { const int G = (int)gridDim.x; const bool split = G >= CH_ITEMS + DB * 4 + 16; ph_attn_jobs(p, split ? CH_ITEMS : 0, split ? G - DB * 4 : G, split ? 3 : 0); }
        __syncthreads(); ph_attn_sample(p, l, smem); ph_ret_sample(p, l, smem); ph_gdn_sample(p, l, smem); ph_ret_scan(p, l);
        if (l + 1 < NL) { const int G = (int)gridDim.x; const bool split = G >= CH_ITEMS + DB * 4 + 16; const int b0 = split ? CH_ITEMS : 0;
            __syncthreads(); ph_convert(p, smem, l == 0 ? CV_IN : (l + 1) * CV_L, (l + 2) * CV_L, b0, G); __syncthreads(); ph_adaln(p, smem, l + 1, l + 2, b0, G); } }
    else if constexpr (PH == PH_MIX3) { ph_attn_combine(p); ph_ret_out(p, l); ph_gdn_out(p, l, smem); }
    else if constexpr (PH == PH_GEMM_OUT) {
        ph_gemm_small<D>(p, WSP(bf16_t, WS_O) + (size_t)MP * D, WSP(bf16_t, WS_WOUT) + (size_t)l * D * D, WSP(float, WS_MOD) + (size_t)l * NC * 6144 + 2048, l == 0 ? p.x_sample : nullptr, smem); __syncthreads();
        pg8::Gemm g{WSP(bf16_t, WS_O), WSP(bf16_t, WS_WOUT) + (size_t)l * D * D, MP, D, D}; pg8::StaticOrder S; S.init(MP, D, (int)gridDim.x, (int)blockIdx.x);
        pg8::EpiResidual E{p.out, WSP(float, WS_MOD) + (size_t)l * NC * 6144 + 2048, l == 0 ? p.x_prompt : p.out};
        pg8::gemm_phase<pg8::EpiResidual, pg8::StaticOrder, true, true>(LDSP(smem), g, S, E);
    }
    else if constexpr (PH == PH_NORM2) ph_norm_mod<1>(p, l, smem);
    else if constexpr (PH == PH_GEMM_GU) {
        pg8::Gemm g{WSP(bf16_t, WS_H), WSP(bf16_t, WS_WGU) + (size_t)l * 2 * FF * D, MPAD, 2 * FF, D}; pg8::StaticOrder S; S.init(MPAD, 2 * FF, (int)gridDim.x, (int)blockIdx.x);
        pg8::EpiSwiglu E{WSP(bf16_t, WS_HID)};
        pg8::gemm_phase<pg8::EpiSwiglu, pg8::StaticOrder, true, true>(LDSP(smem), g, S, E);
    }
    else if constexpr (PH == PH_GEMM_DN) {
        ph_gemm_small<FF>(p, WSP(bf16_t, WS_HID) + (size_t)MP * FF, WSP(bf16_t, WS_WDN) + (size_t)l * D * FF, WSP(float, WS_MOD) + (size_t)l * NC * 6144 + 5120, nullptr, smem); __syncthreads();
        pg8::Gemm g{WSP(bf16_t, WS_HID), WSP(bf16_t, WS_WDN) + (size_t)l * D * FF, MP, D, FF}; pg8::StaticOrder S; S.init(MP, D, (int)gridDim.x, (int)blockIdx.x);
        pg8::EpiResidual E{p.out, WSP(float, WS_MOD) + (size_t)l * NC * 6144 + 5120, p.out};
        pg8::gemm_phase<pg8::EpiResidual, pg8::StaticOrder, true, true>(LDSP(smem), g, S, E);
    }
    else if constexpr (PH == PH_FINAL) ph_final_norm(p);
}
template <int PH> __global__ void __launch_bounds__(NTHR, 2) k_phase(P p, int l) { DYN_SMEM(smem); run_phase<PH>(p, l, smem); }


#ifndef __HIP_EMU__
#define LAS __attribute__((address_space(3)))
#define XB_TMO      128
#define XB_XCNT(j)  (256  + 64 * (j))
#define XB_XSUB(j)  (1280 + 64 * (j))
#define XB_XGEN(j)  (2304 + 64 * (j))
#define XB_TOP      3328
#define XB_TOPGEN   3392
#define XCD_BAR_WORDS 3456
#define XB_SPIN_CAP (1u << 18)

__device__ __forceinline__ unsigned xb_ld(unsigned* p)              { return __hip_atomic_load(p, __ATOMIC_RELAXED, __HIP_MEMORY_SCOPE_AGENT); }
__device__ __forceinline__ unsigned xb_add(unsigned* p, unsigned v) { return __hip_atomic_fetch_add(p, v, __ATOMIC_RELAXED, __HIP_MEMORY_SCOPE_AGENT); }
__device__ __forceinline__ unsigned xb_xcc_id() { return (unsigned)__builtin_amdgcn_s_getreg((3 << 11) | 20) & 0xFu; }
#define XB_SPIN(cond, bar) do { unsigned _sp = 0; while (cond) { __builtin_amdgcn_s_sleep(1); \
    if ((++_sp & 255u) == 0u) { if (xb_ld(&(bar)[XB_TMO])) break; if (_sp > XB_SPIN_CAP) { atomicAdd(&(bar)[XB_TMO], 1u); break; } } } } while (0)

struct XcdBarrier {
    unsigned* bar; unsigned x;
    volatile LAS unsigned* st;
};

__device__ __forceinline__ XcdBarrier xcd_barrier_post(unsigned* bar, volatile LAS unsigned* st) {
    XcdBarrier b; b.bar = bar; b.x = xb_xcc_id(); b.st = st;
    if (threadIdx.x == 0) (void)xb_add(&bar[XB_XCNT(b.x)], 1u);
    return b;
}
__device__ __forceinline__ void xcd_barrier_complete(unsigned* bar, unsigned x, unsigned& nloc, unsigned& nx) {
    const unsigned G = gridDim.x * gridDim.y * gridDim.z;
    unsigned sum, cnt, mine, sp = 0u;
    for (;;) {
        sum = 0u; cnt = 0u; mine = 0u;
#pragma unroll
        for (unsigned j = 0; j < 16; ++j) { const unsigned c = xb_ld(&bar[XB_XCNT(j)]); sum += c; cnt += (c > 0u) ? 1u : 0u; mine = (j == x) ? c : mine; }
        if (sum == G) break;
        __builtin_amdgcn_s_sleep(1);
        if ((++sp & 255u) == 0u) { if (xb_ld(&bar[XB_TMO])) break; if (sp > XB_SPIN_CAP) { atomicAdd(&bar[XB_TMO], 1u); break; } }
    }
    nloc = mine > 0u ? mine : 1u; nx = cnt > 0u ? cnt : 1u;
}

__device__ __forceinline__ void xcd_barrier(const XcdBarrier& b) {
    asm volatile("s_waitcnt vmcnt(0)" ::: "memory");
    __syncthreads();
    if (threadIdx.x == 0) {
        unsigned* bar = b.bar;
        __builtin_amdgcn_s_waitcnt(0);
        unsigned nloc = b.st[0], nx = b.st[1];
        if (nloc == 0u) { xcd_barrier_complete(bar, b.x, nloc, nx); b.st[0] = nloc; b.st[1] = nx; }
        const unsigned old = xb_add(&bar[XB_XSUB(b.x)], 1u);
        const unsigned gen = old / nloc;
        if (old + 1u == (gen + 1u) * nloc) {
            __builtin_amdgcn_fence(__ATOMIC_RELEASE, "agent");
            asm volatile("s_waitcnt vmcnt(0)" ::: "memory");
            const unsigned og = xb_add(&bar[XB_TOP], 1u);
            const unsigned tg = og / nx;
            if (og + 1u == (tg + 1u) * nx) xb_add(&bar[XB_TOPGEN], 1u);
            else XB_SPIN(xb_ld(&bar[XB_TOPGEN]) == tg, bar);
            __builtin_amdgcn_fence(__ATOMIC_ACQUIRE, "agent");
            xb_add(&bar[XB_XGEN(b.x)], 1u);
            asm volatile("s_waitcnt vmcnt(0)" ::: "memory");
        } else {
            XB_SPIN(xb_ld(&bar[XB_XGEN(b.x)]) == gen, bar);
            __builtin_amdgcn_fence(__ATOMIC_ACQUIRE, "agent");
            asm volatile("s_waitcnt vmcnt(0)" ::: "memory");
        }
    }
    __syncthreads();
}

#endif

#ifndef __HIP_EMU__
#define GRID_SYNC() xcd_barrier(bar)
__global__ void __launch_bounds__(NTHR, 2) k_mega(P p_arg) {
    DYN_SMEM(smem);
#if defined(__HIP_DEVICE_COMPILE__)
#define PHASE(PH_, l_) do { const __attribute__((address_space(4))) P* kp_ = (const __attribute__((address_space(4))) P*)__builtin_amdgcn_kernarg_segment_ptr(); LAUNDER_PTR(kp_); P pl_; __builtin_memcpy(&pl_, kp_, sizeof(P)); run_phase<PH_>(pl_, l_, smem); } while (0)
#else
#define PHASE(PH_, l_) run_phase<PH_>(p_arg, l_, smem)
#endif
    cooperative_groups::grid_group grid = cooperative_groups::this_grid();
    volatile LAS unsigned* bst = (volatile LAS unsigned*)((LAS unsigned char*)smem + BAR_LDS_OFF);
    if (threadIdx.x < 4) bst[threadIdx.x] = 0u;
    __syncthreads();
    XcdBarrier bar = xcd_barrier_post((unsigned*)(p_arg.ws + WS_CTL + 4096), bst);
    PHASE(PH_PRO, 0); grid.sync();
#define LAYER(l) do { PHASE(PH_NORM1, l); GRID_SYNC(); PHASE(PH_GEMM_IN, l); GRID_SYNC(); PHASE(PH_ROPE, l); GRID_SYNC(); PHASE(PH_MIX1, l); GRID_SYNC(); PHASE(PH_MIX2, l); GRID_SYNC(); \
        PHASE(PH_MIX3, l); GRID_SYNC(); PHASE(PH_GEMM_OUT, l); GRID_SYNC(); PHASE(PH_NORM2, l); GRID_SYNC(); PHASE(PH_GEMM_GU, l); GRID_SYNC(); PHASE(PH_GEMM_DN, l); GRID_SYNC(); } while (0)
    static_assert(NL == 2, "two layers written out (a loop over the layers makes hipcc hoist every phase's constants to the loop preheader and spill)");
    LAYER(0); LAYER(1);
    PHASE(PH_FINAL, 0);
}
#endif

template <int PH> static void launch_phase(const P& p, int l, int grid, hipStream_t stream) {
#ifndef __HIP_EMU__
    static bool attr_done = false;
    if (!attr_done) { (void)hipFuncSetAttribute((const void*)k_phase<PH>, hipFuncAttributeMaxDynamicSharedMemorySize, SMEM_BYTES); attr_done = true; }
#endif
    LAUNCH(k_phase<PH>, grid, SMEM_BYTES, stream, p, l);
}

extern "C" void kernel_launch(void* const* d_in, const int* in_sizes, int n_in, void* d_out, int out_size, void* d_ws, size_t ws_size, hipStream_t stream) {
    if (n_in != 24 || (size_t)out_size != O_END || ws_size < WS_END) {
        fprintf(stderr, "kernel_launch: shape mismatch: n_in %d out_size %d (want %zu) ws %zu (want %zu)\n", n_in, out_size, (size_t)O_END, ws_size, (size_t)WS_END); return; }
    P p{};
    const float** pp = (const float**)&p;
    for (int i = 0; i < 24; ++i) pp[i] = (const float*)d_in[i];
    p.out = (float*)d_out; p.ws = (unsigned char*)d_ws;
#ifndef __HIP_EMU__
    static int grid = 0;
    if (grid == 0) {
        int dev = 0, cus = 0, per_cu = 0;
        if (hipGetDevice(&dev) != hipSuccess || hipDeviceGetAttribute(&cus, hipDeviceAttributeMultiprocessorCount, dev) != hipSuccess || cus <= 0) { fprintf(stderr, "kernel_launch: device query failed\n"); grid = -1; return; }
        if (hipFuncSetAttribute((const void*)k_mega, hipFuncAttributeMaxDynamicSharedMemorySize, SMEM_BYTES) != hipSuccess) { fprintf(stderr, "kernel_launch: hipFuncSetAttribute failed\n"); grid = -1; return; }
        if (hipOccupancyMaxActiveBlocksPerMultiprocessor(&per_cu, (const void*)k_mega, NTHR, SMEM_BYTES) != hipSuccess || per_cu < 1) { fprintf(stderr, "kernel_launch: occupancy query says %d blocks per CU\n", per_cu); grid = -1; return; }
        grid = cus;
    }
    if (grid < 0) return;
    if (hipMemsetAsync((char*)d_ws + WS_CTL, 0, 65536, stream) != hipSuccess) { fprintf(stderr, "kernel_launch: memset of the barrier words failed\n"); return; }
    { void* args[] = {(void*)&p};
      hipError_t e = hipLaunchCooperativeKernel((const void*)k_mega, dim3(grid), dim3(NTHR), args, SMEM_BYTES, stream);
      if (e != hipSuccess) fprintf(stderr, "kernel_launch: cooperative launch failed: %s (grid %d)\n", hipGetErrorString(e), grid);
      return; }
#else
    int grid = 16;
#endif
    launch_phase<PH_PRO>(p, 0, grid, stream);
    for (int l = 0; l < NL; ++l) {
        launch_phase<PH_NORM1>(p, l, grid, stream);
        launch_phase<PH_GEMM_IN>(p, l, grid, stream);
        launch_phase<PH_ROPE>(p, l, grid, stream);
        launch_phase<PH_MIX1>(p, l, grid, stream);
        launch_phase<PH_MIX2>(p, l, grid, stream);
        launch_phase<PH_MIX3>(p, l, grid, stream);
        launch_phase<PH_GEMM_OUT>(p, l, grid, stream);
        launch_phase<PH_NORM2>(p, l, grid, stream);
        launch_phase<PH_GEMM_GU>(p, l, grid, stream);
        launch_phase<PH_GEMM_DN>(p, l, grid, stream);
    }
    launch_phase<PH_FINAL>(p, 0, grid, stream);
}
```

```cpp
#ifndef __HIP_EMU__
#include <hip/hip_runtime.h>
#include <hip/hip_cooperative_groups.h>
#endif
#include <cstdio>
#include <cstdint>
#include <cmath>

#ifndef CFG_BATCH
#define CFG_BATCH 2
#endif
#ifndef CFG_SEQ
#define CFG_SEQ 8192
#endif
#ifndef CFG_DB
#define CFG_DB 32
#endif
constexpr float LOG2E = 1.4426950408889634f;
constexpr int D = 1024, NL = 2, PB = CFG_BATCH, T = CFG_SEQ, DB = CFG_DB, DS = 8, PAST = 16384, WB = 2048;
constexpr int MP = PB * T, MS = DB * DS, M = MP + MS, MPAD = (M + 255) / 256 * 256, NC = PB + DB;
constexpr int INC = 3848, NPROJ = 3840, FF = 2816, NCH = T / 64, PWIN = T < 2048 ? T : 2048, NPOS = T + DS;
constexpr int NUNIT = PB * 4 * NCH;
constexpr float EPS = 1e-6f;
static_assert(T % 512 == 0, "the attention job decomposition wants T % 512 == 0");
constexpr int C_QA = 0, C_KA = 256, C_VA = 512, C_QR = 768, C_KR = 1024, C_VR = 1280, C_GR = 1536, C_CONV = 1792, C_Z = 3328;
constexpr int SMEM_BYTES = 148480;
constexpr int NTHR = 512;
constexpr int BAR_LDS_OFF = SMEM_BYTES - 64;

typedef unsigned short bf16_t;
typedef short bf16x8 __attribute__((ext_vector_type(8)));
typedef float f32x4 __attribute__((ext_vector_type(4)));
typedef unsigned u32x4 __attribute__((ext_vector_type(4)));
typedef unsigned u32x2 __attribute__((ext_vector_type(2)));
typedef float f32x16 __attribute__((ext_vector_type(16)));

#ifdef __HIP_EMU__
#define LAUNCH(kern, grid, lds, stream, ...) emu_launch(grid, NTHR, [=]() { kern(__VA_ARGS__); })
#define DYN_SMEM(name) unsigned char* name = emu_dyn_smem()
#define WAVE_SYNC() emu_wave_bar()
#define MFMA32(a, b, c) emu_mfma32(a, b, c)
#define GLDS16(gp, lp) memcpy((unsigned char*)(lp) + (threadIdx.x & 63) * 16, (gp), 16)
#define RAW_BARRIER() __syncthreads()
#define GLDS4(gp, lp) ((void)0)
#define WAIT_VM(n)
#define WAIT_LGKM0()
#define LAS
#define UNIFORM(x) (x)
#define COMPILER_FENCE()
#define LAUNDER_V(x)
#define MFMA16(a, b, c) emu_mfma16(a, b, c)
#else
#define WAVE_SYNC() asm volatile("s_waitcnt lgkmcnt(0)" ::: "memory")
#define MFMA32(a, b, c) __builtin_amdgcn_mfma_f32_32x32x16_bf16(a, b, c, 0, 0, 0)
#define LAS __attribute__((address_space(3)))
#define GLDS16(gp, lp) __builtin_amdgcn_global_load_lds((const unsigned*)(gp), (LAS unsigned*)(lp), 16, 0, 0)
#define RAW_BARRIER() __builtin_amdgcn_s_barrier()
#define GLDS4(gp, lp) __builtin_amdgcn_global_load_lds((const unsigned*)(gp), (LAS unsigned*)(lp), 4, 0, 0)
#define WAIT_VM(n) asm volatile("s_waitcnt vmcnt(" #n ")" ::: "memory")
#define WAIT_LGKM0() asm volatile("s_waitcnt lgkmcnt(0)" ::: "memory")
#define UNIFORM(x) __builtin_amdgcn_readfirstlane(x)
#define COMPILER_FENCE() __builtin_amdgcn_sched_barrier(0)
#define LAUNDER_V(x) asm volatile("" : "+v"(x))
#define MFMA16(a, b, c) __builtin_amdgcn_mfma_f32_16x16x32_bf16(a, b, c, 0, 0, 0)
#define LAUNCH(kern, grid, lds, stream, ...) hipLaunchKernelGGL(kern, dim3(grid), dim3(NTHR), lds, stream, __VA_ARGS__)
#define DYN_SMEM(name) extern __shared__ __attribute__((aligned(16))) unsigned char name[]
#endif

#ifdef __HIP_EMU__
__device__ __forceinline__ int tidx() { return (int)threadIdx.x; }
#define LAUNDER_PTR(x)
#else
__device__ __forceinline__ int tidx() { int t = (int)threadIdx.x; asm volatile("" : "+v"(t)); return t; }
#define LAUNDER_PTR(x) asm volatile("" : "+s"(x))
#endif
__device__ __forceinline__ float bf2f(bf16_t v) { return __builtin_bit_cast(float, (unsigned)v << 16); }
__device__ __forceinline__ bf16_t f2bf(float f) { unsigned u = __builtin_bit_cast(unsigned, f); return (bf16_t)((u + 0x7fffu + ((u >> 16) & 1u)) >> 16); }
#ifdef __HIP_EMU__
__device__ __forceinline__ unsigned pk2(float lo, float hi) { return (unsigned)f2bf(lo) | ((unsigned)f2bf(hi) << 16); }
#else
typedef float f32x2_t __attribute__((ext_vector_type(2))); typedef __bf16 bf16x2_t __attribute__((ext_vector_type(2)));
__device__ __forceinline__ unsigned pk2(float lo, float hi) { f32x2_t v = {lo, hi}; bf16x2_t b = __builtin_convertvector(v, bf16x2_t); return __builtin_bit_cast(unsigned, b); }
#endif
__device__ __forceinline__ bf16x8 pack_tiles(const f32x4& lo, const f32x4& hi) {
    u32x4 w; w.x = pk2(lo[0], lo[1]); w.y = pk2(lo[2], lo[3]); w.z = pk2(hi[0], hi[1]); w.w = pk2(hi[2], hi[3]); return __builtin_bit_cast(bf16x8, w);
}
__device__ __forceinline__ float silu_f(float x) { return x / (1.0f + expf(-x)); }
#ifdef __HIP_EMU__
__device__ __forceinline__ float silu_fast(float x) { return x / (1.0f + expf(-x)); }
#else
__device__ __forceinline__ float silu_fast(float x) { return x * __builtin_amdgcn_rcpf(1.0f + __builtin_amdgcn_exp2f(-LOG2E * x)); }
#endif
__device__ __forceinline__ float wave_sum(float v) {
#pragma unroll
    for (int o = 1; o < 64; o <<= 1) v += __shfl_xor(v, o);
    return v;
}
__device__ __forceinline__ float wave_max(float v) {
#pragma unroll
    for (int o = 1; o < 64; o <<= 1) v = fmaxf(v, __shfl_xor(v, o));
    return v;
}

struct P {
    const float *x_prompt, *x_sample, *cache_k, *cache_v, *state_ret, *state_gdn, *state_conv, *c_prompt, *c_sample, *ada_w, *ada_b, *norm_mix, *norm_ffn,
        *w_in, *ret_norm, *conv_w, *a_log, *dt_bias, *gdn_norm, *w_out, *w_gate, *w_up, *w_down, *final_norm;
    float* out; unsigned char* ws;
};

constexpr size_t O_YP = 0, O_YS = O_YP + (size_t)MP * D, O_PWK = O_YS + (size_t)MS * D, O_PWV = O_PWK + (size_t)NL * PB * PWIN * 256,
                 O_PRET = O_PWV + (size_t)NL * PB * PWIN * 256, O_PGDN = O_PRET + (size_t)NL * PB * 4 * 4096, O_PCONV = O_PGDN + (size_t)NL * PB * 4 * 16384,
                 O_SWK = O_PCONV + (size_t)NL * PB * 3 * 1536, O_SWV = O_SWK + (size_t)NL * DB * DS * 256, O_SRET = O_SWV + (size_t)NL * DB * DS * 256,
                 O_SGDN = O_SRET + (size_t)NL * DB * 4 * 4096, O_SCONV = O_SGDN + (size_t)NL * DB * 4 * 16384, O_END = O_SCONV + (size_t)NL * DB * 3 * 1536;

constexpr size_t al256(size_t x) { return (x + 255) / 256 * 256; }
constexpr size_t WS_CTL = 0, WS_CTL_BYTES = 1u << 20;
constexpr size_t WS_MOD = WS_CTL + WS_CTL_BYTES;
constexpr size_t WS_W8 = al256(WS_MOD + (size_t)NL * NC * 6144 * 4);
constexpr size_t WS_ROPE = al256(WS_W8 + (size_t)NL * D * 8 * 4);
constexpr size_t WS_WIN = al256(WS_ROPE + (size_t)4 * NPOS * 32 * 4);
constexpr size_t WS_WOUT = al256(WS_WIN + (size_t)NL * NPROJ * D * 2);
constexpr size_t WS_WGU = al256(WS_WOUT + (size_t)NL * D * D * 2);
constexpr size_t WS_WDN = al256(WS_WGU + (size_t)NL * 2 * FF * D * 2);
constexpr size_t WS_H = al256(WS_WDN + (size_t)NL * D * FF * 2);
constexpr size_t WS_PROJ = al256(WS_H + (size_t)MPAD * D * 2);
constexpr size_t WS_BETA = al256(WS_PROJ + (size_t)MPAD * NPROJ * 2);
constexpr size_t WS_G = al256(WS_BETA + (size_t)M * 4 * 4);
constexpr size_t WS_O = al256(WS_G + (size_t)M * 4 * 4);
constexpr size_t WS_RU = al256(WS_O + (size_t)MPAD * D * 2);
constexpr size_t WS_RS = al256(WS_RU + (size_t)NUNIT * 4096 * 4);
constexpr size_t WS_SCR = al256(WS_RS + (size_t)NUNIT * 4096 * 4);
constexpr size_t WS_GU = WS_SCR;
constexpr size_t WS_GWK = al256(WS_GU + (size_t)NUNIT * 8192 * 2);
constexpr size_t WS_GQ = al256(WS_GWK + (size_t)NUNIT * 16384 * 2);
constexpr size_t WS_GA = al256(WS_GQ + (size_t)NUNIT * 8192 * 2);
constexpr size_t WS_GD = al256(WS_GA + (size_t)NUNIT * 4096 * 2);
constexpr size_t WS_GV = al256(WS_GD + (size_t)NUNIT * 4);
constexpr size_t WS_GS = al256(WS_GV + (size_t)NUNIT * 8192 * 2);
constexpr size_t WS_GEND = al256(WS_GS + (size_t)NUNIT * 16384 * 2);
constexpr size_t ATT_CLS = (size_t)PB * 4 * (T / 32) * 2048;
constexpr size_t WS_KF = WS_GEND;
constexpr size_t WS_VF = al256(WS_KF + 3 * ATT_CLS * 2);
constexpr size_t WS_KRT = al256(WS_VF + 3 * ATT_CLS * 2);
constexpr size_t WS_VRT = al256(WS_KRT + (size_t)MP * 256 * 2);
constexpr size_t WS_AML = al256(WS_VRT + (size_t)MP * 256 * 2);
constexpr size_t WS_AEND = al256(WS_AML + (size_t)MP * 4 * 3 * 2 * 4);
constexpr size_t WS_APO = WS_H;
static_assert((size_t)MP * 4 * 3 * 64 * 2 <= (size_t)MPAD * D * 2, "attention partials overlay H");
constexpr size_t WS_HID = WS_SCR;
constexpr size_t WS_HEND = al256(WS_HID + (size_t)MPAD * FF * 2);
constexpr size_t WS_END = WS_AEND > WS_HEND ? WS_AEND : WS_HEND;

#define WSP(T_, off) ((T_*)(p.ws + (off)))
__device__ __forceinline__ int row_cb(int r) { return r < MP ? r / T : PB + (r - MP) / DS; }
__device__ __forceinline__ int row_pi(int r) { return r < MP ? r % T : T + (r - MP) % DS; }
namespace pg8 {
#ifdef __HIP_EMU__
#define PG8_LAS
#else
#define PG8_LAS __attribute__((address_space(3)))
#endif
typedef unsigned short bf16_t;
typedef short bf16x8 __attribute__((ext_vector_type(8)));
typedef float f32x4 __attribute__((ext_vector_type(4)));
typedef unsigned u32x4 __attribute__((ext_vector_type(4)));
constexpr int BM = 256, BK = 64, HALF = 128, HTB = HALF * BK * 2  , STAGE_BYTES = 8 * HTB, NXCD = 8, WGM = 8;

__host__ __device__ __forceinline__ int lds_byte(int r, int c) { const int st = (r >> 4) * 2 + (c >> 5), rr = r & 15, cc = c & 31, ob = rr * 64 + cc * 2; return st * 1024 + (ob ^ (((ob >> 9) & 1) << 5)); }
__host__ __device__ __forceinline__ void stage_rc(int b, int& R, int& C) { const int st = b / 1024, sb = b % 1024, swz = sb ^ (((sb >> 9) & 1) << 5); R = (st >> 1) * 16 + swz / 64; C = (st & 1) * 32 + (swz % 64) / 2; }
__host__ __device__ __forceinline__ int perm32(int rho) { const int n = rho >> 4, i = rho & 15; return 8 * (i >> 2) + 4 * n + (i & 3); }

struct Unit { int pm, pn; };
struct Gemm { const bf16_t* A; const bf16_t* Bt; int M, N, K; };

struct StaticOrder {
    int nM, nN, nwg, G, c;
    __host__ __device__ void init(int M, int N, int G_, int c_) { nM = M / BM; nN = N / BM; nwg = nM * nN; G = G_; c = c_; }
    __host__ __device__ bool next(int i, Unit& u) const {
        const long L = (long)i * G + c; if (L >= nwg) return false;
        int wgid = (int)L; { const int q = nwg / NXCD, r = nwg % NXCD, xcd = wgid % NXCD, off = wgid / NXCD; wgid = (xcd < r ? xcd * (q + 1) : r * (q + 1) + (xcd - r) * q) + off; }
        const int nig = WGM * nN, gid = wgid / nig, fm = gid * WGM, gsz = (nM - fm) < WGM ? (nM - fm) : WGM;
        u.pm = fm + ((wgid % nig) % gsz); u.pn = (wgid % nig) / gsz; return true;
    }
    __device__ __forceinline__ void a_ready(const Unit&) const {}
    __device__ __forceinline__ void done(const Unit&) const {}
};


struct EpiStoreBf16 {
    static constexpr bool PERM = true, AFTER_DRAIN = false;
    bf16_t* O; int ldc;
    __device__ __forceinline__ void operator()(const f32x4 (&acc)[2][2][4][2], const Unit& u, int wr, int wc, int fr, int fq) const {
        const int row0 = u.pm * BM + wr * 64 + fr, col0 = u.pn * BM + wc * 32 + 8 * fq;
#pragma unroll
        for (int ai = 0; ai < 2; ++ai)
#pragma unroll
            for (int m = 0; m < 4; ++m) { bf16_t* rowp = O + (size_t)(row0 + ai * HALF + m * 16) * ldc + col0;
#pragma unroll
                for (int bj = 0; bj < 2; ++bj) { const f32x4 v0 = acc[ai][bj][m][0], v1 = acc[ai][bj][m][1];
                    u32x4 w; w.x = ::pk2(v0[0], v0[1]); w.y = ::pk2(v0[2], v0[3]); w.z = ::pk2(v1[0], v1[1]); w.w = ::pk2(v1[2], v1[3]);
                    *(u32x4*)(rowp + bj * HALF) = w; } }
    }
};
struct EpiResidual {
    static constexpr bool PERM = false, AFTER_DRAIN = false;
    float* X; const float* gate; const float* Xin;
    __device__ __forceinline__ void operator()(const f32x4 (&acc)[2][2][4][2], const Unit& u, int wr, int wc, int fr, int fq) const {
        const int row0 = u.pm * BM + wr * 64 + fr, col0 = u.pn * BM + wc * 32 + 4 * fq;
#pragma unroll
        for (int ai = 0; ai < 2; ++ai)
#pragma unroll
            for (int m = 0; m < 4; ++m) { const int row = row0 + ai * HALF + m * 16;
                if (MPAD != M && row >= M) continue;
                const float* g = gate + (size_t)::row_cb(row) * 6144 + col0; float* xp = X + (size_t)row * D + col0; const float* xi = Xin + (size_t)row * D + col0;
#pragma unroll
                for (int bj = 0; bj < 2; ++bj)
#pragma unroll
                    for (int n = 0; n < 2; ++n) { const f32x4 gv = *(const f32x4*)(g + bj * HALF + n * 16); f32x4* xq = (f32x4*)(xp + bj * HALF + n * 16); *xq = *(const f32x4*)(xi + bj * HALF + n * 16) + gv * acc[ai][bj][m][n]; } }
    }
};
struct EpiSwiglu {
    static constexpr bool PERM = true, AFTER_DRAIN = false;
    bf16_t* Hd;
    __device__ __forceinline__ void operator()(const f32x4 (&acc)[2][2][4][2], const Unit& u, int wr, int wc, int fr, int fq) const {
        const int row0 = u.pm * BM + wr * 64 + fr, col0 = u.pn * HALF + wc * 32 + 8 * fq;
#pragma unroll
        for (int ai = 0; ai < 2; ++ai)
#pragma unroll
            for (int m = 0; m < 4; ++m) { bf16_t* rowp = Hd + (size_t)(row0 + ai * HALF + m * 16) * FF + col0;
                float v[8];
#pragma unroll
                for (int n = 0; n < 2; ++n)
#pragma unroll
                    for (int j = 0; j < 4; ++j) { const float gt = acc[ai][0][m][n][j], up = acc[ai][1][m][n][j]; v[4 * n + j] = ::silu_fast(gt) * up; }
                u32x4 w; w.x = ::pk2(v[0], v[1]); w.y = ::pk2(v[2], v[3]); w.z = ::pk2(v[4], v[5]); w.w = ::pk2(v[6], v[7]);
                *(u32x4*)rowp = w; }
    }
};

#ifdef __HIP_EMU__
template <class Epi, class Sched, bool ALIGN_EPI = false, bool SP2 = false>
__device__ __forceinline__ void gemm_phase(unsigned char* lds, const Gemm g, const Sched& S, const Epi& E) {
    const int tid = threadIdx.x, wid = tid >> 6, lane = tid & 63, wr = wid >> 2, wc = wid & 3, fr = lane & 15, fq = lane >> 4;
    Unit cur;
    for (int ui = 0; S.next(ui, cur); ++ui) {
        f32x4 acc[2][2][4][2];
        for (int ai = 0; ai < 2; ++ai) for (int bj = 0; bj < 2; ++bj) for (int m = 0; m < 4; ++m) for (int n = 0; n < 2; ++n) for (int j = 0; j < 4; ++j) {
            const int row = 256 * cur.pm + 128 * ai + 64 * wr + 16 * m + fr;
            const int col = Epi::PERM ? 256 * cur.pn + 128 * bj + 32 * wc + 8 * fq + 4 * n + j : 256 * cur.pn + 128 * bj + 32 * wc + 16 * n + 4 * fq + j;
            const bf16_t* a = g.A + (size_t)row * g.K; const bf16_t* b = g.Bt + (size_t)col * g.K; float s = 0.f;
            for (int k = 0; k < g.K; ++k) s += ::bf2f(a[k]) * ::bf2f(b[k]);
            acc[ai][bj][m][n][j] = s; }
        E(acc, cur, wr, wc, fr, fq);
    }
}
#else
template <class Epi, class Sched, bool ALIGN_EPI = false, bool SP2 = false>
__device__ __forceinline__ void gemm_phase(PG8_LAS unsigned char* lds, const Gemm g, const Sched& S, const Epi& E) {
    const int tid = ::tidx(), wid = __builtin_amdgcn_readfirstlane(tid >> 6), lane = tid & 63, wr = wid >> 2, wc = wid & 3, fr = lane & 15, fq = lane >> 4;
    const int K = g.K, nt = K / BK;
    unsigned voffA[2], voffB[2];
#pragma unroll
    for (int i = 0; i < 2; ++i) { int R, C; stage_rc(tid * 16 + i * 8192, R, C); const int Rb = Epi::PERM ? ((R & ~31) + perm32(R & 31)) : R;
        voffA[i] = (unsigned)(R * K + C) * 2u; voffB[i] = (unsigned)(Rb * K + C) * 2u; }
    const size_t kstep = (size_t)(BK * 2);
    const size_t hstep = (size_t)HALF * K * 2;
    const size_t tstep = 2 * hstep;
    const unsigned ldsw = (unsigned)wid * 1024u;
    const int aoff = lds_byte(wr * 64 + fr, fq * 8), boff = lds_byte(wc * 32 + fr, fq * 8);
#define PG8_SA(b, h) (((b) * 2 + (h)) * HTB)
#define PG8_SB(b, h) ((4 + (b) * 2 + (h)) * HTB)
#define PG8_STAGE(bufoff, gbase, voff) do { _Pragma("unroll") for (int _i = 0; _i < 2; ++_i) \
        __builtin_amdgcn_global_load_lds((const unsigned*)((const char*)(gbase) + (voff)[_i]), (PG8_LAS unsigned*)(lds + (bufoff) + ldsw + _i * 8192), 16, 0, 0); } while (0)
#define PG8_LDA(dst, b, h) do { _Pragma("unroll") for (int m = 0; m < 4; ++m) _Pragma("unroll") for (int k = 0; k < 2; ++k) dst[m][k] = *(const PG8_LAS bf16x8*)(lds + PG8_SA(b, h) + aoff + m * 2048 + k * 1024); } while (0)
#define PG8_LDB(dst, b, h) do { _Pragma("unroll") for (int n = 0; n < 2; ++n) _Pragma("unroll") for (int k = 0; k < 2; ++k) dst[n][k] = *(const PG8_LAS bf16x8*)(lds + PG8_SB(b, h) + boff + n * 2048 + k * 1024); } while (0)
#define PG8_MMA(ai, bj, At, Bt) do { __builtin_amdgcn_s_setprio(1); _Pragma("unroll") for (int m = 0; m < 4; ++m) _Pragma("unroll") for (int n = 0; n < 2; ++n) _Pragma("unroll") for (int k = 0; k < 2; ++k) \
        acc[ai][bj][m][n] = __builtin_amdgcn_mfma_f32_16x16x32_bf16(Bt[n][k], At[m][k], acc[ai][bj][m][n], 0, 0, 0); __builtin_amdgcn_s_setprio(0); } while (0)
#define PG8_WAIT_V(n) asm volatile("s_waitcnt vmcnt(" #n ")" ::: "memory")
#define PG8_WAIT_L(n) asm volatile("s_waitcnt lgkmcnt(" #n ")" ::: "memory")
#define PG8_BAR __builtin_amdgcn_s_barrier()
#define PG8_SCHED __builtin_amdgcn_sched_barrier(0)
    Unit cur, nxt; int ui = 0;
    if (!S.next(0, cur)) return;
    f32x4 acc[2][2][4][2];
#pragma unroll
    for (int a = 0; a < 2; ++a)
#pragma unroll
        for (int b = 0; b < 2; ++b)
#pragma unroll
            for (int m = 0; m < 4; ++m)
#pragma unroll
                for (int n = 0; n < 2; ++n) acc[a][b][m][n] = (f32x4){0.f, 0.f, 0.f, 0.f};
    bf16x8 At[4][2], B0[2][2], B1[2][2];
    const char* cA = (const char*)g.A + (size_t)cur.pm * tstep; const char* cB = (const char*)g.Bt + (size_t)cur.pn * tstep;
    S.a_ready(cur);
    if constexpr (SP2) {
        PG8_STAGE(PG8_SB(0, 0), cB, voffB); PG8_STAGE(PG8_SB(0, 1), cB + hstep, voffB); PG8_STAGE(PG8_SA(0, 0), cA, voffA); PG8_STAGE(PG8_SA(0, 1), cA + hstep, voffA);
        if (wr == 1) PG8_BAR;
        PG8_WAIT_V(2); PG8_BAR;
        PG8_STAGE(PG8_SB(1, 0), cB + kstep, voffB); PG8_STAGE(PG8_SA(1, 0), cA + kstep, voffA); PG8_STAGE(PG8_SB(1, 1), cB + hstep + kstep, voffB);
        PG8_WAIT_V(6); PG8_BAR;
    } else {
        PG8_STAGE(PG8_SB(0, 0), cB, voffB); PG8_STAGE(PG8_SA(0, 0), cA, voffA); PG8_STAGE(PG8_SB(0, 1), cB + hstep, voffB); PG8_STAGE(PG8_SA(0, 1), cA + hstep, voffA);
        if (wr == 1) PG8_BAR;
        PG8_WAIT_V(4); PG8_BAR;
        PG8_STAGE(PG8_SB(1, 0), cB + kstep, voffB); PG8_STAGE(PG8_SA(1, 0), cA + kstep, voffA); PG8_STAGE(PG8_SB(1, 1), cB + hstep + kstep, voffB);
        PG8_WAIT_V(6); PG8_BAR;
    }
    for (;;) {
        const bool has_next = S.next(ui + 1, nxt);
        const char* nA = has_next ? (const char*)g.A + (size_t)nxt.pm * tstep : cA; const char* nB = has_next ? (const char*)g.Bt + (size_t)nxt.pn * tstep : cB;
        for (int t = 0; t < nt; t += 2) {
            const bool last = (t == nt - 2);
            const char* a1 = cA + (size_t)(t + 1) * kstep;
            const char* a2 = last ? nA : cA + (size_t)(t + 2) * kstep; const char* b2 = last ? nB : cB + (size_t)(t + 2) * kstep;
            const char* a3 = a2 + kstep; const char* b3 = b2 + kstep;
            if (last && has_next) S.a_ready(nxt);
            if constexpr (SP2) {
            PG8_LDB(B0, 0, 0); PG8_LDB(B1, 0, 1); PG8_SCHED; PG8_LDA(At, 0, 0); PG8_STAGE(PG8_SA(1, 1), a1 + hstep, voffA);
            PG8_WAIT_V(8); PG8_WAIT_L(0); PG8_BAR; PG8_MMA(0, 0, At, B0); PG8_MMA(0, 1, At, B1); PG8_BAR; PG8_SCHED;
            PG8_LDA(At, 0, 1); PG8_STAGE(PG8_SB(0, 0), b2, voffB); PG8_STAGE(PG8_SB(0, 1), b2 + hstep, voffB); PG8_STAGE(PG8_SA(0, 0), a2, voffA);
            PG8_WAIT_V(8); PG8_WAIT_L(0); PG8_BAR; PG8_MMA(1, 0, At, B0); PG8_MMA(1, 1, At, B1); PG8_BAR; PG8_SCHED;
            PG8_LDB(B0, 1, 0); PG8_LDB(B1, 1, 1); PG8_SCHED; PG8_LDA(At, 1, 0); PG8_STAGE(PG8_SA(0, 1), a2 + hstep, voffA);
            PG8_WAIT_V(8); PG8_WAIT_L(0); PG8_BAR; PG8_MMA(0, 0, At, B0); PG8_MMA(0, 1, At, B1); PG8_BAR; PG8_SCHED;
            PG8_LDA(At, 1, 1); PG8_STAGE(PG8_SB(1, 0), b3, voffB); PG8_STAGE(PG8_SB(1, 1), b3 + hstep, voffB); PG8_STAGE(PG8_SA(1, 0), a3, voffA);
            PG8_WAIT_V(8); PG8_WAIT_L(0); PG8_BAR; PG8_MMA(1, 0, At, B0); PG8_MMA(1, 1, At, B1); PG8_BAR; PG8_SCHED;
            } else {
            PG8_LDB(B0, 0, 0); PG8_SCHED; PG8_LDA(At, 0, 0); PG8_STAGE(PG8_SA(1, 1), a1 + hstep, voffA);
            PG8_WAIT_L(8); PG8_BAR; PG8_WAIT_L(0); PG8_MMA(0, 0, At, B0); PG8_BAR; PG8_SCHED;
            PG8_LDB(B1, 0, 1); PG8_STAGE(PG8_SB(0, 0), b2, voffB);
            PG8_BAR; PG8_WAIT_L(0); PG8_MMA(0, 1, At, B1); PG8_BAR;
            PG8_LDA(At, 0, 1); PG8_STAGE(PG8_SA(0, 0), a2, voffA);
            PG8_BAR; PG8_WAIT_L(0); PG8_MMA(1, 0, At, B0); PG8_BAR; PG8_SCHED;
            PG8_STAGE(PG8_SB(0, 1), b2 + hstep, voffB);
            PG8_WAIT_V(6); PG8_BAR; PG8_MMA(1, 1, At, B1); PG8_BAR;
            PG8_LDB(B0, 1, 0); PG8_SCHED; PG8_LDA(At, 1, 0); PG8_STAGE(PG8_SA(0, 1), a2 + hstep, voffA);
            PG8_WAIT_L(8); PG8_BAR; PG8_WAIT_L(0); PG8_MMA(0, 0, At, B0); PG8_BAR; PG8_SCHED;
            PG8_LDB(B1, 1, 1); PG8_STAGE(PG8_SB(1, 0), b3, voffB);
            PG8_BAR; PG8_WAIT_L(0); PG8_MMA(0, 1, At, B1); PG8_BAR;
            PG8_LDA(At, 1, 1); PG8_STAGE(PG8_SA(1, 0), a3, voffA);
            PG8_BAR; PG8_WAIT_L(0); PG8_MMA(1, 0, At, B0); PG8_BAR; PG8_SCHED;
            PG8_STAGE(PG8_SB(1, 1), b3 + hstep, voffB);
            PG8_WAIT_V(6); PG8_BAR; PG8_MMA(1, 1, At, B1); PG8_BAR;
            }
        }
        if constexpr (ALIGN_EPI) { if (wr == 0) PG8_BAR; }
        if constexpr (!Epi::AFTER_DRAIN) { E(acc, cur, wr, wc, fr, fq); S.done(cur); }
        if (!has_next) break;
#pragma unroll
        for (int a = 0; a < 2; ++a)
#pragma unroll
            for (int b = 0; b < 2; ++b)
#pragma unroll
                for (int m = 0; m < 4; ++m)
#pragma unroll
                    for (int n = 0; n < 2; ++n) acc[a][b][m][n] = (f32x4){0.f, 0.f, 0.f, 0.f};
        cur = nxt; cA = nA; cB = nB; ++ui;
        if constexpr (ALIGN_EPI) { if (wr == 1) PG8_BAR; }
    }
    PG8_WAIT_V(0);
    if constexpr (!ALIGN_EPI) { if (wr == 0) PG8_BAR; }
    PG8_BAR;
    if constexpr (Epi::AFTER_DRAIN) { E.fused(acc, cur, wr, wc, fr, fq, lds, wid, lane); S.done(cur); }
#undef PG8_SA
#undef PG8_SB
#undef PG8_STAGE
#undef PG8_LDA
#undef PG8_LDB
#undef PG8_MMA
#undef PG8_WAIT_V
#undef PG8_WAIT_L
#undef PG8_BAR
#undef PG8_SCHED
}
#endif
}


__device__ __forceinline__ void transpose_item(const float* W, int ldw, bf16_t* WT, int K, int k0, int n0, int drow0, float* scr, int lane) {
    float wv[32];
#pragma unroll
    for (int i = 0; i < 32; ++i) wv[i] = W[(size_t)(k0 + 2 * i + (lane >> 5)) * ldw + n0 + (lane & 31)];
#pragma unroll
    for (int i = 0; i < 32; ++i) scr[(2 * i + (lane >> 5)) * 33 + (lane & 31)] = wv[i];
    WAVE_SYNC();
    const int c = lane & 7;
#pragma unroll
    for (int j = 0; j < 4; ++j) { const int n = (lane >> 3) + 8 * j; const float* s = scr + (8 * c) * 33 + n;
        u32x4 o; o.x = pk2(s[0 * 33], s[1 * 33]); o.y = pk2(s[2 * 33], s[3 * 33]); o.z = pk2(s[4 * 33], s[5 * 33]); o.w = pk2(s[6 * 33], s[7 * 33]);
        *(u32x4*)(WT + (size_t)(drow0 + n) * K + k0 + 8 * c) = o; }
    WAVE_SYNC();
}
constexpr int CV_IN = 16 * 120, CV_OUT = 16 * 32, CV_G = 16 * 88, CV_DN = 44 * 32, CV_L = CV_IN + CV_OUT + 2 * CV_G + CV_DN;
__device__ __forceinline__ void ph_convert(const P& p, unsigned char* smem, int i0, int i1, int b0, int b1) {
    if ((int)blockIdx.x < b0 || (int)blockIdx.x >= b1) return;
    const int lane = tidx() & 63, wave = tidx() >> 6;
    float* scr = (float*)smem + wave * (64 * 33 + 32);
    constexpr int I_IN = CV_IN, I_OUT = CV_OUT, I_G = CV_G, I_L = CV_L;
    const int gw = ((int)blockIdx.x - b0) * 8 + wave, ngw = (b1 - b0) * 8;
    for (int it = i0 + gw; it < i1; it += ngw) {
        const int l = it / I_L; int r = it % I_L;
        if (r < I_IN) { const int kb = r / 120, nb = r % 120; transpose_item(p.w_in + (size_t)l * D * INC, INC, WSP(bf16_t, WS_WIN) + (size_t)l * NPROJ * D, D, kb * 64, nb * 32, nb * 32, scr, lane); continue; }
        r -= I_IN;
        if (r < I_OUT) { const int kb = r / 32, nb = r % 32; transpose_item(p.w_out + (size_t)l * D * D, D, WSP(bf16_t, WS_WOUT) + (size_t)l * D * D, D, kb * 64, nb * 32, nb * 32, scr, lane); continue; }
        r -= I_OUT;
        if (r < 2 * I_G) { const int up = r / I_G; r %= I_G; const int kb = r / 88, nb = r % 88, n0 = nb * 32;
            transpose_item((up ? p.w_up : p.w_gate) + (size_t)l * D * FF, FF, WSP(bf16_t, WS_WGU) + (size_t)l * 2 * FF * D, D, kb * 64, n0, (n0 / 128) * 256 + up * 128 + (n0 % 128), scr, lane); continue; }
        r -= 2 * I_G;
        { const int kb = r / 32, nb = r % 32; transpose_item(p.w_down + (size_t)l * FF * D, D, WSP(bf16_t, WS_WDN) + (size_t)l * D * FF, FF, kb * 64, nb * 32, nb * 32, scr, lane); }
    }
}

__device__ __forceinline__ void ph_adaln(const P& p, unsigned char* smem, int l0, int l1, int b0, int b1) {
    if ((int)blockIdx.x < b0 || (int)blockIdx.x >= b1) return;
    float* sc = (float*)smem;
    float* red = sc + NC * 256;
    const int tid = tidx(), col = tid & 31, kg = tid >> 5;
    float* MOD = WSP(float, WS_MOD);
    for (int it = l0 * 192 + (int)blockIdx.x - b0; it < l1 * 192; it += b1 - b0) {
        const int l = it / 192, cb0 = (it % 192) * 32;
        float acc[NC];
#pragma unroll
        for (int r = 0; r < NC; ++r) acc[r] = 0.f;
        for (int kc = 0; kc < 4; ++kc) {
            __syncthreads();
            for (int e = tid; e < NC * 256; e += NTHR) { const int r = e >> 8, k = e & 255; const float c = r < PB ? p.c_prompt[r * D + kc * 256 + k] : p.c_sample[(r - PB) * D + kc * 256 + k]; sc[e] = silu_f(c); }
            __syncthreads();
            for (int kk = 0; kk < 16; ++kk) { const int k = kg * 16 + kk; const float w = p.ada_w[((size_t)l * D + kc * 256 + k) * 6144 + cb0 + col];
#pragma unroll
                for (int r = 0; r < NC; ++r) acc[r] += sc[r * 256 + k] * w; }
        }
#pragma unroll
        for (int r = 0; r < NC; ++r) red[(kg * NC + r) * 32 + col] = acc[r];
        __syncthreads();
        for (int e = tid; e < NC * 32; e += NTHR) { const int r = e >> 5, c = e & 31; float s = p.ada_b[l * 6144 + cb0 + c];
            for (int g = 0; g < 16; ++g) s += red[(g * NC + r) * 32 + c];
            MOD[((size_t)l * NC + r) * 6144 + cb0 + c] = s; }
        __syncthreads();
    }
}

__device__ __forceinline__ void ph_ropetab_copyx(const P& p) {
    const size_t gt = (size_t)blockIdx.x * NTHR + tidx(), ng = (size_t)gridDim.x * NTHR;
    float* tab = WSP(float, WS_ROPE);
    for (size_t e = gt; e < (size_t)NL * D * 8; e += ng) { const size_t lk = e >> 3; const int c = (int)(e & 7); WSP(float, WS_W8)[((lk >> 10) * 8 + c) * D + (lk & 1023)] = p.w_in[lk * INC + NPROJ + c]; }
    for (size_t e = gt; e < (size_t)NPOS * 32; e += ng) {
        const int pi = (int)(e >> 5), i = (int)(e & 31); const double pos = pi < T ? (double)pi : (double)(PAST + pi - T);
        const double ia = exp(-log(10000.0) * (double)i / 32.0), ir = exp(-log(10000.0) * (double)i / 31.0);
        tab[e] = (float)cos(pos * ia); tab[(size_t)NPOS * 32 + e] = (float)sin(pos * ia);
        tab[(size_t)2 * NPOS * 32 + e] = (float)cos(pos * ir); tab[(size_t)3 * NPOS * 32 + e] = (float)sin(pos * ir);
    }
}

template <int WHICH> __device__ __forceinline__ void ph_norm_mod(const P& p, int l, unsigned char* smem) {
    const int lane = tidx() & 63, wave = tidx() >> 6, gw = blockIdx.x * 8 + wave, ngw = gridDim.x * 8;
    const float* nw = (WHICH == 0 ? p.norm_mix : p.norm_ffn) + l * D;
    bf16_t* H = WSP(bf16_t, WS_H);
    const float* w8s = (const float*)smem;
    if (WHICH == 0) { __syncthreads();
        for (int e = tidx(); e < 8 * D / 4; e += NTHR) ((f32x4*)smem)[e] = ((const f32x4*)(WSP(float, WS_W8) + (size_t)l * 8 * D))[e];
        __syncthreads(); }
    f32x4 gw4[4];
#pragma unroll
    for (int j = 0; j < 4; ++j) gw4[j] = *(const f32x4*)(nw + 4 * lane + 256 * j);
    for (int r = gw; r < M; r += ngw) {
        const float* xr = (WHICH == 0 && l == 0) ? (r < MP ? p.x_prompt + (size_t)r * D : p.x_sample + (size_t)(r - MP) * D) : p.out + (size_t)r * D;
        const float* mod = WSP(float, WS_MOD) + ((size_t)l * NC + row_cb(r)) * 6144 + (WHICH == 0 ? 0 : 3072);
        f32x4 v[4]; float ss = 0.f;
#pragma unroll
        for (int j = 0; j < 4; ++j) { v[j] = *(const f32x4*)(xr + 4 * lane + 256 * j); ss += (v[j][0] * v[j][0] + v[j][1] * v[j][1]) + (v[j][2] * v[j][2] + v[j][3] * v[j][3]); }
        const float rstd = 1.0f / sqrtf(wave_sum(ss) * (1.0f / D) + EPS);
        float a8[8];
#pragma unroll
        for (int c = 0; c < 8; ++c) a8[c] = 0.f;
#pragma unroll
        for (int j = 0; j < 4; ++j) { const int k = 4 * lane + 256 * j;
            const f32x4 g = gw4[j], sh = *(const f32x4*)(mod + k), sc = *(const f32x4*)(mod + 1024 + k);
            f32x4 h;
#pragma unroll
            for (int e = 0; e < 4; ++e) h[e] = v[j][e] * rstd * g[e] * (1.0f + sc[e]) + sh[e];
            u32x2 w; w.x = pk2(h[0], h[1]); w.y = pk2(h[2], h[3]); *(u32x2*)(H + (size_t)r * D + k) = w;
            if (WHICH == 0) {
#pragma unroll
                for (int c = 0; c < 8; ++c) { const f32x4 wv = *(const f32x4*)(w8s + c * D + k); a8[c] += (h[0] * wv[0] + h[1] * wv[1]) + (h[2] * wv[2] + h[3] * wv[3]); }
            }
        }
        if (WHICH == 0) {
            float b4[4];
#pragma unroll
            for (int c = 0; c < 4; ++c) { const float keep = lane < 32 ? a8[c] : a8[4 + c], send = lane < 32 ? a8[4 + c] : a8[c]; b4[c] = keep + __shfl_xor(send, 32); }
            float b2[2];
#pragma unroll
            for (int c = 0; c < 2; ++c) { const bool lo = (lane & 16) == 0; const float keep = lo ? b4[c] : b4[2 + c], send = lo ? b4[2 + c] : b4[c]; b2[c] = keep + __shfl_xor(send, 16); }
            float b1; { const bool lo = (lane & 8) == 0; const float keep = lo ? b2[0] : b2[1], send = lo ? b2[1] : b2[0]; b1 = keep + __shfl_xor(send, 8); }
            b1 += __shfl_xor(b1, 4); b1 += __shfl_xor(b1, 2); b1 += __shfl_xor(b1, 1);
            if ((lane & 7) == 0) { const int c = (lane >> 5) * 4 + ((lane >> 4) & 1) * 2 + ((lane >> 3) & 1);
                if (c < 4) WSP(float, WS_BETA)[(size_t)r * 4 + c] = 1.0f / (1.0f + expf(-b1));
                else { const int hh = c - 4; const float xx = b1 + p.dt_bias[l * 4 + hh]; const float sp = xx > 20.f ? xx : log1pf(expf(xx)); WSP(float, WS_G)[(size_t)r * 4 + hh] = -expf(p.a_log[l * 4 + hh]) * sp; } }
        }
    }
}

__device__ __forceinline__ void unpack8(const u32x4 w, float (&f)[8]) {
    f[0] = __builtin_bit_cast(float, w.x << 16); f[1] = __builtin_bit_cast(float, w.x & 0xffff0000u); f[2] = __builtin_bit_cast(float, w.y << 16); f[3] = __builtin_bit_cast(float, w.y & 0xffff0000u);
    f[4] = __builtin_bit_cast(float, w.z << 16); f[5] = __builtin_bit_cast(float, w.z & 0xffff0000u); f[6] = __builtin_bit_cast(float, w.w << 16); f[7] = __builtin_bit_cast(float, w.w & 0xffff0000u);
}
__device__ __forceinline__ u32x4 pack8f(const float (&f)[8]) { u32x4 w; w.x = pk2(f[0], f[1]); w.y = pk2(f[2], f[3]); w.z = pk2(f[4], f[5]); w.w = pk2(f[6], f[7]); return w; }
__device__ __forceinline__ void ph_rope_out(const P& p, int l) {
    const size_t gt = (size_t)blockIdx.x * NTHR + tidx(), ng = (size_t)gridDim.x * NTHR;
    bf16_t* PR = WSP(bf16_t, WS_PROJ); const float* tab = WSP(float, WS_ROPE);
    for (size_t e = gt; e < (size_t)MS * 64; e += ng) {
        const int r = MP + (int)(e >> 6), rem = (int)(e & 63), sec = rem >> 4, hh = (rem >> 2) & 3, d = (rem & 3) * 8;
        const int off = sec == 0 ? C_QA : sec == 1 ? C_KA : sec == 2 ? C_QR : C_KR; const float scale = sec == 0 ? 0.125f * LOG2E : sec == 3 ? 0.125f : 1.0f;
        const float* ct = tab + (size_t)(sec >= 2 ? 2 : 0) * NPOS * 32 + (size_t)row_pi(r) * 32 + d; const float* st = ct + (size_t)NPOS * 32;
        const f32x4 c0 = *(const f32x4*)ct, c1 = *(const f32x4*)(ct + 4), s0 = *(const f32x4*)st, s1 = *(const f32x4*)(st + 4);
        bf16_t* x = PR + (size_t)r * NPROJ + off + hh * 64 + d; float x1[8], x2[8], o1[8], o2[8];
        unpack8(*(const u32x4*)x, x1); unpack8(*(const u32x4*)(x + 32), x2);
#pragma unroll
        for (int k = 0; k < 8; ++k) { const float c = k < 4 ? c0[k & 3] : c1[k & 3], sn = k < 4 ? s0[k & 3] : s1[k & 3]; o1[k] = (x1[k] * c - x2[k] * sn) * scale; o2[k] = (x1[k] * sn + x2[k] * c) * scale; }
        *(u32x4*)x = pack8f(o1); *(u32x4*)(x + 32) = pack8f(o2);
        if (sec == 1) { const int b = (r - MP) / DS, i = (r - MP) % DS; float* o = p.out + O_SWK + (((size_t)l * DB + b) * DS + i) * 256 + hh * 64 + d;
            *(f32x4*)o = (f32x4){o1[0], o1[1], o1[2], o1[3]}; *(f32x4*)(o + 4) = (f32x4){o1[4], o1[5], o1[6], o1[7]}; *(f32x4*)(o + 32) = (f32x4){o2[0], o2[1], o2[2], o2[3]}; *(f32x4*)(o + 36) = (f32x4){o2[4], o2[5], o2[6], o2[7]}; }
    }
    for (size_t e = gt; e < (size_t)MS * 32; e += ng) {
        const int r = MP + (int)(e >> 5), c = (int)(e & 31) * 8; const int b = (r - MP) / DS, i = (r - MP) % DS; float* o = p.out + O_SWV + (((size_t)l * DB + b) * DS + i) * 256 + c;
        float v[8]; unpack8(*(const u32x4*)(PR + (size_t)r * NPROJ + C_VA + c), v); *(f32x4*)o = (f32x4){v[0], v[1], v[2], v[3]}; *(f32x4*)(o + 4) = (f32x4){v[4], v[5], v[6], v[7]};
    }
    for (size_t e = gt; e < (size_t)(PB + DB) * 3 * 1536; e += ng) {
        const int c = (int)(e % 1536), j = (int)((e / 1536) % 3), bb = (int)(e / (3 * 1536));
        if (bb < PB) p.out[O_PCONV + (((size_t)l * PB + bb) * 3 + j) * 1536 + c] = bf2f(PR[(size_t)(bb * T + T - 3 + j) * NPROJ + C_CONV + c]);
        else { const int b = bb - PB; p.out[O_SCONV + (((size_t)l * DB + b) * 3 + j) * 1536 + c] = bf2f(PR[(size_t)(MP + b * DS + DS - 3 + j) * NPROJ + C_CONV + c]); }
    }
}

__device__ __forceinline__ void attn_wave_sample(const P& p, int l, int r, int h, int lane, float* sw  ) {
    const bf16_t* PR = WSP(bf16_t, WS_PROJ);
    const int b = (r - MP) / DS; const int tq = WB + (r - MP) % DS;
    const int kg = lane >> 4, dq = lane & 15;
    f32x4 q4; { const u32x2 w = *(const u32x2*)(PR + (size_t)r * NPROJ + C_QA + h * 64 + 4 * dq); q4 = (f32x4){bf2f((bf16_t)(w.x & 0xffff)), bf2f((bf16_t)(w.x >> 16)), bf2f((bf16_t)(w.y & 0xffff)), bf2f((bf16_t)(w.y >> 16))}; }
    float mx = -INFINITY;
#pragma unroll 8
    for (int e = kg; e < 388; e += 4) {
        const int ee = e < 387 ? e : 386; const int pat = ee / 129, j = ee % 129, dil = pat == 0 ? 1 : pat == 1 ? 4 : 16; const int rr = tq - dil * j;
        f32x4 kv;
        if (rr < WB) kv = *(const f32x4*)(p.cache_k + ((((size_t)l * DB + b) * WB + rr) * 4 + h) * 64 + 4 * dq);
        else { const u32x2 w = *(const u32x2*)(PR + (size_t)(MP + b * DS + (rr - WB)) * NPROJ + C_KA + h * 64 + 4 * dq);
            kv = (f32x4){bf2f((bf16_t)(w.x & 0xffff)), bf2f((bf16_t)(w.x >> 16)), bf2f((bf16_t)(w.y & 0xffff)), bf2f((bf16_t)(w.y >> 16))}; }
        float a = (q4[0] * kv[0] + q4[1] * kv[1]) + (q4[2] * kv[2] + q4[3] * kv[3]);
        a += __shfl_xor(a, 1); a += __shfl_xor(a, 2); a += __shfl_xor(a, 4); a += __shfl_xor(a, 8);
        if (e < 387) { if (dq == 0) sw[e] = a; mx = fmaxf(mx, a); }
    }
    WAVE_SYNC();
    mx = wave_max(mx);
    float lsum = 0.f;
#pragma unroll 1
    for (int i = 0; i < 7; ++i) { const int e = lane + 64 * i; if (e < 387) { const float pe = exp2f(sw[e] - mx); sw[e] = pe; lsum += pe; } }
    lsum = wave_sum(lsum);
    WAVE_SYNC();
    f32x4 o4 = (f32x4){0.f, 0.f, 0.f, 0.f};
#pragma unroll 16
    for (int e = kg; e < 387; e += 4) {
        const float pe = sw[e];
        const int pat = e / 129, j = e % 129, dil = pat == 0 ? 1 : pat == 1 ? 4 : 16; const int rr = tq - dil * j;
        f32x4 v;
        if (rr < WB) v = *(const f32x4*)(p.cache_v + ((((size_t)l * DB + b) * WB + rr) * 4 + h) * 64 + 4 * dq);
        else { const u32x2 w = *(const u32x2*)(PR + (size_t)(MP + b * DS + (rr - WB)) * NPROJ + C_VA + h * 64 + 4 * dq);
            v = (f32x4){bf2f((bf16_t)(w.x & 0xffff)), bf2f((bf16_t)(w.x >> 16)), bf2f((bf16_t)(w.y & 0xffff)), bf2f((bf16_t)(w.y >> 16))}; }
        o4 += pe * v;
    }
#pragma unroll
    for (int e = 0; e < 4; ++e) { float x = o4[e]; x += __shfl_xor(x, 16); x += __shfl_xor(x, 32); o4[e] = x; }
    WAVE_SYNC();
    if (kg == 0) { const float inv = 1.0f / lsum; u32x2 w; w.x = pk2(o4[0] * inv, o4[1] * inv); w.y = pk2(o4[2] * inv, o4[3] * inv);
        *(u32x2*)(WSP(bf16_t, WS_O) + (size_t)r * D + h * 64 + 4 * dq) = w; }
}
__device__ __forceinline__ void ph_attn_sample(const P& p, int l, unsigned char* smem) {
    const int lane = tidx() & 63, wave = tidx() >> 6, gw = (gridDim.x - 1 - blockIdx.x) * 8 + wave, ngw = gridDim.x * 8;
    float* sw = (float*)smem + wave * 392;
    for (int it = gw; it < MS * 4; it += ngw) attn_wave_sample(p, l, MP + (it >> 2), it & 3, lane, sw);
}
__device__ __forceinline__ bf16x8 pack8(const f32x16& v, int s8) {
    u32x4 w; w.x = pk2(v[s8], v[s8 + 1]); w.y = pk2(v[s8 + 2], v[s8 + 3]); w.z = pk2(v[s8 + 4], v[s8 + 5]); w.w = pk2(v[s8 + 6], v[s8 + 7]); return __builtin_bit_cast(bf16x8, w);
}
__device__ __forceinline__ void attn_job(const P& p, int jb, int lane) {
    const int c = lane & 31, hi = lane >> 5;
    constexpr int NB = T / 512;
    const int unit = jb / 48, jj = jb % 48, pat = jj >> 4, sub = jj & 15;
    const int blk = unit % NB, h = (unit / NB) & 3, b = unit / (NB * 4), bh = b * 4 + h;
    int dil, r, qi0, cls, tb;
    if (pat == 0) { dil = 1; r = 0; qi0 = blk * 512 + sub * 32; cls = 0; tb = 0; }
    else if (pat == 1) { dil = 4; r = sub >> 2; qi0 = blk * 128 + (sub & 3) * 32; cls = 1; tb = r * (T / 128); }
    else { dil = 16; r = sub; qi0 = blk * 32; cls = 2; tb = r * (T / 512); }
    const bf16_t* KF = WSP(bf16_t, WS_KF) + cls * ATT_CLS + ((size_t)bh * (T / 32) + tb) * 2048 + lane * 8;
    const bf16_t* VF = WSP(bf16_t, WS_VF) + cls * ATT_CLS + ((size_t)bh * (T / 32) + tb) * 2048 + lane * 8;
    const int tq = dil * (qi0 + c) + r;
    const bf16_t* qp = WSP(bf16_t, WS_PROJ) + (size_t)(b * T + tq) * NPROJ + C_QA + h * 64 + 8 * hi;
    bf16x8 qf[4];
#pragma unroll
    for (int ks = 0; ks < 4; ++ks) qf[ks] = *(const bf16x8*)(qp + 16 * ks);
    bf16x8 kf[5][4];
#pragma unroll
    for (int i = 0; i < 5; ++i) { const int kt0 = qi0 - 128 + 32 * i; const bf16_t* kp = KF + (size_t)(kt0 >= 0 ? (kt0 >> 5) : 0) * 2048;
#pragma unroll
        for (int ks = 0; ks < 4; ++ks) kf[i][ks] = *(const bf16x8*)(kp + 512 * ks); }
    f32x16 S[5];
#pragma unroll
    for (int i = 0; i < 5; ++i) {
        const int kt0 = qi0 - 128 + 32 * i;
        f32x16 acc;
#pragma unroll
        for (int e = 0; e < 16; ++e) acc[e] = 0.f;
#pragma unroll
        for (int ks = 0; ks < 4; ++ks) acc = MFMA32(kf[i][ks], qf[ks], acc);
#pragma unroll
        for (int e = 0; e < 16; ++e) { const int krow = (e & 3) + 8 * (e >> 2) + 4 * hi;
            const bool dead = kt0 < 0 || (i == 0 && krow < c) || (i == 4 && krow > c); if (dead) acc[e] = -INFINITY; }
        S[i] = acc;
    }
    float mx = -INFINITY;
#pragma unroll
    for (int i = 0; i < 5; ++i)
#pragma unroll
        for (int e = 0; e < 16; ++e) mx = fmaxf(mx, S[i][e]);
    mx = fmaxf(mx, __shfl_xor(mx, 32));
    float lsum = 0.f;
#pragma unroll
    for (int i = 0; i < 5; ++i)
#pragma unroll
        for (int e = 0; e < 16; ++e) { const float pe = exp2f(S[i][e] - mx); S[i][e] = pe; lsum += pe; }
    lsum += __shfl_xor(lsum, 32);
    bf16x8 pf[5][2];
#pragma unroll
    for (int i = 0; i < 5; ++i) { pf[i][0] = pack8(S[i], 0); pf[i][1] = pack8(S[i], 8); }
    f32x16 O[2];
#pragma unroll
    for (int dt = 0; dt < 2; ++dt)
#pragma unroll
        for (int e = 0; e < 16; ++e) O[dt][e] = 0.f;
#pragma unroll
    for (int i = 0; i < 5; ++i) {
        const int kt0 = qi0 - 128 + 32 * i; const bf16_t* vp = VF + (size_t)(kt0 >= 0 ? (kt0 >> 5) : 0) * 2048;
#pragma unroll
        for (int s2 = 0; s2 < 2; ++s2)
#pragma unroll
            for (int dt = 0; dt < 2; ++dt) O[dt] = MFMA32(*(const bf16x8*)(vp + (dt * 2 + s2) * 512), pf[i][s2], O[dt]);
    }
    const size_t idx = ((size_t)(b * T + tq) * 4 + h) * 3 + pat;
    bf16_t* po = WSP(bf16_t, WS_APO) + idx * 64;
#pragma unroll
    for (int dt = 0; dt < 2; ++dt)
#pragma unroll
        for (int g = 0; g < 4; ++g) { u32x2 w; w.x = pk2(O[dt][4 * g], O[dt][4 * g + 1]); w.y = pk2(O[dt][4 * g + 2], O[dt][4 * g + 3]); *(u32x2*)(po + 32 * dt + 8 * g + 4 * hi) = w; }
    if (hi == 0) { float* ml = WSP(float, WS_AML) + idx * 2; ml[0] = mx; ml[1] = lsum; }
}
__device__ __forceinline__ void ph_attn_jobs(const P& p, int nc, int b1, int r0) {
    const int bid = (int)blockIdx.x; if (bid >= b1) return;
    const int lane = tidx() & 63, wave = tidx() >> 6, nn = (b1 - nc) * 8, ncw = nc * 8; constexpr int NJ = PB * 4 * (T / 512) * 48;
    const bool late = bid < nc; const int wi = late ? bid * 8 + wave : (bid - nc) * 8 + wave;
    for (int r = late ? r0 : 0;; ++r) { const int base = r * nn + (r > r0 ? (r - r0) * ncw : 0); const int jb = base + (late ? nn + wi : wi);
        if (base >= NJ) break;
        if (jb < NJ) attn_job(p, jb, lane); }
}
__device__ __forceinline__ void ph_attn_combine(const P& p) {
    const size_t gt = (size_t)blockIdx.x * NTHR + tidx(), ng = (size_t)gridDim.x * NTHR;
    for (size_t e = gt; e < (size_t)MP * 4 * 16; e += ng) {
        const size_t rh = e >> 4; const int dq = (int)(e & 15) * 4;
        const float* ml = WSP(float, WS_AML) + rh * 6; const float m0 = ml[0], m1 = ml[2], m2 = ml[4];
        const float mm = fmaxf(m0, fmaxf(m1, m2)); const float w0 = exp2f(m0 - mm), w1 = exp2f(m1 - mm), w2 = exp2f(m2 - mm);
        const float inv = 1.0f / (w0 * ml[1] + w1 * ml[3] + w2 * ml[5]);
        const bf16_t* po = WSP(bf16_t, WS_APO) + rh * 192 + dq;
        const u32x2 a = *(const u32x2*)po, bq = *(const u32x2*)(po + 64), cq = *(const u32x2*)(po + 128);
        float o[4];
        o[0] = w0 * bf2f((bf16_t)(a.x & 0xffff)) + w1 * bf2f((bf16_t)(bq.x & 0xffff)) + w2 * bf2f((bf16_t)(cq.x & 0xffff));
        o[1] = w0 * bf2f((bf16_t)(a.x >> 16)) + w1 * bf2f((bf16_t)(bq.x >> 16)) + w2 * bf2f((bf16_t)(cq.x >> 16));
        o[2] = w0 * bf2f((bf16_t)(a.y & 0xffff)) + w1 * bf2f((bf16_t)(bq.y & 0xffff)) + w2 * bf2f((bf16_t)(cq.y & 0xffff));
        o[3] = w0 * bf2f((bf16_t)(a.y >> 16)) + w1 * bf2f((bf16_t)(bq.y >> 16)) + w2 * bf2f((bf16_t)(cq.y >> 16));
        const size_t row = rh >> 2; const int h = (int)(rh & 3);
        u32x2 w; w.x = pk2(o[0] * inv, o[1] * inv); w.y = pk2(o[2] * inv, o[3] * inv);
        *(u32x2*)(WSP(bf16_t, WS_O) + row * D + h * 64 + dq) = w;
    }
}
__device__ __forceinline__ float ret_lg(int h) { return logf(1.0f - exp2f(-5.0f - (float)h)); }
constexpr int TPK = 72, TPT = 65;
__device__ __forceinline__ void trans_write(const bf16_t* tile, bf16_t* dst  , int tile0, int tid) {
#pragma unroll
    for (int k = 0; k < 4; ++k) { const int ch = tid + NTHR * k, d = ch >> 5, t0 = (ch & 31) * 8; u32x4 w;
        w.x = (unsigned)tile[(t0 + 0) * TPT + d] | ((unsigned)tile[(t0 + 1) * TPT + d] << 16); w.y = (unsigned)tile[(t0 + 2) * TPT + d] | ((unsigned)tile[(t0 + 3) * TPT + d] << 16);
        w.z = (unsigned)tile[(t0 + 4) * TPT + d] | ((unsigned)tile[(t0 + 5) * TPT + d] << 16); w.w = (unsigned)tile[(t0 + 6) * TPT + d] | ((unsigned)tile[(t0 + 7) * TPT + d] << 16);
        *(u32x4*)(dst + (size_t)d * T + tile0 + t0) = w; COMPILER_FENCE(); }
}
__device__ __forceinline__ void store8_b16(bf16_t* dst, const u32x4 w) {
    dst[0] = (bf16_t)(w.x & 0xffff); dst[1] = (bf16_t)(w.x >> 16); dst[2] = (bf16_t)(w.y & 0xffff); dst[3] = (bf16_t)(w.y >> 16);
    dst[4] = (bf16_t)(w.z & 0xffff); dst[5] = (bf16_t)(w.z >> 16); dst[6] = (bf16_t)(w.w & 0xffff); dst[7] = (bf16_t)(w.w >> 16);
}
__device__ __forceinline__ void ph_vtrans(const P& p, int l, unsigned char* smem) {
    bf16_t* ka = (bf16_t*)smem; bf16_t* va = ka + 256 * TPK; bf16_t* vr = va + 256 * TPK; bf16_t* kr = vr + 256 * TPT;
    static_assert((2 * 256 * TPK + 2 * 256 * TPT) * 2 <= BAR_LDS_OFF, "transpose unit LDS");
    const int tid = tidx(); bf16_t* PR = WSP(bf16_t, WS_PROJ); const float* tab = WSP(float, WS_ROPE);
    for (int u = blockIdx.x; u < PB * 4 * (T / 256); u += gridDim.x) {
        const int tile = u % (T / 256), bh = u / (T / 256), h = bh & 3, b = bh >> 2; const float lg = ret_lg(h);
        __syncthreads();
#pragma unroll 1
        for (int k = 0; k < 2; ++k) { const int e = tid + NTHR * k, t = e >> 2, d = (e & 3) * 8, tt = tile * 256 + t; bf16_t* row = PR + (size_t)(b * T + tt) * NPROJ + h * 64 + d;
            float x1[8], x2[8], o1[8], o2[8];
            { const float* ct = tab + (size_t)tt * 32 + d; const float* st = ct + (size_t)NPOS * 32;
              const f32x4 c0 = *(const f32x4*)ct, c1 = *(const f32x4*)(ct + 4), s0 = *(const f32x4*)st, s1 = *(const f32x4*)(st + 4);
              unpack8(*(const u32x4*)(row + C_QA), x1); unpack8(*(const u32x4*)(row + C_QA + 32), x2);
#pragma unroll
              for (int i = 0; i < 8; ++i) { const float c = i < 4 ? c0[i & 3] : c1[i & 3], sn = i < 4 ? s0[i & 3] : s1[i & 3]; o1[i] = (x1[i] * c - x2[i] * sn) * (0.125f * LOG2E); o2[i] = (x1[i] * sn + x2[i] * c) * (0.125f * LOG2E); }
              *(u32x4*)(row + C_QA) = pack8f(o1); *(u32x4*)(row + C_QA + 32) = pack8f(o2);
              unpack8(*(const u32x4*)(row + C_KA), x1); unpack8(*(const u32x4*)(row + C_KA + 32), x2);
#pragma unroll
              for (int i = 0; i < 8; ++i) { const float c = i < 4 ? c0[i & 3] : c1[i & 3], sn = i < 4 ? s0[i & 3] : s1[i & 3]; o1[i] = x1[i] * c - x2[i] * sn; o2[i] = x1[i] * sn + x2[i] * c; }
              *(u32x4*)(ka + t * TPK + d) = pack8f(o1); *(u32x4*)(ka + t * TPK + d + 32) = pack8f(o2);
              if (tt >= T - PWIN) { float* o = p.out + O_PWK + (((size_t)l * PB + b) * PWIN + (tt - (T - PWIN))) * 256 + h * 64 + d;
                  *(f32x4*)o = (f32x4){o1[0], o1[1], o1[2], o1[3]}; *(f32x4*)(o + 4) = (f32x4){o1[4], o1[5], o1[6], o1[7]}; *(f32x4*)(o + 32) = (f32x4){o2[0], o2[1], o2[2], o2[3]}; *(f32x4*)(o + 36) = (f32x4){o2[4], o2[5], o2[6], o2[7]}; } }
            COMPILER_FENCE();
            { const float* ct = tab + (size_t)2 * NPOS * 32 + (size_t)tt * 32 + d; const float* st = ct + (size_t)NPOS * 32;
              const f32x4 c0 = *(const f32x4*)ct, c1 = *(const f32x4*)(ct + 4), s0 = *(const f32x4*)st, s1 = *(const f32x4*)(st + 4);
              const float gq = expf(lg * (float)(tt & 63)), gk = 0.125f / gq;
              unpack8(*(const u32x4*)(row + C_QR), x1); unpack8(*(const u32x4*)(row + C_QR + 32), x2);
#pragma unroll
              for (int i = 0; i < 8; ++i) { const float c = i < 4 ? c0[i & 3] : c1[i & 3], sn = i < 4 ? s0[i & 3] : s1[i & 3]; o1[i] = (x1[i] * c - x2[i] * sn) * gq; o2[i] = (x1[i] * sn + x2[i] * c) * gq; }
              *(u32x4*)(row + C_QR) = pack8f(o1); *(u32x4*)(row + C_QR + 32) = pack8f(o2);
              unpack8(*(const u32x4*)(row + C_KR), x1); unpack8(*(const u32x4*)(row + C_KR + 32), x2);
#pragma unroll
              for (int i = 0; i < 8; ++i) { const float c = i < 4 ? c0[i & 3] : c1[i & 3], sn = i < 4 ? s0[i & 3] : s1[i & 3]; o1[i] = (x1[i] * c - x2[i] * sn) * gk; o2[i] = (x1[i] * sn + x2[i] * c) * gk; }
              const u32x4 w1 = pack8f(o1), w2 = pack8f(o2);
              *(u32x4*)(row + C_KR) = w1; *(u32x4*)(row + C_KR + 32) = w2; store8_b16(kr + t * TPT + d, w1); store8_b16(kr + t * TPT + d + 32, w2); }
            COMPILER_FENCE(); }
#pragma unroll
        for (int k = 0; k < 4; ++k) { const int ch = tid + NTHR * k, t = ch >> 3, d8 = (ch & 7) * 8, tt = tile * 256 + t; const bf16_t* src = PR + (size_t)(b * T + tt) * NPROJ + h * 64 + d8;
            const u32x4 wv = *(const u32x4*)(src + C_VA); *(u32x4*)(va + t * TPK + d8) = wv; store8_b16(vr + t * TPT + d8, *(const u32x4*)(src + C_VR));
            if (tt >= T - PWIN) { float v[8]; unpack8(wv, v); float* o = p.out + O_PWV + (((size_t)l * PB + b) * PWIN + (tt - (T - PWIN))) * 256 + h * 64 + d8;
                *(f32x4*)o = (f32x4){v[0], v[1], v[2], v[3]}; *(f32x4*)(o + 4) = (f32x4){v[4], v[5], v[6], v[7]}; }
            COMPILER_FENCE(); }
        __syncthreads();
#pragma unroll
        for (int cls = 0; cls < 3; ++cls) {
            bf16_t* KFc = WSP(bf16_t, WS_KF) + cls * ATT_CLS + (size_t)bh * (T / 32) * 2048; bf16_t* VFc = WSP(bf16_t, WS_VF) + cls * ATT_CLS + (size_t)bh * (T / 32) * 2048;
#pragma unroll 1
            for (int k = 0; k < 4; ++k) { const int f = tid + NTHR * k, lane = f & 63, c31 = lane & 31, hi = lane >> 5;
                { int g, ks, tl, gtile; bool ok = true;
                  if (cls == 0) { ks = (f >> 6) & 3; g = f >> 8; tl = 32 * g + c31; gtile = tile * 8 + g; }
                  else if (cls == 1) { ks = (f >> 6) & 3; g = f >> 8; const int r = g >> 1, st = g & 1; tl = 4 * (32 * st + c31) + r; gtile = r * (T / 128) + tile * 2 + st; }
                  else { const int r = f >> 7, s16 = f & 15, h2 = (f >> 4) & 1; ks = (f >> 5) & 3; tl = 16 * s16 + r; gtile = r * (T / 512) + (tile >> 1); g = 0; (void)ok;
                      const int slot = 16 * (tile & 1) + s16;
                      *(u32x4*)(KFc + ((size_t)gtile * 4 + ks) * 512 + (slot + 32 * h2) * 8) = *(const u32x4*)(ka + tl * TPK + 16 * ks + 8 * h2); }
                  if (cls < 2) { *(u32x4*)(KFc + ((size_t)gtile * 4 + ks) * 512 + lane * 8) = *(const u32x4*)(ka + tl * TPK + 16 * ks + 8 * hi); } }
                { int dt, s2, gtile, r = 0, st = 0, g = 0;
                  if (cls == 0) { s2 = (f >> 6) & 1; dt = (f >> 7) & 1; g = f >> 8; gtile = tile * 8 + g; }
                  else if (cls == 1) { s2 = (f >> 6) & 1; dt = (f >> 7) & 1; g = f >> 8; r = g >> 1; st = g & 1; gtile = r * (T / 128) + tile * 2 + st; }
                  else { dt = (f >> 6) & 1; r = f >> 7; s2 = tile & 1; gtile = r * (T / 512) + (tile >> 1); }
                  unsigned short e8[8];
#pragma unroll
                  for (int jj = 0; jj < 8; ++jj) { const int kk = 16 * s2 + 8 * (jj >> 2) + 4 * hi + (jj & 3);
                      const int tl = cls == 0 ? 32 * g + kk : cls == 1 ? 4 * (32 * st + kk) + r : 16 * (kk & 15) + r;
                      e8[jj] = va[tl * TPK + 32 * dt + c31]; }
                  u32x4 w; w.x = (unsigned)e8[0] | ((unsigned)e8[1] << 16); w.y = (unsigned)e8[2] | ((unsigned)e8[3] << 16); w.z = (unsigned)e8[4] | ((unsigned)e8[5] << 16); w.w = (unsigned)e8[6] | ((unsigned)e8[7] << 16);
                  *(u32x4*)(VFc + ((size_t)gtile * 4 + dt * 2 + s2) * 512 + lane * 8) = w; }
                COMPILER_FENCE(); }
        }
        trans_write(vr, WSP(bf16_t, WS_VRT) + (size_t)bh * 64 * T, tile * 256, tid);
        trans_write(kr, WSP(bf16_t, WS_KRT) + (size_t)bh * 64 * T, tile * 256, tid);
    }
}

constexpr int CH_ITEMS = PB * 4 * 4;
__device__ __forceinline__ void ph_ret_local(const P& p, int l) {
    const int tid = tidx(), lane = tid & 63, wave = tid >> 6, x = lane & 15, q = lane >> 4, dt = wave >> 1;
    for (int u = blockIdx.x; u < NUNIT; u += gridDim.x) {
        const int n = u % NCH, bh = u / NCH, h = bh & 3, t0 = n * 64; const float g63 = expf(ret_lg(h) * 63.0f);
        const bf16_t* ka = WSP(bf16_t, WS_KRT) + ((size_t)bh * 64 + 16 * dt + x) * T + t0 + 8 * q;
#pragma unroll
        for (int k = 0; k < 2; ++k) { const int et = 2 * (wave & 1) + k; const bf16_t* vb = WSP(bf16_t, WS_VRT) + ((size_t)bh * 64 + 16 * et + x) * T + t0 + 8 * q;
            f32x4 acc = (f32x4){0.f, 0.f, 0.f, 0.f};
#pragma unroll
            for (int ks = 0; ks < 2; ++ks) acc = MFMA16(*(const bf16x8*)(ka + 32 * ks), *(const bf16x8*)(vb + 32 * ks), acc);
            *(f32x4*)(WSP(float, WS_RU) + (size_t)u * 4096 + (16 * et + x) * 64 + 16 * dt + 4 * q) = acc * g63; }
    }
}
__device__ __forceinline__ void ph_ret_scan(const P& p, int l) {
    const int G = (int)gridDim.x, skip = G > 2 * CH_ITEMS ? CH_ITEMS : 0;
    if ((int)blockIdx.x < skip) return;
    const int gt = ((int)blockIdx.x - skip) * NTHR + tidx(), ng = (G - skip) * NTHR;
    for (int e = gt; e < PB * 4 * 4096; e += ng) {
        const int bh = e >> 12, ed = e & 4095, h = bh & 3; const float cd = expf(ret_lg(h) * 64.0f);
        const float* U = WSP(float, WS_RU) + (size_t)bh * NCH * 4096 + ed; bf16_t* SPv = WSP(bf16_t, WS_RS) + (size_t)bh * NCH * 4096 + ed;
        float s = 0.f;
        static_assert(NCH % 8 == 0, "scan batches");
        constexpr int SB = NCH % 32 == 0 ? 32 : 8;
        for (int n0 = 0; n0 < NCH; n0 += SB) {
            float uv[SB];
#pragma unroll
            for (int k = 0; k < SB; ++k) uv[k] = U[(size_t)(n0 + k) * 4096];
#pragma unroll
            for (int k = 0; k < SB; ++k) { SPv[(size_t)(n0 + k) * 4096] = f2bf(s); s = s * cd + uv[k]; } }
        p.out[O_PRET + ((size_t)l * PB * 4 + bh) * 4096 + (ed & 63) * 64 + (ed >> 6)] = s;
    }
}
__device__ __forceinline__ void ph_ret_out(const P& p, int l) {
    const int tid = tidx(), lane = tid & 63, wave = tid >> 6, x = lane & 15, q = lane >> 4, it = UNIFORM(wave & 3);
    const bf16_t* PR = WSP(bf16_t, WS_PROJ);
    for (int u = blockIdx.x * 2 + (wave >> 2); u < NUNIT; u += gridDim.x * 2) {
        const int n = u % NCH, bh = u / NCH, h = bh & 3, b = bh >> 2, t0 = n * 64; const float gam = expf(ret_lg(h));
        const size_t rowi = (size_t)(b * T + t0 + 16 * it + x);
        bf16x8 qf[2];
#pragma unroll
        for (int ks = 0; ks < 2; ++ks) qf[ks] = *(const bf16x8*)(PR + rowi * NPROJ + C_QR + h * 64 + 32 * ks + 8 * q);
        f32x4 at[4];
#pragma unroll
        for (int jt = 0; jt < 4; ++jt) { at[jt] = (f32x4){0.f, 0.f, 0.f, 0.f};
            if (jt <= it) { const bf16_t* kp = PR + (size_t)(b * T + t0 + 16 * jt + x) * NPROJ + C_KR + h * 64 + 8 * q;
#pragma unroll
                for (int ks = 0; ks < 2; ++ks) at[jt] = MFMA16(*(const bf16x8*)(kp + 32 * ks), qf[ks], at[jt]);
                if (jt == it) {
#pragma unroll
                    for (int e = 0; e < 4; ++e) if (4 * q + e > x) at[jt][e] = 0.f; } } }
        const bf16x8 pb0 = pack_tiles(at[0], at[1]), pb1 = pack_tiles(at[2], at[3]);
        f32x4 o[4], os[4];
#pragma unroll
        for (int et = 0; et < 4; ++et) { o[et] = (f32x4){0.f, 0.f, 0.f, 0.f}; os[et] = (f32x4){0.f, 0.f, 0.f, 0.f};
            const bf16_t* vp = WSP(bf16_t, WS_VRT) + ((size_t)bh * 64 + 16 * et + x) * T + t0 + 4 * q;
            { const u32x2 lo = *(const u32x2*)vp, hi = *(const u32x2*)(vp + 16); u32x4 w; w.x = lo.x; w.y = lo.y; w.z = hi.x; w.w = hi.y; o[et] = MFMA16(__builtin_bit_cast(bf16x8, w), pb0, o[et]); }
            if (it >= 2) { const u32x2 lo = *(const u32x2*)(vp + 32), hi = *(const u32x2*)(vp + 48); u32x4 w; w.x = lo.x; w.y = lo.y; w.z = hi.x; w.w = hi.y; o[et] = MFMA16(__builtin_bit_cast(bf16x8, w), pb1, o[et]); }
            const bf16_t* sp = WSP(bf16_t, WS_RS) + (size_t)u * 4096 + (16 * et + x) * 64 + 8 * q;
#pragma unroll
            for (int ks = 0; ks < 2; ++ks) os[et] = MFMA16(*(const bf16x8*)(sp + 32 * ks), qf[ks], os[et]);
            o[et] = o[et] + os[et] * gam; }
        float sq = 0.f;
#pragma unroll
        for (int et = 0; et < 4; ++et) sq += (o[et][0] * o[et][0] + o[et][1] * o[et][1]) + (o[et][2] * o[et][2] + o[et][3] * o[et][3]);
        sq += __shfl_xor(sq, 16); sq += __shfl_xor(sq, 32);
        const float rstd = 1.0f / sqrtf(sq * (1.0f / 64.0f) + EPS);
#pragma unroll
        for (int et = 0; et < 4; ++et) { const int e0 = 16 * et + 4 * q; const u32x2 gw = *(const u32x2*)(PR + rowi * NPROJ + C_GR + h * 64 + e0); const f32x4 nw = *(const f32x4*)(p.ret_norm + l * 64 + e0);
            const float g0 = bf2f((bf16_t)(gw.x & 0xffff)), g1 = bf2f((bf16_t)(gw.x >> 16)), g2 = bf2f((bf16_t)(gw.y & 0xffff)), g3 = bf2f((bf16_t)(gw.y >> 16));
            u32x2 w; w.x = pk2(o[et][0] * rstd * nw[0] * silu_fast(g0), o[et][1] * rstd * nw[1] * silu_fast(g1)); w.y = pk2(o[et][2] * rstd * nw[2] * silu_fast(g2), o[et][3] * rstd * nw[3] * silu_fast(g3));
            *(u32x2*)(WSP(bf16_t, WS_O) + rowi * D + 256 + h * 64 + e0) = w; }
    }
}
__device__ __forceinline__ void ph_ret_sample(const P& p, int l, unsigned char* smem) {
    float* S0 = (float*)smem; float* qs = S0 + 4096; float* ks = qs + 8 * 64; float* vs = ks + 8 * 64;
    const int tid = tidx(); const bf16_t* PR = WSP(bf16_t, WS_PROJ);
    for (int u = gridDim.x - 1 - blockIdx.x; u < DB * 4; u += gridDim.x) {
        const int h = u & 3, b = u >> 2; const float lg = ret_lg(h);
        __syncthreads();
        for (int e = tid; e < 4096; e += NTHR) S0[e] = p.state_ret[(((size_t)l * DB + b) * 4 + h) * 4096 + e];
        { const int j = tid >> 6, d = tid & 63; const size_t row = (size_t)(MP + b * DS + j) * NPROJ;
          qs[tid] = bf2f(PR[row + C_QR + h * 64 + d]); ks[tid] = bf2f(PR[row + C_KR + h * 64 + d]); vs[tid] = bf2f(PR[row + C_VR + h * 64 + d]); }
        __syncthreads();
        { const int i = tid >> 6, e = tid & 63; float o = 0.f;
          for (int j = 0; j <= i; ++j) { float a = 0.f; for (int d = 0; d < 64; ++d) a += qs[i * 64 + d] * ks[j * 64 + d]; o += a * expf(lg * (float)(i - j)) * vs[j * 64 + e]; }
          float o2 = 0.f; for (int d = 0; d < 64; ++d) o2 += qs[i * 64 + d] * S0[d * 64 + e];
          o += o2 * expf(lg * (float)(i + 1));
          const float rstd = 1.0f / sqrtf(wave_sum(o * o) * (1.0f / 64.0f) + EPS);
          const size_t row = (size_t)(MP + b * DS + i); const float g = bf2f(PR[row * NPROJ + C_GR + h * 64 + e]);
          WSP(bf16_t, WS_O)[row * D + 256 + h * 64 + e] = f2bf(o * rstd * p.ret_norm[l * 64 + e] * silu_f(g)); }
        for (int x = tid; x < 4096; x += NTHR) { const int d = x >> 6, e = x & 63; float s = S0[x] * expf(lg * (float)DS);
            for (int j = 0; j < DS; ++j) s += ks[j * 64 + d] * expf(lg * (float)(DS - 1 - j)) * vs[j * 64 + e];
            p.out[O_SRET + (((size_t)l * DB + b) * 4 + h) * 4096 + x] = s; }
    }
}

template <int CS, int LDL> __device__ __forceinline__ void fwd_subst(float (&X)[CS], const float* Ls) {
#pragma unroll
    for (int i = 1; i < CS; ++i) {
        float a[4] = {X[i], 0.f, 0.f, 0.f};
#pragma unroll
        for (int j4 = 0; j4 < (i + 3) / 4; ++j4) { const f32x4 lv = *(const f32x4*)(Ls + i * LDL + 4 * j4);
#pragma unroll
            for (int e = 0; e < 4; ++e) if (4 * j4 + e < i) a[e] -= lv[e] * X[4 * j4 + e]; }
        X[i] = (a[0] + a[1]) + (a[2] + a[3]);
    }
}
constexpr int QP = 132;
constexpr int WSTP = 136;
constexpr int RWP = 392, TP = 136;
__device__ __forceinline__ void ph_gdn_prep(const P& p, int l, unsigned char* smem) {
    float* Ls = (float*)smem; float* As = Ls + 64 * 68; float* gs = As + 64 * 68; float* gcs = gs + 64; float* bts = gcs + 64; float* part = bts + 64;
    bf16_t* raw = (bf16_t*)(part + 4 * 64); bf16_t* Khi = raw + 67 * RWP; bf16_t* Klo = Khi + 64 * TP; bf16_t* Qb = Klo + 64 * TP;
    static_assert((64 * 68 * 2 + 64 * 3 + 4 * 64) * 4 + (67 * RWP + 3 * 64 * TP) * 2 <= BAR_LDS_OFF, "gdn_prep LDS");
    const int tid = tidx(), lane = tid & 63, wave = tid >> 6; const bf16_t* PR = WSP(bf16_t, WS_PROJ);
    for (int u = blockIdx.x; u < NUNIT; u += gridDim.x) {
        const int n = u % NCH, h = (u / NCH) % 4, b = u / (NCH * 4), t0 = n * 64;
        __syncthreads();
        for (int e = tid; e < 67 * 48; e += NTHR) { const int row = e / 48, ch = e % 48, t = t0 - 3 + row; u32x4 v = (u32x4){0u, 0u, 0u, 0u};
            if (t >= 0) v = *(const u32x4*)(PR + (size_t)(b * T + t) * NPROJ + C_CONV + (ch >> 4) * 512 + h * 128 + (ch & 15) * 8);
            *(u32x4*)(raw + row * RWP + ch * 8) = v; }
        if (tid >= 384 && tid < 448) { const int i = tid - 384; const size_t row = (size_t)(b * T + t0 + i); gs[i] = WSP(float, WS_G)[row * 4 + h]; bts[i] = WSP(float, WS_BETA)[row * 4 + h]; }
        __syncthreads();
        float y[64]; const int sec = tid < 128 ? 2 : tid < 256 ? 1 : 0, c = tid & 127;
        if (tid < 384) { const int col = sec * 512 + h * 128 + c;
            const float w0 = p.conv_w[(l * 4 + 0) * 1536 + col], w1 = p.conv_w[(l * 4 + 1) * 1536 + col], w2 = p.conv_w[(l * 4 + 2) * 1536 + col], w3 = p.conv_w[(l * 4 + 3) * 1536 + col];
            const LAS bf16_t* rp = (const LAS bf16_t*)raw + sec * 128 + c; LAUNDER_V(rp); float x0 = bf2f(rp[0]), x1 = bf2f(rp[RWP]), x2 = bf2f(rp[2 * RWP]);
#pragma unroll
            for (int i = 0; i < 64; ++i) { const float x3 = bf2f(rp[(i + 3) * RWP]); y[i] = silu_fast(w0 * x0 + w1 * x1 + w2 * x2 + w3 * x3); x0 = x1; x1 = x2; x2 = x3; if ((i & 7) == 7) COMPILER_FENCE(); } }
        if (tid >= 448) { if (tid == 448) { float a = 0.f; for (int i = 0; i < 64; ++i) { a += gs[i]; gcs[i] = a; } }
            WAVE_SYNC(); const int i = tid - 448; part[128 + i] = expf(gcs[i]); part[192 + i] = expf(gcs[63] - gcs[i]); }
#pragma unroll
        for (int pass = 0; pass < 2; ++pass) {
            if (tid >= 128 + 128 * pass && tid < 256 + 128 * pass) { LAS float* sq = (LAS float*)Ls + c; LAUNDER_V(sq);
#pragma unroll
                for (int i = 0; i < 64; ++i) sq[i * 132] = y[i] * y[i]; }
            __syncthreads();
            { const int i = tid >> 3, pt = tid & 7; const float* rp2 = Ls + i * 132 + pt * 16; float a = 0.f;
#pragma unroll
              for (int k = 0; k < 16; ++k) a += rp2[k];
              a += __shfl_xor(a, 1); a += __shfl_xor(a, 2); a += __shfl_xor(a, 4);
              if (pt == 0) part[64 * pass + i] = 1.0f / sqrtf(a + EPS); }
            __syncthreads();
        }
        if (tid >= 128 && tid < 256) { LAS bf16_t* kh = (LAS bf16_t*)Khi + c; LAS bf16_t* kl = (LAS bf16_t*)Klo + c; LAUNDER_V(kh); LAUNDER_V(kl);
#pragma unroll
            for (int i = 0; i < 64; ++i) { const float v = y[i] * part[i]; y[i] = v; const bf16_t hb = f2bf(v); kh[i * TP] = hb; kl[i * TP] = f2bf(v - bf2f(hb)); if ((i & 7) == 7) COMPILER_FENCE(); }
            bf16_t* dst = WSP(bf16_t, WS_GWK) + (size_t)u * 16384 + 8192; const int mt = c >> 4, x = c & 15;
#pragma unroll
            for (int ks2 = 0; ks2 < 2; ++ks2)
#pragma unroll
                for (int q = 0; q < 4; ++q) { const int i0 = 32 * ks2 + 4 * q; float v[8];
#pragma unroll
                    for (int e = 0; e < 8; ++e) { const int i = i0 + (e < 4 ? e : 12 + e); v[e] = y[i] * part[192 + i]; }
                    u32x4 w; w.x = pk2(v[0], v[1]); w.y = pk2(v[2], v[3]); w.z = pk2(v[4], v[5]); w.w = pk2(v[6], v[7]);
                    *(u32x4*)(dst + ((size_t)((mt * 2 + ks2) * 64 + q * 16 + x)) * 8) = w; COMPILER_FENCE(); } }
        else if (tid >= 256 && tid < 384) { LAS bf16_t* qb = (LAS bf16_t*)Qb + c; LAUNDER_V(qb);
#pragma unroll
            for (int i = 0; i < 64; ++i) { qb[i * TP] = f2bf(y[i] * part[64 + i]); if ((i & 7) == 7) COMPILER_FENCE(); } }
        __syncthreads();
#pragma unroll
        for (int tp = 0; tp < 2; ++tp) { const int pos = wave * 2 + tp, it = pos >> 2, jt = pos & 3, j16 = lane & 15, qd = lane >> 4;
            f32x4 lk = (f32x4){0.f, 0.f, 0.f, 0.f}, aq = (f32x4){0.f, 0.f, 0.f, 0.f};
            if (jt <= it) {
#pragma unroll
                for (int ks = 0; ks < 4; ++ks) { const int ao = (16 * it + j16) * TP + 32 * ks + 8 * qd, bo = (16 * jt + j16) * TP + 32 * ks + 8 * qd;
                    const bf16x8 ah = *(const bf16x8*)(Khi + ao), al = *(const bf16x8*)(Klo + ao), aqf = *(const bf16x8*)(Qb + ao), bh = *(const bf16x8*)(Khi + bo), bl = *(const bf16x8*)(Klo + bo);
                    lk = MFMA16(ah, bh, lk); lk = MFMA16(ah, bl, lk); lk = MFMA16(al, bh, lk); aq = MFMA16(aqf, bh, aq); } }
            const int j = 16 * jt + j16;
#pragma unroll
            for (int e = 0; e < 4; ++e) { const int i = 16 * it + 4 * qd + e; const float ex = j <= i ? expf(gcs[i] - gcs[j]) : 0.f;
                Ls[i * 68 + j] = j < i ? bts[i] * lk[e] * ex : 0.f; As[i * 68 + j] = aq[e] * ex * 0.08838834764831845f; } }
        __syncthreads();
        if (tid < 256) {
            if (tid < 128) {
#pragma unroll
                for (int i = 0; i < 64; ++i) { y[i] *= bts[i]; if ((i & 15) == 15) COMPILER_FENCE(); } }
            else {
#pragma unroll
                for (int i = 0; i < 64; ++i) { y[i] *= bts[i] * part[128 + i]; if ((i & 15) == 15) COMPILER_FENCE(); } }
            fwd_subst<64, 68>(y, Ls);
            if (tid < 128) { bf16_t* U = WSP(bf16_t, WS_GU) + (size_t)u * 8192 + c * 64;
#pragma unroll
                for (int i8 = 0; i8 < 8; ++i8) { u32x4 w; w.x = pk2(y[8 * i8], y[8 * i8 + 1]); w.y = pk2(y[8 * i8 + 2], y[8 * i8 + 3]); w.z = pk2(y[8 * i8 + 4], y[8 * i8 + 5]); w.w = pk2(y[8 * i8 + 6], y[8 * i8 + 7]); *(u32x4*)(U + 8 * i8) = w; } }
            else { LAS bf16_t* wst = (LAS bf16_t*)raw + c; LAUNDER_V(wst);
#pragma unroll
                for (int i = 0; i < 64; ++i) wst[i * WSTP] = f2bf(-y[i]); }
        } else { const int t2 = tid - 256;
#pragma unroll
            for (int k = 0; k < 2; ++k) { const int e8 = t2 + 256 * k, i = e8 >> 3, j0 = (e8 & 7) * 8; const f32x4 a0 = *(const f32x4*)(As + i * 68 + j0), a1 = *(const f32x4*)(As + i * 68 + j0 + 4);
                u32x4 w; w.x = pk2(a0[0], a0[1]); w.y = pk2(a0[2], a0[3]); w.z = pk2(a1[0], a1[1]); w.w = pk2(a1[2], a1[3]); *(u32x4*)(WSP(bf16_t, WS_GA) + (size_t)u * 4096 + i * 64 + j0) = w; }
            if (t2 == 0) WSP(float, WS_GD)[u] = expf(gcs[63]); }
        __syncthreads();
        { bf16_t* dst = WSP(bf16_t, WS_GWK) + (size_t)u * 16384; const bf16_t* wst = raw;
#pragma unroll
          for (int k = 0; k < 2; ++k) { const int f = tid + NTHR * k, ln = f & 63, ks4 = (f >> 6) & 3, mt = f >> 8, q = ln >> 4, x = ln & 15;
              const bf16_t* wr = wst + (16 * mt + x) * WSTP + 32 * ks4 + 4 * q;
              u32x4 w; w.x = (unsigned)wr[0] | ((unsigned)wr[1] << 16); w.y = (unsigned)wr[2] | ((unsigned)wr[3] << 16); w.z = (unsigned)wr[16] | ((unsigned)wr[17] << 16); w.w = (unsigned)wr[18] | ((unsigned)wr[19] << 16);
              *(u32x4*)(dst + (size_t)f * 8) = w; }
#pragma unroll
          for (int k = 0; k < 2; ++k) { const int e8 = tid + NTHR * k, i = e8 >> 4, d0 = (e8 & 15) * 8; float v[8]; unpack8(*(const u32x4*)(Qb + i * TP + d0), v); const float fsc = 0.08838834764831845f * part[128 + i];
#pragma unroll
              for (int x = 0; x < 8; ++x) v[x] *= fsc;
              *(u32x4*)(WSP(bf16_t, WS_GQ) + (size_t)u * 8192 + i * 128 + d0) = pack8f(v); } }
    }
}
constexpr int CH_SLOT = 36864, CH_NSLOT = 4;
static_assert(NCH % 4 == 0 && CH_NSLOT * CH_SLOT <= BAR_LDS_OFF, "chain ring");
__device__ __forceinline__ void chain_stage(const bf16_t* WK, const bf16_t* UTq, int m, int pw, int lane, unsigned char* smem) {
    unsigned char* slot = smem + (m % CH_NSLOT) * CH_SLOT;
#pragma unroll
    for (int k = 0; k < 6; ++k) { const int pc = pw * 6 + k;
        if (pc < 32) GLDS16((const unsigned char*)(WK + (size_t)m * 16384) + pc * 1024 + lane * 16, slot + pc * 1024);
        else GLDS16((const unsigned char*)(UTq + (size_t)m * 8192) + (pc - 32) * 1024 + lane * 16, slot + pc * 1024); }
}
__device__ __forceinline__ void ph_gdn_chain(const P& p, int l, unsigned char* smem) {
    const int tid = tidx(), lane = tid & 63, wave = UNIFORM(tid >> 6), j = lane & 15, q = lane >> 4;
    for (int it = blockIdx.x; it < CH_ITEMS; it += gridDim.x) {
        const int qt = it & 3, bh = it >> 2;
        const bf16_t* WK = WSP(bf16_t, WS_GWK) + (size_t)bh * NCH * 16384;
        const bf16_t* UTq = WSP(bf16_t, WS_GU) + (size_t)bh * NCH * 8192 + qt * 2048;
        __syncthreads();
        if (wave >= 2) {
            const int pw = wave - 2;
            chain_stage(WK, UTq, 0, pw, lane, smem); chain_stage(WK, UTq, 1, pw, lane, smem); chain_stage(WK, UTq, 2, pw, lane, smem);
#pragma unroll 1
            for (int n = 0; n < NCH; ++n) {
                if (n + 2 < NCH) WAIT_VM(12); else if (n + 1 < NCH) WAIT_VM(6); else WAIT_VM(0);
                RAW_BARRIER();
                if (n + 3 < NCH) chain_stage(WK, UTq, n + 3, pw, lane, smem);
            }
        } else {
            const int sl = qt * 2 + wave, c = 16 * sl + j;
            f32x4 S[8];
#pragma unroll
            for (int t = 0; t < 8; ++t) S[t] = (f32x4){0.f, 0.f, 0.f, 0.f};
            bf16x8 sB[4];
#pragma unroll
            for (int ks = 0; ks < 4; ++ks) sB[ks] = pack_tiles(S[2 * ks], S[2 * ks + 1]);
            const float* DC = WSP(float, WS_GD) + bh * NCH;
            float db[4];
#pragma unroll
            for (int d = 0; d < 4; ++d) db[d] = DC[d];
#pragma unroll 1
            for (int n0 = 0; n0 < NCH; n0 += 4) {
#pragma unroll
                for (int k4 = 0; k4 < 4; ++k4) {
                    const int n = n0 + k4, u = bh * NCH + n;
                    f32x4 acc[4]; const float dec = db[k4];
                    if (n + 4 < NCH) db[k4] = DC[n + 4];
                    { bf16_t* sp = WSP(bf16_t, WS_GS) + (size_t)u * 16384 + (size_t)sl * 2048 + lane * 8;
#pragma unroll
                      for (int tp = 0; tp < 4; ++tp) *(bf16x8*)(sp + 512 * tp) = sB[tp]; }
                    WAIT_LGKM0();
                    RAW_BARRIER();
                    const LAS unsigned char* slot = (const LAS unsigned char*)smem + (n % CH_NSLOT) * CH_SLOT + lane * 16; LAUNDER_V(slot);
                    { const LAS unsigned char* us = (const LAS unsigned char*)smem + (n % CH_NSLOT) * CH_SLOT + 32768 + ((16 * wave + j) * 64 + 4 * q) * 2; LAUNDER_V(us);
#pragma unroll
                      for (int mt = 0; mt < 4; ++mt) { const u32x2 w = *(const LAS u32x2*)(us + 32 * mt); acc[mt] = (f32x4){bf2f((bf16_t)(w.x & 0xffff)), bf2f((bf16_t)(w.x >> 16)), bf2f((bf16_t)(w.y & 0xffff)), bf2f((bf16_t)(w.y >> 16))}; } }
                    bf16x8 fa[8], fb[8];
#pragma unroll
                    for (int i = 0; i < 8; ++i) fa[i] = *(const LAS bf16x8*)(slot + i * 1024);
#pragma unroll
                    for (int i = 0; i < 8; ++i) fb[i] = *(const LAS bf16x8*)(slot + (8 + i) * 1024);
                    COMPILER_FENCE();
#pragma unroll
                    for (int ks = 0; ks < 4; ++ks) { acc[0] = MFMA16(fa[ks], sB[ks], acc[0]); acc[1] = MFMA16(fa[4 + ks], sB[ks], acc[1]); }
                    COMPILER_FENCE();
#pragma unroll
                    for (int i = 0; i < 8; ++i) fa[i] = *(const LAS bf16x8*)(slot + 16384 + i * 1024);
#pragma unroll
                    for (int ks = 0; ks < 4; ++ks) { acc[2] = MFMA16(fb[ks], sB[ks], acc[2]); acc[3] = MFMA16(fb[4 + ks], sB[ks], acc[3]); }
                    COMPILER_FENCE();
#pragma unroll
                    for (int i = 0; i < 8; ++i) fb[i] = *(const LAS bf16x8*)(slot + 16384 + (8 + i) * 1024);
                    const bf16x8 vB0 = pack_tiles(acc[0], acc[1]), vB1 = pack_tiles(acc[2], acc[3]);
                    { bf16_t* vp = WSP(bf16_t, WS_GV) + (size_t)u * 8192 + (size_t)sl * 1024 + lane * 8;
                      *(bf16x8*)vp = vB0; *(bf16x8*)(vp + 512) = vB1; }
#pragma unroll
                    for (int t = 0; t < 8; ++t) S[t] = S[t] * dec;
                    COMPILER_FENCE();
#pragma unroll
                    for (int t = 0; t < 4; ++t) S[t] = MFMA16(fa[2 * t], vB0, S[t]);
#pragma unroll
                    for (int t = 0; t < 4; ++t) S[t] = MFMA16(fa[2 * t + 1], vB1, S[t]);
#pragma unroll
                    for (int t = 0; t < 4; ++t) S[4 + t] = MFMA16(fb[2 * t], vB0, S[4 + t]);
#pragma unroll
                    for (int t = 0; t < 4; ++t) S[4 + t] = MFMA16(fb[2 * t + 1], vB1, S[4 + t]);
                    COMPILER_FENCE();
#pragma unroll
                    for (int ks = 0; ks < 4; ++ks) sB[ks] = pack_tiles(S[2 * ks], S[2 * ks + 1]);
                }
            }
            float* o = p.out + O_PGDN + ((size_t)l * PB * 4 + bh) * 16384 + c;
#pragma unroll
            for (int t = 0; t < 8; ++t)
#pragma unroll
                for (int e = 0; e < 4; ++e) o[(size_t)(16 * t + 4 * q + e) * 128] = S[t][e];
        }
    }
}
__device__ __forceinline__ void ph_gdn_out(const P& p, int l, unsigned char* smem) {
    const int tid = tidx(), lane = tid & 63, wave = tid >> 6, j = lane & 15, q = lane >> 4, mt = wave & 3;
    const bf16_t* PR = WSP(bf16_t, WS_PROJ);
    for (int u = blockIdx.x * 2 + (wave >> 2); u < NUNIT; u += gridDim.x * 2) {
        const int n = u % NCH, h = (u / NCH) % 4, b = u / (NCH * 4);
        f32x4 acc[8];
#pragma unroll
        for (int ct = 0; ct < 8; ++ct) acc[ct] = (f32x4){0.f, 0.f, 0.f, 0.f};
        const bf16_t* qg = WSP(bf16_t, WS_GQ) + (size_t)u * 8192 + (16 * mt + j) * 128 + 8 * q;
        const bf16_t* st = WSP(bf16_t, WS_GS) + (size_t)u * 16384 + ((2 * (q & 1)) * 16 + j) * 8 + (q >> 1) * 4;
#pragma unroll
        for (int ks = 0; ks < 4; ++ks) { const bf16x8 a = *(const bf16x8*)(qg + 32 * ks);
#pragma unroll
            for (int ct = 0; ct < 8; ++ct) { const bf16_t* sp = st + (size_t)ct * 2048 + ks * 512; const u32x2 lo = *(const u32x2*)sp, hi = *(const u32x2*)(sp + 128); u32x4 w; w.x = lo.x; w.y = lo.y; w.z = hi.x; w.w = hi.y;
                acc[ct] = MFMA16(a, __builtin_bit_cast(bf16x8, w), acc[ct]); }
            COMPILER_FENCE(); }
        const bf16_t* at = WSP(bf16_t, WS_GA) + (size_t)u * 4096 + (16 * mt + j) * 64 + 8 * q;
        const bf16_t* vt = WSP(bf16_t, WS_GV) + (size_t)u * 8192 + ((2 * (q & 1)) * 16 + j) * 8 + (q >> 1) * 4;
#pragma unroll
        for (int ks = 0; ks < 2; ++ks) { const bf16x8 a = *(const bf16x8*)(at + 32 * ks);
#pragma unroll
            for (int ct = 0; ct < 8; ++ct) { const bf16_t* vp = vt + (size_t)ct * 1024 + ks * 512; const u32x2 lo = *(const u32x2*)vp, hi = *(const u32x2*)(vp + 128); u32x4 w; w.x = lo.x; w.y = lo.y; w.z = hi.x; w.w = hi.y;
                acc[ct] = MFMA16(a, __builtin_bit_cast(bf16x8, w), acc[ct]); }
            COMPILER_FENCE(); }
        float sq[4];
#pragma unroll
        for (int e = 0; e < 4; ++e) { float s = 0.f;
#pragma unroll
            for (int ct = 0; ct < 8; ++ct) s += acc[ct][e] * acc[ct][e];
            s += __shfl_xor(s, 1); s += __shfl_xor(s, 2); s += __shfl_xor(s, 4); s += __shfl_xor(s, 8); sq[e] = 1.0f / sqrtf(s * (1.0f / 128.0f) + EPS); }
        float* stg = (float*)smem + wave * (16 * 132);
#pragma unroll
        for (int e = 0; e < 4; ++e)
#pragma unroll
            for (int ct = 0; ct < 8; ++ct) stg[(4 * q + e) * 132 + 16 * ct + j] = acc[ct][e] * sq[e];
        WAVE_SYNC();
        { const int rr = lane >> 2, cg = lane & 3; const size_t row = (size_t)(b * T + n * 64 + 16 * mt + rr);
#pragma unroll
          for (int k4 = 0; k4 < 4; ++k4) { const int c0 = cg * 32 + k4 * 8; const f32x4 o0 = *(const f32x4*)(stg + rr * 132 + c0), o1 = *(const f32x4*)(stg + rr * 132 + c0 + 4);
              float z[8]; unpack8(*(const u32x4*)(PR + row * NPROJ + C_Z + h * 128 + c0), z); const f32x4 n0 = *(const f32x4*)(p.gdn_norm + l * 128 + c0), n1 = *(const f32x4*)(p.gdn_norm + l * 128 + c0 + 4);
              float r8[8];
#pragma unroll
              for (int i = 0; i < 4; ++i) { r8[i] = o0[i] * n0[i] * silu_fast(z[i]); r8[4 + i] = o1[i] * n1[i] * silu_fast(z[4 + i]); }
              *(u32x4*)(WSP(bf16_t, WS_O) + row * D + 512 + h * 128 + c0) = pack8f(r8); } }
        WAVE_SYNC();
    }
}
__device__ __forceinline__ void ph_gdn_sample(const P& p, int l, unsigned char* smem) {
    float* qs = (float*)smem; float* ks = qs + 8 * QP; float* vs = ks + 8 * QP; float* us = vs + 8 * QP; float* wsm = us + 8 * 128; float* vn = wsm + 8 * 128;
    float* Ls = vn + 8 * 128; float* As = Ls + 8 * 8; float* gs = As + 8 * 8; float* gcs = gs + 8; float* bts = gcs + 8; float* S0 = bts + 8;
    const int tid = tidx(); const bf16_t* PR = WSP(bf16_t, WS_PROJ);
    for (int u = gridDim.x - 1 - blockIdx.x; u < DB * 4; u += gridDim.x) {
        const int h = u & 3, b = u >> 2;
        __syncthreads();
#pragma unroll 4
        for (int e = tid; e < 16384; e += NTHR) S0[e] = p.state_gdn[(((size_t)l * DB + b) * 4 + h) * 16384 + e];
        if (tid < 384) { const int sec = tid >> 7, c = tid & 127, col = sec * 512 + h * 128 + c; float* dst = sec == 0 ? qs : sec == 1 ? ks : vs;
            const float w0 = p.conv_w[(l * 4 + 0) * 1536 + col], w1 = p.conv_w[(l * 4 + 1) * 1536 + col], w2 = p.conv_w[(l * 4 + 2) * 1536 + col], w3 = p.conv_w[(l * 4 + 3) * 1536 + col];
            const float* hist = p.state_conv + (((size_t)l * DB + b) * 3) * 1536 + col; const bf16_t* src = PR + (size_t)(MP + b * DS) * NPROJ + C_CONV + col;
            float x0 = hist[0], x1 = hist[1536], x2 = hist[2 * 1536];
            for (int i = 0; i < DS; ++i) { const float x3 = bf2f(src[(size_t)i * NPROJ]); const float y = w0 * x0 + w1 * x1 + w2 * x2 + w3 * x3; dst[i * QP + c] = silu_f(y); x0 = x1; x1 = x2; x2 = x3; } }
        else if (tid < 384 + DS) { const int i = tid - 384; const size_t row = (size_t)(MP + b * DS + i); gs[i] = WSP(float, WS_G)[row * 4 + h]; bts[i] = WSP(float, WS_BETA)[row * 4 + h]; }
        __syncthreads();
        if (tid < 64) { const int rid = tid >> 2, part = tid & 3; float* rowp = (rid < 8 ? qs + rid * QP : ks + (rid - 8) * QP) + part * 32; float s = 0.f;
            for (int d = 0; d < 32; ++d) s += rowp[d] * rowp[d];
            s += __shfl_xor(s, 1); s += __shfl_xor(s, 2); const float sc = 1.0f / sqrtf(s + EPS);
            for (int d = 0; d < 32; ++d) rowp[d] *= sc; }
        if (tid == 64) { float a = 0.f; for (int i = 0; i < DS; ++i) { a += gs[i]; gcs[i] = a; } }
        __syncthreads();
        if (tid < 64) { const int i = tid >> 3, j = tid & 7; float lv = 0.f, av = 0.f;
            if (j <= i) { float dk = 0.f, dq = 0.f; for (int d = 0; d < 128; ++d) { const float kj = ks[j * QP + d]; dk += ks[i * QP + d] * kj; dq += qs[i * QP + d] * kj; }
                const float e = expf(gcs[i] - gcs[j]); av = dq * e * 0.08838834764831845f; lv = j < i ? bts[i] * dk * e : 0.f; }
            Ls[i * 8 + j] = lv; As[i * 8 + j] = av; }
        __syncthreads();
        if (tid < 256) { const int c = tid; float X[8];
            if (c < 128) {
#pragma unroll
                for (int i = 0; i < 8; ++i) X[i] = vs[i * QP + c] * bts[i]; }
            else {
#pragma unroll
                for (int i = 0; i < 8; ++i) X[i] = ks[i * QP + c - 128] * bts[i] * expf(gcs[i]); }
            fwd_subst<8, 8>(X, Ls);
            float* dst = c < 128 ? us + c : wsm + c - 128;
#pragma unroll
            for (int i = 0; i < 8; ++i) dst[i * 128] = X[i]; }
        __syncthreads();
        const int i = tid >> 6, c2 = (tid & 63) * 2;
        { float a0 = us[i * 128 + c2], a1 = us[i * 128 + c2 + 1];
          for (int d = 0; d < 128; ++d) { const float w = wsm[i * 128 + d]; a0 -= w * S0[d * 128 + c2]; a1 -= w * S0[d * 128 + c2 + 1]; }
          vn[i * 128 + c2] = a0; vn[i * 128 + c2 + 1] = a1; }
        __syncthreads();
        { float o0 = 0.f, o1 = 0.f; const float qsc = 0.08838834764831845f * expf(gcs[i]);
          for (int d = 0; d < 128; ++d) { const float qg = qs[i * QP + d] * qsc; o0 += qg * S0[d * 128 + c2]; o1 += qg * S0[d * 128 + c2 + 1]; }
          for (int j = 0; j < DS; ++j) { const float a = As[i * 8 + j]; o0 += a * vn[j * 128 + c2]; o1 += a * vn[j * 128 + c2 + 1]; }
          const float rstd = 1.0f / sqrtf(wave_sum(o0 * o0 + o1 * o1) * (1.0f / 128.0f) + EPS);
          const size_t row = (size_t)(MP + b * DS + i);
          const float z0 = bf2f(PR[row * NPROJ + C_Z + h * 128 + c2]), z1 = bf2f(PR[row * NPROJ + C_Z + h * 128 + c2 + 1]);
          bf16_t* O = WSP(bf16_t, WS_O) + row * D + 512 + h * 128 + c2;
          O[0] = f2bf(o0 * rstd * p.gdn_norm[l * 128 + c2] * silu_f(z0)); O[1] = f2bf(o1 * rstd * p.gdn_norm[l * 128 + c2 + 1] * silu_f(z1)); }
        { const float gl = gcs[DS - 1], dec = expf(gl); float* o = p.out + O_SGDN + (((size_t)l * DB + b) * 4 + h) * 16384;
#pragma unroll 2
          for (int e = tid; e < 16384; e += NTHR) { const int d = e >> 7, c = e & 127; float s = S0[e] * dec;
              for (int j = 0; j < DS; ++j) s += ks[j * QP + d] * expf(gl - gcs[j]) * vn[j * 128 + c];
              o[e] = s; } }
    }
}


template <int K> __device__ __forceinline__ void ph_gemm_small(const P& p, const bf16_t* A  , const bf16_t* Bt  , const float* gate, const float* xs_in  , unsigned char* smem) {
    static_assert(MS % 16 == 0 && K % 256 == 0, "small GEMM shape");
    constexpr int KW = K / 8, NKS = KW / 32;
    const int tid = tidx(), lane = tid & 63, wave = tid >> 6, x = lane & 15, q = lane >> 4;
    float* red = (float*)smem;
    for (int it = blockIdx.x; it < (MS / 16) * 16; it += gridDim.x) {
        const int rt = it % (MS / 16), cg = it / (MS / 16);
        const bf16_t* ap = A + (size_t)(16 * rt + x) * K + wave * KW + 8 * q;
        const bf16_t* bp = Bt + (size_t)(64 * cg + x) * K + wave * KW + 8 * q;
        f32x4 acc[4];
#pragma unroll
        for (int ct = 0; ct < 4; ++ct) acc[ct] = (f32x4){0.f, 0.f, 0.f, 0.f};
#pragma unroll
        for (int ks = 0; ks < NKS; ++ks) { const bf16x8 a = *(const bf16x8*)(ap + 32 * ks);
#pragma unroll
            for (int ct = 0; ct < 4; ++ct) acc[ct] = MFMA16(a, *(const bf16x8*)(bp + (size_t)ct * 16 * K + 32 * ks), acc[ct]); }
        __syncthreads();
#pragma unroll
        for (int ct = 0; ct < 4; ++ct) *(f32x4*)(red + ((wave * 4 + ct) * 64 + lane) * 4) = acc[ct];
        __syncthreads();
        if (wave < 4) { f32x4 s = (f32x4){0.f, 0.f, 0.f, 0.f};
#pragma unroll
            for (int w = 0; w < 8; ++w) s += *(const f32x4*)(red + ((w * 4 + wave) * 64 + lane) * 4);
            const int col = 64 * cg + 16 * wave + x;
#pragma unroll
            for (int e = 0; e < 4; ++e) { const int row = MP + 16 * rt + 4 * q + e; float* xp = p.out + (size_t)row * D + col; const float xin = xs_in ? xs_in[(size_t)(row - MP) * D + col] : *xp; *xp = xin + gate[(size_t)row_cb(row) * 6144 + col] * s[e]; } }
    }
}

__device__ __forceinline__ void ph_final_norm(const P& p) {
    const int lane = tidx() & 63, wave = tidx() >> 6, gw = blockIdx.x * 8 + wave, ngw = gridDim.x * 8;
    for (int r = gw; r < M; r += ngw) {
        float* xr = p.out + (size_t)r * D; f32x4 v[4]; float ss = 0.f;
#pragma unroll
        for (int j = 0; j < 4; ++j) { v[j] = *(const f32x4*)(xr + 4 * lane + 256 * j); ss += (v[j][0] * v[j][0] + v[j][1] * v[j][1]) + (v[j][2] * v[j][2] + v[j][3] * v[j][3]); }
        const float rstd = 1.0f / sqrtf(wave_sum(ss) * (1.0f / D) + EPS);
#pragma unroll
        for (int j = 0; j < 4; ++j) { const f32x4 g = *(const f32x4*)(p.final_norm + 4 * lane + 256 * j); *(f32x4*)(xr + 4 * lane + 256 * j) = v[j] * rstd * g; }
    }
}

enum Phase { PH_PRO = 0, PH_NORM1, PH_GEMM_IN, PH_ROPE, PH_MIX1, PH_MIX2, PH_MIX3, PH_GEMM_OUT, PH_NORM2, PH_GEMM_GU, PH_GEMM_DN, PH_FINAL };
#ifdef __HIP_EMU__
#define LDSP(x) (x)
#else
#define LDSP(x) ((PG8_LAS unsigned char*)(x))
#endif
template <int PH> __device__ __forceinline__ void run_phase(const P& p, int l, unsigned char* smem) {
    if constexpr (PH == PH_PRO) { ph_convert(p, smem, 0, CV_IN, 0, (int)gridDim.x); __syncthreads(); ph_adaln(p, smem, 0, 1, 0, (int)gridDim.x); ph_ropetab_copyx(p); }
    else if constexpr (PH == PH_NORM1) ph_norm_mod<0>(p, l, smem);
    else if constexpr (PH == PH_GEMM_IN) {
        pg8::Gemm g{WSP(bf16_t, WS_H), WSP(bf16_t, WS_WIN) + (size_t)l * NPROJ * D, MPAD, NPROJ, D}; pg8::StaticOrder S; S.init(MPAD, NPROJ, (int)gridDim.x, (int)blockIdx.x);
        pg8::EpiStoreBf16 E{WSP(bf16_t, WS_PROJ), NPROJ};
        pg8::gemm_phase<pg8::EpiStoreBf16, pg8::StaticOrder, true, true>(LDSP(smem), g, S, E);
    }
    else if constexpr (PH == PH_ROPE) { ph_rope_out(p, l); ph_vtrans(p, l, smem); }
    else if constexpr (PH == PH_MIX1) { ph_ret_local(p, l); ph_gdn_prep(p, l, smem); }
    else if constexpr (PH == PH_MIX2) { ph_gdn_chain(p, l, smem); { const int G = (int)gridDim.x; const bool split = G >= CH_ITEMS + DB * 4 + 16; ph_attn_jobs(p, split ? CH_ITEMS : 0, split ? G - DB * 4 : G, split ? 3 : 0); }
        __syncthreads(); ph_attn_sample(p, l, smem); ph_ret_sample(p, l, smem); ph_gdn_sample(p, l, smem); ph_ret_scan(p, l);
        if (l + 1 < NL) { const int G = (int)gridDim.x; const bool split = G >= CH_ITEMS + DB * 4 + 16; const int b0 = split ? CH_ITEMS : 0;
            __syncthreads(); ph_convert(p, smem, l == 0 ? CV_IN : (l + 1) * CV_L, (l + 2) * CV_L, b0, G); __syncthreads(); ph_adaln(p, smem, l + 1, l + 2, b0, G); } }
    else if constexpr (PH == PH_MIX3) { ph_attn_combine(p); ph_ret_out(p, l); ph_gdn_out(p, l, smem); }
    else if constexpr (PH == PH_GEMM_OUT) {
        ph_gemm_small<D>(p, WSP(bf16_t, WS_O) + (size_t)MP * D, WSP(bf16_t, WS_WOUT) + (size_t)l * D * D, WSP(float, WS_MOD) + (size_t)l * NC * 6144 + 2048, l == 0 ? p.x_sample : nullptr, smem); __syncthreads();
        pg8::Gemm g{WSP(bf16_t, WS_O), WSP(bf16_t, WS_WOUT) + (size_t)l * D * D, MP, D, D}; pg8::StaticOrder S; S.init(MP, D, (int)gridDim.x, (int)blockIdx.x);
        pg8::EpiResidual E{p.out, WSP(float, WS_MOD) + (size_t)l * NC * 6144 + 2048, l == 0 ? p.x_prompt : p.out};
        pg8::gemm_phase<pg8::EpiResidual, pg8::StaticOrder, true, true>(LDSP(smem), g, S, E);
    }
    else if constexpr (PH == PH_NORM2) ph_norm_mod<1>(p, l, smem);
    else if constexpr (PH == PH_GEMM_GU) {
        pg8::Gemm g{WSP(bf16_t, WS_H), WSP(bf16_t, WS_WGU) + (size_t)l * 2 * FF * D, MPAD, 2 * FF, D}; pg8::StaticOrder S; S.init(MPAD, 2 * FF, (int)gridDim.x, (int)blockIdx.x);
        pg8::EpiSwiglu E{WSP(bf16_t, WS_HID)};
        pg8::gemm_phase<pg8::EpiSwiglu, pg8::StaticOrder, true, true>(LDSP(smem), g, S, E);
    }
    else if constexpr (PH == PH_GEMM_DN) {
        ph_gemm_small<FF>(p, WSP(bf16_t, WS_HID) + (size_t)MP * FF, WSP(bf16_t, WS_WDN) + (size_t)l * D * FF, WSP(float, WS_MOD) + (size_t)l * NC * 6144 + 5120, nullptr, smem); __syncthreads();
        pg8::Gemm g{WSP(bf16_t, WS_HID), WSP(bf16_t, WS_WDN) + (size_t)l * D * FF, MP, D, FF}; pg8::StaticOrder S; S.init(MP, D, (int)gridDim.x, (int)blockIdx.x);
        pg8::EpiResidual E{p.out, WSP(float, WS_MOD) + (size_t)l * NC * 6144 + 5120, p.out};
        pg8::gemm_phase<pg8::EpiResidual, pg8::StaticOrder, true, true>(LDSP(smem), g, S, E);
    }
    else if constexpr (PH == PH_FINAL) ph_final_norm(p);
}
template <int PH> __global__ void __launch_bounds__(NTHR, 2) k_phase(P p, int l) { DYN_SMEM(smem); run_phase<PH>(p, l, smem); }


#ifndef __HIP_EMU__
#define LAS __attribute__((address_space(3)))
#define XB_TMO      128
#define XB_XCNT(j)  (256  + 64 * (j))
#define XB_XSUB(j)  (1280 + 64 * (j))
#define XB_XGEN(j)  (2304 + 64 * (j))
#define XB_TOP      3328
#define XB_TOPGEN   3392
#define XCD_BAR_WORDS 3456
#define XB_SPIN_CAP (1u << 18)

__device__ __forceinline__ unsigned xb_ld(unsigned* p)              { return __hip_atomic_load(p, __ATOMIC_RELAXED, __HIP_MEMORY_SCOPE_AGENT); }
__device__ __forceinline__ unsigned xb_add(unsigned* p, unsigned v) { return __hip_atomic_fetch_add(p, v, __ATOMIC_RELAXED, __HIP_MEMORY_SCOPE_AGENT); }
__device__ __forceinline__ unsigned xb_xcc_id() { return (unsigned)__builtin_amdgcn_s_getreg((3 << 11) | 20) & 0xFu; }
#define XB_SPIN(cond, bar) do { unsigned _sp = 0; while (cond) { __builtin_amdgcn_s_sleep(1); \
    if ((++_sp & 255u) == 0u) { if (xb_ld(&(bar)[XB_TMO])) break; if (_sp > XB_SPIN_CAP) { atomicAdd(&(bar)[XB_TMO], 1u); break; } } } } while (0)

struct XcdBarrier {
    unsigned* bar; unsigned x;
    volatile LAS unsigned* st;
};

__device__ __forceinline__ XcdBarrier xcd_barrier_post(unsigned* bar, volatile LAS unsigned* st) {
    XcdBarrier b; b.bar = bar; b.x = xb_xcc_id(); b.st = st;
    if (threadIdx.x == 0) (void)xb_add(&bar[XB_XCNT(b.x)], 1u);
    return b;
}
__device__ __forceinline__ void xcd_barrier_complete(unsigned* bar, unsigned x, unsigned& nloc, unsigned& nx) {
    const unsigned G = gridDim.x * gridDim.y * gridDim.z;
    unsigned sum, cnt, mine, sp = 0u;
    for (;;) {
        sum = 0u; cnt = 0u; mine = 0u;
#pragma unroll
        for (unsigned j = 0; j < 16; ++j) { const unsigned c = xb_ld(&bar[XB_XCNT(j)]); sum += c; cnt += (c > 0u) ? 1u : 0u; mine = (j == x) ? c : mine; }
        if (sum == G) break;
        __builtin_amdgcn_s_sleep(1);
        if ((++sp & 255u) == 0u) { if (xb_ld(&bar[XB_TMO])) break; if (sp > XB_SPIN_CAP) { atomicAdd(&bar[XB_TMO], 1u); break; } }
    }
    nloc = mine > 0u ? mine : 1u; nx = cnt > 0u ? cnt : 1u;
}

__device__ __forceinline__ void xcd_barrier(const XcdBarrier& b) {
    asm volatile("s_waitcnt vmcnt(0)" ::: "memory");
    __syncthreads();
    if (threadIdx.x == 0) {
        unsigned* bar = b.bar;
        __builtin_amdgcn_s_waitcnt(0);
        unsigned nloc = b.st[0], nx = b.st[1];
        if (nloc == 0u) { xcd_barrier_complete(bar, b.x, nloc, nx); b.st[0] = nloc; b.st[1] = nx; }
        const unsigned old = xb_add(&bar[XB_XSUB(b.x)], 1u);
        const unsigned gen = old / nloc;
        if (old + 1u == (gen + 1u) * nloc) {
            __builtin_amdgcn_fence(__ATOMIC_RELEASE, "agent");
            asm volatile("s_waitcnt vmcnt(0)" ::: "memory");
            const unsigned og = xb_add(&bar[XB_TOP], 1u);
            const unsigned tg = og / nx;
            if (og + 1u == (tg + 1u) * nx) xb_add(&bar[XB_TOPGEN], 1u);
            else XB_SPIN(xb_ld(&bar[XB_TOPGEN]) == tg, bar);
            __builtin_amdgcn_fence(__ATOMIC_ACQUIRE, "agent");
            xb_add(&bar[XB_XGEN(b.x)], 1u);
            asm volatile("s_waitcnt vmcnt(0)" ::: "memory");
        } else {
            XB_SPIN(xb_ld(&bar[XB_XGEN(b.x)]) == gen, bar);
            __builtin_amdgcn_fence(__ATOMIC_ACQUIRE, "agent");
            asm volatile("s_waitcnt vmcnt(0)" ::: "memory");
        }
    }
    __syncthreads();
}

#endif

#ifndef __HIP_EMU__
#define GRID_SYNC() xcd_barrier(bar)
__global__ void __launch_bounds__(NTHR, 2) k_mega(P p_arg) {
    DYN_SMEM(smem);
#if defined(__HIP_DEVICE_COMPILE__)
#define PHASE(PH_, l_) do { const __attribute__((address_space(4))) P* kp_ = (const __attribute__((address_space(4))) P*)__builtin_amdgcn_kernarg_segment_ptr(); LAUNDER_PTR(kp_); P pl_; __builtin_memcpy(&pl_, kp_, sizeof(P)); run_phase<PH_>(pl_, l_, smem); } while (0)
#else
#define PHASE(PH_, l_) run_phase<PH_>(p_arg, l_, smem)
#endif
    cooperative_groups::grid_group grid = cooperative_groups::this_grid();
    volatile LAS unsigned* bst = (volatile LAS unsigned*)((LAS unsigned char*)smem + BAR_LDS_OFF);
    if (threadIdx.x < 4) bst[threadIdx.x] = 0u;
    __syncthreads();
    XcdBarrier bar = xcd_barrier_post((unsigned*)(p_arg.ws + WS_CTL + 4096), bst);
    PHASE(PH_PRO, 0); grid.sync();
#define LAYER(l) do { PHASE(PH_NORM1, l); GRID_SYNC(); PHASE(PH_GEMM_IN, l); GRID_SYNC(); PHASE(PH_ROPE, l); GRID_SYNC(); PHASE(PH_MIX1, l); GRID_SYNC(); PHASE(PH_MIX2, l); GRID_SYNC(); \
        PHASE(PH_MIX3, l); GRID_SYNC(); PHASE(PH_GEMM_OUT, l); GRID_SYNC(); PHASE(PH_NORM2, l); GRID_SYNC(); PHASE(PH_GEMM_GU, l); GRID_SYNC(); PHASE(PH_GEMM_DN, l); GRID_SYNC(); } while (0)
    static_assert(NL == 2, "two layers written out (a loop over the layers makes hipcc hoist every phase's constants to the loop preheader and spill)");
    LAYER(0); LAYER(1);
    PHASE(PH_FINAL, 0);
}
#endif

template <int PH> static void launch_phase(const P& p, int l, int grid, hipStream_t stream) {
#ifndef __HIP_EMU__
    static bool attr_done = false;
    if (!attr_done) { (void)hipFuncSetAttribute((const void*)k_phase<PH>, hipFuncAttributeMaxDynamicSharedMemorySize, SMEM_BYTES); attr_done = true; }
#endif
    LAUNCH(k_phase<PH>, grid, SMEM_BYTES, stream, p, l);
}

extern "C" void kernel_launch(void* const* d_in, const int* in_sizes, int n_in, void* d_out, int out_size, void* d_ws, size_t ws_size, hipStream_t stream) {
    if (n_in != 24 || (size_t)out_size != O_END || ws_size < WS_END) {
        fprintf(stderr, "kernel_launch: shape mismatch: n_in %d out_size %d (want %zu) ws %zu (want %zu)\n", n_in, out_size, (size_t)O_END, ws_size, (size_t)WS_END); return; }
    P p{};
    const float** pp = (const float**)&p;
    for (int i = 0; i < 24; ++i) pp[i] = (const float*)d_in[i];
    p.out = (float*)d_out; p.ws = (unsigned char*)d_ws;
#ifndef __HIP_EMU__
    static int grid = 0;
    if (grid == 0) {
        int dev = 0, cus = 0, per_cu = 0;
        if (hipGetDevice(&dev) != hipSuccess || hipDeviceGetAttribute(&cus, hipDeviceAttributeMultiprocessorCount, dev) != hipSuccess || cus <= 0) { fprintf(stderr, "kernel_launch: device query failed\n"); grid = -1; return; }
        if (hipFuncSetAttribute((const void*)k_mega, hipFuncAttributeMaxDynamicSharedMemorySize, SMEM_BYTES) != hipSuccess) { fprintf(stderr, "kernel_launch: hipFuncSetAttribute failed\n"); grid = -1; return; }
        if (hipOccupancyMaxActiveBlocksPerMultiprocessor(&per_cu, (const void*)k_mega, NTHR, SMEM_BYTES) != hipSuccess || per_cu < 1) { fprintf(stderr, "kernel_launch: occupancy query says %d blocks per CU\n", per_cu); grid = -1; return; }
        grid = cus;
    }
    if (grid < 0) return;
    if (hipMemsetAsync((char*)d_ws + WS_CTL, 0, 65536, stream) != hipSuccess) { fprintf(stderr, "kernel_launch: memset of the barrier words failed\n"); return; }
    { void* args[] = {(void*)&p};
      hipError_t e = hipLaunchCooperativeKernel((const void*)k_mega, dim3(grid), dim3(NTHR), args, SMEM_BYTES, stream);
      if (e != hipSuccess) fprintf(stderr, "kernel_launch: cooperative launch failed: %s (grid %d)\n", hipGetErrorString(e), grid);
      return; }
#else
    int grid = 16;
#endif
    launch_phase<PH_PRO>(p, 0, grid, stream);
    for (int l = 0; l < NL; ++l) {
        launch_phase<PH_NORM1>(p, l, grid, stream);
        launch_phase<PH_GEMM_IN>(p, l, grid, stream);
        launch_phase<PH_ROPE>(p, l, grid, stream);
        launch_phase<PH_MIX1>(p, l, grid, stream);
        launch_phase<PH_MIX2>(p, l, grid, stream);
        launch_phase<PH_MIX3>(p, l, grid, stream);
        launch_phase<PH_GEMM_OUT>(p, l, grid, stream);
        launch_phase<PH_NORM2>(p, l, grid, stream);
        launch_phase<PH_GEMM_GU>(p, l, grid, stream);
        launch_phase<PH_GEMM_DN>(p, l, grid, stream);
    }
    launch_phase<PH_FINAL>(p, 0, grid, stream);
}
```

```cpp
#ifndef __HIP_EMU__
#include <hip/hip_runtime.h>
#include <hip/hip_cooperative_groups.h>
#endif
#include <cstdio>
#include <cstdint>
#include <cmath>

#ifndef CFG_BATCH
#define CFG_BATCH 2
#endif
#ifndef CFG_SEQ
#define CFG_SEQ 8192
#endif
#ifndef CFG_DB
#define CFG_DB 32
#endif
constexpr float LOG2E = 1.4426950408889634f;
constexpr int D = 1024, NL = 2, PB = CFG_BATCH, T = CFG_SEQ, DB = CFG_DB, DS = 8, PAST = 16384, WB = 2048;
constexpr int MP = PB * T, MS = DB * DS, M = MP + MS, MPAD = (M + 255) / 256 * 256, NC = PB + DB;
constexpr int INC = 3848, NPROJ = 3840, FF = 2816, NCH = T / 64, PWIN = T < 2048 ? T : 2048, NPOS = T + DS;
constexpr int NUNIT = PB * 4 * NCH;
constexpr float EPS = 1e-6f;
static_assert(T % 512 == 0, "the attention job decomposition wants T % 512 == 0");
constexpr int C_QA = 0, C_KA = 256, C_VA = 512, C_QR = 768, C_KR = 1024, C_VR = 1280, C_GR = 1536, C_CONV = 1792, C_Z = 3328;
constexpr int SMEM_BYTES = 148480;
constexpr int NTHR = 512;
constexpr int BAR_LDS_OFF = SMEM_BYTES - 64;

typedef unsigned short bf16_t;
typedef short bf16x8 __attribute__((ext_vector_type(8)));
typedef float f32x4 __attribute__((ext_vector_type(4)));
typedef unsigned u32x4 __attribute__((ext_vector_type(4)));
typedef unsigned u32x2 __attribute__((ext_vector_type(2)));
typedef float f32x16 __attribute__((ext_vector_type(16)));

#ifdef __HIP_EMU__
#define LAUNCH(kern, grid, lds, stream, ...) emu_launch(grid, NTHR, [=]() { kern(__VA_ARGS__); })
#define DYN_SMEM(name) unsigned char* name = emu_dyn_smem()
#define WAVE_SYNC() emu_wave_bar()
#define MFMA32(a, b, c) emu_mfma32(a, b, c)
#define GLDS16(gp, lp) memcpy((unsigned char*)(lp) + (threadIdx.x & 63) * 16, (gp), 16)
#define RAW_BARRIER() __syncthreads()
#define GLDS4(gp, lp) ((void)0)
#define WAIT_VM(n)
#define WAIT_LGKM0()
#define LAS
#define UNIFORM(x) (x)
#define COMPILER_FENCE()
#define LAUNDER_V(x)
#define MFMA16(a, b, c) emu_mfma16(a, b, c)
#else
#define WAVE_SYNC() asm volatile("s_waitcnt lgkmcnt(0)" ::: "memory")
#define MFMA32(a, b, c) __builtin_amdgcn_mfma_f32_32x32x16_bf16(a, b, c, 0, 0, 0)
#define LAS __attribute__((address_space(3)))
#define GLDS16(gp, lp) __builtin_amdgcn_global_load_lds((const unsigned*)(gp), (LAS unsigned*)(lp), 16, 0, 0)
#define RAW_BARRIER() __builtin_amdgcn_s_barrier()
#define GLDS4(gp, lp) __builtin_amdgcn_global_load_lds((const unsigned*)(gp), (LAS unsigned*)(lp), 4, 0, 0)
#define WAIT_VM(n) asm volatile("s_waitcnt vmcnt(" #n ")" ::: "memory")
#define WAIT_LGKM0() asm volatile("s_waitcnt lgkmcnt(0)" ::: "memory")
#define UNIFORM(x) __builtin_amdgcn_readfirstlane(x)
#define COMPILER_FENCE() __builtin_amdgcn_sched_barrier(0)
#define LAUNDER_V(x) asm volatile("" : "+v"(x))
#define MFMA16(a, b, c) __builtin_amdgcn_mfma_f32_16x16x32_bf16(a, b, c, 0, 0, 0)
#define LAUNCH(kern, grid, lds, stream, ...) hipLaunchKernelGGL(kern, dim3(grid), dim3(NTHR), lds, stream, __VA_ARGS__)
#define DYN_SMEM(name) extern __shared__ __attribute__((aligned(16))) unsigned char name[]
#endif

#ifdef __HIP_EMU__
__device__ __forceinline__ int tidx() { return (int)threadIdx.x; }
#define LAUNDER_PTR(x)
#else
__device__ __forceinline__ int tidx() { int t = (int)threadIdx.x; asm volatile("" : "+v"(t)); return t; }
#define LAUNDER_PTR(x) asm volatile("" : "+s"(x))
#endif
__device__ __forceinline__ float bf2f(bf16_t v) { return __builtin_bit_cast(float, (unsigned)v << 16); }
__device__ __forceinline__ bf16_t f2bf(float f) { unsigned u = __builtin_bit_cast(unsigned, f); return (bf16_t)((u + 0x7fffu + ((u >> 16) & 1u)) >> 16); }
#ifdef __HIP_EMU__
__device__ __forceinline__ unsigned pk2(float lo, float hi) { return (unsigned)f2bf(lo) | ((unsigned)f2bf(hi) << 16); }
#else
typedef float f32x2_t __attribute__((ext_vector_type(2))); typedef __bf16 bf16x2_t __attribute__((ext_vector_type(2)));
__device__ __forceinline__ unsigned pk2(float lo, float hi) { f32x2_t v = {lo, hi}; bf16x2_t b = __builtin_convertvector(v, bf16x2_t); return __builtin_bit_cast(unsigned, b); }
#endif
__device__ __forceinline__ bf16x8 pack_tiles(const f32x4& lo, const f32x4& hi) {
    u32x4 w; w.x = pk2(lo[0], lo[1]); w.y = pk2(lo[2], lo[3]); w.z = pk2(hi[0], hi[1]); w.w = pk2(hi[2], hi[3]); return __builtin_bit_cast(bf16x8, w);
}
__device__ __forceinline__ float silu_f(float x) { return x / (1.0f + expf(-x)); }
#ifdef __HIP_EMU__
__device__ __forceinline__ float silu_fast(float x) { return x / (1.0f + expf(-x)); }
#else
__device__ __forceinline__ float silu_fast(float x) { return x * __builtin_amdgcn_rcpf(1.0f + __builtin_amdgcn_exp2f(-LOG2E * x)); }
#endif
__device__ __forceinline__ float wave_sum(float v) {
#pragma unroll
    for (int o = 1; o < 64; o <<= 1) v += __shfl_xor(v, o);
    return v;
}
__device__ __forceinline__ float wave_max(float v) {
#pragma unroll
    for (int o = 1; o < 64; o <<= 1) v = fmaxf(v, __shfl_xor(v, o));
    return v;
}

struct P {
    const float *x_prompt, *x_sample, *cache_k, *cache_v, *state_ret, *state_gdn, *state_conv, *c_prompt, *c_sample, *ada_w, *ada_b, *norm_mix, *norm_ffn,
        *w_in, *ret_norm, *conv_w, *a_log, *dt_bias, *gdn_norm, *w_out, *w_gate, *w_up, *w_down, *final_norm;
    float* out; unsigned char* ws;
};

constexpr size_t O_YP = 0, O_YS = O_YP + (size_t)MP * D, O_PWK = O_YS + (size_t)MS * D, O_PWV = O_PWK + (size_t)NL * PB * PWIN * 256,
                 O_PRET = O_PWV + (size_t)NL * PB * PWIN * 256, O_PGDN = O_PRET + (size_t)NL * PB * 4 * 4096, O_PCONV = O_PGDN + (size_t)NL * PB * 4 * 16384,
                 O_SWK = O_PCONV + (size_t)NL * PB * 3 * 1536, O_SWV = O_SWK + (size_t)NL * DB * DS * 256, O_SRET = O_SWV + (size_t)NL * DB * DS * 256,
                 O_SGDN = O_SRET + (size_t)NL * DB * 4 * 4096, O_SCONV = O_SGDN + (size_t)NL * DB * 4 * 16384, O_END = O_SCONV + (size_t)NL * DB * 3 * 1536;

constexpr size_t al256(size_t x) { return (x + 255) / 256 * 256; }
constexpr size_t WS_CTL = 0, WS_CTL_BYTES = 1u << 20;
constexpr size_t WS_MOD = WS_CTL + WS_CTL_BYTES;
constexpr size_t WS_W8 = al256(WS_MOD + (size_t)NL * NC * 6144 * 4);
constexpr size_t WS_ROPE = al256(WS_W8 + (size_t)NL * D * 8 * 4);
constexpr size_t WS_WIN = al256(WS_ROPE + (size_t)4 * NPOS * 32 * 4);
constexpr size_t WS_WOUT = al256(WS_WIN + (size_t)NL * NPROJ * D * 2);
constexpr size_t WS_WGU = al256(WS_WOUT + (size_t)NL * D * D * 2);
constexpr size_t WS_WDN = al256(WS_WGU + (size_t)NL * 2 * FF * D * 2);
constexpr size_t WS_H = al256(WS_WDN + (size_t)NL * D * FF * 2);
constexpr size_t WS_PROJ = al256(WS_H + (size_t)MPAD * D * 2);
constexpr size_t WS_BETA = al256(WS_PROJ + (size_t)MPAD * NPROJ * 2);
constexpr size_t WS_G = al256(WS_BETA + (size_t)M * 4 * 4);
constexpr size_t WS_O = al256(WS_G + (size_t)M * 4 * 4);
constexpr size_t WS_RU = al256(WS_O + (size_t)MPAD * D * 2);
constexpr size_t WS_RS = al256(WS_RU + (size_t)NUNIT * 4096 * 4);
constexpr size_t WS_SCR = al256(WS_RS + (size_t)NUNIT * 4096 * 4);
constexpr size_t WS_GU = WS_SCR;
constexpr size_t WS_GWK = al256(WS_GU + (size_t)NUNIT * 8192 * 2);
constexpr size_t WS_GQ = al256(WS_GWK + (size_t)NUNIT * 16384 * 2);
constexpr size_t WS_GA = al256(WS_GQ + (size_t)NUNIT * 8192 * 2);
constexpr size_t WS_GD = al256(WS_GA + (size_t)NUNIT * 4096 * 2);
constexpr size_t WS_GV = al256(WS_GD + (size_t)NUNIT * 4);
constexpr size_t WS_GS = al256(WS_GV + (size_t)NUNIT * 8192 * 2);
constexpr size_t WS_GEND = al256(WS_GS + (size_t)NUNIT * 16384 * 2);
constexpr size_t ATT_CLS = (size_t)PB * 4 * (T / 32) * 2048;
constexpr size_t WS_KF = WS_GEND;
constexpr size_t WS_VF = al256(WS_KF + 3 * ATT_CLS * 2);
constexpr size_t WS_KRT = al256(WS_VF + 3 * ATT_CLS * 2);
constexpr size_t WS_VRT = al256(WS_KRT + (size_t)MP * 256 * 2);
constexpr size_t WS_AML = al256(WS_VRT + (size_t)MP * 256 * 2);
constexpr size_t WS_AEND = al256(WS_AML + (size_t)MP * 4 * 3 * 2 * 4);
constexpr size_t WS_APO = WS_H;
static_assert((size_t)MP * 4 * 3 * 64 * 2 <= (size_t)MPAD * D * 2, "attention partials overlay H");
constexpr size_t WS_HID = WS_SCR;
constexpr size_t WS_HEND = al256(WS_HID + (size_t)MPAD * FF * 2);
constexpr size_t WS_END = WS_AEND > WS_HEND ? WS_AEND : WS_HEND;

#define WSP(T_, off) ((T_*)(p.ws + (off)))
__device__ __forceinline__ int row_cb(int r) { return r < MP ? r / T : PB + (r - MP) / DS; }
__device__ __forceinline__ int row_pi(int r) { return r < MP ? r % T : T + (r - MP) % DS; }
namespace pg8 {
#ifdef __HIP_EMU__
#define PG8_LAS
#else
#define PG8_LAS __attribute__((address_space(3)))
#endif
typedef unsigned short bf16_t;
typedef short bf16x8 __attribute__((ext_vector_type(8)));
typedef float f32x4 __attribute__((ext_vector_type(4)));
typedef unsigned u32x4 __attribute__((ext_vector_type(4)));
constexpr int BM = 256, BK = 64, HALF = 128, HTB = HALF * BK * 2  , STAGE_BYTES = 8 * HTB, NXCD = 8, WGM = 8;

__host__ __device__ __forceinline__ int lds_byte(int r, int c) { const int st = (r >> 4) * 2 + (c >> 5), rr = r & 15, cc = c & 31, ob = rr * 64 + cc * 2; return st * 1024 + (ob ^ (((ob >> 9) & 1) << 5)); }
__host__ __device__ __forceinline__ void stage_rc(int b, int& R, int& C) { const int st = b / 1024, sb = b % 1024, swz = sb ^ (((sb >> 9) & 1) << 5); R = (st >> 1) * 16 + swz / 64; C = (st & 1) * 32 + (swz % 64) / 2; }
__host__ __device__ __forceinline__ int perm32(int rho) { const int n = rho >> 4, i = rho & 15; return 8 * (i >> 2) + 4 * n + (i & 3); }

struct Unit { int pm, pn; };
struct Gemm { const bf16_t* A; const bf16_t* Bt; int M, N, K; };

struct StaticOrder {
    int nM, nN, nwg, G, c;
    __host__ __device__ void init(int M, int N, int G_, int c_) { nM = M / BM; nN = N / BM; nwg = nM * nN; G = G_; c = c_; }
    __host__ __device__ bool next(int i, Unit& u) const {
        const long L = (long)i * G + c; if (L >= nwg) return false;
        int wgid = (int)L; { const int q = nwg / NXCD, r = nwg % NXCD, xcd = wgid % NXCD, off = wgid / NXCD; wgid = (xcd < r ? xcd * (q + 1) : r * (q + 1) + (xcd - r) * q) + off; }
        const int nig = WGM * nN, gid = wgid / nig, fm = gid * WGM, gsz = (nM - fm) < WGM ? (nM - fm) : WGM;
        u.pm = fm + ((wgid % nig) % gsz); u.pn = (wgid % nig) / gsz; return true;
    }
    __device__ __forceinline__ void a_ready(const Unit&) const {}
    __device__ __forceinline__ void done(const Unit&) const {}
};


struct EpiStoreBf16 {
    static constexpr bool PERM = true, AFTER_DRAIN = false;
    bf16_t* O; int ldc;
    __device__ __forceinline__ void operator()(const f32x4 (&acc)[2][2][4][2], const Unit& u, int wr, int wc, int fr, int fq) const {
        const int row0 = u.pm * BM + wr * 64 + fr, col0 = u.pn * BM + wc * 32 + 8 * fq;
#pragma unroll
        for (int ai = 0; ai < 2; ++ai)
#pragma unroll
            for (int m = 0; m < 4; ++m) { bf16_t* rowp = O + (size_t)(row0 + ai * HALF + m * 16) * ldc + col0;
#pragma unroll
                for (int bj = 0; bj < 2; ++bj) { const f32x4 v0 = acc[ai][bj][m][0], v1 = acc[ai][bj][m][1];
                    u32x4 w; w.x = ::pk2(v0[0], v0[1]); w.y = ::pk2(v0[2], v0[3]); w.z = ::pk2(v1[0], v1[1]); w.w = ::pk2(v1[2], v1[3]);
                    *(u32x4*)(rowp + bj * HALF) = w; } }
    }
};
struct EpiResidual {
    static constexpr bool PERM = false, AFTER_DRAIN = false;
    float* X; const float* gate; const float* Xin;
    __device__ __forceinline__ void operator()(const f32x4 (&acc)[2][2][4][2], const Unit& u, int wr, int wc, int fr, int fq) const {
        const int row0 = u.pm * BM + wr * 64 + fr, col0 = u.pn * BM + wc * 32 + 4 * fq;
#pragma unroll
        for (int ai = 0; ai < 2; ++ai)
#pragma unroll
            for (int m = 0; m < 4; ++m) { const int row = row0 + ai * HALF + m * 16;
                if (MPAD != M && row >= M) continue;
                const float* g = gate + (size_t)::row_cb(row) * 6144 + col0; float* xp = X + (size_t)row * D + col0; const float* xi = Xin + (size_t)row * D + col0;
#pragma unroll
                for (int bj = 0; bj < 2; ++bj)
#pragma unroll
                    for (int n = 0; n < 2; ++n) { const f32x4 gv = *(const f32x4*)(g + bj * HALF + n * 16); f32x4* xq = (f32x4*)(xp + bj * HALF + n * 16); *xq = *(const f32x4*)(xi + bj * HALF + n * 16) + gv * acc[ai][bj][m][n]; } }
    }
};
struct EpiSwiglu {
    static constexpr bool PERM = true, AFTER_DRAIN = false;
    bf16_t* Hd;
    __device__ __forceinline__ void operator()(const f32x4 (&acc)[2][2][4][2], const Unit& u, int wr, int wc, int fr, int fq) const {
        const int row0 = u.pm * BM + wr * 64 + fr, col0 = u.pn * HALF + wc * 32 + 8 * fq;
#pragma unroll
        for (int ai = 0; ai < 2; ++ai)
#pragma unroll
            for (int m = 0; m < 4; ++m) { bf16_t* rowp = Hd + (size_t)(row0 + ai * HALF + m * 16) * FF + col0;
                float v[8];
#pragma unroll
                for (int n = 0; n < 2; ++n)
#pragma unroll
                    for (int j = 0; j < 4; ++j) { const float gt = acc[ai][0][m][n][j], up = acc[ai][1][m][n][j]; v[4 * n + j] = ::silu_fast(gt) * up; }
                u32x4 w; w.x = ::pk2(v[0], v[1]); w.y = ::pk2(v[2], v[3]); w.z = ::pk2(v[4], v[5]); w.w = ::pk2(v[6], v[7]);
                *(u32x4*)rowp = w; }
    }
};

#ifdef __HIP_EMU__
template <class Epi, class Sched, bool ALIGN_EPI = false, bool SP2 = false>
__device__ __forceinline__ void gemm_phase(unsigned char* lds, const Gemm g, const Sched& S, const Epi& E) {
    const int tid = threadIdx.x, wid = tid >> 6, lane = tid & 63, wr = wid >> 2, wc = wid & 3, fr = lane & 15, fq = lane >> 4;
    Unit cur;
    for (int ui = 0; S.next(ui, cur); ++ui) {
        f32x4 acc[2][2][4][2];
        for (int ai = 0; ai < 2; ++ai) for (int bj = 0; bj < 2; ++bj) for (int m = 0; m < 4; ++m) for (int n = 0; n < 2; ++n) for (int j = 0; j < 4; ++j) {
            const int row = 256 * cur.pm + 128 * ai + 64 * wr + 16 * m + fr;
            const int col = Epi::PERM ? 256 * cur.pn + 128 * bj + 32 * wc + 8 * fq + 4 * n + j : 256 * cur.pn + 128 * bj + 32 * wc + 16 * n + 4 * fq + j;
            const bf16_t* a = g.A + (size_t)row * g.K; const bf16_t* b = g.Bt + (size_t)col * g.K; float s = 0.f;
            for (int k = 0; k < g.K; ++k) s += ::bf2f(a[k]) * ::bf2f(b[k]);
            acc[ai][bj][m][n][j] = s; }
        E(acc, cur, wr, wc, fr, fq);
    }
}
#else
template <class Epi, class Sched, bool ALIGN_EPI = false, bool SP2 = false>
__device__ __forceinline__ void gemm_phase(PG8_LAS unsigned char* lds, const Gemm g, const Sched& S, const Epi& E) {
    const int tid = ::tidx(), wid = __builtin_amdgcn_readfirstlane(tid >> 6), lane = tid & 63, wr = wid >> 2, wc = wid & 3, fr = lane & 15, fq = lane >> 4;
    const int K = g.K, nt = K / BK;
    unsigned voffA[2], voffB[2];
#pragma unroll
    for (int i = 0; i < 2; ++i) { int R, C; stage_rc(tid * 16 + i * 8192, R, C); const int Rb = Epi::PERM ? ((R & ~31) + perm32(R & 31)) : R;
        voffA[i] = (unsigned)(R * K + C) * 2u; voffB[i] = (unsigned)(Rb * K + C) * 2u; }
    const size_t kstep = (size_t)(BK * 2);
    const size_t hstep = (size_t)HALF * K * 2;
    const size_t tstep = 2 * hstep;
    const unsigned ldsw = (unsigned)wid * 1024u;
    const int aoff = lds_byte(wr * 64 + fr, fq * 8), boff = lds_byte(wc * 32 + fr, fq * 8);
#define PG8_SA(b, h) (((b) * 2 + (h)) * HTB)
#define PG8_SB(b, h) ((4 + (b) * 2 + (h)) * HTB)
#define PG8_STAGE(bufoff, gbase, voff) do { _Pragma("unroll") for (int _i = 0; _i < 2; ++_i) \
        __builtin_amdgcn_global_load_lds((const unsigned*)((const char*)(gbase) + (voff)[_i]), (PG8_LAS unsigned*)(lds + (bufoff) + ldsw + _i * 8192), 16, 0, 0); } while (0)
#define PG8_LDA(dst, b, h) do { _Pragma("unroll") for (int m = 0; m < 4; ++m) _Pragma("unroll") for (int k = 0; k < 2; ++k) dst[m][k] = *(const PG8_LAS bf16x8*)(lds + PG8_SA(b, h) + aoff + m * 2048 + k * 1024); } while (0)
#define PG8_LDB(dst, b, h) do { _Pragma("unroll") for (int n = 0; n < 2; ++n) _Pragma("unroll") for (int k = 0; k < 2; ++k) dst[n][k] = *(const PG8_LAS bf16x8*)(lds + PG8_SB(b, h) + boff + n * 2048 + k * 1024); } while (0)
#define PG8_MMA(ai, bj, At, Bt) do { __builtin_amdgcn_s_setprio(1); _Pragma("unroll") for (int m = 0; m < 4; ++m) _Pragma("unroll") for (int n = 0; n < 2; ++n) _Pragma("unroll") for (int k = 0; k < 2; ++k) \
        acc[ai][bj][m][n] = __builtin_amdgcn_mfma_f32_16x16x32_bf16(Bt[n][k], At[m][k], acc[ai][bj][m][n], 0, 0, 0); __builtin_amdgcn_s_setprio(0); } while (0)
#define PG8_WAIT_V(n) asm volatile("s_waitcnt vmcnt(" #n ")" ::: "memory")
#define PG8_WAIT_L(n) asm volatile("s_waitcnt lgkmcnt(" #n ")" ::: "memory")
#define PG8_BAR __builtin_amdgcn_s_barrier()
#define PG8_SCHED __builtin_amdgcn_sched_barrier(0)
    Unit cur, nxt; int ui = 0;
    if (!S.next(0, cur)) return;
    f32x4 acc[2][2][4][2];
#pragma unroll
    for (int a = 0; a < 2; ++a)
#pragma unroll
        for (int b = 0; b < 2; ++b)
#pragma unroll
            for (int m = 0; m < 4; ++m)
#pragma unroll
                for (int n = 0; n < 2; ++n) acc[a][b][m][n] = (f32x4){0.f, 0.f, 0.f, 0.f};
    bf16x8 At[4][2], B0[2][2], B1[2][2];
    const char* cA = (const char*)g.A + (size_t)cur.pm * tstep; const char* cB = (const char*)g.Bt + (size_t)cur.pn * tstep;
    S.a_ready(cur);
    if constexpr (SP2) {
        PG8_STAGE(PG8_SB(0, 0), cB, voffB); PG8_STAGE(PG8_SB(0, 1), cB + hstep, voffB); PG8_STAGE(PG8_SA(0, 0), cA, voffA); PG8_STAGE(PG8_SA(0, 1), cA + hstep, voffA);
        if (wr == 1) PG8_BAR;
        PG8_WAIT_V(2); PG8_BAR;
        PG8_STAGE(PG8_SB(1, 0), cB + kstep, voffB); PG8_STAGE(PG8_SA(1, 0), cA + kstep, voffA); PG8_STAGE(PG8_SB(1, 1), cB + hstep + kstep, voffB);
        PG8_WAIT_V(6); PG8_BAR;
    } else {
        PG8_STAGE(PG8_SB(0, 0), cB, voffB); PG8_STAGE(PG8_SA(0, 0), cA, voffA); PG8_STAGE(PG8_SB(0, 1), cB + hstep, voffB); PG8_STAGE(PG8_SA(0, 1), cA + hstep, voffA);
        if (wr == 1) PG8_BAR;
        PG8_WAIT_V(4); PG8_BAR;
        PG8_STAGE(PG8_SB(1, 0), cB + kstep, voffB); PG8_STAGE(PG8_SA(1, 0), cA + kstep, voffA); PG8_STAGE(PG8_SB(1, 1), cB + hstep + kstep, voffB);
        PG8_WAIT_V(6); PG8_BAR;
    }
    for (;;) {
        const bool has_next = S.next(ui + 1, nxt);
        const char* nA = has_next ? (const char*)g.A + (size_t)nxt.pm * tstep : cA; const char* nB = has_next ? (const char*)g.Bt + (size_t)nxt.pn * tstep : cB;
        for (int t = 0; t < nt; t += 2) {
            const bool last = (t == nt - 2);
            const char* a1 = cA + (size_t)(t + 1) * kstep;
            const char* a2 = last ? nA : cA + (size_t)(t + 2) * kstep; const char* b2 = last ? nB : cB + (size_t)(t + 2) * kstep;
            const char* a3 = a2 + kstep; const char* b3 = b2 + kstep;
            if (last && has_next) S.a_ready(nxt);
            if constexpr (SP2) {
            PG8_LDB(B0, 0, 0); PG8_LDB(B1, 0, 1); PG8_SCHED; PG8_LDA(At, 0, 0); PG8_STAGE(PG8_SA(1, 1), a1 + hstep, voffA);
            PG8_WAIT_V(8); PG8_WAIT_L(0); PG8_BAR; PG8_MMA(0, 0, At, B0); PG8_MMA(0, 1, At, B1); PG8_BAR; PG8_SCHED;
            PG8_LDA(At, 0, 1); PG8_STAGE(PG8_SB(0, 0), b2, voffB); PG8_STAGE(PG8_SB(0, 1), b2 + hstep, voffB); PG8_STAGE(PG8_SA(0, 0), a2, voffA);
            PG8_WAIT_V(8); PG8_WAIT_L(0); PG8_BAR; PG8_MMA(1, 0, At, B0); PG8_MMA(1, 1, At, B1); PG8_BAR; PG8_SCHED;
            PG8_LDB(B0, 1, 0); PG8_LDB(B1, 1, 1); PG8_SCHED; PG8_LDA(At, 1, 0); PG8_STAGE(PG8_SA(0, 1), a2 + hstep, voffA);
            PG8_WAIT_V(8); PG8_WAIT_L(0); PG8_BAR; PG8_MMA(0, 0, At, B0); PG8_MMA(0, 1, At, B1); PG8_BAR; PG8_SCHED;
            PG8_LDA(At, 1, 1); PG8_STAGE(PG8_SB(1, 0), b3, voffB); PG8_STAGE(PG8_SB(1, 1), b3 + hstep, voffB); PG8_STAGE(PG8_SA(1, 0), a3, voffA);
            PG8_WAIT_V(8); PG8_WAIT_L(0); PG8_BAR; PG8_MMA(1, 0, At, B0); PG8_MMA(1, 1, At, B1); PG8_BAR; PG8_SCHED;
            } else {
            PG8_LDB(B0, 0, 0); PG8_SCHED; PG8_LDA(At, 0, 0); PG8_STAGE(PG8_SA(1, 1), a1 + hstep, voffA);
            PG8_WAIT_L(8); PG8_BAR; PG8_WAIT_L(0); PG8_MMA(0, 0, At, B0); PG8_BAR; PG8_SCHED;
            PG8_LDB(B1, 0, 1); PG8_STAGE(PG8_SB(0, 0), b2, voffB);
            PG8_BAR; PG8_WAIT_L(0); PG8_MMA(0, 1, At, B1); PG8_BAR;
            PG8_LDA(At, 0, 1); PG8_STAGE(PG8_SA(0, 0), a2, voffA);
            PG8_BAR; PG8_WAIT_L(0); PG8_MMA(1, 0, At, B0); PG8_BAR; PG8_SCHED;
            PG8_STAGE(PG8_SB(0, 1), b2 + hstep, voffB);
            PG8_WAIT_V(6); PG8_BAR; PG8_MMA(1, 1, At, B1); PG8_BAR;
            PG8_LDB(B0, 1, 0); PG8_SCHED; PG8_LDA(At, 1, 0); PG8_STAGE(PG8_SA(0, 1), a2 + hstep, voffA);
            PG8_WAIT_L(8); PG8_BAR; PG8_WAIT_L(0); PG8_MMA(0, 0, At, B0); PG8_BAR; PG8_SCHED;
            PG8_LDB(B1, 1, 1); PG8_STAGE(PG8_SB(1, 0), b3, voffB);
            PG8_BAR; PG8_WAIT_L(0); PG8_MMA(0, 1, At, B1); PG8_BAR;
            PG8_LDA(At, 1, 1); PG8_STAGE(PG8_SA(1, 0), a3, voffA);
            PG8_BAR; PG8_WAIT_L(0); PG8_MMA(1, 0, At, B0); PG8_BAR; PG8_SCHED;
            PG8_STAGE(PG8_SB(1, 1), b3 + hstep, voffB);
            PG8_WAIT_V(6); PG8_BAR; PG8_MMA(1, 1, At, B1); PG8_BAR;
            }
        }
        if constexpr (ALIGN_EPI) { if (wr == 0) PG8_BAR; }
        if constexpr (!Epi::AFTER_DRAIN) { E(acc, cur, wr, wc, fr, fq); S.done(cur); }
        if (!has_next) break;
#pragma unroll
        for (int a = 0; a < 2; ++a)
#pragma unroll
            for (int b = 0; b < 2; ++b)
#pragma unroll
                for (int m = 0; m < 4; ++m)
#pragma unroll
                    for (int n = 0; n < 2; ++n) acc[a][b][m][n] = (f32x4){0.f, 0.f, 0.f, 0.f};
        cur = nxt; cA = nA; cB = nB; ++ui;
        if constexpr (ALIGN_EPI) { if (wr == 1) PG8_BAR; }
    }
    PG8_WAIT_V(0);
    if constexpr (!ALIGN_EPI) { if (wr == 0) PG8_BAR; }
    PG8_BAR;
    if constexpr (Epi::AFTER_DRAIN) { E.fused(acc, cur, wr, wc, fr, fq, lds, wid, lane); S.done(cur); }
#undef PG8_SA
#undef PG8_SB
#undef PG8_STAGE
#undef PG8_LDA
#undef PG8_LDB
#undef PG8_MMA
#undef PG8_WAIT_V
#undef PG8_WAIT_L
#undef PG8_BAR
#undef PG8_SCHED
}
#endif
}


__device__ __forceinline__ void transpose_item(const float* W, int ldw, bf16_t* WT, int K, int k0, int n0, int drow0, float* scr, int lane) {
    float wv[32];
#pragma unroll
    for (int i = 0; i < 32; ++i) wv[i] = W[(size_t)(k0 + 2 * i + (lane >> 5)) * ldw + n0 + (lane & 31)];
#pragma unroll
    for (int i = 0; i < 32; ++i) scr[(2 * i + (lane >> 5)) * 33 + (lane & 31)] = wv[i];
    WAVE_SYNC();
    const int c = lane & 7;
#pragma unroll
    for (int j = 0; j < 4; ++j) { const int n = (lane >> 3) + 8 * j; const float* s = scr + (8 * c) * 33 + n;
        u32x4 o; o.x = pk2(s[0 * 33], s[1 * 33]); o.y = pk2(s[2 * 33], s[3 * 33]); o.z = pk2(s[4 * 33], s[5 * 33]); o.w = pk2(s[6 * 33], s[7 * 33]);
        *(u32x4*)(WT + (size_t)(drow0 + n) * K + k0 + 8 * c) = o; }
    WAVE_SYNC();
}
constexpr int CV_IN = 16 * 120, CV_OUT = 16 * 32, CV_G = 16 * 88, CV_DN = 44 * 32, CV_L = CV_IN + CV_OUT + 2 * CV_G + CV_DN;
__device__ __forceinline__ void ph_convert(const P& p, unsigned char* smem, int i0, int i1, int b0, int b1) {
    if ((int)blockIdx.x < b0 || (int)blockIdx.x >= b1) return;
    const int lane = tidx() & 63, wave = tidx() >> 6;
    float* scr = (float*)smem + wave * (64 * 33 + 32);
    constexpr int I_IN = CV_IN, I_OUT = CV_OUT, I_G = CV_G, I_L = CV_L;
    const int gw = ((int)blockIdx.x - b0) * 8 + wave, ngw = (b1 - b0) * 8;
    for (int it = i0 + gw; it < i1; it += ngw) {
        const int l = it / I_L; int r = it % I_L;
        if (r < I_IN) { const int kb = r / 120, nb = r % 120; transpose_item(p.w_in + (size_t)l * D * INC, INC, WSP(bf16_t, WS_WIN) + (size_t)l * NPROJ * D, D, kb * 64, nb * 32, nb * 32, scr, lane); continue; }
        r -= I_IN;
        if (r < I_OUT) { const int kb = r / 32, nb = r % 32; transpose_item(p.w_out + (size_t)l * D * D, D, WSP(bf16_t, WS_WOUT) + (size_t)l * D * D, D, kb * 64, nb * 32, nb * 32, scr, lane); continue; }
        r -= I_OUT;
        if (r < 2 * I_G) { const int up = r / I_G; r %= I_G; const int kb = r / 88, nb = r % 88, n0 = nb * 32;
            transpose_item((up ? p.w_up : p.w_gate) + (size_t)l * D * FF, FF, WSP(bf16_t, WS_WGU) + (size_t)l * 2 * FF * D, D, kb * 64, n0, (n0 / 128) * 256 + up * 128 + (n0 % 128), scr, lane); continue; }
        r -= 2 * I_G;
        { const int kb = r / 32, nb = r % 32; transpose_item(p.w_down + (size_t)l * FF * D, D, WSP(bf16_t, WS_WDN) + (size_t)l * D * FF, FF, kb * 64, nb * 32, nb * 32, scr, lane); }
    }
}

__device__ __forceinline__ void ph_adaln(const P& p, unsigned char* smem, int l0, int l1, int b0, int b1) {
    if ((int)blockIdx.x < b0 || (int)blockIdx.x >= b1) return;
    float* sc = (float*)smem;
    float* red = sc + NC * 256;
    const int tid = tidx(), col = tid & 31, kg = tid >> 5;
    float* MOD = WSP(float, WS_MOD);
    for (int it = l0 * 192 + (int)blockIdx.x - b0; it < l1 * 192; it += b1 - b0) {
        const int l = it / 192, cb0 = (it % 192) * 32;
        float acc[NC];
#pragma unroll
        for (int r = 0; r < NC; ++r) acc[r] = 0.f;
        for (int kc = 0; kc < 4; ++kc) {
            __syncthreads();
            for (int e = tid; e < NC * 256; e += NTHR) { const int r = e >> 8, k = e & 255; const float c = r < PB ? p.c_prompt[r * D + kc * 256 + k] : p.c_sample[(r - PB) * D + kc * 256 + k]; sc[e] = silu_f(c); }
            __syncthreads();
            for (int kk = 0; kk < 16; ++kk) { const int k = kg * 16 + kk; const float w = p.ada_w[((size_t)l * D + kc * 256 + k) * 6144 + cb0 + col];
#pragma unroll
                for (int r = 0; r < NC; ++r) acc[r] += sc[r * 256 + k] * w; }
        }
#pragma unroll
        for (int r = 0; r < NC; ++r) red[(kg * NC + r) * 32 + col] = acc[r];
        __syncthreads();
        for (int e = tid; e < NC * 32; e += NTHR) { const int r = e >> 5, c = e & 31; float s = p.ada_b[l * 6144 + cb0 + c];
            for (int g = 0; g < 16; ++g) s += red[(g * NC + r) * 32 + c];
            MOD[((size_t)l * NC + r) * 6144 + cb0 + c] = s; }
        __syncthreads();
    }
}

__device__ __forceinline__ void ph_ropetab_copyx(const P& p) {
    const size_t gt = (size_t)blockIdx.x * NTHR + tidx(), ng = (size_t)gridDim.x * NTHR;
    float* tab = WSP(float, WS_ROPE);
    for (size_t e = gt; e < (size_t)NL * D * 8; e += ng) { const size_t lk = e >> 3; const int c = (int)(e & 7); WSP(float, WS_W8)[((lk >> 10) * 8 + c) * D + (lk & 1023)] = p.w_in[lk * INC + NPROJ + c]; }
    for (size_t e = gt; e < (size_t)NPOS * 32; e += ng) {
        const int pi = (int)(e >> 5), i = (int)(e & 31); const double pos = pi < T ? (double)pi : (double)(PAST + pi - T);
        const double ia = exp(-log(10000.0) * (double)i / 32.0), ir = exp(-log(10000.0) * (double)i / 31.0);
        tab[e] = (float)cos(pos * ia); tab[(size_t)NPOS * 32 + e] = (float)sin(pos * ia);
        tab[(size_t)2 * NPOS * 32 + e] = (float)cos(pos * ir); tab[(size_t)3 * NPOS * 32 + e] = (float)sin(pos * ir);
    }
}

template <int WHICH> __device__ __forceinline__ void ph_norm_mod(const P& p, int l, unsigned char* smem) {
    const int lane = tidx() & 63, wave = tidx() >> 6, gw = blockIdx.x * 8 + wave, ngw = gridDim.x * 8;
    const float* nw = (WHICH == 0 ? p.norm_mix : p.norm_ffn) + l * D;
    bf16_t* H = WSP(bf16_t, WS_H);
    const float* w8s = (const float*)smem;
    if (WHICH == 0) { __syncthreads();
        for (int e = tidx(); e < 8 * D / 4; e += NTHR) ((f32x4*)smem)[e] = ((const f32x4*)(WSP(float, WS_W8) + (size_t)l * 8 * D))[e];
        __syncthreads(); }
    f32x4 gw4[4];
#pragma unroll
    for (int j = 0; j < 4; ++j) gw4[j] = *(const f32x4*)(nw + 4 * lane + 256 * j);
    for (int r = gw; r < M; r += ngw) {
        const float* xr = (WHICH == 0 && l == 0) ? (r < MP ? p.x_prompt + (size_t)r * D : p.x_sample + (size_t)(r - MP) * D) : p.out + (size_t)r * D;
        const float* mod = WSP(float, WS_MOD) + ((size_t)l * NC + row_cb(r)) * 6144 + (WHICH == 0 ? 0 : 3072);
        f32x4 v[4]; float ss = 0.f;
#pragma unroll
        for (int j = 0; j < 4; ++j) { v[j] = *(const f32x4*)(xr + 4 * lane + 256 * j); ss += (v[j][0] * v[j][0] + v[j][1] * v[j][1]) + (v[j][2] * v[j][2] + v[j][3] * v[j][3]); }
        const float rstd = 1.0f / sqrtf(wave_sum(ss) * (1.0f / D) + EPS);
        float a8[8];
#pragma unroll
        for (int c = 0; c < 8; ++c) a8[c] = 0.f;
#pragma unroll
        for (int j = 0; j < 4; ++j) { const int k = 4 * lane + 256 * j;
            const f32x4 g = gw4[j], sh = *(const f32x4*)(mod + k), sc = *(const f32x4*)(mod + 1024 + k);
            f32x4 h;
#pragma unroll
            for (int e = 0; e < 4; ++e) h[e] = v[j][e] * rstd * g[e] * (1.0f + sc[e]) + sh[e];
            u32x2 w; w.x = pk2(h[0], h[1]); w.y = pk2(h[2], h[3]); *(u32x2*)(H + (size_t)r * D + k) = w;
            if (WHICH == 0) {
#pragma unroll
                for (int c = 0; c < 8; ++c) { const f32x4 wv = *(const f32x4*)(w8s + c * D + k); a8[c] += (h[0] * wv[0] + h[1] * wv[1]) + (h[2] * wv[2] + h[3] * wv[3]); }
            }
        }
        if (WHICH == 0) {
            float b4[4];
#pragma unroll
            for (int c = 0; c < 4; ++c) { const float keep = lane < 32 ? a8[c] : a8[4 + c], send = lane < 32 ? a8[4 + c] : a8[c]; b4[c] = keep + __shfl_xor(send, 32); }
            float b2[2];
#pragma unroll
            for (int c = 0; c < 2; ++c) { const bool lo = (lane & 16) == 0; const float keep = lo ? b4[c] : b4[2 + c], send = lo ? b4[2 + c] : b4[c]; b2[c] = keep + __shfl_xor(send, 16); }
            float b1; { const bool lo = (lane & 8) == 0; const float keep = lo ? b2[0] : b2[1], send = lo ? b2[1] : b2[0]; b1 = keep + __shfl_xor(send, 8); }
            b1 += __shfl_xor(b1, 4); b1 += __shfl_xor(b1, 2); b1 += __shfl_xor(b1, 1);
            if ((lane & 7) == 0) { const int c = (lane >> 5) * 4 + ((lane >> 4) & 1) * 2 + ((lane >> 3) & 1);
                if (c < 4) WSP(float, WS_BETA)[(size_t)r * 4 + c] = 1.0f / (1.0f + expf(-b1));
                else { const int hh = c - 4; const float xx = b1 + p.dt_bias[l * 4 + hh]; const float sp = xx > 20.f ? xx : log1pf(expf(xx)); WSP(float, WS_G)[(size_t)r * 4 + hh] = -expf(p.a_log[l * 4 + hh]) * sp; } }
        }
    }
}

__device__ __forceinline__ void unpack8(const u32x4 w, float (&f)[8]) {
    f[0] = __builtin_bit_cast(float, w.x << 16); f[1] = __builtin_bit_cast(float, w.x & 0xffff0000u); f[2] = __builtin_bit_cast(float, w.y << 16); f[3] = __builtin_bit_cast(float, w.y & 0xffff0000u);
    f[4] = __builtin_bit_cast(float, w.z << 16); f[5] = __builtin_bit_cast(float, w.z & 0xffff0000u); f[6] = __builtin_bit_cast(float, w.w << 16); f[7] = __builtin_bit_cast(float, w.w & 0xffff0000u);
}
__device__ __forceinline__ u32x4 pack8f(const float (&f)[8]) { u32x4 w; w.x = pk2(f[0], f[1]); w.y = pk2(f[2], f[3]); w.z = pk2(f[4], f[5]); w.w = pk2(f[6], f[7]); return w; }
__device__ __forceinline__ void ph_rope_out(const P& p, int l) {
    const size_t gt = (size_t)blockIdx.x * NTHR + tidx(), ng = (size_t)gridDim.x * NTHR;
    bf16_t* PR = WSP(bf16_t, WS_PROJ); const float* tab = WSP(float, WS_ROPE);
    for (size_t e = gt; e < (size_t)MS * 64; e += ng) {
        const int r = MP + (int)(e >> 6), rem = (int)(e & 63), sec = rem >> 4, hh = (rem >> 2) & 3, d = (rem & 3) * 8;
        const int off = sec == 0 ? C_QA : sec == 1 ? C_KA : sec == 2 ? C_QR : C_KR; const float scale = sec == 0 ? 0.125f * LOG2E : sec == 3 ? 0.125f : 1.0f;
        const float* ct = tab + (size_t)(sec >= 2 ? 2 : 0) * NPOS * 32 + (size_t)row_pi(r) * 32 + d; const float* st = ct + (size_t)NPOS * 32;
        const f32x4 c0 = *(const f32x4*)ct, c1 = *(const f32x4*)(ct + 4), s0 = *(const f32x4*)st, s1 = *(const f32x4*)(st + 4);
        bf16_t* x = PR + (size_t)r * NPROJ + off + hh * 64 + d; float x1[8], x2[8], o1[8], o2[8];
        unpack8(*(const u32x4*)x, x1); unpack8(*(const u32x4*)(x + 32), x2);
#pragma unroll
        for (int k = 0; k < 8; ++k) { const float c = k < 4 ? c0[k & 3] : c1[k & 3], sn = k < 4 ? s0[k & 3] : s1[k & 3]; o1[k] = (x1[k] * c - x2[k] * sn) * scale; o2[k] = (x1[k] * sn + x2[k] * c) * scale; }
        *(u32x4*)x = pack8f(o1); *(u32x4*)(x + 32) = pack8f(o2);
        if (sec == 1) { const int b = (r - MP) / DS, i = (r - MP) % DS; float* o = p.out + O_SWK + (((size_t)l * DB + b) * DS + i) * 256 + hh * 64 + d;
            *(f32x4*)o = (f32x4){o1[0], o1[1], o1[2], o1[3]}; *(f32x4*)(o + 4) = (f32x4){o1[4], o1[5], o1[6], o1[7]}; *(f32x4*)(o + 32) = (f32x4){o2[0], o2[1], o2[2], o2[3]}; *(f32x4*)(o + 36) = (f32x4){o2[4], o2[5], o2[6], o2[7]}; }
    }
    for (size_t e = gt; e < (size_t)MS * 32; e += ng) {
        const int r = MP + (int)(e >> 5), c = (int)(e & 31) * 8; const int b = (r - MP) / DS, i = (r - MP) % DS; float* o = p.out + O_SWV + (((size_t)l * DB + b) * DS + i) * 256 + c;
        float v[8]; unpack8(*(const u32x4*)(PR + (size_t)r * NPROJ + C_VA + c), v); *(f32x4*)o = (f32x4){v[0], v[1], v[2], v[3]}; *(f32x4*)(o + 4) = (f32x4){v[4], v[5], v[6], v[7]};
    }
    for (size_t e = gt; e < (size_t)(PB + DB) * 3 * 1536; e += ng) {
        const int c = (int)(e % 1536), j = (int)((e / 1536) % 3), bb = (int)(e / (3 * 1536));
        if (bb < PB) p.out[O_PCONV + (((size_t)l * PB + bb) * 3 + j) * 1536 + c] = bf2f(PR[(size_t)(bb * T + T - 3 + j) * NPROJ + C_CONV + c]);
        else { const int b = bb - PB; p.out[O_SCONV + (((size_t)l * DB + b) * 3 + j) * 1536 + c] = bf2f(PR[(size_t)(MP + b * DS + DS - 3 + j) * NPROJ + C_CONV + c]); }
    }
}

__device__ __forceinline__ void attn_wave_sample(const P& p, int l, int r, int h, int lane, float* sw  ) {
    const bf16_t* PR = WSP(bf16_t, WS_PROJ);
    const int b = (r - MP) / DS; const int tq = WB + (r - MP) % DS;
    const int kg = lane >> 4, dq = lane & 15;
    f32x4 q4; { const u32x2 w = *(const u32x2*)(PR + (size_t)r * NPROJ + C_QA + h * 64 + 4 * dq); q4 = (f32x4){bf2f((bf16_t)(w.x & 0xffff)), bf2f((bf16_t)(w.x >> 16)), bf2f((bf16_t)(w.y & 0xffff)), bf2f((bf16_t)(w.y >> 16))}; }
    float mx = -INFINITY;
#pragma unroll 8
    for (int e = kg; e < 388; e += 4) {
        const int ee = e < 387 ? e : 386; const int pat = ee / 129, j = ee % 129, dil = pat == 0 ? 1 : pat == 1 ? 4 : 16; const int rr = tq - dil * j;
        f32x4 kv;
        if (rr < WB) kv = *(const f32x4*)(p.cache_k + ((((size_t)l * DB + b) * WB + rr) * 4 + h) * 64 + 4 * dq);
        else { const u32x2 w = *(const u32x2*)(PR + (size_t)(MP + b * DS + (rr - WB)) * NPROJ + C_KA + h * 64 + 4 * dq);
            kv = (f32x4){bf2f((bf16_t)(w.x & 0xffff)), bf2f((bf16_t)(w.x >> 16)), bf2f((bf16_t)(w.y & 0xffff)), bf2f((bf16_t)(w.y >> 16))}; }
        float a = (q4[0] * kv[0] + q4[1] * kv[1]) + (q4[2] * kv[2] + q4[3] * kv[3]);
        a += __shfl_xor(a, 1); a += __shfl_xor(a, 2); a += __shfl_xor(a, 4); a += __shfl_xor(a, 8);
        if (e < 387) { if (dq == 0) sw[e] = a; mx = fmaxf(mx, a); }
    }
    WAVE_SYNC();
    mx = wave_max(mx);
    float lsum = 0.f;
#pragma unroll 1
    for (int i = 0; i < 7; ++i) { const int e = lane + 64 * i; if (e < 387) { const float pe = exp2f(sw[e] - mx); sw[e] = pe; lsum += pe; } }
    lsum = wave_sum(lsum);
    WAVE_SYNC();
    f32x4 o4 = (f32x4){0.f, 0.f, 0.f, 0.f};
#pragma unroll 16
    for (int e = kg; e < 387; e += 4) {
        const float pe = sw[e];
        const int pat = e / 129, j = e % 129, dil = pat == 0 ? 1 : pat == 1 ? 4 : 16; const int rr = tq - dil * j;
        f32x4 v;
        if (rr < WB) v = *(const f32x4*)(p.cache_v + ((((size_t)l * DB + b) * WB + rr) * 4 + h) * 64 + 4 * dq);
        else { const u32x2 w = *(const u32x2*)(PR + (size_t)(MP + b * DS + (rr - WB)) * NPROJ + C_VA + h * 64 + 4 * dq);
            v = (f32x4){bf2f((bf16_t)(w.x & 0xffff)), bf2f((bf16_t)(w.x >> 16)), bf2f((bf16_t)(w.y & 0xffff)), bf2f((bf16_t)(w.y >> 16))}; }
        o4 += pe * v;
    }
#pragma unroll
    for (int e = 0; e < 4; ++e) { float x = o4[e]; x += __shfl_xor(x, 16); x += __shfl_xor(x, 32); o4[e] = x; }
    WAVE_SYNC();
    if (kg == 0) { const float inv = 1.0f / lsum; u32x2 w; w.x = pk2(o4[0] * inv, o4[1] * inv); w.y = pk2(o4[2] * inv, o4[3] * inv);
        *(u32x2*)(WSP(bf16_t, WS_O) + (size_t)r * D + h * 64 + 4 * dq) = w; }
}
__device__ __forceinline__ void ph_attn_sample(const P& p, int l, unsigned char* smem) {
    const int lane = tidx() & 63, wave = tidx() >> 6, gw = (gridDim.x - 1 - blockIdx.x) * 8 + wave, ngw = gridDim.x * 8;
    float* sw = (float*)smem + wave * 392;
    for (int it = gw; it < MS * 4; it += ngw) attn_wave_sample(p, l, MP + (it >> 2), it & 3, lane, sw);
}
__device__ __forceinline__ bf16x8 pack8(const f32x16& v, int s8) {
    u32x4 w; w.x = pk2(v[s8], v[s8 + 1]); w.y = pk2(v[s8 + 2], v[s8 + 3]); w.z = pk2(v[s8 + 4], v[s8 + 5]); w.w = pk2(v[s8 + 6], v[s8 + 7]); return __builtin_bit_cast(bf16x8, w);
}
__device__ __forceinline__ void attn_job(const P& p, int jb, int lane) {
    const int c = lane & 31, hi = lane >> 5;
    constexpr int NB = T / 512;
    const int unit = jb / 48, jj = jb % 48, pat = jj >> 4, sub = jj & 15;
    const int blk = unit % NB, h = (unit / NB) & 3, b = unit / (NB * 4), bh = b * 4 + h;
    int dil, r, qi0, cls, tb;
    if (pat == 0) { dil = 1; r = 0; qi0 = blk * 512 + sub * 32; cls = 0; tb = 0; }
    else if (pat == 1) { dil = 4; r = sub >> 2; qi0 = blk * 128 + (sub & 3) * 32; cls = 1; tb = r * (T / 128); }
    else { dil = 16; r = sub; qi0 = blk * 32; cls = 2; tb = r * (T / 512); }
    const bf16_t* KF = WSP(bf16_t, WS_KF) + cls * ATT_CLS + ((size_t)bh * (T / 32) + tb) * 2048 + lane * 8;
    const bf16_t* VF = WSP(bf16_t, WS_VF) + cls * ATT_CLS + ((size_t)bh * (T / 32) + tb) * 2048 + lane * 8;
    const int tq = dil * (qi0 + c) + r;
    const bf16_t* qp = WSP(bf16_t, WS_PROJ) + (size_t)(b * T + tq) * NPROJ + C_QA + h * 64 + 8 * hi;
    bf16x8 qf[4];
#pragma unroll
    for (int ks = 0; ks < 4; ++ks) qf[ks] = *(const bf16x8*)(qp + 16 * ks);
    bf16x8 kf[5][4];
#pragma unroll
    for (int i = 0; i < 5; ++i) { const int kt0 = qi0 - 128 + 32 * i; const bf16_t* kp = KF + (size_t)(kt0 >= 0 ? (kt0 >> 5) : 0) * 2048;
#pragma unroll
        for (int ks = 0; ks < 4; ++ks) kf[i][ks] = *(const bf16x8*)(kp + 512 * ks); }
    f32x16 S[5];
#pragma unroll
    for (int i = 0; i < 5; ++i) {
        const int kt0 = qi0 - 128 + 32 * i;
        f32x16 acc;
#pragma unroll
        for (int e = 0; e < 16; ++e) acc[e] = 0.f;
#pragma unroll
        for (int ks = 0; ks < 4; ++ks) acc = MFMA32(kf[i][ks], qf[ks], acc);
#pragma unroll
        for (int e = 0; e < 16; ++e) { const int krow = (e & 3) + 8 * (e >> 2) + 4 * hi;
            const bool dead = kt0 < 0 || (i == 0 && krow < c) || (i == 4 && krow > c); if (dead) acc[e] = -INFINITY; }
        S[i] = acc;
    }
    float mx = -INFINITY;
#pragma unroll
    for (int i = 0; i < 5; ++i)
#pragma unroll
        for (int e = 0; e < 16; ++e) mx = fmaxf(mx, S[i][e]);
    mx = fmaxf(mx, __shfl_xor(mx, 32));
    float lsum = 0.f;
#pragma unroll
    for (int i = 0; i < 5; ++i)
#pragma unroll
        for (int e = 0; e < 16; ++e) { const float pe = exp2f(S[i][e] - mx); S[i][e] = pe; lsum += pe; }
    lsum += __shfl_xor(lsum, 32);
    bf16x8 pf[5][2];
#pragma unroll
    for (int i = 0; i < 5; ++i) { pf[i][0] = pack8(S[i], 0); pf[i][1] = pack8(S[i], 8); }
    f32x16 O[2];
#pragma unroll
    for (int dt = 0; dt < 2; ++dt)
#pragma unroll
        for (int e = 0; e < 16; ++e) O[dt][e] = 0.f;
#pragma unroll
    for (int i = 0; i < 5; ++i) {
        const int kt0 = qi0 - 128 + 32 * i; const bf16_t* vp = VF + (size_t)(kt0 >= 0 ? (kt0 >> 5) : 0) * 2048;
#pragma unroll
        for (int s2 = 0; s2 < 2; ++s2)
#pragma unroll
            for (int dt = 0; dt < 2; ++dt) O[dt] = MFMA32(*(const bf16x8*)(vp + (dt * 2 + s2) * 512), pf[i][s2], O[dt]);
    }
    const size_t idx = ((size_t)(b * T + tq) * 4 + h) * 3 + pat;
    bf16_t* po = WSP(bf16_t, WS_APO) + idx * 64;
#pragma unroll
    for (int dt = 0; dt < 2; ++dt)
#pragma unroll
        for (int g = 0; g < 4; ++g) { u32x2 w; w.x = pk2(O[dt][4 * g], O[dt][4 * g + 1]); w.y = pk2(O[dt][4 * g + 2], O[dt][4 * g + 3]); *(u32x2*)(po + 32 * dt + 8 * g + 4 * hi) = w; }
    if (hi == 0) { float* ml = WSP(float, WS_AML) + idx * 2; ml[0] = mx; ml[1] = lsum; }
}
__device__ __forceinline__ void ph_attn_jobs(const P& p, int nc, int b1, int r0) {
    const int bid = (int)blockIdx.x; if (bid >= b1) return;
    const int lane = tidx() & 63, wave = tidx() >> 6, nn = (b1 - nc) * 8, ncw = nc * 8; constexpr int NJ = PB * 4 * (T / 512) * 48;
    const bool late = bid < nc; const int wi = late ? bid * 8 + wave : (bid - nc) * 8 + wave;
    for (int r = late ? r0 : 0;; ++r) { const int base = r * nn + (r > r0 ? (r - r0) * ncw : 0); const int jb = base + (late ? nn + wi : wi);
        if (base >= NJ) break;
        if (jb < NJ) attn_job(p, jb, lane); }
}
__device__ __forceinline__ void ph_attn_combine(const P& p) {
    const size_t gt = (size_t)blockIdx.x * NTHR + tidx(), ng = (size_t)gridDim.x * NTHR;
    for (size_t e = gt; e < (size_t)MP * 4 * 16; e += ng) {
        const size_t rh = e >> 4; const int dq = (int)(e & 15) * 4;
        const float* ml = WSP(float, WS_AML) + rh * 6; const float m0 = ml[0], m1 = ml[2], m2 = ml[4];
        const float mm = fmaxf(m0, fmaxf(m1, m2)); const float w0 = exp2f(m0 - mm), w1 = exp2f(m1 - mm), w2 = exp2f(m2 - mm);
        const float inv = 1.0f / (w0 * ml[1] + w1 * ml[3] + w2 * ml[5]);
        const bf16_t* po = WSP(bf16_t, WS_APO) + rh * 192 + dq;
        const u32x2 a = *(const u32x2*)po, bq = *(const u32x2*)(po + 64), cq = *(const u32x2*)(po + 128);
        float o[4];
        o[0] = w0 * bf2f((bf16_t)(a.x & 0xffff)) + w1 * bf2f((bf16_t)(bq.x & 0xffff)) + w2 * bf2f((bf16_t)(cq.x & 0xffff));
        o[1] = w0 * bf2f((bf16_t)(a.x >> 16)) + w1 * bf2f((bf16_t)(bq.x >> 16)) + w2 * bf2f((bf16_t)(cq.x >> 16));
        o[2] = w0 * bf2f((bf16_t)(a.y & 0xffff)) + w1 * bf2f((bf16_t)(bq.y & 0xffff)) + w2 * bf2f((bf16_t)(cq.y & 0xffff));
        o[3] = w0 * bf2f((bf16_t)(a.y >> 16)) + w1 * bf2f((bf16_t)(bq.y >> 16)) + w2 * bf2f((bf16_t)(cq.y >> 16));
        const size_t row = rh >> 2; const int h = (int)(rh & 3);
        u32x2 w; w.x = pk2(o[0] * inv, o[1] * inv); w.y = pk2(o[2] * inv, o[3] * inv);
        *(u32x2*)(WSP(bf16_t, WS_O) + row * D + h * 64 + dq) = w;
    }
}
__device__ __forceinline__ float ret_lg(int h) { return logf(1.0f - exp2f(-5.0f - (float)h)); }
constexpr int TPK = 72, TPT = 65;
__device__ __forceinline__ void trans_write(const bf16_t* tile, bf16_t* dst  , int tile0, int tid) {
#pragma unroll
    for (int k = 0; k < 4; ++k) { const int ch = tid + NTHR * k, d = ch >> 5, t0 = (ch & 31) * 8; u32x4 w;
        w.x = (unsigned)tile[(t0 + 0) * TPT + d] | ((unsigned)tile[(t0 + 1) * TPT + d] << 16); w.y = (unsigned)tile[(t0 + 2) * TPT + d] | ((unsigned)tile[(t0 + 3) * TPT + d] << 16);
        w.z = (unsigned)tile[(t0 + 4) * TPT + d] | ((unsigned)tile[(t0 + 5) * TPT + d] << 16); w.w = (unsigned)tile[(t0 + 6) * TPT + d] | ((unsigned)tile[(t0 + 7) * TPT + d] << 16);
        *(u32x4*)(dst + (size_t)d * T + tile0 + t0) = w; COMPILER_FENCE(); }
}
__device__ __forceinline__ void store8_b16(bf16_t* dst, const u32x4 w) {
    dst[0] = (bf16_t)(w.x & 0xffff); dst[1] = (bf16_t)(w.x >> 16); dst[2] = (bf16_t)(w.y & 0xffff); dst[3] = (bf16_t)(w.y >> 16);
    dst[4] = (bf16_t)(w.z & 0xffff); dst[5] = (bf16_t)(w.z >> 16); dst[6] = (bf16_t)(w.w & 0xffff); dst[7] = (bf16_t)(w.w >> 16);
}
__device__ __forceinline__ void ph_vtrans(const P& p, int l, unsigned char* smem) {
    bf16_t* ka = (bf16_t*)smem; bf16_t* va = ka + 256 * TPK; bf16_t* vr = va + 256 * TPK; bf16_t* kr = vr + 256 * TPT;
    static_assert((2 * 256 * TPK + 2 * 256 * TPT) * 2 <= BAR_LDS_OFF, "transpose unit LDS");
    const int tid = tidx(); bf16_t* PR = WSP(bf16_t, WS_PROJ); const float* tab = WSP(float, WS_ROPE);
    for (int u = blockIdx.x; u < PB * 4 * (T / 256); u += gridDim.x) {
        const int tile = u % (T / 256), bh = u / (T / 256), h = bh & 3, b = bh >> 2; const float lg = ret_lg(h);
        __syncthreads();
#pragma unroll 1
        for (int k = 0; k < 2; ++k) { const int e = tid + NTHR * k, t = e >> 2, d = (e & 3) * 8, tt = tile * 256 + t; bf16_t* row = PR + (size_t)(b * T + tt) * NPROJ + h * 64 + d;
            float x1[8], x2[8], o1[8], o2[8];
            { const float* ct = tab + (size_t)tt * 32 + d; const float* st = ct + (size_t)NPOS * 32;
              const f32x4 c0 = *(const f32x4*)ct, c1 = *(const f32x4*)(ct + 4), s0 = *(const f32x4*)st, s1 = *(const f32x4*)(st + 4);
              unpack8(*(const u32x4*)(row + C_QA), x1); unpack8(*(const u32x4*)(row + C_QA + 32), x2);
#pragma unroll
              for (int i = 0; i < 8; ++i) { const float c = i < 4 ? c0[i & 3] : c1[i & 3], sn = i < 4 ? s0[i & 3] : s1[i & 3]; o1[i] = (x1[i] * c - x2[i] * sn) * (0.125f * LOG2E); o2[i] = (x1[i] * sn + x2[i] * c) * (0.125f * LOG2E); }
              *(u32x4*)(row + C_QA) = pack8f(o1); *(u32x4*)(row + C_QA + 32) = pack8f(o2);
              unpack8(*(const u32x4*)(row + C_KA), x1); unpack8(*(const u32x4*)(row + C_KA + 32), x2);
#pragma unroll
              for (int i = 0; i < 8; ++i) { const float c = i < 4 ? c0[i & 3] : c1[i & 3], sn = i < 4 ? s0[i & 3] : s1[i & 3]; o1[i] = x1[i] * c - x2[i] * sn; o2[i] = x1[i] * sn + x2[i] * c; }
              *(u32x4*)(ka + t * TPK + d) = pack8f(o1); *(u32x4*)(ka + t * TPK + d + 32) = pack8f(o2);
              if (tt >= T - PWIN) { float* o = p.out + O_PWK + (((size_t)l * PB + b) * PWIN + (tt - (T - PWIN))) * 256 + h * 64 + d;
                  *(f32x4*)o = (f32x4){o1[0], o1[1], o1[2], o1[3]}; *(f32x4*)(o + 4) = (f32x4){o1[4], o1[5], o1[6], o1[7]}; *(f32x4*)(o + 32) = (f32x4){o2[0], o2[1], o2[2], o2[3]}; *(f32x4*)(o + 36) = (f32x4){o2[4], o2[5], o2[6], o2[7]}; } }
            COMPILER_FENCE();
            { const float* ct = tab + (size_t)2 * NPOS * 32 + (size_t)tt * 32 + d; const float* st = ct + (size_t)NPOS * 32;
              const f32x4 c0 = *(const f32x4*)ct, c1 = *(const f32x4*)(ct + 4), s0 = *(const f32x4*)st, s1 = *(const f32x4*)(st + 4);
              const float gq = expf(lg * (float)(tt & 63)), gk = 0.125f / gq;
              unpack8(*(const u32x4*)(row + C_QR), x1); unpack8(*(const u32x4*)(row + C_QR + 32), x2);
#pragma unroll
              for (int i = 0; i < 8; ++i) { const float c = i < 4 ? c0[i & 3] : c1[i & 3], sn = i < 4 ? s0[i & 3] : s1[i & 3]; o1[i] = (x1[i] * c - x2[i] * sn) * gq; o2[i] = (x1[i] * sn + x2[i] * c) * gq; }
              *(u32x4*)(row + C_QR) = pack8f(o1); *(u32x4*)(row + C_QR + 32) = pack8f(o2);
              unpack8(*(const u32x4*)(row + C_KR), x1); unpack8(*(const u32x4*)(row + C_KR + 32), x2);
#pragma unroll
              for (int i = 0; i < 8; ++i) { const float c = i < 4 ? c0[i & 3] : c1[i & 3], sn = i < 4 ? s0[i & 3] : s1[i & 3]; o1[i] = (x1[i] * c - x2[i] * sn) * gk; o2[i] = (x1[i] * sn + x2[i] * c) * gk; }
              const u32x4 w1 = pack8f(o1), w2 = pack8f(o2);
              *(u32x4*)(row + C_KR) = w1; *(u32x4*)(row + C_KR + 32) = w2; store8_b16(kr + t * TPT + d, w1); store8_b16(kr + t * TPT + d + 32, w2); }
            COMPILER_FENCE(); }
#pragma unroll
        for (int k = 0; k < 4; ++k) { const int ch = tid + NTHR * k, t = ch >> 3, d8 = (ch & 7) * 8, tt = tile * 256 + t; const bf16_t* src = PR + (size_t)(b * T + tt) * NPROJ + h * 64 + d8;
            const u32x4 wv = *(const u32x4*)(src + C_VA); *(u32x4*)(va + t * TPK + d8) = wv; store8_b16(vr + t * TPT + d8, *(const u32x4*)(src + C_VR));
            if (tt >= T - PWIN) { float v[8]; unpack8(wv, v); float* o = p.out + O_PWV + (((size_t)l * PB + b) * PWIN + (tt - (T - PWIN))) * 256 + h * 64 + d8;
                *(f32x4*)o = (f32x4){v[0], v[1], v[2], v[3]}; *(f32x4*)(o + 4) = (f32x4){v[4], v[5], v[6], v[7]}; }
            COMPILER_FENCE(); }
        __syncthreads();
#pragma unroll
        for (int cls = 0; cls < 3; ++cls) {
            bf16_t* KFc = WSP(bf16_t, WS_KF) + cls * ATT_CLS + (size_t)bh * (T / 32) * 2048; bf16_t* VFc = WSP(bf16_t, WS_VF) + cls * ATT_CLS + (size_t)bh * (T / 32) * 2048;
#pragma unroll 1
            for (int k = 0; k < 4; ++k) { const int f = tid + NTHR * k, lane = f & 63, c31 = lane & 31, hi = lane >> 5;
                { int g, ks, tl, gtile; bool ok = true;
                  if (cls == 0) { ks = (f >> 6) & 3; g = f >> 8; tl = 32 * g + c31; gtile = tile * 8 + g; }
                  else if (cls == 1) { ks = (f >> 6) & 3; g = f >> 8; const int r = g >> 1, st = g & 1; tl = 4 * (32 * st + c31) + r; gtile = r * (T / 128) + tile * 2 + st; }
                  else { const int r = f >> 7, s16 = f & 15, h2 = (f >> 4) & 1; ks = (f >> 5) & 3; tl = 16 * s16 + r; gtile = r * (T / 512) + (tile >> 1); g = 0; (void)ok;
                      const int slot = 16 * (tile & 1) + s16;
                      *(u32x4*)(KFc + ((size_t)gtile * 4 + ks) * 512 + (slot + 32 * h2) * 8) = *(const u32x4*)(ka + tl * TPK + 16 * ks + 8 * h2); }
                  if (cls < 2) { *(u32x4*)(KFc + ((size_t)gtile * 4 + ks) * 512 + lane * 8) = *(const u32x4*)(ka + tl * TPK + 16 * ks + 8 * hi); } }
                { int dt, s2, gtile, r = 0, st = 0, g = 0;
                  if (cls == 0) { s2 = (f >> 6) & 1; dt = (f >> 7) & 1; g = f >> 8; gtile = tile * 8 + g; }
                  else if (cls == 1) { s2 = (f >> 6) & 1; dt = (f >> 7) & 1; g = f >> 8; r = g >> 1; st = g & 1; gtile = r * (T / 128) + tile * 2 + st; }
                  else { dt = (f >> 6) & 1; r = f >> 7; s2 = tile & 1; gtile = r * (T / 512) + (tile >> 1); }
                  unsigned short e8[8];
#pragma unroll
                  for (int jj = 0; jj < 8; ++jj) { const int kk = 16 * s2 + 8 * (jj >> 2) + 4 * hi + (jj & 3);
                      const int tl = cls == 0 ? 32 * g + kk : cls == 1 ? 4 * (32 * st + kk) + r : 16 * (kk & 15) + r;
                      e8[jj] = va[tl * TPK + 32 * dt + c31]; }
                  u32x4 w; w.x = (unsigned)e8[0] | ((unsigned)e8[1] << 16); w.y = (unsigned)e8[2] | ((unsigned)e8[3] << 16); w.z = (unsigned)e8[4] | ((unsigned)e8[5] << 16); w.w = (unsigned)e8[6] | ((unsigned)e8[7] << 16);
                  *(u32x4*)(VFc + ((size_t)gtile * 4 + dt * 2 + s2) * 512 + lane * 8) = w; }
                COMPILER_FENCE(); }
        }
        trans_write(vr, WSP(bf16_t, WS_VRT) + (size_t)bh * 64 * T, tile * 256, tid);
        trans_write(kr, WSP(bf16_t, WS_KRT) + (size_t)bh * 64 * T, tile * 256, tid);
    }
}

constexpr int CH_ITEMS = PB * 4 * 4;
__device__ __forceinline__ void ph_ret_local(const P& p, int l) {
    const int tid = tidx(), lane = tid & 63, wave = tid >> 6, x = lane & 15, q = lane >> 4, dt = wave >> 1;
    for (int u = blockIdx.x; u < NUNIT; u += gridDim.x) {
        const int n = u % NCH, bh = u / NCH, h = bh & 3, t0 = n * 64; const float g63 = expf(ret_lg(h) * 63.0f);
        const bf16_t* ka = WSP(bf16_t, WS_KRT) + ((size_t)bh * 64 + 16 * dt + x) * T + t0 + 8 * q;
#pragma unroll
        for (int k = 0; k < 2; ++k) { const int et = 2 * (wave & 1) + k; const bf16_t* vb = WSP(bf16_t, WS_VRT) + ((size_t)bh * 64 + 16 * et + x) * T + t0 + 8 * q;
            f32x4 acc = (f32x4){0.f, 0.f, 0.f, 0.f};
#pragma unroll
            for (int ks = 0; ks < 2; ++ks) acc = MFMA16(*(const bf16x8*)(ka + 32 * ks), *(const bf16x8*)(vb + 32 * ks), acc);
            *(f32x4*)(WSP(float, WS_RU) + (size_t)u * 4096 + (16 * et + x) * 64 + 16 * dt + 4 * q) = acc * g63; }
    }
}
__device__ __forceinline__ void ph_ret_scan(const P& p, int l) {
    const int G = (int)gridDim.x, skip = G > 2 * CH_ITEMS ? CH_ITEMS : 0;
    if ((int)blockIdx.x < skip) return;
    const int gt = ((int)blockIdx.x - skip) * NTHR + tidx(), ng = (G - skip) * NTHR;
    for (int e = gt; e < PB * 4 * 4096; e += ng) {
        const int bh = e >> 12, ed = e & 4095, h = bh & 3; const float cd = expf(ret_lg(h) * 64.0f);
        const float* U = WSP(float, WS_RU) + (size_t)bh * NCH * 4096 + ed; bf16_t* SPv = WSP(bf16_t, WS_RS) + (size_t)bh * NCH * 4096 + ed;
        float s = 0.f;
        static_assert(NCH % 8 == 0, "scan batches");
        constexpr int SB = NCH % 32 == 0 ? 32 : 8;
        for (int n0 = 0; n0 < NCH; n0 += SB) {
            float uv[SB];
#pragma unroll
            for (int k = 0; k < SB; ++k) uv[k] = U[(size_t)(n0 + k) * 4096];
#pragma unroll
            for (int k = 0; k < SB; ++k) { SPv[(size_t)(n0 + k) * 4096] = f2bf(s); s = s * cd + uv[k]; } }
        p.out[O_PRET + ((size_t)l * PB * 4 + bh) * 4096 + (ed & 63) * 64 + (ed >> 6)] = s;
    }
}
__device__ __forceinline__ void ph_ret_out(const P& p, int l) {
    const int tid = tidx(), lane = tid & 63, wave = tid >> 6, x = lane & 15, q = lane >> 4, it = UNIFORM(wave & 3);
    const bf16_t* PR = WSP(bf16_t, WS_PROJ);
    for (int u = blockIdx.x * 2 + (wave >> 2); u < NUNIT; u += gridDim.x * 2) {
        const int n = u % NCH, bh = u / NCH, h = bh & 3, b = bh >> 2, t0 = n * 64; const float gam = expf(ret_lg(h));
        const size_t rowi = (size_t)(b * T + t0 + 16 * it + x);
        bf16x8 qf[2];
#pragma unroll
        for (int ks = 0; ks < 2; ++ks) qf[ks] = *(const bf16x8*)(PR + rowi * NPROJ + C_QR + h * 64 + 32 * ks + 8 * q);
        f32x4 at[4];
#pragma unroll
        for (int jt = 0; jt < 4; ++jt) { at[jt] = (f32x4){0.f, 0.f, 0.f, 0.f};
            if (jt <= it) { const bf16_t* kp = PR + (size_t)(b * T + t0 + 16 * jt + x) * NPROJ + C_KR + h * 64 + 8 * q;
#pragma unroll
                for (int ks = 0; ks < 2; ++ks) at[jt] = MFMA16(*(const bf16x8*)(kp + 32 * ks), qf[ks], at[jt]);
                if (jt == it) {
#pragma unroll
                    for (int e = 0; e < 4; ++e) if (4 * q + e > x) at[jt][e] = 0.f; } } }
        const bf16x8 pb0 = pack_tiles(at[0], at[1]), pb1 = pack_tiles(at[2], at[3]);
        f32x4 o[4], os[4];
#pragma unroll
        for (int et = 0; et < 4; ++et) { o[et] = (f32x4){0.f, 0.f, 0.f, 0.f}; os[et] = (f32x4){0.f, 0.f, 0.f, 0.f};
            const bf16_t* vp = WSP(bf16_t, WS_VRT) + ((size_t)bh * 64 + 16 * et + x) * T + t0 + 4 * q;
            { const u32x2 lo = *(const u32x2*)vp, hi = *(const u32x2*)(vp + 16); u32x4 w; w.x = lo.x; w.y = lo.y; w.z = hi.x; w.w = hi.y; o[et] = MFMA16(__builtin_bit_cast(bf16x8, w), pb0, o[et]); }
            if (it >= 2) { const u32x2 lo = *(const u32x2*)(vp + 32), hi = *(const u32x2*)(vp + 48); u32x4 w; w.x = lo.x; w.y = lo.y; w.z = hi.x; w.w = hi.y; o[et] = MFMA16(__builtin_bit_cast(bf16x8, w), pb1, o[et]); }
            const bf16_t* sp = WSP(bf16_t, WS_RS) + (size_t)u * 4096 + (16 * et + x) * 64 + 8 * q;
#pragma unroll
            for (int ks = 0; ks < 2; ++ks) os[et] = MFMA16(*(const bf16x8*)(sp + 32 * ks), qf[ks], os[et]);
            o[et] = o[et] + os[et] * gam; }
        float sq = 0.f;
#pragma unroll
        for (int et = 0; et < 4; ++et) sq += (o[et][0] * o[et][0] + o[et][1] * o[et][1]) + (o[et][2] * o[et][2] + o[et][3] * o[et][3]);
        sq += __shfl_xor(sq, 16); sq += __shfl_xor(sq, 32);
        const float rstd = 1.0f / sqrtf(sq * (1.0f / 64.0f) + EPS);
#pragma unroll
        for (int et = 0; et < 4; ++et) { const int e0 = 16 * et + 4 * q; const u32x2 gw = *(const u32x2*)(PR + rowi * NPROJ + C_GR + h * 64 + e0); const f32x4 nw = *(const f32x4*)(p.ret_norm + l * 64 + e0);
            const float g0 = bf2f((bf16_t)(gw.x & 0xffff)), g1 = bf2f((bf16_t)(gw.x >> 16)), g2 = bf2f((bf16_t)(gw.y & 0xffff)), g3 = bf2f((bf16_t)(gw.y >> 16));
            u32x2 w; w.x = pk2(o[et][0] * rstd * nw[0] * silu_fast(g0), o[et][1] * rstd * nw[1] * silu_fast(g1)); w.y = pk2(o[et][2] * rstd * nw[2] * silu_fast(g2), o[et][3] * rstd * nw[3] * silu_fast(g3));
            *(u32x2*)(WSP(bf16_t, WS_O) + rowi * D + 256 + h * 64 + e0) = w; }
    }
}
__device__ __forceinline__ void ph_ret_sample(const P& p, int l, unsigned char* smem) {
    float* S0 = (float*)smem; float* qs = S0 + 4096; float* ks = qs + 8 * 64; float* vs = ks + 8 * 64;
    const int tid = tidx(); const bf16_t* PR = WSP(bf16_t, WS_PROJ);
    for (int u = gridDim.x - 1 - blockIdx.x; u < DB * 4; u += gridDim.x) {
        const int h = u & 3, b = u >> 2; const float lg = ret_lg(h);
        __syncthreads();
        for (int e = tid; e < 4096; e += NTHR) S0[e] = p.state_ret[(((size_t)l * DB + b) * 4 + h) * 4096 + e];
        { const int j = tid >> 6, d = tid & 63; const size_t row = (size_t)(MP + b * DS + j) * NPROJ;
          qs[tid] = bf2f(PR[row + C_QR + h * 64 + d]); ks[tid] = bf2f(PR[row + C_KR + h * 64 + d]); vs[tid] = bf2f(PR[row + C_VR + h * 64 + d]); }
        __syncthreads();
        { const int i = tid >> 6, e = tid & 63; float o = 0.f;
          for (int j = 0; j <= i; ++j) { float a = 0.f; for (int d = 0; d < 64; ++d) a += qs[i * 64 + d] * ks[j * 64 + d]; o += a * expf(lg * (float)(i - j)) * vs[j * 64 + e]; }
          float o2 = 0.f; for (int d = 0; d < 64; ++d) o2 += qs[i * 64 + d] * S0[d * 64 + e];
          o += o2 * expf(lg * (float)(i + 1));
          const float rstd = 1.0f / sqrtf(wave_sum(o * o) * (1.0f / 64.0f) + EPS);
          const size_t row = (size_t)(MP + b * DS + i); const float g = bf2f(PR[row * NPROJ + C_GR + h * 64 + e]);
          WSP(bf16_t, WS_O)[row * D + 256 + h * 64 + e] = f2bf(o * rstd * p.ret_norm[l * 64 + e] * silu_f(g)); }
        for (int x = tid; x < 4096; x += NTHR) { const int d = x >> 6, e = x & 63; float s = S0[x] * expf(lg * (float)DS);
            for (int j = 0; j < DS; ++j) s += ks[j * 64 + d] * expf(lg * (float)(DS - 1 - j)) * vs[j * 64 + e];
            p.out[O_SRET + (((size_t)l * DB + b) * 4 + h) * 4096 + x] = s; }
    }
}

template <int CS, int LDL> __device__ __forceinline__ void fwd_subst(float (&X)[CS], const float* Ls) {
#pragma unroll
    for (int i = 1; i < CS; ++i) {
        float a[4] = {X[i], 0.f, 0.f, 0.f};
#pragma unroll
        for (int j4 = 0; j4 < (i + 3) / 4; ++j4) { const f32x4 lv = *(const f32x4*)(Ls + i * LDL + 4 * j4);
#pragma unroll
            for (int e = 0; e < 4; ++e) if (4 * j4 + e < i) a[e] -= lv[e] * X[4 * j4 + e]; }
        X[i] = (a[0] + a[1]) + (a[2] + a[3]);
    }
}
constexpr int QP = 132;
constexpr int WSTP = 136;
constexpr int RWP = 392, TP = 136;
__device__ __forceinline__ void ph_gdn_prep(const P& p, int l, unsigned char* smem) {
    float* Ls = (float*)smem; float* As = Ls + 64 * 68; float* gs = As + 64 * 68; float* gcs = gs + 64; float* bts = gcs + 64; float* part = bts + 64;
    bf16_t* raw = (bf16_t*)(part + 4 * 64); bf16_t* Khi = raw + 67 * RWP; bf16_t* Klo = Khi + 64 * TP; bf16_t* Qb = Klo + 64 * TP;
    static_assert((64 * 68 * 2 + 64 * 3 + 4 * 64) * 4 + (67 * RWP + 3 * 64 * TP) * 2 <= BAR_LDS_OFF, "gdn_prep LDS");
    const int tid = tidx(), lane = tid & 63, wave = tid >> 6; const bf16_t* PR = WSP(bf16_t, WS_PROJ);
    for (int u = blockIdx.x; u < NUNIT; u += gridDim.x) {
        const int n = u % NCH, h = (u / NCH) % 4, b = u / (NCH * 4), t0 = n * 64;
        __syncthreads();
        for (int e = tid; e < 67 * 48; e += NTHR) { const int row = e / 48, ch = e % 48, t = t0 - 3 + row; u32x4 v = (u32x4){0u, 0u, 0u, 0u};
            if (t >= 0) v = *(const u32x4*)(PR + (size_t)(b * T + t) * NPROJ + C_CONV + (ch >> 4) * 512 + h * 128 + (ch & 15) * 8);
            *(u32x4*)(raw + row * RWP + ch * 8) = v; }
        if (tid >= 384 && tid < 448) { const int i = tid - 384; const size_t row = (size_t)(b * T + t0 + i); gs[i] = WSP(float, WS_G)[row * 4 + h]; bts[i] = WSP(float, WS_BETA)[row * 4 + h]; }
        __syncthreads();
        float y[64]; const int sec = tid < 128 ? 2 : tid < 256 ? 1 : 0, c = tid & 127;
        if (tid < 384) { const int col = sec * 512 + h * 128 + c;
            const float w0 = p.conv_w[(l * 4 + 0) * 1536 + col], w1 = p.conv_w[(l * 4 + 1) * 1536 + col], w2 = p.conv_w[(l * 4 + 2) * 1536 + col], w3 = p.conv_w[(l * 4 + 3) * 1536 + col];
            const LAS bf16_t* rp = (const LAS bf16_t*)raw + sec * 128 + c; LAUNDER_V(rp); float x0 = bf2f(rp[0]), x1 = bf2f(rp[RWP]), x2 = bf2f(rp[2 * RWP]);
#pragma unroll
            for (int i = 0; i < 64; ++i) { const float x3 = bf2f(rp[(i + 3) * RWP]); y[i] = silu_fast(w0 * x0 + w1 * x1 + w2 * x2 + w3 * x3); x0 = x1; x1 = x2; x2 = x3; if ((i & 7) == 7) COMPILER_FENCE(); } }
        if (tid >= 448) { if (tid == 448) { float a = 0.f; for (int i = 0; i < 64; ++i) { a += gs[i]; gcs[i] = a; } }
            WAVE_SYNC(); const int i = tid - 448; part[128 + i] = expf(gcs[i]); part[192 + i] = expf(gcs[63] - gcs[i]); }
#pragma unroll
        for (int pass = 0; pass < 2; ++pass) {
            if (tid >= 128 + 128 * pass && tid < 256 + 128 * pass) { LAS float* sq = (LAS float*)Ls + c; LAUNDER_V(sq);
#pragma unroll
                for (int i = 0; i < 64; ++i) sq[i * 132] = y[i] * y[i]; }
            __syncthreads();
            { const int i = tid >> 3, pt = tid & 7; const float* rp2 = Ls + i * 132 + pt * 16; float a = 0.f;
#pragma unroll
              for (int k = 0; k < 16; ++k) a += rp2[k];
              a += __shfl_xor(a, 1); a += __shfl_xor(a, 2); a += __shfl_xor(a, 4);
              if (pt == 0) part[64 * pass + i] = 1.0f / sqrtf(a + EPS); }
            __syncthreads();
        }
        if (tid >= 128 && tid < 256) { LAS bf16_t* kh = (LAS bf16_t*)Khi + c; LAS bf16_t* kl = (LAS bf16_t*)Klo + c; LAUNDER_V(kh); LAUNDER_V(kl);
#pragma unroll
            for (int i = 0; i < 64; ++i) { const float v = y[i] * part[i]; y[i] = v; const bf16_t hb = f2bf(v); kh[i * TP] = hb; kl[i * TP] = f2bf(v - bf2f(hb)); if ((i & 7) == 7) COMPILER_FENCE(); }
            bf16_t* dst = WSP(bf16_t, WS_GWK) + (size_t)u * 16384 + 8192; const int mt = c >> 4, x = c & 15;
#pragma unroll
            for (int ks2 = 0; ks2 < 2; ++ks2)
#pragma unroll
                for (int q = 0; q < 4; ++q) { const int i0 = 32 * ks2 + 4 * q; float v[8];
#pragma unroll
                    for (int e = 0; e < 8; ++e) { const int i = i0 + (e < 4 ? e : 12 + e); v[e] = y[i] * part[192 + i]; }
                    u32x4 w; w.x = pk2(v[0], v[1]); w.y = pk2(v[2], v[3]); w.z = pk2(v[4], v[5]); w.w = pk2(v[6], v[7]);
                    *(u32x4*)(dst + ((size_t)((mt * 2 + ks2) * 64 + q * 16 + x)) * 8) = w; COMPILER_FENCE(); } }
        else if (tid >= 256 && tid < 384) { LAS bf16_t* qb = (LAS bf16_t*)Qb + c; LAUNDER_V(qb);
#pragma unroll
            for (int i = 0; i < 64; ++i) { qb[i * TP] = f2bf(y[i] * part[64 + i]); if ((i & 7) == 7) COMPILER_FENCE(); } }
        __syncthreads();
#pragma unroll
        for (int tp = 0; tp < 2; ++tp) { const int pos = wave * 2 + tp, it = pos >> 2, jt = pos & 3, j16 = lane & 15, qd = lane >> 4;
            f32x4 lk = (f32x4){0.f, 0.f, 0.f, 0.f}, aq = (f32x4){0.f, 0.f, 0.f, 0.f};
            if (jt <= it) {
#pragma unroll
                for (int ks = 0; ks < 4; ++ks) { const int ao = (16 * it + j16) * TP + 32 * ks + 8 * qd, bo = (16 * jt + j16) * TP + 32 * ks + 8 * qd;
                    const bf16x8 ah = *(const bf16x8*)(Khi + ao), al = *(const bf16x8*)(Klo + ao), aqf = *(const bf16x8*)(Qb + ao), bh = *(const bf16x8*)(Khi + bo), bl = *(const bf16x8*)(Klo + bo);
                    lk = MFMA16(ah, bh, lk); lk = MFMA16(ah, bl, lk); lk = MFMA16(al, bh, lk); aq = MFMA16(aqf, bh, aq); } }
            const int j = 16 * jt + j16;
#pragma unroll
            for (int e = 0; e < 4; ++e) { const int i = 16 * it + 4 * qd + e; const float ex = j <= i ? expf(gcs[i] - gcs[j]) : 0.f;
                Ls[i * 68 + j] = j < i ? bts[i] * lk[e] * ex : 0.f; As[i * 68 + j] = aq[e] * ex * 0.08838834764831845f; } }
        __syncthreads();
        if (tid < 256) {
            if (tid < 128) {
#pragma unroll
                for (int i = 0; i < 64; ++i) { y[i] *= bts[i]; if ((i & 15) == 15) COMPILER_FENCE(); } }
            else {
#pragma unroll
                for (int i = 0; i < 64; ++i) { y[i] *= bts[i] * part[128 + i]; if ((i & 15) == 15) COMPILER_FENCE(); } }
            fwd_subst<64, 68>(y, Ls);
            if (tid < 128) { bf16_t* U = WSP(bf16_t, WS_GU) + (size_t)u * 8192 + c * 64;
#pragma unroll
                for (int i8 = 0; i8 < 8; ++i8) { u32x4 w; w.x = pk2(y[8 * i8], y[8 * i8 + 1]); w.y = pk2(y[8 * i8 + 2], y[8 * i8 + 3]); w.z = pk2(y[8 * i8 + 4], y[8 * i8 + 5]); w.w = pk2(y[8 * i8 + 6], y[8 * i8 + 7]); *(u32x4*)(U + 8 * i8) = w; } }
            else { LAS bf16_t* wst = (LAS bf16_t*)raw + c; LAUNDER_V(wst);
#pragma unroll
                for (int i = 0; i < 64; ++i) wst[i * WSTP] = f2bf(-y[i]); }
        } else { const int t2 = tid - 256;
#pragma unroll
            for (int k = 0; k < 2; ++k) { const int e8 = t2 + 256 * k, i = e8 >> 3, j0 = (e8 & 7) * 8; const f32x4 a0 = *(const f32x4*)(As + i * 68 + j0), a1 = *(const f32x4*)(As + i * 68 + j0 + 4);
                u32x4 w; w.x = pk2(a0[0], a0[1]); w.y = pk2(a0[2], a0[3]); w.z = pk2(a1[0], a1[1]); w.w = pk2(a1[2], a1[3]); *(u32x4*)(WSP(bf16_t, WS_GA) + (size_t)u * 4096 + i * 64 + j0) = w; }
            if (t2 == 0) WSP(float, WS_GD)[u] = expf(gcs[63]); }
        __syncthreads();
        { bf16_t* dst = WSP(bf16_t, WS_GWK) + (size_t)u * 16384; const bf16_t* wst = raw;
#pragma unroll
          for (int k = 0; k < 2; ++k) { const int f = tid + NTHR * k, ln = f & 63, ks4 = (f >> 6) & 3, mt = f >> 8, q = ln >> 4, x = ln & 15;
              const bf16_t* wr = wst + (16 * mt + x) * WSTP + 32 * ks4 + 4 * q;
              u32x4 w; w.x = (unsigned)wr[0] | ((unsigned)wr[1] << 16); w.y = (unsigned)wr[2] | ((unsigned)wr[3] << 16); w.z = (unsigned)wr[16] | ((unsigned)wr[17] << 16); w.w = (unsigned)wr[18] | ((unsigned)wr[19] << 16);
              *(u32x4*)(dst + (size_t)f * 8) = w; }
#pragma unroll
          for (int k = 0; k < 2; ++k) { const int e8 = tid + NTHR * k, i = e8 >> 4, d0 = (e8 & 15) * 8; float v[8]; unpack8(*(const u32x4*)(Qb + i * TP + d0), v); const float fsc = 0.08838834764831845f * part[128 + i];
#pragma unroll
              for (int x = 0; x < 8; ++x) v[x] *= fsc;
              *(u32x4*)(WSP(bf16_t, WS_GQ) + (size_t)u * 8192 + i * 128 + d0) = pack8f(v); } }
    }
}
constexpr int CH_SLOT = 36864, CH_NSLOT = 4;
static_assert(NCH % 4 == 0 && CH_NSLOT * CH_SLOT <= BAR_LDS_OFF, "chain ring");
__device__ __forceinline__ void chain_stage(const bf16_t* WK, const bf16_t* UTq, int m, int pw, int lane, unsigned char* smem) {
    unsigned char* slot = smem + (m % CH_NSLOT) * CH_SLOT;
#pragma unroll
    for (int k = 0; k < 6; ++k) { const int pc = pw * 6 + k;
        if (pc < 32) GLDS16((const unsigned char*)(WK + (size_t)m * 16384) + pc * 1024 + lane * 16, slot + pc * 1024);
        else GLDS16((const unsigned char*)(UTq + (size_t)m * 8192) + (pc - 32) * 1024 + lane * 16, slot + pc * 1024); }
}
__device__ __forceinline__ void ph_gdn_chain(const P& p, int l, unsigned char* smem) {
    const int tid = tidx(), lane = tid & 63, wave = UNIFORM(tid >> 6), j = lane & 15, q = lane >> 4;
    for (int it = blockIdx.x; it < CH_ITEMS; it += gridDim.x) {
        const int qt = it & 3, bh = it >> 2;
        const bf16_t* WK = WSP(bf16_t, WS_GWK) + (size_t)bh * NCH * 16384;
        const bf16_t* UTq = WSP(bf16_t, WS_GU) + (size_t)bh * NCH * 8192 + qt * 2048;
        __syncthreads();
        if (wave >= 2) {
            const int pw = wave - 2;
            chain_stage(WK, UTq, 0, pw, lane, smem); chain_stage(WK, UTq, 1, pw, lane, smem); chain_stage(WK, UTq, 2, pw, lane, smem);
#pragma unroll 1
            for (int n = 0; n < NCH; ++n) {
                if (n + 2 < NCH) WAIT_VM(12); else if (n + 1 < NCH) WAIT_VM(6); else WAIT_VM(0);
                RAW_BARRIER();
                if (n + 3 < NCH) chain_stage(WK, UTq, n + 3, pw, lane, smem);
            }
        } else {
            const int sl = qt * 2 + wave, c = 16 * sl + j;
            f32x4 S[8];
#pragma unroll
            for (int t = 0; t < 8; ++t) S[t] = (f32x4){0.f, 0.f, 0.f, 0.f};
            bf16x8 sB[4];
#pragma unroll
            for (int ks = 0; ks < 4; ++ks) sB[ks] = pack_tiles(S[2 * ks], S[2 * ks + 1]);
            const float* DC = WSP(float, WS_GD) + bh * NCH;
            float db[4];
#pragma unroll
            for (int d = 0; d < 4; ++d) db[d] = DC[d];
#pragma unroll 1
            for (int n0 = 0; n0 < NCH; n0 += 4) {
#pragma unroll
                for (int k4 = 0; k4 < 4; ++k4) {
                    const int n = n0 + k4, u = bh * NCH + n;
                    f32x4 acc[4]; const float dec = db[k4];
                    if (n + 4 < NCH) db[k4] = DC[n + 4];
                    { bf16_t* sp = WSP(bf16_t, WS_GS) + (size_t)u * 16384 + (size_t)sl * 2048 + lane * 8;
#pragma unroll
                      for (int tp = 0; tp < 4; ++tp) *(bf16x8*)(sp + 512 * tp) = sB[tp]; }
                    WAIT_LGKM0();
                    RAW_BARRIER();
                    const LAS unsigned char* slot = (const LAS unsigned char*)smem + (n % CH_NSLOT) * CH_SLOT + lane * 16; LAUNDER_V(slot);
                    { const LAS unsigned char* us = (const LAS unsigned char*)smem + (n % CH_NSLOT) * CH_SLOT + 32768 + ((16 * wave + j) * 64 + 4 * q) * 2; LAUNDER_V(us);
#pragma unroll
                      for (int mt = 0; mt < 4; ++mt) { const u32x2 w = *(const LAS u32x2*)(us + 32 * mt); acc[mt] = (f32x4){bf2f((bf16_t)(w.x & 0xffff)), bf2f((bf16_t)(w.x >> 16)), bf2f((bf16_t)(w.y & 0xffff)), bf2f((bf16_t)(w.y >> 16))}; } }
                    bf16x8 fa[8], fb[8];
#pragma unroll
                    for (int i = 0; i < 8; ++i) fa[i] = *(const LAS bf16x8*)(slot + i * 1024);
#pragma unroll
                    for (int i = 0; i < 8; ++i) fb[i] = *(const LAS bf16x8*)(slot + (8 + i) * 1024);
                    COMPILER_FENCE();
#pragma unroll
                    for (int ks = 0; ks < 4; ++ks) { acc[0] = MFMA16(fa[ks], sB[ks], acc[0]); acc[1] = MFMA16(fa[4 + ks], sB[ks], acc[1]); }
                    COMPILER_FENCE();
#pragma unroll
                    for (int i = 0; i < 8; ++i) fa[i] = *(const LAS bf16x8*)(slot + 16384 + i * 1024);
#pragma unroll
                    for (int ks = 0; ks < 4; ++ks) { acc[2] = MFMA16(fb[ks], sB[ks], acc[2]); acc[3] = MFMA16(fb[4 + ks], sB[ks], acc[3]); }
                    COMPILER_FENCE();
#pragma unroll
                    for (int i = 0; i < 8; ++i) fb[i] = *(const LAS bf16x8*)(slot + 16384 + (8 + i) * 1024);
                    const bf16x8 vB0 = pack_tiles(acc[0], acc[1]), vB1 = pack_tiles(acc[2], acc[3]);
                    { bf16_t* vp = WSP(bf16_t, WS_GV) + (size_t)u * 8192 + (size_t)sl * 1024 + lane * 8;
                      *(bf16x8*)vp = vB0; *(bf16x8*)(vp + 512) = vB1; }
#pragma unroll
                    for (int t = 0; t < 8; ++t) S[t] = S[t] * dec;
                    COMPILER_FENCE();
#pragma unroll
                    for (int t = 0; t < 4; ++t) S[t] = MFMA16(fa[2 * t], vB0, S[t]);
#pragma unroll
                    for (int t = 0; t < 4; ++t) S[t] = MFMA16(fa[2 * t + 1], vB1, S[t]);
#pragma unroll
                    for (int t = 0; t < 4; ++t) S[4 + t] = MFMA16(fb[2 * t], vB0, S[4 + t]);
#pragma unroll
                    for (int t = 0; t < 4; ++t) S[4 + t] = MFMA16(fb[2 * t + 1], vB1, S[4 + t]);
                    COMPILER_FENCE();
#pragma unroll
                    for (int ks = 0; ks < 4; ++ks) sB[ks] = pack_tiles(S[2 * ks], S[2 * ks + 1]);
                }
            }
            float* o = p.out + O_PGDN + ((size_t)l * PB * 4 + bh) * 16384 + c;
#pragma unroll
            for (int t = 0; t < 8; ++t)
#pragma unroll
                for (int e = 0; e < 4; ++e) o[(size_t)(16 * t + 4 * q + e) * 128] = S[t][e];
        }
    }
}
__device__ __forceinline__ void ph_gdn_out(const P& p, int l, unsigned char* smem) {
    const int tid = tidx(), lane = tid & 63, wave = tid >> 6, j = lane & 15, q = lane >> 4, mt = wave & 3;
    const bf16_t* PR = WSP(bf16_t, WS_PROJ);
    for (int u = blockIdx.x * 2 + (wave >> 2); u < NUNIT; u += gridDim.x * 2) {
        const int n = u % NCH, h = (u / NCH) % 4, b = u / (NCH * 4);
        f32x4 acc[8];
#pragma unroll
        for (int ct = 0; ct < 8; ++ct) acc[ct] = (f32x4){0.f, 0.f, 0.f, 0.f};
        const bf16_t* qg = WSP(bf16_t, WS_GQ) + (size_t)u * 8192 + (16 * mt + j) * 128 + 8 * q;
        const bf16_t* st = WSP(bf16_t, WS_GS) + (size_t)u * 16384 + ((2 * (q & 1)) * 16 + j) * 8 + (q >> 1) * 4;
#pragma unroll
        for (int ks = 0; ks < 4; ++ks) { const bf16x8 a = *(const bf16x8*)(qg + 32 * ks);
#pragma unroll
            for (int ct = 0; ct < 8; ++ct) { const bf16_t* sp = st + (size_t)ct * 2048 + ks * 512; const u32x2 lo = *(const u32x2*)sp, hi = *(const u32x2*)(sp + 128); u32x4 w; w.x = lo.x; w.y = lo.y; w.z = hi.x; w.w = hi.y;
                acc[ct] = MFMA16(a, __builtin_bit_cast(bf16x8, w), acc[ct]); }
            COMPILER_FENCE(); }
        const bf16_t* at = WSP(bf16_t, WS_GA) + (size_t)u * 4096 + (16 * mt + j) * 64 + 8 * q;
        const bf16_t* vt = WSP(bf16_t, WS_GV) + (size_t)u * 8192 + ((2 * (q & 1)) * 16 + j) * 8 + (q >> 1) * 4;
#pragma unroll
        for (int ks = 0; ks < 2; ++ks) { const bf16x8 a = *(const bf16x8*)(at + 32 * ks);
#pragma unroll
            for (int ct = 0; ct < 8; ++ct) { const bf16_t* vp = vt + (size_t)ct * 1024 + ks * 512; const u32x2 lo = *(const u32x2*)vp, hi = *(const u32x2*)(vp + 128); u32x4 w; w.x = lo.x; w.y = lo.y; w.z = hi.x; w.w = hi.y;
                acc[ct] = MFMA16(a, __builtin_bit_cast(bf16x8, w), acc[ct]); }
            COMPILER_FENCE(); }
        float sq[4];
#pragma unroll
        for (int e = 0; e < 4; ++e) { float s = 0.f;
#pragma unroll
            for (int ct = 0; ct < 8; ++ct) s += acc[ct][e] * acc[ct][e];
            s += __shfl_xor(s, 1); s += __shfl_xor(s, 2); s += __shfl_xor(s, 4); s += __shfl_xor(s, 8); sq[e] = 1.0f / sqrtf(s * (1.0f / 128.0f) + EPS); }
        float* stg = (float*)smem + wave * (16 * 132);
#pragma unroll
        for (int e = 0; e < 4; ++e)
#pragma unroll
            for (int ct = 0; ct < 8; ++ct) stg[(4 * q + e) * 132 + 16 * ct + j] = acc[ct][e] * sq[e];
        WAVE_SYNC();
        { const int rr = lane >> 2, cg = lane & 3; const size_t row = (size_t)(b * T + n * 64 + 16 * mt + rr);
#pragma unroll
          for (int k4 = 0; k4 < 4; ++k4) { const int c0 = cg * 32 + k4 * 8; const f32x4 o0 = *(const f32x4*)(stg + rr * 132 + c0), o1 = *(const f32x4*)(stg + rr * 132 + c0 + 4);
              float z[8]; unpack8(*(const u32x4*)(PR + row * NPROJ + C_Z + h * 128 + c0), z); const f32x4 n0 = *(const f32x4*)(p.gdn_norm + l * 128 + c0), n1 = *(const f32x4*)(p.gdn_norm + l * 128 + c0 + 4);
              float r8[8];
#pragma unroll
              for (int i = 0; i < 4; ++i) { r8[i] = o0[i] * n0[i] * silu_fast(z[i]); r8[4 + i] = o1[i] * n1[i] * silu_fast(z[4 + i]); }
              *(u32x4*)(WSP(bf16_t, WS_O) + row * D + 512 + h * 128 + c0) = pack8f(r8); } }
        WAVE_SYNC();
    }
}
__device__ __forceinline__ void ph_gdn_sample(const P& p, int l, unsigned char* smem) {
    float* qs = (float*)smem; float* ks = qs + 8 * QP; float* vs = ks + 8 * QP; float* us = vs + 8 * QP; float* wsm = us + 8 * 128; float* vn = wsm + 8 * 128;
    float* Ls = vn + 8 * 128; float* As = Ls + 8 * 8; float* gs = As + 8 * 8; float* gcs = gs + 8; float* bts = gcs + 8; float* S0 = bts + 8;
    const int tid = tidx(); const bf16_t* PR = WSP(bf16_t, WS_PROJ);
    for (int u = gridDim.x - 1 - blockIdx.x; u < DB * 4; u += gridDim.x) {
        const int h = u & 3, b = u >> 2;
        __syncthreads();
#pragma unroll 4
        for (int e = tid; e < 16384; e += NTHR) S0[e] = p.state_gdn[(((size_t)l * DB + b) * 4 + h) * 16384 + e];
        if (tid < 384) { const int sec = tid >> 7, c = tid & 127, col = sec * 512 + h * 128 + c; float* dst = sec == 0 ? qs : sec == 1 ? ks : vs;
            const float w0 = p.conv_w[(l * 4 + 0) * 1536 + col], w1 = p.conv_w[(l * 4 + 1) * 1536 + col], w2 = p.conv_w[(l * 4 + 2) * 1536 + col], w3 = p.conv_w[(l * 4 + 3) * 1536 + col];
            const float* hist = p.state_conv + (((size_t)l * DB + b) * 3) * 1536 + col; const bf16_t* src = PR + (size_t)(MP + b * DS) * NPROJ + C_CONV + col;
            float x0 = hist[0], x1 = hist[1536], x2 = hist[2 * 1536];
            for (int i = 0; i < DS; ++i) { const float x3 = bf2f(src[(size_t)i * NPROJ]); const float y = w0 * x0 + w1 * x1 + w2 * x2 + w3 * x3; dst[i * QP + c] = silu_f(y); x0 = x1; x1 = x2; x2 = x3; } }
        else if (tid < 384 + DS) { const int i = tid - 384; const size_t row = (size_t)(MP + b * DS + i); gs[i] = WSP(float, WS_G)[row * 4 + h]; bts[i] = WSP(float, WS_BETA)[row * 4 + h]; }
        __syncthreads();
        if (tid < 64) { const int rid = tid >> 2, part = tid & 3; float* rowp = (rid < 8 ? qs + rid * QP : ks + (rid - 8) * QP) + part * 32; float s = 0.f;
            for (int d = 0; d < 32; ++d) s += rowp[d] * rowp[d];
            s += __shfl_xor(s, 1); s += __shfl_xor(s, 2); const float sc = 1.0f / sqrtf(s + EPS);
            for (int d = 0; d < 32; ++d) rowp[d] *= sc; }
        if (tid == 64) { float a = 0.f; for (int i = 0; i < DS; ++i) { a += gs[i]; gcs[i] = a; } }
        __syncthreads();
        if (tid < 64) { const int i = tid >> 3, j = tid & 7; float lv = 0.f, av = 0.f;
            if (j <= i) { float dk = 0.f, dq = 0.f; for (int d = 0; d < 128; ++d) { const float kj = ks[j * QP + d]; dk += ks[i * QP + d] * kj; dq += qs[i * QP + d] * kj; }
                const float e = expf(gcs[i] - gcs[j]); av = dq * e * 0.08838834764831845f; lv = j < i ? bts[i] * dk * e : 0.f; }
            Ls[i * 8 + j] = lv; As[i * 8 + j] = av; }
        __syncthreads();
        if (tid < 256) { const int c = tid; float X[8];
            if (c < 128) {
#pragma unroll
                for (int i = 0; i < 8; ++i) X[i] = vs[i * QP + c] * bts[i]; }
            else {
#pragma unroll
                for (int i = 0; i < 8; ++i) X[i] = ks[i * QP + c - 128] * bts[i] * expf(gcs[i]); }
            fwd_subst<8, 8>(X, Ls);
            float* dst = c < 128 ? us + c : wsm + c - 128;
#pragma unroll
            for (int i = 0; i < 8; ++i) dst[i * 128] = X[i]; }
        __syncthreads();
        const int i = tid >> 6, c2 = (tid & 63) * 2;
        { float a0 = us[i * 128 + c2], a1 = us[i * 128 + c2 + 1];
          for (int d = 0; d < 128; ++d) { const float w = wsm[i * 128 + d]; a0 -= w * S0[d * 128 + c2]; a1 -= w * S0[d * 128 + c2 + 1]; }
          vn[i * 128 + c2] = a0; vn[i * 128 + c2 + 1] = a1; }
        __syncthreads();
        { float o0 = 0.f, o1 = 0.f; const float qsc = 0.08838834764831845f * expf(gcs[i]);
          for (int d = 0; d < 128; ++d) { const float qg = qs[i * QP + d] * qsc; o0 += qg * S0[d * 128 + c2]; o1 += qg * S0[d * 128 + c2 + 1]; }
          for (int j = 0; j < DS; ++j) { const float a = As[i * 8 + j]; o0 += a * vn[j * 128 + c2]; o1 += a * vn[j * 128 + c2 + 1]; }
          const float rstd = 1.0f / sqrtf(wave_sum(o0 * o0 + o1 * o1) * (1.0f / 128.0f) + EPS);
          const size_t row = (size_t)(MP + b * DS + i);
          const float z0 = bf2f(PR[row * NPROJ + C_Z + h * 128 + c2]), z1 = bf2f(PR[row * NPROJ + C_Z + h * 128 + c2 + 1]);
          bf16_t* O = WSP(bf16_t, WS_O) + row * D + 512 + h * 128 + c2;
          O[0] = f2bf(o0 * rstd * p.gdn_norm[l * 128 + c2] * silu_f(z0)); O[1] = f2bf(o1 * rstd * p.gdn_norm[l * 128 + c2 + 1] * silu_f(z1)); }
        { const float gl = gcs[DS - 1], dec = expf(gl); float* o = p.out + O_SGDN + (((size_t)l * DB + b) * 4 + h) * 16384;
#pragma unroll 2
          for (int e = tid; e < 16384; e += NTHR) { const int d = e >> 7, c = e & 127; float s = S0[e] * dec;
              for (int j = 0; j < DS; ++j) s += ks[j * QP + d] * expf(gl - gcs[j]) * vn[j * 128 + c];
              o[e] = s; } }
    }
}


template <int K> __device__ __forceinline__ void ph_gemm_small(const P& p, const bf16_t* A  , const bf16_t* Bt  , const float* gate, const float* xs_in  , unsigned char* smem) {
    static_assert(MS % 16 == 0 && K % 256 == 0, "small GEMM shape");
    constexpr int KW = K / 8, NKS = KW / 32;
    const int tid = tidx(), lane = tid & 63, wave = tid >> 6, x = lane & 15, q = lane >> 4;
    float* red = (float*)smem;
    for (int it = blockIdx.x; it < (MS / 16) * 16; it += gridDim.x) {
        const int rt = it % (MS / 16), cg = it / (MS / 16);
        const bf16_t* ap = A + (size_t)(16 * rt + x) * K + wave * KW + 8 * q;
        const bf16_t* bp = Bt + (size_t)(64 * cg + x) * K + wave * KW + 8 * q;
        f32x4 acc[4];
#pragma unroll
        for (int ct = 0; ct < 4; ++ct) acc[ct] = (f32x4){0.f, 0.f, 0.f, 0.f};
#pragma unroll
        for (int ks = 0; ks < NKS; ++ks) { const bf16x8 a = *(const bf16x8*)(ap + 32 * ks);
#pragma unroll
            for (int ct = 0; ct < 4; ++ct) acc[ct] = MFMA16(a, *(const bf16x8*)(bp + (size_t)ct * 16 * K + 32 * ks), acc[ct]); }
        __syncthreads();
#pragma unroll
        for (int ct = 0; ct < 4; ++ct) *(f32x4*)(red + ((wave * 4 + ct) * 64 + lane) * 4) = acc[ct];
        __syncthreads();
        if (wave < 4) { f32x4 s = (f32x4){0.f, 0.f, 0.f, 0.f};
#pragma unroll
            for (int w = 0; w < 8; ++w) s += *(const f32x4*)(red + ((w * 4 + wave) * 64 + lane) * 4);
            const int col = 64 * cg + 16 * wave + x;
#pragma unroll
            for (int e = 0; e < 4; ++e) { const int row = MP + 16 * rt + 4 * q + e; float* xp = p.out + (size_t)row * D + col; const float xin = xs_in ? xs_in[(size_t)(row - MP) * D + col] : *xp; *xp = xin + gate[(size_t)row_cb(row) * 6144 + col] * s[e]; } }
    }
}

__device__ __forceinline__ void ph_final_norm(const P& p) {
    const int lane = tidx() & 63, wave = tidx() >> 6, gw = blockIdx.x * 8 + wave, ngw = gridDim.x * 8;
    for (int r = gw; r < M; r += ngw) {
        float* xr = p.out + (size_t)r * D; f32x4 v[4]; float ss = 0.f;
#pragma unroll
        for (int j = 0; j < 4; ++j) { v[j] = *(const f32x4*)(xr + 4 * lane + 256 * j); ss += (v[j][0] * v[j][0] + v[j][1] * v[j][1]) + (v[j][2] * v[j][2] + v[j][3] * v[j][3]); }
        const float rstd = 1.0f / sqrtf(wave_sum(ss) * (1.0f / D) + EPS);
#pragma unroll
        for (int j = 0; j < 4; ++j) { const f32x4 g = *(const f32x4*)(p.final_norm + 4 * lane + 256 * j); *(f32x4*)(xr + 4 * lane + 256 * j) = v[j] * rstd * g; }
    }
}

enum Phase { PH_PRO = 0, PH_NORM1, PH_GEMM_IN, PH_ROPE, PH_MIX1, PH_MIX2, PH_MIX3, PH_GEMM_OUT, PH_NORM2, PH_GEMM_GU, PH_GEMM_DN, PH_FINAL };
#ifdef __HIP_EMU__
#define LDSP(x) (x)
#else
#define LDSP(x) ((PG8_LAS unsigned char*)(x))
#endif
template <int PH> __device__ __forceinline__ void run_phase(const P& p, int l, unsigned char* smem) {
    if constexpr (PH == PH_PRO) { ph_convert(p, smem, 0, CV_IN, 0, (int)gridDim.x); __syncthreads(); ph_adaln(p, smem, 0, 1, 0, (int)gridDim.x); ph_ropetab_copyx(p); }
    else if constexpr (PH == PH_NORM1) ph_norm_mod<0>(p, l, smem);
    else if constexpr (PH == PH_GEMM_IN) {
        pg8::Gemm g{WSP(bf16_t, WS_H), WSP(bf16_t, WS_WIN) + (size_t)l * NPROJ * D, MPAD, NPROJ, D}; pg8::StaticOrder S; S.init(MPAD, NPROJ, (int)gridDim.x, (int)blockIdx.x);
        pg8::EpiStoreBf16 E{WSP(bf16_t, WS_PROJ), NPROJ};
        pg8::gemm_phase<pg8::EpiStoreBf16, pg8::StaticOrder, true, true>(LDSP(smem), g, S, E);
    }
    else if constexpr (PH == PH_ROPE) { ph_rope_out(p, l); ph_vtrans(p, l, smem); }
    else if constexpr (PH == PH_MIX1) { ph_ret_local(p, l); ph_gdn_prep(p, l, smem); }
    else if constexpr (PH == PH_MIX2) { ph_gdn_chain(p, l, smem); { const int G = (int)gridDim.x; const bool split = G >= CH_ITEMS + DB * 4 + 16; ph_attn_jobs(p, split ? CH_ITEMS : 0, split ? G - DB * 4 : G, split ? 3 : 0); }
        __syncthreads(); ph_attn_sample(p, l, smem); ph_ret_sample(p, l, smem); ph_gdn_sample(p, l, smem); ph_ret_scan(p, l);
        if (l + 1 < NL) { const int G = (int)gridDim.x; const bool split = G >= CH_ITEMS + DB * 4 + 16; const int b0 = split ? CH_ITEMS : 0;
            __syncthreads(); ph_convert(p, smem, l == 0 ? CV_IN : (l + 1) * CV_L, (l + 2) * CV_L, b0, G); __syncthreads(); ph_adaln(p, smem, l + 1, l + 2, b0, G); } }
    else if constexpr (PH == PH_MIX3) { ph_attn_combine(p); ph_ret_out(p, l); ph_gdn_out(p, l, smem); }
    else if constexpr (PH == PH_GEMM_OUT) {
        ph_gemm_small<D>(p, WSP(bf16_t, WS_O) + (size_t)MP * D, WSP(bf16_t, WS_WOUT) + (size_t)l * D * D, WSP(float, WS_MOD) + (size_t)l * NC * 6144 + 2048, l == 0 ? p.x_sample : nullptr, smem); __syncthreads();
        pg8::Gemm g{WSP(bf16_t, WS_O), WSP(bf16_t, WS_WOUT) + (size_t)l * D * D, MP, D, D}; pg8::StaticOrder S; S.init(MP, D, (int)gridDim.x, (int)blockIdx.x);
        pg8::EpiResidual E{p.out, WSP(float, WS_MOD) + (size_t)l * NC * 6144 + 2048, l == 0 ? p.x_prompt : p.out};
        pg8::gemm_phase<pg8::EpiResidual, pg8::StaticOrder, true, true>(LDSP(smem), g, S, E);
    }
    else if constexpr (PH == PH_NORM2) ph_norm_mod<1>(p, l, smem);
    else if constexpr (PH == PH_GEMM_GU) {
        pg8::Gemm g{WSP(bf16_t, WS_H), WSP(bf16_t, WS_WGU) + (size_t)l * 2 * FF * D, MPAD, 2 * FF, D}; pg8::StaticOrder S; S.init(MPAD, 2 * FF, (int)gridDim.x, (int)blockIdx.x);
        pg8::EpiSwiglu E{WSP(bf16_t, WS_HID)};
        pg8::gemm_phase<pg8::EpiSwiglu, pg8::StaticOrder, true, true>(LDSP(smem), g, S, E);
    }
    else if constexpr (PH == PH_GEMM_DN) {
        ph_gemm_small<FF>(p, WSP(bf16_t, WS_HID) + (size_t)MP * FF, WSP(bf16_t, WS_WDN) + (size_t)l * D * FF, WSP(float, WS_MOD) + (size_t)l * NC * 6144 + 5120, nullptr, smem); __syncthreads();
        pg8::Gemm g{WSP(bf16_t, WS_HID), WSP(bf16_t, WS_WDN) + (size_t)l * D * FF, MP, D, FF}; pg8::StaticOrder S; S.init(MP, D, (int)gridDim.x, (int)blockIdx.x);
        pg8::EpiResidual E{p.out, WSP(float, WS_MOD) + (size_t)l * NC * 6144 + 5120, p.out};
        pg8::gemm_phase<pg8::EpiResidual, pg8::StaticOrder, true, true>(LDSP(smem), g, S, E);
    }
    else if constexpr (PH == PH_FINAL) ph_final_norm(p);
}
template <int PH> __global__ void __launch_bounds__(NTHR, 2) k_phase(P p, int l) { DYN_SMEM(smem); run_phase<PH>(p, l, smem); }


#ifndef __HIP_EMU__
#define LAS __attribute__((address_space(3)))
#define XB_TMO      128
#define XB_XCNT(j)  (256  + 64 * (j))
#define XB_XSUB(j)  (1280 + 64 * (j))
#define XB_XGEN(j)  (2304 + 64 * (j))
#define XB_TOP      3328
#define XB_TOPGEN   3392
#define XCD_BAR_WORDS 3456
#define XB_SPIN_CAP (1u << 18)

__device__ __forceinline__ unsigned xb_ld(unsigned* p)              { return __hip_atomic_load(p, __ATOMIC_RELAXED, __HIP_MEMORY_SCOPE_AGENT); }
__device__ __forceinline__ unsigned xb_add(unsigned* p, unsigned v) { return __hip_atomic_fetch_add(p, v, __ATOMIC_RELAXED, __HIP_MEMORY_SCOPE_AGENT); }
__device__ __forceinline__ unsigned xb_xcc_id() { return (unsigned)__builtin_amdgcn_s_getreg((3 << 11) | 20) & 0xFu; }
#define XB_SPIN(cond, bar) do { unsigned _sp = 0; while (cond) { __builtin_amdgcn_s_sleep(1); \
    if ((++_sp & 255u) == 0u) { if (xb_ld(&(bar)[XB_TMO])) break; if (_sp > XB_SPIN_CAP) { atomicAdd(&(bar)[XB_TMO], 1u); break; } } } } while (0)

struct XcdBarrier {
    unsigned* bar; unsigned x;
    volatile LAS unsigned* st;
};

__device__ __forceinline__ XcdBarrier xcd_barrier_post(unsigned* bar, volatile LAS unsigned* st) {
    XcdBarrier b; b.bar = bar; b.x = xb_xcc_id(); b.st = st;
    if (threadIdx.x == 0) (void)xb_add(&bar[XB_XCNT(b.x)], 1u);
    return b;
}
__device__ __forceinline__ void xcd_barrier_complete(unsigned* bar, unsigned x, unsigned& nloc, unsigned& nx) {
    const unsigned G = gridDim.x * gridDim.y * gridDim.z;
    unsigned sum, cnt, mine, sp = 0u;
    for (;;) {
        sum = 0u; cnt = 0u; mine = 0u;
#pragma unroll
        for (unsigned j = 0; j < 16; ++j) { const unsigned c = xb_ld(&bar[XB_XCNT(j)]); sum += c; cnt += (c > 0u) ? 1u : 0u; mine = (j == x) ? c : mine; }
        if (sum == G) break;
        __builtin_amdgcn_s_sleep(1);
        if ((++sp & 255u) == 0u) { if (xb_ld(&bar[XB_TMO])) break; if (sp > XB_SPIN_CAP) { atomicAdd(&bar[XB_TMO], 1u); break; } }
    }
    nloc = mine > 0u ? mine : 1u; nx = cnt > 0u ? cnt : 1u;
}

__device__ __forceinline__ void xcd_barrier(const XcdBarrier& b) {
    asm volatile("s_waitcnt vmcnt(0)" ::: "memory");
    __syncthreads();
    if (threadIdx.x == 0) {
        unsigned* bar = b.bar;
        __builtin_amdgcn_s_waitcnt(0);
        unsigned nloc = b.st[0], nx = b.st[1];
        if (nloc == 0u) { xcd_barrier_complete(bar, b.x, nloc, nx); b.st[0] = nloc; b.st[1] = nx; }
        const unsigned old = xb_add(&bar[XB_XSUB(b.x)], 1u);
        const unsigned gen = old / nloc;
        if (old + 1u == (gen + 1u) * nloc) {
            __builtin_amdgcn_fence(__ATOMIC_RELEASE, "agent");
            asm volatile("s_waitcnt vmcnt(0)" ::: "memory");
            const unsigned og = xb_add(&bar[XB_TOP], 1u);
            const unsigned tg = og / nx;
            if (og + 1u == (tg + 1u) * nx) xb_add(&bar[XB_TOPGEN], 1u);
            else XB_SPIN(xb_ld(&bar[XB_TOPGEN]) == tg, bar);
            __builtin_amdgcn_fence(__ATOMIC_ACQUIRE, "agent");
            xb_add(&bar[XB_XGEN(b.x)], 1u);
            asm volatile("s_waitcnt vmcnt(0)" ::: "memory");
        } else {
            XB_SPIN(xb_ld(&bar[XB_XGEN(b.x)]) == gen, bar);
            __builtin_amdgcn_fence(__ATOMIC_ACQUIRE, "agent");
            asm volatile("s_waitcnt vmcnt(0)" ::: "memory");
        }
    }
    __syncthreads();
}

#endif

#ifndef __HIP_EMU__
#define GRID_SYNC() xcd_barrier(bar)
__global__ void __launch_bounds__(NTHR, 2) k_mega(P p_arg) {
    DYN_SMEM(smem);
#if defined(__HIP_DEVICE_COMPILE__)
#define PHASE(PH_, l_) do { const __attribute__((address_space(4))) P* kp_ = (const __attribute__((address_space(4))) P*)__builtin_amdgcn_kernarg_segment_ptr(); LAUNDER_PTR(kp_); P pl_; __builtin_memcpy(&pl_, kp_, sizeof(P)); run_phase<PH_>(pl_, l_, smem); } while (0)
#else
#define PHASE(PH_, l_) run_phase<PH_>(p_arg, l_, smem)
#endif
    volatile LAS unsigned* bst = (volatile LAS unsigned*)((LAS unsigned char*)smem + BAR_LDS_OFF);
    if (threadIdx.x < 4) bst[threadIdx.x] = 0u;
    __syncthreads();
    XcdBarrier bar = xcd_barrier_post((unsigned*)(p_arg.ws + WS_CTL + 4096), bst);
    PHASE(PH_PRO, 0); GRID_SYNC();
#define LAYER(l) do { PHASE(PH_NORM1, l); GRID_SYNC(); PHASE(PH_GEMM_IN, l); GRID_SYNC(); PHASE(PH_ROPE, l); GRID_SYNC(); PHASE(PH_MIX1, l); GRID_SYNC(); PHASE(PH_MIX2, l); GRID_SYNC(); \
        PHASE(PH_MIX3, l); GRID_SYNC(); PHASE(PH_GEMM_OUT, l); GRID_SYNC(); PHASE(PH_NORM2, l); GRID_SYNC(); PHASE(PH_GEMM_GU, l); GRID_SYNC(); PHASE(PH_GEMM_DN, l); GRID_SYNC(); } while (0)
    static_assert(NL == 2, "two layers written out (a loop over the layers makes hipcc hoist every phase's constants to the loop preheader and spill)");
    LAYER(0); LAYER(1);
    PHASE(PH_FINAL, 0);
}
#endif

template <int PH> static void launch_phase(const P& p, int l, int grid, hipStream_t stream) {
#ifndef __HIP_EMU__
    static bool attr_done = false;
    if (!attr_done) { (void)hipFuncSetAttribute((const void*)k_phase<PH>, hipFuncAttributeMaxDynamicSharedMemorySize, SMEM_BYTES); attr_done = true; }
#endif
    LAUNCH(k_phase<PH>, grid, SMEM_BYTES, stream, p, l);
}

extern "C" void kernel_launch(void* const* d_in, const int* in_sizes, int n_in, void* d_out, int out_size, void* d_ws, size_t ws_size, hipStream_t stream) {
    if (n_in != 24 || (size_t)out_size != O_END || ws_size < WS_END) {
        fprintf(stderr, "kernel_launch: shape mismatch: n_in %d out_size %d (want %zu) ws %zu (want %zu)\n", n_in, out_size, (size_t)O_END, ws_size, (size_t)WS_END); return; }
    P p{};
    const float** pp = (const float**)&p;
    for (int i = 0; i < 24; ++i) pp[i] = (const float*)d_in[i];
    p.out = (float*)d_out; p.ws = (unsigned char*)d_ws;
#ifndef __HIP_EMU__
    static int grid = 0;
    if (grid == 0) {
        int dev = 0, cus = 0, per_cu = 0;
        if (hipGetDevice(&dev) != hipSuccess || hipDeviceGetAttribute(&cus, hipDeviceAttributeMultiprocessorCount, dev) != hipSuccess || cus <= 0) { fprintf(stderr, "kernel_launch: device query failed\n"); grid = -1; return; }
        if (hipFuncSetAttribute((const void*)k_mega, hipFuncAttributeMaxDynamicSharedMemorySize, SMEM_BYTES) != hipSuccess) { fprintf(stderr, "kernel_launch: hipFuncSetAttribute failed\n"); grid = -1; return; }
        if (hipOccupancyMaxActiveBlocksPerMultiprocessor(&per_cu, (const void*)k_mega, NTHR, SMEM_BYTES) != hipSuccess || per_cu < 1) { fprintf(stderr, "kernel_launch: occupancy query says %d blocks per CU\n", per_cu); grid = -1; return; }
        grid = cus;
    }
    if (grid < 0) return;
    if (hipMemsetAsync((char*)d_ws + WS_CTL, 0, 65536, stream) != hipSuccess) { fprintf(stderr, "kernel_launch: memset of the barrier words failed\n"); return; }
    { void* args[] = {(void*)&p};
      hipError_t e = hipLaunchCooperativeKernel((const void*)k_mega, dim3(grid), dim3(NTHR), args, SMEM_BYTES, stream);
      if (e != hipSuccess) fprintf(stderr, "kernel_launch: cooperative launch failed: %s (grid %d)\n", hipGetErrorString(e), grid);
      return; }
#else
    int grid = 16;
#endif
    launch_phase<PH_PRO>(p, 0, grid, stream);
    for (int l = 0; l < NL; ++l) {
        launch_phase<PH_NORM1>(p, l, grid, stream);
        launch_phase<PH_GEMM_IN>(p, l, grid, stream);
        launch_phase<PH_ROPE>(p, l, grid, stream);
        launch_phase<PH_MIX1>(p, l, grid, stream);
        launch_phase<PH_MIX2>(p, l, grid, stream);
        launch_phase<PH_MIX3>(p, l, grid, stream);
        launch_phase<PH_GEMM_OUT>(p, l, grid, stream);
        launch_phase<PH_NORM2>(p, l, grid, stream);
        launch_phase<PH_GEMM_GU>(p, l, grid, stream);
        launch_phase<PH_GEMM_DN>(p, l, grid, stream);
    }
    launch_phase<PH_FINAL>(p, 0, grid, stream);
}
```

```cpp
#ifndef __HIP_EMU__
#include <hip/hip_runtime.h>
#include <hip/hip_cooperative_groups.h>
#endif
#include <cstdio>
#include <cstdint>
#include <cmath>

#ifndef CFG_BATCH
#define CFG_BATCH 2
#endif
#ifndef CFG_SEQ
#define CFG_SEQ 8192
#endif
#ifndef CFG_DB
#define CFG_DB 32
#endif
constexpr float LOG2E = 1.4426950408889634f;
constexpr int D = 1024, NL = 2, PB = CFG_BATCH, T = CFG_SEQ, DB = CFG_DB, DS = 8, PAST = 16384, WB = 2048;
constexpr int MP = PB * T, MS = DB * DS, M = MP + MS, MPAD = (M + 255) / 256 * 256, NC = PB + DB;
constexpr int INC = 3848, NPROJ = 3840, FF = 2816, NCH = T / 64, PWIN = T < 2048 ? T : 2048, NPOS = T + DS;
constexpr int NUNIT = PB * 4 * NCH;
constexpr float EPS = 1e-6f;
static_assert(T % 512 == 0, "the attention job decomposition wants T % 512 == 0");
constexpr int C_QA = 0, C_KA = 256, C_VA = 512, C_QR = 768, C_KR = 1024, C_VR = 1280, C_GR = 1536, C_CONV = 1792, C_Z = 3328;
constexpr int SMEM_BYTES = 148480;
constexpr int NTHR = 512;
constexpr int BAR_LDS_OFF = SMEM_BYTES - 64;

typedef unsigned short bf16_t;
typedef short bf16x8 __attribute__((ext_vector_type(8)));
typedef float f32x4 __attribute__((ext_vector_type(4)));
typedef unsigned u32x4 __attribute__((ext_vector_type(4)));
typedef unsigned u32x2 __attribute__((ext_vector_type(2)));
typedef float f32x16 __attribute__((ext_vector_type(16)));

#ifdef __HIP_EMU__
#define LAUNCH(kern, grid, lds, stream, ...) emu_launch(grid, NTHR, [=]() { kern(__VA_ARGS__); })
#define DYN_SMEM(name) unsigned char* name = emu_dyn_smem()
#define WAVE_SYNC() emu_wave_bar()
#define MFMA32(a, b, c) emu_mfma32(a, b, c)
#define GLDS16(gp, lp) memcpy((unsigned char*)(lp) + (threadIdx.x & 63) * 16, (gp), 16)
#define RAW_BARRIER() __syncthreads()
#define GLDS4(gp, lp) ((void)0)
#define WAIT_VM(n)
#define WAIT_LGKM0()
#define LAS
#define UNIFORM(x) (x)
#define COMPILER_FENCE()
#define LAUNDER_V(x)
#define DRAIN_VM()
#define MFMA16(a, b, c) emu_mfma16(a, b, c)
#else
#define WAVE_SYNC() asm volatile("s_waitcnt lgkmcnt(0)" ::: "memory")
#define MFMA32(a, b, c) __builtin_amdgcn_mfma_f32_32x32x16_bf16(a, b, c, 0, 0, 0)
#define LAS __attribute__((address_space(3)))
#define GLDS16(gp, lp) __builtin_amdgcn_global_load_lds((const unsigned*)(gp), (LAS unsigned*)(lp), 16, 0, 0)
#define RAW_BARRIER() __builtin_amdgcn_s_barrier()
#define GLDS4(gp, lp) __builtin_amdgcn_global_load_lds((const unsigned*)(gp), (LAS unsigned*)(lp), 4, 0, 0)
#define WAIT_VM(n) asm volatile("s_waitcnt vmcnt(" #n ")" ::: "memory")
#define WAIT_LGKM0() asm volatile("s_waitcnt lgkmcnt(0)" ::: "memory")
#define UNIFORM(x) __builtin_amdgcn_readfirstlane(x)
#define COMPILER_FENCE() __builtin_amdgcn_sched_barrier(0)
#define DRAIN_VM() asm volatile("s_waitcnt vmcnt(0)" ::: "memory")
#define LAUNDER_V(x) asm volatile("" : "+v"(x))
#define MFMA16(a, b, c) __builtin_amdgcn_mfma_f32_16x16x32_bf16(a, b, c, 0, 0, 0)
#define LAUNCH(kern, grid, lds, stream, ...) hipLaunchKernelGGL(kern, dim3(grid), dim3(NTHR), lds, stream, __VA_ARGS__)
#define DYN_SMEM(name) extern __shared__ __attribute__((aligned(16))) unsigned char name[]
#endif

#ifdef __HIP_EMU__
__device__ __forceinline__ int tidx() { return (int)threadIdx.x; }
#define LAUNDER_PTR(x)
#else
__device__ __forceinline__ int tidx() { int t = (int)threadIdx.x; asm volatile("" : "+v"(t)); return t; }
#define LAUNDER_PTR(x) asm volatile("" : "+s"(x))
#endif
__device__ __forceinline__ float bf2f(bf16_t v) { return __builtin_bit_cast(float, (unsigned)v << 16); }
__device__ __forceinline__ bf16_t f2bf(float f) { unsigned u = __builtin_bit_cast(unsigned, f); return (bf16_t)((u + 0x7fffu + ((u >> 16) & 1u)) >> 16); }
#ifdef __HIP_EMU__
__device__ __forceinline__ unsigned pk2(float lo, float hi) { return (unsigned)f2bf(lo) | ((unsigned)f2bf(hi) << 16); }
#else
typedef float f32x2_t __attribute__((ext_vector_type(2))); typedef __bf16 bf16x2_t __attribute__((ext_vector_type(2)));
__device__ __forceinline__ unsigned pk2(float lo, float hi) { f32x2_t v = {lo, hi}; bf16x2_t b = __builtin_convertvector(v, bf16x2_t); return __builtin_bit_cast(unsigned, b); }
#endif
__device__ __forceinline__ bf16x8 pack_tiles(const f32x4& lo, const f32x4& hi) {
    u32x4 w; w.x = pk2(lo[0], lo[1]); w.y = pk2(lo[2], lo[3]); w.z = pk2(hi[0], hi[1]); w.w = pk2(hi[2], hi[3]); return __builtin_bit_cast(bf16x8, w);
}
__device__ __forceinline__ float silu_f(float x) { return x / (1.0f + expf(-x)); }
#ifdef __HIP_EMU__
__device__ __forceinline__ float silu_fast(float x) { return x / (1.0f + expf(-x)); }
#else
__device__ __forceinline__ float silu_fast(float x) { return x * __builtin_amdgcn_rcpf(1.0f + __builtin_amdgcn_exp2f(-LOG2E * x)); }
#endif
__device__ __forceinline__ float wave_sum(float v) {
#pragma unroll
    for (int o = 1; o < 64; o <<= 1) v += __shfl_xor(v, o);
    return v;
}
__device__ __forceinline__ float wave_max(float v) {
#pragma unroll
    for (int o = 1; o < 64; o <<= 1) v = fmaxf(v, __shfl_xor(v, o));
    return v;
}

struct P {
    const float *x_prompt, *x_sample, *cache_k, *cache_v, *state_ret, *state_gdn, *state_conv, *c_prompt, *c_sample, *ada_w, *ada_b, *norm_mix, *norm_ffn,
        *w_in, *ret_norm, *conv_w, *a_log, *dt_bias, *gdn_norm, *w_out, *w_gate, *w_up, *w_down, *final_norm;
    float* out; unsigned char* ws;
};

constexpr size_t O_YP = 0, O_YS = O_YP + (size_t)MP * D, O_PWK = O_YS + (size_t)MS * D, O_PWV = O_PWK + (size_t)NL * PB * PWIN * 256,
                 O_PRET = O_PWV + (size_t)NL * PB * PWIN * 256, O_PGDN = O_PRET + (size_t)NL * PB * 4 * 4096, O_PCONV = O_PGDN + (size_t)NL * PB * 4 * 16384,
                 O_SWK = O_PCONV + (size_t)NL * PB * 3 * 1536, O_SWV = O_SWK + (size_t)NL * DB * DS * 256, O_SRET = O_SWV + (size_t)NL * DB * DS * 256,
                 O_SGDN = O_SRET + (size_t)NL * DB * 4 * 4096, O_SCONV = O_SGDN + (size_t)NL * DB * 4 * 16384, O_END = O_SCONV + (size_t)NL * DB * 3 * 1536;

constexpr size_t al256(size_t x) { return (x + 255) / 256 * 256; }
constexpr size_t WS_CTL = 0, WS_CTL_BYTES = 1u << 20;
constexpr size_t WS_MOD = WS_CTL + WS_CTL_BYTES;
constexpr size_t WS_W8 = al256(WS_MOD + (size_t)NL * NC * 6144 * 4);
constexpr size_t WS_ROPE = al256(WS_W8 + (size_t)NL * D * 8 * 4);
constexpr size_t WS_WIN = al256(WS_ROPE + (size_t)4 * NPOS * 32 * 4);
constexpr size_t WS_WOUT = al256(WS_WIN + (size_t)NL * NPROJ * D * 2);
constexpr size_t WS_WGU = al256(WS_WOUT + (size_t)NL * D * D * 2);
constexpr size_t WS_WDN = al256(WS_WGU + (size_t)NL * 2 * FF * D * 2);
constexpr size_t WS_H = al256(WS_WDN + (size_t)NL * D * FF * 2);
constexpr size_t WS_PROJ = al256(WS_H + (size_t)MPAD * D * 2);
constexpr size_t WS_BETA = al256(WS_PROJ + (size_t)MPAD * NPROJ * 2);
constexpr size_t WS_G = al256(WS_BETA + (size_t)M * 4 * 4);
constexpr size_t WS_O = al256(WS_G + (size_t)M * 4 * 4);
constexpr size_t WS_RU = al256(WS_O + (size_t)MPAD * D * 2);
constexpr size_t WS_RS = al256(WS_RU + (size_t)NUNIT * 4096 * 4);
constexpr size_t WS_SCR = al256(WS_RS + (size_t)NUNIT * 4096 * 4);
constexpr size_t WS_GU = WS_SCR;
constexpr size_t WS_GWK = al256(WS_GU + (size_t)NUNIT * 8192 * 2);
constexpr size_t WS_GQ = al256(WS_GWK + (size_t)NUNIT * 16384 * 2);
constexpr size_t WS_GA = al256(WS_GQ + (size_t)NUNIT * 8192 * 2);
constexpr size_t WS_GD = al256(WS_GA + (size_t)NUNIT * 4096 * 2);
constexpr size_t WS_GV = al256(WS_GD + (size_t)NUNIT * 4);
constexpr size_t WS_GS = al256(WS_GV + (size_t)NUNIT * 8192 * 2);
constexpr size_t WS_GEND = al256(WS_GS + (size_t)NUNIT * 16384 * 2);
constexpr size_t ATT_CLS = (size_t)PB * 4 * (T / 32) * 2048;
constexpr size_t WS_KF = WS_GEND;
constexpr size_t WS_VF = al256(WS_KF + 3 * ATT_CLS * 2);
constexpr size_t WS_KRT = al256(WS_VF + 3 * ATT_CLS * 2);
constexpr size_t WS_VRT = al256(WS_KRT + (size_t)MP * 256 * 2);
constexpr size_t WS_AML = al256(WS_VRT + (size_t)MP * 256 * 2);
constexpr size_t WS_AEND = al256(WS_AML + (size_t)MP * 4 * 3 * 2 * 4);
constexpr size_t WS_APO = WS_H;
static_assert((size_t)MP * 4 * 3 * 64 * 2 <= (size_t)MPAD * D * 2, "attention partials overlay H");
constexpr size_t WS_HID = WS_SCR;
constexpr size_t WS_HEND = al256(WS_HID + (size_t)MPAD * FF * 2);
constexpr size_t WS_END = WS_AEND > WS_HEND ? WS_AEND : WS_HEND;

#define WSP(T_, off) ((T_*)(p.ws + (off)))
__device__ __forceinline__ int row_cb(int r) { return r < MP ? r / T : PB + (r - MP) / DS; }
__device__ __forceinline__ int row_pi(int r) { return r < MP ? r % T : T + (r - MP) % DS; }
namespace pg8 {
#ifdef __HIP_EMU__
#define PG8_LAS
#else
#define PG8_LAS __attribute__((address_space(3)))
#endif
typedef unsigned short bf16_t;
typedef short bf16x8 __attribute__((ext_vector_type(8)));
typedef float f32x4 __attribute__((ext_vector_type(4)));
typedef unsigned u32x4 __attribute__((ext_vector_type(4)));
constexpr int BM = 256, BK = 64, HALF = 128, HTB = HALF * BK * 2  , STAGE_BYTES = 8 * HTB, NXCD = 8, WGM = 8;

__host__ __device__ __forceinline__ int lds_byte(int r, int c) { const int st = (r >> 4) * 2 + (c >> 5), rr = r & 15, cc = c & 31, ob = rr * 64 + cc * 2; return st * 1024 + (ob ^ (((ob >> 9) & 1) << 5)); }
__host__ __device__ __forceinline__ void stage_rc(int b, int& R, int& C) { const int st = b / 1024, sb = b % 1024, swz = sb ^ (((sb >> 9) & 1) << 5); R = (st >> 1) * 16 + swz / 64; C = (st & 1) * 32 + (swz % 64) / 2; }
__host__ __device__ __forceinline__ int perm32(int rho) { const int n = rho >> 4, i = rho & 15; return 8 * (i >> 2) + 4 * n + (i & 3); }

struct Unit { int pm, pn; };
struct Gemm { const bf16_t* A; const bf16_t* Bt; int M, N, K; };

struct StaticOrder {
    int nM, nN, nwg, G, c;
    __host__ __device__ void init(int M, int N, int G_, int c_) { nM = M / BM; nN = N / BM; nwg = nM * nN; G = G_; c = c_; }
    __host__ __device__ bool next(int i, Unit& u) const {
        const long L = (long)i * G + c; if (L >= nwg) return false;
        int wgid = (int)L; { const int q = nwg / NXCD, r = nwg % NXCD, xcd = wgid % NXCD, off = wgid / NXCD; wgid = (xcd < r ? xcd * (q + 1) : r * (q + 1) + (xcd - r) * q) + off; }
        const int nig = WGM * nN, gid = wgid / nig, fm = gid * WGM, gsz = (nM - fm) < WGM ? (nM - fm) : WGM;
        u.pm = fm + ((wgid % nig) % gsz); u.pn = (wgid % nig) / gsz; return true;
    }
    __device__ __forceinline__ void a_ready(const Unit&) const {}
    __device__ __forceinline__ void done(const Unit&) const {}
};


struct EpiStoreBf16 {
    static constexpr bool PERM = true, AFTER_DRAIN = false;
    bf16_t* O; int ldc;
    __device__ __forceinline__ void operator()(const f32x4 (&acc)[2][2][4][2], const Unit& u, int wr, int wc, int fr, int fq) const {
        const int row0 = u.pm * BM + wr * 64 + fr, col0 = u.pn * BM + wc * 32 + 8 * fq;
#pragma unroll
        for (int ai = 0; ai < 2; ++ai)
#pragma unroll
            for (int m = 0; m < 4; ++m) { bf16_t* rowp = O + (size_t)(row0 + ai * HALF + m * 16) * ldc + col0;
#pragma unroll
                for (int bj = 0; bj < 2; ++bj) { const f32x4 v0 = acc[ai][bj][m][0], v1 = acc[ai][bj][m][1];
                    u32x4 w; w.x = ::pk2(v0[0], v0[1]); w.y = ::pk2(v0[2], v0[3]); w.z = ::pk2(v1[0], v1[1]); w.w = ::pk2(v1[2], v1[3]);
                    *(u32x4*)(rowp + bj * HALF) = w; } }
    }
};
struct EpiResidual {
    static constexpr bool PERM = false, AFTER_DRAIN = false;
    float* X; const float* gate; const float* Xin;
    __device__ __forceinline__ void operator()(const f32x4 (&acc)[2][2][4][2], const Unit& u, int wr, int wc, int fr, int fq) const {
        const int row0 = u.pm * BM + wr * 64 + fr, col0 = u.pn * BM + wc * 32 + 4 * fq;
#pragma unroll
        for (int ai = 0; ai < 2; ++ai)
#pragma unroll
            for (int m = 0; m < 4; ++m) { const int row = row0 + ai * HALF + m * 16;
                if (MPAD != M && row >= M) continue;
                const float* g = gate + (size_t)::row_cb(row) * 6144 + col0; float* xp = X + (size_t)row * D + col0; const float* xi = Xin + (size_t)row * D + col0;
#pragma unroll
                for (int bj = 0; bj < 2; ++bj)
#pragma unroll
                    for (int n = 0; n < 2; ++n) { const f32x4 gv = *(const f32x4*)(g + bj * HALF + n * 16); f32x4* xq = (f32x4*)(xp + bj * HALF + n * 16); *xq = *(const f32x4*)(xi + bj * HALF + n * 16) + gv * acc[ai][bj][m][n]; } }
    }
};
struct EpiSwiglu {
    static constexpr bool PERM = true, AFTER_DRAIN = false;
    bf16_t* Hd;
    __device__ __forceinline__ void operator()(const f32x4 (&acc)[2][2][4][2], const Unit& u, int wr, int wc, int fr, int fq) const {
        const int row0 = u.pm * BM + wr * 64 + fr, col0 = u.pn * HALF + wc * 32 + 8 * fq;
#pragma unroll
        for (int ai = 0; ai < 2; ++ai)
#pragma unroll
            for (int m = 0; m < 4; ++m) { bf16_t* rowp = Hd + (size_t)(row0 + ai * HALF + m * 16) * FF + col0;
                float v[8];
#pragma unroll
                for (int n = 0; n < 2; ++n)
#pragma unroll
                    for (int j = 0; j < 4; ++j) { const float gt = acc[ai][0][m][n][j], up = acc[ai][1][m][n][j]; v[4 * n + j] = ::silu_fast(gt) * up; }
                u32x4 w; w.x = ::pk2(v[0], v[1]); w.y = ::pk2(v[2], v[3]); w.z = ::pk2(v[4], v[5]); w.w = ::pk2(v[6], v[7]);
                *(u32x4*)rowp = w; }
    }
};

#ifdef __HIP_EMU__
template <class Epi, class Sched, bool ALIGN_EPI = false, bool SP2 = false>
__device__ __forceinline__ void gemm_phase(unsigned char* lds, const Gemm g, const Sched& S, const Epi& E) {
    const int tid = threadIdx.x, wid = tid >> 6, lane = tid & 63, wr = wid >> 2, wc = wid & 3, fr = lane & 15, fq = lane >> 4;
    Unit cur;
    for (int ui = 0; S.next(ui, cur); ++ui) {
        f32x4 acc[2][2][4][2];
        for (int ai = 0; ai < 2; ++ai) for (int bj = 0; bj < 2; ++bj) for (int m = 0; m < 4; ++m) for (int n = 0; n < 2; ++n) for (int j = 0; j < 4; ++j) {
            const int row = 256 * cur.pm + 128 * ai + 64 * wr + 16 * m + fr;
            const int col = Epi::PERM ? 256 * cur.pn + 128 * bj + 32 * wc + 8 * fq + 4 * n + j : 256 * cur.pn + 128 * bj + 32 * wc + 16 * n + 4 * fq + j;
            const bf16_t* a = g.A + (size_t)row * g.K; const bf16_t* b = g.Bt + (size_t)col * g.K; float s = 0.f;
            for (int k = 0; k < g.K; ++k) s += ::bf2f(a[k]) * ::bf2f(b[k]);
            acc[ai][bj][m][n][j] = s; }
        E(acc, cur, wr, wc, fr, fq);
    }
}
#else
template <class Epi, class Sched, bool ALIGN_EPI = false, bool SP2 = false>
__device__ __forceinline__ void gemm_phase(PG8_LAS unsigned char* lds, const Gemm g, const Sched& S, const Epi& E) {
    const int tid = ::tidx(), wid = __builtin_amdgcn_readfirstlane(tid >> 6), lane = tid & 63, wr = wid >> 2, wc = wid & 3, fr = lane & 15, fq = lane >> 4;
    const int K = g.K, nt = K / BK;
    unsigned voffA[2], voffB[2];
#pragma unroll
    for (int i = 0; i < 2; ++i) { int R, C; stage_rc(tid * 16 + i * 8192, R, C); const int Rb = Epi::PERM ? ((R & ~31) + perm32(R & 31)) : R;
        voffA[i] = (unsigned)(R * K + C) * 2u; voffB[i] = (unsigned)(Rb * K + C) * 2u; }
    const size_t kstep = (size_t)(BK * 2);
    const size_t hstep = (size_t)HALF * K * 2;
    const size_t tstep = 2 * hstep;
    const unsigned ldsw = (unsigned)wid * 1024u;
    const int aoff = lds_byte(wr * 64 + fr, fq * 8), boff = lds_byte(wc * 32 + fr, fq * 8);
#define PG8_SA(b, h) (((b) * 2 + (h)) * HTB)
#define PG8_SB(b, h) ((4 + (b) * 2 + (h)) * HTB)
#define PG8_STAGE(bufoff, gbase, voff) do { _Pragma("unroll") for (int _i = 0; _i < 2; ++_i) \
        __builtin_amdgcn_global_load_lds((const unsigned*)((const char*)(gbase) + (voff)[_i]), (PG8_LAS unsigned*)(lds + (bufoff) + ldsw + _i * 8192), 16, 0, 0); } while (0)
#define PG8_LDA(dst, b, h) do { _Pragma("unroll") for (int m = 0; m < 4; ++m) _Pragma("unroll") for (int k = 0; k < 2; ++k) dst[m][k] = *(const PG8_LAS bf16x8*)(lds + PG8_SA(b, h) + aoff + m * 2048 + k * 1024); } while (0)
#define PG8_LDB(dst, b, h) do { _Pragma("unroll") for (int n = 0; n < 2; ++n) _Pragma("unroll") for (int k = 0; k < 2; ++k) dst[n][k] = *(const PG8_LAS bf16x8*)(lds + PG8_SB(b, h) + boff + n * 2048 + k * 1024); } while (0)
#define PG8_MMA(ai, bj, At, Bt) do { __builtin_amdgcn_s_setprio(1); _Pragma("unroll") for (int m = 0; m < 4; ++m) _Pragma("unroll") for (int n = 0; n < 2; ++n) _Pragma("unroll") for (int k = 0; k < 2; ++k) \
        acc[ai][bj][m][n] = __builtin_amdgcn_mfma_f32_16x16x32_bf16(Bt[n][k], At[m][k], acc[ai][bj][m][n], 0, 0, 0); __builtin_amdgcn_s_setprio(0); } while (0)
#define PG8_WAIT_V(n) asm volatile("s_waitcnt vmcnt(" #n ")" ::: "memory")
#define PG8_WAIT_L(n) asm volatile("s_waitcnt lgkmcnt(" #n ")" ::: "memory")
#define PG8_BAR __builtin_amdgcn_s_barrier()
#define PG8_SCHED __builtin_amdgcn_sched_barrier(0)
    Unit cur, nxt; int ui = 0;
    if (!S.next(0, cur)) return;
    f32x4 acc[2][2][4][2];
#pragma unroll
    for (int a = 0; a < 2; ++a)
#pragma unroll
        for (int b = 0; b < 2; ++b)
#pragma unroll
            for (int m = 0; m < 4; ++m)
#pragma unroll
                for (int n = 0; n < 2; ++n) acc[a][b][m][n] = (f32x4){0.f, 0.f, 0.f, 0.f};
    bf16x8 At[4][2], B0[2][2], B1[2][2];
    const char* cA = (const char*)g.A + (size_t)cur.pm * tstep; const char* cB = (const char*)g.Bt + (size_t)cur.pn * tstep;
    S.a_ready(cur);
    if constexpr (SP2) {
        PG8_STAGE(PG8_SB(0, 0), cB, voffB); PG8_STAGE(PG8_SB(0, 1), cB + hstep, voffB); PG8_STAGE(PG8_SA(0, 0), cA, voffA); PG8_STAGE(PG8_SA(0, 1), cA + hstep, voffA);
        if (wr == 1) PG8_BAR;
        PG8_WAIT_V(2); PG8_BAR;
        PG8_STAGE(PG8_SB(1, 0), cB + kstep, voffB); PG8_STAGE(PG8_SA(1, 0), cA + kstep, voffA); PG8_STAGE(PG8_SB(1, 1), cB + hstep + kstep, voffB);
        PG8_WAIT_V(6); PG8_BAR;
    } else {
        PG8_STAGE(PG8_SB(0, 0), cB, voffB); PG8_STAGE(PG8_SA(0, 0), cA, voffA); PG8_STAGE(PG8_SB(0, 1), cB + hstep, voffB); PG8_STAGE(PG8_SA(0, 1), cA + hstep, voffA);
        if (wr == 1) PG8_BAR;
        PG8_WAIT_V(4); PG8_BAR;
        PG8_STAGE(PG8_SB(1, 0), cB + kstep, voffB); PG8_STAGE(PG8_SA(1, 0), cA + kstep, voffA); PG8_STAGE(PG8_SB(1, 1), cB + hstep + kstep, voffB);
        PG8_WAIT_V(6); PG8_BAR;
    }
    for (;;) {
        const bool has_next = S.next(ui + 1, nxt);
        const char* nA = has_next ? (const char*)g.A + (size_t)nxt.pm * tstep : cA; const char* nB = has_next ? (const char*)g.Bt + (size_t)nxt.pn * tstep : cB;
        for (int t = 0; t < nt; t += 2) {
            const bool last = (t == nt - 2);
            const char* a1 = cA + (size_t)(t + 1) * kstep;
            const char* a2 = last ? nA : cA + (size_t)(t + 2) * kstep; const char* b2 = last ? nB : cB + (size_t)(t + 2) * kstep;
            const char* a3 = a2 + kstep; const char* b3 = b2 + kstep;
            if (last && has_next) S.a_ready(nxt);
            if constexpr (SP2) {
            PG8_LDB(B0, 0, 0); PG8_LDB(B1, 0, 1); PG8_SCHED; PG8_LDA(At, 0, 0); PG8_STAGE(PG8_SA(1, 1), a1 + hstep, voffA);
            PG8_WAIT_V(8); PG8_WAIT_L(0); PG8_BAR; PG8_MMA(0, 0, At, B0); PG8_MMA(0, 1, At, B1); PG8_BAR; PG8_SCHED;
            PG8_LDA(At, 0, 1); PG8_STAGE(PG8_SB(0, 0), b2, voffB); PG8_STAGE(PG8_SB(0, 1), b2 + hstep, voffB); PG8_STAGE(PG8_SA(0, 0), a2, voffA);
            PG8_WAIT_V(8); PG8_WAIT_L(0); PG8_BAR; PG8_MMA(1, 0, At, B0); PG8_MMA(1, 1, At, B1); PG8_BAR; PG8_SCHED;
            PG8_LDB(B0, 1, 0); PG8_LDB(B1, 1, 1); PG8_SCHED; PG8_LDA(At, 1, 0); PG8_STAGE(PG8_SA(0, 1), a2 + hstep, voffA);
            PG8_WAIT_V(8); PG8_WAIT_L(0); PG8_BAR; PG8_MMA(0, 0, At, B0); PG8_MMA(0, 1, At, B1); PG8_BAR; PG8_SCHED;
            PG8_LDA(At, 1, 1); PG8_STAGE(PG8_SB(1, 0), b3, voffB); PG8_STAGE(PG8_SB(1, 1), b3 + hstep, voffB); PG8_STAGE(PG8_SA(1, 0), a3, voffA);
            PG8_WAIT_V(8); PG8_WAIT_L(0); PG8_BAR; PG8_MMA(1, 0, At, B0); PG8_MMA(1, 1, At, B1); PG8_BAR; PG8_SCHED;
            } else {
            PG8_LDB(B0, 0, 0); PG8_SCHED; PG8_LDA(At, 0, 0); PG8_STAGE(PG8_SA(1, 1), a1 + hstep, voffA);
            PG8_WAIT_L(8); PG8_BAR; PG8_WAIT_L(0); PG8_MMA(0, 0, At, B0); PG8_BAR; PG8_SCHED;
            PG8_LDB(B1, 0, 1); PG8_STAGE(PG8_SB(0, 0), b2, voffB);
            PG8_BAR; PG8_WAIT_L(0); PG8_MMA(0, 1, At, B1); PG8_BAR;
            PG8_LDA(At, 0, 1); PG8_STAGE(PG8_SA(0, 0), a2, voffA);
            PG8_BAR; PG8_WAIT_L(0); PG8_MMA(1, 0, At, B0); PG8_BAR; PG8_SCHED;
            PG8_STAGE(PG8_SB(0, 1), b2 + hstep, voffB);
            PG8_WAIT_V(6); PG8_BAR; PG8_MMA(1, 1, At, B1); PG8_BAR;
            PG8_LDB(B0, 1, 0); PG8_SCHED; PG8_LDA(At, 1, 0); PG8_STAGE(PG8_SA(0, 1), a2 + hstep, voffA);
            PG8_WAIT_L(8); PG8_BAR; PG8_WAIT_L(0); PG8_MMA(0, 0, At, B0); PG8_BAR; PG8_SCHED;
            PG8_LDB(B1, 1, 1); PG8_STAGE(PG8_SB(1, 0), b3, voffB);
            PG8_BAR; PG8_WAIT_L(0); PG8_MMA(0, 1, At, B1); PG8_BAR;
            PG8_LDA(At, 1, 1); PG8_STAGE(PG8_SA(1, 0), a3, voffA);
            PG8_BAR; PG8_WAIT_L(0); PG8_MMA(1, 0, At, B0); PG8_BAR; PG8_SCHED;
            PG8_STAGE(PG8_SB(1, 1), b3 + hstep, voffB);
            PG8_WAIT_V(6); PG8_BAR; PG8_MMA(1, 1, At, B1); PG8_BAR;
            }
        }
        if constexpr (ALIGN_EPI) { if (wr == 0) PG8_BAR; }
        if constexpr (!Epi::AFTER_DRAIN) { E(acc, cur, wr, wc, fr, fq); S.done(cur); }
        if (!has_next) break;
#pragma unroll
        for (int a = 0; a < 2; ++a)
#pragma unroll
            for (int b = 0; b < 2; ++b)
#pragma unroll
                for (int m = 0; m < 4; ++m)
#pragma unroll
                    for (int n = 0; n < 2; ++n) acc[a][b][m][n] = (f32x4){0.f, 0.f, 0.f, 0.f};
        cur = nxt; cA = nA; cB = nB; ++ui;
        if constexpr (ALIGN_EPI) { if (wr == 1) PG8_BAR; }
    }
    PG8_WAIT_V(0);
    if constexpr (!ALIGN_EPI) { if (wr == 0) PG8_BAR; }
    PG8_BAR;
    if constexpr (Epi::AFTER_DRAIN) { E.fused(acc, cur, wr, wc, fr, fq, lds, wid, lane); S.done(cur); }
#undef PG8_SA
#undef PG8_SB
#undef PG8_STAGE
#undef PG8_LDA
#undef PG8_LDB
#undef PG8_MMA
#undef PG8_WAIT_V
#undef PG8_WAIT_L
#undef PG8_BAR
#undef PG8_SCHED
}
#endif
}


__device__ __forceinline__ void transpose_item(const float* W, int ldw, bf16_t* WT, int K, int k0, int n0, int drow0, float* scr, int lane) {
    float wv[32];
#pragma unroll
    for (int i = 0; i < 32; ++i) wv[i] = W[(size_t)(k0 + 2 * i + (lane >> 5)) * ldw + n0 + (lane & 31)];
#pragma unroll
    for (int i = 0; i < 32; ++i) scr[(2 * i + (lane >> 5)) * 33 + (lane & 31)] = wv[i];
    WAVE_SYNC();
    const int c = lane & 7;
#pragma unroll
    for (int j = 0; j < 4; ++j) { const int n = (lane >> 3) + 8 * j; const float* s = scr + (8 * c) * 33 + n;
        u32x4 o; o.x = pk2(s[0 * 33], s[1 * 33]); o.y = pk2(s[2 * 33], s[3 * 33]); o.z = pk2(s[4 * 33], s[5 * 33]); o.w = pk2(s[6 * 33], s[7 * 33]);
        *(u32x4*)(WT + (size_t)(drow0 + n) * K + k0 + 8 * c) = o; }
    WAVE_SYNC();
}
constexpr int CV_IN = 16 * 120, CV_OUT = 16 * 32, CV_G = 16 * 88, CV_DN = 44 * 32, CV_L = CV_IN + CV_OUT + 2 * CV_G + CV_DN;
__device__ __forceinline__ void ph_convert(const P& p, unsigned char* smem, int i0, int i1, int b0, int b1) {
    if ((int)blockIdx.x < b0 || (int)blockIdx.x >= b1) return;
    const int lane = tidx() & 63, wave = tidx() >> 6;
    float* scr = (float*)smem + wave * (64 * 33 + 32);
    constexpr int I_IN = CV_IN, I_OUT = CV_OUT, I_G = CV_G, I_L = CV_L;
    const int gw = ((int)blockIdx.x - b0) * 8 + wave, ngw = (b1 - b0) * 8;
    for (int it = i0 + gw; it < i1; it += ngw) {
        const int l = it / I_L; int r = it % I_L;
        if (r < I_IN) { const int kb = r / 120, nb = r % 120; transpose_item(p.w_in + (size_t)l * D * INC, INC, WSP(bf16_t, WS_WIN) + (size_t)l * NPROJ * D, D, kb * 64, nb * 32, nb * 32, scr, lane); continue; }
        r -= I_IN;
        if (r < I_OUT) { const int kb = r / 32, nb = r % 32; transpose_item(p.w_out + (size_t)l * D * D, D, WSP(bf16_t, WS_WOUT) + (size_t)l * D * D, D, kb * 64, nb * 32, nb * 32, scr, lane); continue; }
        r -= I_OUT;
        if (r < 2 * I_G) { const int up = r / I_G; r %= I_G; const int kb = r / 88, nb = r % 88, n0 = nb * 32;
            transpose_item((up ? p.w_up : p.w_gate) + (size_t)l * D * FF, FF, WSP(bf16_t, WS_WGU) + (size_t)l * 2 * FF * D, D, kb * 64, n0, (n0 / 128) * 256 + up * 128 + (n0 % 128), scr, lane); continue; }
        r -= 2 * I_G;
        { const int kb = r / 32, nb = r % 32; transpose_item(p.w_down + (size_t)l * FF * D, D, WSP(bf16_t, WS_WDN) + (size_t)l * D * FF, FF, kb * 64, nb * 32, nb * 32, scr, lane); }
    }
}

__device__ __forceinline__ void ph_adaln(const P& p, unsigned char* smem, int l0, int l1, int b0, int b1) {
    if ((int)blockIdx.x < b0 || (int)blockIdx.x >= b1) return;
    float* sc = (float*)smem;
    float* red = sc + NC * 256;
    const int tid = tidx(), col = tid & 31, kg = tid >> 5;
    float* MOD = WSP(float, WS_MOD);
    for (int it = l0 * 192 + (int)blockIdx.x - b0; it < l1 * 192; it += b1 - b0) {
        const int l = it / 192, cb0 = (it % 192) * 32;
        float acc[NC];
#pragma unroll
        for (int r = 0; r < NC; ++r) acc[r] = 0.f;
        for (int kc = 0; kc < 4; ++kc) {
            __syncthreads();
            for (int e = tid; e < NC * 256; e += NTHR) { const int r = e >> 8, k = e & 255; const float c = r < PB ? p.c_prompt[r * D + kc * 256 + k] : p.c_sample[(r - PB) * D + kc * 256 + k]; sc[e] = silu_f(c); }
            __syncthreads();
            for (int kk = 0; kk < 16; ++kk) { const int k = kg * 16 + kk; const float w = p.ada_w[((size_t)l * D + kc * 256 + k) * 6144 + cb0 + col];
#pragma unroll
                for (int r = 0; r < NC; ++r) acc[r] += sc[r * 256 + k] * w; }
        }
#pragma unroll
        for (int r = 0; r < NC; ++r) red[(kg * NC + r) * 32 + col] = acc[r];
        __syncthreads();
        for (int e = tid; e < NC * 32; e += NTHR) { const int r = e >> 5, c = e & 31; float s = p.ada_b[l * 6144 + cb0 + c];
            for (int g = 0; g < 16; ++g) s += red[(g * NC + r) * 32 + c];
            MOD[((size_t)l * NC + r) * 6144 + cb0 + c] = s; }
        __syncthreads();
    }
}

__device__ __forceinline__ void ph_ropetab_copyx(const P& p) {
    const size_t gt = (size_t)blockIdx.x * NTHR + tidx(), ng = (size_t)gridDim.x * NTHR;
    float* tab = WSP(float, WS_ROPE);
    for (size_t e = gt; e < (size_t)NL * D * 8; e += ng) { const size_t lk = e >> 3; const int c = (int)(e & 7); WSP(float, WS_W8)[((lk >> 10) * 8 + c) * D + (lk & 1023)] = p.w_in[lk * INC + NPROJ + c]; }
    for (size_t e = gt; e < (size_t)NPOS * 32; e += ng) {
        const int pi = (int)(e >> 5), i = (int)(e & 31); const double pos = pi < T ? (double)pi : (double)(PAST + pi - T);
        const double ia = exp(-log(10000.0) * (double)i / 32.0), ir = exp(-log(10000.0) * (double)i / 31.0);
        tab[e] = (float)cos(pos * ia); tab[(size_t)NPOS * 32 + e] = (float)sin(pos * ia);
        tab[(size_t)2 * NPOS * 32 + e] = (float)cos(pos * ir); tab[(size_t)3 * NPOS * 32 + e] = (float)sin(pos * ir);
    }
}

template <int WHICH> __device__ __forceinline__ void ph_norm_mod(const P& p, int l, unsigned char* smem) {
    const int lane = tidx() & 63, wave = tidx() >> 6, gw = blockIdx.x * 8 + wave, ngw = gridDim.x * 8;
    const float* nw = (WHICH == 0 ? p.norm_mix : p.norm_ffn) + l * D;
    bf16_t* H = WSP(bf16_t, WS_H);
    const float* w8s = (const float*)smem;
    if (WHICH == 0) { __syncthreads();
        for (int e = tidx(); e < 8 * D / 4; e += NTHR) ((f32x4*)smem)[e] = ((const f32x4*)(WSP(float, WS_W8) + (size_t)l * 8 * D))[e];
        __syncthreads(); }
    f32x4 gw4[4];
#pragma unroll
    for (int j = 0; j < 4; ++j) gw4[j] = *(const f32x4*)(nw + 4 * lane + 256 * j);
    for (int r = gw; r < M; r += ngw) {
        const float* xr = (WHICH == 0 && l == 0) ? (r < MP ? p.x_prompt + (size_t)r * D : p.x_sample + (size_t)(r - MP) * D) : p.out + (size_t)r * D;
        const float* mod = WSP(float, WS_MOD) + ((size_t)l * NC + row_cb(r)) * 6144 + (WHICH == 0 ? 0 : 3072);
        f32x4 v[4]; float ss = 0.f;
#pragma unroll
        for (int j = 0; j < 4; ++j) { v[j] = *(const f32x4*)(xr + 4 * lane + 256 * j); ss += (v[j][0] * v[j][0] + v[j][1] * v[j][1]) + (v[j][2] * v[j][2] + v[j][3] * v[j][3]); }
        const float rstd = 1.0f / sqrtf(wave_sum(ss) * (1.0f / D) + EPS);
        float a8[8];
#pragma unroll
        for (int c = 0; c < 8; ++c) a8[c] = 0.f;
#pragma unroll
        for (int j = 0; j < 4; ++j) { const int k = 4 * lane + 256 * j;
            const f32x4 g = gw4[j], sh = *(const f32x4*)(mod + k), sc = *(const f32x4*)(mod + 1024 + k);
            f32x4 h;
#pragma unroll
            for (int e = 0; e < 4; ++e) h[e] = v[j][e] * rstd * g[e] * (1.0f + sc[e]) + sh[e];
            u32x2 w; w.x = pk2(h[0], h[1]); w.y = pk2(h[2], h[3]); *(u32x2*)(H + (size_t)r * D + k) = w;
            if (WHICH == 0) {
#pragma unroll
                for (int c = 0; c < 8; ++c) { const f32x4 wv = *(const f32x4*)(w8s + c * D + k); a8[c] += (h[0] * wv[0] + h[1] * wv[1]) + (h[2] * wv[2] + h[3] * wv[3]); }
            }
        }
        if (WHICH == 0) {
            float b4[4];
#pragma unroll
            for (int c = 0; c < 4; ++c) { const float keep = lane < 32 ? a8[c] : a8[4 + c], send = lane < 32 ? a8[4 + c] : a8[c]; b4[c] = keep + __shfl_xor(send, 32); }
            float b2[2];
#pragma unroll
            for (int c = 0; c < 2; ++c) { const bool lo = (lane & 16) == 0; const float keep = lo ? b4[c] : b4[2 + c], send = lo ? b4[2 + c] : b4[c]; b2[c] = keep + __shfl_xor(send, 16); }
            float b1; { const bool lo = (lane & 8) == 0; const float keep = lo ? b2[0] : b2[1], send = lo ? b2[1] : b2[0]; b1 = keep + __shfl_xor(send, 8); }
            b1 += __shfl_xor(b1, 4); b1 += __shfl_xor(b1, 2); b1 += __shfl_xor(b1, 1);
            if ((lane & 7) == 0) { const int c = (lane >> 5) * 4 + ((lane >> 4) & 1) * 2 + ((lane >> 3) & 1);
                if (c < 4) WSP(float, WS_BETA)[(size_t)r * 4 + c] = 1.0f / (1.0f + expf(-b1));
                else { const int hh = c - 4; const float xx = b1 + p.dt_bias[l * 4 + hh]; const float sp = xx > 20.f ? xx : log1pf(expf(xx)); WSP(float, WS_G)[(size_t)r * 4 + hh] = -expf(p.a_log[l * 4 + hh]) * sp; } }
        }
    }
}

__device__ __forceinline__ void unpack8(const u32x4 w, float (&f)[8]) {
    f[0] = __builtin_bit_cast(float, w.x << 16); f[1] = __builtin_bit_cast(float, w.x & 0xffff0000u); f[2] = __builtin_bit_cast(float, w.y << 16); f[3] = __builtin_bit_cast(float, w.y & 0xffff0000u);
    f[4] = __builtin_bit_cast(float, w.z << 16); f[5] = __builtin_bit_cast(float, w.z & 0xffff0000u); f[6] = __builtin_bit_cast(float, w.w << 16); f[7] = __builtin_bit_cast(float, w.w & 0xffff0000u);
}
__device__ __forceinline__ u32x4 pack8f(const float (&f)[8]) { u32x4 w; w.x = pk2(f[0], f[1]); w.y = pk2(f[2], f[3]); w.z = pk2(f[4], f[5]); w.w = pk2(f[6], f[7]); return w; }
__device__ __forceinline__ void ph_rope_out(const P& p, int l) {
    const size_t gt = (size_t)blockIdx.x * NTHR + tidx(), ng = (size_t)gridDim.x * NTHR;
    bf16_t* PR = WSP(bf16_t, WS_PROJ); const float* tab = WSP(float, WS_ROPE);
    for (size_t e = gt; e < (size_t)MS * 64; e += ng) {
        const int r = MP + (int)(e >> 6), rem = (int)(e & 63), sec = rem >> 4, hh = (rem >> 2) & 3, d = (rem & 3) * 8;
        const int off = sec == 0 ? C_QA : sec == 1 ? C_KA : sec == 2 ? C_QR : C_KR; const float scale = sec == 0 ? 0.125f * LOG2E : sec == 3 ? 0.125f : 1.0f;
        const float* ct = tab + (size_t)(sec >= 2 ? 2 : 0) * NPOS * 32 + (size_t)row_pi(r) * 32 + d; const float* st = ct + (size_t)NPOS * 32;
        const f32x4 c0 = *(const f32x4*)ct, c1 = *(const f32x4*)(ct + 4), s0 = *(const f32x4*)st, s1 = *(const f32x4*)(st + 4);
        bf16_t* x = PR + (size_t)r * NPROJ + off + hh * 64 + d; float x1[8], x2[8], o1[8], o2[8];
        unpack8(*(const u32x4*)x, x1); unpack8(*(const u32x4*)(x + 32), x2);
#pragma unroll
        for (int k = 0; k < 8; ++k) { const float c = k < 4 ? c0[k & 3] : c1[k & 3], sn = k < 4 ? s0[k & 3] : s1[k & 3]; o1[k] = (x1[k] * c - x2[k] * sn) * scale; o2[k] = (x1[k] * sn + x2[k] * c) * scale; }
        *(u32x4*)x = pack8f(o1); *(u32x4*)(x + 32) = pack8f(o2);
        if (sec == 1) { const int b = (r - MP) / DS, i = (r - MP) % DS; float* o = p.out + O_SWK + (((size_t)l * DB + b) * DS + i) * 256 + hh * 64 + d;
            *(f32x4*)o = (f32x4){o1[0], o1[1], o1[2], o1[3]}; *(f32x4*)(o + 4) = (f32x4){o1[4], o1[5], o1[6], o1[7]}; *(f32x4*)(o + 32) = (f32x4){o2[0], o2[1], o2[2], o2[3]}; *(f32x4*)(o + 36) = (f32x4){o2[4], o2[5], o2[6], o2[7]}; }
    }
    for (size_t e = gt; e < (size_t)MS * 32; e += ng) {
        const int r = MP + (int)(e >> 5), c = (int)(e & 31) * 8; const int b = (r - MP) / DS, i = (r - MP) % DS; float* o = p.out + O_SWV + (((size_t)l * DB + b) * DS + i) * 256 + c;
        float v[8]; unpack8(*(const u32x4*)(PR + (size_t)r * NPROJ + C_VA + c), v); *(f32x4*)o = (f32x4){v[0], v[1], v[2], v[3]}; *(f32x4*)(o + 4) = (f32x4){v[4], v[5], v[6], v[7]};
    }
    for (size_t e = gt; e < (size_t)(PB + DB) * 3 * 1536; e += ng) {
        const int c = (int)(e % 1536), j = (int)((e / 1536) % 3), bb = (int)(e / (3 * 1536));
        if (bb < PB) p.out[O_PCONV + (((size_t)l * PB + bb) * 3 + j) * 1536 + c] = bf2f(PR[(size_t)(bb * T + T - 3 + j) * NPROJ + C_CONV + c]);
        else { const int b = bb - PB; p.out[O_SCONV + (((size_t)l * DB + b) * 3 + j) * 1536 + c] = bf2f(PR[(size_t)(MP + b * DS + DS - 3 + j) * NPROJ + C_CONV + c]); }
    }
}

__device__ __forceinline__ void attn_wave_sample(const P& p, int l, int r, int h, int lane, float* sw  ) {
    const bf16_t* PR = WSP(bf16_t, WS_PROJ);
    const int b = (r - MP) / DS; const int tq = WB + (r - MP) % DS;
    const int kg = lane >> 4, dq = lane & 15;
    f32x4 q4; { const u32x2 w = *(const u32x2*)(PR + (size_t)r * NPROJ + C_QA + h * 64 + 4 * dq); q4 = (f32x4){bf2f((bf16_t)(w.x & 0xffff)), bf2f((bf16_t)(w.x >> 16)), bf2f((bf16_t)(w.y & 0xffff)), bf2f((bf16_t)(w.y >> 16))}; }
    float mx = -INFINITY;
#pragma unroll 8
    for (int e = kg; e < 388; e += 4) {
        const int ee = e < 387 ? e : 386; const int pat = ee / 129, j = ee % 129, dil = pat == 0 ? 1 : pat == 1 ? 4 : 16; const int rr = tq - dil * j;
        f32x4 kv;
        if (rr < WB) kv = *(const f32x4*)(p.cache_k + ((((size_t)l * DB + b) * WB + rr) * 4 + h) * 64 + 4 * dq);
        else { const u32x2 w = *(const u32x2*)(PR + (size_t)(MP + b * DS + (rr - WB)) * NPROJ + C_KA + h * 64 + 4 * dq);
            kv = (f32x4){bf2f((bf16_t)(w.x & 0xffff)), bf2f((bf16_t)(w.x >> 16)), bf2f((bf16_t)(w.y & 0xffff)), bf2f((bf16_t)(w.y >> 16))}; }
        float a = (q4[0] * kv[0] + q4[1] * kv[1]) + (q4[2] * kv[2] + q4[3] * kv[3]);
        a += __shfl_xor(a, 1); a += __shfl_xor(a, 2); a += __shfl_xor(a, 4); a += __shfl_xor(a, 8);
        if (e < 387) { if (dq == 0) sw[e] = a; mx = fmaxf(mx, a); }
    }
    WAVE_SYNC();
    mx = wave_max(mx);
    float lsum = 0.f;
#pragma unroll 1
    for (int i = 0; i < 7; ++i) { const int e = lane + 64 * i; if (e < 387) { const float pe = exp2f(sw[e] - mx); sw[e] = pe; lsum += pe; } }
    lsum = wave_sum(lsum);
    WAVE_SYNC();
    f32x4 o4 = (f32x4){0.f, 0.f, 0.f, 0.f};
#pragma unroll 16
    for (int e = kg; e < 387; e += 4) {
        const float pe = sw[e];
        const int pat = e / 129, j = e % 129, dil = pat == 0 ? 1 : pat == 1 ? 4 : 16; const int rr = tq - dil * j;
        f32x4 v;
        if (rr < WB) v = *(const f32x4*)(p.cache_v + ((((size_t)l * DB + b) * WB + rr) * 4 + h) * 64 + 4 * dq);
        else { const u32x2 w = *(const u32x2*)(PR + (size_t)(MP + b * DS + (rr - WB)) * NPROJ + C_VA + h * 64 + 4 * dq);
            v = (f32x4){bf2f((bf16_t)(w.x & 0xffff)), bf2f((bf16_t)(w.x >> 16)), bf2f((bf16_t)(w.y & 0xffff)), bf2f((bf16_t)(w.y >> 16))}; }
        o4 += pe * v;
    }
#pragma unroll
    for (int e = 0; e < 4; ++e) { float x = o4[e]; x += __shfl_xor(x, 16); x += __shfl_xor(x, 32); o4[e] = x; }
    WAVE_SYNC();
    if (kg == 0) { const float inv = 1.0f / lsum; u32x2 w; w.x = pk2(o4[0] * inv, o4[1] * inv); w.y = pk2(o4[2] * inv, o4[3] * inv);
        *(u32x2*)(WSP(bf16_t, WS_O) + (size_t)r * D + h * 64 + 4 * dq) = w; }
}
__device__ __forceinline__ void ph_attn_sample(const P& p, int l, unsigned char* smem) {
    const int lane = tidx() & 63, wave = tidx() >> 6, gw = (gridDim.x - 1 - blockIdx.x) * 8 + wave, ngw = gridDim.x * 8;
    float* sw = (float*)smem + wave * 392;
    for (int it = gw; it < MS * 4; it += ngw) attn_wave_sample(p, l, MP + (it >> 2), it & 3, lane, sw);
}
__device__ __forceinline__ bf16x8 pack8(const f32x16& v, int s8) {
    u32x4 w; w.x = pk2(v[s8], v[s8 + 1]); w.y = pk2(v[s8 + 2], v[s8 + 3]); w.z = pk2(v[s8 + 4], v[s8 + 5]); w.w = pk2(v[s8 + 6], v[s8 + 7]); return __builtin_bit_cast(bf16x8, w);
}
__device__ __forceinline__ void attn_job(const P& p, int jb, int lane) {
    const int c = lane & 31, hi = lane >> 5;
    constexpr int NB = T / 512;
    const int unit = jb / 48, jj = jb % 48, pat = jj >> 4, sub = jj & 15;
    const int blk = unit % NB, h = (unit / NB) & 3, b = unit / (NB * 4), bh = b * 4 + h;
    int dil, r, qi0, cls, tb;
    if (pat == 0) { dil = 1; r = 0; qi0 = blk * 512 + sub * 32; cls = 0; tb = 0; }
    else if (pat == 1) { dil = 4; r = sub >> 2; qi0 = blk * 128 + (sub & 3) * 32; cls = 1; tb = r * (T / 128); }
    else { dil = 16; r = sub; qi0 = blk * 32; cls = 2; tb = r * (T / 512); }
    const bf16_t* KF = WSP(bf16_t, WS_KF) + cls * ATT_CLS + ((size_t)bh * (T / 32) + tb) * 2048 + lane * 8;
    const bf16_t* VF = WSP(bf16_t, WS_VF) + cls * ATT_CLS + ((size_t)bh * (T / 32) + tb) * 2048 + lane * 8;
    const int tq = dil * (qi0 + c) + r;
    const bf16_t* qp = WSP(bf16_t, WS_PROJ) + (size_t)(b * T + tq) * NPROJ + C_QA + h * 64 + 8 * hi;
    bf16x8 qf[4];
#pragma unroll
    for (int ks = 0; ks < 4; ++ks) qf[ks] = *(const bf16x8*)(qp + 16 * ks);
    bf16x8 kf[5][4];
#pragma unroll
    for (int i = 0; i < 5; ++i) { const int kt0 = qi0 - 128 + 32 * i; const bf16_t* kp = KF + (size_t)(kt0 >= 0 ? (kt0 >> 5) : 0) * 2048;
#pragma unroll
        for (int ks = 0; ks < 4; ++ks) kf[i][ks] = *(const bf16x8*)(kp + 512 * ks); }
    f32x16 S[5];
#pragma unroll
    for (int i = 0; i < 5; ++i) {
        const int kt0 = qi0 - 128 + 32 * i;
        f32x16 acc;
#pragma unroll
        for (int e = 0; e < 16; ++e) acc[e] = 0.f;
#pragma unroll
        for (int ks = 0; ks < 4; ++ks) acc = MFMA32(kf[i][ks], qf[ks], acc);
#pragma unroll
        for (int e = 0; e < 16; ++e) { const int krow = (e & 3) + 8 * (e >> 2) + 4 * hi;
            const bool dead = kt0 < 0 || (i == 0 && krow < c) || (i == 4 && krow > c); if (dead) acc[e] = -INFINITY; }
        S[i] = acc;
    }
    float mx = -INFINITY;
#pragma unroll
    for (int i = 0; i < 5; ++i)
#pragma unroll
        for (int e = 0; e < 16; ++e) mx = fmaxf(mx, S[i][e]);
    mx = fmaxf(mx, __shfl_xor(mx, 32));
    float lsum = 0.f;
#pragma unroll
    for (int i = 0; i < 5; ++i)
#pragma unroll
        for (int e = 0; e < 16; ++e) { const float pe = exp2f(S[i][e] - mx); S[i][e] = pe; lsum += pe; }
    lsum += __shfl_xor(lsum, 32);
    bf16x8 pf[5][2];
#pragma unroll
    for (int i = 0; i < 5; ++i) { pf[i][0] = pack8(S[i], 0); pf[i][1] = pack8(S[i], 8); }
    f32x16 O[2];
#pragma unroll
    for (int dt = 0; dt < 2; ++dt)
#pragma unroll
        for (int e = 0; e < 16; ++e) O[dt][e] = 0.f;
#pragma unroll
    for (int i = 0; i < 5; ++i) {
        const int kt0 = qi0 - 128 + 32 * i; const bf16_t* vp = VF + (size_t)(kt0 >= 0 ? (kt0 >> 5) : 0) * 2048;
#pragma unroll
        for (int s2 = 0; s2 < 2; ++s2)
#pragma unroll
            for (int dt = 0; dt < 2; ++dt) O[dt] = MFMA32(*(const bf16x8*)(vp + (dt * 2 + s2) * 512), pf[i][s2], O[dt]);
    }
    const size_t idx = ((size_t)(b * T + tq) * 4 + h) * 3 + pat;
    bf16_t* po = WSP(bf16_t, WS_APO) + idx * 64;
#pragma unroll
    for (int dt = 0; dt < 2; ++dt)
#pragma unroll
        for (int g = 0; g < 4; ++g) { u32x2 w; w.x = pk2(O[dt][4 * g], O[dt][4 * g + 1]); w.y = pk2(O[dt][4 * g + 2], O[dt][4 * g + 3]); *(u32x2*)(po + 32 * dt + 8 * g + 4 * hi) = w; }
    if (hi == 0) { float* ml = WSP(float, WS_AML) + idx * 2; ml[0] = mx; ml[1] = lsum; }
}
__device__ __forceinline__ void ph_attn_jobs(const P& p, int nc, int b1, int r0) {
    const int bid = (int)blockIdx.x; if (bid >= b1) return;
    const int lane = tidx() & 63, wave = tidx() >> 6, nn = (b1 - nc) * 8, ncw = nc * 8; constexpr int NJ = PB * 4 * (T / 512) * 48;
    const bool late = bid < nc; const int wi = late ? bid * 8 + wave : (bid - nc) * 8 + wave;
    for (int r = late ? r0 : 0;; ++r) { const int base = r * nn + (r > r0 ? (r - r0) * ncw : 0); const int jb = base + (late ? nn + wi : wi);
        if (base >= NJ) break;
        if (jb < NJ) attn_job(p, jb, lane); }
}
__device__ __forceinline__ void ph_attn_combine(const P& p) {
    const size_t gt = (size_t)blockIdx.x * NTHR + tidx(), ng = (size_t)gridDim.x * NTHR;
    for (size_t e = gt; e < (size_t)MP * 4 * 16; e += ng) {
        const size_t rh = e >> 4; const int dq = (int)(e & 15) * 4;
        const float* ml = WSP(float, WS_AML) + rh * 6; const float m0 = ml[0], m1 = ml[2], m2 = ml[4];
        const float mm = fmaxf(m0, fmaxf(m1, m2)); const float w0 = exp2f(m0 - mm), w1 = exp2f(m1 - mm), w2 = exp2f(m2 - mm);
        const float inv = 1.0f / (w0 * ml[1] + w1 * ml[3] + w2 * ml[5]);
        const bf16_t* po = WSP(bf16_t, WS_APO) + rh * 192 + dq;
        const u32x2 a = *(const u32x2*)po, bq = *(const u32x2*)(po + 64), cq = *(const u32x2*)(po + 128);
        float o[4];
        o[0] = w0 * bf2f((bf16_t)(a.x & 0xffff)) + w1 * bf2f((bf16_t)(bq.x & 0xffff)) + w2 * bf2f((bf16_t)(cq.x & 0xffff));
        o[1] = w0 * bf2f((bf16_t)(a.x >> 16)) + w1 * bf2f((bf16_t)(bq.x >> 16)) + w2 * bf2f((bf16_t)(cq.x >> 16));
        o[2] = w0 * bf2f((bf16_t)(a.y & 0xffff)) + w1 * bf2f((bf16_t)(bq.y & 0xffff)) + w2 * bf2f((bf16_t)(cq.y & 0xffff));
        o[3] = w0 * bf2f((bf16_t)(a.y >> 16)) + w1 * bf2f((bf16_t)(bq.y >> 16)) + w2 * bf2f((bf16_t)(cq.y >> 16));
        const size_t row = rh >> 2; const int h = (int)(rh & 3);
        u32x2 w; w.x = pk2(o[0] * inv, o[1] * inv); w.y = pk2(o[2] * inv, o[3] * inv);
        *(u32x2*)(WSP(bf16_t, WS_O) + row * D + h * 64 + dq) = w;
    }
}
__device__ __forceinline__ float ret_lg(int h) { return logf(1.0f - exp2f(-5.0f - (float)h)); }
__device__ __forceinline__ void ret_local_unit(const P& p, int u) {
    const int tid = tidx(), lane = tid & 63, wave = tid >> 6, x = lane & 15, q = lane >> 4, dt = wave >> 1;
    const int n = u % NCH, bh = u / NCH, h = bh & 3, t0 = n * 64; const float g63 = expf(ret_lg(h) * 63.0f);
    const bf16_t* ka = WSP(bf16_t, WS_KRT) + ((size_t)bh * 64 + 16 * dt + x) * T + t0 + 8 * q;
#pragma unroll
    for (int k = 0; k < 2; ++k) { const int et = 2 * (wave & 1) + k; const bf16_t* vb = WSP(bf16_t, WS_VRT) + ((size_t)bh * 64 + 16 * et + x) * T + t0 + 8 * q;
        f32x4 acc = (f32x4){0.f, 0.f, 0.f, 0.f};
#pragma unroll
        for (int ks = 0; ks < 2; ++ks) acc = MFMA16(*(const bf16x8*)(ka + 32 * ks), *(const bf16x8*)(vb + 32 * ks), acc);
        *(f32x4*)(WSP(float, WS_RU) + (size_t)u * 4096 + (16 * et + x) * 64 + 16 * dt + 4 * q) = acc * g63; }
}
constexpr int TPK = 72, TPT = 65;
__device__ __forceinline__ void trans_write(const bf16_t* tile, bf16_t* dst  , int tile0, int tid) {
#pragma unroll
    for (int k = 0; k < 4; ++k) { const int ch = tid + NTHR * k, d = ch >> 5, t0 = (ch & 31) * 8; u32x4 w;
        w.x = (unsigned)tile[(t0 + 0) * TPT + d] | ((unsigned)tile[(t0 + 1) * TPT + d] << 16); w.y = (unsigned)tile[(t0 + 2) * TPT + d] | ((unsigned)tile[(t0 + 3) * TPT + d] << 16);
        w.z = (unsigned)tile[(t0 + 4) * TPT + d] | ((unsigned)tile[(t0 + 5) * TPT + d] << 16); w.w = (unsigned)tile[(t0 + 6) * TPT + d] | ((unsigned)tile[(t0 + 7) * TPT + d] << 16);
        *(u32x4*)(dst + (size_t)d * T + tile0 + t0) = w; COMPILER_FENCE(); }
}
__device__ __forceinline__ void store8_b16(bf16_t* dst, const u32x4 w) {
    dst[0] = (bf16_t)(w.x & 0xffff); dst[1] = (bf16_t)(w.x >> 16); dst[2] = (bf16_t)(w.y & 0xffff); dst[3] = (bf16_t)(w.y >> 16);
    dst[4] = (bf16_t)(w.z & 0xffff); dst[5] = (bf16_t)(w.z >> 16); dst[6] = (bf16_t)(w.w & 0xffff); dst[7] = (bf16_t)(w.w >> 16);
}
__device__ __forceinline__ void ph_vtrans(const P& p, int l, unsigned char* smem) {
    bf16_t* ka = (bf16_t*)smem; bf16_t* va = ka + 256 * TPK; bf16_t* vr = va + 256 * TPK; bf16_t* kr = vr + 256 * TPT;
    static_assert((2 * 256 * TPK + 2 * 256 * TPT) * 2 <= BAR_LDS_OFF, "transpose unit LDS");
    const int tid = tidx(); bf16_t* PR = WSP(bf16_t, WS_PROJ); const float* tab = WSP(float, WS_ROPE);
    for (int u = blockIdx.x; u < PB * 4 * (T / 256); u += gridDim.x) {
        const int tile = u % (T / 256), bh = u / (T / 256), h = bh & 3, b = bh >> 2; const float lg = ret_lg(h);
        __syncthreads();
#pragma unroll 1
        for (int k = 0; k < 2; ++k) { const int e = tid + NTHR * k, t = e >> 2, d = (e & 3) * 8, tt = tile * 256 + t; bf16_t* row = PR + (size_t)(b * T + tt) * NPROJ + h * 64 + d;
            float x1[8], x2[8], o1[8], o2[8];
            { const float* ct = tab + (size_t)tt * 32 + d; const float* st = ct + (size_t)NPOS * 32;
              const f32x4 c0 = *(const f32x4*)ct, c1 = *(const f32x4*)(ct + 4), s0 = *(const f32x4*)st, s1 = *(const f32x4*)(st + 4);
              unpack8(*(const u32x4*)(row + C_QA), x1); unpack8(*(const u32x4*)(row + C_QA + 32), x2);
#pragma unroll
              for (int i = 0; i < 8; ++i) { const float c = i < 4 ? c0[i & 3] : c1[i & 3], sn = i < 4 ? s0[i & 3] : s1[i & 3]; o1[i] = (x1[i] * c - x2[i] * sn) * (0.125f * LOG2E); o2[i] = (x1[i] * sn + x2[i] * c) * (0.125f * LOG2E); }
              *(u32x4*)(row + C_QA) = pack8f(o1); *(u32x4*)(row + C_QA + 32) = pack8f(o2);
              unpack8(*(const u32x4*)(row + C_KA), x1); unpack8(*(const u32x4*)(row + C_KA + 32), x2);
#pragma unroll
              for (int i = 0; i < 8; ++i) { const float c = i < 4 ? c0[i & 3] : c1[i & 3], sn = i < 4 ? s0[i & 3] : s1[i & 3]; o1[i] = x1[i] * c - x2[i] * sn; o2[i] = x1[i] * sn + x2[i] * c; }
              *(u32x4*)(ka + t * TPK + d) = pack8f(o1); *(u32x4*)(ka + t * TPK + d + 32) = pack8f(o2);
              if (tt >= T - PWIN) { float* o = p.out + O_PWK + (((size_t)l * PB + b) * PWIN + (tt - (T - PWIN))) * 256 + h * 64 + d;
                  *(f32x4*)o = (f32x4){o1[0], o1[1], o1[2], o1[3]}; *(f32x4*)(o + 4) = (f32x4){o1[4], o1[5], o1[6], o1[7]}; *(f32x4*)(o + 32) = (f32x4){o2[0], o2[1], o2[2], o2[3]}; *(f32x4*)(o + 36) = (f32x4){o2[4], o2[5], o2[6], o2[7]}; } }
            COMPILER_FENCE();
            { const float* ct = tab + (size_t)2 * NPOS * 32 + (size_t)tt * 32 + d; const float* st = ct + (size_t)NPOS * 32;
              const f32x4 c0 = *(const f32x4*)ct, c1 = *(const f32x4*)(ct + 4), s0 = *(const f32x4*)st, s1 = *(const f32x4*)(st + 4);
              const float gq = expf(lg * (float)(tt & 63)), gk = 0.125f / gq;
              unpack8(*(const u32x4*)(row + C_QR), x1); unpack8(*(const u32x4*)(row + C_QR + 32), x2);
#pragma unroll
              for (int i = 0; i < 8; ++i) { const float c = i < 4 ? c0[i & 3] : c1[i & 3], sn = i < 4 ? s0[i & 3] : s1[i & 3]; o1[i] = (x1[i] * c - x2[i] * sn) * gq; o2[i] = (x1[i] * sn + x2[i] * c) * gq; }
              *(u32x4*)(row + C_QR) = pack8f(o1); *(u32x4*)(row + C_QR + 32) = pack8f(o2);
              unpack8(*(const u32x4*)(row + C_KR), x1); unpack8(*(const u32x4*)(row + C_KR + 32), x2);
#pragma unroll
              for (int i = 0; i < 8; ++i) { const float c = i < 4 ? c0[i & 3] : c1[i & 3], sn = i < 4 ? s0[i & 3] : s1[i & 3]; o1[i] = (x1[i] * c - x2[i] * sn) * gk; o2[i] = (x1[i] * sn + x2[i] * c) * gk; }
              const u32x4 w1 = pack8f(o1), w2 = pack8f(o2);
              *(u32x4*)(row + C_KR) = w1; *(u32x4*)(row + C_KR + 32) = w2; store8_b16(kr + t * TPT + d, w1); store8_b16(kr + t * TPT + d + 32, w2); }
            COMPILER_FENCE(); }
#pragma unroll
        for (int k = 0; k < 4; ++k) { const int ch = tid + NTHR * k, t = ch >> 3, d8 = (ch & 7) * 8, tt = tile * 256 + t; const bf16_t* src = PR + (size_t)(b * T + tt) * NPROJ + h * 64 + d8;
            const u32x4 wv = *(const u32x4*)(src + C_VA); *(u32x4*)(va + t * TPK + d8) = wv; store8_b16(vr + t * TPT + d8, *(const u32x4*)(src + C_VR));
            if (tt >= T - PWIN) { float v[8]; unpack8(wv, v); float* o = p.out + O_PWV + (((size_t)l * PB + b) * PWIN + (tt - (T - PWIN))) * 256 + h * 64 + d8;
                *(f32x4*)o = (f32x4){v[0], v[1], v[2], v[3]}; *(f32x4*)(o + 4) = (f32x4){v[4], v[5], v[6], v[7]}; }
            COMPILER_FENCE(); }
        __syncthreads();
#pragma unroll
        for (int cls = 0; cls < 3; ++cls) {
            bf16_t* KFc = WSP(bf16_t, WS_KF) + cls * ATT_CLS + (size_t)bh * (T / 32) * 2048; bf16_t* VFc = WSP(bf16_t, WS_VF) + cls * ATT_CLS + (size_t)bh * (T / 32) * 2048;
#pragma unroll 1
            for (int k = 0; k < 4; ++k) { const int f = tid + NTHR * k, lane = f & 63, c31 = lane & 31, hi = lane >> 5;
                { int g, ks, tl, gtile; bool ok = true;
                  if (cls == 0) { ks = (f >> 6) & 3; g = f >> 8; tl = 32 * g + c31; gtile = tile * 8 + g; }
                  else if (cls == 1) { ks = (f >> 6) & 3; g = f >> 8; const int r = g >> 1, st = g & 1; tl = 4 * (32 * st + c31) + r; gtile = r * (T / 128) + tile * 2 + st; }
                  else { const int r = f >> 7, s16 = f & 15, h2 = (f >> 4) & 1; ks = (f >> 5) & 3; tl = 16 * s16 + r; gtile = r * (T / 512) + (tile >> 1); g = 0; (void)ok;
                      const int slot = 16 * (tile & 1) + s16;
                      *(u32x4*)(KFc + ((size_t)gtile * 4 + ks) * 512 + (slot + 32 * h2) * 8) = *(const u32x4*)(ka + tl * TPK + 16 * ks + 8 * h2); }
                  if (cls < 2) { *(u32x4*)(KFc + ((size_t)gtile * 4 + ks) * 512 + lane * 8) = *(const u32x4*)(ka + tl * TPK + 16 * ks + 8 * hi); } }
                { int dt, s2, gtile, r = 0, st = 0, g = 0;
                  if (cls == 0) { s2 = (f >> 6) & 1; dt = (f >> 7) & 1; g = f >> 8; gtile = tile * 8 + g; }
                  else if (cls == 1) { s2 = (f >> 6) & 1; dt = (f >> 7) & 1; g = f >> 8; r = g >> 1; st = g & 1; gtile = r * (T / 128) + tile * 2 + st; }
                  else { dt = (f >> 6) & 1; r = f >> 7; s2 = tile & 1; gtile = r * (T / 512) + (tile >> 1); }
                  unsigned short e8[8];
#pragma unroll
                  for (int jj = 0; jj < 8; ++jj) { const int kk = 16 * s2 + 8 * (jj >> 2) + 4 * hi + (jj & 3);
                      const int tl = cls == 0 ? 32 * g + kk : cls == 1 ? 4 * (32 * st + kk) + r : 16 * (kk & 15) + r;
                      e8[jj] = va[tl * TPK + 32 * dt + c31]; }
                  u32x4 w; w.x = (unsigned)e8[0] | ((unsigned)e8[1] << 16); w.y = (unsigned)e8[2] | ((unsigned)e8[3] << 16); w.z = (unsigned)e8[4] | ((unsigned)e8[5] << 16); w.w = (unsigned)e8[6] | ((unsigned)e8[7] << 16);
                  *(u32x4*)(VFc + ((size_t)gtile * 4 + dt * 2 + s2) * 512 + lane * 8) = w; }
                COMPILER_FENCE(); }
        }
        trans_write(vr, WSP(bf16_t, WS_VRT) + (size_t)bh * 64 * T, tile * 256, tid);
        trans_write(kr, WSP(bf16_t, WS_KRT) + (size_t)bh * 64 * T, tile * 256, tid);
        DRAIN_VM(); __syncthreads();
#pragma unroll 1
        for (int k = 0; k < 4; ++k) ret_local_unit(p, bh * NCH + tile * 4 + k);
    }
}

constexpr int CH_ITEMS = PB * 4 * 4;
__device__ __forceinline__ void ph_ret_scan(const P& p, int l) {
    const int G = (int)gridDim.x, skip = G > 2 * CH_ITEMS ? CH_ITEMS : 0;
    if ((int)blockIdx.x < skip) return;
    const int gt = ((int)blockIdx.x - skip) * NTHR + tidx(), ng = (G - skip) * NTHR;
    for (int e = gt; e < PB * 4 * 4096; e += ng) {
        const int bh = e >> 12, ed = e & 4095, h = bh & 3; const float cd = expf(ret_lg(h) * 64.0f);
        const float* U = WSP(float, WS_RU) + (size_t)bh * NCH * 4096 + ed; bf16_t* SPv = WSP(bf16_t, WS_RS) + (size_t)bh * NCH * 4096 + ed;
        float s = 0.f;
        static_assert(NCH % 8 == 0, "scan batches");
        constexpr int SB = NCH % 32 == 0 ? 32 : 8;
        for (int n0 = 0; n0 < NCH; n0 += SB) {
            float uv[SB];
#pragma unroll
            for (int k = 0; k < SB; ++k) uv[k] = U[(size_t)(n0 + k) * 4096];
#pragma unroll
            for (int k = 0; k < SB; ++k) { SPv[(size_t)(n0 + k) * 4096] = f2bf(s); s = s * cd + uv[k]; } }
        p.out[O_PRET + ((size_t)l * PB * 4 + bh) * 4096 + (ed & 63) * 64 + (ed >> 6)] = s;
    }
}
__device__ __forceinline__ void ph_ret_out(const P& p, int l) {
    const int tid = tidx(), lane = tid & 63, wave = tid >> 6, x = lane & 15, q = lane >> 4, it = UNIFORM(wave & 3);
    const bf16_t* PR = WSP(bf16_t, WS_PROJ);
    for (int u = blockIdx.x * 2 + (wave >> 2); u < NUNIT; u += gridDim.x * 2) {
        const int n = u % NCH, bh = u / NCH, h = bh & 3, b = bh >> 2, t0 = n * 64; const float gam = expf(ret_lg(h));
        const size_t rowi = (size_t)(b * T + t0 + 16 * it + x);
        bf16x8 qf[2];
#pragma unroll
        for (int ks = 0; ks < 2; ++ks) qf[ks] = *(const bf16x8*)(PR + rowi * NPROJ + C_QR + h * 64 + 32 * ks + 8 * q);
        f32x4 at[4];
#pragma unroll
        for (int jt = 0; jt < 4; ++jt) { at[jt] = (f32x4){0.f, 0.f, 0.f, 0.f};
            if (jt <= it) { const bf16_t* kp = PR + (size_t)(b * T + t0 + 16 * jt + x) * NPROJ + C_KR + h * 64 + 8 * q;
#pragma unroll
                for (int ks = 0; ks < 2; ++ks) at[jt] = MFMA16(*(const bf16x8*)(kp + 32 * ks), qf[ks], at[jt]);
                if (jt == it) {
#pragma unroll
                    for (int e = 0; e < 4; ++e) if (4 * q + e > x) at[jt][e] = 0.f; } } }
        const bf16x8 pb0 = pack_tiles(at[0], at[1]), pb1 = pack_tiles(at[2], at[3]);
        f32x4 o[4], os[4];
#pragma unroll
        for (int et = 0; et < 4; ++et) { o[et] = (f32x4){0.f, 0.f, 0.f, 0.f}; os[et] = (f32x4){0.f, 0.f, 0.f, 0.f};
            const bf16_t* vp = WSP(bf16_t, WS_VRT) + ((size_t)bh * 64 + 16 * et + x) * T + t0 + 4 * q;
            { const u32x2 lo = *(const u32x2*)vp, hi = *(const u32x2*)(vp + 16); u32x4 w; w.x = lo.x; w.y = lo.y; w.z = hi.x; w.w = hi.y; o[et] = MFMA16(__builtin_bit_cast(bf16x8, w), pb0, o[et]); }
            if (it >= 2) { const u32x2 lo = *(const u32x2*)(vp + 32), hi = *(const u32x2*)(vp + 48); u32x4 w; w.x = lo.x; w.y = lo.y; w.z = hi.x; w.w = hi.y; o[et] = MFMA16(__builtin_bit_cast(bf16x8, w), pb1, o[et]); }
            const bf16_t* sp = WSP(bf16_t, WS_RS) + (size_t)u * 4096 + (16 * et + x) * 64 + 8 * q;
#pragma unroll
            for (int ks = 0; ks < 2; ++ks) os[et] = MFMA16(*(const bf16x8*)(sp + 32 * ks), qf[ks], os[et]);
            o[et] = o[et] + os[et] * gam; }
        float sq = 0.f;
#pragma unroll
        for (int et = 0; et < 4; ++et) sq += (o[et][0] * o[et][0] + o[et][1] * o[et][1]) + (o[et][2] * o[et][2] + o[et][3] * o[et][3]);
        sq += __shfl_xor(sq, 16); sq += __shfl_xor(sq, 32);
        const float rstd = 1.0f / sqrtf(sq * (1.0f / 64.0f) + EPS);
#pragma unroll
        for (int et = 0; et < 4; ++et) { const int e0 = 16 * et + 4 * q; const u32x2 gw = *(const u32x2*)(PR + rowi * NPROJ + C_GR + h * 64 + e0); const f32x4 nw = *(const f32x4*)(p.ret_norm + l * 64 + e0);
            const float g0 = bf2f((bf16_t)(gw.x & 0xffff)), g1 = bf2f((bf16_t)(gw.x >> 16)), g2 = bf2f((bf16_t)(gw.y & 0xffff)), g3 = bf2f((bf16_t)(gw.y >> 16));
            u32x2 w; w.x = pk2(o[et][0] * rstd * nw[0] * silu_fast(g0), o[et][1] * rstd * nw[1] * silu_fast(g1)); w.y = pk2(o[et][2] * rstd * nw[2] * silu_fast(g2), o[et][3] * rstd * nw[3] * silu_fast(g3));
            *(u32x2*)(WSP(bf16_t, WS_O) + rowi * D + 256 + h * 64 + e0) = w; }
    }
}
__device__ __forceinline__ void ph_ret_sample(const P& p, int l, unsigned char* smem) {
    float* S0 = (float*)smem; float* qs = S0 + 4096; float* ks = qs + 8 * 64; float* vs = ks + 8 * 64;
    const int tid = tidx(); const bf16_t* PR = WSP(bf16_t, WS_PROJ);
    for (int u = gridDim.x - 1 - blockIdx.x; u < DB * 4; u += gridDim.x) {
        const int h = u & 3, b = u >> 2; const float lg = ret_lg(h);
        __syncthreads();
        for (int e = tid; e < 4096; e += NTHR) S0[e] = p.state_ret[(((size_t)l * DB + b) * 4 + h) * 4096 + e];
        { const int j = tid >> 6, d = tid & 63; const size_t row = (size_t)(MP + b * DS + j) * NPROJ;
          qs[tid] = bf2f(PR[row + C_QR + h * 64 + d]); ks[tid] = bf2f(PR[row + C_KR + h * 64 + d]); vs[tid] = bf2f(PR[row + C_VR + h * 64 + d]); }
        __syncthreads();
        { const int i = tid >> 6, e = tid & 63; float o = 0.f;
          for (int j = 0; j <= i; ++j) { float a = 0.f; for (int d = 0; d < 64; ++d) a += qs[i * 64 + d] * ks[j * 64 + d]; o += a * expf(lg * (float)(i - j)) * vs[j * 64 + e]; }
          float o2 = 0.f; for (int d = 0; d < 64; ++d) o2 += qs[i * 64 + d] * S0[d * 64 + e];
          o += o2 * expf(lg * (float)(i + 1));
          const float rstd = 1.0f / sqrtf(wave_sum(o * o) * (1.0f / 64.0f) + EPS);
          const size_t row = (size_t)(MP + b * DS + i); const float g = bf2f(PR[row * NPROJ + C_GR + h * 64 + e]);
          WSP(bf16_t, WS_O)[row * D + 256 + h * 64 + e] = f2bf(o * rstd * p.ret_norm[l * 64 + e] * silu_f(g)); }
        for (int x = tid; x < 4096; x += NTHR) { const int d = x >> 6, e = x & 63; float s = S0[x] * expf(lg * (float)DS);
            for (int j = 0; j < DS; ++j) s += ks[j * 64 + d] * expf(lg * (float)(DS - 1 - j)) * vs[j * 64 + e];
            p.out[O_SRET + (((size_t)l * DB + b) * 4 + h) * 4096 + x] = s; }
    }
}

template <int CS, int LDL> __device__ __forceinline__ void fwd_subst(float (&X)[CS], const float* Ls) {
#pragma unroll
    for (int i = 1; i < CS; ++i) {
        float a[4] = {X[i], 0.f, 0.f, 0.f};
#pragma unroll
        for (int j4 = 0; j4 < (i + 3) / 4; ++j4) { const f32x4 lv = *(const f32x4*)(Ls + i * LDL + 4 * j4);
#pragma unroll
            for (int e = 0; e < 4; ++e) if (4 * j4 + e < i) a[e] -= lv[e] * X[4 * j4 + e]; }
        X[i] = (a[0] + a[1]) + (a[2] + a[3]);
    }
}
constexpr int QP = 132;
constexpr int WSTP = 136;
constexpr int RWP = 392, TP = 136;
__device__ __forceinline__ void ph_gdn_prep(const P& p, int l, unsigned char* smem) {
    float* Ls = (float*)smem; float* As = Ls + 64 * 68; float* gs = As + 64 * 68; float* gcs = gs + 64; float* bts = gcs + 64; float* part = bts + 64;
    bf16_t* raw = (bf16_t*)(part + 4 * 64); bf16_t* Khi = raw + 67 * RWP; bf16_t* Klo = Khi + 64 * TP; bf16_t* Qb = Klo + 64 * TP;
    static_assert((64 * 68 * 2 + 64 * 3 + 4 * 64) * 4 + (67 * RWP + 3 * 64 * TP) * 2 <= BAR_LDS_OFF, "gdn_prep LDS");
    const int tid = tidx(), lane = tid & 63, wave = tid >> 6; const bf16_t* PR = WSP(bf16_t, WS_PROJ);
    for (int u = blockIdx.x; u < NUNIT; u += gridDim.x) {
        const int n = u % NCH, h = (u / NCH) % 4, b = u / (NCH * 4), t0 = n * 64;
        __syncthreads();
        for (int e = tid; e < 67 * 48; e += NTHR) { const int row = e / 48, ch = e % 48, t = t0 - 3 + row; u32x4 v = (u32x4){0u, 0u, 0u, 0u};
            if (t >= 0) v = *(const u32x4*)(PR + (size_t)(b * T + t) * NPROJ + C_CONV + (ch >> 4) * 512 + h * 128 + (ch & 15) * 8);
            *(u32x4*)(raw + row * RWP + ch * 8) = v; }
        if (tid >= 384 && tid < 448) { const int i = tid - 384; const size_t row = (size_t)(b * T + t0 + i); gs[i] = WSP(float, WS_G)[row * 4 + h]; bts[i] = WSP(float, WS_BETA)[row * 4 + h]; }
        __syncthreads();
        float y[64]; const int sec = tid < 128 ? 2 : tid < 256 ? 1 : 0, c = tid & 127;
        if (tid < 384) { const int col = sec * 512 + h * 128 + c;
            const float w0 = p.conv_w[(l * 4 + 0) * 1536 + col], w1 = p.conv_w[(l * 4 + 1) * 1536 + col], w2 = p.conv_w[(l * 4 + 2) * 1536 + col], w3 = p.conv_w[(l * 4 + 3) * 1536 + col];
            const LAS bf16_t* rp = (const LAS bf16_t*)raw + sec * 128 + c; LAUNDER_V(rp); float x0 = bf2f(rp[0]), x1 = bf2f(rp[RWP]), x2 = bf2f(rp[2 * RWP]);
#pragma unroll
            for (int i = 0; i < 64; ++i) { const float x3 = bf2f(rp[(i + 3) * RWP]); y[i] = silu_fast(w0 * x0 + w1 * x1 + w2 * x2 + w3 * x3); x0 = x1; x1 = x2; x2 = x3; if ((i & 7) == 7) COMPILER_FENCE(); } }
        if (tid >= 448) { if (tid == 448) { float a = 0.f; for (int i = 0; i < 64; ++i) { a += gs[i]; gcs[i] = a; } }
            WAVE_SYNC(); const int i = tid - 448; part[128 + i] = expf(gcs[i]); part[192 + i] = expf(gcs[63] - gcs[i]); }
#pragma unroll
        for (int pass = 0; pass < 2; ++pass) {
            if (tid >= 128 + 128 * pass && tid < 256 + 128 * pass) { LAS float* sq = (LAS float*)Ls + c; LAUNDER_V(sq);
#pragma unroll
                for (int i = 0; i < 64; ++i) sq[i * 132] = y[i] * y[i]; }
            __syncthreads();
            { const int i = tid >> 3, pt = tid & 7; const float* rp2 = Ls + i * 132 + pt * 16; float a = 0.f;
#pragma unroll
              for (int k = 0; k < 16; ++k) a += rp2[k];
              a += __shfl_xor(a, 1); a += __shfl_xor(a, 2); a += __shfl_xor(a, 4);
              if (pt == 0) part[64 * pass + i] = 1.0f / sqrtf(a + EPS); }
            __syncthreads();
        }
        if (tid >= 128 && tid < 256) { LAS bf16_t* kh = (LAS bf16_t*)Khi + c; LAS bf16_t* kl = (LAS bf16_t*)Klo + c; LAUNDER_V(kh); LAUNDER_V(kl);
#pragma unroll
            for (int i = 0; i < 64; ++i) { const float v = y[i] * part[i]; y[i] = v; const bf16_t hb = f2bf(v); kh[i * TP] = hb; kl[i * TP] = f2bf(v - bf2f(hb)); if ((i & 7) == 7) COMPILER_FENCE(); }
            bf16_t* dst = WSP(bf16_t, WS_GWK) + (size_t)u * 16384 + 8192; const int mt = c >> 4, x = c & 15;
#pragma unroll
            for (int ks2 = 0; ks2 < 2; ++ks2)
#pragma unroll
                for (int q = 0; q < 4; ++q) { const int i0 = 32 * ks2 + 4 * q; float v[8];
#pragma unroll
                    for (int e = 0; e < 8; ++e) { const int i = i0 + (e < 4 ? e : 12 + e); v[e] = y[i] * part[192 + i]; }
                    u32x4 w; w.x = pk2(v[0], v[1]); w.y = pk2(v[2], v[3]); w.z = pk2(v[4], v[5]); w.w = pk2(v[6], v[7]);
                    *(u32x4*)(dst + ((size_t)((mt * 2 + ks2) * 64 + q * 16 + x)) * 8) = w; COMPILER_FENCE(); } }
        else if (tid >= 256 && tid < 384) { LAS bf16_t* qb = (LAS bf16_t*)Qb + c; LAUNDER_V(qb);
#pragma unroll
            for (int i = 0; i < 64; ++i) { qb[i * TP] = f2bf(y[i] * part[64 + i]); if ((i & 7) == 7) COMPILER_FENCE(); } }
        __syncthreads();
#pragma unroll
        for (int tp = 0; tp < 2; ++tp) { const int pos = wave * 2 + tp, it = pos >> 2, jt = pos & 3, j16 = lane & 15, qd = lane >> 4;
            f32x4 lk = (f32x4){0.f, 0.f, 0.f, 0.f}, aq = (f32x4){0.f, 0.f, 0.f, 0.f};
            if (jt <= it) {
#pragma unroll
                for (int ks = 0; ks < 4; ++ks) { const int ao = (16 * it + j16) * TP + 32 * ks + 8 * qd, bo = (16 * jt + j16) * TP + 32 * ks + 8 * qd;
                    const bf16x8 ah = *(const bf16x8*)(Khi + ao), al = *(const bf16x8*)(Klo + ao), aqf = *(const bf16x8*)(Qb + ao), bh = *(const bf16x8*)(Khi + bo), bl = *(const bf16x8*)(Klo + bo);
                    lk = MFMA16(ah, bh, lk); lk = MFMA16(ah, bl, lk); lk = MFMA16(al, bh, lk); aq = MFMA16(aqf, bh, aq); } }
            const int j = 16 * jt + j16;
#pragma unroll
            for (int e = 0; e < 4; ++e) { const int i = 16 * it + 4 * qd + e; const float ex = j <= i ? expf(gcs[i] - gcs[j]) : 0.f;
                Ls[i * 68 + j] = j < i ? bts[i] * lk[e] * ex : 0.f; As[i * 68 + j] = aq[e] * ex * 0.08838834764831845f; } }
        __syncthreads();
        if (tid < 256) {
            if (tid < 128) {
#pragma unroll
                for (int i = 0; i < 64; ++i) { y[i] *= bts[i]; if ((i & 15) == 15) COMPILER_FENCE(); } }
            else {
#pragma unroll
                for (int i = 0; i < 64; ++i) { y[i] *= bts[i] * part[128 + i]; if ((i & 15) == 15) COMPILER_FENCE(); } }
            fwd_subst<64, 68>(y, Ls);
            if (tid < 128) { bf16_t* U = WSP(bf16_t, WS_GU) + (size_t)u * 8192 + c * 64;
#pragma unroll
                for (int i8 = 0; i8 < 8; ++i8) { u32x4 w; w.x = pk2(y[8 * i8], y[8 * i8 + 1]); w.y = pk2(y[8 * i8 + 2], y[8 * i8 + 3]); w.z = pk2(y[8 * i8 + 4], y[8 * i8 + 5]); w.w = pk2(y[8 * i8 + 6], y[8 * i8 + 7]); *(u32x4*)(U + 8 * i8) = w; } }
            else { LAS bf16_t* wst = (LAS bf16_t*)raw + c; LAUNDER_V(wst);
#pragma unroll
                for (int i = 0; i < 64; ++i) wst[i * WSTP] = f2bf(-y[i]); }
        } else { const int t2 = tid - 256;
#pragma unroll
            for (int k = 0; k < 2; ++k) { const int e8 = t2 + 256 * k, i = e8 >> 3, j0 = (e8 & 7) * 8; const f32x4 a0 = *(const f32x4*)(As + i * 68 + j0), a1 = *(const f32x4*)(As + i * 68 + j0 + 4);
                u32x4 w; w.x = pk2(a0[0], a0[1]); w.y = pk2(a0[2], a0[3]); w.z = pk2(a1[0], a1[1]); w.w = pk2(a1[2], a1[3]); *(u32x4*)(WSP(bf16_t, WS_GA) + (size_t)u * 4096 + i * 64 + j0) = w; }
            if (t2 == 0) WSP(float, WS_GD)[u] = expf(gcs[63]); }
        __syncthreads();
        { bf16_t* dst = WSP(bf16_t, WS_GWK) + (size_t)u * 16384; const bf16_t* wst = raw;
#pragma unroll
          for (int k = 0; k < 2; ++k) { const int f = tid + NTHR * k, ln = f & 63, ks4 = (f >> 6) & 3, mt = f >> 8, q = ln >> 4, x = ln & 15;
              const bf16_t* wr = wst + (16 * mt + x) * WSTP + 32 * ks4 + 4 * q;
              u32x4 w; w.x = (unsigned)wr[0] | ((unsigned)wr[1] << 16); w.y = (unsigned)wr[2] | ((unsigned)wr[3] << 16); w.z = (unsigned)wr[16] | ((unsigned)wr[17] << 16); w.w = (unsigned)wr[18] | ((unsigned)wr[19] << 16);
              *(u32x4*)(dst + (size_t)f * 8) = w; }
#pragma unroll
          for (int k = 0; k < 2; ++k) { const int e8 = tid + NTHR * k, i = e8 >> 4, d0 = (e8 & 15) * 8; float v[8]; unpack8(*(const u32x4*)(Qb + i * TP + d0), v); const float fsc = 0.08838834764831845f * part[128 + i];
#pragma unroll
              for (int x = 0; x < 8; ++x) v[x] *= fsc;
              *(u32x4*)(WSP(bf16_t, WS_GQ) + (size_t)u * 8192 + i * 128 + d0) = pack8f(v); } }
    }
}
constexpr int CH_SLOT = 36864, CH_NSLOT = 4;
static_assert(NCH % 4 == 0 && CH_NSLOT * CH_SLOT <= BAR_LDS_OFF, "chain ring");
__device__ __forceinline__ void chain_stage(const bf16_t* WK, const bf16_t* UTq, int m, int pw, int lane, unsigned char* smem) {
    unsigned char* slot = smem + (m % CH_NSLOT) * CH_SLOT;
#pragma unroll
    for (int k = 0; k < 6; ++k) { const int pc = pw * 6 + k;
        if (pc < 32) GLDS16((const unsigned char*)(WK + (size_t)m * 16384) + pc * 1024 + lane * 16, slot + pc * 1024);
        else GLDS16((const unsigned char*)(UTq + (size_t)m * 8192) + (pc - 32) * 1024 + lane * 16, slot + pc * 1024); }
}
__device__ __forceinline__ void ph_gdn_chain(const P& p, int l, unsigned char* smem) {
    const int tid = tidx(), lane = tid & 63, wave = UNIFORM(tid >> 6), j = lane & 15, q = lane >> 4;
    for (int it = blockIdx.x; it < CH_ITEMS; it += gridDim.x) {
        const int qt = it & 3, bh = it >> 2;
        const bf16_t* WK = WSP(bf16_t, WS_GWK) + (size_t)bh * NCH * 16384;
        const bf16_t* UTq = WSP(bf16_t, WS_GU) + (size_t)bh * NCH * 8192 + qt * 2048;
        __syncthreads();
        if (wave >= 2) {
            const int pw = wave - 2;
            chain_stage(WK, UTq, 0, pw, lane, smem); chain_stage(WK, UTq, 1, pw, lane, smem); chain_stage(WK, UTq, 2, pw, lane, smem);
#pragma unroll 1
            for (int n = 0; n < NCH; ++n) {
                if (n + 2 < NCH) WAIT_VM(12); else if (n + 1 < NCH) WAIT_VM(6); else WAIT_VM(0);
                RAW_BARRIER();
                if (n + 3 < NCH) chain_stage(WK, UTq, n + 3, pw, lane, smem);
            }
        } else {
            const int sl = qt * 2 + wave, c = 16 * sl + j;
            f32x4 S[8];
#pragma unroll
            for (int t = 0; t < 8; ++t) S[t] = (f32x4){0.f, 0.f, 0.f, 0.f};
            bf16x8 sB[4];
#pragma unroll
            for (int ks = 0; ks < 4; ++ks) sB[ks] = pack_tiles(S[2 * ks], S[2 * ks + 1]);
            const float* DC = WSP(float, WS_GD) + bh * NCH;
            float db[4];
#pragma unroll
            for (int d = 0; d < 4; ++d) db[d] = DC[d];
#pragma unroll 1
            for (int n0 = 0; n0 < NCH; n0 += 4) {
#pragma unroll
                for (int k4 = 0; k4 < 4; ++k4) {
                    const int n = n0 + k4, u = bh * NCH + n;
                    f32x4 acc[4]; const float dec = db[k4];
                    if (n + 4 < NCH) db[k4] = DC[n + 4];
                    { bf16_t* sp = WSP(bf16_t, WS_GS) + (size_t)u * 16384 + (size_t)sl * 2048 + lane * 8;
#pragma unroll
                      for (int tp = 0; tp < 4; ++tp) *(bf16x8*)(sp + 512 * tp) = sB[tp]; }
                    WAIT_LGKM0();
                    RAW_BARRIER();
                    const LAS unsigned char* slot = (const LAS unsigned char*)smem + (n % CH_NSLOT) * CH_SLOT + lane * 16; LAUNDER_V(slot);
                    { const LAS unsigned char* us = (const LAS unsigned char*)smem + (n % CH_NSLOT) * CH_SLOT + 32768 + ((16 * wave + j) * 64 + 4 * q) * 2; LAUNDER_V(us);
#pragma unroll
                      for (int mt = 0; mt < 4; ++mt) { const u32x2 w = *(const LAS u32x2*)(us + 32 * mt); acc[mt] = (f32x4){bf2f((bf16_t)(w.x & 0xffff)), bf2f((bf16_t)(w.x >> 16)), bf2f((bf16_t)(w.y & 0xffff)), bf2f((bf16_t)(w.y >> 16))}; } }
                    bf16x8 fa[8], fb[8];
#pragma unroll
                    for (int i = 0; i < 8; ++i) fa[i] = *(const LAS bf16x8*)(slot + i * 1024);
#pragma unroll
                    for (int i = 0; i < 8; ++i) fb[i] = *(const LAS bf16x8*)(slot + (8 + i) * 1024);
                    COMPILER_FENCE();
#pragma unroll
                    for (int ks = 0; ks < 4; ++ks) { acc[0] = MFMA16(fa[ks], sB[ks], acc[0]); acc[1] = MFMA16(fa[4 + ks], sB[ks], acc[1]); }
                    COMPILER_FENCE();
#pragma unroll
                    for (int i = 0; i < 8; ++i) fa[i] = *(const LAS bf16x8*)(slot + 16384 + i * 1024);
#pragma unroll
                    for (int ks = 0; ks < 4; ++ks) { acc[2] = MFMA16(fb[ks], sB[ks], acc[2]); acc[3] = MFMA16(fb[4 + ks], sB[ks], acc[3]); }
                    COMPILER_FENCE();
#pragma unroll
                    for (int i = 0; i < 8; ++i) fb[i] = *(const LAS bf16x8*)(slot + 16384 + (8 + i) * 1024);
                    const bf16x8 vB0 = pack_tiles(acc[0], acc[1]), vB1 = pack_tiles(acc[2], acc[3]);
                    { bf16_t* vp = WSP(bf16_t, WS_GV) + (size_t)u * 8192 + (size_t)sl * 1024 + lane * 8;
                      *(bf16x8*)vp = vB0; *(bf16x8*)(vp + 512) = vB1; }
#pragma unroll
                    for (int t = 0; t < 8; ++t) S[t] = S[t] * dec;
                    COMPILER_FENCE();
#pragma unroll
                    for (int t = 0; t < 4; ++t) S[t] = MFMA16(fa[2 * t], vB0, S[t]);
#pragma unroll
                    for (int t = 0; t < 4; ++t) S[t] = MFMA16(fa[2 * t + 1], vB1, S[t]);
#pragma unroll
                    for (int t = 0; t < 4; ++t) S[4 + t] = MFMA16(fb[2 * t], vB0, S[4 + t]);
#pragma unroll
                    for (int t = 0; t < 4; ++t) S[4 + t] = MFMA16(fb[2 * t + 1], vB1, S[4 + t]);
                    COMPILER_FENCE();
#pragma unroll
                    for (int ks = 0; ks < 4; ++ks) sB[ks] = pack_tiles(S[2 * ks], S[2 * ks + 1]);
                }
            }
            float* o = p.out + O_PGDN + ((size_t)l * PB * 4 + bh) * 16384 + c;
#pragma unroll
            for (int t = 0; t < 8; ++t)
#pragma unroll
                for (int e = 0; e < 4; ++e) o[(size_t)(16 * t + 4 * q + e) * 128] = S[t][e];
        }
    }
}
__device__ __forceinline__ void ph_gdn_out(const P& p, int l, unsigned char* smem) {
    const int tid = tidx(), lane = tid & 63, wave = tid >> 6, j = lane & 15, q = lane >> 4, mt = wave & 3;
    const bf16_t* PR = WSP(bf16_t, WS_PROJ);
    for (int u = blockIdx.x * 2 + (wave >> 2); u < NUNIT; u += gridDim.x * 2) {
        const int n = u % NCH, h = (u / NCH) % 4, b = u / (NCH * 4);
        f32x4 acc[8];
#pragma unroll
        for (int ct = 0; ct < 8; ++ct) acc[ct] = (f32x4){0.f, 0.f, 0.f, 0.f};
        const bf16_t* qg = WSP(bf16_t, WS_GQ) + (size_t)u * 8192 + (16 * mt + j) * 128 + 8 * q;
        const bf16_t* st = WSP(bf16_t, WS_GS) + (size_t)u * 16384 + ((2 * (q & 1)) * 16 + j) * 8 + (q >> 1) * 4;
#pragma unroll
        for (int ks = 0; ks < 4; ++ks) { const bf16x8 a = *(const bf16x8*)(qg + 32 * ks);
#pragma unroll
            for (int ct = 0; ct < 8; ++ct) { const bf16_t* sp = st + (size_t)ct * 2048 + ks * 512; const u32x2 lo = *(const u32x2*)sp, hi = *(const u32x2*)(sp + 128); u32x4 w; w.x = lo.x; w.y = lo.y; w.z = hi.x; w.w = hi.y;
                acc[ct] = MFMA16(a, __builtin_bit_cast(bf16x8, w), acc[ct]); }
            COMPILER_FENCE(); }
        const bf16_t* at = WSP(bf16_t, WS_GA) + (size_t)u * 4096 + (16 * mt + j) * 64 + 8 * q;
        const bf16_t* vt = WSP(bf16_t, WS_GV) + (size_t)u * 8192 + ((2 * (q & 1)) * 16 + j) * 8 + (q >> 1) * 4;
#pragma unroll
        for (int ks = 0; ks < 2; ++ks) { const bf16x8 a = *(const bf16x8*)(at + 32 * ks);
#pragma unroll
            for (int ct = 0; ct < 8; ++ct) { const bf16_t* vp = vt + (size_t)ct * 1024 + ks * 512; const u32x2 lo = *(const u32x2*)vp, hi = *(const u32x2*)(vp + 128); u32x4 w; w.x = lo.x; w.y = lo.y; w.z = hi.x; w.w = hi.y;
                acc[ct] = MFMA16(a, __builtin_bit_cast(bf16x8, w), acc[ct]); }
            COMPILER_FENCE(); }
        float sq[4];
#pragma unroll
        for (int e = 0; e < 4; ++e) { float s = 0.f;
#pragma unroll
            for (int ct = 0; ct < 8; ++ct) s += acc[ct][e] * acc[ct][e];
            s += __shfl_xor(s, 1); s += __shfl_xor(s, 2); s += __shfl_xor(s, 4); s += __shfl_xor(s, 8); sq[e] = 1.0f / sqrtf(s * (1.0f / 128.0f) + EPS); }
        float* stg = (float*)smem + wave * (16 * 132);
#pragma unroll
        for (int e = 0; e < 4; ++e)
#pragma unroll
            for (int ct = 0; ct < 8; ++ct) stg[(4 * q + e) * 132 + 16 * ct + j] = acc[ct][e] * sq[e];
        WAVE_SYNC();
        { const int rr = lane >> 2, cg = lane & 3; const size_t row = (size_t)(b * T + n * 64 + 16 * mt + rr);
#pragma unroll
          for (int k4 = 0; k4 < 4; ++k4) { const int c0 = cg * 32 + k4 * 8; const f32x4 o0 = *(const f32x4*)(stg + rr * 132 + c0), o1 = *(const f32x4*)(stg + rr * 132 + c0 + 4);
              float z[8]; unpack8(*(const u32x4*)(PR + row * NPROJ + C_Z + h * 128 + c0), z); const f32x4 n0 = *(const f32x4*)(p.gdn_norm + l * 128 + c0), n1 = *(const f32x4*)(p.gdn_norm + l * 128 + c0 + 4);
              float r8[8];
#pragma unroll
              for (int i = 0; i < 4; ++i) { r8[i] = o0[i] * n0[i] * silu_fast(z[i]); r8[4 + i] = o1[i] * n1[i] * silu_fast(z[4 + i]); }
              *(u32x4*)(WSP(bf16_t, WS_O) + row * D + 512 + h * 128 + c0) = pack8f(r8); } }
        WAVE_SYNC();
    }
}
__device__ __forceinline__ void ph_gdn_sample(const P& p, int l, unsigned char* smem) {
    float* qs = (float*)smem; float* ks = qs + 8 * QP; float* vs = ks + 8 * QP; float* us = vs + 8 * QP; float* wsm = us + 8 * 128; float* vn = wsm + 8 * 128;
    float* Ls = vn + 8 * 128; float* As = Ls + 8 * 8; float* gs = As + 8 * 8; float* gcs = gs + 8; float* bts = gcs + 8; float* S0 = bts + 8;
    const int tid = tidx(); const bf16_t* PR = WSP(bf16_t, WS_PROJ);
    for (int u = gridDim.x - 1 - blockIdx.x; u < DB * 4; u += gridDim.x) {
        const int h = u & 3, b = u >> 2;
        __syncthreads();
#pragma unroll 4
        for (int e = tid; e < 16384; e += NTHR) S0[e] = p.state_gdn[(((size_t)l * DB + b) * 4 + h) * 16384 + e];
        if (tid < 384) { const int sec = tid >> 7, c = tid & 127, col = sec * 512 + h * 128 + c; float* dst = sec == 0 ? qs : sec == 1 ? ks : vs;
            const float w0 = p.conv_w[(l * 4 + 0) * 1536 + col], w1 = p.conv_w[(l * 4 + 1) * 1536 + col], w2 = p.conv_w[(l * 4 + 2) * 1536 + col], w3 = p.conv_w[(l * 4 + 3) * 1536 + col];
            const float* hist = p.state_conv + (((size_t)l * DB + b) * 3) * 1536 + col; const bf16_t* src = PR + (size_t)(MP + b * DS) * NPROJ + C_CONV + col;
            float x0 = hist[0], x1 = hist[1536], x2 = hist[2 * 1536];
            for (int i = 0; i < DS; ++i) { const float x3 = bf2f(src[(size_t)i * NPROJ]); const float y = w0 * x0 + w1 * x1 + w2 * x2 + w3 * x3; dst[i * QP + c] = silu_f(y); x0 = x1; x1 = x2; x2 = x3; } }
        else if (tid < 384 + DS) { const int i = tid - 384; const size_t row = (size_t)(MP + b * DS + i); gs[i] = WSP(float, WS_G)[row * 4 + h]; bts[i] = WSP(float, WS_BETA)[row * 4 + h]; }
        __syncthreads();
        if (tid < 64) { const int rid = tid >> 2, part = tid & 3; float* rowp = (rid < 8 ? qs + rid * QP : ks + (rid - 8) * QP) + part * 32; float s = 0.f;
            for (int d = 0; d < 32; ++d) s += rowp[d] * rowp[d];
            s += __shfl_xor(s, 1); s += __shfl_xor(s, 2); const float sc = 1.0f / sqrtf(s + EPS);
            for (int d = 0; d < 32; ++d) rowp[d] *= sc; }
        if (tid == 64) { float a = 0.f; for (int i = 0; i < DS; ++i) { a += gs[i]; gcs[i] = a; } }
        __syncthreads();
        if (tid < 64) { const int i = tid >> 3, j = tid & 7; float lv = 0.f, av = 0.f;
            if (j <= i) { float dk = 0.f, dq = 0.f; for (int d = 0; d < 128; ++d) { const float kj = ks[j * QP + d]; dk += ks[i * QP + d] * kj; dq += qs[i * QP + d] * kj; }
                const float e = expf(gcs[i] - gcs[j]); av = dq * e * 0.08838834764831845f; lv = j < i ? bts[i] * dk * e : 0.f; }
            Ls[i * 8 + j] = lv; As[i * 8 + j] = av; }
        __syncthreads();
        if (tid < 256) { const int c = tid; float X[8];
            if (c < 128) {
#pragma unroll
                for (int i = 0; i < 8; ++i) X[i] = vs[i * QP + c] * bts[i]; }
            else {
#pragma unroll
                for (int i = 0; i < 8; ++i) X[i] = ks[i * QP + c - 128] * bts[i] * expf(gcs[i]); }
            fwd_subst<8, 8>(X, Ls);
            float* dst = c < 128 ? us + c : wsm + c - 128;
#pragma unroll
            for (int i = 0; i < 8; ++i) dst[i * 128] = X[i]; }
        __syncthreads();
        const int i = tid >> 6, c2 = (tid & 63) * 2;
        { float a0 = us[i * 128 + c2], a1 = us[i * 128 + c2 + 1];
          for (int d = 0; d < 128; ++d) { const float w = wsm[i * 128 + d]; a0 -= w * S0[d * 128 + c2]; a1 -= w * S0[d * 128 + c2 + 1]; }
          vn[i * 128 + c2] = a0; vn[i * 128 + c2 + 1] = a1; }
        __syncthreads();
        { float o0 = 0.f, o1 = 0.f; const float qsc = 0.08838834764831845f * expf(gcs[i]);
          for (int d = 0; d < 128; ++d) { const float qg = qs[i * QP + d] * qsc; o0 += qg * S0[d * 128 + c2]; o1 += qg * S0[d * 128 + c2 + 1]; }
          for (int j = 0; j < DS; ++j) { const float a = As[i * 8 + j]; o0 += a * vn[j * 128 + c2]; o1 += a * vn[j * 128 + c2 + 1]; }
          const float rstd = 1.0f / sqrtf(wave_sum(o0 * o0 + o1 * o1) * (1.0f / 128.0f) + EPS);
          const size_t row = (size_t)(MP + b * DS + i);
          const float z0 = bf2f(PR[row * NPROJ + C_Z + h * 128 + c2]), z1 = bf2f(PR[row * NPROJ + C_Z + h * 128 + c2 + 1]);
          bf16_t* O = WSP(bf16_t, WS_O) + row * D + 512 + h * 128 + c2;
          O[0] = f2bf(o0 * rstd * p.gdn_norm[l * 128 + c2] * silu_f(z0)); O[1] = f2bf(o1 * rstd * p.gdn_norm[l * 128 + c2 + 1] * silu_f(z1)); }
        { const float gl = gcs[DS - 1], dec = expf(gl); float* o = p.out + O_SGDN + (((size_t)l * DB + b) * 4 + h) * 16384;
#pragma unroll 2
          for (int e = tid; e < 16384; e += NTHR) { const int d = e >> 7, c = e & 127; float s = S0[e] * dec;
              for (int j = 0; j < DS; ++j) s += ks[j * QP + d] * expf(gl - gcs[j]) * vn[j * 128 + c];
              o[e] = s; } }
    }
}


template <int K> __device__ __forceinline__ void ph_gemm_small(const P& p, const bf16_t* A  , const bf16_t* Bt  , const float* gate, const float* xs_in  , unsigned char* smem) {
    static_assert(MS % 16 == 0 && K % 256 == 0, "small GEMM shape");
    constexpr int KW = K / 8, NKS = KW / 32;
    const int tid = tidx(), lane = tid & 63, wave = tid >> 6, x = lane & 15, q = lane >> 4;
    float* red = (float*)smem;
    for (int it = blockIdx.x; it < (MS / 16) * 16; it += gridDim.x) {
        const int rt = it % (MS / 16), cg = it / (MS / 16);
        const bf16_t* ap = A + (size_t)(16 * rt + x) * K + wave * KW + 8 * q;
        const bf16_t* bp = Bt + (size_t)(64 * cg + x) * K + wave * KW + 8 * q;
        f32x4 acc[4];
#pragma unroll
        for (int ct = 0; ct < 4; ++ct) acc[ct] = (f32x4){0.f, 0.f, 0.f, 0.f};
#pragma unroll
        for (int ks = 0; ks < NKS; ++ks) { const bf16x8 a = *(const bf16x8*)(ap + 32 * ks);
#pragma unroll
            for (int ct = 0; ct < 4; ++ct) acc[ct] = MFMA16(a, *(const bf16x8*)(bp + (size_t)ct * 16 * K + 32 * ks), acc[ct]); }
        __syncthreads();
#pragma unroll
        for (int ct = 0; ct < 4; ++ct) *(f32x4*)(red + ((wave * 4 + ct) * 64 + lane) * 4) = acc[ct];
        __syncthreads();
        if (wave < 4) { f32x4 s = (f32x4){0.f, 0.f, 0.f, 0.f};
#pragma unroll
            for (int w = 0; w < 8; ++w) s += *(const f32x4*)(red + ((w * 4 + wave) * 64 + lane) * 4);
            const int col = 64 * cg + 16 * wave + x;
#pragma unroll
            for (int e = 0; e < 4; ++e) { const int row = MP + 16 * rt + 4 * q + e; float* xp = p.out + (size_t)row * D + col; const float xin = xs_in ? xs_in[(size_t)(row - MP) * D + col] : *xp; *xp = xin + gate[(size_t)row_cb(row) * 6144 + col] * s[e]; } }
    }
}

__device__ __forceinline__ void ph_final_norm(const P& p) {
    const int lane = tidx() & 63, wave = tidx() >> 6, gw = blockIdx.x * 8 + wave, ngw = gridDim.x * 8;
    for (int r = gw; r < M; r += ngw) {
        float* xr = p.out + (size_t)r * D; f32x4 v[4]; float ss = 0.f;
#pragma unroll
        for (int j = 0; j < 4; ++j) { v[j] = *(const f32x4*)(xr + 4 * lane + 256 * j); ss += (v[j][0] * v[j][0] + v[j][1] * v[j][1]) + (v[j][2] * v[j][2] + v[j][3] * v[j][3]); }
        const float rstd = 1.0f / sqrtf(wave_sum(ss) * (1.0f / D) + EPS);
#pragma unroll
        for (int j = 0; j < 4; ++j) { const f32x4 g = *(const f32x4*)(p.final_norm + 4 * lane + 256 * j); *(f32x4*)(xr + 4 * lane + 256 * j) = v[j] * rstd * g; }
    }
}

enum Phase { PH_PRO = 0, PH_NORM1, PH_GEMM_IN, PH_ROPE, PH_MIX1, PH_MIX2, PH_MIX3, PH_GEMM_OUT, PH_NORM2, PH_GEMM_GU, PH_GEMM_DN, PH_FINAL };
#ifdef __HIP_EMU__
#define LDSP(x) (x)
#else
#define LDSP(x) ((PG8_LAS unsigned char*)(x))
#endif
template <int PH> __device__ __forceinline__ void run_phase(const P& p, int l, unsigned char* smem) {
    if constexpr (PH == PH_PRO) { ph_convert(p, smem, 0, CV_IN, 0, (int)gridDim.x); __syncthreads(); ph_adaln(p, smem, 0, 1, 0, (int)gridDim.x); ph_ropetab_copyx(p); }
    else if constexpr (PH == PH_NORM1) ph_norm_mod<0>(p, l, smem);
    else if constexpr (PH == PH_GEMM_IN) {
        pg8::Gemm g{WSP(bf16_t, WS_H), WSP(bf16_t, WS_WIN) + (size_t)l * NPROJ * D, MPAD, NPROJ, D}; pg8::StaticOrder S; S.init(MPAD, NPROJ, (int)gridDim.x, (int)blockIdx.x);
        pg8::EpiStoreBf16 E{WSP(bf16_t, WS_PROJ), NPROJ};
        pg8::gemm_phase<pg8::EpiStoreBf16, pg8::StaticOrder, true, true>(LDSP(smem), g, S, E);
    }
    else if constexpr (PH == PH_ROPE) { ph_rope_out(p, l); ph_vtrans(p, l, smem); ph_gdn_prep(p, l, smem); }
    else if constexpr (PH == PH_MIX2) { ph_gdn_chain(p, l, smem); { const int G = (int)gridDim.x; const bool split = G >= CH_ITEMS + DB * 4 + 16; ph_attn_jobs(p, split ? CH_ITEMS : 0, split ? G - DB * 4 : G, split ? 3 : 0); }
        __syncthreads(); ph_attn_sample(p, l, smem); ph_ret_sample(p, l, smem); ph_gdn_sample(p, l, smem); ph_ret_scan(p, l);
        if (l + 1 < NL) { const int G = (int)gridDim.x; const bool split = G >= CH_ITEMS + DB * 4 + 16; const int b0 = split ? CH_ITEMS : 0;
            __syncthreads(); ph_convert(p, smem, l == 0 ? CV_IN : (l + 1) * CV_L, (l + 2) * CV_L, b0, G); __syncthreads(); ph_adaln(p, smem, l + 1, l + 2, b0, G); } }
    else if constexpr (PH == PH_MIX3) { ph_attn_combine(p); ph_ret_out(p, l); ph_gdn_out(p, l, smem); }
    else if constexpr (PH == PH_GEMM_OUT) {
        ph_gemm_small<D>(p, WSP(bf16_t, WS_O) + (size_t)MP * D, WSP(bf16_t, WS_WOUT) + (size_t)l * D * D, WSP(float, WS_MOD) + (size_t)l * NC * 6144 + 2048, l == 0 ? p.x_sample : nullptr, smem); __syncthreads();
        pg8::Gemm g{WSP(bf16_t, WS_O), WSP(bf16_t, WS_WOUT) + (size_t)l * D * D, MP, D, D}; pg8::StaticOrder S; S.init(MP, D, (int)gridDim.x, (int)blockIdx.x);
        pg8::EpiResidual E{p.out, WSP(float, WS_MOD) + (size_t)l * NC * 6144 + 2048, l == 0 ? p.x_prompt : p.out};
        pg8::gemm_phase<pg8::EpiResidual, pg8::StaticOrder, true, true>(LDSP(smem), g, S, E);
    }
    else if constexpr (PH == PH_NORM2) ph_norm_mod<1>(p, l, smem);
    else if constexpr (PH == PH_GEMM_GU) {
        pg8::Gemm g{WSP(bf16_t, WS_H), WSP(bf16_t, WS_WGU) + (size_t)l * 2 * FF * D, MPAD, 2 * FF, D}; pg8::StaticOrder S; S.init(MPAD, 2 * FF, (int)gridDim.x, (int)blockIdx.x);
        pg8::EpiSwiglu E{WSP(bf16_t, WS_HID)};
        pg8::gemm_phase<pg8::EpiSwiglu, pg8::StaticOrder, true, true>(LDSP(smem), g, S, E);
    }
    else if constexpr (PH == PH_GEMM_DN) {
        ph_gemm_small<FF>(p, WSP(bf16_t, WS_HID) + (size_t)MP * FF, WSP(bf16_t, WS_WDN) + (size_t)l * D * FF, WSP(float, WS_MOD) + (size_t)l * NC * 6144 + 5120, nullptr, smem); __syncthreads();
        pg8::Gemm g{WSP(bf16_t, WS_HID), WSP(bf16_t, WS_WDN) + (size_t)l * D * FF, MP, D, FF}; pg8::StaticOrder S; S.init(MP, D, (int)gridDim.x, (int)blockIdx.x);
        pg8::EpiResidual E{p.out, WSP(float, WS_MOD) + (size_t)l * NC * 6144 + 5120, p.out};
        pg8::gemm_phase<pg8::EpiResidual, pg8::StaticOrder, true, true>(LDSP(smem), g, S, E);
    }
    else if constexpr (PH == PH_FINAL) ph_final_norm(p);
}
template <int PH> __global__ void __launch_bounds__(NTHR, 2) k_phase(P p, int l) { DYN_SMEM(smem); run_phase<PH>(p, l, smem); }


#ifndef __HIP_EMU__
#define LAS __attribute__((address_space(3)))
#define XB_TMO      128
#define XB_XCNT(j)  (256  + 64 * (j))
#define XB_XSUB(j)  (1280 + 64 * (j))
#define XB_XGEN(j)  (2304 + 64 * (j))
#define XB_TOP      3328
#define XB_TOPGEN   3392
#define XCD_BAR_WORDS 3456
#define XB_SPIN_CAP (1u << 18)

__device__ __forceinline__ unsigned xb_ld(unsigned* p)              { return __hip_atomic_load(p, __ATOMIC_RELAXED, __HIP_MEMORY_SCOPE_AGENT); }
__device__ __forceinline__ unsigned xb_add(unsigned* p, unsigned v) { return __hip_atomic_fetch_add(p, v, __ATOMIC_RELAXED, __HIP_MEMORY_SCOPE_AGENT); }
__device__ __forceinline__ unsigned xb_xcc_id() { return (unsigned)__builtin_amdgcn_s_getreg((3 << 11) | 20) & 0xFu; }
#define XB_SPIN(cond, bar) do { unsigned _sp = 0; while (cond) { __builtin_amdgcn_s_sleep(1); \
    if ((++_sp & 255u) == 0u) { if (xb_ld(&(bar)[XB_TMO])) break; if (_sp > XB_SPIN_CAP) { atomicAdd(&(bar)[XB_TMO], 1u); break; } } } } while (0)

struct XcdBarrier {
    unsigned* bar; unsigned x;
    volatile LAS unsigned* st;
};

__device__ __forceinline__ XcdBarrier xcd_barrier_post(unsigned* bar, volatile LAS unsigned* st) {
    XcdBarrier b; b.bar = bar; b.x = xb_xcc_id(); b.st = st;
    if (threadIdx.x == 0) (void)xb_add(&bar[XB_XCNT(b.x)], 1u);
    return b;
}
__device__ __forceinline__ void xcd_barrier_complete(unsigned* bar, unsigned x, unsigned& nloc, unsigned& nx) {
    const unsigned G = gridDim.x * gridDim.y * gridDim.z;
    unsigned sum, cnt, mine, sp = 0u;
    for (;;) {
        sum = 0u; cnt = 0u; mine = 0u;
#pragma unroll
        for (unsigned j = 0; j < 16; ++j) { const unsigned c = xb_ld(&bar[XB_XCNT(j)]); sum += c; cnt += (c > 0u) ? 1u : 0u; mine = (j == x) ? c : mine; }
        if (sum == G) break;
        __builtin_amdgcn_s_sleep(1);
        if ((++sp & 255u) == 0u) { if (xb_ld(&bar[XB_TMO])) break; if (sp > XB_SPIN_CAP) { atomicAdd(&bar[XB_TMO], 1u); break; } }
    }
    nloc = mine > 0u ? mine : 1u; nx = cnt > 0u ? cnt : 1u;
}

__device__ __forceinline__ void xcd_barrier(const XcdBarrier& b) {
    asm volatile("s_waitcnt vmcnt(0)" ::: "memory");
    __syncthreads();
    if (threadIdx.x == 0) {
        unsigned* bar = b.bar;
        __builtin_amdgcn_s_waitcnt(0);
        unsigned nloc = b.st[0], nx = b.st[1];
        if (nloc == 0u) { xcd_barrier_complete(bar, b.x, nloc, nx); b.st[0] = nloc; b.st[1] = nx; }
        const unsigned old = xb_add(&bar[XB_XSUB(b.x)], 1u);
        const unsigned gen = old / nloc;
        if (old + 1u == (gen + 1u) * nloc) {
            __builtin_amdgcn_fence(__ATOMIC_RELEASE, "agent");
            asm volatile("s_waitcnt vmcnt(0)" ::: "memory");
            const unsigned og = xb_add(&bar[XB_TOP], 1u);
            const unsigned tg = og / nx;
            if (og + 1u == (tg + 1u) * nx) xb_add(&bar[XB_TOPGEN], 1u);
            else XB_SPIN(xb_ld(&bar[XB_TOPGEN]) == tg, bar);
            __builtin_amdgcn_fence(__ATOMIC_ACQUIRE, "agent");
            xb_add(&bar[XB_XGEN(b.x)], 1u);
            asm volatile("s_waitcnt vmcnt(0)" ::: "memory");
        } else {
            XB_SPIN(xb_ld(&bar[XB_XGEN(b.x)]) == gen, bar);
            __builtin_amdgcn_fence(__ATOMIC_ACQUIRE, "agent");
            asm volatile("s_waitcnt vmcnt(0)" ::: "memory");
        }
    }
    __syncthreads();
}

#endif

#ifndef __HIP_EMU__
#define GRID_SYNC() xcd_barrier(bar)
__global__ void __launch_bounds__(NTHR, 2) k_mega(P p_arg) {
    DYN_SMEM(smem);
#if defined(__HIP_DEVICE_COMPILE__)
#define PHASE(PH_, l_) do { const __attribute__((address_space(4))) P* kp_ = (const __attribute__((address_space(4))) P*)__builtin_amdgcn_kernarg_segment_ptr(); LAUNDER_PTR(kp_); P pl_; __builtin_memcpy(&pl_, kp_, sizeof(P)); run_phase<PH_>(pl_, l_, smem); } while (0)
#else
#define PHASE(PH_, l_) run_phase<PH_>(p_arg, l_, smem)
#endif
    volatile LAS unsigned* bst = (volatile LAS unsigned*)((LAS unsigned char*)smem + BAR_LDS_OFF);
    if (threadIdx.x < 4) bst[threadIdx.x] = 0u;
    __syncthreads();
    XcdBarrier bar = xcd_barrier_post((unsigned*)(p_arg.ws + WS_CTL + 4096), bst);
    PHASE(PH_PRO, 0); GRID_SYNC();
#define LAYER(l) do { PHASE(PH_NORM1, l); GRID_SYNC(); PHASE(PH_GEMM_IN, l); GRID_SYNC(); PHASE(PH_ROPE, l); GRID_SYNC(); PHASE(PH_MIX2, l); GRID_SYNC(); \
        PHASE(PH_MIX3, l); GRID_SYNC(); PHASE(PH_GEMM_OUT, l); GRID_SYNC(); PHASE(PH_NORM2, l); GRID_SYNC(); PHASE(PH_GEMM_GU, l); GRID_SYNC(); PHASE(PH_GEMM_DN, l); GRID_SYNC(); } while (0)
    static_assert(NL == 2, "two layers written out (a loop over the layers makes hipcc hoist every phase's constants to the loop preheader and spill)");
    LAYER(0); LAYER(1);
    PHASE(PH_FINAL, 0);
}
#endif

template <int PH> static void launch_phase(const P& p, int l, int grid, hipStream_t stream) {
#ifndef __HIP_EMU__
    static bool attr_done = false;
    if (!attr_done) { (void)hipFuncSetAttribute((const void*)k_phase<PH>, hipFuncAttributeMaxDynamicSharedMemorySize, SMEM_BYTES); attr_done = true; }
#endif
    LAUNCH(k_phase<PH>, grid, SMEM_BYTES, stream, p, l);
}

extern "C" void kernel_launch(void* const* d_in, const int* in_sizes, int n_in, void* d_out, int out_size, void* d_ws, size_t ws_size, hipStream_t stream) {
    if (n_in != 24 || (size_t)out_size != O_END || ws_size < WS_END) {
        fprintf(stderr, "kernel_launch: shape mismatch: n_in %d out_size %d (want %zu) ws %zu (want %zu)\n", n_in, out_size, (size_t)O_END, ws_size, (size_t)WS_END); return; }
    P p{};
    const float** pp = (const float**)&p;
    for (int i = 0; i < 24; ++i) pp[i] = (const float*)d_in[i];
    p.out = (float*)d_out; p.ws = (unsigned char*)d_ws;
#ifndef __HIP_EMU__
    static int grid = 0;
    if (grid == 0) {
        int dev = 0, cus = 0, per_cu = 0;
        if (hipGetDevice(&dev) != hipSuccess || hipDeviceGetAttribute(&cus, hipDeviceAttributeMultiprocessorCount, dev) != hipSuccess || cus <= 0) { fprintf(stderr, "kernel_launch: device query failed\n"); grid = -1; return; }
        if (hipFuncSetAttribute((const void*)k_mega, hipFuncAttributeMaxDynamicSharedMemorySize, SMEM_BYTES) != hipSuccess) { fprintf(stderr, "kernel_launch: hipFuncSetAttribute failed\n"); grid = -1; return; }
        if (hipOccupancyMaxActiveBlocksPerMultiprocessor(&per_cu, (const void*)k_mega, NTHR, SMEM_BYTES) != hipSuccess || per_cu < 1) { fprintf(stderr, "kernel_launch: occupancy query says %d blocks per CU\n", per_cu); grid = -1; return; }
        grid = cus;
    }
    if (grid < 0) return;
    if (hipMemsetAsync((char*)d_ws + WS_CTL, 0, 65536, stream) != hipSuccess) { fprintf(stderr, "kernel_launch: memset of the barrier words failed\n"); return; }
    { void* args[] = {(void*)&p};
      hipError_t e = hipLaunchCooperativeKernel((const void*)k_mega, dim3(grid), dim3(NTHR), args, SMEM_BYTES, stream);
      if (e != hipSuccess) fprintf(stderr, "kernel_launch: cooperative launch failed: %s (grid %d)\n", hipGetErrorString(e), grid);
      return; }
#else
    int grid = 16;
#endif
    launch_phase<PH_PRO>(p, 0, grid, stream);
    for (int l = 0; l < NL; ++l) {
        launch_phase<PH_NORM1>(p, l, grid, stream);
        launch_phase<PH_GEMM_IN>(p, l, grid, stream);
        launch_phase<PH_ROPE>(p, l, grid, stream);
        launch_phase<PH_MIX2>(p, l, grid, stream);
        launch_phase<PH_MIX3>(p, l, grid, stream);
        launch_phase<PH_GEMM_OUT>(p, l, grid, stream);
        launch_phase<PH_NORM2>(p, l, grid, stream);
        launch_phase<PH_GEMM_GU>(p, l, grid, stream);
        launch_phase<PH_GEMM_DN>(p, l, grid, stream);
    }
    launch_phase<PH_FINAL>(p, 0, grid, stream);
}
```
